# Optimizing an MI355X kernel written in HIP

```python
import jax, jax.numpy as jnp
from jax import lax
import numpy as np

D_MODEL = 1024
BATCH = 4
SEQ = 4096
DEPTH = 1
DEC_BATCH = 128
DEC_SEQ = 4
PAST_LEN = 2048
PAGE_SIZE = 128

A_HEADS = 4
A_DQK = 128
A_DV = 256
A_CHUNK = 64
B_HEADS = 16
B_KV = 4
B_REP = B_HEADS // B_KV
B_HD = 64
CMP_BLOCK = 64
SEL_BLOCK = 64
N_SEL = 16
WINDOW = 512
SEL_QBLOCK = 64
WIN_QBLOCK = 128
P_HEADS = 8
P_NKEYS = 128
P_EXPERTS = P_NKEYS * P_NKEYS
P_DKEY = 256
P_DHALF = P_DKEY // 2
P_TOPK = 16
P_TBLOCK = 256
DN_ALPHA = (2.0 * DEPTH) ** 0.25
DN_BETA = (8.0 * DEPTH) ** -0.25
LN_EPS = 1e-5
NEG = -1e30

SPLIT_SIZES = (A_HEADS * A_DQK, A_HEADS * A_DQK, A_HEADS * A_DV, A_HEADS, A_HEADS, A_HEADS * A_DV,
               B_HEADS * B_HD, 2 * B_KV * B_HD, 2 * B_KV * B_HD, 2 * B_KV * B_HD, 3 * B_HEADS)
D_IN = sum(SPLIT_SIZES)

kernel_name = "hybrid_mlstm_nsa_peer_step"


def layer_norm(x, g, b):
    xf = x.astype(jnp.float32)
    mu = xf.mean(-1, keepdims=True)
    var = jnp.square(xf - mu).mean(-1, keepdims=True)
    return ((xf - mu) * lax.rsqrt(var + LN_EPS) * g + b).astype(x.dtype)


def alibi_slopes():
    s = 2.0 ** (-8.0 * np.arange(1, B_HEADS + 1) / B_HEADS)
    return jnp.asarray(s, jnp.float32).reshape(B_KV, B_REP)


def in_projection(x, w_in, b_in):
    proj = jnp.einsum('btd,de->bte', x, w_in) + b_in
    return jnp.split(proj, np.cumsum(SPLIT_SIZES)[:-1].tolist(), axis=-1)


def mlstm_scan(q, k, v, i_pre, log_f, C0, n0, m0, chunk):
    b_, h_, t_, _ = q.shape
    nc = t_ // chunk

    def to_chunks(a):
        return jnp.moveaxis(a.reshape(a.shape[:2] + (nc, chunk) + a.shape[3:]), 2, 0)

    causal = jnp.tril(jnp.ones((chunk, chunk), dtype=bool))

    def step(carry, inp):
        C, n, m = carry
        qc, kc, vc, ic, fc = inp
        b = jnp.cumsum(fc, axis=-1)
        d_log = jnp.where(causal, b[..., :, None] - b[..., None, :] + ic[..., None, :], -jnp.inf)
        inter = b + m[..., None]
        m_t = jnp.maximum(inter, d_log.max(-1))
        s = jnp.einsum('bhtd,bhsd->bhts', qc, kc) * jnp.exp(d_log - m_t[..., None])
        w_inter = jnp.exp(inter - m_t)
        num = w_inter[..., None] * jnp.einsum('bhtd,bhdv->bhtv', qc, C) + jnp.einsum('bhts,bhsv->bhtv', s, vc)
        den = w_inter * jnp.einsum('bhtd,bhd->bht', qc, n) + s.sum(-1)
        h = num / jnp.maximum(jnp.abs(den), jnp.exp(-m_t))[..., None]
        b_end = b[..., -1]
        g = b_end[..., None] - b + ic
        m_new = jnp.maximum(b_end + m, g.max(-1))
        a = jnp.exp(b_end + m - m_new)
        w = jnp.exp(g - m_new[..., None])
        C_new = a[..., None, None] * C + jnp.einsum('bhs,bhsd,bhsv->bhdv', w, kc, vc)
        n_new = a[..., None] * n + jnp.einsum('bhs,bhsd->bhd', w, kc)
        return (C_new, n_new, m_new), h

    (C, n, m), h = lax.scan(step, (C0, n0, m0), tuple(to_chunks(a) for a in (q, k, v, i_pre, log_f)))
    h = jnp.moveaxis(h, 0, 2).reshape(b_, h_, t_, v.shape[-1])
    return h, C, n, m


def mlstm_branch(a_q, a_k, a_v, a_i, a_f, a_o, C0, n0, m0, chunk, norm_a_g):
    B, T, _ = a_q.shape
    f32 = jnp.float32

    def heads(a, d):
        return a.reshape(B, T, A_HEADS, d).transpose(0, 2, 1, 3).astype(f32)

    q = heads(a_q, A_DQK)
    k = heads(a_k, A_DQK) * (A_DQK ** -0.5)
    v = heads(a_v, A_DV)
    i_pre = a_i.astype(f32).transpose(0, 2, 1)
    log_f = jax.nn.log_sigmoid(a_f.astype(f32)).transpose(0, 2, 1)
    h, C, n, m = mlstm_scan(q, k, v, i_pre, log_f, C0.astype(f32), n0.astype(f32), m0.astype(f32), chunk)
    mu = h.mean(-1, keepdims=True)
    var = jnp.square(h - mu).mean(-1, keepdims=True)
    h = ((h - mu) * lax.rsqrt(var + LN_EPS)).transpose(0, 2, 1, 3).reshape(B, T, A_HEADS * A_DV) * norm_a_g
    y = (h * jax.nn.sigmoid(a_o.astype(f32))).astype(a_q.dtype)
    return y, C, n, m


def dense_attn(q, k, v, q_pos, k_pos, slopes, window):
    s = jnp.einsum('...qgrd,...kgd->...grqk', q, k).astype(jnp.float32) * (B_HD ** -0.5)
    dist = q_pos[..., None, None, :, None] - k_pos[..., None, None, None, :]
    s = s - slopes[:, :, None, None] * dist.astype(jnp.float32)
    mask = (dist >= 0) & (k_pos >= 0)[..., None, None, None, :]
    if window is not None:
        mask = mask & (dist < window)
    p = jnp.where(mask, jax.nn.softmax(jnp.where(mask, s, NEG), axis=-1), 0.0)
    o = jnp.einsum('...grqk,...kgd->...qgrd', p.astype(v.dtype), v)
    return o, p


def pad_blocks(a):
    pad = (-a.shape[1]) % SEL_BLOCK
    return jnp.pad(a, ((0, 0), (0, pad)) + ((0, 0),) * (a.ndim - 2))


def compress(kv, pe, w_cmp):
    B, Tp, G, d = kv.shape
    blk = kv.reshape(B, Tp // CMP_BLOCK, CMP_BLOCK, G, d) + pe[:, None, :]
    return jnp.einsum('bnlgd,lde->bnge', blk, w_cmp)


def select_attn(q, k, v, q_pos, blk_idx, slopes):
    B, Tq, G, R, d = q.shape
    qb = SEL_QBLOCK if Tq % SEL_QBLOCK == 0 else Tq
    nq = Tq // qb
    n_sel = blk_idx.shape[-1]
    kt = k.transpose(0, 2, 1, 3)
    vt = v.transpose(0, 2, 1, 3)
    b_ix = jnp.arange(B)[:, None, None]
    g_ix = jnp.arange(G)[None, :, None]
    offs = jnp.arange(SEL_BLOCK)

    def one_block(args):
        qi, ii, pi = args
        tok = (ii[..., None] * SEL_BLOCK + offs).reshape(B, G, qb * n_sel * SEL_BLOCK)
        kg = kt[b_ix, g_ix, tok].reshape(B, G, qb, n_sel * SEL_BLOCK, d)
        vg = vt[b_ix, g_ix, tok].reshape(B, G, qb, n_sel * SEL_BLOCK, d)
        tok = tok.reshape(B, G, qb, n_sel * SEL_BLOCK)
        s = jnp.einsum('bqgrd,bgqkd->bgrqk', qi, kg).astype(jnp.float32) * (B_HD ** -0.5)
        dist = (pi[None, None, :, None] - tok)[:, :, None]
        s = s - slopes[None, :, :, None, None] * dist.astype(jnp.float32)
        mask = dist >= 0
        p = jnp.where(mask, jax.nn.softmax(jnp.where(mask, s, NEG), axis=-1), 0.0)
        return jnp.einsum('bgrqk,bgqkd->bqgrd', p.astype(v.dtype), vg)

    q_blocks = jnp.moveaxis(q.reshape(B, nq, qb, G, R, d), 1, 0)
    i_blocks = jnp.moveaxis(blk_idx.reshape(B, G, nq, qb, n_sel), 2, 0)
    p_blocks = q_pos.reshape(nq, qb)
    o = lax.map(one_block, (q_blocks, i_blocks, p_blocks))
    return jnp.moveaxis(o, 0, 1).reshape(B, Tq, G, R, d)


def nsa_cmp_slc(q, k_cmp, v_cmp, k_slc, v_slc, q_pos, nsa_pe, nsa_w_cmp, slopes):
    k_cmp, v_cmp, k_slc, v_slc = pad_blocks(k_cmp), pad_blocks(v_cmp), pad_blocks(k_slc), pad_blocks(v_slc)
    nb = k_cmp.shape[1] // CMP_BLOCK
    kc = compress(k_cmp, nsa_pe[0], nsa_w_cmp[0])
    vc = compress(v_cmp, nsa_pe[1], nsa_w_cmp[1])
    blk_end = (jnp.arange(nb) + 1) * CMP_BLOCK - 1
    o_cmp, p_cmp = dense_attn(q, kc, vc, q_pos, blk_end, slopes, None)
    imp = p_cmp.sum(2)
    j = jnp.arange(nb)[None, :]
    cur = (q_pos // SEL_BLOCK)[:, None]
    imp = jnp.where((j == cur) | (j == 0), float(B_REP + 1), imp)
    imp = jnp.where(j > cur, -1.0, imp)
    _, blk_idx = lax.top_k(imp, min(N_SEL, nb))
    o_slc = select_attn(q, k_slc, v_slc, q_pos, blk_idx, slopes)
    return o_cmp, o_slc


def window_prompt(q, k, v, slopes):
    B, T, G, R, d = q.shape
    nq = T // WIN_QBLOCK
    span = WINDOW + WIN_QBLOCK
    kp = jnp.pad(k, ((0, 0), (WINDOW, 0), (0, 0), (0, 0)))
    vp = jnp.pad(v, ((0, 0), (WINDOW, 0), (0, 0), (0, 0)))
    idx = jnp.arange(nq)[:, None] * WIN_QBLOCK + jnp.arange(span)[None, :]
    q_pos = jnp.arange(T).reshape(nq, WIN_QBLOCK)
    o, _ = dense_attn(q.reshape(B, nq, WIN_QBLOCK, G, R, d), kp[:, idx], vp[:, idx], q_pos, idx - WINDOW,
                      slopes, WINDOW)
    return o.reshape(B, T, G, R, d)


def token_mixers(x, q_pos, C0, n0, m0, chunk, past_cmp, past_slc, win_buf,
                 w_in, b_in, norm_a_g, nsa_pe, nsa_w_cmp):
    B, T, _ = x.shape
    a_q, a_k, a_v, a_i, a_f, a_o, b_q, b_cmp, b_slc, b_win, b_gate = in_projection(x, w_in, b_in)
    y_a, C, n, m = mlstm_branch(a_q, a_k, a_v, a_i, a_f, a_o, C0, n0, m0, chunk, norm_a_g)
    slopes = alibi_slopes()
    q = b_q.reshape(B, T, B_KV, B_REP, B_HD)
    kv_cmp = b_cmp.reshape(B, T, 2, B_KV, B_HD)
    kv_slc = b_slc.reshape(B, T, 2, B_KV, B_HD)
    kv_win = b_win.reshape(B, T, 2, B_KV, B_HD)
    if past_cmp is None:
        all_cmp, all_slc = kv_cmp, kv_slc
        o_win = window_prompt(q, kv_win[:, :, 0], kv_win[:, :, 1], slopes)
        new_win = kv_win[:, -min(WINDOW, T):]
    else:
        all_cmp = jnp.concatenate([past_cmp, kv_cmp], axis=1)
        all_slc = jnp.concatenate([past_slc, kv_slc], axis=1)
        buf = jnp.concatenate([win_buf, kv_win], axis=1)
        wb = win_buf.shape[1]
        k_pos = past_cmp.shape[1] - wb + jnp.arange(buf.shape[1])
        o_win, _ = dense_attn(q, buf[:, :, 0], buf[:, :, 1], q_pos, k_pos, slopes, WINDOW)
        new_win = buf[:, -wb:]
    o_cmp, o_slc = nsa_cmp_slc(q, all_cmp[:, :, 0], all_cmp[:, :, 1], all_slc[:, :, 0], all_slc[:, :, 1],
                               q_pos, nsa_pe, nsa_w_cmp, slopes)
    g = jax.nn.sigmoid(b_gate.astype(jnp.float32).reshape(B, T, 3, B_KV, B_REP))[..., None]
    y_b = (g[:, :, 0] * o_cmp + g[:, :, 1] * o_slc + g[:, :, 2] * o_win).reshape(B, T, B_HEADS * B_HD)
    return y_a, y_b.astype(x.dtype), kv_cmp, kv_slc, new_win, C, n, m


def peer_ffn(x, peer_wq, peer_keys, peer_u, peer_v):
    B, T, D = x.shape
    xf = x.reshape(B * T, D)
    n_tok = B * T
    xf = jnp.pad(xf, ((0, (-n_tok) % P_TBLOCK), (0, 0)))

    def one(xb):
        q = (xb @ peer_wq).reshape(P_TBLOCK, P_HEADS, 2, P_DHALF)
        s = jnp.einsum('tpcd,pckd->tpck', q, peer_keys).astype(jnp.float32)
        s1, i1 = lax.top_k(s[:, :, 0], P_TOPK)
        s2, i2 = lax.top_k(s[:, :, 1], P_TOPK)
        cand = (s1[..., :, None] + s2[..., None, :]).reshape(P_TBLOCK, P_HEADS, P_TOPK * P_TOPK)
        cidx = (i1[..., :, None] * P_NKEYS + i2[..., None, :]).reshape(P_TBLOCK, P_HEADS, P_TOPK * P_TOPK)
        top_s, j = lax.top_k(cand, P_TOPK)
        eidx = jnp.take_along_axis(cidx, j, axis=-1)
        gate = jax.nn.softmax(top_s, axis=-1)
        u = peer_u[eidx]
        v = peer_v[eidx]
        act = jax.nn.gelu(jnp.einsum('td,tpkd->tpk', xb, u).astype(jnp.float32), approximate=False)
        return jnp.einsum('tpk,tpkd->td', (gate * act).astype(v.dtype), v)

    out = lax.map(one, xf.reshape(-1, P_TBLOCK, D)).reshape(-1, D)[:n_tok]
    return out.reshape(B, T, D)


def layer_tail(x, y_a, y_b, w_br_a, w_br_b, w_merge, w_out, ln1_g, ln1_b,
               peer_wq, peer_keys, peer_u, peer_v, ln2_g, ln2_b):
    B, T, D = x.shape
    gates = jax.nn.sigmoid(jnp.einsum('btd,de->bte', x, w_merge)).reshape(B, T, 2, D)
    merged = gates[:, :, 0] * (y_a @ w_br_a) + gates[:, :, 1] * (y_b @ w_br_b)
    h = layer_norm(DN_ALPHA * x + merged @ w_out, ln1_g, ln1_b)
    return layer_norm(DN_ALPHA * h + peer_ffn(h, peer_wq, peer_keys, peer_u, peer_v), ln2_g, ln2_b)


def setup_inputs(seed: int = 0) -> dict:
    key = jax.random.key(seed)
    ks = jax.random.split(key, 28)
    nrm = jax.random.normal
    n_pages = PAST_LEN // PAGE_SIZE
    n_used = DEC_BATCH * n_pages
    n_pool = n_used + n_used // 4
    win_buf = min(WINDOW, PAST_LEN)
    f_start = int(np.cumsum(SPLIT_SIZES)[3])
    b_in = 0.02 * nrm(ks[10], (D_IN,))
    b_in = b_in.at[f_start:f_start + A_HEADS].add(jnp.linspace(3.0, 6.0, A_HEADS))
    return {
        'x_prompt': nrm(ks[0], (BATCH, SEQ, D_MODEL)),
        'x_sample': nrm(ks[1], (DEC_BATCH, DEC_SEQ, D_MODEL)),
        'cache_cmp_kv': nrm(ks[2], (n_pool, PAGE_SIZE, 2, B_KV, B_HD)),
        'cache_slc_kv': nrm(ks[3], (n_pool, PAGE_SIZE, 2, B_KV, B_HD)),
        'cache_win_kv': nrm(ks[4], (DEC_BATCH, win_buf, 2, B_KV, B_HD)),
        'state_C': 0.1 * nrm(ks[5], (DEC_BATCH, A_HEADS, A_DQK, A_DV)),
        'state_n': 0.1 * nrm(ks[6], (DEC_BATCH, A_HEADS, A_DQK)),
        'state_m': 0.5 * nrm(ks[7], (DEC_BATCH, A_HEADS)),
        'page_table': jax.random.permutation(ks[8], n_pool)[:n_used].reshape(DEC_BATCH, n_pages).astype(jnp.int32),
        'w_in': nrm(ks[9], (D_MODEL, D_IN)) * D_MODEL ** -0.5,
        'b_in': b_in,
        'norm_a_g': 1.0 + 0.02 * nrm(ks[11], (A_HEADS * A_DV,)),
        'nsa_pe': 0.02 * nrm(ks[12], (2, CMP_BLOCK, B_HD)),
        'nsa_w_cmp': nrm(ks[13], (2, CMP_BLOCK, B_HD, B_HD)) * (CMP_BLOCK * B_HD) ** -0.5,
        'w_br_a': nrm(ks[14], (A_HEADS * A_DV, D_MODEL)) * (A_HEADS * A_DV) ** -0.5 * DN_BETA,
        'w_br_b': nrm(ks[15], (B_HEADS * B_HD, D_MODEL)) * (B_HEADS * B_HD) ** -0.5 * DN_BETA,
        'w_merge': nrm(ks[16], (D_MODEL, 2 * D_MODEL)) * D_MODEL ** -0.5,
        'w_out': nrm(ks[17], (D_MODEL, D_MODEL)) * D_MODEL ** -0.5 * DN_BETA,
        'ln1_g': 1.0 + 0.02 * nrm(ks[18], (D_MODEL,)),
        'ln1_b': 0.02 * nrm(ks[19], (D_MODEL,)),
        'peer_wq': nrm(ks[20], (D_MODEL, P_HEADS * P_DKEY)) * D_MODEL ** -0.5,
        'peer_keys': nrm(ks[21], (P_HEADS, 2, P_NKEYS, P_DHALF)) * P_DHALF ** -0.5,
        'peer_u': nrm(ks[22], (P_EXPERTS, D_MODEL)) * D_MODEL ** -0.5,
        'peer_v': nrm(ks[23], (P_EXPERTS, D_MODEL)) * P_HEADS ** -0.5 * DN_BETA,
        'ln2_g': 1.0 + 0.02 * nrm(ks[24], (D_MODEL,)),
        'ln2_b': 0.02 * nrm(ks[25], (D_MODEL,)),
    }


def reference(x_prompt, x_sample, cache_cmp_kv, cache_slc_kv, cache_win_kv, state_C, state_n, state_m,
              page_table, w_in, b_in, norm_a_g, nsa_pe, nsa_w_cmp, w_br_a, w_br_b, w_merge, w_out,
              ln1_g, ln1_b, peer_wq, peer_keys, peer_u, peer_v, ln2_g, ln2_b):
    Bp, Tp, _ = x_prompt.shape
    dt = x_prompt.dtype
    C0 = jnp.zeros((Bp, A_HEADS, A_DQK, A_DV), jnp.float32)
    n0 = jnp.zeros((Bp, A_HEADS, A_DQK), jnp.float32)
    m0 = jnp.zeros((Bp, A_HEADS), jnp.float32)
    ya, yb, p_cmp, p_slc, p_win, p_C, p_n, p_m = token_mixers(
        x_prompt, jnp.arange(Tp), C0, n0, m0, A_CHUNK, None, None, None,
        w_in, b_in, norm_a_g, nsa_pe, nsa_w_cmp)
    y_prompt = layer_tail(x_prompt, ya, yb, w_br_a, w_br_b, w_merge, w_out, ln1_g, ln1_b,
                          peer_wq, peer_keys, peer_u, peer_v, ln2_g, ln2_b)
    Bs, Ts, _ = x_sample.shape
    past_len = page_table.shape[1] * PAGE_SIZE
    past_cmp = cache_cmp_kv[page_table].reshape(Bs, past_len, 2, B_KV, B_HD)
    past_slc = cache_slc_kv[page_table].reshape(Bs, past_len, 2, B_KV, B_HD)
    ya_s, yb_s, s_cmp, s_slc, s_win, s_C, s_n, s_m = token_mixers(
        x_sample, past_len + jnp.arange(Ts), state_C, state_n, state_m, Ts, past_cmp, past_slc, cache_win_kv,
        w_in, b_in, norm_a_g, nsa_pe, nsa_w_cmp)
    y_sample = layer_tail(x_sample, ya_s, yb_s, w_br_a, w_br_b, w_merge, w_out, ln1_g, ln1_b,
                          peer_wq, peer_keys, peer_u, peer_v, ln2_g, ln2_b)
    sd = state_C.dtype
    return (y_prompt, y_sample, p_cmp, p_slc, p_win, p_C.astype(dt), p_n.astype(dt), p_m.astype(dt),
            s_cmp, s_slc, s_win, s_C.astype(sd), s_n.astype(sd), s_m.astype(sd))
```

```cpp
#include <hip/hip_runtime.h>
#include <stdint.h>

#ifndef MK_ONE_LAUNCH
#define MK_ONE_LAUNCH 0
#endif

typedef unsigned short bf16_t;
typedef short bf16x8 __attribute__((ext_vector_type(8)));
typedef float f32x4 __attribute__((ext_vector_type(4)));
typedef unsigned u32x4 __attribute__((ext_vector_type(4)));
typedef unsigned u32x2 __attribute__((ext_vector_type(2)));
#define DEVI __device__ __forceinline__

constexpr int NTP = 16384, NTS = 512, NT = NTP + NTS, DM = 1024;
constexpr int PS = 5632;
constexpr int C_AQ = 0, C_AK = 512, C_AV = 1024, C_AO = 2048, C_BQ = 3072, C_CMP = 4096, C_SLC = 4608, C_WIN = 5120;
constexpr int NPAD_IN = 5888;
constexpr float DN_ALPHA = 1.189207115002721f;
constexpr float LN_EPS = 1e-5f;
constexpr size_t O_Y = 0;
constexpr size_t O_PCMP = O_Y + (size_t)NT * 1024;
constexpr size_t O_PSLC = O_PCMP + (size_t)NTP * 512;
constexpr size_t O_PWIN = O_PSLC + (size_t)NTP * 512;
constexpr size_t O_PC = O_PWIN + (size_t)4 * 512 * 512;
constexpr size_t O_PN = O_PC + (size_t)16 * 128 * 256;
constexpr size_t O_PM = O_PN + 16 * 128;
constexpr size_t O_SCMP = O_PM + 16;
constexpr size_t O_SSLC = O_SCMP + (size_t)NTS * 512;
constexpr size_t O_SWIN = O_SSLC + (size_t)NTS * 512;
constexpr size_t O_SC = O_SWIN + (size_t)128 * 512 * 512;
constexpr size_t O_SN = O_SC + (size_t)512 * 128 * 256;
constexpr size_t O_SM = O_SN + 512 * 128;

struct P {
    const float *xp, *xs, *cache_cmp, *cache_slc, *cache_win, *state_C, *state_n, *state_m;
    const int* page_table;
    const float *w_in, *b_in, *norm_a_g, *nsa_pe, *nsa_w_cmp, *w_br_a, *w_br_b, *w_merge, *w_out, *ln1_g, *ln1_b;
    const float *peer_wq, *peer_keys, *peer_u, *peer_v, *ln2_g, *ln2_b;
    float* out;
    bf16_t *XB, *WINT, *WMT, *WAT, *WBT, *WOT, *WQT, *KEYSB, *UB, *VB, *PROJ;
    float *SM, *BCUM, *MPREV, *ACOEF, *SCL, *MLOC, *DC, *DN, *CPREV, *NPREV, *KC, *VC, *OCMP;
    unsigned long long* SEL;
    bf16_t *YA, *YB, *G, *MERGED, *HB, *PQ;
    float *TMP, *R, *H, *EGATE;
    int* EIDX;
    unsigned* bar;
};

DEVI bf16_t f2bf(float f) { unsigned u = __float_as_uint(f); u += 0x7FFFu + ((u >> 16) & 1u); return (bf16_t)(u >> 16); }
DEVI float bf2f(bf16_t h) { return __uint_as_float(((unsigned)h) << 16); }
DEVI unsigned pack2(float a, float b) { return (unsigned)f2bf(a) | ((unsigned)f2bf(b) << 16); }
DEVI float wave_max(float v) { for (int o = 32; o > 0; o >>= 1) v = fmaxf(v, __shfl_xor(v, o)); return v; }
DEVI float wave_sum(float v) { for (int o = 32; o > 0; o >>= 1) v += __shfl_xor(v, o); return v; }
DEVI float sigmoidf_(float x) { return 1.f / (1.f + __expf(-x)); }
DEVI float logsigmoidf_(float x) { return fminf(x, 0.f) - log1pf(__expf(-fabsf(x))); }
DEVI int win_map(int np) {
    if (np < 2048) return np;
    if (np < 5632) return np + 8;
    if (np < 5640) return np - 5632 + 2048;
    if (np < 5688) return np;
    return -1;
}
DEVI float alibi_slope(int h) { return exp2f(-0.5f * (float)(h + 1)); }

template <class MapFn>
DEVI void transpose_cvt(const float* __restrict__ W, bf16_t* __restrict__ WT, int K, int Nsrc, int Ndst, MapFn mapfn, float* tile  , int bid, int nblk) {
    const int tid = threadIdx.x;
    const int tn = Ndst / 64, tk = K / 64;
    for (int t = bid; t < tn * tk; t += nblk) {
        const int n0 = (t % tn) * 64, k0 = (t / tn) * 64;
        __syncthreads();
#pragma unroll
        for (int i = 0; i < 8; ++i) {
            const int kk = (tid >> 6) + i * 8, nn = tid & 63;
            const int n = mapfn(n0 + nn);
            tile[kk * 65 + nn] = n >= 0 ? W[(size_t)(k0 + kk) * Nsrc + n] : 0.f;
        }
        __syncthreads();
#pragma unroll
        for (int i = 0; i < 8; ++i) {
            const int nn = (tid >> 6) + i * 8, kk = tid & 63;
            WT[(size_t)(n0 + nn) * K + k0 + kk] = f2bf(tile[kk * 65 + nn]);
        }
    }
}
struct IdMap { DEVI int operator()(int n) const { return n; } };
struct WinMap { DEVI int operator()(int n) const { return win_map(n); } };

DEVI void cvt_rows(const float* __restrict__ src, bf16_t* __restrict__ dst, size_t n4, int bid, int nblk) {
    for (size_t i = (size_t)bid * blockDim.x + threadIdx.x; i < n4; i += (size_t)nblk * blockDim.x) {
        const f32x4 v = ((const f32x4*)src)[i];
        u32x2 o; o.x = pack2(v.x, v.y); o.y = pack2(v.z, v.w);
        ((u32x2*)dst)[i] = o;
    }
}

DEVI void stage_prologue(const P& p, char* smem, int bid, int nblk) {
    float* tile = (float*)smem;
    cvt_rows(p.xp, p.XB, (size_t)NTP * 256, bid, nblk);
    cvt_rows(p.xs, p.XB + (size_t)NTP * 1024, (size_t)NTS * 256, bid, nblk);
    cvt_rows(p.peer_u, p.UB, (size_t)16384 * 256, bid, nblk);
    cvt_rows(p.peer_v, p.VB, (size_t)16384 * 256, bid, nblk);
    cvt_rows(p.peer_keys, p.KEYSB, (size_t)16 * 128 * 128 / 4, bid, nblk);
    transpose_cvt(p.w_in, p.WINT, 1024, 5688, NPAD_IN, WinMap(), tile, bid, nblk);
    transpose_cvt(p.w_merge, p.WMT, 1024, 2048, 2048, IdMap(), tile, bid, nblk);
    transpose_cvt(p.w_br_a, p.WAT, 1024, 1024, 1024, IdMap(), tile, bid, nblk);
    transpose_cvt(p.w_br_b, p.WBT, 1024, 1024, 1024, IdMap(), tile, bid, nblk);
    transpose_cvt(p.w_out, p.WOT, 1024, 1024, 1024, IdMap(), tile, bid, nblk);
    transpose_cvt(p.peer_wq, p.WQT, 1024, 2048, 2048, IdMap(), tile, bid, nblk);
    {
        const size_t per_b = (size_t)508 * 512 / 4;
        for (size_t i = (size_t)bid * blockDim.x + threadIdx.x; i < 128 * per_b; i += (size_t)nblk * blockDim.x) {
            const size_t b = i / per_b, r = i % per_b;
            ((f32x4*)(p.out + O_SWIN + b * 512 * 512))[r] = ((const f32x4*)(p.cache_win + b * 512 * 512 + 4 * 512))[r];
        }
    }
}

template <class Epi>
DEVI void gemm_phase(const bf16_t* __restrict__ A, const bf16_t* __restrict__ Bt, int M, int N, int K, const Epi& epi, char* smem, int bid, int nblk) {
    bf16_t* As = (bf16_t*)smem;
    bf16_t* Bs = As + 256 * 72;
    const int tid = threadIdx.x, lane = tid & 63, wid = tid >> 6, wm = wid >> 1, wn = wid & 1;
    const int fr = lane & 15, fq = lane >> 4;
    const int ntm = M / 256, ntn = N / 128, nk = K / 64;
    for (int tile = bid; tile < ntm * ntn; tile += nblk) {
        const int tm = tile / ntn, tn = tile % ntn;
        f32x4 acc[4][4];
#pragma unroll
        for (int i = 0; i < 4; ++i)
#pragma unroll
            for (int j = 0; j < 4; ++j) acc[i][j] = (f32x4){0.f, 0.f, 0.f, 0.f};
        const bf16_t* Ag = A + (size_t)(tm * 256 + (tid >> 1)) * K + (tid & 1) * 32;
        const bf16_t* Bg = Bt + (size_t)(tn * 128 + (tid >> 2)) * K + (tid & 3) * 16;
        u32x4 ra[4], rb[2];
#pragma unroll
        for (int i = 0; i < 4; ++i) ra[i] = *(const u32x4*)(Ag + i * 8);
#pragma unroll
        for (int i = 0; i < 2; ++i) rb[i] = *(const u32x4*)(Bg + i * 8);
        for (int kt = 0; kt < nk; ++kt) {
            __syncthreads();
#pragma unroll
            for (int i = 0; i < 4; ++i) *(u32x4*)(As + (tid >> 1) * 72 + (tid & 1) * 32 + i * 8) = ra[i];
#pragma unroll
            for (int i = 0; i < 2; ++i) *(u32x4*)(Bs + (tid >> 2) * 72 + (tid & 3) * 16 + i * 8) = rb[i];
            __syncthreads();
            if (kt + 1 < nk) {
#pragma unroll
                for (int i = 0; i < 4; ++i) ra[i] = *(const u32x4*)(Ag + (kt + 1) * 64 + i * 8);
#pragma unroll
                for (int i = 0; i < 2; ++i) rb[i] = *(const u32x4*)(Bg + (kt + 1) * 64 + i * 8);
            }
#pragma unroll
            for (int ks = 0; ks < 2; ++ks) {
                bf16x8 af[4], bfr[4];
#pragma unroll
                for (int i = 0; i < 4; ++i) af[i] = *(const bf16x8*)(As + (wm * 64 + i * 16 + fr) * 72 + ks * 32 + fq * 8);
#pragma unroll
                for (int j = 0; j < 4; ++j) bfr[j] = *(const bf16x8*)(Bs + (wn * 64 + j * 16 + fr) * 72 + ks * 32 + fq * 8);
#pragma unroll
                for (int i = 0; i < 4; ++i)
#pragma unroll
                    for (int j = 0; j < 4; ++j) acc[i][j] = __builtin_amdgcn_mfma_f32_16x16x32_bf16(bfr[j], af[i], acc[i][j], 0, 0, 0);
            }
        }
#pragma unroll
        for (int i = 0; i < 4; ++i)
#pragma unroll
            for (int j = 0; j < 4; ++j) epi(tm * 256 + wm * 64 + i * 16 + fr, tn * 128 + wn * 64 + j * 16 + fq * 4, acc[i][j]);
    }
}

struct EpiInProj {
    P p;
    DEVI void operator()(int row, int col, f32x4 v) const {
        if (col >= 5688) return;
        const int oc = win_map(col);
#pragma unroll
        for (int q = 0; q < 4; ++q) v[q] += p.b_in[oc + q];
        if (col >= 5632) { *(f32x4*)(p.SM + (size_t)row * 64 + (col - 5632)) = v; return; }
        if (col >= C_AK && col < C_AV) v *= 0.08838834764831845f;
        u32x2 o; o.x = pack2(v[0], v[1]); o.y = pack2(v[2], v[3]);
        *(u32x2*)(p.PROJ + (size_t)row * PS + col) = o;
        if (col >= C_CMP) {
            const int reg = (col - C_CMP) >> 9, c = (col - C_CMP) & 511;
            float* dst = nullptr;
            if (row < NTP) {
                if (reg == 0) dst = p.out + O_PCMP + (size_t)row * 512 + c;
                else if (reg == 1) dst = p.out + O_PSLC + (size_t)row * 512 + c;
                else { const int b = row >> 12, t = row & 4095; if (t >= 3584) dst = p.out + O_PWIN + ((size_t)b * 512 + (t - 3584)) * 512 + c; }
            } else {
                const int rs = row - NTP;
                if (reg == 0) dst = p.out + O_SCMP + (size_t)rs * 512 + c;
                else if (reg == 1) dst = p.out + O_SSLC + (size_t)rs * 512 + c;
                else { const int b = rs >> 2, tq = rs & 3; dst = p.out + O_SWIN + ((size_t)b * 512 + 508 + tq) * 512 + c; }
            }
            if (dst) *(f32x4*)dst = v;
        }
    }
};
struct EpiG {
    P p;
    DEVI void operator()(int row, int col, f32x4 v) const {
        u32x2 o; o.x = pack2(sigmoidf_(v[0]), sigmoidf_(v[1])); o.y = pack2(sigmoidf_(v[2]), sigmoidf_(v[3]));
        *(u32x2*)(p.G + (size_t)row * 2048 + col) = o;
    }
};
struct EpiM1 {
    P p;
    DEVI void operator()(int row, int col, f32x4 v) const {
        const u32x2 g = *(const u32x2*)(p.G + (size_t)row * 2048 + col);
        v[0] *= __uint_as_float(g.x << 16); v[1] *= __uint_as_float(g.x & 0xFFFF0000u);
        v[2] *= __uint_as_float(g.y << 16); v[3] *= __uint_as_float(g.y & 0xFFFF0000u);
        *(f32x4*)(p.TMP + (size_t)row * 1024 + col) = v;
    }
};
struct EpiM2 {
    P p;
    DEVI void operator()(int row, int col, f32x4 v) const {
        const u32x2 g = *(const u32x2*)(p.G + (size_t)row * 2048 + 1024 + col);
        const f32x4 t = *(const f32x4*)(p.TMP + (size_t)row * 1024 + col);
        v[0] = t[0] + v[0] * __uint_as_float(g.x << 16); v[1] = t[1] + v[1] * __uint_as_float(g.x & 0xFFFF0000u);
        v[2] = t[2] + v[2] * __uint_as_float(g.y << 16); v[3] = t[3] + v[3] * __uint_as_float(g.y & 0xFFFF0000u);
        u32x2 o; o.x = pack2(v[0], v[1]); o.y = pack2(v[2], v[3]);
        *(u32x2*)(p.MERGED + (size_t)row * 1024 + col) = o;
    }
};
struct EpiR {
    P p;
    DEVI void operator()(int row, int col, f32x4 v) const {
        const float* xr = row < NTP ? p.xp + (size_t)row * 1024 : p.xs + (size_t)(row - NTP) * 1024;
        const f32x4 x = *(const f32x4*)(xr + col);
        *(f32x4*)(p.R + (size_t)row * 1024 + col) = x * DN_ALPHA + v;
    }
};
struct EpiPQ {
    P p;
    DEVI void operator()(int row, int col, f32x4 v) const {
        u32x2 o; o.x = pack2(v[0], v[1]); o.y = pack2(v[2], v[3]);
        *(u32x2*)(p.PQ + (size_t)row * 2048 + col) = o;
    }
};

DEVI void stage_mlstm_gates(const P& p, int bid, int nblk) {
    const int lane = threadIdx.x & 63, wid = threadIdx.x >> 6;
    for (int bh = bid * 8 + wid; bh < 16; bh += nblk * 8) {
        const int b = bh >> 2, h = bh & 3;
        float m = 0.f;
        for (int c = 0; c < 64; ++c) {
            const size_t row = (size_t)b * 4096 + c * 64 + lane;
            const float ip = p.SM[row * 64 + h];
            const float lf = logsigmoidf_(p.SM[row * 64 + 4 + h]);
            float cs = lf;
#pragma unroll
            for (int o = 1; o < 64; o <<= 1) { const float t = __shfl_up(cs, o); if (lane >= o) cs += t; }
            p.BCUM[bh * 4096 + c * 64 + lane] = cs;
            const float bend = __shfl(cs, 63);
            const float g = bend - cs + ip;
            const float mloc = wave_max(g);
            const float mnew = fmaxf(bend + m, mloc);
            if (lane == 0) {
                p.MPREV[bh * 64 + c] = m;
                p.ACOEF[bh * 64 + c] = __expf(bend + m - mnew);
                p.SCL[bh * 64 + c] = __expf(mloc - mnew);
                p.MLOC[bh * 64 + c] = mloc;
            }
            m = mnew;
        }
        if (lane == 0) p.out[O_PM + bh] = m;
    }
}

DEVI void stage_mlstm_dc(const P& p, char* smem, int bid, int nblk) {
    float* ks = (float*)smem;
    float* ws = ks + 64 * 128;
    const int tid = threadIdx.x;
    for (int task = bid; task < 1024; task += nblk) {
        const int bh = task >> 6, c = task & 63, b = bh >> 2, h = bh & 3;
        const size_t row0 = (size_t)b * 4096 + c * 64;
        __syncthreads();
        if (tid < 64) {
            const float bend = p.BCUM[bh * 4096 + c * 64 + 63];
            const float g = bend - p.BCUM[bh * 4096 + c * 64 + tid] + p.SM[(row0 + tid) * 64 + h];
            ws[tid] = __expf(g - p.MLOC[task]);
        }
        __syncthreads();
        for (int idx = tid; idx < 64 * 128; idx += 512) {
            const int s = idx >> 7, d = idx & 127;
            ks[idx] = ws[s] * bf2f(p.PROJ[(row0 + s) * PS + C_AK + h * 128 + d]);
        }
        __syncthreads();
        const int v = tid & 255, dg = tid >> 8;
        float acc[64];
#pragma unroll
        for (int i = 0; i < 64; ++i) acc[i] = 0.f;
        for (int s = 0; s < 64; ++s) {
            const float vv = bf2f(p.PROJ[(row0 + s) * PS + C_AV + h * 256 + v]);
#pragma unroll
            for (int i = 0; i < 64; ++i) acc[i] += ks[s * 128 + dg * 64 + i] * vv;
        }
#pragma unroll
        for (int i = 0; i < 64; ++i) p.DC[((size_t)task * 128 + dg * 64 + i) * 256 + v] = acc[i];
        if (tid < 128) {
            float a = 0.f;
            for (int s = 0; s < 64; ++s) a += ks[s * 128 + tid];
            p.DN[task * 128 + tid] = a;
        }
    }
}

DEVI void stage_mlstm_scan(const P& p, int bid, int nblk) {
    for (int e = bid * blockDim.x + threadIdx.x; e < 16 * 32768 + 16 * 128; e += nblk * blockDim.x) {
        if (e < 16 * 32768) {
            const int bh = e >> 15, dv = e & 32767;
            float C = 0.f;
            for (int c = 0; c < 64; ++c) {
                const size_t idx = ((size_t)(bh * 64 + c)) * 32768 + dv;
                p.CPREV[idx] = C;
                C = p.ACOEF[bh * 64 + c] * C + p.SCL[bh * 64 + c] * p.DC[idx];
            }
            p.out[O_PC + e] = C;
        } else {
            const int e2 = e - 16 * 32768, bh = e2 >> 7, d = e2 & 127;
            float n = 0.f;
            for (int c = 0; c < 64; ++c) {
                const size_t idx = (size_t)(bh * 64 + c) * 128 + d;
                p.NPREV[idx] = n;
                n = p.ACOEF[bh * 64 + c] * n + p.SCL[bh * 64 + c] * p.DN[idx];
            }
            p.out[O_PN + e2] = n;
        }
    }
}

constexpr int MLO_LDS = (64 * 128 + 64 * 129 + 64 * 64 + 6 * 64 + 64 * 256) * 4;
DEVI void stage_mlstm_out(const P& p, char* smem, int bid, int nblk) {
    float* qs = (float*)smem;
    float* ks = qs + 64 * 128;
    float* Ps = ks + 64 * 129;
    float* bcum = Ps + 64 * 64;
    float* ipre = bcum + 64; float* mt = ipre + 64; float* wint = mt + 64; float* den = wint + 64; float* emt = den + 64;
    float* hs = emt + 64;
    const int tid = threadIdx.x, lane = tid & 63, wid = tid >> 6;
    for (int task = bid; task < 1024; task += nblk) {
        const int bh = task >> 6, c = task & 63, b = bh >> 2, h = bh & 3;
        const size_t row0 = (size_t)b * 4096 + c * 64;
        __syncthreads();
        for (int idx = tid; idx < 64 * 128; idx += 512) {
            const int t = idx >> 7, d = idx & 127;
            qs[idx] = bf2f(p.PROJ[(row0 + t) * PS + C_AQ + h * 128 + d]);
            ks[t * 129 + d] = bf2f(p.PROJ[(row0 + t) * PS + C_AK + h * 128 + d]);
        }
        if (tid < 64) { bcum[tid] = p.BCUM[bh * 4096 + c * 64 + tid]; ipre[tid] = p.SM[(row0 + tid) * 64 + h]; }
        const float mprev = p.MPREV[task];
        __syncthreads();
        for (int idx = tid; idx < 4096; idx += 512) {
            const int t = idx >> 6, s = idx & 63;
            float a = 0.f;
            if (s <= t) for (int d = 0; d < 128; ++d) a += qs[t * 128 + d] * ks[s * 129 + d];
            Ps[idx] = a;
        }
        if (tid < 64) {
            const int t = tid;
            float mx = bcum[t] + mprev;
            for (int s = 0; s <= t; ++s) mx = fmaxf(mx, bcum[t] - bcum[s] + ipre[s]);
            mt[t] = mx; wint[t] = __expf(bcum[t] + mprev - mx); emt[t] = __expf(-mx);
        }
        __syncthreads();
        for (int idx = tid; idx < 4096; idx += 512) {
            const int t = idx >> 6, s = idx & 63;
            if (s <= t) Ps[idx] *= __expf(bcum[t] - bcum[s] + ipre[s] - mt[t]);
        }
        __syncthreads();
        if (tid < 64) {
            const int t = tid;
            float ds = 0.f, qn = 0.f;
            for (int s = 0; s < 64; ++s) ds += Ps[t * 64 + s];
            for (int d = 0; d < 128; ++d) qn += qs[t * 128 + d] * p.NPREV[(size_t)task * 128 + d];
            den[t] = wint[t] * qn + ds;
        }
        __syncthreads();
        const int v = tid & 255, th = tid >> 8;
#pragma unroll 1
        for (int pass = 0; pass < 2; ++pass) {
            const int tb = th * 32 + pass * 16;
            float acc[16];
#pragma unroll
            for (int i = 0; i < 16; ++i) acc[i] = 0.f;
#pragma unroll 2
            for (int d = 0; d < 128; ++d) {
                const float cv = p.CPREV[((size_t)task * 128 + d) * 256 + v];
#pragma unroll
                for (int i = 0; i < 16; ++i) acc[i] += qs[(tb + i) * 128 + d] * cv;
            }
#pragma unroll
            for (int i = 0; i < 16; ++i) acc[i] *= wint[tb + i];
#pragma unroll 2
            for (int s = 0; s < 64; ++s) {
                const float vv = bf2f(p.PROJ[(row0 + s) * PS + C_AV + h * 256 + v]);
#pragma unroll
                for (int i = 0; i < 16; ++i) acc[i] += Ps[(tb + i) * 64 + s] * vv;
            }
#pragma unroll
            for (int i = 0; i < 16; ++i) { const int t = tb + i; hs[t * 256 + v] = acc[i] / fmaxf(fabsf(den[t]), emt[t]); }
        }
        __syncthreads();
        for (int rr = 0; rr < 8; ++rr) {
            const int t = wid * 8 + rr;
            const f32x4 x = *(const f32x4*)(hs + t * 256 + lane * 4);
            const float mean = wave_sum(x[0] + x[1] + x[2] + x[3]) * (1.f / 256.f);
            float q = 0.f;
#pragma unroll
            for (int k = 0; k < 4; ++k) q += (x[k] - mean) * (x[k] - mean);
            const float rs = rsqrtf(wave_sum(q) * (1.f / 256.f) + LN_EPS);
            float y[4];
#pragma unroll
            for (int k = 0; k < 4; ++k) {
                const int vi = lane * 4 + k;
                const float o = bf2f(p.PROJ[(row0 + t) * PS + C_AO + h * 256 + vi]);
                y[k] = (x[k] - mean) * rs * p.norm_a_g[h * 256 + vi] * sigmoidf_(o);
            }
            u32x2 o2; o2.x = pack2(y[0], y[1]); o2.y = pack2(y[2], y[3]);
            *(u32x2*)(p.YA + (row0 + t) * 1024 + h * 256 + lane * 4) = o2;
        }
    }
}

DEVI void stage_mlstm_sample(const P& p, char* smem, int bid, int nblk) {
    float* qs = (float*)smem;
    float* ks = qs + 512;
    float* vs = ks + 512;
    float* part = vs + 1024;
    float* hs = part + 2048;
    float* sc = hs + 1024;
    float* bc = sc; float* ip = sc + 4; float* mt = sc + 8; float* wint = sc + 12; float* emt = sc + 16; float* ww = sc + 20; float* den = sc + 24;
    float* Pm = sc + 32;
    float* misc = sc + 48;
    const int tid = threadIdx.x, lane = tid & 63, wid = tid >> 6;
    for (int task = bid; task < 512; task += nblk) {
        const int b = task >> 2, h = task & 3;
        const size_t row0 = (size_t)NTP + b * 4;
        __syncthreads();
        { const int t = tid >> 7, d = tid & 127;
          qs[tid] = bf2f(p.PROJ[(row0 + t) * PS + C_AQ + h * 128 + d]);
          ks[tid] = bf2f(p.PROJ[(row0 + t) * PS + C_AK + h * 128 + d]); }
        for (int idx = tid; idx < 1024; idx += 512) { const int t = idx >> 8, v = idx & 255; vs[idx] = bf2f(p.PROJ[(row0 + t) * PS + C_AV + h * 256 + v]); }
        if (tid == 0) {
            const float m0 = p.state_m[task];
            float cs = 0.f;
            for (int t = 0; t < 4; ++t) { cs += logsigmoidf_(p.SM[(row0 + t) * 64 + 4 + h]); bc[t] = cs; ip[t] = p.SM[(row0 + t) * 64 + h]; }
            for (int t = 0; t < 4; ++t) {
                float mx = bc[t] + m0;
                for (int s = 0; s <= t; ++s) mx = fmaxf(mx, bc[t] - bc[s] + ip[s]);
                mt[t] = mx; wint[t] = __expf(bc[t] + m0 - mx); emt[t] = __expf(-mx);
            }
            const float bend = bc[3];
            float mnew = bend + m0;
            for (int s = 0; s < 4; ++s) mnew = fmaxf(mnew, bend - bc[s] + ip[s]);
            misc[0] = __expf(bend + m0 - mnew);
            for (int s = 0; s < 4; ++s) ww[s] = __expf(bend - bc[s] + ip[s] - mnew);
            p.out[O_SM + task] = mnew;
        }
        __syncthreads();
        if (tid < 16) {
            const int t = tid >> 2, s = tid & 3;
            float a = 0.f;
            if (s <= t) { for (int d = 0; d < 128; ++d) a += qs[t * 128 + d] * ks[s * 128 + d]; a *= __expf(bc[t] - bc[s] + ip[s] - mt[t]); }
            Pm[tid] = a;
        }
        __syncthreads();
        if (tid < 4) {
            const int t = tid; float qn = 0.f;
            for (int d = 0; d < 128; ++d) qn += qs[t * 128 + d] * p.state_n[(size_t)task * 128 + d];
            den[t] = wint[t] * qn + Pm[t * 4] + Pm[t * 4 + 1] + Pm[t * 4 + 2] + Pm[t * 4 + 3];
        }
        const float a = misc[0];
        if (tid >= 128 && tid < 256) {
            const int d = tid - 128;
            float n = a * p.state_n[(size_t)task * 128 + d];
            for (int s = 0; s < 4; ++s) n += ww[s] * ks[s * 128 + d];
            p.out[O_SN + (size_t)task * 128 + d] = n;
        }
        {
            const int v = tid & 255, dh = tid >> 8;
            float acc[4] = {0.f, 0.f, 0.f, 0.f};
            float wv[4];
#pragma unroll
            for (int s = 0; s < 4; ++s) wv[s] = ww[s] * vs[s * 256 + v];
            for (int d = dh * 64; d < dh * 64 + 64; ++d) {
                const size_t ci = ((size_t)task * 128 + d) * 256 + v;
                const float c0 = p.state_C[ci];
#pragma unroll
                for (int t = 0; t < 4; ++t) acc[t] += qs[t * 128 + d] * c0;
                float cn = a * c0;
#pragma unroll
                for (int s = 0; s < 4; ++s) cn += ks[s * 128 + d] * wv[s];
                p.out[O_SC + ci] = cn;
            }
#pragma unroll
            for (int t = 0; t < 4; ++t) part[(dh * 4 + t) * 256 + v] = acc[t];
        }
        __syncthreads();
        if (tid < 256) {
            const int v = tid;
#pragma unroll
            for (int t = 0; t < 4; ++t) {
                float num = wint[t] * (part[t * 256 + v] + part[(4 + t) * 256 + v]);
#pragma unroll
                for (int s = 0; s < 4; ++s) num += Pm[t * 4 + s] * vs[s * 256 + v];
                hs[t * 256 + v] = num / fmaxf(fabsf(den[t]), emt[t]);
            }
        }
        __syncthreads();
        if (wid < 4) {
            const int t = wid;
            const f32x4 x = *(const f32x4*)(hs + t * 256 + lane * 4);
            const float mean = wave_sum(x[0] + x[1] + x[2] + x[3]) * (1.f / 256.f);
            float q = 0.f;
#pragma unroll
            for (int k = 0; k < 4; ++k) q += (x[k] - mean) * (x[k] - mean);
            const float rs = rsqrtf(wave_sum(q) * (1.f / 256.f) + LN_EPS);
            float y[4];
#pragma unroll
            for (int k = 0; k < 4; ++k) {
                const int vi = lane * 4 + k;
                const float o = bf2f(p.PROJ[(row0 + t) * PS + C_AO + h * 256 + vi]);
                y[k] = (x[k] - mean) * rs * p.norm_a_g[h * 256 + vi] * sigmoidf_(o);
            }
            u32x2 o2; o2.x = pack2(y[0], y[1]); o2.y = pack2(y[2], y[3]);
            *(u32x2*)(p.YA + (row0 + t) * 1024 + h * 256 + lane * 4) = o2;
        }
    }
}

DEVI void stage_compress(const P& p, char* smem, int bid, int nblk) {
    float* tile = (float*)smem;
    const int tid = threadIdx.x;
    const int kv = tid >> 8, g = (tid >> 6) & 3, e = tid & 63;
    for (int task = bid; task < 256 + 4096; task += nblk) {
        const bool prompt = task < 256;
        int b, n; size_t src_row0;
        if (prompt) { b = task >> 6; n = task & 63; src_row0 = (size_t)b * 4096 + n * 64; }
        else { const int ts = task - 256; b = ts >> 5; n = ts & 31; const int page = p.page_table[b * 16 + (n >> 1)]; src_row0 = (size_t)page * 128 + (n & 1) * 64; }
        float acc = 0.f;
        for (int l0 = 0; l0 < 64; l0 += 16) {
            __syncthreads();
#pragma unroll
            for (int i = 0; i < 16; ++i) {
                const int idx = tid + i * 512, l = idx >> 9, c = idx & 511;
                float val = prompt ? bf2f(p.PROJ[(src_row0 + l0 + l) * PS + C_CMP + c]) : p.cache_cmp[(src_row0 + l0 + l) * 512 + c];
                val += p.nsa_pe[((c >> 8) * 64 + l0 + l) * 64 + (c & 63)];
                tile[idx] = val;
            }
            __syncthreads();
            for (int l = 0; l < 16; ++l) {
                const float* wr = p.nsa_w_cmp + ((size_t)(kv * 64 + l0 + l) * 64) * 64 + e;
                const float* tr = tile + l * 512 + kv * 256 + g * 64;
#pragma unroll 8
                for (int d = 0; d < 64; ++d) acc += tr[d] * wr[d * 64];
            }
        }
        (kv == 0 ? p.KC : p.VC)[(size_t)task * 256 + g * 64 + e] = acc;
    }
}

DEVI void stage_cmp_select(const P& p, int bid, int nblk) {
    const int lane = threadIdx.x & 63, wid = threadIdx.x >> 6;
    for (int wt = bid * 8 + wid; wt < NT * 4; wt += nblk * 8) {
        const int row = wt >> 2, g = wt & 3;
        int pos, nb, nvalid, cur; const float *kcb, *vcb;
        if (row < NTP) { const int b = row >> 12, t = row & 4095; pos = t; nb = 64; nvalid = (t + 1) >> 6; cur = t >> 6; kcb = p.KC + (size_t)(b * 64) * 256; vcb = p.VC + (size_t)(b * 64) * 256; }
        else { const int rs = row - NTP, b = rs >> 2, tq = rs & 3; pos = 2048 + tq; nb = 33; nvalid = 32; cur = 32; kcb = p.KC + (size_t)(256 + b * 32) * 256; vcb = p.VC + (size_t)(256 + b * 32) * 256; }
        const int j = lane;
        float pr[4] = {0.f, 0.f, 0.f, 0.f};
        float imp = 0.f;
        if (nvalid > 0) {
            float dot[4] = {0.f, 0.f, 0.f, 0.f};
            if (j < nvalid) {
                const float* kr = kcb + (size_t)j * 256 + g * 64;
                const bf16_t* qr = p.PROJ + (size_t)row * PS + C_BQ + g * 256;
                for (int d = 0; d < 64; ++d) {
                    const float kk = kr[d];
#pragma unroll
                    for (int r = 0; r < 4; ++r) dot[r] += bf2f(qr[r * 64 + d]) * kk;
                }
            }
#pragma unroll
            for (int r = 0; r < 4; ++r) {
                const float s = j < nvalid ? dot[r] * 0.125f - alibi_slope(g * 4 + r) * (float)(pos - (j * 64 + 63)) : -INFINITY;
                const float mx = wave_max(s);
                const float e = j < nvalid ? __expf(s - mx) : 0.f;
                const float sum = wave_sum(e);
                pr[r] = e / sum;
                imp += pr[r];
            }
            float o[4] = {0.f, 0.f, 0.f, 0.f};
            for (int jj = 0; jj < nvalid; ++jj) {
                const float vv = vcb[(size_t)jj * 256 + g * 64 + lane];
#pragma unroll
                for (int r = 0; r < 4; ++r) o[r] += __shfl(pr[r], jj) * vv;
            }
#pragma unroll
            for (int r = 0; r < 4; ++r) p.OCMP[(size_t)row * 1024 + (g * 4 + r) * 64 + lane] = o[r];
        } else {
#pragma unroll
            for (int r = 0; r < 4; ++r) p.OCMP[(size_t)row * 1024 + (g * 4 + r) * 64 + lane] = 0.f;
        }
        if (j == cur || j == 0) imp = 5.0f;
        if (j > cur) imp = -1.0f;
        if (j >= nb) imp = -2.0f;
        int rank = 0;
        for (int jj = 0; jj < 64; ++jj) { const float v = __shfl(imp, jj); rank += (v > imp || (v == imp && jj < j)) ? 1 : 0; }
        const unsigned long long mask = __ballot(rank < 16 && j < nb);
        if (lane == 0) p.SEL[(size_t)row * 4 + g] = mask;
    }
}

struct KBlock { const void* kb; const void* vb; int stride; int f32; int count; int pos0; };

template <bool WIN>
DEVI void attend_block(const KBlock& B, int qpos, const float* qs, const float (&slope)[4], float (&m)[4], float (&l)[4], float (&o)[4], int lane) {
    const int pos = B.pos0 + lane;
    const bool valid = lane < B.count && pos <= qpos && (!WIN || pos > qpos - 512);
    if (!__any(valid)) return;
    float dot[4] = {0.f, 0.f, 0.f, 0.f};
    if (valid) {
        if (B.f32) {
            const float* kr = (const float*)B.kb + (size_t)lane * B.stride;
#pragma unroll 4
            for (int d4 = 0; d4 < 16; ++d4) {
                const f32x4 kk = *(const f32x4*)(kr + d4 * 4);
#pragma unroll
                for (int e = 0; e < 4; ++e) { const f32x4 qq = *(const f32x4*)(qs + (d4 * 4 + e) * 4);
#pragma unroll
                    for (int r = 0; r < 4; ++r) dot[r] += kk[e] * qq[r]; }
            }
        } else {
            const bf16_t* kr = (const bf16_t*)B.kb + (size_t)lane * B.stride;
#pragma unroll 2
            for (int d8 = 0; d8 < 8; ++d8) {
                const u32x4 kk = *(const u32x4*)(kr + d8 * 8);
                const unsigned w[4] = {kk.x, kk.y, kk.z, kk.w};
#pragma unroll
                for (int e = 0; e < 4; ++e) {
                    const float k0 = __uint_as_float(w[e] << 16), k1 = __uint_as_float(w[e] & 0xFFFF0000u);
                    const f32x4 q0 = *(const f32x4*)(qs + (d8 * 8 + e * 2) * 4), q1 = *(const f32x4*)(qs + (d8 * 8 + e * 2 + 1) * 4);
#pragma unroll
                    for (int r = 0; r < 4; ++r) dot[r] += k0 * q0[r] + k1 * q1[r];
                }
            }
        }
    }
    float pr[4];
#pragma unroll
    for (int r = 0; r < 4; ++r) {
        const float s = valid ? dot[r] * 0.125f - slope[r] * (float)(qpos - pos) : -INFINITY;
        const float mn = fmaxf(m[r], wave_max(s));
        const float sc = __expf(m[r] - mn);
        pr[r] = valid ? __expf(s - mn) : 0.f;
        l[r] = l[r] * sc + wave_sum(pr[r]);
        o[r] *= sc; m[r] = mn;
    }
    for (int kk = 0; kk < B.count; ++kk) {
        const float vv = B.f32 ? ((const float*)B.vb)[(size_t)kk * B.stride + lane] : bf2f(((const bf16_t*)B.vb)[(size_t)kk * B.stride + lane]);
#pragma unroll
        for (int r = 0; r < 4; ++r) o[r] += __shfl(pr[r], kk) * vv;
    }
}

DEVI void stage_slc_win(const P& p, char* smem, int bid, int nblk) {
    const int lane = threadIdx.x & 63, wid = threadIdx.x >> 6;
    float* qs = (float*)smem + wid * 256;
    for (int wt = bid * 8 + wid; wt < NT * 4; wt += nblk * 8) {
        const int row = wt >> 2, g = wt & 3;
        const bool prompt = row < NTP;
        int b, t, qpos;
        if (prompt) { b = row >> 12; t = row & 4095; qpos = t; } else { const int rs = row - NTP; b = rs >> 2; t = rs & 3; qpos = 2048 + t; }
        {
            const bf16_t* qr = p.PROJ + (size_t)row * PS + C_BQ + g * 256;
            f32x4 qv;
#pragma unroll
            for (int r = 0; r < 4; ++r) qv[r] = bf2f(qr[r * 64 + lane]);
            *(f32x4*)(qs + lane * 4) = qv;
            asm volatile("s_waitcnt lgkmcnt(0)" ::: "memory");
        }
        float slope[4];
#pragma unroll
        for (int r = 0; r < 4; ++r) slope[r] = alibi_slope(g * 4 + r);
        float res[2][4];
        {
            float m[4], l[4], o[4];
#pragma unroll
            for (int r = 0; r < 4; ++r) { m[r] = -INFINITY; l[r] = 0.f; o[r] = 0.f; }
            unsigned long long mask = p.SEL[(size_t)row * 4 + g];
            while (mask) {
                const int j = __builtin_ctzll(mask); mask &= mask - 1;
                KBlock B;
                if (prompt) {
                    const bf16_t* base = p.PROJ + ((size_t)b * 4096 + j * 64) * PS + C_SLC + g * 64;
                    B.kb = base; B.vb = base + 256; B.stride = PS; B.f32 = 0; B.count = 64; B.pos0 = j * 64;
                } else if (j < 32) {
                    const int page = p.page_table[b * 16 + (j >> 1)];
                    const float* base = p.cache_slc + ((size_t)page * 128 + (j & 1) * 64) * 512 + g * 64;
                    B.kb = base; B.vb = base + 256; B.stride = 512; B.f32 = 1; B.count = 64; B.pos0 = j * 64;
                } else {
                    const bf16_t* base = p.PROJ + ((size_t)NTP + b * 4) * PS + C_SLC + g * 64;
                    B.kb = base; B.vb = base + 256; B.stride = PS; B.f32 = 0; B.count = 4; B.pos0 = 2048;
                }
                attend_block<false>(B, qpos, qs, slope, m, l, o, lane);
            }
#pragma unroll
            for (int r = 0; r < 4; ++r) res[0][r] = o[r] / l[r];
        }
        {
            float m[4], l[4], o[4];
#pragma unroll
            for (int r = 0; r < 4; ++r) { m[r] = -INFINITY; l[r] = 0.f; o[r] = 0.f; }
            if (prompt) {
                const int lo = (t - 511 > 0 ? t - 511 : 0) >> 6, hi = t >> 6;
                for (int j = lo; j <= hi; ++j) {
                    KBlock B; const bf16_t* base = p.PROJ + ((size_t)b * 4096 + j * 64) * PS + C_WIN + g * 64;
                    B.kb = base; B.vb = base + 256; B.stride = PS; B.f32 = 0; B.count = 64; B.pos0 = j * 64;
                    attend_block<true>(B, qpos, qs, slope, m, l, o, lane);
                }
            } else {
                for (int j = 0; j < 8; ++j) {
                    KBlock B; const float* base = p.cache_win + ((size_t)b * 512 + j * 64) * 512 + g * 64;
                    B.kb = base; B.vb = base + 256; B.stride = 512; B.f32 = 1; B.count = 64; B.pos0 = 1536 + j * 64;
                    attend_block<true>(B, qpos, qs, slope, m, l, o, lane);
                }
                KBlock B; const bf16_t* base = p.PROJ + ((size_t)NTP + b * 4) * PS + C_WIN + g * 64;
                B.kb = base; B.vb = base + 256; B.stride = PS; B.f32 = 0; B.count = 4; B.pos0 = 2048;
                attend_block<true>(B, qpos, qs, slope, m, l, o, lane);
            }
#pragma unroll
            for (int r = 0; r < 4; ++r) res[1][r] = o[r] / l[r];
        }
        const float* gt = p.SM + (size_t)row * 64 + 8;
#pragma unroll
        for (int r = 0; r < 4; ++r) {
            const float g0 = sigmoidf_(gt[g * 4 + r]), g1 = sigmoidf_(gt[16 + g * 4 + r]), g2 = sigmoidf_(gt[32 + g * 4 + r]);
            const float oc = p.OCMP[(size_t)row * 1024 + (g * 4 + r) * 64 + lane];
            p.YB[(size_t)row * 1024 + (g * 4 + r) * 64 + lane] = f2bf(g0 * oc + g1 * res[0][r] + g2 * res[1][r]);
        }
    }
}

DEVI void stage_ln1(const P& p, int bid, int nblk) {
    const int lane = threadIdx.x & 63, wid = threadIdx.x >> 6;
    for (int row = bid * 8 + wid; row < NT; row += nblk * 8) {
        f32x4 x[4];
        float s = 0.f;
#pragma unroll
        for (int i = 0; i < 4; ++i) { x[i] = *(const f32x4*)(p.R + (size_t)row * 1024 + i * 256 + lane * 4); s += x[i][0] + x[i][1] + x[i][2] + x[i][3]; }
        const float mean = wave_sum(s) * (1.f / 1024.f);
        float q = 0.f;
#pragma unroll
        for (int i = 0; i < 4; ++i)
#pragma unroll
            for (int k = 0; k < 4; ++k) q += (x[i][k] - mean) * (x[i][k] - mean);
        const float rs = rsqrtf(wave_sum(q) * (1.f / 1024.f) + LN_EPS);
#pragma unroll
        for (int i = 0; i < 4; ++i) {
            const int c = i * 256 + lane * 4;
            const f32x4 gg = *(const f32x4*)(p.ln1_g + c), bb = *(const f32x4*)(p.ln1_b + c);
            f32x4 y;
#pragma unroll
            for (int k = 0; k < 4; ++k) y[k] = (x[i][k] - mean) * rs * gg[k] + bb[k];
            *(f32x4*)(p.H + (size_t)row * 1024 + c) = y;
            u32x2 o; o.x = pack2(y[0], y[1]); o.y = pack2(y[2], y[3]);
            *(u32x2*)(p.HB + (size_t)row * 1024 + c) = o;
        }
    }
}

__device__ const unsigned char PEER_CA[50] = {0,0,0,0,0,0,0,0,0,0,0,0,0,0,0,0, 1,1,1,1,1,1,1,1, 2,2,2,2,2, 3,3,3,3, 4,4,4, 5,5, 6,6, 7,7, 8,9,10,11,12,13,14,15};
__device__ const unsigned char PEER_CB[50] = {0,1,2,3,4,5,6,7,8,9,10,11,12,13,14,15, 0,1,2,3,4,5,6,7, 0,1,2,3,4, 0,1,2,3, 0,1,2, 0,1, 0,1, 0,1, 0,0,0,0,0,0,0,0};

DEVI void stage_peer_route(const P& p, char* smem, int bid, int nblk) {
    const int lane = threadIdx.x & 63, wid = threadIdx.x >> 6;
    float* qs = (float*)smem + wid * 320;
    float* ts = qs + 256; int* ti = (int*)(qs + 288);
    for (int wt = bid * 8 + wid; wt < NT * 8; wt += nblk * 8) {
        const int row = wt >> 3, ph = wt & 7;
        {
            const bf16_t* qr = p.PQ + (size_t)row * 2048 + ph * 256;
#pragma unroll
            for (int i = 0; i < 4; ++i) qs[i * 64 + lane] = bf2f(qr[i * 64 + lane]);
            asm volatile("s_waitcnt lgkmcnt(0)" ::: "memory");
        }
        float sc[2][2];
#pragma unroll
        for (int c = 0; c < 2; ++c)
#pragma unroll
            for (int kh = 0; kh < 2; ++kh) {
                const bf16_t* kr = p.KEYSB + ((size_t)((ph * 2 + c) * 128 + kh * 64 + lane)) * 128;
                float a = 0.f;
#pragma unroll 4
                for (int d8 = 0; d8 < 16; ++d8) {
                    const u32x4 kk = *(const u32x4*)(kr + d8 * 8);
                    const unsigned w[4] = {kk.x, kk.y, kk.z, kk.w};
#pragma unroll
                    for (int e = 0; e < 4; ++e) a += __uint_as_float(w[e] << 16) * qs[c * 128 + d8 * 8 + e * 2] + __uint_as_float(w[e] & 0xFFFF0000u) * qs[c * 128 + d8 * 8 + e * 2 + 1];
                }
                sc[c][kh] = a;
            }
#pragma unroll
        for (int c = 0; c < 2; ++c) {
            int r0 = 0, r1 = 0;
            for (int kk = 0; kk < 64; ++kk) {
                const float v0 = __shfl(sc[c][0], kk), v1 = __shfl(sc[c][1], kk);
                r0 += (v0 > sc[c][0] || (v0 == sc[c][0] && kk < lane)) ? 1 : 0;
                r0 += (v1 > sc[c][0]) ? 1 : 0;
                r1 += (v0 >= sc[c][1]) ? 1 : 0;
                r1 += (v1 > sc[c][1] || (v1 == sc[c][1] && kk < lane)) ? 1 : 0;
            }
            if (r0 < 16) { ts[c * 16 + r0] = sc[c][0]; ti[c * 16 + r0] = lane; }
            if (r1 < 16) { ts[c * 16 + r1] = sc[c][1]; ti[c * 16 + r1] = lane + 64; }
        }
        asm volatile("s_waitcnt lgkmcnt(0)" ::: "memory");
        float cand = -INFINITY; int cidx = 0;
        if (lane < 50) { const int a = PEER_CA[lane], bq = PEER_CB[lane]; cand = ts[a] + ts[16 + bq]; cidx = ti[a] * 128 + ti[16 + bq]; }
        int rk = 0;
        for (int kk = 0; kk < 50; ++kk) { const float v = __shfl(cand, kk); rk += (v > cand || (v == cand && kk < lane)) ? 1 : 0; }
        const bool sel = lane < 50 && rk < 16;
        const float mx = wave_max(sel ? cand : -INFINITY);
        const float e = sel ? __expf(cand - mx) : 0.f;
        const float sum = wave_sum(e);
        if (sel) { p.EIDX[(size_t)row * 128 + ph * 16 + rk] = cidx; p.EGATE[(size_t)row * 128 + ph * 16 + rk] = e / sum; }
        asm volatile("s_waitcnt lgkmcnt(0)" ::: "memory");
    }
}

DEVI void stage_peer_apply(const P& p, int bid, int nblk) {
    const int lane = threadIdx.x & 63, wid = threadIdx.x >> 6;
    for (int row = bid * 8 + wid; row < NT; row += nblk * 8) {
        float hv[16], acc[16];
#pragma unroll
        for (int i = 0; i < 2; ++i) {
            const f32x4 a = *(const f32x4*)(p.H + (size_t)row * 1024 + i * 512 + lane * 8), b2 = *(const f32x4*)(p.H + (size_t)row * 1024 + i * 512 + lane * 8 + 4);
#pragma unroll
            for (int k = 0; k < 4; ++k) { hv[i * 8 + k] = a[k]; hv[i * 8 + 4 + k] = b2[k]; }
        }
#pragma unroll
        for (int i = 0; i < 16; ++i) acc[i] = 0.f;
        for (int e = 0; e < 128; ++e) {
            const int idx = p.EIDX[(size_t)row * 128 + e];
            const float gt = p.EGATE[(size_t)row * 128 + e];
            const bf16_t* ur = p.UB + (size_t)idx * 1024 + lane * 8;
            const bf16_t* vr = p.VB + (size_t)idx * 1024 + lane * 8;
            float dot = 0.f;
#pragma unroll
            for (int i = 0; i < 2; ++i) {
                const u32x4 u = *(const u32x4*)(ur + i * 512);
                const unsigned w[4] = {u.x, u.y, u.z, u.w};
#pragma unroll
                for (int k = 0; k < 4; ++k) dot += __uint_as_float(w[k] << 16) * hv[i * 8 + k * 2] + __uint_as_float(w[k] & 0xFFFF0000u) * hv[i * 8 + k * 2 + 1];
            }
            dot = wave_sum(dot);
            const float act = 0.5f * dot * (1.f + erff(dot * 0.7071067811865476f));
            const float cf = gt * act;
#pragma unroll
            for (int i = 0; i < 2; ++i) {
                const u32x4 u = *(const u32x4*)(vr + i * 512);
                const unsigned w[4] = {u.x, u.y, u.z, u.w};
#pragma unroll
                for (int k = 0; k < 4; ++k) { acc[i * 8 + k * 2] += cf * __uint_as_float(w[k] << 16); acc[i * 8 + k * 2 + 1] += cf * __uint_as_float(w[k] & 0xFFFF0000u); }
            }
        }
        float s = 0.f;
#pragma unroll
        for (int i = 0; i < 16; ++i) { acc[i] += DN_ALPHA * hv[i]; s += acc[i]; }
        const float mean = wave_sum(s) * (1.f / 1024.f);
        float q = 0.f;
#pragma unroll
        for (int i = 0; i < 16; ++i) q += (acc[i] - mean) * (acc[i] - mean);
        const float rs = rsqrtf(wave_sum(q) * (1.f / 1024.f) + LN_EPS);
#pragma unroll
        for (int i = 0; i < 2; ++i) {
            const int c = i * 512 + lane * 8;
            f32x4 y0, y1;
#pragma unroll
            for (int k = 0; k < 4; ++k) {
                y0[k] = (acc[i * 8 + k] - mean) * rs * p.ln2_g[c + k] + p.ln2_b[c + k];
                y1[k] = (acc[i * 8 + 4 + k] - mean) * rs * p.ln2_g[c + 4 + k] + p.ln2_b[c + 4 + k];
            }
            *(f32x4*)(p.out + O_Y + (size_t)row * 1024 + c) = y0;
            *(f32x4*)(p.out + O_Y + (size_t)row * 1024 + c + 4) = y1;
        }
    }
}

constexpr int LDS_BYTES = 152 * 1024;
static_assert(MLO_LDS <= LDS_BYTES, "lds");
template <int S>
DEVI void run_stage(const P& p, char* smem, int bid, int nblk) {
    if (S == 0) stage_prologue(p, smem, bid, nblk);
    if (S == 1) { EpiInProj e{p}; gemm_phase(p.XB, p.WINT, NT, NPAD_IN, 1024, e, smem, bid, nblk); }
    if (S == 2) { stage_mlstm_gates(p, bid, nblk); stage_compress(p, smem, bid, nblk); }
    if (S == 3) { stage_mlstm_dc(p, smem, bid, nblk); stage_cmp_select(p, bid, nblk); stage_mlstm_sample(p, smem, bid, nblk); }
    if (S == 4) { stage_mlstm_scan(p, bid, nblk); stage_slc_win(p, smem, bid, nblk); { EpiG e{p}; gemm_phase(p.XB, p.WMT, NT, 2048, 1024, e, smem, bid, nblk); } }
    if (S == 5) stage_mlstm_out(p, smem, bid, nblk);
    if (S == 6) { EpiM1 e{p}; gemm_phase(p.YA, p.WAT, NT, 1024, 1024, e, smem, bid, nblk); }
    if (S == 7) { EpiM2 e{p}; gemm_phase(p.YB, p.WBT, NT, 1024, 1024, e, smem, bid, nblk); }
    if (S == 8) { EpiR e{p}; gemm_phase(p.MERGED, p.WOT, NT, 1024, 1024, e, smem, bid, nblk); }
    if (S == 9) stage_ln1(p, bid, nblk);
    if (S == 10) { EpiPQ e{p}; gemm_phase(p.HB, p.WQT, NT, 2048, 1024, e, smem, bid, nblk); }
    if (S == 11) stage_peer_route(p, smem, bid, nblk);
    if (S == 12) stage_peer_apply(p, bid, nblk);
}
constexpr int NSTAGES = 13;

template <int S>
__global__ void __launch_bounds__(512, 2) k_stage(P p) {
    extern __shared__ __attribute__((aligned(16))) char smem[];
    run_stage<S>(p, smem, blockIdx.x, gridDim.x);
}

template <int S> static void launch_stage(const P& p, int grid, hipStream_t stream) {
    hipFuncSetAttribute((const void*)k_stage<S>, hipFuncAttributeMaxDynamicSharedMemorySize, LDS_BYTES);
    k_stage<S><<<dim3(grid), dim3(512), LDS_BYTES, stream>>>(p);
}

extern "C" void kernel_launch(void* const* d_in, const int* in_sizes, int n_in, void* d_out, int out_size, void* d_ws, size_t ws_size, hipStream_t stream) {
    (void)in_sizes; (void)n_in; (void)out_size; (void)ws_size;
    P p{};
    p.xp = (const float*)d_in[0]; p.xs = (const float*)d_in[1]; p.cache_cmp = (const float*)d_in[2]; p.cache_slc = (const float*)d_in[3];
    p.cache_win = (const float*)d_in[4]; p.state_C = (const float*)d_in[5]; p.state_n = (const float*)d_in[6]; p.state_m = (const float*)d_in[7];
    p.page_table = (const int*)d_in[8];
    p.w_in = (const float*)d_in[9]; p.b_in = (const float*)d_in[10]; p.norm_a_g = (const float*)d_in[11]; p.nsa_pe = (const float*)d_in[12];
    p.nsa_w_cmp = (const float*)d_in[13]; p.w_br_a = (const float*)d_in[14]; p.w_br_b = (const float*)d_in[15]; p.w_merge = (const float*)d_in[16];
    p.w_out = (const float*)d_in[17]; p.ln1_g = (const float*)d_in[18]; p.ln1_b = (const float*)d_in[19];
    p.peer_wq = (const float*)d_in[20]; p.peer_keys = (const float*)d_in[21]; p.peer_u = (const float*)d_in[22]; p.peer_v = (const float*)d_in[23];
    p.ln2_g = (const float*)d_in[24]; p.ln2_b = (const float*)d_in[25];
    p.out = (float*)d_out;
    char* w = (char*)d_ws; size_t off = 0;
    auto take = [&](size_t bytes) { char* r = w + off; off += (bytes + 255) & ~(size_t)255; return r; };
    p.bar = (unsigned*)take(16384);
    p.XB = (bf16_t*)take((size_t)NT * 1024 * 2);
    p.WINT = (bf16_t*)take((size_t)NPAD_IN * 1024 * 2);
    p.WMT = (bf16_t*)take((size_t)2048 * 1024 * 2);
    p.WAT = (bf16_t*)take((size_t)1024 * 1024 * 2);
    p.WBT = (bf16_t*)take((size_t)1024 * 1024 * 2);
    p.WOT = (bf16_t*)take((size_t)1024 * 1024 * 2);
    p.WQT = (bf16_t*)take((size_t)2048 * 1024 * 2);
    p.KEYSB = (bf16_t*)take((size_t)16 * 128 * 128 * 2);
    p.UB = (bf16_t*)take((size_t)16384 * 1024 * 2);
    p.VB = (bf16_t*)take((size_t)16384 * 1024 * 2);
    p.PROJ = (bf16_t*)take((size_t)NT * PS * 2);
    p.SM = (float*)take((size_t)NT * 64 * 4);
    p.BCUM = (float*)take((size_t)16 * 4096 * 4);
    p.MPREV = (float*)take(4096); p.ACOEF = (float*)take(4096); p.SCL = (float*)take(4096); p.MLOC = (float*)take(4096);
    p.DC = (float*)take((size_t)1024 * 32768 * 4);
    p.DN = (float*)take((size_t)1024 * 128 * 4);
    p.CPREV = (float*)take((size_t)1024 * 32768 * 4);
    p.NPREV = (float*)take((size_t)1024 * 128 * 4);
    p.KC = (float*)take((size_t)4352 * 256 * 4);
    p.VC = (float*)take((size_t)4352 * 256 * 4);
    p.OCMP = (float*)take((size_t)NT * 1024 * 4);
    p.SEL = (unsigned long long*)take((size_t)NT * 4 * 8);
    p.YA = (bf16_t*)take((size_t)NT * 1024 * 2);
    p.YB = (bf16_t*)take((size_t)NT * 1024 * 2);
    p.G = (bf16_t*)take((size_t)NT * 2048 * 2);
    p.TMP = (float*)take((size_t)NT * 1024 * 4);
    p.MERGED = (bf16_t*)take((size_t)NT * 1024 * 2);
    p.R = (float*)take((size_t)NT * 1024 * 4);
    p.H = (float*)take((size_t)NT * 1024 * 4);
    p.HB = (bf16_t*)take((size_t)NT * 1024 * 2);
    p.PQ = (bf16_t*)take((size_t)NT * 2048 * 2);
    p.EIDX = (int*)take((size_t)NT * 128 * 4);
    p.EGATE = (float*)take((size_t)NT * 128 * 4);

    const int grid = 512;
    launch_stage<0>(p, grid, stream);
    launch_stage<1>(p, grid, stream);
    launch_stage<2>(p, grid, stream);
    launch_stage<3>(p, grid, stream);
    launch_stage<4>(p, grid, stream);
    launch_stage<5>(p, grid, stream);
    launch_stage<6>(p, grid, stream);
    launch_stage<7>(p, grid, stream);
    launch_stage<8>(p, grid, stream);
    launch_stage<9>(p, grid, stream);
    launch_stage<10>(p, grid, stream);
    launch_stage<11>(p, grid, stream);
    launch_stage<12>(p, grid, stream);
}
```

```cpp
#include <hip/hip_runtime.h>
#include <stdint.h>

#ifndef MK_ONE_LAUNCH
#define MK_ONE_LAUNCH 1
#endif

typedef unsigned short bf16_t;
typedef short bf16x8 __attribute__((ext_vector_type(8)));
typedef float f32x4 __attribute__((ext_vector_type(4)));
typedef unsigned u32x4 __attribute__((ext_vector_type(4)));
typedef unsigned u32x2 __attribute__((ext_vector_type(2)));
#define DEVI __device__ __forceinline__

constexpr int NTP = 16384, NTS = 512, NT = NTP + NTS, DM = 1024;
constexpr int PS = 5632;
constexpr int C_AQ = 0, C_AK = 512, C_AV = 1024, C_AO = 2048, C_BQ = 3072, C_CMP = 4096, C_SLC = 4608, C_WIN = 5120;
constexpr int NPAD_IN = 5888;
constexpr float DN_ALPHA = 1.189207115002721f;
constexpr float LN_EPS = 1e-5f;
constexpr size_t O_Y = 0;
constexpr size_t O_PCMP = O_Y + (size_t)NT * 1024;
constexpr size_t O_PSLC = O_PCMP + (size_t)NTP * 512;
constexpr size_t O_PWIN = O_PSLC + (size_t)NTP * 512;
constexpr size_t O_PC = O_PWIN + (size_t)4 * 512 * 512;
constexpr size_t O_PN = O_PC + (size_t)16 * 128 * 256;
constexpr size_t O_PM = O_PN + 16 * 128;
constexpr size_t O_SCMP = O_PM + 16;
constexpr size_t O_SSLC = O_SCMP + (size_t)NTS * 512;
constexpr size_t O_SWIN = O_SSLC + (size_t)NTS * 512;
constexpr size_t O_SC = O_SWIN + (size_t)128 * 512 * 512;
constexpr size_t O_SN = O_SC + (size_t)512 * 128 * 256;
constexpr size_t O_SM = O_SN + 512 * 128;

struct P {
    const float *xp, *xs, *cache_cmp, *cache_slc, *cache_win, *state_C, *state_n, *state_m;
    const int* page_table;
    const float *w_in, *b_in, *norm_a_g, *nsa_pe, *nsa_w_cmp, *w_br_a, *w_br_b, *w_merge, *w_out, *ln1_g, *ln1_b;
    const float *peer_wq, *peer_keys, *peer_u, *peer_v, *ln2_g, *ln2_b;
    float* out;
    bf16_t *XB, *WINT, *WMT, *WAT, *WBT, *WOT, *WQT, *KEYSB, *UB, *VB, *PROJ;
    float *SM, *BCUM, *MPREV, *ACOEF, *SCL, *MLOC, *DC, *DN, *CPREV, *NPREV, *KC, *VC, *OCMP;
    unsigned long long* SEL;
    bf16_t *YA, *YB, *G, *MERGED, *HB, *PQ;
    float *TMP, *R, *H, *EGATE;
    int* EIDX;
    unsigned* bar;
};

DEVI bf16_t f2bf(float f) { unsigned u = __float_as_uint(f); u += 0x7FFFu + ((u >> 16) & 1u); return (bf16_t)(u >> 16); }
DEVI float bf2f(bf16_t h) { return __uint_as_float(((unsigned)h) << 16); }
DEVI unsigned pack2(float a, float b) { return (unsigned)f2bf(a) | ((unsigned)f2bf(b) << 16); }
DEVI float wave_max(float v) { for (int o = 32; o > 0; o >>= 1) v = fmaxf(v, __shfl_xor(v, o)); return v; }
DEVI float wave_sum(float v) { for (int o = 32; o > 0; o >>= 1) v += __shfl_xor(v, o); return v; }
DEVI float sigmoidf_(float x) { return 1.f / (1.f + __expf(-x)); }
DEVI float logsigmoidf_(float x) { return fminf(x, 0.f) - log1pf(__expf(-fabsf(x))); }
DEVI int win_map(int np) {
    if (np < 2048) return np;
    if (np < 5632) return np + 8;
    if (np < 5640) return np - 5632 + 2048;
    if (np < 5688) return np;
    return -1;
}
DEVI float alibi_slope(int h) { return exp2f(-0.5f * (float)(h + 1)); }

template <class MapFn>
DEVI void transpose_cvt(const float* __restrict__ W, bf16_t* __restrict__ WT, int K, int Nsrc, int Ndst, MapFn mapfn, float* tile  , int bid, int nblk) {
    const int tid = threadIdx.x;
    const int tn = Ndst / 64, tk = K / 64;
    for (int t = bid; t < tn * tk; t += nblk) {
        const int n0 = (t % tn) * 64, k0 = (t / tn) * 64;
        __syncthreads();
#pragma unroll
        for (int i = 0; i < 8; ++i) {
            const int kk = (tid >> 6) + i * 8, nn = tid & 63;
            const int n = mapfn(n0 + nn);
            tile[kk * 65 + nn] = n >= 0 ? W[(size_t)(k0 + kk) * Nsrc + n] : 0.f;
        }
        __syncthreads();
#pragma unroll
        for (int i = 0; i < 8; ++i) {
            const int nn = (tid >> 6) + i * 8, kk = tid & 63;
            WT[(size_t)(n0 + nn) * K + k0 + kk] = f2bf(tile[kk * 65 + nn]);
        }
    }
}
struct IdMap { DEVI int operator()(int n) const { return n; } };
struct WinMap { DEVI int operator()(int n) const { return win_map(n); } };

DEVI void cvt_rows(const float* __restrict__ src, bf16_t* __restrict__ dst, size_t n4, int bid, int nblk) {
    for (size_t i = (size_t)bid * blockDim.x + threadIdx.x; i < n4; i += (size_t)nblk * blockDim.x) {
        const f32x4 v = ((const f32x4*)src)[i];
        u32x2 o; o.x = pack2(v.x, v.y); o.y = pack2(v.z, v.w);
        ((u32x2*)dst)[i] = o;
    }
}

DEVI void stage_prologue(const P& p, char* smem, int bid, int nblk) {
    float* tile = (float*)smem;
    cvt_rows(p.xp, p.XB, (size_t)NTP * 256, bid, nblk);
    cvt_rows(p.xs, p.XB + (size_t)NTP * 1024, (size_t)NTS * 256, bid, nblk);
    cvt_rows(p.peer_u, p.UB, (size_t)16384 * 256, bid, nblk);
    cvt_rows(p.peer_v, p.VB, (size_t)16384 * 256, bid, nblk);
    cvt_rows(p.peer_keys, p.KEYSB, (size_t)16 * 128 * 128 / 4, bid, nblk);
    transpose_cvt(p.w_in, p.WINT, 1024, 5688, NPAD_IN, WinMap(), tile, bid, nblk);
    transpose_cvt(p.w_merge, p.WMT, 1024, 2048, 2048, IdMap(), tile, bid, nblk);
    transpose_cvt(p.w_br_a, p.WAT, 1024, 1024, 1024, IdMap(), tile, bid, nblk);
    transpose_cvt(p.w_br_b, p.WBT, 1024, 1024, 1024, IdMap(), tile, bid, nblk);
    transpose_cvt(p.w_out, p.WOT, 1024, 1024, 1024, IdMap(), tile, bid, nblk);
    transpose_cvt(p.peer_wq, p.WQT, 1024, 2048, 2048, IdMap(), tile, bid, nblk);
    {
        const size_t per_b = (size_t)508 * 512 / 4;
        for (size_t i = (size_t)bid * blockDim.x + threadIdx.x; i < 128 * per_b; i += (size_t)nblk * blockDim.x) {
            const size_t b = i / per_b, r = i % per_b;
            ((f32x4*)(p.out + O_SWIN + b * 512 * 512))[r] = ((const f32x4*)(p.cache_win + b * 512 * 512 + 4 * 512))[r];
        }
    }
}

template <class Epi>
DEVI void gemm_phase(const bf16_t* __restrict__ A, const bf16_t* __restrict__ Bt, int M, int N, int K, const Epi& epi, char* smem, int bid, int nblk) {
    bf16_t* As = (bf16_t*)smem;
    bf16_t* Bs = As + 256 * 72;
    const int tid = threadIdx.x, lane = tid & 63, wid = tid >> 6, wm = wid >> 1, wn = wid & 1;
    const int fr = lane & 15, fq = lane >> 4;
    const int ntm = M / 256, ntn = N / 128, nk = K / 64;
    for (int tile = bid; tile < ntm * ntn; tile += nblk) {
        const int tm = tile / ntn, tn = tile % ntn;
        f32x4 acc[4][4];
#pragma unroll
        for (int i = 0; i < 4; ++i)
#pragma unroll
            for (int j = 0; j < 4; ++j) acc[i][j] = (f32x4){0.f, 0.f, 0.f, 0.f};
        const bf16_t* Ag = A + (size_t)(tm * 256 + (tid >> 1)) * K + (tid & 1) * 32;
        const bf16_t* Bg = Bt + (size_t)(tn * 128 + (tid >> 2)) * K + (tid & 3) * 16;
        u32x4 ra[4], rb[2];
#pragma unroll
        for (int i = 0; i < 4; ++i) ra[i] = *(const u32x4*)(Ag + i * 8);
#pragma unroll
        for (int i = 0; i < 2; ++i) rb[i] = *(const u32x4*)(Bg + i * 8);
        for (int kt = 0; kt < nk; ++kt) {
            __syncthreads();
#pragma unroll
            for (int i = 0; i < 4; ++i) *(u32x4*)(As + (tid >> 1) * 72 + (tid & 1) * 32 + i * 8) = ra[i];
#pragma unroll
            for (int i = 0; i < 2; ++i) *(u32x4*)(Bs + (tid >> 2) * 72 + (tid & 3) * 16 + i * 8) = rb[i];
            __syncthreads();
            if (kt + 1 < nk) {
#pragma unroll
                for (int i = 0; i < 4; ++i) ra[i] = *(const u32x4*)(Ag + (kt + 1) * 64 + i * 8);
#pragma unroll
                for (int i = 0; i < 2; ++i) rb[i] = *(const u32x4*)(Bg + (kt + 1) * 64 + i * 8);
            }
#pragma unroll
            for (int ks = 0; ks < 2; ++ks) {
                bf16x8 af[4], bfr[4];
#pragma unroll
                for (int i = 0; i < 4; ++i) af[i] = *(const bf16x8*)(As + (wm * 64 + i * 16 + fr) * 72 + ks * 32 + fq * 8);
#pragma unroll
                for (int j = 0; j < 4; ++j) bfr[j] = *(const bf16x8*)(Bs + (wn * 64 + j * 16 + fr) * 72 + ks * 32 + fq * 8);
#pragma unroll
                for (int i = 0; i < 4; ++i)
#pragma unroll
                    for (int j = 0; j < 4; ++j) acc[i][j] = __builtin_amdgcn_mfma_f32_16x16x32_bf16(bfr[j], af[i], acc[i][j], 0, 0, 0);
            }
        }
#pragma unroll
        for (int i = 0; i < 4; ++i)
#pragma unroll
            for (int j = 0; j < 4; ++j) epi(tm * 256 + wm * 64 + i * 16 + fr, tn * 128 + wn * 64 + j * 16 + fq * 4, acc[i][j]);
    }
}

struct EpiInProj {
    P p;
    DEVI void operator()(int row, int col, f32x4 v) const {
        if (col >= 5688) return;
        const int oc = win_map(col);
#pragma unroll
        for (int q = 0; q < 4; ++q) v[q] += p.b_in[oc + q];
        if (col >= 5632) { *(f32x4*)(p.SM + (size_t)row * 64 + (col - 5632)) = v; return; }
        if (col >= C_AK && col < C_AV) v *= 0.08838834764831845f;
        u32x2 o; o.x = pack2(v[0], v[1]); o.y = pack2(v[2], v[3]);
        *(u32x2*)(p.PROJ + (size_t)row * PS + col) = o;
        if (col >= C_CMP) {
            const int reg = (col - C_CMP) >> 9, c = (col - C_CMP) & 511;
            float* dst = nullptr;
            if (row < NTP) {
                if (reg == 0) dst = p.out + O_PCMP + (size_t)row * 512 + c;
                else if (reg == 1) dst = p.out + O_PSLC + (size_t)row * 512 + c;
                else { const int b = row >> 12, t = row & 4095; if (t >= 3584) dst = p.out + O_PWIN + ((size_t)b * 512 + (t - 3584)) * 512 + c; }
            } else {
                const int rs = row - NTP;
                if (reg == 0) dst = p.out + O_SCMP + (size_t)rs * 512 + c;
                else if (reg == 1) dst = p.out + O_SSLC + (size_t)rs * 512 + c;
                else { const int b = rs >> 2, tq = rs & 3; dst = p.out + O_SWIN + ((size_t)b * 512 + 508 + tq) * 512 + c; }
            }
            if (dst) *(f32x4*)dst = v;
        }
    }
};
struct EpiG {
    P p;
    DEVI void operator()(int row, int col, f32x4 v) const {
        u32x2 o; o.x = pack2(sigmoidf_(v[0]), sigmoidf_(v[1])); o.y = pack2(sigmoidf_(v[2]), sigmoidf_(v[3]));
        *(u32x2*)(p.G + (size_t)row * 2048 + col) = o;
    }
};
struct EpiM1 {
    P p;
    DEVI void operator()(int row, int col, f32x4 v) const {
        const u32x2 g = *(const u32x2*)(p.G + (size_t)row * 2048 + col);
        v[0] *= __uint_as_float(g.x << 16); v[1] *= __uint_as_float(g.x & 0xFFFF0000u);
        v[2] *= __uint_as_float(g.y << 16); v[3] *= __uint_as_float(g.y & 0xFFFF0000u);
        *(f32x4*)(p.TMP + (size_t)row * 1024 + col) = v;
    }
};
struct EpiM2 {
    P p;
    DEVI void operator()(int row, int col, f32x4 v) const {
        const u32x2 g = *(const u32x2*)(p.G + (size_t)row * 2048 + 1024 + col);
        const f32x4 t = *(const f32x4*)(p.TMP + (size_t)row * 1024 + col);
        v[0] = t[0] + v[0] * __uint_as_float(g.x << 16); v[1] = t[1] + v[1] * __uint_as_float(g.x & 0xFFFF0000u);
        v[2] = t[2] + v[2] * __uint_as_float(g.y << 16); v[3] = t[3] + v[3] * __uint_as_float(g.y & 0xFFFF0000u);
        u32x2 o; o.x = pack2(v[0], v[1]); o.y = pack2(v[2], v[3]);
        *(u32x2*)(p.MERGED + (size_t)row * 1024 + col) = o;
    }
};
struct EpiR {
    P p;
    DEVI void operator()(int row, int col, f32x4 v) const {
        const float* xr = row < NTP ? p.xp + (size_t)row * 1024 : p.xs + (size_t)(row - NTP) * 1024;
        const f32x4 x = *(const f32x4*)(xr + col);
        *(f32x4*)(p.R + (size_t)row * 1024 + col) = x * DN_ALPHA + v;
    }
};
struct EpiPQ {
    P p;
    DEVI void operator()(int row, int col, f32x4 v) const {
        u32x2 o; o.x = pack2(v[0], v[1]); o.y = pack2(v[2], v[3]);
        *(u32x2*)(p.PQ + (size_t)row * 2048 + col) = o;
    }
};

DEVI void stage_mlstm_gates(const P& p, int bid, int nblk) {
    const int lane = threadIdx.x & 63, wid = threadIdx.x >> 6;
    for (int bh = bid * 8 + wid; bh < 16; bh += nblk * 8) {
        const int b = bh >> 2, h = bh & 3;
        float m = 0.f;
        for (int c = 0; c < 64; ++c) {
            const size_t row = (size_t)b * 4096 + c * 64 + lane;
            const float ip = p.SM[row * 64 + h];
            const float lf = logsigmoidf_(p.SM[row * 64 + 4 + h]);
            float cs = lf;
#pragma unroll
            for (int o = 1; o < 64; o <<= 1) { const float t = __shfl_up(cs, o); if (lane >= o) cs += t; }
            p.BCUM[bh * 4096 + c * 64 + lane] = cs;
            const float bend = __shfl(cs, 63);
            const float g = bend - cs + ip;
            const float mloc = wave_max(g);
            const float mnew = fmaxf(bend + m, mloc);
            if (lane == 0) {
                p.MPREV[bh * 64 + c] = m;
                p.ACOEF[bh * 64 + c] = __expf(bend + m - mnew);
                p.SCL[bh * 64 + c] = __expf(mloc - mnew);
                p.MLOC[bh * 64 + c] = mloc;
            }
            m = mnew;
        }
        if (lane == 0) p.out[O_PM + bh] = m;
    }
}

DEVI void stage_mlstm_dc(const P& p, char* smem, int bid, int nblk) {
    float* ks = (float*)smem;
    float* ws = ks + 64 * 128;
    const int tid = threadIdx.x;
    for (int task = bid; task < 1024; task += nblk) {
        const int bh = task >> 6, c = task & 63, b = bh >> 2, h = bh & 3;
        const size_t row0 = (size_t)b * 4096 + c * 64;
        __syncthreads();
        if (tid < 64) {
            const float bend = p.BCUM[bh * 4096 + c * 64 + 63];
            const float g = bend - p.BCUM[bh * 4096 + c * 64 + tid] + p.SM[(row0 + tid) * 64 + h];
            ws[tid] = __expf(g - p.MLOC[task]);
        }
        __syncthreads();
        for (int idx = tid; idx < 64 * 128; idx += 512) {
            const int s = idx >> 7, d = idx & 127;
            ks[idx] = ws[s] * bf2f(p.PROJ[(row0 + s) * PS + C_AK + h * 128 + d]);
        }
        __syncthreads();
        const int v = tid & 255, dg = tid >> 8;
        float acc[64];
#pragma unroll
        for (int i = 0; i < 64; ++i) acc[i] = 0.f;
        for (int s = 0; s < 64; ++s) {
            const float vv = bf2f(p.PROJ[(row0 + s) * PS + C_AV + h * 256 + v]);
#pragma unroll
            for (int i = 0; i < 64; ++i) acc[i] += ks[s * 128 + dg * 64 + i] * vv;
        }
#pragma unroll
        for (int i = 0; i < 64; ++i) p.DC[((size_t)task * 128 + dg * 64 + i) * 256 + v] = acc[i];
        if (tid < 128) {
            float a = 0.f;
            for (int s = 0; s < 64; ++s) a += ks[s * 128 + tid];
            p.DN[task * 128 + tid] = a;
        }
    }
}

DEVI void stage_mlstm_scan(const P& p, int bid, int nblk) {
    for (int e = bid * blockDim.x + threadIdx.x; e < 16 * 32768 + 16 * 128; e += nblk * blockDim.x) {
        if (e < 16 * 32768) {
            const int bh = e >> 15, dv = e & 32767;
            float C = 0.f;
            for (int c = 0; c < 64; ++c) {
                const size_t idx = ((size_t)(bh * 64 + c)) * 32768 + dv;
                p.CPREV[idx] = C;
                C = p.ACOEF[bh * 64 + c] * C + p.SCL[bh * 64 + c] * p.DC[idx];
            }
            p.out[O_PC + e] = C;
        } else {
            const int e2 = e - 16 * 32768, bh = e2 >> 7, d = e2 & 127;
            float n = 0.f;
            for (int c = 0; c < 64; ++c) {
                const size_t idx = (size_t)(bh * 64 + c) * 128 + d;
                p.NPREV[idx] = n;
                n = p.ACOEF[bh * 64 + c] * n + p.SCL[bh * 64 + c] * p.DN[idx];
            }
            p.out[O_PN + e2] = n;
        }
    }
}

constexpr int MLO_LDS = (64 * 128 + 64 * 129 + 64 * 64 + 6 * 64 + 64 * 256) * 4;
DEVI void stage_mlstm_out(const P& p, char* smem, int bid, int nblk) {
    float* qs = (float*)smem;
    float* ks = qs + 64 * 128;
    float* Ps = ks + 64 * 129;
    float* bcum = Ps + 64 * 64;
    float* ipre = bcum + 64; float* mt = ipre + 64; float* wint = mt + 64; float* den = wint + 64; float* emt = den + 64;
    float* hs = emt + 64;
    const int tid = threadIdx.x, lane = tid & 63, wid = tid >> 6;
    for (int task = bid; task < 1024; task += nblk) {
        const int bh = task >> 6, c = task & 63, b = bh >> 2, h = bh & 3;
        const size_t row0 = (size_t)b * 4096 + c * 64;
        __syncthreads();
        for (int idx = tid; idx < 64 * 128; idx += 512) {
            const int t = idx >> 7, d = idx & 127;
            qs[idx] = bf2f(p.PROJ[(row0 + t) * PS + C_AQ + h * 128 + d]);
            ks[t * 129 + d] = bf2f(p.PROJ[(row0 + t) * PS + C_AK + h * 128 + d]);
        }
        if (tid < 64) { bcum[tid] = p.BCUM[bh * 4096 + c * 64 + tid]; ipre[tid] = p.SM[(row0 + tid) * 64 + h]; }
        const float mprev = p.MPREV[task];
        __syncthreads();
        for (int idx = tid; idx < 4096; idx += 512) {
            const int t = idx >> 6, s = idx & 63;
            float a = 0.f;
            if (s <= t) for (int d = 0; d < 128; ++d) a += qs[t * 128 + d] * ks[s * 129 + d];
            Ps[idx] = a;
        }
        if (tid < 64) {
            const int t = tid;
            float mx = bcum[t] + mprev;
            for (int s = 0; s <= t; ++s) mx = fmaxf(mx, bcum[t] - bcum[s] + ipre[s]);
            mt[t] = mx; wint[t] = __expf(bcum[t] + mprev - mx); emt[t] = __expf(-mx);
        }
        __syncthreads();
        for (int idx = tid; idx < 4096; idx += 512) {
            const int t = idx >> 6, s = idx & 63;
            if (s <= t) Ps[idx] *= __expf(bcum[t] - bcum[s] + ipre[s] - mt[t]);
        }
        __syncthreads();
        if (tid < 64) {
            const int t = tid;
            float ds = 0.f, qn = 0.f;
            for (int s = 0; s < 64; ++s) ds += Ps[t * 64 + s];
            for (int d = 0; d < 128; ++d) qn += qs[t * 128 + d] * p.NPREV[(size_t)task * 128 + d];
            den[t] = wint[t] * qn + ds;
        }
        __syncthreads();
        const int v = tid & 255, th = tid >> 8;
#pragma unroll 1
        for (int pass = 0; pass < 2; ++pass) {
            const int tb = th * 32 + pass * 16;
            float acc[16];
#pragma unroll
            for (int i = 0; i < 16; ++i) acc[i] = 0.f;
#pragma unroll 2
            for (int d = 0; d < 128; ++d) {
                const float cv = p.CPREV[((size_t)task * 128 + d) * 256 + v];
#pragma unroll
                for (int i = 0; i < 16; ++i) acc[i] += qs[(tb + i) * 128 + d] * cv;
            }
#pragma unroll
            for (int i = 0; i < 16; ++i) acc[i] *= wint[tb + i];
#pragma unroll 2
            for (int s = 0; s < 64; ++s) {
                const float vv = bf2f(p.PROJ[(row0 + s) * PS + C_AV + h * 256 + v]);
#pragma unroll
                for (int i = 0; i < 16; ++i) acc[i] += Ps[(tb + i) * 64 + s] * vv;
            }
#pragma unroll
            for (int i = 0; i < 16; ++i) { const int t = tb + i; hs[t * 256 + v] = acc[i] / fmaxf(fabsf(den[t]), emt[t]); }
        }
        __syncthreads();
        for (int rr = 0; rr < 8; ++rr) {
            const int t = wid * 8 + rr;
            const f32x4 x = *(const f32x4*)(hs + t * 256 + lane * 4);
            const float mean = wave_sum(x[0] + x[1] + x[2] + x[3]) * (1.f / 256.f);
            float q = 0.f;
#pragma unroll
            for (int k = 0; k < 4; ++k) q += (x[k] - mean) * (x[k] - mean);
            const float rs = rsqrtf(wave_sum(q) * (1.f / 256.f) + LN_EPS);
            float y[4];
#pragma unroll
            for (int k = 0; k < 4; ++k) {
                const int vi = lane * 4 + k;
                const float o = bf2f(p.PROJ[(row0 + t) * PS + C_AO + h * 256 + vi]);
                y[k] = (x[k] - mean) * rs * p.norm_a_g[h * 256 + vi] * sigmoidf_(o);
            }
            u32x2 o2; o2.x = pack2(y[0], y[1]); o2.y = pack2(y[2], y[3]);
            *(u32x2*)(p.YA + (row0 + t) * 1024 + h * 256 + lane * 4) = o2;
        }
    }
}

DEVI void stage_mlstm_sample(const P& p, char* smem, int bid, int nblk) {
    float* qs = (float*)smem;
    float* ks = qs + 512;
    float* vs = ks + 512;
    float* part = vs + 1024;
    float* hs = part + 2048;
    float* sc = hs + 1024;
    float* bc = sc; float* ip = sc + 4; float* mt = sc + 8; float* wint = sc + 12; float* emt = sc + 16; float* ww = sc + 20; float* den = sc + 24;
    float* Pm = sc + 32;
    float* misc = sc + 48;
    const int tid = threadIdx.x, lane = tid & 63, wid = tid >> 6;
    for (int task = bid; task < 512; task += nblk) {
        const int b = task >> 2, h = task & 3;
        const size_t row0 = (size_t)NTP + b * 4;
        __syncthreads();
        { const int t = tid >> 7, d = tid & 127;
          qs[tid] = bf2f(p.PROJ[(row0 + t) * PS + C_AQ + h * 128 + d]);
          ks[tid] = bf2f(p.PROJ[(row0 + t) * PS + C_AK + h * 128 + d]); }
        for (int idx = tid; idx < 1024; idx += 512) { const int t = idx >> 8, v = idx & 255; vs[idx] = bf2f(p.PROJ[(row0 + t) * PS + C_AV + h * 256 + v]); }
        if (tid == 0) {
            const float m0 = p.state_m[task];
            float cs = 0.f;
            for (int t = 0; t < 4; ++t) { cs += logsigmoidf_(p.SM[(row0 + t) * 64 + 4 + h]); bc[t] = cs; ip[t] = p.SM[(row0 + t) * 64 + h]; }
            for (int t = 0; t < 4; ++t) {
                float mx = bc[t] + m0;
                for (int s = 0; s <= t; ++s) mx = fmaxf(mx, bc[t] - bc[s] + ip[s]);
                mt[t] = mx; wint[t] = __expf(bc[t] + m0 - mx); emt[t] = __expf(-mx);
            }
            const float bend = bc[3];
            float mnew = bend + m0;
            for (int s = 0; s < 4; ++s) mnew = fmaxf(mnew, bend - bc[s] + ip[s]);
            misc[0] = __expf(bend + m0 - mnew);
            for (int s = 0; s < 4; ++s) ww[s] = __expf(bend - bc[s] + ip[s] - mnew);
            p.out[O_SM + task] = mnew;
        }
        __syncthreads();
        if (tid < 16) {
            const int t = tid >> 2, s = tid & 3;
            float a = 0.f;
            if (s <= t) { for (int d = 0; d < 128; ++d) a += qs[t * 128 + d] * ks[s * 128 + d]; a *= __expf(bc[t] - bc[s] + ip[s] - mt[t]); }
            Pm[tid] = a;
        }
        __syncthreads();
        if (tid < 4) {
            const int t = tid; float qn = 0.f;
            for (int d = 0; d < 128; ++d) qn += qs[t * 128 + d] * p.state_n[(size_t)task * 128 + d];
            den[t] = wint[t] * qn + Pm[t * 4] + Pm[t * 4 + 1] + Pm[t * 4 + 2] + Pm[t * 4 + 3];
        }
        const float a = misc[0];
        if (tid >= 128 && tid < 256) {
            const int d = tid - 128;
            float n = a * p.state_n[(size_t)task * 128 + d];
            for (int s = 0; s < 4; ++s) n += ww[s] * ks[s * 128 + d];
            p.out[O_SN + (size_t)task * 128 + d] = n;
        }
        {
            const int v = tid & 255, dh = tid >> 8;
            float acc[4] = {0.f, 0.f, 0.f, 0.f};
            float wv[4];
#pragma unroll
            for (int s = 0; s < 4; ++s) wv[s] = ww[s] * vs[s * 256 + v];
            for (int d = dh * 64; d < dh * 64 + 64; ++d) {
                const size_t ci = ((size_t)task * 128 + d) * 256 + v;
                const float c0 = p.state_C[ci];
#pragma unroll
                for (int t = 0; t < 4; ++t) acc[t] += qs[t * 128 + d] * c0;
                float cn = a * c0;
#pragma unroll
                for (int s = 0; s < 4; ++s) cn += ks[s * 128 + d] * wv[s];
                p.out[O_SC + ci] = cn;
            }
#pragma unroll
            for (int t = 0; t < 4; ++t) part[(dh * 4 + t) * 256 + v] = acc[t];
        }
        __syncthreads();
        if (tid < 256) {
            const int v = tid;
#pragma unroll
            for (int t = 0; t < 4; ++t) {
                float num = wint[t] * (part[t * 256 + v] + part[(4 + t) * 256 + v]);
#pragma unroll
                for (int s = 0; s < 4; ++s) num += Pm[t * 4 + s] * vs[s * 256 + v];
                hs[t * 256 + v] = num / fmaxf(fabsf(den[t]), emt[t]);
            }
        }
        __syncthreads();
        if (wid < 4) {
            const int t = wid;
            const f32x4 x = *(const f32x4*)(hs + t * 256 + lane * 4);
            const float mean = wave_sum(x[0] + x[1] + x[2] + x[3]) * (1.f / 256.f);
            float q = 0.f;
#pragma unroll
            for (int k = 0; k < 4; ++k) q += (x[k] - mean) * (x[k] - mean);
            const float rs = rsqrtf(wave_sum(q) * (1.f / 256.f) + LN_EPS);
            float y[4];
#pragma unroll
            for (int k = 0; k < 4; ++k) {
                const int vi = lane * 4 + k;
                const float o = bf2f(p.PROJ[(row0 + t) * PS + C_AO + h * 256 + vi]);
                y[k] = (x[k] - mean) * rs * p.norm_a_g[h * 256 + vi] * sigmoidf_(o);
            }
            u32x2 o2; o2.x = pack2(y[0], y[1]); o2.y = pack2(y[2], y[3]);
            *(u32x2*)(p.YA + (row0 + t) * 1024 + h * 256 + lane * 4) = o2;
        }
    }
}

DEVI void stage_compress(const P& p, char* smem, int bid, int nblk) {
    float* tile = (float*)smem;
    const int tid = threadIdx.x;
    const int kv = tid >> 8, g = (tid >> 6) & 3, e = tid & 63;
    for (int task = bid; task < 256 + 4096; task += nblk) {
        const bool prompt = task < 256;
        int b, n; size_t src_row0;
        if (prompt) { b = task >> 6; n = task & 63; src_row0 = (size_t)b * 4096 + n * 64; }
        else { const int ts = task - 256; b = ts >> 5; n = ts & 31; const int page = p.page_table[b * 16 + (n >> 1)]; src_row0 = (size_t)page * 128 + (n & 1) * 64; }
        float acc = 0.f;
        for (int l0 = 0; l0 < 64; l0 += 16) {
            __syncthreads();
#pragma unroll
            for (int i = 0; i < 16; ++i) {
                const int idx = tid + i * 512, l = idx >> 9, c = idx & 511;
                float val = prompt ? bf2f(p.PROJ[(src_row0 + l0 + l) * PS + C_CMP + c]) : p.cache_cmp[(src_row0 + l0 + l) * 512 + c];
                val += p.nsa_pe[((c >> 8) * 64 + l0 + l) * 64 + (c & 63)];
                tile[idx] = val;
            }
            __syncthreads();
            for (int l = 0; l < 16; ++l) {
                const float* wr = p.nsa_w_cmp + ((size_t)(kv * 64 + l0 + l) * 64) * 64 + e;
                const float* tr = tile + l * 512 + kv * 256 + g * 64;
#pragma unroll 8
                for (int d = 0; d < 64; ++d) acc += tr[d] * wr[d * 64];
            }
        }
        (kv == 0 ? p.KC : p.VC)[(size_t)task * 256 + g * 64 + e] = acc;
    }
}

DEVI void stage_cmp_select(const P& p, int bid, int nblk) {
    const int lane = threadIdx.x & 63, wid = threadIdx.x >> 6;
    for (int wt = bid * 8 + wid; wt < NT * 4; wt += nblk * 8) {
        const int row = wt >> 2, g = wt & 3;
        int pos, nb, nvalid, cur; const float *kcb, *vcb;
        if (row < NTP) { const int b = row >> 12, t = row & 4095; pos = t; nb = 64; nvalid = (t + 1) >> 6; cur = t >> 6; kcb = p.KC + (size_t)(b * 64) * 256; vcb = p.VC + (size_t)(b * 64) * 256; }
        else { const int rs = row - NTP, b = rs >> 2, tq = rs & 3; pos = 2048 + tq; nb = 33; nvalid = 32; cur = 32; kcb = p.KC + (size_t)(256 + b * 32) * 256; vcb = p.VC + (size_t)(256 + b * 32) * 256; }
        const int j = lane;
        float pr[4] = {0.f, 0.f, 0.f, 0.f};
        float imp = 0.f;
        if (nvalid > 0) {
            float dot[4] = {0.f, 0.f, 0.f, 0.f};
            if (j < nvalid) {
                const float* kr = kcb + (size_t)j * 256 + g * 64;
                const bf16_t* qr = p.PROJ + (size_t)row * PS + C_BQ + g * 256;
                for (int d = 0; d < 64; ++d) {
                    const float kk = kr[d];
#pragma unroll
                    for (int r = 0; r < 4; ++r) dot[r] += bf2f(qr[r * 64 + d]) * kk;
                }
            }
#pragma unroll
            for (int r = 0; r < 4; ++r) {
                const float s = j < nvalid ? dot[r] * 0.125f - alibi_slope(g * 4 + r) * (float)(pos - (j * 64 + 63)) : -INFINITY;
                const float mx = wave_max(s);
                const float e = j < nvalid ? __expf(s - mx) : 0.f;
                const float sum = wave_sum(e);
                pr[r] = e / sum;
                imp += pr[r];
            }
            float o[4] = {0.f, 0.f, 0.f, 0.f};
            for (int jj = 0; jj < nvalid; ++jj) {
                const float vv = vcb[(size_t)jj * 256 + g * 64 + lane];
#pragma unroll
                for (int r = 0; r < 4; ++r) o[r] += __shfl(pr[r], jj) * vv;
            }
#pragma unroll
            for (int r = 0; r < 4; ++r) p.OCMP[(size_t)row * 1024 + (g * 4 + r) * 64 + lane] = o[r];
        } else {
#pragma unroll
            for (int r = 0; r < 4; ++r) p.OCMP[(size_t)row * 1024 + (g * 4 + r) * 64 + lane] = 0.f;
        }
        if (j == cur || j == 0) imp = 5.0f;
        if (j > cur) imp = -1.0f;
        if (j >= nb) imp = -2.0f;
        int rank = 0;
        for (int jj = 0; jj < 64; ++jj) { const float v = __shfl(imp, jj); rank += (v > imp || (v == imp && jj < j)) ? 1 : 0; }
        const unsigned long long mask = __ballot(rank < 16 && j < nb);
        if (lane == 0) p.SEL[(size_t)row * 4 + g] = mask;
    }
}

struct KBlock { const void* kb; const void* vb; int stride; int f32; int count; int pos0; };

template <bool WIN>
DEVI void attend_block(const KBlock& B, int qpos, const float* qs, const float (&slope)[4], float (&m)[4], float (&l)[4], float (&o)[4], int lane) {
    const int pos = B.pos0 + lane;
    const bool valid = lane < B.count && pos <= qpos && (!WIN || pos > qpos - 512);
    if (!__any(valid)) return;
    float dot[4] = {0.f, 0.f, 0.f, 0.f};
    if (valid) {
        if (B.f32) {
            const float* kr = (const float*)B.kb + (size_t)lane * B.stride;
#pragma unroll 4
            for (int d4 = 0; d4 < 16; ++d4) {
                const f32x4 kk = *(const f32x4*)(kr + d4 * 4);
#pragma unroll
                for (int e = 0; e < 4; ++e) { const f32x4 qq = *(const f32x4*)(qs + (d4 * 4 + e) * 4);
#pragma unroll
                    for (int r = 0; r < 4; ++r) dot[r] += kk[e] * qq[r]; }
            }
        } else {
            const bf16_t* kr = (const bf16_t*)B.kb + (size_t)lane * B.stride;
#pragma unroll 2
            for (int d8 = 0; d8 < 8; ++d8) {
                const u32x4 kk = *(const u32x4*)(kr + d8 * 8);
                const unsigned w[4] = {kk.x, kk.y, kk.z, kk.w};
#pragma unroll
                for (int e = 0; e < 4; ++e) {
                    const float k0 = __uint_as_float(w[e] << 16), k1 = __uint_as_float(w[e] & 0xFFFF0000u);
                    const f32x4 q0 = *(const f32x4*)(qs + (d8 * 8 + e * 2) * 4), q1 = *(const f32x4*)(qs + (d8 * 8 + e * 2 + 1) * 4);
#pragma unroll
                    for (int r = 0; r < 4; ++r) dot[r] += k0 * q0[r] + k1 * q1[r];
                }
            }
        }
    }
    float pr[4];
#pragma unroll
    for (int r = 0; r < 4; ++r) {
        const float s = valid ? dot[r] * 0.125f - slope[r] * (float)(qpos - pos) : -INFINITY;
        const float mn = fmaxf(m[r], wave_max(s));
        const float sc = __expf(m[r] - mn);
        pr[r] = valid ? __expf(s - mn) : 0.f;
        l[r] = l[r] * sc + wave_sum(pr[r]);
        o[r] *= sc; m[r] = mn;
    }
    for (int kk = 0; kk < B.count; ++kk) {
        const float vv = B.f32 ? ((const float*)B.vb)[(size_t)kk * B.stride + lane] : bf2f(((const bf16_t*)B.vb)[(size_t)kk * B.stride + lane]);
#pragma unroll
        for (int r = 0; r < 4; ++r) o[r] += __shfl(pr[r], kk) * vv;
    }
}

DEVI void stage_slc_win(const P& p, char* smem, int bid, int nblk) {
    const int lane = threadIdx.x & 63, wid = threadIdx.x >> 6;
    float* qs = (float*)smem + wid * 256;
    for (int wt = bid * 8 + wid; wt < NT * 4; wt += nblk * 8) {
        const int row = wt >> 2, g = wt & 3;
        const bool prompt = row < NTP;
        int b, t, qpos;
        if (prompt) { b = row >> 12; t = row & 4095; qpos = t; } else { const int rs = row - NTP; b = rs >> 2; t = rs & 3; qpos = 2048 + t; }
        {
            const bf16_t* qr = p.PROJ + (size_t)row * PS + C_BQ + g * 256;
            f32x4 qv;
#pragma unroll
            for (int r = 0; r < 4; ++r) qv[r] = bf2f(qr[r * 64 + lane]);
            *(f32x4*)(qs + lane * 4) = qv;
            asm volatile("s_waitcnt lgkmcnt(0)" ::: "memory");
        }
        float slope[4];
#pragma unroll
        for (int r = 0; r < 4; ++r) slope[r] = alibi_slope(g * 4 + r);
        float res[2][4];
        {
            float m[4], l[4], o[4];
#pragma unroll
            for (int r = 0; r < 4; ++r) { m[r] = -INFINITY; l[r] = 0.f; o[r] = 0.f; }
            unsigned long long mask = p.SEL[(size_t)row * 4 + g];
            while (mask) {
                const int j = __builtin_ctzll(mask); mask &= mask - 1;
                KBlock B;
                if (prompt) {
                    const bf16_t* base = p.PROJ + ((size_t)b * 4096 + j * 64) * PS + C_SLC + g * 64;
                    B.kb = base; B.vb = base + 256; B.stride = PS; B.f32 = 0; B.count = 64; B.pos0 = j * 64;
                } else if (j < 32) {
                    const int page = p.page_table[b * 16 + (j >> 1)];
                    const float* base = p.cache_slc + ((size_t)page * 128 + (j & 1) * 64) * 512 + g * 64;
                    B.kb = base; B.vb = base + 256; B.stride = 512; B.f32 = 1; B.count = 64; B.pos0 = j * 64;
                } else {
                    const bf16_t* base = p.PROJ + ((size_t)NTP + b * 4) * PS + C_SLC + g * 64;
                    B.kb = base; B.vb = base + 256; B.stride = PS; B.f32 = 0; B.count = 4; B.pos0 = 2048;
                }
                attend_block<false>(B, qpos, qs, slope, m, l, o, lane);
            }
#pragma unroll
            for (int r = 0; r < 4; ++r) res[0][r] = o[r] / l[r];
        }
        {
            float m[4], l[4], o[4];
#pragma unroll
            for (int r = 0; r < 4; ++r) { m[r] = -INFINITY; l[r] = 0.f; o[r] = 0.f; }
            if (prompt) {
                const int lo = (t - 511 > 0 ? t - 511 : 0) >> 6, hi = t >> 6;
                for (int j = lo; j <= hi; ++j) {
                    KBlock B; const bf16_t* base = p.PROJ + ((size_t)b * 4096 + j * 64) * PS + C_WIN + g * 64;
                    B.kb = base; B.vb = base + 256; B.stride = PS; B.f32 = 0; B.count = 64; B.pos0 = j * 64;
                    attend_block<true>(B, qpos, qs, slope, m, l, o, lane);
                }
            } else {
                for (int j = 0; j < 8; ++j) {
                    KBlock B; const float* base = p.cache_win + ((size_t)b * 512 + j * 64) * 512 + g * 64;
                    B.kb = base; B.vb = base + 256; B.stride = 512; B.f32 = 1; B.count = 64; B.pos0 = 1536 + j * 64;
                    attend_block<true>(B, qpos, qs, slope, m, l, o, lane);
                }
                KBlock B; const bf16_t* base = p.PROJ + ((size_t)NTP + b * 4) * PS + C_WIN + g * 64;
                B.kb = base; B.vb = base + 256; B.stride = PS; B.f32 = 0; B.count = 4; B.pos0 = 2048;
                attend_block<true>(B, qpos, qs, slope, m, l, o, lane);
            }
#pragma unroll
            for (int r = 0; r < 4; ++r) res[1][r] = o[r] / l[r];
        }
        const float* gt = p.SM + (size_t)row * 64 + 8;
#pragma unroll
        for (int r = 0; r < 4; ++r) {
            const float g0 = sigmoidf_(gt[g * 4 + r]), g1 = sigmoidf_(gt[16 + g * 4 + r]), g2 = sigmoidf_(gt[32 + g * 4 + r]);
            const float oc = p.OCMP[(size_t)row * 1024 + (g * 4 + r) * 64 + lane];
            p.YB[(size_t)row * 1024 + (g * 4 + r) * 64 + lane] = f2bf(g0 * oc + g1 * res[0][r] + g2 * res[1][r]);
        }
    }
}

DEVI void stage_ln1(const P& p, int bid, int nblk) {
    const int lane = threadIdx.x & 63, wid = threadIdx.x >> 6;
    for (int row = bid * 8 + wid; row < NT; row += nblk * 8) {
        f32x4 x[4];
        float s = 0.f;
#pragma unroll
        for (int i = 0; i < 4; ++i) { x[i] = *(const f32x4*)(p.R + (size_t)row * 1024 + i * 256 + lane * 4); s += x[i][0] + x[i][1] + x[i][2] + x[i][3]; }
        const float mean = wave_sum(s) * (1.f / 1024.f);
        float q = 0.f;
#pragma unroll
        for (int i = 0; i < 4; ++i)
#pragma unroll
            for (int k = 0; k < 4; ++k) q += (x[i][k] - mean) * (x[i][k] - mean);
        const float rs = rsqrtf(wave_sum(q) * (1.f / 1024.f) + LN_EPS);
#pragma unroll
        for (int i = 0; i < 4; ++i) {
            const int c = i * 256 + lane * 4;
            const f32x4 gg = *(const f32x4*)(p.ln1_g + c), bb = *(const f32x4*)(p.ln1_b + c);
            f32x4 y;
#pragma unroll
            for (int k = 0; k < 4; ++k) y[k] = (x[i][k] - mean) * rs * gg[k] + bb[k];
            *(f32x4*)(p.H + (size_t)row * 1024 + c) = y;
            u32x2 o; o.x = pack2(y[0], y[1]); o.y = pack2(y[2], y[3]);
            *(u32x2*)(p.HB + (size_t)row * 1024 + c) = o;
        }
    }
}

__device__ const unsigned char PEER_CA[50] = {0,0,0,0,0,0,0,0,0,0,0,0,0,0,0,0, 1,1,1,1,1,1,1,1, 2,2,2,2,2, 3,3,3,3, 4,4,4, 5,5, 6,6, 7,7, 8,9,10,11,12,13,14,15};
__device__ const unsigned char PEER_CB[50] = {0,1,2,3,4,5,6,7,8,9,10,11,12,13,14,15, 0,1,2,3,4,5,6,7, 0,1,2,3,4, 0,1,2,3, 0,1,2, 0,1, 0,1, 0,1, 0,0,0,0,0,0,0,0};

DEVI void stage_peer_route(const P& p, char* smem, int bid, int nblk) {
    const int lane = threadIdx.x & 63, wid = threadIdx.x >> 6;
    float* qs = (float*)smem + wid * 320;
    float* ts = qs + 256; int* ti = (int*)(qs + 288);
    for (int wt = bid * 8 + wid; wt < NT * 8; wt += nblk * 8) {
        const int row = wt >> 3, ph = wt & 7;
        {
            const bf16_t* qr = p.PQ + (size_t)row * 2048 + ph * 256;
#pragma unroll
            for (int i = 0; i < 4; ++i) qs[i * 64 + lane] = bf2f(qr[i * 64 + lane]);
            asm volatile("s_waitcnt lgkmcnt(0)" ::: "memory");
        }
        float sc[2][2];
#pragma unroll
        for (int c = 0; c < 2; ++c)
#pragma unroll
            for (int kh = 0; kh < 2; ++kh) {
                const bf16_t* kr = p.KEYSB + ((size_t)((ph * 2 + c) * 128 + kh * 64 + lane)) * 128;
                float a = 0.f;
#pragma unroll 4
                for (int d8 = 0; d8 < 16; ++d8) {
                    const u32x4 kk = *(const u32x4*)(kr + d8 * 8);
                    const unsigned w[4] = {kk.x, kk.y, kk.z, kk.w};
#pragma unroll
                    for (int e = 0; e < 4; ++e) a += __uint_as_float(w[e] << 16) * qs[c * 128 + d8 * 8 + e * 2] + __uint_as_float(w[e] & 0xFFFF0000u) * qs[c * 128 + d8 * 8 + e * 2 + 1];
                }
                sc[c][kh] = a;
            }
#pragma unroll
        for (int c = 0; c < 2; ++c) {
            int r0 = 0, r1 = 0;
            for (int kk = 0; kk < 64; ++kk) {
                const float v0 = __shfl(sc[c][0], kk), v1 = __shfl(sc[c][1], kk);
                r0 += (v0 > sc[c][0] || (v0 == sc[c][0] && kk < lane)) ? 1 : 0;
                r0 += (v1 > sc[c][0]) ? 1 : 0;
                r1 += (v0 >= sc[c][1]) ? 1 : 0;
                r1 += (v1 > sc[c][1] || (v1 == sc[c][1] && kk < lane)) ? 1 : 0;
            }
            if (r0 < 16) { ts[c * 16 + r0] = sc[c][0]; ti[c * 16 + r0] = lane; }
            if (r1 < 16) { ts[c * 16 + r1] = sc[c][1]; ti[c * 16 + r1] = lane + 64; }
        }
        asm volatile("s_waitcnt lgkmcnt(0)" ::: "memory");
        float cand = -INFINITY; int cidx = 0;
        if (lane < 50) { const int a = PEER_CA[lane], bq = PEER_CB[lane]; cand = ts[a] + ts[16 + bq]; cidx = ti[a] * 128 + ti[16 + bq]; }
        int rk = 0;
        for (int kk = 0; kk < 50; ++kk) { const float v = __shfl(cand, kk); rk += (v > cand || (v == cand && kk < lane)) ? 1 : 0; }
        const bool sel = lane < 50 && rk < 16;
        const float mx = wave_max(sel ? cand : -INFINITY);
        const float e = sel ? __expf(cand - mx) : 0.f;
        const float sum = wave_sum(e);
        if (sel) { p.EIDX[(size_t)row * 128 + ph * 16 + rk] = cidx; p.EGATE[(size_t)row * 128 + ph * 16 + rk] = e / sum; }
        asm volatile("s_waitcnt lgkmcnt(0)" ::: "memory");
    }
}

DEVI void stage_peer_apply(const P& p, int bid, int nblk) {
    const int lane = threadIdx.x & 63, wid = threadIdx.x >> 6;
    for (int row = bid * 8 + wid; row < NT; row += nblk * 8) {
        float hv[16], acc[16];
#pragma unroll
        for (int i = 0; i < 2; ++i) {
            const f32x4 a = *(const f32x4*)(p.H + (size_t)row * 1024 + i * 512 + lane * 8), b2 = *(const f32x4*)(p.H + (size_t)row * 1024 + i * 512 + lane * 8 + 4);
#pragma unroll
            for (int k = 0; k < 4; ++k) { hv[i * 8 + k] = a[k]; hv[i * 8 + 4 + k] = b2[k]; }
        }
#pragma unroll
        for (int i = 0; i < 16; ++i) acc[i] = 0.f;
        for (int e = 0; e < 128; ++e) {
            const int idx = p.EIDX[(size_t)row * 128 + e];
            const float gt = p.EGATE[(size_t)row * 128 + e];
            const bf16_t* ur = p.UB + (size_t)idx * 1024 + lane * 8;
            const bf16_t* vr = p.VB + (size_t)idx * 1024 + lane * 8;
            float dot = 0.f;
#pragma unroll
            for (int i = 0; i < 2; ++i) {
                const u32x4 u = *(const u32x4*)(ur + i * 512);
                const unsigned w[4] = {u.x, u.y, u.z, u.w};
#pragma unroll
                for (int k = 0; k < 4; ++k) dot += __uint_as_float(w[k] << 16) * hv[i * 8 + k * 2] + __uint_as_float(w[k] & 0xFFFF0000u) * hv[i * 8 + k * 2 + 1];
            }
            dot = wave_sum(dot);
            const float act = 0.5f * dot * (1.f + erff(dot * 0.7071067811865476f));
            const float cf = gt * act;
#pragma unroll
            for (int i = 0; i < 2; ++i) {
                const u32x4 u = *(const u32x4*)(vr + i * 512);
                const unsigned w[4] = {u.x, u.y, u.z, u.w};
#pragma unroll
                for (int k = 0; k < 4; ++k) { acc[i * 8 + k * 2] += cf * __uint_as_float(w[k] << 16); acc[i * 8 + k * 2 + 1] += cf * __uint_as_float(w[k] & 0xFFFF0000u); }
            }
        }
        float s = 0.f;
#pragma unroll
        for (int i = 0; i < 16; ++i) { acc[i] += DN_ALPHA * hv[i]; s += acc[i]; }
        const float mean = wave_sum(s) * (1.f / 1024.f);
        float q = 0.f;
#pragma unroll
        for (int i = 0; i < 16; ++i) q += (acc[i] - mean) * (acc[i] - mean);
        const float rs = rsqrtf(wave_sum(q) * (1.f / 1024.f) + LN_EPS);
#pragma unroll
        for (int i = 0; i < 2; ++i) {
            const int c = i * 512 + lane * 8;
            f32x4 y0, y1;
#pragma unroll
            for (int k = 0; k < 4; ++k) {
                y0[k] = (acc[i * 8 + k] - mean) * rs * p.ln2_g[c + k] + p.ln2_b[c + k];
                y1[k] = (acc[i * 8 + 4 + k] - mean) * rs * p.ln2_g[c + 4 + k] + p.ln2_b[c + 4 + k];
            }
            *(f32x4*)(p.out + O_Y + (size_t)row * 1024 + c) = y0;
            *(f32x4*)(p.out + O_Y + (size_t)row * 1024 + c + 4) = y1;
        }
    }
}


#define XB_TMO      128
#define XB_XCNT(j)  (256  + 64 * (j))
#define XB_XSUB(j)  (1280 + 64 * (j))
#define XB_XGEN(j)  (2304 + 64 * (j))
#define XB_TOP      3328
#define XB_TOPGEN   3392
#define XCD_BAR_WORDS 3456
#define XB_SPIN_CAP (1u << 18)
#define LAS __attribute__((address_space(3)))

__device__ __forceinline__ unsigned xb_ld(unsigned* p)              { return __hip_atomic_load(p, __ATOMIC_RELAXED, __HIP_MEMORY_SCOPE_AGENT); }
__device__ __forceinline__ unsigned xb_add(unsigned* p, unsigned v) { return __hip_atomic_fetch_add(p, v, __ATOMIC_RELAXED, __HIP_MEMORY_SCOPE_AGENT); }
__device__ __forceinline__ unsigned xb_xcc_id() { return (unsigned)__builtin_amdgcn_s_getreg((3 << 11) | 20) & 0xFu; }
#define XB_SPIN(cond, bar) do { unsigned _sp = 0; while (cond) { __builtin_amdgcn_s_sleep(1); \
    if ((++_sp & 255u) == 0u) { if (xb_ld(&(bar)[XB_TMO])) break; if (_sp > XB_SPIN_CAP) { atomicAdd(&(bar)[XB_TMO], 1u); break; } } } } while (0)

struct XcdBarrier {
    unsigned* bar; unsigned x;
    volatile LAS unsigned* st;
};

__device__ __forceinline__ XcdBarrier xcd_barrier_post(unsigned* bar, volatile LAS unsigned* st) {
    XcdBarrier b; b.bar = bar; b.x = xb_xcc_id(); b.st = st;
    if (threadIdx.x == 0) (void)xb_add(&bar[XB_XCNT(b.x)], 1u);
    return b;
}
__device__ __forceinline__ void xcd_barrier_complete(unsigned* bar, unsigned x, unsigned& nloc, unsigned& nx) {
    const unsigned G = gridDim.x * gridDim.y * gridDim.z;
    unsigned sum, cnt, mine, sp = 0u;
    for (;;) {
        sum = 0u; cnt = 0u; mine = 0u;
#pragma unroll
        for (unsigned j = 0; j < 16; ++j) { const unsigned c = xb_ld(&bar[XB_XCNT(j)]); sum += c; cnt += (c > 0u) ? 1u : 0u; mine = (j == x) ? c : mine; }
        if (sum == G) break;
        __builtin_amdgcn_s_sleep(1);
        if ((++sp & 255u) == 0u) { if (xb_ld(&bar[XB_TMO])) break; if (sp > XB_SPIN_CAP) { atomicAdd(&bar[XB_TMO], 1u); break; } }
    }
    nloc = mine > 0u ? mine : 1u; nx = cnt > 0u ? cnt : 1u;
}

__device__ __forceinline__ void xcd_barrier(const XcdBarrier& b) {
    asm volatile("s_waitcnt vmcnt(0)" ::: "memory");
    __syncthreads();
    if (threadIdx.x == 0) {
        unsigned* bar = b.bar;
        __builtin_amdgcn_s_waitcnt(0);
        unsigned nloc = b.st[0], nx = b.st[1];
        if (nloc == 0u) { xcd_barrier_complete(bar, b.x, nloc, nx); b.st[0] = nloc; b.st[1] = nx; }
        const unsigned old = xb_add(&bar[XB_XSUB(b.x)], 1u);
        const unsigned gen = old / nloc;
        if (old + 1u == (gen + 1u) * nloc) {
            __builtin_amdgcn_fence(__ATOMIC_RELEASE, "agent");
            asm volatile("s_waitcnt vmcnt(0)" ::: "memory");
            const unsigned og = xb_add(&bar[XB_TOP], 1u);
            const unsigned tg = og / nx;
            if (og + 1u == (tg + 1u) * nx) xb_add(&bar[XB_TOPGEN], 1u);
            else XB_SPIN(xb_ld(&bar[XB_TOPGEN]) == tg, bar);
            __builtin_amdgcn_fence(__ATOMIC_ACQUIRE, "agent");
            xb_add(&bar[XB_XGEN(b.x)], 1u);
            asm volatile("s_waitcnt vmcnt(0)" ::: "memory");
        } else {
            XB_SPIN(xb_ld(&bar[XB_XGEN(b.x)]) == gen, bar);
            __builtin_amdgcn_fence(__ATOMIC_ACQUIRE, "agent");
            asm volatile("s_waitcnt vmcnt(0)" ::: "memory");
        }
    }
    __syncthreads();
}

constexpr int LDS_BYTES = 152 * 1024;
static_assert(MLO_LDS <= LDS_BYTES, "lds");
template <int S>
DEVI void run_stage(const P& p, char* smem, int bid, int nblk) {
    if (S == 0) stage_prologue(p, smem, bid, nblk);
    if (S == 1) { EpiInProj e{p}; gemm_phase(p.XB, p.WINT, NT, NPAD_IN, 1024, e, smem, bid, nblk); }
    if (S == 2) { stage_mlstm_gates(p, bid, nblk); stage_compress(p, smem, bid, nblk); }
    if (S == 3) { stage_mlstm_dc(p, smem, bid, nblk); stage_cmp_select(p, bid, nblk); stage_mlstm_sample(p, smem, bid, nblk); }
    if (S == 4) { stage_mlstm_scan(p, bid, nblk); stage_slc_win(p, smem, bid, nblk); { EpiG e{p}; gemm_phase(p.XB, p.WMT, NT, 2048, 1024, e, smem, bid, nblk); } }
    if (S == 5) stage_mlstm_out(p, smem, bid, nblk);
    if (S == 6) { EpiM1 e{p}; gemm_phase(p.YA, p.WAT, NT, 1024, 1024, e, smem, bid, nblk); }
    if (S == 7) { EpiM2 e{p}; gemm_phase(p.YB, p.WBT, NT, 1024, 1024, e, smem, bid, nblk); }
    if (S == 8) { EpiR e{p}; gemm_phase(p.MERGED, p.WOT, NT, 1024, 1024, e, smem, bid, nblk); }
    if (S == 9) stage_ln1(p, bid, nblk);
    if (S == 10) { EpiPQ e{p}; gemm_phase(p.HB, p.WQT, NT, 2048, 1024, e, smem, bid, nblk); }
    if (S == 11) stage_peer_route(p, smem, bid, nblk);
    if (S == 12) stage_peer_apply(p, bid, nblk);
}
constexpr int NSTAGES = 13;

template <int S>
__global__ void __launch_bounds__(512, 2) k_stage(P p) {
    extern __shared__ __attribute__((aligned(16))) char smem[];
    run_stage<S>(p, smem, blockIdx.x, gridDim.x);
}


#if MK_ONE_LAUNCH
__global__ void __launch_bounds__(512, 2) k_mega(P p) {
    extern __shared__ __attribute__((aligned(16))) char smem_all[];
    if (threadIdx.x == 0) *(u32x4*)smem_all = (u32x4){0u, 0u, 0u, 0u};
    __syncthreads();
    XcdBarrier bar = xcd_barrier_post(p.bar, (volatile LAS unsigned*)smem_all);
    char* smem = smem_all + 16;
    const int bid = blockIdx.x, nblk = gridDim.x;
    run_stage<0>(p, smem, bid, nblk);  xcd_barrier(bar);
    run_stage<1>(p, smem, bid, nblk);  xcd_barrier(bar);
    run_stage<2>(p, smem, bid, nblk);  xcd_barrier(bar);
    run_stage<3>(p, smem, bid, nblk);  xcd_barrier(bar);
    run_stage<4>(p, smem, bid, nblk);  xcd_barrier(bar);
    run_stage<5>(p, smem, bid, nblk);  xcd_barrier(bar);
    run_stage<6>(p, smem, bid, nblk);  xcd_barrier(bar);
    run_stage<7>(p, smem, bid, nblk);  xcd_barrier(bar);
    run_stage<8>(p, smem, bid, nblk);  xcd_barrier(bar);
    run_stage<9>(p, smem, bid, nblk);  xcd_barrier(bar);
    run_stage<10>(p, smem, bid, nblk); xcd_barrier(bar);
    run_stage<11>(p, smem, bid, nblk); xcd_barrier(bar);
    run_stage<12>(p, smem, bid, nblk);
}
#endif

template <int S> static void launch_stage(const P& p, int grid, hipStream_t stream) {
    (void)hipFuncSetAttribute((const void*)k_stage<S>, hipFuncAttributeMaxDynamicSharedMemorySize, LDS_BYTES);
    k_stage<S><<<dim3(grid), dim3(512), LDS_BYTES, stream>>>(p);
}

extern "C" void kernel_launch(void* const* d_in, const int* in_sizes, int n_in, void* d_out, int out_size, void* d_ws, size_t ws_size, hipStream_t stream) {
    (void)in_sizes; (void)n_in; (void)out_size; (void)ws_size;
    P p{};
    p.xp = (const float*)d_in[0]; p.xs = (const float*)d_in[1]; p.cache_cmp = (const float*)d_in[2]; p.cache_slc = (const float*)d_in[3];
    p.cache_win = (const float*)d_in[4]; p.state_C = (const float*)d_in[5]; p.state_n = (const float*)d_in[6]; p.state_m = (const float*)d_in[7];
    p.page_table = (const int*)d_in[8];
    p.w_in = (const float*)d_in[9]; p.b_in = (const float*)d_in[10]; p.norm_a_g = (const float*)d_in[11]; p.nsa_pe = (const float*)d_in[12];
    p.nsa_w_cmp = (const float*)d_in[13]; p.w_br_a = (const float*)d_in[14]; p.w_br_b = (const float*)d_in[15]; p.w_merge = (const float*)d_in[16];
    p.w_out = (const float*)d_in[17]; p.ln1_g = (const float*)d_in[18]; p.ln1_b = (const float*)d_in[19];
    p.peer_wq = (const float*)d_in[20]; p.peer_keys = (const float*)d_in[21]; p.peer_u = (const float*)d_in[22]; p.peer_v = (const float*)d_in[23];
    p.ln2_g = (const float*)d_in[24]; p.ln2_b = (const float*)d_in[25];
    p.out = (float*)d_out;
    char* w = (char*)d_ws; size_t off = 0;
    auto take = [&](size_t bytes) { char* r = w + off; off += (bytes + 255) & ~(size_t)255; return r; };
    p.bar = (unsigned*)take(16384);
    p.XB = (bf16_t*)take((size_t)NT * 1024 * 2);
    p.WINT = (bf16_t*)take((size_t)NPAD_IN * 1024 * 2);
    p.WMT = (bf16_t*)take((size_t)2048 * 1024 * 2);
    p.WAT = (bf16_t*)take((size_t)1024 * 1024 * 2);
    p.WBT = (bf16_t*)take((size_t)1024 * 1024 * 2);
    p.WOT = (bf16_t*)take((size_t)1024 * 1024 * 2);
    p.WQT = (bf16_t*)take((size_t)2048 * 1024 * 2);
    p.KEYSB = (bf16_t*)take((size_t)16 * 128 * 128 * 2);
    p.UB = (bf16_t*)take((size_t)16384 * 1024 * 2);
    p.VB = (bf16_t*)take((size_t)16384 * 1024 * 2);
    p.PROJ = (bf16_t*)take((size_t)NT * PS * 2);
    p.SM = (float*)take((size_t)NT * 64 * 4);
    p.BCUM = (float*)take((size_t)16 * 4096 * 4);
    p.MPREV = (float*)take(4096); p.ACOEF = (float*)take(4096); p.SCL = (float*)take(4096); p.MLOC = (float*)take(4096);
    p.DC = (float*)take((size_t)1024 * 32768 * 4);
    p.DN = (float*)take((size_t)1024 * 128 * 4);
    p.CPREV = (float*)take((size_t)1024 * 32768 * 4);
    p.NPREV = (float*)take((size_t)1024 * 128 * 4);
    p.KC = (float*)take((size_t)4352 * 256 * 4);
    p.VC = (float*)take((size_t)4352 * 256 * 4);
    p.OCMP = (float*)take((size_t)NT * 1024 * 4);
    p.SEL = (unsigned long long*)take((size_t)NT * 4 * 8);
    p.YA = (bf16_t*)take((size_t)NT * 1024 * 2);
    p.YB = (bf16_t*)take((size_t)NT * 1024 * 2);
    p.G = (bf16_t*)take((size_t)NT * 2048 * 2);
    p.TMP = (float*)take((size_t)NT * 1024 * 4);
    p.MERGED = (bf16_t*)take((size_t)NT * 1024 * 2);
    p.R = (float*)take((size_t)NT * 1024 * 4);
    p.H = (float*)take((size_t)NT * 1024 * 4);
    p.HB = (bf16_t*)take((size_t)NT * 1024 * 2);
    p.PQ = (bf16_t*)take((size_t)NT * 2048 * 2);
    p.EIDX = (int*)take((size_t)NT * 128 * 4);
    p.EGATE = (float*)take((size_t)NT * 128 * 4);

#if MK_ONE_LAUNCH
    {
        constexpr size_t kDynLds = LDS_BYTES + 16;
        (void)hipFuncSetAttribute((const void*)k_mega, hipFuncAttributeMaxDynamicSharedMemorySize, (int)kDynLds);
        int dev = 0, cus = 0, per_cu = 0;
        (void)hipGetDevice(&dev);
        (void)hipDeviceGetAttribute(&cus, hipDeviceAttributeMultiprocessorCount, dev);
        (void)hipOccupancyMaxActiveBlocksPerMultiprocessor(&per_cu, (const void*)k_mega, 512, kDynLds);
        if (per_cu < 1 || cus < 1) return;
        const int grid = cus;
        (void)hipMemsetAsync(p.bar, 0, XCD_BAR_WORDS * sizeof(unsigned), stream);
        k_mega<<<dim3(grid), dim3(512), kDynLds, stream>>>(p);
    }
#else
    const int grid = 512;
    launch_stage<0>(p, grid, stream);
    launch_stage<1>(p, grid, stream);
    launch_stage<2>(p, grid, stream);
    launch_stage<3>(p, grid, stream);
    launch_stage<4>(p, grid, stream);
    launch_stage<5>(p, grid, stream);
    launch_stage<6>(p, grid, stream);
    launch_stage<7>(p, grid, stream);
    launch_stage<8>(p, grid, stream);
    launch_stage<9>(p, grid, stream);
    launch_stage<10>(p, grid, stream);
    launch_stage<11>(p, grid, stream);
    launch_stage<12>(p, grid, stream);
#endif
}
```

```cpp
#include <hip/hip_runtime.h>
#include <stdint.h>

#ifndef MK_ONE_LAUNCH
#define MK_ONE_LAUNCH 1
#endif

typedef unsigned short bf16_t;
typedef short bf16x8 __attribute__((ext_vector_type(8)));
typedef float f32x4 __attribute__((ext_vector_type(4)));
typedef unsigned u32x4 __attribute__((ext_vector_type(4)));
typedef unsigned u32x2 __attribute__((ext_vector_type(2)));
#define DEVI __device__ __forceinline__

constexpr int NTP = 16384, NTS = 512, NT = NTP + NTS, DM = 1024;
constexpr int PS = 5632;
constexpr int C_AQ = 0, C_AK = 512, C_AV = 1024, C_AO = 2048, C_BQ = 3072, C_CMP = 4096, C_SLC = 4608, C_WIN = 5120;
constexpr int NPAD_IN = 5888;
constexpr float DN_ALPHA = 1.189207115002721f;
constexpr float LN_EPS = 1e-5f;
constexpr size_t O_Y = 0;
constexpr size_t O_PCMP = O_Y + (size_t)NT * 1024;
constexpr size_t O_PSLC = O_PCMP + (size_t)NTP * 512;
constexpr size_t O_PWIN = O_PSLC + (size_t)NTP * 512;
constexpr size_t O_PC = O_PWIN + (size_t)4 * 512 * 512;
constexpr size_t O_PN = O_PC + (size_t)16 * 128 * 256;
constexpr size_t O_PM = O_PN + 16 * 128;
constexpr size_t O_SCMP = O_PM + 16;
constexpr size_t O_SSLC = O_SCMP + (size_t)NTS * 512;
constexpr size_t O_SWIN = O_SSLC + (size_t)NTS * 512;
constexpr size_t O_SC = O_SWIN + (size_t)128 * 512 * 512;
constexpr size_t O_SN = O_SC + (size_t)512 * 128 * 256;
constexpr size_t O_SM = O_SN + 512 * 128;

struct P {
    const float *xp, *xs, *cache_cmp, *cache_slc, *cache_win, *state_C, *state_n, *state_m;
    const int* page_table;
    const float *w_in, *b_in, *norm_a_g, *nsa_pe, *nsa_w_cmp, *w_br_a, *w_br_b, *w_merge, *w_out, *ln1_g, *ln1_b;
    const float *peer_wq, *peer_keys, *peer_u, *peer_v, *ln2_g, *ln2_b;
    float* out;
    bf16_t *XB, *WINT, *WMT, *WAT, *WBT, *WOT, *WQT, *KEYSB, *UB, *VB, *PROJ;
    float *SM, *BCUM, *MPREV, *ACOEF, *SCL, *MLOC, *DC, *DN, *CPREV, *NPREV, *KC, *VC, *OCMP;
    unsigned long long* SEL;
    bf16_t *YA, *YB, *G, *MERGED, *HB, *PQ;
    float *TMP, *R, *H, *EGATE;
    int* EIDX;
    unsigned* bar;
};

DEVI bf16_t f2bf(float f) { unsigned u = __float_as_uint(f); u += 0x7FFFu + ((u >> 16) & 1u); return (bf16_t)(u >> 16); }
DEVI float bf2f(bf16_t h) { return __uint_as_float(((unsigned)h) << 16); }
DEVI unsigned pack2(float a, float b) { return (unsigned)f2bf(a) | ((unsigned)f2bf(b) << 16); }
DEVI float wave_max(float v) { for (int o = 32; o > 0; o >>= 1) v = fmaxf(v, __shfl_xor(v, o)); return v; }
DEVI float wave_sum(float v) { for (int o = 32; o > 0; o >>= 1) v += __shfl_xor(v, o); return v; }
DEVI float sigmoidf_(float x) { return 1.f / (1.f + __expf(-x)); }
DEVI float logsigmoidf_(float x) { return fminf(x, 0.f) - log1pf(__expf(-fabsf(x))); }
DEVI int win_map(int np) {
    if (np < 2048) return np;
    if (np < 5632) return np + 8;
    if (np < 5640) return np - 5632 + 2048;
    if (np < 5688) return np;
    return -1;
}
DEVI float alibi_slope(int h) { return exp2f(-0.5f * (float)(h + 1)); }

template <class MapFn>
DEVI void transpose_cvt(const float* __restrict__ W, bf16_t* __restrict__ WT, int K, int Nsrc, int Ndst, MapFn mapfn, float* tile  , int bid, int nblk) {
    const int tid = threadIdx.x;
    const int tn = Ndst / 64, tk = K / 64;
    for (int t = bid; t < tn * tk; t += nblk) {
        const int n0 = (t % tn) * 64, k0 = (t / tn) * 64;
        __syncthreads();
#pragma unroll
        for (int i = 0; i < 8; ++i) {
            const int kk = (tid >> 6) + i * 8, nn = tid & 63;
            const int n = mapfn(n0 + nn);
            tile[kk * 65 + nn] = n >= 0 ? W[(size_t)(k0 + kk) * Nsrc + n] : 0.f;
        }
        __syncthreads();
#pragma unroll
        for (int i = 0; i < 8; ++i) {
            const int nn = (tid >> 6) + i * 8, kk = tid & 63;
            WT[(size_t)(n0 + nn) * K + k0 + kk] = f2bf(tile[kk * 65 + nn]);
        }
    }
}
struct IdMap { DEVI int operator()(int n) const { return n; } };
struct WinMap { DEVI int operator()(int n) const { return win_map(n); } };

DEVI void cvt_rows(const float* __restrict__ src, bf16_t* __restrict__ dst, size_t n4, int bid, int nblk) {
    for (size_t i = (size_t)bid * blockDim.x + threadIdx.x; i < n4; i += (size_t)nblk * blockDim.x) {
        const f32x4 v = ((const f32x4*)src)[i];
        u32x2 o; o.x = pack2(v.x, v.y); o.y = pack2(v.z, v.w);
        ((u32x2*)dst)[i] = o;
    }
}

DEVI void stage_prologue(const P& p, char* smem, int bid, int nblk) {
    float* tile = (float*)smem;
    cvt_rows(p.xp, p.XB, (size_t)NTP * 256, bid, nblk);
    cvt_rows(p.xs, p.XB + (size_t)NTP * 1024, (size_t)NTS * 256, bid, nblk);
    cvt_rows(p.peer_u, p.UB, (size_t)16384 * 256, bid, nblk);
    cvt_rows(p.peer_v, p.VB, (size_t)16384 * 256, bid, nblk);
    cvt_rows(p.peer_keys, p.KEYSB, (size_t)16 * 128 * 128 / 4, bid, nblk);
    transpose_cvt(p.w_in, p.WINT, 1024, 5688, NPAD_IN, WinMap(), tile, bid, nblk);
    transpose_cvt(p.w_merge, p.WMT, 1024, 2048, 2048, IdMap(), tile, bid, nblk);
    transpose_cvt(p.w_br_a, p.WAT, 1024, 1024, 1024, IdMap(), tile, bid, nblk);
    transpose_cvt(p.w_br_b, p.WBT, 1024, 1024, 1024, IdMap(), tile, bid, nblk);
    transpose_cvt(p.w_out, p.WOT, 1024, 1024, 1024, IdMap(), tile, bid, nblk);
    transpose_cvt(p.peer_wq, p.WQT, 1024, 2048, 2048, IdMap(), tile, bid, nblk);
    {
        const size_t per_b = (size_t)508 * 512 / 4;
        for (size_t i = (size_t)bid * blockDim.x + threadIdx.x; i < 128 * per_b; i += (size_t)nblk * blockDim.x) {
            const size_t b = i / per_b, r = i % per_b;
            ((f32x4*)(p.out + O_SWIN + b * 512 * 512))[r] = ((const f32x4*)(p.cache_win + b * 512 * 512 + 4 * 512))[r];
        }
    }
}

template <class Epi>
DEVI void gemm_phase(const bf16_t* __restrict__ A, const bf16_t* __restrict__ Bt, int M, int N, int K, const Epi& epi, char* smem, int bid, int nblk) {
    bf16_t* As = (bf16_t*)smem;
    bf16_t* Bs = As + 256 * 72;
    const int tid = threadIdx.x, lane = tid & 63, wid = tid >> 6, wm = wid >> 1, wn = wid & 1;
    const int fr = lane & 15, fq = lane >> 4;
    const int ntm = M / 256, ntn = N / 128, nk = K / 64;
    for (int tile = bid; tile < ntm * ntn; tile += nblk) {
        const int tm = tile / ntn, tn = tile % ntn;
        f32x4 acc[4][4];
#pragma unroll
        for (int i = 0; i < 4; ++i)
#pragma unroll
            for (int j = 0; j < 4; ++j) acc[i][j] = (f32x4){0.f, 0.f, 0.f, 0.f};
        const bf16_t* Ag = A + (size_t)(tm * 256 + (tid >> 1)) * K + (tid & 1) * 32;
        const bf16_t* Bg = Bt + (size_t)(tn * 128 + (tid >> 2)) * K + (tid & 3) * 16;
        u32x4 ra[4], rb[2];
#pragma unroll
        for (int i = 0; i < 4; ++i) ra[i] = *(const u32x4*)(Ag + i * 8);
#pragma unroll
        for (int i = 0; i < 2; ++i) rb[i] = *(const u32x4*)(Bg + i * 8);
        for (int kt = 0; kt < nk; ++kt) {
            __syncthreads();
#pragma unroll
            for (int i = 0; i < 4; ++i) *(u32x4*)(As + (tid >> 1) * 72 + (tid & 1) * 32 + i * 8) = ra[i];
#pragma unroll
            for (int i = 0; i < 2; ++i) *(u32x4*)(Bs + (tid >> 2) * 72 + (tid & 3) * 16 + i * 8) = rb[i];
            __syncthreads();
            if (kt + 1 < nk) {
#pragma unroll
                for (int i = 0; i < 4; ++i) ra[i] = *(const u32x4*)(Ag + (kt + 1) * 64 + i * 8);
#pragma unroll
                for (int i = 0; i < 2; ++i) rb[i] = *(const u32x4*)(Bg + (kt + 1) * 64 + i * 8);
            }
#pragma unroll
            for (int ks = 0; ks < 2; ++ks) {
                bf16x8 af[4], bfr[4];
#pragma unroll
                for (int i = 0; i < 4; ++i) af[i] = *(const bf16x8*)(As + (wm * 64 + i * 16 + fr) * 72 + ks * 32 + fq * 8);
#pragma unroll
                for (int j = 0; j < 4; ++j) bfr[j] = *(const bf16x8*)(Bs + (wn * 64 + j * 16 + fr) * 72 + ks * 32 + fq * 8);
#pragma unroll
                for (int i = 0; i < 4; ++i)
#pragma unroll
                    for (int j = 0; j < 4; ++j) acc[i][j] = __builtin_amdgcn_mfma_f32_16x16x32_bf16(bfr[j], af[i], acc[i][j], 0, 0, 0);
            }
        }
#pragma unroll
        for (int i = 0; i < 4; ++i)
#pragma unroll
            for (int j = 0; j < 4; ++j) epi(tm * 256 + wm * 64 + i * 16 + fr, tn * 128 + wn * 64 + j * 16 + fq * 4, acc[i][j]);
    }
}

struct EpiInProj {
    P p;
    DEVI void operator()(int row, int col, f32x4 v) const {
        if (col >= 5688) return;
        const int oc = win_map(col);
#pragma unroll
        for (int q = 0; q < 4; ++q) v[q] += p.b_in[oc + q];
        if (col >= 5632) { *(f32x4*)(p.SM + (size_t)row * 64 + (col - 5632)) = v; return; }
        if (col >= C_AK && col < C_AV) v *= 0.08838834764831845f;
        u32x2 o; o.x = pack2(v[0], v[1]); o.y = pack2(v[2], v[3]);
        *(u32x2*)(p.PROJ + (size_t)row * PS + col) = o;
        if (col >= C_CMP) {
            const int reg = (col - C_CMP) >> 9, c = (col - C_CMP) & 511;
            float* dst = nullptr;
            if (row < NTP) {
                if (reg == 0) dst = p.out + O_PCMP + (size_t)row * 512 + c;
                else if (reg == 1) dst = p.out + O_PSLC + (size_t)row * 512 + c;
                else { const int b = row >> 12, t = row & 4095; if (t >= 3584) dst = p.out + O_PWIN + ((size_t)b * 512 + (t - 3584)) * 512 + c; }
            } else {
                const int rs = row - NTP;
                if (reg == 0) dst = p.out + O_SCMP + (size_t)rs * 512 + c;
                else if (reg == 1) dst = p.out + O_SSLC + (size_t)rs * 512 + c;
                else { const int b = rs >> 2, tq = rs & 3; dst = p.out + O_SWIN + ((size_t)b * 512 + 508 + tq) * 512 + c; }
            }
            if (dst) *(f32x4*)dst = v;
        }
    }
};
struct EpiG {
    P p;
    DEVI void operator()(int row, int col, f32x4 v) const {
        u32x2 o; o.x = pack2(sigmoidf_(v[0]), sigmoidf_(v[1])); o.y = pack2(sigmoidf_(v[2]), sigmoidf_(v[3]));
        *(u32x2*)(p.G + (size_t)row * 2048 + col) = o;
    }
};
struct EpiM1 {
    P p;
    DEVI void operator()(int row, int col, f32x4 v) const {
        const u32x2 g = *(const u32x2*)(p.G + (size_t)row * 2048 + col);
        v[0] *= __uint_as_float(g.x << 16); v[1] *= __uint_as_float(g.x & 0xFFFF0000u);
        v[2] *= __uint_as_float(g.y << 16); v[3] *= __uint_as_float(g.y & 0xFFFF0000u);
        *(f32x4*)(p.TMP + (size_t)row * 1024 + col) = v;
    }
};
struct EpiM2 {
    P p;
    DEVI void operator()(int row, int col, f32x4 v) const {
        const u32x2 g = *(const u32x2*)(p.G + (size_t)row * 2048 + 1024 + col);
        const f32x4 t = *(const f32x4*)(p.TMP + (size_t)row * 1024 + col);
        v[0] = t[0] + v[0] * __uint_as_float(g.x << 16); v[1] = t[1] + v[1] * __uint_as_float(g.x & 0xFFFF0000u);
        v[2] = t[2] + v[2] * __uint_as_float(g.y << 16); v[3] = t[3] + v[3] * __uint_as_float(g.y & 0xFFFF0000u);
        u32x2 o; o.x = pack2(v[0], v[1]); o.y = pack2(v[2], v[3]);
        *(u32x2*)(p.MERGED + (size_t)row * 1024 + col) = o;
    }
};
struct EpiR {
    P p;
    DEVI void operator()(int row, int col, f32x4 v) const {
        const float* xr = row < NTP ? p.xp + (size_t)row * 1024 : p.xs + (size_t)(row - NTP) * 1024;
        const f32x4 x = *(const f32x4*)(xr + col);
        *(f32x4*)(p.R + (size_t)row * 1024 + col) = x * DN_ALPHA + v;
    }
};
struct EpiPQ {
    P p;
    DEVI void operator()(int row, int col, f32x4 v) const {
        u32x2 o; o.x = pack2(v[0], v[1]); o.y = pack2(v[2], v[3]);
        *(u32x2*)(p.PQ + (size_t)row * 2048 + col) = o;
    }
};

DEVI void stage_mlstm_gates(const P& p, int bid, int nblk) {
    const int lane = threadIdx.x & 63, wid = threadIdx.x >> 6;
    for (int bh = bid * 8 + wid; bh < 16; bh += nblk * 8) {
        const int b = bh >> 2, h = bh & 3;
        float m = 0.f;
        for (int c = 0; c < 64; ++c) {
            const size_t row = (size_t)b * 4096 + c * 64 + lane;
            const float ip = p.SM[row * 64 + h];
            const float lf = logsigmoidf_(p.SM[row * 64 + 4 + h]);
            float cs = lf;
#pragma unroll
            for (int o = 1; o < 64; o <<= 1) { const float t = __shfl_up(cs, o); if (lane >= o) cs += t; }
            p.BCUM[bh * 4096 + c * 64 + lane] = cs;
            const float bend = __shfl(cs, 63);
            const float g = bend - cs + ip;
            const float mloc = wave_max(g);
            const float mnew = fmaxf(bend + m, mloc);
            if (lane == 0) {
                p.MPREV[bh * 64 + c] = m;
                p.ACOEF[bh * 64 + c] = __expf(bend + m - mnew);
                p.SCL[bh * 64 + c] = __expf(mloc - mnew);
                p.MLOC[bh * 64 + c] = mloc;
            }
            m = mnew;
        }
        if (lane == 0) p.out[O_PM + bh] = m;
    }
}

DEVI void stage_mlstm_dc(const P& p, char* smem, int bid, int nblk) {
    float* ks = (float*)smem;
    float* ws = ks + 64 * 128;
    const int tid = threadIdx.x;
    for (int task = bid; task < 1024; task += nblk) {
        const int bh = task >> 6, c = task & 63, b = bh >> 2, h = bh & 3;
        const size_t row0 = (size_t)b * 4096 + c * 64;
        __syncthreads();
        if (tid < 64) {
            const float bend = p.BCUM[bh * 4096 + c * 64 + 63];
            const float g = bend - p.BCUM[bh * 4096 + c * 64 + tid] + p.SM[(row0 + tid) * 64 + h];
            ws[tid] = __expf(g - p.MLOC[task]);
        }
        __syncthreads();
        for (int idx = tid; idx < 64 * 128; idx += 512) {
            const int s = idx >> 7, d = idx & 127;
            ks[idx] = ws[s] * bf2f(p.PROJ[(row0 + s) * PS + C_AK + h * 128 + d]);
        }
        __syncthreads();
        const int v = tid & 255, dg = tid >> 8;
        float acc[64];
#pragma unroll
        for (int i = 0; i < 64; ++i) acc[i] = 0.f;
        for (int s = 0; s < 64; ++s) {
            const float vv = bf2f(p.PROJ[(row0 + s) * PS + C_AV + h * 256 + v]);
#pragma unroll
            for (int i = 0; i < 64; ++i) acc[i] += ks[s * 128 + dg * 64 + i] * vv;
        }
#pragma unroll
        for (int i = 0; i < 64; ++i) p.DC[((size_t)task * 128 + dg * 64 + i) * 256 + v] = acc[i];
        if (tid < 128) {
            float a = 0.f;
            for (int s = 0; s < 64; ++s) a += ks[s * 128 + tid];
            p.DN[task * 128 + tid] = a;
        }
    }
}

DEVI void stage_mlstm_scan(const P& p, int bid, int nblk) {
    for (int e = bid * blockDim.x + threadIdx.x; e < 16 * 32768 + 16 * 128; e += nblk * blockDim.x) {
        if (e < 16 * 32768) {
            const int bh = e >> 15, dv = e & 32767;
            float C = 0.f;
            for (int c = 0; c < 64; ++c) {
                const size_t idx = ((size_t)(bh * 64 + c)) * 32768 + dv;
                p.CPREV[idx] = C;
                C = p.ACOEF[bh * 64 + c] * C + p.SCL[bh * 64 + c] * p.DC[idx];
            }
            p.out[O_PC + e] = C;
        } else {
            const int e2 = e - 16 * 32768, bh = e2 >> 7, d = e2 & 127;
            float n = 0.f;
            for (int c = 0; c < 64; ++c) {
                const size_t idx = (size_t)(bh * 64 + c) * 128 + d;
                p.NPREV[idx] = n;
                n = p.ACOEF[bh * 64 + c] * n + p.SCL[bh * 64 + c] * p.DN[idx];
            }
            p.out[O_PN + e2] = n;
        }
    }
}

constexpr int MLO_LDS = (64 * 128 + 64 * 129 + 64 * 64 + 6 * 64 + 64 * 256) * 4;
DEVI void stage_mlstm_out(const P& p, char* smem, int bid, int nblk) {
    float* qs = (float*)smem;
    float* ks = qs + 64 * 128;
    float* Ps = ks + 64 * 129;
    float* bcum = Ps + 64 * 64;
    float* ipre = bcum + 64; float* mt = ipre + 64; float* wint = mt + 64; float* den = wint + 64; float* emt = den + 64;
    float* hs = emt + 64;
    const int tid = threadIdx.x, lane = tid & 63, wid = tid >> 6;
    for (int task = bid; task < 1024; task += nblk) {
        const int bh = task >> 6, c = task & 63, b = bh >> 2, h = bh & 3;
        const size_t row0 = (size_t)b * 4096 + c * 64;
        __syncthreads();
        for (int idx = tid; idx < 64 * 128; idx += 512) {
            const int t = idx >> 7, d = idx & 127;
            qs[idx] = bf2f(p.PROJ[(row0 + t) * PS + C_AQ + h * 128 + d]);
            ks[t * 129 + d] = bf2f(p.PROJ[(row0 + t) * PS + C_AK + h * 128 + d]);
        }
        if (tid < 64) { bcum[tid] = p.BCUM[bh * 4096 + c * 64 + tid]; ipre[tid] = p.SM[(row0 + tid) * 64 + h]; }
        const float mprev = p.MPREV[task];
        __syncthreads();
        for (int idx = tid; idx < 4096; idx += 512) {
            const int t = idx >> 6, s = idx & 63;
            float a = 0.f;
            if (s <= t) for (int d = 0; d < 128; ++d) a += qs[t * 128 + d] * ks[s * 129 + d];
            Ps[idx] = a;
        }
        if (tid < 64) {
            const int t = tid;
            float mx = bcum[t] + mprev;
            for (int s = 0; s <= t; ++s) mx = fmaxf(mx, bcum[t] - bcum[s] + ipre[s]);
            mt[t] = mx; wint[t] = __expf(bcum[t] + mprev - mx); emt[t] = __expf(-mx);
        }
        __syncthreads();
        for (int idx = tid; idx < 4096; idx += 512) {
            const int t = idx >> 6, s = idx & 63;
            if (s <= t) Ps[idx] *= __expf(bcum[t] - bcum[s] + ipre[s] - mt[t]);
        }
        __syncthreads();
        if (tid < 64) {
            const int t = tid;
            float ds = 0.f, qn = 0.f;
            for (int s = 0; s < 64; ++s) ds += Ps[t * 64 + s];
            for (int d = 0; d < 128; ++d) qn += qs[t * 128 + d] * p.NPREV[(size_t)task * 128 + d];
            den[t] = wint[t] * qn + ds;
        }
        __syncthreads();
        const int v = tid & 255, th = tid >> 8;
#pragma unroll 1
        for (int pass = 0; pass < 2; ++pass) {
            const int tb = th * 32 + pass * 16;
            float acc[16];
#pragma unroll
            for (int i = 0; i < 16; ++i) acc[i] = 0.f;
#pragma unroll 2
            for (int d = 0; d < 128; ++d) {
                const float cv = p.CPREV[((size_t)task * 128 + d) * 256 + v];
#pragma unroll
                for (int i = 0; i < 16; ++i) acc[i] += qs[(tb + i) * 128 + d] * cv;
            }
#pragma unroll
            for (int i = 0; i < 16; ++i) acc[i] *= wint[tb + i];
#pragma unroll 2
            for (int s = 0; s < 64; ++s) {
                const float vv = bf2f(p.PROJ[(row0 + s) * PS + C_AV + h * 256 + v]);
#pragma unroll
                for (int i = 0; i < 16; ++i) acc[i] += Ps[(tb + i) * 64 + s] * vv;
            }
#pragma unroll
            for (int i = 0; i < 16; ++i) { const int t = tb + i; hs[t * 256 + v] = acc[i] / fmaxf(fabsf(den[t]), emt[t]); }
        }
        __syncthreads();
        for (int rr = 0; rr < 8; ++rr) {
            const int t = wid * 8 + rr;
            const f32x4 x = *(const f32x4*)(hs + t * 256 + lane * 4);
            const float mean = wave_sum(x[0] + x[1] + x[2] + x[3]) * (1.f / 256.f);
            float q = 0.f;
#pragma unroll
            for (int k = 0; k < 4; ++k) q += (x[k] - mean) * (x[k] - mean);
            const float rs = rsqrtf(wave_sum(q) * (1.f / 256.f) + LN_EPS);
            float y[4];
#pragma unroll
            for (int k = 0; k < 4; ++k) {
                const int vi = lane * 4 + k;
                const float o = bf2f(p.PROJ[(row0 + t) * PS + C_AO + h * 256 + vi]);
                y[k] = (x[k] - mean) * rs * p.norm_a_g[h * 256 + vi] * sigmoidf_(o);
            }
            u32x2 o2; o2.x = pack2(y[0], y[1]); o2.y = pack2(y[2], y[3]);
            *(u32x2*)(p.YA + (row0 + t) * 1024 + h * 256 + lane * 4) = o2;
        }
    }
}

DEVI void stage_mlstm_sample(const P& p, char* smem, int bid, int nblk) {
    float* qs = (float*)smem;
    float* ks = qs + 512;
    float* vs = ks + 512;
    float* part = vs + 1024;
    float* hs = part + 2048;
    float* sc = hs + 1024;
    float* bc = sc; float* ip = sc + 4; float* mt = sc + 8; float* wint = sc + 12; float* emt = sc + 16; float* ww = sc + 20; float* den = sc + 24;
    float* Pm = sc + 32;
    float* misc = sc + 48;
    const int tid = threadIdx.x, lane = tid & 63, wid = tid >> 6;
    for (int task = bid; task < 512; task += nblk) {
        const int b = task >> 2, h = task & 3;
        const size_t row0 = (size_t)NTP + b * 4;
        __syncthreads();
        { const int t = tid >> 7, d = tid & 127;
          qs[tid] = bf2f(p.PROJ[(row0 + t) * PS + C_AQ + h * 128 + d]);
          ks[tid] = bf2f(p.PROJ[(row0 + t) * PS + C_AK + h * 128 + d]); }
        for (int idx = tid; idx < 1024; idx += 512) { const int t = idx >> 8, v = idx & 255; vs[idx] = bf2f(p.PROJ[(row0 + t) * PS + C_AV + h * 256 + v]); }
        if (tid == 0) {
            const float m0 = p.state_m[task];
            float cs = 0.f;
            for (int t = 0; t < 4; ++t) { cs += logsigmoidf_(p.SM[(row0 + t) * 64 + 4 + h]); bc[t] = cs; ip[t] = p.SM[(row0 + t) * 64 + h]; }
            for (int t = 0; t < 4; ++t) {
                float mx = bc[t] + m0;
                for (int s = 0; s <= t; ++s) mx = fmaxf(mx, bc[t] - bc[s] + ip[s]);
                mt[t] = mx; wint[t] = __expf(bc[t] + m0 - mx); emt[t] = __expf(-mx);
            }
            const float bend = bc[3];
            float mnew = bend + m0;
            for (int s = 0; s < 4; ++s) mnew = fmaxf(mnew, bend - bc[s] + ip[s]);
            misc[0] = __expf(bend + m0 - mnew);
            for (int s = 0; s < 4; ++s) ww[s] = __expf(bend - bc[s] + ip[s] - mnew);
            p.out[O_SM + task] = mnew;
        }
        __syncthreads();
        if (tid < 16) {
            const int t = tid >> 2, s = tid & 3;
            float a = 0.f;
            if (s <= t) { for (int d = 0; d < 128; ++d) a += qs[t * 128 + d] * ks[s * 128 + d]; a *= __expf(bc[t] - bc[s] + ip[s] - mt[t]); }
            Pm[tid] = a;
        }
        __syncthreads();
        if (tid < 4) {
            const int t = tid; float qn = 0.f;
            for (int d = 0; d < 128; ++d) qn += qs[t * 128 + d] * p.state_n[(size_t)task * 128 + d];
            den[t] = wint[t] * qn + Pm[t * 4] + Pm[t * 4 + 1] + Pm[t * 4 + 2] + Pm[t * 4 + 3];
        }
        const float a = misc[0];
        if (tid >= 128 && tid < 256) {
            const int d = tid - 128;
            float n = a * p.state_n[(size_t)task * 128 + d];
            for (int s = 0; s < 4; ++s) n += ww[s] * ks[s * 128 + d];
            p.out[O_SN + (size_t)task * 128 + d] = n;
        }
        {
            const int v = tid & 255, dh = tid >> 8;
            float acc[4] = {0.f, 0.f, 0.f, 0.f};
            float wv[4];
#pragma unroll
            for (int s = 0; s < 4; ++s) wv[s] = ww[s] * vs[s * 256 + v];
            for (int d = dh * 64; d < dh * 64 + 64; ++d) {
                const size_t ci = ((size_t)task * 128 + d) * 256 + v;
                const float c0 = p.state_C[ci];
#pragma unroll
                for (int t = 0; t < 4; ++t) acc[t] += qs[t * 128 + d] * c0;
                float cn = a * c0;
#pragma unroll
                for (int s = 0; s < 4; ++s) cn += ks[s * 128 + d] * wv[s];
                p.out[O_SC + ci] = cn;
            }
#pragma unroll
            for (int t = 0; t < 4; ++t) part[(dh * 4 + t) * 256 + v] = acc[t];
        }
        __syncthreads();
        if (tid < 256) {
            const int v = tid;
#pragma unroll
            for (int t = 0; t < 4; ++t) {
                float num = wint[t] * (part[t * 256 + v] + part[(4 + t) * 256 + v]);
#pragma unroll
                for (int s = 0; s < 4; ++s) num += Pm[t * 4 + s] * vs[s * 256 + v];
                hs[t * 256 + v] = num / fmaxf(fabsf(den[t]), emt[t]);
            }
        }
        __syncthreads();
        if (wid < 4) {
            const int t = wid;
            const f32x4 x = *(const f32x4*)(hs + t * 256 + lane * 4);
            const float mean = wave_sum(x[0] + x[1] + x[2] + x[3]) * (1.f / 256.f);
            float q = 0.f;
#pragma unroll
            for (int k = 0; k < 4; ++k) q += (x[k] - mean) * (x[k] - mean);
            const float rs = rsqrtf(wave_sum(q) * (1.f / 256.f) + LN_EPS);
            float y[4];
#pragma unroll
            for (int k = 0; k < 4; ++k) {
                const int vi = lane * 4 + k;
                const float o = bf2f(p.PROJ[(row0 + t) * PS + C_AO + h * 256 + vi]);
                y[k] = (x[k] - mean) * rs * p.norm_a_g[h * 256 + vi] * sigmoidf_(o);
            }
            u32x2 o2; o2.x = pack2(y[0], y[1]); o2.y = pack2(y[2], y[3]);
            *(u32x2*)(p.YA + (row0 + t) * 1024 + h * 256 + lane * 4) = o2;
        }
    }
}

DEVI void stage_compress(const P& p, char* smem, int bid, int nblk) {
    float* tile = (float*)smem;
    const int tid = threadIdx.x;
    const int kv = tid >> 8, g = (tid >> 6) & 3, e = tid & 63;
    for (int task = bid; task < 256 + 4096; task += nblk) {
        const bool prompt = task < 256;
        int b, n; size_t src_row0;
        if (prompt) { b = task >> 6; n = task & 63; src_row0 = (size_t)b * 4096 + n * 64; }
        else { const int ts = task - 256; b = ts >> 5; n = ts & 31; const int page = p.page_table[b * 16 + (n >> 1)]; src_row0 = (size_t)page * 128 + (n & 1) * 64; }
        float acc = 0.f;
        for (int l0 = 0; l0 < 64; l0 += 16) {
            __syncthreads();
#pragma unroll
            for (int i = 0; i < 16; ++i) {
                const int idx = tid + i * 512, l = idx >> 9, c = idx & 511;
                float val = prompt ? bf2f(p.PROJ[(src_row0 + l0 + l) * PS + C_CMP + c]) : p.cache_cmp[(src_row0 + l0 + l) * 512 + c];
                val += p.nsa_pe[((c >> 8) * 64 + l0 + l) * 64 + (c & 63)];
                tile[idx] = val;
            }
            __syncthreads();
            for (int l = 0; l < 16; ++l) {
                const float* wr = p.nsa_w_cmp + ((size_t)(kv * 64 + l0 + l) * 64) * 64 + e;
                const float* tr = tile + l * 512 + kv * 256 + g * 64;
#pragma unroll 8
                for (int d = 0; d < 64; ++d) acc += tr[d] * wr[d * 64];
            }
        }
        (kv == 0 ? p.KC : p.VC)[(size_t)task * 512 + g * 64 + e] = acc;
    }
}

DEVI void stage_cmp_select(const P& p, int bid, int nblk) {
    const int lane = threadIdx.x & 63, wid = threadIdx.x >> 6;
    for (int wt = bid * 8 + wid; wt < NT * 4; wt += nblk * 8) {
        const int row = wt >> 2, g = wt & 3;
        int pos, nb, nvalid, cur; const float *kcb, *vcb;
        if (row < NTP) { const int b = row >> 12, t = row & 4095; pos = t; nb = 64; nvalid = (t + 1) >> 6; cur = t >> 6; kcb = p.KC + (size_t)(b * 64) * 256; vcb = p.VC + (size_t)(b * 64) * 256; }
        else { const int rs = row - NTP, b = rs >> 2, tq = rs & 3; pos = 2048 + tq; nb = 33; nvalid = 32; cur = 32; kcb = p.KC + (size_t)(256 + b * 32) * 256; vcb = p.VC + (size_t)(256 + b * 32) * 256; }
        const int j = lane;
        float pr[4] = {0.f, 0.f, 0.f, 0.f};
        float imp = 0.f;
        if (nvalid > 0) {
            float dot[4] = {0.f, 0.f, 0.f, 0.f};
            if (j < nvalid) {
                const float* kr = kcb + (size_t)j * 256 + g * 64;
                const bf16_t* qr = p.PROJ + (size_t)row * PS + C_BQ + g * 256;
                for (int d = 0; d < 64; ++d) {
                    const float kk = kr[d];
#pragma unroll
                    for (int r = 0; r < 4; ++r) dot[r] += bf2f(qr[r * 64 + d]) * kk;
                }
            }
#pragma unroll
            for (int r = 0; r < 4; ++r) {
                const float s = j < nvalid ? dot[r] * 0.125f - alibi_slope(g * 4 + r) * (float)(pos - (j * 64 + 63)) : -INFINITY;
                const float mx = wave_max(s);
                const float e = j < nvalid ? __expf(s - mx) : 0.f;
                const float sum = wave_sum(e);
                pr[r] = e / sum;
                imp += pr[r];
            }
            float o[4] = {0.f, 0.f, 0.f, 0.f};
            for (int jj = 0; jj < nvalid; ++jj) {
                const float vv = vcb[(size_t)jj * 256 + g * 64 + lane];
#pragma unroll
                for (int r = 0; r < 4; ++r) o[r] += __shfl(pr[r], jj) * vv;
            }
#pragma unroll
            for (int r = 0; r < 4; ++r) p.OCMP[(size_t)row * 1024 + (g * 4 + r) * 64 + lane] = o[r];
        } else {
#pragma unroll
            for (int r = 0; r < 4; ++r) p.OCMP[(size_t)row * 1024 + (g * 4 + r) * 64 + lane] = 0.f;
        }
        if (j == cur || j == 0) imp = 5.0f;
        if (j > cur) imp = -1.0f;
        if (j >= nb) imp = -2.0f;
        int rank = 0;
        for (int jj = 0; jj < 64; ++jj) { const float v = __shfl(imp, jj); rank += (v > imp || (v == imp && jj < j)) ? 1 : 0; }
        const unsigned long long mask = __ballot(rank < 16 && j < nb);
        if (lane == 0) p.SEL[(size_t)row * 4 + g] = mask;
    }
}

struct KBlock { const void* kb; const void* vb; int stride; int f32; int count; int pos0; };

template <bool WIN>
DEVI void attend_block(const KBlock& B, int qpos, const float* qs, const float (&slope)[4], float (&m)[4], float (&l)[4], float (&o)[4], int lane) {
    const int pos = B.pos0 + lane;
    const bool valid = lane < B.count && pos <= qpos && (!WIN || pos > qpos - 512);
    if (!__any(valid)) return;
    float dot[4] = {0.f, 0.f, 0.f, 0.f};
    if (valid) {
        if (B.f32) {
            const float* kr = (const float*)B.kb + (size_t)lane * B.stride;
#pragma unroll 4
            for (int d4 = 0; d4 < 16; ++d4) {
                const f32x4 kk = *(const f32x4*)(kr + d4 * 4);
#pragma unroll
                for (int e = 0; e < 4; ++e) { const f32x4 qq = *(const f32x4*)(qs + (d4 * 4 + e) * 4);
#pragma unroll
                    for (int r = 0; r < 4; ++r) dot[r] += kk[e] * qq[r]; }
            }
        } else {
            const bf16_t* kr = (const bf16_t*)B.kb + (size_t)lane * B.stride;
#pragma unroll 2
            for (int d8 = 0; d8 < 8; ++d8) {
                const u32x4 kk = *(const u32x4*)(kr + d8 * 8);
                const unsigned w[4] = {kk.x, kk.y, kk.z, kk.w};
#pragma unroll
                for (int e = 0; e < 4; ++e) {
                    const float k0 = __uint_as_float(w[e] << 16), k1 = __uint_as_float(w[e] & 0xFFFF0000u);
                    const f32x4 q0 = *(const f32x4*)(qs + (d8 * 8 + e * 2) * 4), q1 = *(const f32x4*)(qs + (d8 * 8 + e * 2 + 1) * 4);
#pragma unroll
                    for (int r = 0; r < 4; ++r) dot[r] += k0 * q0[r] + k1 * q1[r];
                }
            }
        }
    }
    float pr[4];
#pragma unroll
    for (int r = 0; r < 4; ++r) {
        const float s = valid ? dot[r] * 0.125f - slope[r] * (float)(qpos - pos) : -INFINITY;
        const float mn = fmaxf(m[r], wave_max(s));
        const float sc = __expf(m[r] - mn);
        pr[r] = valid ? __expf(s - mn) : 0.f;
        l[r] = l[r] * sc + wave_sum(pr[r]);
        o[r] *= sc; m[r] = mn;
    }
    for (int kk = 0; kk < B.count; ++kk) {
        const float vv = B.f32 ? ((const float*)B.vb)[(size_t)kk * B.stride + lane] : bf2f(((const bf16_t*)B.vb)[(size_t)kk * B.stride + lane]);
#pragma unroll
        for (int r = 0; r < 4; ++r) o[r] += __shfl(pr[r], kk) * vv;
    }
}

DEVI void stage_slc_win(const P& p, char* smem, int bid, int nblk) {
    const int lane = threadIdx.x & 63, wid = threadIdx.x >> 6;
    float* qs = (float*)smem + wid * 256;
    for (int wt = bid * 8 + wid; wt < NT * 4; wt += nblk * 8) {
        const int row = wt >> 2, g = wt & 3;
        const bool prompt = row < NTP;
        int b, t, qpos;
        if (prompt) { b = row >> 12; t = row & 4095; qpos = t; } else { const int rs = row - NTP; b = rs >> 2; t = rs & 3; qpos = 2048 + t; }
        {
            const bf16_t* qr = p.PROJ + (size_t)row * PS + C_BQ + g * 256;
            f32x4 qv;
#pragma unroll
            for (int r = 0; r < 4; ++r) qv[r] = bf2f(qr[r * 64 + lane]);
            *(f32x4*)(qs + lane * 4) = qv;
            asm volatile("s_waitcnt lgkmcnt(0)" ::: "memory");
        }
        float slope[4];
#pragma unroll
        for (int r = 0; r < 4; ++r) slope[r] = alibi_slope(g * 4 + r);
        float res[2][4];
        {
            float m[4], l[4], o[4];
#pragma unroll
            for (int r = 0; r < 4; ++r) { m[r] = -INFINITY; l[r] = 0.f; o[r] = 0.f; }
            unsigned long long mask = p.SEL[(size_t)row * 4 + g];
            while (mask) {
                const int j = __builtin_ctzll(mask); mask &= mask - 1;
                KBlock B;
                if (prompt) {
                    const bf16_t* base = p.PROJ + ((size_t)b * 4096 + j * 64) * PS + C_SLC + g * 64;
                    B.kb = base; B.vb = base + 256; B.stride = PS; B.f32 = 0; B.count = 64; B.pos0 = j * 64;
                } else if (j < 32) {
                    const int page = p.page_table[b * 16 + (j >> 1)];
                    const float* base = p.cache_slc + ((size_t)page * 128 + (j & 1) * 64) * 512 + g * 64;
                    B.kb = base; B.vb = base + 256; B.stride = 512; B.f32 = 1; B.count = 64; B.pos0 = j * 64;
                } else {
                    const bf16_t* base = p.PROJ + ((size_t)NTP + b * 4) * PS + C_SLC + g * 64;
                    B.kb = base; B.vb = base + 256; B.stride = PS; B.f32 = 0; B.count = 4; B.pos0 = 2048;
                }
                attend_block<false>(B, qpos, qs, slope, m, l, o, lane);
            }
#pragma unroll
            for (int r = 0; r < 4; ++r) res[0][r] = o[r] / l[r];
        }
        {
            float m[4], l[4], o[4];
#pragma unroll
            for (int r = 0; r < 4; ++r) { m[r] = -INFINITY; l[r] = 0.f; o[r] = 0.f; }
            if (prompt) {
                const int lo = (t - 511 > 0 ? t - 511 : 0) >> 6, hi = t >> 6;
                for (int j = lo; j <= hi; ++j) {
                    KBlock B; const bf16_t* base = p.PROJ + ((size_t)b * 4096 + j * 64) * PS + C_WIN + g * 64;
                    B.kb = base; B.vb = base + 256; B.stride = PS; B.f32 = 0; B.count = 64; B.pos0 = j * 64;
                    attend_block<true>(B, qpos, qs, slope, m, l, o, lane);
                }
            } else {
                for (int j = 0; j < 8; ++j) {
                    KBlock B; const float* base = p.cache_win + ((size_t)b * 512 + j * 64) * 512 + g * 64;
                    B.kb = base; B.vb = base + 256; B.stride = 512; B.f32 = 1; B.count = 64; B.pos0 = 1536 + j * 64;
                    attend_block<true>(B, qpos, qs, slope, m, l, o, lane);
                }
                KBlock B; const bf16_t* base = p.PROJ + ((size_t)NTP + b * 4) * PS + C_WIN + g * 64;
                B.kb = base; B.vb = base + 256; B.stride = PS; B.f32 = 0; B.count = 4; B.pos0 = 2048;
                attend_block<true>(B, qpos, qs, slope, m, l, o, lane);
            }
#pragma unroll
            for (int r = 0; r < 4; ++r) res[1][r] = o[r] / l[r];
        }
        const float* gt = p.SM + (size_t)row * 64 + 8;
#pragma unroll
        for (int r = 0; r < 4; ++r) {
            const float g0 = sigmoidf_(gt[g * 4 + r]), g1 = sigmoidf_(gt[16 + g * 4 + r]), g2 = sigmoidf_(gt[32 + g * 4 + r]);
            const float oc = p.OCMP[(size_t)row * 1024 + (g * 4 + r) * 64 + lane];
            p.YB[(size_t)row * 1024 + (g * 4 + r) * 64 + lane] = f2bf(g0 * oc + g1 * res[0][r] + g2 * res[1][r]);
        }
    }
}

typedef float f32x16 __attribute__((ext_vector_type(16)));
typedef short s16x4 __attribute__((ext_vector_type(4)));
typedef __attribute__((address_space(3))) const char* lds_cptr;
#define MFMA32(a, b, c) __builtin_amdgcn_mfma_f32_32x32x16_bf16(a, b, c, 0, 0, 0)
DEVI int crow(int r, int hi) { return (r & 3) + 8 * (r >> 2) + 4 * hi; }
DEVI unsigned cvtpk(float lo, float hi) { unsigned r; asm("v_cvt_pk_bf16_f32 %0, %1, %2" : "=v"(r) : "v"(lo), "v"(hi)); return r; }
DEVI s16x4 vtr(lds_cptr p) { return __builtin_bit_cast(s16x4, __builtin_amdgcn_ds_read_tr16_b64_v4i16((__attribute__((address_space(3))) s16x4*)p)); }
DEVI float half_max(float m) { auto rr = __builtin_amdgcn_permlane32_swap(__float_as_uint(m), __float_as_uint(m), false, false); return fmaxf(__uint_as_float(rr[0]), __uint_as_float(rr[1])); }
DEVI float half_sum(float m) { auto rr = __builtin_amdgcn_permlane32_swap(__float_as_uint(m), __float_as_uint(m), false, false); return __uint_as_float(rr[0]) + __uint_as_float(rr[1]); }

struct BlkDesc { const char* k; int stride_bytes; int f32; int count; int pos0; };
DEVI u32x4 pack8f(const f32x4 a, const f32x4 b) { u32x4 r; r[0] = pack2(a[0], a[1]); r[1] = pack2(a[2], a[3]); r[2] = pack2(b[0], b[1]); r[3] = pack2(b[2], b[3]); return r; }
DEVI void blk_load(const BlkDesc& d, int tid, u32x4& rk, u32x4& rv) {
    const int key = tid & 63, chunk = tid >> 6;
    rk = (u32x4){0u, 0u, 0u, 0u}; rv = rk;
    if (key < d.count) {
        const char* kr = d.k + (size_t)key * d.stride_bytes;
        if (d.f32) {
            const f32x4* s1 = (const f32x4*)(kr + chunk * 32); const f32x4* s2 = (const f32x4*)(kr + 1024 + chunk * 32);
            rk = pack8f(s1[0], s1[1]); rv = pack8f(s2[0], s2[1]);
        } else { rk = *(const u32x4*)(kr + chunk * 16); rv = *(const u32x4*)(kr + 512 + chunk * 16); }
    }
}
DEVI void blk_store(char* kimg, char* vimg, int tid, const u32x4& rk, const u32x4& rv) {
    const int key = tid & 63, chunk = tid >> 6;
    *(u32x4*)(kimg + chunk * 1024 + key * 16) = rk;
    *(u32x4*)(vimg + (chunk >> 2) * 4096 + key * 64 + (chunk & 3) * 16) = rv;
}

DEVI void attn_tile(const char* kimg, const char* vimg, const bf16x8 (&qr)[4], float& m2, float& lsum, f32x16& o0, f32x16& o1, f32x16& s0, f32x16& s1,
                    float sl, float bb, int lh, int ll, bool fast, float* wsf_hi  , float* wsf_r  , int lane) {
    const int r32 = lane & 31, hi = lane >> 5;
    const f32x16 z = {};
    s0 = z; s1 = z;
    {
        const char* kp = kimg + hi * 1024 + r32 * 16;
#pragma unroll
        for (int d0 = 0; d0 < 4; ++d0) {
            const bf16x8 k0 = *(const bf16x8*)(kp + d0 * 2048), k1 = *(const bf16x8*)(kp + d0 * 2048 + 512);
            s0 = MFMA32(k0, qr[d0], s0); s1 = MFMA32(k1, qr[d0], s1);
        }
    }
    float mx = -1e30f;
    if (fast) {
#pragma unroll
        for (int r = 0; r < 16; ++r) {
            const int c = (r & 3) + 8 * (r >> 2);
            s0[r] = fmaf(s0[r], 1.4426950408889634f, fmaf(sl, (float)c, bb)); s1[r] = fmaf(s1[r], 1.4426950408889634f, fmaf(sl, (float)(c + 32), bb));
            mx = fmaxf(mx, fmaxf(s0[r], s1[r]));
        }
    } else {
#pragma unroll
        for (int r = 0; r < 16; ++r) {
            const int c = (r & 3) + 8 * (r >> 2);
            const float t0 = fmaf(s0[r], 1.4426950408889634f, fmaf(sl, (float)c, bb)), t1 = fmaf(s1[r], 1.4426950408889634f, fmaf(sl, (float)(c + 32), bb));
            s0[r] = (c <= lh && c > ll) ? t0 : -INFINITY; s1[r] = (c + 32 <= lh && c + 32 > ll) ? t1 : -INFINITY;
            mx = fmaxf(mx, fmaxf(s0[r], s1[r]));
        }
    }
    mx = half_max(mx);
    const float mnew = fmaxf(m2, mx);
    const float f = __builtin_amdgcn_exp2f(m2 - mnew);
    m2 = mnew;
    float ps = 0.f;
#pragma unroll
    for (int r = 0; r < 16; ++r) { s0[r] = __builtin_amdgcn_exp2f(s0[r] - mnew); s1[r] = __builtin_amdgcn_exp2f(s1[r] - mnew); ps += s0[r] + s1[r]; }
    lsum = lsum * f + ps;
    if (__any(f != 1.f)) {
        if (hi == 0) *wsf_r = f;
        asm volatile("s_waitcnt lgkmcnt(0)" ::: "memory");
#pragma unroll
        for (int a = 0; a < 4; ++a) {
            const f32x4 fv = *(const f32x4*)(wsf_hi + 8 * a);
#pragma unroll
            for (int k = 0; k < 4; ++k) { o0[4 * a + k] *= fv[k]; o1[4 * a + k] *= fv[k]; }
        }
        asm volatile("s_waitcnt lgkmcnt(0)" ::: "memory");
    }
    u32x4 pw[4];
#pragma unroll
    for (int k = 0; k < 4; ++k) { pw[0][k] = cvtpk(s0[2 * k], s0[2 * k + 1]); pw[1][k] = cvtpk(s0[8 + 2 * k], s0[8 + 2 * k + 1]); pw[2][k] = cvtpk(s1[2 * k], s1[2 * k + 1]); pw[3][k] = cvtpk(s1[8 + 2 * k], s1[8 + 2 * k + 1]); }
    const lds_cptr vp = (lds_cptr)vimg + ((lane >> 4) & 1) * 32 + (lane & 3) * 8 + (4 * hi + ((lane & 15) >> 2)) * 64;
#pragma unroll
    for (int i = 0; i < 8; ++i) {
        const s16x4 lo = vtr(vp + ((i >> 2) * 4096 + (i & 3) * 1024)), hh = vtr(vp + ((i >> 2) * 4096 + (i & 3) * 1024 + 512));
        const bf16x8 vf = (bf16x8){lo[0], lo[1], lo[2], lo[3], hh[0], hh[1], hh[2], hh[3]};
        const bf16x8 pf = __builtin_bit_cast(bf16x8, pw[i & 3]);
        if (i < 4) o0 = MFMA32(pf, vf, o0); else o1 = MFMA32(pf, vf, o1);
    }
}

constexpr int NSA_KV0 = 0, NSA_KV1 = 16384, NSA_WSF = 32768, NSA_IMP = NSA_WSF + 2048, NSA_SEL = NSA_IMP + 16384, NSA_LIST = NSA_SEL + 512, NSA_OST = NSA_LIST + 256, NSA_YAC = NSA_OST + 32768, NSA_LDS = NSA_YAC + 65536;
static_assert(NSA_LDS <= 152 * 1024, "lds");

DEVI BlkDesc nsa_desc(const P& p, bool prompt, int b, int g, int branch, int j) {
    BlkDesc d;
    if (prompt) {
        if (branch == 0) { d.k = (const char*)(p.KC + ((size_t)(b * 64) * 512 + g * 64)); d.stride_bytes = 2048; d.f32 = 1; d.count = 64; d.pos0 = 0; }
        else { d.k = (const char*)(p.PROJ + ((size_t)b * 4096 + j * 64) * PS + (branch == 1 ? C_SLC : C_WIN) + g * 64); d.stride_bytes = PS * 2; d.f32 = 0; d.count = 64; d.pos0 = j * 64; }
    } else {
        if (branch == 0) { d.k = (const char*)(p.KC + ((size_t)(256 + b * 32) * 512 + g * 64)); d.stride_bytes = 2048; d.f32 = 1; d.count = 32; d.pos0 = 0; }
        else if (branch == 1 && j < 32) { const int page = p.page_table[b * 16 + (j >> 1)]; d.k = (const char*)(p.cache_slc + ((size_t)page * 128 + (j & 1) * 64) * 512 + g * 64); d.stride_bytes = 2048; d.f32 = 1; d.count = 64; d.pos0 = j * 64; }
        else if (branch == 2 && j < 8) { d.k = (const char*)(p.cache_win + ((size_t)b * 512 + j * 64) * 512 + g * 64); d.stride_bytes = 2048; d.f32 = 1; d.count = 64; d.pos0 = 1536 + j * 64; }
        else { d.k = (const char*)(p.PROJ + ((size_t)NTP + b * 4) * PS + (branch == 1 ? C_SLC : C_WIN) + g * 64); d.stride_bytes = PS * 2; d.f32 = 0; d.count = 4; d.pos0 = 2048; }
    }
    return d;
}

DEVI void stage_nsa_attn(const P& p, char* smem, int bid, int nblk) {
    const int tid = threadIdx.x, lane = tid & 63, wid = tid >> 6, r32 = lane & 31, hi = lane >> 5;
    float* wsf = (float*)(smem + NSA_WSF) + wid * 64;
    float* impb = (float*)(smem + NSA_IMP) + wid * 512;
    unsigned long long* selm = (unsigned long long*)(smem + NSA_SEL);
    unsigned char* blist = (unsigned char*)(smem + NSA_LIST);
    for (int unit = bid; unit < 1024 + 512; unit += nblk) {
        const bool prompt = unit < 1024;
        int b, g, qt, t0, ntok, nb, cur; size_t rowbase;
        if (prompt) { b = unit >> 8; g = (unit >> 6) & 3; qt = unit & 63; t0 = qt * 64; ntok = 64; nb = 64; cur = qt; rowbase = (size_t)b * 4096 + t0; }
        else { const int us = unit - 1024; b = us >> 2; g = us & 3; qt = 0; t0 = 2048; ntok = 4; nb = 33; cur = 32; rowbase = (size_t)NTP + b * 4; }
        const int tokl = wid * 8 + (r32 >> 2), head = r32 & 3;
        const bool tok_ok = tokl < ntok;
        const int qpos = t0 + tokl;
        const float slope2 = alibi_slope(g * 4 + head) * 1.4426950408889634f;
        bf16x8 qr[4];
        {
            const bf16_t* qp = p.PROJ + (rowbase + (tok_ok ? tokl : 0)) * PS + C_BQ + (g * 4 + head) * 64 + hi * 8;
#pragma unroll
            for (int d0 = 0; d0 < 4; ++d0) {
                u32x4 v = *(const u32x4*)(qp + d0 * 16);
#pragma unroll
                for (int k = 0; k < 4; ++k) { const float lo = __uint_as_float(v[k] << 16) * 0.125f, hh = __uint_as_float(v[k] & 0xFFFF0000u) * 0.125f; v[k] = tok_ok ? ((__float_as_uint(lo) >> 16) | (__float_as_uint(hh) & 0xFFFF0000u)) : 0u; }
                qr[d0] = __builtin_bit_cast(bf16x8, v);
            }
        }
        int hi4 = 4 * hi; asm volatile("" : "+v"(hi4));
        float* yl = (float*)(smem + NSA_YAC) + wid * 2048 + hi4 * 64 + r32;
        float* wsf_hi = wsf + hi4; float* wsf_r = wsf + r32;
        f32x16 o0, o1, s0, s1; float m2, lsum;
        auto finish = [&](int br) {
            const float lt = half_sum(lsum);
            float fac = 0.f;
            if (tok_ok && lt > 0.f) fac = sigmoidf_(p.SM[(rowbase + tokl) * 64 + 8 + br * 16 + g * 4 + head]) / lt;
            if (hi == 0) *wsf_r = fac;
            asm volatile("s_waitcnt lgkmcnt(0)" ::: "memory");
#pragma unroll
            for (int a = 0; a < 4; ++a) {
                const f32x4 fv = *(const f32x4*)(wsf_hi + 8 * a);
#pragma unroll
                for (int k = 0; k < 4; ++k) {
                    float* yp = yl + (8 * a + k) * 64;
                    if (br == 0) { yp[0] = o0[4 * a + k] * fv[k]; yp[32] = o1[4 * a + k] * fv[k]; }
                    else { yp[0] += o0[4 * a + k] * fv[k]; yp[32] += o1[4 * a + k] * fv[k]; }
                }
            }
            asm volatile("s_waitcnt lgkmcnt(0)" ::: "memory");
        };
        __syncthreads();
        {
            const BlkDesc d = nsa_desc(p, prompt, b, g, 0, 0);
            u32x4 rk, rv; blk_load(d, tid, rk, rv); blk_store(smem + NSA_KV0, smem + NSA_KV0 + 8192, tid, rk, rv);
            __syncthreads();
            o0 = (f32x16){}; o1 = (f32x16){}; m2 = -1e30f; lsum = 0.f;
            {
                const int nv = ((qpos + 1) >> 6) - 1;
                const int lh = (nv < d.count - 1 ? nv : d.count - 1) - hi4;
                const float sl = 64.f * slope2;
                attn_tile(smem + NSA_KV0, smem + NSA_KV0 + 8192, qr, m2, lsum, o0, o1, s0, s1, sl, tok_ok ? sl * (float)(hi4 - (t0 >> 6)) : -INFINITY, lh, -1000, false, wsf_hi, wsf_r, lane);
            }
            const float lt = half_sum(lsum);
            const float inv = lt > 0.f ? 1.f / lt : 0.f;
            float* ib = impb + (r32 >> 2) * 64 + hi4;
#pragma unroll
            for (int r = 0; r < 16; ++r) {
                float a = s0[r] * inv, c = s1[r] * inv;
                a += __shfl_xor(a, 1); a += __shfl_xor(a, 2); c += __shfl_xor(c, 1); c += __shfl_xor(c, 2);
                if (head == 0) { ib[(r & 3) + 8 * (r >> 2)] = a; ib[(r & 3) + 8 * (r >> 2) + 32] = c; }
            }
            asm volatile("s_waitcnt lgkmcnt(0)" ::: "memory");
            finish(0);
#pragma unroll 1
            for (int tl = 0; tl < 8; ++tl) {
                const int j = lane;
                float v = impb[tl * 64 + j];
                if (j == cur || j == 0) v = 5.0f;
                if (j > cur) v = -1.0f;
                if (j >= nb) v = -2.0f;
                impb[tl * 64 + j] = v;
                asm volatile("s_waitcnt lgkmcnt(0)" ::: "memory");
                int rank = 0;
#pragma unroll 8
                for (int jj = 0; jj < 64; ++jj) { const float u = impb[tl * 64 + jj]; rank += (u > v || (u == v && jj < j)) ? 1 : 0; }
                const unsigned long long mask = __ballot(rank < 16 && j < nb);
                if (lane == 0) selm[wid * 8 + tl] = (wid * 8 + tl < ntok) ? mask : 0ull;
            }
        }
        __syncthreads();
        if (wid == 0) {
            unsigned long long u = selm[lane];
#pragma unroll
            for (int o = 32; o > 0; o >>= 1) u |= __shfl_xor(u, o);
            if (prompt) u &= (qt == 63) ? ~0ull : ((1ull << (qt + 1)) - 1ull);
            if (lane == 0) {
                int n = 0;
                while (u) { const int j = __builtin_ctzll(u); u &= u - 1; blist[1 + n++] = (unsigned char)(0x40 | j); }
                if (prompt) { for (int j = (qt - 8 > 0 ? qt - 8 : 0); j <= qt; ++j) blist[1 + n++] = (unsigned char)(0x80 | j); }
                else { for (int j = 0; j <= 8; ++j) blist[1 + n++] = (unsigned char)(0x80 | j); }
                blist[0] = (unsigned char)n;
            }
        }
        __syncthreads();
        const int nblkk = blist[0];
        const unsigned long long mysel = selm[tokl];
        {
            u32x4 rk, rv;
            { const int e = blist[1]; const BlkDesc d = nsa_desc(p, prompt, b, g, e >> 6, e & 63); blk_load(d, tid, rk, rv); blk_store(smem + NSA_KV0, smem + NSA_KV0 + 8192, tid, rk, rv); }
            __syncthreads();
            int prev_br = 1;
            o0 = (f32x16){}; o1 = (f32x16){}; m2 = -1e30f; lsum = 0.f;
            for (int i = 0; i < nblkk; ++i) {
                const int e = blist[1 + i], br = e >> 6, j = e & 63;
                char* cur_img = smem + ((i & 1) ? NSA_KV1 : NSA_KV0);
                char* nxt_img = smem + ((i & 1) ? NSA_KV0 : NSA_KV1);
                const BlkDesc d = nsa_desc(p, prompt, b, g, br, j);
                if (i + 1 < nblkk) { const int e2 = blist[2 + i]; const BlkDesc d2 = nsa_desc(p, prompt, b, g, e2 >> 6, e2 & 63); blk_load(d2, tid, rk, rv); }
                if (br != prev_br) { finish(1); o0 = (f32x16){}; o1 = (f32x16){}; m2 = -1e30f; lsum = 0.f; prev_br = br; }
                {
                    asm volatile("" : "+v"(hi4));
                    const bool lsel = tok_ok && (br == 2 || ((mysel >> j) & 1ull));
                    const int rel = qpos - d.pos0;
                    const int lh = (rel < d.count - 1 ? rel : d.count - 1) - hi4;
                    const int ll = (br == 2 ? rel - 512 : -1000) - hi4;
                    const bool fast = __all(!lsel || (lh >= 59 && ll < 0));
                    attn_tile(cur_img, cur_img + 8192, qr, m2, lsum, o0, o1, s0, s1, slope2, lsel ? slope2 * (float)(hi4 + d.pos0 - t0) : -INFINITY, lh, ll, fast, wsf_hi, wsf_r, lane);
                }
                if (i + 1 < nblkk) blk_store(nxt_img, nxt_img + 8192, tid, rk, rv);
                __syncthreads();
            }
            finish(2);
        }
        {
            const float* yac = (const float*)(smem + NSA_YAC) + wid * 2048;
#pragma unroll
            for (int i = 0; i < 4; ++i) {
                const int orow = i * 8 + (lane >> 3), ch = lane & 7, tk = wid * 8 + (orow >> 2), hd = orow & 3;
                const f32x4 a = *(const f32x4*)(yac + orow * 64 + ch * 8), c = *(const f32x4*)(yac + orow * 64 + ch * 8 + 4);
                if (tk < ntok) *(u32x4*)(p.YB + (rowbase + tk) * 1024 + (g * 4 + hd) * 64 + ch * 8) = pack8f(a, c);
            }
            asm volatile("s_waitcnt lgkmcnt(0)" ::: "memory");
        }
    }
}

DEVI void stage_ln1(const P& p, int bid, int nblk) {
    const int lane = threadIdx.x & 63, wid = threadIdx.x >> 6;
    for (int row = bid * 8 + wid; row < NT; row += nblk * 8) {
        f32x4 x[4];
        float s = 0.f;
#pragma unroll
        for (int i = 0; i < 4; ++i) { x[i] = *(const f32x4*)(p.R + (size_t)row * 1024 + i * 256 + lane * 4); s += x[i][0] + x[i][1] + x[i][2] + x[i][3]; }
        const float mean = wave_sum(s) * (1.f / 1024.f);
        float q = 0.f;
#pragma unroll
        for (int i = 0; i < 4; ++i)
#pragma unroll
            for (int k = 0; k < 4; ++k) q += (x[i][k] - mean) * (x[i][k] - mean);
        const float rs = rsqrtf(wave_sum(q) * (1.f / 1024.f) + LN_EPS);
#pragma unroll
        for (int i = 0; i < 4; ++i) {
            const int c = i * 256 + lane * 4;
            const f32x4 gg = *(const f32x4*)(p.ln1_g + c), bb = *(const f32x4*)(p.ln1_b + c);
            f32x4 y;
#pragma unroll
            for (int k = 0; k < 4; ++k) y[k] = (x[i][k] - mean) * rs * gg[k] + bb[k];
            *(f32x4*)(p.H + (size_t)row * 1024 + c) = y;
            u32x2 o; o.x = pack2(y[0], y[1]); o.y = pack2(y[2], y[3]);
            *(u32x2*)(p.HB + (size_t)row * 1024 + c) = o;
        }
    }
}

__device__ const unsigned char PEER_CA[50] = {0,0,0,0,0,0,0,0,0,0,0,0,0,0,0,0, 1,1,1,1,1,1,1,1, 2,2,2,2,2, 3,3,3,3, 4,4,4, 5,5, 6,6, 7,7, 8,9,10,11,12,13,14,15};
__device__ const unsigned char PEER_CB[50] = {0,1,2,3,4,5,6,7,8,9,10,11,12,13,14,15, 0,1,2,3,4,5,6,7, 0,1,2,3,4, 0,1,2,3, 0,1,2, 0,1, 0,1, 0,1, 0,0,0,0,0,0,0,0};

DEVI void stage_peer_route(const P& p, char* smem, int bid, int nblk) {
    const int lane = threadIdx.x & 63, wid = threadIdx.x >> 6;
    float* qs = (float*)smem + wid * 320;
    float* ts = qs + 256; int* ti = (int*)(qs + 288);
    for (int wt = bid * 8 + wid; wt < NT * 8; wt += nblk * 8) {
        const int row = wt >> 3, ph = wt & 7;
        {
            const bf16_t* qr = p.PQ + (size_t)row * 2048 + ph * 256;
#pragma unroll
            for (int i = 0; i < 4; ++i) qs[i * 64 + lane] = bf2f(qr[i * 64 + lane]);
            asm volatile("s_waitcnt lgkmcnt(0)" ::: "memory");
        }
        float sc[2][2];
#pragma unroll
        for (int c = 0; c < 2; ++c)
#pragma unroll
            for (int kh = 0; kh < 2; ++kh) {
                const bf16_t* kr = p.KEYSB + ((size_t)((ph * 2 + c) * 128 + kh * 64 + lane)) * 128;
                float a = 0.f;
#pragma unroll 4
                for (int d8 = 0; d8 < 16; ++d8) {
                    const u32x4 kk = *(const u32x4*)(kr + d8 * 8);
                    const unsigned w[4] = {kk.x, kk.y, kk.z, kk.w};
#pragma unroll
                    for (int e = 0; e < 4; ++e) a += __uint_as_float(w[e] << 16) * qs[c * 128 + d8 * 8 + e * 2] + __uint_as_float(w[e] & 0xFFFF0000u) * qs[c * 128 + d8 * 8 + e * 2 + 1];
                }
                sc[c][kh] = a;
            }
#pragma unroll
        for (int c = 0; c < 2; ++c) {
            int r0 = 0, r1 = 0;
            for (int kk = 0; kk < 64; ++kk) {
                const float v0 = __shfl(sc[c][0], kk), v1 = __shfl(sc[c][1], kk);
                r0 += (v0 > sc[c][0] || (v0 == sc[c][0] && kk < lane)) ? 1 : 0;
                r0 += (v1 > sc[c][0]) ? 1 : 0;
                r1 += (v0 >= sc[c][1]) ? 1 : 0;
                r1 += (v1 > sc[c][1] || (v1 == sc[c][1] && kk < lane)) ? 1 : 0;
            }
            if (r0 < 16) { ts[c * 16 + r0] = sc[c][0]; ti[c * 16 + r0] = lane; }
            if (r1 < 16) { ts[c * 16 + r1] = sc[c][1]; ti[c * 16 + r1] = lane + 64; }
        }
        asm volatile("s_waitcnt lgkmcnt(0)" ::: "memory");
        float cand = -INFINITY; int cidx = 0;
        if (lane < 50) { const int a = PEER_CA[lane], bq = PEER_CB[lane]; cand = ts[a] + ts[16 + bq]; cidx = ti[a] * 128 + ti[16 + bq]; }
        int rk = 0;
        for (int kk = 0; kk < 50; ++kk) { const float v = __shfl(cand, kk); rk += (v > cand || (v == cand && kk < lane)) ? 1 : 0; }
        const bool sel = lane < 50 && rk < 16;
        const float mx = wave_max(sel ? cand : -INFINITY);
        const float e = sel ? __expf(cand - mx) : 0.f;
        const float sum = wave_sum(e);
        if (sel) { p.EIDX[(size_t)row * 128 + ph * 16 + rk] = cidx; p.EGATE[(size_t)row * 128 + ph * 16 + rk] = e / sum; }
        asm volatile("s_waitcnt lgkmcnt(0)" ::: "memory");
    }
}

constexpr int PA_WAVE_LDS = 2048 + 512 + 512 + 512;
DEVI void stage_peer_apply(const P& p, char* smem, int bid, int nblk) {
    const int lane = threadIdx.x & 63, wid = threadIdx.x >> 6;
    char* wl = smem + wid * PA_WAVE_LDS;
    bf16_t* hb = (bf16_t*)wl;
    int* idxs = (int*)(wl + 2048);
    float* gts = (float*)(wl + 2560);
    float* cs = (float*)(wl + 3072);
    const int fr = lane & 15, fq = lane >> 4;
    for (int row = bid * 8 + wid; row < NT; row += nblk * 8) {
        {
            const bf16_t* hr = p.HB + (size_t)row * 1024 + lane * 8;
            *(u32x4*)(hb + lane * 8) = *(const u32x4*)hr;
            *(u32x4*)(hb + 512 + lane * 8) = *(const u32x4*)(hr + 512);
            idxs[lane] = p.EIDX[(size_t)row * 128 + lane]; idxs[lane + 64] = p.EIDX[(size_t)row * 128 + 64 + lane];
            gts[lane] = p.EGATE[(size_t)row * 128 + lane]; gts[lane + 64] = p.EGATE[(size_t)row * 128 + 64 + lane];
            asm volatile("s_waitcnt lgkmcnt(0)" ::: "memory");
        }
#pragma unroll 1
        for (int g = 0; g < 8; ++g) {
            const int my_e = idxs[g * 16 + fr];
            const bf16_t* ub = p.UB + (size_t)my_e * 1024 + fq * 8;
            f32x4 acc = (f32x4){0.f, 0.f, 0.f, 0.f};
            bf16x8 a0[16], a1[16];
#pragma unroll
            for (int s2 = 0; s2 < 16; ++s2) a0[s2] = *(const bf16x8*)(ub + s2 * 32);
#pragma unroll
            for (int s2 = 0; s2 < 16; ++s2) a1[s2] = *(const bf16x8*)(ub + (16 + s2) * 32);
#pragma unroll
            for (int s2 = 0; s2 < 16; ++s2) { const bf16x8 hf = *(const bf16x8*)(hb + s2 * 32 + fq * 8); acc = __builtin_amdgcn_mfma_f32_16x16x32_bf16(a0[s2], hf, acc, 0, 0, 0); }
#pragma unroll
            for (int s2 = 0; s2 < 16; ++s2) { const bf16x8 hf = *(const bf16x8*)(hb + (16 + s2) * 32 + fq * 8); acc = __builtin_amdgcn_mfma_f32_16x16x32_bf16(a1[s2], hf, acc, 0, 0, 0); }
            const f32x4 gg = *(const f32x4*)(gts + g * 16 + fq * 4);
            f32x4 cv;
#pragma unroll
            for (int r = 0; r < 4; ++r) { const float d = acc[r]; cv[r] = gg[r] * 0.5f * d * (1.f + erff(d * 0.7071067811865476f)); }
            if (fr == 0) *(f32x4*)(cs + g * 16 + fq * 4) = cv;
        }
        asm volatile("s_waitcnt lgkmcnt(0)" ::: "memory");
        float acc[16];
#pragma unroll
        for (int i = 0; i < 16; ++i) acc[i] = 0.f;
#pragma unroll 1
        for (int e0 = 0; e0 < 128; e0 += 8) {
            u32x4 v0[8], v1[8]; float c[8];
#pragma unroll
            for (int k = 0; k < 8; ++k) {
                const int idx = idxs[e0 + k];
                const bf16_t* vr = p.VB + (size_t)idx * 1024 + lane * 8;
                v0[k] = *(const u32x4*)vr; v1[k] = *(const u32x4*)(vr + 512);
                c[k] = cs[e0 + k];
            }
#pragma unroll
            for (int k = 0; k < 8; ++k) {
#pragma unroll
                for (int w = 0; w < 4; ++w) {
                    acc[w * 2] += c[k] * __uint_as_float(v0[k][w] << 16); acc[w * 2 + 1] += c[k] * __uint_as_float(v0[k][w] & 0xFFFF0000u);
                    acc[8 + w * 2] += c[k] * __uint_as_float(v1[k][w] << 16); acc[8 + w * 2 + 1] += c[k] * __uint_as_float(v1[k][w] & 0xFFFF0000u);
                }
            }
        }
        float s = 0.f;
#pragma unroll
        for (int i = 0; i < 2; ++i) {
            const f32x4 a = *(const f32x4*)(p.H + (size_t)row * 1024 + i * 512 + lane * 8), b2 = *(const f32x4*)(p.H + (size_t)row * 1024 + i * 512 + lane * 8 + 4);
#pragma unroll
            for (int k = 0; k < 4; ++k) { acc[i * 8 + k] += DN_ALPHA * a[k]; acc[i * 8 + 4 + k] += DN_ALPHA * b2[k]; }
        }
#pragma unroll
        for (int i = 0; i < 16; ++i) s += acc[i];
        const float mean = wave_sum(s) * (1.f / 1024.f);
        float q = 0.f;
#pragma unroll
        for (int i = 0; i < 16; ++i) q += (acc[i] - mean) * (acc[i] - mean);
        const float rs = rsqrtf(wave_sum(q) * (1.f / 1024.f) + LN_EPS);
#pragma unroll
        for (int i = 0; i < 2; ++i) {
            const int c = i * 512 + lane * 8;
            const f32x4 g0 = *(const f32x4*)(p.ln2_g + c), g1 = *(const f32x4*)(p.ln2_g + c + 4), b0 = *(const f32x4*)(p.ln2_b + c), b1 = *(const f32x4*)(p.ln2_b + c + 4);
            f32x4 y0, y1;
#pragma unroll
            for (int k = 0; k < 4; ++k) { y0[k] = (acc[i * 8 + k] - mean) * rs * g0[k] + b0[k]; y1[k] = (acc[i * 8 + 4 + k] - mean) * rs * g1[k] + b1[k]; }
            *(f32x4*)(p.out + O_Y + (size_t)row * 1024 + c) = y0;
            *(f32x4*)(p.out + O_Y + (size_t)row * 1024 + c + 4) = y1;
        }
    }
}

#define XB_TMO      128
#define XB_XCNT(j)  (256  + 64 * (j))
#define XB_XSUB(j)  (1280 + 64 * (j))
#define XB_XGEN(j)  (2304 + 64 * (j))
#define XB_TOP      3328
#define XB_TOPGEN   3392
#define XCD_BAR_WORDS 3456
#define XB_SPIN_CAP (1u << 18)
#define LAS __attribute__((address_space(3)))

__device__ __forceinline__ unsigned xb_ld(unsigned* p)              { return __hip_atomic_load(p, __ATOMIC_RELAXED, __HIP_MEMORY_SCOPE_AGENT); }
__device__ __forceinline__ unsigned xb_add(unsigned* p, unsigned v) { return __hip_atomic_fetch_add(p, v, __ATOMIC_RELAXED, __HIP_MEMORY_SCOPE_AGENT); }
__device__ __forceinline__ unsigned xb_xcc_id() { return (unsigned)__builtin_amdgcn_s_getreg((3 << 11) | 20) & 0xFu; }
#define XB_SPIN(cond, bar) do { unsigned _sp = 0; while (cond) { __builtin_amdgcn_s_sleep(1); \
    if ((++_sp & 255u) == 0u) { if (xb_ld(&(bar)[XB_TMO])) break; if (_sp > XB_SPIN_CAP) { atomicAdd(&(bar)[XB_TMO], 1u); break; } } } } while (0)

struct XcdBarrier {
    unsigned* bar; unsigned x;
    volatile LAS unsigned* st;
};

__device__ __forceinline__ XcdBarrier xcd_barrier_post(unsigned* bar, volatile LAS unsigned* st) {
    XcdBarrier b; b.bar = bar; b.x = xb_xcc_id(); b.st = st;
    if (threadIdx.x == 0) (void)xb_add(&bar[XB_XCNT(b.x)], 1u);
    return b;
}
__device__ __forceinline__ void xcd_barrier_complete(unsigned* bar, unsigned x, unsigned& nloc, unsigned& nx) {
    const unsigned G = gridDim.x * gridDim.y * gridDim.z;
    unsigned sum, cnt, mine, sp = 0u;
    for (;;) {
        sum = 0u; cnt = 0u; mine = 0u;
#pragma unroll
        for (unsigned j = 0; j < 16; ++j) { const unsigned c = xb_ld(&bar[XB_XCNT(j)]); sum += c; cnt += (c > 0u) ? 1u : 0u; mine = (j == x) ? c : mine; }
        if (sum == G) break;
        __builtin_amdgcn_s_sleep(1);
        if ((++sp & 255u) == 0u) { if (xb_ld(&bar[XB_TMO])) break; if (sp > XB_SPIN_CAP) { atomicAdd(&bar[XB_TMO], 1u); break; } }
    }
    nloc = mine > 0u ? mine : 1u; nx = cnt > 0u ? cnt : 1u;
}

__device__ __forceinline__ void xcd_barrier(const XcdBarrier& b) {
    asm volatile("s_waitcnt vmcnt(0)" ::: "memory");
    __syncthreads();
    if (threadIdx.x == 0) {
        unsigned* bar = b.bar;
        __builtin_amdgcn_s_waitcnt(0);
        unsigned nloc = b.st[0], nx = b.st[1];
        if (nloc == 0u) { xcd_barrier_complete(bar, b.x, nloc, nx); b.st[0] = nloc; b.st[1] = nx; }
        const unsigned old = xb_add(&bar[XB_XSUB(b.x)], 1u);
        const unsigned gen = old / nloc;
        if (old + 1u == (gen + 1u) * nloc) {
            __builtin_amdgcn_fence(__ATOMIC_RELEASE, "agent");
            asm volatile("s_waitcnt vmcnt(0)" ::: "memory");
            const unsigned og = xb_add(&bar[XB_TOP], 1u);
            const unsigned tg = og / nx;
            if (og + 1u == (tg + 1u) * nx) xb_add(&bar[XB_TOPGEN], 1u);
            else XB_SPIN(xb_ld(&bar[XB_TOPGEN]) == tg, bar);
            __builtin_amdgcn_fence(__ATOMIC_ACQUIRE, "agent");
            xb_add(&bar[XB_XGEN(b.x)], 1u);
            asm volatile("s_waitcnt vmcnt(0)" ::: "memory");
        } else {
            XB_SPIN(xb_ld(&bar[XB_XGEN(b.x)]) == gen, bar);
            __builtin_amdgcn_fence(__ATOMIC_ACQUIRE, "agent");
            asm volatile("s_waitcnt vmcnt(0)" ::: "memory");
        }
    }
    __syncthreads();
}

constexpr int LDS_BYTES = 152 * 1024;
static_assert(MLO_LDS <= LDS_BYTES, "lds");
template <int S>
DEVI void run_stage(const P& p, char* smem, int bid, int nblk) {
    if (S == 0) stage_prologue(p, smem, bid, nblk);
    if (S == 1) { EpiInProj e{p}; gemm_phase(p.XB, p.WINT, NT, NPAD_IN, 1024, e, smem, bid, nblk); }
    if (S == 2) { stage_mlstm_gates(p, bid, nblk); stage_compress(p, smem, bid, nblk); }
    if (S == 3) { stage_mlstm_dc(p, smem, bid, nblk); stage_mlstm_sample(p, smem, bid, nblk); }
    if (S == 4) { stage_mlstm_scan(p, bid, nblk); stage_nsa_attn(p, smem, bid, nblk); { EpiG e{p}; gemm_phase(p.XB, p.WMT, NT, 2048, 1024, e, smem, bid, nblk); } }
    if (S == 5) stage_mlstm_out(p, smem, bid, nblk);
    if (S == 6) { EpiM1 e{p}; gemm_phase(p.YA, p.WAT, NT, 1024, 1024, e, smem, bid, nblk); }
    if (S == 7) { EpiM2 e{p}; gemm_phase(p.YB, p.WBT, NT, 1024, 1024, e, smem, bid, nblk); }
    if (S == 8) { EpiR e{p}; gemm_phase(p.MERGED, p.WOT, NT, 1024, 1024, e, smem, bid, nblk); }
    if (S == 9) stage_ln1(p, bid, nblk);
    if (S == 10) { EpiPQ e{p}; gemm_phase(p.HB, p.WQT, NT, 2048, 1024, e, smem, bid, nblk); }
    if (S == 11) stage_peer_route(p, smem, bid, nblk);
    if (S == 12) stage_peer_apply(p, smem, bid, nblk);
}
constexpr int NSTAGES = 13;

template <int S>
__global__ void __launch_bounds__(512, 2) k_stage(P p) {
    extern __shared__ __attribute__((aligned(16))) char smem[];
    run_stage<S>(p, smem, blockIdx.x, gridDim.x);
}


#if MK_ONE_LAUNCH
__global__ void __launch_bounds__(512, 2) k_mega(P p) {
    extern __shared__ __attribute__((aligned(16))) char smem_all[];
    if (threadIdx.x == 0) *(u32x4*)smem_all = (u32x4){0u, 0u, 0u, 0u};
    __syncthreads();
    XcdBarrier bar = xcd_barrier_post(p.bar, (volatile LAS unsigned*)smem_all);
    char* smem = smem_all + 16;
    const int bid = blockIdx.x, nblk = gridDim.x;
    run_stage<0>(p, smem, bid, nblk);  xcd_barrier(bar);
    run_stage<1>(p, smem, bid, nblk);  xcd_barrier(bar);
    run_stage<2>(p, smem, bid, nblk);  xcd_barrier(bar);
    run_stage<3>(p, smem, bid, nblk);  xcd_barrier(bar);
    run_stage<4>(p, smem, bid, nblk);  xcd_barrier(bar);
    run_stage<5>(p, smem, bid, nblk);  xcd_barrier(bar);
    run_stage<6>(p, smem, bid, nblk);  xcd_barrier(bar);
    run_stage<7>(p, smem, bid, nblk);  xcd_barrier(bar);
    run_stage<8>(p, smem, bid, nblk);  xcd_barrier(bar);
    run_stage<9>(p, smem, bid, nblk);  xcd_barrier(bar);
    run_stage<10>(p, smem, bid, nblk); xcd_barrier(bar);
    run_stage<11>(p, smem, bid, nblk); xcd_barrier(bar);
    run_stage<12>(p, smem, bid, nblk);
}
#endif

template <int S> static void launch_stage(const P& p, int grid, hipStream_t stream) {
    (void)hipFuncSetAttribute((const void*)k_stage<S>, hipFuncAttributeMaxDynamicSharedMemorySize, LDS_BYTES);
    k_stage<S><<<dim3(grid), dim3(512), LDS_BYTES, stream>>>(p);
}

extern "C" void kernel_launch(void* const* d_in, const int* in_sizes, int n_in, void* d_out, int out_size, void* d_ws, size_t ws_size, hipStream_t stream) {
    (void)in_sizes; (void)n_in; (void)out_size; (void)ws_size;
    P p{};
    p.xp = (const float*)d_in[0]; p.xs = (const float*)d_in[1]; p.cache_cmp = (const float*)d_in[2]; p.cache_slc = (const float*)d_in[3];
    p.cache_win = (const float*)d_in[4]; p.state_C = (const float*)d_in[5]; p.state_n = (const float*)d_in[6]; p.state_m = (const float*)d_in[7];
    p.page_table = (const int*)d_in[8];
    p.w_in = (const float*)d_in[9]; p.b_in = (const float*)d_in[10]; p.norm_a_g = (const float*)d_in[11]; p.nsa_pe = (const float*)d_in[12];
    p.nsa_w_cmp = (const float*)d_in[13]; p.w_br_a = (const float*)d_in[14]; p.w_br_b = (const float*)d_in[15]; p.w_merge = (const float*)d_in[16];
    p.w_out = (const float*)d_in[17]; p.ln1_g = (const float*)d_in[18]; p.ln1_b = (const float*)d_in[19];
    p.peer_wq = (const float*)d_in[20]; p.peer_keys = (const float*)d_in[21]; p.peer_u = (const float*)d_in[22]; p.peer_v = (const float*)d_in[23];
    p.ln2_g = (const float*)d_in[24]; p.ln2_b = (const float*)d_in[25];
    p.out = (float*)d_out;
    char* w = (char*)d_ws; size_t off = 0;
    auto take = [&](size_t bytes) { char* r = w + off; off += (bytes + 255) & ~(size_t)255; return r; };
    p.bar = (unsigned*)take(16384);
    p.XB = (bf16_t*)take((size_t)NT * 1024 * 2);
    p.WINT = (bf16_t*)take((size_t)NPAD_IN * 1024 * 2);
    p.WMT = (bf16_t*)take((size_t)2048 * 1024 * 2);
    p.WAT = (bf16_t*)take((size_t)1024 * 1024 * 2);
    p.WBT = (bf16_t*)take((size_t)1024 * 1024 * 2);
    p.WOT = (bf16_t*)take((size_t)1024 * 1024 * 2);
    p.WQT = (bf16_t*)take((size_t)2048 * 1024 * 2);
    p.KEYSB = (bf16_t*)take((size_t)16 * 128 * 128 * 2);
    p.UB = (bf16_t*)take((size_t)16384 * 1024 * 2);
    p.VB = (bf16_t*)take((size_t)16384 * 1024 * 2);
    p.PROJ = (bf16_t*)take((size_t)NT * PS * 2);
    p.SM = (float*)take((size_t)NT * 64 * 4);
    p.BCUM = (float*)take((size_t)16 * 4096 * 4);
    p.MPREV = (float*)take(4096); p.ACOEF = (float*)take(4096); p.SCL = (float*)take(4096); p.MLOC = (float*)take(4096);
    p.DC = (float*)take((size_t)1024 * 32768 * 4);
    p.DN = (float*)take((size_t)1024 * 128 * 4);
    p.CPREV = (float*)take((size_t)1024 * 32768 * 4);
    p.NPREV = (float*)take((size_t)1024 * 128 * 4);
    p.KC = (float*)take((size_t)4352 * 512 * 4);
    p.VC = p.KC + 256;
    p.OCMP = (float*)take((size_t)NT * 1024 * 4);
    p.SEL = (unsigned long long*)take((size_t)NT * 4 * 8);
    p.YA = (bf16_t*)take((size_t)NT * 1024 * 2);
    p.YB = (bf16_t*)take((size_t)NT * 1024 * 2);
    p.G = (bf16_t*)take((size_t)NT * 2048 * 2);
    p.TMP = (float*)take((size_t)NT * 1024 * 4);
    p.MERGED = (bf16_t*)take((size_t)NT * 1024 * 2);
    p.R = (float*)take((size_t)NT * 1024 * 4);
    p.H = (float*)take((size_t)NT * 1024 * 4);
    p.HB = (bf16_t*)take((size_t)NT * 1024 * 2);
    p.PQ = (bf16_t*)take((size_t)NT * 2048 * 2);
    p.EIDX = (int*)take((size_t)NT * 128 * 4);
    p.EGATE = (float*)take((size_t)NT * 128 * 4);

#if MK_ONE_LAUNCH
    {
        constexpr size_t kDynLds = LDS_BYTES + 16;
        (void)hipFuncSetAttribute((const void*)k_mega, hipFuncAttributeMaxDynamicSharedMemorySize, (int)kDynLds);
        int dev = 0, cus = 0, per_cu = 0;
        (void)hipGetDevice(&dev);
        (void)hipDeviceGetAttribute(&cus, hipDeviceAttributeMultiprocessorCount, dev);
        (void)hipOccupancyMaxActiveBlocksPerMultiprocessor(&per_cu, (const void*)k_mega, 512, kDynLds);
        if (per_cu < 1 || cus < 1) return;
        const int grid = cus;
        (void)hipMemsetAsync(p.bar, 0, XCD_BAR_WORDS * sizeof(unsigned), stream);
        k_mega<<<dim3(grid), dim3(512), kDynLds, stream>>>(p);
    }
#else
    const int grid = 512;
    launch_stage<0>(p, grid, stream);
    launch_stage<1>(p, grid, stream);
    launch_stage<2>(p, grid, stream);
    launch_stage<3>(p, grid, stream);
    launch_stage<4>(p, grid, stream);
    launch_stage<5>(p, grid, stream);
    launch_stage<6>(p, grid, stream);
    launch_stage<7>(p, grid, stream);
    launch_stage<8>(p, grid, stream);
    launch_stage<9>(p, grid, stream);
    launch_stage<10>(p, grid, stream);
    launch_stage<11>(p, grid, stream);
    launch_stage<12>(p, grid, stream);
#endif
}
```

```cpp
#include <hip/hip_runtime.h>
#include <stdint.h>

#ifndef REP_MASK
#define REP_MASK 0
#endif
#ifndef MK_ONE_LAUNCH
#define MK_ONE_LAUNCH 1
#endif

typedef unsigned short bf16_t;
typedef short bf16x8 __attribute__((ext_vector_type(8)));
typedef float f32x4 __attribute__((ext_vector_type(4)));
typedef unsigned u32x4 __attribute__((ext_vector_type(4)));
typedef unsigned u32x2 __attribute__((ext_vector_type(2)));
#define DEVI __device__ __forceinline__

constexpr int NTP = 16384, NTS = 512, NT = NTP + NTS, DM = 1024;
constexpr int PS = 5632;
constexpr int C_AQ = 0, C_AK = 512, C_AV = 1024, C_AO = 2048, C_BQ = 3072, C_CMP = 4096, C_SLC = 4608, C_WIN = 5120;
constexpr int NPAD_IN = 5888;
constexpr float DN_ALPHA = 1.189207115002721f;
constexpr float LN_EPS = 1e-5f;
constexpr size_t O_Y = 0;
constexpr size_t O_PCMP = O_Y + (size_t)NT * 1024;
constexpr size_t O_PSLC = O_PCMP + (size_t)NTP * 512;
constexpr size_t O_PWIN = O_PSLC + (size_t)NTP * 512;
constexpr size_t O_PC = O_PWIN + (size_t)4 * 512 * 512;
constexpr size_t O_PN = O_PC + (size_t)16 * 128 * 256;
constexpr size_t O_PM = O_PN + 16 * 128;
constexpr size_t O_SCMP = O_PM + 16;
constexpr size_t O_SSLC = O_SCMP + (size_t)NTS * 512;
constexpr size_t O_SWIN = O_SSLC + (size_t)NTS * 512;
constexpr size_t O_SC = O_SWIN + (size_t)128 * 512 * 512;
constexpr size_t O_SN = O_SC + (size_t)512 * 128 * 256;
constexpr size_t O_SM = O_SN + 512 * 128;

struct P {
    const float *xp, *xs, *cache_cmp, *cache_slc, *cache_win, *state_C, *state_n, *state_m;
    const int* page_table;
    const float *w_in, *b_in, *norm_a_g, *nsa_pe, *nsa_w_cmp, *w_br_a, *w_br_b, *w_merge, *w_out, *ln1_g, *ln1_b;
    const float *peer_wq, *peer_keys, *peer_u, *peer_v, *ln2_g, *ln2_b;
    float* out;
    bf16_t *XB, *WINT, *WMT, *WAT, *WBT, *WOT, *WQT, *KEYSB, *UB, *VB, *PROJ, *WCT;
    float* PW;
    float *SM, *BCUM, *MPREV, *ACOEF, *SCL, *MLOC, *DC, *KC, *VC, *OCMP;
    bf16_t* CPT;
    unsigned long long* SEL;
    bf16_t *YA, *YB, *G, *MERGED, *HB, *PQ;
    float *TMP, *R, *H, *EGATE;
    int* EIDX;
    unsigned* bar;
};

DEVI bf16_t f2bf(float f) { unsigned u = __float_as_uint(f); u += 0x7FFFu + ((u >> 16) & 1u); return (bf16_t)(u >> 16); }
DEVI float bf2f(bf16_t h) { return __uint_as_float(((unsigned)h) << 16); }
DEVI unsigned pack2(float a, float b) { return (unsigned)f2bf(a) | ((unsigned)f2bf(b) << 16); }
DEVI u32x4 pack8f(const f32x4 a, const f32x4 b) { u32x4 r; r[0] = pack2(a[0], a[1]); r[1] = pack2(a[2], a[3]); r[2] = pack2(b[0], b[1]); r[3] = pack2(b[2], b[3]); return r; }
DEVI float wave_max(float v) { for (int o = 32; o > 0; o >>= 1) v = fmaxf(v, __shfl_xor(v, o)); return v; }
DEVI float wave_sum(float v) { for (int o = 32; o > 0; o >>= 1) v += __shfl_xor(v, o); return v; }
DEVI float sigmoidf_(float x) { return 1.f / (1.f + __expf(-x)); }
DEVI float logsigmoidf_(float x) { return fminf(x, 0.f) - log1pf(__expf(-fabsf(x))); }
DEVI int win_map(int np) {
    if (np < 2048) return np;
    if (np < 5632) return np + 8;
    if (np < 5640) return np - 5632 + 2048;
    if (np < 5688) return np;
    return -1;
}
DEVI float alibi_slope(int h) { return exp2f(-0.5f * (float)(h + 1)); }

template <class MapFn>
DEVI void transpose_cvt(const float* __restrict__ W, bf16_t* __restrict__ WT, int K, int Nsrc, int Ndst, MapFn mapfn, float* tile  , int bid, int nblk) {
    const int tid = threadIdx.x;
    const int tn = Ndst / 64, tk = K / 64;
    for (int t = bid; t < tn * tk; t += nblk) {
        const int n0 = (t % tn) * 64, k0 = (t / tn) * 64;
        __syncthreads();
#pragma unroll
        for (int i = 0; i < 8; ++i) {
            const int kk = (tid >> 6) + i * 8, nn = tid & 63;
            const int n = mapfn(n0 + nn);
            tile[kk * 65 + nn] = n >= 0 ? W[(size_t)(k0 + kk) * Nsrc + n] : 0.f;
        }
        __syncthreads();
#pragma unroll
        for (int i = 0; i < 8; ++i) {
            const int nn = (tid >> 6) + i * 8, kk = tid & 63;
            WT[(size_t)(n0 + nn) * K + k0 + kk] = f2bf(tile[kk * 65 + nn]);
        }
    }
}
struct IdMap { DEVI int operator()(int n) const { return n; } };
struct WinMap { DEVI int operator()(int n) const { return win_map(n); } };

DEVI void cvt_rows(const float* __restrict__ src, bf16_t* __restrict__ dst, size_t n4, int bid, int nblk) {
    for (size_t i = (size_t)bid * blockDim.x + threadIdx.x; i < n4; i += (size_t)nblk * blockDim.x) {
        const f32x4 v = ((const f32x4*)src)[i];
        u32x2 o; o.x = pack2(v.x, v.y); o.y = pack2(v.z, v.w);
        ((u32x2*)dst)[i] = o;
    }
}

DEVI void stage_prologue(const P& p, char* smem, int bid, int nblk) {
    float* tile = (float*)smem;
    cvt_rows(p.xp, p.XB, (size_t)NTP * 256, bid, nblk);
    cvt_rows(p.xs, p.XB + (size_t)NTP * 1024, (size_t)NTS * 256, bid, nblk);
    cvt_rows(p.peer_u, p.UB, (size_t)16384 * 256, bid, nblk);
    cvt_rows(p.peer_v, p.VB, (size_t)16384 * 256, bid, nblk);
    cvt_rows(p.peer_keys, p.KEYSB, (size_t)16 * 128 * 128 / 4, bid, nblk);
    transpose_cvt(p.w_in, p.WINT, 1024, 5688, NPAD_IN, WinMap(), tile, bid, nblk);
    transpose_cvt(p.w_merge, p.WMT, 1024, 2048, 2048, IdMap(), tile, bid, nblk);
    transpose_cvt(p.w_br_a, p.WAT, 1024, 1024, 1024, IdMap(), tile, bid, nblk);
    transpose_cvt(p.w_br_b, p.WBT, 1024, 1024, 1024, IdMap(), tile, bid, nblk);
    transpose_cvt(p.w_out, p.WOT, 1024, 1024, 1024, IdMap(), tile, bid, nblk);
    transpose_cvt(p.peer_wq, p.WQT, 1024, 2048, 2048, IdMap(), tile, bid, nblk);
    transpose_cvt(p.nsa_w_cmp, p.WCT, 4096, 64, 64, IdMap(), tile, bid, nblk);
    transpose_cvt(p.nsa_w_cmp + 4096 * 64, p.WCT + 64 * 4096, 4096, 64, 64, IdMap(), tile, bid, nblk);
    for (int blk = bid; blk < 32; blk += nblk) {
        const int tid = threadIdx.x, kvv = tid >> 8, e = tid & 63, kq = (tid >> 6) & 3;
        float a = 0.f;
        for (int k = blk * 128 + kq * 32; k < blk * 128 + kq * 32 + 32; ++k) a += p.nsa_pe[kvv * 4096 + k] * p.nsa_w_cmp[((size_t)kvv * 4096 + k) * 64 + e];
        atomicAdd(p.PW + kvv * 64 + e, a);
    }
    {
        const size_t per_b = (size_t)508 * 512 / 4;
        for (size_t i = (size_t)bid * blockDim.x + threadIdx.x; i < 128 * per_b; i += (size_t)nblk * blockDim.x) {
            const size_t b = i / per_b, r = i % per_b;
            ((f32x4*)(p.out + O_SWIN + b * 512 * 512))[r] = ((const f32x4*)(p.cache_win + b * 512 * 512 + 4 * 512))[r];
        }
    }
}

template <class Epi>
DEVI void gemm_phase(const bf16_t* __restrict__ A, const bf16_t* __restrict__ Bt, int M, int N, int K, const Epi& epi, char* smem, int bid, int nblk) {
    bf16_t* As = (bf16_t*)smem;
    bf16_t* Bs = As + 256 * 72;
    const int tid = threadIdx.x, lane = tid & 63, wid = tid >> 6, wm = wid >> 1, wn = wid & 1;
    const int fr = lane & 15, fq = lane >> 4;
    const int ntm = M / 256, ntn = N / 128, nk = K / 64;
    for (int tile = bid; tile < ntm * ntn; tile += nblk) {
        const int tm = tile / ntn, tn = tile % ntn;
        f32x4 acc[4][4];
#pragma unroll
        for (int i = 0; i < 4; ++i)
#pragma unroll
            for (int j = 0; j < 4; ++j) acc[i][j] = (f32x4){0.f, 0.f, 0.f, 0.f};
        const bf16_t* Ag = A + (size_t)(tm * 256 + (tid >> 1)) * K + (tid & 1) * 32;
        const bf16_t* Bg = Bt + (size_t)(tn * 128 + (tid >> 2)) * K + (tid & 3) * 16;
        u32x4 ra[4], rb[2];
#pragma unroll
        for (int i = 0; i < 4; ++i) ra[i] = *(const u32x4*)(Ag + i * 8);
#pragma unroll
        for (int i = 0; i < 2; ++i) rb[i] = *(const u32x4*)(Bg + i * 8);
        for (int kt = 0; kt < nk; ++kt) {
            __syncthreads();
#pragma unroll
            for (int i = 0; i < 4; ++i) *(u32x4*)(As + (tid >> 1) * 72 + (tid & 1) * 32 + i * 8) = ra[i];
#pragma unroll
            for (int i = 0; i < 2; ++i) *(u32x4*)(Bs + (tid >> 2) * 72 + (tid & 3) * 16 + i * 8) = rb[i];
            __syncthreads();
            if (kt + 1 < nk) {
#pragma unroll
                for (int i = 0; i < 4; ++i) ra[i] = *(const u32x4*)(Ag + (kt + 1) * 64 + i * 8);
#pragma unroll
                for (int i = 0; i < 2; ++i) rb[i] = *(const u32x4*)(Bg + (kt + 1) * 64 + i * 8);
            }
#pragma unroll
            for (int ks = 0; ks < 2; ++ks) {
                bf16x8 af[4], bfr[4];
#pragma unroll
                for (int i = 0; i < 4; ++i) af[i] = *(const bf16x8*)(As + (wm * 64 + i * 16 + fr) * 72 + ks * 32 + fq * 8);
#pragma unroll
                for (int j = 0; j < 4; ++j) bfr[j] = *(const bf16x8*)(Bs + (wn * 64 + j * 16 + fr) * 72 + ks * 32 + fq * 8);
#pragma unroll
                for (int i = 0; i < 4; ++i)
#pragma unroll
                    for (int j = 0; j < 4; ++j) acc[i][j] = __builtin_amdgcn_mfma_f32_16x16x32_bf16(bfr[j], af[i], acc[i][j], 0, 0, 0);
            }
        }
#pragma unroll
        for (int i = 0; i < 4; ++i)
#pragma unroll
            for (int j = 0; j < 4; ++j) epi(tm * 256 + wm * 64 + i * 16 + fr, tn * 128 + wn * 64 + j * 16 + fq * 4, acc[i][j]);
    }
}

struct NoPre {};
struct EpiInProj {
    P p;
    typedef f32x4 Pre;
    static constexpr int BATCH = 0;
    DEVI Pre pre(int row, int col) const {
        f32x4 b = {0.f, 0.f, 0.f, 0.f};
        if (col < 5688) { const int oc = win_map(col);
#pragma unroll
            for (int q = 0; q < 4; ++q) b[q] = p.b_in[oc + q]; }
        return b;
    }
    DEVI void put(int row, int col, f32x4 v, const Pre& bias) const {
        if (col >= 5688) return;
        v += bias;
        if (col >= 5632) { *(f32x4*)(p.SM + (size_t)row * 64 + (col - 5632)) = v; return; }
        if (col >= C_AK && col < C_AV) v *= 0.08838834764831845f;
        u32x2 o; o.x = pack2(v[0], v[1]); o.y = pack2(v[2], v[3]);
        *(u32x2*)(p.PROJ + (size_t)row * PS + col) = o;
        if (col >= C_CMP) {
            const int reg = (col - C_CMP) >> 9, c = (col - C_CMP) & 511;
            float* dst = nullptr;
            if (row < NTP) {
                if (reg == 0) dst = p.out + O_PCMP + (size_t)row * 512 + c;
                else if (reg == 1) dst = p.out + O_PSLC + (size_t)row * 512 + c;
                else { const int b = row >> 12, t = row & 4095; if (t >= 3584) dst = p.out + O_PWIN + ((size_t)b * 512 + (t - 3584)) * 512 + c; }
            } else {
                const int rs = row - NTP;
                if (reg == 0) dst = p.out + O_SCMP + (size_t)rs * 512 + c;
                else if (reg == 1) dst = p.out + O_SSLC + (size_t)rs * 512 + c;
                else { const int b = rs >> 2, tq = rs & 3; dst = p.out + O_SWIN + ((size_t)b * 512 + 508 + tq) * 512 + c; }
            }
            if (dst) *(f32x4*)dst = v;
        }
    }
};
struct EpiG {
    P p;
    typedef NoPre Pre;
    static constexpr int BATCH = 4;
    DEVI Pre pre(int, int) const { return NoPre(); }
    DEVI void put(int row, int col, f32x4 v, const Pre&) const {
        u32x2 o; o.x = pack2(sigmoidf_(v[0]), sigmoidf_(v[1])); o.y = pack2(sigmoidf_(v[2]), sigmoidf_(v[3]));
        *(u32x2*)(p.G + (size_t)row * 2048 + col) = o;
    }
};
struct EpiM1 {
    P p;
    typedef u32x2 Pre;
    static constexpr int BATCH = 16;
    DEVI Pre pre(int row, int col) const { return *(const u32x2*)(p.G + (size_t)row * 2048 + col); }
    DEVI void put(int row, int col, f32x4 v, const Pre& g) const {
        v[0] *= __uint_as_float(g.x << 16); v[1] *= __uint_as_float(g.x & 0xFFFF0000u);
        v[2] *= __uint_as_float(g.y << 16); v[3] *= __uint_as_float(g.y & 0xFFFF0000u);
        *(f32x4*)(p.TMP + (size_t)row * 1024 + col) = v;
    }
};
struct PreM2 { u32x2 g; f32x4 t; };
struct EpiM2 {
    P p;
    typedef PreM2 Pre;
    static constexpr int BATCH = 8;
    DEVI Pre pre(int row, int col) const { PreM2 r; r.g = *(const u32x2*)(p.G + (size_t)row * 2048 + 1024 + col); r.t = *(const f32x4*)(p.TMP + (size_t)row * 1024 + col); return r; }
    DEVI void put(int row, int col, f32x4 v, const Pre& q) const {
        v[0] = q.t[0] + v[0] * __uint_as_float(q.g.x << 16); v[1] = q.t[1] + v[1] * __uint_as_float(q.g.x & 0xFFFF0000u);
        v[2] = q.t[2] + v[2] * __uint_as_float(q.g.y << 16); v[3] = q.t[3] + v[3] * __uint_as_float(q.g.y & 0xFFFF0000u);
        u32x2 o; o.x = pack2(v[0], v[1]); o.y = pack2(v[2], v[3]);
        *(u32x2*)(p.MERGED + (size_t)row * 1024 + col) = o;
    }
};
struct EpiR {
    P p;
    typedef f32x4 Pre;
    static constexpr int BATCH = 16;
    DEVI Pre pre(int row, int col) const {
        const float* xr = row < NTP ? p.xp + (size_t)row * 1024 : p.xs + (size_t)(row - NTP) * 1024;
        return *(const f32x4*)(xr + col);
    }
    DEVI void put(int row, int col, f32x4 v, const Pre& x) const { *(f32x4*)(p.R + (size_t)row * 1024 + col) = x * DN_ALPHA + v; }
};
struct EpiPQ {
    P p;
    typedef NoPre Pre;
    static constexpr int BATCH = 4;
    DEVI Pre pre(int, int) const { return NoPre(); }
    DEVI void put(int row, int col, f32x4 v, const Pre&) const {
        u32x2 o; o.x = pack2(v[0], v[1]); o.y = pack2(v[2], v[3]);
        *(u32x2*)(p.PQ + (size_t)row * 2048 + col) = o;
    }
};

DEVI void stage_mlstm_gates(const P& p, char* smem, int bid, int nblk) {
    const int lane = threadIdx.x & 63, wid = threadIdx.x >> 6;
    float* bend_s = (float*)smem; float* mloc_s = bend_s + 64;
    for (int bh = bid; bh < 16; bh += nblk) {
        const int b = bh >> 2, h = bh & 3;
        __syncthreads();
        for (int cc = 0; cc < 8; ++cc) {
            const int c = wid * 8 + cc;
            const size_t row = (size_t)b * 4096 + c * 64 + lane;
            const float ip = p.SM[row * 64 + h];
            const float lf = logsigmoidf_(p.SM[row * 64 + 4 + h]);
            float cs = lf;
#pragma unroll
            for (int o = 1; o < 64; o <<= 1) { const float t = __shfl_up(cs, o); if (lane >= o) cs += t; }
            p.BCUM[bh * 4096 + c * 64 + lane] = cs;
            const float bend = __shfl(cs, 63);
            const float mloc = wave_max(bend - cs + ip);
            if (lane == 0) { bend_s[c] = bend; mloc_s[c] = mloc; }
        }
        __syncthreads();
        if (threadIdx.x == 0) {
            float m = 0.f;
            for (int c = 0; c < 64; ++c) {
                const float bend = bend_s[c], mloc = mloc_s[c];
                const float mnew = fmaxf(bend + m, mloc);
                p.MPREV[bh * 64 + c] = m;
                p.ACOEF[bh * 64 + c] = __expf(bend + m - mnew);
                p.SCL[bh * 64 + c] = __expf(mloc - mnew);
                p.MLOC[bh * 64 + c] = mloc;
                m = mnew;
            }
            p.out[O_PM + bh] = m;
        }
    }
}

constexpr int MD_KT = 0, MD_VT = 128 * 144, MD_WS = MD_VT + 272 * 144, MD_LDS = MD_WS + 256;
DEVI void stage_mlstm_dc(const P& p, char* smem, int bid, int nblk) {
    const int tid = threadIdx.x, lane = tid & 63, wid = tid >> 6, fr = lane & 15, fq = lane >> 4;
    bf16_t* Kt = (bf16_t*)(smem + MD_KT);
    bf16_t* Vt = (bf16_t*)(smem + MD_VT);
    float* ws = (float*)(smem + MD_WS);
    for (int task = bid; task < 1024; task += nblk) {
        const int bh = task >> 6, c = task & 63, b = bh >> 2, h = bh & 3;
        const size_t row0 = (size_t)b * 4096 + c * 64;
        __syncthreads();
        if (tid < 64) {
            const float bend = p.BCUM[bh * 4096 + c * 64 + 63];
            const float g = bend - p.BCUM[bh * 4096 + c * 64 + tid] + p.SM[(row0 + tid) * 64 + h];
            ws[tid] = __expf(g - p.MLOC[task]);
        }
        __syncthreads();
        {
            const int sidx = tid & 63, ch = tid >> 6;
            const float w = ws[sidx];
#pragma unroll
            for (int half = 0; half < 2; ++half) {
                const u32x4 kk = *(const u32x4*)(p.PROJ + (row0 + sidx) * PS + C_AK + h * 128 + half * 64 + ch * 8);
#pragma unroll
                for (int e = 0; e < 4; ++e) {
                    Kt[(half * 64 + ch * 8 + e * 2) * 72 + sidx] = f2bf(w * __uint_as_float(kk[e] << 16));
                    Kt[(half * 64 + ch * 8 + e * 2 + 1) * 72 + sidx] = f2bf(w * __uint_as_float(kk[e] & 0xFFFF0000u));
                }
            }
#pragma unroll
            for (int q4 = 0; q4 < 4; ++q4) {
                const u32x4 vv = *(const u32x4*)(p.PROJ + (row0 + sidx) * PS + C_AV + h * 256 + q4 * 64 + ch * 8);
#pragma unroll
                for (int e = 0; e < 4; ++e) {
                    Vt[(q4 * 64 + ch * 8 + e * 2) * 72 + sidx] = (bf16_t)(vv[e] & 0xFFFFu);
                    Vt[(q4 * 64 + ch * 8 + e * 2 + 1) * 72 + sidx] = (bf16_t)(vv[e] >> 16);
                }
            }
            for (int i = tid; i < 16 * 64; i += 512) Vt[(256 + (i >> 6)) * 72 + (i & 63)] = (i >> 6) == 0 ? (bf16_t)0x3F80 : (bf16_t)0;
        }
        __syncthreads();
        const int nvt = wid == 0 ? 3 : 2;
        for (int vi = 0; vi < nvt; ++vi) {
            const int vt = vi < 2 ? wid * 2 + vi : 16;
            f32x4 acc[8];
#pragma unroll
            for (int dt = 0; dt < 8; ++dt) acc[dt] = (f32x4){0.f, 0.f, 0.f, 0.f};
#pragma unroll
            for (int ks = 0; ks < 2; ++ks) {
                const bf16x8 bf = *(const bf16x8*)(Vt + (vt * 16 + fr) * 72 + ks * 32 + fq * 8);
#pragma unroll
                for (int dt = 0; dt < 8; ++dt) {
                    const bf16x8 af = *(const bf16x8*)(Kt + (dt * 16 + fr) * 72 + ks * 32 + fq * 8);
                    acc[dt] = __builtin_amdgcn_mfma_f32_16x16x32_bf16(af, bf, acc[dt], 0, 0, 0);
                }
            }
            const int v = vt * 16 + fr;
            if (v <= 256) {
#pragma unroll
                for (int dt = 0; dt < 8; ++dt) *(f32x4*)(p.DC + ((size_t)task * 272 + v) * 128 + dt * 16 + fq * 4) = acc[dt];
            }
        }
    }
}

DEVI void stage_mlstm_scan(const P& p, int bid, int nblk) {
    for (int e = bid * blockDim.x + threadIdx.x; e < 16 * 257 * 128; e += nblk * blockDim.x) {
        const int bh = e / (257 * 128), r = e % (257 * 128), v = r >> 7, d = r & 127;
        float C = 0.f;
#pragma unroll 8
        for (int c = 0; c < 64; ++c) {
            const size_t idx = ((size_t)(bh * 64 + c) * 272 + v) * 128 + d;
            p.CPT[idx] = f2bf(C);
            C = p.ACOEF[bh * 64 + c] * C + p.SCL[bh * 64 + c] * p.DC[idx];
        }
        if (v < 256) p.out[O_PC + ((size_t)bh * 128 + d) * 256 + v] = C; else p.out[O_PN + bh * 128 + d] = C;
    }
}

constexpr int MO_Q = 0, MO_K = 64 * 272, MO_VT = MO_K + 64 * 272, MO_P = MO_VT + 272 * 144, MO_SC = MO_P + 64 * 144, MO_HS = MO_SC + 2048, MO_LDS = MO_HS + 64 * 256 * 4;
static_assert(MO_LDS <= 152 * 1024, "lds");
DEVI void stage_mlstm_out(const P& p, char* smem, int bid, int nblk) {
    const int tid = threadIdx.x, lane = tid & 63, wid = tid >> 6, fr = lane & 15, fq = lane >> 4;
    bf16_t* Qs = (bf16_t*)(smem + MO_Q);
    bf16_t* Ks = (bf16_t*)(smem + MO_K);
    bf16_t* Vt = (bf16_t*)(smem + MO_VT);
    bf16_t* Ps = (bf16_t*)(smem + MO_P);
    float* sc = (float*)(smem + MO_SC);
    float* rowt = sc; float* colt = sc + 64; float* wint = sc + 128; float* emt = sc + 192; float* den = sc + 256;
    float* hs = (float*)(smem + MO_HS);
    for (int task = bid; task < 1024; task += nblk) {
        const int bh = task >> 6, c = task & 63, b = bh >> 2, h = bh & 3;
        const size_t row0 = (size_t)b * 4096 + c * 64;
        __syncthreads();
        {
            for (int i = tid; i < 64 * 16; i += 512) {
                const int t = i >> 4, ch = i & 15;
                *(u32x4*)(Qs + t * 136 + ch * 8) = *(const u32x4*)(p.PROJ + (row0 + t) * PS + C_AQ + h * 128 + ch * 8);
                *(u32x4*)(Ks + t * 136 + ch * 8) = *(const u32x4*)(p.PROJ + (row0 + t) * PS + C_AK + h * 128 + ch * 8);
            }
            const int sidx = tid & 63, ch = tid >> 6;
#pragma unroll
            for (int q4 = 0; q4 < 4; ++q4) {
                const u32x4 vv = *(const u32x4*)(p.PROJ + (row0 + sidx) * PS + C_AV + h * 256 + q4 * 64 + ch * 8);
#pragma unroll
                for (int e = 0; e < 4; ++e) {
                    Vt[(q4 * 64 + ch * 8 + e * 2) * 72 + sidx] = (bf16_t)(vv[e] & 0xFFFFu);
                    Vt[(q4 * 64 + ch * 8 + e * 2 + 1) * 72 + sidx] = (bf16_t)(vv[e] >> 16);
                }
            }
            for (int i = tid; i < 16 * 64; i += 512) Vt[(256 + (i >> 6)) * 72 + (i & 63)] = (i >> 6) == 0 ? (bf16_t)0x3F80 : (bf16_t)0;
            if (wid == 0) {
                const float bc = p.BCUM[bh * 4096 + c * 64 + lane], ip = p.SM[(row0 + lane) * 64 + h];
                const float mprev = p.MPREV[task];
                float pm = ip - bc;
#pragma unroll
                for (int o = 1; o < 64; o <<= 1) { const float t = __shfl_up(pm, o); if (lane >= o) pm = fmaxf(pm, t); }
                const float mt = fmaxf(bc + mprev, bc + pm);
                rowt[lane] = bc - mt; colt[lane] = ip - bc; wint[lane] = __expf(bc + mprev - mt); emt[lane] = __expf(-mt);
            }
        }
        __syncthreads();
        {
            const int tt = wid >> 1;
#pragma unroll
            for (int si = 0; si < 2; ++si) {
                const int st = (wid & 1) * 2 + si;
                f32x4 acc = (f32x4){0.f, 0.f, 0.f, 0.f};
                if (st <= tt) {
#pragma unroll
                    for (int ks = 0; ks < 4; ++ks) {
                        const bf16x8 af = *(const bf16x8*)(Qs + (tt * 16 + fr) * 136 + ks * 32 + fq * 8);
                        const bf16x8 bf = *(const bf16x8*)(Ks + (st * 16 + fr) * 136 + ks * 32 + fq * 8);
                        acc = __builtin_amdgcn_mfma_f32_16x16x32_bf16(af, bf, acc, 0, 0, 0);
                    }
                }
                const int s = st * 16 + fr; const float ct = colt[s];
#pragma unroll
                for (int r = 0; r < 4; ++r) {
                    const int t = tt * 16 + fq * 4 + r;
                    const float pv = (s <= t) ? acc[r] * __expf(rowt[t] + ct) : 0.f;
                    Ps[t * 72 + s] = f2bf(pv);
                }
            }
        }
        __syncthreads();
        {
            const bf16_t* cpt = p.CPT + (size_t)task * 272 * 128;
            f32x4 acc[4][2];
#pragma unroll
            for (int tt = 0; tt < 4; ++tt)
#pragma unroll
                for (int vi = 0; vi < 2; ++vi) acc[tt][vi] = (f32x4){0.f, 0.f, 0.f, 0.f};
            f32x4 accd = (f32x4){0.f, 0.f, 0.f, 0.f};
#pragma unroll
            for (int ks = 0; ks < 4; ++ks) {
                bf16x8 af[4];
#pragma unroll
                for (int tt = 0; tt < 4; ++tt) af[tt] = *(const bf16x8*)(Qs + (tt * 16 + fr) * 136 + ks * 32 + fq * 8);
#pragma unroll
                for (int vi = 0; vi < 2; ++vi) {
                    const bf16x8 bf = *(const bf16x8*)(cpt + (size_t)((wid * 2 + vi) * 16 + fr) * 128 + ks * 32 + fq * 8);
#pragma unroll
                    for (int tt = 0; tt < 4; ++tt) acc[tt][vi] = __builtin_amdgcn_mfma_f32_16x16x32_bf16(af[tt], bf, acc[tt][vi], 0, 0, 0);
                }
                if (wid < 4) {
                    const bf16x8 bf = *(const bf16x8*)(cpt + (size_t)(256 + fr) * 128 + ks * 32 + fq * 8);
                    const bf16x8 a2 = *(const bf16x8*)(Qs + (wid * 16 + fr) * 136 + ks * 32 + fq * 8);
                    accd = __builtin_amdgcn_mfma_f32_16x16x32_bf16(a2, bf, accd, 0, 0, 0);
                }
            }
#pragma unroll
            for (int tt = 0; tt < 4; ++tt) {
                const f32x4 wv = *(const f32x4*)(wint + tt * 16 + fq * 4);
#pragma unroll
                for (int vi = 0; vi < 2; ++vi) acc[tt][vi] *= wv;
            }
            if (wid < 4) accd *= *(const f32x4*)(wint + wid * 16 + fq * 4);
#pragma unroll
            for (int ks = 0; ks < 2; ++ks) {
                bf16x8 af[4];
#pragma unroll
                for (int tt = 0; tt < 4; ++tt) af[tt] = *(const bf16x8*)(Ps + (tt * 16 + fr) * 72 + ks * 32 + fq * 8);
#pragma unroll
                for (int vi = 0; vi < 2; ++vi) {
                    const bf16x8 bf = *(const bf16x8*)(Vt + ((wid * 2 + vi) * 16 + fr) * 72 + ks * 32 + fq * 8);
#pragma unroll
                    for (int tt = 0; tt < 4; ++tt) acc[tt][vi] = __builtin_amdgcn_mfma_f32_16x16x32_bf16(af[tt], bf, acc[tt][vi], 0, 0, 0);
                }
                if (wid < 4) {
                    const bf16x8 bf = *(const bf16x8*)(Vt + (256 + fr) * 72 + ks * 32 + fq * 8);
                    const bf16x8 a2 = *(const bf16x8*)(Ps + (wid * 16 + fr) * 72 + ks * 32 + fq * 8);
                    accd = __builtin_amdgcn_mfma_f32_16x16x32_bf16(a2, bf, accd, 0, 0, 0);
                }
            }
            if (wid < 4 && fr == 0) *(f32x4*)(den + wid * 16 + fq * 4) = accd;
            __syncthreads();
#pragma unroll
            for (int tt = 0; tt < 4; ++tt) {
                const f32x4 dv = *(const f32x4*)(den + tt * 16 + fq * 4), ev = *(const f32x4*)(emt + tt * 16 + fq * 4);
#pragma unroll
                for (int vi = 0; vi < 2; ++vi)
#pragma unroll
                    for (int r = 0; r < 4; ++r) hs[(tt * 16 + fq * 4 + r) * 256 + (wid * 2 + vi) * 16 + fr] = acc[tt][vi][r] / fmaxf(fabsf(dv[r]), ev[r]);
            }
        }
        __syncthreads();
        for (int rr = 0; rr < 8; ++rr) {
            const int t = wid * 8 + rr;
            const f32x4 x = *(const f32x4*)(hs + t * 256 + lane * 4);
            const float mean = wave_sum(x[0] + x[1] + x[2] + x[3]) * (1.f / 256.f);
            float q = 0.f;
#pragma unroll
            for (int k = 0; k < 4; ++k) q += (x[k] - mean) * (x[k] - mean);
            const float rs = rsqrtf(wave_sum(q) * (1.f / 256.f) + LN_EPS);
            const u32x2 ov = *(const u32x2*)(p.PROJ + (row0 + t) * PS + C_AO + h * 256 + lane * 4);
            const f32x4 gg = *(const f32x4*)(p.norm_a_g + h * 256 + lane * 4);
            const float o4[4] = {__uint_as_float(ov.x << 16), __uint_as_float(ov.x & 0xFFFF0000u), __uint_as_float(ov.y << 16), __uint_as_float(ov.y & 0xFFFF0000u)};
            float y[4];
#pragma unroll
            for (int k = 0; k < 4; ++k) y[k] = (x[k] - mean) * rs * gg[k] * sigmoidf_(o4[k]);
            u32x2 o2; o2.x = pack2(y[0], y[1]); o2.y = pack2(y[2], y[3]);
            *(u32x2*)(p.YA + (row0 + t) * 1024 + h * 256 + lane * 4) = o2;
        }
    }
}

DEVI void stage_mlstm_sample(const P& p, char* smem, int bid, int nblk) {
    float* qs = (float*)smem;
    float* ks = qs + 512;
    float* vs = ks + 512;
    float* part = vs + 1024;
    float* hs = part + 2048;
    float* sc = hs + 1024;
    float* bc = sc; float* ip = sc + 4; float* mt = sc + 8; float* wint = sc + 12; float* emt = sc + 16; float* ww = sc + 20; float* den = sc + 24;
    float* Pm = sc + 32;
    float* misc = sc + 48;
    const int tid = threadIdx.x, lane = tid & 63, wid = tid >> 6;
    for (int task = bid; task < 512; task += nblk) {
        const int b = task >> 2, h = task & 3;
        const size_t row0 = (size_t)NTP + b * 4;
        __syncthreads();
        { const int t = tid >> 7, d = tid & 127;
          qs[tid] = bf2f(p.PROJ[(row0 + t) * PS + C_AQ + h * 128 + d]);
          ks[tid] = bf2f(p.PROJ[(row0 + t) * PS + C_AK + h * 128 + d]); }
        for (int idx = tid; idx < 1024; idx += 512) { const int t = idx >> 8, v = idx & 255; vs[idx] = bf2f(p.PROJ[(row0 + t) * PS + C_AV + h * 256 + v]); }
        if (tid == 0) {
            const float m0 = p.state_m[task];
            float cs = 0.f;
            for (int t = 0; t < 4; ++t) { cs += logsigmoidf_(p.SM[(row0 + t) * 64 + 4 + h]); bc[t] = cs; ip[t] = p.SM[(row0 + t) * 64 + h]; }
            for (int t = 0; t < 4; ++t) {
                float mx = bc[t] + m0;
                for (int s = 0; s <= t; ++s) mx = fmaxf(mx, bc[t] - bc[s] + ip[s]);
                mt[t] = mx; wint[t] = __expf(bc[t] + m0 - mx); emt[t] = __expf(-mx);
            }
            const float bend = bc[3];
            float mnew = bend + m0;
            for (int s = 0; s < 4; ++s) mnew = fmaxf(mnew, bend - bc[s] + ip[s]);
            misc[0] = __expf(bend + m0 - mnew);
            for (int s = 0; s < 4; ++s) ww[s] = __expf(bend - bc[s] + ip[s] - mnew);
            p.out[O_SM + task] = mnew;
        }
        __syncthreads();
        if (tid < 16) {
            const int t = tid >> 2, s = tid & 3;
            float a = 0.f;
            if (s <= t) { for (int d = 0; d < 128; ++d) a += qs[t * 128 + d] * ks[s * 128 + d]; a *= __expf(bc[t] - bc[s] + ip[s] - mt[t]); }
            Pm[tid] = a;
        }
        __syncthreads();
        if (tid < 4) {
            const int t = tid; float qn = 0.f;
            for (int d = 0; d < 128; ++d) qn += qs[t * 128 + d] * p.state_n[(size_t)task * 128 + d];
            den[t] = wint[t] * qn + Pm[t * 4] + Pm[t * 4 + 1] + Pm[t * 4 + 2] + Pm[t * 4 + 3];
        }
        const float a = misc[0];
        if (tid >= 128 && tid < 256) {
            const int d = tid - 128;
            float n = a * p.state_n[(size_t)task * 128 + d];
            for (int s = 0; s < 4; ++s) n += ww[s] * ks[s * 128 + d];
            p.out[O_SN + (size_t)task * 128 + d] = n;
        }
        {
            const int v = tid & 255, dh = tid >> 8;
            float acc[4] = {0.f, 0.f, 0.f, 0.f};
            float wv[4];
#pragma unroll
            for (int s = 0; s < 4; ++s) wv[s] = ww[s] * vs[s * 256 + v];
            for (int d = dh * 64; d < dh * 64 + 64; ++d) {
                const size_t ci = ((size_t)task * 128 + d) * 256 + v;
                const float c0 = p.state_C[ci];
#pragma unroll
                for (int t = 0; t < 4; ++t) acc[t] += qs[t * 128 + d] * c0;
                float cn = a * c0;
#pragma unroll
                for (int s = 0; s < 4; ++s) cn += ks[s * 128 + d] * wv[s];
                p.out[O_SC + ci] = cn;
            }
#pragma unroll
            for (int t = 0; t < 4; ++t) part[(dh * 4 + t) * 256 + v] = acc[t];
        }
        __syncthreads();
        if (tid < 256) {
            const int v = tid;
#pragma unroll
            for (int t = 0; t < 4; ++t) {
                float num = wint[t] * (part[t * 256 + v] + part[(4 + t) * 256 + v]);
#pragma unroll
                for (int s = 0; s < 4; ++s) num += Pm[t * 4 + s] * vs[s * 256 + v];
                hs[t * 256 + v] = num / fmaxf(fabsf(den[t]), emt[t]);
            }
        }
        __syncthreads();
        if (wid < 4) {
            const int t = wid;
            const f32x4 x = *(const f32x4*)(hs + t * 256 + lane * 4);
            const float mean = wave_sum(x[0] + x[1] + x[2] + x[3]) * (1.f / 256.f);
            float q = 0.f;
#pragma unroll
            for (int k = 0; k < 4; ++k) q += (x[k] - mean) * (x[k] - mean);
            const float rs = rsqrtf(wave_sum(q) * (1.f / 256.f) + LN_EPS);
            float y[4];
#pragma unroll
            for (int k = 0; k < 4; ++k) {
                const int vi = lane * 4 + k;
                const float o = bf2f(p.PROJ[(row0 + t) * PS + C_AO + h * 256 + vi]);
                y[k] = (x[k] - mean) * rs * p.norm_a_g[h * 256 + vi] * sigmoidf_(o);
            }
            u32x2 o2; o2.x = pack2(y[0], y[1]); o2.y = pack2(y[2], y[3]);
            *(u32x2*)(p.YA + (row0 + t) * 1024 + h * 256 + lane * 4) = o2;
        }
    }
}

DEVI void stage_compress(const P& p, int bid, int nblk) {
    const int tid = threadIdx.x, lane = tid & 63, wid = tid >> 6, fr = lane & 15, fq = lane >> 4;
    const int kv = wid & 1, rt = wid >> 1;
    for (int task = bid; task < 272; task += nblk) {
        const bool prompt = task >= 256;
        const int bi = rt * 4 + (fr >> 2), g = fr & 3;
        const char* abase; int rstride; int oblk;
        if (prompt) { const int blk = (task - 256) * 16 + bi; abase = (const char*)(p.PROJ + (size_t)blk * 64 * PS + C_CMP + kv * 256 + g * 64 + fq * 8); rstride = PS * 2; oblk = blk; }
        else { const int gb = task * 16 + bi, b = gb >> 5, n = gb & 31; const int page = p.page_table[b * 16 + (n >> 1)];
               abase = (const char*)(p.cache_cmp + ((size_t)page * 128 + (n & 1) * 64) * 512 + kv * 256 + g * 64 + fq * 8); rstride = 2048; oblk = 256 + gb; }
        const bf16_t* wb = p.WCT + ((size_t)kv * 64 + fr) * 4096 + fq * 8;
        f32x4 acc[4];
#pragma unroll
        for (int nt = 0; nt < 4; ++nt) acc[nt] = (f32x4){0.f, 0.f, 0.f, 0.f};
        if (prompt) {
#pragma unroll 2
            for (int l = 0; l < 64; ++l) {
                const char* ar = abase + (size_t)l * rstride;
                bf16x8 a[2];
#pragma unroll
                for (int hf = 0; hf < 2; ++hf) a[hf] = *(const bf16x8*)(ar + hf * 64);
#pragma unroll
                for (int hf = 0; hf < 2; ++hf)
#pragma unroll
                    for (int nt = 0; nt < 4; ++nt) {
                        const bf16x8 bfrag = *(const bf16x8*)(wb + (size_t)nt * 16 * 4096 + l * 64 + hf * 32);
                        acc[nt] = __builtin_amdgcn_mfma_f32_16x16x32_bf16(a[hf], bfrag, acc[nt], 0, 0, 0);
                    }
            }
        } else {
            f32x4 an[8];
#pragma unroll
            for (int i = 0; i < 8; ++i) an[i] = *(const f32x4*)(abase + (size_t)(i >> 2) * rstride + ((i >> 1) & 1) * 128 + (i & 1) * 16);
#pragma unroll 1
            for (int l = 0; l < 64; l += 2) {
                f32x4 ac[8];
#pragma unroll
                for (int i = 0; i < 8; ++i) ac[i] = an[i];
                if (l + 2 < 64) {
#pragma unroll
                    for (int i = 0; i < 8; ++i) an[i] = *(const f32x4*)(abase + (size_t)(l + 2 + (i >> 2)) * rstride + ((i >> 1) & 1) * 128 + (i & 1) * 16);
                }
#pragma unroll
                for (int ll = 0; ll < 2; ++ll)
#pragma unroll
                    for (int hf = 0; hf < 2; ++hf) {
                        const bf16x8 a = __builtin_bit_cast(bf16x8, pack8f(ac[ll * 4 + hf * 2], ac[ll * 4 + hf * 2 + 1]));
#pragma unroll
                        for (int nt = 0; nt < 4; ++nt) {
                            const bf16x8 bfrag = *(const bf16x8*)(wb + (size_t)nt * 16 * 4096 + (l + ll) * 64 + hf * 32);
                            acc[nt] = __builtin_amdgcn_mfma_f32_16x16x32_bf16(a, bfrag, acc[nt], 0, 0, 0);
                        }
                    }
            }
        }
        {
            const int ob = prompt ? (task - 256) * 16 + rt * 4 + fq : 256 + task * 16 + rt * 4 + fq;
#pragma unroll
            for (int nt = 0; nt < 4; ++nt) {
                const float bias = p.PW[kv * 64 + nt * 16 + fr];
#pragma unroll
                for (int r = 0; r < 4; ++r) p.KC[(size_t)ob * 512 + kv * 256 + r * 64 + nt * 16 + fr] = acc[nt][r] + bias;
            }
        }
        (void)oblk;
    }
}

DEVI void stage_cmp_select(const P& p, int bid, int nblk) {
    const int lane = threadIdx.x & 63, wid = threadIdx.x >> 6;
    for (int wt = bid * 8 + wid; wt < NT * 4; wt += nblk * 8) {
        const int row = wt >> 2, g = wt & 3;
        int pos, nb, nvalid, cur; const float *kcb, *vcb;
        if (row < NTP) { const int b = row >> 12, t = row & 4095; pos = t; nb = 64; nvalid = (t + 1) >> 6; cur = t >> 6; kcb = p.KC + (size_t)(b * 64) * 256; vcb = p.VC + (size_t)(b * 64) * 256; }
        else { const int rs = row - NTP, b = rs >> 2, tq = rs & 3; pos = 2048 + tq; nb = 33; nvalid = 32; cur = 32; kcb = p.KC + (size_t)(256 + b * 32) * 256; vcb = p.VC + (size_t)(256 + b * 32) * 256; }
        const int j = lane;
        float pr[4] = {0.f, 0.f, 0.f, 0.f};
        float imp = 0.f;
        if (nvalid > 0) {
            float dot[4] = {0.f, 0.f, 0.f, 0.f};
            if (j < nvalid) {
                const float* kr = kcb + (size_t)j * 256 + g * 64;
                const bf16_t* qr = p.PROJ + (size_t)row * PS + C_BQ + g * 256;
                for (int d = 0; d < 64; ++d) {
                    const float kk = kr[d];
#pragma unroll
                    for (int r = 0; r < 4; ++r) dot[r] += bf2f(qr[r * 64 + d]) * kk;
                }
            }
#pragma unroll
            for (int r = 0; r < 4; ++r) {
                const float s = j < nvalid ? dot[r] * 0.125f - alibi_slope(g * 4 + r) * (float)(pos - (j * 64 + 63)) : -INFINITY;
                const float mx = wave_max(s);
                const float e = j < nvalid ? __expf(s - mx) : 0.f;
                const float sum = wave_sum(e);
                pr[r] = e / sum;
                imp += pr[r];
            }
            float o[4] = {0.f, 0.f, 0.f, 0.f};
            for (int jj = 0; jj < nvalid; ++jj) {
                const float vv = vcb[(size_t)jj * 256 + g * 64 + lane];
#pragma unroll
                for (int r = 0; r < 4; ++r) o[r] += __shfl(pr[r], jj) * vv;
            }
#pragma unroll
            for (int r = 0; r < 4; ++r) p.OCMP[(size_t)row * 1024 + (g * 4 + r) * 64 + lane] = o[r];
        } else {
#pragma unroll
            for (int r = 0; r < 4; ++r) p.OCMP[(size_t)row * 1024 + (g * 4 + r) * 64 + lane] = 0.f;
        }
        if (j == cur || j == 0) imp = 5.0f;
        if (j > cur) imp = -1.0f;
        if (j >= nb) imp = -2.0f;
        int rank = 0;
        for (int jj = 0; jj < 64; ++jj) { const float v = __shfl(imp, jj); rank += (v > imp || (v == imp && jj < j)) ? 1 : 0; }
        const unsigned long long mask = __ballot(rank < 16 && j < nb);
        if (lane == 0) p.SEL[(size_t)row * 4 + g] = mask;
    }
}

struct KBlock { const void* kb; const void* vb; int stride; int f32; int count; int pos0; };

template <bool WIN>
DEVI void attend_block(const KBlock& B, int qpos, const float* qs, const float (&slope)[4], float (&m)[4], float (&l)[4], float (&o)[4], int lane) {
    const int pos = B.pos0 + lane;
    const bool valid = lane < B.count && pos <= qpos && (!WIN || pos > qpos - 512);
    if (!__any(valid)) return;
    float dot[4] = {0.f, 0.f, 0.f, 0.f};
    if (valid) {
        if (B.f32) {
            const float* kr = (const float*)B.kb + (size_t)lane * B.stride;
#pragma unroll 4
            for (int d4 = 0; d4 < 16; ++d4) {
                const f32x4 kk = *(const f32x4*)(kr + d4 * 4);
#pragma unroll
                for (int e = 0; e < 4; ++e) { const f32x4 qq = *(const f32x4*)(qs + (d4 * 4 + e) * 4);
#pragma unroll
                    for (int r = 0; r < 4; ++r) dot[r] += kk[e] * qq[r]; }
            }
        } else {
            const bf16_t* kr = (const bf16_t*)B.kb + (size_t)lane * B.stride;
#pragma unroll 2
            for (int d8 = 0; d8 < 8; ++d8) {
                const u32x4 kk = *(const u32x4*)(kr + d8 * 8);
                const unsigned w[4] = {kk.x, kk.y, kk.z, kk.w};
#pragma unroll
                for (int e = 0; e < 4; ++e) {
                    const float k0 = __uint_as_float(w[e] << 16), k1 = __uint_as_float(w[e] & 0xFFFF0000u);
                    const f32x4 q0 = *(const f32x4*)(qs + (d8 * 8 + e * 2) * 4), q1 = *(const f32x4*)(qs + (d8 * 8 + e * 2 + 1) * 4);
#pragma unroll
                    for (int r = 0; r < 4; ++r) dot[r] += k0 * q0[r] + k1 * q1[r];
                }
            }
        }
    }
    float pr[4];
#pragma unroll
    for (int r = 0; r < 4; ++r) {
        const float s = valid ? dot[r] * 0.125f - slope[r] * (float)(qpos - pos) : -INFINITY;
        const float mn = fmaxf(m[r], wave_max(s));
        const float sc = __expf(m[r] - mn);
        pr[r] = valid ? __expf(s - mn) : 0.f;
        l[r] = l[r] * sc + wave_sum(pr[r]);
        o[r] *= sc; m[r] = mn;
    }
    for (int kk = 0; kk < B.count; ++kk) {
        const float vv = B.f32 ? ((const float*)B.vb)[(size_t)kk * B.stride + lane] : bf2f(((const bf16_t*)B.vb)[(size_t)kk * B.stride + lane]);
#pragma unroll
        for (int r = 0; r < 4; ++r) o[r] += __shfl(pr[r], kk) * vv;
    }
}

DEVI void stage_slc_win(const P& p, char* smem, int bid, int nblk) {
    const int lane = threadIdx.x & 63, wid = threadIdx.x >> 6;
    float* qs = (float*)smem + wid * 256;
    for (int wt = bid * 8 + wid; wt < NT * 4; wt += nblk * 8) {
        const int row = wt >> 2, g = wt & 3;
        const bool prompt = row < NTP;
        int b, t, qpos;
        if (prompt) { b = row >> 12; t = row & 4095; qpos = t; } else { const int rs = row - NTP; b = rs >> 2; t = rs & 3; qpos = 2048 + t; }
        {
            const bf16_t* qr = p.PROJ + (size_t)row * PS + C_BQ + g * 256;
            f32x4 qv;
#pragma unroll
            for (int r = 0; r < 4; ++r) qv[r] = bf2f(qr[r * 64 + lane]);
            *(f32x4*)(qs + lane * 4) = qv;
            asm volatile("s_waitcnt lgkmcnt(0)" ::: "memory");
        }
        float slope[4];
#pragma unroll
        for (int r = 0; r < 4; ++r) slope[r] = alibi_slope(g * 4 + r);
        float res[2][4];
        {
            float m[4], l[4], o[4];
#pragma unroll
            for (int r = 0; r < 4; ++r) { m[r] = -INFINITY; l[r] = 0.f; o[r] = 0.f; }
            unsigned long long mask = p.SEL[(size_t)row * 4 + g];
            while (mask) {
                const int j = __builtin_ctzll(mask); mask &= mask - 1;
                KBlock B;
                if (prompt) {
                    const bf16_t* base = p.PROJ + ((size_t)b * 4096 + j * 64) * PS + C_SLC + g * 64;
                    B.kb = base; B.vb = base + 256; B.stride = PS; B.f32 = 0; B.count = 64; B.pos0 = j * 64;
                } else if (j < 32) {
                    const int page = p.page_table[b * 16 + (j >> 1)];
                    const float* base = p.cache_slc + ((size_t)page * 128 + (j & 1) * 64) * 512 + g * 64;
                    B.kb = base; B.vb = base + 256; B.stride = 512; B.f32 = 1; B.count = 64; B.pos0 = j * 64;
                } else {
                    const bf16_t* base = p.PROJ + ((size_t)NTP + b * 4) * PS + C_SLC + g * 64;
                    B.kb = base; B.vb = base + 256; B.stride = PS; B.f32 = 0; B.count = 4; B.pos0 = 2048;
                }
                attend_block<false>(B, qpos, qs, slope, m, l, o, lane);
            }
#pragma unroll
            for (int r = 0; r < 4; ++r) res[0][r] = o[r] / l[r];
        }
        {
            float m[4], l[4], o[4];
#pragma unroll
            for (int r = 0; r < 4; ++r) { m[r] = -INFINITY; l[r] = 0.f; o[r] = 0.f; }
            if (prompt) {
                const int lo = (t - 511 > 0 ? t - 511 : 0) >> 6, hi = t >> 6;
                for (int j = lo; j <= hi; ++j) {
                    KBlock B; const bf16_t* base = p.PROJ + ((size_t)b * 4096 + j * 64) * PS + C_WIN + g * 64;
                    B.kb = base; B.vb = base + 256; B.stride = PS; B.f32 = 0; B.count = 64; B.pos0 = j * 64;
                    attend_block<true>(B, qpos, qs, slope, m, l, o, lane);
                }
            } else {
                for (int j = 0; j < 8; ++j) {
                    KBlock B; const float* base = p.cache_win + ((size_t)b * 512 + j * 64) * 512 + g * 64;
                    B.kb = base; B.vb = base + 256; B.stride = 512; B.f32 = 1; B.count = 64; B.pos0 = 1536 + j * 64;
                    attend_block<true>(B, qpos, qs, slope, m, l, o, lane);
                }
                KBlock B; const bf16_t* base = p.PROJ + ((size_t)NTP + b * 4) * PS + C_WIN + g * 64;
                B.kb = base; B.vb = base + 256; B.stride = PS; B.f32 = 0; B.count = 4; B.pos0 = 2048;
                attend_block<true>(B, qpos, qs, slope, m, l, o, lane);
            }
#pragma unroll
            for (int r = 0; r < 4; ++r) res[1][r] = o[r] / l[r];
        }
        const float* gt = p.SM + (size_t)row * 64 + 8;
#pragma unroll
        for (int r = 0; r < 4; ++r) {
            const float g0 = sigmoidf_(gt[g * 4 + r]), g1 = sigmoidf_(gt[16 + g * 4 + r]), g2 = sigmoidf_(gt[32 + g * 4 + r]);
            const float oc = p.OCMP[(size_t)row * 1024 + (g * 4 + r) * 64 + lane];
            p.YB[(size_t)row * 1024 + (g * 4 + r) * 64 + lane] = f2bf(g0 * oc + g1 * res[0][r] + g2 * res[1][r]);
        }
    }
}

typedef float f32x16 __attribute__((ext_vector_type(16)));
typedef short s16x4 __attribute__((ext_vector_type(4)));
typedef __attribute__((address_space(3))) const char* lds_cptr;
#define MFMA32(a, b, c) __builtin_amdgcn_mfma_f32_32x32x16_bf16(a, b, c, 0, 0, 0)
DEVI int crow(int r, int hi) { return (r & 3) + 8 * (r >> 2) + 4 * hi; }
DEVI unsigned cvtpk(float lo, float hi) { unsigned r; asm("v_cvt_pk_bf16_f32 %0, %1, %2" : "=v"(r) : "v"(lo), "v"(hi)); return r; }
DEVI s16x4 vtr(lds_cptr p) { return __builtin_bit_cast(s16x4, __builtin_amdgcn_ds_read_tr16_b64_v4i16((__attribute__((address_space(3))) s16x4*)p)); }
DEVI float half_max(float m) { auto rr = __builtin_amdgcn_permlane32_swap(__float_as_uint(m), __float_as_uint(m), false, false); return fmaxf(__uint_as_float(rr[0]), __uint_as_float(rr[1])); }
DEVI float half_sum(float m) { auto rr = __builtin_amdgcn_permlane32_swap(__float_as_uint(m), __float_as_uint(m), false, false); return __uint_as_float(rr[0]) + __uint_as_float(rr[1]); }

struct BlkDesc { const char* k; int stride_bytes; int f32; int count; int pos0; };
DEVI void blk_load(const BlkDesc& d, int tid, u32x4& rk, u32x4& rv) {
    const int key = tid & 63, chunk = tid >> 6;
    rk = (u32x4){0u, 0u, 0u, 0u}; rv = rk;
    if (key < d.count) {
        const char* kr = d.k + (size_t)key * d.stride_bytes;
        if (d.f32) {
            const f32x4* s1 = (const f32x4*)(kr + chunk * 32); const f32x4* s2 = (const f32x4*)(kr + 1024 + chunk * 32);
            rk = pack8f(s1[0], s1[1]); rv = pack8f(s2[0], s2[1]);
        } else { rk = *(const u32x4*)(kr + chunk * 16); rv = *(const u32x4*)(kr + 512 + chunk * 16); }
    }
}
DEVI void blk_store(char* kimg, char* vimg, int tid, const u32x4& rk, const u32x4& rv) {
    const int key = tid & 63, chunk = tid >> 6;
    *(u32x4*)(kimg + chunk * 1024 + key * 16) = rk;
    *(u32x4*)(vimg + (chunk >> 2) * 4096 + key * 64 + (chunk & 3) * 16) = rv;
}

DEVI void attn_tile(const char* kimg, const char* vimg, const bf16x8 (&qr)[4], float& m2, float& lsum, f32x16& o0, f32x16& o1, f32x16& s0, f32x16& s1,
                    float sl, float bb, int lh, int ll, bool fast, float* wsf_hi  , float* wsf_r  , int lane) {
    const int r32 = lane & 31, hi = lane >> 5;
    const f32x16 z = {};
    s0 = z; s1 = z;
    {
        const char* kp = kimg + hi * 1024 + r32 * 16;
#pragma unroll
        for (int d0 = 0; d0 < 4; ++d0) {
            const bf16x8 k0 = *(const bf16x8*)(kp + d0 * 2048), k1 = *(const bf16x8*)(kp + d0 * 2048 + 512);
            s0 = MFMA32(k0, qr[d0], s0); s1 = MFMA32(k1, qr[d0], s1);
        }
    }
    float mx = -1e30f;
    if (fast) {
#pragma unroll
        for (int r = 0; r < 16; ++r) {
            const int c = (r & 3) + 8 * (r >> 2);
            s0[r] = fmaf(s0[r], 1.4426950408889634f, fmaf(sl, (float)c, bb)); s1[r] = fmaf(s1[r], 1.4426950408889634f, fmaf(sl, (float)(c + 32), bb));
            mx = fmaxf(mx, fmaxf(s0[r], s1[r]));
        }
    } else {
#pragma unroll
        for (int r = 0; r < 16; ++r) {
            const int c = (r & 3) + 8 * (r >> 2);
            const float t0 = fmaf(s0[r], 1.4426950408889634f, fmaf(sl, (float)c, bb)), t1 = fmaf(s1[r], 1.4426950408889634f, fmaf(sl, (float)(c + 32), bb));
            s0[r] = (c <= lh && c > ll) ? t0 : -INFINITY; s1[r] = (c + 32 <= lh && c + 32 > ll) ? t1 : -INFINITY;
            mx = fmaxf(mx, fmaxf(s0[r], s1[r]));
        }
    }
    mx = half_max(mx);
    const float mnew = fmaxf(m2, mx);
    const float f = __builtin_amdgcn_exp2f(m2 - mnew);
    m2 = mnew;
    float ps = 0.f;
#pragma unroll
    for (int r = 0; r < 16; ++r) { s0[r] = __builtin_amdgcn_exp2f(s0[r] - mnew); s1[r] = __builtin_amdgcn_exp2f(s1[r] - mnew); ps += s0[r] + s1[r]; }
    lsum = lsum * f + ps;
    if (__any(f != 1.f)) {
        if (hi == 0) *wsf_r = f;
        asm volatile("s_waitcnt lgkmcnt(0)" ::: "memory");
#pragma unroll
        for (int a = 0; a < 4; ++a) {
            const f32x4 fv = *(const f32x4*)(wsf_hi + 8 * a);
#pragma unroll
            for (int k = 0; k < 4; ++k) { o0[4 * a + k] *= fv[k]; o1[4 * a + k] *= fv[k]; }
        }
        asm volatile("s_waitcnt lgkmcnt(0)" ::: "memory");
    }
    u32x4 pw[4];
#pragma unroll
    for (int k = 0; k < 4; ++k) { pw[0][k] = cvtpk(s0[2 * k], s0[2 * k + 1]); pw[1][k] = cvtpk(s0[8 + 2 * k], s0[8 + 2 * k + 1]); pw[2][k] = cvtpk(s1[2 * k], s1[2 * k + 1]); pw[3][k] = cvtpk(s1[8 + 2 * k], s1[8 + 2 * k + 1]); }
    const lds_cptr vp = (lds_cptr)vimg + ((lane >> 4) & 1) * 32 + (lane & 3) * 8 + (4 * hi + ((lane & 15) >> 2)) * 64;
#pragma unroll
    for (int i = 0; i < 8; ++i) {
        const s16x4 lo = vtr(vp + ((i >> 2) * 4096 + (i & 3) * 1024)), hh = vtr(vp + ((i >> 2) * 4096 + (i & 3) * 1024 + 512));
        const bf16x8 vf = (bf16x8){lo[0], lo[1], lo[2], lo[3], hh[0], hh[1], hh[2], hh[3]};
        const bf16x8 pf = __builtin_bit_cast(bf16x8, pw[i & 3]);
        if (i < 4) o0 = MFMA32(pf, vf, o0); else o1 = MFMA32(pf, vf, o1);
    }
}

constexpr int NSA_KV0 = 0, NSA_KV1 = 16384, NSA_WSF = 32768, NSA_IMP = NSA_WSF + 2048, NSA_SEL = NSA_IMP + 16384, NSA_LIST = NSA_SEL + 512, NSA_OST = NSA_LIST + 256, NSA_YAC = NSA_OST + 32768, NSA_LDS = NSA_YAC + 65536;
static_assert(NSA_LDS <= 152 * 1024, "lds");

DEVI BlkDesc nsa_desc(const P& p, bool prompt, int b, int g, int branch, int j) {
    BlkDesc d;
    if (prompt) {
        if (branch == 0) { d.k = (const char*)(p.KC + ((size_t)(b * 64) * 512 + g * 64)); d.stride_bytes = 2048; d.f32 = 1; d.count = 64; d.pos0 = 0; }
        else { d.k = (const char*)(p.PROJ + ((size_t)b * 4096 + j * 64) * PS + (branch == 1 ? C_SLC : C_WIN) + g * 64); d.stride_bytes = PS * 2; d.f32 = 0; d.count = 64; d.pos0 = j * 64; }
    } else {
        if (branch == 0) { d.k = (const char*)(p.KC + ((size_t)(256 + b * 32) * 512 + g * 64)); d.stride_bytes = 2048; d.f32 = 1; d.count = 32; d.pos0 = 0; }
        else if (branch == 1 && j < 32) { const int page = p.page_table[b * 16 + (j >> 1)]; d.k = (const char*)(p.cache_slc + ((size_t)page * 128 + (j & 1) * 64) * 512 + g * 64); d.stride_bytes = 2048; d.f32 = 1; d.count = 64; d.pos0 = j * 64; }
        else if (branch == 2 && j < 8) { d.k = (const char*)(p.cache_win + ((size_t)b * 512 + j * 64) * 512 + g * 64); d.stride_bytes = 2048; d.f32 = 1; d.count = 64; d.pos0 = 1536 + j * 64; }
        else { d.k = (const char*)(p.PROJ + ((size_t)NTP + b * 4) * PS + (branch == 1 ? C_SLC : C_WIN) + g * 64); d.stride_bytes = PS * 2; d.f32 = 0; d.count = 4; d.pos0 = 2048; }
    }
    return d;
}

DEVI void stage_nsa_attn(const P& p, char* smem, int bid, int nblk) {
    const int tid = threadIdx.x, lane = tid & 63, wid = tid >> 6, r32 = lane & 31, hi = lane >> 5;
    float* wsf = (float*)(smem + NSA_WSF) + wid * 64;
    float* impb = (float*)(smem + NSA_IMP) + wid * 512;
    unsigned long long* selm = (unsigned long long*)(smem + NSA_SEL);
    unsigned char* blist = (unsigned char*)(smem + NSA_LIST);
    for (int unit = bid; unit < 1024 + 512; unit += nblk) {
        const bool prompt = unit < 1024;
        int b, g, qt, t0, ntok, nb, cur; size_t rowbase;
        if (prompt) { b = unit >> 8; g = (unit >> 6) & 3; qt = unit & 63; t0 = qt * 64; ntok = 64; nb = 64; cur = qt; rowbase = (size_t)b * 4096 + t0; }
        else { const int us = unit - 1024; b = us >> 2; g = us & 3; qt = 0; t0 = 2048; ntok = 4; nb = 33; cur = 32; rowbase = (size_t)NTP + b * 4; }
        const int tokl = wid * 8 + (r32 >> 2), head = r32 & 3;
        const bool tok_ok = tokl < ntok;
        const int qpos = t0 + tokl;
        const float slope2 = alibi_slope(g * 4 + head) * 1.4426950408889634f;
        bf16x8 qr[4];
        {
            const bf16_t* qp = p.PROJ + (rowbase + (tok_ok ? tokl : 0)) * PS + C_BQ + (g * 4 + head) * 64 + hi * 8;
#pragma unroll
            for (int d0 = 0; d0 < 4; ++d0) {
                u32x4 v = *(const u32x4*)(qp + d0 * 16);
#pragma unroll
                for (int k = 0; k < 4; ++k) { const float lo = __uint_as_float(v[k] << 16) * 0.125f, hh = __uint_as_float(v[k] & 0xFFFF0000u) * 0.125f; v[k] = tok_ok ? ((__float_as_uint(lo) >> 16) | (__float_as_uint(hh) & 0xFFFF0000u)) : 0u; }
                qr[d0] = __builtin_bit_cast(bf16x8, v);
            }
        }
        int hi4 = 4 * hi; asm volatile("" : "+v"(hi4));
        float* yl = (float*)(smem + NSA_YAC) + wid * 2048 + hi4 * 64 + r32;
        float* wsf_hi = wsf + hi4; float* wsf_r = wsf + r32;
        f32x16 o0, o1, s0, s1; float m2, lsum;
        auto finish = [&](int br) {
            const float lt = half_sum(lsum);
            float fac = 0.f;
            if (tok_ok && lt > 0.f) fac = sigmoidf_(p.SM[(rowbase + tokl) * 64 + 8 + br * 16 + g * 4 + head]) / lt;
            if (hi == 0) *wsf_r = fac;
            asm volatile("s_waitcnt lgkmcnt(0)" ::: "memory");
#pragma unroll
            for (int a = 0; a < 4; ++a) {
                const f32x4 fv = *(const f32x4*)(wsf_hi + 8 * a);
#pragma unroll
                for (int k = 0; k < 4; ++k) {
                    float* yp = yl + (8 * a + k) * 64;
                    if (br == 0) { yp[0] = o0[4 * a + k] * fv[k]; yp[32] = o1[4 * a + k] * fv[k]; }
                    else { yp[0] += o0[4 * a + k] * fv[k]; yp[32] += o1[4 * a + k] * fv[k]; }
                }
            }
            asm volatile("s_waitcnt lgkmcnt(0)" ::: "memory");
        };
        __syncthreads();
        {
            const BlkDesc d = nsa_desc(p, prompt, b, g, 0, 0);
            u32x4 rk, rv; blk_load(d, tid, rk, rv); blk_store(smem + NSA_KV0, smem + NSA_KV0 + 8192, tid, rk, rv);
            __syncthreads();
            o0 = (f32x16){}; o1 = (f32x16){}; m2 = -1e30f; lsum = 0.f;
            {
                const int nv = ((qpos + 1) >> 6) - 1;
                const int lh = (nv < d.count - 1 ? nv : d.count - 1) - hi4;
                const float sl = 64.f * slope2;
                attn_tile(smem + NSA_KV0, smem + NSA_KV0 + 8192, qr, m2, lsum, o0, o1, s0, s1, sl, tok_ok ? sl * (float)(hi4 - (t0 >> 6)) : -INFINITY, lh, -1000, false, wsf_hi, wsf_r, lane);
            }
            const float lt = half_sum(lsum);
            const float inv = lt > 0.f ? 1.f / lt : 0.f;
            float* ib = impb + (r32 >> 2) * 64 + hi4;
#pragma unroll
            for (int r = 0; r < 16; ++r) {
                float a = s0[r] * inv, c = s1[r] * inv;
                a += __shfl_xor(a, 1); a += __shfl_xor(a, 2); c += __shfl_xor(c, 1); c += __shfl_xor(c, 2);
                if (head == 0) { ib[(r & 3) + 8 * (r >> 2)] = a; ib[(r & 3) + 8 * (r >> 2) + 32] = c; }
            }
            asm volatile("s_waitcnt lgkmcnt(0)" ::: "memory");
            finish(0);
#pragma unroll 1
            for (int tl = 0; tl < 8; ++tl) {
                const int j = lane;
                float v = impb[tl * 64 + j];
                if (j == cur || j == 0) v = 5.0f;
                if (j > cur) v = -1.0f;
                if (j >= nb) v = -2.0f;
                impb[tl * 64 + j] = v;
                asm volatile("s_waitcnt lgkmcnt(0)" ::: "memory");
                int rank = 0;
#pragma unroll 8
                for (int jj = 0; jj < 64; ++jj) { const float u = impb[tl * 64 + jj]; rank += (u > v || (u == v && jj < j)) ? 1 : 0; }
                const unsigned long long mask = __ballot(rank < 16 && j < nb);
                if (lane == 0) selm[wid * 8 + tl] = (wid * 8 + tl < ntok) ? mask : 0ull;
            }
        }
        __syncthreads();
        if (wid == 0) {
            unsigned long long u = selm[lane];
#pragma unroll
            for (int o = 32; o > 0; o >>= 1) u |= __shfl_xor(u, o);
            if (prompt) u &= (qt == 63) ? ~0ull : ((1ull << (qt + 1)) - 1ull);
            if (lane == 0) {
                int n = 0;
                while (u) { const int j = __builtin_ctzll(u); u &= u - 1; blist[1 + n++] = (unsigned char)(0x40 | j); }
                if (prompt) { for (int j = (qt - 8 > 0 ? qt - 8 : 0); j <= qt; ++j) blist[1 + n++] = (unsigned char)(0x80 | j); }
                else { for (int j = 0; j <= 8; ++j) blist[1 + n++] = (unsigned char)(0x80 | j); }
                blist[0] = (unsigned char)n;
            }
        }
        __syncthreads();
        const int nblkk = blist[0];
        const unsigned long long mysel = selm[tokl];
        {
            u32x4 rk, rv;
            { const int e = blist[1]; const BlkDesc d = nsa_desc(p, prompt, b, g, e >> 6, e & 63); blk_load(d, tid, rk, rv); blk_store(smem + NSA_KV0, smem + NSA_KV0 + 8192, tid, rk, rv); }
            __syncthreads();
            int prev_br = 1;
            o0 = (f32x16){}; o1 = (f32x16){}; m2 = -1e30f; lsum = 0.f;
            for (int i = 0; i < nblkk; ++i) {
                const int e = blist[1 + i], br = e >> 6, j = e & 63;
                char* cur_img = smem + ((i & 1) ? NSA_KV1 : NSA_KV0);
                char* nxt_img = smem + ((i & 1) ? NSA_KV0 : NSA_KV1);
                const BlkDesc d = nsa_desc(p, prompt, b, g, br, j);
                if (i + 1 < nblkk) { const int e2 = blist[2 + i]; const BlkDesc d2 = nsa_desc(p, prompt, b, g, e2 >> 6, e2 & 63); blk_load(d2, tid, rk, rv); }
                if (br != prev_br) { finish(1); o0 = (f32x16){}; o1 = (f32x16){}; m2 = -1e30f; lsum = 0.f; prev_br = br; }
                {
                    asm volatile("" : "+v"(hi4));
                    const bool lsel = tok_ok && (br == 2 || ((mysel >> j) & 1ull));
                    const int rel = qpos - d.pos0;
                    const int lh = (rel < d.count - 1 ? rel : d.count - 1) - hi4;
                    const int ll = (br == 2 ? rel - 512 : -1000) - hi4;
                    const bool fast = __all(!lsel || (lh >= 59 && ll < 0));
                    attn_tile(cur_img, cur_img + 8192, qr, m2, lsum, o0, o1, s0, s1, slope2, lsel ? slope2 * (float)(hi4 + d.pos0 - t0) : -INFINITY, lh, ll, fast, wsf_hi, wsf_r, lane);
                }
                if (i + 1 < nblkk) blk_store(nxt_img, nxt_img + 8192, tid, rk, rv);
                __syncthreads();
            }
            finish(2);
        }
        {
            const float* yac = (const float*)(smem + NSA_YAC) + wid * 2048;
#pragma unroll
            for (int i = 0; i < 4; ++i) {
                const int orow = i * 8 + (lane >> 3), ch = lane & 7, tk = wid * 8 + (orow >> 2), hd = orow & 3;
                const f32x4 a = *(const f32x4*)(yac + orow * 64 + ch * 8), c = *(const f32x4*)(yac + orow * 64 + ch * 8 + 4);
                if (tk < ntok) *(u32x4*)(p.YB + (rowbase + tk) * 1024 + (g * 4 + hd) * 64 + ch * 8) = pack8f(a, c);
            }
            asm volatile("s_waitcnt lgkmcnt(0)" ::: "memory");
        }
    }
}

DEVI void stage_ln1(const P& p, int bid, int nblk) {
    const int lane = threadIdx.x & 63, wid = threadIdx.x >> 6;
    for (int row = bid * 8 + wid; row < NT; row += nblk * 8) {
        f32x4 x[4];
        float s = 0.f;
#pragma unroll
        for (int i = 0; i < 4; ++i) { x[i] = *(const f32x4*)(p.R + (size_t)row * 1024 + i * 256 + lane * 4); s += x[i][0] + x[i][1] + x[i][2] + x[i][3]; }
        const float mean = wave_sum(s) * (1.f / 1024.f);
        float q = 0.f;
#pragma unroll
        for (int i = 0; i < 4; ++i)
#pragma unroll
            for (int k = 0; k < 4; ++k) q += (x[i][k] - mean) * (x[i][k] - mean);
        const float rs = rsqrtf(wave_sum(q) * (1.f / 1024.f) + LN_EPS);
#pragma unroll
        for (int i = 0; i < 4; ++i) {
            const int c = i * 256 + lane * 4;
            const f32x4 gg = *(const f32x4*)(p.ln1_g + c), bb = *(const f32x4*)(p.ln1_b + c);
            f32x4 y;
#pragma unroll
            for (int k = 0; k < 4; ++k) y[k] = (x[i][k] - mean) * rs * gg[k] + bb[k];
            *(f32x4*)(p.H + (size_t)row * 1024 + c) = y;
            u32x2 o; o.x = pack2(y[0], y[1]); o.y = pack2(y[2], y[3]);
            *(u32x2*)(p.HB + (size_t)row * 1024 + c) = o;
        }
    }
}

__device__ const unsigned char PEER_CA[50] = {0,0,0,0,0,0,0,0,0,0,0,0,0,0,0,0, 1,1,1,1,1,1,1,1, 2,2,2,2,2, 3,3,3,3, 4,4,4, 5,5, 6,6, 7,7, 8,9,10,11,12,13,14,15};
__device__ const unsigned char PEER_CB[50] = {0,1,2,3,4,5,6,7,8,9,10,11,12,13,14,15, 0,1,2,3,4,5,6,7, 0,1,2,3,4, 0,1,2,3, 0,1,2, 0,1, 0,1, 0,1, 0,0,0,0,0,0,0,0};

DEVI void ce_desc(unsigned& a, unsigned& b) { const unsigned hi = a > b ? a : b, lo = a > b ? b : a; a = hi; b = lo; }
template <int BASE> DEVI void sort16_desc(unsigned (&x)[64]) {
#pragma unroll
    for (int k = 2; k <= 16; k <<= 1)
#pragma unroll
        for (int j = k >> 1; j > 0; j >>= 1)
#pragma unroll
            for (int i = 0; i < 16; ++i) {
                const int l = i ^ j;
                if (l > i) { if ((i & k) == 0) ce_desc(x[BASE + i], x[BASE + l]); else ce_desc(x[BASE + l], x[BASE + i]); }
            }
}
DEVI void merge_top16(const unsigned* a, const unsigned* b, unsigned* t) {
    unsigned c[16];
#pragma unroll
    for (int i = 0; i < 16; ++i) c[i] = a[i] > b[15 - i] ? a[i] : b[15 - i];
#pragma unroll
    for (int j = 8; j > 0; j >>= 1)
#pragma unroll
        for (int i = 0; i < 16; ++i) { const int l = i ^ j; if (l > i) ce_desc(c[i], c[l]); }
#pragma unroll
    for (int i = 0; i < 16; ++i) t[i] = c[i];
}
DEVI float key_score(unsigned k) { const unsigned u = k & ~127u; return __uint_as_float((u & 0x80000000u) ? (u & 0x7FFFFFFFu) : ~u); }

DEVI void stage_peer_route(const P& p, char* smem, int bid, int nblk) {
    const int lane = threadIdx.x & 63, wid = threadIdx.x >> 6, r32 = lane & 31, hi = lane >> 5;
    unsigned* tl = (unsigned*)smem + wid * 1024;
    for (int wt = bid * 8 + wid; wt < 528 * 8; wt += nblk * 8) {
        const int tile = wt >> 3, ph = wt & 7;
        const int row = tile * 32 + r32;
        int hi4 = 4 * hi; asm volatile("" : "+v"(hi4));
#pragma unroll 1
        for (int c = 0; c < 2; ++c) {
            f32x16 acc[4];
#pragma unroll
            for (int t = 0; t < 4; ++t) acc[t] = (f32x16){};
            const bf16_t* qp = p.PQ + (size_t)row * 2048 + ph * 256 + c * 128 + hi * 8;
            const bf16_t* kp = p.KEYSB + ((size_t)((ph * 2 + c) * 128 + r32)) * 128 + hi * 8;
#pragma unroll
            for (int s8 = 0; s8 < 8; ++s8) {
                const bf16x8 qf = *(const bf16x8*)(qp + s8 * 16);
#pragma unroll
                for (int t = 0; t < 4; ++t) {
                    const bf16x8 kf = *(const bf16x8*)(kp + (size_t)t * 32 * 128 + s8 * 16);
                    acc[t] = MFMA32(kf, qf, acc[t]);
                }
            }
            unsigned x[64];
#pragma unroll
            for (int t = 0; t < 4; ++t)
#pragma unroll
                for (int r = 0; r < 16; ++r) {
                    const unsigned u = __float_as_uint(acc[t][r]);
                    const unsigned o = (u & 0x80000000u) ? ~u : (u | 0x80000000u);
                    x[t * 16 + r] = (o & ~127u) | (unsigned)(127 - ((r & 3) + 8 * (r >> 2) + 32 * t) - hi4);
                }
            sort16_desc<0>(x); sort16_desc<16>(x); sort16_desc<32>(x); sort16_desc<48>(x);
            unsigned t01[16], t23[16], tt[16], oth[16], fin[16];
            merge_top16(&x[0], &x[16], t01); merge_top16(&x[32], &x[48], t23); merge_top16(t01, t23, tt);
#pragma unroll
            for (int i = 0; i < 16; ++i) { auto rr = __builtin_amdgcn_permlane32_swap(tt[i], tt[i], false, false); oth[i] = hi ? rr[0] : rr[1]; }
            merge_top16(tt, oth, fin);
            if (hi == 0) {
#pragma unroll
                for (int i = 0; i < 4; ++i) *(u32x4*)(tl + r32 * 32 + c * 16 + i * 4) = (u32x4){fin[4 * i], fin[4 * i + 1], fin[4 * i + 2], fin[4 * i + 3]};
            }
        }
        asm volatile("s_waitcnt lgkmcnt(0)" ::: "memory");
        const int ca = lane < 50 ? PEER_CA[lane] : 0, cb = lane < 50 ? PEER_CB[lane] : 0;
#pragma unroll 1
        for (int tk = 0; tk < 32; ++tk) {
            const unsigned ka = tl[tk * 32 + ca], kb = tl[tk * 32 + 16 + cb];
            const float cand = lane < 50 ? key_score(ka) + key_score(kb) : -INFINITY;
            const int cidx = (127 - (int)(ka & 127u)) * 128 + (127 - (int)(kb & 127u));
            int rk = 0;
#pragma unroll 10
            for (int kk = 0; kk < 50; ++kk) { const float v = __shfl(cand, kk); rk += (v > cand || (v == cand && kk < lane)) ? 1 : 0; }
            const bool sel = lane < 50 && rk < 16;
            const float mx = wave_max(sel ? cand : -INFINITY);
            const float e = sel ? __expf(cand - mx) : 0.f;
            const float sum = wave_sum(e);
            const size_t orow = (size_t)(tile * 32 + tk);
            if (sel) { p.EIDX[orow * 128 + ph * 16 + rk] = cidx; p.EGATE[orow * 128 + ph * 16 + rk] = e / sum; }
        }
        asm volatile("s_waitcnt lgkmcnt(0)" ::: "memory");
    }
}

constexpr int PA_WAVE_LDS = 2048 + 512 + 512 + 512;
DEVI void stage_peer_apply(const P& p, char* smem, int bid, int nblk) {
    const int lane = threadIdx.x & 63, wid = threadIdx.x >> 6;
    char* wl = smem + wid * PA_WAVE_LDS;
    bf16_t* hb = (bf16_t*)wl;
    int* idxs = (int*)(wl + 2048);
    float* gts = (float*)(wl + 2560);
    float* cs = (float*)(wl + 3072);
    const int fr = lane & 15, fq = lane >> 4;
    for (int row = bid * 8 + wid; row < NT; row += nblk * 8) {
        {
            const bf16_t* hr = p.HB + (size_t)row * 1024 + lane * 8;
            *(u32x4*)(hb + lane * 8) = *(const u32x4*)hr;
            *(u32x4*)(hb + 512 + lane * 8) = *(const u32x4*)(hr + 512);
            idxs[lane] = p.EIDX[(size_t)row * 128 + lane]; idxs[lane + 64] = p.EIDX[(size_t)row * 128 + 64 + lane];
            gts[lane] = p.EGATE[(size_t)row * 128 + lane]; gts[lane + 64] = p.EGATE[(size_t)row * 128 + 64 + lane];
            asm volatile("s_waitcnt lgkmcnt(0)" ::: "memory");
        }
#pragma unroll 1
        for (int g = 0; g < 8; ++g) {
            const int my_e = idxs[g * 16 + fr];
            const bf16_t* ub = p.UB + (size_t)my_e * 1024 + fq * 8;
            f32x4 acc = (f32x4){0.f, 0.f, 0.f, 0.f};
            bf16x8 a0[16], a1[16];
#pragma unroll
            for (int s2 = 0; s2 < 16; ++s2) a0[s2] = *(const bf16x8*)(ub + s2 * 32);
#pragma unroll
            for (int s2 = 0; s2 < 16; ++s2) a1[s2] = *(const bf16x8*)(ub + (16 + s2) * 32);
#pragma unroll
            for (int s2 = 0; s2 < 16; ++s2) { const bf16x8 hf = *(const bf16x8*)(hb + s2 * 32 + fq * 8); acc = __builtin_amdgcn_mfma_f32_16x16x32_bf16(a0[s2], hf, acc, 0, 0, 0); }
#pragma unroll
            for (int s2 = 0; s2 < 16; ++s2) { const bf16x8 hf = *(const bf16x8*)(hb + (16 + s2) * 32 + fq * 8); acc = __builtin_amdgcn_mfma_f32_16x16x32_bf16(a1[s2], hf, acc, 0, 0, 0); }
            const f32x4 gg = *(const f32x4*)(gts + g * 16 + fq * 4);
            f32x4 cv;
#pragma unroll
            for (int r = 0; r < 4; ++r) { const float d = acc[r]; cv[r] = gg[r] * 0.5f * d * (1.f + erff(d * 0.7071067811865476f)); }
            if (fr == 0) *(f32x4*)(cs + g * 16 + fq * 4) = cv;
        }
        asm volatile("s_waitcnt lgkmcnt(0)" ::: "memory");
        float acc[16];
#pragma unroll
        for (int i = 0; i < 16; ++i) acc[i] = 0.f;
#pragma unroll 1
        for (int e0 = 0; e0 < 128; e0 += 8) {
            u32x4 v0[8], v1[8]; float c[8];
#pragma unroll
            for (int k = 0; k < 8; ++k) {
                const int idx = idxs[e0 + k];
                const bf16_t* vr = p.VB + (size_t)idx * 1024 + lane * 8;
                v0[k] = *(const u32x4*)vr; v1[k] = *(const u32x4*)(vr + 512);
                c[k] = cs[e0 + k];
            }
#pragma unroll
            for (int k = 0; k < 8; ++k) {
#pragma unroll
                for (int w = 0; w < 4; ++w) {
                    acc[w * 2] += c[k] * __uint_as_float(v0[k][w] << 16); acc[w * 2 + 1] += c[k] * __uint_as_float(v0[k][w] & 0xFFFF0000u);
                    acc[8 + w * 2] += c[k] * __uint_as_float(v1[k][w] << 16); acc[8 + w * 2 + 1] += c[k] * __uint_as_float(v1[k][w] & 0xFFFF0000u);
                }
            }
        }
        float s = 0.f;
#pragma unroll
        for (int i = 0; i < 2; ++i) {
            const f32x4 a = *(const f32x4*)(p.H + (size_t)row * 1024 + i * 512 + lane * 8), b2 = *(const f32x4*)(p.H + (size_t)row * 1024 + i * 512 + lane * 8 + 4);
#pragma unroll
            for (int k = 0; k < 4; ++k) { acc[i * 8 + k] += DN_ALPHA * a[k]; acc[i * 8 + 4 + k] += DN_ALPHA * b2[k]; }
        }
#pragma unroll
        for (int i = 0; i < 16; ++i) s += acc[i];
        const float mean = wave_sum(s) * (1.f / 1024.f);
        float q = 0.f;
#pragma unroll
        for (int i = 0; i < 16; ++i) q += (acc[i] - mean) * (acc[i] - mean);
        const float rs = rsqrtf(wave_sum(q) * (1.f / 1024.f) + LN_EPS);
#pragma unroll
        for (int i = 0; i < 2; ++i) {
            const int c = i * 512 + lane * 8;
            const f32x4 g0 = *(const f32x4*)(p.ln2_g + c), g1 = *(const f32x4*)(p.ln2_g + c + 4), b0 = *(const f32x4*)(p.ln2_b + c), b1 = *(const f32x4*)(p.ln2_b + c + 4);
            f32x4 y0, y1;
#pragma unroll
            for (int k = 0; k < 4; ++k) { y0[k] = (acc[i * 8 + k] - mean) * rs * g0[k] + b0[k]; y1[k] = (acc[i * 8 + 4 + k] - mean) * rs * g1[k] + b1[k]; }
            *(f32x4*)(p.out + O_Y + (size_t)row * 1024 + c) = y0;
            *(f32x4*)(p.out + O_Y + (size_t)row * 1024 + c + 4) = y1;
        }
    }
}

namespace pg8 {
#define PG8_LAS __attribute__((address_space(3)))
typedef unsigned short bf16_t;
typedef short bf16x8 __attribute__((ext_vector_type(8)));
typedef float f32x4 __attribute__((ext_vector_type(4)));
typedef unsigned u32x4 __attribute__((ext_vector_type(4)));
constexpr int BM = 256, BK = 64, HALF = 128, HTB = HALF * BK * 2  , STAGE_BYTES = 8 * HTB, NXCD = 8, WGM = 8;

__host__ __device__ __forceinline__ int lds_byte(int r, int c) { const int st = (r >> 4) * 2 + (c >> 5), rr = r & 15, cc = c & 31, ob = rr * 64 + cc * 2; return st * 1024 + (ob ^ (((ob >> 9) & 1) << 5)); }
__host__ __device__ __forceinline__ void stage_rc(int b, int& R, int& C) { const int st = b / 1024, sb = b % 1024, swz = sb ^ (((sb >> 9) & 1) << 5); R = (st >> 1) * 16 + swz / 64; C = (st & 1) * 32 + (swz % 64) / 2; }
__host__ __device__ __forceinline__ int perm32(int rho) { const int n = rho >> 4, i = rho & 15; return 8 * (i >> 2) + 4 * n + (i & 3); }

struct Unit { int pm, pn; };
struct Gemm { const bf16_t* A; const bf16_t* Bt; int M, N, K; };

struct StaticOrder {
    int nM, nN, nwg, G, c;
    __host__ __device__ void init(int M, int N, int G_, int c_) { nM = M / BM; nN = N / BM; nwg = nM * nN; G = G_; c = c_; }
    __host__ __device__ bool next(int i, Unit& u) const {
        const long L = (long)i * G + c; if (L >= nwg) return false;
        int wgid = (int)L; { const int q = nwg / NXCD, r = nwg % NXCD, xcd = wgid % NXCD, off = wgid / NXCD; wgid = (xcd < r ? xcd * (q + 1) : r * (q + 1) + (xcd - r) * q) + off; }
        const int nig = WGM * nN, gid = wgid / nig, fm = gid * WGM, gsz = (nM - fm) < WGM ? (nM - fm) : WGM;
        u.pm = fm + ((wgid % nig) % gsz); u.pn = (wgid % nig) / gsz; return true;
    }
    __device__ __forceinline__ void a_ready(const Unit&) const {}
    __device__ __forceinline__ void done(const Unit&) const {}
};
template <class Epi, class Sched, bool STAMP = false>
__device__ __forceinline__ void gemm_phase(PG8_LAS unsigned char* lds, const Gemm g, const Sched& S, const Epi& E, unsigned long long* stamps) {
    const int tid = threadIdx.x, wid = __builtin_amdgcn_readfirstlane(tid >> 6), lane = tid & 63, wr = wid >> 2, wc = wid & 3, fr = lane & 15, fq = lane >> 4;
    const int K = g.K, nt = K / BK;
    int ts_lo = 0, ts_hi = 0, nts = 0; const unsigned long long rt_entry = STAMP ? (unsigned long long)wall_clock64() : 0ull;
#define PG8_STAMP() do { if (STAMP && wid == 0 && nts < 64) { const unsigned long long _c = (unsigned long long)clock64(); \
        ts_lo = (lane == nts) ? (int)(unsigned)_c : ts_lo; ts_hi = (lane == nts) ? (int)(unsigned)(_c >> 32) : ts_hi; ++nts; } } while (0)
    PG8_STAMP();
    unsigned voffA[2], voffB[2];
#pragma unroll
    for (int i = 0; i < 2; ++i) { int R, C; stage_rc(tid * 16 + i * 8192, R, C); const int Rb = Epi::PERM ? ((R & ~31) + perm32(R & 31)) : R;
        voffA[i] = (unsigned)(R * K + C) * 2u; voffB[i] = (unsigned)(Rb * K + C) * 2u; }
    const size_t kstep = (size_t)(BK * 2);
    const size_t hstep = (size_t)HALF * K * 2;
    const size_t tstep = 2 * hstep;
    const unsigned ldsw = (unsigned)wid * 1024u;
    const int aoff = lds_byte(wr * 64 + fr, fq * 8), boff = lds_byte(wc * 32 + fr, fq * 8);
#define PG8_SA(b, h) (((b) * 2 + (h)) * HTB)
#define PG8_SB(b, h) ((4 + (b) * 2 + (h)) * HTB)
#define PG8_STAGE(bufoff, gbase, voff) do { _Pragma("unroll") for (int _i = 0; _i < 2; ++_i) \
        __builtin_amdgcn_global_load_lds((const unsigned*)((const char*)(gbase) + (voff)[_i]), (PG8_LAS unsigned*)(lds + (bufoff) + ldsw + _i * 8192), 16, 0, 0); } while (0)
#define PG8_LDA(dst, b, h) do { _Pragma("unroll") for (int m = 0; m < 4; ++m) _Pragma("unroll") for (int k = 0; k < 2; ++k) dst[m][k] = *(const PG8_LAS bf16x8*)(lds + PG8_SA(b, h) + aoff + m * 2048 + k * 1024); } while (0)
#define PG8_LDB(dst, b, h) do { _Pragma("unroll") for (int n = 0; n < 2; ++n) _Pragma("unroll") for (int k = 0; k < 2; ++k) dst[n][k] = *(const PG8_LAS bf16x8*)(lds + PG8_SB(b, h) + boff + n * 2048 + k * 1024); } while (0)
#define PG8_MMA(ai, bj, At, Bt) do { __builtin_amdgcn_s_setprio(1); _Pragma("unroll") for (int m = 0; m < 4; ++m) _Pragma("unroll") for (int n = 0; n < 2; ++n) _Pragma("unroll") for (int k = 0; k < 2; ++k) \
        acc[ai][bj][m][n] = __builtin_amdgcn_mfma_f32_16x16x32_bf16(Bt[n][k], At[m][k], acc[ai][bj][m][n], 0, 0, 0); __builtin_amdgcn_s_setprio(0); } while (0)
#define PG8_WAIT_V(n) asm volatile("s_waitcnt vmcnt(" #n ")" ::: "memory")
#define PG8_WAIT_L(n) asm volatile("s_waitcnt lgkmcnt(" #n ")" ::: "memory")
#define PG8_BAR __builtin_amdgcn_s_barrier()
#define PG8_SCHED __builtin_amdgcn_sched_barrier(0)
    Unit cur, nxt; int ui = 0;
    if (!S.next(0, cur)) return;
    f32x4 acc[2][2][4][2];
#pragma unroll
    for (int a = 0; a < 2; ++a)
#pragma unroll
        for (int b = 0; b < 2; ++b)
#pragma unroll
            for (int m = 0; m < 4; ++m)
#pragma unroll
                for (int n = 0; n < 2; ++n) acc[a][b][m][n] = (f32x4){0.f, 0.f, 0.f, 0.f};
    bf16x8 At[4][2], B0[2][2], B1[2][2];
    const char* cA = (const char*)g.A + (size_t)cur.pm * tstep; const char* cB = (const char*)g.Bt + (size_t)cur.pn * tstep;
    S.a_ready(cur);
    PG8_STAGE(PG8_SB(0, 0), cB, voffB); PG8_STAGE(PG8_SA(0, 0), cA, voffA); PG8_STAGE(PG8_SB(0, 1), cB + hstep, voffB); PG8_STAGE(PG8_SA(0, 1), cA + hstep, voffA);
    if (wr == 1) PG8_BAR;
    PG8_WAIT_V(4); PG8_BAR;
    PG8_STAGE(PG8_SB(1, 0), cB + kstep, voffB); PG8_STAGE(PG8_SA(1, 0), cA + kstep, voffA); PG8_STAGE(PG8_SB(1, 1), cB + hstep + kstep, voffB);
    PG8_WAIT_V(6); PG8_BAR;
    PG8_STAMP();
    for (;;) {
        const bool has_next = S.next(ui + 1, nxt);
        const char* nA = has_next ? (const char*)g.A + (size_t)nxt.pm * tstep : cA; const char* nB = has_next ? (const char*)g.Bt + (size_t)nxt.pn * tstep : cB;
        for (int t = 0; t < nt; t += 2) {
            const bool last = (t == nt - 2);
            const char* a1 = cA + (size_t)(t + 1) * kstep;
            const char* a2 = last ? nA : cA + (size_t)(t + 2) * kstep; const char* b2 = last ? nB : cB + (size_t)(t + 2) * kstep;
            const char* a3 = a2 + kstep; const char* b3 = b2 + kstep;
            if (last && has_next) S.a_ready(nxt);
            PG8_LDB(B0, 0, 0); PG8_SCHED; PG8_LDA(At, 0, 0); PG8_STAGE(PG8_SA(1, 1), a1 + hstep, voffA);
            PG8_WAIT_L(8); PG8_BAR; PG8_WAIT_L(0); PG8_MMA(0, 0, At, B0); PG8_BAR; PG8_SCHED;
            PG8_LDB(B1, 0, 1); PG8_STAGE(PG8_SB(0, 0), b2, voffB);
            PG8_BAR; PG8_WAIT_L(0); PG8_MMA(0, 1, At, B1); PG8_BAR;
            PG8_LDA(At, 0, 1); PG8_STAGE(PG8_SA(0, 0), a2, voffA);
            PG8_BAR; PG8_WAIT_L(0); PG8_MMA(1, 0, At, B0); PG8_BAR; PG8_SCHED;
            PG8_STAGE(PG8_SB(0, 1), b2 + hstep, voffB);
            PG8_WAIT_V(6); PG8_BAR; PG8_MMA(1, 1, At, B1); PG8_BAR;
            PG8_LDB(B0, 1, 0); PG8_SCHED; PG8_LDA(At, 1, 0); PG8_STAGE(PG8_SA(0, 1), a2 + hstep, voffA);
            PG8_WAIT_L(8); PG8_BAR; PG8_WAIT_L(0); PG8_MMA(0, 0, At, B0); PG8_BAR; PG8_SCHED;
            PG8_LDB(B1, 1, 1); PG8_STAGE(PG8_SB(1, 0), b3, voffB);
            PG8_BAR; PG8_WAIT_L(0); PG8_MMA(0, 1, At, B1); PG8_BAR;
            PG8_LDA(At, 1, 1); PG8_STAGE(PG8_SA(1, 0), a3, voffA);
            PG8_BAR; PG8_WAIT_L(0); PG8_MMA(1, 0, At, B0); PG8_BAR; PG8_SCHED;
            PG8_STAGE(PG8_SB(1, 1), b3 + hstep, voffB);
            PG8_WAIT_V(6); PG8_BAR; PG8_MMA(1, 1, At, B1); PG8_BAR;
        }
        PG8_STAMP();
        if constexpr (!Epi::AFTER_DRAIN) { E(acc, cur, wr, wc, fr, fq); S.done(cur); }
        PG8_STAMP();
        if (!has_next) break;
#pragma unroll
        for (int a = 0; a < 2; ++a)
#pragma unroll
            for (int b = 0; b < 2; ++b)
#pragma unroll
                for (int m = 0; m < 4; ++m)
#pragma unroll
                    for (int n = 0; n < 2; ++n) acc[a][b][m][n] = (f32x4){0.f, 0.f, 0.f, 0.f};
        cur = nxt; cA = nA; cB = nB; ++ui;
    }
    PG8_WAIT_V(0);
    if (wr == 0) PG8_BAR;
    PG8_BAR;
    if constexpr (Epi::AFTER_DRAIN) { E.fused(acc, cur, wr, wc, fr, fq, lds, wid, lane); S.done(cur); }
    PG8_STAMP();
    if (STAMP && wid == 0) { stamps[lane] = lane < nts ? (((unsigned long long)(unsigned)ts_hi << 32) | (unsigned)ts_lo) : 0ull;
        if (lane == 62) stamps[62] = rt_entry; if (lane == 63) stamps[63] = (unsigned long long)wall_clock64(); }
#undef PG8_STAMP
#undef PG8_SA
#undef PG8_SB
#undef PG8_STAGE
#undef PG8_LDA
#undef PG8_LDB
#undef PG8_MMA
#undef PG8_WAIT_V
#undef PG8_WAIT_L
#undef PG8_BAR
#undef PG8_SCHED
}
}

template <class F> struct EpiAdapt {
    static constexpr bool PERM = false, AFTER_DRAIN = false;
    F f;
    __device__ __forceinline__ void operator()(const pg8::f32x4 (&acc)[2][2][4][2], const pg8::Unit& u, int wr, int wc, int fr, int fq) const {
        constexpr int B = F::BATCH;
        const int row0 = u.pm * 256 + wr * 64 + fr, col0 = u.pn * 256 + wc * 32 + 4 * fq;
        if constexpr (B == 0) {
            typename F::Pre pre[4];
#pragma unroll
            for (int i = 0; i < 4; ++i) pre[i] = f.pre(row0, col0 + (i >> 1) * 128 + (i & 1) * 16);
#pragma unroll
            for (int q = 0; q < 32; ++q) { const int n = q & 1, bj = (q >> 1) & 1, m = (q >> 2) & 3, ai = q >> 4; f.put(row0 + ai * 128 + m * 16, col0 + bj * 128 + n * 16, acc[ai][bj][m][n], pre[bj * 2 + n]); }
        } else
#pragma unroll
        for (int q0 = 0; q0 < 32; q0 += (B > 0 ? B : 32)) {
            typename F::Pre pre[B > 0 ? B : 1];
#pragma unroll
            for (int i = 0; i < B; ++i) { const int q = q0 + i, n = q & 1, bj = (q >> 1) & 1, m = (q >> 2) & 3, ai = q >> 4; pre[i] = f.pre(row0 + ai * 128 + m * 16, col0 + bj * 128 + n * 16); }
#pragma unroll
            for (int i = 0; i < B; ++i) { const int q = q0 + i, n = q & 1, bj = (q >> 1) & 1, m = (q >> 2) & 3, ai = q >> 4; f.put(row0 + ai * 128 + m * 16, col0 + bj * 128 + n * 16, acc[ai][bj][m][n], pre[i]); }
        }
    }
};
template <class F>
DEVI void gemm_pg8(const bf16_t* A, const bf16_t* Bt, int M, int N, int K, const F& f, char* smem, int bid, int nblk) {
    pg8::Gemm g{A, Bt, M, N, K};
    pg8::StaticOrder S; S.init(M, N, nblk, bid);
    EpiAdapt<F> E{f};
    __syncthreads();
    pg8::gemm_phase<EpiAdapt<F>, pg8::StaticOrder, false>((PG8_LAS unsigned char*)smem, g, S, E, nullptr);
    __syncthreads();
}

#define XB_TMO      128
#define XB_XCNT(j)  (256  + 64 * (j))
#define XB_XSUB(j)  (1280 + 64 * (j))
#define XB_XGEN(j)  (2304 + 64 * (j))
#define XB_TOP      3328
#define XB_TOPGEN   3392
#define XCD_BAR_WORDS 3456
#define XB_SPIN_CAP (1u << 18)
#define LAS __attribute__((address_space(3)))

__device__ __forceinline__ unsigned xb_ld(unsigned* p)              { return __hip_atomic_load(p, __ATOMIC_RELAXED, __HIP_MEMORY_SCOPE_AGENT); }
__device__ __forceinline__ unsigned xb_add(unsigned* p, unsigned v) { return __hip_atomic_fetch_add(p, v, __ATOMIC_RELAXED, __HIP_MEMORY_SCOPE_AGENT); }
__device__ __forceinline__ unsigned xb_xcc_id() { return (unsigned)__builtin_amdgcn_s_getreg((3 << 11) | 20) & 0xFu; }
#define XB_SPIN(cond, bar) do { unsigned _sp = 0; while (cond) { __builtin_amdgcn_s_sleep(1); \
    if ((++_sp & 255u) == 0u) { if (xb_ld(&(bar)[XB_TMO])) break; if (_sp > XB_SPIN_CAP) { atomicAdd(&(bar)[XB_TMO], 1u); break; } } } } while (0)

struct XcdBarrier {
    unsigned* bar; unsigned x;
    volatile LAS unsigned* st;
};

__device__ __forceinline__ XcdBarrier xcd_barrier_post(unsigned* bar, volatile LAS unsigned* st) {
    XcdBarrier b; b.bar = bar; b.x = xb_xcc_id(); b.st = st;
    if (threadIdx.x == 0) (void)xb_add(&bar[XB_XCNT(b.x)], 1u);
    return b;
}
__device__ __forceinline__ void xcd_barrier_complete(unsigned* bar, unsigned x, unsigned& nloc, unsigned& nx) {
    const unsigned G = gridDim.x * gridDim.y * gridDim.z;
    unsigned sum, cnt, mine, sp = 0u;
    for (;;) {
        sum = 0u; cnt = 0u; mine = 0u;
#pragma unroll
        for (unsigned j = 0; j < 16; ++j) { const unsigned c = xb_ld(&bar[XB_XCNT(j)]); sum += c; cnt += (c > 0u) ? 1u : 0u; mine = (j == x) ? c : mine; }
        if (sum == G) break;
        __builtin_amdgcn_s_sleep(1);
        if ((++sp & 255u) == 0u) { if (xb_ld(&bar[XB_TMO])) break; if (sp > XB_SPIN_CAP) { atomicAdd(&bar[XB_TMO], 1u); break; } }
    }
    nloc = mine > 0u ? mine : 1u; nx = cnt > 0u ? cnt : 1u;
}

__device__ __forceinline__ void xcd_barrier(const XcdBarrier& b) {
    asm volatile("s_waitcnt vmcnt(0)" ::: "memory");
    __syncthreads();
    if (threadIdx.x == 0) {
        unsigned* bar = b.bar;
        __builtin_amdgcn_s_waitcnt(0);
        unsigned nloc = b.st[0], nx = b.st[1];
        if (nloc == 0u) { xcd_barrier_complete(bar, b.x, nloc, nx); b.st[0] = nloc; b.st[1] = nx; }
        const unsigned old = xb_add(&bar[XB_XSUB(b.x)], 1u);
        const unsigned gen = old / nloc;
        if (old + 1u == (gen + 1u) * nloc) {
            __builtin_amdgcn_fence(__ATOMIC_RELEASE, "agent");
            asm volatile("s_waitcnt vmcnt(0)" ::: "memory");
            const unsigned og = xb_add(&bar[XB_TOP], 1u);
            const unsigned tg = og / nx;
            if (og + 1u == (tg + 1u) * nx) xb_add(&bar[XB_TOPGEN], 1u);
            else XB_SPIN(xb_ld(&bar[XB_TOPGEN]) == tg, bar);
            __builtin_amdgcn_fence(__ATOMIC_ACQUIRE, "agent");
            xb_add(&bar[XB_XGEN(b.x)], 1u);
            asm volatile("s_waitcnt vmcnt(0)" ::: "memory");
        } else {
            XB_SPIN(xb_ld(&bar[XB_XGEN(b.x)]) == gen, bar);
            __builtin_amdgcn_fence(__ATOMIC_ACQUIRE, "agent");
            asm volatile("s_waitcnt vmcnt(0)" ::: "memory");
        }
    }
    __syncthreads();
}

constexpr int LDS_BYTES = 152 * 1024;

template <int S>
DEVI void run_stage(const P& p, char* smem, int bid, int nblk) {
    if (S == 0) stage_prologue(p, smem, bid, nblk);
    if (S == 1) { EpiInProj e{p}; gemm_pg8(p.XB, p.WINT, NT, NPAD_IN, 1024, e, smem, bid, nblk); }
    if (S == 2) { stage_mlstm_gates(p, smem, bid, nblk); stage_compress(p, bid, nblk); }
    if (S == 3) { stage_mlstm_dc(p, smem, bid, nblk); stage_mlstm_sample(p, smem, bid, nblk); }
    if (S == 4) { stage_mlstm_scan(p, bid, nblk); stage_nsa_attn(p, smem, bid, nblk); { EpiG e{p}; gemm_pg8(p.XB, p.WMT, NT, 2048, 1024, e, smem, bid, nblk); } }
    if (S == 5) stage_mlstm_out(p, smem, bid, nblk);
    if (S == 6) { EpiM1 e{p}; gemm_pg8(p.YA, p.WAT, NT, 1024, 1024, e, smem, bid, nblk); }
    if (S == 7) { EpiM2 e{p}; gemm_pg8(p.YB, p.WBT, NT, 1024, 1024, e, smem, bid, nblk); }
    if (S == 8) { EpiR e{p}; gemm_pg8(p.MERGED, p.WOT, NT, 1024, 1024, e, smem, bid, nblk); }
    if (S == 9) stage_ln1(p, bid, nblk);
    if (S == 10) { EpiPQ e{p}; gemm_pg8(p.HB, p.WQT, NT, 2048, 1024, e, smem, bid, nblk); }
    if (S == 11) stage_peer_route(p, smem, bid, nblk);
    if (S == 12) stage_peer_apply(p, smem, bid, nblk);
}
constexpr int NSTAGES = 13;

template <int S>
__global__ void __launch_bounds__(512, 2) k_stage(P p) {
    extern __shared__ __attribute__((aligned(16))) char smem[];
    run_stage<S>(p, smem, blockIdx.x, gridDim.x);
}


#if MK_ONE_LAUNCH
__global__ void __launch_bounds__(512, 2) k_mega(P p) {
    extern __shared__ __attribute__((aligned(16))) char smem_all[];
    if (threadIdx.x == 0) *(u32x4*)smem_all = (u32x4){0u, 0u, 0u, 0u};
    __syncthreads();
    XcdBarrier bar = xcd_barrier_post(p.bar, (volatile LAS unsigned*)smem_all);
    char* smem = smem_all + 16;
    const int bid = blockIdx.x, nblk = gridDim.x;
    run_stage<0>(p, smem, bid, nblk); if ((REP_MASK >> 0) & 1) { xcd_barrier(bar); run_stage<0>(p, smem, bid, nblk); }  xcd_barrier(bar);
    run_stage<1>(p, smem, bid, nblk); if ((REP_MASK >> 1) & 1) { xcd_barrier(bar); run_stage<1>(p, smem, bid, nblk); }  xcd_barrier(bar);
    run_stage<2>(p, smem, bid, nblk); if ((REP_MASK >> 2) & 1) { xcd_barrier(bar); run_stage<2>(p, smem, bid, nblk); }  xcd_barrier(bar);
    run_stage<3>(p, smem, bid, nblk); if ((REP_MASK >> 3) & 1) { xcd_barrier(bar); run_stage<3>(p, smem, bid, nblk); }  xcd_barrier(bar);
    run_stage<4>(p, smem, bid, nblk); if ((REP_MASK >> 4) & 1) { xcd_barrier(bar); run_stage<4>(p, smem, bid, nblk); }  xcd_barrier(bar);
    run_stage<5>(p, smem, bid, nblk); if ((REP_MASK >> 5) & 1) { xcd_barrier(bar); run_stage<5>(p, smem, bid, nblk); }  xcd_barrier(bar);
    run_stage<6>(p, smem, bid, nblk); if ((REP_MASK >> 6) & 1) { xcd_barrier(bar); run_stage<6>(p, smem, bid, nblk); }  xcd_barrier(bar);
    run_stage<7>(p, smem, bid, nblk); if ((REP_MASK >> 7) & 1) { xcd_barrier(bar); run_stage<7>(p, smem, bid, nblk); }  xcd_barrier(bar);
    run_stage<8>(p, smem, bid, nblk); if ((REP_MASK >> 8) & 1) { xcd_barrier(bar); run_stage<8>(p, smem, bid, nblk); }  xcd_barrier(bar);
    run_stage<9>(p, smem, bid, nblk); if ((REP_MASK >> 9) & 1) { xcd_barrier(bar); run_stage<9>(p, smem, bid, nblk); }  xcd_barrier(bar);
    run_stage<10>(p, smem, bid, nblk); if ((REP_MASK >> 10) & 1) { xcd_barrier(bar); run_stage<10>(p, smem, bid, nblk); } xcd_barrier(bar);
    run_stage<11>(p, smem, bid, nblk); if ((REP_MASK >> 11) & 1) { xcd_barrier(bar); run_stage<11>(p, smem, bid, nblk); } xcd_barrier(bar);
    run_stage<12>(p, smem, bid, nblk); if ((REP_MASK >> 12) & 1) { xcd_barrier(bar); run_stage<12>(p, smem, bid, nblk); }
}
#endif

template <int S> static void launch_stage(const P& p, int grid, hipStream_t stream) {
    (void)hipFuncSetAttribute((const void*)k_stage<S>, hipFuncAttributeMaxDynamicSharedMemorySize, LDS_BYTES);
    k_stage<S><<<dim3(grid), dim3(512), LDS_BYTES, stream>>>(p);
}

extern "C" void kernel_launch(void* const* d_in, const int* in_sizes, int n_in, void* d_out, int out_size, void* d_ws, size_t ws_size, hipStream_t stream) {
    (void)in_sizes; (void)n_in; (void)out_size; (void)ws_size;
    P p{};
    p.xp = (const float*)d_in[0]; p.xs = (const float*)d_in[1]; p.cache_cmp = (const float*)d_in[2]; p.cache_slc = (const float*)d_in[3];
    p.cache_win = (const float*)d_in[4]; p.state_C = (const float*)d_in[5]; p.state_n = (const float*)d_in[6]; p.state_m = (const float*)d_in[7];
    p.page_table = (const int*)d_in[8];
    p.w_in = (const float*)d_in[9]; p.b_in = (const float*)d_in[10]; p.norm_a_g = (const float*)d_in[11]; p.nsa_pe = (const float*)d_in[12];
    p.nsa_w_cmp = (const float*)d_in[13]; p.w_br_a = (const float*)d_in[14]; p.w_br_b = (const float*)d_in[15]; p.w_merge = (const float*)d_in[16];
    p.w_out = (const float*)d_in[17]; p.ln1_g = (const float*)d_in[18]; p.ln1_b = (const float*)d_in[19];
    p.peer_wq = (const float*)d_in[20]; p.peer_keys = (const float*)d_in[21]; p.peer_u = (const float*)d_in[22]; p.peer_v = (const float*)d_in[23];
    p.ln2_g = (const float*)d_in[24]; p.ln2_b = (const float*)d_in[25];
    p.out = (float*)d_out;
    char* w = (char*)d_ws; size_t off = 0;
    auto take = [&](size_t bytes) { char* r = w + off; off += (bytes + 255) & ~(size_t)255; return r; };
    p.bar = (unsigned*)take(16384);
    p.PW = (float*)(p.bar + 3584);
    p.WCT = (bf16_t*)take((size_t)2 * 64 * 4096 * 2);
    p.XB = (bf16_t*)take((size_t)NT * 1024 * 2);
    p.WINT = (bf16_t*)take((size_t)NPAD_IN * 1024 * 2);
    p.WMT = (bf16_t*)take((size_t)2048 * 1024 * 2);
    p.WAT = (bf16_t*)take((size_t)1024 * 1024 * 2);
    p.WBT = (bf16_t*)take((size_t)1024 * 1024 * 2);
    p.WOT = (bf16_t*)take((size_t)1024 * 1024 * 2);
    p.WQT = (bf16_t*)take((size_t)2048 * 1024 * 2);
    p.KEYSB = (bf16_t*)take((size_t)16 * 128 * 128 * 2);
    p.UB = (bf16_t*)take((size_t)16384 * 1024 * 2);
    p.VB = (bf16_t*)take((size_t)16384 * 1024 * 2);
    p.PROJ = (bf16_t*)take((size_t)NT * PS * 2);
    p.SM = (float*)take((size_t)NT * 64 * 4);
    p.BCUM = (float*)take((size_t)16 * 4096 * 4);
    p.MPREV = (float*)take(4096); p.ACOEF = (float*)take(4096); p.SCL = (float*)take(4096); p.MLOC = (float*)take(4096);
    p.DC = (float*)take((size_t)1024 * 272 * 128 * 4);
    p.CPT = (bf16_t*)take((size_t)1024 * 272 * 128 * 2);
    p.KC = (float*)take((size_t)4352 * 512 * 4);
    p.VC = p.KC + 256;
    p.OCMP = (float*)take((size_t)NT * 1024 * 4);
    p.SEL = (unsigned long long*)take((size_t)NT * 4 * 8);
    p.YA = (bf16_t*)take((size_t)NT * 1024 * 2);
    p.YB = (bf16_t*)take((size_t)NT * 1024 * 2);
    p.G = (bf16_t*)take((size_t)NT * 2048 * 2);
    p.TMP = (float*)take((size_t)NT * 1024 * 4);
    p.MERGED = (bf16_t*)take((size_t)NT * 1024 * 2);
    p.R = (float*)take((size_t)NT * 1024 * 4);
    p.H = (float*)take((size_t)NT * 1024 * 4);
    p.HB = (bf16_t*)take((size_t)NT * 1024 * 2);
    p.PQ = (bf16_t*)take((size_t)NT * 2048 * 2);
    p.EIDX = (int*)take((size_t)NT * 128 * 4);
    p.EGATE = (float*)take((size_t)NT * 128 * 4);

    (void)hipMemsetAsync(p.bar, 0, 16384, stream);
#if MK_ONE_LAUNCH
    {
        constexpr size_t kDynLds = LDS_BYTES + 16;
        (void)hipFuncSetAttribute((const void*)k_mega, hipFuncAttributeMaxDynamicSharedMemorySize, (int)kDynLds);
        int dev = 0, cus = 0, per_cu = 0;
        (void)hipGetDevice(&dev);
        (void)hipDeviceGetAttribute(&cus, hipDeviceAttributeMultiprocessorCount, dev);
        (void)hipOccupancyMaxActiveBlocksPerMultiprocessor(&per_cu, (const void*)k_mega, 512, kDynLds);
        if (per_cu < 1 || cus < 1) return;
        const int grid = cus;
        k_mega<<<dim3(grid), dim3(512), kDynLds, stream>>>(p);
    }
#else
    const int grid = 512;
    launch_stage<0>(p, grid, stream);
    launch_stage<1>(p, grid, stream);
    launch_stage<2>(p, grid, stream);
    launch_stage<3>(p, grid, stream);
    launch_stage<4>(p, grid, stream);
    launch_stage<5>(p, grid, stream);
    launch_stage<6>(p, grid, stream);
    launch_stage<7>(p, grid, stream);
    launch_stage<8>(p, grid, stream);
    launch_stage<9>(p, grid, stream);
    launch_stage<10>(p, grid, stream);
    launch_stage<11>(p, grid, stream);
    launch_stage<12>(p, grid, stream);
#endif
}
```

```cpp
#include <hip/hip_runtime.h>
#include <stdint.h>

#ifndef REP_MASK
#define REP_MASK 0
#endif
#ifndef MK_ONE_LAUNCH
#define MK_ONE_LAUNCH 1
#endif

typedef unsigned short bf16_t;
typedef short bf16x8 __attribute__((ext_vector_type(8)));
typedef float f32x4 __attribute__((ext_vector_type(4)));
typedef unsigned u32x4 __attribute__((ext_vector_type(4)));
typedef unsigned u32x2 __attribute__((ext_vector_type(2)));
typedef float f32x2 __attribute__((ext_vector_type(2)));
typedef __bf16 bf16x2_t __attribute__((ext_vector_type(2)));
#define DEVI __device__ __forceinline__

constexpr int NTP = 16384, NTS = 512, NT = NTP + NTS, DM = 1024;
constexpr int PS = 5632;
constexpr int C_AQ = 0, C_AK = 512, C_AV = 1024, C_AO = 2048, C_BQ = 3072, C_CMP = 4096, C_SLC = 4608, C_WIN = 5120;
constexpr int NPAD_IN = 5888;
constexpr float DN_ALPHA = 1.189207115002721f;
constexpr float LN_EPS = 1e-5f;
constexpr size_t O_Y = 0;
constexpr size_t O_PCMP = O_Y + (size_t)NT * 1024;
constexpr size_t O_PSLC = O_PCMP + (size_t)NTP * 512;
constexpr size_t O_PWIN = O_PSLC + (size_t)NTP * 512;
constexpr size_t O_PC = O_PWIN + (size_t)4 * 512 * 512;
constexpr size_t O_PN = O_PC + (size_t)16 * 128 * 256;
constexpr size_t O_PM = O_PN + 16 * 128;
constexpr size_t O_SCMP = O_PM + 16;
constexpr size_t O_SSLC = O_SCMP + (size_t)NTS * 512;
constexpr size_t O_SWIN = O_SSLC + (size_t)NTS * 512;
constexpr size_t O_SC = O_SWIN + (size_t)128 * 512 * 512;
constexpr size_t O_SN = O_SC + (size_t)512 * 128 * 256;
constexpr size_t O_SM = O_SN + 512 * 128;

struct P {
    const float *xp, *xs, *cache_cmp, *cache_slc, *cache_win, *state_C, *state_n, *state_m;
    const int* page_table;
    const float *w_in, *b_in, *norm_a_g, *nsa_pe, *nsa_w_cmp, *w_br_a, *w_br_b, *w_merge, *w_out, *ln1_g, *ln1_b;
    const float *peer_wq, *peer_keys, *peer_u, *peer_v, *ln2_g, *ln2_b;
    float* out;
    bf16_t *XB, *WINT, *WMT, *WAT, *WBT, *WOT, *WQT, *KEYSB, *UB, *VB, *PROJ, *WCT;
    float* PW;
    float *SM, *BCUM, *MPREV, *ACOEF, *SCL, *MLOC, *DC, *KC, *VC, *OCMP;
    bf16_t* CPT;
    unsigned char *U8, *V8;
    float *US, *VS;
    unsigned long long* SEL;
    bf16_t *YA, *YB, *G, *MERGED, *HB, *PQ;
    float *TMP, *R, *H, *EGATE;
    int* EIDX;
    unsigned* bar;
};

DEVI bf16_t f2bf(float f) { return __builtin_bit_cast(unsigned short, (__bf16)f); }
DEVI float bf2f(bf16_t h) { return __uint_as_float(((unsigned)h) << 16); }
DEVI unsigned pack2(float a, float b) { return __builtin_bit_cast(unsigned, __builtin_convertvector((f32x2){a, b}, bf16x2_t)); }
DEVI u32x4 pack8f(const f32x4 a, const f32x4 b) { u32x4 r; r[0] = pack2(a[0], a[1]); r[1] = pack2(a[2], a[3]); r[2] = pack2(b[0], b[1]); r[3] = pack2(b[2], b[3]); return r; }
DEVI float wave_max(float v) { for (int o = 32; o > 0; o >>= 1) v = fmaxf(v, __shfl_xor(v, o)); return v; }
DEVI float wave_sum(float v) { for (int o = 32; o > 0; o >>= 1) v += __shfl_xor(v, o); return v; }
DEVI float sigmoidf_(float x) { return 1.f / (1.f + __expf(-x)); }
DEVI float logsigmoidf_(float x) { return fminf(x, 0.f) - log1pf(__expf(-fabsf(x))); }
DEVI int win_map(int np) {
    if (np < 2048) return np;
    if (np < 5632) return np + 8;
    if (np < 5640) return np - 5632 + 2048;
    if (np < 5688) return np;
    return -1;
}
DEVI float alibi_slope(int h) { return exp2f(-0.5f * (float)(h + 1)); }

template <class MapFn>
DEVI void transpose_cvt(const float* __restrict__ W, bf16_t* __restrict__ WT, int K, int Nsrc, int Ndst, MapFn mapfn, float* tile  , int bid, int nblk) {
    const int tid = threadIdx.x;
    const int tn = Ndst / 64, tk = K / 64;
    for (int t = bid; t < tn * tk; t += nblk) {
        const int n0 = (t % tn) * 64, k0 = (t / tn) * 64;
        __syncthreads();
#pragma unroll
        for (int i = 0; i < 8; ++i) {
            const int kk = (tid >> 6) + i * 8, nn = tid & 63;
            const int n = mapfn(n0 + nn);
            tile[kk * 65 + nn] = n >= 0 ? W[(size_t)(k0 + kk) * Nsrc + n] : 0.f;
        }
        __syncthreads();
#pragma unroll
        for (int i = 0; i < 8; ++i) {
            const int nn = (tid >> 6) + i * 8, kk = tid & 63;
            WT[(size_t)(n0 + nn) * K + k0 + kk] = f2bf(tile[kk * 65 + nn]);
        }
    }
}
struct IdMap { DEVI int operator()(int n) const { return n; } };
struct WinMap { DEVI int operator()(int n) const { return win_map(n); } };

DEVI void cvt_rows(const float* __restrict__ src, bf16_t* __restrict__ dst, size_t n4, int bid, int nblk) {
    for (size_t i = (size_t)bid * blockDim.x + threadIdx.x; i < n4; i += (size_t)nblk * blockDim.x) {
        const f32x4 v = ((const f32x4*)src)[i];
        u32x2 o; o.x = pack2(v.x, v.y); o.y = pack2(v.z, v.w);
        ((u32x2*)dst)[i] = o;
    }
}

DEVI void stage_prologue(const P& p, char* smem, int bid, int nblk) {
    float* tile = (float*)smem;
    cvt_rows(p.xp, p.XB, (size_t)NTP * 256, bid, nblk);
    cvt_rows(p.xs, p.XB + (size_t)NTP * 1024, (size_t)NTS * 256, bid, nblk);
    {
        const int lane = threadIdx.x & 63, wid = threadIdx.x >> 6;
        for (int r = bid * 8 + wid; r < 2 * 16384; r += nblk * 8) {
            const bool isv = r >= 16384; const int e = isv ? r - 16384 : r;
            const float* src = (isv ? p.peer_v : p.peer_u) + (size_t)e * 1024 + lane * 16;
            f32x4 x[4]; float am = 0.f;
#pragma unroll
            for (int i = 0; i < 4; ++i) { x[i] = *(const f32x4*)(src + i * 4);
#pragma unroll
                for (int k = 0; k < 4; ++k) am = fmaxf(am, fabsf(x[i][k])); }
            am = wave_max(am);
            const float inv = am > 0.f ? 448.f / am : 1.f;
            u32x4 o;
#pragma unroll
            for (int i = 0; i < 4; ++i) { int w = __builtin_amdgcn_cvt_pk_fp8_f32(x[i][0] * inv, x[i][1] * inv, 0, false); w = __builtin_amdgcn_cvt_pk_fp8_f32(x[i][2] * inv, x[i][3] * inv, w, true); o[i] = (unsigned)w; }
            *(u32x4*)((isv ? p.V8 : p.U8) + (size_t)e * 1024 + lane * 16) = o;
            if (lane == 0) (isv ? p.VS : p.US)[e] = am > 0.f ? am / 448.f : 1.f;
        }
    }
    cvt_rows(p.peer_keys, p.KEYSB, (size_t)16 * 128 * 128 / 4, bid, nblk);
    transpose_cvt(p.w_in, p.WINT, 1024, 5688, NPAD_IN, WinMap(), tile, bid, nblk);
    transpose_cvt(p.w_merge, p.WMT, 1024, 2048, 2048, IdMap(), tile, bid, nblk);
    transpose_cvt(p.w_br_a, p.WAT, 1024, 1024, 1024, IdMap(), tile, bid, nblk);
    transpose_cvt(p.w_br_b, p.WBT, 1024, 1024, 1024, IdMap(), tile, bid, nblk);
    transpose_cvt(p.w_out, p.WOT, 1024, 1024, 1024, IdMap(), tile, bid, nblk);
    transpose_cvt(p.peer_wq, p.WQT, 1024, 2048, 2048, IdMap(), tile, bid, nblk);
    transpose_cvt(p.nsa_w_cmp, p.WCT, 4096, 64, 64, IdMap(), tile, bid, nblk);
    transpose_cvt(p.nsa_w_cmp + 4096 * 64, p.WCT + 64 * 4096, 4096, 64, 64, IdMap(), tile, bid, nblk);
    for (int blk = bid; blk < 32; blk += nblk) {
        const int tid = threadIdx.x, kvv = tid >> 8, e = tid & 63, kq = (tid >> 6) & 3;
        float a = 0.f;
        for (int k = blk * 128 + kq * 32; k < blk * 128 + kq * 32 + 32; ++k) a += p.nsa_pe[kvv * 4096 + k] * p.nsa_w_cmp[((size_t)kvv * 4096 + k) * 64 + e];
        atomicAdd(p.PW + kvv * 64 + e, a);
    }
    {
        const size_t per_b = (size_t)508 * 512 / 4;
        for (size_t i = (size_t)bid * blockDim.x + threadIdx.x; i < 128 * per_b; i += (size_t)nblk * blockDim.x) {
            const size_t b = i / per_b, r = i % per_b;
            ((f32x4*)(p.out + O_SWIN + b * 512 * 512))[r] = ((const f32x4*)(p.cache_win + b * 512 * 512 + 4 * 512))[r];
        }
    }
}

template <class Epi>
DEVI void gemm_phase(const bf16_t* __restrict__ A, const bf16_t* __restrict__ Bt, int M, int N, int K, const Epi& epi, char* smem, int bid, int nblk) {
    bf16_t* As = (bf16_t*)smem;
    bf16_t* Bs = As + 256 * 72;
    const int tid = threadIdx.x, lane = tid & 63, wid = tid >> 6, wm = wid >> 1, wn = wid & 1;
    const int fr = lane & 15, fq = lane >> 4;
    const int ntm = M / 256, ntn = N / 128, nk = K / 64;
    for (int tile = bid; tile < ntm * ntn; tile += nblk) {
        const int tm = tile / ntn, tn = tile % ntn;
        f32x4 acc[4][4];
#pragma unroll
        for (int i = 0; i < 4; ++i)
#pragma unroll
            for (int j = 0; j < 4; ++j) acc[i][j] = (f32x4){0.f, 0.f, 0.f, 0.f};
        const bf16_t* Ag = A + (size_t)(tm * 256 + (tid >> 1)) * K + (tid & 1) * 32;
        const bf16_t* Bg = Bt + (size_t)(tn * 128 + (tid >> 2)) * K + (tid & 3) * 16;
        u32x4 ra[4], rb[2];
#pragma unroll
        for (int i = 0; i < 4; ++i) ra[i] = *(const u32x4*)(Ag + i * 8);
#pragma unroll
        for (int i = 0; i < 2; ++i) rb[i] = *(const u32x4*)(Bg + i * 8);
        for (int kt = 0; kt < nk; ++kt) {
            __syncthreads();
#pragma unroll
            for (int i = 0; i < 4; ++i) *(u32x4*)(As + (tid >> 1) * 72 + (tid & 1) * 32 + i * 8) = ra[i];
#pragma unroll
            for (int i = 0; i < 2; ++i) *(u32x4*)(Bs + (tid >> 2) * 72 + (tid & 3) * 16 + i * 8) = rb[i];
            __syncthreads();
            if (kt + 1 < nk) {
#pragma unroll
                for (int i = 0; i < 4; ++i) ra[i] = *(const u32x4*)(Ag + (kt + 1) * 64 + i * 8);
#pragma unroll
                for (int i = 0; i < 2; ++i) rb[i] = *(const u32x4*)(Bg + (kt + 1) * 64 + i * 8);
            }
#pragma unroll
            for (int ks = 0; ks < 2; ++ks) {
                bf16x8 af[4], bfr[4];
#pragma unroll
                for (int i = 0; i < 4; ++i) af[i] = *(const bf16x8*)(As + (wm * 64 + i * 16 + fr) * 72 + ks * 32 + fq * 8);
#pragma unroll
                for (int j = 0; j < 4; ++j) bfr[j] = *(const bf16x8*)(Bs + (wn * 64 + j * 16 + fr) * 72 + ks * 32 + fq * 8);
#pragma unroll
                for (int i = 0; i < 4; ++i)
#pragma unroll
                    for (int j = 0; j < 4; ++j) acc[i][j] = __builtin_amdgcn_mfma_f32_16x16x32_bf16(bfr[j], af[i], acc[i][j], 0, 0, 0);
            }
        }
#pragma unroll
        for (int i = 0; i < 4; ++i)
#pragma unroll
            for (int j = 0; j < 4; ++j) epi(tm * 256 + wm * 64 + i * 16 + fr, tn * 128 + wn * 64 + j * 16 + fq * 4, acc[i][j]);
    }
}

struct NoPre {};
struct EpiInProj {
    P p;
    typedef f32x4 Pre;
    static constexpr int BATCH = 0;
    DEVI Pre pre(int row, int col) const {
        f32x4 b = {0.f, 0.f, 0.f, 0.f};
        if (col < 5688) { const int oc = win_map(col);
#pragma unroll
            for (int q = 0; q < 4; ++q) b[q] = p.b_in[oc + q]; }
        return b;
    }
    DEVI void put(int row, int col, f32x4 v, const Pre& bias) const {
        if (col >= 5688) return;
        v += bias;
        if (col >= 5632) { *(f32x4*)(p.SM + (size_t)row * 64 + (col - 5632)) = v; return; }
        if (col >= C_AK && col < C_AV) v *= 0.08838834764831845f;
        u32x2 o; o.x = pack2(v[0], v[1]); o.y = pack2(v[2], v[3]);
        *(u32x2*)(p.PROJ + (size_t)row * PS + col) = o;
        if (col >= C_CMP) {
            const int reg = (col - C_CMP) >> 9, c = (col - C_CMP) & 511;
            float* dst = nullptr;
            if (row < NTP) {
                if (reg == 0) dst = p.out + O_PCMP + (size_t)row * 512 + c;
                else if (reg == 1) dst = p.out + O_PSLC + (size_t)row * 512 + c;
                else { const int b = row >> 12, t = row & 4095; if (t >= 3584) dst = p.out + O_PWIN + ((size_t)b * 512 + (t - 3584)) * 512 + c; }
            } else {
                const int rs = row - NTP;
                if (reg == 0) dst = p.out + O_SCMP + (size_t)rs * 512 + c;
                else if (reg == 1) dst = p.out + O_SSLC + (size_t)rs * 512 + c;
                else { const int b = rs >> 2, tq = rs & 3; dst = p.out + O_SWIN + ((size_t)b * 512 + 508 + tq) * 512 + c; }
            }
            if (dst) *(f32x4*)dst = v;
        }
    }
};
struct EpiG {
    P p;
    typedef NoPre Pre;
    static constexpr int BATCH = 4;
    DEVI Pre pre(int, int) const { return NoPre(); }
    DEVI void put(int row, int col, f32x4 v, const Pre&) const {
        u32x2 o; o.x = pack2(sigmoidf_(v[0]), sigmoidf_(v[1])); o.y = pack2(sigmoidf_(v[2]), sigmoidf_(v[3]));
        *(u32x2*)(p.G + (size_t)row * 2048 + col) = o;
    }
};
struct EpiM1 {
    P p;
    typedef u32x2 Pre;
    static constexpr int BATCH = 16;
    DEVI Pre pre(int row, int col) const { return *(const u32x2*)(p.G + (size_t)row * 2048 + col); }
    DEVI void put(int row, int col, f32x4 v, const Pre& g) const {
        v[0] *= __uint_as_float(g.x << 16); v[1] *= __uint_as_float(g.x & 0xFFFF0000u);
        v[2] *= __uint_as_float(g.y << 16); v[3] *= __uint_as_float(g.y & 0xFFFF0000u);
        *(f32x4*)(p.TMP + (size_t)row * 1024 + col) = v;
    }
};
struct PreM2 { u32x2 g; f32x4 t; };
struct EpiM2 {
    P p;
    typedef PreM2 Pre;
    static constexpr int BATCH = 8;
    DEVI Pre pre(int row, int col) const { PreM2 r; r.g = *(const u32x2*)(p.G + (size_t)row * 2048 + 1024 + col); r.t = *(const f32x4*)(p.TMP + (size_t)row * 1024 + col); return r; }
    DEVI void put(int row, int col, f32x4 v, const Pre& q) const {
        v[0] = q.t[0] + v[0] * __uint_as_float(q.g.x << 16); v[1] = q.t[1] + v[1] * __uint_as_float(q.g.x & 0xFFFF0000u);
        v[2] = q.t[2] + v[2] * __uint_as_float(q.g.y << 16); v[3] = q.t[3] + v[3] * __uint_as_float(q.g.y & 0xFFFF0000u);
        u32x2 o; o.x = pack2(v[0], v[1]); o.y = pack2(v[2], v[3]);
        *(u32x2*)(p.MERGED + (size_t)row * 1024 + col) = o;
    }
};
struct EpiR {
    P p;
    typedef f32x4 Pre;
    static constexpr int BATCH = 16;
    DEVI Pre pre(int row, int col) const {
        const float* xr = row < NTP ? p.xp + (size_t)row * 1024 : p.xs + (size_t)(row - NTP) * 1024;
        return *(const f32x4*)(xr + col);
    }
    DEVI void put(int row, int col, f32x4 v, const Pre& x) const { *(f32x4*)(p.R + (size_t)row * 1024 + col) = x * DN_ALPHA + v; }
};
struct EpiPQ {
    P p;
    typedef NoPre Pre;
    static constexpr int BATCH = 4;
    DEVI Pre pre(int, int) const { return NoPre(); }
    DEVI void put(int row, int col, f32x4 v, const Pre&) const {
        u32x2 o; o.x = pack2(v[0], v[1]); o.y = pack2(v[2], v[3]);
        *(u32x2*)(p.PQ + (size_t)row * 2048 + col) = o;
    }
};

DEVI void stage_mlstm_gates(const P& p, char* smem, int bid, int nblk) {
    const int lane = threadIdx.x & 63, wid = threadIdx.x >> 6;
    float* bend_s = (float*)smem; float* mloc_s = bend_s + 64;
    for (int bh = bid; bh < 16; bh += nblk) {
        const int b = bh >> 2, h = bh & 3;
        __syncthreads();
        for (int cc = 0; cc < 8; ++cc) {
            const int c = wid * 8 + cc;
            const size_t row = (size_t)b * 4096 + c * 64 + lane;
            const float ip = p.SM[row * 64 + h];
            const float lf = logsigmoidf_(p.SM[row * 64 + 4 + h]);
            float cs = lf;
#pragma unroll
            for (int o = 1; o < 64; o <<= 1) { const float t = __shfl_up(cs, o); if (lane >= o) cs += t; }
            p.BCUM[bh * 4096 + c * 64 + lane] = cs;
            const float bend = __shfl(cs, 63);
            const float mloc = wave_max(bend - cs + ip);
            if (lane == 0) { bend_s[c] = bend; mloc_s[c] = mloc; }
        }
        __syncthreads();
        if (threadIdx.x == 0) {
            float m = 0.f;
            for (int c = 0; c < 64; ++c) {
                const float bend = bend_s[c], mloc = mloc_s[c];
                const float mnew = fmaxf(bend + m, mloc);
                p.MPREV[bh * 64 + c] = m;
                p.ACOEF[bh * 64 + c] = __expf(bend + m - mnew);
                p.SCL[bh * 64 + c] = __expf(mloc - mnew);
                p.MLOC[bh * 64 + c] = mloc;
                m = mnew;
            }
            p.out[O_PM + bh] = m;
        }
    }
}

constexpr int MD_KT = 0, MD_VT = 128 * 144, MD_WS = MD_VT + 272 * 144, MD_LDS = MD_WS + 256;
DEVI void stage_mlstm_dc(const P& p, char* smem, int bid, int nblk) {
    const int tid = threadIdx.x, lane = tid & 63, wid = tid >> 6, fr = lane & 15, fq = lane >> 4;
    bf16_t* Kt = (bf16_t*)(smem + MD_KT);
    bf16_t* Vt = (bf16_t*)(smem + MD_VT);
    float* ws = (float*)(smem + MD_WS);
    for (int task = bid; task < 1024; task += nblk) {
        const int bh = task >> 6, c = task & 63, b = bh >> 2, h = bh & 3;
        const size_t row0 = (size_t)b * 4096 + c * 64;
        __syncthreads();
        if (tid < 64) {
            const float bend = p.BCUM[bh * 4096 + c * 64 + 63];
            const float g = bend - p.BCUM[bh * 4096 + c * 64 + tid] + p.SM[(row0 + tid) * 64 + h];
            ws[tid] = __expf(g - p.MLOC[task]);
        }
        __syncthreads();
        {
            const int sidx = tid & 63, ch = tid >> 6;
            const float w = ws[sidx];
#pragma unroll
            for (int half = 0; half < 2; ++half) {
                const u32x4 kk = *(const u32x4*)(p.PROJ + (row0 + sidx) * PS + C_AK + h * 128 + half * 64 + ch * 8);
#pragma unroll
                for (int e = 0; e < 4; ++e) {
                    Kt[(half * 64 + ch * 8 + e * 2) * 72 + sidx] = f2bf(w * __uint_as_float(kk[e] << 16));
                    Kt[(half * 64 + ch * 8 + e * 2 + 1) * 72 + sidx] = f2bf(w * __uint_as_float(kk[e] & 0xFFFF0000u));
                }
            }
#pragma unroll
            for (int q4 = 0; q4 < 4; ++q4) {
                const u32x4 vv = *(const u32x4*)(p.PROJ + (row0 + sidx) * PS + C_AV + h * 256 + q4 * 64 + ch * 8);
#pragma unroll
                for (int e = 0; e < 4; ++e) {
                    Vt[(q4 * 64 + ch * 8 + e * 2) * 72 + sidx] = (bf16_t)(vv[e] & 0xFFFFu);
                    Vt[(q4 * 64 + ch * 8 + e * 2 + 1) * 72 + sidx] = (bf16_t)(vv[e] >> 16);
                }
            }
            for (int i = tid; i < 16 * 64; i += 512) Vt[(256 + (i >> 6)) * 72 + (i & 63)] = (i >> 6) == 0 ? (bf16_t)0x3F80 : (bf16_t)0;
        }
        __syncthreads();
        const int nvt = wid == 0 ? 3 : 2;
        for (int vi = 0; vi < nvt; ++vi) {
            const int vt = vi < 2 ? wid * 2 + vi : 16;
            f32x4 acc[8];
#pragma unroll
            for (int dt = 0; dt < 8; ++dt) acc[dt] = (f32x4){0.f, 0.f, 0.f, 0.f};
#pragma unroll
            for (int ks = 0; ks < 2; ++ks) {
                const bf16x8 bf = *(const bf16x8*)(Vt + (vt * 16 + fr) * 72 + ks * 32 + fq * 8);
#pragma unroll
                for (int dt = 0; dt < 8; ++dt) {
                    const bf16x8 af = *(const bf16x8*)(Kt + (dt * 16 + fr) * 72 + ks * 32 + fq * 8);
                    acc[dt] = __builtin_amdgcn_mfma_f32_16x16x32_bf16(af, bf, acc[dt], 0, 0, 0);
                }
            }
            const int v = vt * 16 + fr;
            if (v <= 256) {
#pragma unroll
                for (int dt = 0; dt < 8; ++dt) *(f32x4*)(p.DC + ((size_t)task * 272 + v) * 128 + dt * 16 + fq * 4) = acc[dt];
            }
        }
    }
}

DEVI void stage_mlstm_scan(const P& p, int bid, int nblk) {
    for (int e = bid * blockDim.x + threadIdx.x; e < 16 * 257 * 128; e += nblk * blockDim.x) {
        const int bh = e / (257 * 128), r = e % (257 * 128), v = r >> 7, d = r & 127;
        float C = 0.f;
#pragma unroll 8
        for (int c = 0; c < 64; ++c) {
            const size_t idx = ((size_t)(bh * 64 + c) * 272 + v) * 128 + d;
            p.CPT[idx] = f2bf(C);
            C = p.ACOEF[bh * 64 + c] * C + p.SCL[bh * 64 + c] * p.DC[idx];
        }
        if (v < 256) p.out[O_PC + ((size_t)bh * 128 + d) * 256 + v] = C; else p.out[O_PN + bh * 128 + d] = C;
    }
}

constexpr int MO_Q = 0, MO_K = 64 * 272, MO_VT = MO_K + 64 * 272, MO_P = MO_VT + 272 * 144, MO_SC = MO_P + 64 * 144, MO_HS = MO_SC + 2048, MO_LDS = MO_HS + 64 * 256 * 4;
static_assert(MO_LDS <= 152 * 1024, "lds");
DEVI void stage_mlstm_out(const P& p, char* smem, int bid, int nblk) {
    const int tid = threadIdx.x, lane = tid & 63, wid = tid >> 6, fr = lane & 15, fq = lane >> 4;
    bf16_t* Qs = (bf16_t*)(smem + MO_Q);
    bf16_t* Ks = (bf16_t*)(smem + MO_K);
    bf16_t* Vt = (bf16_t*)(smem + MO_VT);
    bf16_t* Ps = (bf16_t*)(smem + MO_P);
    float* sc = (float*)(smem + MO_SC);
    float* rowt = sc; float* colt = sc + 64; float* wint = sc + 128; float* emt = sc + 192; float* den = sc + 256;
    float* hs = (float*)(smem + MO_HS);
    for (int task = bid; task < 1024; task += nblk) {
        const int bh = task >> 6, c = task & 63, b = bh >> 2, h = bh & 3;
        const size_t row0 = (size_t)b * 4096 + c * 64;
        __syncthreads();
        {
            for (int i = tid; i < 64 * 16; i += 512) {
                const int t = i >> 4, ch = i & 15;
                *(u32x4*)(Qs + t * 136 + ch * 8) = *(const u32x4*)(p.PROJ + (row0 + t) * PS + C_AQ + h * 128 + ch * 8);
                *(u32x4*)(Ks + t * 136 + ch * 8) = *(const u32x4*)(p.PROJ + (row0 + t) * PS + C_AK + h * 128 + ch * 8);
            }
            const int sidx = tid & 63, ch = tid >> 6;
#pragma unroll
            for (int q4 = 0; q4 < 4; ++q4) {
                const u32x4 vv = *(const u32x4*)(p.PROJ + (row0 + sidx) * PS + C_AV + h * 256 + q4 * 64 + ch * 8);
#pragma unroll
                for (int e = 0; e < 4; ++e) {
                    Vt[(q4 * 64 + ch * 8 + e * 2) * 72 + sidx] = (bf16_t)(vv[e] & 0xFFFFu);
                    Vt[(q4 * 64 + ch * 8 + e * 2 + 1) * 72 + sidx] = (bf16_t)(vv[e] >> 16);
                }
            }
            for (int i = tid; i < 16 * 64; i += 512) Vt[(256 + (i >> 6)) * 72 + (i & 63)] = (i >> 6) == 0 ? (bf16_t)0x3F80 : (bf16_t)0;
            if (wid == 0) {
                const float bc = p.BCUM[bh * 4096 + c * 64 + lane], ip = p.SM[(row0 + lane) * 64 + h];
                const float mprev = p.MPREV[task];
                float pm = ip - bc;
#pragma unroll
                for (int o = 1; o < 64; o <<= 1) { const float t = __shfl_up(pm, o); if (lane >= o) pm = fmaxf(pm, t); }
                const float mt = fmaxf(bc + mprev, bc + pm);
                rowt[lane] = bc - mt; colt[lane] = ip - bc; wint[lane] = __expf(bc + mprev - mt); emt[lane] = __expf(-mt);
            }
        }
        __syncthreads();
        {
            const int tt = wid >> 1;
#pragma unroll
            for (int si = 0; si < 2; ++si) {
                const int st = (wid & 1) * 2 + si;
                f32x4 acc = (f32x4){0.f, 0.f, 0.f, 0.f};
                if (st <= tt) {
#pragma unroll
                    for (int ks = 0; ks < 4; ++ks) {
                        const bf16x8 af = *(const bf16x8*)(Qs + (tt * 16 + fr) * 136 + ks * 32 + fq * 8);
                        const bf16x8 bf = *(const bf16x8*)(Ks + (st * 16 + fr) * 136 + ks * 32 + fq * 8);
                        acc = __builtin_amdgcn_mfma_f32_16x16x32_bf16(af, bf, acc, 0, 0, 0);
                    }
                }
                const int s = st * 16 + fr; const float ct = colt[s];
#pragma unroll
                for (int r = 0; r < 4; ++r) {
                    const int t = tt * 16 + fq * 4 + r;
                    const float pv = (s <= t) ? acc[r] * __expf(rowt[t] + ct) : 0.f;
                    Ps[t * 72 + s] = f2bf(pv);
                }
            }
        }
        __syncthreads();
        {
            const bf16_t* cpt = p.CPT + (size_t)task * 272 * 128;
            f32x4 acc[4][2];
#pragma unroll
            for (int tt = 0; tt < 4; ++tt)
#pragma unroll
                for (int vi = 0; vi < 2; ++vi) acc[tt][vi] = (f32x4){0.f, 0.f, 0.f, 0.f};
            f32x4 accd = (f32x4){0.f, 0.f, 0.f, 0.f};
#pragma unroll
            for (int ks = 0; ks < 4; ++ks) {
                bf16x8 af[4];
#pragma unroll
                for (int tt = 0; tt < 4; ++tt) af[tt] = *(const bf16x8*)(Qs + (tt * 16 + fr) * 136 + ks * 32 + fq * 8);
#pragma unroll
                for (int vi = 0; vi < 2; ++vi) {
                    const bf16x8 bf = *(const bf16x8*)(cpt + (size_t)((wid * 2 + vi) * 16 + fr) * 128 + ks * 32 + fq * 8);
#pragma unroll
                    for (int tt = 0; tt < 4; ++tt) acc[tt][vi] = __builtin_amdgcn_mfma_f32_16x16x32_bf16(af[tt], bf, acc[tt][vi], 0, 0, 0);
                }
                if (wid < 4) {
                    const bf16x8 bf = *(const bf16x8*)(cpt + (size_t)(256 + fr) * 128 + ks * 32 + fq * 8);
                    const bf16x8 a2 = *(const bf16x8*)(Qs + (wid * 16 + fr) * 136 + ks * 32 + fq * 8);
                    accd = __builtin_amdgcn_mfma_f32_16x16x32_bf16(a2, bf, accd, 0, 0, 0);
                }
            }
#pragma unroll
            for (int tt = 0; tt < 4; ++tt) {
                const f32x4 wv = *(const f32x4*)(wint + tt * 16 + fq * 4);
#pragma unroll
                for (int vi = 0; vi < 2; ++vi) acc[tt][vi] *= wv;
            }
            if (wid < 4) accd *= *(const f32x4*)(wint + wid * 16 + fq * 4);
#pragma unroll
            for (int ks = 0; ks < 2; ++ks) {
                bf16x8 af[4];
#pragma unroll
                for (int tt = 0; tt < 4; ++tt) af[tt] = *(const bf16x8*)(Ps + (tt * 16 + fr) * 72 + ks * 32 + fq * 8);
#pragma unroll
                for (int vi = 0; vi < 2; ++vi) {
                    const bf16x8 bf = *(const bf16x8*)(Vt + ((wid * 2 + vi) * 16 + fr) * 72 + ks * 32 + fq * 8);
#pragma unroll
                    for (int tt = 0; tt < 4; ++tt) acc[tt][vi] = __builtin_amdgcn_mfma_f32_16x16x32_bf16(af[tt], bf, acc[tt][vi], 0, 0, 0);
                }
                if (wid < 4) {
                    const bf16x8 bf = *(const bf16x8*)(Vt + (256 + fr) * 72 + ks * 32 + fq * 8);
                    const bf16x8 a2 = *(const bf16x8*)(Ps + (wid * 16 + fr) * 72 + ks * 32 + fq * 8);
                    accd = __builtin_amdgcn_mfma_f32_16x16x32_bf16(a2, bf, accd, 0, 0, 0);
                }
            }
            if (wid < 4 && fr == 0) *(f32x4*)(den + wid * 16 + fq * 4) = accd;
            __syncthreads();
#pragma unroll
            for (int tt = 0; tt < 4; ++tt) {
                const f32x4 dv = *(const f32x4*)(den + tt * 16 + fq * 4), ev = *(const f32x4*)(emt + tt * 16 + fq * 4);
#pragma unroll
                for (int vi = 0; vi < 2; ++vi)
#pragma unroll
                    for (int r = 0; r < 4; ++r) hs[(tt * 16 + fq * 4 + r) * 256 + (wid * 2 + vi) * 16 + fr] = acc[tt][vi][r] / fmaxf(fabsf(dv[r]), ev[r]);
            }
        }
        __syncthreads();
        for (int rr = 0; rr < 8; ++rr) {
            const int t = wid * 8 + rr;
            const f32x4 x = *(const f32x4*)(hs + t * 256 + lane * 4);
            const float mean = wave_sum(x[0] + x[1] + x[2] + x[3]) * (1.f / 256.f);
            float q = 0.f;
#pragma unroll
            for (int k = 0; k < 4; ++k) q += (x[k] - mean) * (x[k] - mean);
            const float rs = rsqrtf(wave_sum(q) * (1.f / 256.f) + LN_EPS);
            const u32x2 ov = *(const u32x2*)(p.PROJ + (row0 + t) * PS + C_AO + h * 256 + lane * 4);
            const f32x4 gg = *(const f32x4*)(p.norm_a_g + h * 256 + lane * 4);
            const float o4[4] = {__uint_as_float(ov.x << 16), __uint_as_float(ov.x & 0xFFFF0000u), __uint_as_float(ov.y << 16), __uint_as_float(ov.y & 0xFFFF0000u)};
            float y[4];
#pragma unroll
            for (int k = 0; k < 4; ++k) y[k] = (x[k] - mean) * rs * gg[k] * sigmoidf_(o4[k]);
            u32x2 o2; o2.x = pack2(y[0], y[1]); o2.y = pack2(y[2], y[3]);
            *(u32x2*)(p.YA + (row0 + t) * 1024 + h * 256 + lane * 4) = o2;
        }
    }
}

DEVI void stage_mlstm_sample(const P& p, char* smem, int bid, int nblk) {
    float* qs = (float*)smem;
    float* ks = qs + 512;
    float* vs = ks + 512;
    float* part = vs + 1024;
    float* hs = part + 2048;
    float* sc = hs + 1024;
    float* bc = sc; float* ip = sc + 4; float* mt = sc + 8; float* wint = sc + 12; float* emt = sc + 16; float* ww = sc + 20; float* den = sc + 24;
    float* Pm = sc + 32;
    float* misc = sc + 48;
    const int tid = threadIdx.x, lane = tid & 63, wid = tid >> 6;
    for (int task = bid; task < 512; task += nblk) {
        const int b = task >> 2, h = task & 3;
        const size_t row0 = (size_t)NTP + b * 4;
        __syncthreads();
        { const int t = tid >> 7, d = tid & 127;
          qs[tid] = bf2f(p.PROJ[(row0 + t) * PS + C_AQ + h * 128 + d]);
          ks[tid] = bf2f(p.PROJ[(row0 + t) * PS + C_AK + h * 128 + d]); }
        for (int idx = tid; idx < 1024; idx += 512) { const int t = idx >> 8, v = idx & 255; vs[idx] = bf2f(p.PROJ[(row0 + t) * PS + C_AV + h * 256 + v]); }
        if (tid == 0) {
            const float m0 = p.state_m[task];
            float cs = 0.f;
            for (int t = 0; t < 4; ++t) { cs += logsigmoidf_(p.SM[(row0 + t) * 64 + 4 + h]); bc[t] = cs; ip[t] = p.SM[(row0 + t) * 64 + h]; }
            for (int t = 0; t < 4; ++t) {
                float mx = bc[t] + m0;
                for (int s = 0; s <= t; ++s) mx = fmaxf(mx, bc[t] - bc[s] + ip[s]);
                mt[t] = mx; wint[t] = __expf(bc[t] + m0 - mx); emt[t] = __expf(-mx);
            }
            const float bend = bc[3];
            float mnew = bend + m0;
            for (int s = 0; s < 4; ++s) mnew = fmaxf(mnew, bend - bc[s] + ip[s]);
            misc[0] = __expf(bend + m0 - mnew);
            for (int s = 0; s < 4; ++s) ww[s] = __expf(bend - bc[s] + ip[s] - mnew);
            p.out[O_SM + task] = mnew;
        }
        __syncthreads();
        if (tid < 16) {
            const int t = tid >> 2, s = tid & 3;
            float a = 0.f;
            if (s <= t) { for (int d = 0; d < 128; ++d) a += qs[t * 128 + d] * ks[s * 128 + d]; a *= __expf(bc[t] - bc[s] + ip[s] - mt[t]); }
            Pm[tid] = a;
        }
        __syncthreads();
        if (tid < 4) {
            const int t = tid; float qn = 0.f;
            for (int d = 0; d < 128; ++d) qn += qs[t * 128 + d] * p.state_n[(size_t)task * 128 + d];
            den[t] = wint[t] * qn + Pm[t * 4] + Pm[t * 4 + 1] + Pm[t * 4 + 2] + Pm[t * 4 + 3];
        }
        const float a = misc[0];
        if (tid >= 128 && tid < 256) {
            const int d = tid - 128;
            float n = a * p.state_n[(size_t)task * 128 + d];
            for (int s = 0; s < 4; ++s) n += ww[s] * ks[s * 128 + d];
            p.out[O_SN + (size_t)task * 128 + d] = n;
        }
        {
            const int v = tid & 255, dh = tid >> 8;
            float acc[4] = {0.f, 0.f, 0.f, 0.f};
            float wv[4];
#pragma unroll
            for (int s = 0; s < 4; ++s) wv[s] = ww[s] * vs[s * 256 + v];
            for (int d0 = dh * 64; d0 < dh * 64 + 64; d0 += 16) {
                float c0[16];
#pragma unroll
                for (int i = 0; i < 16; ++i) c0[i] = __builtin_nontemporal_load(p.state_C + ((size_t)task * 128 + d0 + i) * 256 + v);
#pragma unroll
                for (int i = 0; i < 16; ++i) {
                    const int d = d0 + i;
#pragma unroll
                    for (int t = 0; t < 4; ++t) acc[t] += qs[t * 128 + d] * c0[i];
                    float cn = a * c0[i];
#pragma unroll
                    for (int s = 0; s < 4; ++s) cn += ks[s * 128 + d] * wv[s];
                    __builtin_nontemporal_store(cn, p.out + O_SC + ((size_t)task * 128 + d) * 256 + v);
                }
            }
#pragma unroll
            for (int t = 0; t < 4; ++t) part[(dh * 4 + t) * 256 + v] = acc[t];
        }
        __syncthreads();
        if (tid < 256) {
            const int v = tid;
#pragma unroll
            for (int t = 0; t < 4; ++t) {
                float num = wint[t] * (part[t * 256 + v] + part[(4 + t) * 256 + v]);
#pragma unroll
                for (int s = 0; s < 4; ++s) num += Pm[t * 4 + s] * vs[s * 256 + v];
                hs[t * 256 + v] = num / fmaxf(fabsf(den[t]), emt[t]);
            }
        }
        __syncthreads();
        if (wid < 4) {
            const int t = wid;
            const f32x4 x = *(const f32x4*)(hs + t * 256 + lane * 4);
            const float mean = wave_sum(x[0] + x[1] + x[2] + x[3]) * (1.f / 256.f);
            float q = 0.f;
#pragma unroll
            for (int k = 0; k < 4; ++k) q += (x[k] - mean) * (x[k] - mean);
            const float rs = rsqrtf(wave_sum(q) * (1.f / 256.f) + LN_EPS);
            float y[4];
#pragma unroll
            for (int k = 0; k < 4; ++k) {
                const int vi = lane * 4 + k;
                const float o = bf2f(p.PROJ[(row0 + t) * PS + C_AO + h * 256 + vi]);
                y[k] = (x[k] - mean) * rs * p.norm_a_g[h * 256 + vi] * sigmoidf_(o);
            }
            u32x2 o2; o2.x = pack2(y[0], y[1]); o2.y = pack2(y[2], y[3]);
            *(u32x2*)(p.YA + (row0 + t) * 1024 + h * 256 + lane * 4) = o2;
        }
    }
}

constexpr int CP_ABUF = 33280, CP_WBUF = 18432, CP_A = 0, CP_W = 2 * CP_ABUF, CP_LDS = CP_W + 2 * CP_WBUF;
constexpr int CP_AROW = 1024 + 8;
DEVI void stage_compress(const P& p, char* smem, int bid, int nblk) {
    const int tid = threadIdx.x, lane = tid & 63, wid = tid >> 6, fr = lane & 15, fq = lane >> 4;
    const int kv = wid & 1, rt = wid >> 1;
    for (int it = 0; it < 2; ++it) {
        const int task = it == 0 ? bid : 256 + (nblk - 1 - bid);
        if (task >= 272 || (it == 0 && task >= 256)) continue;
        const bool prompt = task >= 256;
        const int rowbytes = prompt ? 1024 : 2048, npieces = prompt ? 2 : 4;
        const char* src[4]; int dsto[4];
#pragma unroll
        for (int q = 0; q < 4; ++q) {
            const int off = q * 8192 + tid * 16, r = off / rowbytes, cb = off % rowbytes;
            if (prompt) { const int blk = (task - 256) * 16 + (r & 15); src[q] = (const char*)(p.PROJ + (size_t)blk * 64 * PS + C_CMP) + cb; dsto[q] = (r & 15) * CP_AROW * 2 + cb; }
            else { const int gb = task * 16 + r, b = gb >> 5, n = gb & 31; const int page = p.page_table[b * 16 + (n >> 1)];
                   src[q] = (const char*)(p.cache_cmp + ((size_t)page * 128 + (n & 1) * 64) * 512) + cb; dsto[q] = r * CP_AROW * 2 + (cb >> 1); }
        }
        const size_t sstride = prompt ? (size_t)PS * 2 : 2048;
        const char* wsrc[2]; int wdst[2];
#pragma unroll
        for (int q = 0; q < 2; ++q) { const int idx = q * 512 + tid, row = idx >> 3, ch = idx & 7; wsrc[q] = (const char*)(p.WCT + (size_t)row * 4096) + ch * 16; wdst[q] = row * 144 + ch * 16; }
        f32x4 acc[4];
#pragma unroll
        for (int nt = 0; nt < 4; ++nt) acc[nt] = (f32x4){0.f, 0.f, 0.f, 0.f};
        f32x4 ra0[4], ra1[4]; u32x4 rw0[2], rw1[2];
        auto issue = [&](int l, f32x4 (&ra)[4], u32x4 (&rw)[2]) {
#pragma unroll
            for (int q = 0; q < 4; ++q) if (q < npieces) ra[q] = *(const f32x4*)(src[q] + (size_t)l * sstride);
#pragma unroll
            for (int q = 0; q < 2; ++q) rw[q] = *(const u32x4*)(wsrc[q] + l * 128);
        };
        auto commit = [&](int buf, const f32x4 (&ra)[4], const u32x4 (&rw)[2]) {
            char* ab = smem + CP_A + buf * CP_ABUF; char* wbuf = smem + CP_W + buf * CP_WBUF;
#pragma unroll
            for (int q = 0; q < 4; ++q) if (q < npieces) {
                if (prompt) *(f32x4*)(ab + dsto[q]) = ra[q];
                else { u32x2 o; o.x = pack2(ra[q][0], ra[q][1]); o.y = pack2(ra[q][2], ra[q][3]); *(u32x2*)(ab + dsto[q]) = o; }
            }
#pragma unroll
            for (int q = 0; q < 2; ++q) *(u32x4*)(wbuf + wdst[q]) = rw[q];
        };
        auto consume = [&](int buf) {
            const char* ab = smem + CP_A + buf * CP_ABUF; const char* wbuf = smem + CP_W + buf * CP_WBUF;
            const bf16_t* arow = (const bf16_t*)ab + (rt * 4 + (fr >> 2)) * CP_AROW + kv * 256 + (fr & 3) * 64 + fq * 8;
#pragma unroll
            for (int hf = 0; hf < 2; ++hf) {
                const bf16x8 a = *(const bf16x8*)(arow + hf * 32);
#pragma unroll
                for (int nt = 0; nt < 4; ++nt) {
                    const bf16x8 bfrag = *(const bf16x8*)(wbuf + (kv * 64 + nt * 16 + fr) * 144 + hf * 64 + fq * 16);
                    acc[nt] = __builtin_amdgcn_mfma_f32_16x16x32_bf16(a, bfrag, acc[nt], 0, 0, 0);
                }
            }
        };
        __syncthreads();
        issue(0, ra0, rw0); issue(1, ra1, rw1); commit(0, ra0, rw0); issue(2, ra0, rw0);
        __syncthreads();
#pragma unroll 1
        for (int l = 0; l < 64; l += 2) {
            consume(0);
            commit(1, ra1, rw1);
            if (l + 3 < 64) issue(l + 3, ra1, rw1);
            __syncthreads();
            consume(1);
            if (l + 2 < 64) commit(0, ra0, rw0);
            if (l + 4 < 64) issue(l + 4, ra0, rw0);
            __syncthreads();
        }
        {
            const int ob = prompt ? (task - 256) * 16 + rt * 4 + fq : 256 + task * 16 + rt * 4 + fq;
#pragma unroll
            for (int nt = 0; nt < 4; ++nt) {
                const float bias = p.PW[kv * 64 + nt * 16 + fr];
#pragma unroll
                for (int r = 0; r < 4; ++r) p.KC[(size_t)ob * 512 + kv * 256 + r * 64 + nt * 16 + fr] = acc[nt][r] + bias;
            }
        }
    }
}

DEVI void stage_cmp_select(const P& p, int bid, int nblk) {
    const int lane = threadIdx.x & 63, wid = threadIdx.x >> 6;
    for (int wt = bid * 8 + wid; wt < NT * 4; wt += nblk * 8) {
        const int row = wt >> 2, g = wt & 3;
        int pos, nb, nvalid, cur; const float *kcb, *vcb;
        if (row < NTP) { const int b = row >> 12, t = row & 4095; pos = t; nb = 64; nvalid = (t + 1) >> 6; cur = t >> 6; kcb = p.KC + (size_t)(b * 64) * 256; vcb = p.VC + (size_t)(b * 64) * 256; }
        else { const int rs = row - NTP, b = rs >> 2, tq = rs & 3; pos = 2048 + tq; nb = 33; nvalid = 32; cur = 32; kcb = p.KC + (size_t)(256 + b * 32) * 256; vcb = p.VC + (size_t)(256 + b * 32) * 256; }
        const int j = lane;
        float pr[4] = {0.f, 0.f, 0.f, 0.f};
        float imp = 0.f;
        if (nvalid > 0) {
            float dot[4] = {0.f, 0.f, 0.f, 0.f};
            if (j < nvalid) {
                const float* kr = kcb + (size_t)j * 256 + g * 64;
                const bf16_t* qr = p.PROJ + (size_t)row * PS + C_BQ + g * 256;
                for (int d = 0; d < 64; ++d) {
                    const float kk = kr[d];
#pragma unroll
                    for (int r = 0; r < 4; ++r) dot[r] += bf2f(qr[r * 64 + d]) * kk;
                }
            }
#pragma unroll
            for (int r = 0; r < 4; ++r) {
                const float s = j < nvalid ? dot[r] * 0.125f - alibi_slope(g * 4 + r) * (float)(pos - (j * 64 + 63)) : -INFINITY;
                const float mx = wave_max(s);
                const float e = j < nvalid ? __expf(s - mx) : 0.f;
                const float sum = wave_sum(e);
                pr[r] = e / sum;
                imp += pr[r];
            }
            float o[4] = {0.f, 0.f, 0.f, 0.f};
            for (int jj = 0; jj < nvalid; ++jj) {
                const float vv = vcb[(size_t)jj * 256 + g * 64 + lane];
#pragma unroll
                for (int r = 0; r < 4; ++r) o[r] += __shfl(pr[r], jj) * vv;
            }
#pragma unroll
            for (int r = 0; r < 4; ++r) p.OCMP[(size_t)row * 1024 + (g * 4 + r) * 64 + lane] = o[r];
        } else {
#pragma unroll
            for (int r = 0; r < 4; ++r) p.OCMP[(size_t)row * 1024 + (g * 4 + r) * 64 + lane] = 0.f;
        }
        if (j == cur || j == 0) imp = 5.0f;
        if (j > cur) imp = -1.0f;
        if (j >= nb) imp = -2.0f;
        int rank = 0;
        for (int jj = 0; jj < 64; ++jj) { const float v = __shfl(imp, jj); rank += (v > imp || (v == imp && jj < j)) ? 1 : 0; }
        const unsigned long long mask = __ballot(rank < 16 && j < nb);
        if (lane == 0) p.SEL[(size_t)row * 4 + g] = mask;
    }
}

struct KBlock { const void* kb; const void* vb; int stride; int f32; int count; int pos0; };

template <bool WIN>
DEVI void attend_block(const KBlock& B, int qpos, const float* qs, const float (&slope)[4], float (&m)[4], float (&l)[4], float (&o)[4], int lane) {
    const int pos = B.pos0 + lane;
    const bool valid = lane < B.count && pos <= qpos && (!WIN || pos > qpos - 512);
    if (!__any(valid)) return;
    float dot[4] = {0.f, 0.f, 0.f, 0.f};
    if (valid) {
        if (B.f32) {
            const float* kr = (const float*)B.kb + (size_t)lane * B.stride;
#pragma unroll 4
            for (int d4 = 0; d4 < 16; ++d4) {
                const f32x4 kk = *(const f32x4*)(kr + d4 * 4);
#pragma unroll
                for (int e = 0; e < 4; ++e) { const f32x4 qq = *(const f32x4*)(qs + (d4 * 4 + e) * 4);
#pragma unroll
                    for (int r = 0; r < 4; ++r) dot[r] += kk[e] * qq[r]; }
            }
        } else {
            const bf16_t* kr = (const bf16_t*)B.kb + (size_t)lane * B.stride;
#pragma unroll 2
            for (int d8 = 0; d8 < 8; ++d8) {
                const u32x4 kk = *(const u32x4*)(kr + d8 * 8);
                const unsigned w[4] = {kk.x, kk.y, kk.z, kk.w};
#pragma unroll
                for (int e = 0; e < 4; ++e) {
                    const float k0 = __uint_as_float(w[e] << 16), k1 = __uint_as_float(w[e] & 0xFFFF0000u);
                    const f32x4 q0 = *(const f32x4*)(qs + (d8 * 8 + e * 2) * 4), q1 = *(const f32x4*)(qs + (d8 * 8 + e * 2 + 1) * 4);
#pragma unroll
                    for (int r = 0; r < 4; ++r) dot[r] += k0 * q0[r] + k1 * q1[r];
                }
            }
        }
    }
    float pr[4];
#pragma unroll
    for (int r = 0; r < 4; ++r) {
        const float s = valid ? dot[r] * 0.125f - slope[r] * (float)(qpos - pos) : -INFINITY;
        const float mn = fmaxf(m[r], wave_max(s));
        const float sc = __expf(m[r] - mn);
        pr[r] = valid ? __expf(s - mn) : 0.f;
        l[r] = l[r] * sc + wave_sum(pr[r]);
        o[r] *= sc; m[r] = mn;
    }
    for (int kk = 0; kk < B.count; ++kk) {
        const float vv = B.f32 ? ((const float*)B.vb)[(size_t)kk * B.stride + lane] : bf2f(((const bf16_t*)B.vb)[(size_t)kk * B.stride + lane]);
#pragma unroll
        for (int r = 0; r < 4; ++r) o[r] += __shfl(pr[r], kk) * vv;
    }
}

DEVI void stage_slc_win(const P& p, char* smem, int bid, int nblk) {
    const int lane = threadIdx.x & 63, wid = threadIdx.x >> 6;
    float* qs = (float*)smem + wid * 256;
    for (int wt = bid * 8 + wid; wt < NT * 4; wt += nblk * 8) {
        const int row = wt >> 2, g = wt & 3;
        const bool prompt = row < NTP;
        int b, t, qpos;
        if (prompt) { b = row >> 12; t = row & 4095; qpos = t; } else { const int rs = row - NTP; b = rs >> 2; t = rs & 3; qpos = 2048 + t; }
        {
            const bf16_t* qr = p.PROJ + (size_t)row * PS + C_BQ + g * 256;
            f32x4 qv;
#pragma unroll
            for (int r = 0; r < 4; ++r) qv[r] = bf2f(qr[r * 64 + lane]);
            *(f32x4*)(qs + lane * 4) = qv;
            asm volatile("s_waitcnt lgkmcnt(0)" ::: "memory");
        }
        float slope[4];
#pragma unroll
        for (int r = 0; r < 4; ++r) slope[r] = alibi_slope(g * 4 + r);
        float res[2][4];
        {
            float m[4], l[4], o[4];
#pragma unroll
            for (int r = 0; r < 4; ++r) { m[r] = -INFINITY; l[r] = 0.f; o[r] = 0.f; }
            unsigned long long mask = p.SEL[(size_t)row * 4 + g];
            while (mask) {
                const int j = __builtin_ctzll(mask); mask &= mask - 1;
                KBlock B;
                if (prompt) {
                    const bf16_t* base = p.PROJ + ((size_t)b * 4096 + j * 64) * PS + C_SLC + g * 64;
                    B.kb = base; B.vb = base + 256; B.stride = PS; B.f32 = 0; B.count = 64; B.pos0 = j * 64;
                } else if (j < 32) {
                    const int page = p.page_table[b * 16 + (j >> 1)];
                    const float* base = p.cache_slc + ((size_t)page * 128 + (j & 1) * 64) * 512 + g * 64;
                    B.kb = base; B.vb = base + 256; B.stride = 512; B.f32 = 1; B.count = 64; B.pos0 = j * 64;
                } else {
                    const bf16_t* base = p.PROJ + ((size_t)NTP + b * 4) * PS + C_SLC + g * 64;
                    B.kb = base; B.vb = base + 256; B.stride = PS; B.f32 = 0; B.count = 4; B.pos0 = 2048;
                }
                attend_block<false>(B, qpos, qs, slope, m, l, o, lane);
            }
#pragma unroll
            for (int r = 0; r < 4; ++r) res[0][r] = o[r] / l[r];
        }
        {
            float m[4], l[4], o[4];
#pragma unroll
            for (int r = 0; r < 4; ++r) { m[r] = -INFINITY; l[r] = 0.f; o[r] = 0.f; }
            if (prompt) {
                const int lo = (t - 511 > 0 ? t - 511 : 0) >> 6, hi = t >> 6;
                for (int j = lo; j <= hi; ++j) {
                    KBlock B; const bf16_t* base = p.PROJ + ((size_t)b * 4096 + j * 64) * PS + C_WIN + g * 64;
                    B.kb = base; B.vb = base + 256; B.stride = PS; B.f32 = 0; B.count = 64; B.pos0 = j * 64;
                    attend_block<true>(B, qpos, qs, slope, m, l, o, lane);
                }
            } else {
                for (int j = 0; j < 8; ++j) {
                    KBlock B; const float* base = p.cache_win + ((size_t)b * 512 + j * 64) * 512 + g * 64;
                    B.kb = base; B.vb = base + 256; B.stride = 512; B.f32 = 1; B.count = 64; B.pos0 = 1536 + j * 64;
                    attend_block<true>(B, qpos, qs, slope, m, l, o, lane);
                }
                KBlock B; const bf16_t* base = p.PROJ + ((size_t)NTP + b * 4) * PS + C_WIN + g * 64;
                B.kb = base; B.vb = base + 256; B.stride = PS; B.f32 = 0; B.count = 4; B.pos0 = 2048;
                attend_block<true>(B, qpos, qs, slope, m, l, o, lane);
            }
#pragma unroll
            for (int r = 0; r < 4; ++r) res[1][r] = o[r] / l[r];
        }
        const float* gt = p.SM + (size_t)row * 64 + 8;
#pragma unroll
        for (int r = 0; r < 4; ++r) {
            const float g0 = sigmoidf_(gt[g * 4 + r]), g1 = sigmoidf_(gt[16 + g * 4 + r]), g2 = sigmoidf_(gt[32 + g * 4 + r]);
            const float oc = p.OCMP[(size_t)row * 1024 + (g * 4 + r) * 64 + lane];
            p.YB[(size_t)row * 1024 + (g * 4 + r) * 64 + lane] = f2bf(g0 * oc + g1 * res[0][r] + g2 * res[1][r]);
        }
    }
}

typedef float f32x16 __attribute__((ext_vector_type(16)));
typedef short s16x4 __attribute__((ext_vector_type(4)));
typedef __attribute__((address_space(3))) const char* lds_cptr;
#define MFMA32(a, b, c) __builtin_amdgcn_mfma_f32_32x32x16_bf16(a, b, c, 0, 0, 0)
DEVI int crow(int r, int hi) { return (r & 3) + 8 * (r >> 2) + 4 * hi; }
DEVI unsigned cvtpk(float lo, float hi) { return pack2(lo, hi); }
DEVI s16x4 vtr(lds_cptr p) { return __builtin_bit_cast(s16x4, __builtin_amdgcn_ds_read_tr16_b64_v4i16((__attribute__((address_space(3))) s16x4*)p)); }
DEVI float half_max(float m) { auto rr = __builtin_amdgcn_permlane32_swap(__float_as_uint(m), __float_as_uint(m), false, false); return fmaxf(__uint_as_float(rr[0]), __uint_as_float(rr[1])); }
DEVI float half_sum(float m) { auto rr = __builtin_amdgcn_permlane32_swap(__float_as_uint(m), __float_as_uint(m), false, false); return __uint_as_float(rr[0]) + __uint_as_float(rr[1]); }

struct BlkDesc { const char* k; int stride_bytes; int f32; int count; int pos0; };
DEVI void blk_load(const BlkDesc& d, int tid, u32x4& rk, u32x4& rv) {
    const int key = tid & 63, chunk = tid >> 6;
    rk = (u32x4){0u, 0u, 0u, 0u}; rv = rk;
    if (key < d.count) {
        const char* kr = d.k + (size_t)key * d.stride_bytes;
        if (d.f32) {
            const f32x4* s1 = (const f32x4*)(kr + chunk * 32); const f32x4* s2 = (const f32x4*)(kr + 1024 + chunk * 32);
            rk = pack8f(s1[0], s1[1]); rv = pack8f(s2[0], s2[1]);
        } else { rk = *(const u32x4*)(kr + chunk * 16); rv = *(const u32x4*)(kr + 512 + chunk * 16); }
    }
}
DEVI void blk_store(char* kimg, char* vimg, int tid, const u32x4& rk, const u32x4& rv) {
    const int key = tid & 63, chunk = tid >> 6;
    *(u32x4*)(kimg + chunk * 1024 + key * 16) = rk;
    *(u32x4*)(vimg + (chunk >> 2) * 4096 + key * 64 + (chunk & 3) * 16) = rv;
}

DEVI void attn_tile(const char* kimg, const char* vimg, const bf16x8 (&qr)[4], float& m2, float& lsum, f32x16& o0, f32x16& o1, f32x16& s0, f32x16& s1,
                    float sl, float bb, int lh, int ll, bool fast, float* wsf_hi  , float* wsf_r  , int lane) {
    const int r32 = lane & 31, hi = lane >> 5;
    const f32x16 z = {};
    s0 = z; s1 = z;
    {
        const char* kp = kimg + hi * 1024 + r32 * 16;
#pragma unroll
        for (int d0 = 0; d0 < 4; ++d0) {
            const bf16x8 k0 = *(const bf16x8*)(kp + d0 * 2048), k1 = *(const bf16x8*)(kp + d0 * 2048 + 512);
            s0 = MFMA32(k0, qr[d0], s0); s1 = MFMA32(k1, qr[d0], s1);
        }
    }
    float mx = -1e30f;
    if (fast) {
#pragma unroll
        for (int r = 0; r < 16; ++r) {
            const int c = (r & 3) + 8 * (r >> 2);
            s0[r] = fmaf(s0[r], 1.4426950408889634f, fmaf(sl, (float)c, bb)); s1[r] = fmaf(s1[r], 1.4426950408889634f, fmaf(sl, (float)(c + 32), bb));
            mx = fmaxf(mx, fmaxf(s0[r], s1[r]));
        }
    } else {
#pragma unroll
        for (int r = 0; r < 16; ++r) {
            const int c = (r & 3) + 8 * (r >> 2);
            const float t0 = fmaf(s0[r], 1.4426950408889634f, fmaf(sl, (float)c, bb)), t1 = fmaf(s1[r], 1.4426950408889634f, fmaf(sl, (float)(c + 32), bb));
            s0[r] = (c <= lh && c > ll) ? t0 : -INFINITY; s1[r] = (c + 32 <= lh && c + 32 > ll) ? t1 : -INFINITY;
            mx = fmaxf(mx, fmaxf(s0[r], s1[r]));
        }
    }
    mx = half_max(mx);
    const float mnew = fmaxf(m2, mx);
    const float f = __builtin_amdgcn_exp2f(m2 - mnew);
    m2 = mnew;
    float ps = 0.f;
#pragma unroll
    for (int r = 0; r < 16; ++r) { s0[r] = __builtin_amdgcn_exp2f(s0[r] - mnew); s1[r] = __builtin_amdgcn_exp2f(s1[r] - mnew); ps += s0[r] + s1[r]; }
    lsum = lsum * f + ps;
    if (__any(f != 1.f)) {
        if (hi == 0) *wsf_r = f;
        asm volatile("s_waitcnt lgkmcnt(0)" ::: "memory");
#pragma unroll
        for (int a = 0; a < 4; ++a) {
            const f32x4 fv = *(const f32x4*)(wsf_hi + 8 * a);
#pragma unroll
            for (int k = 0; k < 4; ++k) { o0[4 * a + k] *= fv[k]; o1[4 * a + k] *= fv[k]; }
        }
        asm volatile("s_waitcnt lgkmcnt(0)" ::: "memory");
    }
    u32x4 pw[4];
#pragma unroll
    for (int k = 0; k < 4; ++k) { pw[0][k] = cvtpk(s0[2 * k], s0[2 * k + 1]); pw[1][k] = cvtpk(s0[8 + 2 * k], s0[8 + 2 * k + 1]); pw[2][k] = cvtpk(s1[2 * k], s1[2 * k + 1]); pw[3][k] = cvtpk(s1[8 + 2 * k], s1[8 + 2 * k + 1]); }
    const lds_cptr vp = (lds_cptr)vimg + ((lane >> 4) & 1) * 32 + (lane & 3) * 8 + (4 * hi + ((lane & 15) >> 2)) * 64;
#pragma unroll
    for (int i = 0; i < 8; ++i) {
        const s16x4 lo = vtr(vp + ((i >> 2) * 4096 + (i & 3) * 1024)), hh = vtr(vp + ((i >> 2) * 4096 + (i & 3) * 1024 + 512));
        const bf16x8 vf = (bf16x8){lo[0], lo[1], lo[2], lo[3], hh[0], hh[1], hh[2], hh[3]};
        const bf16x8 pf = __builtin_bit_cast(bf16x8, pw[i & 3]);
        if (i < 4) o0 = MFMA32(pf, vf, o0); else o1 = MFMA32(pf, vf, o1);
    }
}

constexpr int NSA_KV0 = 0, NSA_KV1 = 16384, NSA_WSF = 32768, NSA_IMP = NSA_WSF + 2048, NSA_SEL = NSA_IMP + 16384, NSA_LIST = NSA_SEL + 512, NSA_OST = NSA_LIST + 256, NSA_YAC = NSA_OST + 32768, NSA_LDS = NSA_YAC + 65536;
static_assert(NSA_LDS <= 152 * 1024, "lds");

DEVI BlkDesc nsa_desc(const P& p, bool prompt, int b, int g, int branch, int j) {
    BlkDesc d;
    if (prompt) {
        if (branch == 0) { d.k = (const char*)(p.KC + ((size_t)(b * 64) * 512 + g * 64)); d.stride_bytes = 2048; d.f32 = 1; d.count = 64; d.pos0 = 0; }
        else { d.k = (const char*)(p.PROJ + ((size_t)b * 4096 + j * 64) * PS + (branch == 1 ? C_SLC : C_WIN) + g * 64); d.stride_bytes = PS * 2; d.f32 = 0; d.count = 64; d.pos0 = j * 64; }
    } else {
        if (branch == 0) { d.k = (const char*)(p.KC + ((size_t)(256 + b * 32) * 512 + g * 64)); d.stride_bytes = 2048; d.f32 = 1; d.count = 32; d.pos0 = 0; }
        else if (branch == 1 && j < 32) { const int page = p.page_table[b * 16 + (j >> 1)]; d.k = (const char*)(p.cache_slc + ((size_t)page * 128 + (j & 1) * 64) * 512 + g * 64); d.stride_bytes = 2048; d.f32 = 1; d.count = 64; d.pos0 = j * 64; }
        else if (branch == 2 && j < 8) { d.k = (const char*)(p.cache_win + ((size_t)b * 512 + j * 64) * 512 + g * 64); d.stride_bytes = 2048; d.f32 = 1; d.count = 64; d.pos0 = 1536 + j * 64; }
        else { d.k = (const char*)(p.PROJ + ((size_t)NTP + b * 4) * PS + (branch == 1 ? C_SLC : C_WIN) + g * 64); d.stride_bytes = PS * 2; d.f32 = 0; d.count = 4; d.pos0 = 2048; }
    }
    return d;
}

constexpr int NS_IMG = 0, NS_WSF = 131072, NS_IMP = NS_WSF + 2048, NS_SEL = NS_IMP + 2048, NS_LIST = NS_SEL + 64, NS_YC = NS_LIST + 64, NS_PM = NS_YC + 4096, NS_Q = NS_PM + 2048, NS_LDS = NS_Q + 4096;
static_assert(NS_LDS <= 152 * 1024, "lds");
DEVI void wave_stage_block(const BlkDesc& d, char* kimg, char* vimg, int lane) {
    asm volatile("" : "+v"(lane));
    const int rsub = lane >> 4, pc = lane & 15;
    if (d.f32) {
#pragma unroll
        for (int half = 0; half < 2; ++half) {
#pragma unroll
            for (int i0 = 0; i0 < 16; i0 += 8) {
                f32x4 x[8];
#pragma unroll
                for (int i = 0; i < 8; ++i) { const int row = 4 * (i0 + i) + rsub; x[i] = row < d.count ? __builtin_nontemporal_load((const f32x4*)(d.k + (size_t)row * d.stride_bytes + half * 1024 + pc * 16)) : (f32x4){0.f, 0.f, 0.f, 0.f}; }
#pragma unroll
                for (int i = 0; i < 8; ++i) {
                    const int row = 4 * (i0 + i) + rsub, c = pc >> 1;
                    u32x2 o; o.x = pack2(x[i][0], x[i][1]); o.y = pack2(x[i][2], x[i][3]);
                    if (half == 0) *(u32x2*)(kimg + c * 1024 + row * 16 + (pc & 1) * 8) = o;
                    else *(u32x2*)(vimg + (c >> 2) * 4096 + row * 64 + (c & 3) * 16 + (pc & 1) * 8) = o;
                }
            }
        }
    } else {
        const int row = lane >> 3, c = lane & 7;
#pragma unroll
        for (int i = 0; i < 8; ++i) {
            const int rr = 8 * i + row;
            u32x4 kk = {0u, 0u, 0u, 0u}, vv = {0u, 0u, 0u, 0u};
            if (rr < d.count) { kk = *(const u32x4*)(d.k + (size_t)rr * d.stride_bytes + c * 16); vv = *(const u32x4*)(d.k + (size_t)rr * d.stride_bytes + 512 + c * 16); }
            *(u32x4*)(kimg + c * 1024 + rr * 16) = kk;
            *(u32x4*)(vimg + (c >> 2) * 4096 + rr * 64 + (c & 3) * 16) = vv;
        }
    }
    asm volatile("s_waitcnt lgkmcnt(0)" ::: "memory");
}

DEVI void nsa_sample_unit(const P& p, char* smem, int us) {
    const int tid = threadIdx.x, lane = tid & 63, wid = tid >> 6, r32 = lane & 31, hi = lane >> 5;
    const int b = us >> 2, g = us & 3;
    const size_t rowbase = (size_t)NTP + b * 4;
    char* kimg = smem + NS_IMG + wid * 16384; char* vimg = kimg + 8192;
    float* wsf = (float*)(smem + NS_WSF) + wid * 64;
    float* impb = (float*)(smem + NS_IMP);
    unsigned long long* selm = (unsigned long long*)(smem + NS_SEL);
    unsigned char* blist = (unsigned char*)(smem + NS_LIST);
    float* ycmp = (float*)(smem + NS_YC);
    const int tokl = r32 >> 2, head = r32 & 3;
    const bool tok_ok = r32 < 16;
    const int qpos = 2048 + tokl;
    const float slope2 = alibi_slope(g * 4 + head) * 1.4426950408889634f;
    char* qsh = smem + NS_Q;
    int hi4 = 4 * hi; asm volatile("" : "+v"(hi4));
    float* wsf_hi = wsf + hi4; float* wsf_r = wsf + r32;
    f32x16 s0, s1;
    __syncthreads();
    if (wid == 0) {
        bf16x8 qr[4];
        {
            const bf16_t* qp = p.PROJ + (rowbase + (tok_ok ? tokl : 0)) * PS + C_BQ + (g * 4 + head) * 64 + hi * 8;
#pragma unroll
            for (int d0 = 0; d0 < 4; ++d0) {
                u32x4 v = *(const u32x4*)(qp + d0 * 16);
#pragma unroll
                for (int k = 0; k < 4; ++k) { const float lo = __uint_as_float(v[k] << 16) * 0.125f, hh = __uint_as_float(v[k] & 0xFFFF0000u) * 0.125f; v[k] = tok_ok ? ((__float_as_uint(lo) >> 16) | (__float_as_uint(hh) & 0xFFFF0000u)) : 0u; }
                qr[d0] = __builtin_bit_cast(bf16x8, v);
                *(u32x4*)(qsh + d0 * 1024 + lane * 16) = v;
            }
        }
        f32x16 o0 = {}, o1 = {}; float m2 = -1e30f, lsum = 0.f;
        const BlkDesc d = nsa_desc(p, false, b, g, 0, 0);
        wave_stage_block(d, kimg, vimg, lane);
        const int lh = 31 - hi4;
        const float sl = 64.f * slope2;
        attn_tile(kimg, vimg, qr, m2, lsum, o0, o1, s0, s1, sl, tok_ok ? sl * (float)(hi4 - 32) : -INFINITY, lh, -1000, false, wsf_hi, wsf_r, lane);
        const float lt = half_sum(lsum);
        const float inv = lt > 0.f ? 1.f / lt : 0.f;
        float* ib = impb + (r32 >> 2) * 64 + hi4;
#pragma unroll
        for (int r = 0; r < 16; ++r) {
            float a = s0[r] * inv, c = s1[r] * inv;
            a += __shfl_xor(a, 1); a += __shfl_xor(a, 2); c += __shfl_xor(c, 1); c += __shfl_xor(c, 2);
            if (head == 0) { ib[(r & 3) + 8 * (r >> 2)] = a; ib[(r & 3) + 8 * (r >> 2) + 32] = c; }
        }
        float fac = 0.f;
        if (tok_ok && lt > 0.f) fac = sigmoidf_(p.SM[(rowbase + tokl) * 64 + 8 + g * 4 + head]) / lt;
        if (hi == 0) *wsf_r = fac;
        asm volatile("s_waitcnt lgkmcnt(0)" ::: "memory");
#pragma unroll
        for (int a = 0; a < 2; ++a) {
            const f32x4 fv = *(const f32x4*)(wsf_hi + 8 * a);
#pragma unroll
            for (int k = 0; k < 4; ++k) { float* yp = ycmp + (8 * a + k + hi4) * 64 + r32; yp[0] = o0[4 * a + k] * fv[k]; yp[32] = o1[4 * a + k] * fv[k]; }
        }
        asm volatile("s_waitcnt lgkmcnt(0)" ::: "memory");
#pragma unroll 1
        for (int tl = 0; tl < 4; ++tl) {
            const int j = lane;
            float v = impb[tl * 64 + j];
            if (j == 32 || j == 0) v = 5.0f;
            if (j > 32) v = -2.0f;
            impb[tl * 64 + j] = v;
            asm volatile("s_waitcnt lgkmcnt(0)" ::: "memory");
            int rank = 0;
#pragma unroll 8
            for (int jj = 0; jj < 64; ++jj) { const float u = impb[tl * 64 + jj]; rank += (u > v || (u == v && jj < j)) ? 1 : 0; }
            const unsigned long long mask = __ballot(rank < 16 && j < 33);
            if (lane == 0) selm[tl] = mask;
        }
        asm volatile("s_waitcnt lgkmcnt(0)" ::: "memory");
        if (lane == 0) {
            unsigned long long u = selm[0] | selm[1] | selm[2] | selm[3];
            int n = 0;
            while (u) { const int j = __builtin_ctzll(u); u &= u - 1; blist[1 + n++] = (unsigned char)(0x40 | j); }
            for (int j = 0; j <= 8; ++j) blist[1 + n++] = (unsigned char)(0x80 | j);
            blist[0] = (unsigned char)n;
        }
    }
    __syncthreads();
    const int nb = blist[0];
    const unsigned long long mysel = tok_ok ? selm[tokl] : 0ull;
    int nslc = 0;
    for (int i = 0; i < nb; ++i) nslc += (blist[1 + i] >> 6) == 1 ? 1 : 0;
    float so[16], ms, lst;
    float wo[16], mw, lwt;
#pragma unroll 1
    for (int pass = 0; pass < 2; ++pass) {
        f32x16 o0 = {}, o1 = {}; float m2 = -1e30f, lsum = 0.f;
        const int i0 = pass == 0 ? 0 : nslc, i1 = pass == 0 ? nslc : nb;
#pragma unroll 1
        for (int i = i0 + wid; i < i1; i += 8) {
            const int e = blist[1 + i], br = e >> 6, j = e & 63;
            const BlkDesc d = nsa_desc(p, false, b, g, br, j);
            wave_stage_block(d, kimg, vimg, lane);
            asm volatile("" : "+v"(hi4));
            const bool lsel = tok_ok && (br == 2 || ((mysel >> j) & 1ull));
            const int rel = qpos - d.pos0;
            const int lh = (rel < d.count - 1 ? rel : d.count - 1) - hi4;
            const int ll = (br == 2 ? rel - 512 : -1000) - hi4;
            const bool fast = __all(!lsel || (lh >= 59 && ll < 0));
            const float bb = lsel ? slope2 * (float)(hi4 + d.pos0 - 2048) : -INFINITY;
            bf16x8 qr[4];
#pragma unroll
            for (int d0 = 0; d0 < 4; ++d0) qr[d0] = *(const bf16x8*)(qsh + d0 * 1024 + lane * 16);
            attn_tile(kimg, vimg, qr, m2, lsum, o0, o1, s0, s1, slope2, bb, lh, ll, fast, wsf_hi, wsf_r, lane);
        }
        const float lt = half_sum(lsum);
        if (pass == 0) { ms = m2; lst = lt;
#pragma unroll
            for (int r = 0; r < 8; ++r) { so[r] = o0[r]; so[8 + r] = o1[r]; } }
        else { mw = m2; lwt = lt;
#pragma unroll
            for (int r = 0; r < 8; ++r) { wo[r] = o0[r]; wo[8 + r] = o1[r]; } }
    }
    {
        float* po = (float*)kimg;
        float* pm = (float*)(smem + NS_PM) + wid * 64;
        if (lane < 16) { pm[lane * 2] = ms; pm[lane * 2 + 1] = lst; pm[32 + lane * 2] = mw; pm[32 + lane * 2 + 1] = lwt; }
#pragma unroll
        for (int a = 0; a < 2; ++a)
#pragma unroll
            for (int k = 0; k < 4; ++k) {
                float* yp = po + (8 * a + k + hi4) * 64 + r32;
                yp[0] = so[4 * a + k]; yp[32] = so[8 + 4 * a + k]; yp[1024] = wo[4 * a + k]; yp[1024 + 32] = wo[8 + 4 * a + k];
            }
    }
    __syncthreads();
    {
        const int row = tid >> 5, dcol = tid & 31, tk = row >> 2, hd = row & 3;
        float res[2][2];
#pragma unroll
        for (int br = 0; br < 2; ++br) {
            float M = -1e30f;
#pragma unroll
            for (int w = 0; w < 8; ++w) M = fmaxf(M, ((const float*)(smem + NS_PM))[w * 64 + br * 32 + row * 2]);
            float L = 0.f, a0 = 0.f, a1 = 0.f;
#pragma unroll
            for (int w = 0; w < 8; ++w) {
                const float* pmw = (const float*)(smem + NS_PM) + w * 64 + br * 32 + row * 2;
                const float f = __builtin_amdgcn_exp2f(pmw[0] - M);
                const float* pow_ = (const float*)(smem + NS_IMG + w * 16384) + br * 1024 + row * 64 + dcol;
                L += pmw[1] * f; a0 += pow_[0] * f; a1 += pow_[32] * f;
            }
            const float gate = sigmoidf_(p.SM[(rowbase + tk) * 64 + 8 + (br + 1) * 16 + g * 4 + hd]);
            const float sc = L > 0.f ? gate / L : 0.f;
            res[br][0] = a0 * sc; res[br][1] = a1 * sc;
        }
        const float y0 = ycmp[row * 64 + dcol] + res[0][0] + res[1][0], y1 = ycmp[row * 64 + dcol + 32] + res[0][1] + res[1][1];
        bf16_t* yb = p.YB + (rowbase + tk) * 1024 + (g * 4 + hd) * 64;
        yb[dcol] = f2bf(y0); yb[dcol + 32] = f2bf(y1);
    }
}

DEVI void stage_nsa_attn(const P& p, char* smem, int bid, int nblk) {
    const int tid = threadIdx.x, lane = tid & 63, wid = tid >> 6, r32 = lane & 31, hi = lane >> 5;
    float* wsf = (float*)(smem + NSA_WSF) + wid * 64;
    float* impb = (float*)(smem + NSA_IMP) + wid * 512;
    unsigned long long* selm = (unsigned long long*)(smem + NSA_SEL);
    unsigned char* blist = (unsigned char*)(smem + NSA_LIST);
#ifndef NSA_REP
#define NSA_REP 0
#endif
    const int n_units = 1024 + 512 + (NSA_REP == 1 ? 1024 : 0) + (NSA_REP == 2 ? 512 : 0);
    for (int unit0 = bid; unit0 < n_units; unit0 += nblk) {
        const int unit = unit0 < 1536 ? unit0 : (NSA_REP == 1 ? unit0 - 1536 : unit0 - 512);
        const bool prompt = unit < 1024;
        if (!prompt) { nsa_sample_unit(p, smem, unit - 1024); continue; }
        int b, g, qt, t0, ntok, nb, cur; size_t rowbase;
        if (prompt) { b = unit >> 8; g = ((unit >> 6) + b) & 3; qt = (b & 1) ? 63 - (unit & 63) : (unit & 63); t0 = qt * 64;
             ntok = 64; nb = 64; cur = qt; rowbase = (size_t)b * 4096 + t0; }
        else { const int us = unit - 1024; b = us >> 2; g = us & 3; qt = 0; t0 = 2048; ntok = 4; nb = 33; cur = 32; rowbase = (size_t)NTP + b * 4; }
        const int tokl = wid * 8 + (r32 >> 2), head = r32 & 3;
        const bool tok_ok = tokl < ntok;
        const int qpos = t0 + tokl;
        const float slope2 = alibi_slope(g * 4 + head) * 1.4426950408889634f;
        bf16x8 qr[4];
        {
            const bf16_t* qp = p.PROJ + (rowbase + (tok_ok ? tokl : 0)) * PS + C_BQ + (g * 4 + head) * 64 + hi * 8;
#pragma unroll
            for (int d0 = 0; d0 < 4; ++d0) {
                u32x4 v = *(const u32x4*)(qp + d0 * 16);
#pragma unroll
                for (int k = 0; k < 4; ++k) { const float lo = __uint_as_float(v[k] << 16) * 0.125f, hh = __uint_as_float(v[k] & 0xFFFF0000u) * 0.125f; v[k] = tok_ok ? ((__float_as_uint(lo) >> 16) | (__float_as_uint(hh) & 0xFFFF0000u)) : 0u; }
                qr[d0] = __builtin_bit_cast(bf16x8, v);
            }
        }
        int hi4 = 4 * hi; asm volatile("" : "+v"(hi4));
        float* yl = (float*)(smem + NSA_YAC) + wid * 2048 + hi4 * 64 + r32;
        float* wsf_hi = wsf + hi4; float* wsf_r = wsf + r32;
        f32x16 o0, o1, s0, s1; float m2, lsum;
        auto finish = [&](int br) {
            const float lt = half_sum(lsum);
            float fac = 0.f;
            if (tok_ok && lt > 0.f) fac = sigmoidf_(p.SM[(rowbase + tokl) * 64 + 8 + br * 16 + g * 4 + head]) / lt;
            if (hi == 0) *wsf_r = fac;
            asm volatile("s_waitcnt lgkmcnt(0)" ::: "memory");
#pragma unroll
            for (int a = 0; a < 4; ++a) {
                const f32x4 fv = *(const f32x4*)(wsf_hi + 8 * a);
#pragma unroll
                for (int k = 0; k < 4; ++k) {
                    float* yp = yl + (8 * a + k) * 64;
                    if (br == 0) { yp[0] = o0[4 * a + k] * fv[k]; yp[32] = o1[4 * a + k] * fv[k]; }
                    else { yp[0] += o0[4 * a + k] * fv[k]; yp[32] += o1[4 * a + k] * fv[k]; }
                }
            }
            asm volatile("s_waitcnt lgkmcnt(0)" ::: "memory");
        };
        __syncthreads();
        {
            const BlkDesc d = nsa_desc(p, prompt, b, g, 0, 0);
            u32x4 rk, rv; blk_load(d, tid, rk, rv); blk_store(smem + NSA_KV0, smem + NSA_KV0 + 8192, tid, rk, rv);
            __syncthreads();
            o0 = (f32x16){}; o1 = (f32x16){}; m2 = -1e30f; lsum = 0.f;
            {
                const int nv = ((qpos + 1) >> 6) - 1;
                const int lh = (nv < d.count - 1 ? nv : d.count - 1) - hi4;
                const float sl = 64.f * slope2;
                attn_tile(smem + NSA_KV0, smem + NSA_KV0 + 8192, qr, m2, lsum, o0, o1, s0, s1, sl, tok_ok ? sl * (float)(hi4 - (t0 >> 6)) : -INFINITY, lh, -1000, false, wsf_hi, wsf_r, lane);
            }
            const float lt = half_sum(lsum);
            const float inv = lt > 0.f ? 1.f / lt : 0.f;
            float* ib = impb + (r32 >> 2) * 64 + hi4;
#pragma unroll
            for (int r = 0; r < 16; ++r) {
                float a = s0[r] * inv, c = s1[r] * inv;
                a += __shfl_xor(a, 1); a += __shfl_xor(a, 2); c += __shfl_xor(c, 1); c += __shfl_xor(c, 2);
                if (head == 0) { ib[(r & 3) + 8 * (r >> 2)] = a; ib[(r & 3) + 8 * (r >> 2) + 32] = c; }
            }
            asm volatile("s_waitcnt lgkmcnt(0)" ::: "memory");
            finish(0);
#pragma unroll 1
            for (int tl = 0; tl < 8; ++tl) {
                const int j = lane;
                float v = impb[tl * 64 + j];
                if (j == cur || j == 0) v = 5.0f;
                if (j > cur) v = -1.0f;
                if (j >= nb) v = -2.0f;
                impb[tl * 64 + j] = v;
                asm volatile("s_waitcnt lgkmcnt(0)" ::: "memory");
                int rank = 0;
#pragma unroll 8
                for (int jj = 0; jj < 64; ++jj) { const float u = impb[tl * 64 + jj]; rank += (u > v || (u == v && jj < j)) ? 1 : 0; }
                const unsigned long long mask = __ballot(rank < 16 && j < nb);
                if (lane == 0) selm[wid * 8 + tl] = (wid * 8 + tl < ntok) ? mask : 0ull;
            }
        }
        __syncthreads();
        if (wid == 0) {
            unsigned long long u = selm[lane];
#pragma unroll
            for (int o = 32; o > 0; o >>= 1) u |= __shfl_xor(u, o);
            if (prompt) u &= (qt == 63) ? ~0ull : ((1ull << (qt + 1)) - 1ull);
            if (lane == 0) {
                int n = 0;
                while (u) { const int j = __builtin_ctzll(u); u &= u - 1; blist[1 + n++] = (unsigned char)(0x40 | j); }
                if (prompt) { for (int j = (qt - 8 > 0 ? qt - 8 : 0); j <= qt; ++j) blist[1 + n++] = (unsigned char)(0x80 | j); }
                else { for (int j = 0; j <= 8; ++j) blist[1 + n++] = (unsigned char)(0x80 | j); }
                blist[0] = (unsigned char)n;
            }
        }
        __syncthreads();
        const int nblkk = blist[0];
        const unsigned long long mysel = selm[tokl];
        {
            u32x4 rk, rv;
            { const int e = blist[1]; const BlkDesc d = nsa_desc(p, prompt, b, g, e >> 6, e & 63); blk_load(d, tid, rk, rv); blk_store(smem + NSA_KV0, smem + NSA_KV0 + 8192, tid, rk, rv); }
            __syncthreads();
            int prev_br = 1;
            o0 = (f32x16){}; o1 = (f32x16){}; m2 = -1e30f; lsum = 0.f;
            for (int i = 0; i < nblkk; ++i) {
                const int e = blist[1 + i], br = e >> 6, j = e & 63;
                char* cur_img = smem + ((i & 1) ? NSA_KV1 : NSA_KV0);
                char* nxt_img = smem + ((i & 1) ? NSA_KV0 : NSA_KV1);
                const BlkDesc d = nsa_desc(p, prompt, b, g, br, j);
                if (i + 1 < nblkk) { const int e2 = blist[2 + i]; const BlkDesc d2 = nsa_desc(p, prompt, b, g, e2 >> 6, e2 & 63); blk_load(d2, tid, rk, rv); }
                if (br != prev_br) { finish(1); o0 = (f32x16){}; o1 = (f32x16){}; m2 = -1e30f; lsum = 0.f; prev_br = br; }
                {
                    asm volatile("" : "+v"(hi4));
                    const bool lsel = tok_ok && (br == 2 || ((mysel >> j) & 1ull));
                    const int rel = qpos - d.pos0;
                    const int lh = (rel < d.count - 1 ? rel : d.count - 1) - hi4;
                    const int ll = (br == 2 ? rel - 512 : -1000) - hi4;
                    const bool fast = __all(!lsel || (lh >= 59 && ll < 0));
                    if (__any(lsel && lh + hi4 >= 0 && ll + hi4 < 63))
                    attn_tile(cur_img, cur_img + 8192, qr, m2, lsum, o0, o1, s0, s1, slope2, lsel ? slope2 * (float)(hi4 + d.pos0 - t0) : -INFINITY, lh, ll, fast, wsf_hi, wsf_r, lane);
                }
                if (i + 1 < nblkk) blk_store(nxt_img, nxt_img + 8192, tid, rk, rv);
                __syncthreads();
            }
            finish(2);
        }
        {
            const float* yac = (const float*)(smem + NSA_YAC) + wid * 2048;
#pragma unroll
            for (int i = 0; i < 4; ++i) {
                const int orow = i * 8 + (lane >> 3), ch = lane & 7, tk = wid * 8 + (orow >> 2), hd = orow & 3;
                const f32x4 a = *(const f32x4*)(yac + orow * 64 + ch * 8), c = *(const f32x4*)(yac + orow * 64 + ch * 8 + 4);
                if (tk < ntok) *(u32x4*)(p.YB + (rowbase + tk) * 1024 + (g * 4 + hd) * 64 + ch * 8) = pack8f(a, c);
            }
            asm volatile("s_waitcnt lgkmcnt(0)" ::: "memory");
        }
    }
}

DEVI void stage_ln1(const P& p, int bid, int nblk) {
    const int lane = threadIdx.x & 63, wid = threadIdx.x >> 6;
    for (int row = bid * 8 + wid; row < NT; row += nblk * 8) {
        f32x4 x[4];
        float s = 0.f;
#pragma unroll
        for (int i = 0; i < 4; ++i) { x[i] = *(const f32x4*)(p.R + (size_t)row * 1024 + i * 256 + lane * 4); s += x[i][0] + x[i][1] + x[i][2] + x[i][3]; }
        const float mean = wave_sum(s) * (1.f / 1024.f);
        float q = 0.f;
#pragma unroll
        for (int i = 0; i < 4; ++i)
#pragma unroll
            for (int k = 0; k < 4; ++k) q += (x[i][k] - mean) * (x[i][k] - mean);
        const float rs = rsqrtf(wave_sum(q) * (1.f / 1024.f) + LN_EPS);
#pragma unroll
        for (int i = 0; i < 4; ++i) {
            const int c = i * 256 + lane * 4;
            const f32x4 gg = *(const f32x4*)(p.ln1_g + c), bb = *(const f32x4*)(p.ln1_b + c);
            f32x4 y;
#pragma unroll
            for (int k = 0; k < 4; ++k) y[k] = (x[i][k] - mean) * rs * gg[k] + bb[k];
            *(f32x4*)(p.H + (size_t)row * 1024 + c) = y;
            u32x2 o; o.x = pack2(y[0], y[1]); o.y = pack2(y[2], y[3]);
            *(u32x2*)(p.HB + (size_t)row * 1024 + c) = o;
        }
    }
}

__device__ const unsigned char PEER_CA[50] = {0,0,0,0,0,0,0,0,0,0,0,0,0,0,0,0, 1,1,1,1,1,1,1,1, 2,2,2,2,2, 3,3,3,3, 4,4,4, 5,5, 6,6, 7,7, 8,9,10,11,12,13,14,15};
__device__ const unsigned char PEER_CB[50] = {0,1,2,3,4,5,6,7,8,9,10,11,12,13,14,15, 0,1,2,3,4,5,6,7, 0,1,2,3,4, 0,1,2,3, 0,1,2, 0,1, 0,1, 0,1, 0,0,0,0,0,0,0,0};

DEVI void ce_desc(unsigned& a, unsigned& b) { const unsigned hi = a > b ? a : b, lo = a > b ? b : a; a = hi; b = lo; }
template <int BASE> DEVI void sort16_desc(unsigned (&x)[64]) {
#pragma unroll
    for (int k = 2; k <= 16; k <<= 1)
#pragma unroll
        for (int j = k >> 1; j > 0; j >>= 1)
#pragma unroll
            for (int i = 0; i < 16; ++i) {
                const int l = i ^ j;
                if (l > i) { if ((i & k) == 0) ce_desc(x[BASE + i], x[BASE + l]); else ce_desc(x[BASE + l], x[BASE + i]); }
            }
}
DEVI void merge_top16(const unsigned* a, const unsigned* b, unsigned* t) {
    unsigned c[16];
#pragma unroll
    for (int i = 0; i < 16; ++i) c[i] = a[i] > b[15 - i] ? a[i] : b[15 - i];
#pragma unroll
    for (int j = 8; j > 0; j >>= 1)
#pragma unroll
        for (int i = 0; i < 16; ++i) { const int l = i ^ j; if (l > i) ce_desc(c[i], c[l]); }
#pragma unroll
    for (int i = 0; i < 16; ++i) t[i] = c[i];
}
DEVI float key_score(unsigned k) { const unsigned u = k & ~127u; return __uint_as_float((u & 0x80000000u) ? (u & 0x7FFFFFFFu) : ~u); }

DEVI void stage_peer_route(const P& p, char* smem, int bid, int nblk) {
    const int lane = threadIdx.x & 63, wid = threadIdx.x >> 6, r32 = lane & 31, hi = lane >> 5;
    unsigned* tl = (unsigned*)smem + wid * 1024;
    for (int wt = bid * 8 + wid; wt < 528 * 8; wt += nblk * 8) {
        const int tile = wt >> 3, ph = wt & 7;
        const int row = tile * 32 + r32;
        int hi4 = 4 * hi; asm volatile("" : "+v"(hi4));
#pragma unroll 1
        for (int c = 0; c < 2; ++c) {
            f32x16 acc[4];
#pragma unroll
            for (int t = 0; t < 4; ++t) acc[t] = (f32x16){};
            const bf16_t* qp = p.PQ + (size_t)row * 2048 + ph * 256 + c * 128 + hi * 8;
            const bf16_t* kp = p.KEYSB + ((size_t)((ph * 2 + c) * 128 + r32)) * 128 + hi * 8;
#pragma unroll
            for (int s8 = 0; s8 < 8; ++s8) {
                const bf16x8 qf = *(const bf16x8*)(qp + s8 * 16);
#pragma unroll
                for (int t = 0; t < 4; ++t) {
                    const bf16x8 kf = *(const bf16x8*)(kp + (size_t)t * 32 * 128 + s8 * 16);
                    acc[t] = MFMA32(kf, qf, acc[t]);
                }
            }
            unsigned x[64];
#pragma unroll
            for (int t = 0; t < 4; ++t)
#pragma unroll
                for (int r = 0; r < 16; ++r) {
                    const unsigned u = __float_as_uint(acc[t][r]);
                    const unsigned o = (u & 0x80000000u) ? ~u : (u | 0x80000000u);
                    x[t * 16 + r] = (o & ~127u) | (unsigned)(127 - ((r & 3) + 8 * (r >> 2) + 32 * t) - hi4);
                }
            sort16_desc<0>(x); sort16_desc<16>(x); sort16_desc<32>(x); sort16_desc<48>(x);
            unsigned t01[16], t23[16], tt[16], oth[16], fin[16];
            merge_top16(&x[0], &x[16], t01); merge_top16(&x[32], &x[48], t23); merge_top16(t01, t23, tt);
#pragma unroll
            for (int i = 0; i < 16; ++i) { auto rr = __builtin_amdgcn_permlane32_swap(tt[i], tt[i], false, false); oth[i] = hi ? rr[0] : rr[1]; }
            merge_top16(tt, oth, fin);
            if (hi == 0) {
#pragma unroll
                for (int i = 0; i < 4; ++i) *(u32x4*)(tl + r32 * 32 + c * 16 + i * 4) = (u32x4){fin[4 * i], fin[4 * i + 1], fin[4 * i + 2], fin[4 * i + 3]};
            }
        }
        asm volatile("s_waitcnt lgkmcnt(0)" ::: "memory");
        const int ca = lane < 50 ? PEER_CA[lane] : 0, cb = lane < 50 ? PEER_CB[lane] : 0;
#pragma unroll 1
        for (int tk = 0; tk < 32; ++tk) {
            const unsigned ka = tl[tk * 32 + ca], kb = tl[tk * 32 + 16 + cb];
            const float cand = lane < 50 ? key_score(ka) + key_score(kb) : -INFINITY;
            const int cidx = (127 - (int)(ka & 127u)) * 128 + (127 - (int)(kb & 127u));
            int rk = 0;
#pragma unroll 10
            for (int kk = 0; kk < 50; ++kk) { const float v = __shfl(cand, kk); rk += (v > cand || (v == cand && kk < lane)) ? 1 : 0; }
            const bool sel = lane < 50 && rk < 16;
            const float mx = wave_max(sel ? cand : -INFINITY);
            const float e = sel ? __expf(cand - mx) : 0.f;
            const float sum = wave_sum(e);
            const size_t orow = (size_t)(tile * 32 + tk);
            if (sel) { p.EIDX[orow * 128 + ph * 16 + rk] = cidx; p.EGATE[orow * 128 + ph * 16 + rk] = e / sum; }
        }
        asm volatile("s_waitcnt lgkmcnt(0)" ::: "memory");
    }
}

constexpr int PA_WAVE_LDS = 1024 + 1024 + 512 + 512 + 512;
DEVI void stage_peer_apply(const P& p, char* smem, int bid, int nblk) {
    const int lane = threadIdx.x & 63, wid = threadIdx.x >> 6;
    char* wl = smem + wid * PA_WAVE_LDS;
    unsigned char* hhi = (unsigned char*)wl; unsigned char* hlo = hhi + 1024;
    int* idxs = (int*)(wl + 2048);
    float* gts = (float*)(wl + 2560);
    float* cs = (float*)(wl + 3072);
    const int fr = lane & 15, fq = lane >> 4;
    for (int row = bid * 8 + wid; row < NT; row += nblk * 8) {
        float hv[16];
        {
            const float* hr = p.H + (size_t)row * 1024 + lane * 16;
            u32x4 ohi, olo;
#pragma unroll
            for (int i = 0; i < 4; ++i) {
                const f32x4 x = *(const f32x4*)(hr + i * 4);
#pragma unroll
                for (int k = 0; k < 4; ++k) hv[i * 4 + k] = x[k];
                int w = __builtin_amdgcn_cvt_pk_fp8_f32(x[0], x[1], 0, false); w = __builtin_amdgcn_cvt_pk_fp8_f32(x[2], x[3], w, true);
                const f32x2 d01 = __builtin_amdgcn_cvt_pk_f32_fp8(w, false), d23 = __builtin_amdgcn_cvt_pk_f32_fp8(w, true);
                int w2 = __builtin_amdgcn_cvt_pk_fp8_f32(x[0] - d01[0], x[1] - d01[1], 0, false); w2 = __builtin_amdgcn_cvt_pk_fp8_f32(x[2] - d23[0], x[3] - d23[1], w2, true);
                ohi[i] = (unsigned)w; olo[i] = (unsigned)w2;
            }
            *(u32x4*)(hhi + lane * 16) = ohi; *(u32x4*)(hlo + lane * 16) = olo;
            idxs[lane] = p.EIDX[(size_t)row * 128 + lane]; idxs[lane + 64] = p.EIDX[(size_t)row * 128 + 64 + lane];
            gts[lane] = p.EGATE[(size_t)row * 128 + lane]; gts[lane + 64] = p.EGATE[(size_t)row * 128 + 64 + lane];
            asm volatile("s_waitcnt lgkmcnt(0)" ::: "memory");
        }
#pragma unroll 1
        for (int g = 0; g < 8; ++g) {
            const int my_e = idxs[g * 16 + fr];
            const unsigned char* ub = p.U8 + (size_t)my_e * 1024 + fq * 16;
            f32x4 acc = (f32x4){0.f, 0.f, 0.f, 0.f};
            u32x4 a[16];
#pragma unroll
            for (int s2 = 0; s2 < 16; ++s2) a[s2] = *(const u32x4*)(ub + s2 * 64);
#pragma unroll
            for (int s2 = 0; s2 < 16; ++s2) {
                const u32x4 bh = *(const u32x4*)(hhi + s2 * 64 + fq * 16), bl = *(const u32x4*)(hlo + s2 * 64 + fq * 16);
                const long a0 = (long)(((unsigned long long)a[s2][1] << 32) | a[s2][0]), a1 = (long)(((unsigned long long)a[s2][3] << 32) | a[s2][2]);
                const long h0 = (long)(((unsigned long long)bh[1] << 32) | bh[0]), h1 = (long)(((unsigned long long)bh[3] << 32) | bh[2]);
                const long l0 = (long)(((unsigned long long)bl[1] << 32) | bl[0]), l1 = (long)(((unsigned long long)bl[3] << 32) | bl[2]);
                acc = __builtin_amdgcn_mfma_f32_16x16x32_fp8_fp8(a0, h0, acc, 0, 0, 0);
                acc = __builtin_amdgcn_mfma_f32_16x16x32_fp8_fp8(a1, h1, acc, 0, 0, 0);
                acc = __builtin_amdgcn_mfma_f32_16x16x32_fp8_fp8(a0, l0, acc, 0, 0, 0);
                acc = __builtin_amdgcn_mfma_f32_16x16x32_fp8_fp8(a1, l1, acc, 0, 0, 0);
            }
            const f32x4 gg = *(const f32x4*)(gts + g * 16 + fq * 4);
            f32x4 cv;
#pragma unroll
            for (int r = 0; r < 4; ++r) {
                const int e = idxs[g * 16 + fq * 4 + r];
                const float d = acc[r] * p.US[e];
                cv[r] = gg[r] * p.VS[e] * 0.5f * d * (1.f + erff(d * 0.7071067811865476f));
            }
            if (fr == 0) *(f32x4*)(cs + g * 16 + fq * 4) = cv;
        }
        asm volatile("s_waitcnt lgkmcnt(0)" ::: "memory");
        float acc[16];
#pragma unroll
        for (int i = 0; i < 16; ++i) acc[i] = 0.f;
#pragma unroll 1
        for (int e0 = 0; e0 < 128; e0 += 16) {
            u32x4 v[16]; float c[16];
#pragma unroll
            for (int k = 0; k < 16; ++k) { v[k] = *(const u32x4*)(p.V8 + (size_t)idxs[e0 + k] * 1024 + lane * 16); c[k] = cs[e0 + k]; }
#pragma unroll
            for (int k = 0; k < 16; ++k) {
#pragma unroll
                for (int w = 0; w < 4; ++w) {
                    const f32x2 lo = __builtin_amdgcn_cvt_pk_f32_fp8((int)v[k][w], false), hh = __builtin_amdgcn_cvt_pk_f32_fp8((int)v[k][w], true);
                    acc[w * 4] += c[k] * lo[0]; acc[w * 4 + 1] += c[k] * lo[1]; acc[w * 4 + 2] += c[k] * hh[0]; acc[w * 4 + 3] += c[k] * hh[1];
                }
            }
        }
        float s = 0.f;
#pragma unroll
        for (int i = 0; i < 16; ++i) { acc[i] += DN_ALPHA * hv[i]; s += acc[i]; }
        const float mean = wave_sum(s) * (1.f / 1024.f);
        float q = 0.f;
#pragma unroll
        for (int i = 0; i < 16; ++i) q += (acc[i] - mean) * (acc[i] - mean);
        const float rs = rsqrtf(wave_sum(q) * (1.f / 1024.f) + LN_EPS);
#pragma unroll
        for (int i = 0; i < 4; ++i) {
            const int c = lane * 16 + i * 4;
            const f32x4 g0 = *(const f32x4*)(p.ln2_g + c), b0 = *(const f32x4*)(p.ln2_b + c);
            f32x4 y0;
#pragma unroll
            for (int k = 0; k < 4; ++k) y0[k] = (acc[i * 4 + k] - mean) * rs * g0[k] + b0[k];
            *(f32x4*)(p.out + O_Y + (size_t)row * 1024 + c) = y0;
        }
    }
}

namespace pg8 {
#define PG8_LAS __attribute__((address_space(3)))
typedef unsigned short bf16_t;
typedef short bf16x8 __attribute__((ext_vector_type(8)));
typedef float f32x4 __attribute__((ext_vector_type(4)));
typedef unsigned u32x4 __attribute__((ext_vector_type(4)));
constexpr int BM = 256, BK = 64, HALF = 128, HTB = HALF * BK * 2  , STAGE_BYTES = 8 * HTB, NXCD = 8, WGM = 8;

__host__ __device__ __forceinline__ int lds_byte(int r, int c) { const int st = (r >> 4) * 2 + (c >> 5), rr = r & 15, cc = c & 31, ob = rr * 64 + cc * 2; return st * 1024 + (ob ^ (((ob >> 9) & 1) << 5)); }
__host__ __device__ __forceinline__ void stage_rc(int b, int& R, int& C) { const int st = b / 1024, sb = b % 1024, swz = sb ^ (((sb >> 9) & 1) << 5); R = (st >> 1) * 16 + swz / 64; C = (st & 1) * 32 + (swz % 64) / 2; }
__host__ __device__ __forceinline__ int perm32(int rho) { const int n = rho >> 4, i = rho & 15; return 8 * (i >> 2) + 4 * n + (i & 3); }

struct Unit { int pm, pn; };
struct Gemm { const bf16_t* A; const bf16_t* Bt; int M, N, K; };

struct StaticOrder {
    int nM, nN, nwg, G, c;
    __host__ __device__ void init(int M, int N, int G_, int c_) { nM = M / BM; nN = N / BM; nwg = nM * nN; G = G_; c = c_; }
    __host__ __device__ bool next(int i, Unit& u) const {
        const long L = (long)i * G + c; if (L >= nwg) return false;
        int wgid = (int)L; { const int q = nwg / NXCD, r = nwg % NXCD, xcd = wgid % NXCD, off = wgid / NXCD; wgid = (xcd < r ? xcd * (q + 1) : r * (q + 1) + (xcd - r) * q) + off; }
        const int nig = WGM * nN, gid = wgid / nig, fm = gid * WGM, gsz = (nM - fm) < WGM ? (nM - fm) : WGM;
        u.pm = fm + ((wgid % nig) % gsz); u.pn = (wgid % nig) / gsz; return true;
    }
    __device__ __forceinline__ void a_ready(const Unit&) const {}
    __device__ __forceinline__ void done(const Unit&) const {}
};
template <class Epi, class Sched, bool STAMP = false>
__device__ __forceinline__ void gemm_phase(PG8_LAS unsigned char* lds, const Gemm g, const Sched& S, const Epi& E, unsigned long long* stamps) {
    const int tid = threadIdx.x, wid = __builtin_amdgcn_readfirstlane(tid >> 6), lane = tid & 63, wr = wid >> 2, wc = wid & 3, fr = lane & 15, fq = lane >> 4;
    const int K = g.K, nt = K / BK;
    int ts_lo = 0, ts_hi = 0, nts = 0; const unsigned long long rt_entry = STAMP ? (unsigned long long)wall_clock64() : 0ull;
#define PG8_STAMP() do { if (STAMP && wid == 0 && nts < 64) { const unsigned long long _c = (unsigned long long)clock64(); \
        ts_lo = (lane == nts) ? (int)(unsigned)_c : ts_lo; ts_hi = (lane == nts) ? (int)(unsigned)(_c >> 32) : ts_hi; ++nts; } } while (0)
    PG8_STAMP();
    unsigned voffA[2], voffB[2];
#pragma unroll
    for (int i = 0; i < 2; ++i) { int R, C; stage_rc(tid * 16 + i * 8192, R, C); const int Rb = Epi::PERM ? ((R & ~31) + perm32(R & 31)) : R;
        voffA[i] = (unsigned)(R * K + C) * 2u; voffB[i] = (unsigned)(Rb * K + C) * 2u; }
    const size_t kstep = (size_t)(BK * 2);
    const size_t hstep = (size_t)HALF * K * 2;
    const size_t tstep = 2 * hstep;
    const unsigned ldsw = (unsigned)wid * 1024u;
    const int aoff = lds_byte(wr * 64 + fr, fq * 8), boff = lds_byte(wc * 32 + fr, fq * 8);
#define PG8_SA(b, h) (((b) * 2 + (h)) * HTB)
#define PG8_SB(b, h) ((4 + (b) * 2 + (h)) * HTB)
#define PG8_STAGE(bufoff, gbase, voff) do { _Pragma("unroll") for (int _i = 0; _i < 2; ++_i) \
        __builtin_amdgcn_global_load_lds((const unsigned*)((const char*)(gbase) + (voff)[_i]), (PG8_LAS unsigned*)(lds + (bufoff) + ldsw + _i * 8192), 16, 0, 0); } while (0)
#define PG8_LDA(dst, b, h) do { _Pragma("unroll") for (int m = 0; m < 4; ++m) _Pragma("unroll") for (int k = 0; k < 2; ++k) dst[m][k] = *(const PG8_LAS bf16x8*)(lds + PG8_SA(b, h) + aoff + m * 2048 + k * 1024); } while (0)
#define PG8_LDB(dst, b, h) do { _Pragma("unroll") for (int n = 0; n < 2; ++n) _Pragma("unroll") for (int k = 0; k < 2; ++k) dst[n][k] = *(const PG8_LAS bf16x8*)(lds + PG8_SB(b, h) + boff + n * 2048 + k * 1024); } while (0)
#define PG8_MMA(ai, bj, At, Bt) do { __builtin_amdgcn_s_setprio(1); _Pragma("unroll") for (int m = 0; m < 4; ++m) _Pragma("unroll") for (int n = 0; n < 2; ++n) _Pragma("unroll") for (int k = 0; k < 2; ++k) \
        acc[ai][bj][m][n] = __builtin_amdgcn_mfma_f32_16x16x32_bf16(Bt[n][k], At[m][k], acc[ai][bj][m][n], 0, 0, 0); __builtin_amdgcn_s_setprio(0); } while (0)
#define PG8_WAIT_V(n) asm volatile("s_waitcnt vmcnt(" #n ")" ::: "memory")
#define PG8_WAIT_L(n) asm volatile("s_waitcnt lgkmcnt(" #n ")" ::: "memory")
#define PG8_BAR __builtin_amdgcn_s_barrier()
#define PG8_SCHED __builtin_amdgcn_sched_barrier(0)
    Unit cur, nxt; int ui = 0;
    if (!S.next(0, cur)) return;
    f32x4 acc[2][2][4][2];
#pragma unroll
    for (int a = 0; a < 2; ++a)
#pragma unroll
        for (int b = 0; b < 2; ++b)
#pragma unroll
            for (int m = 0; m < 4; ++m)
#pragma unroll
                for (int n = 0; n < 2; ++n) acc[a][b][m][n] = (f32x4){0.f, 0.f, 0.f, 0.f};
    bf16x8 At[4][2], B0[2][2], B1[2][2];
    const char* cA = (const char*)g.A + (size_t)cur.pm * tstep; const char* cB = (const char*)g.Bt + (size_t)cur.pn * tstep;
    S.a_ready(cur);
    PG8_STAGE(PG8_SB(0, 0), cB, voffB); PG8_STAGE(PG8_SA(0, 0), cA, voffA); PG8_STAGE(PG8_SB(0, 1), cB + hstep, voffB); PG8_STAGE(PG8_SA(0, 1), cA + hstep, voffA);
    if (wr == 1) PG8_BAR;
    PG8_WAIT_V(4); PG8_BAR;
    PG8_STAGE(PG8_SB(1, 0), cB + kstep, voffB); PG8_STAGE(PG8_SA(1, 0), cA + kstep, voffA); PG8_STAGE(PG8_SB(1, 1), cB + hstep + kstep, voffB);
    PG8_WAIT_V(6); PG8_BAR;
    PG8_STAMP();
    for (;;) {
        const bool has_next = S.next(ui + 1, nxt);
        const char* nA = has_next ? (const char*)g.A + (size_t)nxt.pm * tstep : cA; const char* nB = has_next ? (const char*)g.Bt + (size_t)nxt.pn * tstep : cB;
        for (int t = 0; t < nt; t += 2) {
            const bool last = (t == nt - 2);
            const char* a1 = cA + (size_t)(t + 1) * kstep;
            const char* a2 = last ? nA : cA + (size_t)(t + 2) * kstep; const char* b2 = last ? nB : cB + (size_t)(t + 2) * kstep;
            const char* a3 = a2 + kstep; const char* b3 = b2 + kstep;
            if (last && has_next) S.a_ready(nxt);
            PG8_LDB(B0, 0, 0); PG8_SCHED; PG8_LDA(At, 0, 0); PG8_STAGE(PG8_SA(1, 1), a1 + hstep, voffA);
            PG8_WAIT_L(8); PG8_BAR; PG8_WAIT_L(0); PG8_MMA(0, 0, At, B0); PG8_BAR; PG8_SCHED;
            PG8_LDB(B1, 0, 1); PG8_STAGE(PG8_SB(0, 0), b2, voffB);
            PG8_BAR; PG8_WAIT_L(0); PG8_MMA(0, 1, At, B1); PG8_BAR;
            PG8_LDA(At, 0, 1); PG8_STAGE(PG8_SA(0, 0), a2, voffA);
            PG8_BAR; PG8_WAIT_L(0); PG8_MMA(1, 0, At, B0); PG8_BAR; PG8_SCHED;
            PG8_STAGE(PG8_SB(0, 1), b2 + hstep, voffB);
            PG8_WAIT_V(6); PG8_BAR; PG8_MMA(1, 1, At, B1); PG8_BAR;
            PG8_LDB(B0, 1, 0); PG8_SCHED; PG8_LDA(At, 1, 0); PG8_STAGE(PG8_SA(0, 1), a2 + hstep, voffA);
            PG8_WAIT_L(8); PG8_BAR; PG8_WAIT_L(0); PG8_MMA(0, 0, At, B0); PG8_BAR; PG8_SCHED;
            PG8_LDB(B1, 1, 1); PG8_STAGE(PG8_SB(1, 0), b3, voffB);
            PG8_BAR; PG8_WAIT_L(0); PG8_MMA(0, 1, At, B1); PG8_BAR;
            PG8_LDA(At, 1, 1); PG8_STAGE(PG8_SA(1, 0), a3, voffA);
            PG8_BAR; PG8_WAIT_L(0); PG8_MMA(1, 0, At, B0); PG8_BAR; PG8_SCHED;
            PG8_STAGE(PG8_SB(1, 1), b3 + hstep, voffB);
            PG8_WAIT_V(6); PG8_BAR; PG8_MMA(1, 1, At, B1); PG8_BAR;
        }
        PG8_STAMP();
        if constexpr (!Epi::AFTER_DRAIN) { E(acc, cur, wr, wc, fr, fq); S.done(cur); }
        PG8_STAMP();
        if (!has_next) break;
#pragma unroll
        for (int a = 0; a < 2; ++a)
#pragma unroll
            for (int b = 0; b < 2; ++b)
#pragma unroll
                for (int m = 0; m < 4; ++m)
#pragma unroll
                    for (int n = 0; n < 2; ++n) acc[a][b][m][n] = (f32x4){0.f, 0.f, 0.f, 0.f};
        cur = nxt; cA = nA; cB = nB; ++ui;
    }
    PG8_WAIT_V(0);
    if (wr == 0) PG8_BAR;
    PG8_BAR;
    if constexpr (Epi::AFTER_DRAIN) { E.fused(acc, cur, wr, wc, fr, fq, lds, wid, lane); S.done(cur); }
    PG8_STAMP();
    if (STAMP && wid == 0) { stamps[lane] = lane < nts ? (((unsigned long long)(unsigned)ts_hi << 32) | (unsigned)ts_lo) : 0ull;
        if (lane == 62) stamps[62] = rt_entry; if (lane == 63) stamps[63] = (unsigned long long)wall_clock64(); }
#undef PG8_STAMP
#undef PG8_SA
#undef PG8_SB
#undef PG8_STAGE
#undef PG8_LDA
#undef PG8_LDB
#undef PG8_MMA
#undef PG8_WAIT_V
#undef PG8_WAIT_L
#undef PG8_BAR
#undef PG8_SCHED
}
}

template <class F> struct EpiAdapt {
    static constexpr bool PERM = false, AFTER_DRAIN = false;
    F f;
    __device__ __forceinline__ void operator()(const pg8::f32x4 (&acc)[2][2][4][2], const pg8::Unit& u, int wr, int wc, int fr, int fq) const {
        constexpr int B = F::BATCH;
        const int row0 = u.pm * 256 + wr * 64 + fr, col0 = u.pn * 256 + wc * 32 + 4 * fq;
        if constexpr (B == 0) {
            typename F::Pre pre[4];
#pragma unroll
            for (int i = 0; i < 4; ++i) pre[i] = f.pre(row0, col0 + (i >> 1) * 128 + (i & 1) * 16);
#pragma unroll
            for (int q = 0; q < 32; ++q) { const int n = q & 1, bj = (q >> 1) & 1, m = (q >> 2) & 3, ai = q >> 4; f.put(row0 + ai * 128 + m * 16, col0 + bj * 128 + n * 16, acc[ai][bj][m][n], pre[bj * 2 + n]); }
        } else
#pragma unroll
        for (int q0 = 0; q0 < 32; q0 += (B > 0 ? B : 32)) {
            typename F::Pre pre[B > 0 ? B : 1];
#pragma unroll
            for (int i = 0; i < B; ++i) { const int q = q0 + i, n = q & 1, bj = (q >> 1) & 1, m = (q >> 2) & 3, ai = q >> 4; pre[i] = f.pre(row0 + ai * 128 + m * 16, col0 + bj * 128 + n * 16); }
#pragma unroll
            for (int i = 0; i < B; ++i) { const int q = q0 + i, n = q & 1, bj = (q >> 1) & 1, m = (q >> 2) & 3, ai = q >> 4; f.put(row0 + ai * 128 + m * 16, col0 + bj * 128 + n * 16, acc[ai][bj][m][n], pre[i]); }
        }
    }
};
template <class F>
DEVI void gemm_pg8(const bf16_t* A, const bf16_t* Bt, int M, int N, int K, const F& f, char* smem, int bid, int nblk) {
    pg8::Gemm g{A, Bt, M, N, K};
    pg8::StaticOrder S; S.init(M, N, nblk, bid);
    EpiAdapt<F> E{f};
    __syncthreads();
    pg8::gemm_phase<EpiAdapt<F>, pg8::StaticOrder, false>((PG8_LAS unsigned char*)smem, g, S, E, nullptr);
    __syncthreads();
}

#define XB_TMO      128
#define XB_XCNT(j)  (256  + 64 * (j))
#define XB_XSUB(j)  (1280 + 64 * (j))
#define XB_XGEN(j)  (2304 + 64 * (j))
#define XB_TOP      3328
#define XB_TOPGEN   3392
#define XCD_BAR_WORDS 3456
#define XB_SPIN_CAP (1u << 18)
#define LAS __attribute__((address_space(3)))

__device__ __forceinline__ unsigned xb_ld(unsigned* p)              { return __hip_atomic_load(p, __ATOMIC_RELAXED, __HIP_MEMORY_SCOPE_AGENT); }
__device__ __forceinline__ unsigned xb_add(unsigned* p, unsigned v) { return __hip_atomic_fetch_add(p, v, __ATOMIC_RELAXED, __HIP_MEMORY_SCOPE_AGENT); }
__device__ __forceinline__ unsigned xb_xcc_id() { return (unsigned)__builtin_amdgcn_s_getreg((3 << 11) | 20) & 0xFu; }
#define XB_SPIN(cond, bar) do { unsigned _sp = 0; while (cond) { __builtin_amdgcn_s_sleep(1); \
    if ((++_sp & 255u) == 0u) { if (xb_ld(&(bar)[XB_TMO])) break; if (_sp > XB_SPIN_CAP) { atomicAdd(&(bar)[XB_TMO], 1u); break; } } } } while (0)

struct XcdBarrier {
    unsigned* bar; unsigned x;
    volatile LAS unsigned* st;
};

__device__ __forceinline__ XcdBarrier xcd_barrier_post(unsigned* bar, volatile LAS unsigned* st) {
    XcdBarrier b; b.bar = bar; b.x = xb_xcc_id(); b.st = st;
    if (threadIdx.x == 0) (void)xb_add(&bar[XB_XCNT(b.x)], 1u);
    return b;
}
__device__ __forceinline__ void xcd_barrier_complete(unsigned* bar, unsigned x, unsigned& nloc, unsigned& nx) {
    const unsigned G = gridDim.x * gridDim.y * gridDim.z;
    unsigned sum, cnt, mine, sp = 0u;
    for (;;) {
        sum = 0u; cnt = 0u; mine = 0u;
#pragma unroll
        for (unsigned j = 0; j < 16; ++j) { const unsigned c = xb_ld(&bar[XB_XCNT(j)]); sum += c; cnt += (c > 0u) ? 1u : 0u; mine = (j == x) ? c : mine; }
        if (sum == G) break;
        __builtin_amdgcn_s_sleep(1);
        if ((++sp & 255u) == 0u) { if (xb_ld(&bar[XB_TMO])) break; if (sp > XB_SPIN_CAP) { atomicAdd(&bar[XB_TMO], 1u); break; } }
    }
    nloc = mine > 0u ? mine : 1u; nx = cnt > 0u ? cnt : 1u;
}

__device__ __forceinline__ void xcd_barrier(const XcdBarrier& b) {
    asm volatile("s_waitcnt vmcnt(0)" ::: "memory");
    __syncthreads();
    if (threadIdx.x == 0) {
        unsigned* bar = b.bar;
        __builtin_amdgcn_s_waitcnt(0);
        unsigned nloc = b.st[0], nx = b.st[1];
        if (nloc == 0u) { xcd_barrier_complete(bar, b.x, nloc, nx); b.st[0] = nloc; b.st[1] = nx; }
        const unsigned old = xb_add(&bar[XB_XSUB(b.x)], 1u);
        const unsigned gen = old / nloc;
        if (old + 1u == (gen + 1u) * nloc) {
            __builtin_amdgcn_fence(__ATOMIC_RELEASE, "agent");
            asm volatile("s_waitcnt vmcnt(0)" ::: "memory");
            const unsigned og = xb_add(&bar[XB_TOP], 1u);
            const unsigned tg = og / nx;
            if (og + 1u == (tg + 1u) * nx) xb_add(&bar[XB_TOPGEN], 1u);
            else XB_SPIN(xb_ld(&bar[XB_TOPGEN]) == tg, bar);
            __builtin_amdgcn_fence(__ATOMIC_ACQUIRE, "agent");
            xb_add(&bar[XB_XGEN(b.x)], 1u);
            asm volatile("s_waitcnt vmcnt(0)" ::: "memory");
        } else {
            XB_SPIN(xb_ld(&bar[XB_XGEN(b.x)]) == gen, bar);
            __builtin_amdgcn_fence(__ATOMIC_ACQUIRE, "agent");
            asm volatile("s_waitcnt vmcnt(0)" ::: "memory");
        }
    }
    __syncthreads();
}

constexpr int LDS_BYTES = 152 * 1024;

template <int S>
DEVI void run_stage(const P& p, char* smem, int bid, int nblk) {
    if (S == 0) stage_prologue(p, smem, bid, nblk);
    if (S == 1) { EpiInProj e{p}; gemm_pg8(p.XB, p.WINT, NT, NPAD_IN, 1024, e, smem, bid, nblk); }
    if (S == 2) { stage_mlstm_gates(p, smem, bid, nblk); stage_compress(p, smem, bid, nblk); }
    if (S == 3) { stage_mlstm_dc(p, smem, bid, nblk); stage_mlstm_sample(p, smem, bid, nblk); }
    if (S == 4) { stage_mlstm_scan(p, bid, nblk); stage_nsa_attn(p, smem, bid, nblk); { EpiG e{p}; gemm_pg8(p.XB, p.WMT, NT, 2048, 1024, e, smem, bid, nblk); } }
    if (S == 5) stage_mlstm_out(p, smem, bid, nblk);
    if (S == 6) { EpiM1 e{p}; gemm_pg8(p.YA, p.WAT, NT, 1024, 1024, e, smem, bid, nblk); }
    if (S == 7) { EpiM2 e{p}; gemm_pg8(p.YB, p.WBT, NT, 1024, 1024, e, smem, bid, nblk); }
    if (S == 8) { EpiR e{p}; gemm_pg8(p.MERGED, p.WOT, NT, 1024, 1024, e, smem, bid, nblk); }
    if (S == 9) stage_ln1(p, bid, nblk);
    if (S == 10) { EpiPQ e{p}; gemm_pg8(p.HB, p.WQT, NT, 2048, 1024, e, smem, bid, nblk); }
    if (S == 11) stage_peer_route(p, smem, bid, nblk);
    if (S == 12) stage_peer_apply(p, smem, bid, nblk);
}
constexpr int NSTAGES = 13;

template <int S>
__global__ void __launch_bounds__(512, 2) k_stage(P p) {
    extern __shared__ __attribute__((aligned(16))) char smem[];
    run_stage<S>(p, smem, blockIdx.x, gridDim.x);
}


#if MK_ONE_LAUNCH
__global__ void __launch_bounds__(512, 2) k_mega(P p) {
    extern __shared__ __attribute__((aligned(16))) char smem_all[];
    if (threadIdx.x == 0) *(u32x4*)smem_all = (u32x4){0u, 0u, 0u, 0u};
    __syncthreads();
    XcdBarrier bar = xcd_barrier_post(p.bar, (volatile LAS unsigned*)smem_all);
    char* smem = smem_all + 16;
    const int bid = blockIdx.x, nblk = gridDim.x;
    run_stage<0>(p, smem, bid, nblk); if ((REP_MASK >> 0) & 1) { xcd_barrier(bar); run_stage<0>(p, smem, bid, nblk); }  xcd_barrier(bar);
    run_stage<1>(p, smem, bid, nblk); if ((REP_MASK >> 1) & 1) { xcd_barrier(bar); run_stage<1>(p, smem, bid, nblk); }  xcd_barrier(bar);
    run_stage<2>(p, smem, bid, nblk); if ((REP_MASK >> 2) & 1) { xcd_barrier(bar); run_stage<2>(p, smem, bid, nblk); }  xcd_barrier(bar);
    run_stage<3>(p, smem, bid, nblk); if ((REP_MASK >> 3) & 1) { xcd_barrier(bar); run_stage<3>(p, smem, bid, nblk); }  xcd_barrier(bar);
    run_stage<4>(p, smem, bid, nblk); if ((REP_MASK >> 4) & 1) { xcd_barrier(bar); run_stage<4>(p, smem, bid, nblk); }  xcd_barrier(bar);
    run_stage<5>(p, smem, bid, nblk); if ((REP_MASK >> 5) & 1) { xcd_barrier(bar); run_stage<5>(p, smem, bid, nblk); }  xcd_barrier(bar);
    run_stage<6>(p, smem, bid, nblk); if ((REP_MASK >> 6) & 1) { xcd_barrier(bar); run_stage<6>(p, smem, bid, nblk); }  xcd_barrier(bar);
    run_stage<7>(p, smem, bid, nblk); if ((REP_MASK >> 7) & 1) { xcd_barrier(bar); run_stage<7>(p, smem, bid, nblk); }  xcd_barrier(bar);
    run_stage<8>(p, smem, bid, nblk); if ((REP_MASK >> 8) & 1) { xcd_barrier(bar); run_stage<8>(p, smem, bid, nblk); }  xcd_barrier(bar);
    run_stage<9>(p, smem, bid, nblk); if ((REP_MASK >> 9) & 1) { xcd_barrier(bar); run_stage<9>(p, smem, bid, nblk); }  xcd_barrier(bar);
    run_stage<10>(p, smem, bid, nblk); if ((REP_MASK >> 10) & 1) { xcd_barrier(bar); run_stage<10>(p, smem, bid, nblk); } xcd_barrier(bar);
    run_stage<11>(p, smem, bid, nblk); if ((REP_MASK >> 11) & 1) { xcd_barrier(bar); run_stage<11>(p, smem, bid, nblk); } xcd_barrier(bar);
    run_stage<12>(p, smem, bid, nblk); if ((REP_MASK >> 12) & 1) { xcd_barrier(bar); run_stage<12>(p, smem, bid, nblk); }
}
#endif

template <int S> static void launch_stage(const P& p, int grid, hipStream_t stream) {
    (void)hipFuncSetAttribute((const void*)k_stage<S>, hipFuncAttributeMaxDynamicSharedMemorySize, LDS_BYTES);
    k_stage<S><<<dim3(grid), dim3(512), LDS_BYTES, stream>>>(p);
}

extern "C" void kernel_launch(void* const* d_in, const int* in_sizes, int n_in, void* d_out, int out_size, void* d_ws, size_t ws_size, hipStream_t stream) {
    (void)in_sizes; (void)n_in; (void)out_size; (void)ws_size;
    P p{};
    p.xp = (const float*)d_in[0]; p.xs = (const float*)d_in[1]; p.cache_cmp = (const float*)d_in[2]; p.cache_slc = (const float*)d_in[3];
    p.cache_win = (const float*)d_in[4]; p.state_C = (const float*)d_in[5]; p.state_n = (const float*)d_in[6]; p.state_m = (const float*)d_in[7];
    p.page_table = (const int*)d_in[8];
    p.w_in = (const float*)d_in[9]; p.b_in = (const float*)d_in[10]; p.norm_a_g = (const float*)d_in[11]; p.nsa_pe = (const float*)d_in[12];
    p.nsa_w_cmp = (const float*)d_in[13]; p.w_br_a = (const float*)d_in[14]; p.w_br_b = (const float*)d_in[15]; p.w_merge = (const float*)d_in[16];
    p.w_out = (const float*)d_in[17]; p.ln1_g = (const float*)d_in[18]; p.ln1_b = (const float*)d_in[19];
    p.peer_wq = (const float*)d_in[20]; p.peer_keys = (const float*)d_in[21]; p.peer_u = (const float*)d_in[22]; p.peer_v = (const float*)d_in[23];
    p.ln2_g = (const float*)d_in[24]; p.ln2_b = (const float*)d_in[25];
    p.out = (float*)d_out;
    char* w = (char*)d_ws; size_t off = 0;
    auto take = [&](size_t bytes) { char* r = w + off; off += (bytes + 255) & ~(size_t)255; return r; };
    p.bar = (unsigned*)take(16384);
    p.PW = (float*)(p.bar + 3584);
    p.WCT = (bf16_t*)take((size_t)2 * 64 * 4096 * 2);
    p.XB = (bf16_t*)take((size_t)NT * 1024 * 2);
    p.WINT = (bf16_t*)take((size_t)NPAD_IN * 1024 * 2);
    p.WMT = (bf16_t*)take((size_t)2048 * 1024 * 2);
    p.WAT = (bf16_t*)take((size_t)1024 * 1024 * 2);
    p.WBT = (bf16_t*)take((size_t)1024 * 1024 * 2);
    p.WOT = (bf16_t*)take((size_t)1024 * 1024 * 2);
    p.WQT = (bf16_t*)take((size_t)2048 * 1024 * 2);
    p.KEYSB = (bf16_t*)take((size_t)16 * 128 * 128 * 2);
    p.U8 = (unsigned char*)take((size_t)16384 * 1024);
    p.V8 = (unsigned char*)take((size_t)16384 * 1024);
    p.US = (float*)take(16384 * 4);
    p.VS = (float*)take(16384 * 4);
    p.PROJ = (bf16_t*)take((size_t)NT * PS * 2);
    p.SM = (float*)take((size_t)NT * 64 * 4);
    p.BCUM = (float*)take((size_t)16 * 4096 * 4);
    p.MPREV = (float*)take(4096); p.ACOEF = (float*)take(4096); p.SCL = (float*)take(4096); p.MLOC = (float*)take(4096);
    p.DC = (float*)take((size_t)1024 * 272 * 128 * 4);
    p.CPT = (bf16_t*)take((size_t)1024 * 272 * 128 * 2);
    p.KC = (float*)take((size_t)4352 * 512 * 4);
    p.VC = p.KC + 256;
    p.OCMP = (float*)take((size_t)NT * 1024 * 4);
    p.SEL = (unsigned long long*)take((size_t)NT * 4 * 8);
    p.YA = (bf16_t*)take((size_t)NT * 1024 * 2);
    p.YB = (bf16_t*)take((size_t)NT * 1024 * 2);
    p.G = (bf16_t*)take((size_t)NT * 2048 * 2);
    p.TMP = (float*)take((size_t)NT * 1024 * 4);
    p.MERGED = (bf16_t*)take((size_t)NT * 1024 * 2);
    p.R = (float*)take((size_t)NT * 1024 * 4);
    p.H = (float*)take((size_t)NT * 1024 * 4);
    p.HB = (bf16_t*)take((size_t)NT * 1024 * 2);
    p.PQ = (bf16_t*)take((size_t)NT * 2048 * 2);
    p.EIDX = (int*)take((size_t)NT * 128 * 4);
    p.EGATE = (float*)take((size_t)NT * 128 * 4);

    (void)hipMemsetAsync(p.bar, 0, 16384, stream);
#if MK_ONE_LAUNCH
    {
        constexpr size_t kDynLds = LDS_BYTES + 16;
        (void)hipFuncSetAttribute((const void*)k_mega, hipFuncAttributeMaxDynamicSharedMemorySize, (int)kDynLds);
        int dev = 0, cus = 0, per_cu = 0;
        (void)hipGetDevice(&dev);
        (void)hipDeviceGetAttribute(&cus, hipDeviceAttributeMultiprocessorCount, dev);
        (void)hipOccupancyMaxActiveBlocksPerMultiprocessor(&per_cu, (const void*)k_mega, 512, kDynLds);
        if (per_cu < 1 || cus < 1) return;
        const int grid = cus;
        k_mega<<<dim3(grid), dim3(512), kDynLds, stream>>>(p);
    }
#else
    const int grid = 512;
    launch_stage<0>(p, grid, stream);
    launch_stage<1>(p, grid, stream);
    launch_stage<2>(p, grid, stream);
    launch_stage<3>(p, grid, stream);
    launch_stage<4>(p, grid, stream);
    launch_stage<5>(p, grid, stream);
    launch_stage<6>(p, grid, stream);
    launch_stage<7>(p, grid, stream);
    launch_stage<8>(p, grid, stream);
    launch_stage<9>(p, grid, stream);
    launch_stage<10>(p, grid, stream);
    launch_stage<11>(p, grid, stream);
    launch_stage<12>(p, grid, stream);
#endif
}
```

```cpp
#include <hip/hip_runtime.h>
#include <stdint.h>

#ifndef REP_MASK
#define REP_MASK 0
#endif
#ifndef MK_ONE_LAUNCH
#define MK_ONE_LAUNCH 1
#endif

typedef unsigned short bf16_t;
typedef short bf16x8 __attribute__((ext_vector_type(8)));
typedef float f32x4 __attribute__((ext_vector_type(4)));
typedef unsigned u32x4 __attribute__((ext_vector_type(4)));
typedef unsigned u32x2 __attribute__((ext_vector_type(2)));
typedef float f32x2 __attribute__((ext_vector_type(2)));
typedef __bf16 bf16x2_t __attribute__((ext_vector_type(2)));
#define DEVI __device__ __forceinline__
__device__ __forceinline__ int tid_opq() { int t = threadIdx.x; asm volatile("" : "+v"(t)); return t; }

constexpr int NTP = 16384, NTS = 512, NT = NTP + NTS, DM = 1024;
constexpr int PS = 5632;
constexpr int C_AQ = 0, C_AK = 512, C_AV = 1024, C_AO = 2048, C_BQ = 3072, C_CMP = 4096, C_SLC = 4608, C_WIN = 5120;
constexpr int NPAD_IN = 5888;
constexpr float DN_ALPHA = 1.189207115002721f;
constexpr float LN_EPS = 1e-5f;
constexpr size_t O_Y = 0;
constexpr size_t O_PCMP = O_Y + (size_t)NT * 1024;
constexpr size_t O_PSLC = O_PCMP + (size_t)NTP * 512;
constexpr size_t O_PWIN = O_PSLC + (size_t)NTP * 512;
constexpr size_t O_PC = O_PWIN + (size_t)4 * 512 * 512;
constexpr size_t O_PN = O_PC + (size_t)16 * 128 * 256;
constexpr size_t O_PM = O_PN + 16 * 128;
constexpr size_t O_SCMP = O_PM + 16;
constexpr size_t O_SSLC = O_SCMP + (size_t)NTS * 512;
constexpr size_t O_SWIN = O_SSLC + (size_t)NTS * 512;
constexpr size_t O_SC = O_SWIN + (size_t)128 * 512 * 512;
constexpr size_t O_SN = O_SC + (size_t)512 * 128 * 256;
constexpr size_t O_SM = O_SN + 512 * 128;

struct P {
    const float *xp, *xs, *cache_cmp, *cache_slc, *cache_win, *state_C, *state_n, *state_m;
    const int* page_table;
    const float *w_in, *b_in, *norm_a_g, *nsa_pe, *nsa_w_cmp, *w_br_a, *w_br_b, *w_merge, *w_out, *ln1_g, *ln1_b;
    const float *peer_wq, *peer_keys, *peer_u, *peer_v, *ln2_g, *ln2_b;
    float* out;
    bf16_t *XB, *WINT, *WMT, *WAT, *WBT, *WOT, *WQT, *KEYSB, *UB, *VB, *PROJ, *WCT;
    float* PW;
    float *SM, *BCUM, *MPREV, *ACOEF, *SCL, *MLOC, *DC, *KC, *VC, *OCMP;
    bf16_t* CPT;
    unsigned char *U8, *V8;
    float *US, *VS;
    unsigned long long* SEL;
    bf16_t *YA, *YB, *G, *MERGED, *HB, *PQ;
    float *R, *H, *EGATE;
    bf16_t* TMPB;
    int* EIDX;
    unsigned* bar;
};

DEVI bf16_t f2bf(float f) { return __builtin_bit_cast(unsigned short, (__bf16)f); }
DEVI float bf2f(bf16_t h) { return __uint_as_float(((unsigned)h) << 16); }
DEVI unsigned pack2(float a, float b) { return __builtin_bit_cast(unsigned, __builtin_convertvector((f32x2){a, b}, bf16x2_t)); }
DEVI u32x4 pack8f(const f32x4 a, const f32x4 b) { u32x4 r; r[0] = pack2(a[0], a[1]); r[1] = pack2(a[2], a[3]); r[2] = pack2(b[0], b[1]); r[3] = pack2(b[2], b[3]); return r; }
DEVI float wave_max(float v) { for (int o = 32; o > 0; o >>= 1) v = fmaxf(v, __shfl_xor(v, o)); return v; }
DEVI float wave_sum(float v) { for (int o = 32; o > 0; o >>= 1) v += __shfl_xor(v, o); return v; }
DEVI float sigmoidf_(float x) { return 1.f / (1.f + __expf(-x)); }
DEVI float logsigmoidf_(float x) { return fminf(x, 0.f) - log1pf(__expf(-fabsf(x))); }
DEVI int win_map(int np) {
    if (np < 2048) return np;
    if (np < 5632) return np + 8;
    if (np < 5640) return np - 5632 + 2048;
    if (np < 5688) return np;
    return -1;
}
DEVI float alibi_slope(int h) { return exp2f(-0.5f * (float)(h + 1)); }

template <class MapFn>
DEVI void transpose_cvt(const float* __restrict__ W, bf16_t* __restrict__ WT, int K, int Nsrc, int Ndst, MapFn mapfn, float* tile  , int bid, int nblk) {
    const int tid = tid_opq();
    const int tn = Ndst / 64, tk = K / 64;
    for (int t = bid; t < tn * tk; t += nblk) {
        const int n0 = (t % tn) * 64, k0 = (t / tn) * 64;
        __syncthreads();
#pragma unroll
        for (int i = 0; i < 8; ++i) {
            const int kk = (tid >> 6) + i * 8, nn = tid & 63;
            const int n = mapfn(n0 + nn);
            tile[kk * 65 + nn] = n >= 0 ? W[(size_t)(k0 + kk) * Nsrc + n] : 0.f;
        }
        __syncthreads();
#pragma unroll
        for (int i = 0; i < 8; ++i) {
            const int nn = (tid >> 6) + i * 8, kk = tid & 63;
            WT[(size_t)(n0 + nn) * K + k0 + kk] = f2bf(tile[kk * 65 + nn]);
        }
    }
}
struct IdMap { DEVI int operator()(int n) const { return n; } };
struct WinMap { DEVI int operator()(int n) const { return win_map(n); } };

DEVI void cvt_rows(const float* __restrict__ src, bf16_t* __restrict__ dst, size_t n4, int bid, int nblk) {
    for (size_t i = (size_t)bid * blockDim.x + tid_opq(); i < n4; i += (size_t)nblk * blockDim.x) {
        const f32x4 v = ((const f32x4*)src)[i];
        u32x2 o; o.x = pack2(v.x, v.y); o.y = pack2(v.z, v.w);
        ((u32x2*)dst)[i] = o;
    }
}

DEVI void stage_prologue(const P& p, char* smem, int bid, int nblk) {
    float* tile = (float*)smem;
    cvt_rows(p.xp, p.XB, (size_t)NTP * 256, bid, nblk);
    cvt_rows(p.xs, p.XB + (size_t)NTP * 1024, (size_t)NTS * 256, bid, nblk);
    {
        const int lane = tid_opq() & 63, wid = tid_opq() >> 6;
        for (int r = bid * 8 + wid; r < 2 * 16384; r += nblk * 8) {
            const bool isv = r >= 16384; const int e = isv ? r - 16384 : r;
            const float* src = (isv ? p.peer_v : p.peer_u) + (size_t)e * 1024 + lane * 16;
            f32x4 x[4]; float am = 0.f;
#pragma unroll
            for (int i = 0; i < 4; ++i) { x[i] = *(const f32x4*)(src + i * 4);
#pragma unroll
                for (int k = 0; k < 4; ++k) am = fmaxf(am, fabsf(x[i][k])); }
            am = wave_max(am);
            const float inv = am > 0.f ? 448.f / am : 1.f;
            u32x4 o;
#pragma unroll
            for (int i = 0; i < 4; ++i) { int w = __builtin_amdgcn_cvt_pk_fp8_f32(x[i][0] * inv, x[i][1] * inv, 0, false); w = __builtin_amdgcn_cvt_pk_fp8_f32(x[i][2] * inv, x[i][3] * inv, w, true); o[i] = (unsigned)w; }
            *(u32x4*)((isv ? p.V8 : p.U8) + (size_t)e * 1024 + lane * 16) = o;
            if (lane == 0) (isv ? p.VS : p.US)[e] = am > 0.f ? am / 448.f : 1.f;
        }
    }
    cvt_rows(p.peer_keys, p.KEYSB, (size_t)16 * 128 * 128 / 4, bid, nblk);
    transpose_cvt(p.w_in, p.WINT, 1024, 5688, NPAD_IN, WinMap(), tile, bid, nblk);
    transpose_cvt(p.w_merge, p.WINT + (size_t)NPAD_IN * 1024, 1024, 2048, 2048, IdMap(), tile, bid, nblk);
    transpose_cvt(p.w_br_a, p.WAT, 1024, 1024, 1024, IdMap(), tile, bid, nblk);
    transpose_cvt(p.w_br_b, p.WBT, 1024, 1024, 1024, IdMap(), tile, bid, nblk);
    transpose_cvt(p.w_out, p.WOT, 1024, 1024, 1024, IdMap(), tile, bid, nblk);
    transpose_cvt(p.peer_wq, p.WQT, 1024, 2048, 2048, IdMap(), tile, bid, nblk);
    transpose_cvt(p.nsa_w_cmp, p.WCT, 4096, 64, 64, IdMap(), tile, bid, nblk);
    transpose_cvt(p.nsa_w_cmp + 4096 * 64, p.WCT + 64 * 4096, 4096, 64, 64, IdMap(), tile, bid, nblk);
    for (int blk = bid; blk < 32; blk += nblk) {
        const int tid = tid_opq(), kvv = tid >> 8, e = tid & 63, kq = (tid >> 6) & 3;
        float a = 0.f;
        for (int k = blk * 128 + kq * 32; k < blk * 128 + kq * 32 + 32; ++k) a += p.nsa_pe[kvv * 4096 + k] * p.nsa_w_cmp[((size_t)kvv * 4096 + k) * 64 + e];
        atomicAdd(p.PW + kvv * 64 + e, a);
    }
    {
        const size_t per_b = (size_t)508 * 512 / 4;
        for (size_t i = (size_t)bid * blockDim.x + tid_opq(); i < 128 * per_b; i += (size_t)nblk * blockDim.x) {
            const size_t b = i / per_b, r = i % per_b;
            ((f32x4*)(p.out + O_SWIN + b * 512 * 512))[r] = ((const f32x4*)(p.cache_win + b * 512 * 512 + 4 * 512))[r];
        }
    }
}

template <class Epi>
DEVI void gemm_phase(const bf16_t* __restrict__ A, const bf16_t* __restrict__ Bt, int M, int N, int K, const Epi& epi, char* smem, int bid, int nblk) {
    bf16_t* As = (bf16_t*)smem;
    bf16_t* Bs = As + 256 * 72;
    const int tid = tid_opq(), lane = tid & 63, wid = tid >> 6, wm = wid >> 1, wn = wid & 1;
    const int fr = lane & 15, fq = lane >> 4;
    const int ntm = M / 256, ntn = N / 128, nk = K / 64;
    for (int tile = bid; tile < ntm * ntn; tile += nblk) {
        const int tm = tile / ntn, tn = tile % ntn;
        f32x4 acc[4][4];
#pragma unroll
        for (int i = 0; i < 4; ++i)
#pragma unroll
            for (int j = 0; j < 4; ++j) acc[i][j] = (f32x4){0.f, 0.f, 0.f, 0.f};
        const bf16_t* Ag = A + (size_t)(tm * 256 + (tid >> 1)) * K + (tid & 1) * 32;
        const bf16_t* Bg = Bt + (size_t)(tn * 128 + (tid >> 2)) * K + (tid & 3) * 16;
        u32x4 ra[4], rb[2];
#pragma unroll
        for (int i = 0; i < 4; ++i) ra[i] = *(const u32x4*)(Ag + i * 8);
#pragma unroll
        for (int i = 0; i < 2; ++i) rb[i] = *(const u32x4*)(Bg + i * 8);
        for (int kt = 0; kt < nk; ++kt) {
            __syncthreads();
#pragma unroll
            for (int i = 0; i < 4; ++i) *(u32x4*)(As + (tid >> 1) * 72 + (tid & 1) * 32 + i * 8) = ra[i];
#pragma unroll
            for (int i = 0; i < 2; ++i) *(u32x4*)(Bs + (tid >> 2) * 72 + (tid & 3) * 16 + i * 8) = rb[i];
            __syncthreads();
            if (kt + 1 < nk) {
#pragma unroll
                for (int i = 0; i < 4; ++i) ra[i] = *(const u32x4*)(Ag + (kt + 1) * 64 + i * 8);
#pragma unroll
                for (int i = 0; i < 2; ++i) rb[i] = *(const u32x4*)(Bg + (kt + 1) * 64 + i * 8);
            }
#pragma unroll
            for (int ks = 0; ks < 2; ++ks) {
                bf16x8 af[4], bfr[4];
#pragma unroll
                for (int i = 0; i < 4; ++i) af[i] = *(const bf16x8*)(As + (wm * 64 + i * 16 + fr) * 72 + ks * 32 + fq * 8);
#pragma unroll
                for (int j = 0; j < 4; ++j) bfr[j] = *(const bf16x8*)(Bs + (wn * 64 + j * 16 + fr) * 72 + ks * 32 + fq * 8);
#pragma unroll
                for (int i = 0; i < 4; ++i)
#pragma unroll
                    for (int j = 0; j < 4; ++j) acc[i][j] = __builtin_amdgcn_mfma_f32_16x16x32_bf16(bfr[j], af[i], acc[i][j], 0, 0, 0);
            }
        }
#pragma unroll
        for (int i = 0; i < 4; ++i)
#pragma unroll
            for (int j = 0; j < 4; ++j) epi(tm * 256 + wm * 64 + i * 16 + fr, tn * 128 + wn * 64 + j * 16 + fq * 4, acc[i][j]);
    }
}

struct NoPre {};
DEVI f32x4 bf4_lo(const u32x4& g) { return (f32x4){__uint_as_float(g[0] << 16), __uint_as_float(g[0] & 0xFFFF0000u), __uint_as_float(g[1] << 16), __uint_as_float(g[1] & 0xFFFF0000u)}; }
DEVI f32x4 bf4_hi(const u32x4& g) { return (f32x4){__uint_as_float(g[2] << 16), __uint_as_float(g[2] & 0xFFFF0000u), __uint_as_float(g[3] << 16), __uint_as_float(g[3] & 0xFFFF0000u)}; }
struct EpiInProj {
    P p;
    typedef NoPre Pre;
    static constexpr int BATCH = 4;
    static constexpr bool COLBIAS = true;
    DEVI void bias8(int col, f32x4& b0, f32x4& b1) const {
        b0 = (f32x4){0.f, 0.f, 0.f, 0.f}; b1 = b0;
        if (col < 5688) { const int oc = win_map(col);
#pragma unroll
            for (int q = 0; q < 4; ++q) { b0[q] = p.b_in[oc + q]; b1[q] = p.b_in[oc + 4 + q]; } }
    }
    DEVI Pre pre(int, int) const { return NoPre(); }
    DEVI void put(int row, int col, f32x4 v0, f32x4 v1, const Pre&) const {
        if (col >= NPAD_IN) {
#pragma unroll
            for (int k = 0; k < 4; ++k) { v0[k] = sigmoidf_(v0[k]); v1[k] = sigmoidf_(v1[k]); }
            *(u32x4*)(p.G + (size_t)row * 2048 + (col - NPAD_IN)) = pack8f(v0, v1);
            return;
        }
        if (col >= 5688) return;
        if (col >= 5632) { *(f32x4*)(p.SM + (size_t)row * 64 + (col - 5632)) = v0; *(f32x4*)(p.SM + (size_t)row * 64 + (col - 5632) + 4) = v1; return; }
        if (col >= C_AK && col < C_AV) { v0 *= 0.08838834764831845f; v1 *= 0.08838834764831845f; }
        *(u32x4*)(p.PROJ + (size_t)row * PS + col) = pack8f(v0, v1);
        if (col >= C_CMP) {
            const int reg = (col - C_CMP) >> 9, c = (col - C_CMP) & 511;
            float* dst = nullptr;
            if (row < NTP) {
                if (reg == 0) dst = p.out + O_PCMP + (size_t)row * 512 + c;
                else if (reg == 1) dst = p.out + O_PSLC + (size_t)row * 512 + c;
                else { const int b = row >> 12, t = row & 4095; if (t >= 3584) dst = p.out + O_PWIN + ((size_t)b * 512 + (t - 3584)) * 512 + c; }
            } else {
                const int rs = row - NTP;
                if (reg == 0) dst = p.out + O_SCMP + (size_t)rs * 512 + c;
                else if (reg == 1) dst = p.out + O_SSLC + (size_t)rs * 512 + c;
                else { const int b = rs >> 2, tq = rs & 3; dst = p.out + O_SWIN + ((size_t)b * 512 + 508 + tq) * 512 + c; }
            }
            if (dst) { *(f32x4*)dst = v0; *(f32x4*)(dst + 4) = v1; }
        }
    }
};
struct EpiG {
    P p;
    typedef NoPre Pre;
    static constexpr int BATCH = 4;
    static constexpr bool COLBIAS = false;
    DEVI Pre pre(int, int) const { return NoPre(); }
    DEVI void put(int row, int col, f32x4 v0, f32x4 v1, const Pre&) const {
#pragma unroll
        for (int k = 0; k < 4; ++k) { v0[k] = sigmoidf_(v0[k]); v1[k] = sigmoidf_(v1[k]); }
        *(u32x4*)(p.G + (size_t)row * 2048 + col) = pack8f(v0, v1);
    }
};
struct EpiM1 {
    P p;
    typedef u32x4 Pre;
    static constexpr int BATCH = 8;
    static constexpr bool COLBIAS = false;
    DEVI Pre pre(int row, int col) const { return *(const u32x4*)(p.G + (size_t)row * 2048 + col); }
    DEVI void put(int row, int col, f32x4 v0, f32x4 v1, const Pre& g) const {
        *(u32x4*)(p.TMPB + (size_t)row * 1024 + col) = pack8f(v0 * bf4_lo(g), v1 * bf4_hi(g));
    }
};
struct PreM2 { u32x4 g; u32x4 t; };
struct EpiM2 {
    P p;
    typedef PreM2 Pre;
    static constexpr int BATCH = 8;
    static constexpr bool COLBIAS = false;
    DEVI Pre pre(int row, int col) const { PreM2 r; r.g = *(const u32x4*)(p.G + (size_t)row * 2048 + 1024 + col); r.t = *(const u32x4*)(p.TMPB + (size_t)row * 1024 + col); return r; }
    DEVI void put(int row, int col, f32x4 v0, f32x4 v1, const Pre& q) const {
        *(u32x4*)(p.MERGED + (size_t)row * 1024 + col) = pack8f(bf4_lo(q.t) + v0 * bf4_lo(q.g), bf4_hi(q.t) + v1 * bf4_hi(q.g));
    }
};
struct PreR { f32x4 a, b; };
struct EpiR {
    P p;
    typedef PreR Pre;
    static constexpr int BATCH = 8;
    static constexpr bool COLBIAS = false;
    DEVI Pre pre(int row, int col) const {
        const float* xr = row < NTP ? p.xp + (size_t)row * 1024 : p.xs + (size_t)(row - NTP) * 1024;
        PreR r; r.a = *(const f32x4*)(xr + col); r.b = *(const f32x4*)(xr + col + 4); return r;
    }
    DEVI void put(int row, int col, f32x4 v0, f32x4 v1, const Pre& x) const {
        *(f32x4*)(p.R + (size_t)row * 1024 + col) = x.a * DN_ALPHA + v0; *(f32x4*)(p.R + (size_t)row * 1024 + col + 4) = x.b * DN_ALPHA + v1;
    }
};
struct EpiPQ {
    P p;
    typedef NoPre Pre;
    static constexpr int BATCH = 4;
    static constexpr bool COLBIAS = false;
    DEVI Pre pre(int, int) const { return NoPre(); }
    DEVI void put(int row, int col, f32x4 v0, f32x4 v1, const Pre&) const { *(u32x4*)(p.PQ + (size_t)row * 2048 + col) = pack8f(v0, v1); }
};

DEVI void stage_mlstm_gates(const P& p, char* smem, int bid, int nblk) {
    const int lane = tid_opq() & 63, wid = tid_opq() >> 6;
    float* bend_s = (float*)smem; float* mloc_s = bend_s + 64;
    for (int bh = bid; bh < 16; bh += nblk) {
        const int b = bh >> 2, h = bh & 3;
        __syncthreads();
        for (int cc = 0; cc < 8; ++cc) {
            const int c = wid * 8 + cc;
            const size_t row = (size_t)b * 4096 + c * 64 + lane;
            const float ip = p.SM[row * 64 + h];
            const float lf = logsigmoidf_(p.SM[row * 64 + 4 + h]);
            float cs = lf;
#pragma unroll
            for (int o = 1; o < 64; o <<= 1) { const float t = __shfl_up(cs, o); if (lane >= o) cs += t; }
            p.BCUM[bh * 4096 + c * 64 + lane] = cs;
            const float bend = __shfl(cs, 63);
            const float mloc = wave_max(bend - cs + ip);
            if (lane == 0) { bend_s[c] = bend; mloc_s[c] = mloc; }
        }
        __syncthreads();
        if (tid_opq() == 0) {
            float m = 0.f;
            for (int c = 0; c < 64; ++c) {
                const float bend = bend_s[c], mloc = mloc_s[c];
                const float mnew = fmaxf(bend + m, mloc);
                p.MPREV[bh * 64 + c] = m;
                p.ACOEF[bh * 64 + c] = __expf(bend + m - mnew);
                p.SCL[bh * 64 + c] = __expf(mloc - mnew);
                p.MLOC[bh * 64 + c] = mloc;
                m = mnew;
            }
            p.out[O_PM + bh] = m;
        }
    }
}

constexpr int MD_KT = 0, MD_VT = 128 * 144, MD_WS = MD_VT + 272 * 144, MD_LDS = MD_WS + 256;
DEVI void stage_mlstm_dc(const P& p, char* smem, int bid, int nblk) {
    const int tid = tid_opq(), lane = tid & 63, wid = tid >> 6, fr = lane & 15, fq = lane >> 4;
    bf16_t* Kt = (bf16_t*)(smem + MD_KT);
    bf16_t* Vt = (bf16_t*)(smem + MD_VT);
    float* ws = (float*)(smem + MD_WS);
    for (int task = bid; task < 1024; task += nblk) {
        const int bh = task >> 6, c = task & 63, b = bh >> 2, h = bh & 3;
        const size_t row0 = (size_t)b * 4096 + c * 64;
        __syncthreads();
        if (tid < 64) {
            const float bend = p.BCUM[bh * 4096 + c * 64 + 63];
            const float g = bend - p.BCUM[bh * 4096 + c * 64 + tid] + p.SM[(row0 + tid) * 64 + h];
            ws[tid] = __expf(g - p.MLOC[task]);
        }
        __syncthreads();
        {
            const int sidx = tid & 63, ch = tid >> 6;
            const float w = ws[sidx];
#pragma unroll
            for (int half = 0; half < 2; ++half) {
                const u32x4 kk = *(const u32x4*)(p.PROJ + (row0 + sidx) * PS + C_AK + h * 128 + half * 64 + ch * 8);
#pragma unroll
                for (int e = 0; e < 4; ++e) {
                    Kt[(half * 64 + ch * 8 + e * 2) * 72 + sidx] = f2bf(w * __uint_as_float(kk[e] << 16));
                    Kt[(half * 64 + ch * 8 + e * 2 + 1) * 72 + sidx] = f2bf(w * __uint_as_float(kk[e] & 0xFFFF0000u));
                }
            }
#pragma unroll
            for (int q4 = 0; q4 < 4; ++q4) {
                const u32x4 vv = *(const u32x4*)(p.PROJ + (row0 + sidx) * PS + C_AV + h * 256 + q4 * 64 + ch * 8);
#pragma unroll
                for (int e = 0; e < 4; ++e) {
                    Vt[(q4 * 64 + ch * 8 + e * 2) * 72 + sidx] = (bf16_t)(vv[e] & 0xFFFFu);
                    Vt[(q4 * 64 + ch * 8 + e * 2 + 1) * 72 + sidx] = (bf16_t)(vv[e] >> 16);
                }
            }
            for (int i = tid; i < 16 * 64; i += 512) Vt[(256 + (i >> 6)) * 72 + (i & 63)] = (i >> 6) == 0 ? (bf16_t)0x3F80 : (bf16_t)0;
        }
        __syncthreads();
        const int nvt = wid == 0 ? 3 : 2;
        for (int vi = 0; vi < nvt; ++vi) {
            const int vt = vi < 2 ? wid * 2 + vi : 16;
            f32x4 acc[8];
#pragma unroll
            for (int dt = 0; dt < 8; ++dt) acc[dt] = (f32x4){0.f, 0.f, 0.f, 0.f};
#pragma unroll
            for (int ks = 0; ks < 2; ++ks) {
                const bf16x8 bf = *(const bf16x8*)(Vt + (vt * 16 + fr) * 72 + ks * 32 + fq * 8);
#pragma unroll
                for (int dt = 0; dt < 8; ++dt) {
                    const bf16x8 af = *(const bf16x8*)(Kt + (dt * 16 + fr) * 72 + ks * 32 + fq * 8);
                    acc[dt] = __builtin_amdgcn_mfma_f32_16x16x32_bf16(af, bf, acc[dt], 0, 0, 0);
                }
            }
            const int v = vt * 16 + fr;
            if (v <= 256) {
#pragma unroll
                for (int dt = 0; dt < 8; ++dt) *(f32x4*)(p.DC + ((size_t)task * 272 + v) * 128 + dt * 16 + fq * 4) = acc[dt];
            }
        }
    }
}

DEVI void stage_mlstm_scan(const P& p, int bid, int nblk) {
    for (int e = bid * blockDim.x + tid_opq(); e < 16 * 257 * 128; e += nblk * blockDim.x) {
        const int bh = e / (257 * 128), r = e % (257 * 128), v = r >> 7, d = r & 127;
        float C = 0.f;
#pragma unroll 8
        for (int c = 0; c < 64; ++c) {
            const size_t idx = ((size_t)(bh * 64 + c) * 272 + v) * 128 + d;
            p.CPT[idx] = f2bf(C);
            C = p.ACOEF[bh * 64 + c] * C + p.SCL[bh * 64 + c] * p.DC[idx];
        }
        if (v < 256) p.out[O_PC + ((size_t)bh * 128 + d) * 256 + v] = C; else p.out[O_PN + bh * 128 + d] = C;
    }
}

constexpr int MO_Q = 0, MO_K = 64 * 272, MO_VT = MO_K + 64 * 272, MO_P = MO_VT + 272 * 144, MO_SC = MO_P + 64 * 144, MO_HS = MO_SC + 2048, MO_LDS = MO_HS + 64 * 256 * 4;
static_assert(MO_LDS <= 152 * 1024, "lds");
DEVI void stage_mlstm_out(const P& p, char* smem, int bid, int nblk) {
    const int tid = tid_opq(), lane = tid & 63, wid = tid >> 6, fr = lane & 15, fq = lane >> 4;
    bf16_t* Qs = (bf16_t*)(smem + MO_Q);
    bf16_t* Ks = (bf16_t*)(smem + MO_K);
    bf16_t* Vt = (bf16_t*)(smem + MO_VT);
    bf16_t* Ps = (bf16_t*)(smem + MO_P);
    float* sc = (float*)(smem + MO_SC);
    float* rowt = sc; float* colt = sc + 64; float* wint = sc + 128; float* emt = sc + 192; float* den = sc + 256;
    float* hs = (float*)(smem + MO_HS);
    for (int task = bid; task < 1024; task += nblk) {
        const int bh = task >> 6, c = task & 63, b = bh >> 2, h = bh & 3;
        const size_t row0 = (size_t)b * 4096 + c * 64;
        __syncthreads();
        {
            for (int i = tid; i < 64 * 16; i += 512) {
                const int t = i >> 4, ch = i & 15;
                *(u32x4*)(Qs + t * 136 + ch * 8) = *(const u32x4*)(p.PROJ + (row0 + t) * PS + C_AQ + h * 128 + ch * 8);
                *(u32x4*)(Ks + t * 136 + ch * 8) = *(const u32x4*)(p.PROJ + (row0 + t) * PS + C_AK + h * 128 + ch * 8);
            }
            const int sidx = tid & 63, ch = tid >> 6;
#pragma unroll
            for (int q4 = 0; q4 < 4; ++q4) {
                const u32x4 vv = *(const u32x4*)(p.PROJ + (row0 + sidx) * PS + C_AV + h * 256 + q4 * 64 + ch * 8);
#pragma unroll
                for (int e = 0; e < 4; ++e) {
                    Vt[(q4 * 64 + ch * 8 + e * 2) * 72 + sidx] = (bf16_t)(vv[e] & 0xFFFFu);
                    Vt[(q4 * 64 + ch * 8 + e * 2 + 1) * 72 + sidx] = (bf16_t)(vv[e] >> 16);
                }
            }
            for (int i = tid; i < 16 * 64; i += 512) Vt[(256 + (i >> 6)) * 72 + (i & 63)] = (i >> 6) == 0 ? (bf16_t)0x3F80 : (bf16_t)0;
            if (wid == 0) {
                const float bc = p.BCUM[bh * 4096 + c * 64 + lane], ip = p.SM[(row0 + lane) * 64 + h];
                const float mprev = p.MPREV[task];
                float pm = ip - bc;
#pragma unroll
                for (int o = 1; o < 64; o <<= 1) { const float t = __shfl_up(pm, o); if (lane >= o) pm = fmaxf(pm, t); }
                const float mt = fmaxf(bc + mprev, bc + pm);
                rowt[lane] = bc - mt; colt[lane] = ip - bc; wint[lane] = __expf(bc + mprev - mt); emt[lane] = __expf(-mt);
            }
        }
        __syncthreads();
        {
            const int tt = wid >> 1;
#pragma unroll
            for (int si = 0; si < 2; ++si) {
                const int st = (wid & 1) * 2 + si;
                f32x4 acc = (f32x4){0.f, 0.f, 0.f, 0.f};
                if (st <= tt) {
#pragma unroll
                    for (int ks = 0; ks < 4; ++ks) {
                        const bf16x8 af = *(const bf16x8*)(Qs + (tt * 16 + fr) * 136 + ks * 32 + fq * 8);
                        const bf16x8 bf = *(const bf16x8*)(Ks + (st * 16 + fr) * 136 + ks * 32 + fq * 8);
                        acc = __builtin_amdgcn_mfma_f32_16x16x32_bf16(af, bf, acc, 0, 0, 0);
                    }
                }
                const int s = st * 16 + fr; const float ct = colt[s];
#pragma unroll
                for (int r = 0; r < 4; ++r) {
                    const int t = tt * 16 + fq * 4 + r;
                    const float pv = (s <= t) ? acc[r] * __expf(rowt[t] + ct) : 0.f;
                    Ps[t * 72 + s] = f2bf(pv);
                }
            }
        }
        __syncthreads();
        {
            const bf16_t* cpt = p.CPT + (size_t)task * 272 * 128;
            f32x4 acc[4][2];
#pragma unroll
            for (int tt = 0; tt < 4; ++tt)
#pragma unroll
                for (int vi = 0; vi < 2; ++vi) acc[tt][vi] = (f32x4){0.f, 0.f, 0.f, 0.f};
            f32x4 accd = (f32x4){0.f, 0.f, 0.f, 0.f};
            bf16x8 cb[4][2], cd[4];
#pragma unroll
            for (int ks = 0; ks < 4; ++ks) {
#pragma unroll
                for (int vi = 0; vi < 2; ++vi) cb[ks][vi] = *(const bf16x8*)(cpt + (size_t)((wid * 2 + vi) * 16 + fr) * 128 + ks * 32 + fq * 8);
                cd[ks] = *(const bf16x8*)(cpt + (size_t)(256 + fr) * 128 + ks * 32 + fq * 8);
            }
#pragma unroll
            for (int ks = 0; ks < 4; ++ks) {
                bf16x8 af[4];
#pragma unroll
                for (int tt = 0; tt < 4; ++tt) af[tt] = *(const bf16x8*)(Qs + (tt * 16 + fr) * 136 + ks * 32 + fq * 8);
#pragma unroll
                for (int vi = 0; vi < 2; ++vi) {
#pragma unroll
                    for (int tt = 0; tt < 4; ++tt) acc[tt][vi] = __builtin_amdgcn_mfma_f32_16x16x32_bf16(af[tt], cb[ks][vi], acc[tt][vi], 0, 0, 0);
                }
                if (wid < 4) {
                    const bf16x8 a2 = *(const bf16x8*)(Qs + (wid * 16 + fr) * 136 + ks * 32 + fq * 8);
                    accd = __builtin_amdgcn_mfma_f32_16x16x32_bf16(a2, cd[ks], accd, 0, 0, 0);
                }
            }
#pragma unroll
            for (int tt = 0; tt < 4; ++tt) {
                const f32x4 wv = *(const f32x4*)(wint + tt * 16 + fq * 4);
#pragma unroll
                for (int vi = 0; vi < 2; ++vi) acc[tt][vi] *= wv;
            }
            if (wid < 4) accd *= *(const f32x4*)(wint + wid * 16 + fq * 4);
#pragma unroll
            for (int ks = 0; ks < 2; ++ks) {
                bf16x8 af[4];
#pragma unroll
                for (int tt = 0; tt < 4; ++tt) af[tt] = *(const bf16x8*)(Ps + (tt * 16 + fr) * 72 + ks * 32 + fq * 8);
#pragma unroll
                for (int vi = 0; vi < 2; ++vi) {
                    const bf16x8 bf = *(const bf16x8*)(Vt + ((wid * 2 + vi) * 16 + fr) * 72 + ks * 32 + fq * 8);
#pragma unroll
                    for (int tt = 0; tt < 4; ++tt) acc[tt][vi] = __builtin_amdgcn_mfma_f32_16x16x32_bf16(af[tt], bf, acc[tt][vi], 0, 0, 0);
                }
                if (wid < 4) {
                    const bf16x8 bf = *(const bf16x8*)(Vt + (256 + fr) * 72 + ks * 32 + fq * 8);
                    const bf16x8 a2 = *(const bf16x8*)(Ps + (wid * 16 + fr) * 72 + ks * 32 + fq * 8);
                    accd = __builtin_amdgcn_mfma_f32_16x16x32_bf16(a2, bf, accd, 0, 0, 0);
                }
            }
            if (wid < 4 && fr == 0) *(f32x4*)(den + wid * 16 + fq * 4) = accd;
            __syncthreads();
#pragma unroll
            for (int tt = 0; tt < 4; ++tt) {
                const f32x4 dv = *(const f32x4*)(den + tt * 16 + fq * 4), ev = *(const f32x4*)(emt + tt * 16 + fq * 4);
#pragma unroll
                for (int vi = 0; vi < 2; ++vi)
#pragma unroll
                    for (int r = 0; r < 4; ++r) hs[(tt * 16 + fq * 4 + r) * 256 + (wid * 2 + vi) * 16 + fr] = acc[tt][vi][r] / fmaxf(fabsf(dv[r]), ev[r]);
            }
        }
        __syncthreads();
        u32x2 ovs[8];
#pragma unroll
        for (int rr = 0; rr < 8; ++rr) ovs[rr] = *(const u32x2*)(p.PROJ + (row0 + wid * 8 + rr) * PS + C_AO + h * 256 + lane * 4);
        const f32x4 gg = *(const f32x4*)(p.norm_a_g + h * 256 + lane * 4);
#pragma unroll
        for (int rr = 0; rr < 8; ++rr) {
            const int t = wid * 8 + rr;
            const f32x4 x = *(const f32x4*)(hs + t * 256 + lane * 4);
            const float mean = wave_sum(x[0] + x[1] + x[2] + x[3]) * (1.f / 256.f);
            float q = 0.f;
#pragma unroll
            for (int k = 0; k < 4; ++k) q += (x[k] - mean) * (x[k] - mean);
            const float rs = rsqrtf(wave_sum(q) * (1.f / 256.f) + LN_EPS);
            const u32x2 ov = ovs[rr];
            const float o4[4] = {__uint_as_float(ov.x << 16), __uint_as_float(ov.x & 0xFFFF0000u), __uint_as_float(ov.y << 16), __uint_as_float(ov.y & 0xFFFF0000u)};
            float y[4];
#pragma unroll
            for (int k = 0; k < 4; ++k) y[k] = (x[k] - mean) * rs * gg[k] * sigmoidf_(o4[k]);
            u32x2 o2; o2.x = pack2(y[0], y[1]); o2.y = pack2(y[2], y[3]);
            *(u32x2*)(p.YA + (row0 + t) * 1024 + h * 256 + lane * 4) = o2;
        }
    }
}

DEVI void stage_mlstm_sample(const P& p, char* smem, int bid, int nblk) {
    float* qs = (float*)smem;
    float* ks = qs + 512;
    float* vs = ks + 512;
    float* part = vs + 1024;
    float* hs = part + 2048;
    float* sc = hs + 1024;
    float* bc = sc; float* ip = sc + 4; float* mt = sc + 8; float* wint = sc + 12; float* emt = sc + 16; float* ww = sc + 20; float* den = sc + 24;
    float* Pm = sc + 32;
    float* misc = sc + 48;
    const int tid = tid_opq(), lane = tid & 63, wid = tid >> 6;
    for (int task = bid; task < 512; task += nblk) {
        const int b = task >> 2, h = task & 3;
        const size_t row0 = (size_t)NTP + b * 4;
        __syncthreads();
        { const int t = tid >> 7, d = tid & 127;
          qs[tid] = bf2f(p.PROJ[(row0 + t) * PS + C_AQ + h * 128 + d]);
          ks[tid] = bf2f(p.PROJ[(row0 + t) * PS + C_AK + h * 128 + d]); }
        for (int idx = tid; idx < 1024; idx += 512) { const int t = idx >> 8, v = idx & 255; vs[idx] = bf2f(p.PROJ[(row0 + t) * PS + C_AV + h * 256 + v]); }
        if (tid == 0) {
            const float m0 = p.state_m[task];
            float cs = 0.f;
            for (int t = 0; t < 4; ++t) { cs += logsigmoidf_(p.SM[(row0 + t) * 64 + 4 + h]); bc[t] = cs; ip[t] = p.SM[(row0 + t) * 64 + h]; }
            for (int t = 0; t < 4; ++t) {
                float mx = bc[t] + m0;
                for (int s = 0; s <= t; ++s) mx = fmaxf(mx, bc[t] - bc[s] + ip[s]);
                mt[t] = mx; wint[t] = __expf(bc[t] + m0 - mx); emt[t] = __expf(-mx);
            }
            const float bend = bc[3];
            float mnew = bend + m0;
            for (int s = 0; s < 4; ++s) mnew = fmaxf(mnew, bend - bc[s] + ip[s]);
            misc[0] = __expf(bend + m0 - mnew);
            for (int s = 0; s < 4; ++s) ww[s] = __expf(bend - bc[s] + ip[s] - mnew);
            p.out[O_SM + task] = mnew;
        }
        __syncthreads();
        if (tid < 16) {
            const int t = tid >> 2, s = tid & 3;
            float a = 0.f;
            if (s <= t) { for (int d = 0; d < 128; ++d) a += qs[t * 128 + d] * ks[s * 128 + d]; a *= __expf(bc[t] - bc[s] + ip[s] - mt[t]); }
            Pm[tid] = a;
        }
        __syncthreads();
        if (tid < 4) {
            const int t = tid; float qn = 0.f;
            for (int d = 0; d < 128; ++d) qn += qs[t * 128 + d] * p.state_n[(size_t)task * 128 + d];
            den[t] = wint[t] * qn + Pm[t * 4] + Pm[t * 4 + 1] + Pm[t * 4 + 2] + Pm[t * 4 + 3];
        }
        const float a = misc[0];
        if (tid >= 128 && tid < 256) {
            const int d = tid - 128;
            float n = a * p.state_n[(size_t)task * 128 + d];
            for (int s = 0; s < 4; ++s) n += ww[s] * ks[s * 128 + d];
            p.out[O_SN + (size_t)task * 128 + d] = n;
        }
        {
            const int v = tid & 255, dh = tid >> 8;
            float acc[4] = {0.f, 0.f, 0.f, 0.f};
            float wv[4];
#pragma unroll
            for (int s = 0; s < 4; ++s) wv[s] = ww[s] * vs[s * 256 + v];
            for (int d0 = dh * 64; d0 < dh * 64 + 64; d0 += 16) {
                float c0[16];
#pragma unroll
                for (int i = 0; i < 16; ++i) c0[i] = __builtin_nontemporal_load(p.state_C + ((size_t)task * 128 + d0 + i) * 256 + v);
#pragma unroll
                for (int i = 0; i < 16; ++i) {
                    const int d = d0 + i;
#pragma unroll
                    for (int t = 0; t < 4; ++t) acc[t] += qs[t * 128 + d] * c0[i];
                    float cn = a * c0[i];
#pragma unroll
                    for (int s = 0; s < 4; ++s) cn += ks[s * 128 + d] * wv[s];
                    __builtin_nontemporal_store(cn, p.out + O_SC + ((size_t)task * 128 + d) * 256 + v);
                }
            }
#pragma unroll
            for (int t = 0; t < 4; ++t) part[(dh * 4 + t) * 256 + v] = acc[t];
        }
        __syncthreads();
        if (tid < 256) {
            const int v = tid;
#pragma unroll
            for (int t = 0; t < 4; ++t) {
                float num = wint[t] * (part[t * 256 + v] + part[(4 + t) * 256 + v]);
#pragma unroll
                for (int s = 0; s < 4; ++s) num += Pm[t * 4 + s] * vs[s * 256 + v];
                hs[t * 256 + v] = num / fmaxf(fabsf(den[t]), emt[t]);
            }
        }
        __syncthreads();
        if (wid < 4) {
            const int t = wid;
            const f32x4 x = *(const f32x4*)(hs + t * 256 + lane * 4);
            const float mean = wave_sum(x[0] + x[1] + x[2] + x[3]) * (1.f / 256.f);
            float q = 0.f;
#pragma unroll
            for (int k = 0; k < 4; ++k) q += (x[k] - mean) * (x[k] - mean);
            const float rs = rsqrtf(wave_sum(q) * (1.f / 256.f) + LN_EPS);
            float y[4];
#pragma unroll
            for (int k = 0; k < 4; ++k) {
                const int vi = lane * 4 + k;
                const float o = bf2f(p.PROJ[(row0 + t) * PS + C_AO + h * 256 + vi]);
                y[k] = (x[k] - mean) * rs * p.norm_a_g[h * 256 + vi] * sigmoidf_(o);
            }
            u32x2 o2; o2.x = pack2(y[0], y[1]); o2.y = pack2(y[2], y[3]);
            *(u32x2*)(p.YA + (row0 + t) * 1024 + h * 256 + lane * 4) = o2;
        }
    }
}

constexpr int CP_ABUF = 33280, CP_WBUF = 18432, CP_A = 0, CP_W = 2 * CP_ABUF, CP_LDS = CP_W + 2 * CP_WBUF;
constexpr int CP_AROW = 1024 + 8;
DEVI void stage_compress(const P& p, char* smem, int bid, int nblk) {
    const int tid = tid_opq(), lane = tid & 63, wid = tid >> 6, fr = lane & 15, fq = lane >> 4;
    const int kv = wid & 1, rt = wid >> 1;
    for (int it = 0; it < 2; ++it) {
        const int task = it == 0 ? bid : 256 + (nblk - 1 - bid);
        if (task >= 272 || (it == 0 && task >= 256)) continue;
        const bool prompt = task >= 256;
        const int rowbytes = prompt ? 1024 : 2048, npieces = prompt ? 2 : 4;
        const char* src[4]; int dsto[4];
#pragma unroll
        for (int q = 0; q < 4; ++q) {
            const int off = q * 8192 + tid * 16, r = off / rowbytes, cb = off % rowbytes;
            if (prompt) { const int blk = (task - 256) * 16 + (r & 15); src[q] = (const char*)(p.PROJ + (size_t)blk * 64 * PS + C_CMP) + cb; dsto[q] = (r & 15) * CP_AROW * 2 + cb; }
            else { const int gb = task * 16 + r, b = gb >> 5, n = gb & 31; const int page = p.page_table[b * 16 + (n >> 1)];
                   src[q] = (const char*)(p.cache_cmp + ((size_t)page * 128 + (n & 1) * 64) * 512) + cb; dsto[q] = r * CP_AROW * 2 + (cb >> 1); }
        }
        const size_t sstride = prompt ? (size_t)PS * 2 : 2048;
        const char* wsrc[2]; int wdst[2];
#pragma unroll
        for (int q = 0; q < 2; ++q) { const int idx = q * 512 + tid, row = idx >> 3, ch = idx & 7; wsrc[q] = (const char*)(p.WCT + (size_t)row * 4096) + ch * 16; wdst[q] = row * 144 + ch * 16; }
        f32x4 acc[4];
#pragma unroll
        for (int nt = 0; nt < 4; ++nt) acc[nt] = (f32x4){0.f, 0.f, 0.f, 0.f};
        f32x4 ra0[4], ra1[4]; u32x4 rw0[2], rw1[2];
        auto issue = [&](int l, f32x4 (&ra)[4], u32x4 (&rw)[2]) {
#pragma unroll
            for (int q = 0; q < 4; ++q) if (q < npieces) ra[q] = *(const f32x4*)(src[q] + (size_t)l * sstride);
#pragma unroll
            for (int q = 0; q < 2; ++q) rw[q] = *(const u32x4*)(wsrc[q] + l * 128);
        };
        auto commit = [&](int buf, const f32x4 (&ra)[4], const u32x4 (&rw)[2]) {
            char* ab = smem + CP_A + buf * CP_ABUF; char* wbuf = smem + CP_W + buf * CP_WBUF;
#pragma unroll
            for (int q = 0; q < 4; ++q) if (q < npieces) {
                if (prompt) *(f32x4*)(ab + dsto[q]) = ra[q];
                else { u32x2 o; o.x = pack2(ra[q][0], ra[q][1]); o.y = pack2(ra[q][2], ra[q][3]); *(u32x2*)(ab + dsto[q]) = o; }
            }
#pragma unroll
            for (int q = 0; q < 2; ++q) *(u32x4*)(wbuf + wdst[q]) = rw[q];
        };
        auto consume = [&](int buf) {
            const char* ab = smem + CP_A + buf * CP_ABUF; const char* wbuf = smem + CP_W + buf * CP_WBUF;
            const bf16_t* arow = (const bf16_t*)ab + (rt * 4 + (fr >> 2)) * CP_AROW + kv * 256 + (fr & 3) * 64 + fq * 8;
#pragma unroll
            for (int hf = 0; hf < 2; ++hf) {
                const bf16x8 a = *(const bf16x8*)(arow + hf * 32);
#pragma unroll
                for (int nt = 0; nt < 4; ++nt) {
                    const bf16x8 bfrag = *(const bf16x8*)(wbuf + (kv * 64 + nt * 16 + fr) * 144 + hf * 64 + fq * 16);
                    acc[nt] = __builtin_amdgcn_mfma_f32_16x16x32_bf16(a, bfrag, acc[nt], 0, 0, 0);
                }
            }
        };
        __syncthreads();
        issue(0, ra0, rw0); issue(1, ra1, rw1); commit(0, ra0, rw0); issue(2, ra0, rw0);
        __syncthreads();
#pragma unroll 1
        for (int l = 0; l < 64; l += 2) {
            consume(0);
            commit(1, ra1, rw1);
            if (l + 3 < 64) issue(l + 3, ra1, rw1);
            __syncthreads();
            consume(1);
            if (l + 2 < 64) commit(0, ra0, rw0);
            if (l + 4 < 64) issue(l + 4, ra0, rw0);
            __syncthreads();
        }
        {
            const int ob = prompt ? (task - 256) * 16 + rt * 4 + fq : 256 + task * 16 + rt * 4 + fq;
#pragma unroll
            for (int nt = 0; nt < 4; ++nt) {
                const float bias = p.PW[kv * 64 + nt * 16 + fr];
#pragma unroll
                for (int r = 0; r < 4; ++r) p.KC[(size_t)ob * 512 + kv * 256 + r * 64 + nt * 16 + fr] = acc[nt][r] + bias;
            }
        }
    }
}

DEVI void stage_cmp_select(const P& p, int bid, int nblk) {
    const int lane = tid_opq() & 63, wid = tid_opq() >> 6;
    for (int wt = bid * 8 + wid; wt < NT * 4; wt += nblk * 8) {
        const int row = wt >> 2, g = wt & 3;
        int pos, nb, nvalid, cur; const float *kcb, *vcb;
        if (row < NTP) { const int b = row >> 12, t = row & 4095; pos = t; nb = 64; nvalid = (t + 1) >> 6; cur = t >> 6; kcb = p.KC + (size_t)(b * 64) * 256; vcb = p.VC + (size_t)(b * 64) * 256; }
        else { const int rs = row - NTP, b = rs >> 2, tq = rs & 3; pos = 2048 + tq; nb = 33; nvalid = 32; cur = 32; kcb = p.KC + (size_t)(256 + b * 32) * 256; vcb = p.VC + (size_t)(256 + b * 32) * 256; }
        const int j = lane;
        float pr[4] = {0.f, 0.f, 0.f, 0.f};
        float imp = 0.f;
        if (nvalid > 0) {
            float dot[4] = {0.f, 0.f, 0.f, 0.f};
            if (j < nvalid) {
                const float* kr = kcb + (size_t)j * 256 + g * 64;
                const bf16_t* qr = p.PROJ + (size_t)row * PS + C_BQ + g * 256;
                for (int d = 0; d < 64; ++d) {
                    const float kk = kr[d];
#pragma unroll
                    for (int r = 0; r < 4; ++r) dot[r] += bf2f(qr[r * 64 + d]) * kk;
                }
            }
#pragma unroll
            for (int r = 0; r < 4; ++r) {
                const float s = j < nvalid ? dot[r] * 0.125f - alibi_slope(g * 4 + r) * (float)(pos - (j * 64 + 63)) : -INFINITY;
                const float mx = wave_max(s);
                const float e = j < nvalid ? __expf(s - mx) : 0.f;
                const float sum = wave_sum(e);
                pr[r] = e / sum;
                imp += pr[r];
            }
            float o[4] = {0.f, 0.f, 0.f, 0.f};
            for (int jj = 0; jj < nvalid; ++jj) {
                const float vv = vcb[(size_t)jj * 256 + g * 64 + lane];
#pragma unroll
                for (int r = 0; r < 4; ++r) o[r] += __shfl(pr[r], jj) * vv;
            }
#pragma unroll
            for (int r = 0; r < 4; ++r) p.OCMP[(size_t)row * 1024 + (g * 4 + r) * 64 + lane] = o[r];
        } else {
#pragma unroll
            for (int r = 0; r < 4; ++r) p.OCMP[(size_t)row * 1024 + (g * 4 + r) * 64 + lane] = 0.f;
        }
        if (j == cur || j == 0) imp = 5.0f;
        if (j > cur) imp = -1.0f;
        if (j >= nb) imp = -2.0f;
        int rank = 0;
        for (int jj = 0; jj < 64; ++jj) { const float v = __shfl(imp, jj); rank += (v > imp || (v == imp && jj < j)) ? 1 : 0; }
        const unsigned long long mask = __ballot(rank < 16 && j < nb);
        if (lane == 0) p.SEL[(size_t)row * 4 + g] = mask;
    }
}

struct KBlock { const void* kb; const void* vb; int stride; int f32; int count; int pos0; };

template <bool WIN>
DEVI void attend_block(const KBlock& B, int qpos, const float* qs, const float (&slope)[4], float (&m)[4], float (&l)[4], float (&o)[4], int lane) {
    const int pos = B.pos0 + lane;
    const bool valid = lane < B.count && pos <= qpos && (!WIN || pos > qpos - 512);
    if (!__any(valid)) return;
    float dot[4] = {0.f, 0.f, 0.f, 0.f};
    if (valid) {
        if (B.f32) {
            const float* kr = (const float*)B.kb + (size_t)lane * B.stride;
#pragma unroll 4
            for (int d4 = 0; d4 < 16; ++d4) {
                const f32x4 kk = *(const f32x4*)(kr + d4 * 4);
#pragma unroll
                for (int e = 0; e < 4; ++e) { const f32x4 qq = *(const f32x4*)(qs + (d4 * 4 + e) * 4);
#pragma unroll
                    for (int r = 0; r < 4; ++r) dot[r] += kk[e] * qq[r]; }
            }
        } else {
            const bf16_t* kr = (const bf16_t*)B.kb + (size_t)lane * B.stride;
#pragma unroll 2
            for (int d8 = 0; d8 < 8; ++d8) {
                const u32x4 kk = *(const u32x4*)(kr + d8 * 8);
                const unsigned w[4] = {kk.x, kk.y, kk.z, kk.w};
#pragma unroll
                for (int e = 0; e < 4; ++e) {
                    const float k0 = __uint_as_float(w[e] << 16), k1 = __uint_as_float(w[e] & 0xFFFF0000u);
                    const f32x4 q0 = *(const f32x4*)(qs + (d8 * 8 + e * 2) * 4), q1 = *(const f32x4*)(qs + (d8 * 8 + e * 2 + 1) * 4);
#pragma unroll
                    for (int r = 0; r < 4; ++r) dot[r] += k0 * q0[r] + k1 * q1[r];
                }
            }
        }
    }
    float pr[4];
#pragma unroll
    for (int r = 0; r < 4; ++r) {
        const float s = valid ? dot[r] * 0.125f - slope[r] * (float)(qpos - pos) : -INFINITY;
        const float mn = fmaxf(m[r], wave_max(s));
        const float sc = __expf(m[r] - mn);
        pr[r] = valid ? __expf(s - mn) : 0.f;
        l[r] = l[r] * sc + wave_sum(pr[r]);
        o[r] *= sc; m[r] = mn;
    }
    for (int kk = 0; kk < B.count; ++kk) {
        const float vv = B.f32 ? ((const float*)B.vb)[(size_t)kk * B.stride + lane] : bf2f(((const bf16_t*)B.vb)[(size_t)kk * B.stride + lane]);
#pragma unroll
        for (int r = 0; r < 4; ++r) o[r] += __shfl(pr[r], kk) * vv;
    }
}

DEVI void stage_slc_win(const P& p, char* smem, int bid, int nblk) {
    const int lane = tid_opq() & 63, wid = tid_opq() >> 6;
    float* qs = (float*)smem + wid * 256;
    for (int wt = bid * 8 + wid; wt < NT * 4; wt += nblk * 8) {
        const int row = wt >> 2, g = wt & 3;
        const bool prompt = row < NTP;
        int b, t, qpos;
        if (prompt) { b = row >> 12; t = row & 4095; qpos = t; } else { const int rs = row - NTP; b = rs >> 2; t = rs & 3; qpos = 2048 + t; }
        {
            const bf16_t* qr = p.PROJ + (size_t)row * PS + C_BQ + g * 256;
            f32x4 qv;
#pragma unroll
            for (int r = 0; r < 4; ++r) qv[r] = bf2f(qr[r * 64 + lane]);
            *(f32x4*)(qs + lane * 4) = qv;
            asm volatile("s_waitcnt lgkmcnt(0)" ::: "memory");
        }
        float slope[4];
#pragma unroll
        for (int r = 0; r < 4; ++r) slope[r] = alibi_slope(g * 4 + r);
        float res[2][4];
        {
            float m[4], l[4], o[4];
#pragma unroll
            for (int r = 0; r < 4; ++r) { m[r] = -INFINITY; l[r] = 0.f; o[r] = 0.f; }
            unsigned long long mask = p.SEL[(size_t)row * 4 + g];
            while (mask) {
                const int j = __builtin_ctzll(mask); mask &= mask - 1;
                KBlock B;
                if (prompt) {
                    const bf16_t* base = p.PROJ + ((size_t)b * 4096 + j * 64) * PS + C_SLC + g * 64;
                    B.kb = base; B.vb = base + 256; B.stride = PS; B.f32 = 0; B.count = 64; B.pos0 = j * 64;
                } else if (j < 32) {
                    const int page = p.page_table[b * 16 + (j >> 1)];
                    const float* base = p.cache_slc + ((size_t)page * 128 + (j & 1) * 64) * 512 + g * 64;
                    B.kb = base; B.vb = base + 256; B.stride = 512; B.f32 = 1; B.count = 64; B.pos0 = j * 64;
                } else {
                    const bf16_t* base = p.PROJ + ((size_t)NTP + b * 4) * PS + C_SLC + g * 64;
                    B.kb = base; B.vb = base + 256; B.stride = PS; B.f32 = 0; B.count = 4; B.pos0 = 2048;
                }
                attend_block<false>(B, qpos, qs, slope, m, l, o, lane);
            }
#pragma unroll
            for (int r = 0; r < 4; ++r) res[0][r] = o[r] / l[r];
        }
        {
            float m[4], l[4], o[4];
#pragma unroll
            for (int r = 0; r < 4; ++r) { m[r] = -INFINITY; l[r] = 0.f; o[r] = 0.f; }
            if (prompt) {
                const int lo = (t - 511 > 0 ? t - 511 : 0) >> 6, hi = t >> 6;
                for (int j = lo; j <= hi; ++j) {
                    KBlock B; const bf16_t* base = p.PROJ + ((size_t)b * 4096 + j * 64) * PS + C_WIN + g * 64;
                    B.kb = base; B.vb = base + 256; B.stride = PS; B.f32 = 0; B.count = 64; B.pos0 = j * 64;
                    attend_block<true>(B, qpos, qs, slope, m, l, o, lane);
                }
            } else {
                for (int j = 0; j < 8; ++j) {
                    KBlock B; const float* base = p.cache_win + ((size_t)b * 512 + j * 64) * 512 + g * 64;
                    B.kb = base; B.vb = base + 256; B.stride = 512; B.f32 = 1; B.count = 64; B.pos0 = 1536 + j * 64;
                    attend_block<true>(B, qpos, qs, slope, m, l, o, lane);
                }
                KBlock B; const bf16_t* base = p.PROJ + ((size_t)NTP + b * 4) * PS + C_WIN + g * 64;
                B.kb = base; B.vb = base + 256; B.stride = PS; B.f32 = 0; B.count = 4; B.pos0 = 2048;
                attend_block<true>(B, qpos, qs, slope, m, l, o, lane);
            }
#pragma unroll
            for (int r = 0; r < 4; ++r) res[1][r] = o[r] / l[r];
        }
        const float* gt = p.SM + (size_t)row * 64 + 8;
#pragma unroll
        for (int r = 0; r < 4; ++r) {
            const float g0 = sigmoidf_(gt[g * 4 + r]), g1 = sigmoidf_(gt[16 + g * 4 + r]), g2 = sigmoidf_(gt[32 + g * 4 + r]);
            const float oc = p.OCMP[(size_t)row * 1024 + (g * 4 + r) * 64 + lane];
            p.YB[(size_t)row * 1024 + (g * 4 + r) * 64 + lane] = f2bf(g0 * oc + g1 * res[0][r] + g2 * res[1][r]);
        }
    }
}

typedef float f32x16 __attribute__((ext_vector_type(16)));
typedef short s16x4 __attribute__((ext_vector_type(4)));
typedef __attribute__((address_space(3))) const char* lds_cptr;
#define MFMA32(a, b, c) __builtin_amdgcn_mfma_f32_32x32x16_bf16(a, b, c, 0, 0, 0)
DEVI int crow(int r, int hi) { return (r & 3) + 8 * (r >> 2) + 4 * hi; }
DEVI unsigned cvtpk(float lo, float hi) { return pack2(lo, hi); }
DEVI s16x4 vtr(lds_cptr p) { return __builtin_bit_cast(s16x4, __builtin_amdgcn_ds_read_tr16_b64_v4i16((__attribute__((address_space(3))) s16x4*)p)); }
DEVI float half_max(float m) { auto rr = __builtin_amdgcn_permlane32_swap(__float_as_uint(m), __float_as_uint(m), false, false); return fmaxf(__uint_as_float(rr[0]), __uint_as_float(rr[1])); }
DEVI float half_sum(float m) { auto rr = __builtin_amdgcn_permlane32_swap(__float_as_uint(m), __float_as_uint(m), false, false); return __uint_as_float(rr[0]) + __uint_as_float(rr[1]); }

struct BlkDesc { const char* k; int stride_bytes; int f32; int count; int pos0; };
DEVI void blk_load(const BlkDesc& d, int tid, u32x4& rk, u32x4& rv) {
    const int key = tid & 63, chunk = tid >> 6;
    rk = (u32x4){0u, 0u, 0u, 0u}; rv = rk;
    if (key < d.count) {
        const char* kr = d.k + (size_t)key * d.stride_bytes;
        if (d.f32) {
            const f32x4* s1 = (const f32x4*)(kr + chunk * 32); const f32x4* s2 = (const f32x4*)(kr + 1024 + chunk * 32);
            rk = pack8f(s1[0], s1[1]); rv = pack8f(s2[0], s2[1]);
        } else { rk = *(const u32x4*)(kr + chunk * 16); rv = *(const u32x4*)(kr + 512 + chunk * 16); }
    }
}
DEVI void blk_store(char* kimg, char* vimg, int tid, const u32x4& rk, const u32x4& rv) {
    const int key = tid & 63, chunk = tid >> 6;
    *(u32x4*)(kimg + chunk * 1024 + key * 16) = rk;
    *(u32x4*)(vimg + (chunk >> 2) * 4096 + key * 64 + (chunk & 3) * 16) = rv;
}

DEVI void attn_tile(const char* kimg, const char* vimg, const bf16x8 (&qr)[4], float& m2, float& lsum, f32x16& o0, f32x16& o1, f32x16& s0, f32x16& s1,
                    float sl, float bb, int lh, int ll, bool fast, float* wsf_hi  , float* wsf_r  , int lane) {
    const int r32 = lane & 31, hi = lane >> 5;
    const f32x16 z = {};
    s0 = z; s1 = z;
    {
        const char* kp = kimg + hi * 1024 + r32 * 16;
#pragma unroll
        for (int d0 = 0; d0 < 4; ++d0) {
            const bf16x8 k0 = *(const bf16x8*)(kp + d0 * 2048), k1 = *(const bf16x8*)(kp + d0 * 2048 + 512);
            s0 = MFMA32(k0, qr[d0], s0); s1 = MFMA32(k1, qr[d0], s1);
        }
    }
    float mx = -1e30f;
    if (fast) {
#pragma unroll
        for (int r = 0; r < 16; ++r) {
            const int c = (r & 3) + 8 * (r >> 2);
            s0[r] = fmaf(s0[r], 1.4426950408889634f, fmaf(sl, (float)c, bb)); s1[r] = fmaf(s1[r], 1.4426950408889634f, fmaf(sl, (float)(c + 32), bb));
            mx = fmaxf(mx, fmaxf(s0[r], s1[r]));
        }
    } else {
#pragma unroll
        for (int r = 0; r < 16; ++r) {
            const int c = (r & 3) + 8 * (r >> 2);
            const float t0 = fmaf(s0[r], 1.4426950408889634f, fmaf(sl, (float)c, bb)), t1 = fmaf(s1[r], 1.4426950408889634f, fmaf(sl, (float)(c + 32), bb));
            s0[r] = (c <= lh && c > ll) ? t0 : -INFINITY; s1[r] = (c + 32 <= lh && c + 32 > ll) ? t1 : -INFINITY;
            mx = fmaxf(mx, fmaxf(s0[r], s1[r]));
        }
    }
    mx = half_max(mx);
    const float mnew = fmaxf(m2, mx);
    const float f = __builtin_amdgcn_exp2f(m2 - mnew);
    m2 = mnew;
    float ps = 0.f;
#pragma unroll
    for (int r = 0; r < 16; ++r) { s0[r] = __builtin_amdgcn_exp2f(s0[r] - mnew); s1[r] = __builtin_amdgcn_exp2f(s1[r] - mnew); ps += s0[r] + s1[r]; }
    lsum = lsum * f + ps;
    if (__any(f != 1.f)) {
        if (hi == 0) *wsf_r = f;
        asm volatile("s_waitcnt lgkmcnt(0)" ::: "memory");
#pragma unroll
        for (int a = 0; a < 4; ++a) {
            const f32x4 fv = *(const f32x4*)(wsf_hi + 8 * a);
#pragma unroll
            for (int k = 0; k < 4; ++k) { o0[4 * a + k] *= fv[k]; o1[4 * a + k] *= fv[k]; }
        }
        asm volatile("s_waitcnt lgkmcnt(0)" ::: "memory");
    }
    u32x4 pw[4];
#pragma unroll
    for (int k = 0; k < 4; ++k) { pw[0][k] = cvtpk(s0[2 * k], s0[2 * k + 1]); pw[1][k] = cvtpk(s0[8 + 2 * k], s0[8 + 2 * k + 1]); pw[2][k] = cvtpk(s1[2 * k], s1[2 * k + 1]); pw[3][k] = cvtpk(s1[8 + 2 * k], s1[8 + 2 * k + 1]); }
    const lds_cptr vp = (lds_cptr)vimg + ((lane >> 4) & 1) * 32 + (lane & 3) * 8 + (4 * hi + ((lane & 15) >> 2)) * 64;
#pragma unroll
    for (int i = 0; i < 8; ++i) {
        const s16x4 lo = vtr(vp + ((i >> 2) * 4096 + (i & 3) * 1024)), hh = vtr(vp + ((i >> 2) * 4096 + (i & 3) * 1024 + 512));
        const bf16x8 vf = (bf16x8){lo[0], lo[1], lo[2], lo[3], hh[0], hh[1], hh[2], hh[3]};
        const bf16x8 pf = __builtin_bit_cast(bf16x8, pw[i & 3]);
        if (i < 4) o0 = MFMA32(pf, vf, o0); else o1 = MFMA32(pf, vf, o1);
    }
}

constexpr int NSA_KV0 = 0, NSA_KV1 = 16384, NSA_WSF = 32768, NSA_IMP = NSA_WSF + 2048, NSA_SEL = NSA_IMP + 16384, NSA_LIST = NSA_SEL + 512, NSA_OST = NSA_LIST + 256, NSA_YAC = NSA_OST + 32768, NSA_LDS = NSA_YAC + 65536;
static_assert(NSA_LDS <= 152 * 1024, "lds");

DEVI BlkDesc nsa_desc(const P& p, bool prompt, int b, int g, int branch, int j) {
    BlkDesc d;
    if (prompt) {
        if (branch == 0) { d.k = (const char*)(p.KC + ((size_t)(b * 64) * 512 + g * 64)); d.stride_bytes = 2048; d.f32 = 1; d.count = 64; d.pos0 = 0; }
        else { d.k = (const char*)(p.PROJ + ((size_t)b * 4096 + j * 64) * PS + (branch == 1 ? C_SLC : C_WIN) + g * 64); d.stride_bytes = PS * 2; d.f32 = 0; d.count = 64; d.pos0 = j * 64; }
    } else {
        if (branch == 0) { d.k = (const char*)(p.KC + ((size_t)(256 + b * 32) * 512 + g * 64)); d.stride_bytes = 2048; d.f32 = 1; d.count = 32; d.pos0 = 0; }
        else if (branch == 1 && j < 32) { const int page = p.page_table[b * 16 + (j >> 1)]; d.k = (const char*)(p.cache_slc + ((size_t)page * 128 + (j & 1) * 64) * 512 + g * 64); d.stride_bytes = 2048; d.f32 = 1; d.count = 64; d.pos0 = j * 64; }
        else if (branch == 2 && j < 8) { d.k = (const char*)(p.cache_win + ((size_t)b * 512 + j * 64) * 512 + g * 64); d.stride_bytes = 2048; d.f32 = 1; d.count = 64; d.pos0 = 1536 + j * 64; }
        else { d.k = (const char*)(p.PROJ + ((size_t)NTP + b * 4) * PS + (branch == 1 ? C_SLC : C_WIN) + g * 64); d.stride_bytes = PS * 2; d.f32 = 0; d.count = 4; d.pos0 = 2048; }
    }
    return d;
}

constexpr int NS_IMG = 0, NS_WSF = 131072, NS_IMP = NS_WSF + 2048, NS_SEL = NS_IMP + 2048, NS_LIST = NS_SEL + 64, NS_YC = NS_LIST + 64, NS_PM = NS_YC + 4096, NS_Q = NS_PM + 2048, NS_LDS = NS_Q + 4096;
static_assert(NS_LDS <= 152 * 1024, "lds");
DEVI void wave_stage_block(const BlkDesc& d, char* kimg, char* vimg, int lane) {
    asm volatile("" : "+v"(lane));
    const int rsub = lane >> 4, pc = lane & 15;
    if (d.f32) {
#pragma unroll
        for (int half = 0; half < 2; ++half) {
#pragma unroll
            for (int i0 = 0; i0 < 16; i0 += 6) {
                f32x4 x[6];
#pragma unroll
                for (int i = 0; i < 6; ++i) if (i0 + i < 16) { const int row = 4 * (i0 + i) + rsub; x[i] = row < d.count ? __builtin_nontemporal_load((const f32x4*)(d.k + (size_t)row * d.stride_bytes + half * 1024 + pc * 16)) : (f32x4){0.f, 0.f, 0.f, 0.f}; }
#pragma unroll
                for (int i = 0; i < 6; ++i) if (i0 + i < 16) {
                    const int row = 4 * (i0 + i) + rsub, c = pc >> 1;
                    u32x2 o; o.x = pack2(x[i][0], x[i][1]); o.y = pack2(x[i][2], x[i][3]);
                    if (half == 0) *(u32x2*)(kimg + c * 1024 + row * 16 + (pc & 1) * 8) = o;
                    else *(u32x2*)(vimg + (c >> 2) * 4096 + row * 64 + (c & 3) * 16 + (pc & 1) * 8) = o;
                }
            }
        }
    } else {
        const int row = lane >> 3, c = lane & 7;
#pragma unroll
        for (int i = 0; i < 8; ++i) {
            const int rr = 8 * i + row;
            u32x4 kk = {0u, 0u, 0u, 0u}, vv = {0u, 0u, 0u, 0u};
            if (rr < d.count) { kk = *(const u32x4*)(d.k + (size_t)rr * d.stride_bytes + c * 16); vv = *(const u32x4*)(d.k + (size_t)rr * d.stride_bytes + 512 + c * 16); }
            *(u32x4*)(kimg + c * 1024 + rr * 16) = kk;
            *(u32x4*)(vimg + (c >> 2) * 4096 + rr * 64 + (c & 3) * 16) = vv;
        }
    }
    asm volatile("s_waitcnt lgkmcnt(0)" ::: "memory");
}

DEVI void nsa_sample_unit(const P& p, char* smem, int us) {
    const int tid = tid_opq(), lane = tid & 63, wid = tid >> 6, r32 = lane & 31, hi = lane >> 5;
    const int b = us >> 2, g = us & 3;
    const size_t rowbase = (size_t)NTP + b * 4;
    char* kimg = smem + NS_IMG + wid * 16384; char* vimg = kimg + 8192;
    float* wsf = (float*)(smem + NS_WSF) + wid * 64;
    float* impb = (float*)(smem + NS_IMP);
    unsigned long long* selm = (unsigned long long*)(smem + NS_SEL);
    unsigned char* blist = (unsigned char*)(smem + NS_LIST);
    float* ycmp = (float*)(smem + NS_YC);
    const int tokl = r32 >> 2, head = r32 & 3;
    const bool tok_ok = r32 < 16;
    const int qpos = 2048 + tokl;
    const float slope2 = alibi_slope(g * 4 + head) * 1.4426950408889634f;
    char* qsh = smem + NS_Q;
    int hi4 = 4 * hi; asm volatile("" : "+v"(hi4));
    float* wsf_hi = wsf + hi4; float* wsf_r = wsf + r32;
    f32x16 s0, s1;
    __syncthreads();
    if (wid == 0) {
        bf16x8 qr[4];
        {
            const bf16_t* qp = p.PROJ + (rowbase + (tok_ok ? tokl : 0)) * PS + C_BQ + (g * 4 + head) * 64 + hi * 8;
#pragma unroll
            for (int d0 = 0; d0 < 4; ++d0) {
                u32x4 v = *(const u32x4*)(qp + d0 * 16);
#pragma unroll
                for (int k = 0; k < 4; ++k) { const float lo = __uint_as_float(v[k] << 16) * 0.125f, hh = __uint_as_float(v[k] & 0xFFFF0000u) * 0.125f; v[k] = tok_ok ? ((__float_as_uint(lo) >> 16) | (__float_as_uint(hh) & 0xFFFF0000u)) : 0u; }
                qr[d0] = __builtin_bit_cast(bf16x8, v);
                *(u32x4*)(qsh + d0 * 1024 + lane * 16) = v;
            }
        }
        f32x16 o0 = {}, o1 = {}; float m2 = -1e30f, lsum = 0.f;
        const BlkDesc d = nsa_desc(p, false, b, g, 0, 0);
        wave_stage_block(d, kimg, vimg, lane);
        const int lh = 31 - hi4;
        const float sl = 64.f * slope2;
        attn_tile(kimg, vimg, qr, m2, lsum, o0, o1, s0, s1, sl, tok_ok ? sl * (float)(hi4 - 32) : -INFINITY, lh, -1000, false, wsf_hi, wsf_r, lane);
        const float lt = half_sum(lsum);
        const float inv = lt > 0.f ? 1.f / lt : 0.f;
        float* ib = impb + (r32 >> 2) * 64 + hi4;
#pragma unroll
        for (int r = 0; r < 16; ++r) {
            float a = s0[r] * inv, c = s1[r] * inv;
            a += __shfl_xor(a, 1); a += __shfl_xor(a, 2); c += __shfl_xor(c, 1); c += __shfl_xor(c, 2);
            if (head == 0) { ib[(r & 3) + 8 * (r >> 2)] = a; ib[(r & 3) + 8 * (r >> 2) + 32] = c; }
        }
        float fac = 0.f;
        if (tok_ok && lt > 0.f) fac = sigmoidf_(p.SM[(rowbase + tokl) * 64 + 8 + g * 4 + head]) / lt;
        if (hi == 0) *wsf_r = fac;
        asm volatile("s_waitcnt lgkmcnt(0)" ::: "memory");
#pragma unroll
        for (int a = 0; a < 2; ++a) {
            const f32x4 fv = *(const f32x4*)(wsf_hi + 8 * a);
#pragma unroll
            for (int k = 0; k < 4; ++k) { float* yp = ycmp + (8 * a + k + hi4) * 64 + r32; yp[0] = o0[4 * a + k] * fv[k]; yp[32] = o1[4 * a + k] * fv[k]; }
        }
        asm volatile("s_waitcnt lgkmcnt(0)" ::: "memory");
#pragma unroll 1
        for (int tl = 0; tl < 4; ++tl) {
            const int j = lane;
            float v = impb[tl * 64 + j];
            if (j == 32 || j == 0) v = 5.0f;
            if (j > 32) v = -2.0f;
            impb[tl * 64 + j] = v;
            asm volatile("s_waitcnt lgkmcnt(0)" ::: "memory");
            int rank = 0;
#pragma unroll 8
            for (int jj = 0; jj < 64; ++jj) { const float u = impb[tl * 64 + jj]; rank += (u > v || (u == v && jj < j)) ? 1 : 0; }
            const unsigned long long mask = __ballot(rank < 16 && j < 33);
            if (lane == 0) selm[tl] = mask;
        }
        asm volatile("s_waitcnt lgkmcnt(0)" ::: "memory");
        if (lane == 0) {
            unsigned long long u = selm[0] | selm[1] | selm[2] | selm[3];
            int n = 0;
            while (u) { const int j = __builtin_ctzll(u); u &= u - 1; blist[1 + n++] = (unsigned char)(0x40 | j); }
            for (int j = 0; j <= 8; ++j) blist[1 + n++] = (unsigned char)(0x80 | j);
            blist[0] = (unsigned char)n;
        }
    }
    __syncthreads();
    const int nb = blist[0];
    const unsigned long long mysel = tok_ok ? selm[tokl] : 0ull;
    int nslc = 0;
    for (int i = 0; i < nb; ++i) nslc += (blist[1 + i] >> 6) == 1 ? 1 : 0;
    float so[16], ms, lst;
    float wo[16], mw, lwt;
#pragma unroll 1
    for (int pass = 0; pass < 2; ++pass) {
        f32x16 o0 = {}, o1 = {}; float m2 = -1e30f, lsum = 0.f;
        const int i0 = pass == 0 ? 0 : nslc, i1 = pass == 0 ? nslc : nb;
#pragma unroll 1
        for (int i = i0 + wid; i < i1; i += 8) {
            const int e = blist[1 + i], br = e >> 6, j = e & 63;
            const BlkDesc d = nsa_desc(p, false, b, g, br, j);
            wave_stage_block(d, kimg, vimg, lane);
            asm volatile("" : "+v"(hi4));
            const bool lsel = tok_ok && (br == 2 || ((mysel >> j) & 1ull));
            const int rel = qpos - d.pos0;
            const int lh = (rel < d.count - 1 ? rel : d.count - 1) - hi4;
            const int ll = (br == 2 ? rel - 512 : -1000) - hi4;
            const bool fast = __all(!lsel || (lh >= 59 && ll < 0));
            const float bb = lsel ? slope2 * (float)(hi4 + d.pos0 - 2048) : -INFINITY;
            bf16x8 qr[4];
#pragma unroll
            for (int d0 = 0; d0 < 4; ++d0) qr[d0] = *(const bf16x8*)(qsh + d0 * 1024 + lane * 16);
            attn_tile(kimg, vimg, qr, m2, lsum, o0, o1, s0, s1, slope2, bb, lh, ll, fast, wsf_hi, wsf_r, lane);
        }
        const float lt = half_sum(lsum);
        if (pass == 0) { ms = m2; lst = lt;
#pragma unroll
            for (int r = 0; r < 8; ++r) { so[r] = o0[r]; so[8 + r] = o1[r]; } }
        else { mw = m2; lwt = lt;
#pragma unroll
            for (int r = 0; r < 8; ++r) { wo[r] = o0[r]; wo[8 + r] = o1[r]; } }
    }
    {
        float* po = (float*)kimg;
        float* pm = (float*)(smem + NS_PM) + wid * 64;
        if (lane < 16) { pm[lane * 2] = ms; pm[lane * 2 + 1] = lst; pm[32 + lane * 2] = mw; pm[32 + lane * 2 + 1] = lwt; }
#pragma unroll
        for (int a = 0; a < 2; ++a)
#pragma unroll
            for (int k = 0; k < 4; ++k) {
                float* yp = po + (8 * a + k + hi4) * 64 + r32;
                yp[0] = so[4 * a + k]; yp[32] = so[8 + 4 * a + k]; yp[1024] = wo[4 * a + k]; yp[1024 + 32] = wo[8 + 4 * a + k];
            }
    }
    __syncthreads();
    {
        const int row = tid >> 5, dcol = tid & 31, tk = row >> 2, hd = row & 3;
        float res[2][2];
#pragma unroll
        for (int br = 0; br < 2; ++br) {
            float M = -1e30f;
#pragma unroll
            for (int w = 0; w < 8; ++w) M = fmaxf(M, ((const float*)(smem + NS_PM))[w * 64 + br * 32 + row * 2]);
            float L = 0.f, a0 = 0.f, a1 = 0.f;
#pragma unroll
            for (int w = 0; w < 8; ++w) {
                const float* pmw = (const float*)(smem + NS_PM) + w * 64 + br * 32 + row * 2;
                const float f = __builtin_amdgcn_exp2f(pmw[0] - M);
                const float* pow_ = (const float*)(smem + NS_IMG + w * 16384) + br * 1024 + row * 64 + dcol;
                L += pmw[1] * f; a0 += pow_[0] * f; a1 += pow_[32] * f;
            }
            const float gate = sigmoidf_(p.SM[(rowbase + tk) * 64 + 8 + (br + 1) * 16 + g * 4 + hd]);
            const float sc = L > 0.f ? gate / L : 0.f;
            res[br][0] = a0 * sc; res[br][1] = a1 * sc;
        }
        const float y0 = ycmp[row * 64 + dcol] + res[0][0] + res[1][0], y1 = ycmp[row * 64 + dcol + 32] + res[0][1] + res[1][1];
        bf16_t* yb = p.YB + (rowbase + tk) * 1024 + (g * 4 + hd) * 64;
        yb[dcol] = f2bf(y0); yb[dcol + 32] = f2bf(y1);
    }
}

constexpr int NP_KVB = 18432, NP_KV0 = 0, NP_KV1 = NP_KVB, NP_WSF = 2 * NP_KVB, NP_IMP = NP_WSF + 2048, NP_SEL = NP_IMP + 16384, NP_LIST = NP_SEL + 512, NP_YAC = NP_LIST + 256, NP_LDS = NP_YAC + 65536;
static_assert(NP_LDS <= 152 * 1024, "lds");
DEVI void blk_store_ext(const BlkDesc& d, int pstep, int poff, int t0, char* kimg, char* vimg, int tid, const u32x4& rk, const u32x4& rv) {
    const int key = tid & 63, chunk = tid >> 6;
    *(u32x4*)(kimg + chunk * 1024 + key * 16) = rk;
    *(u32x4*)(vimg + (chunk >> 2) * 4096 + key * 64 + (chunk & 3) * 16) = rv;
    if (chunk == 0) {
        const int rel = d.pos0 + key * pstep + poff - t0;
        const int phi = (rel >> 6) << 6, plo = rel & 63;
        const unsigned bh = pack2((float)phi, (float)phi), bl = pack2((float)plo, (float)plo);
        *(u32x4*)(kimg + 8 * 1024 + key * 16) = (u32x4){bh, bl, 0x00003F80u, 0u};
    }
}
DEVI void attn_tile2(const char* kimg, const char* vimg, const bf16x8 (&qr)[4], const bf16x8 qext, float& m, float& lsum, f32x16& o0, f32x16& o1, f32x16& s0, f32x16& s1,
                     int lh, int ll, bool fast, float* wsf_hi, float* wsf_r, int lane) {
    const int r32 = lane & 31, hi = lane >> 5;
    const f32x16 z = {};
    s0 = z; s1 = z;
    {
        const char* kp = kimg + hi * 1024 + r32 * 16;
#pragma unroll
        for (int d0 = 0; d0 < 5; ++d0) {
            const bf16x8 k0 = *(const bf16x8*)(kp + d0 * 2048), k1 = *(const bf16x8*)(kp + d0 * 2048 + 512);
            const bf16x8 qf = d0 < 4 ? qr[d0 < 4 ? d0 : 0] : qext;
            s0 = MFMA32(k0, qf, s0); s1 = MFMA32(k1, qf, s1);
        }
    }
    if (!fast) {
#pragma unroll
        for (int r = 0; r < 16; ++r) {
            const int c = (r & 3) + 8 * (r >> 2);
            s0[r] = (c <= lh && c > ll) ? s0[r] : -INFINITY; s1[r] = (c + 32 <= lh && c + 32 > ll) ? s1[r] : -INFINITY;
        }
    }
    float mx = fmaxf(s0[0], s1[0]);
#pragma unroll
    for (int r = 1; r < 16; ++r) mx = fmaxf(mx, fmaxf(s0[r], s1[r]));
    mx = half_max(mx);
    const float mnew = fmaxf(m, mx);
    const float f = __builtin_amdgcn_exp2f((m - mnew) * 1.4426950408889634f);
    m = mnew;
    const float nm2 = -mnew * 1.4426950408889634f;
    float ps = 0.f;
#pragma unroll
    for (int r = 0; r < 16; ++r) { s0[r] = __builtin_amdgcn_exp2f(fmaf(s0[r], 1.4426950408889634f, nm2)); s1[r] = __builtin_amdgcn_exp2f(fmaf(s1[r], 1.4426950408889634f, nm2)); ps += s0[r] + s1[r]; }
    lsum = lsum * f + ps;
    if (__any(f != 1.f)) {
        if (hi == 0) *wsf_r = f;
        asm volatile("s_waitcnt lgkmcnt(0)" ::: "memory");
#pragma unroll
        for (int a = 0; a < 4; ++a) {
            const f32x4 fv = *(const f32x4*)(wsf_hi + 8 * a);
#pragma unroll
            for (int k = 0; k < 4; ++k) { o0[4 * a + k] *= fv[k]; o1[4 * a + k] *= fv[k]; }
        }
        asm volatile("s_waitcnt lgkmcnt(0)" ::: "memory");
    }
    u32x4 pw[4];
#pragma unroll
    for (int k = 0; k < 4; ++k) { pw[0][k] = cvtpk(s0[2 * k], s0[2 * k + 1]); pw[1][k] = cvtpk(s0[8 + 2 * k], s0[8 + 2 * k + 1]); pw[2][k] = cvtpk(s1[2 * k], s1[2 * k + 1]); pw[3][k] = cvtpk(s1[8 + 2 * k], s1[8 + 2 * k + 1]); }
    const lds_cptr vp = (lds_cptr)vimg + ((lane >> 4) & 1) * 32 + (lane & 3) * 8 + (4 * hi + ((lane & 15) >> 2)) * 64;
#pragma unroll
    for (int i = 0; i < 8; ++i) {
        const s16x4 lo = vtr(vp + ((i >> 2) * 4096 + (i & 3) * 1024)), hh = vtr(vp + ((i >> 2) * 4096 + (i & 3) * 1024 + 512));
        const bf16x8 vf = (bf16x8){lo[0], lo[1], lo[2], lo[3], hh[0], hh[1], hh[2], hh[3]};
        const bf16x8 pf = __builtin_bit_cast(bf16x8, pw[i & 3]);
        if (i < 4) o0 = MFMA32(pf, vf, o0); else o1 = MFMA32(pf, vf, o1);
    }
}

DEVI void attn_tile3(const char* kA, const char* vA, const char* kB, const char* vB, const bf16x8 (&qr)[4], const bf16x8 qeA, const bf16x8 qeB, float& m, float& lsum,
                     f32x16& o0, f32x16& o1, int lhA, int llA, bool fastA, int lhB, int llB, bool fastB, float* wsf_hi, float* wsf_r, int lane) {
    const int r32 = lane & 31, hi = lane >> 5;
    f32x16 a0 = {}, a1 = {}, b0 = {}, b1 = {};
    {
        const char* kpa = kA + hi * 1024 + r32 * 16; const char* kpb = kB + hi * 1024 + r32 * 16;
#pragma unroll
        for (int d0 = 0; d0 < 5; ++d0) {
            const bf16x8 ka0 = *(const bf16x8*)(kpa + d0 * 2048), ka1 = *(const bf16x8*)(kpa + d0 * 2048 + 512);
            const bf16x8 kb0 = *(const bf16x8*)(kpb + d0 * 2048), kb1 = *(const bf16x8*)(kpb + d0 * 2048 + 512);
            const bf16x8 qa = d0 < 4 ? qr[d0 < 4 ? d0 : 0] : qeA, qb = d0 < 4 ? qr[d0 < 4 ? d0 : 0] : qeB;
            a0 = MFMA32(ka0, qa, a0); a1 = MFMA32(ka1, qa, a1); b0 = MFMA32(kb0, qb, b0); b1 = MFMA32(kb1, qb, b1);
        }
    }
    if (!fastA) {
#pragma unroll
        for (int r = 0; r < 16; ++r) { const int c = (r & 3) + 8 * (r >> 2); a0[r] = (c <= lhA && c > llA) ? a0[r] : -INFINITY; a1[r] = (c + 32 <= lhA && c + 32 > llA) ? a1[r] : -INFINITY; }
    }
    if (!fastB) {
#pragma unroll
        for (int r = 0; r < 16; ++r) { const int c = (r & 3) + 8 * (r >> 2); b0[r] = (c <= lhB && c > llB) ? b0[r] : -INFINITY; b1[r] = (c + 32 <= lhB && c + 32 > llB) ? b1[r] : -INFINITY; }
    }
    float mx = fmaxf(fmaxf(a0[0], a1[0]), fmaxf(b0[0], b1[0]));
#pragma unroll
    for (int r = 1; r < 16; ++r) mx = fmaxf(mx, fmaxf(fmaxf(a0[r], a1[r]), fmaxf(b0[r], b1[r])));
    mx = half_max(mx);
    const float mnew = fmaxf(m, mx);
    const float f = __builtin_amdgcn_exp2f((m - mnew) * 1.4426950408889634f);
    m = mnew;
    const float nm2 = -mnew * 1.4426950408889634f;
    float ps = 0.f;
#pragma unroll
    for (int r = 0; r < 16; ++r) {
        a0[r] = __builtin_amdgcn_exp2f(fmaf(a0[r], 1.4426950408889634f, nm2)); a1[r] = __builtin_amdgcn_exp2f(fmaf(a1[r], 1.4426950408889634f, nm2));
        b0[r] = __builtin_amdgcn_exp2f(fmaf(b0[r], 1.4426950408889634f, nm2)); b1[r] = __builtin_amdgcn_exp2f(fmaf(b1[r], 1.4426950408889634f, nm2));
        ps += (a0[r] + a1[r]) + (b0[r] + b1[r]);
    }
    lsum = lsum * f + ps;
    if (__any(f != 1.f)) {
        if (hi == 0) *wsf_r = f;
        asm volatile("s_waitcnt lgkmcnt(0)" ::: "memory");
#pragma unroll
        for (int a = 0; a < 4; ++a) {
            const f32x4 fv = *(const f32x4*)(wsf_hi + 8 * a);
#pragma unroll
            for (int k = 0; k < 4; ++k) { o0[4 * a + k] *= fv[k]; o1[4 * a + k] *= fv[k]; }
        }
        asm volatile("s_waitcnt lgkmcnt(0)" ::: "memory");
    }
    const int voff = ((lane >> 4) & 1) * 32 + (lane & 3) * 8 + (4 * hi + ((lane & 15) >> 2)) * 64;
#pragma unroll
    for (int t = 0; t < 2; ++t) {
        const f32x16& p0 = t == 0 ? a0 : b0; const f32x16& p1 = t == 0 ? a1 : b1;
        u32x4 pw[4];
#pragma unroll
        for (int k = 0; k < 4; ++k) { pw[0][k] = cvtpk(p0[2 * k], p0[2 * k + 1]); pw[1][k] = cvtpk(p0[8 + 2 * k], p0[8 + 2 * k + 1]); pw[2][k] = cvtpk(p1[2 * k], p1[2 * k + 1]); pw[3][k] = cvtpk(p1[8 + 2 * k], p1[8 + 2 * k + 1]); }
        const lds_cptr vp = (lds_cptr)(t == 0 ? vA : vB) + voff;
#pragma unroll
        for (int i = 0; i < 8; ++i) {
            const s16x4 lo = vtr(vp + ((i >> 2) * 4096 + (i & 3) * 1024)), hh = vtr(vp + ((i >> 2) * 4096 + (i & 3) * 1024 + 512));
            const bf16x8 vf = (bf16x8){lo[0], lo[1], lo[2], lo[3], hh[0], hh[1], hh[2], hh[3]};
            const bf16x8 pf = __builtin_bit_cast(bf16x8, pw[i & 3]);
            if (i < 4) o0 = MFMA32(pf, vf, o0); else o1 = MFMA32(pf, vf, o1);
        }
    }
}

constexpr int NQ_KVB = 18432, NQ_WSF = 4 * NQ_KVB, NQ_SEL = NQ_WSF + 2048, NQ_LIST = NQ_SEL + 512, NQ_YAC = NQ_LIST + 256, NQ_LDS = NQ_YAC + 65536, NQ_IMP = 2 * NQ_KVB;
static_assert(NQ_LDS <= 152 * 1024, "lds");
DEVI void nsa_prompt_unit(const P& p, char* smem, int unit) {
    const int tid = tid_opq(), lane = tid & 63, wid = tid >> 6, r32 = lane & 31, hi = lane >> 5;
    float* wsf = (float*)(smem + NQ_WSF) + wid * 64;
    float* impb = (float*)(smem + NQ_IMP) + wid * 512;
    unsigned long long* selm = (unsigned long long*)(smem + NQ_SEL);
    unsigned char* blist = (unsigned char*)(smem + NQ_LIST);
    const int b = unit >> 8, g = ((unit >> 6) + b) & 3, qt = (b & 1) ? 63 - (unit & 63) : (unit & 63), t0 = qt * 64;
    const size_t rowbase = (size_t)b * 4096 + t0;
    const int tokl = wid * 8 + (r32 >> 2), head = r32 & 3;
    const int qpos = t0 + tokl;
    const float slope = alibi_slope(g * 4 + head);
    bf16x8 qr[4];
    {
        const bf16_t* qp = p.PROJ + (rowbase + tokl) * PS + C_BQ + (g * 4 + head) * 64 + hi * 8;
#pragma unroll
        for (int d0 = 0; d0 < 4; ++d0) {
            u32x4 v = *(const u32x4*)(qp + d0 * 16);
#pragma unroll
            for (int k = 0; k < 4; ++k) { const float lo = __uint_as_float(v[k] << 16) * 0.125f, hh = __uint_as_float(v[k] & 0xFFFF0000u) * 0.125f; v[k] = (__float_as_uint(lo) >> 16) | (__float_as_uint(hh) & 0xFFFF0000u); }
            qr[d0] = __builtin_bit_cast(bf16x8, v);
        }
    }
    unsigned qe_w;
    { const unsigned sh = (unsigned)f2bf(slope); const float rem = slope - __uint_as_float(sh << 16); qe_w = sh | ((unsigned)f2bf(rem) << 16); if (hi) qe_w = 0u; }
    int hi4 = 4 * hi; asm volatile("" : "+v"(hi4));
    float* yl = (float*)(smem + NQ_YAC) + wid * 2048 + hi4 * 64 + r32;
    float* wsf_hi = wsf + hi4; float* wsf_r = wsf + r32;
    f32x16 o0, o1; float m, lsum;
    auto finish = [&](int br) {
        const float lt = half_sum(lsum);
        float fac = 0.f;
        if (lt > 0.f) fac = sigmoidf_(p.SM[(rowbase + tokl) * 64 + 8 + br * 16 + g * 4 + head]) / lt;
        if (hi == 0) *wsf_r = fac;
        asm volatile("s_waitcnt lgkmcnt(0)" ::: "memory");
#pragma unroll
        for (int a = 0; a < 4; ++a) {
            const f32x4 fv = *(const f32x4*)(wsf_hi + 8 * a);
#pragma unroll
            for (int k = 0; k < 4; ++k) {
                float* yp = yl + (8 * a + k) * 64;
                if (br == 0) { yp[0] = o0[4 * a + k] * fv[k]; yp[32] = o1[4 * a + k] * fv[k]; }
                else { yp[0] += o0[4 * a + k] * fv[k]; yp[32] += o1[4 * a + k] * fv[k]; }
            }
        }
        asm volatile("s_waitcnt lgkmcnt(0)" ::: "memory");
    };
    __syncthreads();
    if (tid < 64) *(u32x4*)(smem + 9 * 1024 + tid * 16) = (u32x4){0u, 0u, 0u, 0u};
    {
        const BlkDesc d = nsa_desc(p, true, b, g, 0, 0);
        u32x4 rk, rv; blk_load(d, tid, rk, rv); blk_store_ext(d, 64, 63, t0, smem, smem + 10240, tid, rk, rv);
        __syncthreads();
        o0 = (f32x16){}; o1 = (f32x16){}; m = -1e30f; lsum = 0.f;
        f32x16 s0, s1;
        {
            const int nv = ((qpos + 1) >> 6) - 1;
            const int lh = (nv < 63 ? nv : 63) - hi4;
            const bf16x8 qext = __builtin_bit_cast(bf16x8, (u32x4){qe_w, qe_w, 0u, 0u});
            attn_tile2(smem, smem + 10240, qr, qext, m, lsum, o0, o1, s0, s1, lh, -1000, false, wsf_hi, wsf_r, lane);
        }
        const float lt = half_sum(lsum);
        const float inv = lt > 0.f ? 1.f / lt : 0.f;
        float* ib = impb + (r32 >> 2) * 64 + hi4;
#pragma unroll
        for (int r = 0; r < 16; ++r) {
            float a = s0[r] * inv, c = s1[r] * inv;
            a += __shfl_xor(a, 1); a += __shfl_xor(a, 2); c += __shfl_xor(c, 1); c += __shfl_xor(c, 2);
            if (head == 0) { ib[(r & 3) + 8 * (r >> 2)] = a; ib[(r & 3) + 8 * (r >> 2) + 32] = c; }
        }
        asm volatile("s_waitcnt lgkmcnt(0)" ::: "memory");
        finish(0);
#pragma unroll 1
        for (int tl = 0; tl < 8; ++tl) {
            const int j = lane;
            float v = impb[tl * 64 + j];
            if (j == qt || j == 0) v = 5.0f;
            if (j > qt) v = -1.0f;
            impb[tl * 64 + j] = v;
            asm volatile("s_waitcnt lgkmcnt(0)" ::: "memory");
            int rank = 0;
#pragma unroll 8
            for (int jj = 0; jj < 64; ++jj) { const float u = impb[tl * 64 + jj]; rank += (u > v || (u == v && jj < j)) ? 1 : 0; }
            const unsigned long long mask = __ballot(rank < 16);
            if (lane == 0) selm[wid * 8 + tl] = mask;
        }
    }
    __syncthreads();
    if (wid == 0) {
        unsigned long long u = selm[lane];
#pragma unroll
        for (int o = 32; o > 0; o >>= 1) u |= __shfl_xor(u, o);
        u &= (qt == 63) ? ~0ull : ((1ull << (qt + 1)) - 1ull);
        if (lane == 0) {
            int n = 0;
            while (u) { const int j = __builtin_ctzll(u); u &= u - 1; blist[2 + n++] = (unsigned char)j; }
            blist[0] = (unsigned char)n;
            int nw = 0;
            for (int j = (qt - 8 > 0 ? qt - 8 : 0); j <= qt; ++j) blist[2 + n + nw++] = (unsigned char)j;
            blist[1] = (unsigned char)nw;
        }
    }
    __syncthreads();
    if (tid >= 64 && tid < 256) *(u32x4*)(smem + (tid >> 6) * NQ_KVB + 9 * 1024 + (tid & 63) * 16) = (u32x4){0u, 0u, 0u, 0u};
    const int ns = blist[0], nw = blist[1];
    const int nss = (ns + 1) >> 1, nsteps = nss + ((nw + 1) >> 1);
    const unsigned long long mysel = selm[tokl];
    {
        auto step_blocks = [&](int s, int& br, int& jA, int& jB) {
            if (s < nss) { br = 1; jA = blist[2 + 2 * s]; jB = 2 * s + 1 < ns ? (int)blist[2 + 2 * s + 1] : -1; }
            else { const int w = s - nss; br = 2; jA = blist[2 + ns + 2 * w]; jB = 2 * w + 1 < nw ? (int)blist[2 + ns + 2 * w + 1] : -1; }
        };
        u32x4 rkA, rvA, rkB, rvB;
        auto load_step = [&](int s) {
            int br, jA, jB; step_blocks(s, br, jA, jB);
            const BlkDesc dA = nsa_desc(p, true, b, g, br, jA); blk_load(dA, tid, rkA, rvA);
            if (jB >= 0) { const BlkDesc dB = nsa_desc(p, true, b, g, br, jB); blk_load(dB, tid, rkB, rvB); }
        };
        auto store_step = [&](int s, char* buf) {
            int br, jA, jB; step_blocks(s, br, jA, jB);
            BlkDesc dA; dA.pos0 = jA * 64; blk_store_ext(dA, 1, 0, t0, buf, buf + 10240, tid, rkA, rvA);
            if (jB >= 0) { BlkDesc dB; dB.pos0 = jB * 64; blk_store_ext(dB, 1, 0, t0, buf + NQ_KVB, buf + NQ_KVB + 10240, tid, rkB, rvB); }
        };
        load_step(0); store_step(0, smem);
        __syncthreads();
        int prev_br = 1;
        o0 = (f32x16){}; o1 = (f32x16){}; m = -1e30f; lsum = 0.f;
        for (int s = 0; s < nsteps; ++s) {
            int br, jA, jB; step_blocks(s, br, jA, jB);
            char* cur = smem + (s & 1) * 2 * NQ_KVB;
            char* nxt = smem + ((s & 1) ^ 1) * 2 * NQ_KVB;
            if (s + 1 < nsteps) load_step(s + 1);
            if (br != prev_br) { finish(1); o0 = (f32x16){}; o1 = (f32x16){}; m = -1e30f; lsum = 0.f; prev_br = br; }
            {
                asm volatile("" : "+v"(hi4));
                const bool lselA = br == 2 || ((mysel >> jA) & 1ull);
                const int relA = qpos - jA * 64;
                const int lhA = (relA < 63 ? relA : 63) - hi4, llA = (br == 2 ? relA - 512 : -1000) - hi4;
                const bool fastA = __all(!lselA || (lhA >= 59 && llA < 0));
                const bool needA = __any(lselA && lhA + hi4 >= 0 && llA + hi4 < 63);
                const bf16x8 qeA = __builtin_bit_cast(bf16x8, (u32x4){qe_w, qe_w, (lselA || hi) ? 0u : 0x0000C6EAu, 0u});
                bool needB = false; bool lselB = false; int lhB = -1000, llB = -1000; bool fastB = false;
                if (jB >= 0) {
                    lselB = br == 2 || ((mysel >> jB) & 1ull);
                    const int relB = qpos - jB * 64;
                    lhB = (relB < 63 ? relB : 63) - hi4; llB = (br == 2 ? relB - 512 : -1000) - hi4;
                    fastB = __all(!lselB || (lhB >= 59 && llB < 0));
                    needB = __any(lselB && lhB + hi4 >= 0 && llB + hi4 < 63);
                }
                const bf16x8 qeB = __builtin_bit_cast(bf16x8, (u32x4){qe_w, qe_w, (lselB || hi) ? 0u : 0x0000C6EAu, 0u});
                f32x16 s0, s1;
                if (needA && needB) attn_tile3(cur, cur + 10240, cur + NQ_KVB, cur + NQ_KVB + 10240, qr, qeA, qeB, m, lsum, o0, o1, lhA, llA, fastA, lhB, llB, fastB, wsf_hi, wsf_r, lane);
                else if (needA) attn_tile2(cur, cur + 10240, qr, qeA, m, lsum, o0, o1, s0, s1, lhA, llA, fastA, wsf_hi, wsf_r, lane);
                else if (needB) attn_tile2(cur + NQ_KVB, cur + NQ_KVB + 10240, qr, qeB, m, lsum, o0, o1, s0, s1, lhB, llB, fastB, wsf_hi, wsf_r, lane);
            }
            if (s + 1 < nsteps) store_step(s + 1, nxt);
            __syncthreads();
        }
        finish(2);
    }
    {
        const float* yac = (const float*)(smem + NQ_YAC) + wid * 2048;
#pragma unroll
        for (int i = 0; i < 4; ++i) {
            const int orow = i * 8 + (lane >> 3), ch = lane & 7, tk = wid * 8 + (orow >> 2), hd = orow & 3;
            const f32x4 a = *(const f32x4*)(yac + orow * 64 + ch * 8), c = *(const f32x4*)(yac + orow * 64 + ch * 8 + 4);
            *(u32x4*)(p.YB + (rowbase + tk) * 1024 + (g * 4 + hd) * 64 + ch * 8) = pack8f(a, c);
        }
        asm volatile("s_waitcnt lgkmcnt(0)" ::: "memory");
    }
}

DEVI void stage_nsa_attn(const P& p, char* smem, int bid, int nblk) {
#ifndef NSA_REP
#define NSA_REP 0
#endif
    const int n_units = 1024 + 512 + (NSA_REP == 1 ? 1024 : 0) + (NSA_REP == 2 ? 512 : 0);
    for (int unit0 = bid; unit0 < n_units; unit0 += nblk) {
        const int unit = unit0 < 1536 ? unit0 : (NSA_REP == 1 ? unit0 - 1536 : unit0 - 512);
        if (unit < 1024) nsa_prompt_unit(p, smem, unit); else nsa_sample_unit(p, smem, unit - 1024);
    }
}

DEVI void stage_ln1(const P& p, int bid, int nblk) {
    const int lane = tid_opq() & 63, wid = tid_opq() >> 6;
    for (int row = bid * 8 + wid; row < NT; row += nblk * 8) {
        f32x4 x[4];
        float s = 0.f;
#pragma unroll
        for (int i = 0; i < 4; ++i) { x[i] = *(const f32x4*)(p.R + (size_t)row * 1024 + i * 256 + lane * 4); s += x[i][0] + x[i][1] + x[i][2] + x[i][3]; }
        const float mean = wave_sum(s) * (1.f / 1024.f);
        float q = 0.f;
#pragma unroll
        for (int i = 0; i < 4; ++i)
#pragma unroll
            for (int k = 0; k < 4; ++k) q += (x[i][k] - mean) * (x[i][k] - mean);
        const float rs = rsqrtf(wave_sum(q) * (1.f / 1024.f) + LN_EPS);
#pragma unroll
        for (int i = 0; i < 4; ++i) {
            const int c = i * 256 + lane * 4;
            const f32x4 gg = *(const f32x4*)(p.ln1_g + c), bb = *(const f32x4*)(p.ln1_b + c);
            f32x4 y;
#pragma unroll
            for (int k = 0; k < 4; ++k) y[k] = (x[i][k] - mean) * rs * gg[k] + bb[k];
            u32x2 o; o.x = pack2(y[0], y[1]); o.y = pack2(y[2], y[3]);
            *(u32x2*)(p.HB + (size_t)row * 1024 + c) = o;
        }
        if (lane == 0) { p.H[(size_t)row * 2] = mean; p.H[(size_t)row * 2 + 1] = rs; }
    }
}

__device__ const unsigned char PEER_CA[50] = {0,0,0,0,0,0,0,0,0,0,0,0,0,0,0,0, 1,1,1,1,1,1,1,1, 2,2,2,2,2, 3,3,3,3, 4,4,4, 5,5, 6,6, 7,7, 8,9,10,11,12,13,14,15};
__device__ const unsigned char PEER_CB[50] = {0,1,2,3,4,5,6,7,8,9,10,11,12,13,14,15, 0,1,2,3,4,5,6,7, 0,1,2,3,4, 0,1,2,3, 0,1,2, 0,1, 0,1, 0,1, 0,0,0,0,0,0,0,0};

DEVI void ce_desc(unsigned& a, unsigned& b) { const unsigned hi = a > b ? a : b, lo = a > b ? b : a; a = hi; b = lo; }
template <int BASE> DEVI void sort16_desc(unsigned (&x)[64]) {
#pragma unroll
    for (int k = 2; k <= 16; k <<= 1)
#pragma unroll
        for (int j = k >> 1; j > 0; j >>= 1)
#pragma unroll
            for (int i = 0; i < 16; ++i) {
                const int l = i ^ j;
                if (l > i) { if ((i & k) == 0) ce_desc(x[BASE + i], x[BASE + l]); else ce_desc(x[BASE + l], x[BASE + i]); }
            }
}
DEVI void merge_top16(const unsigned* a, const unsigned* b, unsigned* t) {
    unsigned c[16];
#pragma unroll
    for (int i = 0; i < 16; ++i) c[i] = a[i] > b[15 - i] ? a[i] : b[15 - i];
#pragma unroll
    for (int j = 8; j > 0; j >>= 1)
#pragma unroll
        for (int i = 0; i < 16; ++i) { const int l = i ^ j; if (l > i) ce_desc(c[i], c[l]); }
#pragma unroll
    for (int i = 0; i < 16; ++i) t[i] = c[i];
}
DEVI float key_score(unsigned k) { const unsigned u = k & ~127u; return __uint_as_float((u & 0x80000000u) ? (u & 0x7FFFFFFFu) : ~u); }

DEVI void sort8_desc(unsigned (&x)[16]) {
#pragma unroll
    for (int k = 2; k <= 8; k <<= 1)
#pragma unroll
        for (int j = k >> 1; j > 0; j >>= 1)
#pragma unroll
            for (int i = 0; i < 8; ++i) {
                const int l = i ^ j;
                if (l > i) { if ((i & k) == 0) ce_desc(x[i], x[l]); else ce_desc(x[l], x[i]); }
            }
}
DEVI unsigned sum_key(unsigned ka, unsigned kb, unsigned tag) {
    const unsigned u = __float_as_uint(key_score(ka) + key_score(kb));
    const unsigned o = (u & 0x80000000u) ? ~u : (u | 0x80000000u);
    return (o & ~255u) | tag;
}
DEVI float key_score8(unsigned k) { const unsigned u = k & ~255u; return __uint_as_float((u & 0x80000000u) ? (u & 0x7FFFFFFFu) : ~u); }

DEVI void route_top16(const P& p, int row, int ph, int c, int r32, int hi, int hi4, unsigned (&fin)[16]) {
    f32x16 acc[4];
#pragma unroll
    for (int t = 0; t < 4; ++t) acc[t] = (f32x16){};
    const bf16_t* qp = p.PQ + (size_t)row * 2048 + ph * 256 + c * 128 + hi * 8;
    const bf16_t* kp = p.KEYSB + ((size_t)((ph * 2 + c) * 128 + r32)) * 128 + hi * 8;
#pragma unroll
    for (int s8 = 0; s8 < 8; ++s8) {
        const bf16x8 qf = *(const bf16x8*)(qp + s8 * 16);
#pragma unroll
        for (int t = 0; t < 4; ++t) {
            const bf16x8 kf = *(const bf16x8*)(kp + (size_t)t * 32 * 128 + s8 * 16);
            acc[t] = MFMA32(kf, qf, acc[t]);
        }
    }
    unsigned x[64];
#pragma unroll
    for (int t = 0; t < 4; ++t)
#pragma unroll
        for (int r = 0; r < 16; ++r) {
            const unsigned u = __float_as_uint(acc[t][r]);
            const unsigned o = (u & 0x80000000u) ? ~u : (u | 0x80000000u);
            x[t * 16 + r] = (o & ~127u) | (unsigned)(127 - ((r & 3) + 8 * (r >> 2) + 32 * t) - hi4);
        }
    sort16_desc<0>(x); sort16_desc<16>(x); sort16_desc<32>(x); sort16_desc<48>(x);
    unsigned t01[16], t23[16], tt[16], oth[16];
    merge_top16(&x[0], &x[16], t01); merge_top16(&x[32], &x[48], t23); merge_top16(t01, t23, tt);
#pragma unroll
    for (int i = 0; i < 16; ++i) { auto rr = __builtin_amdgcn_permlane32_swap(tt[i], tt[i], false, false); oth[i] = hi ? rr[0] : rr[1]; }
    merge_top16(tt, oth, fin);
}

DEVI void stage_peer_route(const P& p, char* smem, int bid, int nblk) {
    const int lane = tid_opq() & 63, wid = tid_opq() >> 6, r32 = lane & 31, hi = lane >> 5;
    unsigned char* tb = (unsigned char*)smem + wid * 1024 + r32 * 32;
    for (int wt = bid * 8 + wid; wt < 528 * 8; wt += nblk * 8) {
        const int tile = wt >> 3, ph = wt & 7;
        const int row = tile * 32 + r32;
        int hi4 = 4 * hi; asm volatile("" : "+v"(hi4));
        unsigned fa[16], fb[16];
        route_top16(p, row, ph, 0, r32, hi, hi4, fa);
        asm volatile("" : "+v"(hi4));
        route_top16(p, row, ph, 1, r32, hi, hi4, fb);
        if (hi == 0) {
            u32x4 wa, wb;
#pragma unroll
            for (int i = 0; i < 4; ++i) {
                wa[i] = (127u - (fa[4 * i] & 127u)) | ((127u - (fa[4 * i + 1] & 127u)) << 8) | ((127u - (fa[4 * i + 2] & 127u)) << 16) | ((127u - (fa[4 * i + 3] & 127u)) << 24);
                wb[i] = (127u - (fb[4 * i] & 127u)) | ((127u - (fb[4 * i + 1] & 127u)) << 8) | ((127u - (fb[4 * i + 2] & 127u)) << 16) | ((127u - (fb[4 * i + 3] & 127u)) << 24);
            }
            *(u32x4*)tb = wa; *(u32x4*)(tb + 16) = wb;
        }
        unsigned g0[16], g1[16], g2[16], g3[16];
#pragma unroll
        for (int j = 0; j < 16; ++j) g0[j] = sum_key(fa[0], fb[j], (unsigned)j);
#pragma unroll
        for (int k = 0; k < 15; ++k) g1[k] = sum_key(fa[k + 1], fb[0], (unsigned)((k + 1) << 4));
        g1[15] = 0u;
#pragma unroll
        for (int j = 1; j < 8; ++j) g2[j - 1] = sum_key(fa[1], fb[j], (unsigned)(16 | j));
        g2[7] = 0u; g2[8] = 0u; g2[9] = 0u;
#pragma unroll
        for (int i = 2; i < 8; ++i) g2[17 - i] = sum_key(fa[i], fb[1], (unsigned)((i << 4) | 1));
#pragma unroll
        for (int j = 8; j > 0; j >>= 1)
#pragma unroll
            for (int i = 0; i < 16; ++i) { const int l = i ^ j; if (l > i) ce_desc(g2[i], g2[l]); }
        g3[0] = sum_key(fa[2], fb[2], 0x22u); g3[1] = sum_key(fa[2], fb[3], 0x23u); g3[2] = sum_key(fa[2], fb[4], 0x24u);
        g3[3] = sum_key(fa[3], fb[2], 0x32u); g3[4] = sum_key(fa[4], fb[2], 0x42u); g3[5] = sum_key(fa[3], fb[3], 0x33u);
#pragma unroll
        for (int i = 6; i < 16; ++i) g3[i] = 0u;
        sort8_desc(g3);
        unsigned t01[16], t23[16], top[16];
        merge_top16(g0, g1, t01); merge_top16(g2, g3, t23); merge_top16(t01, t23, top);
        float ev[16]; float sum = 0.f;
        const float vmax = key_score8(top[0]);
#pragma unroll
        for (int k = 0; k < 16; ++k) { ev[k] = __expf(key_score8(top[k]) - vmax); sum += ev[k]; }
        const float inv = 1.f / sum;
        asm volatile("s_waitcnt lgkmcnt(0)" ::: "memory");
        if (hi == 0) {
            int* dst = p.EIDX + (size_t)row * 128 + ph * 16;
#pragma unroll
            for (int q4 = 0; q4 < 4; ++q4) {
                u32x4 o;
#pragma unroll
                for (int k = 0; k < 4; ++k) { const unsigned tg = top[q4 * 4 + k] & 255u; o[k] = (unsigned)tb[tg >> 4] * 128u + (unsigned)tb[16 + (tg & 15u)]; }
                *(u32x4*)(dst + q4 * 4) = o;
            }
        } else {
            float* dst = p.EGATE + (size_t)row * 128 + ph * 16;
#pragma unroll
            for (int q4 = 0; q4 < 4; ++q4) *(f32x4*)(dst + q4 * 4) = (f32x4){ev[q4 * 4] * inv, ev[q4 * 4 + 1] * inv, ev[q4 * 4 + 2] * inv, ev[q4 * 4 + 3] * inv};
        }
        asm volatile("s_waitcnt lgkmcnt(0)" ::: "memory");
    }
}

constexpr int PA_WAVE_LDS = 1024 + 1024 + 512 + 512 + 512;
DEVI void stage_peer_apply(const P& p, char* smem, int bid, int nblk) {
    const int lane = tid_opq() & 63, wid = tid_opq() >> 6;
    char* wl = smem + wid * PA_WAVE_LDS;
    unsigned char* hhi = (unsigned char*)wl; unsigned char* hlo = hhi + 1024;
    int* idxs = (int*)(wl + 2048);
    float* gts = (float*)(wl + 2560);
    float* cs = (float*)(wl + 3072);
    const int fr = lane & 15, fq = lane >> 4;
    for (int row = bid * 8 + wid; row < NT; row += nblk * 8) {
        float hv[16];
        {
            const float* hr = p.R + (size_t)row * 1024 + lane * 16;
            const float mean1 = p.H[(size_t)row * 2], rs1 = p.H[(size_t)row * 2 + 1];
            u32x4 ohi, olo;
#pragma unroll
            for (int i = 0; i < 4; ++i) {
                f32x4 x = *(const f32x4*)(hr + i * 4);
                { const f32x4 g1 = *(const f32x4*)(p.ln1_g + lane * 16 + i * 4), b1 = *(const f32x4*)(p.ln1_b + lane * 16 + i * 4);
#pragma unroll
                  for (int k = 0; k < 4; ++k) x[k] = (x[k] - mean1) * rs1 * g1[k] + b1[k]; }
#pragma unroll
                for (int k = 0; k < 4; ++k) hv[i * 4 + k] = x[k];
                int w = __builtin_amdgcn_cvt_pk_fp8_f32(x[0], x[1], 0, false); w = __builtin_amdgcn_cvt_pk_fp8_f32(x[2], x[3], w, true);
                const f32x2 d01 = __builtin_amdgcn_cvt_pk_f32_fp8(w, false), d23 = __builtin_amdgcn_cvt_pk_f32_fp8(w, true);
                int w2 = __builtin_amdgcn_cvt_pk_fp8_f32(x[0] - d01[0], x[1] - d01[1], 0, false); w2 = __builtin_amdgcn_cvt_pk_fp8_f32(x[2] - d23[0], x[3] - d23[1], w2, true);
                ohi[i] = (unsigned)w; olo[i] = (unsigned)w2;
            }
            *(u32x4*)(hhi + lane * 16) = ohi; *(u32x4*)(hlo + lane * 16) = olo;
            idxs[lane] = p.EIDX[(size_t)row * 128 + lane]; idxs[lane + 64] = p.EIDX[(size_t)row * 128 + 64 + lane];
            gts[lane] = p.EGATE[(size_t)row * 128 + lane]; gts[lane + 64] = p.EGATE[(size_t)row * 128 + 64 + lane];
            asm volatile("s_waitcnt lgkmcnt(0)" ::: "memory");
        }
#pragma unroll 1
        for (int g = 0; g < 8; ++g) {
            const int my_e = idxs[g * 16 + fr];
            const unsigned char* ub = p.U8 + (size_t)my_e * 1024 + fq * 16;
            f32x4 acc = (f32x4){0.f, 0.f, 0.f, 0.f};
            u32x4 a[16];
#pragma unroll
            for (int s2 = 0; s2 < 16; ++s2) a[s2] = *(const u32x4*)(ub + s2 * 64);
#pragma unroll
            for (int s2 = 0; s2 < 16; ++s2) {
                const u32x4 bh = *(const u32x4*)(hhi + s2 * 64 + fq * 16), bl = *(const u32x4*)(hlo + s2 * 64 + fq * 16);
                const long a0 = (long)(((unsigned long long)a[s2][1] << 32) | a[s2][0]), a1 = (long)(((unsigned long long)a[s2][3] << 32) | a[s2][2]);
                const long h0 = (long)(((unsigned long long)bh[1] << 32) | bh[0]), h1 = (long)(((unsigned long long)bh[3] << 32) | bh[2]);
                const long l0 = (long)(((unsigned long long)bl[1] << 32) | bl[0]), l1 = (long)(((unsigned long long)bl[3] << 32) | bl[2]);
                acc = __builtin_amdgcn_mfma_f32_16x16x32_fp8_fp8(a0, h0, acc, 0, 0, 0);
                acc = __builtin_amdgcn_mfma_f32_16x16x32_fp8_fp8(a1, h1, acc, 0, 0, 0);
                acc = __builtin_amdgcn_mfma_f32_16x16x32_fp8_fp8(a0, l0, acc, 0, 0, 0);
                acc = __builtin_amdgcn_mfma_f32_16x16x32_fp8_fp8(a1, l1, acc, 0, 0, 0);
            }
            const f32x4 gg = *(const f32x4*)(gts + g * 16 + fq * 4);
            f32x4 cv;
#pragma unroll
            for (int r = 0; r < 4; ++r) {
                const int e = idxs[g * 16 + fq * 4 + r];
                const float d = acc[r] * p.US[e];
                cv[r] = gg[r] * p.VS[e] * 0.5f * d * (1.f + erff(d * 0.7071067811865476f));
            }
            if (fr == 0) *(f32x4*)(cs + g * 16 + fq * 4) = cv;
        }
        asm volatile("s_waitcnt lgkmcnt(0)" ::: "memory");
        float acc[16];
#pragma unroll
        for (int i = 0; i < 16; ++i) acc[i] = 0.f;
#pragma unroll 1
        for (int e0 = 0; e0 < 128; e0 += 16) {
            u32x4 v[16]; float c[16];
#pragma unroll
            for (int k = 0; k < 16; ++k) { v[k] = *(const u32x4*)(p.V8 + (size_t)idxs[e0 + k] * 1024 + lane * 16); c[k] = cs[e0 + k]; }
#pragma unroll
            for (int k = 0; k < 16; ++k) {
#pragma unroll
                for (int w = 0; w < 4; ++w) {
                    const f32x2 lo = __builtin_amdgcn_cvt_pk_f32_fp8((int)v[k][w], false), hh = __builtin_amdgcn_cvt_pk_f32_fp8((int)v[k][w], true);
                    acc[w * 4] += c[k] * lo[0]; acc[w * 4 + 1] += c[k] * lo[1]; acc[w * 4 + 2] += c[k] * hh[0]; acc[w * 4 + 3] += c[k] * hh[1];
                }
            }
        }
        float s = 0.f;
#pragma unroll
        for (int i = 0; i < 16; ++i) { acc[i] += DN_ALPHA * hv[i]; s += acc[i]; }
        const float mean = wave_sum(s) * (1.f / 1024.f);
        float q = 0.f;
#pragma unroll
        for (int i = 0; i < 16; ++i) q += (acc[i] - mean) * (acc[i] - mean);
        const float rs = rsqrtf(wave_sum(q) * (1.f / 1024.f) + LN_EPS);
#pragma unroll
        for (int i = 0; i < 4; ++i) {
            const int c = lane * 16 + i * 4;
            const f32x4 g0 = *(const f32x4*)(p.ln2_g + c), b0 = *(const f32x4*)(p.ln2_b + c);
            f32x4 y0;
#pragma unroll
            for (int k = 0; k < 4; ++k) y0[k] = (acc[i * 4 + k] - mean) * rs * g0[k] + b0[k];
            *(f32x4*)(p.out + O_Y + (size_t)row * 1024 + c) = y0;
        }
    }
}

namespace pg8 {
#define PG8_LAS __attribute__((address_space(3)))
typedef unsigned short bf16_t;
typedef short bf16x8 __attribute__((ext_vector_type(8)));
typedef float f32x4 __attribute__((ext_vector_type(4)));
typedef unsigned u32x4 __attribute__((ext_vector_type(4)));
constexpr int BM = 256, BK = 64, HALF = 128, HTB = HALF * BK * 2  , STAGE_BYTES = 8 * HTB, NXCD = 8, WGM = 8;

__host__ __device__ __forceinline__ int lds_byte(int r, int c) { const int st = (r >> 4) * 2 + (c >> 5), rr = r & 15, cc = c & 31, ob = rr * 64 + cc * 2; return st * 1024 + (ob ^ (((ob >> 9) & 1) << 5)); }
__host__ __device__ __forceinline__ void stage_rc(int b, int& R, int& C) { const int st = b / 1024, sb = b % 1024, swz = sb ^ (((sb >> 9) & 1) << 5); R = (st >> 1) * 16 + swz / 64; C = (st & 1) * 32 + (swz % 64) / 2; }
__host__ __device__ __forceinline__ int perm32(int rho) { const int n = rho >> 4, i = rho & 15; return 8 * (i >> 2) + 4 * n + (i & 3); }

struct Unit { int pm, pn; };
struct Gemm { const bf16_t* A; const bf16_t* Bt; int M, N, K; };

struct StaticOrder {
    int nM, nN, nwg, G, c;
    __host__ __device__ void init(int M, int N, int G_, int c_) { nM = M / BM; nN = N / BM; nwg = nM * nN; G = G_; c = c_; }
    __host__ __device__ bool next(int i, Unit& u) const {
        const long L = (long)i * G + c; if (L >= nwg) return false;
        int wgid = (int)L; { const int q = nwg / NXCD, r = nwg % NXCD, xcd = wgid % NXCD, off = wgid / NXCD; wgid = (xcd < r ? xcd * (q + 1) : r * (q + 1) + (xcd - r) * q) + off; }
        const int nig = WGM * nN, gid = wgid / nig, fm = gid * WGM, gsz = (nM - fm) < WGM ? (nM - fm) : WGM;
        u.pm = fm + ((wgid % nig) % gsz); u.pn = (wgid % nig) / gsz; return true;
    }
    __device__ __forceinline__ void a_ready(const Unit&) const {}
    __device__ __forceinline__ void done(const Unit&) const {}
};
template <class Epi, class Sched, bool STAMP = false>
__device__ __forceinline__ void gemm_phase(PG8_LAS unsigned char* lds, const Gemm g, const Sched& S, const Epi& E, unsigned long long* stamps) {
    const int tid = tid_opq(), wid = __builtin_amdgcn_readfirstlane(tid >> 6), lane = tid & 63, wr = wid >> 2, wc = wid & 3, fr = lane & 15, fq = lane >> 4;
    const int K = g.K, nt = K / BK;
    int ts_lo = 0, ts_hi = 0, nts = 0; const unsigned long long rt_entry = STAMP ? (unsigned long long)wall_clock64() : 0ull;
#define PG8_STAMP() do { if (STAMP && wid == 0 && nts < 64) { const unsigned long long _c = (unsigned long long)clock64(); \
        ts_lo = (lane == nts) ? (int)(unsigned)_c : ts_lo; ts_hi = (lane == nts) ? (int)(unsigned)(_c >> 32) : ts_hi; ++nts; } } while (0)
    PG8_STAMP();
    unsigned voffA[2], voffB[2];
#pragma unroll
    for (int i = 0; i < 2; ++i) { int R, C; stage_rc(tid * 16 + i * 8192, R, C); const int Rb = Epi::PERM ? ((R & ~31) + perm32(R & 31)) : R;
        voffA[i] = (unsigned)(R * K + C) * 2u; voffB[i] = (unsigned)(Rb * K + C) * 2u; }
    const size_t kstep = (size_t)(BK * 2);
    const size_t hstep = (size_t)HALF * K * 2;
    const size_t tstep = 2 * hstep;
    const unsigned ldsw = (unsigned)wid * 1024u;
    const int aoff = lds_byte(wr * 64 + fr, fq * 8), boff = lds_byte(wc * 32 + fr, fq * 8);
#define PG8_SA(b, h) (((b) * 2 + (h)) * HTB)
#define PG8_SB(b, h) ((4 + (b) * 2 + (h)) * HTB)
#define PG8_STAGE(bufoff, gbase, voff) do { _Pragma("unroll") for (int _i = 0; _i < 2; ++_i) \
        __builtin_amdgcn_global_load_lds((const unsigned*)((const char*)(gbase) + (voff)[_i]), (PG8_LAS unsigned*)(lds + (bufoff) + ldsw + _i * 8192), 16, 0, 0); } while (0)
#define PG8_LDA(dst, b, h) do { _Pragma("unroll") for (int m = 0; m < 4; ++m) _Pragma("unroll") for (int k = 0; k < 2; ++k) dst[m][k] = *(const PG8_LAS bf16x8*)(lds + PG8_SA(b, h) + aoff + m * 2048 + k * 1024); } while (0)
#define PG8_LDB(dst, b, h) do { _Pragma("unroll") for (int n = 0; n < 2; ++n) _Pragma("unroll") for (int k = 0; k < 2; ++k) dst[n][k] = *(const PG8_LAS bf16x8*)(lds + PG8_SB(b, h) + boff + n * 2048 + k * 1024); } while (0)
#define PG8_MMA(ai, bj, At, Bt) do { __builtin_amdgcn_s_setprio(1); _Pragma("unroll") for (int m = 0; m < 4; ++m) _Pragma("unroll") for (int n = 0; n < 2; ++n) _Pragma("unroll") for (int k = 0; k < 2; ++k) \
        acc[ai][bj][m][n] = __builtin_amdgcn_mfma_f32_16x16x32_bf16(Bt[n][k], At[m][k], acc[ai][bj][m][n], 0, 0, 0); __builtin_amdgcn_s_setprio(0); } while (0)
#define PG8_WAIT_V(n) asm volatile("s_waitcnt vmcnt(" #n ")" ::: "memory")
#define PG8_WAIT_L(n) asm volatile("s_waitcnt lgkmcnt(" #n ")" ::: "memory")
#define PG8_BAR __builtin_amdgcn_s_barrier()
#define PG8_SCHED __builtin_amdgcn_sched_barrier(0)
    Unit cur, nxt; int ui = 0;
    if (!S.next(0, cur)) return;
    f32x4 acc[2][2][4][2];
#pragma unroll
    for (int a = 0; a < 2; ++a)
#pragma unroll
        for (int b = 0; b < 2; ++b)
#pragma unroll
            for (int m = 0; m < 4; ++m)
#pragma unroll
                for (int n = 0; n < 2; ++n) acc[a][b][m][n] = (f32x4){0.f, 0.f, 0.f, 0.f};
    bf16x8 At[4][2], B0[2][2], B1[2][2];
    const char* cA = (const char*)g.A + (size_t)cur.pm * tstep; const char* cB = (const char*)g.Bt + (size_t)cur.pn * tstep;
    S.a_ready(cur);
    PG8_STAGE(PG8_SB(0, 0), cB, voffB); PG8_STAGE(PG8_SA(0, 0), cA, voffA); PG8_STAGE(PG8_SB(0, 1), cB + hstep, voffB); PG8_STAGE(PG8_SA(0, 1), cA + hstep, voffA);
    if (wr == 1) PG8_BAR;
    PG8_WAIT_V(4); PG8_BAR;
    PG8_STAGE(PG8_SB(1, 0), cB + kstep, voffB); PG8_STAGE(PG8_SA(1, 0), cA + kstep, voffA); PG8_STAGE(PG8_SB(1, 1), cB + hstep + kstep, voffB);
    PG8_WAIT_V(6); PG8_BAR;
    PG8_STAMP();
    for (;;) {
        const bool has_next = S.next(ui + 1, nxt);
        const char* nA = has_next ? (const char*)g.A + (size_t)nxt.pm * tstep : cA; const char* nB = has_next ? (const char*)g.Bt + (size_t)nxt.pn * tstep : cB;
        for (int t = 0; t < nt; t += 2) {
            const bool last = (t == nt - 2);
            const char* a1 = cA + (size_t)(t + 1) * kstep;
            const char* a2 = last ? nA : cA + (size_t)(t + 2) * kstep; const char* b2 = last ? nB : cB + (size_t)(t + 2) * kstep;
            const char* a3 = a2 + kstep; const char* b3 = b2 + kstep;
            if (last && has_next) S.a_ready(nxt);
            PG8_LDB(B0, 0, 0); PG8_SCHED; PG8_LDA(At, 0, 0); PG8_STAGE(PG8_SA(1, 1), a1 + hstep, voffA);
            PG8_WAIT_L(8); PG8_BAR; PG8_WAIT_L(0); PG8_MMA(0, 0, At, B0); PG8_BAR; PG8_SCHED;
            PG8_LDB(B1, 0, 1); PG8_STAGE(PG8_SB(0, 0), b2, voffB);
            PG8_BAR; PG8_WAIT_L(0); PG8_MMA(0, 1, At, B1); PG8_BAR;
            PG8_LDA(At, 0, 1); PG8_STAGE(PG8_SA(0, 0), a2, voffA);
            PG8_BAR; PG8_WAIT_L(0); PG8_MMA(1, 0, At, B0); PG8_BAR; PG8_SCHED;
            PG8_STAGE(PG8_SB(0, 1), b2 + hstep, voffB);
            PG8_WAIT_V(6); PG8_BAR; PG8_MMA(1, 1, At, B1); PG8_BAR;
            PG8_LDB(B0, 1, 0); PG8_SCHED; PG8_LDA(At, 1, 0); PG8_STAGE(PG8_SA(0, 1), a2 + hstep, voffA);
            PG8_WAIT_L(8); PG8_BAR; PG8_WAIT_L(0); PG8_MMA(0, 0, At, B0); PG8_BAR; PG8_SCHED;
            PG8_LDB(B1, 1, 1); PG8_STAGE(PG8_SB(1, 0), b3, voffB);
            PG8_BAR; PG8_WAIT_L(0); PG8_MMA(0, 1, At, B1); PG8_BAR;
            PG8_LDA(At, 1, 1); PG8_STAGE(PG8_SA(1, 0), a3, voffA);
            PG8_BAR; PG8_WAIT_L(0); PG8_MMA(1, 0, At, B0); PG8_BAR; PG8_SCHED;
            PG8_STAGE(PG8_SB(1, 1), b3 + hstep, voffB);
            PG8_WAIT_V(6); PG8_BAR; PG8_MMA(1, 1, At, B1); PG8_BAR;
        }
        PG8_STAMP();
        if constexpr (!Epi::AFTER_DRAIN) { E(acc, cur, wr, wc, fr, fq); S.done(cur); }
        PG8_STAMP();
        if (!has_next) break;
#pragma unroll
        for (int a = 0; a < 2; ++a)
#pragma unroll
            for (int b = 0; b < 2; ++b)
#pragma unroll
                for (int m = 0; m < 4; ++m)
#pragma unroll
                    for (int n = 0; n < 2; ++n) acc[a][b][m][n] = (f32x4){0.f, 0.f, 0.f, 0.f};
        cur = nxt; cA = nA; cB = nB; ++ui;
    }
    PG8_WAIT_V(0);
    if (wr == 0) PG8_BAR;
    PG8_BAR;
    if constexpr (Epi::AFTER_DRAIN) { E.fused(acc, cur, wr, wc, fr, fq, lds, wid, lane); S.done(cur); }
    PG8_STAMP();
    if (STAMP && wid == 0) { stamps[lane] = lane < nts ? (((unsigned long long)(unsigned)ts_hi << 32) | (unsigned)ts_lo) : 0ull;
        if (lane == 62) stamps[62] = rt_entry; if (lane == 63) stamps[63] = (unsigned long long)wall_clock64(); }
#undef PG8_STAMP
#undef PG8_SA
#undef PG8_SB
#undef PG8_STAGE
#undef PG8_LDA
#undef PG8_LDB
#undef PG8_MMA
#undef PG8_WAIT_V
#undef PG8_WAIT_L
#undef PG8_BAR
#undef PG8_SCHED
}
}

template <class F> struct EpiAdapt {
    static constexpr bool PERM = true, AFTER_DRAIN = false;
    F f;
    __device__ __forceinline__ void operator()(const pg8::f32x4 (&acc)[2][2][4][2], const pg8::Unit& u, int wr, int wc, int fr, int fq) const {
        constexpr int B = F::BATCH;
        const int row0 = u.pm * 256 + wr * 64 + fr, col0 = u.pn * 256 + wc * 32 + 8 * fq;
        f32x4 b0[2], b1[2];
        if constexpr (F::COLBIAS) { f.bias8(col0, b0[0], b1[0]); f.bias8(col0 + 128, b0[1], b1[1]); }
#pragma unroll
        for (int q0 = 0; q0 < 16; q0 += B) {
            typename F::Pre pre[B];
#pragma unroll
            for (int i = 0; i < B; ++i) { const int q = q0 + i, bj = q & 1, m = (q >> 1) & 3, ai = q >> 3; pre[i] = f.pre(row0 + ai * 128 + m * 16, col0 + bj * 128); }
#pragma unroll
            for (int i = 0; i < B; ++i) { const int q = q0 + i, bj = q & 1, m = (q >> 1) & 3, ai = q >> 3;
                f32x4 v0 = acc[ai][bj][m][0], v1 = acc[ai][bj][m][1];
                if constexpr (F::COLBIAS) { v0 += b0[bj]; v1 += b1[bj]; }
                f.put(row0 + ai * 128 + m * 16, col0 + bj * 128, v0, v1, pre[i]); }
        }
    }
};
template <class F>
DEVI void gemm_pg8(const bf16_t* A, const bf16_t* Bt, int M, int N, int K, const F& f, char* smem, int bid, int nblk) {
    pg8::Gemm g{A, Bt, M, N, K};
    pg8::StaticOrder S; S.init(M, N, nblk, bid);
    EpiAdapt<F> E{f};
    __syncthreads();
    pg8::gemm_phase<EpiAdapt<F>, pg8::StaticOrder, false>((PG8_LAS unsigned char*)smem, g, S, E, nullptr);
    __syncthreads();
}

template <class F>
DEVI void gemm_small_rows(const bf16_t* __restrict__ A, const bf16_t* __restrict__ Bt, int N, const F& f, char* smem, int bid, int nblk) {
    const int tid = tid_opq(), lane = tid & 63, wid = tid >> 6, fr = lane & 15, fq = lane >> 4;
    float* part = (float*)smem;
    const int ntn = N / 64, ntiles = (NTS / 32) * ntn;
    for (int tile = bid; tile < ntiles; tile += nblk) {
        const int tm = tile / ntn, tn = tile % ntn;
        const int row0 = NTP + tm * 32, col0 = tn * 64;
        f32x4 acc[2][4];
#pragma unroll
        for (int m = 0; m < 2; ++m)
#pragma unroll
            for (int n = 0; n < 4; ++n) acc[m][n] = (f32x4){0.f, 0.f, 0.f, 0.f};
        const bf16_t* ap = A + (size_t)(row0 + fr) * 1024 + wid * 128 + fq * 8;
        const bf16_t* bp = Bt + (size_t)(col0 + fr) * 1024 + wid * 128 + fq * 8;
        bf16x8 af[4][2], bfr[4][4];
#pragma unroll
        for (int ks = 0; ks < 4; ++ks) {
#pragma unroll
            for (int m = 0; m < 2; ++m) af[ks][m] = *(const bf16x8*)(ap + (size_t)m * 16 * 1024 + ks * 32);
#pragma unroll
            for (int n = 0; n < 4; ++n) bfr[ks][n] = *(const bf16x8*)(bp + (size_t)n * 16 * 1024 + ks * 32);
        }
#pragma unroll
        for (int ks = 0; ks < 4; ++ks)
#pragma unroll
            for (int m = 0; m < 2; ++m)
#pragma unroll
                for (int n = 0; n < 4; ++n) acc[m][n] = __builtin_amdgcn_mfma_f32_16x16x32_bf16(bfr[ks][n], af[ks][m], acc[m][n], 0, 0, 0);
        __syncthreads();
#pragma unroll
        for (int m = 0; m < 2; ++m)
#pragma unroll
            for (int n = 0; n < 4; ++n) *(f32x4*)(part + ((size_t)wid * 32 + m * 16 + fr) * 64 + n * 16 + fq * 4) = acc[m][n];
        __syncthreads();
        if (tid < 256) {
            const int r = tid >> 3, c8 = (tid & 7) * 8;
            f32x4 v0 = {0.f, 0.f, 0.f, 0.f}, v1 = v0;
#pragma unroll
            for (int w = 0; w < 8; ++w) { v0 += *(const f32x4*)(part + ((size_t)w * 32 + r) * 64 + c8); v1 += *(const f32x4*)(part + ((size_t)w * 32 + r) * 64 + c8 + 4); }
            const typename F::Pre pre = f.pre(row0 + r, col0 + c8);
            f.put(row0 + r, col0 + c8, v0, v1, pre);
        }
    }
}
template <class F>
DEVI void gemm_tail(const bf16_t* A, const bf16_t* Bt, int N, const F& f, char* smem, int bid, int nblk) {
    gemm_small_rows(A, Bt, N, f, smem, bid, nblk);
    gemm_pg8(A, Bt, NTP, N, 1024, f, smem, bid, nblk);
}

#define XB_TMO      128
#define XB_XCNT(j)  (256  + 64 * (j))
#define XB_XSUB(j)  (1280 + 64 * (j))
#define XB_XGEN(j)  (2304 + 64 * (j))
#define XB_TOP      3328
#define XB_TOPGEN   3392
#define XCD_BAR_WORDS 3456
#define XB_SPIN_CAP (1u << 18)
#define LAS __attribute__((address_space(3)))

__device__ __forceinline__ unsigned xb_ld(unsigned* p)              { return __hip_atomic_load(p, __ATOMIC_RELAXED, __HIP_MEMORY_SCOPE_AGENT); }
__device__ __forceinline__ unsigned xb_add(unsigned* p, unsigned v) { return __hip_atomic_fetch_add(p, v, __ATOMIC_RELAXED, __HIP_MEMORY_SCOPE_AGENT); }
__device__ __forceinline__ unsigned xb_xcc_id() { return (unsigned)__builtin_amdgcn_s_getreg((3 << 11) | 20) & 0xFu; }
#define XB_SPIN(cond, bar) do { unsigned _sp = 0; while (cond) { __builtin_amdgcn_s_sleep(1); \
    if ((++_sp & 255u) == 0u) { if (xb_ld(&(bar)[XB_TMO])) break; if (_sp > XB_SPIN_CAP) { atomicAdd(&(bar)[XB_TMO], 1u); break; } } } } while (0)

struct XcdBarrier {
    unsigned* bar; unsigned x;
    volatile LAS unsigned* st;
};

__device__ __forceinline__ XcdBarrier xcd_barrier_post(unsigned* bar, volatile LAS unsigned* st) {
    XcdBarrier b; b.bar = bar; b.x = xb_xcc_id(); b.st = st;
    if (tid_opq() == 0) (void)xb_add(&bar[XB_XCNT(b.x)], 1u);
    return b;
}
__device__ __forceinline__ void xcd_barrier_complete(unsigned* bar, unsigned x, unsigned& nloc, unsigned& nx) {
    const unsigned G = gridDim.x * gridDim.y * gridDim.z;
    unsigned sum, cnt, mine, sp = 0u;
    for (;;) {
        sum = 0u; cnt = 0u; mine = 0u;
#pragma unroll
        for (unsigned j = 0; j < 16; ++j) { const unsigned c = xb_ld(&bar[XB_XCNT(j)]); sum += c; cnt += (c > 0u) ? 1u : 0u; mine = (j == x) ? c : mine; }
        if (sum == G) break;
        __builtin_amdgcn_s_sleep(1);
        if ((++sp & 255u) == 0u) { if (xb_ld(&bar[XB_TMO])) break; if (sp > XB_SPIN_CAP) { atomicAdd(&bar[XB_TMO], 1u); break; } }
    }
    nloc = mine > 0u ? mine : 1u; nx = cnt > 0u ? cnt : 1u;
}

__device__ __forceinline__ void xcd_barrier(const XcdBarrier& b) {
    asm volatile("s_waitcnt vmcnt(0)" ::: "memory");
    __syncthreads();
    if (tid_opq() == 0) {
        unsigned* bar = b.bar;
        __builtin_amdgcn_s_waitcnt(0);
        unsigned nloc = b.st[0], nx = b.st[1];
        if (nloc == 0u) { xcd_barrier_complete(bar, b.x, nloc, nx); b.st[0] = nloc; b.st[1] = nx; }
        const unsigned old = xb_add(&bar[XB_XSUB(b.x)], 1u);
        const unsigned gen = old / nloc;
        if (old + 1u == (gen + 1u) * nloc) {
            __builtin_amdgcn_fence(__ATOMIC_RELEASE, "agent");
            asm volatile("s_waitcnt vmcnt(0)" ::: "memory");
            const unsigned og = xb_add(&bar[XB_TOP], 1u);
            const unsigned tg = og / nx;
            if (og + 1u == (tg + 1u) * nx) xb_add(&bar[XB_TOPGEN], 1u);
            else XB_SPIN(xb_ld(&bar[XB_TOPGEN]) == tg, bar);
            __builtin_amdgcn_fence(__ATOMIC_ACQUIRE, "agent");
            xb_add(&bar[XB_XGEN(b.x)], 1u);
            asm volatile("s_waitcnt vmcnt(0)" ::: "memory");
        } else {
            XB_SPIN(xb_ld(&bar[XB_XGEN(b.x)]) == gen, bar);
            __builtin_amdgcn_fence(__ATOMIC_ACQUIRE, "agent");
            asm volatile("s_waitcnt vmcnt(0)" ::: "memory");
        }
    }
    __syncthreads();
}

constexpr int LDS_BYTES = 152 * 1024;

template <int S>
DEVI void run_stage(const P& p, char* smem, int bid, int nblk) {
    if (S == 0) stage_prologue(p, smem, bid, nblk);
    if (S == 1) { EpiInProj e{p}; gemm_pg8(p.XB, p.WINT, NT, NPAD_IN + 2048, 1024, e, smem, bid, nblk); }
    if (S == 2) { stage_mlstm_gates(p, smem, bid, nblk); stage_compress(p, smem, bid, nblk); }
    if (S == 3) { stage_mlstm_dc(p, smem, bid, nblk); stage_mlstm_sample(p, smem, bid, nblk); }
    if (S == 4) { stage_mlstm_scan(p, bid, nblk); stage_nsa_attn(p, smem, bid, nblk); }
    if (S == 5) stage_mlstm_out(p, smem, bid, nblk);
    if (S == 6) { EpiM1 e{p}; gemm_tail(p.YA, p.WAT, 1024, e, smem, bid, nblk); }
    if (S == 7) { EpiM2 e{p}; gemm_tail(p.YB, p.WBT, 1024, e, smem, bid, nblk); }
    if (S == 8) { EpiR e{p}; gemm_tail(p.MERGED, p.WOT, 1024, e, smem, bid, nblk); }
    if (S == 9) stage_ln1(p, bid, nblk);
    if (S == 10) { EpiPQ e{p}; gemm_tail(p.HB, p.WQT, 2048, e, smem, bid, nblk); }
    if (S == 11) stage_peer_route(p, smem, bid, nblk);
    if (S == 12) stage_peer_apply(p, smem, bid, nblk);
}
constexpr int NSTAGES = 13;

template <int S>
__global__ void __launch_bounds__(512, 2) k_stage(P p) {
    extern __shared__ __attribute__((aligned(16))) char smem[];
    run_stage<S>(p, smem, blockIdx.x, gridDim.x);
}


#if MK_ONE_LAUNCH
__global__ void __launch_bounds__(512, 2) k_mega(P p) {
    extern __shared__ __attribute__((aligned(16))) char smem_all[];
    if (tid_opq() == 0) *(u32x4*)smem_all = (u32x4){0u, 0u, 0u, 0u};
    __syncthreads();
    XcdBarrier bar = xcd_barrier_post(p.bar, (volatile LAS unsigned*)smem_all);
    char* smem = smem_all + 16;
    const int bid = blockIdx.x, nblk = gridDim.x;
    run_stage<0>(p, smem, bid, nblk); if ((REP_MASK >> 0) & 1) { xcd_barrier(bar); run_stage<0>(p, smem, bid, nblk); }  xcd_barrier(bar);
    run_stage<1>(p, smem, bid, nblk); if ((REP_MASK >> 1) & 1) { xcd_barrier(bar); run_stage<1>(p, smem, bid, nblk); }  xcd_barrier(bar);
    run_stage<2>(p, smem, bid, nblk); if ((REP_MASK >> 2) & 1) { xcd_barrier(bar); run_stage<2>(p, smem, bid, nblk); }  xcd_barrier(bar);
    run_stage<3>(p, smem, bid, nblk); if ((REP_MASK >> 3) & 1) { xcd_barrier(bar); run_stage<3>(p, smem, bid, nblk); }  xcd_barrier(bar);
    run_stage<4>(p, smem, bid, nblk); if ((REP_MASK >> 4) & 1) { xcd_barrier(bar); run_stage<4>(p, smem, bid, nblk); }  xcd_barrier(bar);
    run_stage<5>(p, smem, bid, nblk); if ((REP_MASK >> 5) & 1) { xcd_barrier(bar); run_stage<5>(p, smem, bid, nblk); }  xcd_barrier(bar);
    run_stage<6>(p, smem, bid, nblk); if ((REP_MASK >> 6) & 1) { xcd_barrier(bar); run_stage<6>(p, smem, bid, nblk); }  xcd_barrier(bar);
    run_stage<7>(p, smem, bid, nblk); if ((REP_MASK >> 7) & 1) { xcd_barrier(bar); run_stage<7>(p, smem, bid, nblk); }  xcd_barrier(bar);
    run_stage<8>(p, smem, bid, nblk); if ((REP_MASK >> 8) & 1) { xcd_barrier(bar); run_stage<8>(p, smem, bid, nblk); }  xcd_barrier(bar);
    run_stage<9>(p, smem, bid, nblk); if ((REP_MASK >> 9) & 1) { xcd_barrier(bar); run_stage<9>(p, smem, bid, nblk); }  xcd_barrier(bar);
    run_stage<10>(p, smem, bid, nblk); if ((REP_MASK >> 10) & 1) { xcd_barrier(bar); run_stage<10>(p, smem, bid, nblk); } xcd_barrier(bar);
    run_stage<11>(p, smem, bid, nblk); if ((REP_MASK >> 11) & 1) { xcd_barrier(bar); run_stage<11>(p, smem, bid, nblk); } xcd_barrier(bar);
    run_stage<12>(p, smem, bid, nblk); if ((REP_MASK >> 12) & 1) { xcd_barrier(bar); run_stage<12>(p, smem, bid, nblk); }
}
#endif

template <int S> static void launch_stage(const P& p, int grid, hipStream_t stream) {
    (void)hipFuncSetAttribute((const void*)k_stage<S>, hipFuncAttributeMaxDynamicSharedMemorySize, LDS_BYTES);
    k_stage<S><<<dim3(grid), dim3(512), LDS_BYTES, stream>>>(p);
}

extern "C" void kernel_launch(void* const* d_in, const int* in_sizes, int n_in, void* d_out, int out_size, void* d_ws, size_t ws_size, hipStream_t stream) {
    (void)in_sizes; (void)n_in; (void)out_size; (void)ws_size;
    P p{};
    p.xp = (const float*)d_in[0]; p.xs = (const float*)d_in[1]; p.cache_cmp = (const float*)d_in[2]; p.cache_slc = (const float*)d_in[3];
    p.cache_win = (const float*)d_in[4]; p.state_C = (const float*)d_in[5]; p.state_n = (const float*)d_in[6]; p.state_m = (const float*)d_in[7];
    p.page_table = (const int*)d_in[8];
    p.w_in = (const float*)d_in[9]; p.b_in = (const float*)d_in[10]; p.norm_a_g = (const float*)d_in[11]; p.nsa_pe = (const float*)d_in[12];
    p.nsa_w_cmp = (const float*)d_in[13]; p.w_br_a = (const float*)d_in[14]; p.w_br_b = (const float*)d_in[15]; p.w_merge = (const float*)d_in[16];
    p.w_out = (const float*)d_in[17]; p.ln1_g = (const float*)d_in[18]; p.ln1_b = (const float*)d_in[19];
    p.peer_wq = (const float*)d_in[20]; p.peer_keys = (const float*)d_in[21]; p.peer_u = (const float*)d_in[22]; p.peer_v = (const float*)d_in[23];
    p.ln2_g = (const float*)d_in[24]; p.ln2_b = (const float*)d_in[25];
    p.out = (float*)d_out;
    char* w = (char*)d_ws; size_t off = 0;
    auto take = [&](size_t bytes) { char* r = w + off; off += (bytes + 255) & ~(size_t)255; return r; };
    p.bar = (unsigned*)take(16384);
    p.PW = (float*)(p.bar + 3584);
    p.WCT = (bf16_t*)take((size_t)2 * 64 * 4096 * 2);
    p.XB = (bf16_t*)take((size_t)NT * 1024 * 2);
    p.WINT = (bf16_t*)take((size_t)(NPAD_IN + 2048) * 1024 * 2);
    p.WMT = (bf16_t*)take((size_t)2048 * 1024 * 2);
    p.WAT = (bf16_t*)take((size_t)1024 * 1024 * 2);
    p.WBT = (bf16_t*)take((size_t)1024 * 1024 * 2);
    p.WOT = (bf16_t*)take((size_t)1024 * 1024 * 2);
    p.WQT = (bf16_t*)take((size_t)2048 * 1024 * 2);
    p.KEYSB = (bf16_t*)take((size_t)16 * 128 * 128 * 2);
    p.U8 = (unsigned char*)take((size_t)16384 * 1024);
    p.V8 = (unsigned char*)take((size_t)16384 * 1024);
    p.US = (float*)take(16384 * 4);
    p.VS = (float*)take(16384 * 4);
    p.PROJ = (bf16_t*)take((size_t)NT * PS * 2);
    p.SM = (float*)take((size_t)NT * 64 * 4);
    p.BCUM = (float*)take((size_t)16 * 4096 * 4);
    p.MPREV = (float*)take(4096); p.ACOEF = (float*)take(4096); p.SCL = (float*)take(4096); p.MLOC = (float*)take(4096);
    p.DC = (float*)take((size_t)1024 * 272 * 128 * 4);
    p.CPT = (bf16_t*)take((size_t)1024 * 272 * 128 * 2);
    p.KC = (float*)take((size_t)4352 * 512 * 4);
    p.VC = p.KC + 256;
    p.OCMP = (float*)take((size_t)NT * 1024 * 4);
    p.SEL = (unsigned long long*)take((size_t)NT * 4 * 8);
    p.YA = (bf16_t*)take((size_t)NT * 1024 * 2);
    p.YB = (bf16_t*)take((size_t)NT * 1024 * 2);
    p.G = (bf16_t*)take((size_t)NT * 2048 * 2);
    p.TMPB = (bf16_t*)take((size_t)NT * 1024 * 2);
    p.MERGED = (bf16_t*)take((size_t)NT * 1024 * 2);
    p.R = (float*)take((size_t)NT * 1024 * 4);
    p.H = (float*)take((size_t)NT * 1024 * 4);
    p.HB = (bf16_t*)take((size_t)NT * 1024 * 2);
    p.PQ = (bf16_t*)take((size_t)NT * 2048 * 2);
    p.EIDX = (int*)take((size_t)NT * 128 * 4);
    p.EGATE = (float*)take((size_t)NT * 128 * 4);

    (void)hipMemsetAsync(p.bar, 0, 16384, stream);
#if MK_ONE_LAUNCH
    {
        constexpr size_t kDynLds = LDS_BYTES + 16;
        (void)hipFuncSetAttribute((const void*)k_mega, hipFuncAttributeMaxDynamicSharedMemorySize, (int)kDynLds);
        int dev = 0, cus = 0, per_cu = 0;
        (void)hipGetDevice(&dev);
        (void)hipDeviceGetAttribute(&cus, hipDeviceAttributeMultiprocessorCount, dev);
        (void)hipOccupancyMaxActiveBlocksPerMultiprocessor(&per_cu, (const void*)k_mega, 512, kDynLds);
        if (per_cu < 1 || cus < 1) return;
        const int grid = cus;
        k_mega<<<dim3(grid), dim3(512), kDynLds, stream>>>(p);
    }
#else
    const int grid = 512;
    launch_stage<0>(p, grid, stream);
    launch_stage<1>(p, grid, stream);
    launch_stage<2>(p, grid, stream);
    launch_stage<3>(p, grid, stream);
    launch_stage<4>(p, grid, stream);
    launch_stage<5>(p, grid, stream);
    launch_stage<6>(p, grid, stream);
    launch_stage<7>(p, grid, stream);
    launch_stage<8>(p, grid, stream);
    launch_stage<9>(p, grid, stream);
    launch_stage<10>(p, grid, stream);
    launch_stage<11>(p, grid, stream);
    launch_stage<12>(p, grid, stream);
#endif
}
```

```cpp
#include <hip/hip_runtime.h>
#include <stdint.h>

#ifndef REP_MASK
#define REP_MASK 0
#endif
#ifndef MK_ONE_LAUNCH
#define MK_ONE_LAUNCH 1
#endif

typedef unsigned short bf16_t;
typedef short bf16x8 __attribute__((ext_vector_type(8)));
typedef float f32x4 __attribute__((ext_vector_type(4)));
typedef unsigned u32x4 __attribute__((ext_vector_type(4)));
typedef unsigned u32x2 __attribute__((ext_vector_type(2)));
typedef float f32x2 __attribute__((ext_vector_type(2)));
typedef __bf16 bf16x2_t __attribute__((ext_vector_type(2)));
#define DEVI __device__ __forceinline__
__device__ __forceinline__ int tid_opq() { int t = threadIdx.x; asm volatile("" : "+v"(t)); return t; }

constexpr int NTP = 16384, NTS = 512, NT = NTP + NTS, DM = 1024;
constexpr int PS = 5632;
constexpr int C_AQ = 0, C_AK = 512, C_AV = 1024, C_AO = 2048, C_BQ = 3072, C_CMP = 4096, C_SLC = 4608, C_WIN = 5120;
constexpr int NPAD_IN = 5888;
constexpr float DN_ALPHA = 1.189207115002721f;
constexpr float LN_EPS = 1e-5f;
constexpr size_t O_Y = 0;
constexpr size_t O_PCMP = O_Y + (size_t)NT * 1024;
constexpr size_t O_PSLC = O_PCMP + (size_t)NTP * 512;
constexpr size_t O_PWIN = O_PSLC + (size_t)NTP * 512;
constexpr size_t O_PC = O_PWIN + (size_t)4 * 512 * 512;
constexpr size_t O_PN = O_PC + (size_t)16 * 128 * 256;
constexpr size_t O_PM = O_PN + 16 * 128;
constexpr size_t O_SCMP = O_PM + 16;
constexpr size_t O_SSLC = O_SCMP + (size_t)NTS * 512;
constexpr size_t O_SWIN = O_SSLC + (size_t)NTS * 512;
constexpr size_t O_SC = O_SWIN + (size_t)128 * 512 * 512;
constexpr size_t O_SN = O_SC + (size_t)512 * 128 * 256;
constexpr size_t O_SM = O_SN + 512 * 128;

struct P {
    const float *xp, *xs, *cache_cmp, *cache_slc, *cache_win, *state_C, *state_n, *state_m;
    const int* page_table;
    const float *w_in, *b_in, *norm_a_g, *nsa_pe, *nsa_w_cmp, *w_br_a, *w_br_b, *w_merge, *w_out, *ln1_g, *ln1_b;
    const float *peer_wq, *peer_keys, *peer_u, *peer_v, *ln2_g, *ln2_b;
    float* out;
    bf16_t *XB, *WINT, *WMT, *WAT, *WBT, *WOT, *WQT, *KEYSB, *UB, *VB, *PROJ, *WCT;
    float* PW;
    float *SM, *BCUM, *MPREV, *ACOEF, *SCL, *MLOC, *DC, *KC, *VC, *OCMP;
    bf16_t* CPT;
    unsigned char *U8, *V8;
    float *US, *VS;
    unsigned long long* SEL;
    bf16_t *YA, *YB, *G, *MERGED, *HB, *PQ;
    float *R, *H, *EGATE;
    bf16_t* TMPB;
    int* EIDX;
    unsigned* bar;
};

DEVI bf16_t f2bf(float f) { return __builtin_bit_cast(unsigned short, (__bf16)f); }
DEVI float bf2f(bf16_t h) { return __uint_as_float(((unsigned)h) << 16); }
DEVI unsigned pack2(float a, float b) { return __builtin_bit_cast(unsigned, __builtin_convertvector((f32x2){a, b}, bf16x2_t)); }
DEVI u32x4 pack8f(const f32x4 a, const f32x4 b) { u32x4 r; r[0] = pack2(a[0], a[1]); r[1] = pack2(a[2], a[3]); r[2] = pack2(b[0], b[1]); r[3] = pack2(b[2], b[3]); return r; }
DEVI float wave_max(float v) { for (int o = 32; o > 0; o >>= 1) v = fmaxf(v, __shfl_xor(v, o)); return v; }
DEVI float wave_sum(float v) { for (int o = 32; o > 0; o >>= 1) v += __shfl_xor(v, o); return v; }
DEVI float sigmoidf_(float x) { return 1.f / (1.f + __expf(-x)); }
DEVI float logsigmoidf_(float x) { return fminf(x, 0.f) - log1pf(__expf(-fabsf(x))); }
DEVI int win_map(int np) {
    if (np < 2048) return np;
    if (np < 5632) return np + 8;
    if (np < 5640) return np - 5632 + 2048;
    if (np < 5688) return np;
    return -1;
}
DEVI float alibi_slope(int h) { return exp2f(-0.5f * (float)(h + 1)); }

template <class MapFn>
DEVI void transpose_cvt(const float* __restrict__ W, bf16_t* __restrict__ WT, int K, int Nsrc, int Ndst, MapFn mapfn, float* tile  , int bid, int nblk) {
    const int tid = tid_opq();
    const int tn = Ndst / 64, tk = K / 64;
    for (int t = bid; t < tn * tk; t += nblk) {
        const int n0 = (t % tn) * 64, k0 = (t / tn) * 64;
        __syncthreads();
#pragma unroll
        for (int i = 0; i < 8; ++i) {
            const int kk = (tid >> 6) + i * 8, nn = tid & 63;
            const int n = mapfn(n0 + nn);
            tile[kk * 65 + nn] = n >= 0 ? W[(size_t)(k0 + kk) * Nsrc + n] : 0.f;
        }
        __syncthreads();
#pragma unroll
        for (int i = 0; i < 8; ++i) {
            const int nn = (tid >> 6) + i * 8, kk = tid & 63;
            WT[(size_t)(n0 + nn) * K + k0 + kk] = f2bf(tile[kk * 65 + nn]);
        }
    }
}
struct IdMap { DEVI int operator()(int n) const { return n; } };
struct WinMap { DEVI int operator()(int n) const { return win_map(n); } };

DEVI void cvt_rows(const float* __restrict__ src, bf16_t* __restrict__ dst, size_t n4, int bid, int nblk) {
    for (size_t i = (size_t)bid * blockDim.x + tid_opq(); i < n4; i += (size_t)nblk * blockDim.x) {
        const f32x4 v = ((const f32x4*)src)[i];
        u32x2 o; o.x = pack2(v.x, v.y); o.y = pack2(v.z, v.w);
        ((u32x2*)dst)[i] = o;
    }
}

DEVI void stage_prologue(const P& p, char* smem, int bid, int nblk) {
    float* tile = (float*)smem;
    cvt_rows(p.xp, p.XB, (size_t)NTP * 256, bid, nblk);
    cvt_rows(p.xs, p.XB + (size_t)NTP * 1024, (size_t)NTS * 256, bid, nblk);
    {
        const int lane = tid_opq() & 63, wid = tid_opq() >> 6;
        for (int r = bid * 8 + wid; r < 2 * 16384; r += nblk * 8) {
            const bool isv = r >= 16384; const int e = isv ? r - 16384 : r;
            const float* src = (isv ? p.peer_v : p.peer_u) + (size_t)e * 1024 + lane * 16;
            f32x4 x[4]; float am = 0.f;
#pragma unroll
            for (int i = 0; i < 4; ++i) { x[i] = *(const f32x4*)(src + i * 4);
#pragma unroll
                for (int k = 0; k < 4; ++k) am = fmaxf(am, fabsf(x[i][k])); }
            am = wave_max(am);
            const float inv = am > 0.f ? 448.f / am : 1.f;
            u32x4 o;
#pragma unroll
            for (int i = 0; i < 4; ++i) { int w = __builtin_amdgcn_cvt_pk_fp8_f32(x[i][0] * inv, x[i][1] * inv, 0, false); w = __builtin_amdgcn_cvt_pk_fp8_f32(x[i][2] * inv, x[i][3] * inv, w, true); o[i] = (unsigned)w; }
            *(u32x4*)((isv ? p.V8 : p.U8) + (size_t)e * 1024 + lane * 16) = o;
            if (lane == 0) (isv ? p.VS : p.US)[e] = am > 0.f ? am / 448.f : 1.f;
        }
    }
    cvt_rows(p.peer_keys, p.KEYSB, (size_t)16 * 128 * 128 / 4, bid, nblk);
    transpose_cvt(p.w_in, p.WINT, 1024, 5688, NPAD_IN, WinMap(), tile, bid, nblk);
    transpose_cvt(p.w_merge, p.WINT + (size_t)NPAD_IN * 1024, 1024, 2048, 2048, IdMap(), tile, bid, nblk);
    transpose_cvt(p.w_br_a, p.WAT, 1024, 1024, 1024, IdMap(), tile, bid, nblk);
    transpose_cvt(p.w_br_b, p.WBT, 1024, 1024, 1024, IdMap(), tile, bid, nblk);
    transpose_cvt(p.w_out, p.WOT, 1024, 1024, 1024, IdMap(), tile, bid, nblk);
    transpose_cvt(p.peer_wq, p.WQT, 1024, 2048, 2048, IdMap(), tile, bid, nblk);
    transpose_cvt(p.nsa_w_cmp, p.WCT, 4096, 64, 64, IdMap(), tile, bid, nblk);
    transpose_cvt(p.nsa_w_cmp + 4096 * 64, p.WCT + 64 * 4096, 4096, 64, 64, IdMap(), tile, bid, nblk);
    for (int blk = bid; blk < 32; blk += nblk) {
        const int tid = tid_opq(), kvv = tid >> 8, e = tid & 63, kq = (tid >> 6) & 3;
        float a = 0.f;
        for (int k = blk * 128 + kq * 32; k < blk * 128 + kq * 32 + 32; ++k) a += p.nsa_pe[kvv * 4096 + k] * p.nsa_w_cmp[((size_t)kvv * 4096 + k) * 64 + e];
        atomicAdd(p.PW + kvv * 64 + e, a);
    }
    {
        const size_t per_b = (size_t)508 * 512 / 4;
        for (size_t i = (size_t)bid * blockDim.x + tid_opq(); i < 128 * per_b; i += (size_t)nblk * blockDim.x) {
            const size_t b = i / per_b, r = i % per_b;
            ((f32x4*)(p.out + O_SWIN + b * 512 * 512))[r] = ((const f32x4*)(p.cache_win + b * 512 * 512 + 4 * 512))[r];
        }
    }
}

template <class Epi>
DEVI void gemm_phase(const bf16_t* __restrict__ A, const bf16_t* __restrict__ Bt, int M, int N, int K, const Epi& epi, char* smem, int bid, int nblk) {
    bf16_t* As = (bf16_t*)smem;
    bf16_t* Bs = As + 256 * 72;
    const int tid = tid_opq(), lane = tid & 63, wid = tid >> 6, wm = wid >> 1, wn = wid & 1;
    const int fr = lane & 15, fq = lane >> 4;
    const int ntm = M / 256, ntn = N / 128, nk = K / 64;
    for (int tile = bid; tile < ntm * ntn; tile += nblk) {
        const int tm = tile / ntn, tn = tile % ntn;
        f32x4 acc[4][4];
#pragma unroll
        for (int i = 0; i < 4; ++i)
#pragma unroll
            for (int j = 0; j < 4; ++j) acc[i][j] = (f32x4){0.f, 0.f, 0.f, 0.f};
        const bf16_t* Ag = A + (size_t)(tm * 256 + (tid >> 1)) * K + (tid & 1) * 32;
        const bf16_t* Bg = Bt + (size_t)(tn * 128 + (tid >> 2)) * K + (tid & 3) * 16;
        u32x4 ra[4], rb[2];
#pragma unroll
        for (int i = 0; i < 4; ++i) ra[i] = *(const u32x4*)(Ag + i * 8);
#pragma unroll
        for (int i = 0; i < 2; ++i) rb[i] = *(const u32x4*)(Bg + i * 8);
        for (int kt = 0; kt < nk; ++kt) {
            __syncthreads();
#pragma unroll
            for (int i = 0; i < 4; ++i) *(u32x4*)(As + (tid >> 1) * 72 + (tid & 1) * 32 + i * 8) = ra[i];
#pragma unroll
            for (int i = 0; i < 2; ++i) *(u32x4*)(Bs + (tid >> 2) * 72 + (tid & 3) * 16 + i * 8) = rb[i];
            __syncthreads();
            if (kt + 1 < nk) {
#pragma unroll
                for (int i = 0; i < 4; ++i) ra[i] = *(const u32x4*)(Ag + (kt + 1) * 64 + i * 8);
#pragma unroll
                for (int i = 0; i < 2; ++i) rb[i] = *(const u32x4*)(Bg + (kt + 1) * 64 + i * 8);
            }
#pragma unroll
            for (int ks = 0; ks < 2; ++ks) {
                bf16x8 af[4], bfr[4];
#pragma unroll
                for (int i = 0; i < 4; ++i) af[i] = *(const bf16x8*)(As + (wm * 64 + i * 16 + fr) * 72 + ks * 32 + fq * 8);
#pragma unroll
                for (int j = 0; j < 4; ++j) bfr[j] = *(const bf16x8*)(Bs + (wn * 64 + j * 16 + fr) * 72 + ks * 32 + fq * 8);
#pragma unroll
                for (int i = 0; i < 4; ++i)
#pragma unroll
                    for (int j = 0; j < 4; ++j) acc[i][j] = __builtin_amdgcn_mfma_f32_16x16x32_bf16(bfr[j], af[i], acc[i][j], 0, 0, 0);
            }
        }
#pragma unroll
        for (int i = 0; i < 4; ++i)
#pragma unroll
            for (int j = 0; j < 4; ++j) epi(tm * 256 + wm * 64 + i * 16 + fr, tn * 128 + wn * 64 + j * 16 + fq * 4, acc[i][j]);
    }
}

struct NoPre {};
DEVI f32x4 bf4_lo(const u32x4& g) { return (f32x4){__uint_as_float(g[0] << 16), __uint_as_float(g[0] & 0xFFFF0000u), __uint_as_float(g[1] << 16), __uint_as_float(g[1] & 0xFFFF0000u)}; }
DEVI f32x4 bf4_hi(const u32x4& g) { return (f32x4){__uint_as_float(g[2] << 16), __uint_as_float(g[2] & 0xFFFF0000u), __uint_as_float(g[3] << 16), __uint_as_float(g[3] & 0xFFFF0000u)}; }
struct EpiInProj {
    P p;
    typedef NoPre Pre;
    static constexpr int BATCH = 4;
    static constexpr bool COLBIAS = true;
    DEVI void bias8(int col, f32x4& b0, f32x4& b1) const {
        b0 = (f32x4){0.f, 0.f, 0.f, 0.f}; b1 = b0;
        if (col < 5688) { const int oc = win_map(col);
#pragma unroll
            for (int q = 0; q < 4; ++q) { b0[q] = p.b_in[oc + q]; b1[q] = p.b_in[oc + 4 + q]; } }
    }
    DEVI Pre pre(int, int) const { return NoPre(); }
    DEVI void put(int row, int col, f32x4 v0, f32x4 v1, const Pre&) const {
        if (col >= NPAD_IN) {
#pragma unroll
            for (int k = 0; k < 4; ++k) { v0[k] = sigmoidf_(v0[k]); v1[k] = sigmoidf_(v1[k]); }
            *(u32x4*)(p.G + (size_t)row * 2048 + (col - NPAD_IN)) = pack8f(v0, v1);
            return;
        }
        if (col >= 5688) return;
        if (col >= 5632) { *(f32x4*)(p.SM + (size_t)row * 64 + (col - 5632)) = v0; *(f32x4*)(p.SM + (size_t)row * 64 + (col - 5632) + 4) = v1; return; }
        if (col >= C_AK && col < C_AV) { v0 *= 0.08838834764831845f; v1 *= 0.08838834764831845f; }
        *(u32x4*)(p.PROJ + (size_t)row * PS + col) = pack8f(v0, v1);
        if (col >= C_CMP) {
            const int reg = (col - C_CMP) >> 9, c = (col - C_CMP) & 511;
            float* dst = nullptr;
            if (row < NTP) {
                if (reg == 0) dst = p.out + O_PCMP + (size_t)row * 512 + c;
                else if (reg == 1) dst = p.out + O_PSLC + (size_t)row * 512 + c;
                else { const int b = row >> 12, t = row & 4095; if (t >= 3584) dst = p.out + O_PWIN + ((size_t)b * 512 + (t - 3584)) * 512 + c; }
            } else {
                const int rs = row - NTP;
                if (reg == 0) dst = p.out + O_SCMP + (size_t)rs * 512 + c;
                else if (reg == 1) dst = p.out + O_SSLC + (size_t)rs * 512 + c;
                else { const int b = rs >> 2, tq = rs & 3; dst = p.out + O_SWIN + ((size_t)b * 512 + 508 + tq) * 512 + c; }
            }
            if (dst) { *(f32x4*)dst = v0; *(f32x4*)(dst + 4) = v1; }
        }
    }
};
struct EpiG {
    P p;
    typedef NoPre Pre;
    static constexpr int BATCH = 4;
    static constexpr bool COLBIAS = false;
    DEVI Pre pre(int, int) const { return NoPre(); }
    DEVI void put(int row, int col, f32x4 v0, f32x4 v1, const Pre&) const {
#pragma unroll
        for (int k = 0; k < 4; ++k) { v0[k] = sigmoidf_(v0[k]); v1[k] = sigmoidf_(v1[k]); }
        *(u32x4*)(p.G + (size_t)row * 2048 + col) = pack8f(v0, v1);
    }
};
struct EpiM1 {
    P p;
    typedef u32x4 Pre;
    static constexpr int BATCH = 8;
    static constexpr bool COLBIAS = false;
    DEVI Pre pre(int row, int col) const { return *(const u32x4*)(p.G + (size_t)row * 2048 + 1024 + col); }
    DEVI void put(int row, int col, f32x4 v0, f32x4 v1, const Pre& g) const {
        *(u32x4*)(p.TMPB + (size_t)row * 1024 + col) = pack8f(v0 * bf4_lo(g), v1 * bf4_hi(g));
    }
};
struct PreM2 { u32x4 g; u32x4 t; };
struct EpiM2 {
    P p;
    typedef PreM2 Pre;
    static constexpr int BATCH = 8;
    static constexpr bool COLBIAS = false;
    DEVI Pre pre(int row, int col) const { PreM2 r; r.g = *(const u32x4*)(p.G + (size_t)row * 2048 + col); r.t = *(const u32x4*)(p.TMPB + (size_t)row * 1024 + col); return r; }
    DEVI void put(int row, int col, f32x4 v0, f32x4 v1, const Pre& q) const {
        *(u32x4*)(p.MERGED + (size_t)row * 1024 + col) = pack8f(bf4_lo(q.t) + v0 * bf4_lo(q.g), bf4_hi(q.t) + v1 * bf4_hi(q.g));
    }
};
struct PreR { f32x4 a, b; };
struct EpiR {
    P p;
    typedef PreR Pre;
    static constexpr int BATCH = 8;
    static constexpr bool COLBIAS = false;
    DEVI Pre pre(int row, int col) const {
        const float* xr = row < NTP ? p.xp + (size_t)row * 1024 : p.xs + (size_t)(row - NTP) * 1024;
        PreR r; r.a = *(const f32x4*)(xr + col); r.b = *(const f32x4*)(xr + col + 4); return r;
    }
    DEVI void put(int row, int col, f32x4 v0, f32x4 v1, const Pre& x) const {
        *(f32x4*)(p.R + (size_t)row * 1024 + col) = x.a * DN_ALPHA + v0; *(f32x4*)(p.R + (size_t)row * 1024 + col + 4) = x.b * DN_ALPHA + v1;
    }
};
struct EpiPQ {
    P p;
    typedef NoPre Pre;
    static constexpr int BATCH = 4;
    static constexpr bool COLBIAS = false;
    DEVI Pre pre(int, int) const { return NoPre(); }
    DEVI void put(int row, int col, f32x4 v0, f32x4 v1, const Pre&) const { *(u32x4*)(p.PQ + (size_t)row * 2048 + col) = pack8f(v0, v1); }
};

DEVI void stage_mlstm_gates(const P& p, char* smem, int bid, int nblk) {
    const int lane = tid_opq() & 63, wid = tid_opq() >> 6;
    float* bend_s = (float*)smem; float* mloc_s = bend_s + 64;
    for (int bh = bid; bh < 16; bh += nblk) {
        const int b = bh >> 2, h = bh & 3;
        __syncthreads();
        for (int cc = 0; cc < 8; ++cc) {
            const int c = wid * 8 + cc;
            const size_t row = (size_t)b * 4096 + c * 64 + lane;
            const float ip = p.SM[row * 64 + h];
            const float lf = logsigmoidf_(p.SM[row * 64 + 4 + h]);
            float cs = lf;
#pragma unroll
            for (int o = 1; o < 64; o <<= 1) { const float t = __shfl_up(cs, o); if (lane >= o) cs += t; }
            p.BCUM[bh * 4096 + c * 64 + lane] = cs;
            const float bend = __shfl(cs, 63);
            const float mloc = wave_max(bend - cs + ip);
            if (lane == 0) { bend_s[c] = bend; mloc_s[c] = mloc; }
        }
        __syncthreads();
        if (tid_opq() == 0) {
            float m = 0.f;
            for (int c = 0; c < 64; ++c) {
                const float bend = bend_s[c], mloc = mloc_s[c];
                const float mnew = fmaxf(bend + m, mloc);
                p.MPREV[bh * 64 + c] = m;
                p.ACOEF[bh * 64 + c] = __expf(bend + m - mnew);
                p.SCL[bh * 64 + c] = __expf(mloc - mnew);
                p.MLOC[bh * 64 + c] = mloc;
                m = mnew;
            }
            p.out[O_PM + bh] = m;
        }
    }
}

constexpr int MD_KT = 0, MD_VT = 128 * 144, MD_WS = MD_VT + 272 * 144, MD_LDS = MD_WS + 256;
DEVI void stage_mlstm_dc(const P& p, char* smem, int bid, int nblk) {
    const int tid = tid_opq(), lane = tid & 63, wid = tid >> 6, fr = lane & 15, fq = lane >> 4;
    bf16_t* Kt = (bf16_t*)(smem + MD_KT);
    bf16_t* Vt = (bf16_t*)(smem + MD_VT);
    float* ws = (float*)(smem + MD_WS);
    for (int task = bid; task < 1024; task += nblk) {
        const int bh = task >> 6, c = task & 63, b = bh >> 2, h = bh & 3;
        const size_t row0 = (size_t)b * 4096 + c * 64;
        __syncthreads();
        if (tid < 64) {
            const float ip = p.SM[(row0 + tid) * 64 + h];
            float cs = logsigmoidf_(p.SM[(row0 + tid) * 64 + 4 + h]);
#pragma unroll
            for (int o = 1; o < 64; o <<= 1) { const float t = __shfl_up(cs, o); if (tid >= o) cs += t; }
            const float g = __shfl(cs, 63) - cs + ip;
            ws[tid] = __expf(g - wave_max(g));
        }
        __syncthreads();
        {
            const int sidx = tid & 63, ch = tid >> 6;
            const float w = ws[sidx];
#pragma unroll
            for (int half = 0; half < 2; ++half) {
                const u32x4 kk = *(const u32x4*)(p.PROJ + (row0 + sidx) * PS + C_AK + h * 128 + half * 64 + ch * 8);
#pragma unroll
                for (int e = 0; e < 4; ++e) {
                    Kt[(half * 64 + ch * 8 + e * 2) * 72 + sidx] = f2bf(w * __uint_as_float(kk[e] << 16));
                    Kt[(half * 64 + ch * 8 + e * 2 + 1) * 72 + sidx] = f2bf(w * __uint_as_float(kk[e] & 0xFFFF0000u));
                }
            }
#pragma unroll
            for (int q4 = 0; q4 < 4; ++q4) {
                const u32x4 vv = *(const u32x4*)(p.PROJ + (row0 + sidx) * PS + C_AV + h * 256 + q4 * 64 + ch * 8);
#pragma unroll
                for (int e = 0; e < 4; ++e) {
                    Vt[(q4 * 64 + ch * 8 + e * 2) * 72 + sidx] = (bf16_t)(vv[e] & 0xFFFFu);
                    Vt[(q4 * 64 + ch * 8 + e * 2 + 1) * 72 + sidx] = (bf16_t)(vv[e] >> 16);
                }
            }
            for (int i = tid; i < 16 * 64; i += 512) Vt[(256 + (i >> 6)) * 72 + (i & 63)] = (i >> 6) == 0 ? (bf16_t)0x3F80 : (bf16_t)0;
        }
        __syncthreads();
        const int nvt = wid == 0 ? 3 : 2;
        for (int vi = 0; vi < nvt; ++vi) {
            const int vt = vi < 2 ? wid * 2 + vi : 16;
            f32x4 acc[8];
#pragma unroll
            for (int dt = 0; dt < 8; ++dt) acc[dt] = (f32x4){0.f, 0.f, 0.f, 0.f};
#pragma unroll
            for (int ks = 0; ks < 2; ++ks) {
                const bf16x8 bf = *(const bf16x8*)(Vt + (vt * 16 + fr) * 72 + ks * 32 + fq * 8);
#pragma unroll
                for (int dt = 0; dt < 8; ++dt) {
                    const bf16x8 af = *(const bf16x8*)(Kt + (dt * 16 + fr) * 72 + ks * 32 + fq * 8);
                    acc[dt] = __builtin_amdgcn_mfma_f32_16x16x32_bf16(af, bf, acc[dt], 0, 0, 0);
                }
            }
            const int v = vt * 16 + fr;
            if (v <= 256) {
#pragma unroll
                for (int dt = 0; dt < 8; ++dt) *(f32x4*)(p.DC + ((size_t)task * 272 + v) * 128 + dt * 16 + fq * 4) = acc[dt];
            }
        }
    }
}

DEVI void stage_mlstm_scan(const P& p, int bid, int nblk) {
    const int nthr = 512;
    for (int e = bid * nthr + tid_opq(); e < 16 * 257 * 32; e += nblk * nthr) {
        const int bh = e / (257 * 32), r = e % (257 * 32), v = r >> 5, d = (r & 31) * 4;
        f32x4 C = {0.f, 0.f, 0.f, 0.f};
        const float* ac = p.ACOEF + bh * 64; const float* sc = p.SCL + bh * 64;
        const size_t base = ((size_t)(bh * 64) * 272 + v) * 128 + d, cstride = (size_t)272 * 128;
#pragma unroll 1
        for (int c0 = 0; c0 < 64; c0 += 8) {
            f32x4 dc[8];
#pragma unroll
            for (int i = 0; i < 8; ++i) dc[i] = __builtin_nontemporal_load((const f32x4*)(p.DC + base + (size_t)(c0 + i) * cstride));
#pragma unroll
            for (int i = 0; i < 8; ++i) {
                u32x2 o; o.x = pack2(C[0], C[1]); o.y = pack2(C[2], C[3]);
                *(u32x2*)(p.CPT + base + (size_t)(c0 + i) * cstride) = o;
                C = C * ac[c0 + i] + dc[i] * sc[c0 + i];
            }
        }
        if (v < 256) {
#pragma unroll
            for (int k = 0; k < 4; ++k) p.out[O_PC + ((size_t)bh * 128 + d + k) * 256 + v] = C[k];
        } else *(f32x4*)(p.out + O_PN + bh * 128 + d) = C;
    }
}

constexpr int MO_Q = 0, MO_K = 64 * 272, MO_VT = MO_K + 64 * 272, MO_P = MO_VT + 272 * 144, MO_SC = MO_P + 64 * 144, MO_HS = MO_SC + 2048, MO_LDS = MO_HS + 64 * 256 * 4;
static_assert(MO_LDS <= 152 * 1024, "lds");
DEVI void stage_mlstm_out(const P& p, char* smem, int bid, int nblk) {
    const int tid = tid_opq(), lane = tid & 63, wid = tid >> 6, fr = lane & 15, fq = lane >> 4;
    bf16_t* Qs = (bf16_t*)(smem + MO_Q);
    bf16_t* Ks = (bf16_t*)(smem + MO_K);
    bf16_t* Vt = (bf16_t*)(smem + MO_VT);
    bf16_t* Ps = (bf16_t*)(smem + MO_P);
    float* sc = (float*)(smem + MO_SC);
    float* rowt = sc; float* colt = sc + 64; float* wint = sc + 128; float* emt = sc + 192; float* den = sc + 256;
    float* hs = (float*)(smem + MO_HS);
    for (int task = bid; task < 1024; task += nblk) {
        const int bh = task >> 6, c = task & 63, b = bh >> 2, h = bh & 3;
        const size_t row0 = (size_t)b * 4096 + c * 64;
        __syncthreads();
        {
            for (int i = tid; i < 64 * 16; i += 512) {
                const int t = i >> 4, ch = i & 15;
                *(u32x4*)(Qs + t * 136 + ch * 8) = *(const u32x4*)(p.PROJ + (row0 + t) * PS + C_AQ + h * 128 + ch * 8);
                *(u32x4*)(Ks + t * 136 + ch * 8) = *(const u32x4*)(p.PROJ + (row0 + t) * PS + C_AK + h * 128 + ch * 8);
            }
            const int sidx = tid & 63, ch = tid >> 6;
#pragma unroll
            for (int q4 = 0; q4 < 4; ++q4) {
                const u32x4 vv = *(const u32x4*)(p.PROJ + (row0 + sidx) * PS + C_AV + h * 256 + q4 * 64 + ch * 8);
#pragma unroll
                for (int e = 0; e < 4; ++e) {
                    Vt[(q4 * 64 + ch * 8 + e * 2) * 72 + sidx] = (bf16_t)(vv[e] & 0xFFFFu);
                    Vt[(q4 * 64 + ch * 8 + e * 2 + 1) * 72 + sidx] = (bf16_t)(vv[e] >> 16);
                }
            }
            for (int i = tid; i < 16 * 64; i += 512) Vt[(256 + (i >> 6)) * 72 + (i & 63)] = (i >> 6) == 0 ? (bf16_t)0x3F80 : (bf16_t)0;
            if (wid == 0) {
                const float bc = p.BCUM[bh * 4096 + c * 64 + lane], ip = p.SM[(row0 + lane) * 64 + h];
                const float mprev = p.MPREV[task];
                float pm = ip - bc;
#pragma unroll
                for (int o = 1; o < 64; o <<= 1) { const float t = __shfl_up(pm, o); if (lane >= o) pm = fmaxf(pm, t); }
                const float mt = fmaxf(bc + mprev, bc + pm);
                rowt[lane] = bc - mt; colt[lane] = ip - bc; wint[lane] = __expf(bc + mprev - mt); emt[lane] = __expf(-mt);
            }
        }
        __syncthreads();
        {
            const int tt = wid >> 1;
#pragma unroll
            for (int si = 0; si < 2; ++si) {
                const int st = (wid & 1) * 2 + si;
                f32x4 acc = (f32x4){0.f, 0.f, 0.f, 0.f};
                if (st <= tt) {
#pragma unroll
                    for (int ks = 0; ks < 4; ++ks) {
                        const bf16x8 af = *(const bf16x8*)(Qs + (tt * 16 + fr) * 136 + ks * 32 + fq * 8);
                        const bf16x8 bf = *(const bf16x8*)(Ks + (st * 16 + fr) * 136 + ks * 32 + fq * 8);
                        acc = __builtin_amdgcn_mfma_f32_16x16x32_bf16(af, bf, acc, 0, 0, 0);
                    }
                }
                const int s = st * 16 + fr; const float ct = colt[s];
#pragma unroll
                for (int r = 0; r < 4; ++r) {
                    const int t = tt * 16 + fq * 4 + r;
                    const float pv = (s <= t) ? acc[r] * __expf(rowt[t] + ct) : 0.f;
                    Ps[t * 72 + s] = f2bf(pv);
                }
            }
        }
        __syncthreads();
        {
            const bf16_t* cpt = p.CPT + (size_t)task * 272 * 128;
            f32x4 acc[4][2];
#pragma unroll
            for (int tt = 0; tt < 4; ++tt)
#pragma unroll
                for (int vi = 0; vi < 2; ++vi) acc[tt][vi] = (f32x4){0.f, 0.f, 0.f, 0.f};
            f32x4 accd = (f32x4){0.f, 0.f, 0.f, 0.f};
            bf16x8 cb[4][2], cd[4];
#pragma unroll
            for (int ks = 0; ks < 4; ++ks) {
#pragma unroll
                for (int vi = 0; vi < 2; ++vi) cb[ks][vi] = *(const bf16x8*)(cpt + (size_t)((wid * 2 + vi) * 16 + fr) * 128 + ks * 32 + fq * 8);
                cd[ks] = *(const bf16x8*)(cpt + (size_t)(256 + fr) * 128 + ks * 32 + fq * 8);
            }
#pragma unroll
            for (int ks = 0; ks < 4; ++ks) {
                bf16x8 af[4];
#pragma unroll
                for (int tt = 0; tt < 4; ++tt) af[tt] = *(const bf16x8*)(Qs + (tt * 16 + fr) * 136 + ks * 32 + fq * 8);
#pragma unroll
                for (int vi = 0; vi < 2; ++vi) {
#pragma unroll
                    for (int tt = 0; tt < 4; ++tt) acc[tt][vi] = __builtin_amdgcn_mfma_f32_16x16x32_bf16(af[tt], cb[ks][vi], acc[tt][vi], 0, 0, 0);
                }
                if (wid < 4) {
                    const bf16x8 a2 = *(const bf16x8*)(Qs + (wid * 16 + fr) * 136 + ks * 32 + fq * 8);
                    accd = __builtin_amdgcn_mfma_f32_16x16x32_bf16(a2, cd[ks], accd, 0, 0, 0);
                }
            }
#pragma unroll
            for (int tt = 0; tt < 4; ++tt) {
                const f32x4 wv = *(const f32x4*)(wint + tt * 16 + fq * 4);
#pragma unroll
                for (int vi = 0; vi < 2; ++vi) acc[tt][vi] *= wv;
            }
            if (wid < 4) accd *= *(const f32x4*)(wint + wid * 16 + fq * 4);
#pragma unroll
            for (int ks = 0; ks < 2; ++ks) {
                bf16x8 af[4];
#pragma unroll
                for (int tt = 0; tt < 4; ++tt) af[tt] = *(const bf16x8*)(Ps + (tt * 16 + fr) * 72 + ks * 32 + fq * 8);
#pragma unroll
                for (int vi = 0; vi < 2; ++vi) {
                    const bf16x8 bf = *(const bf16x8*)(Vt + ((wid * 2 + vi) * 16 + fr) * 72 + ks * 32 + fq * 8);
#pragma unroll
                    for (int tt = 0; tt < 4; ++tt) acc[tt][vi] = __builtin_amdgcn_mfma_f32_16x16x32_bf16(af[tt], bf, acc[tt][vi], 0, 0, 0);
                }
                if (wid < 4) {
                    const bf16x8 bf = *(const bf16x8*)(Vt + (256 + fr) * 72 + ks * 32 + fq * 8);
                    const bf16x8 a2 = *(const bf16x8*)(Ps + (wid * 16 + fr) * 72 + ks * 32 + fq * 8);
                    accd = __builtin_amdgcn_mfma_f32_16x16x32_bf16(a2, bf, accd, 0, 0, 0);
                }
            }
            if (wid < 4 && fr == 0) *(f32x4*)(den + wid * 16 + fq * 4) = accd;
            __syncthreads();
#pragma unroll
            for (int tt = 0; tt < 4; ++tt) {
                const f32x4 dv = *(const f32x4*)(den + tt * 16 + fq * 4), ev = *(const f32x4*)(emt + tt * 16 + fq * 4);
#pragma unroll
                for (int vi = 0; vi < 2; ++vi)
#pragma unroll
                    for (int r = 0; r < 4; ++r) hs[(tt * 16 + fq * 4 + r) * 256 + (wid * 2 + vi) * 16 + fr] = acc[tt][vi][r] / fmaxf(fabsf(dv[r]), ev[r]);
            }
        }
        __syncthreads();
        u32x2 ovs[8];
#pragma unroll
        for (int rr = 0; rr < 8; ++rr) ovs[rr] = *(const u32x2*)(p.PROJ + (row0 + wid * 8 + rr) * PS + C_AO + h * 256 + lane * 4);
        const f32x4 gg = *(const f32x4*)(p.norm_a_g + h * 256 + lane * 4);
#pragma unroll
        for (int rr = 0; rr < 8; ++rr) {
            const int t = wid * 8 + rr;
            const f32x4 x = *(const f32x4*)(hs + t * 256 + lane * 4);
            const float mean = wave_sum(x[0] + x[1] + x[2] + x[3]) * (1.f / 256.f);
            float q = 0.f;
#pragma unroll
            for (int k = 0; k < 4; ++k) q += (x[k] - mean) * (x[k] - mean);
            const float rs = rsqrtf(wave_sum(q) * (1.f / 256.f) + LN_EPS);
            const u32x2 ov = ovs[rr];
            const float o4[4] = {__uint_as_float(ov.x << 16), __uint_as_float(ov.x & 0xFFFF0000u), __uint_as_float(ov.y << 16), __uint_as_float(ov.y & 0xFFFF0000u)};
            float y[4];
#pragma unroll
            for (int k = 0; k < 4; ++k) y[k] = (x[k] - mean) * rs * gg[k] * sigmoidf_(o4[k]);
            u32x2 o2; o2.x = pack2(y[0], y[1]); o2.y = pack2(y[2], y[3]);
            *(u32x2*)(p.YA + (row0 + t) * 1024 + h * 256 + lane * 4) = o2;
        }
    }
}

DEVI void stage_mlstm_sample(const P& p, char* smem, int bid, int nblk) {
    float* qs = (float*)smem;
    float* ks = qs + 512;
    float* vs = ks + 512;
    float* part = vs + 1024;
    float* hs = part + 2048;
    float* sc = hs + 1024;
    float* bc = sc; float* ip = sc + 4; float* mt = sc + 8; float* wint = sc + 12; float* emt = sc + 16; float* ww = sc + 20; float* den = sc + 24;
    float* Pm = sc + 32;
    float* misc = sc + 48;
    const int tid = tid_opq(), lane = tid & 63, wid = tid >> 6;
    for (int task = bid; task < 512; task += nblk) {
        const int b = task >> 2, h = task & 3;
        const size_t row0 = (size_t)NTP + b * 4;
        __syncthreads();
        { const int t = tid >> 7, d = tid & 127;
          qs[tid] = bf2f(p.PROJ[(row0 + t) * PS + C_AQ + h * 128 + d]);
          ks[tid] = bf2f(p.PROJ[(row0 + t) * PS + C_AK + h * 128 + d]); }
        for (int idx = tid; idx < 1024; idx += 512) { const int t = idx >> 8, v = idx & 255; vs[idx] = bf2f(p.PROJ[(row0 + t) * PS + C_AV + h * 256 + v]); }
        if (tid == 0) {
            const float m0 = p.state_m[task];
            float cs = 0.f;
            for (int t = 0; t < 4; ++t) { cs += logsigmoidf_(p.SM[(row0 + t) * 64 + 4 + h]); bc[t] = cs; ip[t] = p.SM[(row0 + t) * 64 + h]; }
            for (int t = 0; t < 4; ++t) {
                float mx = bc[t] + m0;
                for (int s = 0; s <= t; ++s) mx = fmaxf(mx, bc[t] - bc[s] + ip[s]);
                mt[t] = mx; wint[t] = __expf(bc[t] + m0 - mx); emt[t] = __expf(-mx);
            }
            const float bend = bc[3];
            float mnew = bend + m0;
            for (int s = 0; s < 4; ++s) mnew = fmaxf(mnew, bend - bc[s] + ip[s]);
            misc[0] = __expf(bend + m0 - mnew);
            for (int s = 0; s < 4; ++s) ww[s] = __expf(bend - bc[s] + ip[s] - mnew);
            p.out[O_SM + task] = mnew;
        }
        __syncthreads();
        if (tid < 16) {
            const int t = tid >> 2, s = tid & 3;
            float a = 0.f;
            if (s <= t) { for (int d = 0; d < 128; ++d) a += qs[t * 128 + d] * ks[s * 128 + d]; a *= __expf(bc[t] - bc[s] + ip[s] - mt[t]); }
            Pm[tid] = a;
        }
        __syncthreads();
        if (tid < 4) {
            const int t = tid; float qn = 0.f;
            for (int d = 0; d < 128; ++d) qn += qs[t * 128 + d] * p.state_n[(size_t)task * 128 + d];
            den[t] = wint[t] * qn + Pm[t * 4] + Pm[t * 4 + 1] + Pm[t * 4 + 2] + Pm[t * 4 + 3];
        }
        const float a = misc[0];
        if (tid >= 128 && tid < 256) {
            const int d = tid - 128;
            float n = a * p.state_n[(size_t)task * 128 + d];
            for (int s = 0; s < 4; ++s) n += ww[s] * ks[s * 128 + d];
            p.out[O_SN + (size_t)task * 128 + d] = n;
        }
        {
            const int v = tid & 255, dh = tid >> 8;
            float acc[4] = {0.f, 0.f, 0.f, 0.f};
            float wv[4];
#pragma unroll
            for (int s = 0; s < 4; ++s) wv[s] = ww[s] * vs[s * 256 + v];
            for (int d0 = dh * 64; d0 < dh * 64 + 64; d0 += 16) {
                float c0[16];
#pragma unroll
                for (int i = 0; i < 16; ++i) c0[i] = __builtin_nontemporal_load(p.state_C + ((size_t)task * 128 + d0 + i) * 256 + v);
#pragma unroll
                for (int i = 0; i < 16; ++i) {
                    const int d = d0 + i;
#pragma unroll
                    for (int t = 0; t < 4; ++t) acc[t] += qs[t * 128 + d] * c0[i];
                    float cn = a * c0[i];
#pragma unroll
                    for (int s = 0; s < 4; ++s) cn += ks[s * 128 + d] * wv[s];
                    __builtin_nontemporal_store(cn, p.out + O_SC + ((size_t)task * 128 + d) * 256 + v);
                }
            }
#pragma unroll
            for (int t = 0; t < 4; ++t) part[(dh * 4 + t) * 256 + v] = acc[t];
        }
        __syncthreads();
        if (tid < 256) {
            const int v = tid;
#pragma unroll
            for (int t = 0; t < 4; ++t) {
                float num = wint[t] * (part[t * 256 + v] + part[(4 + t) * 256 + v]);
#pragma unroll
                for (int s = 0; s < 4; ++s) num += Pm[t * 4 + s] * vs[s * 256 + v];
                hs[t * 256 + v] = num / fmaxf(fabsf(den[t]), emt[t]);
            }
        }
        __syncthreads();
        if (wid < 4) {
            const int t = wid;
            const f32x4 x = *(const f32x4*)(hs + t * 256 + lane * 4);
            const float mean = wave_sum(x[0] + x[1] + x[2] + x[3]) * (1.f / 256.f);
            float q = 0.f;
#pragma unroll
            for (int k = 0; k < 4; ++k) q += (x[k] - mean) * (x[k] - mean);
            const float rs = rsqrtf(wave_sum(q) * (1.f / 256.f) + LN_EPS);
            float y[4];
#pragma unroll
            for (int k = 0; k < 4; ++k) {
                const int vi = lane * 4 + k;
                const float o = bf2f(p.PROJ[(row0 + t) * PS + C_AO + h * 256 + vi]);
                y[k] = (x[k] - mean) * rs * p.norm_a_g[h * 256 + vi] * sigmoidf_(o);
            }
            u32x2 o2; o2.x = pack2(y[0], y[1]); o2.y = pack2(y[2], y[3]);
            *(u32x2*)(p.YA + (row0 + t) * 1024 + h * 256 + lane * 4) = o2;
        }
    }
}

constexpr int CP_ABUF = 33280, CP_WBUF = 18432, CP_A = 0, CP_W = 2 * CP_ABUF, CP_LDS = CP_W + 2 * CP_WBUF;
constexpr int CP_AROW = 1024 + 8;
DEVI void stage_compress(const P& p, char* smem, int bid, int nblk) {
    const int tid = tid_opq(), lane = tid & 63, wid = tid >> 6, fr = lane & 15, fq = lane >> 4;
    const int kv = wid & 1, rt = wid >> 1;
    const int n_it = (256 + nblk - 1) / nblk + (16 + nblk - 1) / nblk;
    for (int it = 0; it < n_it; ++it) {
        const int ns_it = (256 + nblk - 1) / nblk;
        const int task = it < ns_it ? bid + it * nblk : 256 + (nblk - 1 - bid) + (it - ns_it) * nblk;
        if (task >= 272 || (it < ns_it && task >= 256)) continue;
        const bool prompt = task >= 256;
        const int rowbytes = prompt ? 1024 : 2048, npieces = prompt ? 2 : 4;
        const char* src[4]; int dsto[4];
#pragma unroll
        for (int q = 0; q < 4; ++q) {
            const int off = q * 8192 + tid * 16, r = off / rowbytes, cb = off % rowbytes;
            if (prompt) { const int blk = (task - 256) * 16 + (r & 15); src[q] = (const char*)(p.PROJ + (size_t)blk * 64 * PS + C_CMP) + cb; dsto[q] = (r & 15) * CP_AROW * 2 + cb; }
            else { const int gb = task * 16 + r, b = gb >> 5, n = gb & 31; const int page = p.page_table[b * 16 + (n >> 1)];
                   src[q] = (const char*)(p.cache_cmp + ((size_t)page * 128 + (n & 1) * 64) * 512) + cb; dsto[q] = r * CP_AROW * 2 + (cb >> 1); }
        }
        const size_t sstride = prompt ? (size_t)PS * 2 : 2048;
        const char* wsrc[2]; int wdst[2];
#pragma unroll
        for (int q = 0; q < 2; ++q) { const int idx = q * 512 + tid, row = idx >> 3, ch = idx & 7; wsrc[q] = (const char*)(p.WCT + (size_t)row * 4096) + ch * 16; wdst[q] = row * 144 + ch * 16; }
        f32x4 acc[4];
#pragma unroll
        for (int nt = 0; nt < 4; ++nt) acc[nt] = (f32x4){0.f, 0.f, 0.f, 0.f};
        f32x4 ra0[4], ra1[4]; u32x4 rw0[2], rw1[2];
        auto issue = [&](int l, f32x4 (&ra)[4], u32x4 (&rw)[2]) {
#pragma unroll
            for (int q = 0; q < 4; ++q) if (q < npieces) ra[q] = *(const f32x4*)(src[q] + (size_t)l * sstride);
#pragma unroll
            for (int q = 0; q < 2; ++q) rw[q] = *(const u32x4*)(wsrc[q] + l * 128);
        };
        auto commit = [&](int buf, const f32x4 (&ra)[4], const u32x4 (&rw)[2]) {
            char* ab = smem + CP_A + buf * CP_ABUF; char* wbuf = smem + CP_W + buf * CP_WBUF;
#pragma unroll
            for (int q = 0; q < 4; ++q) if (q < npieces) {
                if (prompt) *(f32x4*)(ab + dsto[q]) = ra[q];
                else { u32x2 o; o.x = pack2(ra[q][0], ra[q][1]); o.y = pack2(ra[q][2], ra[q][3]); *(u32x2*)(ab + dsto[q]) = o; }
            }
#pragma unroll
            for (int q = 0; q < 2; ++q) *(u32x4*)(wbuf + wdst[q]) = rw[q];
        };
        auto consume = [&](int buf) {
            const char* ab = smem + CP_A + buf * CP_ABUF; const char* wbuf = smem + CP_W + buf * CP_WBUF;
            const bf16_t* arow = (const bf16_t*)ab + (rt * 4 + (fr >> 2)) * CP_AROW + kv * 256 + (fr & 3) * 64 + fq * 8;
#pragma unroll
            for (int hf = 0; hf < 2; ++hf) {
                const bf16x8 a = *(const bf16x8*)(arow + hf * 32);
#pragma unroll
                for (int nt = 0; nt < 4; ++nt) {
                    const bf16x8 bfrag = *(const bf16x8*)(wbuf + (kv * 64 + nt * 16 + fr) * 144 + hf * 64 + fq * 16);
                    acc[nt] = __builtin_amdgcn_mfma_f32_16x16x32_bf16(a, bfrag, acc[nt], 0, 0, 0);
                }
            }
        };
        __syncthreads();
        issue(0, ra0, rw0); issue(1, ra1, rw1); commit(0, ra0, rw0); issue(2, ra0, rw0);
        __syncthreads();
#pragma unroll 1
        for (int l = 0; l < 64; l += 2) {
            consume(0);
            commit(1, ra1, rw1);
            if (l + 3 < 64) issue(l + 3, ra1, rw1);
            __syncthreads();
            consume(1);
            if (l + 2 < 64) commit(0, ra0, rw0);
            if (l + 4 < 64) issue(l + 4, ra0, rw0);
            __syncthreads();
        }
        {
            const int ob = prompt ? (task - 256) * 16 + rt * 4 + fq : 256 + task * 16 + rt * 4 + fq;
#pragma unroll
            for (int nt = 0; nt < 4; ++nt) {
                const float bias = p.PW[kv * 64 + nt * 16 + fr];
#pragma unroll
                for (int r = 0; r < 4; ++r) p.KC[(size_t)ob * 512 + kv * 256 + r * 64 + nt * 16 + fr] = acc[nt][r] + bias;
            }
        }
    }
}

DEVI void stage_cmp_select(const P& p, int bid, int nblk) {
    const int lane = tid_opq() & 63, wid = tid_opq() >> 6;
    for (int wt = bid * 8 + wid; wt < NT * 4; wt += nblk * 8) {
        const int row = wt >> 2, g = wt & 3;
        int pos, nb, nvalid, cur; const float *kcb, *vcb;
        if (row < NTP) { const int b = row >> 12, t = row & 4095; pos = t; nb = 64; nvalid = (t + 1) >> 6; cur = t >> 6; kcb = p.KC + (size_t)(b * 64) * 256; vcb = p.VC + (size_t)(b * 64) * 256; }
        else { const int rs = row - NTP, b = rs >> 2, tq = rs & 3; pos = 2048 + tq; nb = 33; nvalid = 32; cur = 32; kcb = p.KC + (size_t)(256 + b * 32) * 256; vcb = p.VC + (size_t)(256 + b * 32) * 256; }
        const int j = lane;
        float pr[4] = {0.f, 0.f, 0.f, 0.f};
        float imp = 0.f;
        if (nvalid > 0) {
            float dot[4] = {0.f, 0.f, 0.f, 0.f};
            if (j < nvalid) {
                const float* kr = kcb + (size_t)j * 256 + g * 64;
                const bf16_t* qr = p.PROJ + (size_t)row * PS + C_BQ + g * 256;
                for (int d = 0; d < 64; ++d) {
                    const float kk = kr[d];
#pragma unroll
                    for (int r = 0; r < 4; ++r) dot[r] += bf2f(qr[r * 64 + d]) * kk;
                }
            }
#pragma unroll
            for (int r = 0; r < 4; ++r) {
                const float s = j < nvalid ? dot[r] * 0.125f - alibi_slope(g * 4 + r) * (float)(pos - (j * 64 + 63)) : -INFINITY;
                const float mx = wave_max(s);
                const float e = j < nvalid ? __expf(s - mx) : 0.f;
                const float sum = wave_sum(e);
                pr[r] = e / sum;
                imp += pr[r];
            }
            float o[4] = {0.f, 0.f, 0.f, 0.f};
            for (int jj = 0; jj < nvalid; ++jj) {
                const float vv = vcb[(size_t)jj * 256 + g * 64 + lane];
#pragma unroll
                for (int r = 0; r < 4; ++r) o[r] += __shfl(pr[r], jj) * vv;
            }
#pragma unroll
            for (int r = 0; r < 4; ++r) p.OCMP[(size_t)row * 1024 + (g * 4 + r) * 64 + lane] = o[r];
        } else {
#pragma unroll
            for (int r = 0; r < 4; ++r) p.OCMP[(size_t)row * 1024 + (g * 4 + r) * 64 + lane] = 0.f;
        }
        if (j == cur || j == 0) imp = 5.0f;
        if (j > cur) imp = -1.0f;
        if (j >= nb) imp = -2.0f;
        int rank = 0;
        for (int jj = 0; jj < 64; ++jj) { const float v = __shfl(imp, jj); rank += (v > imp || (v == imp && jj < j)) ? 1 : 0; }
        const unsigned long long mask = __ballot(rank < 16 && j < nb);
        if (lane == 0) p.SEL[(size_t)row * 4 + g] = mask;
    }
}

struct KBlock { const void* kb; const void* vb; int stride; int f32; int count; int pos0; };

template <bool WIN>
DEVI void attend_block(const KBlock& B, int qpos, const float* qs, const float (&slope)[4], float (&m)[4], float (&l)[4], float (&o)[4], int lane) {
    const int pos = B.pos0 + lane;
    const bool valid = lane < B.count && pos <= qpos && (!WIN || pos > qpos - 512);
    if (!__any(valid)) return;
    float dot[4] = {0.f, 0.f, 0.f, 0.f};
    if (valid) {
        if (B.f32) {
            const float* kr = (const float*)B.kb + (size_t)lane * B.stride;
#pragma unroll 4
            for (int d4 = 0; d4 < 16; ++d4) {
                const f32x4 kk = *(const f32x4*)(kr + d4 * 4);
#pragma unroll
                for (int e = 0; e < 4; ++e) { const f32x4 qq = *(const f32x4*)(qs + (d4 * 4 + e) * 4);
#pragma unroll
                    for (int r = 0; r < 4; ++r) dot[r] += kk[e] * qq[r]; }
            }
        } else {
            const bf16_t* kr = (const bf16_t*)B.kb + (size_t)lane * B.stride;
#pragma unroll 2
            for (int d8 = 0; d8 < 8; ++d8) {
                const u32x4 kk = *(const u32x4*)(kr + d8 * 8);
                const unsigned w[4] = {kk.x, kk.y, kk.z, kk.w};
#pragma unroll
                for (int e = 0; e < 4; ++e) {
                    const float k0 = __uint_as_float(w[e] << 16), k1 = __uint_as_float(w[e] & 0xFFFF0000u);
                    const f32x4 q0 = *(const f32x4*)(qs + (d8 * 8 + e * 2) * 4), q1 = *(const f32x4*)(qs + (d8 * 8 + e * 2 + 1) * 4);
#pragma unroll
                    for (int r = 0; r < 4; ++r) dot[r] += k0 * q0[r] + k1 * q1[r];
                }
            }
        }
    }
    float pr[4];
#pragma unroll
    for (int r = 0; r < 4; ++r) {
        const float s = valid ? dot[r] * 0.125f - slope[r] * (float)(qpos - pos) : -INFINITY;
        const float mn = fmaxf(m[r], wave_max(s));
        const float sc = __expf(m[r] - mn);
        pr[r] = valid ? __expf(s - mn) : 0.f;
        l[r] = l[r] * sc + wave_sum(pr[r]);
        o[r] *= sc; m[r] = mn;
    }
    for (int kk = 0; kk < B.count; ++kk) {
        const float vv = B.f32 ? ((const float*)B.vb)[(size_t)kk * B.stride + lane] : bf2f(((const bf16_t*)B.vb)[(size_t)kk * B.stride + lane]);
#pragma unroll
        for (int r = 0; r < 4; ++r) o[r] += __shfl(pr[r], kk) * vv;
    }
}

DEVI void stage_slc_win(const P& p, char* smem, int bid, int nblk) {
    const int lane = tid_opq() & 63, wid = tid_opq() >> 6;
    float* qs = (float*)smem + wid * 256;
    for (int wt = bid * 8 + wid; wt < NT * 4; wt += nblk * 8) {
        const int row = wt >> 2, g = wt & 3;
        const bool prompt = row < NTP;
        int b, t, qpos;
        if (prompt) { b = row >> 12; t = row & 4095; qpos = t; } else { const int rs = row - NTP; b = rs >> 2; t = rs & 3; qpos = 2048 + t; }
        {
            const bf16_t* qr = p.PROJ + (size_t)row * PS + C_BQ + g * 256;
            f32x4 qv;
#pragma unroll
            for (int r = 0; r < 4; ++r) qv[r] = bf2f(qr[r * 64 + lane]);
            *(f32x4*)(qs + lane * 4) = qv;
            asm volatile("s_waitcnt lgkmcnt(0)" ::: "memory");
        }
        float slope[4];
#pragma unroll
        for (int r = 0; r < 4; ++r) slope[r] = alibi_slope(g * 4 + r);
        float res[2][4];
        {
            float m[4], l[4], o[4];
#pragma unroll
            for (int r = 0; r < 4; ++r) { m[r] = -INFINITY; l[r] = 0.f; o[r] = 0.f; }
            unsigned long long mask = p.SEL[(size_t)row * 4 + g];
            while (mask) {
                const int j = __builtin_ctzll(mask); mask &= mask - 1;
                KBlock B;
                if (prompt) {
                    const bf16_t* base = p.PROJ + ((size_t)b * 4096 + j * 64) * PS + C_SLC + g * 64;
                    B.kb = base; B.vb = base + 256; B.stride = PS; B.f32 = 0; B.count = 64; B.pos0 = j * 64;
                } else if (j < 32) {
                    const int page = p.page_table[b * 16 + (j >> 1)];
                    const float* base = p.cache_slc + ((size_t)page * 128 + (j & 1) * 64) * 512 + g * 64;
                    B.kb = base; B.vb = base + 256; B.stride = 512; B.f32 = 1; B.count = 64; B.pos0 = j * 64;
                } else {
                    const bf16_t* base = p.PROJ + ((size_t)NTP + b * 4) * PS + C_SLC + g * 64;
                    B.kb = base; B.vb = base + 256; B.stride = PS; B.f32 = 0; B.count = 4; B.pos0 = 2048;
                }
                attend_block<false>(B, qpos, qs, slope, m, l, o, lane);
            }
#pragma unroll
            for (int r = 0; r < 4; ++r) res[0][r] = o[r] / l[r];
        }
        {
            float m[4], l[4], o[4];
#pragma unroll
            for (int r = 0; r < 4; ++r) { m[r] = -INFINITY; l[r] = 0.f; o[r] = 0.f; }
            if (prompt) {
                const int lo = (t - 511 > 0 ? t - 511 : 0) >> 6, hi = t >> 6;
                for (int j = lo; j <= hi; ++j) {
                    KBlock B; const bf16_t* base = p.PROJ + ((size_t)b * 4096 + j * 64) * PS + C_WIN + g * 64;
                    B.kb = base; B.vb = base + 256; B.stride = PS; B.f32 = 0; B.count = 64; B.pos0 = j * 64;
                    attend_block<true>(B, qpos, qs, slope, m, l, o, lane);
                }
            } else {
                for (int j = 0; j < 8; ++j) {
                    KBlock B; const float* base = p.cache_win + ((size_t)b * 512 + j * 64) * 512 + g * 64;
                    B.kb = base; B.vb = base + 256; B.stride = 512; B.f32 = 1; B.count = 64; B.pos0 = 1536 + j * 64;
                    attend_block<true>(B, qpos, qs, slope, m, l, o, lane);
                }
                KBlock B; const bf16_t* base = p.PROJ + ((size_t)NTP + b * 4) * PS + C_WIN + g * 64;
                B.kb = base; B.vb = base + 256; B.stride = PS; B.f32 = 0; B.count = 4; B.pos0 = 2048;
                attend_block<true>(B, qpos, qs, slope, m, l, o, lane);
            }
#pragma unroll
            for (int r = 0; r < 4; ++r) res[1][r] = o[r] / l[r];
        }
        const float* gt = p.SM + (size_t)row * 64 + 8;
#pragma unroll
        for (int r = 0; r < 4; ++r) {
            const float g0 = sigmoidf_(gt[g * 4 + r]), g1 = sigmoidf_(gt[16 + g * 4 + r]), g2 = sigmoidf_(gt[32 + g * 4 + r]);
            const float oc = p.OCMP[(size_t)row * 1024 + (g * 4 + r) * 64 + lane];
            p.YB[(size_t)row * 1024 + (g * 4 + r) * 64 + lane] = f2bf(g0 * oc + g1 * res[0][r] + g2 * res[1][r]);
        }
    }
}

typedef float f32x16 __attribute__((ext_vector_type(16)));
typedef short s16x4 __attribute__((ext_vector_type(4)));
typedef __attribute__((address_space(3))) const char* lds_cptr;
#define MFMA32(a, b, c) __builtin_amdgcn_mfma_f32_32x32x16_bf16(a, b, c, 0, 0, 0)
DEVI int crow(int r, int hi) { return (r & 3) + 8 * (r >> 2) + 4 * hi; }
DEVI unsigned cvtpk(float lo, float hi) { return pack2(lo, hi); }
DEVI s16x4 vtr(lds_cptr p) { return __builtin_bit_cast(s16x4, __builtin_amdgcn_ds_read_tr16_b64_v4i16((__attribute__((address_space(3))) s16x4*)p)); }
DEVI float half_max(float m) { auto rr = __builtin_amdgcn_permlane32_swap(__float_as_uint(m), __float_as_uint(m), false, false); return fmaxf(__uint_as_float(rr[0]), __uint_as_float(rr[1])); }
DEVI float half_sum(float m) { auto rr = __builtin_amdgcn_permlane32_swap(__float_as_uint(m), __float_as_uint(m), false, false); return __uint_as_float(rr[0]) + __uint_as_float(rr[1]); }

struct BlkDesc { const char* k; int stride_bytes; int f32; int count; int pos0; };
DEVI void blk_load(const BlkDesc& d, int tid, u32x4& rk, u32x4& rv) {
    const int key = tid & 63, chunk = tid >> 6;
    rk = (u32x4){0u, 0u, 0u, 0u}; rv = rk;
    if (key < d.count) {
        const char* kr = d.k + (size_t)key * d.stride_bytes;
        if (d.f32) {
            const f32x4* s1 = (const f32x4*)(kr + chunk * 32); const f32x4* s2 = (const f32x4*)(kr + 1024 + chunk * 32);
            rk = pack8f(s1[0], s1[1]); rv = pack8f(s2[0], s2[1]);
        } else { rk = *(const u32x4*)(kr + chunk * 16); rv = *(const u32x4*)(kr + 512 + chunk * 16); }
    }
}
DEVI void blk_store(char* kimg, char* vimg, int tid, const u32x4& rk, const u32x4& rv) {
    const int key = tid & 63, chunk = tid >> 6;
    *(u32x4*)(kimg + chunk * 1024 + key * 16) = rk;
    *(u32x4*)(vimg + (chunk >> 2) * 4096 + key * 64 + (chunk & 3) * 16) = rv;
}

DEVI void attn_tile(const char* kimg, const char* vimg, const bf16x8 (&qr)[4], float& m2, float& lsum, f32x16& o0, f32x16& o1, f32x16& s0, f32x16& s1,
                    float sl, float bb, int lh, int ll, bool fast, float* wsf_hi  , float* wsf_r  , int lane) {
    const int r32 = lane & 31, hi = lane >> 5;
    const f32x16 z = {};
    s0 = z; s1 = z;
    {
        const char* kp = kimg + hi * 1024 + r32 * 16;
#pragma unroll
        for (int d0 = 0; d0 < 4; ++d0) {
            const bf16x8 k0 = *(const bf16x8*)(kp + d0 * 2048), k1 = *(const bf16x8*)(kp + d0 * 2048 + 512);
            s0 = MFMA32(k0, qr[d0], s0); s1 = MFMA32(k1, qr[d0], s1);
        }
    }
    float mx = -1e30f;
    if (fast) {
#pragma unroll
        for (int r = 0; r < 16; ++r) {
            const int c = (r & 3) + 8 * (r >> 2);
            s0[r] = fmaf(s0[r], 1.4426950408889634f, fmaf(sl, (float)c, bb)); s1[r] = fmaf(s1[r], 1.4426950408889634f, fmaf(sl, (float)(c + 32), bb));
            mx = fmaxf(mx, fmaxf(s0[r], s1[r]));
        }
    } else {
#pragma unroll
        for (int r = 0; r < 16; ++r) {
            const int c = (r & 3) + 8 * (r >> 2);
            const float t0 = fmaf(s0[r], 1.4426950408889634f, fmaf(sl, (float)c, bb)), t1 = fmaf(s1[r], 1.4426950408889634f, fmaf(sl, (float)(c + 32), bb));
            s0[r] = (c <= lh && c > ll) ? t0 : -INFINITY; s1[r] = (c + 32 <= lh && c + 32 > ll) ? t1 : -INFINITY;
            mx = fmaxf(mx, fmaxf(s0[r], s1[r]));
        }
    }
    mx = half_max(mx);
    const float mnew = fmaxf(m2, mx);
    const float f = __builtin_amdgcn_exp2f(m2 - mnew);
    m2 = mnew;
    float ps = 0.f;
#pragma unroll
    for (int r = 0; r < 16; ++r) { s0[r] = __builtin_amdgcn_exp2f(s0[r] - mnew); s1[r] = __builtin_amdgcn_exp2f(s1[r] - mnew); ps += s0[r] + s1[r]; }
    lsum = lsum * f + ps;
    if (__any(f != 1.f)) {
        if (hi == 0) *wsf_r = f;
        asm volatile("s_waitcnt lgkmcnt(0)" ::: "memory");
#pragma unroll
        for (int a = 0; a < 4; ++a) {
            const f32x4 fv = *(const f32x4*)(wsf_hi + 8 * a);
#pragma unroll
            for (int k = 0; k < 4; ++k) { o0[4 * a + k] *= fv[k]; o1[4 * a + k] *= fv[k]; }
        }
        asm volatile("s_waitcnt lgkmcnt(0)" ::: "memory");
    }
    u32x4 pw[4];
#pragma unroll
    for (int k = 0; k < 4; ++k) { pw[0][k] = cvtpk(s0[2 * k], s0[2 * k + 1]); pw[1][k] = cvtpk(s0[8 + 2 * k], s0[8 + 2 * k + 1]); pw[2][k] = cvtpk(s1[2 * k], s1[2 * k + 1]); pw[3][k] = cvtpk(s1[8 + 2 * k], s1[8 + 2 * k + 1]); }
    const lds_cptr vp = (lds_cptr)vimg + ((lane >> 4) & 1) * 32 + (lane & 3) * 8 + (4 * hi + ((lane & 15) >> 2)) * 64;
#pragma unroll
    for (int i = 0; i < 8; ++i) {
        const s16x4 lo = vtr(vp + ((i >> 2) * 4096 + (i & 3) * 1024)), hh = vtr(vp + ((i >> 2) * 4096 + (i & 3) * 1024 + 512));
        const bf16x8 vf = (bf16x8){lo[0], lo[1], lo[2], lo[3], hh[0], hh[1], hh[2], hh[3]};
        const bf16x8 pf = __builtin_bit_cast(bf16x8, pw[i & 3]);
        if (i < 4) o0 = MFMA32(pf, vf, o0); else o1 = MFMA32(pf, vf, o1);
    }
}

constexpr int NSA_KV0 = 0, NSA_KV1 = 16384, NSA_WSF = 32768, NSA_IMP = NSA_WSF + 2048, NSA_SEL = NSA_IMP + 16384, NSA_LIST = NSA_SEL + 512, NSA_OST = NSA_LIST + 256, NSA_YAC = NSA_OST + 32768, NSA_LDS = NSA_YAC + 65536;
static_assert(NSA_LDS <= 152 * 1024, "lds");

DEVI BlkDesc nsa_desc(const P& p, bool prompt, int b, int g, int branch, int j) {
    BlkDesc d;
    if (prompt) {
        if (branch == 0) { d.k = (const char*)(p.KC + ((size_t)(b * 64) * 512 + g * 64)); d.stride_bytes = 2048; d.f32 = 1; d.count = 64; d.pos0 = 0; }
        else { d.k = (const char*)(p.PROJ + ((size_t)b * 4096 + j * 64) * PS + (branch == 1 ? C_SLC : C_WIN) + g * 64); d.stride_bytes = PS * 2; d.f32 = 0; d.count = 64; d.pos0 = j * 64; }
    } else {
        if (branch == 0) { d.k = (const char*)(p.KC + ((size_t)(256 + b * 32) * 512 + g * 64)); d.stride_bytes = 2048; d.f32 = 1; d.count = 32; d.pos0 = 0; }
        else if (branch == 1 && j < 32) { const int page = p.page_table[b * 16 + (j >> 1)]; d.k = (const char*)(p.cache_slc + ((size_t)page * 128 + (j & 1) * 64) * 512 + g * 64); d.stride_bytes = 2048; d.f32 = 1; d.count = 64; d.pos0 = j * 64; }
        else if (branch == 2 && j < 8) { d.k = (const char*)(p.cache_win + ((size_t)b * 512 + j * 64) * 512 + g * 64); d.stride_bytes = 2048; d.f32 = 1; d.count = 64; d.pos0 = 1536 + j * 64; }
        else { d.k = (const char*)(p.PROJ + ((size_t)NTP + b * 4) * PS + (branch == 1 ? C_SLC : C_WIN) + g * 64); d.stride_bytes = PS * 2; d.f32 = 0; d.count = 4; d.pos0 = 2048; }
    }
    return d;
}

constexpr int NS_IMG = 0, NS_WSF = 131072, NS_IMP = NS_WSF + 2048, NS_SEL = NS_IMP + 2048, NS_LIST = NS_SEL + 64, NS_YC = NS_LIST + 64, NS_PM = NS_YC + 4096, NS_Q = NS_PM + 2048, NS_LDS = NS_Q + 4096;
static_assert(NS_LDS <= 152 * 1024, "lds");
DEVI void wave_stage_block(const BlkDesc& d, char* kimg, char* vimg, int lane) {
    asm volatile("" : "+v"(lane));
    const int rsub = lane >> 4, pc = lane & 15;
    if (d.f32) {
#pragma unroll
        for (int half = 0; half < 2; ++half) {
#pragma unroll
            for (int i0 = 0; i0 < 16; i0 += 6) {
                f32x4 x[6];
#pragma unroll
                for (int i = 0; i < 6; ++i) if (i0 + i < 16) { const int row = 4 * (i0 + i) + rsub; x[i] = row < d.count ? __builtin_nontemporal_load((const f32x4*)(d.k + (size_t)row * d.stride_bytes + half * 1024 + pc * 16)) : (f32x4){0.f, 0.f, 0.f, 0.f}; }
#pragma unroll
                for (int i = 0; i < 6; ++i) if (i0 + i < 16) {
                    const int row = 4 * (i0 + i) + rsub, c = pc >> 1;
                    u32x2 o; o.x = pack2(x[i][0], x[i][1]); o.y = pack2(x[i][2], x[i][3]);
                    if (half == 0) *(u32x2*)(kimg + c * 1024 + row * 16 + (pc & 1) * 8) = o;
                    else *(u32x2*)(vimg + (c >> 2) * 4096 + row * 64 + (c & 3) * 16 + (pc & 1) * 8) = o;
                }
            }
        }
    } else {
        const int row = lane >> 3, c = lane & 7;
#pragma unroll
        for (int i = 0; i < 8; ++i) {
            const int rr = 8 * i + row;
            u32x4 kk = {0u, 0u, 0u, 0u}, vv = {0u, 0u, 0u, 0u};
            if (rr < d.count) { kk = *(const u32x4*)(d.k + (size_t)rr * d.stride_bytes + c * 16); vv = *(const u32x4*)(d.k + (size_t)rr * d.stride_bytes + 512 + c * 16); }
            *(u32x4*)(kimg + c * 1024 + rr * 16) = kk;
            *(u32x4*)(vimg + (c >> 2) * 4096 + rr * 64 + (c & 3) * 16) = vv;
        }
    }
    asm volatile("s_waitcnt lgkmcnt(0)" ::: "memory");
}

DEVI void nsa_sample_unit(const P& p, char* smem, int us) {
    const int tid = tid_opq(), lane = tid & 63, wid = tid >> 6, r32 = lane & 31, hi = lane >> 5;
    const int b = us >> 2, g = us & 3;
    const size_t rowbase = (size_t)NTP + b * 4;
    char* kimg = smem + NS_IMG + wid * 16384; char* vimg = kimg + 8192;
    float* wsf = (float*)(smem + NS_WSF) + wid * 64;
    float* impb = (float*)(smem + NS_IMP);
    unsigned long long* selm = (unsigned long long*)(smem + NS_SEL);
    unsigned char* blist = (unsigned char*)(smem + NS_LIST);
    float* ycmp = (float*)(smem + NS_YC);
    const int tokl = r32 >> 2, head = r32 & 3;
    const bool tok_ok = r32 < 16;
    const int qpos = 2048 + tokl;
    const float slope2 = alibi_slope(g * 4 + head) * 1.4426950408889634f;
    char* qsh = smem + NS_Q;
    int hi4 = 4 * hi; asm volatile("" : "+v"(hi4));
    float* wsf_hi = wsf + hi4; float* wsf_r = wsf + r32;
    f32x16 s0, s1;
    __syncthreads();
    if (wid == 0) {
        bf16x8 qr[4];
        {
            const bf16_t* qp = p.PROJ + (rowbase + (tok_ok ? tokl : 0)) * PS + C_BQ + (g * 4 + head) * 64 + hi * 8;
#pragma unroll
            for (int d0 = 0; d0 < 4; ++d0) {
                u32x4 v = *(const u32x4*)(qp + d0 * 16);
#pragma unroll
                for (int k = 0; k < 4; ++k) { const float lo = __uint_as_float(v[k] << 16) * 0.125f, hh = __uint_as_float(v[k] & 0xFFFF0000u) * 0.125f; v[k] = tok_ok ? ((__float_as_uint(lo) >> 16) | (__float_as_uint(hh) & 0xFFFF0000u)) : 0u; }
                qr[d0] = __builtin_bit_cast(bf16x8, v);
                *(u32x4*)(qsh + d0 * 1024 + lane * 16) = v;
            }
        }
        f32x16 o0 = {}, o1 = {}; float m2 = -1e30f, lsum = 0.f;
        const BlkDesc d = nsa_desc(p, false, b, g, 0, 0);
        wave_stage_block(d, kimg, vimg, lane);
        const int lh = 31 - hi4;
        const float sl = 64.f * slope2;
        attn_tile(kimg, vimg, qr, m2, lsum, o0, o1, s0, s1, sl, tok_ok ? sl * (float)(hi4 - 32) : -INFINITY, lh, -1000, false, wsf_hi, wsf_r, lane);
        const float lt = half_sum(lsum);
        const float inv = lt > 0.f ? 1.f / lt : 0.f;
        float* ib = impb + (r32 >> 2) * 64 + hi4;
#pragma unroll
        for (int r = 0; r < 16; ++r) {
            float a = s0[r] * inv, c = s1[r] * inv;
            a += __shfl_xor(a, 1); a += __shfl_xor(a, 2); c += __shfl_xor(c, 1); c += __shfl_xor(c, 2);
            if (head == 0) { ib[(r & 3) + 8 * (r >> 2)] = a; ib[(r & 3) + 8 * (r >> 2) + 32] = c; }
        }
        float fac = 0.f;
        if (tok_ok && lt > 0.f) fac = sigmoidf_(p.SM[(rowbase + tokl) * 64 + 8 + g * 4 + head]) / lt;
        if (hi == 0) *wsf_r = fac;
        asm volatile("s_waitcnt lgkmcnt(0)" ::: "memory");
#pragma unroll
        for (int a = 0; a < 2; ++a) {
            const f32x4 fv = *(const f32x4*)(wsf_hi + 8 * a);
#pragma unroll
            for (int k = 0; k < 4; ++k) { float* yp = ycmp + (8 * a + k + hi4) * 64 + r32; yp[0] = o0[4 * a + k] * fv[k]; yp[32] = o1[4 * a + k] * fv[k]; }
        }
        asm volatile("s_waitcnt lgkmcnt(0)" ::: "memory");
#pragma unroll 1
        for (int tl = 0; tl < 4; ++tl) {
            const int j = lane;
            float v = impb[tl * 64 + j];
            if (j == 32 || j == 0) v = 5.0f;
            if (j > 32) v = -2.0f;
            impb[tl * 64 + j] = v;
            asm volatile("s_waitcnt lgkmcnt(0)" ::: "memory");
            int rank = 0;
#pragma unroll 8
            for (int jj = 0; jj < 64; ++jj) { const float u = impb[tl * 64 + jj]; rank += (u > v || (u == v && jj < j)) ? 1 : 0; }
            const unsigned long long mask = __ballot(rank < 16 && j < 33);
            if (lane == 0) selm[tl] = mask;
        }
        asm volatile("s_waitcnt lgkmcnt(0)" ::: "memory");
        if (lane == 0) {
            unsigned long long u = selm[0] | selm[1] | selm[2] | selm[3];
            int n = 0;
            while (u) { const int j = __builtin_ctzll(u); u &= u - 1; blist[1 + n++] = (unsigned char)(0x40 | j); }
            for (int j = 0; j <= 8; ++j) blist[1 + n++] = (unsigned char)(0x80 | j);
            blist[0] = (unsigned char)n;
        }
    }
    __syncthreads();
    const int nb = blist[0];
    const unsigned long long mysel = tok_ok ? selm[tokl] : 0ull;
    int nslc = 0;
    for (int i = 0; i < nb; ++i) nslc += (blist[1 + i] >> 6) == 1 ? 1 : 0;
    float so[16], ms, lst;
    float wo[16], mw, lwt;
#pragma unroll 1
    for (int pass = 0; pass < 2; ++pass) {
        f32x16 o0 = {}, o1 = {}; float m2 = -1e30f, lsum = 0.f;
        const int i0 = pass == 0 ? 0 : nslc, i1 = pass == 0 ? nslc : nb;
#pragma unroll 1
        for (int i = i0 + wid; i < i1; i += 8) {
            const int e = blist[1 + i], br = e >> 6, j = e & 63;
            const BlkDesc d = nsa_desc(p, false, b, g, br, j);
            wave_stage_block(d, kimg, vimg, lane);
            asm volatile("" : "+v"(hi4));
            const bool lsel = tok_ok && (br == 2 || ((mysel >> j) & 1ull));
            const int rel = qpos - d.pos0;
            const int lh = (rel < d.count - 1 ? rel : d.count - 1) - hi4;
            const int ll = (br == 2 ? rel - 512 : -1000) - hi4;
            const bool fast = __all(!lsel || (lh >= 59 && ll < 0));
            const float bb = lsel ? slope2 * (float)(hi4 + d.pos0 - 2048) : -INFINITY;
            bf16x8 qr[4];
#pragma unroll
            for (int d0 = 0; d0 < 4; ++d0) qr[d0] = *(const bf16x8*)(qsh + d0 * 1024 + lane * 16);
            attn_tile(kimg, vimg, qr, m2, lsum, o0, o1, s0, s1, slope2, bb, lh, ll, fast, wsf_hi, wsf_r, lane);
        }
        const float lt = half_sum(lsum);
        if (pass == 0) { ms = m2; lst = lt;
#pragma unroll
            for (int r = 0; r < 8; ++r) { so[r] = o0[r]; so[8 + r] = o1[r]; } }
        else { mw = m2; lwt = lt;
#pragma unroll
            for (int r = 0; r < 8; ++r) { wo[r] = o0[r]; wo[8 + r] = o1[r]; } }
    }
    {
        float* po = (float*)kimg;
        float* pm = (float*)(smem + NS_PM) + wid * 64;
        if (lane < 16) { pm[lane * 2] = ms; pm[lane * 2 + 1] = lst; pm[32 + lane * 2] = mw; pm[32 + lane * 2 + 1] = lwt; }
#pragma unroll
        for (int a = 0; a < 2; ++a)
#pragma unroll
            for (int k = 0; k < 4; ++k) {
                float* yp = po + (8 * a + k + hi4) * 64 + r32;
                yp[0] = so[4 * a + k]; yp[32] = so[8 + 4 * a + k]; yp[1024] = wo[4 * a + k]; yp[1024 + 32] = wo[8 + 4 * a + k];
            }
    }
    __syncthreads();
    {
        const int row = tid >> 5, dcol = tid & 31, tk = row >> 2, hd = row & 3;
        float res[2][2];
#pragma unroll
        for (int br = 0; br < 2; ++br) {
            float M = -1e30f;
#pragma unroll
            for (int w = 0; w < 8; ++w) M = fmaxf(M, ((const float*)(smem + NS_PM))[w * 64 + br * 32 + row * 2]);
            float L = 0.f, a0 = 0.f, a1 = 0.f;
#pragma unroll
            for (int w = 0; w < 8; ++w) {
                const float* pmw = (const float*)(smem + NS_PM) + w * 64 + br * 32 + row * 2;
                const float f = __builtin_amdgcn_exp2f(pmw[0] - M);
                const float* pow_ = (const float*)(smem + NS_IMG + w * 16384) + br * 1024 + row * 64 + dcol;
                L += pmw[1] * f; a0 += pow_[0] * f; a1 += pow_[32] * f;
            }
            const float gate = sigmoidf_(p.SM[(rowbase + tk) * 64 + 8 + (br + 1) * 16 + g * 4 + hd]);
            const float sc = L > 0.f ? gate / L : 0.f;
            res[br][0] = a0 * sc; res[br][1] = a1 * sc;
        }
        const float y0 = ycmp[row * 64 + dcol] + res[0][0] + res[1][0], y1 = ycmp[row * 64 + dcol + 32] + res[0][1] + res[1][1];
        bf16_t* yb = p.YB + (rowbase + tk) * 1024 + (g * 4 + hd) * 64;
        yb[dcol] = f2bf(y0); yb[dcol + 32] = f2bf(y1);
    }
}

constexpr int NP_KVB = 18432, NP_KV0 = 0, NP_KV1 = NP_KVB, NP_WSF = 2 * NP_KVB, NP_IMP = NP_WSF + 2048, NP_SEL = NP_IMP + 16384, NP_LIST = NP_SEL + 512, NP_YAC = NP_LIST + 256, NP_LDS = NP_YAC + 65536;
static_assert(NP_LDS <= 152 * 1024, "lds");
DEVI void blk_store_ext(const BlkDesc& d, int pstep, int poff, int t0, char* kimg, char* vimg, int tid, const u32x4& rk, const u32x4& rv) {
    const int key = tid & 63, chunk = tid >> 6;
    *(u32x4*)(kimg + chunk * 1024 + key * 16) = rk;
    *(u32x4*)(vimg + (chunk >> 2) * 4096 + key * 64 + (chunk & 3) * 16) = rv;
    if (chunk == 0) {
        const int rel = d.pos0 + key * pstep + poff - t0;
        const int phi = (rel >> 6) << 6, plo = rel & 63;
        const unsigned bh = pack2((float)phi, (float)phi), bl = pack2((float)plo, (float)plo);
        *(u32x4*)(kimg + 8 * 1024 + key * 16) = (u32x4){bh, bl, 0x00003F80u, 0u};
    }
}
DEVI void attn_tile2(const char* kimg, const char* vimg, const bf16x8 (&qr)[4], const bf16x8 qext, float& m, float& lsum, f32x16& o0, f32x16& o1, f32x16& s0, f32x16& s1,
                     int lh, int ll, bool fast, float* wsf_hi, float* wsf_r, int lane) {
    const int r32 = lane & 31, hi = lane >> 5;
    const f32x16 z = {};
    s0 = z; s1 = z;
    {
        const char* kp = kimg + hi * 1024 + r32 * 16;
#pragma unroll
        for (int d0 = 0; d0 < 5; ++d0) {
            const bf16x8 k0 = *(const bf16x8*)(kp + d0 * 2048), k1 = *(const bf16x8*)(kp + d0 * 2048 + 512);
            const bf16x8 qf = d0 < 4 ? qr[d0 < 4 ? d0 : 0] : qext;
            s0 = MFMA32(k0, qf, s0); s1 = MFMA32(k1, qf, s1);
        }
    }
    if (!fast) {
#pragma unroll
        for (int r = 0; r < 16; ++r) {
            const int c = (r & 3) + 8 * (r >> 2);
            s0[r] = (c <= lh && c > ll) ? s0[r] : -INFINITY; s1[r] = (c + 32 <= lh && c + 32 > ll) ? s1[r] : -INFINITY;
        }
    }
    float mx = fmaxf(s0[0], s1[0]);
#pragma unroll
    for (int r = 1; r < 16; ++r) mx = fmaxf(mx, fmaxf(s0[r], s1[r]));
    mx = half_max(mx);
    const float mnew = fmaxf(m, mx);
    const float f = __builtin_amdgcn_exp2f((m - mnew) * 1.4426950408889634f);
    m = mnew;
    const float nm2 = -mnew * 1.4426950408889634f;
    float ps = 0.f;
#pragma unroll
    for (int r = 0; r < 16; ++r) { s0[r] = __builtin_amdgcn_exp2f(fmaf(s0[r], 1.4426950408889634f, nm2)); s1[r] = __builtin_amdgcn_exp2f(fmaf(s1[r], 1.4426950408889634f, nm2)); ps += s0[r] + s1[r]; }
    lsum = lsum * f + ps;
    if (__any(f != 1.f)) {
        if (hi == 0) *wsf_r = f;
        asm volatile("s_waitcnt lgkmcnt(0)" ::: "memory");
#pragma unroll
        for (int a = 0; a < 4; ++a) {
            const f32x4 fv = *(const f32x4*)(wsf_hi + 8 * a);
#pragma unroll
            for (int k = 0; k < 4; ++k) { o0[4 * a + k] *= fv[k]; o1[4 * a + k] *= fv[k]; }
        }
        asm volatile("s_waitcnt lgkmcnt(0)" ::: "memory");
    }
    u32x4 pw[4];
#pragma unroll
    for (int k = 0; k < 4; ++k) { pw[0][k] = cvtpk(s0[2 * k], s0[2 * k + 1]); pw[1][k] = cvtpk(s0[8 + 2 * k], s0[8 + 2 * k + 1]); pw[2][k] = cvtpk(s1[2 * k], s1[2 * k + 1]); pw[3][k] = cvtpk(s1[8 + 2 * k], s1[8 + 2 * k + 1]); }
    const lds_cptr vp = (lds_cptr)vimg + ((lane >> 4) & 1) * 32 + (lane & 3) * 8 + (4 * hi + ((lane & 15) >> 2)) * 64;
#pragma unroll
    for (int i = 0; i < 8; ++i) {
        const s16x4 lo = vtr(vp + ((i >> 2) * 4096 + (i & 3) * 1024)), hh = vtr(vp + ((i >> 2) * 4096 + (i & 3) * 1024 + 512));
        const bf16x8 vf = (bf16x8){lo[0], lo[1], lo[2], lo[3], hh[0], hh[1], hh[2], hh[3]};
        const bf16x8 pf = __builtin_bit_cast(bf16x8, pw[i & 3]);
        if (i < 4) o0 = MFMA32(pf, vf, o0); else o1 = MFMA32(pf, vf, o1);
    }
}

DEVI void attn_tile3(const char* kA, const char* vA, const char* kB, const char* vB, const bf16x8 (&qr)[4], const bf16x8 qeA, const bf16x8 qeB, float& m, float& lsum,
                     f32x16& o0, f32x16& o1, int lhA, int llA, bool fastA, int lhB, int llB, bool fastB, float* wsf_hi, float* wsf_r, int lane) {
    const int r32 = lane & 31, hi = lane >> 5;
    f32x16 a0 = {}, a1 = {}, b0 = {}, b1 = {};
    {
        const char* kpa = kA + hi * 1024 + r32 * 16; const char* kpb = kB + hi * 1024 + r32 * 16;
#pragma unroll
        for (int d0 = 0; d0 < 5; ++d0) {
            const bf16x8 ka0 = *(const bf16x8*)(kpa + d0 * 2048), ka1 = *(const bf16x8*)(kpa + d0 * 2048 + 512);
            const bf16x8 kb0 = *(const bf16x8*)(kpb + d0 * 2048), kb1 = *(const bf16x8*)(kpb + d0 * 2048 + 512);
            const bf16x8 qa = d0 < 4 ? qr[d0 < 4 ? d0 : 0] : qeA, qb = d0 < 4 ? qr[d0 < 4 ? d0 : 0] : qeB;
            a0 = MFMA32(ka0, qa, a0); a1 = MFMA32(ka1, qa, a1); b0 = MFMA32(kb0, qb, b0); b1 = MFMA32(kb1, qb, b1);
        }
    }
    if (!fastA) {
#pragma unroll
        for (int r = 0; r < 16; ++r) { const int c = (r & 3) + 8 * (r >> 2); a0[r] = (c <= lhA && c > llA) ? a0[r] : -INFINITY; a1[r] = (c + 32 <= lhA && c + 32 > llA) ? a1[r] : -INFINITY; }
    }
    if (!fastB) {
#pragma unroll
        for (int r = 0; r < 16; ++r) { const int c = (r & 3) + 8 * (r >> 2); b0[r] = (c <= lhB && c > llB) ? b0[r] : -INFINITY; b1[r] = (c + 32 <= lhB && c + 32 > llB) ? b1[r] : -INFINITY; }
    }
    float mx = fmaxf(fmaxf(a0[0], a1[0]), fmaxf(b0[0], b1[0]));
#pragma unroll
    for (int r = 1; r < 16; ++r) mx = fmaxf(mx, fmaxf(fmaxf(a0[r], a1[r]), fmaxf(b0[r], b1[r])));
    mx = half_max(mx);
    const float mnew = fmaxf(m, mx);
    const float f = __builtin_amdgcn_exp2f((m - mnew) * 1.4426950408889634f);
    m = mnew;
    const float nm2 = -mnew * 1.4426950408889634f;
    float ps = 0.f;
#pragma unroll
    for (int r = 0; r < 16; ++r) {
        a0[r] = __builtin_amdgcn_exp2f(fmaf(a0[r], 1.4426950408889634f, nm2)); a1[r] = __builtin_amdgcn_exp2f(fmaf(a1[r], 1.4426950408889634f, nm2));
        b0[r] = __builtin_amdgcn_exp2f(fmaf(b0[r], 1.4426950408889634f, nm2)); b1[r] = __builtin_amdgcn_exp2f(fmaf(b1[r], 1.4426950408889634f, nm2));
        ps += (a0[r] + a1[r]) + (b0[r] + b1[r]);
    }
    lsum = lsum * f + ps;
    if (__any(f != 1.f)) {
        if (hi == 0) *wsf_r = f;
        asm volatile("s_waitcnt lgkmcnt(0)" ::: "memory");
#pragma unroll
        for (int a = 0; a < 4; ++a) {
            const f32x4 fv = *(const f32x4*)(wsf_hi + 8 * a);
#pragma unroll
            for (int k = 0; k < 4; ++k) { o0[4 * a + k] *= fv[k]; o1[4 * a + k] *= fv[k]; }
        }
        asm volatile("s_waitcnt lgkmcnt(0)" ::: "memory");
    }
    const int voff = ((lane >> 4) & 1) * 32 + (lane & 3) * 8 + (4 * hi + ((lane & 15) >> 2)) * 64;
#pragma unroll
    for (int t = 0; t < 2; ++t) {
        const f32x16& p0 = t == 0 ? a0 : b0; const f32x16& p1 = t == 0 ? a1 : b1;
        u32x4 pw[4];
#pragma unroll
        for (int k = 0; k < 4; ++k) { pw[0][k] = cvtpk(p0[2 * k], p0[2 * k + 1]); pw[1][k] = cvtpk(p0[8 + 2 * k], p0[8 + 2 * k + 1]); pw[2][k] = cvtpk(p1[2 * k], p1[2 * k + 1]); pw[3][k] = cvtpk(p1[8 + 2 * k], p1[8 + 2 * k + 1]); }
        const lds_cptr vp = (lds_cptr)(t == 0 ? vA : vB) + voff;
#pragma unroll
        for (int i = 0; i < 8; ++i) {
            const s16x4 lo = vtr(vp + ((i >> 2) * 4096 + (i & 3) * 1024)), hh = vtr(vp + ((i >> 2) * 4096 + (i & 3) * 1024 + 512));
            const bf16x8 vf = (bf16x8){lo[0], lo[1], lo[2], lo[3], hh[0], hh[1], hh[2], hh[3]};
            const bf16x8 pf = __builtin_bit_cast(bf16x8, pw[i & 3]);
            if (i < 4) o0 = MFMA32(pf, vf, o0); else o1 = MFMA32(pf, vf, o1);
        }
    }
}

constexpr int NQ_KVB = 18432, NQ_WSF = 4 * NQ_KVB, NQ_SEL = NQ_WSF + 2048, NQ_LIST = NQ_SEL + 512, NQ_YAC = NQ_LIST + 256, NQ_LDS = NQ_YAC + 65536, NQ_IMP = 2 * NQ_KVB;
static_assert(NQ_LDS <= 152 * 1024, "lds");
DEVI void nsa_prompt_unit(const P& p, char* smem, int unit) {
    const int tid = tid_opq(), lane = tid & 63, wid = tid >> 6, r32 = lane & 31, hi = lane >> 5;
    float* wsf = (float*)(smem + NQ_WSF) + wid * 64;
    float* impb = (float*)(smem + NQ_IMP) + wid * 512;
    unsigned long long* selm = (unsigned long long*)(smem + NQ_SEL);
    unsigned char* blist = (unsigned char*)(smem + NQ_LIST);
    const int b = unit >> 8, g = ((unit >> 6) + b) & 3, qt = (b & 1) ? 63 - (unit & 63) : (unit & 63), t0 = qt * 64;
    const size_t rowbase = (size_t)b * 4096 + t0;
    const int tokl = wid * 8 + (r32 >> 2), head = r32 & 3;
    const int qpos = t0 + tokl;
    const float slope = alibi_slope(g * 4 + head);
    bf16x8 qr[4];
    {
        const bf16_t* qp = p.PROJ + (rowbase + tokl) * PS + C_BQ + (g * 4 + head) * 64 + hi * 8;
#pragma unroll
        for (int d0 = 0; d0 < 4; ++d0) {
            u32x4 v = *(const u32x4*)(qp + d0 * 16);
#pragma unroll
            for (int k = 0; k < 4; ++k) { const float lo = __uint_as_float(v[k] << 16) * 0.125f, hh = __uint_as_float(v[k] & 0xFFFF0000u) * 0.125f; v[k] = (__float_as_uint(lo) >> 16) | (__float_as_uint(hh) & 0xFFFF0000u); }
            qr[d0] = __builtin_bit_cast(bf16x8, v);
        }
    }
    unsigned qe_w;
    { const unsigned sh = (unsigned)f2bf(slope); const float rem = slope - __uint_as_float(sh << 16); qe_w = sh | ((unsigned)f2bf(rem) << 16); if (hi) qe_w = 0u; }
    int hi4 = 4 * hi; asm volatile("" : "+v"(hi4));
    float* yl = (float*)(smem + NQ_YAC) + wid * 2048 + hi4 * 64 + r32;
    float* wsf_hi = wsf + hi4; float* wsf_r = wsf + r32;
    f32x16 o0, o1; float m, lsum;
    auto finish = [&](int br) {
        const float lt = half_sum(lsum);
        float fac = 0.f;
        if (lt > 0.f) fac = sigmoidf_(p.SM[(rowbase + tokl) * 64 + 8 + br * 16 + g * 4 + head]) / lt;
        if (hi == 0) *wsf_r = fac;
        asm volatile("s_waitcnt lgkmcnt(0)" ::: "memory");
#pragma unroll
        for (int a = 0; a < 4; ++a) {
            const f32x4 fv = *(const f32x4*)(wsf_hi + 8 * a);
#pragma unroll
            for (int k = 0; k < 4; ++k) {
                float* yp = yl + (8 * a + k) * 64;
                if (br == 0) { yp[0] = o0[4 * a + k] * fv[k]; yp[32] = o1[4 * a + k] * fv[k]; }
                else { yp[0] += o0[4 * a + k] * fv[k]; yp[32] += o1[4 * a + k] * fv[k]; }
            }
        }
        asm volatile("s_waitcnt lgkmcnt(0)" ::: "memory");
    };
    __syncthreads();
    if (tid < 64) *(u32x4*)(smem + 9 * 1024 + tid * 16) = (u32x4){0u, 0u, 0u, 0u};
    {
        const BlkDesc d = nsa_desc(p, true, b, g, 0, 0);
        u32x4 rk, rv; blk_load(d, tid, rk, rv); blk_store_ext(d, 64, 63, t0, smem, smem + 10240, tid, rk, rv);
        __syncthreads();
        o0 = (f32x16){}; o1 = (f32x16){}; m = -1e30f; lsum = 0.f;
        f32x16 s0, s1;
        {
            const int nv = ((qpos + 1) >> 6) - 1;
            const int lh = (nv < 63 ? nv : 63) - hi4;
            const bf16x8 qext = __builtin_bit_cast(bf16x8, (u32x4){qe_w, qe_w, 0u, 0u});
            attn_tile2(smem, smem + 10240, qr, qext, m, lsum, o0, o1, s0, s1, lh, -1000, false, wsf_hi, wsf_r, lane);
        }
        const float lt = half_sum(lsum);
        const float inv = lt > 0.f ? 1.f / lt : 0.f;
        float* ib = impb + (r32 >> 2) * 64 + hi4;
#pragma unroll
        for (int r = 0; r < 16; ++r) {
            float a = s0[r] * inv, c = s1[r] * inv;
            a += __shfl_xor(a, 1); a += __shfl_xor(a, 2); c += __shfl_xor(c, 1); c += __shfl_xor(c, 2);
            if (head == 0) { ib[(r & 3) + 8 * (r >> 2)] = a; ib[(r & 3) + 8 * (r >> 2) + 32] = c; }
        }
        asm volatile("s_waitcnt lgkmcnt(0)" ::: "memory");
        finish(0);
#pragma unroll 1
        for (int tl = 0; tl < 8; ++tl) {
            const int j = lane;
            float v = impb[tl * 64 + j];
            if (j == qt || j == 0) v = 5.0f;
            if (j > qt) v = -1.0f;
            impb[tl * 64 + j] = v;
            asm volatile("s_waitcnt lgkmcnt(0)" ::: "memory");
            int rank = 0;
#pragma unroll 8
            for (int jj = 0; jj < 64; ++jj) { const float u = impb[tl * 64 + jj]; rank += (u > v || (u == v && jj < j)) ? 1 : 0; }
            const unsigned long long mask = __ballot(rank < 16);
            if (lane == 0) selm[wid * 8 + tl] = mask;
        }
    }
    __syncthreads();
    if (wid == 0) {
        unsigned long long u = selm[lane];
#pragma unroll
        for (int o = 32; o > 0; o >>= 1) u |= __shfl_xor(u, o);
        u &= (qt == 63) ? ~0ull : ((1ull << (qt + 1)) - 1ull);
        if (lane == 0) {
            int n = 0;
            while (u) { const int j = __builtin_ctzll(u); u &= u - 1; blist[2 + n++] = (unsigned char)j; }
            blist[0] = (unsigned char)n;
            int nw = 0;
            for (int j = (qt - 8 > 0 ? qt - 8 : 0); j <= qt; ++j) blist[2 + n + nw++] = (unsigned char)j;
            blist[1] = (unsigned char)nw;
        }
    }
    __syncthreads();
    if (tid >= 64 && tid < 256) *(u32x4*)(smem + (tid >> 6) * NQ_KVB + 9 * 1024 + (tid & 63) * 16) = (u32x4){0u, 0u, 0u, 0u};
    const int ns = blist[0], nw = blist[1];
    const int nss = (ns + 1) >> 1, nsteps = nss + ((nw + 1) >> 1);
    const unsigned long long mysel = selm[tokl];
    {
        auto step_blocks = [&](int s, int& br, int& jA, int& jB) {
            if (s < nss) { br = 1; jA = blist[2 + 2 * s]; jB = 2 * s + 1 < ns ? (int)blist[2 + 2 * s + 1] : -1; }
            else { const int w = s - nss; br = 2; jA = blist[2 + ns + 2 * w]; jB = 2 * w + 1 < nw ? (int)blist[2 + ns + 2 * w + 1] : -1; }
        };
        u32x4 rkA, rvA, rkB, rvB;
        auto load_step = [&](int s) {
            int br, jA, jB; step_blocks(s, br, jA, jB);
            const BlkDesc dA = nsa_desc(p, true, b, g, br, jA); blk_load(dA, tid, rkA, rvA);
            if (jB >= 0) { const BlkDesc dB = nsa_desc(p, true, b, g, br, jB); blk_load(dB, tid, rkB, rvB); }
        };
        auto store_step = [&](int s, char* buf) {
            int br, jA, jB; step_blocks(s, br, jA, jB);
            BlkDesc dA; dA.pos0 = jA * 64; blk_store_ext(dA, 1, 0, t0, buf, buf + 10240, tid, rkA, rvA);
            if (jB >= 0) { BlkDesc dB; dB.pos0 = jB * 64; blk_store_ext(dB, 1, 0, t0, buf + NQ_KVB, buf + NQ_KVB + 10240, tid, rkB, rvB); }
        };
        load_step(0); store_step(0, smem);
        __syncthreads();
        int prev_br = 1;
        o0 = (f32x16){}; o1 = (f32x16){}; m = -1e30f; lsum = 0.f;
        for (int s = 0; s < nsteps; ++s) {
            int br, jA, jB; step_blocks(s, br, jA, jB);
            char* cur = smem + (s & 1) * 2 * NQ_KVB;
            char* nxt = smem + ((s & 1) ^ 1) * 2 * NQ_KVB;
            if (s + 1 < nsteps) load_step(s + 1);
            if (br != prev_br) { finish(1); o0 = (f32x16){}; o1 = (f32x16){}; m = -1e30f; lsum = 0.f; prev_br = br; }
            {
                asm volatile("" : "+v"(hi4));
                const bool lselA = br == 2 || ((mysel >> jA) & 1ull);
                const int relA = qpos - jA * 64;
                const int lhA = (relA < 63 ? relA : 63) - hi4, llA = (br == 2 ? relA - 512 : -1000) - hi4;
                const bool fastA = __all(!lselA || (lhA >= 59 && llA < 0));
                const bool needA = __any(lselA && lhA + hi4 >= 0 && llA + hi4 < 63);
                const bf16x8 qeA = __builtin_bit_cast(bf16x8, (u32x4){qe_w, qe_w, (lselA || hi) ? 0u : 0x0000C6EAu, 0u});
                bool needB = false; bool lselB = false; int lhB = -1000, llB = -1000; bool fastB = false;
                if (jB >= 0) {
                    lselB = br == 2 || ((mysel >> jB) & 1ull);
                    const int relB = qpos - jB * 64;
                    lhB = (relB < 63 ? relB : 63) - hi4; llB = (br == 2 ? relB - 512 : -1000) - hi4;
                    fastB = __all(!lselB || (lhB >= 59 && llB < 0));
                    needB = __any(lselB && lhB + hi4 >= 0 && llB + hi4 < 63);
                }
                const bf16x8 qeB = __builtin_bit_cast(bf16x8, (u32x4){qe_w, qe_w, (lselB || hi) ? 0u : 0x0000C6EAu, 0u});
                f32x16 s0, s1;
                if (needA && needB) attn_tile3(cur, cur + 10240, cur + NQ_KVB, cur + NQ_KVB + 10240, qr, qeA, qeB, m, lsum, o0, o1, lhA, llA, fastA, lhB, llB, fastB, wsf_hi, wsf_r, lane);
                else if (needA) attn_tile2(cur, cur + 10240, qr, qeA, m, lsum, o0, o1, s0, s1, lhA, llA, fastA, wsf_hi, wsf_r, lane);
                else if (needB) attn_tile2(cur + NQ_KVB, cur + NQ_KVB + 10240, qr, qeB, m, lsum, o0, o1, s0, s1, lhB, llB, fastB, wsf_hi, wsf_r, lane);
            }
            if (s + 1 < nsteps) store_step(s + 1, nxt);
            __syncthreads();
        }
        finish(2);
    }
    {
        const float* yac = (const float*)(smem + NQ_YAC) + wid * 2048;
#pragma unroll
        for (int i = 0; i < 4; ++i) {
            const int orow = i * 8 + (lane >> 3), ch = lane & 7, tk = wid * 8 + (orow >> 2), hd = orow & 3;
            const f32x4 a = *(const f32x4*)(yac + orow * 64 + ch * 8), c = *(const f32x4*)(yac + orow * 64 + ch * 8 + 4);
            *(u32x4*)(p.YB + (rowbase + tk) * 1024 + (g * 4 + hd) * 64 + ch * 8) = pack8f(a, c);
        }
        asm volatile("s_waitcnt lgkmcnt(0)" ::: "memory");
    }
}

DEVI void stage_nsa_attn(const P& p, char* smem, int bid, int nblk) {
#ifndef NSA_REP
#define NSA_REP 0
#endif
    const int n_units = 1024 + 512 + (NSA_REP == 1 ? 1024 : 0) + (NSA_REP == 2 ? 512 : 0);
    for (int unit0 = bid; unit0 < n_units; unit0 += nblk) {
        const int unit = unit0 < 1536 ? unit0 : (NSA_REP == 1 ? unit0 - 1536 : unit0 - 512);
        if (unit < 1024) nsa_prompt_unit(p, smem, unit); else nsa_sample_unit(p, smem, unit - 1024);
    }
}

DEVI void stage_ln1(const P& p, int bid, int nblk) {
    const int lane = tid_opq() & 63, wid = tid_opq() >> 6;
    for (int row = bid * 8 + wid; row < NT; row += nblk * 8) {
        f32x4 x[4];
        float s = 0.f;
#pragma unroll
        for (int i = 0; i < 4; ++i) { x[i] = *(const f32x4*)(p.R + (size_t)row * 1024 + i * 256 + lane * 4); s += x[i][0] + x[i][1] + x[i][2] + x[i][3]; }
        const float mean = wave_sum(s) * (1.f / 1024.f);
        float q = 0.f;
#pragma unroll
        for (int i = 0; i < 4; ++i)
#pragma unroll
            for (int k = 0; k < 4; ++k) q += (x[i][k] - mean) * (x[i][k] - mean);
        const float rs = rsqrtf(wave_sum(q) * (1.f / 1024.f) + LN_EPS);
#pragma unroll
        for (int i = 0; i < 4; ++i) {
            const int c = i * 256 + lane * 4;
            const f32x4 gg = *(const f32x4*)(p.ln1_g + c), bb = *(const f32x4*)(p.ln1_b + c);
            f32x4 y;
#pragma unroll
            for (int k = 0; k < 4; ++k) y[k] = (x[i][k] - mean) * rs * gg[k] + bb[k];
            u32x2 o; o.x = pack2(y[0], y[1]); o.y = pack2(y[2], y[3]);
            *(u32x2*)(p.HB + (size_t)row * 1024 + c) = o;
        }
        if (lane == 0) { p.H[(size_t)row * 2] = mean; p.H[(size_t)row * 2 + 1] = rs; }
    }
}

__device__ const unsigned char PEER_CA[50] = {0,0,0,0,0,0,0,0,0,0,0,0,0,0,0,0, 1,1,1,1,1,1,1,1, 2,2,2,2,2, 3,3,3,3, 4,4,4, 5,5, 6,6, 7,7, 8,9,10,11,12,13,14,15};
__device__ const unsigned char PEER_CB[50] = {0,1,2,3,4,5,6,7,8,9,10,11,12,13,14,15, 0,1,2,3,4,5,6,7, 0,1,2,3,4, 0,1,2,3, 0,1,2, 0,1, 0,1, 0,1, 0,0,0,0,0,0,0,0};

DEVI void ce_desc(unsigned& a, unsigned& b) { const unsigned hi = a > b ? a : b, lo = a > b ? b : a; a = hi; b = lo; }
template <int BASE> DEVI void sort16_desc(unsigned (&x)[64]) {
#pragma unroll
    for (int k = 2; k <= 16; k <<= 1)
#pragma unroll
        for (int j = k >> 1; j > 0; j >>= 1)
#pragma unroll
            for (int i = 0; i < 16; ++i) {
                const int l = i ^ j;
                if (l > i) { if ((i & k) == 0) ce_desc(x[BASE + i], x[BASE + l]); else ce_desc(x[BASE + l], x[BASE + i]); }
            }
}
DEVI void merge_top16(const unsigned* a, const unsigned* b, unsigned* t) {
    unsigned c[16];
#pragma unroll
    for (int i = 0; i < 16; ++i) c[i] = a[i] > b[15 - i] ? a[i] : b[15 - i];
#pragma unroll
    for (int j = 8; j > 0; j >>= 1)
#pragma unroll
        for (int i = 0; i < 16; ++i) { const int l = i ^ j; if (l > i) ce_desc(c[i], c[l]); }
#pragma unroll
    for (int i = 0; i < 16; ++i) t[i] = c[i];
}
DEVI float key_score(unsigned k) { const unsigned u = k & ~127u; return __uint_as_float((u & 0x80000000u) ? (u & 0x7FFFFFFFu) : ~u); }

DEVI void sort8_desc(unsigned (&x)[16]) {
#pragma unroll
    for (int k = 2; k <= 8; k <<= 1)
#pragma unroll
        for (int j = k >> 1; j > 0; j >>= 1)
#pragma unroll
            for (int i = 0; i < 8; ++i) {
                const int l = i ^ j;
                if (l > i) { if ((i & k) == 0) ce_desc(x[i], x[l]); else ce_desc(x[l], x[i]); }
            }
}
DEVI unsigned sum_key(unsigned ka, unsigned kb, unsigned tag) {
    const unsigned u = __float_as_uint(key_score(ka) + key_score(kb));
    const unsigned o = (u & 0x80000000u) ? ~u : (u | 0x80000000u);
    return (o & ~255u) | tag;
}
DEVI float key_score8(unsigned k) { const unsigned u = k & ~255u; return __uint_as_float((u & 0x80000000u) ? (u & 0x7FFFFFFFu) : ~u); }

DEVI void route_top16(const P& p, int row, int ph, int c, int r32, int hi, int hi4, unsigned (&fin)[16]) {
    f32x16 acc[4];
#pragma unroll
    for (int t = 0; t < 4; ++t) acc[t] = (f32x16){};
    const bf16_t* qp = p.PQ + (size_t)row * 2048 + ph * 256 + c * 128 + hi * 8;
    const bf16_t* kp = p.KEYSB + ((size_t)((ph * 2 + c) * 128 + r32)) * 128 + hi * 8;
#pragma unroll
    for (int s8 = 0; s8 < 8; ++s8) {
        const bf16x8 qf = *(const bf16x8*)(qp + s8 * 16);
#pragma unroll
        for (int t = 0; t < 4; ++t) {
            const bf16x8 kf = *(const bf16x8*)(kp + (size_t)t * 32 * 128 + s8 * 16);
            acc[t] = MFMA32(kf, qf, acc[t]);
        }
    }
    unsigned x[64];
#pragma unroll
    for (int t = 0; t < 4; ++t)
#pragma unroll
        for (int r = 0; r < 16; ++r) {
            const unsigned u = __float_as_uint(acc[t][r]);
            const unsigned o = (u & 0x80000000u) ? ~u : (u | 0x80000000u);
            x[t * 16 + r] = (o & ~127u) | (unsigned)(127 - ((r & 3) + 8 * (r >> 2) + 32 * t) - hi4);
        }
    sort16_desc<0>(x); sort16_desc<16>(x); sort16_desc<32>(x); sort16_desc<48>(x);
    unsigned t01[16], t23[16], tt[16], oth[16];
    merge_top16(&x[0], &x[16], t01); merge_top16(&x[32], &x[48], t23); merge_top16(t01, t23, tt);
#pragma unroll
    for (int i = 0; i < 16; ++i) { auto rr = __builtin_amdgcn_permlane32_swap(tt[i], tt[i], false, false); oth[i] = hi ? rr[0] : rr[1]; }
    merge_top16(tt, oth, fin);
}

DEVI void stage_peer_route(const P& p, char* smem, int bid, int nblk) {
    const int lane = tid_opq() & 63, wid = tid_opq() >> 6, r32 = lane & 31, hi = lane >> 5;
    unsigned char* tb = (unsigned char*)smem + wid * 1024 + r32 * 32;
    const int tpw = (NT + nblk - 1) / nblk, row_lo = bid * tpw, row_hi = (row_lo + tpw < NT) ? row_lo + tpw : NT;
    const int ph = wid;
    for (int pass = 0; row_lo + pass * 32 < row_hi; ++pass) {
        const int row_raw = row_lo + pass * 32 + r32;
        const bool row_ok = row_raw < row_hi;
        const int row = row_ok ? row_raw : row_lo;
        int hi4 = 4 * hi; asm volatile("" : "+v"(hi4));
        unsigned fa[16], fb[16];
        route_top16(p, row, ph, 0, r32, hi, hi4, fa);
        asm volatile("" : "+v"(hi4));
        route_top16(p, row, ph, 1, r32, hi, hi4, fb);
        if (hi == 0) {
            u32x4 wa, wb;
#pragma unroll
            for (int i = 0; i < 4; ++i) {
                wa[i] = (127u - (fa[4 * i] & 127u)) | ((127u - (fa[4 * i + 1] & 127u)) << 8) | ((127u - (fa[4 * i + 2] & 127u)) << 16) | ((127u - (fa[4 * i + 3] & 127u)) << 24);
                wb[i] = (127u - (fb[4 * i] & 127u)) | ((127u - (fb[4 * i + 1] & 127u)) << 8) | ((127u - (fb[4 * i + 2] & 127u)) << 16) | ((127u - (fb[4 * i + 3] & 127u)) << 24);
            }
            *(u32x4*)tb = wa; *(u32x4*)(tb + 16) = wb;
        }
        unsigned g0[16], g1[16], g2[16], g3[16];
#pragma unroll
        for (int j = 0; j < 16; ++j) g0[j] = sum_key(fa[0], fb[j], (unsigned)j);
#pragma unroll
        for (int k = 0; k < 15; ++k) g1[k] = sum_key(fa[k + 1], fb[0], (unsigned)((k + 1) << 4));
        g1[15] = 0u;
#pragma unroll
        for (int j = 1; j < 8; ++j) g2[j - 1] = sum_key(fa[1], fb[j], (unsigned)(16 | j));
        g2[7] = 0u; g2[8] = 0u; g2[9] = 0u;
#pragma unroll
        for (int i = 2; i < 8; ++i) g2[17 - i] = sum_key(fa[i], fb[1], (unsigned)((i << 4) | 1));
#pragma unroll
        for (int j = 8; j > 0; j >>= 1)
#pragma unroll
            for (int i = 0; i < 16; ++i) { const int l = i ^ j; if (l > i) ce_desc(g2[i], g2[l]); }
        g3[0] = sum_key(fa[2], fb[2], 0x22u); g3[1] = sum_key(fa[2], fb[3], 0x23u); g3[2] = sum_key(fa[2], fb[4], 0x24u);
        g3[3] = sum_key(fa[3], fb[2], 0x32u); g3[4] = sum_key(fa[4], fb[2], 0x42u); g3[5] = sum_key(fa[3], fb[3], 0x33u);
#pragma unroll
        for (int i = 6; i < 16; ++i) g3[i] = 0u;
        sort8_desc(g3);
        unsigned t01[16], t23[16], top[16];
        merge_top16(g0, g1, t01); merge_top16(g2, g3, t23); merge_top16(t01, t23, top);
        float ev[16]; float sum = 0.f;
        const float vmax = key_score8(top[0]);
#pragma unroll
        for (int k = 0; k < 16; ++k) { ev[k] = __expf(key_score8(top[k]) - vmax); sum += ev[k]; }
        const float inv = 1.f / sum;
        asm volatile("s_waitcnt lgkmcnt(0)" ::: "memory");
        if (!row_ok) {   } else if (hi == 0) {
            int* dst = p.EIDX + (size_t)row * 128 + ph * 16;
#pragma unroll
            for (int q4 = 0; q4 < 4; ++q4) {
                u32x4 o;
#pragma unroll
                for (int k = 0; k < 4; ++k) { const unsigned tg = top[q4 * 4 + k] & 255u; o[k] = (unsigned)tb[tg >> 4] * 128u + (unsigned)tb[16 + (tg & 15u)]; }
                *(u32x4*)(dst + q4 * 4) = o;
            }
        } else {
            float* dst = p.EGATE + (size_t)row * 128 + ph * 16;
#pragma unroll
            for (int q4 = 0; q4 < 4; ++q4) *(f32x4*)(dst + q4 * 4) = (f32x4){ev[q4 * 4] * inv, ev[q4 * 4 + 1] * inv, ev[q4 * 4 + 2] * inv, ev[q4 * 4 + 3] * inv};
        }
        asm volatile("s_waitcnt lgkmcnt(0)" ::: "memory");
    }
}

constexpr int PA_WAVE_LDS = 1024 + 1024 + 512 + 512 + 512;
DEVI void stage_peer_apply(const P& p, char* smem, int bid, int nblk) {
    const int lane = tid_opq() & 63, wid = tid_opq() >> 6;
    char* wl = smem + wid * PA_WAVE_LDS;
    unsigned char* hhi = (unsigned char*)wl; unsigned char* hlo = hhi + 1024;
    int* idxs = (int*)(wl + 2048);
    float* gts = (float*)(wl + 2560);
    float* cs = (float*)(wl + 3072);
    const int fr = lane & 15, fq = lane >> 4;
    const int tpw = (NT + nblk - 1) / nblk, row_lo = bid * tpw, row_hi = (row_lo + tpw < NT) ? row_lo + tpw : NT;
    for (int row = row_lo + wid; row < row_hi; row += 8) {
        float hv[16];
        {
            const float* hr = p.R + (size_t)row * 1024 + lane * 16;
            const float mean1 = p.H[(size_t)row * 2], rs1 = p.H[(size_t)row * 2 + 1];
            u32x4 ohi, olo;
#pragma unroll
            for (int i = 0; i < 4; ++i) {
                f32x4 x = *(const f32x4*)(hr + i * 4);
                { const f32x4 g1 = *(const f32x4*)(p.ln1_g + lane * 16 + i * 4), b1 = *(const f32x4*)(p.ln1_b + lane * 16 + i * 4);
#pragma unroll
                  for (int k = 0; k < 4; ++k) x[k] = (x[k] - mean1) * rs1 * g1[k] + b1[k]; }
#pragma unroll
                for (int k = 0; k < 4; ++k) hv[i * 4 + k] = x[k];
                int w = __builtin_amdgcn_cvt_pk_fp8_f32(x[0], x[1], 0, false); w = __builtin_amdgcn_cvt_pk_fp8_f32(x[2], x[3], w, true);
                const f32x2 d01 = __builtin_amdgcn_cvt_pk_f32_fp8(w, false), d23 = __builtin_amdgcn_cvt_pk_f32_fp8(w, true);
                int w2 = __builtin_amdgcn_cvt_pk_fp8_f32(x[0] - d01[0], x[1] - d01[1], 0, false); w2 = __builtin_amdgcn_cvt_pk_fp8_f32(x[2] - d23[0], x[3] - d23[1], w2, true);
                ohi[i] = (unsigned)w; olo[i] = (unsigned)w2;
            }
            *(u32x4*)(hhi + lane * 16) = ohi; *(u32x4*)(hlo + lane * 16) = olo;
            idxs[lane] = p.EIDX[(size_t)row * 128 + lane]; idxs[lane + 64] = p.EIDX[(size_t)row * 128 + 64 + lane];
            gts[lane] = p.EGATE[(size_t)row * 128 + lane]; gts[lane + 64] = p.EGATE[(size_t)row * 128 + 64 + lane];
            asm volatile("s_waitcnt lgkmcnt(0)" ::: "memory");
        }
#pragma unroll 1
        for (int g = 0; g < 8; ++g) {
            const int my_e = idxs[g * 16 + fr];
            const unsigned char* ub = p.U8 + (size_t)my_e * 1024 + fq * 16;
            f32x4 acc = (f32x4){0.f, 0.f, 0.f, 0.f};
            u32x4 a[16];
#pragma unroll
            for (int s2 = 0; s2 < 16; ++s2) a[s2] = *(const u32x4*)(ub + s2 * 64);
#pragma unroll
            for (int s2 = 0; s2 < 16; ++s2) {
                const u32x4 bh = *(const u32x4*)(hhi + s2 * 64 + fq * 16), bl = *(const u32x4*)(hlo + s2 * 64 + fq * 16);
                const long a0 = (long)(((unsigned long long)a[s2][1] << 32) | a[s2][0]), a1 = (long)(((unsigned long long)a[s2][3] << 32) | a[s2][2]);
                const long h0 = (long)(((unsigned long long)bh[1] << 32) | bh[0]), h1 = (long)(((unsigned long long)bh[3] << 32) | bh[2]);
                const long l0 = (long)(((unsigned long long)bl[1] << 32) | bl[0]), l1 = (long)(((unsigned long long)bl[3] << 32) | bl[2]);
                acc = __builtin_amdgcn_mfma_f32_16x16x32_fp8_fp8(a0, h0, acc, 0, 0, 0);
                acc = __builtin_amdgcn_mfma_f32_16x16x32_fp8_fp8(a1, h1, acc, 0, 0, 0);
                acc = __builtin_amdgcn_mfma_f32_16x16x32_fp8_fp8(a0, l0, acc, 0, 0, 0);
                acc = __builtin_amdgcn_mfma_f32_16x16x32_fp8_fp8(a1, l1, acc, 0, 0, 0);
            }
            const f32x4 gg = *(const f32x4*)(gts + g * 16 + fq * 4);
            f32x4 cv;
#pragma unroll
            for (int r = 0; r < 4; ++r) {
                const int e = idxs[g * 16 + fq * 4 + r];
                const float d = acc[r] * p.US[e];
                cv[r] = gg[r] * p.VS[e] * 0.5f * d * (1.f + erff(d * 0.7071067811865476f));
            }
            if (fr == 0) *(f32x4*)(cs + g * 16 + fq * 4) = cv;
        }
        asm volatile("s_waitcnt lgkmcnt(0)" ::: "memory");
        float acc[16];
#pragma unroll
        for (int i = 0; i < 16; ++i) acc[i] = 0.f;
#pragma unroll 1
        for (int e0 = 0; e0 < 128; e0 += 16) {
            u32x4 v[16]; float c[16];
#pragma unroll
            for (int k = 0; k < 16; ++k) { v[k] = *(const u32x4*)(p.V8 + (size_t)idxs[e0 + k] * 1024 + lane * 16); c[k] = cs[e0 + k]; }
#pragma unroll
            for (int k = 0; k < 16; ++k) {
#pragma unroll
                for (int w = 0; w < 4; ++w) {
                    const f32x2 lo = __builtin_amdgcn_cvt_pk_f32_fp8((int)v[k][w], false), hh = __builtin_amdgcn_cvt_pk_f32_fp8((int)v[k][w], true);
                    acc[w * 4] += c[k] * lo[0]; acc[w * 4 + 1] += c[k] * lo[1]; acc[w * 4 + 2] += c[k] * hh[0]; acc[w * 4 + 3] += c[k] * hh[1];
                }
            }
        }
        float s = 0.f;
#pragma unroll
        for (int i = 0; i < 16; ++i) { acc[i] += DN_ALPHA * hv[i]; s += acc[i]; }
        const float mean = wave_sum(s) * (1.f / 1024.f);
        float q = 0.f;
#pragma unroll
        for (int i = 0; i < 16; ++i) q += (acc[i] - mean) * (acc[i] - mean);
        const float rs = rsqrtf(wave_sum(q) * (1.f / 1024.f) + LN_EPS);
#pragma unroll
        for (int i = 0; i < 4; ++i) {
            const int c = lane * 16 + i * 4;
            const f32x4 g0 = *(const f32x4*)(p.ln2_g + c), b0 = *(const f32x4*)(p.ln2_b + c);
            f32x4 y0;
#pragma unroll
            for (int k = 0; k < 4; ++k) y0[k] = (acc[i * 4 + k] - mean) * rs * g0[k] + b0[k];
            *(f32x4*)(p.out + O_Y + (size_t)row * 1024 + c) = y0;
        }
    }
}

namespace pg8 {
#define PG8_LAS __attribute__((address_space(3)))
typedef unsigned short bf16_t;
typedef short bf16x8 __attribute__((ext_vector_type(8)));
typedef float f32x4 __attribute__((ext_vector_type(4)));
typedef unsigned u32x4 __attribute__((ext_vector_type(4)));
constexpr int BM = 256, BK = 64, HALF = 128, HTB = HALF * BK * 2  , STAGE_BYTES = 8 * HTB, NXCD = 8, WGM = 8;

__host__ __device__ __forceinline__ int lds_byte(int r, int c) { const int st = (r >> 4) * 2 + (c >> 5), rr = r & 15, cc = c & 31, ob = rr * 64 + cc * 2; return st * 1024 + (ob ^ (((ob >> 9) & 1) << 5)); }
__host__ __device__ __forceinline__ void stage_rc(int b, int& R, int& C) { const int st = b / 1024, sb = b % 1024, swz = sb ^ (((sb >> 9) & 1) << 5); R = (st >> 1) * 16 + swz / 64; C = (st & 1) * 32 + (swz % 64) / 2; }
__host__ __device__ __forceinline__ int perm32(int rho) { const int n = rho >> 4, i = rho & 15; return 8 * (i >> 2) + 4 * n + (i & 3); }

struct Unit { int pm, pn; };
struct Gemm { const bf16_t* A; const bf16_t* Bt; int M, N, K; };

struct StaticOrder {
    int nM, nN, nwg, G, c;
    __host__ __device__ void init(int M, int N, int G_, int c_) { nM = M / BM; nN = N / BM; nwg = nM * nN; G = G_; c = c_; }
    __host__ __device__ bool next(int i, Unit& u) const {
        const long L = (long)i * G + c; if (L >= nwg) return false;
        int wgid = (int)L; { const int q = nwg / NXCD, r = nwg % NXCD, xcd = wgid % NXCD, off = wgid / NXCD; wgid = (xcd < r ? xcd * (q + 1) : r * (q + 1) + (xcd - r) * q) + off; }
        const int nig = WGM * nN, gid = wgid / nig, fm = gid * WGM, gsz = (nM - fm) < WGM ? (nM - fm) : WGM;
        u.pm = fm + ((wgid % nig) % gsz); u.pn = (wgid % nig) / gsz; return true;
    }
    __device__ __forceinline__ void a_ready(const Unit&) const {}
    __device__ __forceinline__ void done(const Unit&) const {}
};
template <class Epi, class Sched, bool STAMP = false>
__device__ __forceinline__ void gemm_phase(PG8_LAS unsigned char* lds, const Gemm g, const Sched& S, const Epi& E, unsigned long long* stamps) {
    const int tid = tid_opq(), wid = __builtin_amdgcn_readfirstlane(tid >> 6), lane = tid & 63, wr = wid >> 2, wc = wid & 3, fr = lane & 15, fq = lane >> 4;
    const int K = g.K, nt = K / BK;
    int ts_lo = 0, ts_hi = 0, nts = 0; const unsigned long long rt_entry = STAMP ? (unsigned long long)wall_clock64() : 0ull;
#define PG8_STAMP() do { if (STAMP && wid == 0 && nts < 64) { const unsigned long long _c = (unsigned long long)clock64(); \
        ts_lo = (lane == nts) ? (int)(unsigned)_c : ts_lo; ts_hi = (lane == nts) ? (int)(unsigned)(_c >> 32) : ts_hi; ++nts; } } while (0)
    PG8_STAMP();
    unsigned voffA[2], voffB[2];
#pragma unroll
    for (int i = 0; i < 2; ++i) { int R, C; stage_rc(tid * 16 + i * 8192, R, C); const int Rb = Epi::PERM ? ((R & ~31) + perm32(R & 31)) : R;
        voffA[i] = (unsigned)(R * K + C) * 2u; voffB[i] = (unsigned)(Rb * K + C) * 2u; }
    const size_t kstep = (size_t)(BK * 2);
    const size_t hstep = (size_t)HALF * K * 2;
    const size_t tstep = 2 * hstep;
    const unsigned ldsw = (unsigned)wid * 1024u;
    const int aoff = lds_byte(wr * 64 + fr, fq * 8), boff = lds_byte(wc * 32 + fr, fq * 8);
#define PG8_SA(b, h) (((b) * 2 + (h)) * HTB)
#define PG8_SB(b, h) ((4 + (b) * 2 + (h)) * HTB)
#define PG8_STAGE(bufoff, gbase, voff) do { _Pragma("unroll") for (int _i = 0; _i < 2; ++_i) \
        __builtin_amdgcn_global_load_lds((const unsigned*)((const char*)(gbase) + (voff)[_i]), (PG8_LAS unsigned*)(lds + (bufoff) + ldsw + _i * 8192), 16, 0, 0); } while (0)
#define PG8_LDA(dst, b, h) do { _Pragma("unroll") for (int m = 0; m < 4; ++m) _Pragma("unroll") for (int k = 0; k < 2; ++k) dst[m][k] = *(const PG8_LAS bf16x8*)(lds + PG8_SA(b, h) + aoff + m * 2048 + k * 1024); } while (0)
#define PG8_LDB(dst, b, h) do { _Pragma("unroll") for (int n = 0; n < 2; ++n) _Pragma("unroll") for (int k = 0; k < 2; ++k) dst[n][k] = *(const PG8_LAS bf16x8*)(lds + PG8_SB(b, h) + boff + n * 2048 + k * 1024); } while (0)
#define PG8_MMA(ai, bj, At, Bt) do { __builtin_amdgcn_s_setprio(1); _Pragma("unroll") for (int m = 0; m < 4; ++m) _Pragma("unroll") for (int n = 0; n < 2; ++n) _Pragma("unroll") for (int k = 0; k < 2; ++k) \
        acc[ai][bj][m][n] = __builtin_amdgcn_mfma_f32_16x16x32_bf16(Bt[n][k], At[m][k], acc[ai][bj][m][n], 0, 0, 0); __builtin_amdgcn_s_setprio(0); } while (0)
#define PG8_WAIT_V(n) asm volatile("s_waitcnt vmcnt(" #n ")" ::: "memory")
#define PG8_WAIT_L(n) asm volatile("s_waitcnt lgkmcnt(" #n ")" ::: "memory")
#define PG8_BAR __builtin_amdgcn_s_barrier()
#define PG8_SCHED __builtin_amdgcn_sched_barrier(0)
    Unit cur, nxt; int ui = 0;
    if (!S.next(0, cur)) return;
    f32x4 acc[2][2][4][2];
#pragma unroll
    for (int a = 0; a < 2; ++a)
#pragma unroll
        for (int b = 0; b < 2; ++b)
#pragma unroll
            for (int m = 0; m < 4; ++m)
#pragma unroll
                for (int n = 0; n < 2; ++n) acc[a][b][m][n] = (f32x4){0.f, 0.f, 0.f, 0.f};
    bf16x8 At[4][2], B0[2][2], B1[2][2];
    const char* cA = (const char*)g.A + (size_t)cur.pm * tstep; const char* cB = (const char*)g.Bt + (size_t)cur.pn * tstep;
    S.a_ready(cur);
    PG8_STAGE(PG8_SB(0, 0), cB, voffB); PG8_STAGE(PG8_SA(0, 0), cA, voffA); PG8_STAGE(PG8_SB(0, 1), cB + hstep, voffB); PG8_STAGE(PG8_SA(0, 1), cA + hstep, voffA);
    if (wr == 1) PG8_BAR;
    PG8_WAIT_V(4); PG8_BAR;
    PG8_STAGE(PG8_SB(1, 0), cB + kstep, voffB); PG8_STAGE(PG8_SA(1, 0), cA + kstep, voffA); PG8_STAGE(PG8_SB(1, 1), cB + hstep + kstep, voffB);
    PG8_WAIT_V(6); PG8_BAR;
    PG8_STAMP();
    for (;;) {
        const bool has_next = S.next(ui + 1, nxt);
        const char* nA = has_next ? (const char*)g.A + (size_t)nxt.pm * tstep : cA; const char* nB = has_next ? (const char*)g.Bt + (size_t)nxt.pn * tstep : cB;
        for (int t = 0; t < nt; t += 2) {
            const bool last = (t == nt - 2);
            const char* a1 = cA + (size_t)(t + 1) * kstep;
            const char* a2 = last ? nA : cA + (size_t)(t + 2) * kstep; const char* b2 = last ? nB : cB + (size_t)(t + 2) * kstep;
            const char* a3 = a2 + kstep; const char* b3 = b2 + kstep;
            if (last && has_next) S.a_ready(nxt);
            PG8_LDB(B0, 0, 0); PG8_SCHED; PG8_LDA(At, 0, 0); PG8_STAGE(PG8_SA(1, 1), a1 + hstep, voffA);
            PG8_WAIT_L(8); PG8_BAR; PG8_WAIT_L(0); PG8_MMA(0, 0, At, B0); PG8_BAR; PG8_SCHED;
            PG8_LDB(B1, 0, 1); PG8_STAGE(PG8_SB(0, 0), b2, voffB);
            PG8_BAR; PG8_WAIT_L(0); PG8_MMA(0, 1, At, B1); PG8_BAR;
            PG8_LDA(At, 0, 1); PG8_STAGE(PG8_SA(0, 0), a2, voffA);
            PG8_BAR; PG8_WAIT_L(0); PG8_MMA(1, 0, At, B0); PG8_BAR; PG8_SCHED;
            PG8_STAGE(PG8_SB(0, 1), b2 + hstep, voffB);
            PG8_WAIT_V(6); PG8_BAR; PG8_MMA(1, 1, At, B1); PG8_BAR;
            PG8_LDB(B0, 1, 0); PG8_SCHED; PG8_LDA(At, 1, 0); PG8_STAGE(PG8_SA(0, 1), a2 + hstep, voffA);
            PG8_WAIT_L(8); PG8_BAR; PG8_WAIT_L(0); PG8_MMA(0, 0, At, B0); PG8_BAR; PG8_SCHED;
            PG8_LDB(B1, 1, 1); PG8_STAGE(PG8_SB(1, 0), b3, voffB);
            PG8_BAR; PG8_WAIT_L(0); PG8_MMA(0, 1, At, B1); PG8_BAR;
            PG8_LDA(At, 1, 1); PG8_STAGE(PG8_SA(1, 0), a3, voffA);
            PG8_BAR; PG8_WAIT_L(0); PG8_MMA(1, 0, At, B0); PG8_BAR; PG8_SCHED;
            PG8_STAGE(PG8_SB(1, 1), b3 + hstep, voffB);
            PG8_WAIT_V(6); PG8_BAR; PG8_MMA(1, 1, At, B1); PG8_BAR;
        }
        PG8_STAMP();
        if constexpr (!Epi::AFTER_DRAIN) { E(acc, cur, wr, wc, fr, fq); S.done(cur); }
        PG8_STAMP();
        if (!has_next) break;
#pragma unroll
        for (int a = 0; a < 2; ++a)
#pragma unroll
            for (int b = 0; b < 2; ++b)
#pragma unroll
                for (int m = 0; m < 4; ++m)
#pragma unroll
                    for (int n = 0; n < 2; ++n) acc[a][b][m][n] = (f32x4){0.f, 0.f, 0.f, 0.f};
        cur = nxt; cA = nA; cB = nB; ++ui;
    }
    PG8_WAIT_V(0);
    if (wr == 0) PG8_BAR;
    PG8_BAR;
    if constexpr (Epi::AFTER_DRAIN) { E.fused(acc, cur, wr, wc, fr, fq, lds, wid, lane); S.done(cur); }
    PG8_STAMP();
    if (STAMP && wid == 0) { stamps[lane] = lane < nts ? (((unsigned long long)(unsigned)ts_hi << 32) | (unsigned)ts_lo) : 0ull;
        if (lane == 62) stamps[62] = rt_entry; if (lane == 63) stamps[63] = (unsigned long long)wall_clock64(); }
#undef PG8_STAMP
#undef PG8_SA
#undef PG8_SB
#undef PG8_STAGE
#undef PG8_LDA
#undef PG8_LDB
#undef PG8_MMA
#undef PG8_WAIT_V
#undef PG8_WAIT_L
#undef PG8_BAR
#undef PG8_SCHED
}
}

template <class F> struct EpiAdapt {
    static constexpr bool PERM = true, AFTER_DRAIN = false;
    F f;
    __device__ __forceinline__ void operator()(const pg8::f32x4 (&acc)[2][2][4][2], const pg8::Unit& u, int wr, int wc, int fr, int fq) const {
        constexpr int B = F::BATCH;
        const int row0 = u.pm * 256 + wr * 64 + fr, col0 = u.pn * 256 + wc * 32 + 8 * fq;
        f32x4 b0[2], b1[2];
        if constexpr (F::COLBIAS) { f.bias8(col0, b0[0], b1[0]); f.bias8(col0 + 128, b0[1], b1[1]); }
#pragma unroll
        for (int q0 = 0; q0 < 16; q0 += B) {
            typename F::Pre pre[B];
#pragma unroll
            for (int i = 0; i < B; ++i) { const int q = q0 + i, bj = q & 1, m = (q >> 1) & 3, ai = q >> 3; pre[i] = f.pre(row0 + ai * 128 + m * 16, col0 + bj * 128); }
#pragma unroll
            for (int i = 0; i < B; ++i) { const int q = q0 + i, bj = q & 1, m = (q >> 1) & 3, ai = q >> 3;
                f32x4 v0 = acc[ai][bj][m][0], v1 = acc[ai][bj][m][1];
                if constexpr (F::COLBIAS) { v0 += b0[bj]; v1 += b1[bj]; }
                f.put(row0 + ai * 128 + m * 16, col0 + bj * 128, v0, v1, pre[i]); }
        }
    }
};
template <class F>
DEVI void gemm_pg8(const bf16_t* A, const bf16_t* Bt, int M, int N, int K, const F& f, char* smem, int bid, int nblk) {
    pg8::Gemm g{A, Bt, M, N, K};
    pg8::StaticOrder S; S.init(M, N, nblk, bid);
    EpiAdapt<F> E{f};
    __syncthreads();
    pg8::gemm_phase<EpiAdapt<F>, pg8::StaticOrder, false>((PG8_LAS unsigned char*)smem, g, S, E, nullptr);
    __syncthreads();
}

template <class F>
DEVI void gemm_small_rows(const bf16_t* __restrict__ A, const bf16_t* __restrict__ Bt, int N, const F& f, char* smem, int bid, int nblk) {
    const int tid = tid_opq(), lane = tid & 63, wid = tid >> 6, fr = lane & 15, fq = lane >> 4;
    float* part = (float*)smem;
    const int ntn = N / 64, ntiles = (NTS / 32) * ntn;
    for (int tile = bid; tile < ntiles; tile += nblk) {
        const int tm = tile / ntn, tn = tile % ntn;
        const int row0 = NTP + tm * 32, col0 = tn * 64;
        f32x4 acc[2][4];
#pragma unroll
        for (int m = 0; m < 2; ++m)
#pragma unroll
            for (int n = 0; n < 4; ++n) acc[m][n] = (f32x4){0.f, 0.f, 0.f, 0.f};
        const bf16_t* ap = A + (size_t)(row0 + fr) * 1024 + wid * 128 + fq * 8;
        const bf16_t* bp = Bt + (size_t)(col0 + fr) * 1024 + wid * 128 + fq * 8;
        bf16x8 af[4][2], bfr[4][4];
#pragma unroll
        for (int ks = 0; ks < 4; ++ks) {
#pragma unroll
            for (int m = 0; m < 2; ++m) af[ks][m] = *(const bf16x8*)(ap + (size_t)m * 16 * 1024 + ks * 32);
#pragma unroll
            for (int n = 0; n < 4; ++n) bfr[ks][n] = *(const bf16x8*)(bp + (size_t)n * 16 * 1024 + ks * 32);
        }
#pragma unroll
        for (int ks = 0; ks < 4; ++ks)
#pragma unroll
            for (int m = 0; m < 2; ++m)
#pragma unroll
                for (int n = 0; n < 4; ++n) acc[m][n] = __builtin_amdgcn_mfma_f32_16x16x32_bf16(bfr[ks][n], af[ks][m], acc[m][n], 0, 0, 0);
        __syncthreads();
#pragma unroll
        for (int m = 0; m < 2; ++m)
#pragma unroll
            for (int n = 0; n < 4; ++n) *(f32x4*)(part + ((size_t)wid * 32 + m * 16 + fr) * 64 + n * 16 + fq * 4) = acc[m][n];
        __syncthreads();
        if (tid < 256) {
            const int r = tid >> 3, c8 = (tid & 7) * 8;
            f32x4 v0 = {0.f, 0.f, 0.f, 0.f}, v1 = v0;
#pragma unroll
            for (int w = 0; w < 8; ++w) { v0 += *(const f32x4*)(part + ((size_t)w * 32 + r) * 64 + c8); v1 += *(const f32x4*)(part + ((size_t)w * 32 + r) * 64 + c8 + 4); }
            const typename F::Pre pre = f.pre(row0 + r, col0 + c8);
            f.put(row0 + r, col0 + c8, v0, v1, pre);
        }
    }
}
template <class F>
DEVI void gemm_tail(const bf16_t* A, const bf16_t* Bt, int N, const F& f, char* smem, int bid, int nblk) {
    gemm_small_rows(A, Bt, N, f, smem, bid, nblk);
    gemm_pg8(A, Bt, NTP, N, 1024, f, smem, bid, nblk);
}

#define XB_TMO      128
#define XB_XCNT(j)  (256  + 64 * (j))
#define XB_XSUB(j)  (1280 + 64 * (j))
#define XB_XGEN(j)  (2304 + 64 * (j))
#define XB_TOP      3328
#define XB_TOPGEN   3392
#define XCD_BAR_WORDS 3456
#define XB_SPIN_CAP (1u << 18)
#define LAS __attribute__((address_space(3)))

__device__ __forceinline__ unsigned xb_ld(unsigned* p)              { return __hip_atomic_load(p, __ATOMIC_RELAXED, __HIP_MEMORY_SCOPE_AGENT); }
__device__ __forceinline__ unsigned xb_add(unsigned* p, unsigned v) { return __hip_atomic_fetch_add(p, v, __ATOMIC_RELAXED, __HIP_MEMORY_SCOPE_AGENT); }
__device__ __forceinline__ unsigned xb_xcc_id() { return (unsigned)__builtin_amdgcn_s_getreg((3 << 11) | 20) & 0xFu; }
#define XB_SPIN(cond, bar) do { unsigned _sp = 0; while (cond) { __builtin_amdgcn_s_sleep(1); \
    if ((++_sp & 255u) == 0u) { if (xb_ld(&(bar)[XB_TMO])) break; if (_sp > XB_SPIN_CAP) { atomicAdd(&(bar)[XB_TMO], 1u); break; } } } } while (0)

struct XcdBarrier {
    unsigned* bar; unsigned x;
    volatile LAS unsigned* st;
};

__device__ __forceinline__ XcdBarrier xcd_barrier_post(unsigned* bar, volatile LAS unsigned* st) {
    XcdBarrier b; b.bar = bar; b.x = xb_xcc_id(); b.st = st;
    if (tid_opq() == 0) (void)xb_add(&bar[XB_XCNT(b.x)], 1u);
    return b;
}
__device__ __forceinline__ void xcd_barrier_complete(unsigned* bar, unsigned x, unsigned& nloc, unsigned& nx) {
    const unsigned G = gridDim.x * gridDim.y * gridDim.z;
    unsigned sum, cnt, mine, sp = 0u;
    for (;;) {
        sum = 0u; cnt = 0u; mine = 0u;
#pragma unroll
        for (unsigned j = 0; j < 16; ++j) { const unsigned c = xb_ld(&bar[XB_XCNT(j)]); sum += c; cnt += (c > 0u) ? 1u : 0u; mine = (j == x) ? c : mine; }
        if (sum == G) break;
        __builtin_amdgcn_s_sleep(1);
        if ((++sp & 255u) == 0u) { if (xb_ld(&bar[XB_TMO])) break; if (sp > XB_SPIN_CAP) { atomicAdd(&bar[XB_TMO], 1u); break; } }
    }
    nloc = mine > 0u ? mine : 1u; nx = cnt > 0u ? cnt : 1u;
}

__device__ __forceinline__ void xcd_barrier(const XcdBarrier& b) {
    asm volatile("s_waitcnt vmcnt(0)" ::: "memory");
    __syncthreads();
    if (tid_opq() == 0) {
        unsigned* bar = b.bar;
        __builtin_amdgcn_s_waitcnt(0);
        unsigned nloc = b.st[0], nx = b.st[1];
        if (nloc == 0u) { xcd_barrier_complete(bar, b.x, nloc, nx); b.st[0] = nloc; b.st[1] = nx; }
        const unsigned old = xb_add(&bar[XB_XSUB(b.x)], 1u);
        const unsigned gen = old / nloc;
        if (old + 1u == (gen + 1u) * nloc) {
            __builtin_amdgcn_fence(__ATOMIC_RELEASE, "agent");
            asm volatile("s_waitcnt vmcnt(0)" ::: "memory");
            const unsigned og = xb_add(&bar[XB_TOP], 1u);
            const unsigned tg = og / nx;
            if (og + 1u == (tg + 1u) * nx) xb_add(&bar[XB_TOPGEN], 1u);
            else XB_SPIN(xb_ld(&bar[XB_TOPGEN]) == tg, bar);
            __builtin_amdgcn_fence(__ATOMIC_ACQUIRE, "agent");
            xb_add(&bar[XB_XGEN(b.x)], 1u);
            asm volatile("s_waitcnt vmcnt(0)" ::: "memory");
        } else {
            XB_SPIN(xb_ld(&bar[XB_XGEN(b.x)]) == gen, bar);
            __builtin_amdgcn_fence(__ATOMIC_ACQUIRE, "agent");
            asm volatile("s_waitcnt vmcnt(0)" ::: "memory");
        }
    }
    __syncthreads();
}

constexpr int LDS_BYTES = 152 * 1024;

template <int S>
DEVI void run_stage(const P& p, char* smem, int bid, int nblk) {
    if (S == 0) stage_prologue(p, smem, bid, nblk);
    if (S == 1) { EpiInProj e{p}; gemm_pg8(p.XB, p.WINT, NT, NPAD_IN + 2048, 1024, e, smem, bid, nblk); }
    if (S == 2) { stage_mlstm_gates(p, smem, bid, nblk); stage_compress(p, smem, bid, nblk); stage_mlstm_dc(p, smem, bid, nblk); stage_mlstm_sample(p, smem, bid, nblk); }
    if (S == 4) { stage_mlstm_scan(p, bid, nblk); stage_nsa_attn(p, smem, bid, nblk); }
    if (S == 5) { stage_mlstm_out(p, smem, bid, nblk); { EpiM1 e{p}; gemm_tail(p.YB, p.WBT, 1024, e, smem, bid, nblk); } }
    if (S == 6) { EpiM2 e{p}; gemm_tail(p.YA, p.WAT, 1024, e, smem, bid, nblk); }
    if (S == 8) { EpiR e{p}; gemm_tail(p.MERGED, p.WOT, 1024, e, smem, bid, nblk); }
    if (S == 9) stage_ln1(p, bid, nblk);
    if (S == 10) { EpiPQ e{p}; gemm_tail(p.HB, p.WQT, 2048, e, smem, bid, nblk); }
    if (S == 11) { stage_peer_route(p, smem, bid, nblk); __threadfence_block(); __syncthreads(); stage_peer_apply(p, smem, bid, nblk); }
}
constexpr int NSTAGES = 13;

template <int S>
__global__ void __launch_bounds__(512, 2) k_stage(P p) {
    extern __shared__ __attribute__((aligned(16))) char smem[];
    run_stage<S>(p, smem, blockIdx.x, gridDim.x);
}


#if MK_ONE_LAUNCH
__global__ void __launch_bounds__(512, 2) k_mega(P p) {
    extern __shared__ __attribute__((aligned(16))) char smem_all[];
    if (tid_opq() == 0) *(u32x4*)smem_all = (u32x4){0u, 0u, 0u, 0u};
    __syncthreads();
    XcdBarrier bar = xcd_barrier_post(p.bar, (volatile LAS unsigned*)smem_all);
    char* smem = smem_all + 16;
    const int bid = blockIdx.x, nblk = gridDim.x;
    run_stage<0>(p, smem, bid, nblk); if ((REP_MASK >> 0) & 1) { xcd_barrier(bar); run_stage<0>(p, smem, bid, nblk); }  xcd_barrier(bar);
    run_stage<1>(p, smem, bid, nblk); if ((REP_MASK >> 1) & 1) { xcd_barrier(bar); run_stage<1>(p, smem, bid, nblk); }  xcd_barrier(bar);
    run_stage<2>(p, smem, bid, nblk); if ((REP_MASK >> 2) & 1) { xcd_barrier(bar); run_stage<2>(p, smem, bid, nblk); }  xcd_barrier(bar);
    run_stage<4>(p, smem, bid, nblk); if ((REP_MASK >> 4) & 1) { xcd_barrier(bar); run_stage<4>(p, smem, bid, nblk); }  xcd_barrier(bar);
    run_stage<5>(p, smem, bid, nblk); if ((REP_MASK >> 5) & 1) { xcd_barrier(bar); run_stage<5>(p, smem, bid, nblk); }  xcd_barrier(bar);
    run_stage<6>(p, smem, bid, nblk); if ((REP_MASK >> 6) & 1) { xcd_barrier(bar); run_stage<6>(p, smem, bid, nblk); }  xcd_barrier(bar);
    run_stage<8>(p, smem, bid, nblk); if ((REP_MASK >> 8) & 1) { xcd_barrier(bar); run_stage<8>(p, smem, bid, nblk); }  xcd_barrier(bar);
    run_stage<9>(p, smem, bid, nblk); if ((REP_MASK >> 9) & 1) { xcd_barrier(bar); run_stage<9>(p, smem, bid, nblk); }  xcd_barrier(bar);
    run_stage<10>(p, smem, bid, nblk); if ((REP_MASK >> 10) & 1) { xcd_barrier(bar); run_stage<10>(p, smem, bid, nblk); } xcd_barrier(bar);
    run_stage<11>(p, smem, bid, nblk); if ((REP_MASK >> 11) & 1) { xcd_barrier(bar); run_stage<11>(p, smem, bid, nblk); }
}
#endif

template <int S> static void launch_stage(const P& p, int grid, hipStream_t stream) {
    (void)hipFuncSetAttribute((const void*)k_stage<S>, hipFuncAttributeMaxDynamicSharedMemorySize, LDS_BYTES);
    k_stage<S><<<dim3(grid), dim3(512), LDS_BYTES, stream>>>(p);
}

extern "C" void kernel_launch(void* const* d_in, const int* in_sizes, int n_in, void* d_out, int out_size, void* d_ws, size_t ws_size, hipStream_t stream) {
    (void)in_sizes; (void)n_in; (void)out_size; (void)ws_size;
    P p{};
    p.xp = (const float*)d_in[0]; p.xs = (const float*)d_in[1]; p.cache_cmp = (const float*)d_in[2]; p.cache_slc = (const float*)d_in[3];
    p.cache_win = (const float*)d_in[4]; p.state_C = (const float*)d_in[5]; p.state_n = (const float*)d_in[6]; p.state_m = (const float*)d_in[7];
    p.page_table = (const int*)d_in[8];
    p.w_in = (const float*)d_in[9]; p.b_in = (const float*)d_in[10]; p.norm_a_g = (const float*)d_in[11]; p.nsa_pe = (const float*)d_in[12];
    p.nsa_w_cmp = (const float*)d_in[13]; p.w_br_a = (const float*)d_in[14]; p.w_br_b = (const float*)d_in[15]; p.w_merge = (const float*)d_in[16];
    p.w_out = (const float*)d_in[17]; p.ln1_g = (const float*)d_in[18]; p.ln1_b = (const float*)d_in[19];
    p.peer_wq = (const float*)d_in[20]; p.peer_keys = (const float*)d_in[21]; p.peer_u = (const float*)d_in[22]; p.peer_v = (const float*)d_in[23];
    p.ln2_g = (const float*)d_in[24]; p.ln2_b = (const float*)d_in[25];
    p.out = (float*)d_out;
    char* w = (char*)d_ws; size_t off = 0;
    auto take = [&](size_t bytes) { char* r = w + off; off += (bytes + 255) & ~(size_t)255; return r; };
    p.bar = (unsigned*)take(16384);
    p.PW = (float*)(p.bar + 3584);
    p.WCT = (bf16_t*)take((size_t)2 * 64 * 4096 * 2);
    p.XB = (bf16_t*)take((size_t)NT * 1024 * 2);
    p.WINT = (bf16_t*)take((size_t)(NPAD_IN + 2048) * 1024 * 2);
    p.WMT = (bf16_t*)take((size_t)2048 * 1024 * 2);
    p.WAT = (bf16_t*)take((size_t)1024 * 1024 * 2);
    p.WBT = (bf16_t*)take((size_t)1024 * 1024 * 2);
    p.WOT = (bf16_t*)take((size_t)1024 * 1024 * 2);
    p.WQT = (bf16_t*)take((size_t)2048 * 1024 * 2);
    p.KEYSB = (bf16_t*)take((size_t)16 * 128 * 128 * 2);
    p.U8 = (unsigned char*)take((size_t)16384 * 1024);
    p.V8 = (unsigned char*)take((size_t)16384 * 1024);
    p.US = (float*)take(16384 * 4);
    p.VS = (float*)take(16384 * 4);
    p.PROJ = (bf16_t*)take((size_t)NT * PS * 2);
    p.SM = (float*)take((size_t)NT * 64 * 4);
    p.BCUM = (float*)take((size_t)16 * 4096 * 4);
    p.MPREV = (float*)take(4096); p.ACOEF = (float*)take(4096); p.SCL = (float*)take(4096); p.MLOC = (float*)take(4096);
    p.DC = (float*)take((size_t)1024 * 272 * 128 * 4);
    p.CPT = (bf16_t*)take((size_t)1024 * 272 * 128 * 2);
    p.KC = (float*)take((size_t)4352 * 512 * 4);
    p.VC = p.KC + 256;
    p.OCMP = (float*)take((size_t)NT * 1024 * 4);
    p.SEL = (unsigned long long*)take((size_t)NT * 4 * 8);
    p.YA = (bf16_t*)take((size_t)NT * 1024 * 2);
    p.YB = (bf16_t*)take((size_t)NT * 1024 * 2);
    p.G = (bf16_t*)take((size_t)NT * 2048 * 2);
    p.TMPB = (bf16_t*)take((size_t)NT * 1024 * 2);
    p.MERGED = (bf16_t*)take((size_t)NT * 1024 * 2);
    p.R = (float*)take((size_t)NT * 1024 * 4);
    p.H = (float*)take((size_t)NT * 1024 * 4);
    p.HB = (bf16_t*)take((size_t)NT * 1024 * 2);
    p.PQ = (bf16_t*)take((size_t)NT * 2048 * 2);
    p.EIDX = (int*)take((size_t)NT * 128 * 4);
    p.EGATE = (float*)take((size_t)NT * 128 * 4);

    (void)hipMemsetAsync(p.bar, 0, 16384, stream);
#if MK_ONE_LAUNCH
    {
        constexpr size_t kDynLds = LDS_BYTES + 16;
        (void)hipFuncSetAttribute((const void*)k_mega, hipFuncAttributeMaxDynamicSharedMemorySize, (int)kDynLds);
        int dev = 0, cus = 0, per_cu = 0;
        (void)hipGetDevice(&dev);
        (void)hipDeviceGetAttribute(&cus, hipDeviceAttributeMultiprocessorCount, dev);
        (void)hipOccupancyMaxActiveBlocksPerMultiprocessor(&per_cu, (const void*)k_mega, 512, kDynLds);
        if (per_cu < 1 || cus < 1) return;
        const int grid = cus;
        k_mega<<<dim3(grid), dim3(512), kDynLds, stream>>>(p);
    }
#else
    const int grid = 512;
    launch_stage<0>(p, grid, stream);
    launch_stage<1>(p, grid, stream);
    launch_stage<2>(p, grid, stream);
    launch_stage<4>(p, grid, stream);
    launch_stage<5>(p, grid, stream);
    launch_stage<6>(p, grid, stream);
    launch_stage<8>(p, grid, stream);
    launch_stage<9>(p, grid, stream);
    launch_stage<10>(p, grid, stream);
    launch_stage<11>(p, grid, stream);
#endif
}
```

```cpp
#include <hip/hip_runtime.h>
#include <stdint.h>

#ifndef REP_MASK
#define REP_MASK 0
#endif
#ifndef MK_ONE_LAUNCH
#define MK_ONE_LAUNCH 1
#endif

typedef unsigned short bf16_t;
typedef short bf16x8 __attribute__((ext_vector_type(8)));
typedef float f32x4 __attribute__((ext_vector_type(4)));
typedef unsigned u32x4 __attribute__((ext_vector_type(4)));
typedef unsigned u32x2 __attribute__((ext_vector_type(2)));
typedef float f32x2 __attribute__((ext_vector_type(2)));
typedef __bf16 bf16x2_t __attribute__((ext_vector_type(2)));
#define DEVI __device__ __forceinline__
__device__ __forceinline__ int tid_opq() { int t = threadIdx.x; asm volatile("" : "+v"(t)); return t; }

constexpr int NTP = 16384, NTS = 512, NT = NTP + NTS, DM = 1024;
constexpr int PS = 5632;
constexpr int C_AQ = 0, C_AK = 512, C_AV = 1024, C_AO = 2048, C_BQ = 3072, C_CMP = 4096, C_SLC = 4608, C_WIN = 5120;
constexpr int NPAD_IN = 5888;
constexpr float DN_ALPHA = 1.189207115002721f;
constexpr float LN_EPS = 1e-5f;
constexpr size_t O_Y = 0;
constexpr size_t O_PCMP = O_Y + (size_t)NT * 1024;
constexpr size_t O_PSLC = O_PCMP + (size_t)NTP * 512;
constexpr size_t O_PWIN = O_PSLC + (size_t)NTP * 512;
constexpr size_t O_PC = O_PWIN + (size_t)4 * 512 * 512;
constexpr size_t O_PN = O_PC + (size_t)16 * 128 * 256;
constexpr size_t O_PM = O_PN + 16 * 128;
constexpr size_t O_SCMP = O_PM + 16;
constexpr size_t O_SSLC = O_SCMP + (size_t)NTS * 512;
constexpr size_t O_SWIN = O_SSLC + (size_t)NTS * 512;
constexpr size_t O_SC = O_SWIN + (size_t)128 * 512 * 512;
constexpr size_t O_SN = O_SC + (size_t)512 * 128 * 256;
constexpr size_t O_SM = O_SN + 512 * 128;

struct P {
    const float *xp, *xs, *cache_cmp, *cache_slc, *cache_win, *state_C, *state_n, *state_m;
    const int* page_table;
    const float *w_in, *b_in, *norm_a_g, *nsa_pe, *nsa_w_cmp, *w_br_a, *w_br_b, *w_merge, *w_out, *ln1_g, *ln1_b;
    const float *peer_wq, *peer_keys, *peer_u, *peer_v, *ln2_g, *ln2_b;
    float* out;
    bf16_t *XB, *WINT, *WMT, *WAT, *WBT, *WOT, *WQT, *KEYSB, *UB, *VB, *PROJ, *WCT;
    float* PW;
    float *SM, *BCUM, *MPREV, *ACOEF, *SCL, *MLOC, *DC, *KC, *VC, *OCMP;
    bf16_t* CPT;
    unsigned char *U8, *V8;
    float *US, *VS;
    unsigned long long* SEL;
    bf16_t *YA, *YB, *G, *MERGED, *HB, *PQ;
    float *R, *H, *EGATE;
    bf16_t* TMPB;
    int* EIDX;
    unsigned* bar;
};

DEVI bf16_t f2bf(float f) { return __builtin_bit_cast(unsigned short, (__bf16)f); }
DEVI float bf2f(bf16_t h) { return __uint_as_float(((unsigned)h) << 16); }
DEVI unsigned pack2(float a, float b) { return __builtin_bit_cast(unsigned, __builtin_convertvector((f32x2){a, b}, bf16x2_t)); }
DEVI u32x4 pack8f(const f32x4 a, const f32x4 b) { u32x4 r; r[0] = pack2(a[0], a[1]); r[1] = pack2(a[2], a[3]); r[2] = pack2(b[0], b[1]); r[3] = pack2(b[2], b[3]); return r; }
DEVI float wave_max(float v) { for (int o = 32; o > 0; o >>= 1) v = fmaxf(v, __shfl_xor(v, o)); return v; }
DEVI float wave_sum(float v) { for (int o = 32; o > 0; o >>= 1) v += __shfl_xor(v, o); return v; }
DEVI float sigmoidf_(float x) { return 1.f / (1.f + __expf(-x)); }
DEVI float logsigmoidf_(float x) { return fminf(x, 0.f) - log1pf(__expf(-fabsf(x))); }
DEVI int win_map(int np) {
    if (np < 2048) return np;
    if (np < 5632) return np + 8;
    if (np < 5640) return np - 5632 + 2048;
    if (np < 5688) return np;
    return -1;
}
DEVI float alibi_slope(int h) { return exp2f(-0.5f * (float)(h + 1)); }

template <class MapFn>
DEVI void transpose_cvt(const float* __restrict__ W, bf16_t* __restrict__ WT, int K, int Nsrc, int Ndst, MapFn mapfn, float* tile  , int bid, int nblk) {
    const int tid = tid_opq();
    const int tn = Ndst / 64, tk = K / 64;
    for (int t = bid; t < tn * tk; t += nblk) {
        const int n0 = (t % tn) * 64, k0 = (t / tn) * 64;
        __syncthreads();
#pragma unroll
        for (int i = 0; i < 8; ++i) {
            const int kk = (tid >> 6) + i * 8, nn = tid & 63;
            const int n = mapfn(n0 + nn);
            tile[kk * 65 + nn] = n >= 0 ? W[(size_t)(k0 + kk) * Nsrc + n] : 0.f;
        }
        __syncthreads();
#pragma unroll
        for (int i = 0; i < 8; ++i) {
            const int nn = (tid >> 6) + i * 8, kk = tid & 63;
            WT[(size_t)(n0 + nn) * K + k0 + kk] = f2bf(tile[kk * 65 + nn]);
        }
    }
}
struct IdMap { DEVI int operator()(int n) const { return n; } };
struct WinMap { DEVI int operator()(int n) const { return win_map(n); } };

DEVI void cvt_rows(const float* __restrict__ src, bf16_t* __restrict__ dst, size_t n4, int bid, int nblk) {
    const size_t stride = (size_t)nblk * 512;
    for (size_t i0 = (size_t)bid * 512 + tid_opq(); i0 < n4; i0 += stride * 8) {
        f32x4 v[8];
#pragma unroll
        for (int u = 0; u < 8; ++u) { const size_t i = i0 + u * stride; v[u] = i < n4 ? __builtin_nontemporal_load((const f32x4*)src + i) : (f32x4){0.f, 0.f, 0.f, 0.f}; }
#pragma unroll
        for (int u = 0; u < 8; ++u) { const size_t i = i0 + u * stride; if (i < n4) { u32x2 o; o.x = pack2(v[u][0], v[u][1]); o.y = pack2(v[u][2], v[u][3]); ((u32x2*)dst)[i] = o; } }
    }
}

DEVI void stage_prologue(const P& p, char* smem, int bid, int nblk) {
    float* tile = (float*)smem;
    cvt_rows(p.xp, p.XB, (size_t)NTP * 256, bid, nblk);
    cvt_rows(p.xs, p.XB + (size_t)NTP * 1024, (size_t)NTS * 256, bid, nblk);
    {
        const int lane = tid_opq() & 63, wid = tid_opq() >> 6;
        for (int r0 = bid * 8 + wid; r0 < 2 * 16384; r0 += nblk * 8 * 2) {
            f32x4 x[2][4]; float am[2] = {0.f, 0.f};
#pragma unroll
            for (int j = 0; j < 2; ++j) {
                const int r = r0 + j * nblk * 8;
                if (r < 2 * 16384) {
                    const bool isv = r >= 16384; const int e = isv ? r - 16384 : r;
                    const float* src = (isv ? p.peer_v : p.peer_u) + (size_t)e * 1024 + lane * 16;
#pragma unroll
                    for (int i = 0; i < 4; ++i) x[j][i] = __builtin_nontemporal_load((const f32x4*)(src + i * 4));
                }
            }
#pragma unroll
            for (int j = 0; j < 2; ++j) {
                const int r = r0 + j * nblk * 8;
                if (r < 2 * 16384) {
                    const bool isv = r >= 16384; const int e = isv ? r - 16384 : r;
#pragma unroll
                    for (int i = 0; i < 4; ++i)
#pragma unroll
                        for (int k = 0; k < 4; ++k) am[j] = fmaxf(am[j], fabsf(x[j][i][k]));
                    const float amx = wave_max(am[j]);
                    const float inv = amx > 0.f ? 448.f / amx : 1.f;
                    u32x4 o;
#pragma unroll
                    for (int i = 0; i < 4; ++i) { int w = __builtin_amdgcn_cvt_pk_fp8_f32(x[j][i][0] * inv, x[j][i][1] * inv, 0, false); w = __builtin_amdgcn_cvt_pk_fp8_f32(x[j][i][2] * inv, x[j][i][3] * inv, w, true); o[i] = (unsigned)w; }
                    *(u32x4*)((isv ? p.V8 : p.U8) + (size_t)e * 1024 + lane * 16) = o;
                    if (lane == 0) (isv ? p.VS : p.US)[e] = amx > 0.f ? amx / 448.f : 1.f;
                }
            }
        }
    }
    cvt_rows(p.peer_keys, p.KEYSB, (size_t)16 * 128 * 128 / 4, bid, nblk);
    transpose_cvt(p.w_in, p.WINT, 1024, 5688, NPAD_IN, WinMap(), tile, bid, nblk);
    transpose_cvt(p.w_merge, p.WINT + (size_t)NPAD_IN * 1024, 1024, 2048, 2048, IdMap(), tile, bid, nblk);
    transpose_cvt(p.w_br_a, p.WAT, 1024, 1024, 1024, IdMap(), tile, bid, nblk);
    transpose_cvt(p.w_br_b, p.WBT, 1024, 1024, 1024, IdMap(), tile, bid, nblk);
    transpose_cvt(p.w_out, p.WOT, 1024, 1024, 1024, IdMap(), tile, bid, nblk);
    transpose_cvt(p.peer_wq, p.WQT, 1024, 2048, 2048, IdMap(), tile, bid, nblk);
    transpose_cvt(p.nsa_w_cmp, p.WCT, 4096, 64, 64, IdMap(), tile, bid, nblk);
    transpose_cvt(p.nsa_w_cmp + 4096 * 64, p.WCT + 64 * 4096, 4096, 64, 64, IdMap(), tile, bid, nblk);
    for (int blk = bid; blk < 32; blk += nblk) {
        const int tid = tid_opq(), kvv = tid >> 8, e = tid & 63, kq = (tid >> 6) & 3;
        float a = 0.f;
        for (int k = blk * 128 + kq * 32; k < blk * 128 + kq * 32 + 32; ++k) a += p.nsa_pe[kvv * 4096 + k] * p.nsa_w_cmp[((size_t)kvv * 4096 + k) * 64 + e];
        atomicAdd(p.PW + kvv * 64 + e, a);
    }
    {
        const size_t per_b = (size_t)508 * 512 / 4;
        const size_t stride = (size_t)nblk * 512, ntot = 128 * per_b;
        for (size_t i0 = (size_t)bid * 512 + tid_opq(); i0 < ntot; i0 += stride * 8) {
            f32x4 v[8];
#pragma unroll
            for (int u = 0; u < 8; ++u) { const size_t i = i0 + u * stride; if (i < ntot) { const size_t b = i / per_b, r = i % per_b; v[u] = __builtin_nontemporal_load((const f32x4*)(p.cache_win + b * 512 * 512 + 4 * 512) + r); } }
#pragma unroll
            for (int u = 0; u < 8; ++u) { const size_t i = i0 + u * stride; if (i < ntot) { const size_t b = i / per_b, r = i % per_b; __builtin_nontemporal_store(v[u], (f32x4*)(p.out + O_SWIN + b * 512 * 512) + r); } }
        }
    }
}

template <class Epi>
DEVI void gemm_phase(const bf16_t* __restrict__ A, const bf16_t* __restrict__ Bt, int M, int N, int K, const Epi& epi, char* smem, int bid, int nblk) {
    bf16_t* As = (bf16_t*)smem;
    bf16_t* Bs = As + 256 * 72;
    const int tid = tid_opq(), lane = tid & 63, wid = tid >> 6, wm = wid >> 1, wn = wid & 1;
    const int fr = lane & 15, fq = lane >> 4;
    const int ntm = M / 256, ntn = N / 128, nk = K / 64;
    for (int tile = bid; tile < ntm * ntn; tile += nblk) {
        const int tm = tile / ntn, tn = tile % ntn;
        f32x4 acc[4][4];
#pragma unroll
        for (int i = 0; i < 4; ++i)
#pragma unroll
            for (int j = 0; j < 4; ++j) acc[i][j] = (f32x4){0.f, 0.f, 0.f, 0.f};
        const bf16_t* Ag = A + (size_t)(tm * 256 + (tid >> 1)) * K + (tid & 1) * 32;
        const bf16_t* Bg = Bt + (size_t)(tn * 128 + (tid >> 2)) * K + (tid & 3) * 16;
        u32x4 ra[4], rb[2];
#pragma unroll
        for (int i = 0; i < 4; ++i) ra[i] = *(const u32x4*)(Ag + i * 8);
#pragma unroll
        for (int i = 0; i < 2; ++i) rb[i] = *(const u32x4*)(Bg + i * 8);
        for (int kt = 0; kt < nk; ++kt) {
            __syncthreads();
#pragma unroll
            for (int i = 0; i < 4; ++i) *(u32x4*)(As + (tid >> 1) * 72 + (tid & 1) * 32 + i * 8) = ra[i];
#pragma unroll
            for (int i = 0; i < 2; ++i) *(u32x4*)(Bs + (tid >> 2) * 72 + (tid & 3) * 16 + i * 8) = rb[i];
            __syncthreads();
            if (kt + 1 < nk) {
#pragma unroll
                for (int i = 0; i < 4; ++i) ra[i] = *(const u32x4*)(Ag + (kt + 1) * 64 + i * 8);
#pragma unroll
                for (int i = 0; i < 2; ++i) rb[i] = *(const u32x4*)(Bg + (kt + 1) * 64 + i * 8);
            }
#pragma unroll
            for (int ks = 0; ks < 2; ++ks) {
                bf16x8 af[4], bfr[4];
#pragma unroll
                for (int i = 0; i < 4; ++i) af[i] = *(const bf16x8*)(As + (wm * 64 + i * 16 + fr) * 72 + ks * 32 + fq * 8);
#pragma unroll
                for (int j = 0; j < 4; ++j) bfr[j] = *(const bf16x8*)(Bs + (wn * 64 + j * 16 + fr) * 72 + ks * 32 + fq * 8);
#pragma unroll
                for (int i = 0; i < 4; ++i)
#pragma unroll
                    for (int j = 0; j < 4; ++j) acc[i][j] = __builtin_amdgcn_mfma_f32_16x16x32_bf16(bfr[j], af[i], acc[i][j], 0, 0, 0);
            }
        }
#pragma unroll
        for (int i = 0; i < 4; ++i)
#pragma unroll
            for (int j = 0; j < 4; ++j) epi(tm * 256 + wm * 64 + i * 16 + fr, tn * 128 + wn * 64 + j * 16 + fq * 4, acc[i][j]);
    }
}

struct NoPre {};
DEVI f32x4 bf4_lo(const u32x4& g) { return (f32x4){__uint_as_float(g[0] << 16), __uint_as_float(g[0] & 0xFFFF0000u), __uint_as_float(g[1] << 16), __uint_as_float(g[1] & 0xFFFF0000u)}; }
DEVI f32x4 bf4_hi(const u32x4& g) { return (f32x4){__uint_as_float(g[2] << 16), __uint_as_float(g[2] & 0xFFFF0000u), __uint_as_float(g[3] << 16), __uint_as_float(g[3] & 0xFFFF0000u)}; }
struct EpiInProj {
    P p;
    typedef NoPre Pre;
    static constexpr int BATCH = 4;
    static constexpr bool COLBIAS = true;
    DEVI void bias8(int col, f32x4& b0, f32x4& b1) const {
        b0 = (f32x4){0.f, 0.f, 0.f, 0.f}; b1 = b0;
        if (col < 5688) { const int oc = win_map(col);
#pragma unroll
            for (int q = 0; q < 4; ++q) { b0[q] = p.b_in[oc + q]; b1[q] = p.b_in[oc + 4 + q]; } }
    }
    DEVI Pre pre(int, int) const { return NoPre(); }
    DEVI void put(int row, int col, f32x4 v0, f32x4 v1, const Pre&) const {
        if (col >= NPAD_IN) {
#pragma unroll
            for (int k = 0; k < 4; ++k) { v0[k] = sigmoidf_(v0[k]); v1[k] = sigmoidf_(v1[k]); }
            *(u32x4*)(p.G + (size_t)row * 2048 + (col - NPAD_IN)) = pack8f(v0, v1);
            return;
        }
        if (col >= 5688) return;
        if (col >= 5632) { *(f32x4*)(p.SM + (size_t)row * 64 + (col - 5632)) = v0; *(f32x4*)(p.SM + (size_t)row * 64 + (col - 5632) + 4) = v1; return; }
        if (col >= C_AK && col < C_AV) { v0 *= 0.08838834764831845f; v1 *= 0.08838834764831845f; }
        *(u32x4*)(p.PROJ + (size_t)row * PS + col) = pack8f(v0, v1);
        if (col >= C_CMP) {
            const int reg = (col - C_CMP) >> 9, c = (col - C_CMP) & 511;
            float* dst = nullptr;
            if (row < NTP) {
                if (reg == 0) dst = p.out + O_PCMP + (size_t)row * 512 + c;
                else if (reg == 1) dst = p.out + O_PSLC + (size_t)row * 512 + c;
                else { const int b = row >> 12, t = row & 4095; if (t >= 3584) dst = p.out + O_PWIN + ((size_t)b * 512 + (t - 3584)) * 512 + c; }
            } else {
                const int rs = row - NTP;
                if (reg == 0) dst = p.out + O_SCMP + (size_t)rs * 512 + c;
                else if (reg == 1) dst = p.out + O_SSLC + (size_t)rs * 512 + c;
                else { const int b = rs >> 2, tq = rs & 3; dst = p.out + O_SWIN + ((size_t)b * 512 + 508 + tq) * 512 + c; }
            }
            if (dst) { *(f32x4*)dst = v0; *(f32x4*)(dst + 4) = v1; }
        }
    }
};
struct EpiG {
    P p;
    typedef NoPre Pre;
    static constexpr int BATCH = 4;
    static constexpr bool COLBIAS = false;
    DEVI Pre pre(int, int) const { return NoPre(); }
    DEVI void put(int row, int col, f32x4 v0, f32x4 v1, const Pre&) const {
#pragma unroll
        for (int k = 0; k < 4; ++k) { v0[k] = sigmoidf_(v0[k]); v1[k] = sigmoidf_(v1[k]); }
        *(u32x4*)(p.G + (size_t)row * 2048 + col) = pack8f(v0, v1);
    }
};
struct EpiM1 {
    P p;
    typedef u32x4 Pre;
    static constexpr int BATCH = 8;
    static constexpr bool COLBIAS = false;
    DEVI Pre pre(int row, int col) const { return *(const u32x4*)(p.G + (size_t)row * 2048 + 1024 + col); }
    DEVI void put(int row, int col, f32x4 v0, f32x4 v1, const Pre& g) const {
        *(u32x4*)(p.TMPB + (size_t)row * 1024 + col) = pack8f(v0 * bf4_lo(g), v1 * bf4_hi(g));
    }
};
struct PreM2 { u32x4 g; u32x4 t; };
struct EpiM2 {
    P p;
    typedef PreM2 Pre;
    static constexpr int BATCH = 8;
    static constexpr bool COLBIAS = false;
    DEVI Pre pre(int row, int col) const { PreM2 r; r.g = *(const u32x4*)(p.G + (size_t)row * 2048 + col); r.t = *(const u32x4*)(p.TMPB + (size_t)row * 1024 + col); return r; }
    DEVI void put(int row, int col, f32x4 v0, f32x4 v1, const Pre& q) const {
        *(u32x4*)(p.MERGED + (size_t)row * 1024 + col) = pack8f(bf4_lo(q.t) + v0 * bf4_lo(q.g), bf4_hi(q.t) + v1 * bf4_hi(q.g));
    }
};
struct PreR { f32x4 a, b; };
struct EpiR {
    P p;
    typedef PreR Pre;
    static constexpr int BATCH = 8;
    static constexpr bool COLBIAS = false;
    DEVI Pre pre(int row, int col) const {
        const float* xr = row < NTP ? p.xp + (size_t)row * 1024 : p.xs + (size_t)(row - NTP) * 1024;
        PreR r; r.a = *(const f32x4*)(xr + col); r.b = *(const f32x4*)(xr + col + 4); return r;
    }
    DEVI void put(int row, int col, f32x4 v0, f32x4 v1, const Pre& x) const {
        *(f32x4*)(p.R + (size_t)row * 1024 + col) = x.a * DN_ALPHA + v0; *(f32x4*)(p.R + (size_t)row * 1024 + col + 4) = x.b * DN_ALPHA + v1;
    }
};
struct EpiPQ {
    P p;
    typedef NoPre Pre;
    static constexpr int BATCH = 4;
    static constexpr bool COLBIAS = false;
    DEVI Pre pre(int, int) const { return NoPre(); }
    DEVI void put(int row, int col, f32x4 v0, f32x4 v1, const Pre&) const { *(u32x4*)(p.PQ + (size_t)row * 2048 + col) = pack8f(v0, v1); }
};

DEVI void stage_mlstm_gates(const P& p, char* smem, int bid, int nblk) {
    const int lane = tid_opq() & 63, wid = tid_opq() >> 6;
    float* bend_s = (float*)smem; float* mloc_s = bend_s + 64;
    for (int bh = bid; bh < 16; bh += nblk) {
        const int b = bh >> 2, h = bh & 3;
        __syncthreads();
        for (int cc = 0; cc < 8; ++cc) {
            const int c = wid * 8 + cc;
            const size_t row = (size_t)b * 4096 + c * 64 + lane;
            const float ip = p.SM[row * 64 + h];
            const float lf = logsigmoidf_(p.SM[row * 64 + 4 + h]);
            float cs = lf;
#pragma unroll
            for (int o = 1; o < 64; o <<= 1) { const float t = __shfl_up(cs, o); if (lane >= o) cs += t; }
            p.BCUM[bh * 4096 + c * 64 + lane] = cs;
            const float bend = __shfl(cs, 63);
            const float mloc = wave_max(bend - cs + ip);
            if (lane == 0) { bend_s[c] = bend; mloc_s[c] = mloc; }
        }
        __syncthreads();
        if (tid_opq() == 0) {
            float m = 0.f;
            for (int c = 0; c < 64; ++c) {
                const float bend = bend_s[c], mloc = mloc_s[c];
                const float mnew = fmaxf(bend + m, mloc);
                p.MPREV[bh * 64 + c] = m;
                p.ACOEF[bh * 64 + c] = __expf(bend + m - mnew);
                p.SCL[bh * 64 + c] = __expf(mloc - mnew);
                p.MLOC[bh * 64 + c] = mloc;
                m = mnew;
            }
            p.out[O_PM + bh] = m;
        }
    }
}

constexpr int MD_KT = 0, MD_VT = 128 * 144, MD_WS = MD_VT + 272 * 144, MD_LDS = MD_WS + 256;
DEVI void stage_mlstm_dc(const P& p, char* smem, int bid, int nblk) {
    const int tid = tid_opq(), lane = tid & 63, wid = tid >> 6, fr = lane & 15, fq = lane >> 4;
    bf16_t* Kt = (bf16_t*)(smem + MD_KT);
    bf16_t* Vt = (bf16_t*)(smem + MD_VT);
    float* ws = (float*)(smem + MD_WS);
    for (int task = bid; task < 1024; task += nblk) {
        const int bh = task >> 6, c = task & 63, b = bh >> 2, h = bh & 3;
        const size_t row0 = (size_t)b * 4096 + c * 64;
        __syncthreads();
        if (tid < 64) {
            const float ip = p.SM[(row0 + tid) * 64 + h];
            float cs = logsigmoidf_(p.SM[(row0 + tid) * 64 + 4 + h]);
#pragma unroll
            for (int o = 1; o < 64; o <<= 1) { const float t = __shfl_up(cs, o); if (tid >= o) cs += t; }
            const float g = __shfl(cs, 63) - cs + ip;
            ws[tid] = __expf(g - wave_max(g));
        }
        __syncthreads();
        {
            const int sidx = tid & 63, ch = tid >> 6;
            const float w = ws[sidx];
#pragma unroll
            for (int half = 0; half < 2; ++half) {
                const u32x4 kk = *(const u32x4*)(p.PROJ + (row0 + sidx) * PS + C_AK + h * 128 + half * 64 + ch * 8);
#pragma unroll
                for (int e = 0; e < 4; ++e) {
                    Kt[(half * 64 + ch * 8 + e * 2) * 72 + sidx] = f2bf(w * __uint_as_float(kk[e] << 16));
                    Kt[(half * 64 + ch * 8 + e * 2 + 1) * 72 + sidx] = f2bf(w * __uint_as_float(kk[e] & 0xFFFF0000u));
                }
            }
#pragma unroll
            for (int q4 = 0; q4 < 4; ++q4) {
                const u32x4 vv = *(const u32x4*)(p.PROJ + (row0 + sidx) * PS + C_AV + h * 256 + q4 * 64 + ch * 8);
#pragma unroll
                for (int e = 0; e < 4; ++e) {
                    Vt[(q4 * 64 + ch * 8 + e * 2) * 72 + sidx] = (bf16_t)(vv[e] & 0xFFFFu);
                    Vt[(q4 * 64 + ch * 8 + e * 2 + 1) * 72 + sidx] = (bf16_t)(vv[e] >> 16);
                }
            }
            for (int i = tid; i < 16 * 64; i += 512) Vt[(256 + (i >> 6)) * 72 + (i & 63)] = (i >> 6) == 0 ? (bf16_t)0x3F80 : (bf16_t)0;
        }
        __syncthreads();
        const int nvt = wid == 0 ? 3 : 2;
        for (int vi = 0; vi < nvt; ++vi) {
            const int vt = vi < 2 ? wid * 2 + vi : 16;
            f32x4 acc[8];
#pragma unroll
            for (int dt = 0; dt < 8; ++dt) acc[dt] = (f32x4){0.f, 0.f, 0.f, 0.f};
#pragma unroll
            for (int ks = 0; ks < 2; ++ks) {
                const bf16x8 bf = *(const bf16x8*)(Vt + (vt * 16 + fr) * 72 + ks * 32 + fq * 8);
#pragma unroll
                for (int dt = 0; dt < 8; ++dt) {
                    const bf16x8 af = *(const bf16x8*)(Kt + (dt * 16 + fr) * 72 + ks * 32 + fq * 8);
                    acc[dt] = __builtin_amdgcn_mfma_f32_16x16x32_bf16(af, bf, acc[dt], 0, 0, 0);
                }
            }
            const int v = vt * 16 + fr;
            if (v <= 256) {
#pragma unroll
                for (int dt = 0; dt < 8; ++dt) *(f32x4*)(p.DC + ((size_t)task * 272 + v) * 128 + dt * 16 + fq * 4) = acc[dt];
            }
        }
    }
}

DEVI void stage_mlstm_scan(const P& p, int bid, int nblk) {
    const int nthr = 512;
    for (int e = bid * nthr + tid_opq(); e < 16 * 257 * 32; e += nblk * nthr) {
        const int bh = e / (257 * 32), r = e % (257 * 32), v = r >> 5, d = (r & 31) * 4;
        f32x4 C = {0.f, 0.f, 0.f, 0.f};
        const float* ac = p.ACOEF + bh * 64; const float* sc = p.SCL + bh * 64;
        const size_t base = ((size_t)(bh * 64) * 272 + v) * 128 + d, cstride = (size_t)272 * 128;
#pragma unroll 1
        for (int c0 = 0; c0 < 64; c0 += 8) {
            f32x4 dc[8];
#pragma unroll
            for (int i = 0; i < 8; ++i) dc[i] = __builtin_nontemporal_load((const f32x4*)(p.DC + base + (size_t)(c0 + i) * cstride));
#pragma unroll
            for (int i = 0; i < 8; ++i) {
                u32x2 o; o.x = pack2(C[0], C[1]); o.y = pack2(C[2], C[3]);
                *(u32x2*)(p.CPT + base + (size_t)(c0 + i) * cstride) = o;
                C = C * ac[c0 + i] + dc[i] * sc[c0 + i];
            }
        }
        if (v < 256) {
#pragma unroll
            for (int k = 0; k < 4; ++k) p.out[O_PC + ((size_t)bh * 128 + d + k) * 256 + v] = C[k];
        } else *(f32x4*)(p.out + O_PN + bh * 128 + d) = C;
    }
}

constexpr int MO_Q = 0, MO_K = 64 * 272, MO_VT = MO_K + 64 * 272, MO_P = MO_VT + 272 * 144, MO_SC = MO_P + 64 * 144, MO_HS = MO_SC + 2048, MO_LDS = MO_HS + 64 * 256 * 4;
static_assert(MO_LDS <= 152 * 1024, "lds");
DEVI void stage_mlstm_out(const P& p, char* smem, int bid, int nblk) {
    const int tid = tid_opq(), lane = tid & 63, wid = tid >> 6, fr = lane & 15, fq = lane >> 4;
    bf16_t* Qs = (bf16_t*)(smem + MO_Q);
    bf16_t* Ks = (bf16_t*)(smem + MO_K);
    bf16_t* Vt = (bf16_t*)(smem + MO_VT);
    bf16_t* Ps = (bf16_t*)(smem + MO_P);
    float* sc = (float*)(smem + MO_SC);
    float* rowt = sc; float* colt = sc + 64; float* wint = sc + 128; float* emt = sc + 192; float* den = sc + 256;
    float* hs = (float*)(smem + MO_HS);
    for (int task = bid; task < 1024; task += nblk) {
        const int bh = task >> 6, c = task & 63, b = bh >> 2, h = bh & 3;
        const size_t row0 = (size_t)b * 4096 + c * 64;
        __syncthreads();
        {
            for (int i = tid; i < 64 * 16; i += 512) {
                const int t = i >> 4, ch = i & 15;
                *(u32x4*)(Qs + t * 136 + ch * 8) = *(const u32x4*)(p.PROJ + (row0 + t) * PS + C_AQ + h * 128 + ch * 8);
                *(u32x4*)(Ks + t * 136 + ch * 8) = *(const u32x4*)(p.PROJ + (row0 + t) * PS + C_AK + h * 128 + ch * 8);
            }
            const int sidx = tid & 63, ch = tid >> 6;
#pragma unroll
            for (int q4 = 0; q4 < 4; ++q4) {
                const u32x4 vv = *(const u32x4*)(p.PROJ + (row0 + sidx) * PS + C_AV + h * 256 + q4 * 64 + ch * 8);
#pragma unroll
                for (int e = 0; e < 4; ++e) {
                    Vt[(q4 * 64 + ch * 8 + e * 2) * 72 + sidx] = (bf16_t)(vv[e] & 0xFFFFu);
                    Vt[(q4 * 64 + ch * 8 + e * 2 + 1) * 72 + sidx] = (bf16_t)(vv[e] >> 16);
                }
            }
            for (int i = tid; i < 16 * 64; i += 512) Vt[(256 + (i >> 6)) * 72 + (i & 63)] = (i >> 6) == 0 ? (bf16_t)0x3F80 : (bf16_t)0;
            if (wid == 0) {
                const float bc = p.BCUM[bh * 4096 + c * 64 + lane], ip = p.SM[(row0 + lane) * 64 + h];
                const float mprev = p.MPREV[task];
                float pm = ip - bc;
#pragma unroll
                for (int o = 1; o < 64; o <<= 1) { const float t = __shfl_up(pm, o); if (lane >= o) pm = fmaxf(pm, t); }
                const float mt = fmaxf(bc + mprev, bc + pm);
                rowt[lane] = bc - mt; colt[lane] = ip - bc; wint[lane] = __expf(bc + mprev - mt); emt[lane] = __expf(-mt);
            }
        }
        __syncthreads();
        {
            const int tt = wid >> 1;
#pragma unroll
            for (int si = 0; si < 2; ++si) {
                const int st = (wid & 1) * 2 + si;
                f32x4 acc = (f32x4){0.f, 0.f, 0.f, 0.f};
                if (st <= tt) {
#pragma unroll
                    for (int ks = 0; ks < 4; ++ks) {
                        const bf16x8 af = *(const bf16x8*)(Qs + (tt * 16 + fr) * 136 + ks * 32 + fq * 8);
                        const bf16x8 bf = *(const bf16x8*)(Ks + (st * 16 + fr) * 136 + ks * 32 + fq * 8);
                        acc = __builtin_amdgcn_mfma_f32_16x16x32_bf16(af, bf, acc, 0, 0, 0);
                    }
                }
                const int s = st * 16 + fr; const float ct = colt[s];
#pragma unroll
                for (int r = 0; r < 4; ++r) {
                    const int t = tt * 16 + fq * 4 + r;
                    const float pv = (s <= t) ? acc[r] * __expf(rowt[t] + ct) : 0.f;
                    Ps[t * 72 + s] = f2bf(pv);
                }
            }
        }
        __syncthreads();
        {
            const bf16_t* cpt = p.CPT + (size_t)task * 272 * 128;
            f32x4 acc[4][2];
#pragma unroll
            for (int tt = 0; tt < 4; ++tt)
#pragma unroll
                for (int vi = 0; vi < 2; ++vi) acc[tt][vi] = (f32x4){0.f, 0.f, 0.f, 0.f};
            f32x4 accd = (f32x4){0.f, 0.f, 0.f, 0.f};
            bf16x8 cb[4][2], cd[4];
#pragma unroll
            for (int ks = 0; ks < 4; ++ks) {
#pragma unroll
                for (int vi = 0; vi < 2; ++vi) cb[ks][vi] = *(const bf16x8*)(cpt + (size_t)((wid * 2 + vi) * 16 + fr) * 128 + ks * 32 + fq * 8);
                cd[ks] = *(const bf16x8*)(cpt + (size_t)(256 + fr) * 128 + ks * 32 + fq * 8);
            }
#pragma unroll
            for (int ks = 0; ks < 4; ++ks) {
                bf16x8 af[4];
#pragma unroll
                for (int tt = 0; tt < 4; ++tt) af[tt] = *(const bf16x8*)(Qs + (tt * 16 + fr) * 136 + ks * 32 + fq * 8);
#pragma unroll
                for (int vi = 0; vi < 2; ++vi) {
#pragma unroll
                    for (int tt = 0; tt < 4; ++tt) acc[tt][vi] = __builtin_amdgcn_mfma_f32_16x16x32_bf16(af[tt], cb[ks][vi], acc[tt][vi], 0, 0, 0);
                }
                if (wid < 4) {
                    const bf16x8 a2 = *(const bf16x8*)(Qs + (wid * 16 + fr) * 136 + ks * 32 + fq * 8);
                    accd = __builtin_amdgcn_mfma_f32_16x16x32_bf16(a2, cd[ks], accd, 0, 0, 0);
                }
            }
#pragma unroll
            for (int tt = 0; tt < 4; ++tt) {
                const f32x4 wv = *(const f32x4*)(wint + tt * 16 + fq * 4);
#pragma unroll
                for (int vi = 0; vi < 2; ++vi) acc[tt][vi] *= wv;
            }
            if (wid < 4) accd *= *(const f32x4*)(wint + wid * 16 + fq * 4);
#pragma unroll
            for (int ks = 0; ks < 2; ++ks) {
                bf16x8 af[4];
#pragma unroll
                for (int tt = 0; tt < 4; ++tt) af[tt] = *(const bf16x8*)(Ps + (tt * 16 + fr) * 72 + ks * 32 + fq * 8);
#pragma unroll
                for (int vi = 0; vi < 2; ++vi) {
                    const bf16x8 bf = *(const bf16x8*)(Vt + ((wid * 2 + vi) * 16 + fr) * 72 + ks * 32 + fq * 8);
#pragma unroll
                    for (int tt = 0; tt < 4; ++tt) acc[tt][vi] = __builtin_amdgcn_mfma_f32_16x16x32_bf16(af[tt], bf, acc[tt][vi], 0, 0, 0);
                }
                if (wid < 4) {
                    const bf16x8 bf = *(const bf16x8*)(Vt + (256 + fr) * 72 + ks * 32 + fq * 8);
                    const bf16x8 a2 = *(const bf16x8*)(Ps + (wid * 16 + fr) * 72 + ks * 32 + fq * 8);
                    accd = __builtin_amdgcn_mfma_f32_16x16x32_bf16(a2, bf, accd, 0, 0, 0);
                }
            }
            if (wid < 4 && fr == 0) *(f32x4*)(den + wid * 16 + fq * 4) = accd;
            __syncthreads();
#pragma unroll
            for (int tt = 0; tt < 4; ++tt) {
                const f32x4 dv = *(const f32x4*)(den + tt * 16 + fq * 4), ev = *(const f32x4*)(emt + tt * 16 + fq * 4);
#pragma unroll
                for (int vi = 0; vi < 2; ++vi)
#pragma unroll
                    for (int r = 0; r < 4; ++r) hs[(tt * 16 + fq * 4 + r) * 256 + (wid * 2 + vi) * 16 + fr] = acc[tt][vi][r] / fmaxf(fabsf(dv[r]), ev[r]);
            }
        }
        __syncthreads();
        u32x2 ovs[8];
#pragma unroll
        for (int rr = 0; rr < 8; ++rr) ovs[rr] = *(const u32x2*)(p.PROJ + (row0 + wid * 8 + rr) * PS + C_AO + h * 256 + lane * 4);
        const f32x4 gg = *(const f32x4*)(p.norm_a_g + h * 256 + lane * 4);
#pragma unroll
        for (int rr = 0; rr < 8; ++rr) {
            const int t = wid * 8 + rr;
            const f32x4 x = *(const f32x4*)(hs + t * 256 + lane * 4);
            const float mean = wave_sum(x[0] + x[1] + x[2] + x[3]) * (1.f / 256.f);
            float q = 0.f;
#pragma unroll
            for (int k = 0; k < 4; ++k) q += (x[k] - mean) * (x[k] - mean);
            const float rs = rsqrtf(wave_sum(q) * (1.f / 256.f) + LN_EPS);
            const u32x2 ov = ovs[rr];
            const float o4[4] = {__uint_as_float(ov.x << 16), __uint_as_float(ov.x & 0xFFFF0000u), __uint_as_float(ov.y << 16), __uint_as_float(ov.y & 0xFFFF0000u)};
            float y[4];
#pragma unroll
            for (int k = 0; k < 4; ++k) y[k] = (x[k] - mean) * rs * gg[k] * sigmoidf_(o4[k]);
            u32x2 o2; o2.x = pack2(y[0], y[1]); o2.y = pack2(y[2], y[3]);
            *(u32x2*)(p.YA + (row0 + t) * 1024 + h * 256 + lane * 4) = o2;
        }
    }
}

DEVI void stage_mlstm_sample(const P& p, char* smem, int bid, int nblk) {
    float* qs = (float*)smem;
    float* ks = qs + 512;
    float* vs = ks + 512;
    float* part = vs + 1024;
    float* hs = part + 2048;
    float* sc = hs + 1024;
    float* bc = sc; float* ip = sc + 4; float* mt = sc + 8; float* wint = sc + 12; float* emt = sc + 16; float* ww = sc + 20; float* den = sc + 24;
    float* Pm = sc + 32;
    float* misc = sc + 48;
    const int tid = tid_opq(), lane = tid & 63, wid = tid >> 6;
    for (int task = bid; task < 512; task += nblk) {
        const int b = task >> 2, h = task & 3;
        const size_t row0 = (size_t)NTP + b * 4;
        __syncthreads();
        { const int t = tid >> 7, d = tid & 127;
          qs[tid] = bf2f(p.PROJ[(row0 + t) * PS + C_AQ + h * 128 + d]);
          ks[tid] = bf2f(p.PROJ[(row0 + t) * PS + C_AK + h * 128 + d]); }
        for (int idx = tid; idx < 1024; idx += 512) { const int t = idx >> 8, v = idx & 255; vs[idx] = bf2f(p.PROJ[(row0 + t) * PS + C_AV + h * 256 + v]); }
        if (tid == 0) {
            const float m0 = p.state_m[task];
            float cs = 0.f;
            for (int t = 0; t < 4; ++t) { cs += logsigmoidf_(p.SM[(row0 + t) * 64 + 4 + h]); bc[t] = cs; ip[t] = p.SM[(row0 + t) * 64 + h]; }
            for (int t = 0; t < 4; ++t) {
                float mx = bc[t] + m0;
                for (int s = 0; s <= t; ++s) mx = fmaxf(mx, bc[t] - bc[s] + ip[s]);
                mt[t] = mx; wint[t] = __expf(bc[t] + m0 - mx); emt[t] = __expf(-mx);
            }
            const float bend = bc[3];
            float mnew = bend + m0;
            for (int s = 0; s < 4; ++s) mnew = fmaxf(mnew, bend - bc[s] + ip[s]);
            misc[0] = __expf(bend + m0 - mnew);
            for (int s = 0; s < 4; ++s) ww[s] = __expf(bend - bc[s] + ip[s] - mnew);
            p.out[O_SM + task] = mnew;
        }
        __syncthreads();
        if (tid < 16) {
            const int t = tid >> 2, s = tid & 3;
            float a = 0.f;
            if (s <= t) { for (int d = 0; d < 128; ++d) a += qs[t * 128 + d] * ks[s * 128 + d]; a *= __expf(bc[t] - bc[s] + ip[s] - mt[t]); }
            Pm[tid] = a;
        }
        __syncthreads();
        if (tid < 4) {
            const int t = tid; float qn = 0.f;
            for (int d = 0; d < 128; ++d) qn += qs[t * 128 + d] * p.state_n[(size_t)task * 128 + d];
            den[t] = wint[t] * qn + Pm[t * 4] + Pm[t * 4 + 1] + Pm[t * 4 + 2] + Pm[t * 4 + 3];
        }
        const float a = misc[0];
        if (tid >= 128 && tid < 256) {
            const int d = tid - 128;
            float n = a * p.state_n[(size_t)task * 128 + d];
            for (int s = 0; s < 4; ++s) n += ww[s] * ks[s * 128 + d];
            p.out[O_SN + (size_t)task * 128 + d] = n;
        }
        {
            const int v = tid & 255, dh = tid >> 8;
            float acc[4] = {0.f, 0.f, 0.f, 0.f};
            float wv[4];
#pragma unroll
            for (int s = 0; s < 4; ++s) wv[s] = ww[s] * vs[s * 256 + v];
            for (int d0 = dh * 64; d0 < dh * 64 + 64; d0 += 16) {
                float c0[16];
#pragma unroll
                for (int i = 0; i < 16; ++i) c0[i] = __builtin_nontemporal_load(p.state_C + ((size_t)task * 128 + d0 + i) * 256 + v);
#pragma unroll
                for (int i = 0; i < 16; ++i) {
                    const int d = d0 + i;
#pragma unroll
                    for (int t = 0; t < 4; ++t) acc[t] += qs[t * 128 + d] * c0[i];
                    float cn = a * c0[i];
#pragma unroll
                    for (int s = 0; s < 4; ++s) cn += ks[s * 128 + d] * wv[s];
                    __builtin_nontemporal_store(cn, p.out + O_SC + ((size_t)task * 128 + d) * 256 + v);
                }
            }
#pragma unroll
            for (int t = 0; t < 4; ++t) part[(dh * 4 + t) * 256 + v] = acc[t];
        }
        __syncthreads();
        if (tid < 256) {
            const int v = tid;
#pragma unroll
            for (int t = 0; t < 4; ++t) {
                float num = wint[t] * (part[t * 256 + v] + part[(4 + t) * 256 + v]);
#pragma unroll
                for (int s = 0; s < 4; ++s) num += Pm[t * 4 + s] * vs[s * 256 + v];
                hs[t * 256 + v] = num / fmaxf(fabsf(den[t]), emt[t]);
            }
        }
        __syncthreads();
        if (wid < 4) {
            const int t = wid;
            const f32x4 x = *(const f32x4*)(hs + t * 256 + lane * 4);
            const float mean = wave_sum(x[0] + x[1] + x[2] + x[3]) * (1.f / 256.f);
            float q = 0.f;
#pragma unroll
            for (int k = 0; k < 4; ++k) q += (x[k] - mean) * (x[k] - mean);
            const float rs = rsqrtf(wave_sum(q) * (1.f / 256.f) + LN_EPS);
            float y[4];
#pragma unroll
            for (int k = 0; k < 4; ++k) {
                const int vi = lane * 4 + k;
                const float o = bf2f(p.PROJ[(row0 + t) * PS + C_AO + h * 256 + vi]);
                y[k] = (x[k] - mean) * rs * p.norm_a_g[h * 256 + vi] * sigmoidf_(o);
            }
            u32x2 o2; o2.x = pack2(y[0], y[1]); o2.y = pack2(y[2], y[3]);
            *(u32x2*)(p.YA + (row0 + t) * 1024 + h * 256 + lane * 4) = o2;
        }
    }
}

constexpr int CP_ABUF = 33280, CP_WBUF = 18432, CP_A = 0, CP_W = 2 * CP_ABUF, CP_LDS = CP_W + 2 * CP_WBUF;
constexpr int CP_AROW = 1024 + 8;
DEVI void stage_compress(const P& p, char* smem, int bid, int nblk) {
    const int tid = tid_opq(), lane = tid & 63, wid = tid >> 6, fr = lane & 15, fq = lane >> 4;
    const int kv = wid & 1, rt = wid >> 1;
    const int n_it = (256 + nblk - 1) / nblk + (16 + nblk - 1) / nblk;
    for (int it = 0; it < n_it; ++it) {
        const int ns_it = (256 + nblk - 1) / nblk;
        const int task = it < ns_it ? bid + it * nblk : 256 + (nblk - 1 - bid) + (it - ns_it) * nblk;
        if (task >= 272 || (it < ns_it && task >= 256)) continue;
        const bool prompt = task >= 256;
        const int rowbytes = prompt ? 1024 : 2048, npieces = prompt ? 2 : 4;
        const char* src[4]; int dsto[4];
#pragma unroll
        for (int q = 0; q < 4; ++q) {
            const int off = q * 8192 + tid * 16, r = off / rowbytes, cb = off % rowbytes;
            if (prompt) { const int blk = (task - 256) * 16 + (r & 15); src[q] = (const char*)(p.PROJ + (size_t)blk * 64 * PS + C_CMP) + cb; dsto[q] = (r & 15) * CP_AROW * 2 + cb; }
            else { const int gb = task * 16 + r, b = gb >> 5, n = gb & 31; const int page = p.page_table[b * 16 + (n >> 1)];
                   src[q] = (const char*)(p.cache_cmp + ((size_t)page * 128 + (n & 1) * 64) * 512) + cb; dsto[q] = r * CP_AROW * 2 + (cb >> 1); }
        }
        const size_t sstride = prompt ? (size_t)PS * 2 : 2048;
        const char* wsrc[2]; int wdst[2];
#pragma unroll
        for (int q = 0; q < 2; ++q) { const int idx = q * 512 + tid, row = idx >> 3, ch = idx & 7; wsrc[q] = (const char*)(p.WCT + (size_t)row * 4096) + ch * 16; wdst[q] = row * 144 + ch * 16; }
        f32x4 acc[4];
#pragma unroll
        for (int nt = 0; nt < 4; ++nt) acc[nt] = (f32x4){0.f, 0.f, 0.f, 0.f};
        f32x4 ra0[4], ra1[4]; u32x4 rw0[2], rw1[2];
        auto issue = [&](int l, f32x4 (&ra)[4], u32x4 (&rw)[2]) {
#pragma unroll
            for (int q = 0; q < 4; ++q) if (q < npieces) ra[q] = *(const f32x4*)(src[q] + (size_t)l * sstride);
#pragma unroll
            for (int q = 0; q < 2; ++q) rw[q] = *(const u32x4*)(wsrc[q] + l * 128);
        };
        auto commit = [&](int buf, const f32x4 (&ra)[4], const u32x4 (&rw)[2]) {
            char* ab = smem + CP_A + buf * CP_ABUF; char* wbuf = smem + CP_W + buf * CP_WBUF;
#pragma unroll
            for (int q = 0; q < 4; ++q) if (q < npieces) {
                if (prompt) *(f32x4*)(ab + dsto[q]) = ra[q];
                else { u32x2 o; o.x = pack2(ra[q][0], ra[q][1]); o.y = pack2(ra[q][2], ra[q][3]); *(u32x2*)(ab + dsto[q]) = o; }
            }
#pragma unroll
            for (int q = 0; q < 2; ++q) *(u32x4*)(wbuf + wdst[q]) = rw[q];
        };
        auto consume = [&](int buf) {
            const char* ab = smem + CP_A + buf * CP_ABUF; const char* wbuf = smem + CP_W + buf * CP_WBUF;
            const bf16_t* arow = (const bf16_t*)ab + (rt * 4 + (fr >> 2)) * CP_AROW + kv * 256 + (fr & 3) * 64 + fq * 8;
#pragma unroll
            for (int hf = 0; hf < 2; ++hf) {
                const bf16x8 a = *(const bf16x8*)(arow + hf * 32);
#pragma unroll
                for (int nt = 0; nt < 4; ++nt) {
                    const bf16x8 bfrag = *(const bf16x8*)(wbuf + (kv * 64 + nt * 16 + fr) * 144 + hf * 64 + fq * 16);
                    acc[nt] = __builtin_amdgcn_mfma_f32_16x16x32_bf16(a, bfrag, acc[nt], 0, 0, 0);
                }
            }
        };
        __syncthreads();
        issue(0, ra0, rw0); issue(1, ra1, rw1); commit(0, ra0, rw0); issue(2, ra0, rw0);
        __syncthreads();
#pragma unroll 1
        for (int l = 0; l < 64; l += 2) {
            consume(0);
            commit(1, ra1, rw1);
            if (l + 3 < 64) issue(l + 3, ra1, rw1);
            __syncthreads();
            consume(1);
            if (l + 2 < 64) commit(0, ra0, rw0);
            if (l + 4 < 64) issue(l + 4, ra0, rw0);
            __syncthreads();
        }
        {
            const int ob = prompt ? (task - 256) * 16 + rt * 4 + fq : 256 + task * 16 + rt * 4 + fq;
#pragma unroll
            for (int nt = 0; nt < 4; ++nt) {
                const float bias = p.PW[kv * 64 + nt * 16 + fr];
#pragma unroll
                for (int r = 0; r < 4; ++r) p.KC[(size_t)ob * 512 + kv * 256 + r * 64 + nt * 16 + fr] = acc[nt][r] + bias;
            }
        }
    }
}

DEVI void stage_cmp_select(const P& p, int bid, int nblk) {
    const int lane = tid_opq() & 63, wid = tid_opq() >> 6;
    for (int wt = bid * 8 + wid; wt < NT * 4; wt += nblk * 8) {
        const int row = wt >> 2, g = wt & 3;
        int pos, nb, nvalid, cur; const float *kcb, *vcb;
        if (row < NTP) { const int b = row >> 12, t = row & 4095; pos = t; nb = 64; nvalid = (t + 1) >> 6; cur = t >> 6; kcb = p.KC + (size_t)(b * 64) * 256; vcb = p.VC + (size_t)(b * 64) * 256; }
        else { const int rs = row - NTP, b = rs >> 2, tq = rs & 3; pos = 2048 + tq; nb = 33; nvalid = 32; cur = 32; kcb = p.KC + (size_t)(256 + b * 32) * 256; vcb = p.VC + (size_t)(256 + b * 32) * 256; }
        const int j = lane;
        float pr[4] = {0.f, 0.f, 0.f, 0.f};
        float imp = 0.f;
        if (nvalid > 0) {
            float dot[4] = {0.f, 0.f, 0.f, 0.f};
            if (j < nvalid) {
                const float* kr = kcb + (size_t)j * 256 + g * 64;
                const bf16_t* qr = p.PROJ + (size_t)row * PS + C_BQ + g * 256;
                for (int d = 0; d < 64; ++d) {
                    const float kk = kr[d];
#pragma unroll
                    for (int r = 0; r < 4; ++r) dot[r] += bf2f(qr[r * 64 + d]) * kk;
                }
            }
#pragma unroll
            for (int r = 0; r < 4; ++r) {
                const float s = j < nvalid ? dot[r] * 0.125f - alibi_slope(g * 4 + r) * (float)(pos - (j * 64 + 63)) : -INFINITY;
                const float mx = wave_max(s);
                const float e = j < nvalid ? __expf(s - mx) : 0.f;
                const float sum = wave_sum(e);
                pr[r] = e / sum;
                imp += pr[r];
            }
            float o[4] = {0.f, 0.f, 0.f, 0.f};
            for (int jj = 0; jj < nvalid; ++jj) {
                const float vv = vcb[(size_t)jj * 256 + g * 64 + lane];
#pragma unroll
                for (int r = 0; r < 4; ++r) o[r] += __shfl(pr[r], jj) * vv;
            }
#pragma unroll
            for (int r = 0; r < 4; ++r) p.OCMP[(size_t)row * 1024 + (g * 4 + r) * 64 + lane] = o[r];
        } else {
#pragma unroll
            for (int r = 0; r < 4; ++r) p.OCMP[(size_t)row * 1024 + (g * 4 + r) * 64 + lane] = 0.f;
        }
        if (j == cur || j == 0) imp = 5.0f;
        if (j > cur) imp = -1.0f;
        if (j >= nb) imp = -2.0f;
        int rank = 0;
        for (int jj = 0; jj < 64; ++jj) { const float v = __shfl(imp, jj); rank += (v > imp || (v == imp && jj < j)) ? 1 : 0; }
        const unsigned long long mask = __ballot(rank < 16 && j < nb);
        if (lane == 0) p.SEL[(size_t)row * 4 + g] = mask;
    }
}

struct KBlock { const void* kb; const void* vb; int stride; int f32; int count; int pos0; };

template <bool WIN>
DEVI void attend_block(const KBlock& B, int qpos, const float* qs, const float (&slope)[4], float (&m)[4], float (&l)[4], float (&o)[4], int lane) {
    const int pos = B.pos0 + lane;
    const bool valid = lane < B.count && pos <= qpos && (!WIN || pos > qpos - 512);
    if (!__any(valid)) return;
    float dot[4] = {0.f, 0.f, 0.f, 0.f};
    if (valid) {
        if (B.f32) {
            const float* kr = (const float*)B.kb + (size_t)lane * B.stride;
#pragma unroll 4
            for (int d4 = 0; d4 < 16; ++d4) {
                const f32x4 kk = *(const f32x4*)(kr + d4 * 4);
#pragma unroll
                for (int e = 0; e < 4; ++e) { const f32x4 qq = *(const f32x4*)(qs + (d4 * 4 + e) * 4);
#pragma unroll
                    for (int r = 0; r < 4; ++r) dot[r] += kk[e] * qq[r]; }
            }
        } else {
            const bf16_t* kr = (const bf16_t*)B.kb + (size_t)lane * B.stride;
#pragma unroll 2
            for (int d8 = 0; d8 < 8; ++d8) {
                const u32x4 kk = *(const u32x4*)(kr + d8 * 8);
                const unsigned w[4] = {kk.x, kk.y, kk.z, kk.w};
#pragma unroll
                for (int e = 0; e < 4; ++e) {
                    const float k0 = __uint_as_float(w[e] << 16), k1 = __uint_as_float(w[e] & 0xFFFF0000u);
                    const f32x4 q0 = *(const f32x4*)(qs + (d8 * 8 + e * 2) * 4), q1 = *(const f32x4*)(qs + (d8 * 8 + e * 2 + 1) * 4);
#pragma unroll
                    for (int r = 0; r < 4; ++r) dot[r] += k0 * q0[r] + k1 * q1[r];
                }
            }
        }
    }
    float pr[4];
#pragma unroll
    for (int r = 0; r < 4; ++r) {
        const float s = valid ? dot[r] * 0.125f - slope[r] * (float)(qpos - pos) : -INFINITY;
        const float mn = fmaxf(m[r], wave_max(s));
        const float sc = __expf(m[r] - mn);
        pr[r] = valid ? __expf(s - mn) : 0.f;
        l[r] = l[r] * sc + wave_sum(pr[r]);
        o[r] *= sc; m[r] = mn;
    }
    for (int kk = 0; kk < B.count; ++kk) {
        const float vv = B.f32 ? ((const float*)B.vb)[(size_t)kk * B.stride + lane] : bf2f(((const bf16_t*)B.vb)[(size_t)kk * B.stride + lane]);
#pragma unroll
        for (int r = 0; r < 4; ++r) o[r] += __shfl(pr[r], kk) * vv;
    }
}

DEVI void stage_slc_win(const P& p, char* smem, int bid, int nblk) {
    const int lane = tid_opq() & 63, wid = tid_opq() >> 6;
    float* qs = (float*)smem + wid * 256;
    for (int wt = bid * 8 + wid; wt < NT * 4; wt += nblk * 8) {
        const int row = wt >> 2, g = wt & 3;
        const bool prompt = row < NTP;
        int b, t, qpos;
        if (prompt) { b = row >> 12; t = row & 4095; qpos = t; } else { const int rs = row - NTP; b = rs >> 2; t = rs & 3; qpos = 2048 + t; }
        {
            const bf16_t* qr = p.PROJ + (size_t)row * PS + C_BQ + g * 256;
            f32x4 qv;
#pragma unroll
            for (int r = 0; r < 4; ++r) qv[r] = bf2f(qr[r * 64 + lane]);
            *(f32x4*)(qs + lane * 4) = qv;
            asm volatile("s_waitcnt lgkmcnt(0)" ::: "memory");
        }
        float slope[4];
#pragma unroll
        for (int r = 0; r < 4; ++r) slope[r] = alibi_slope(g * 4 + r);
        float res[2][4];
        {
            float m[4], l[4], o[4];
#pragma unroll
            for (int r = 0; r < 4; ++r) { m[r] = -INFINITY; l[r] = 0.f; o[r] = 0.f; }
            unsigned long long mask = p.SEL[(size_t)row * 4 + g];
            while (mask) {
                const int j = __builtin_ctzll(mask); mask &= mask - 1;
                KBlock B;
                if (prompt) {
                    const bf16_t* base = p.PROJ + ((size_t)b * 4096 + j * 64) * PS + C_SLC + g * 64;
                    B.kb = base; B.vb = base + 256; B.stride = PS; B.f32 = 0; B.count = 64; B.pos0 = j * 64;
                } else if (j < 32) {
                    const int page = p.page_table[b * 16 + (j >> 1)];
                    const float* base = p.cache_slc + ((size_t)page * 128 + (j & 1) * 64) * 512 + g * 64;
                    B.kb = base; B.vb = base + 256; B.stride = 512; B.f32 = 1; B.count = 64; B.pos0 = j * 64;
                } else {
                    const bf16_t* base = p.PROJ + ((size_t)NTP + b * 4) * PS + C_SLC + g * 64;
                    B.kb = base; B.vb = base + 256; B.stride = PS; B.f32 = 0; B.count = 4; B.pos0 = 2048;
                }
                attend_block<false>(B, qpos, qs, slope, m, l, o, lane);
            }
#pragma unroll
            for (int r = 0; r < 4; ++r) res[0][r] = o[r] / l[r];
        }
        {
            float m[4], l[4], o[4];
#pragma unroll
            for (int r = 0; r < 4; ++r) { m[r] = -INFINITY; l[r] = 0.f; o[r] = 0.f; }
            if (prompt) {
                const int lo = (t - 511 > 0 ? t - 511 : 0) >> 6, hi = t >> 6;
                for (int j = lo; j <= hi; ++j) {
                    KBlock B; const bf16_t* base = p.PROJ + ((size_t)b * 4096 + j * 64) * PS + C_WIN + g * 64;
                    B.kb = base; B.vb = base + 256; B.stride = PS; B.f32 = 0; B.count = 64; B.pos0 = j * 64;
                    attend_block<true>(B, qpos, qs, slope, m, l, o, lane);
                }
            } else {
                for (int j = 0; j < 8; ++j) {
                    KBlock B; const float* base = p.cache_win + ((size_t)b * 512 + j * 64) * 512 + g * 64;
                    B.kb = base; B.vb = base + 256; B.stride = 512; B.f32 = 1; B.count = 64; B.pos0 = 1536 + j * 64;
                    attend_block<true>(B, qpos, qs, slope, m, l, o, lane);
                }
                KBlock B; const bf16_t* base = p.PROJ + ((size_t)NTP + b * 4) * PS + C_WIN + g * 64;
                B.kb = base; B.vb = base + 256; B.stride = PS; B.f32 = 0; B.count = 4; B.pos0 = 2048;
                attend_block<true>(B, qpos, qs, slope, m, l, o, lane);
            }
#pragma unroll
            for (int r = 0; r < 4; ++r) res[1][r] = o[r] / l[r];
        }
        const float* gt = p.SM + (size_t)row * 64 + 8;
#pragma unroll
        for (int r = 0; r < 4; ++r) {
            const float g0 = sigmoidf_(gt[g * 4 + r]), g1 = sigmoidf_(gt[16 + g * 4 + r]), g2 = sigmoidf_(gt[32 + g * 4 + r]);
            const float oc = p.OCMP[(size_t)row * 1024 + (g * 4 + r) * 64 + lane];
            p.YB[(size_t)row * 1024 + (g * 4 + r) * 64 + lane] = f2bf(g0 * oc + g1 * res[0][r] + g2 * res[1][r]);
        }
    }
}

typedef float f32x16 __attribute__((ext_vector_type(16)));
typedef short s16x4 __attribute__((ext_vector_type(4)));
typedef __attribute__((address_space(3))) const char* lds_cptr;
#define MFMA32(a, b, c) __builtin_amdgcn_mfma_f32_32x32x16_bf16(a, b, c, 0, 0, 0)
DEVI int crow(int r, int hi) { return (r & 3) + 8 * (r >> 2) + 4 * hi; }
DEVI unsigned cvtpk(float lo, float hi) { return pack2(lo, hi); }
DEVI s16x4 vtr(lds_cptr p) { return __builtin_bit_cast(s16x4, __builtin_amdgcn_ds_read_tr16_b64_v4i16((__attribute__((address_space(3))) s16x4*)p)); }
DEVI float half_max(float m) { auto rr = __builtin_amdgcn_permlane32_swap(__float_as_uint(m), __float_as_uint(m), false, false); return fmaxf(__uint_as_float(rr[0]), __uint_as_float(rr[1])); }
DEVI float half_sum(float m) { auto rr = __builtin_amdgcn_permlane32_swap(__float_as_uint(m), __float_as_uint(m), false, false); return __uint_as_float(rr[0]) + __uint_as_float(rr[1]); }

struct BlkDesc { const char* k; int stride_bytes; int f32; int count; int pos0; };
DEVI void blk_load(const BlkDesc& d, int tid, u32x4& rk, u32x4& rv) {
    const int key = tid & 63, chunk = tid >> 6;
    rk = (u32x4){0u, 0u, 0u, 0u}; rv = rk;
    if (key < d.count) {
        const char* kr = d.k + (size_t)key * d.stride_bytes;
        if (d.f32) {
            const f32x4* s1 = (const f32x4*)(kr + chunk * 32); const f32x4* s2 = (const f32x4*)(kr + 1024 + chunk * 32);
            rk = pack8f(s1[0], s1[1]); rv = pack8f(s2[0], s2[1]);
        } else { rk = *(const u32x4*)(kr + chunk * 16); rv = *(const u32x4*)(kr + 512 + chunk * 16); }
    }
}
DEVI void blk_store(char* kimg, char* vimg, int tid, const u32x4& rk, const u32x4& rv) {
    const int key = tid & 63, chunk = tid >> 6;
    *(u32x4*)(kimg + chunk * 1024 + key * 16) = rk;
    *(u32x4*)(vimg + (chunk >> 2) * 4096 + key * 64 + (chunk & 3) * 16) = rv;
}

DEVI void attn_tile(const char* kimg, const char* vimg, const bf16x8 (&qr)[4], float& m2, float& lsum, f32x16& o0, f32x16& o1, f32x16& s0, f32x16& s1,
                    float sl, float bb, int lh, int ll, bool fast, float* wsf_hi  , float* wsf_r  , int lane) {
    const int r32 = lane & 31, hi = lane >> 5;
    const f32x16 z = {};
    s0 = z; s1 = z;
    {
        const char* kp = kimg + hi * 1024 + r32 * 16;
#pragma unroll
        for (int d0 = 0; d0 < 4; ++d0) {
            const bf16x8 k0 = *(const bf16x8*)(kp + d0 * 2048), k1 = *(const bf16x8*)(kp + d0 * 2048 + 512);
            s0 = MFMA32(k0, qr[d0], s0); s1 = MFMA32(k1, qr[d0], s1);
        }
    }
    float mx = -1e30f;
    if (fast) {
#pragma unroll
        for (int r = 0; r < 16; ++r) {
            const int c = (r & 3) + 8 * (r >> 2);
            s0[r] = fmaf(s0[r], 1.4426950408889634f, fmaf(sl, (float)c, bb)); s1[r] = fmaf(s1[r], 1.4426950408889634f, fmaf(sl, (float)(c + 32), bb));
            mx = fmaxf(mx, fmaxf(s0[r], s1[r]));
        }
    } else {
#pragma unroll
        for (int r = 0; r < 16; ++r) {
            const int c = (r & 3) + 8 * (r >> 2);
            const float t0 = fmaf(s0[r], 1.4426950408889634f, fmaf(sl, (float)c, bb)), t1 = fmaf(s1[r], 1.4426950408889634f, fmaf(sl, (float)(c + 32), bb));
            s0[r] = (c <= lh && c > ll) ? t0 : -INFINITY; s1[r] = (c + 32 <= lh && c + 32 > ll) ? t1 : -INFINITY;
            mx = fmaxf(mx, fmaxf(s0[r], s1[r]));
        }
    }
    mx = half_max(mx);
    const float mnew = fmaxf(m2, mx);
    const float f = __builtin_amdgcn_exp2f(m2 - mnew);
    m2 = mnew;
    float ps = 0.f;
#pragma unroll
    for (int r = 0; r < 16; ++r) { s0[r] = __builtin_amdgcn_exp2f(s0[r] - mnew); s1[r] = __builtin_amdgcn_exp2f(s1[r] - mnew); ps += s0[r] + s1[r]; }
    lsum = lsum * f + ps;
    if (__any(f != 1.f)) {
        if (hi == 0) *wsf_r = f;
        asm volatile("s_waitcnt lgkmcnt(0)" ::: "memory");
#pragma unroll
        for (int a = 0; a < 4; ++a) {
            const f32x4 fv = *(const f32x4*)(wsf_hi + 8 * a);
#pragma unroll
            for (int k = 0; k < 4; ++k) { o0[4 * a + k] *= fv[k]; o1[4 * a + k] *= fv[k]; }
        }
        asm volatile("s_waitcnt lgkmcnt(0)" ::: "memory");
    }
    u32x4 pw[4];
#pragma unroll
    for (int k = 0; k < 4; ++k) { pw[0][k] = cvtpk(s0[2 * k], s0[2 * k + 1]); pw[1][k] = cvtpk(s0[8 + 2 * k], s0[8 + 2 * k + 1]); pw[2][k] = cvtpk(s1[2 * k], s1[2 * k + 1]); pw[3][k] = cvtpk(s1[8 + 2 * k], s1[8 + 2 * k + 1]); }
    const lds_cptr vp = (lds_cptr)vimg + ((lane >> 4) & 1) * 32 + (lane & 3) * 8 + (4 * hi + ((lane & 15) >> 2)) * 64;
#pragma unroll
    for (int i = 0; i < 8; ++i) {
        const s16x4 lo = vtr(vp + ((i >> 2) * 4096 + (i & 3) * 1024)), hh = vtr(vp + ((i >> 2) * 4096 + (i & 3) * 1024 + 512));
        const bf16x8 vf = (bf16x8){lo[0], lo[1], lo[2], lo[3], hh[0], hh[1], hh[2], hh[3]};
        const bf16x8 pf = __builtin_bit_cast(bf16x8, pw[i & 3]);
        if (i < 4) o0 = MFMA32(pf, vf, o0); else o1 = MFMA32(pf, vf, o1);
    }
}

constexpr int NSA_KV0 = 0, NSA_KV1 = 16384, NSA_WSF = 32768, NSA_IMP = NSA_WSF + 2048, NSA_SEL = NSA_IMP + 16384, NSA_LIST = NSA_SEL + 512, NSA_OST = NSA_LIST + 256, NSA_YAC = NSA_OST + 32768, NSA_LDS = NSA_YAC + 65536;
static_assert(NSA_LDS <= 152 * 1024, "lds");

DEVI BlkDesc nsa_desc(const P& p, bool prompt, int b, int g, int branch, int j) {
    BlkDesc d;
    if (prompt) {
        if (branch == 0) { d.k = (const char*)(p.KC + ((size_t)(b * 64) * 512 + g * 64)); d.stride_bytes = 2048; d.f32 = 1; d.count = 64; d.pos0 = 0; }
        else { d.k = (const char*)(p.PROJ + ((size_t)b * 4096 + j * 64) * PS + (branch == 1 ? C_SLC : C_WIN) + g * 64); d.stride_bytes = PS * 2; d.f32 = 0; d.count = 64; d.pos0 = j * 64; }
    } else {
        if (branch == 0) { d.k = (const char*)(p.KC + ((size_t)(256 + b * 32) * 512 + g * 64)); d.stride_bytes = 2048; d.f32 = 1; d.count = 32; d.pos0 = 0; }
        else if (branch == 1 && j < 32) { const int page = p.page_table[b * 16 + (j >> 1)]; d.k = (const char*)(p.cache_slc + ((size_t)page * 128 + (j & 1) * 64) * 512 + g * 64); d.stride_bytes = 2048; d.f32 = 1; d.count = 64; d.pos0 = j * 64; }
        else if (branch == 2 && j < 8) { d.k = (const char*)(p.cache_win + ((size_t)b * 512 + j * 64) * 512 + g * 64); d.stride_bytes = 2048; d.f32 = 1; d.count = 64; d.pos0 = 1536 + j * 64; }
        else { d.k = (const char*)(p.PROJ + ((size_t)NTP + b * 4) * PS + (branch == 1 ? C_SLC : C_WIN) + g * 64); d.stride_bytes = PS * 2; d.f32 = 0; d.count = 4; d.pos0 = 2048; }
    }
    return d;
}

constexpr int NS_IMG = 0, NS_WSF = 131072, NS_IMP = NS_WSF + 2048, NS_SEL = NS_IMP + 2048, NS_LIST = NS_SEL + 64, NS_YC = NS_LIST + 64, NS_PM = NS_YC + 4096, NS_Q = NS_PM + 2048, NS_LDS = NS_Q + 4096;
static_assert(NS_LDS <= 152 * 1024, "lds");
DEVI void wave_stage_block(const BlkDesc& d, char* kimg, char* vimg, int lane) {
    asm volatile("" : "+v"(lane));
    const int rsub = lane >> 4, pc = lane & 15;
    if (d.f32) {
#pragma unroll
        for (int half = 0; half < 2; ++half) {
#pragma unroll
            for (int i0 = 0; i0 < 16; i0 += 6) {
                f32x4 x[6];
#pragma unroll
                for (int i = 0; i < 6; ++i) if (i0 + i < 16) { const int row = 4 * (i0 + i) + rsub; x[i] = row < d.count ? __builtin_nontemporal_load((const f32x4*)(d.k + (size_t)row * d.stride_bytes + half * 1024 + pc * 16)) : (f32x4){0.f, 0.f, 0.f, 0.f}; }
#pragma unroll
                for (int i = 0; i < 6; ++i) if (i0 + i < 16) {
                    const int row = 4 * (i0 + i) + rsub, c = pc >> 1;
                    u32x2 o; o.x = pack2(x[i][0], x[i][1]); o.y = pack2(x[i][2], x[i][3]);
                    if (half == 0) *(u32x2*)(kimg + c * 1024 + row * 16 + (pc & 1) * 8) = o;
                    else *(u32x2*)(vimg + (c >> 2) * 4096 + row * 64 + (c & 3) * 16 + (pc & 1) * 8) = o;
                }
            }
        }
    } else {
        const int row = lane >> 3, c = lane & 7;
#pragma unroll
        for (int i = 0; i < 8; ++i) {
            const int rr = 8 * i + row;
            u32x4 kk = {0u, 0u, 0u, 0u}, vv = {0u, 0u, 0u, 0u};
            if (rr < d.count) { kk = *(const u32x4*)(d.k + (size_t)rr * d.stride_bytes + c * 16); vv = *(const u32x4*)(d.k + (size_t)rr * d.stride_bytes + 512 + c * 16); }
            *(u32x4*)(kimg + c * 1024 + rr * 16) = kk;
            *(u32x4*)(vimg + (c >> 2) * 4096 + rr * 64 + (c & 3) * 16) = vv;
        }
    }
    asm volatile("s_waitcnt lgkmcnt(0)" ::: "memory");
}

DEVI void nsa_sample_unit(const P& p, char* smem, int us) {
    const int tid = tid_opq(), lane = tid & 63, wid = tid >> 6, r32 = lane & 31, hi = lane >> 5;
    const int b = us >> 2, g = us & 3;
    const size_t rowbase = (size_t)NTP + b * 4;
    char* kimg = smem + NS_IMG + wid * 16384; char* vimg = kimg + 8192;
    float* wsf = (float*)(smem + NS_WSF) + wid * 64;
    float* impb = (float*)(smem + NS_IMP);
    unsigned long long* selm = (unsigned long long*)(smem + NS_SEL);
    unsigned char* blist = (unsigned char*)(smem + NS_LIST);
    float* ycmp = (float*)(smem + NS_YC);
    const int tokl = r32 >> 2, head = r32 & 3;
    const bool tok_ok = r32 < 16;
    const int qpos = 2048 + tokl;
    const float slope2 = alibi_slope(g * 4 + head) * 1.4426950408889634f;
    char* qsh = smem + NS_Q;
    int hi4 = 4 * hi; asm volatile("" : "+v"(hi4));
    float* wsf_hi = wsf + hi4; float* wsf_r = wsf + r32;
    f32x16 s0, s1;
    __syncthreads();
    if (wid == 0) {
        bf16x8 qr[4];
        {
            const bf16_t* qp = p.PROJ + (rowbase + (tok_ok ? tokl : 0)) * PS + C_BQ + (g * 4 + head) * 64 + hi * 8;
#pragma unroll
            for (int d0 = 0; d0 < 4; ++d0) {
                u32x4 v = *(const u32x4*)(qp + d0 * 16);
#pragma unroll
                for (int k = 0; k < 4; ++k) { const float lo = __uint_as_float(v[k] << 16) * 0.125f, hh = __uint_as_float(v[k] & 0xFFFF0000u) * 0.125f; v[k] = tok_ok ? ((__float_as_uint(lo) >> 16) | (__float_as_uint(hh) & 0xFFFF0000u)) : 0u; }
                qr[d0] = __builtin_bit_cast(bf16x8, v);
                *(u32x4*)(qsh + d0 * 1024 + lane * 16) = v;
            }
        }
        f32x16 o0 = {}, o1 = {}; float m2 = -1e30f, lsum = 0.f;
        const BlkDesc d = nsa_desc(p, false, b, g, 0, 0);
        wave_stage_block(d, kimg, vimg, lane);
        const int lh = 31 - hi4;
        const float sl = 64.f * slope2;
        attn_tile(kimg, vimg, qr, m2, lsum, o0, o1, s0, s1, sl, tok_ok ? sl * (float)(hi4 - 32) : -INFINITY, lh, -1000, false, wsf_hi, wsf_r, lane);
        const float lt = half_sum(lsum);
        const float inv = lt > 0.f ? 1.f / lt : 0.f;
        float* ib = impb + (r32 >> 2) * 64 + hi4;
#pragma unroll
        for (int r = 0; r < 16; ++r) {
            float a = s0[r] * inv, c = s1[r] * inv;
            a += __shfl_xor(a, 1); a += __shfl_xor(a, 2); c += __shfl_xor(c, 1); c += __shfl_xor(c, 2);
            if (head == 0) { ib[(r & 3) + 8 * (r >> 2)] = a; ib[(r & 3) + 8 * (r >> 2) + 32] = c; }
        }
        float fac = 0.f;
        if (tok_ok && lt > 0.f) fac = sigmoidf_(p.SM[(rowbase + tokl) * 64 + 8 + g * 4 + head]) / lt;
        if (hi == 0) *wsf_r = fac;
        asm volatile("s_waitcnt lgkmcnt(0)" ::: "memory");
#pragma unroll
        for (int a = 0; a < 2; ++a) {
            const f32x4 fv = *(const f32x4*)(wsf_hi + 8 * a);
#pragma unroll
            for (int k = 0; k < 4; ++k) { float* yp = ycmp + (8 * a + k + hi4) * 64 + r32; yp[0] = o0[4 * a + k] * fv[k]; yp[32] = o1[4 * a + k] * fv[k]; }
        }
        asm volatile("s_waitcnt lgkmcnt(0)" ::: "memory");
#pragma unroll 1
        for (int tl = 0; tl < 4; ++tl) {
            const int j = lane;
            float v = impb[tl * 64 + j];
            if (j == 32 || j == 0) v = 5.0f;
            if (j > 32) v = -2.0f;
            impb[tl * 64 + j] = v;
            asm volatile("s_waitcnt lgkmcnt(0)" ::: "memory");
            int rank = 0;
#pragma unroll 8
            for (int jj = 0; jj < 64; ++jj) { const float u = impb[tl * 64 + jj]; rank += (u > v || (u == v && jj < j)) ? 1 : 0; }
            const unsigned long long mask = __ballot(rank < 16 && j < 33);
            if (lane == 0) selm[tl] = mask;
        }
        asm volatile("s_waitcnt lgkmcnt(0)" ::: "memory");
        if (lane == 0) {
            unsigned long long u = selm[0] | selm[1] | selm[2] | selm[3];
            int n = 0;
            while (u) { const int j = __builtin_ctzll(u); u &= u - 1; blist[1 + n++] = (unsigned char)(0x40 | j); }
            for (int j = 0; j <= 8; ++j) blist[1 + n++] = (unsigned char)(0x80 | j);
            blist[0] = (unsigned char)n;
        }
    }
    __syncthreads();
    const int nb = blist[0];
    const unsigned long long mysel = tok_ok ? selm[tokl] : 0ull;
    int nslc = 0;
    for (int i = 0; i < nb; ++i) nslc += (blist[1 + i] >> 6) == 1 ? 1 : 0;
    float so[16], ms, lst;
    float wo[16], mw, lwt;
#pragma unroll 1
    for (int pass = 0; pass < 2; ++pass) {
        f32x16 o0 = {}, o1 = {}; float m2 = -1e30f, lsum = 0.f;
        const int i0 = pass == 0 ? 0 : nslc, i1 = pass == 0 ? nslc : nb;
#pragma unroll 1
        for (int i = i0 + wid; i < i1; i += 8) {
            const int e = blist[1 + i], br = e >> 6, j = e & 63;
            const BlkDesc d = nsa_desc(p, false, b, g, br, j);
            wave_stage_block(d, kimg, vimg, lane);
            asm volatile("" : "+v"(hi4));
            const bool lsel = tok_ok && (br == 2 || ((mysel >> j) & 1ull));
            const int rel = qpos - d.pos0;
            const int lh = (rel < d.count - 1 ? rel : d.count - 1) - hi4;
            const int ll = (br == 2 ? rel - 512 : -1000) - hi4;
            const bool fast = __all(!lsel || (lh >= 59 && ll < 0));
            const float bb = lsel ? slope2 * (float)(hi4 + d.pos0 - 2048) : -INFINITY;
            bf16x8 qr[4];
#pragma unroll
            for (int d0 = 0; d0 < 4; ++d0) qr[d0] = *(const bf16x8*)(qsh + d0 * 1024 + lane * 16);
            attn_tile(kimg, vimg, qr, m2, lsum, o0, o1, s0, s1, slope2, bb, lh, ll, fast, wsf_hi, wsf_r, lane);
        }
        const float lt = half_sum(lsum);
        if (pass == 0) { ms = m2; lst = lt;
#pragma unroll
            for (int r = 0; r < 8; ++r) { so[r] = o0[r]; so[8 + r] = o1[r]; } }
        else { mw = m2; lwt = lt;
#pragma unroll
            for (int r = 0; r < 8; ++r) { wo[r] = o0[r]; wo[8 + r] = o1[r]; } }
    }
    {
        float* po = (float*)kimg;
        float* pm = (float*)(smem + NS_PM) + wid * 64;
        if (lane < 16) { pm[lane * 2] = ms; pm[lane * 2 + 1] = lst; pm[32 + lane * 2] = mw; pm[32 + lane * 2 + 1] = lwt; }
#pragma unroll
        for (int a = 0; a < 2; ++a)
#pragma unroll
            for (int k = 0; k < 4; ++k) {
                float* yp = po + (8 * a + k + hi4) * 64 + r32;
                yp[0] = so[4 * a + k]; yp[32] = so[8 + 4 * a + k]; yp[1024] = wo[4 * a + k]; yp[1024 + 32] = wo[8 + 4 * a + k];
            }
    }
    __syncthreads();
    {
        const int row = tid >> 5, dcol = tid & 31, tk = row >> 2, hd = row & 3;
        float res[2][2];
#pragma unroll
        for (int br = 0; br < 2; ++br) {
            float M = -1e30f;
#pragma unroll
            for (int w = 0; w < 8; ++w) M = fmaxf(M, ((const float*)(smem + NS_PM))[w * 64 + br * 32 + row * 2]);
            float L = 0.f, a0 = 0.f, a1 = 0.f;
#pragma unroll
            for (int w = 0; w < 8; ++w) {
                const float* pmw = (const float*)(smem + NS_PM) + w * 64 + br * 32 + row * 2;
                const float f = __builtin_amdgcn_exp2f(pmw[0] - M);
                const float* pow_ = (const float*)(smem + NS_IMG + w * 16384) + br * 1024 + row * 64 + dcol;
                L += pmw[1] * f; a0 += pow_[0] * f; a1 += pow_[32] * f;
            }
            const float gate = sigmoidf_(p.SM[(rowbase + tk) * 64 + 8 + (br + 1) * 16 + g * 4 + hd]);
            const float sc = L > 0.f ? gate / L : 0.f;
            res[br][0] = a0 * sc; res[br][1] = a1 * sc;
        }
        const float y0 = ycmp[row * 64 + dcol] + res[0][0] + res[1][0], y1 = ycmp[row * 64 + dcol + 32] + res[0][1] + res[1][1];
        bf16_t* yb = p.YB + (rowbase + tk) * 1024 + (g * 4 + hd) * 64;
        yb[dcol] = f2bf(y0); yb[dcol + 32] = f2bf(y1);
    }
}

constexpr int NP_KVB = 18432, NP_KV0 = 0, NP_KV1 = NP_KVB, NP_WSF = 2 * NP_KVB, NP_IMP = NP_WSF + 2048, NP_SEL = NP_IMP + 16384, NP_LIST = NP_SEL + 512, NP_YAC = NP_LIST + 256, NP_LDS = NP_YAC + 65536;
static_assert(NP_LDS <= 152 * 1024, "lds");
DEVI void blk_store_ext(const BlkDesc& d, int pstep, int poff, int t0, char* kimg, char* vimg, int tid, const u32x4& rk, const u32x4& rv) {
    const int key = tid & 63, chunk = tid >> 6;
    *(u32x4*)(kimg + chunk * 1024 + key * 16) = rk;
    *(u32x4*)(vimg + (chunk >> 2) * 4096 + key * 64 + (chunk & 3) * 16) = rv;
    if (chunk == 0) {
        const int rel = d.pos0 + key * pstep + poff - t0;
        const int phi = (rel >> 6) << 6, plo = rel & 63;
        const unsigned bh = pack2((float)phi, (float)phi), bl = pack2((float)plo, (float)plo);
        *(u32x4*)(kimg + 8 * 1024 + key * 16) = (u32x4){bh, bl, 0x00003F80u, 0u};
    }
}
DEVI void attn_tile2(const char* kimg, const char* vimg, const bf16x8 (&qr)[4], const bf16x8 qext, float& m, float& lsum, f32x16& o0, f32x16& o1, f32x16& s0, f32x16& s1,
                     int lh, int ll, bool fast, float* wsf_hi, float* wsf_r, int lane) {
    const int r32 = lane & 31, hi = lane >> 5;
    const f32x16 z = {};
    s0 = z; s1 = z;
    {
        const char* kp = kimg + hi * 1024 + r32 * 16;
#pragma unroll
        for (int d0 = 0; d0 < 5; ++d0) {
            const bf16x8 k0 = *(const bf16x8*)(kp + d0 * 2048), k1 = *(const bf16x8*)(kp + d0 * 2048 + 512);
            const bf16x8 qf = d0 < 4 ? qr[d0 < 4 ? d0 : 0] : qext;
            s0 = MFMA32(k0, qf, s0); s1 = MFMA32(k1, qf, s1);
        }
    }
    if (!fast) {
#pragma unroll
        for (int r = 0; r < 16; ++r) {
            const int c = (r & 3) + 8 * (r >> 2);
            s0[r] = (c <= lh && c > ll) ? s0[r] : -INFINITY; s1[r] = (c + 32 <= lh && c + 32 > ll) ? s1[r] : -INFINITY;
        }
    }
    float mx = fmaxf(s0[0], s1[0]);
#pragma unroll
    for (int r = 1; r < 16; ++r) mx = fmaxf(mx, fmaxf(s0[r], s1[r]));
    mx = half_max(mx);
    const float mnew = fmaxf(m, mx);
    const float f = __builtin_amdgcn_exp2f((m - mnew) * 1.4426950408889634f);
    m = mnew;
    const float nm2 = -mnew * 1.4426950408889634f;
    float ps = 0.f;
#pragma unroll
    for (int r = 0; r < 16; ++r) { s0[r] = __builtin_amdgcn_exp2f(fmaf(s0[r], 1.4426950408889634f, nm2)); s1[r] = __builtin_amdgcn_exp2f(fmaf(s1[r], 1.4426950408889634f, nm2)); ps += s0[r] + s1[r]; }
    lsum = lsum * f + ps;
    if (__any(f != 1.f)) {
        if (hi == 0) *wsf_r = f;
        asm volatile("s_waitcnt lgkmcnt(0)" ::: "memory");
#pragma unroll
        for (int a = 0; a < 4; ++a) {
            const f32x4 fv = *(const f32x4*)(wsf_hi + 8 * a);
#pragma unroll
            for (int k = 0; k < 4; ++k) { o0[4 * a + k] *= fv[k]; o1[4 * a + k] *= fv[k]; }
        }
        asm volatile("s_waitcnt lgkmcnt(0)" ::: "memory");
    }
    u32x4 pw[4];
#pragma unroll
    for (int k = 0; k < 4; ++k) { pw[0][k] = cvtpk(s0[2 * k], s0[2 * k + 1]); pw[1][k] = cvtpk(s0[8 + 2 * k], s0[8 + 2 * k + 1]); pw[2][k] = cvtpk(s1[2 * k], s1[2 * k + 1]); pw[3][k] = cvtpk(s1[8 + 2 * k], s1[8 + 2 * k + 1]); }
    const lds_cptr vp = (lds_cptr)vimg + ((lane >> 4) & 1) * 32 + (lane & 3) * 8 + (4 * hi + ((lane & 15) >> 2)) * 64;
#pragma unroll
    for (int i = 0; i < 8; ++i) {
        const s16x4 lo = vtr(vp + ((i >> 2) * 4096 + (i & 3) * 1024)), hh = vtr(vp + ((i >> 2) * 4096 + (i & 3) * 1024 + 512));
        const bf16x8 vf = (bf16x8){lo[0], lo[1], lo[2], lo[3], hh[0], hh[1], hh[2], hh[3]};
        const bf16x8 pf = __builtin_bit_cast(bf16x8, pw[i & 3]);
        if (i < 4) o0 = MFMA32(pf, vf, o0); else o1 = MFMA32(pf, vf, o1);
    }
}

DEVI void attn_tile3(const char* kA, const char* vA, const char* kB, const char* vB, const bf16x8 (&qr)[4], const bf16x8 qeA, const bf16x8 qeB, float& m, float& lsum,
                     f32x16& o0, f32x16& o1, int lhA, int llA, bool fastA, int lhB, int llB, bool fastB, float* wsf_hi, float* wsf_r, int lane) {
    const int r32 = lane & 31, hi = lane >> 5;
    f32x16 a0 = {}, a1 = {}, b0 = {}, b1 = {};
    {
        const char* kpa = kA + hi * 1024 + r32 * 16; const char* kpb = kB + hi * 1024 + r32 * 16;
#pragma unroll
        for (int d0 = 0; d0 < 5; ++d0) {
            const bf16x8 ka0 = *(const bf16x8*)(kpa + d0 * 2048), ka1 = *(const bf16x8*)(kpa + d0 * 2048 + 512);
            const bf16x8 kb0 = *(const bf16x8*)(kpb + d0 * 2048), kb1 = *(const bf16x8*)(kpb + d0 * 2048 + 512);
            const bf16x8 qa = d0 < 4 ? qr[d0 < 4 ? d0 : 0] : qeA, qb = d0 < 4 ? qr[d0 < 4 ? d0 : 0] : qeB;
            a0 = MFMA32(ka0, qa, a0); a1 = MFMA32(ka1, qa, a1); b0 = MFMA32(kb0, qb, b0); b1 = MFMA32(kb1, qb, b1);
        }
    }
    if (!fastA) {
#pragma unroll
        for (int r = 0; r < 16; ++r) { const int c = (r & 3) + 8 * (r >> 2); a0[r] = (c <= lhA && c > llA) ? a0[r] : -INFINITY; a1[r] = (c + 32 <= lhA && c + 32 > llA) ? a1[r] : -INFINITY; }
    }
    if (!fastB) {
#pragma unroll
        for (int r = 0; r < 16; ++r) { const int c = (r & 3) + 8 * (r >> 2); b0[r] = (c <= lhB && c > llB) ? b0[r] : -INFINITY; b1[r] = (c + 32 <= lhB && c + 32 > llB) ? b1[r] : -INFINITY; }
    }
    float mx = fmaxf(fmaxf(a0[0], a1[0]), fmaxf(b0[0], b1[0]));
#pragma unroll
    for (int r = 1; r < 16; ++r) mx = fmaxf(mx, fmaxf(fmaxf(a0[r], a1[r]), fmaxf(b0[r], b1[r])));
    mx = half_max(mx);
    const float mnew = fmaxf(m, mx);
    const float f = __builtin_amdgcn_exp2f((m - mnew) * 1.4426950408889634f);
    m = mnew;
    const float nm2 = -mnew * 1.4426950408889634f;
    float ps = 0.f;
#pragma unroll
    for (int r = 0; r < 16; ++r) {
        a0[r] = __builtin_amdgcn_exp2f(fmaf(a0[r], 1.4426950408889634f, nm2)); a1[r] = __builtin_amdgcn_exp2f(fmaf(a1[r], 1.4426950408889634f, nm2));
        b0[r] = __builtin_amdgcn_exp2f(fmaf(b0[r], 1.4426950408889634f, nm2)); b1[r] = __builtin_amdgcn_exp2f(fmaf(b1[r], 1.4426950408889634f, nm2));
        ps += (a0[r] + a1[r]) + (b0[r] + b1[r]);
    }
    lsum = lsum * f + ps;
    if (__any(f != 1.f)) {
        if (hi == 0) *wsf_r = f;
        asm volatile("s_waitcnt lgkmcnt(0)" ::: "memory");
#pragma unroll
        for (int a = 0; a < 4; ++a) {
            const f32x4 fv = *(const f32x4*)(wsf_hi + 8 * a);
#pragma unroll
            for (int k = 0; k < 4; ++k) { o0[4 * a + k] *= fv[k]; o1[4 * a + k] *= fv[k]; }
        }
        asm volatile("s_waitcnt lgkmcnt(0)" ::: "memory");
    }
    const int voff = ((lane >> 4) & 1) * 32 + (lane & 3) * 8 + (4 * hi + ((lane & 15) >> 2)) * 64;
#pragma unroll
    for (int t = 0; t < 2; ++t) {
        const f32x16& p0 = t == 0 ? a0 : b0; const f32x16& p1 = t == 0 ? a1 : b1;
        u32x4 pw[4];
#pragma unroll
        for (int k = 0; k < 4; ++k) { pw[0][k] = cvtpk(p0[2 * k], p0[2 * k + 1]); pw[1][k] = cvtpk(p0[8 + 2 * k], p0[8 + 2 * k + 1]); pw[2][k] = cvtpk(p1[2 * k], p1[2 * k + 1]); pw[3][k] = cvtpk(p1[8 + 2 * k], p1[8 + 2 * k + 1]); }
        const lds_cptr vp = (lds_cptr)(t == 0 ? vA : vB) + voff;
#pragma unroll
        for (int i = 0; i < 8; ++i) {
            const s16x4 lo = vtr(vp + ((i >> 2) * 4096 + (i & 3) * 1024)), hh = vtr(vp + ((i >> 2) * 4096 + (i & 3) * 1024 + 512));
            const bf16x8 vf = (bf16x8){lo[0], lo[1], lo[2], lo[3], hh[0], hh[1], hh[2], hh[3]};
            const bf16x8 pf = __builtin_bit_cast(bf16x8, pw[i & 3]);
            if (i < 4) o0 = MFMA32(pf, vf, o0); else o1 = MFMA32(pf, vf, o1);
        }
    }
}

constexpr int NQ_KVB = 18432, NQ_WSF = 4 * NQ_KVB, NQ_SEL = NQ_WSF + 2048, NQ_LIST = NQ_SEL + 512, NQ_YAC = NQ_LIST + 256, NQ_LDS = NQ_YAC + 65536, NQ_IMP = 2 * NQ_KVB;
static_assert(NQ_LDS <= 152 * 1024, "lds");
DEVI void nsa_prompt_unit(const P& p, char* smem, int unit) {
    const int tid = tid_opq(), lane = tid & 63, wid = tid >> 6, r32 = lane & 31, hi = lane >> 5;
    float* wsf = (float*)(smem + NQ_WSF) + wid * 64;
    float* impb = (float*)(smem + NQ_IMP) + wid * 512;
    unsigned long long* selm = (unsigned long long*)(smem + NQ_SEL);
    unsigned char* blist = (unsigned char*)(smem + NQ_LIST);
    const int b = unit >> 8, g = ((unit >> 6) + b) & 3, qt = (b & 1) ? 63 - (unit & 63) : (unit & 63), t0 = qt * 64;
    const size_t rowbase = (size_t)b * 4096 + t0;
    const int tokl = wid * 8 + (r32 >> 2), head = r32 & 3;
    const int qpos = t0 + tokl;
    const float slope = alibi_slope(g * 4 + head);
    bf16x8 qr[4];
    {
        const bf16_t* qp = p.PROJ + (rowbase + tokl) * PS + C_BQ + (g * 4 + head) * 64 + hi * 8;
#pragma unroll
        for (int d0 = 0; d0 < 4; ++d0) {
            u32x4 v = *(const u32x4*)(qp + d0 * 16);
#pragma unroll
            for (int k = 0; k < 4; ++k) { const float lo = __uint_as_float(v[k] << 16) * 0.125f, hh = __uint_as_float(v[k] & 0xFFFF0000u) * 0.125f; v[k] = (__float_as_uint(lo) >> 16) | (__float_as_uint(hh) & 0xFFFF0000u); }
            qr[d0] = __builtin_bit_cast(bf16x8, v);
        }
    }
    unsigned qe_w;
    { const unsigned sh = (unsigned)f2bf(slope); const float rem = slope - __uint_as_float(sh << 16); qe_w = sh | ((unsigned)f2bf(rem) << 16); if (hi) qe_w = 0u; }
    int hi4 = 4 * hi; asm volatile("" : "+v"(hi4));
    float* yl = (float*)(smem + NQ_YAC) + wid * 2048 + hi4 * 64 + r32;
    float* wsf_hi = wsf + hi4; float* wsf_r = wsf + r32;
    f32x16 o0, o1; float m, lsum;
    auto finish = [&](int br) {
        const float lt = half_sum(lsum);
        float fac = 0.f;
        if (lt > 0.f) fac = sigmoidf_(p.SM[(rowbase + tokl) * 64 + 8 + br * 16 + g * 4 + head]) / lt;
        if (hi == 0) *wsf_r = fac;
        asm volatile("s_waitcnt lgkmcnt(0)" ::: "memory");
#pragma unroll
        for (int a = 0; a < 4; ++a) {
            const f32x4 fv = *(const f32x4*)(wsf_hi + 8 * a);
#pragma unroll
            for (int k = 0; k < 4; ++k) {
                float* yp = yl + (8 * a + k) * 64;
                if (br == 0) { yp[0] = o0[4 * a + k] * fv[k]; yp[32] = o1[4 * a + k] * fv[k]; }
                else { yp[0] += o0[4 * a + k] * fv[k]; yp[32] += o1[4 * a + k] * fv[k]; }
            }
        }
        asm volatile("s_waitcnt lgkmcnt(0)" ::: "memory");
    };
    __syncthreads();
    if (tid < 64) *(u32x4*)(smem + 9 * 1024 + tid * 16) = (u32x4){0u, 0u, 0u, 0u};
    {
        const BlkDesc d = nsa_desc(p, true, b, g, 0, 0);
        u32x4 rk, rv; blk_load(d, tid, rk, rv); blk_store_ext(d, 64, 63, t0, smem, smem + 10240, tid, rk, rv);
        __syncthreads();
        o0 = (f32x16){}; o1 = (f32x16){}; m = -1e30f; lsum = 0.f;
        f32x16 s0, s1;
        {
            const int nv = ((qpos + 1) >> 6) - 1;
            const int lh = (nv < 63 ? nv : 63) - hi4;
            const bf16x8 qext = __builtin_bit_cast(bf16x8, (u32x4){qe_w, qe_w, 0u, 0u});
            attn_tile2(smem, smem + 10240, qr, qext, m, lsum, o0, o1, s0, s1, lh, -1000, false, wsf_hi, wsf_r, lane);
        }
        const float lt = half_sum(lsum);
        const float inv = lt > 0.f ? 1.f / lt : 0.f;
        float* ib = impb + (r32 >> 2) * 64 + hi4;
#pragma unroll
        for (int r = 0; r < 16; ++r) {
            float a = s0[r] * inv, c = s1[r] * inv;
            a += __shfl_xor(a, 1); a += __shfl_xor(a, 2); c += __shfl_xor(c, 1); c += __shfl_xor(c, 2);
            if (head == 0) { ib[(r & 3) + 8 * (r >> 2)] = a; ib[(r & 3) + 8 * (r >> 2) + 32] = c; }
        }
        asm volatile("s_waitcnt lgkmcnt(0)" ::: "memory");
        finish(0);
#pragma unroll 1
        for (int tl = 0; tl < 8; ++tl) {
            const int j = lane;
            float v = impb[tl * 64 + j];
            if (j == qt || j == 0) v = 5.0f;
            if (j > qt) v = -1.0f;
            impb[tl * 64 + j] = v;
            asm volatile("s_waitcnt lgkmcnt(0)" ::: "memory");
            int rank = 0;
#pragma unroll 8
            for (int jj = 0; jj < 64; ++jj) { const float u = impb[tl * 64 + jj]; rank += (u > v || (u == v && jj < j)) ? 1 : 0; }
            const unsigned long long mask = __ballot(rank < 16);
            if (lane == 0) selm[wid * 8 + tl] = mask;
        }
    }
    __syncthreads();
    if (wid == 0) {
        unsigned long long u = selm[lane];
#pragma unroll
        for (int o = 32; o > 0; o >>= 1) u |= __shfl_xor(u, o);
        u &= (qt == 63) ? ~0ull : ((1ull << (qt + 1)) - 1ull);
        if (lane == 0) {
            int n = 0;
            while (u) { const int j = __builtin_ctzll(u); u &= u - 1; blist[2 + n++] = (unsigned char)j; }
            blist[0] = (unsigned char)n;
            int nw = 0;
            for (int j = (qt - 8 > 0 ? qt - 8 : 0); j <= qt; ++j) blist[2 + n + nw++] = (unsigned char)j;
            blist[1] = (unsigned char)nw;
        }
    }
    __syncthreads();
    if (tid >= 64 && tid < 256) *(u32x4*)(smem + (tid >> 6) * NQ_KVB + 9 * 1024 + (tid & 63) * 16) = (u32x4){0u, 0u, 0u, 0u};
    const int ns = blist[0], nw = blist[1];
    const int nss = (ns + 1) >> 1, nsteps = nss + ((nw + 1) >> 1);
    const unsigned long long mysel = selm[tokl];
    {
        auto step_blocks = [&](int s, int& br, int& jA, int& jB) {
            if (s < nss) { br = 1; jA = blist[2 + 2 * s]; jB = 2 * s + 1 < ns ? (int)blist[2 + 2 * s + 1] : -1; }
            else { const int w = s - nss; br = 2; jA = blist[2 + ns + 2 * w]; jB = 2 * w + 1 < nw ? (int)blist[2 + ns + 2 * w + 1] : -1; }
        };
        u32x4 rkA, rvA, rkB, rvB;
        auto load_step = [&](int s) {
            int br, jA, jB; step_blocks(s, br, jA, jB);
            const BlkDesc dA = nsa_desc(p, true, b, g, br, jA); blk_load(dA, tid, rkA, rvA);
            if (jB >= 0) { const BlkDesc dB = nsa_desc(p, true, b, g, br, jB); blk_load(dB, tid, rkB, rvB); }
        };
        auto store_step = [&](int s, char* buf) {
            int br, jA, jB; step_blocks(s, br, jA, jB);
            BlkDesc dA; dA.pos0 = jA * 64; blk_store_ext(dA, 1, 0, t0, buf, buf + 10240, tid, rkA, rvA);
            if (jB >= 0) { BlkDesc dB; dB.pos0 = jB * 64; blk_store_ext(dB, 1, 0, t0, buf + NQ_KVB, buf + NQ_KVB + 10240, tid, rkB, rvB); }
        };
        load_step(0); store_step(0, smem);
        __syncthreads();
        int prev_br = 1;
        o0 = (f32x16){}; o1 = (f32x16){}; m = -1e30f; lsum = 0.f;
        for (int s = 0; s < nsteps; ++s) {
            int br, jA, jB; step_blocks(s, br, jA, jB);
            char* cur = smem + (s & 1) * 2 * NQ_KVB;
            char* nxt = smem + ((s & 1) ^ 1) * 2 * NQ_KVB;
            if (s + 1 < nsteps) load_step(s + 1);
            if (br != prev_br) { finish(1); o0 = (f32x16){}; o1 = (f32x16){}; m = -1e30f; lsum = 0.f; prev_br = br; }
            {
                asm volatile("" : "+v"(hi4));
                const bool lselA = br == 2 || ((mysel >> jA) & 1ull);
                const int relA = qpos - jA * 64;
                const int lhA = (relA < 63 ? relA : 63) - hi4, llA = (br == 2 ? relA - 512 : -1000) - hi4;
                const bool fastA = __all(!lselA || (lhA >= 59 && llA < 0));
                const bool needA = __any(lselA && lhA + hi4 >= 0 && llA + hi4 < 63);
                const bf16x8 qeA = __builtin_bit_cast(bf16x8, (u32x4){qe_w, qe_w, (lselA || hi) ? 0u : 0x0000C6EAu, 0u});
                bool needB = false; bool lselB = false; int lhB = -1000, llB = -1000; bool fastB = false;
                if (jB >= 0) {
                    lselB = br == 2 || ((mysel >> jB) & 1ull);
                    const int relB = qpos - jB * 64;
                    lhB = (relB < 63 ? relB : 63) - hi4; llB = (br == 2 ? relB - 512 : -1000) - hi4;
                    fastB = __all(!lselB || (lhB >= 59 && llB < 0));
                    needB = __any(lselB && lhB + hi4 >= 0 && llB + hi4 < 63);
                }
                const bf16x8 qeB = __builtin_bit_cast(bf16x8, (u32x4){qe_w, qe_w, (lselB || hi) ? 0u : 0x0000C6EAu, 0u});
                f32x16 s0, s1;
                if (needA && needB) attn_tile3(cur, cur + 10240, cur + NQ_KVB, cur + NQ_KVB + 10240, qr, qeA, qeB, m, lsum, o0, o1, lhA, llA, fastA, lhB, llB, fastB, wsf_hi, wsf_r, lane);
                else if (needA) attn_tile2(cur, cur + 10240, qr, qeA, m, lsum, o0, o1, s0, s1, lhA, llA, fastA, wsf_hi, wsf_r, lane);
                else if (needB) attn_tile2(cur + NQ_KVB, cur + NQ_KVB + 10240, qr, qeB, m, lsum, o0, o1, s0, s1, lhB, llB, fastB, wsf_hi, wsf_r, lane);
            }
            if (s + 1 < nsteps) store_step(s + 1, nxt);
            __syncthreads();
        }
        finish(2);
    }
    {
        const float* yac = (const float*)(smem + NQ_YAC) + wid * 2048;
#pragma unroll
        for (int i = 0; i < 4; ++i) {
            const int orow = i * 8 + (lane >> 3), ch = lane & 7, tk = wid * 8 + (orow >> 2), hd = orow & 3;
            const f32x4 a = *(const f32x4*)(yac + orow * 64 + ch * 8), c = *(const f32x4*)(yac + orow * 64 + ch * 8 + 4);
            *(u32x4*)(p.YB + (rowbase + tk) * 1024 + (g * 4 + hd) * 64 + ch * 8) = pack8f(a, c);
        }
        asm volatile("s_waitcnt lgkmcnt(0)" ::: "memory");
    }
}

DEVI void stage_nsa_attn(const P& p, char* smem, int bid, int nblk) {
#ifndef NSA_REP
#define NSA_REP 0
#endif
    const int n_units = 1024 + 512 + (NSA_REP == 1 ? 1024 : 0) + (NSA_REP == 2 ? 512 : 0);
    for (int unit0 = bid; unit0 < n_units; unit0 += nblk) {
        const int unit = unit0 < 1536 ? unit0 : (NSA_REP == 1 ? unit0 - 1536 : unit0 - 512);
        if (unit < 1024) nsa_prompt_unit(p, smem, unit); else nsa_sample_unit(p, smem, unit - 1024);
    }
}

DEVI void stage_ln1(const P& p, int bid, int nblk) {
    const int lane = tid_opq() & 63, wid = tid_opq() >> 6;
    for (int row = bid * 8 + wid; row < NT; row += nblk * 8) {
        f32x4 x[4];
        float s = 0.f;
#pragma unroll
        for (int i = 0; i < 4; ++i) { x[i] = *(const f32x4*)(p.R + (size_t)row * 1024 + i * 256 + lane * 4); s += x[i][0] + x[i][1] + x[i][2] + x[i][3]; }
        const float mean = wave_sum(s) * (1.f / 1024.f);
        float q = 0.f;
#pragma unroll
        for (int i = 0; i < 4; ++i)
#pragma unroll
            for (int k = 0; k < 4; ++k) q += (x[i][k] - mean) * (x[i][k] - mean);
        const float rs = rsqrtf(wave_sum(q) * (1.f / 1024.f) + LN_EPS);
#pragma unroll
        for (int i = 0; i < 4; ++i) {
            const int c = i * 256 + lane * 4;
            const f32x4 gg = *(const f32x4*)(p.ln1_g + c), bb = *(const f32x4*)(p.ln1_b + c);
            f32x4 y;
#pragma unroll
            for (int k = 0; k < 4; ++k) y[k] = (x[i][k] - mean) * rs * gg[k] + bb[k];
            u32x2 o; o.x = pack2(y[0], y[1]); o.y = pack2(y[2], y[3]);
            *(u32x2*)(p.HB + (size_t)row * 1024 + c) = o;
        }
        if (lane == 0) { p.H[(size_t)row * 2] = mean; p.H[(size_t)row * 2 + 1] = rs; }
    }
}

__device__ const unsigned char PEER_CA[50] = {0,0,0,0,0,0,0,0,0,0,0,0,0,0,0,0, 1,1,1,1,1,1,1,1, 2,2,2,2,2, 3,3,3,3, 4,4,4, 5,5, 6,6, 7,7, 8,9,10,11,12,13,14,15};
__device__ const unsigned char PEER_CB[50] = {0,1,2,3,4,5,6,7,8,9,10,11,12,13,14,15, 0,1,2,3,4,5,6,7, 0,1,2,3,4, 0,1,2,3, 0,1,2, 0,1, 0,1, 0,1, 0,0,0,0,0,0,0,0};

DEVI void ce_desc(unsigned& a, unsigned& b) { const unsigned hi = a > b ? a : b, lo = a > b ? b : a; a = hi; b = lo; }
template <int BASE> DEVI void sort16_desc(unsigned (&x)[64]) {
#pragma unroll
    for (int k = 2; k <= 16; k <<= 1)
#pragma unroll
        for (int j = k >> 1; j > 0; j >>= 1)
#pragma unroll
            for (int i = 0; i < 16; ++i) {
                const int l = i ^ j;
                if (l > i) { if ((i & k) == 0) ce_desc(x[BASE + i], x[BASE + l]); else ce_desc(x[BASE + l], x[BASE + i]); }
            }
}
DEVI void merge_top16(const unsigned* a, const unsigned* b, unsigned* t) {
    unsigned c[16];
#pragma unroll
    for (int i = 0; i < 16; ++i) c[i] = a[i] > b[15 - i] ? a[i] : b[15 - i];
#pragma unroll
    for (int j = 8; j > 0; j >>= 1)
#pragma unroll
        for (int i = 0; i < 16; ++i) { const int l = i ^ j; if (l > i) ce_desc(c[i], c[l]); }
#pragma unroll
    for (int i = 0; i < 16; ++i) t[i] = c[i];
}
DEVI float key_score(unsigned k) { const unsigned u = k & ~127u; return __uint_as_float((u & 0x80000000u) ? (u & 0x7FFFFFFFu) : ~u); }

DEVI void sort8_desc(unsigned (&x)[16]) {
#pragma unroll
    for (int k = 2; k <= 8; k <<= 1)
#pragma unroll
        for (int j = k >> 1; j > 0; j >>= 1)
#pragma unroll
            for (int i = 0; i < 8; ++i) {
                const int l = i ^ j;
                if (l > i) { if ((i & k) == 0) ce_desc(x[i], x[l]); else ce_desc(x[l], x[i]); }
            }
}
DEVI unsigned sum_key(unsigned ka, unsigned kb, unsigned tag) {
    const unsigned u = __float_as_uint(key_score(ka) + key_score(kb));
    const unsigned o = (u & 0x80000000u) ? ~u : (u | 0x80000000u);
    return (o & ~255u) | tag;
}
DEVI float key_score8(unsigned k) { const unsigned u = k & ~255u; return __uint_as_float((u & 0x80000000u) ? (u & 0x7FFFFFFFu) : ~u); }

DEVI void route_top16(const P& p, int row, int ph, int c, int r32, int hi, int hi4, unsigned (&fin)[16]) {
    f32x16 acc[4];
#pragma unroll
    for (int t = 0; t < 4; ++t) acc[t] = (f32x16){};
    const bf16_t* qp = p.PQ + (size_t)row * 2048 + ph * 256 + c * 128 + hi * 8;
    const bf16_t* kp = p.KEYSB + ((size_t)((ph * 2 + c) * 128 + r32)) * 128 + hi * 8;
#pragma unroll
    for (int s8 = 0; s8 < 8; ++s8) {
        const bf16x8 qf = *(const bf16x8*)(qp + s8 * 16);
#pragma unroll
        for (int t = 0; t < 4; ++t) {
            const bf16x8 kf = *(const bf16x8*)(kp + (size_t)t * 32 * 128 + s8 * 16);
            acc[t] = MFMA32(kf, qf, acc[t]);
        }
    }
    unsigned x[64];
#pragma unroll
    for (int t = 0; t < 4; ++t)
#pragma unroll
        for (int r = 0; r < 16; ++r) {
            const unsigned u = __float_as_uint(acc[t][r]);
            const unsigned o = (u & 0x80000000u) ? ~u : (u | 0x80000000u);
            x[t * 16 + r] = (o & ~127u) | (unsigned)(127 - ((r & 3) + 8 * (r >> 2) + 32 * t) - hi4);
        }
    sort16_desc<0>(x); sort16_desc<16>(x); sort16_desc<32>(x); sort16_desc<48>(x);
    unsigned t01[16], t23[16], tt[16], oth[16];
    merge_top16(&x[0], &x[16], t01); merge_top16(&x[32], &x[48], t23); merge_top16(t01, t23, tt);
#pragma unroll
    for (int i = 0; i < 16; ++i) { auto rr = __builtin_amdgcn_permlane32_swap(tt[i], tt[i], false, false); oth[i] = hi ? rr[0] : rr[1]; }
    merge_top16(tt, oth, fin);
}

DEVI void stage_peer_route(const P& p, char* smem, int bid, int nblk, int p0, int p1) {
    const int lane = tid_opq() & 63, wid = tid_opq() >> 6, r32 = lane & 31, hi = lane >> 5;
    unsigned char* tb = (unsigned char*)smem + wid * 1024 + r32 * 32;
    const int tpw = (NT + nblk - 1) / nblk, row_lo = bid * tpw, row_hi = (row_lo + tpw < NT) ? row_lo + tpw : NT;
    const int ph = wid;
    for (int pass = p0; pass < p1 && row_lo + pass * 32 < row_hi; ++pass) {
        const int row_raw = row_lo + pass * 32 + r32;
        const bool row_ok = row_raw < row_hi;
        const int row = row_ok ? row_raw : row_lo;
        int hi4 = 4 * hi; asm volatile("" : "+v"(hi4));
        unsigned fa[16], fb[16];
        route_top16(p, row, ph, 0, r32, hi, hi4, fa);
        asm volatile("" : "+v"(hi4));
        route_top16(p, row, ph, 1, r32, hi, hi4, fb);
        if (hi == 0) {
            u32x4 wa, wb;
#pragma unroll
            for (int i = 0; i < 4; ++i) {
                wa[i] = (127u - (fa[4 * i] & 127u)) | ((127u - (fa[4 * i + 1] & 127u)) << 8) | ((127u - (fa[4 * i + 2] & 127u)) << 16) | ((127u - (fa[4 * i + 3] & 127u)) << 24);
                wb[i] = (127u - (fb[4 * i] & 127u)) | ((127u - (fb[4 * i + 1] & 127u)) << 8) | ((127u - (fb[4 * i + 2] & 127u)) << 16) | ((127u - (fb[4 * i + 3] & 127u)) << 24);
            }
            *(u32x4*)tb = wa; *(u32x4*)(tb + 16) = wb;
        }
        unsigned g0[16], g1[16], g2[16], g3[16];
#pragma unroll
        for (int j = 0; j < 16; ++j) g0[j] = sum_key(fa[0], fb[j], (unsigned)j);
#pragma unroll
        for (int k = 0; k < 15; ++k) g1[k] = sum_key(fa[k + 1], fb[0], (unsigned)((k + 1) << 4));
        g1[15] = 0u;
#pragma unroll
        for (int j = 1; j < 8; ++j) g2[j - 1] = sum_key(fa[1], fb[j], (unsigned)(16 | j));
        g2[7] = 0u; g2[8] = 0u; g2[9] = 0u;
#pragma unroll
        for (int i = 2; i < 8; ++i) g2[17 - i] = sum_key(fa[i], fb[1], (unsigned)((i << 4) | 1));
#pragma unroll
        for (int j = 8; j > 0; j >>= 1)
#pragma unroll
            for (int i = 0; i < 16; ++i) { const int l = i ^ j; if (l > i) ce_desc(g2[i], g2[l]); }
        g3[0] = sum_key(fa[2], fb[2], 0x22u); g3[1] = sum_key(fa[2], fb[3], 0x23u); g3[2] = sum_key(fa[2], fb[4], 0x24u);
        g3[3] = sum_key(fa[3], fb[2], 0x32u); g3[4] = sum_key(fa[4], fb[2], 0x42u); g3[5] = sum_key(fa[3], fb[3], 0x33u);
#pragma unroll
        for (int i = 6; i < 16; ++i) g3[i] = 0u;
        sort8_desc(g3);
        unsigned t01[16], t23[16], top[16];
        merge_top16(g0, g1, t01); merge_top16(g2, g3, t23); merge_top16(t01, t23, top);
        float ev[16]; float sum = 0.f;
        const float vmax = key_score8(top[0]);
#pragma unroll
        for (int k = 0; k < 16; ++k) { ev[k] = __expf(key_score8(top[k]) - vmax); sum += ev[k]; }
        const float inv = 1.f / sum;
        asm volatile("s_waitcnt lgkmcnt(0)" ::: "memory");
        if (!row_ok) {   } else if (hi == 0) {
            int* dst = p.EIDX + (size_t)row * 128 + ph * 16;
#pragma unroll
            for (int q4 = 0; q4 < 4; ++q4) {
                u32x4 o;
#pragma unroll
                for (int k = 0; k < 4; ++k) { const unsigned tg = top[q4 * 4 + k] & 255u; o[k] = (unsigned)tb[tg >> 4] * 128u + (unsigned)tb[16 + (tg & 15u)]; }
                *(u32x4*)(dst + q4 * 4) = o;
            }
        } else {
            float* dst = p.EGATE + (size_t)row * 128 + ph * 16;
#pragma unroll
            for (int q4 = 0; q4 < 4; ++q4) *(f32x4*)(dst + q4 * 4) = (f32x4){ev[q4 * 4] * inv, ev[q4 * 4 + 1] * inv, ev[q4 * 4 + 2] * inv, ev[q4 * 4 + 3] * inv};
        }
        asm volatile("s_waitcnt lgkmcnt(0)" ::: "memory");
    }
}

constexpr int PA_WAVE_LDS = 1024 + 1024 + 512 + 512 + 512;
DEVI void stage_peer_apply(const P& p, char* smem, int bid, int nblk, int p0, int p1) {
    const int lane = tid_opq() & 63, wid = tid_opq() >> 6;
    char* wl = smem + wid * PA_WAVE_LDS;
    unsigned char* hhi = (unsigned char*)wl; unsigned char* hlo = hhi + 1024;
    int* idxs = (int*)(wl + 2048);
    float* gts = (float*)(wl + 2560);
    float* cs = (float*)(wl + 3072);
    const int fr = lane & 15, fq = lane >> 4;
    const int tpw = (NT + nblk - 1) / nblk, row_lo = bid * tpw, row_hi = (row_lo + tpw < NT) ? row_lo + tpw : NT;
    for (int row = row_lo + p0 * 32 + wid; row < row_hi && row < row_lo + p1 * 32; row += 8) {
        float hv[16];
        {
            const float* hr = p.R + (size_t)row * 1024 + lane * 16;
            const float mean1 = p.H[(size_t)row * 2], rs1 = p.H[(size_t)row * 2 + 1];
            u32x4 ohi, olo;
#pragma unroll
            for (int i = 0; i < 4; ++i) {
                f32x4 x = *(const f32x4*)(hr + i * 4);
                { const f32x4 g1 = *(const f32x4*)(p.ln1_g + lane * 16 + i * 4), b1 = *(const f32x4*)(p.ln1_b + lane * 16 + i * 4);
#pragma unroll
                  for (int k = 0; k < 4; ++k) x[k] = (x[k] - mean1) * rs1 * g1[k] + b1[k]; }
#pragma unroll
                for (int k = 0; k < 4; ++k) hv[i * 4 + k] = x[k];
                int w = __builtin_amdgcn_cvt_pk_fp8_f32(x[0], x[1], 0, false); w = __builtin_amdgcn_cvt_pk_fp8_f32(x[2], x[3], w, true);
                const f32x2 d01 = __builtin_amdgcn_cvt_pk_f32_fp8(w, false), d23 = __builtin_amdgcn_cvt_pk_f32_fp8(w, true);
                int w2 = __builtin_amdgcn_cvt_pk_fp8_f32(x[0] - d01[0], x[1] - d01[1], 0, false); w2 = __builtin_amdgcn_cvt_pk_fp8_f32(x[2] - d23[0], x[3] - d23[1], w2, true);
                ohi[i] = (unsigned)w; olo[i] = (unsigned)w2;
            }
            *(u32x4*)(hhi + lane * 16) = ohi; *(u32x4*)(hlo + lane * 16) = olo;
            idxs[lane] = p.EIDX[(size_t)row * 128 + lane]; idxs[lane + 64] = p.EIDX[(size_t)row * 128 + 64 + lane];
            gts[lane] = p.EGATE[(size_t)row * 128 + lane]; gts[lane + 64] = p.EGATE[(size_t)row * 128 + 64 + lane];
            asm volatile("s_waitcnt lgkmcnt(0)" ::: "memory");
        }
#pragma unroll 1
        for (int g = 0; g < 8; ++g) {
            const int my_e = idxs[g * 16 + fr];
            const unsigned char* ub = p.U8 + (size_t)my_e * 1024 + fq * 16;
            f32x4 acc = (f32x4){0.f, 0.f, 0.f, 0.f};
            u32x4 a[16];
#pragma unroll
            for (int s2 = 0; s2 < 16; ++s2) a[s2] = *(const u32x4*)(ub + s2 * 64);
#pragma unroll
            for (int s2 = 0; s2 < 16; ++s2) {
                const u32x4 bh = *(const u32x4*)(hhi + s2 * 64 + fq * 16), bl = *(const u32x4*)(hlo + s2 * 64 + fq * 16);
                const long a0 = (long)(((unsigned long long)a[s2][1] << 32) | a[s2][0]), a1 = (long)(((unsigned long long)a[s2][3] << 32) | a[s2][2]);
                const long h0 = (long)(((unsigned long long)bh[1] << 32) | bh[0]), h1 = (long)(((unsigned long long)bh[3] << 32) | bh[2]);
                const long l0 = (long)(((unsigned long long)bl[1] << 32) | bl[0]), l1 = (long)(((unsigned long long)bl[3] << 32) | bl[2]);
                acc = __builtin_amdgcn_mfma_f32_16x16x32_fp8_fp8(a0, h0, acc, 0, 0, 0);
                acc = __builtin_amdgcn_mfma_f32_16x16x32_fp8_fp8(a1, h1, acc, 0, 0, 0);
                acc = __builtin_amdgcn_mfma_f32_16x16x32_fp8_fp8(a0, l0, acc, 0, 0, 0);
                acc = __builtin_amdgcn_mfma_f32_16x16x32_fp8_fp8(a1, l1, acc, 0, 0, 0);
            }
            const f32x4 gg = *(const f32x4*)(gts + g * 16 + fq * 4);
            f32x4 cv;
#pragma unroll
            for (int r = 0; r < 4; ++r) {
                const int e = idxs[g * 16 + fq * 4 + r];
                const float d = acc[r] * p.US[e];
                cv[r] = gg[r] * p.VS[e] * 0.5f * d * (1.f + erff(d * 0.7071067811865476f));
            }
            if (fr == 0) *(f32x4*)(cs + g * 16 + fq * 4) = cv;
        }
        asm volatile("s_waitcnt lgkmcnt(0)" ::: "memory");
        float acc[16];
#pragma unroll
        for (int i = 0; i < 16; ++i) acc[i] = 0.f;
#pragma unroll 1
        for (int e0 = 0; e0 < 128; e0 += 16) {
            u32x4 v[16]; float c[16];
#pragma unroll
            for (int k = 0; k < 16; ++k) { v[k] = *(const u32x4*)(p.V8 + (size_t)idxs[e0 + k] * 1024 + lane * 16); c[k] = cs[e0 + k]; }
#pragma unroll
            for (int k = 0; k < 16; ++k) {
#pragma unroll
                for (int w = 0; w < 4; ++w) {
                    const f32x2 lo = __builtin_amdgcn_cvt_pk_f32_fp8((int)v[k][w], false), hh = __builtin_amdgcn_cvt_pk_f32_fp8((int)v[k][w], true);
                    acc[w * 4] += c[k] * lo[0]; acc[w * 4 + 1] += c[k] * lo[1]; acc[w * 4 + 2] += c[k] * hh[0]; acc[w * 4 + 3] += c[k] * hh[1];
                }
            }
        }
        float s = 0.f;
#pragma unroll
        for (int i = 0; i < 16; ++i) { acc[i] += DN_ALPHA * hv[i]; s += acc[i]; }
        const float mean = wave_sum(s) * (1.f / 1024.f);
        float q = 0.f;
#pragma unroll
        for (int i = 0; i < 16; ++i) q += (acc[i] - mean) * (acc[i] - mean);
        const float rs = rsqrtf(wave_sum(q) * (1.f / 1024.f) + LN_EPS);
#pragma unroll
        for (int i = 0; i < 4; ++i) {
            const int c = lane * 16 + i * 4;
            const f32x4 g0 = *(const f32x4*)(p.ln2_g + c), b0 = *(const f32x4*)(p.ln2_b + c);
            f32x4 y0;
#pragma unroll
            for (int k = 0; k < 4; ++k) y0[k] = (acc[i * 4 + k] - mean) * rs * g0[k] + b0[k];
            *(f32x4*)(p.out + O_Y + (size_t)row * 1024 + c) = y0;
        }
    }
}

namespace pg8 {
#define PG8_LAS __attribute__((address_space(3)))
typedef unsigned short bf16_t;
typedef short bf16x8 __attribute__((ext_vector_type(8)));
typedef float f32x4 __attribute__((ext_vector_type(4)));
typedef unsigned u32x4 __attribute__((ext_vector_type(4)));
constexpr int BM = 256, BK = 64, HALF = 128, HTB = HALF * BK * 2  , STAGE_BYTES = 8 * HTB, NXCD = 8, WGM = 8;

__host__ __device__ __forceinline__ int lds_byte(int r, int c) { const int st = (r >> 4) * 2 + (c >> 5), rr = r & 15, cc = c & 31, ob = rr * 64 + cc * 2; return st * 1024 + (ob ^ (((ob >> 9) & 1) << 5)); }
__host__ __device__ __forceinline__ void stage_rc(int b, int& R, int& C) { const int st = b / 1024, sb = b % 1024, swz = sb ^ (((sb >> 9) & 1) << 5); R = (st >> 1) * 16 + swz / 64; C = (st & 1) * 32 + (swz % 64) / 2; }
__host__ __device__ __forceinline__ int perm32(int rho) { const int n = rho >> 4, i = rho & 15; return 8 * (i >> 2) + 4 * n + (i & 3); }

struct Unit { int pm, pn; };
struct Gemm { const bf16_t* A; const bf16_t* Bt; int M, N, K; };

struct StaticOrder {
    int nM, nN, nwg, G, c;
    __host__ __device__ void init(int M, int N, int G_, int c_) { nM = M / BM; nN = N / BM; nwg = nM * nN; G = G_; c = c_; }
    __host__ __device__ bool next(int i, Unit& u) const {
        const long L = (long)i * G + c; if (L >= nwg) return false;
        int wgid = (int)L; { const int q = nwg / NXCD, r = nwg % NXCD, xcd = wgid % NXCD, off = wgid / NXCD; wgid = (xcd < r ? xcd * (q + 1) : r * (q + 1) + (xcd - r) * q) + off; }
        const int nig = WGM * nN, gid = wgid / nig, fm = gid * WGM, gsz = (nM - fm) < WGM ? (nM - fm) : WGM;
        u.pm = fm + ((wgid % nig) % gsz); u.pn = (wgid % nig) / gsz; return true;
    }
    __device__ __forceinline__ void a_ready(const Unit&) const {}
    __device__ __forceinline__ void done(const Unit&) const {}
};
template <class Epi, class Sched, bool STAMP = false>
__device__ __forceinline__ void gemm_phase(PG8_LAS unsigned char* lds, const Gemm g, const Sched& S, const Epi& E, unsigned long long* stamps) {
    const int tid = tid_opq(), wid = __builtin_amdgcn_readfirstlane(tid >> 6), lane = tid & 63, wr = wid >> 2, wc = wid & 3, fr = lane & 15, fq = lane >> 4;
    const int K = g.K, nt = K / BK;
    int ts_lo = 0, ts_hi = 0, nts = 0; const unsigned long long rt_entry = STAMP ? (unsigned long long)wall_clock64() : 0ull;
#define PG8_STAMP() do { if (STAMP && wid == 0 && nts < 64) { const unsigned long long _c = (unsigned long long)clock64(); \
        ts_lo = (lane == nts) ? (int)(unsigned)_c : ts_lo; ts_hi = (lane == nts) ? (int)(unsigned)(_c >> 32) : ts_hi; ++nts; } } while (0)
    PG8_STAMP();
    unsigned voffA[2], voffB[2];
#pragma unroll
    for (int i = 0; i < 2; ++i) { int R, C; stage_rc(tid * 16 + i * 8192, R, C); const int Rb = Epi::PERM ? ((R & ~31) + perm32(R & 31)) : R;
        voffA[i] = (unsigned)(R * K + C) * 2u; voffB[i] = (unsigned)(Rb * K + C) * 2u; }
    const size_t kstep = (size_t)(BK * 2);
    const size_t hstep = (size_t)HALF * K * 2;
    const size_t tstep = 2 * hstep;
    const unsigned ldsw = (unsigned)wid * 1024u;
    const int aoff = lds_byte(wr * 64 + fr, fq * 8), boff = lds_byte(wc * 32 + fr, fq * 8);
#define PG8_SA(b, h) (((b) * 2 + (h)) * HTB)
#define PG8_SB(b, h) ((4 + (b) * 2 + (h)) * HTB)
#define PG8_STAGE(bufoff, gbase, voff) do { _Pragma("unroll") for (int _i = 0; _i < 2; ++_i) \
        __builtin_amdgcn_global_load_lds((const unsigned*)((const char*)(gbase) + (voff)[_i]), (PG8_LAS unsigned*)(lds + (bufoff) + ldsw + _i * 8192), 16, 0, 0); } while (0)
#define PG8_LDA(dst, b, h) do { _Pragma("unroll") for (int m = 0; m < 4; ++m) _Pragma("unroll") for (int k = 0; k < 2; ++k) dst[m][k] = *(const PG8_LAS bf16x8*)(lds + PG8_SA(b, h) + aoff + m * 2048 + k * 1024); } while (0)
#define PG8_LDB(dst, b, h) do { _Pragma("unroll") for (int n = 0; n < 2; ++n) _Pragma("unroll") for (int k = 0; k < 2; ++k) dst[n][k] = *(const PG8_LAS bf16x8*)(lds + PG8_SB(b, h) + boff + n * 2048 + k * 1024); } while (0)
#define PG8_MMA(ai, bj, At, Bt) do { __builtin_amdgcn_s_setprio(1); _Pragma("unroll") for (int m = 0; m < 4; ++m) _Pragma("unroll") for (int n = 0; n < 2; ++n) _Pragma("unroll") for (int k = 0; k < 2; ++k) \
        acc[ai][bj][m][n] = __builtin_amdgcn_mfma_f32_16x16x32_bf16(Bt[n][k], At[m][k], acc[ai][bj][m][n], 0, 0, 0); __builtin_amdgcn_s_setprio(0); } while (0)
#define PG8_WAIT_V(n) asm volatile("s_waitcnt vmcnt(" #n ")" ::: "memory")
#define PG8_WAIT_L(n) asm volatile("s_waitcnt lgkmcnt(" #n ")" ::: "memory")
#define PG8_BAR __builtin_amdgcn_s_barrier()
#define PG8_SCHED __builtin_amdgcn_sched_barrier(0)
    Unit cur, nxt; int ui = 0;
    if (!S.next(0, cur)) return;
    f32x4 acc[2][2][4][2];
#pragma unroll
    for (int a = 0; a < 2; ++a)
#pragma unroll
        for (int b = 0; b < 2; ++b)
#pragma unroll
            for (int m = 0; m < 4; ++m)
#pragma unroll
                for (int n = 0; n < 2; ++n) acc[a][b][m][n] = (f32x4){0.f, 0.f, 0.f, 0.f};
    bf16x8 At[4][2], B0[2][2], B1[2][2];
    const char* cA = (const char*)g.A + (size_t)cur.pm * tstep; const char* cB = (const char*)g.Bt + (size_t)cur.pn * tstep;
    S.a_ready(cur);
    PG8_STAGE(PG8_SB(0, 0), cB, voffB); PG8_STAGE(PG8_SA(0, 0), cA, voffA); PG8_STAGE(PG8_SB(0, 1), cB + hstep, voffB); PG8_STAGE(PG8_SA(0, 1), cA + hstep, voffA);
    if (wr == 1) PG8_BAR;
    PG8_WAIT_V(4); PG8_BAR;
    PG8_STAGE(PG8_SB(1, 0), cB + kstep, voffB); PG8_STAGE(PG8_SA(1, 0), cA + kstep, voffA); PG8_STAGE(PG8_SB(1, 1), cB + hstep + kstep, voffB);
    PG8_WAIT_V(6); PG8_BAR;
    PG8_STAMP();
    for (;;) {
        const bool has_next = S.next(ui + 1, nxt);
        const char* nA = has_next ? (const char*)g.A + (size_t)nxt.pm * tstep : cA; const char* nB = has_next ? (const char*)g.Bt + (size_t)nxt.pn * tstep : cB;
        for (int t = 0; t < nt; t += 2) {
            const bool last = (t == nt - 2);
            const char* a1 = cA + (size_t)(t + 1) * kstep;
            const char* a2 = last ? nA : cA + (size_t)(t + 2) * kstep; const char* b2 = last ? nB : cB + (size_t)(t + 2) * kstep;
            const char* a3 = a2 + kstep; const char* b3 = b2 + kstep;
            if (last && has_next) S.a_ready(nxt);
            PG8_LDB(B0, 0, 0); PG8_SCHED; PG8_LDA(At, 0, 0); PG8_STAGE(PG8_SA(1, 1), a1 + hstep, voffA);
            PG8_WAIT_L(8); PG8_BAR; PG8_WAIT_L(0); PG8_MMA(0, 0, At, B0); PG8_BAR; PG8_SCHED;
            PG8_LDB(B1, 0, 1); PG8_STAGE(PG8_SB(0, 0), b2, voffB);
            PG8_BAR; PG8_WAIT_L(0); PG8_MMA(0, 1, At, B1); PG8_BAR;
            PG8_LDA(At, 0, 1); PG8_STAGE(PG8_SA(0, 0), a2, voffA);
            PG8_BAR; PG8_WAIT_L(0); PG8_MMA(1, 0, At, B0); PG8_BAR; PG8_SCHED;
            PG8_STAGE(PG8_SB(0, 1), b2 + hstep, voffB);
            PG8_WAIT_V(6); PG8_BAR; PG8_MMA(1, 1, At, B1); PG8_BAR;
            PG8_LDB(B0, 1, 0); PG8_SCHED; PG8_LDA(At, 1, 0); PG8_STAGE(PG8_SA(0, 1), a2 + hstep, voffA);
            PG8_WAIT_L(8); PG8_BAR; PG8_WAIT_L(0); PG8_MMA(0, 0, At, B0); PG8_BAR; PG8_SCHED;
            PG8_LDB(B1, 1, 1); PG8_STAGE(PG8_SB(1, 0), b3, voffB);
            PG8_BAR; PG8_WAIT_L(0); PG8_MMA(0, 1, At, B1); PG8_BAR;
            PG8_LDA(At, 1, 1); PG8_STAGE(PG8_SA(1, 0), a3, voffA);
            PG8_BAR; PG8_WAIT_L(0); PG8_MMA(1, 0, At, B0); PG8_BAR; PG8_SCHED;
            PG8_STAGE(PG8_SB(1, 1), b3 + hstep, voffB);
            PG8_WAIT_V(6); PG8_BAR; PG8_MMA(1, 1, At, B1); PG8_BAR;
        }
        PG8_STAMP();
        if constexpr (!Epi::AFTER_DRAIN) { E(acc, cur, wr, wc, fr, fq); S.done(cur); }
        PG8_STAMP();
        if (!has_next) break;
#pragma unroll
        for (int a = 0; a < 2; ++a)
#pragma unroll
            for (int b = 0; b < 2; ++b)
#pragma unroll
                for (int m = 0; m < 4; ++m)
#pragma unroll
                    for (int n = 0; n < 2; ++n) acc[a][b][m][n] = (f32x4){0.f, 0.f, 0.f, 0.f};
        cur = nxt; cA = nA; cB = nB; ++ui;
    }
    PG8_WAIT_V(0);
    if (wr == 0) PG8_BAR;
    PG8_BAR;
    if constexpr (Epi::AFTER_DRAIN) { E.fused(acc, cur, wr, wc, fr, fq, lds, wid, lane); S.done(cur); }
    PG8_STAMP();
    if (STAMP && wid == 0) { stamps[lane] = lane < nts ? (((unsigned long long)(unsigned)ts_hi << 32) | (unsigned)ts_lo) : 0ull;
        if (lane == 62) stamps[62] = rt_entry; if (lane == 63) stamps[63] = (unsigned long long)wall_clock64(); }
#undef PG8_STAMP
#undef PG8_SA
#undef PG8_SB
#undef PG8_STAGE
#undef PG8_LDA
#undef PG8_LDB
#undef PG8_MMA
#undef PG8_WAIT_V
#undef PG8_WAIT_L
#undef PG8_BAR
#undef PG8_SCHED
}
}

template <class F> struct EpiAdapt {
    static constexpr bool PERM = true, AFTER_DRAIN = false;
    F f;
    __device__ __forceinline__ void operator()(const pg8::f32x4 (&acc)[2][2][4][2], const pg8::Unit& u, int wr, int wc, int fr, int fq) const {
        constexpr int B = F::BATCH;
        const int row0 = u.pm * 256 + wr * 64 + fr, col0 = u.pn * 256 + wc * 32 + 8 * fq;
        f32x4 b0[2], b1[2];
        if constexpr (F::COLBIAS) { f.bias8(col0, b0[0], b1[0]); f.bias8(col0 + 128, b0[1], b1[1]); }
#pragma unroll
        for (int q0 = 0; q0 < 16; q0 += B) {
            typename F::Pre pre[B];
#pragma unroll
            for (int i = 0; i < B; ++i) { const int q = q0 + i, bj = q & 1, m = (q >> 1) & 3, ai = q >> 3; pre[i] = f.pre(row0 + ai * 128 + m * 16, col0 + bj * 128); }
#pragma unroll
            for (int i = 0; i < B; ++i) { const int q = q0 + i, bj = q & 1, m = (q >> 1) & 3, ai = q >> 3;
                f32x4 v0 = acc[ai][bj][m][0], v1 = acc[ai][bj][m][1];
                if constexpr (F::COLBIAS) { v0 += b0[bj]; v1 += b1[bj]; }
                f.put(row0 + ai * 128 + m * 16, col0 + bj * 128, v0, v1, pre[i]); }
        }
    }
};
template <class F>
DEVI void gemm_pg8(const bf16_t* A, const bf16_t* Bt, int M, int N, int K, const F& f, char* smem, int bid, int nblk) {
    pg8::Gemm g{A, Bt, M, N, K};
    pg8::StaticOrder S; S.init(M, N, nblk, bid);
    EpiAdapt<F> E{f};
    __syncthreads();
    pg8::gemm_phase<EpiAdapt<F>, pg8::StaticOrder, false>((PG8_LAS unsigned char*)smem, g, S, E, nullptr);
    __syncthreads();
}

template <class F>
DEVI void gemm_small_rows(const bf16_t* __restrict__ A, const bf16_t* __restrict__ Bt, int N, const F& f, char* smem, int bid, int nblk) {
    const int tid = tid_opq(), lane = tid & 63, wid = tid >> 6, fr = lane & 15, fq = lane >> 4;
    float* part = (float*)smem;
    const int ntn = N / 64, ntiles = (NTS / 32) * ntn;
    for (int tile = bid; tile < ntiles; tile += nblk) {
        const int tm = tile / ntn, tn = tile % ntn;
        const int row0 = NTP + tm * 32, col0 = tn * 64;
        f32x4 acc[2][4];
#pragma unroll
        for (int m = 0; m < 2; ++m)
#pragma unroll
            for (int n = 0; n < 4; ++n) acc[m][n] = (f32x4){0.f, 0.f, 0.f, 0.f};
        const bf16_t* ap = A + (size_t)(row0 + fr) * 1024 + wid * 128 + fq * 8;
        const bf16_t* bp = Bt + (size_t)(col0 + fr) * 1024 + wid * 128 + fq * 8;
        bf16x8 af[4][2], bfr[4][4];
#pragma unroll
        for (int ks = 0; ks < 4; ++ks) {
#pragma unroll
            for (int m = 0; m < 2; ++m) af[ks][m] = *(const bf16x8*)(ap + (size_t)m * 16 * 1024 + ks * 32);
#pragma unroll
            for (int n = 0; n < 4; ++n) bfr[ks][n] = *(const bf16x8*)(bp + (size_t)n * 16 * 1024 + ks * 32);
        }
#pragma unroll
        for (int ks = 0; ks < 4; ++ks)
#pragma unroll
            for (int m = 0; m < 2; ++m)
#pragma unroll
                for (int n = 0; n < 4; ++n) acc[m][n] = __builtin_amdgcn_mfma_f32_16x16x32_bf16(bfr[ks][n], af[ks][m], acc[m][n], 0, 0, 0);
        __syncthreads();
#pragma unroll
        for (int m = 0; m < 2; ++m)
#pragma unroll
            for (int n = 0; n < 4; ++n) *(f32x4*)(part + ((size_t)wid * 32 + m * 16 + fr) * 64 + n * 16 + fq * 4) = acc[m][n];
        __syncthreads();
        if (tid < 256) {
            const int r = tid >> 3, c8 = (tid & 7) * 8;
            f32x4 v0 = {0.f, 0.f, 0.f, 0.f}, v1 = v0;
#pragma unroll
            for (int w = 0; w < 8; ++w) { v0 += *(const f32x4*)(part + ((size_t)w * 32 + r) * 64 + c8); v1 += *(const f32x4*)(part + ((size_t)w * 32 + r) * 64 + c8 + 4); }
            const typename F::Pre pre = f.pre(row0 + r, col0 + c8);
            f.put(row0 + r, col0 + c8, v0, v1, pre);
        }
    }
}
template <class F>
DEVI void gemm_tail(const bf16_t* A, const bf16_t* Bt, int N, const F& f, char* smem, int bid, int nblk) {
    gemm_small_rows(A, Bt, N, f, smem, bid, nblk);
    gemm_pg8(A, Bt, NTP, N, 1024, f, smem, bid, nblk);
}

#define XB_TMO      128
#define XB_XCNT(j)  (256  + 64 * (j))
#define XB_XSUB(j)  (1280 + 64 * (j))
#define XB_XGEN(j)  (2304 + 64 * (j))
#define XB_TOP      3328
#define XB_TOPGEN   3392
#define XCD_BAR_WORDS 3456
#define XB_SPIN_CAP (1u << 18)
#define LAS __attribute__((address_space(3)))

__device__ __forceinline__ unsigned xb_ld(unsigned* p)              { return __hip_atomic_load(p, __ATOMIC_RELAXED, __HIP_MEMORY_SCOPE_AGENT); }
__device__ __forceinline__ unsigned xb_add(unsigned* p, unsigned v) { return __hip_atomic_fetch_add(p, v, __ATOMIC_RELAXED, __HIP_MEMORY_SCOPE_AGENT); }
__device__ __forceinline__ unsigned xb_xcc_id() { return (unsigned)__builtin_amdgcn_s_getreg((3 << 11) | 20) & 0xFu; }
#define XB_SPIN(cond, bar) do { unsigned _sp = 0; while (cond) { __builtin_amdgcn_s_sleep(1); \
    if ((++_sp & 255u) == 0u) { if (xb_ld(&(bar)[XB_TMO])) break; if (_sp > XB_SPIN_CAP) { atomicAdd(&(bar)[XB_TMO], 1u); break; } } } } while (0)

struct XcdBarrier {
    unsigned* bar; unsigned x;
    volatile LAS unsigned* st;
};

__device__ __forceinline__ XcdBarrier xcd_barrier_post(unsigned* bar, volatile LAS unsigned* st) {
    XcdBarrier b; b.bar = bar; b.x = xb_xcc_id(); b.st = st;
    if (tid_opq() == 0) (void)xb_add(&bar[XB_XCNT(b.x)], 1u);
    return b;
}
__device__ __forceinline__ void xcd_barrier_complete(unsigned* bar, unsigned x, unsigned& nloc, unsigned& nx) {
    const unsigned G = gridDim.x * gridDim.y * gridDim.z;
    unsigned sum, cnt, mine, sp = 0u;
    for (;;) {
        sum = 0u; cnt = 0u; mine = 0u;
#pragma unroll
        for (unsigned j = 0; j < 16; ++j) { const unsigned c = xb_ld(&bar[XB_XCNT(j)]); sum += c; cnt += (c > 0u) ? 1u : 0u; mine = (j == x) ? c : mine; }
        if (sum == G) break;
        __builtin_amdgcn_s_sleep(1);
        if ((++sp & 255u) == 0u) { if (xb_ld(&bar[XB_TMO])) break; if (sp > XB_SPIN_CAP) { atomicAdd(&bar[XB_TMO], 1u); break; } }
    }
    nloc = mine > 0u ? mine : 1u; nx = cnt > 0u ? cnt : 1u;
}

__device__ __forceinline__ void xcd_barrier(const XcdBarrier& b) {
    asm volatile("s_waitcnt vmcnt(0)" ::: "memory");
    __syncthreads();
    if (tid_opq() == 0) {
        unsigned* bar = b.bar;
        __builtin_amdgcn_s_waitcnt(0);
        unsigned nloc = b.st[0], nx = b.st[1];
        if (nloc == 0u) { xcd_barrier_complete(bar, b.x, nloc, nx); b.st[0] = nloc; b.st[1] = nx; }
        const unsigned old = xb_add(&bar[XB_XSUB(b.x)], 1u);
        const unsigned gen = old / nloc;
        if (old + 1u == (gen + 1u) * nloc) {
            __builtin_amdgcn_fence(__ATOMIC_RELEASE, "agent");
            asm volatile("s_waitcnt vmcnt(0)" ::: "memory");
            const unsigned og = xb_add(&bar[XB_TOP], 1u);
            const unsigned tg = og / nx;
            if (og + 1u == (tg + 1u) * nx) xb_add(&bar[XB_TOPGEN], 1u);
            else XB_SPIN(xb_ld(&bar[XB_TOPGEN]) == tg, bar);
            __builtin_amdgcn_fence(__ATOMIC_ACQUIRE, "agent");
            xb_add(&bar[XB_XGEN(b.x)], 1u);
            asm volatile("s_waitcnt vmcnt(0)" ::: "memory");
        } else {
            XB_SPIN(xb_ld(&bar[XB_XGEN(b.x)]) == gen, bar);
            __builtin_amdgcn_fence(__ATOMIC_ACQUIRE, "agent");
            asm volatile("s_waitcnt vmcnt(0)" ::: "memory");
        }
    }
    __syncthreads();
}

constexpr int LDS_BYTES = 152 * 1024;

template <int S>
DEVI void run_stage(const P& p, char* smem, int bid, int nblk) {
    if (S == 0) stage_prologue(p, smem, bid, nblk);
    if (S == 1) { EpiInProj e{p}; gemm_pg8(p.XB, p.WINT, NT, NPAD_IN + 2048, 1024, e, smem, bid, nblk); }
    if (S == 2) {
        stage_mlstm_gates(p, smem, bid, nblk);
        if (bid & 1) { stage_mlstm_dc(p, smem, bid, nblk); stage_compress(p, smem, bid, nblk); stage_mlstm_sample(p, smem, bid, nblk); }
        else { stage_compress(p, smem, bid, nblk); stage_mlstm_dc(p, smem, bid, nblk); stage_mlstm_sample(p, smem, bid, nblk); }
    }
    if (S == 4) { stage_mlstm_scan(p, bid, nblk); stage_nsa_attn(p, smem, bid, nblk); }
    if (S == 5) { stage_mlstm_out(p, smem, bid, nblk); { EpiM1 e{p}; gemm_tail(p.YB, p.WBT, 1024, e, smem, bid, nblk); } }
    if (S == 6) { EpiM2 e{p}; gemm_tail(p.YA, p.WAT, 1024, e, smem, bid, nblk); }
    if (S == 8) { EpiR e{p}; gemm_tail(p.MERGED, p.WOT, 1024, e, smem, bid, nblk); }
    if (S == 9) stage_ln1(p, bid, nblk);
    if (S == 10) { EpiPQ e{p}; gemm_tail(p.HB, p.WQT, 2048, e, smem, bid, nblk); }
    if (S == 11) {
        if (bid & 1) {
            for (int ps = 0; ps < 4; ++ps) { stage_peer_route(p, smem, bid, nblk, ps, ps + 1); __threadfence_block(); __syncthreads(); stage_peer_apply(p, smem, bid, nblk, ps, ps + 1); __syncthreads(); }
        } else { stage_peer_route(p, smem, bid, nblk, 0, 64); __threadfence_block(); __syncthreads(); stage_peer_apply(p, smem, bid, nblk, 0, 64); }
    }
}
constexpr int NSTAGES = 13;

template <int S>
__global__ void __launch_bounds__(512, 2) k_stage(P p) {
    extern __shared__ __attribute__((aligned(16))) char smem[];
    run_stage<S>(p, smem, blockIdx.x, gridDim.x);
}


#if MK_ONE_LAUNCH
__global__ void __launch_bounds__(512, 2) k_mega(P p) {
    extern __shared__ __attribute__((aligned(16))) char smem_all[];
    if (tid_opq() == 0) *(u32x4*)smem_all = (u32x4){0u, 0u, 0u, 0u};
    __syncthreads();
    XcdBarrier bar = xcd_barrier_post(p.bar, (volatile LAS unsigned*)smem_all);
    char* smem = smem_all + 16;
    const int bid = blockIdx.x, nblk = gridDim.x;
    run_stage<0>(p, smem, bid, nblk); if ((REP_MASK >> 0) & 1) { xcd_barrier(bar); run_stage<0>(p, smem, bid, nblk); }  xcd_barrier(bar);
    run_stage<1>(p, smem, bid, nblk); if ((REP_MASK >> 1) & 1) { xcd_barrier(bar); run_stage<1>(p, smem, bid, nblk); }  xcd_barrier(bar);
    run_stage<2>(p, smem, bid, nblk); if ((REP_MASK >> 2) & 1) { xcd_barrier(bar); run_stage<2>(p, smem, bid, nblk); }  xcd_barrier(bar);
    run_stage<4>(p, smem, bid, nblk); if ((REP_MASK >> 4) & 1) { xcd_barrier(bar); run_stage<4>(p, smem, bid, nblk); }  xcd_barrier(bar);
    run_stage<5>(p, smem, bid, nblk); if ((REP_MASK >> 5) & 1) { xcd_barrier(bar); run_stage<5>(p, smem, bid, nblk); }  xcd_barrier(bar);
    run_stage<6>(p, smem, bid, nblk); if ((REP_MASK >> 6) & 1) { xcd_barrier(bar); run_stage<6>(p, smem, bid, nblk); }  xcd_barrier(bar);
    run_stage<8>(p, smem, bid, nblk); if ((REP_MASK >> 8) & 1) { xcd_barrier(bar); run_stage<8>(p, smem, bid, nblk); }  xcd_barrier(bar);
    run_stage<9>(p, smem, bid, nblk); if ((REP_MASK >> 9) & 1) { xcd_barrier(bar); run_stage<9>(p, smem, bid, nblk); }  xcd_barrier(bar);
    run_stage<10>(p, smem, bid, nblk); if ((REP_MASK >> 10) & 1) { xcd_barrier(bar); run_stage<10>(p, smem, bid, nblk); } xcd_barrier(bar);
    run_stage<11>(p, smem, bid, nblk); if ((REP_MASK >> 11) & 1) { xcd_barrier(bar); run_stage<11>(p, smem, bid, nblk); }
}
#endif

template <int S> static void launch_stage(const P& p, int grid, hipStream_t stream) {
    (void)hipFuncSetAttribute((const void*)k_stage<S>, hipFuncAttributeMaxDynamicSharedMemorySize, LDS_BYTES);
    k_stage<S><<<dim3(grid), dim3(512), LDS_BYTES, stream>>>(p);
}

extern "C" void kernel_launch(void* const* d_in, const int* in_sizes, int n_in, void* d_out, int out_size, void* d_ws, size_t ws_size, hipStream_t stream) {
    (void)in_sizes; (void)n_in; (void)out_size; (void)ws_size;
    P p{};
    p.xp = (const float*)d_in[0]; p.xs = (const float*)d_in[1]; p.cache_cmp = (const float*)d_in[2]; p.cache_slc = (const float*)d_in[3];
    p.cache_win = (const float*)d_in[4]; p.state_C = (const float*)d_in[5]; p.state_n = (const float*)d_in[6]; p.state_m = (const float*)d_in[7];
    p.page_table = (const int*)d_in[8];
    p.w_in = (const float*)d_in[9]; p.b_in = (const float*)d_in[10]; p.norm_a_g = (const float*)d_in[11]; p.nsa_pe = (const float*)d_in[12];
    p.nsa_w_cmp = (const float*)d_in[13]; p.w_br_a = (const float*)d_in[14]; p.w_br_b = (const float*)d_in[15]; p.w_merge = (const float*)d_in[16];
    p.w_out = (const float*)d_in[17]; p.ln1_g = (const float*)d_in[18]; p.ln1_b = (const float*)d_in[19];
    p.peer_wq = (const float*)d_in[20]; p.peer_keys = (const float*)d_in[21]; p.peer_u = (const float*)d_in[22]; p.peer_v = (const float*)d_in[23];
    p.ln2_g = (const float*)d_in[24]; p.ln2_b = (const float*)d_in[25];
    p.out = (float*)d_out;
    char* w = (char*)d_ws; size_t off = 0;
    auto take = [&](size_t bytes) { char* r = w + off; off += (bytes + 255) & ~(size_t)255; return r; };
    p.bar = (unsigned*)take(16384);
    p.PW = (float*)(p.bar + 3584);
    p.WCT = (bf16_t*)take((size_t)2 * 64 * 4096 * 2);
    p.XB = (bf16_t*)take((size_t)NT * 1024 * 2);
    p.WINT = (bf16_t*)take((size_t)(NPAD_IN + 2048) * 1024 * 2);
    p.WMT = (bf16_t*)take((size_t)2048 * 1024 * 2);
    p.WAT = (bf16_t*)take((size_t)1024 * 1024 * 2);
    p.WBT = (bf16_t*)take((size_t)1024 * 1024 * 2);
    p.WOT = (bf16_t*)take((size_t)1024 * 1024 * 2);
    p.WQT = (bf16_t*)take((size_t)2048 * 1024 * 2);
    p.KEYSB = (bf16_t*)take((size_t)16 * 128 * 128 * 2);
    p.U8 = (unsigned char*)take((size_t)16384 * 1024);
    p.V8 = (unsigned char*)take((size_t)16384 * 1024);
    p.US = (float*)take(16384 * 4);
    p.VS = (float*)take(16384 * 4);
    p.PROJ = (bf16_t*)take((size_t)NT * PS * 2);
    p.SM = (float*)take((size_t)NT * 64 * 4);
    p.BCUM = (float*)take((size_t)16 * 4096 * 4);
    p.MPREV = (float*)take(4096); p.ACOEF = (float*)take(4096); p.SCL = (float*)take(4096); p.MLOC = (float*)take(4096);
    p.DC = (float*)take((size_t)1024 * 272 * 128 * 4);
    p.CPT = (bf16_t*)take((size_t)1024 * 272 * 128 * 2);
    p.KC = (float*)take((size_t)4352 * 512 * 4);
    p.VC = p.KC + 256;
    p.OCMP = (float*)take((size_t)NT * 1024 * 4);
    p.SEL = (unsigned long long*)take((size_t)NT * 4 * 8);
    p.YA = (bf16_t*)take((size_t)NT * 1024 * 2);
    p.YB = (bf16_t*)take((size_t)NT * 1024 * 2);
    p.G = (bf16_t*)take((size_t)NT * 2048 * 2);
    p.TMPB = (bf16_t*)take((size_t)NT * 1024 * 2);
    p.MERGED = (bf16_t*)take((size_t)NT * 1024 * 2);
    p.R = (float*)take((size_t)NT * 1024 * 4);
    p.H = (float*)take((size_t)NT * 1024 * 4);
    p.HB = (bf16_t*)take((size_t)NT * 1024 * 2);
    p.PQ = (bf16_t*)take((size_t)NT * 2048 * 2);
    p.EIDX = (int*)take((size_t)NT * 128 * 4);
    p.EGATE = (float*)take((size_t)NT * 128 * 4);

    (void)hipMemsetAsync(p.bar, 0, 16384, stream);
#if MK_ONE_LAUNCH
    {
        constexpr size_t kDynLds = LDS_BYTES + 16;
        (void)hipFuncSetAttribute((const void*)k_mega, hipFuncAttributeMaxDynamicSharedMemorySize, (int)kDynLds);
        int dev = 0, cus = 0, per_cu = 0;
        (void)hipGetDevice(&dev);
        (void)hipDeviceGetAttribute(&cus, hipDeviceAttributeMultiprocessorCount, dev);
        (void)hipOccupancyMaxActiveBlocksPerMultiprocessor(&per_cu, (const void*)k_mega, 512, kDynLds);
        if (per_cu < 1 || cus < 1) return;
        const int grid = cus;
        k_mega<<<dim3(grid), dim3(512), kDynLds, stream>>>(p);
    }
#else
    const int grid = 512;
    launch_stage<0>(p, grid, stream);
    launch_stage<1>(p, grid, stream);
    launch_stage<2>(p, grid, stream);
    launch_stage<4>(p, grid, stream);
    launch_stage<5>(p, grid, stream);
    launch_stage<6>(p, grid, stream);
    launch_stage<8>(p, grid, stream);
    launch_stage<9>(p, grid, stream);
    launch_stage<10>(p, grid, stream);
    launch_stage<11>(p, grid, stream);
#endif
}
```

```cpp
#include <hip/hip_runtime.h>
#include <stdint.h>

#ifndef REP_MASK
#define REP_MASK 0
#endif
#ifndef MK_ONE_LAUNCH
#define MK_ONE_LAUNCH 1
#endif

typedef unsigned short bf16_t;
typedef short bf16x8 __attribute__((ext_vector_type(8)));
typedef float f32x4 __attribute__((ext_vector_type(4)));
typedef unsigned u32x4 __attribute__((ext_vector_type(4)));
typedef unsigned u32x2 __attribute__((ext_vector_type(2)));
typedef float f32x2 __attribute__((ext_vector_type(2)));
typedef __bf16 bf16x2_t __attribute__((ext_vector_type(2)));
#define DEVI __device__ __forceinline__
__device__ __forceinline__ int tid_opq() { int t = threadIdx.x; asm volatile("" : "+v"(t)); return t; }

constexpr int NTP = 16384, NTS = 512, NT = NTP + NTS, DM = 1024;
constexpr int PS = 5632;
constexpr int C_AQ = 0, C_AK = 512, C_AV = 1024, C_AO = 2048, C_BQ = 3072, C_CMP = 4096, C_SLC = 4608, C_WIN = 5120;
constexpr int NPAD_IN = 5888;
constexpr float DN_ALPHA = 1.189207115002721f;
constexpr float LN_EPS = 1e-5f;
constexpr size_t O_Y = 0;
constexpr size_t O_PCMP = O_Y + (size_t)NT * 1024;
constexpr size_t O_PSLC = O_PCMP + (size_t)NTP * 512;
constexpr size_t O_PWIN = O_PSLC + (size_t)NTP * 512;
constexpr size_t O_PC = O_PWIN + (size_t)4 * 512 * 512;
constexpr size_t O_PN = O_PC + (size_t)16 * 128 * 256;
constexpr size_t O_PM = O_PN + 16 * 128;
constexpr size_t O_SCMP = O_PM + 16;
constexpr size_t O_SSLC = O_SCMP + (size_t)NTS * 512;
constexpr size_t O_SWIN = O_SSLC + (size_t)NTS * 512;
constexpr size_t O_SC = O_SWIN + (size_t)128 * 512 * 512;
constexpr size_t O_SN = O_SC + (size_t)512 * 128 * 256;
constexpr size_t O_SM = O_SN + 512 * 128;

struct P {
    const float *xp, *xs, *cache_cmp, *cache_slc, *cache_win, *state_C, *state_n, *state_m;
    const int* page_table;
    const float *w_in, *b_in, *norm_a_g, *nsa_pe, *nsa_w_cmp, *w_br_a, *w_br_b, *w_merge, *w_out, *ln1_g, *ln1_b;
    const float *peer_wq, *peer_keys, *peer_u, *peer_v, *ln2_g, *ln2_b;
    float* out;
    bf16_t *XB, *WINT, *WMT, *WAT, *WBT, *WOT, *WQT, *KEYSB, *UB, *VB, *PROJ, *WCT;
    float* PW;
    float *SM, *BCUM, *MPREV, *ACOEF, *SCL, *MLOC, *DC, *KC, *VC, *OCMP;
    bf16_t* CPT;
    unsigned char *U8, *V8;
    float *US, *VS;
    unsigned long long* SEL;
    bf16_t *YA, *YB, *G, *MERGED, *HB, *PQ;
    float *R, *H, *EGATE;
    bf16_t* TMPB;
    int* EIDX;
    unsigned* bar;
};

DEVI bf16_t f2bf(float f) { return __builtin_bit_cast(unsigned short, (__bf16)f); }
DEVI float bf2f(bf16_t h) { return __uint_as_float(((unsigned)h) << 16); }
DEVI unsigned pack2(float a, float b) { return __builtin_bit_cast(unsigned, __builtin_convertvector((f32x2){a, b}, bf16x2_t)); }
DEVI u32x4 pack8f(const f32x4 a, const f32x4 b) { u32x4 r; r[0] = pack2(a[0], a[1]); r[1] = pack2(a[2], a[3]); r[2] = pack2(b[0], b[1]); r[3] = pack2(b[2], b[3]); return r; }
DEVI float wave_max(float v) { for (int o = 32; o > 0; o >>= 1) v = fmaxf(v, __shfl_xor(v, o)); return v; }
DEVI float wave_sum(float v) { for (int o = 32; o > 0; o >>= 1) v += __shfl_xor(v, o); return v; }
DEVI float sigmoidf_(float x) { return 1.f / (1.f + __expf(-x)); }
DEVI float logsigmoidf_(float x) { return fminf(x, 0.f) - log1pf(__expf(-fabsf(x))); }
DEVI int win_map(int np) {
    if (np < 2048) return np;
    if (np < 5632) return np + 8;
    if (np < 5640) return np - 5632 + 2048;
    if (np < 5688) return np;
    return -1;
}
DEVI float alibi_slope(int h) { return exp2f(-0.5f * (float)(h + 1)); }

template <class MapFn>
DEVI void transpose_cvt(const float* __restrict__ W, bf16_t* __restrict__ WT, int K, int Nsrc, int Ndst, MapFn mapfn, float* tile  , int bid, int nblk) {
    const int tid = tid_opq();
    const int tn = Ndst / 64, tk = K / 64;
    for (int t = bid; t < tn * tk; t += nblk) {
        const int n0 = (t % tn) * 64, k0 = (t / tn) * 64;
        __syncthreads();
#pragma unroll
        for (int i = 0; i < 8; ++i) {
            const int kk = (tid >> 6) + i * 8, nn = tid & 63;
            const int n = mapfn(n0 + nn);
            tile[kk * 65 + nn] = n >= 0 ? W[(size_t)(k0 + kk) * Nsrc + n] : 0.f;
        }
        __syncthreads();
#pragma unroll
        for (int i = 0; i < 8; ++i) {
            const int nn = (tid >> 6) + i * 8, kk = tid & 63;
            WT[(size_t)(n0 + nn) * K + k0 + kk] = f2bf(tile[kk * 65 + nn]);
        }
    }
}
struct IdMap { DEVI int operator()(int n) const { return n; } };
struct WinMap { DEVI int operator()(int n) const { return win_map(n); } };

DEVI void cvt_rows(const float* __restrict__ src, bf16_t* __restrict__ dst, size_t n4, int bid, int nblk) {
    const size_t stride = (size_t)nblk * 512;
    for (size_t i0 = (size_t)bid * 512 + tid_opq(); i0 < n4; i0 += stride * 8) {
        f32x4 v[8];
#pragma unroll
        for (int u = 0; u < 8; ++u) { const size_t i = i0 + u * stride; v[u] = i < n4 ? __builtin_nontemporal_load((const f32x4*)src + i) : (f32x4){0.f, 0.f, 0.f, 0.f}; }
#pragma unroll
        for (int u = 0; u < 8; ++u) { const size_t i = i0 + u * stride; if (i < n4) { u32x2 o; o.x = pack2(v[u][0], v[u][1]); o.y = pack2(v[u][2], v[u][3]); ((u32x2*)dst)[i] = o; } }
    }
}

DEVI void stage_prologue(const P& p, char* smem, int bid, int nblk) {
    float* tile = (float*)smem;
    cvt_rows(p.xp, p.XB, (size_t)NTP * 256, bid, nblk);
    cvt_rows(p.xs, p.XB + (size_t)NTP * 1024, (size_t)NTS * 256, bid, nblk);
    {
        const int lane = tid_opq() & 63, wid = tid_opq() >> 6;
        for (int r0 = bid * 8 + wid; r0 < 2 * 16384; r0 += nblk * 8 * 2) {
            f32x4 x[2][4]; float am[2] = {0.f, 0.f};
#pragma unroll
            for (int j = 0; j < 2; ++j) {
                const int r = r0 + j * nblk * 8;
                if (r < 2 * 16384) {
                    const bool isv = r >= 16384; const int e = isv ? r - 16384 : r;
                    const float* src = (isv ? p.peer_v : p.peer_u) + (size_t)e * 1024 + lane * 16;
#pragma unroll
                    for (int i = 0; i < 4; ++i) x[j][i] = __builtin_nontemporal_load((const f32x4*)(src + i * 4));
                }
            }
#pragma unroll
            for (int j = 0; j < 2; ++j) {
                const int r = r0 + j * nblk * 8;
                if (r < 2 * 16384) {
                    const bool isv = r >= 16384; const int e = isv ? r - 16384 : r;
#pragma unroll
                    for (int i = 0; i < 4; ++i)
#pragma unroll
                        for (int k = 0; k < 4; ++k) am[j] = fmaxf(am[j], fabsf(x[j][i][k]));
                    const float amx = wave_max(am[j]);
                    const float inv = amx > 0.f ? 448.f / amx : 1.f;
                    u32x4 o;
#pragma unroll
                    for (int i = 0; i < 4; ++i) { int w = __builtin_amdgcn_cvt_pk_fp8_f32(x[j][i][0] * inv, x[j][i][1] * inv, 0, false); w = __builtin_amdgcn_cvt_pk_fp8_f32(x[j][i][2] * inv, x[j][i][3] * inv, w, true); o[i] = (unsigned)w; }
                    *(u32x4*)((isv ? p.V8 : p.U8) + (size_t)e * 1024 + lane * 16) = o;
                    if (lane == 0) (isv ? p.VS : p.US)[e] = amx > 0.f ? amx / 448.f : 1.f;
                }
            }
        }
    }
    cvt_rows(p.peer_keys, p.KEYSB, (size_t)16 * 128 * 128 / 4, bid, nblk);
    transpose_cvt(p.w_in, p.WINT, 1024, 5688, NPAD_IN, WinMap(), tile, bid, nblk);
    transpose_cvt(p.w_merge, p.WINT + (size_t)NPAD_IN * 1024, 1024, 2048, 2048, IdMap(), tile, bid, nblk);
    transpose_cvt(p.w_br_a, p.WAT, 1024, 1024, 1024, IdMap(), tile, bid, nblk);
    transpose_cvt(p.w_br_b, p.WBT, 1024, 1024, 1024, IdMap(), tile, bid, nblk);
    transpose_cvt(p.w_out, p.WOT, 1024, 1024, 1024, IdMap(), tile, bid, nblk);
    transpose_cvt(p.peer_wq, p.WQT, 1024, 2048, 2048, IdMap(), tile, bid, nblk);
    transpose_cvt(p.nsa_w_cmp, p.WCT, 4096, 64, 64, IdMap(), tile, bid, nblk);
    transpose_cvt(p.nsa_w_cmp + 4096 * 64, p.WCT + 64 * 4096, 4096, 64, 64, IdMap(), tile, bid, nblk);
    for (int blk = bid; blk < 32; blk += nblk) {
        const int tid = tid_opq(), kvv = tid >> 8, e = tid & 63, kq = (tid >> 6) & 3;
        float a = 0.f;
        for (int k = blk * 128 + kq * 32; k < blk * 128 + kq * 32 + 32; ++k) a += p.nsa_pe[kvv * 4096 + k] * p.nsa_w_cmp[((size_t)kvv * 4096 + k) * 64 + e];
        atomicAdd(p.PW + kvv * 64 + e, a);
    }
    {
        const size_t per_b = (size_t)508 * 512 / 4;
        const size_t stride = (size_t)nblk * 512, ntot = 128 * per_b;
        for (size_t i0 = (size_t)bid * 512 + tid_opq(); i0 < ntot; i0 += stride * 8) {
            f32x4 v[8];
#pragma unroll
            for (int u = 0; u < 8; ++u) { const size_t i = i0 + u * stride; if (i < ntot) { const size_t b = i / per_b, r = i % per_b; v[u] = __builtin_nontemporal_load((const f32x4*)(p.cache_win + b * 512 * 512 + 4 * 512) + r); } }
#pragma unroll
            for (int u = 0; u < 8; ++u) { const size_t i = i0 + u * stride; if (i < ntot) { const size_t b = i / per_b, r = i % per_b; __builtin_nontemporal_store(v[u], (f32x4*)(p.out + O_SWIN + b * 512 * 512) + r); } }
        }
    }
}

template <class Epi>
DEVI void gemm_phase(const bf16_t* __restrict__ A, const bf16_t* __restrict__ Bt, int M, int N, int K, const Epi& epi, char* smem, int bid, int nblk) {
    bf16_t* As = (bf16_t*)smem;
    bf16_t* Bs = As + 256 * 72;
    const int tid = tid_opq(), lane = tid & 63, wid = tid >> 6, wm = wid >> 1, wn = wid & 1;
    const int fr = lane & 15, fq = lane >> 4;
    const int ntm = M / 256, ntn = N / 128, nk = K / 64;
    for (int tile = bid; tile < ntm * ntn; tile += nblk) {
        const int tm = tile / ntn, tn = tile % ntn;
        f32x4 acc[4][4];
#pragma unroll
        for (int i = 0; i < 4; ++i)
#pragma unroll
            for (int j = 0; j < 4; ++j) acc[i][j] = (f32x4){0.f, 0.f, 0.f, 0.f};
        const bf16_t* Ag = A + (size_t)(tm * 256 + (tid >> 1)) * K + (tid & 1) * 32;
        const bf16_t* Bg = Bt + (size_t)(tn * 128 + (tid >> 2)) * K + (tid & 3) * 16;
        u32x4 ra[4], rb[2];
#pragma unroll
        for (int i = 0; i < 4; ++i) ra[i] = *(const u32x4*)(Ag + i * 8);
#pragma unroll
        for (int i = 0; i < 2; ++i) rb[i] = *(const u32x4*)(Bg + i * 8);
        for (int kt = 0; kt < nk; ++kt) {
            __syncthreads();
#pragma unroll
            for (int i = 0; i < 4; ++i) *(u32x4*)(As + (tid >> 1) * 72 + (tid & 1) * 32 + i * 8) = ra[i];
#pragma unroll
            for (int i = 0; i < 2; ++i) *(u32x4*)(Bs + (tid >> 2) * 72 + (tid & 3) * 16 + i * 8) = rb[i];
            __syncthreads();
            if (kt + 1 < nk) {
#pragma unroll
                for (int i = 0; i < 4; ++i) ra[i] = *(const u32x4*)(Ag + (kt + 1) * 64 + i * 8);
#pragma unroll
                for (int i = 0; i < 2; ++i) rb[i] = *(const u32x4*)(Bg + (kt + 1) * 64 + i * 8);
            }
#pragma unroll
            for (int ks = 0; ks < 2; ++ks) {
                bf16x8 af[4], bfr[4];
#pragma unroll
                for (int i = 0; i < 4; ++i) af[i] = *(const bf16x8*)(As + (wm * 64 + i * 16 + fr) * 72 + ks * 32 + fq * 8);
#pragma unroll
                for (int j = 0; j < 4; ++j) bfr[j] = *(const bf16x8*)(Bs + (wn * 64 + j * 16 + fr) * 72 + ks * 32 + fq * 8);
#pragma unroll
                for (int i = 0; i < 4; ++i)
#pragma unroll
                    for (int j = 0; j < 4; ++j) acc[i][j] = __builtin_amdgcn_mfma_f32_16x16x32_bf16(bfr[j], af[i], acc[i][j], 0, 0, 0);
            }
        }
#pragma unroll
        for (int i = 0; i < 4; ++i)
#pragma unroll
            for (int j = 0; j < 4; ++j) epi(tm * 256 + wm * 64 + i * 16 + fr, tn * 128 + wn * 64 + j * 16 + fq * 4, acc[i][j]);
    }
}

struct NoPre {};
DEVI f32x4 bf4_lo(const u32x4& g) { return (f32x4){__uint_as_float(g[0] << 16), __uint_as_float(g[0] & 0xFFFF0000u), __uint_as_float(g[1] << 16), __uint_as_float(g[1] & 0xFFFF0000u)}; }
DEVI f32x4 bf4_hi(const u32x4& g) { return (f32x4){__uint_as_float(g[2] << 16), __uint_as_float(g[2] & 0xFFFF0000u), __uint_as_float(g[3] << 16), __uint_as_float(g[3] & 0xFFFF0000u)}; }
struct EpiInProj {
    P p;
    typedef NoPre Pre;
    static constexpr int BATCH = 4;
    static constexpr bool COLBIAS = true;
    DEVI void bias8(int col, f32x4& b0, f32x4& b1) const {
        b0 = (f32x4){0.f, 0.f, 0.f, 0.f}; b1 = b0;
        if (col < 5688) { const int oc = win_map(col);
#pragma unroll
            for (int q = 0; q < 4; ++q) { b0[q] = p.b_in[oc + q]; b1[q] = p.b_in[oc + 4 + q]; } }
    }
    DEVI Pre pre(int, int) const { return NoPre(); }
    DEVI void put(int row, int col, f32x4 v0, f32x4 v1, const Pre&) const {
        if (col >= NPAD_IN) {
#pragma unroll
            for (int k = 0; k < 4; ++k) { v0[k] = sigmoidf_(v0[k]); v1[k] = sigmoidf_(v1[k]); }
            *(u32x4*)(p.G + (size_t)row * 2048 + (col - NPAD_IN)) = pack8f(v0, v1);
            return;
        }
        if (col >= 5688) return;
        if (col >= 5632) { *(f32x4*)(p.SM + (size_t)row * 64 + (col - 5632)) = v0; *(f32x4*)(p.SM + (size_t)row * 64 + (col - 5632) + 4) = v1; return; }
        if (col >= C_AK && col < C_AV) { v0 *= 0.08838834764831845f; v1 *= 0.08838834764831845f; }
        *(u32x4*)(p.PROJ + (size_t)row * PS + col) = pack8f(v0, v1);
        if (col >= C_CMP) {
            const int reg = (col - C_CMP) >> 9, c = (col - C_CMP) & 511;
            float* dst = nullptr;
            if (row < NTP) {
                if (reg == 0) dst = p.out + O_PCMP + (size_t)row * 512 + c;
                else if (reg == 1) dst = p.out + O_PSLC + (size_t)row * 512 + c;
                else { const int b = row >> 12, t = row & 4095; if (t >= 3584) dst = p.out + O_PWIN + ((size_t)b * 512 + (t - 3584)) * 512 + c; }
            } else {
                const int rs = row - NTP;
                if (reg == 0) dst = p.out + O_SCMP + (size_t)rs * 512 + c;
                else if (reg == 1) dst = p.out + O_SSLC + (size_t)rs * 512 + c;
                else { const int b = rs >> 2, tq = rs & 3; dst = p.out + O_SWIN + ((size_t)b * 512 + 508 + tq) * 512 + c; }
            }
            if (dst) { *(f32x4*)dst = v0; *(f32x4*)(dst + 4) = v1; }
        }
    }
};
struct EpiG {
    P p;
    typedef NoPre Pre;
    static constexpr int BATCH = 4;
    static constexpr bool COLBIAS = false;
    DEVI Pre pre(int, int) const { return NoPre(); }
    DEVI void put(int row, int col, f32x4 v0, f32x4 v1, const Pre&) const {
#pragma unroll
        for (int k = 0; k < 4; ++k) { v0[k] = sigmoidf_(v0[k]); v1[k] = sigmoidf_(v1[k]); }
        *(u32x4*)(p.G + (size_t)row * 2048 + col) = pack8f(v0, v1);
    }
};
struct EpiM1 {
    P p;
    typedef u32x4 Pre;
    static constexpr int BATCH = 8;
    static constexpr bool COLBIAS = false;
    DEVI Pre pre(int row, int col) const { return *(const u32x4*)(p.G + (size_t)row * 2048 + 1024 + col); }
    DEVI void put(int row, int col, f32x4 v0, f32x4 v1, const Pre& g) const {
        *(u32x4*)(p.TMPB + (size_t)row * 1024 + col) = pack8f(v0 * bf4_lo(g), v1 * bf4_hi(g));
    }
};
struct PreM2 { u32x4 g; u32x4 t; };
struct EpiM2 {
    P p;
    typedef PreM2 Pre;
    static constexpr int BATCH = 8;
    static constexpr bool COLBIAS = false;
    DEVI Pre pre(int row, int col) const { PreM2 r; r.g = *(const u32x4*)(p.G + (size_t)row * 2048 + col); r.t = *(const u32x4*)(p.TMPB + (size_t)row * 1024 + col); return r; }
    DEVI void put(int row, int col, f32x4 v0, f32x4 v1, const Pre& q) const {
        *(u32x4*)(p.MERGED + (size_t)row * 1024 + col) = pack8f(bf4_lo(q.t) + v0 * bf4_lo(q.g), bf4_hi(q.t) + v1 * bf4_hi(q.g));
    }
};
struct PreR { f32x4 a, b; };
struct EpiR {
    P p;
    typedef PreR Pre;
    static constexpr int BATCH = 8;
    static constexpr bool COLBIAS = false;
    DEVI Pre pre(int row, int col) const {
        const float* xr = row < NTP ? p.xp + (size_t)row * 1024 : p.xs + (size_t)(row - NTP) * 1024;
        PreR r; r.a = *(const f32x4*)(xr + col); r.b = *(const f32x4*)(xr + col + 4); return r;
    }
    DEVI void put(int row, int col, f32x4 v0, f32x4 v1, const Pre& x) const {
        *(f32x4*)(p.R + (size_t)row * 1024 + col) = x.a * DN_ALPHA + v0; *(f32x4*)(p.R + (size_t)row * 1024 + col + 4) = x.b * DN_ALPHA + v1;
    }
};
struct EpiPQ {
    P p;
    typedef NoPre Pre;
    static constexpr int BATCH = 4;
    static constexpr bool COLBIAS = false;
    DEVI Pre pre(int, int) const { return NoPre(); }
    DEVI void put(int row, int col, f32x4 v0, f32x4 v1, const Pre&) const { *(u32x4*)(p.PQ + (size_t)row * 2048 + col) = pack8f(v0, v1); }
};

DEVI void stage_mlstm_gates(const P& p, char* smem, int bid, int nblk) {
    const int lane = tid_opq() & 63, wid = tid_opq() >> 6;
    float* bend_s = (float*)smem; float* mloc_s = bend_s + 64;
    for (int bh = bid; bh < 16; bh += nblk) {
        const int b = bh >> 2, h = bh & 3;
        __syncthreads();
        for (int cc = 0; cc < 8; ++cc) {
            const int c = wid * 8 + cc;
            const size_t row = (size_t)b * 4096 + c * 64 + lane;
            const float ip = p.SM[row * 64 + h];
            const float lf = logsigmoidf_(p.SM[row * 64 + 4 + h]);
            float cs = lf;
#pragma unroll
            for (int o = 1; o < 64; o <<= 1) { const float t = __shfl_up(cs, o); if (lane >= o) cs += t; }
            p.BCUM[bh * 4096 + c * 64 + lane] = cs;
            const float bend = __shfl(cs, 63);
            const float mloc = wave_max(bend - cs + ip);
            if (lane == 0) { bend_s[c] = bend; mloc_s[c] = mloc; }
        }
        __syncthreads();
        if (tid_opq() == 0) {
            float m = 0.f;
            for (int c = 0; c < 64; ++c) {
                const float bend = bend_s[c], mloc = mloc_s[c];
                const float mnew = fmaxf(bend + m, mloc);
                p.MPREV[bh * 64 + c] = m;
                p.ACOEF[bh * 64 + c] = __expf(bend + m - mnew);
                p.SCL[bh * 64 + c] = __expf(mloc - mnew);
                p.MLOC[bh * 64 + c] = mloc;
                m = mnew;
            }
            p.out[O_PM + bh] = m;
        }
    }
}

constexpr int MD_KT = 0, MD_VT = 128 * 144, MD_WS = MD_VT + 272 * 144, MD_LDS = MD_WS + 256;
DEVI void stage_mlstm_dc(const P& p, char* smem, int bid, int nblk) {
    const int tid = tid_opq(), lane = tid & 63, wid = tid >> 6, fr = lane & 15, fq = lane >> 4;
    bf16_t* Kt = (bf16_t*)(smem + MD_KT);
    bf16_t* Vt = (bf16_t*)(smem + MD_VT);
    float* ws = (float*)(smem + MD_WS);
    for (int task = bid; task < 1024; task += nblk) {
        const int bh = task >> 6, c = task & 63, b = bh >> 2, h = bh & 3;
        const size_t row0 = (size_t)b * 4096 + c * 64;
        __syncthreads();
        if (tid < 64) {
            const float ip = p.SM[(row0 + tid) * 64 + h];
            float cs = logsigmoidf_(p.SM[(row0 + tid) * 64 + 4 + h]);
#pragma unroll
            for (int o = 1; o < 64; o <<= 1) { const float t = __shfl_up(cs, o); if (tid >= o) cs += t; }
            const float g = __shfl(cs, 63) - cs + ip;
            ws[tid] = __expf(g - wave_max(g));
        }
        __syncthreads();
        {
            const int sidx = tid & 63, ch = tid >> 6;
            const float w = ws[sidx];
#pragma unroll
            for (int half = 0; half < 2; ++half) {
                const u32x4 kk = *(const u32x4*)(p.PROJ + (row0 + sidx) * PS + C_AK + h * 128 + half * 64 + ch * 8);
#pragma unroll
                for (int e = 0; e < 4; ++e) {
                    Kt[(half * 64 + ch * 8 + e * 2) * 72 + sidx] = f2bf(w * __uint_as_float(kk[e] << 16));
                    Kt[(half * 64 + ch * 8 + e * 2 + 1) * 72 + sidx] = f2bf(w * __uint_as_float(kk[e] & 0xFFFF0000u));
                }
            }
#pragma unroll
            for (int q4 = 0; q4 < 4; ++q4) {
                const u32x4 vv = *(const u32x4*)(p.PROJ + (row0 + sidx) * PS + C_AV + h * 256 + q4 * 64 + ch * 8);
#pragma unroll
                for (int e = 0; e < 4; ++e) {
                    Vt[(q4 * 64 + ch * 8 + e * 2) * 72 + sidx] = (bf16_t)(vv[e] & 0xFFFFu);
                    Vt[(q4 * 64 + ch * 8 + e * 2 + 1) * 72 + sidx] = (bf16_t)(vv[e] >> 16);
                }
            }
            for (int i = tid; i < 16 * 64; i += 512) Vt[(256 + (i >> 6)) * 72 + (i & 63)] = (i >> 6) == 0 ? (bf16_t)0x3F80 : (bf16_t)0;
        }
        __syncthreads();
        const int nvt = wid == 0 ? 3 : 2;
        for (int vi = 0; vi < nvt; ++vi) {
            const int vt = vi < 2 ? wid * 2 + vi : 16;
            f32x4 acc[8];
#pragma unroll
            for (int dt = 0; dt < 8; ++dt) acc[dt] = (f32x4){0.f, 0.f, 0.f, 0.f};
#pragma unroll
            for (int ks = 0; ks < 2; ++ks) {
                const bf16x8 bf = *(const bf16x8*)(Vt + (vt * 16 + fr) * 72 + ks * 32 + fq * 8);
#pragma unroll
                for (int dt = 0; dt < 8; ++dt) {
                    const bf16x8 af = *(const bf16x8*)(Kt + (dt * 16 + fr) * 72 + ks * 32 + fq * 8);
                    acc[dt] = __builtin_amdgcn_mfma_f32_16x16x32_bf16(af, bf, acc[dt], 0, 0, 0);
                }
            }
            const int v = vt * 16 + fr;
            if (v <= 256) {
#pragma unroll
                for (int dt = 0; dt < 8; ++dt) *(f32x4*)(p.DC + ((size_t)task * 272 + v) * 128 + dt * 16 + fq * 4) = acc[dt];
            }
        }
    }
}

DEVI void stage_mlstm_scan(const P& p, int bid, int nblk) {
    const int nthr = 512;
    for (int e = bid * nthr + tid_opq(); e < 16 * 257 * 32; e += nblk * nthr) {
        const int bh = e / (257 * 32), r = e % (257 * 32), v = r >> 5, d = (r & 31) * 4;
        f32x4 C = {0.f, 0.f, 0.f, 0.f};
        const float* ac = p.ACOEF + bh * 64; const float* sc = p.SCL + bh * 64;
        const size_t base = ((size_t)(bh * 64) * 272 + v) * 128 + d, cstride = (size_t)272 * 128;
#pragma unroll 1
        for (int c0 = 0; c0 < 64; c0 += 8) {
            f32x4 dc[8];
#pragma unroll
            for (int i = 0; i < 8; ++i) dc[i] = __builtin_nontemporal_load((const f32x4*)(p.DC + base + (size_t)(c0 + i) * cstride));
#pragma unroll
            for (int i = 0; i < 8; ++i) {
                u32x2 o; o.x = pack2(C[0], C[1]); o.y = pack2(C[2], C[3]);
                *(u32x2*)(p.CPT + base + (size_t)(c0 + i) * cstride) = o;
                C = C * ac[c0 + i] + dc[i] * sc[c0 + i];
            }
        }
        if (v < 256) {
#pragma unroll
            for (int k = 0; k < 4; ++k) p.out[O_PC + ((size_t)bh * 128 + d + k) * 256 + v] = C[k];
        } else *(f32x4*)(p.out + O_PN + bh * 128 + d) = C;
    }
}

constexpr int MO_Q = 0, MO_K = 64 * 272, MO_VT = MO_K + 64 * 272, MO_P = MO_VT + 272 * 144, MO_SC = MO_P + 64 * 144, MO_HS = MO_SC + 2048, MO_LDS = MO_HS + 64 * 256 * 4;
static_assert(MO_LDS <= 152 * 1024, "lds");
DEVI void stage_mlstm_out(const P& p, char* smem, int bid, int nblk) {
    const int tid = tid_opq(), lane = tid & 63, wid = tid >> 6, fr = lane & 15, fq = lane >> 4;
    bf16_t* Qs = (bf16_t*)(smem + MO_Q);
    bf16_t* Ks = (bf16_t*)(smem + MO_K);
    bf16_t* Vt = (bf16_t*)(smem + MO_VT);
    bf16_t* Ps = (bf16_t*)(smem + MO_P);
    float* sc = (float*)(smem + MO_SC);
    float* rowt = sc; float* colt = sc + 64; float* wint = sc + 128; float* emt = sc + 192; float* den = sc + 256;
    float* hs = (float*)(smem + MO_HS);
    for (int task = bid; task < 1024; task += nblk) {
        const int bh = task >> 6, c = task & 63, b = bh >> 2, h = bh & 3;
        const size_t row0 = (size_t)b * 4096 + c * 64;
        __syncthreads();
        {
            for (int i = tid; i < 64 * 16; i += 512) {
                const int t = i >> 4, ch = i & 15;
                *(u32x4*)(Qs + t * 136 + ch * 8) = *(const u32x4*)(p.PROJ + (row0 + t) * PS + C_AQ + h * 128 + ch * 8);
                *(u32x4*)(Ks + t * 136 + ch * 8) = *(const u32x4*)(p.PROJ + (row0 + t) * PS + C_AK + h * 128 + ch * 8);
            }
            const int sidx = tid & 63, ch = tid >> 6;
#pragma unroll
            for (int q4 = 0; q4 < 4; ++q4) {
                const u32x4 vv = *(const u32x4*)(p.PROJ + (row0 + sidx) * PS + C_AV + h * 256 + q4 * 64 + ch * 8);
#pragma unroll
                for (int e = 0; e < 4; ++e) {
                    Vt[(q4 * 64 + ch * 8 + e * 2) * 72 + sidx] = (bf16_t)(vv[e] & 0xFFFFu);
                    Vt[(q4 * 64 + ch * 8 + e * 2 + 1) * 72 + sidx] = (bf16_t)(vv[e] >> 16);
                }
            }
            for (int i = tid; i < 16 * 64; i += 512) Vt[(256 + (i >> 6)) * 72 + (i & 63)] = (i >> 6) == 0 ? (bf16_t)0x3F80 : (bf16_t)0;
            if (wid == 0) {
                const float bc = p.BCUM[bh * 4096 + c * 64 + lane], ip = p.SM[(row0 + lane) * 64 + h];
                const float mprev = p.MPREV[task];
                float pm = ip - bc;
#pragma unroll
                for (int o = 1; o < 64; o <<= 1) { const float t = __shfl_up(pm, o); if (lane >= o) pm = fmaxf(pm, t); }
                const float mt = fmaxf(bc + mprev, bc + pm);
                rowt[lane] = bc - mt; colt[lane] = ip - bc; wint[lane] = __expf(bc + mprev - mt); emt[lane] = __expf(-mt);
            }
        }
        __syncthreads();
        {
            const int tt = wid >> 1;
#pragma unroll
            for (int si = 0; si < 2; ++si) {
                const int st = (wid & 1) * 2 + si;
                f32x4 acc = (f32x4){0.f, 0.f, 0.f, 0.f};
                if (st <= tt) {
#pragma unroll
                    for (int ks = 0; ks < 4; ++ks) {
                        const bf16x8 af = *(const bf16x8*)(Qs + (tt * 16 + fr) * 136 + ks * 32 + fq * 8);
                        const bf16x8 bf = *(const bf16x8*)(Ks + (st * 16 + fr) * 136 + ks * 32 + fq * 8);
                        acc = __builtin_amdgcn_mfma_f32_16x16x32_bf16(af, bf, acc, 0, 0, 0);
                    }
                }
                const int s = st * 16 + fr; const float ct = colt[s];
#pragma unroll
                for (int r = 0; r < 4; ++r) {
                    const int t = tt * 16 + fq * 4 + r;
                    const float pv = (s <= t) ? acc[r] * __expf(rowt[t] + ct) : 0.f;
                    Ps[t * 72 + s] = f2bf(pv);
                }
            }
        }
        __syncthreads();
        {
            const bf16_t* cpt = p.CPT + (size_t)task * 272 * 128;
            f32x4 acc[4][2];
#pragma unroll
            for (int tt = 0; tt < 4; ++tt)
#pragma unroll
                for (int vi = 0; vi < 2; ++vi) acc[tt][vi] = (f32x4){0.f, 0.f, 0.f, 0.f};
            f32x4 accd = (f32x4){0.f, 0.f, 0.f, 0.f};
            bf16x8 cb[4][2], cd[4];
#pragma unroll
            for (int ks = 0; ks < 4; ++ks) {
#pragma unroll
                for (int vi = 0; vi < 2; ++vi) cb[ks][vi] = *(const bf16x8*)(cpt + (size_t)((wid * 2 + vi) * 16 + fr) * 128 + ks * 32 + fq * 8);
                cd[ks] = *(const bf16x8*)(cpt + (size_t)(256 + fr) * 128 + ks * 32 + fq * 8);
            }
#pragma unroll
            for (int ks = 0; ks < 4; ++ks) {
                bf16x8 af[4];
#pragma unroll
                for (int tt = 0; tt < 4; ++tt) af[tt] = *(const bf16x8*)(Qs + (tt * 16 + fr) * 136 + ks * 32 + fq * 8);
#pragma unroll
                for (int vi = 0; vi < 2; ++vi) {
#pragma unroll
                    for (int tt = 0; tt < 4; ++tt) acc[tt][vi] = __builtin_amdgcn_mfma_f32_16x16x32_bf16(af[tt], cb[ks][vi], acc[tt][vi], 0, 0, 0);
                }
                if (wid < 4) {
                    const bf16x8 a2 = *(const bf16x8*)(Qs + (wid * 16 + fr) * 136 + ks * 32 + fq * 8);
                    accd = __builtin_amdgcn_mfma_f32_16x16x32_bf16(a2, cd[ks], accd, 0, 0, 0);
                }
            }
#pragma unroll
            for (int tt = 0; tt < 4; ++tt) {
                const f32x4 wv = *(const f32x4*)(wint + tt * 16 + fq * 4);
#pragma unroll
                for (int vi = 0; vi < 2; ++vi) acc[tt][vi] *= wv;
            }
            if (wid < 4) accd *= *(const f32x4*)(wint + wid * 16 + fq * 4);
#pragma unroll
            for (int ks = 0; ks < 2; ++ks) {
                bf16x8 af[4];
#pragma unroll
                for (int tt = 0; tt < 4; ++tt) af[tt] = *(const bf16x8*)(Ps + (tt * 16 + fr) * 72 + ks * 32 + fq * 8);
#pragma unroll
                for (int vi = 0; vi < 2; ++vi) {
                    const bf16x8 bf = *(const bf16x8*)(Vt + ((wid * 2 + vi) * 16 + fr) * 72 + ks * 32 + fq * 8);
#pragma unroll
                    for (int tt = 0; tt < 4; ++tt) acc[tt][vi] = __builtin_amdgcn_mfma_f32_16x16x32_bf16(af[tt], bf, acc[tt][vi], 0, 0, 0);
                }
                if (wid < 4) {
                    const bf16x8 bf = *(const bf16x8*)(Vt + (256 + fr) * 72 + ks * 32 + fq * 8);
                    const bf16x8 a2 = *(const bf16x8*)(Ps + (wid * 16 + fr) * 72 + ks * 32 + fq * 8);
                    accd = __builtin_amdgcn_mfma_f32_16x16x32_bf16(a2, bf, accd, 0, 0, 0);
                }
            }
            if (wid < 4 && fr == 0) *(f32x4*)(den + wid * 16 + fq * 4) = accd;
            __syncthreads();
#pragma unroll
            for (int tt = 0; tt < 4; ++tt) {
                const f32x4 dv = *(const f32x4*)(den + tt * 16 + fq * 4), ev = *(const f32x4*)(emt + tt * 16 + fq * 4);
#pragma unroll
                for (int vi = 0; vi < 2; ++vi)
#pragma unroll
                    for (int r = 0; r < 4; ++r) hs[(tt * 16 + fq * 4 + r) * 256 + (wid * 2 + vi) * 16 + fr] = acc[tt][vi][r] / fmaxf(fabsf(dv[r]), ev[r]);
            }
        }
        __syncthreads();
        u32x2 ovs[8];
#pragma unroll
        for (int rr = 0; rr < 8; ++rr) ovs[rr] = *(const u32x2*)(p.PROJ + (row0 + wid * 8 + rr) * PS + C_AO + h * 256 + lane * 4);
        const f32x4 gg = *(const f32x4*)(p.norm_a_g + h * 256 + lane * 4);
#pragma unroll
        for (int rr = 0; rr < 8; ++rr) {
            const int t = wid * 8 + rr;
            const f32x4 x = *(const f32x4*)(hs + t * 256 + lane * 4);
            const float mean = wave_sum(x[0] + x[1] + x[2] + x[3]) * (1.f / 256.f);
            float q = 0.f;
#pragma unroll
            for (int k = 0; k < 4; ++k) q += (x[k] - mean) * (x[k] - mean);
            const float rs = rsqrtf(wave_sum(q) * (1.f / 256.f) + LN_EPS);
            const u32x2 ov = ovs[rr];
            const float o4[4] = {__uint_as_float(ov.x << 16), __uint_as_float(ov.x & 0xFFFF0000u), __uint_as_float(ov.y << 16), __uint_as_float(ov.y & 0xFFFF0000u)};
            float y[4];
#pragma unroll
            for (int k = 0; k < 4; ++k) y[k] = (x[k] - mean) * rs * gg[k] * sigmoidf_(o4[k]);
            u32x2 o2; o2.x = pack2(y[0], y[1]); o2.y = pack2(y[2], y[3]);
            *(u32x2*)(p.YA + (row0 + t) * 1024 + h * 256 + lane * 4) = o2;
        }
    }
}

DEVI void stage_mlstm_sample(const P& p, char* smem, int bid, int nblk) {
    float* qs = (float*)smem;
    float* ks = qs + 512;
    float* vs = ks + 512;
    float* part = vs + 1024;
    float* hs = part + 2048;
    float* sc = hs + 1024;
    float* bc = sc; float* ip = sc + 4; float* mt = sc + 8; float* wint = sc + 12; float* emt = sc + 16; float* ww = sc + 20; float* den = sc + 24;
    float* Pm = sc + 32;
    float* misc = sc + 48;
    const int tid = tid_opq(), lane = tid & 63, wid = tid >> 6;
    for (int task = bid; task < 512; task += nblk) {
        const int b = task >> 2, h = task & 3;
        const size_t row0 = (size_t)NTP + b * 4;
        __syncthreads();
        { const int t = tid >> 7, d = tid & 127;
          qs[tid] = bf2f(p.PROJ[(row0 + t) * PS + C_AQ + h * 128 + d]);
          ks[tid] = bf2f(p.PROJ[(row0 + t) * PS + C_AK + h * 128 + d]); }
        for (int idx = tid; idx < 1024; idx += 512) { const int t = idx >> 8, v = idx & 255; vs[idx] = bf2f(p.PROJ[(row0 + t) * PS + C_AV + h * 256 + v]); }
        if (tid == 0) {
            const float m0 = p.state_m[task];
            float cs = 0.f;
            for (int t = 0; t < 4; ++t) { cs += logsigmoidf_(p.SM[(row0 + t) * 64 + 4 + h]); bc[t] = cs; ip[t] = p.SM[(row0 + t) * 64 + h]; }
            for (int t = 0; t < 4; ++t) {
                float mx = bc[t] + m0;
                for (int s = 0; s <= t; ++s) mx = fmaxf(mx, bc[t] - bc[s] + ip[s]);
                mt[t] = mx; wint[t] = __expf(bc[t] + m0 - mx); emt[t] = __expf(-mx);
            }
            const float bend = bc[3];
            float mnew = bend + m0;
            for (int s = 0; s < 4; ++s) mnew = fmaxf(mnew, bend - bc[s] + ip[s]);
            misc[0] = __expf(bend + m0 - mnew);
            for (int s = 0; s < 4; ++s) ww[s] = __expf(bend - bc[s] + ip[s] - mnew);
            p.out[O_SM + task] = mnew;
        }
        __syncthreads();
        if (tid < 16) {
            const int t = tid >> 2, s = tid & 3;
            float a = 0.f;
            if (s <= t) { for (int d = 0; d < 128; ++d) a += qs[t * 128 + d] * ks[s * 128 + d]; a *= __expf(bc[t] - bc[s] + ip[s] - mt[t]); }
            Pm[tid] = a;
        }
        __syncthreads();
        if (tid < 4) {
            const int t = tid; float qn = 0.f;
            for (int d = 0; d < 128; ++d) qn += qs[t * 128 + d] * p.state_n[(size_t)task * 128 + d];
            den[t] = wint[t] * qn + Pm[t * 4] + Pm[t * 4 + 1] + Pm[t * 4 + 2] + Pm[t * 4 + 3];
        }
        const float a = misc[0];
        if (tid >= 128 && tid < 256) {
            const int d = tid - 128;
            float n = a * p.state_n[(size_t)task * 128 + d];
            for (int s = 0; s < 4; ++s) n += ww[s] * ks[s * 128 + d];
            p.out[O_SN + (size_t)task * 128 + d] = n;
        }
        {
            const int v = tid & 255, dh = tid >> 8;
            float acc[4] = {0.f, 0.f, 0.f, 0.f};
            float wv[4];
#pragma unroll
            for (int s = 0; s < 4; ++s) wv[s] = ww[s] * vs[s * 256 + v];
            for (int d0 = dh * 64; d0 < dh * 64 + 64; d0 += 16) {
                float c0[16];
#pragma unroll
                for (int i = 0; i < 16; ++i) c0[i] = __builtin_nontemporal_load(p.state_C + ((size_t)task * 128 + d0 + i) * 256 + v);
#pragma unroll
                for (int i = 0; i < 16; ++i) {
                    const int d = d0 + i;
#pragma unroll
                    for (int t = 0; t < 4; ++t) acc[t] += qs[t * 128 + d] * c0[i];
                    float cn = a * c0[i];
#pragma unroll
                    for (int s = 0; s < 4; ++s) cn += ks[s * 128 + d] * wv[s];
                    __builtin_nontemporal_store(cn, p.out + O_SC + ((size_t)task * 128 + d) * 256 + v);
                }
            }
#pragma unroll
            for (int t = 0; t < 4; ++t) part[(dh * 4 + t) * 256 + v] = acc[t];
        }
        __syncthreads();
        if (tid < 256) {
            const int v = tid;
#pragma unroll
            for (int t = 0; t < 4; ++t) {
                float num = wint[t] * (part[t * 256 + v] + part[(4 + t) * 256 + v]);
#pragma unroll
                for (int s = 0; s < 4; ++s) num += Pm[t * 4 + s] * vs[s * 256 + v];
                hs[t * 256 + v] = num / fmaxf(fabsf(den[t]), emt[t]);
            }
        }
        __syncthreads();
        if (wid < 4) {
            const int t = wid;
            const f32x4 x = *(const f32x4*)(hs + t * 256 + lane * 4);
            const float mean = wave_sum(x[0] + x[1] + x[2] + x[3]) * (1.f / 256.f);
            float q = 0.f;
#pragma unroll
            for (int k = 0; k < 4; ++k) q += (x[k] - mean) * (x[k] - mean);
            const float rs = rsqrtf(wave_sum(q) * (1.f / 256.f) + LN_EPS);
            float y[4];
#pragma unroll
            for (int k = 0; k < 4; ++k) {
                const int vi = lane * 4 + k;
                const float o = bf2f(p.PROJ[(row0 + t) * PS + C_AO + h * 256 + vi]);
                y[k] = (x[k] - mean) * rs * p.norm_a_g[h * 256 + vi] * sigmoidf_(o);
            }
            u32x2 o2; o2.x = pack2(y[0], y[1]); o2.y = pack2(y[2], y[3]);
            *(u32x2*)(p.YA + (row0 + t) * 1024 + h * 256 + lane * 4) = o2;
        }
    }
}

constexpr int CP_ABUF = 33280, CP_WBUF = 18432, CP_A = 0, CP_W = 2 * CP_ABUF, CP_LDS = CP_W + 2 * CP_WBUF;
constexpr int CP_AROW = 1024 + 8;
DEVI void stage_compress(const P& p, char* smem, int bid, int nblk) {
    const int tid = tid_opq(), lane = tid & 63, wid = tid >> 6, fr = lane & 15, fq = lane >> 4;
    const int kv = wid & 1, rt = wid >> 1;
    const int n_it = (256 + nblk - 1) / nblk + (16 + nblk - 1) / nblk;
    for (int it = 0; it < n_it; ++it) {
        const int ns_it = (256 + nblk - 1) / nblk;
        const int task = it < ns_it ? bid + it * nblk : 256 + (nblk - 1 - bid) + (it - ns_it) * nblk;
        if (task >= 272 || (it < ns_it && task >= 256)) continue;
        const bool prompt = task >= 256;
        const int rowbytes = prompt ? 1024 : 2048, npieces = prompt ? 2 : 4;
        const char* src[4]; int dsto[4];
#pragma unroll
        for (int q = 0; q < 4; ++q) {
            const int off = q * 8192 + tid * 16, r = off / rowbytes, cb = off % rowbytes;
            if (prompt) { const int blk = (task - 256) * 16 + (r & 15); src[q] = (const char*)(p.PROJ + (size_t)blk * 64 * PS + C_CMP) + cb; dsto[q] = (r & 15) * CP_AROW * 2 + cb; }
            else { const int gb = task * 16 + r, b = gb >> 5, n = gb & 31; const int page = p.page_table[b * 16 + (n >> 1)];
                   src[q] = (const char*)(p.cache_cmp + ((size_t)page * 128 + (n & 1) * 64) * 512) + cb; dsto[q] = r * CP_AROW * 2 + (cb >> 1); }
        }
        const size_t sstride = prompt ? (size_t)PS * 2 : 2048;
        const char* wsrc[2]; int wdst[2];
#pragma unroll
        for (int q = 0; q < 2; ++q) { const int idx = q * 512 + tid, row = idx >> 3, ch = idx & 7; wsrc[q] = (const char*)(p.WCT + (size_t)row * 4096) + ch * 16; wdst[q] = row * 144 + ch * 16; }
        f32x4 acc[4];
#pragma unroll
        for (int nt = 0; nt < 4; ++nt) acc[nt] = (f32x4){0.f, 0.f, 0.f, 0.f};
        f32x4 ra0[4], ra1[4]; u32x4 rw0[2], rw1[2];
        auto issue = [&](int l, f32x4 (&ra)[4], u32x4 (&rw)[2]) {
#pragma unroll
            for (int q = 0; q < 4; ++q) if (q < npieces) ra[q] = *(const f32x4*)(src[q] + (size_t)l * sstride);
#pragma unroll
            for (int q = 0; q < 2; ++q) rw[q] = *(const u32x4*)(wsrc[q] + l * 128);
        };
        auto commit = [&](int buf, const f32x4 (&ra)[4], const u32x4 (&rw)[2]) {
            char* ab = smem + CP_A + buf * CP_ABUF; char* wbuf = smem + CP_W + buf * CP_WBUF;
#pragma unroll
            for (int q = 0; q < 4; ++q) if (q < npieces) {
                if (prompt) *(f32x4*)(ab + dsto[q]) = ra[q];
                else { u32x2 o; o.x = pack2(ra[q][0], ra[q][1]); o.y = pack2(ra[q][2], ra[q][3]); *(u32x2*)(ab + dsto[q]) = o; }
            }
#pragma unroll
            for (int q = 0; q < 2; ++q) *(u32x4*)(wbuf + wdst[q]) = rw[q];
        };
        auto consume = [&](int buf) {
            const char* ab = smem + CP_A + buf * CP_ABUF; const char* wbuf = smem + CP_W + buf * CP_WBUF;
            const bf16_t* arow = (const bf16_t*)ab + (rt * 4 + (fr >> 2)) * CP_AROW + kv * 256 + (fr & 3) * 64 + fq * 8;
#pragma unroll
            for (int hf = 0; hf < 2; ++hf) {
                const bf16x8 a = *(const bf16x8*)(arow + hf * 32);
#pragma unroll
                for (int nt = 0; nt < 4; ++nt) {
                    const bf16x8 bfrag = *(const bf16x8*)(wbuf + (kv * 64 + nt * 16 + fr) * 144 + hf * 64 + fq * 16);
                    acc[nt] = __builtin_amdgcn_mfma_f32_16x16x32_bf16(a, bfrag, acc[nt], 0, 0, 0);
                }
            }
        };
        __syncthreads();
        issue(0, ra0, rw0); issue(1, ra1, rw1); commit(0, ra0, rw0); issue(2, ra0, rw0);
        __syncthreads();
#pragma unroll 1
        for (int l = 0; l < 64; l += 2) {
            consume(0);
            commit(1, ra1, rw1);
            if (l + 3 < 64) issue(l + 3, ra1, rw1);
            __syncthreads();
            consume(1);
            if (l + 2 < 64) commit(0, ra0, rw0);
            if (l + 4 < 64) issue(l + 4, ra0, rw0);
            __syncthreads();
        }
        {
            const int ob = prompt ? (task - 256) * 16 + rt * 4 + fq : 256 + task * 16 + rt * 4 + fq;
#pragma unroll
            for (int nt = 0; nt < 4; ++nt) {
                const float bias = p.PW[kv * 64 + nt * 16 + fr];
#pragma unroll
                for (int r = 0; r < 4; ++r) p.KC[(size_t)ob * 512 + kv * 256 + r * 64 + nt * 16 + fr] = acc[nt][r] + bias;
            }
        }
    }
}

DEVI void stage_cmp_select(const P& p, int bid, int nblk) {
    const int lane = tid_opq() & 63, wid = tid_opq() >> 6;
    for (int wt = bid * 8 + wid; wt < NT * 4; wt += nblk * 8) {
        const int row = wt >> 2, g = wt & 3;
        int pos, nb, nvalid, cur; const float *kcb, *vcb;
        if (row < NTP) { const int b = row >> 12, t = row & 4095; pos = t; nb = 64; nvalid = (t + 1) >> 6; cur = t >> 6; kcb = p.KC + (size_t)(b * 64) * 256; vcb = p.VC + (size_t)(b * 64) * 256; }
        else { const int rs = row - NTP, b = rs >> 2, tq = rs & 3; pos = 2048 + tq; nb = 33; nvalid = 32; cur = 32; kcb = p.KC + (size_t)(256 + b * 32) * 256; vcb = p.VC + (size_t)(256 + b * 32) * 256; }
        const int j = lane;
        float pr[4] = {0.f, 0.f, 0.f, 0.f};
        float imp = 0.f;
        if (nvalid > 0) {
            float dot[4] = {0.f, 0.f, 0.f, 0.f};
            if (j < nvalid) {
                const float* kr = kcb + (size_t)j * 256 + g * 64;
                const bf16_t* qr = p.PROJ + (size_t)row * PS + C_BQ + g * 256;
                for (int d = 0; d < 64; ++d) {
                    const float kk = kr[d];
#pragma unroll
                    for (int r = 0; r < 4; ++r) dot[r] += bf2f(qr[r * 64 + d]) * kk;
                }
            }
#pragma unroll
            for (int r = 0; r < 4; ++r) {
                const float s = j < nvalid ? dot[r] * 0.125f - alibi_slope(g * 4 + r) * (float)(pos - (j * 64 + 63)) : -INFINITY;
                const float mx = wave_max(s);
                const float e = j < nvalid ? __expf(s - mx) : 0.f;
                const float sum = wave_sum(e);
                pr[r] = e / sum;
                imp += pr[r];
            }
            float o[4] = {0.f, 0.f, 0.f, 0.f};
            for (int jj = 0; jj < nvalid; ++jj) {
                const float vv = vcb[(size_t)jj * 256 + g * 64 + lane];
#pragma unroll
                for (int r = 0; r < 4; ++r) o[r] += __shfl(pr[r], jj) * vv;
            }
#pragma unroll
            for (int r = 0; r < 4; ++r) p.OCMP[(size_t)row * 1024 + (g * 4 + r) * 64 + lane] = o[r];
        } else {
#pragma unroll
            for (int r = 0; r < 4; ++r) p.OCMP[(size_t)row * 1024 + (g * 4 + r) * 64 + lane] = 0.f;
        }
        if (j == cur || j == 0) imp = 5.0f;
        if (j > cur) imp = -1.0f;
        if (j >= nb) imp = -2.0f;
        int rank = 0;
        for (int jj = 0; jj < 64; ++jj) { const float v = __shfl(imp, jj); rank += (v > imp || (v == imp && jj < j)) ? 1 : 0; }
        const unsigned long long mask = __ballot(rank < 16 && j < nb);
        if (lane == 0) p.SEL[(size_t)row * 4 + g] = mask;
    }
}

struct KBlock { const void* kb; const void* vb; int stride; int f32; int count; int pos0; };

template <bool WIN>
DEVI void attend_block(const KBlock& B, int qpos, const float* qs, const float (&slope)[4], float (&m)[4], float (&l)[4], float (&o)[4], int lane) {
    const int pos = B.pos0 + lane;
    const bool valid = lane < B.count && pos <= qpos && (!WIN || pos > qpos - 512);
    if (!__any(valid)) return;
    float dot[4] = {0.f, 0.f, 0.f, 0.f};
    if (valid) {
        if (B.f32) {
            const float* kr = (const float*)B.kb + (size_t)lane * B.stride;
#pragma unroll 4
            for (int d4 = 0; d4 < 16; ++d4) {
                const f32x4 kk = *(const f32x4*)(kr + d4 * 4);
#pragma unroll
                for (int e = 0; e < 4; ++e) { const f32x4 qq = *(const f32x4*)(qs + (d4 * 4 + e) * 4);
#pragma unroll
                    for (int r = 0; r < 4; ++r) dot[r] += kk[e] * qq[r]; }
            }
        } else {
            const bf16_t* kr = (const bf16_t*)B.kb + (size_t)lane * B.stride;
#pragma unroll 2
            for (int d8 = 0; d8 < 8; ++d8) {
                const u32x4 kk = *(const u32x4*)(kr + d8 * 8);
                const unsigned w[4] = {kk.x, kk.y, kk.z, kk.w};
#pragma unroll
                for (int e = 0; e < 4; ++e) {
                    const float k0 = __uint_as_float(w[e] << 16), k1 = __uint_as_float(w[e] & 0xFFFF0000u);
                    const f32x4 q0 = *(const f32x4*)(qs + (d8 * 8 + e * 2) * 4), q1 = *(const f32x4*)(qs + (d8 * 8 + e * 2 + 1) * 4);
#pragma unroll
                    for (int r = 0; r < 4; ++r) dot[r] += k0 * q0[r] + k1 * q1[r];
                }
            }
        }
    }
    float pr[4];
#pragma unroll
    for (int r = 0; r < 4; ++r) {
        const float s = valid ? dot[r] * 0.125f - slope[r] * (float)(qpos - pos) : -INFINITY;
        const float mn = fmaxf(m[r], wave_max(s));
        const float sc = __expf(m[r] - mn);
        pr[r] = valid ? __expf(s - mn) : 0.f;
        l[r] = l[r] * sc + wave_sum(pr[r]);
        o[r] *= sc; m[r] = mn;
    }
    for (int kk = 0; kk < B.count; ++kk) {
        const float vv = B.f32 ? ((const float*)B.vb)[(size_t)kk * B.stride + lane] : bf2f(((const bf16_t*)B.vb)[(size_t)kk * B.stride + lane]);
#pragma unroll
        for (int r = 0; r < 4; ++r) o[r] += __shfl(pr[r], kk) * vv;
    }
}

DEVI void stage_slc_win(const P& p, char* smem, int bid, int nblk) {
    const int lane = tid_opq() & 63, wid = tid_opq() >> 6;
    float* qs = (float*)smem + wid * 256;
    for (int wt = bid * 8 + wid; wt < NT * 4; wt += nblk * 8) {
        const int row = wt >> 2, g = wt & 3;
        const bool prompt = row < NTP;
        int b, t, qpos;
        if (prompt) { b = row >> 12; t = row & 4095; qpos = t; } else { const int rs = row - NTP; b = rs >> 2; t = rs & 3; qpos = 2048 + t; }
        {
            const bf16_t* qr = p.PROJ + (size_t)row * PS + C_BQ + g * 256;
            f32x4 qv;
#pragma unroll
            for (int r = 0; r < 4; ++r) qv[r] = bf2f(qr[r * 64 + lane]);
            *(f32x4*)(qs + lane * 4) = qv;
            asm volatile("s_waitcnt lgkmcnt(0)" ::: "memory");
        }
        float slope[4];
#pragma unroll
        for (int r = 0; r < 4; ++r) slope[r] = alibi_slope(g * 4 + r);
        float res[2][4];
        {
            float m[4], l[4], o[4];
#pragma unroll
            for (int r = 0; r < 4; ++r) { m[r] = -INFINITY; l[r] = 0.f; o[r] = 0.f; }
            unsigned long long mask = p.SEL[(size_t)row * 4 + g];
            while (mask) {
                const int j = __builtin_ctzll(mask); mask &= mask - 1;
                KBlock B;
                if (prompt) {
                    const bf16_t* base = p.PROJ + ((size_t)b * 4096 + j * 64) * PS + C_SLC + g * 64;
                    B.kb = base; B.vb = base + 256; B.stride = PS; B.f32 = 0; B.count = 64; B.pos0 = j * 64;
                } else if (j < 32) {
                    const int page = p.page_table[b * 16 + (j >> 1)];
                    const float* base = p.cache_slc + ((size_t)page * 128 + (j & 1) * 64) * 512 + g * 64;
                    B.kb = base; B.vb = base + 256; B.stride = 512; B.f32 = 1; B.count = 64; B.pos0 = j * 64;
                } else {
                    const bf16_t* base = p.PROJ + ((size_t)NTP + b * 4) * PS + C_SLC + g * 64;
                    B.kb = base; B.vb = base + 256; B.stride = PS; B.f32 = 0; B.count = 4; B.pos0 = 2048;
                }
                attend_block<false>(B, qpos, qs, slope, m, l, o, lane);
            }
#pragma unroll
            for (int r = 0; r < 4; ++r) res[0][r] = o[r] / l[r];
        }
        {
            float m[4], l[4], o[4];
#pragma unroll
            for (int r = 0; r < 4; ++r) { m[r] = -INFINITY; l[r] = 0.f; o[r] = 0.f; }
            if (prompt) {
                const int lo = (t - 511 > 0 ? t - 511 : 0) >> 6, hi = t >> 6;
                for (int j = lo; j <= hi; ++j) {
                    KBlock B; const bf16_t* base = p.PROJ + ((size_t)b * 4096 + j * 64) * PS + C_WIN + g * 64;
                    B.kb = base; B.vb = base + 256; B.stride = PS; B.f32 = 0; B.count = 64; B.pos0 = j * 64;
                    attend_block<true>(B, qpos, qs, slope, m, l, o, lane);
                }
            } else {
                for (int j = 0; j < 8; ++j) {
                    KBlock B; const float* base = p.cache_win + ((size_t)b * 512 + j * 64) * 512 + g * 64;
                    B.kb = base; B.vb = base + 256; B.stride = 512; B.f32 = 1; B.count = 64; B.pos0 = 1536 + j * 64;
                    attend_block<true>(B, qpos, qs, slope, m, l, o, lane);
                }
                KBlock B; const bf16_t* base = p.PROJ + ((size_t)NTP + b * 4) * PS + C_WIN + g * 64;
                B.kb = base; B.vb = base + 256; B.stride = PS; B.f32 = 0; B.count = 4; B.pos0 = 2048;
                attend_block<true>(B, qpos, qs, slope, m, l, o, lane);
            }
#pragma unroll
            for (int r = 0; r < 4; ++r) res[1][r] = o[r] / l[r];
        }
        const float* gt = p.SM + (size_t)row * 64 + 8;
#pragma unroll
        for (int r = 0; r < 4; ++r) {
            const float g0 = sigmoidf_(gt[g * 4 + r]), g1 = sigmoidf_(gt[16 + g * 4 + r]), g2 = sigmoidf_(gt[32 + g * 4 + r]);
            const float oc = p.OCMP[(size_t)row * 1024 + (g * 4 + r) * 64 + lane];
            p.YB[(size_t)row * 1024 + (g * 4 + r) * 64 + lane] = f2bf(g0 * oc + g1 * res[0][r] + g2 * res[1][r]);
        }
    }
}

typedef float f32x16 __attribute__((ext_vector_type(16)));
typedef short s16x4 __attribute__((ext_vector_type(4)));
typedef __attribute__((address_space(3))) const char* lds_cptr;
#define MFMA32(a, b, c) __builtin_amdgcn_mfma_f32_32x32x16_bf16(a, b, c, 0, 0, 0)
DEVI int crow(int r, int hi) { return (r & 3) + 8 * (r >> 2) + 4 * hi; }
DEVI unsigned cvtpk(float lo, float hi) { return pack2(lo, hi); }
DEVI s16x4 vtr(lds_cptr p) { return __builtin_bit_cast(s16x4, __builtin_amdgcn_ds_read_tr16_b64_v4i16((__attribute__((address_space(3))) s16x4*)p)); }
DEVI float half_max(float m) { auto rr = __builtin_amdgcn_permlane32_swap(__float_as_uint(m), __float_as_uint(m), false, false); return fmaxf(__uint_as_float(rr[0]), __uint_as_float(rr[1])); }
DEVI float half_sum(float m) { auto rr = __builtin_amdgcn_permlane32_swap(__float_as_uint(m), __float_as_uint(m), false, false); return __uint_as_float(rr[0]) + __uint_as_float(rr[1]); }

struct BlkDesc { const char* k; int stride_bytes; int f32; int count; int pos0; };
DEVI void blk_load(const BlkDesc& d, int tid, u32x4& rk, u32x4& rv) {
    const int key = tid & 63, chunk = tid >> 6;
    rk = (u32x4){0u, 0u, 0u, 0u}; rv = rk;
    if (key < d.count) {
        const char* kr = d.k + (size_t)key * d.stride_bytes;
        if (d.f32) {
            const f32x4* s1 = (const f32x4*)(kr + chunk * 32); const f32x4* s2 = (const f32x4*)(kr + 1024 + chunk * 32);
            rk = pack8f(s1[0], s1[1]); rv = pack8f(s2[0], s2[1]);
        } else { rk = *(const u32x4*)(kr + chunk * 16); rv = *(const u32x4*)(kr + 512 + chunk * 16); }
    }
}
DEVI void blk_store(char* kimg, char* vimg, int tid, const u32x4& rk, const u32x4& rv) {
    const int key = tid & 63, chunk = tid >> 6;
    *(u32x4*)(kimg + chunk * 1024 + key * 16) = rk;
    *(u32x4*)(vimg + (chunk >> 2) * 4096 + key * 64 + (chunk & 3) * 16) = rv;
}

DEVI void attn_tile(const char* kimg, const char* vimg, const bf16x8 (&qr)[4], float& m2, float& lsum, f32x16& o0, f32x16& o1, f32x16& s0, f32x16& s1,
                    float sl, float bb, int lh, int ll, bool fast, float* wsf_hi  , float* wsf_r  , int lane) {
    const int r32 = lane & 31, hi = lane >> 5;
    const f32x16 z = {};
    s0 = z; s1 = z;
    {
        const char* kp = kimg + hi * 1024 + r32 * 16;
#pragma unroll
        for (int d0 = 0; d0 < 4; ++d0) {
            const bf16x8 k0 = *(const bf16x8*)(kp + d0 * 2048), k1 = *(const bf16x8*)(kp + d0 * 2048 + 512);
            s0 = MFMA32(k0, qr[d0], s0); s1 = MFMA32(k1, qr[d0], s1);
        }
    }
    float mx = -1e30f;
    if (fast) {
#pragma unroll
        for (int r = 0; r < 16; ++r) {
            const int c = (r & 3) + 8 * (r >> 2);
            s0[r] = fmaf(s0[r], 1.4426950408889634f, fmaf(sl, (float)c, bb)); s1[r] = fmaf(s1[r], 1.4426950408889634f, fmaf(sl, (float)(c + 32), bb));
            mx = fmaxf(mx, fmaxf(s0[r], s1[r]));
        }
    } else {
#pragma unroll
        for (int r = 0; r < 16; ++r) {
            const int c = (r & 3) + 8 * (r >> 2);
            const float t0 = fmaf(s0[r], 1.4426950408889634f, fmaf(sl, (float)c, bb)), t1 = fmaf(s1[r], 1.4426950408889634f, fmaf(sl, (float)(c + 32), bb));
            s0[r] = (c <= lh && c > ll) ? t0 : -INFINITY; s1[r] = (c + 32 <= lh && c + 32 > ll) ? t1 : -INFINITY;
            mx = fmaxf(mx, fmaxf(s0[r], s1[r]));
        }
    }
    mx = half_max(mx);
    const float mnew = fmaxf(m2, mx);
    const float f = __builtin_amdgcn_exp2f(m2 - mnew);
    m2 = mnew;
    float ps = 0.f;
#pragma unroll
    for (int r = 0; r < 16; ++r) { s0[r] = __builtin_amdgcn_exp2f(s0[r] - mnew); s1[r] = __builtin_amdgcn_exp2f(s1[r] - mnew); ps += s0[r] + s1[r]; }
    lsum = lsum * f + ps;
    if (__any(f != 1.f)) {
        if (hi == 0) *wsf_r = f;
        asm volatile("s_waitcnt lgkmcnt(0)" ::: "memory");
#pragma unroll
        for (int a = 0; a < 4; ++a) {
            const f32x4 fv = *(const f32x4*)(wsf_hi + 8 * a);
#pragma unroll
            for (int k = 0; k < 4; ++k) { o0[4 * a + k] *= fv[k]; o1[4 * a + k] *= fv[k]; }
        }
        asm volatile("s_waitcnt lgkmcnt(0)" ::: "memory");
    }
    u32x4 pw[4];
#pragma unroll
    for (int k = 0; k < 4; ++k) { pw[0][k] = cvtpk(s0[2 * k], s0[2 * k + 1]); pw[1][k] = cvtpk(s0[8 + 2 * k], s0[8 + 2 * k + 1]); pw[2][k] = cvtpk(s1[2 * k], s1[2 * k + 1]); pw[3][k] = cvtpk(s1[8 + 2 * k], s1[8 + 2 * k + 1]); }
    const lds_cptr vp = (lds_cptr)vimg + ((lane >> 4) & 1) * 32 + (lane & 3) * 8 + (4 * hi + ((lane & 15) >> 2)) * 64;
#pragma unroll
    for (int i = 0; i < 8; ++i) {
        const s16x4 lo = vtr(vp + ((i >> 2) * 4096 + (i & 3) * 1024)), hh = vtr(vp + ((i >> 2) * 4096 + (i & 3) * 1024 + 512));
        const bf16x8 vf = (bf16x8){lo[0], lo[1], lo[2], lo[3], hh[0], hh[1], hh[2], hh[3]};
        const bf16x8 pf = __builtin_bit_cast(bf16x8, pw[i & 3]);
        if (i < 4) o0 = MFMA32(pf, vf, o0); else o1 = MFMA32(pf, vf, o1);
    }
}

constexpr int NSA_KV0 = 0, NSA_KV1 = 16384, NSA_WSF = 32768, NSA_IMP = NSA_WSF + 2048, NSA_SEL = NSA_IMP + 16384, NSA_LIST = NSA_SEL + 512, NSA_OST = NSA_LIST + 256, NSA_YAC = NSA_OST + 32768, NSA_LDS = NSA_YAC + 65536;
static_assert(NSA_LDS <= 152 * 1024, "lds");

DEVI BlkDesc nsa_desc(const P& p, bool prompt, int b, int g, int branch, int j) {
    BlkDesc d;
    if (prompt) {
        if (branch == 0) { d.k = (const char*)(p.KC + ((size_t)(b * 64) * 512 + g * 64)); d.stride_bytes = 2048; d.f32 = 1; d.count = 64; d.pos0 = 0; }
        else { d.k = (const char*)(p.PROJ + ((size_t)b * 4096 + j * 64) * PS + (branch == 1 ? C_SLC : C_WIN) + g * 64); d.stride_bytes = PS * 2; d.f32 = 0; d.count = 64; d.pos0 = j * 64; }
    } else {
        if (branch == 0) { d.k = (const char*)(p.KC + ((size_t)(256 + b * 32) * 512 + g * 64)); d.stride_bytes = 2048; d.f32 = 1; d.count = 32; d.pos0 = 0; }
        else if (branch == 1 && j < 32) { const int page = p.page_table[b * 16 + (j >> 1)]; d.k = (const char*)(p.cache_slc + ((size_t)page * 128 + (j & 1) * 64) * 512 + g * 64); d.stride_bytes = 2048; d.f32 = 1; d.count = 64; d.pos0 = j * 64; }
        else if (branch == 2 && j < 8) { d.k = (const char*)(p.cache_win + ((size_t)b * 512 + j * 64) * 512 + g * 64); d.stride_bytes = 2048; d.f32 = 1; d.count = 64; d.pos0 = 1536 + j * 64; }
        else { d.k = (const char*)(p.PROJ + ((size_t)NTP + b * 4) * PS + (branch == 1 ? C_SLC : C_WIN) + g * 64); d.stride_bytes = PS * 2; d.f32 = 0; d.count = 4; d.pos0 = 2048; }
    }
    return d;
}

constexpr int NS_IMG = 0, NS_WSF = 131072, NS_IMP = NS_WSF + 2048, NS_SEL = NS_IMP + 2048, NS_LIST = NS_SEL + 64, NS_YC = NS_LIST + 64, NS_PM = NS_YC + 4096, NS_Q = NS_PM + 2048, NS_LDS = NS_Q + 4096;
static_assert(NS_LDS <= 152 * 1024, "lds");
DEVI void wave_stage_block(const BlkDesc& d, char* kimg, char* vimg, int lane) {
    asm volatile("" : "+v"(lane));
    const int rsub = lane >> 4, pc = lane & 15;
    if (d.f32) {
#pragma unroll
        for (int half = 0; half < 2; ++half) {
#pragma unroll
            for (int i0 = 0; i0 < 16; i0 += 6) {
                f32x4 x[6];
#pragma unroll
                for (int i = 0; i < 6; ++i) if (i0 + i < 16) { const int row = 4 * (i0 + i) + rsub; x[i] = row < d.count ? __builtin_nontemporal_load((const f32x4*)(d.k + (size_t)row * d.stride_bytes + half * 1024 + pc * 16)) : (f32x4){0.f, 0.f, 0.f, 0.f}; }
#pragma unroll
                for (int i = 0; i < 6; ++i) if (i0 + i < 16) {
                    const int row = 4 * (i0 + i) + rsub, c = pc >> 1;
                    u32x2 o; o.x = pack2(x[i][0], x[i][1]); o.y = pack2(x[i][2], x[i][3]);
                    if (half == 0) *(u32x2*)(kimg + c * 1024 + row * 16 + (pc & 1) * 8) = o;
                    else *(u32x2*)(vimg + (c >> 2) * 4096 + row * 64 + (c & 3) * 16 + (pc & 1) * 8) = o;
                }
            }
        }
    } else {
        const int row = lane >> 3, c = lane & 7;
#pragma unroll
        for (int i = 0; i < 8; ++i) {
            const int rr = 8 * i + row;
            u32x4 kk = {0u, 0u, 0u, 0u}, vv = {0u, 0u, 0u, 0u};
            if (rr < d.count) { kk = *(const u32x4*)(d.k + (size_t)rr * d.stride_bytes + c * 16); vv = *(const u32x4*)(d.k + (size_t)rr * d.stride_bytes + 512 + c * 16); }
            *(u32x4*)(kimg + c * 1024 + rr * 16) = kk;
            *(u32x4*)(vimg + (c >> 2) * 4096 + rr * 64 + (c & 3) * 16) = vv;
        }
    }
    asm volatile("s_waitcnt lgkmcnt(0)" ::: "memory");
}

DEVI void nsa_sample_unit(const P& p, char* smem, int us) {
    const int tid = tid_opq(), lane = tid & 63, wid = tid >> 6, r32 = lane & 31, hi = lane >> 5;
    const int b = us >> 2, g = us & 3;
    const size_t rowbase = (size_t)NTP + b * 4;
    char* kimg = smem + NS_IMG + wid * 16384; char* vimg = kimg + 8192;
    float* wsf = (float*)(smem + NS_WSF) + wid * 64;
    float* impb = (float*)(smem + NS_IMP);
    unsigned long long* selm = (unsigned long long*)(smem + NS_SEL);
    unsigned char* blist = (unsigned char*)(smem + NS_LIST);
    float* ycmp = (float*)(smem + NS_YC);
    const int tokl = r32 >> 2, head = r32 & 3;
    const bool tok_ok = r32 < 16;
    const int qpos = 2048 + tokl;
    const float slope2 = alibi_slope(g * 4 + head) * 1.4426950408889634f;
    char* qsh = smem + NS_Q;
    int hi4 = 4 * hi; asm volatile("" : "+v"(hi4));
    float* wsf_hi = wsf + hi4; float* wsf_r = wsf + r32;
    f32x16 s0, s1;
    __syncthreads();
    if (wid == 0) {
        bf16x8 qr[4];
        {
            const bf16_t* qp = p.PROJ + (rowbase + (tok_ok ? tokl : 0)) * PS + C_BQ + (g * 4 + head) * 64 + hi * 8;
#pragma unroll
            for (int d0 = 0; d0 < 4; ++d0) {
                u32x4 v = *(const u32x4*)(qp + d0 * 16);
#pragma unroll
                for (int k = 0; k < 4; ++k) { const float lo = __uint_as_float(v[k] << 16) * 0.125f, hh = __uint_as_float(v[k] & 0xFFFF0000u) * 0.125f; v[k] = tok_ok ? ((__float_as_uint(lo) >> 16) | (__float_as_uint(hh) & 0xFFFF0000u)) : 0u; }
                qr[d0] = __builtin_bit_cast(bf16x8, v);
                *(u32x4*)(qsh + d0 * 1024 + lane * 16) = v;
            }
        }
        f32x16 o0 = {}, o1 = {}; float m2 = -1e30f, lsum = 0.f;
        const BlkDesc d = nsa_desc(p, false, b, g, 0, 0);
        wave_stage_block(d, kimg, vimg, lane);
        const int lh = 31 - hi4;
        const float sl = 64.f * slope2;
        attn_tile(kimg, vimg, qr, m2, lsum, o0, o1, s0, s1, sl, tok_ok ? sl * (float)(hi4 - 32) : -INFINITY, lh, -1000, false, wsf_hi, wsf_r, lane);
        const float lt = half_sum(lsum);
        const float inv = lt > 0.f ? 1.f / lt : 0.f;
        float* ib = impb + (r32 >> 2) * 64 + hi4;
#pragma unroll
        for (int r = 0; r < 16; ++r) {
            float a = s0[r] * inv, c = s1[r] * inv;
            a += __shfl_xor(a, 1); a += __shfl_xor(a, 2); c += __shfl_xor(c, 1); c += __shfl_xor(c, 2);
            if (head == 0) { ib[(r & 3) + 8 * (r >> 2)] = a; ib[(r & 3) + 8 * (r >> 2) + 32] = c; }
        }
        float fac = 0.f;
        if (tok_ok && lt > 0.f) fac = sigmoidf_(p.SM[(rowbase + tokl) * 64 + 8 + g * 4 + head]) / lt;
        if (hi == 0) *wsf_r = fac;
        asm volatile("s_waitcnt lgkmcnt(0)" ::: "memory");
#pragma unroll
        for (int a = 0; a < 2; ++a) {
            const f32x4 fv = *(const f32x4*)(wsf_hi + 8 * a);
#pragma unroll
            for (int k = 0; k < 4; ++k) { float* yp = ycmp + (8 * a + k + hi4) * 64 + r32; yp[0] = o0[4 * a + k] * fv[k]; yp[32] = o1[4 * a + k] * fv[k]; }
        }
        asm volatile("s_waitcnt lgkmcnt(0)" ::: "memory");
#pragma unroll 1
        for (int tl = 0; tl < 4; ++tl) {
            const int j = lane;
            float v = impb[tl * 64 + j];
            if (j == 32 || j == 0) v = 5.0f;
            if (j > 32) v = -2.0f;
            impb[tl * 64 + j] = v;
            asm volatile("s_waitcnt lgkmcnt(0)" ::: "memory");
            int rank = 0;
#pragma unroll 8
            for (int jj = 0; jj < 64; ++jj) { const float u = impb[tl * 64 + jj]; rank += (u > v || (u == v && jj < j)) ? 1 : 0; }
            const unsigned long long mask = __ballot(rank < 16 && j < 33);
            if (lane == 0) selm[tl] = mask;
        }
        asm volatile("s_waitcnt lgkmcnt(0)" ::: "memory");
        if (lane == 0) {
            unsigned long long u = selm[0] | selm[1] | selm[2] | selm[3];
            int n = 0;
            while (u) { const int j = __builtin_ctzll(u); u &= u - 1; blist[1 + n++] = (unsigned char)(0x40 | j); }
            for (int j = 0; j <= 8; ++j) blist[1 + n++] = (unsigned char)(0x80 | j);
            blist[0] = (unsigned char)n;
        }
    }
    __syncthreads();
    const int nb = blist[0];
    const unsigned long long mysel = tok_ok ? selm[tokl] : 0ull;
    int nslc = 0;
    for (int i = 0; i < nb; ++i) nslc += (blist[1 + i] >> 6) == 1 ? 1 : 0;
    float so[16], ms, lst;
    float wo[16], mw, lwt;
#pragma unroll 1
    for (int pass = 0; pass < 2; ++pass) {
        f32x16 o0 = {}, o1 = {}; float m2 = -1e30f, lsum = 0.f;
        const int i0 = pass == 0 ? 0 : nslc, i1 = pass == 0 ? nslc : nb;
#pragma unroll 1
        for (int i = i0 + wid; i < i1; i += 8) {
            const int e = blist[1 + i], br = e >> 6, j = e & 63;
            const BlkDesc d = nsa_desc(p, false, b, g, br, j);
            wave_stage_block(d, kimg, vimg, lane);
            asm volatile("" : "+v"(hi4));
            const bool lsel = tok_ok && (br == 2 || ((mysel >> j) & 1ull));
            const int rel = qpos - d.pos0;
            const int lh = (rel < d.count - 1 ? rel : d.count - 1) - hi4;
            const int ll = (br == 2 ? rel - 512 : -1000) - hi4;
            const bool fast = __all(!lsel || (lh >= 59 && ll < 0));
            const float bb = lsel ? slope2 * (float)(hi4 + d.pos0 - 2048) : -INFINITY;
            bf16x8 qr[4];
#pragma unroll
            for (int d0 = 0; d0 < 4; ++d0) qr[d0] = *(const bf16x8*)(qsh + d0 * 1024 + lane * 16);
            attn_tile(kimg, vimg, qr, m2, lsum, o0, o1, s0, s1, slope2, bb, lh, ll, fast, wsf_hi, wsf_r, lane);
        }
        const float lt = half_sum(lsum);
        if (pass == 0) { ms = m2; lst = lt;
#pragma unroll
            for (int r = 0; r < 8; ++r) { so[r] = o0[r]; so[8 + r] = o1[r]; } }
        else { mw = m2; lwt = lt;
#pragma unroll
            for (int r = 0; r < 8; ++r) { wo[r] = o0[r]; wo[8 + r] = o1[r]; } }
    }
    {
        float* po = (float*)kimg;
        float* pm = (float*)(smem + NS_PM) + wid * 64;
        if (lane < 16) { pm[lane * 2] = ms; pm[lane * 2 + 1] = lst; pm[32 + lane * 2] = mw; pm[32 + lane * 2 + 1] = lwt; }
#pragma unroll
        for (int a = 0; a < 2; ++a)
#pragma unroll
            for (int k = 0; k < 4; ++k) {
                float* yp = po + (8 * a + k + hi4) * 64 + r32;
                yp[0] = so[4 * a + k]; yp[32] = so[8 + 4 * a + k]; yp[1024] = wo[4 * a + k]; yp[1024 + 32] = wo[8 + 4 * a + k];
            }
    }
    __syncthreads();
    {
        const int row = tid >> 5, dcol = tid & 31, tk = row >> 2, hd = row & 3;
        float res[2][2];
#pragma unroll
        for (int br = 0; br < 2; ++br) {
            float M = -1e30f;
#pragma unroll
            for (int w = 0; w < 8; ++w) M = fmaxf(M, ((const float*)(smem + NS_PM))[w * 64 + br * 32 + row * 2]);
            float L = 0.f, a0 = 0.f, a1 = 0.f;
#pragma unroll
            for (int w = 0; w < 8; ++w) {
                const float* pmw = (const float*)(smem + NS_PM) + w * 64 + br * 32 + row * 2;
                const float f = __builtin_amdgcn_exp2f(pmw[0] - M);
                const float* pow_ = (const float*)(smem + NS_IMG + w * 16384) + br * 1024 + row * 64 + dcol;
                L += pmw[1] * f; a0 += pow_[0] * f; a1 += pow_[32] * f;
            }
            const float gate = sigmoidf_(p.SM[(rowbase + tk) * 64 + 8 + (br + 1) * 16 + g * 4 + hd]);
            const float sc = L > 0.f ? gate / L : 0.f;
            res[br][0] = a0 * sc; res[br][1] = a1 * sc;
        }
        const float y0 = ycmp[row * 64 + dcol] + res[0][0] + res[1][0], y1 = ycmp[row * 64 + dcol + 32] + res[0][1] + res[1][1];
        bf16_t* yb = p.YB + (rowbase + tk) * 1024 + (g * 4 + hd) * 64;
        yb[dcol] = f2bf(y0); yb[dcol + 32] = f2bf(y1);
    }
}

constexpr int NP_KVB = 18432, NP_KV0 = 0, NP_KV1 = NP_KVB, NP_WSF = 2 * NP_KVB, NP_IMP = NP_WSF + 2048, NP_SEL = NP_IMP + 16384, NP_LIST = NP_SEL + 512, NP_YAC = NP_LIST + 256, NP_LDS = NP_YAC + 65536;
static_assert(NP_LDS <= 152 * 1024, "lds");
DEVI void blk_store_ext(const BlkDesc& d, int pstep, int poff, int t0, char* kimg, char* vimg, int tid, const u32x4& rk, const u32x4& rv) {
    const int key = tid & 63, chunk = tid >> 6;
    *(u32x4*)(kimg + chunk * 1024 + key * 16) = rk;
    *(u32x4*)(vimg + (chunk >> 2) * 4096 + key * 64 + (chunk & 3) * 16) = rv;
    if (chunk == 0) {
        const int rel = d.pos0 + key * pstep + poff - t0;
        const int phi = (rel >> 6) << 6, plo = rel & 63;
        const unsigned bh = pack2((float)phi, (float)phi), bl = pack2((float)plo, (float)plo);
        *(u32x4*)(kimg + 8 * 1024 + key * 16) = (u32x4){bh, bl, 0x00003F80u, 0u};
    }
}
DEVI void attn_tile2(const char* kimg, const char* vimg, const bf16x8 (&qr)[4], const bf16x8 qext, float& m, float& lsum, f32x16& o0, f32x16& o1, f32x16& s0, f32x16& s1,
                     int lh, int ll, bool fast, float* wsf_hi, float* wsf_r, int lane) {
    const int r32 = lane & 31, hi = lane >> 5;
    const f32x16 z = {};
    s0 = z; s1 = z;
    {
        const char* kp = kimg + hi * 1024 + r32 * 16;
#pragma unroll
        for (int d0 = 0; d0 < 5; ++d0) {
            const bf16x8 k0 = *(const bf16x8*)(kp + d0 * 2048), k1 = *(const bf16x8*)(kp + d0 * 2048 + 512);
            const bf16x8 qf = d0 < 4 ? qr[d0 < 4 ? d0 : 0] : qext;
            s0 = MFMA32(k0, qf, s0); s1 = MFMA32(k1, qf, s1);
        }
    }
    if (!fast) {
#pragma unroll
        for (int r = 0; r < 16; ++r) {
            const int c = (r & 3) + 8 * (r >> 2);
            s0[r] = (c <= lh && c > ll) ? s0[r] : -INFINITY; s1[r] = (c + 32 <= lh && c + 32 > ll) ? s1[r] : -INFINITY;
        }
    }
    float mx = fmaxf(s0[0], s1[0]);
#pragma unroll
    for (int r = 1; r < 16; ++r) mx = fmaxf(mx, fmaxf(s0[r], s1[r]));
    mx = half_max(mx);
    const float mnew = fmaxf(m, mx);
    const float f = __builtin_amdgcn_exp2f((m - mnew) * 1.4426950408889634f);
    m = mnew;
    const float nm2 = -mnew * 1.4426950408889634f;
    float ps = 0.f;
#pragma unroll
    for (int r = 0; r < 16; ++r) { s0[r] = __builtin_amdgcn_exp2f(fmaf(s0[r], 1.4426950408889634f, nm2)); s1[r] = __builtin_amdgcn_exp2f(fmaf(s1[r], 1.4426950408889634f, nm2)); ps += s0[r] + s1[r]; }
    lsum = lsum * f + ps;
    if (__any(f != 1.f)) {
        if (hi == 0) *wsf_r = f;
        asm volatile("s_waitcnt lgkmcnt(0)" ::: "memory");
#pragma unroll
        for (int a = 0; a < 4; ++a) {
            const f32x4 fv = *(const f32x4*)(wsf_hi + 8 * a);
#pragma unroll
            for (int k = 0; k < 4; ++k) { o0[4 * a + k] *= fv[k]; o1[4 * a + k] *= fv[k]; }
        }
        asm volatile("s_waitcnt lgkmcnt(0)" ::: "memory");
    }
    u32x4 pw[4];
#pragma unroll
    for (int k = 0; k < 4; ++k) { pw[0][k] = cvtpk(s0[2 * k], s0[2 * k + 1]); pw[1][k] = cvtpk(s0[8 + 2 * k], s0[8 + 2 * k + 1]); pw[2][k] = cvtpk(s1[2 * k], s1[2 * k + 1]); pw[3][k] = cvtpk(s1[8 + 2 * k], s1[8 + 2 * k + 1]); }
    const lds_cptr vp = (lds_cptr)vimg + ((lane >> 4) & 1) * 32 + (lane & 3) * 8 + (4 * hi + ((lane & 15) >> 2)) * 64;
#pragma unroll
    for (int i = 0; i < 8; ++i) {
        const s16x4 lo = vtr(vp + ((i >> 2) * 4096 + (i & 3) * 1024)), hh = vtr(vp + ((i >> 2) * 4096 + (i & 3) * 1024 + 512));
        const bf16x8 vf = (bf16x8){lo[0], lo[1], lo[2], lo[3], hh[0], hh[1], hh[2], hh[3]};
        const bf16x8 pf = __builtin_bit_cast(bf16x8, pw[i & 3]);
        if (i < 4) o0 = MFMA32(pf, vf, o0); else o1 = MFMA32(pf, vf, o1);
    }
}

DEVI void attn_tile3(const char* kA, const char* vA, const char* kB, const char* vB, const bf16x8 (&qr)[4], const bf16x8 qeA, const bf16x8 qeB, float& m, float& lsum,
                     f32x16& o0, f32x16& o1, int lhA, int llA, bool fastA, int lhB, int llB, bool fastB, float* wsf_hi, float* wsf_r, int lane) {
    const int r32 = lane & 31, hi = lane >> 5;
    f32x16 a0 = {}, a1 = {}, b0 = {}, b1 = {};
    {
        const char* kpa = kA + hi * 1024 + r32 * 16; const char* kpb = kB + hi * 1024 + r32 * 16;
#pragma unroll
        for (int d0 = 0; d0 < 5; ++d0) {
            const bf16x8 ka0 = *(const bf16x8*)(kpa + d0 * 2048), ka1 = *(const bf16x8*)(kpa + d0 * 2048 + 512);
            const bf16x8 kb0 = *(const bf16x8*)(kpb + d0 * 2048), kb1 = *(const bf16x8*)(kpb + d0 * 2048 + 512);
            const bf16x8 qa = d0 < 4 ? qr[d0 < 4 ? d0 : 0] : qeA, qb = d0 < 4 ? qr[d0 < 4 ? d0 : 0] : qeB;
            a0 = MFMA32(ka0, qa, a0); a1 = MFMA32(ka1, qa, a1); b0 = MFMA32(kb0, qb, b0); b1 = MFMA32(kb1, qb, b1);
        }
    }
    if (!fastA) {
#pragma unroll
        for (int r = 0; r < 16; ++r) { const int c = (r & 3) + 8 * (r >> 2); a0[r] = (c <= lhA && c > llA) ? a0[r] : -INFINITY; a1[r] = (c + 32 <= lhA && c + 32 > llA) ? a1[r] : -INFINITY; }
    }
    if (!fastB) {
#pragma unroll
        for (int r = 0; r < 16; ++r) { const int c = (r & 3) + 8 * (r >> 2); b0[r] = (c <= lhB && c > llB) ? b0[r] : -INFINITY; b1[r] = (c + 32 <= lhB && c + 32 > llB) ? b1[r] : -INFINITY; }
    }
    float mx = fmaxf(fmaxf(a0[0], a1[0]), fmaxf(b0[0], b1[0]));
#pragma unroll
    for (int r = 1; r < 16; ++r) mx = fmaxf(mx, fmaxf(fmaxf(a0[r], a1[r]), fmaxf(b0[r], b1[r])));
    mx = half_max(mx);
    const float mnew = fmaxf(m, mx);
    const float f = __builtin_amdgcn_exp2f((m - mnew) * 1.4426950408889634f);
    m = mnew;
    const float nm2 = -mnew * 1.4426950408889634f;
    float ps = 0.f;
#pragma unroll
    for (int r = 0; r < 16; ++r) {
        a0[r] = __builtin_amdgcn_exp2f(fmaf(a0[r], 1.4426950408889634f, nm2)); a1[r] = __builtin_amdgcn_exp2f(fmaf(a1[r], 1.4426950408889634f, nm2));
        b0[r] = __builtin_amdgcn_exp2f(fmaf(b0[r], 1.4426950408889634f, nm2)); b1[r] = __builtin_amdgcn_exp2f(fmaf(b1[r], 1.4426950408889634f, nm2));
        ps += (a0[r] + a1[r]) + (b0[r] + b1[r]);
    }
    lsum = lsum * f + ps;
    if (__any(f != 1.f)) {
        if (hi == 0) *wsf_r = f;
        asm volatile("s_waitcnt lgkmcnt(0)" ::: "memory");
#pragma unroll
        for (int a = 0; a < 4; ++a) {
            const f32x4 fv = *(const f32x4*)(wsf_hi + 8 * a);
#pragma unroll
            for (int k = 0; k < 4; ++k) { o0[4 * a + k] *= fv[k]; o1[4 * a + k] *= fv[k]; }
        }
        asm volatile("s_waitcnt lgkmcnt(0)" ::: "memory");
    }
    const int voff = ((lane >> 4) & 1) * 32 + (lane & 3) * 8 + (4 * hi + ((lane & 15) >> 2)) * 64;
#pragma unroll
    for (int t = 0; t < 2; ++t) {
        const f32x16& p0 = t == 0 ? a0 : b0; const f32x16& p1 = t == 0 ? a1 : b1;
        u32x4 pw[4];
#pragma unroll
        for (int k = 0; k < 4; ++k) { pw[0][k] = cvtpk(p0[2 * k], p0[2 * k + 1]); pw[1][k] = cvtpk(p0[8 + 2 * k], p0[8 + 2 * k + 1]); pw[2][k] = cvtpk(p1[2 * k], p1[2 * k + 1]); pw[3][k] = cvtpk(p1[8 + 2 * k], p1[8 + 2 * k + 1]); }
        const lds_cptr vp = (lds_cptr)(t == 0 ? vA : vB) + voff;
#pragma unroll
        for (int i = 0; i < 8; ++i) {
            const s16x4 lo = vtr(vp + ((i >> 2) * 4096 + (i & 3) * 1024)), hh = vtr(vp + ((i >> 2) * 4096 + (i & 3) * 1024 + 512));
            const bf16x8 vf = (bf16x8){lo[0], lo[1], lo[2], lo[3], hh[0], hh[1], hh[2], hh[3]};
            const bf16x8 pf = __builtin_bit_cast(bf16x8, pw[i & 3]);
            if (i < 4) o0 = MFMA32(pf, vf, o0); else o1 = MFMA32(pf, vf, o1);
        }
    }
}

constexpr int NQ_KVB = 18432, NQ_WSF = 4 * NQ_KVB, NQ_SEL = NQ_WSF + 2048, NQ_LIST = NQ_SEL + 512, NQ_YAC = NQ_LIST + 256, NQ_LDS = NQ_YAC + 65536, NQ_IMP = 2 * NQ_KVB;
static_assert(NQ_LDS <= 152 * 1024, "lds");
DEVI void nsa_prompt_unit(const P& p, char* smem, int unit) {
    const int tid = tid_opq(), lane = tid & 63, wid = tid >> 6, r32 = lane & 31, hi = lane >> 5;
    float* wsf = (float*)(smem + NQ_WSF) + wid * 64;
    float* impb = (float*)(smem + NQ_IMP) + wid * 512;
    unsigned long long* selm = (unsigned long long*)(smem + NQ_SEL);
    unsigned char* blist = (unsigned char*)(smem + NQ_LIST);
    const int b = unit >> 8, g = ((unit >> 6) + b) & 3, qt = (b & 1) ? 63 - (unit & 63) : (unit & 63), t0 = qt * 64;
    const size_t rowbase = (size_t)b * 4096 + t0;
    const int tokl = wid * 8 + (r32 >> 2), head = r32 & 3;
    const int qpos = t0 + tokl;
    const float slope = alibi_slope(g * 4 + head);
    bf16x8 qr[4];
    {
        const bf16_t* qp = p.PROJ + (rowbase + tokl) * PS + C_BQ + (g * 4 + head) * 64 + hi * 8;
#pragma unroll
        for (int d0 = 0; d0 < 4; ++d0) {
            u32x4 v = *(const u32x4*)(qp + d0 * 16);
#pragma unroll
            for (int k = 0; k < 4; ++k) { const float lo = __uint_as_float(v[k] << 16) * 0.125f, hh = __uint_as_float(v[k] & 0xFFFF0000u) * 0.125f; v[k] = (__float_as_uint(lo) >> 16) | (__float_as_uint(hh) & 0xFFFF0000u); }
            qr[d0] = __builtin_bit_cast(bf16x8, v);
        }
    }
    unsigned qe_w;
    { const unsigned sh = (unsigned)f2bf(slope); const float rem = slope - __uint_as_float(sh << 16); qe_w = sh | ((unsigned)f2bf(rem) << 16); if (hi) qe_w = 0u; }
    int hi4 = 4 * hi; asm volatile("" : "+v"(hi4));
    float* yl = (float*)(smem + NQ_YAC) + wid * 2048 + hi4 * 64 + r32;
    float* wsf_hi = wsf + hi4; float* wsf_r = wsf + r32;
    f32x16 o0, o1; float m, lsum;
    auto finish = [&](int br) {
        const float lt = half_sum(lsum);
        float fac = 0.f;
        if (lt > 0.f) fac = sigmoidf_(p.SM[(rowbase + tokl) * 64 + 8 + br * 16 + g * 4 + head]) / lt;
        if (hi == 0) *wsf_r = fac;
        asm volatile("s_waitcnt lgkmcnt(0)" ::: "memory");
#pragma unroll
        for (int a = 0; a < 4; ++a) {
            const f32x4 fv = *(const f32x4*)(wsf_hi + 8 * a);
#pragma unroll
            for (int k = 0; k < 4; ++k) {
                float* yp = yl + (8 * a + k) * 64;
                if (br == 0) { yp[0] = o0[4 * a + k] * fv[k]; yp[32] = o1[4 * a + k] * fv[k]; }
                else { yp[0] += o0[4 * a + k] * fv[k]; yp[32] += o1[4 * a + k] * fv[k]; }
            }
        }
        asm volatile("s_waitcnt lgkmcnt(0)" ::: "memory");
    };
    __syncthreads();
    if (tid < 64) *(u32x4*)(smem + 9 * 1024 + tid * 16) = (u32x4){0u, 0u, 0u, 0u};
    {
        const BlkDesc d = nsa_desc(p, true, b, g, 0, 0);
        u32x4 rk, rv; blk_load(d, tid, rk, rv); blk_store_ext(d, 64, 63, t0, smem, smem + 10240, tid, rk, rv);
        __syncthreads();
        o0 = (f32x16){}; o1 = (f32x16){}; m = -1e30f; lsum = 0.f;
        f32x16 s0, s1;
        {
            const int nv = ((qpos + 1) >> 6) - 1;
            const int lh = (nv < 63 ? nv : 63) - hi4;
            const bf16x8 qext = __builtin_bit_cast(bf16x8, (u32x4){qe_w, qe_w, 0u, 0u});
            attn_tile2(smem, smem + 10240, qr, qext, m, lsum, o0, o1, s0, s1, lh, -1000, false, wsf_hi, wsf_r, lane);
        }
        const float lt = half_sum(lsum);
        const float inv = lt > 0.f ? 1.f / lt : 0.f;
        float* ib = impb + (r32 >> 2) * 64 + hi4;
#pragma unroll
        for (int r = 0; r < 16; ++r) {
            float a = s0[r] * inv, c = s1[r] * inv;
            a += __shfl_xor(a, 1); a += __shfl_xor(a, 2); c += __shfl_xor(c, 1); c += __shfl_xor(c, 2);
            if (head == 0) { ib[(r & 3) + 8 * (r >> 2)] = a; ib[(r & 3) + 8 * (r >> 2) + 32] = c; }
        }
        asm volatile("s_waitcnt lgkmcnt(0)" ::: "memory");
        finish(0);
#pragma unroll 1
        for (int tl = 0; tl < 8; ++tl) {
            const int j = lane;
            float v = impb[tl * 64 + j];
            if (j == qt || j == 0) v = 5.0f;
            if (j > qt) v = -1.0f;
            impb[tl * 64 + j] = v;
            asm volatile("s_waitcnt lgkmcnt(0)" ::: "memory");
            int rank = 0;
#pragma unroll 8
            for (int jj = 0; jj < 64; ++jj) { const float u = impb[tl * 64 + jj]; rank += (u > v || (u == v && jj < j)) ? 1 : 0; }
            const unsigned long long mask = __ballot(rank < 16);
            if (lane == 0) selm[wid * 8 + tl] = mask;
        }
    }
    __syncthreads();
    if (wid == 0) {
        unsigned long long u = selm[lane];
#pragma unroll
        for (int o = 32; o > 0; o >>= 1) u |= __shfl_xor(u, o);
        u &= (qt == 63) ? ~0ull : ((1ull << (qt + 1)) - 1ull);
        if (lane == 0) {
            int n = 0;
            while (u) { const int j = __builtin_ctzll(u); u &= u - 1; blist[2 + n++] = (unsigned char)j; }
            blist[0] = (unsigned char)n;
            int nw = 0;
            for (int j = (qt - 8 > 0 ? qt - 8 : 0); j <= qt; ++j) blist[2 + n + nw++] = (unsigned char)j;
            blist[1] = (unsigned char)nw;
        }
    }
    __syncthreads();
    if (tid >= 64 && tid < 256) *(u32x4*)(smem + (tid >> 6) * NQ_KVB + 9 * 1024 + (tid & 63) * 16) = (u32x4){0u, 0u, 0u, 0u};
    const int ns = blist[0], nw = blist[1];
    const int nss = (ns + 1) >> 1, nsteps = nss + ((nw + 1) >> 1);
    const unsigned long long mysel = selm[tokl];
    {
        auto step_blocks = [&](int s, int& br, int& jA, int& jB) {
            if (s < nss) { br = 1; jA = blist[2 + 2 * s]; jB = 2 * s + 1 < ns ? (int)blist[2 + 2 * s + 1] : -1; }
            else { const int w = s - nss; br = 2; jA = blist[2 + ns + 2 * w]; jB = 2 * w + 1 < nw ? (int)blist[2 + ns + 2 * w + 1] : -1; }
        };
        u32x4 rkA, rvA, rkB, rvB;
        auto load_step = [&](int s) {
            int br, jA, jB; step_blocks(s, br, jA, jB);
            const BlkDesc dA = nsa_desc(p, true, b, g, br, jA); blk_load(dA, tid, rkA, rvA);
            if (jB >= 0) { const BlkDesc dB = nsa_desc(p, true, b, g, br, jB); blk_load(dB, tid, rkB, rvB); }
        };
        auto store_step = [&](int s, char* buf) {
            int br, jA, jB; step_blocks(s, br, jA, jB);
            BlkDesc dA; dA.pos0 = jA * 64; blk_store_ext(dA, 1, 0, t0, buf, buf + 10240, tid, rkA, rvA);
            if (jB >= 0) { BlkDesc dB; dB.pos0 = jB * 64; blk_store_ext(dB, 1, 0, t0, buf + NQ_KVB, buf + NQ_KVB + 10240, tid, rkB, rvB); }
        };
        load_step(0); store_step(0, smem);
        __syncthreads();
        int prev_br = 1;
        o0 = (f32x16){}; o1 = (f32x16){}; m = -1e30f; lsum = 0.f;
        for (int s = 0; s < nsteps; ++s) {
            int br, jA, jB; step_blocks(s, br, jA, jB);
            char* cur = smem + (s & 1) * 2 * NQ_KVB;
            char* nxt = smem + ((s & 1) ^ 1) * 2 * NQ_KVB;
            if (s + 1 < nsteps) load_step(s + 1);
            if (br != prev_br) { finish(1); o0 = (f32x16){}; o1 = (f32x16){}; m = -1e30f; lsum = 0.f; prev_br = br; }
            {
                asm volatile("" : "+v"(hi4));
                const bool lselA = br == 2 || ((mysel >> jA) & 1ull);
                const int relA = qpos - jA * 64;
                const int lhA = (relA < 63 ? relA : 63) - hi4, llA = (br == 2 ? relA - 512 : -1000) - hi4;
                const bool fastA = __all(!lselA || (lhA >= 59 && llA < 0));
                const bool needA = __any(lselA && lhA + hi4 >= 0 && llA + hi4 < 63);
                const bf16x8 qeA = __builtin_bit_cast(bf16x8, (u32x4){qe_w, qe_w, (lselA || hi) ? 0u : 0x0000C6EAu, 0u});
                bool needB = false; bool lselB = false; int lhB = -1000, llB = -1000; bool fastB = false;
                if (jB >= 0) {
                    lselB = br == 2 || ((mysel >> jB) & 1ull);
                    const int relB = qpos - jB * 64;
                    lhB = (relB < 63 ? relB : 63) - hi4; llB = (br == 2 ? relB - 512 : -1000) - hi4;
                    fastB = __all(!lselB || (lhB >= 59 && llB < 0));
                    needB = __any(lselB && lhB + hi4 >= 0 && llB + hi4 < 63);
                }
                const bf16x8 qeB = __builtin_bit_cast(bf16x8, (u32x4){qe_w, qe_w, (lselB || hi) ? 0u : 0x0000C6EAu, 0u});
                f32x16 s0, s1;
                if (needA && needB) attn_tile3(cur, cur + 10240, cur + NQ_KVB, cur + NQ_KVB + 10240, qr, qeA, qeB, m, lsum, o0, o1, lhA, llA, fastA, lhB, llB, fastB, wsf_hi, wsf_r, lane);
                else if (needA) attn_tile2(cur, cur + 10240, qr, qeA, m, lsum, o0, o1, s0, s1, lhA, llA, fastA, wsf_hi, wsf_r, lane);
                else if (needB) attn_tile2(cur + NQ_KVB, cur + NQ_KVB + 10240, qr, qeB, m, lsum, o0, o1, s0, s1, lhB, llB, fastB, wsf_hi, wsf_r, lane);
            }
            if (s + 1 < nsteps) store_step(s + 1, nxt);
            __syncthreads();
        }
        finish(2);
    }
    {
        const float* yac = (const float*)(smem + NQ_YAC) + wid * 2048;
#pragma unroll
        for (int i = 0; i < 4; ++i) {
            const int orow = i * 8 + (lane >> 3), ch = lane & 7, tk = wid * 8 + (orow >> 2), hd = orow & 3;
            const f32x4 a = *(const f32x4*)(yac + orow * 64 + ch * 8), c = *(const f32x4*)(yac + orow * 64 + ch * 8 + 4);
            *(u32x4*)(p.YB + (rowbase + tk) * 1024 + (g * 4 + hd) * 64 + ch * 8) = pack8f(a, c);
        }
        asm volatile("s_waitcnt lgkmcnt(0)" ::: "memory");
    }
}

DEVI void stage_nsa_attn(const P& p, char* smem, int bid, int nblk) {
#ifndef NSA_REP
#define NSA_REP 0
#endif
    const int n_units = 1024 + 512 + (NSA_REP == 1 ? 1024 : 0) + (NSA_REP == 2 ? 512 : 0);
    for (int unit0 = bid; unit0 < n_units; unit0 += nblk) {
        const int unit = unit0 < 1536 ? unit0 : (NSA_REP == 1 ? unit0 - 1536 : unit0 - 512);
        if (unit < 1024) nsa_prompt_unit(p, smem, unit); else nsa_sample_unit(p, smem, unit - 1024);
    }
}

DEVI void stage_ln1(const P& p, int bid, int nblk) {
    const int lane = tid_opq() & 63, wid = tid_opq() >> 6;
    for (int row = bid * 8 + wid; row < NT; row += nblk * 8) {
        f32x4 x[4];
        float s = 0.f;
#pragma unroll
        for (int i = 0; i < 4; ++i) { x[i] = *(const f32x4*)(p.R + (size_t)row * 1024 + i * 256 + lane * 4); s += x[i][0] + x[i][1] + x[i][2] + x[i][3]; }
        const float mean = wave_sum(s) * (1.f / 1024.f);
        float q = 0.f;
#pragma unroll
        for (int i = 0; i < 4; ++i)
#pragma unroll
            for (int k = 0; k < 4; ++k) q += (x[i][k] - mean) * (x[i][k] - mean);
        const float rs = rsqrtf(wave_sum(q) * (1.f / 1024.f) + LN_EPS);
#pragma unroll
        for (int i = 0; i < 4; ++i) {
            const int c = i * 256 + lane * 4;
            const f32x4 gg = *(const f32x4*)(p.ln1_g + c), bb = *(const f32x4*)(p.ln1_b + c);
            f32x4 y;
#pragma unroll
            for (int k = 0; k < 4; ++k) y[k] = (x[i][k] - mean) * rs * gg[k] + bb[k];
            u32x2 o; o.x = pack2(y[0], y[1]); o.y = pack2(y[2], y[3]);
            *(u32x2*)(p.HB + (size_t)row * 1024 + c) = o;
        }
        if (lane == 0) { p.H[(size_t)row * 2] = mean; p.H[(size_t)row * 2 + 1] = rs; }
    }
}

__device__ const unsigned char PEER_CA[50] = {0,0,0,0,0,0,0,0,0,0,0,0,0,0,0,0, 1,1,1,1,1,1,1,1, 2,2,2,2,2, 3,3,3,3, 4,4,4, 5,5, 6,6, 7,7, 8,9,10,11,12,13,14,15};
__device__ const unsigned char PEER_CB[50] = {0,1,2,3,4,5,6,7,8,9,10,11,12,13,14,15, 0,1,2,3,4,5,6,7, 0,1,2,3,4, 0,1,2,3, 0,1,2, 0,1, 0,1, 0,1, 0,0,0,0,0,0,0,0};

DEVI void ce_desc(unsigned& a, unsigned& b) { const unsigned hi = a > b ? a : b, lo = a > b ? b : a; a = hi; b = lo; }
template <int BASE> DEVI void sort16_desc(unsigned (&x)[64]) {
#pragma unroll
    for (int k = 2; k <= 16; k <<= 1)
#pragma unroll
        for (int j = k >> 1; j > 0; j >>= 1)
#pragma unroll
            for (int i = 0; i < 16; ++i) {
                const int l = i ^ j;
                if (l > i) { if ((i & k) == 0) ce_desc(x[BASE + i], x[BASE + l]); else ce_desc(x[BASE + l], x[BASE + i]); }
            }
}
DEVI void merge_top16(const unsigned* a, const unsigned* b, unsigned* t) {
    unsigned c[16];
#pragma unroll
    for (int i = 0; i < 16; ++i) c[i] = a[i] > b[15 - i] ? a[i] : b[15 - i];
#pragma unroll
    for (int j = 8; j > 0; j >>= 1)
#pragma unroll
        for (int i = 0; i < 16; ++i) { const int l = i ^ j; if (l > i) ce_desc(c[i], c[l]); }
#pragma unroll
    for (int i = 0; i < 16; ++i) t[i] = c[i];
}
DEVI float key_score(unsigned k) { const unsigned u = k & ~127u; return __uint_as_float((u & 0x80000000u) ? (u & 0x7FFFFFFFu) : ~u); }

DEVI void sort8_desc(unsigned (&x)[16]) {
#pragma unroll
    for (int k = 2; k <= 8; k <<= 1)
#pragma unroll
        for (int j = k >> 1; j > 0; j >>= 1)
#pragma unroll
            for (int i = 0; i < 8; ++i) {
                const int l = i ^ j;
                if (l > i) { if ((i & k) == 0) ce_desc(x[i], x[l]); else ce_desc(x[l], x[i]); }
            }
}
DEVI unsigned sum_key(unsigned ka, unsigned kb, unsigned tag) {
    const unsigned u = __float_as_uint(key_score(ka) + key_score(kb));
    const unsigned o = (u & 0x80000000u) ? ~u : (u | 0x80000000u);
    return (o & ~255u) | tag;
}
DEVI float key_score8(unsigned k) { const unsigned u = k & ~255u; return __uint_as_float((u & 0x80000000u) ? (u & 0x7FFFFFFFu) : ~u); }

DEVI void route_top16(const P& p, int row, int ph, int c, int r32, int hi, int hi4, unsigned (&fin)[16]) {
    f32x16 acc[4];
#pragma unroll
    for (int t = 0; t < 4; ++t) acc[t] = (f32x16){};
    const bf16_t* qp = p.PQ + (size_t)row * 2048 + ph * 256 + c * 128 + hi * 8;
    const bf16_t* kp = p.KEYSB + ((size_t)((ph * 2 + c) * 128 + r32)) * 128 + hi * 8;
#pragma unroll
    for (int s8 = 0; s8 < 8; ++s8) {
        const bf16x8 qf = *(const bf16x8*)(qp + s8 * 16);
#pragma unroll
        for (int t = 0; t < 4; ++t) {
            const bf16x8 kf = *(const bf16x8*)(kp + (size_t)t * 32 * 128 + s8 * 16);
            acc[t] = MFMA32(kf, qf, acc[t]);
        }
    }
    unsigned x[64];
#pragma unroll
    for (int t = 0; t < 4; ++t)
#pragma unroll
        for (int r = 0; r < 16; ++r) {
            const unsigned u = __float_as_uint(acc[t][r]);
            const unsigned o = (u & 0x80000000u) ? ~u : (u | 0x80000000u);
            x[t * 16 + r] = (o & ~127u) | (unsigned)(127 - ((r & 3) + 8 * (r >> 2) + 32 * t) - hi4);
        }
    sort16_desc<0>(x); sort16_desc<16>(x); sort16_desc<32>(x); sort16_desc<48>(x);
    unsigned t01[16], t23[16], tt[16], oth[16];
    merge_top16(&x[0], &x[16], t01); merge_top16(&x[32], &x[48], t23); merge_top16(t01, t23, tt);
#pragma unroll
    for (int i = 0; i < 16; ++i) { auto rr = __builtin_amdgcn_permlane32_swap(tt[i], tt[i], false, false); oth[i] = hi ? rr[0] : rr[1]; }
    merge_top16(tt, oth, fin);
}

DEVI void stage_peer_route(const P& p, char* smem, int bid, int nblk, int p0, int p1) {
    const int lane = tid_opq() & 63, wid = tid_opq() >> 6, r32 = lane & 31, hi = lane >> 5;
    unsigned char* tb = (unsigned char*)smem + wid * 1024 + r32 * 32;
    const int tpw = (NT + nblk - 1) / nblk, row_lo = bid * tpw, row_hi = (row_lo + tpw < NT) ? row_lo + tpw : NT;
    const int ph = wid;
    for (int pass = p0; pass < p1 && row_lo + pass * 32 < row_hi; ++pass) {
        const int row_raw = row_lo + pass * 32 + r32;
        const bool row_ok = row_raw < row_hi;
        const int row = row_ok ? row_raw : row_lo;
        int hi4 = 4 * hi; asm volatile("" : "+v"(hi4));
        unsigned fa[16], fb[16];
        route_top16(p, row, ph, 0, r32, hi, hi4, fa);
        asm volatile("" : "+v"(hi4));
        route_top16(p, row, ph, 1, r32, hi, hi4, fb);
        if (hi == 0) {
            u32x4 wa, wb;
#pragma unroll
            for (int i = 0; i < 4; ++i) {
                wa[i] = (127u - (fa[4 * i] & 127u)) | ((127u - (fa[4 * i + 1] & 127u)) << 8) | ((127u - (fa[4 * i + 2] & 127u)) << 16) | ((127u - (fa[4 * i + 3] & 127u)) << 24);
                wb[i] = (127u - (fb[4 * i] & 127u)) | ((127u - (fb[4 * i + 1] & 127u)) << 8) | ((127u - (fb[4 * i + 2] & 127u)) << 16) | ((127u - (fb[4 * i + 3] & 127u)) << 24);
            }
            *(u32x4*)tb = wa; *(u32x4*)(tb + 16) = wb;
        }
        unsigned g0[16], g1[16], g2[16], g3[16];
#pragma unroll
        for (int j = 0; j < 16; ++j) g0[j] = sum_key(fa[0], fb[j], (unsigned)j);
#pragma unroll
        for (int k = 0; k < 15; ++k) g1[k] = sum_key(fa[k + 1], fb[0], (unsigned)((k + 1) << 4));
        g1[15] = 0u;
#pragma unroll
        for (int j = 1; j < 8; ++j) g2[j - 1] = sum_key(fa[1], fb[j], (unsigned)(16 | j));
        g2[7] = 0u; g2[8] = 0u; g2[9] = 0u;
#pragma unroll
        for (int i = 2; i < 8; ++i) g2[17 - i] = sum_key(fa[i], fb[1], (unsigned)((i << 4) | 1));
#pragma unroll
        for (int j = 8; j > 0; j >>= 1)
#pragma unroll
            for (int i = 0; i < 16; ++i) { const int l = i ^ j; if (l > i) ce_desc(g2[i], g2[l]); }
        g3[0] = sum_key(fa[2], fb[2], 0x22u); g3[1] = sum_key(fa[2], fb[3], 0x23u); g3[2] = sum_key(fa[2], fb[4], 0x24u);
        g3[3] = sum_key(fa[3], fb[2], 0x32u); g3[4] = sum_key(fa[4], fb[2], 0x42u); g3[5] = sum_key(fa[3], fb[3], 0x33u);
#pragma unroll
        for (int i = 6; i < 16; ++i) g3[i] = 0u;
        sort8_desc(g3);
        unsigned t01[16], t23[16], top[16];
        merge_top16(g0, g1, t01); merge_top16(g2, g3, t23); merge_top16(t01, t23, top);
        float ev[16]; float sum = 0.f;
        const float vmax = key_score8(top[0]);
#pragma unroll
        for (int k = 0; k < 16; ++k) { ev[k] = __expf(key_score8(top[k]) - vmax); sum += ev[k]; }
        const float inv = 1.f / sum;
        asm volatile("s_waitcnt lgkmcnt(0)" ::: "memory");
        if (!row_ok) {   } else if (hi == 0) {
            int* dst = p.EIDX + (size_t)row * 128 + ph * 16;
#pragma unroll
            for (int q4 = 0; q4 < 4; ++q4) {
                u32x4 o;
#pragma unroll
                for (int k = 0; k < 4; ++k) { const unsigned tg = top[q4 * 4 + k] & 255u; o[k] = (unsigned)tb[tg >> 4] * 128u + (unsigned)tb[16 + (tg & 15u)]; }
                *(u32x4*)(dst + q4 * 4) = o;
            }
        } else {
            float* dst = p.EGATE + (size_t)row * 128 + ph * 16;
#pragma unroll
            for (int q4 = 0; q4 < 4; ++q4) *(f32x4*)(dst + q4 * 4) = (f32x4){ev[q4 * 4] * inv, ev[q4 * 4 + 1] * inv, ev[q4 * 4 + 2] * inv, ev[q4 * 4 + 3] * inv};
        }
        asm volatile("s_waitcnt lgkmcnt(0)" ::: "memory");
    }
}

constexpr int PA_WAVE_LDS = 1024 + 1024 + 512 + 512 + 512;
DEVI void stage_peer_apply(const P& p, char* smem, int bid, int nblk, int p0, int p1) {
    const int lane = tid_opq() & 63, wid = tid_opq() >> 6;
    char* wl = smem + wid * PA_WAVE_LDS;
    unsigned char* hhi = (unsigned char*)wl; unsigned char* hlo = hhi + 1024;
    int* idxs = (int*)(wl + 2048);
    float* gts = (float*)(wl + 2560);
    float* cs = (float*)(wl + 3072);
    const int fr = lane & 15, fq = lane >> 4;
    const int tpw = (NT + nblk - 1) / nblk, row_lo = bid * tpw, row_hi = (row_lo + tpw < NT) ? row_lo + tpw : NT;
    for (int row = row_lo + p0 * 32 + wid; row < row_hi && row < row_lo + p1 * 32; row += 8) {
        float hv[16];
        {
            const float* hr = p.R + (size_t)row * 1024 + lane * 16;
            const float mean1 = p.H[(size_t)row * 2], rs1 = p.H[(size_t)row * 2 + 1];
            u32x4 ohi, olo;
#pragma unroll
            for (int i = 0; i < 4; ++i) {
                f32x4 x = *(const f32x4*)(hr + i * 4);
                { const f32x4 g1 = *(const f32x4*)(p.ln1_g + lane * 16 + i * 4), b1 = *(const f32x4*)(p.ln1_b + lane * 16 + i * 4);
#pragma unroll
                  for (int k = 0; k < 4; ++k) x[k] = (x[k] - mean1) * rs1 * g1[k] + b1[k]; }
#pragma unroll
                for (int k = 0; k < 4; ++k) hv[i * 4 + k] = x[k];
                int w = __builtin_amdgcn_cvt_pk_fp8_f32(x[0], x[1], 0, false); w = __builtin_amdgcn_cvt_pk_fp8_f32(x[2], x[3], w, true);
                const f32x2 d01 = __builtin_amdgcn_cvt_pk_f32_fp8(w, false), d23 = __builtin_amdgcn_cvt_pk_f32_fp8(w, true);
                int w2 = __builtin_amdgcn_cvt_pk_fp8_f32(x[0] - d01[0], x[1] - d01[1], 0, false); w2 = __builtin_amdgcn_cvt_pk_fp8_f32(x[2] - d23[0], x[3] - d23[1], w2, true);
                ohi[i] = (unsigned)w; olo[i] = (unsigned)w2;
            }
            *(u32x4*)(hhi + lane * 16) = ohi; *(u32x4*)(hlo + lane * 16) = olo;
            idxs[lane] = p.EIDX[(size_t)row * 128 + lane]; idxs[lane + 64] = p.EIDX[(size_t)row * 128 + 64 + lane];
            gts[lane] = p.EGATE[(size_t)row * 128 + lane]; gts[lane + 64] = p.EGATE[(size_t)row * 128 + 64 + lane];
            asm volatile("s_waitcnt lgkmcnt(0)" ::: "memory");
        }
        {
            u32x4 a0[16], a1[16];
            auto issue_u = [&](int g, u32x4 (&a)[16]) {
                const unsigned char* ub = p.U8 + (size_t)idxs[g * 16 + fr] * 1024 + fq * 16;
#pragma unroll
                for (int s2 = 0; s2 < 16; ++s2) a[s2] = *(const u32x4*)(ub + s2 * 64);
            };
            auto consume_u = [&](int g, const u32x4 (&a)[16]) {
                f32x4 acc = (f32x4){0.f, 0.f, 0.f, 0.f};
#pragma unroll
                for (int s2 = 0; s2 < 16; ++s2) {
                    const u32x4 bh = *(const u32x4*)(hhi + s2 * 64 + fq * 16), bl = *(const u32x4*)(hlo + s2 * 64 + fq * 16);
                    const long x0 = (long)(((unsigned long long)a[s2][1] << 32) | a[s2][0]), x1 = (long)(((unsigned long long)a[s2][3] << 32) | a[s2][2]);
                    const long h0 = (long)(((unsigned long long)bh[1] << 32) | bh[0]), h1 = (long)(((unsigned long long)bh[3] << 32) | bh[2]);
                    const long l0 = (long)(((unsigned long long)bl[1] << 32) | bl[0]), l1 = (long)(((unsigned long long)bl[3] << 32) | bl[2]);
                    acc = __builtin_amdgcn_mfma_f32_16x16x32_fp8_fp8(x0, h0, acc, 0, 0, 0);
                    acc = __builtin_amdgcn_mfma_f32_16x16x32_fp8_fp8(x1, h1, acc, 0, 0, 0);
                    acc = __builtin_amdgcn_mfma_f32_16x16x32_fp8_fp8(x0, l0, acc, 0, 0, 0);
                    acc = __builtin_amdgcn_mfma_f32_16x16x32_fp8_fp8(x1, l1, acc, 0, 0, 0);
                }
                const f32x4 gg = *(const f32x4*)(gts + g * 16 + fq * 4);
                f32x4 cv;
#pragma unroll
                for (int r = 0; r < 4; ++r) {
                    const int e = idxs[g * 16 + fq * 4 + r];
                    const float d = acc[r] * p.US[e];
                    cv[r] = gg[r] * p.VS[e] * 0.5f * d * (1.f + erff(d * 0.7071067811865476f));
                }
                if (fr == 0) *(f32x4*)(cs + g * 16 + fq * 4) = cv;
            };
            issue_u(0, a0);
#pragma unroll 1
            for (int g = 0; g < 8; g += 2) {
                issue_u(g + 1, a1);
                consume_u(g, a0);
                if (g + 2 < 8) issue_u(g + 2, a0);
                consume_u(g + 1, a1);
            }
        }
        asm volatile("s_waitcnt lgkmcnt(0)" ::: "memory");
        float acc[16];
#pragma unroll
        for (int i = 0; i < 16; ++i) acc[i] = 0.f;
        {
            u32x4 v0[8], v1[8];
            auto issue_v = [&](int e0, u32x4 (&v)[8]) {
#pragma unroll
                for (int k = 0; k < 8; ++k) v[k] = *(const u32x4*)(p.V8 + (size_t)idxs[e0 + k] * 1024 + lane * 16);
            };
            auto consume_v = [&](int e0, const u32x4 (&v)[8]) {
#pragma unroll
                for (int k = 0; k < 8; ++k) {
                    const float c = cs[e0 + k];
#pragma unroll
                    for (int w = 0; w < 4; ++w) {
                        const f32x2 lo = __builtin_amdgcn_cvt_pk_f32_fp8((int)v[k][w], false), hh = __builtin_amdgcn_cvt_pk_f32_fp8((int)v[k][w], true);
                        acc[w * 4] += c * lo[0]; acc[w * 4 + 1] += c * lo[1]; acc[w * 4 + 2] += c * hh[0]; acc[w * 4 + 3] += c * hh[1];
                    }
                }
            };
            issue_v(0, v0);
#pragma unroll 1
            for (int e0 = 0; e0 < 128; e0 += 16) {
                issue_v(e0 + 8, v1);
                consume_v(e0, v0);
                if (e0 + 16 < 128) issue_v(e0 + 16, v0);
                consume_v(e0 + 8, v1);
            }
        }
        float s = 0.f;
#pragma unroll
        for (int i = 0; i < 16; ++i) { acc[i] += DN_ALPHA * hv[i]; s += acc[i]; }
        const float mean = wave_sum(s) * (1.f / 1024.f);
        float q = 0.f;
#pragma unroll
        for (int i = 0; i < 16; ++i) q += (acc[i] - mean) * (acc[i] - mean);
        const float rs = rsqrtf(wave_sum(q) * (1.f / 1024.f) + LN_EPS);
#pragma unroll
        for (int i = 0; i < 4; ++i) {
            const int c = lane * 16 + i * 4;
            const f32x4 g0 = *(const f32x4*)(p.ln2_g + c), b0 = *(const f32x4*)(p.ln2_b + c);
            f32x4 y0;
#pragma unroll
            for (int k = 0; k < 4; ++k) y0[k] = (acc[i * 4 + k] - mean) * rs * g0[k] + b0[k];
            *(f32x4*)(p.out + O_Y + (size_t)row * 1024 + c) = y0;
        }
    }
}

namespace pg8 {
#define PG8_LAS __attribute__((address_space(3)))
typedef unsigned short bf16_t;
typedef short bf16x8 __attribute__((ext_vector_type(8)));
typedef float f32x4 __attribute__((ext_vector_type(4)));
typedef unsigned u32x4 __attribute__((ext_vector_type(4)));
constexpr int BM = 256, BK = 64, HALF = 128, HTB = HALF * BK * 2  , STAGE_BYTES = 8 * HTB, NXCD = 8, WGM = 8;

__host__ __device__ __forceinline__ int lds_byte(int r, int c) { const int st = (r >> 4) * 2 + (c >> 5), rr = r & 15, cc = c & 31, ob = rr * 64 + cc * 2; return st * 1024 + (ob ^ (((ob >> 9) & 1) << 5)); }
__host__ __device__ __forceinline__ void stage_rc(int b, int& R, int& C) { const int st = b / 1024, sb = b % 1024, swz = sb ^ (((sb >> 9) & 1) << 5); R = (st >> 1) * 16 + swz / 64; C = (st & 1) * 32 + (swz % 64) / 2; }
__host__ __device__ __forceinline__ int perm32(int rho) { const int n = rho >> 4, i = rho & 15; return 8 * (i >> 2) + 4 * n + (i & 3); }

struct Unit { int pm, pn; };
struct Gemm { const bf16_t* A; const bf16_t* Bt; int M, N, K; };

struct StaticOrder {
    int nM, nN, nwg, G, c;
    __host__ __device__ void init(int M, int N, int G_, int c_) { nM = M / BM; nN = N / BM; nwg = nM * nN; G = G_; c = c_; }
    __host__ __device__ bool next(int i, Unit& u) const {
        const long L = (long)i * G + c; if (L >= nwg) return false;
        int wgid = (int)L; { const int q = nwg / NXCD, r = nwg % NXCD, xcd = wgid % NXCD, off = wgid / NXCD; wgid = (xcd < r ? xcd * (q + 1) : r * (q + 1) + (xcd - r) * q) + off; }
        const int nig = WGM * nN, gid = wgid / nig, fm = gid * WGM, gsz = (nM - fm) < WGM ? (nM - fm) : WGM;
        u.pm = fm + ((wgid % nig) % gsz); u.pn = (wgid % nig) / gsz; return true;
    }
    __device__ __forceinline__ void a_ready(const Unit&) const {}
    __device__ __forceinline__ void done(const Unit&) const {}
};
template <class Epi, class Sched, bool STAMP = false>
__device__ __forceinline__ void gemm_phase(PG8_LAS unsigned char* lds, const Gemm g, const Sched& S, const Epi& E, unsigned long long* stamps) {
    const int tid = tid_opq(), wid = __builtin_amdgcn_readfirstlane(tid >> 6), lane = tid & 63, wr = wid >> 2, wc = wid & 3, fr = lane & 15, fq = lane >> 4;
    const int K = g.K, nt = K / BK;
    int ts_lo = 0, ts_hi = 0, nts = 0; const unsigned long long rt_entry = STAMP ? (unsigned long long)wall_clock64() : 0ull;
#define PG8_STAMP() do { if (STAMP && wid == 0 && nts < 64) { const unsigned long long _c = (unsigned long long)clock64(); \
        ts_lo = (lane == nts) ? (int)(unsigned)_c : ts_lo; ts_hi = (lane == nts) ? (int)(unsigned)(_c >> 32) : ts_hi; ++nts; } } while (0)
    PG8_STAMP();
    unsigned voffA[2], voffB[2];
#pragma unroll
    for (int i = 0; i < 2; ++i) { int R, C; stage_rc(tid * 16 + i * 8192, R, C); const int Rb = Epi::PERM ? ((R & ~31) + perm32(R & 31)) : R;
        voffA[i] = (unsigned)(R * K + C) * 2u; voffB[i] = (unsigned)(Rb * K + C) * 2u; }
    const size_t kstep = (size_t)(BK * 2);
    const size_t hstep = (size_t)HALF * K * 2;
    const size_t tstep = 2 * hstep;
    const unsigned ldsw = (unsigned)wid * 1024u;
    const int aoff = lds_byte(wr * 64 + fr, fq * 8), boff = lds_byte(wc * 32 + fr, fq * 8);
#define PG8_SA(b, h) (((b) * 2 + (h)) * HTB)
#define PG8_SB(b, h) ((4 + (b) * 2 + (h)) * HTB)
#define PG8_STAGE(bufoff, gbase, voff) do { _Pragma("unroll") for (int _i = 0; _i < 2; ++_i) \
        __builtin_amdgcn_global_load_lds((const unsigned*)((const char*)(gbase) + (voff)[_i]), (PG8_LAS unsigned*)(lds + (bufoff) + ldsw + _i * 8192), 16, 0, 0); } while (0)
#define PG8_LDA(dst, b, h) do { _Pragma("unroll") for (int m = 0; m < 4; ++m) _Pragma("unroll") for (int k = 0; k < 2; ++k) dst[m][k] = *(const PG8_LAS bf16x8*)(lds + PG8_SA(b, h) + aoff + m * 2048 + k * 1024); } while (0)
#define PG8_LDB(dst, b, h) do { _Pragma("unroll") for (int n = 0; n < 2; ++n) _Pragma("unroll") for (int k = 0; k < 2; ++k) dst[n][k] = *(const PG8_LAS bf16x8*)(lds + PG8_SB(b, h) + boff + n * 2048 + k * 1024); } while (0)
#define PG8_MMA(ai, bj, At, Bt) do { __builtin_amdgcn_s_setprio(1); _Pragma("unroll") for (int m = 0; m < 4; ++m) _Pragma("unroll") for (int n = 0; n < 2; ++n) _Pragma("unroll") for (int k = 0; k < 2; ++k) \
        acc[ai][bj][m][n] = __builtin_amdgcn_mfma_f32_16x16x32_bf16(Bt[n][k], At[m][k], acc[ai][bj][m][n], 0, 0, 0); __builtin_amdgcn_s_setprio(0); } while (0)
#define PG8_WAIT_V(n) asm volatile("s_waitcnt vmcnt(" #n ")" ::: "memory")
#define PG8_WAIT_L(n) asm volatile("s_waitcnt lgkmcnt(" #n ")" ::: "memory")
#define PG8_BAR __builtin_amdgcn_s_barrier()
#define PG8_SCHED __builtin_amdgcn_sched_barrier(0)
    Unit cur, nxt; int ui = 0;
    if (!S.next(0, cur)) return;
    f32x4 acc[2][2][4][2];
#pragma unroll
    for (int a = 0; a < 2; ++a)
#pragma unroll
        for (int b = 0; b < 2; ++b)
#pragma unroll
            for (int m = 0; m < 4; ++m)
#pragma unroll
                for (int n = 0; n < 2; ++n) acc[a][b][m][n] = (f32x4){0.f, 0.f, 0.f, 0.f};
    bf16x8 At[4][2], B0[2][2], B1[2][2];
    const char* cA = (const char*)g.A + (size_t)cur.pm * tstep; const char* cB = (const char*)g.Bt + (size_t)cur.pn * tstep;
    S.a_ready(cur);
    PG8_STAGE(PG8_SB(0, 0), cB, voffB); PG8_STAGE(PG8_SA(0, 0), cA, voffA); PG8_STAGE(PG8_SB(0, 1), cB + hstep, voffB); PG8_STAGE(PG8_SA(0, 1), cA + hstep, voffA);
    if (wr == 1) PG8_BAR;
    PG8_WAIT_V(4); PG8_BAR;
    PG8_STAGE(PG8_SB(1, 0), cB + kstep, voffB); PG8_STAGE(PG8_SA(1, 0), cA + kstep, voffA); PG8_STAGE(PG8_SB(1, 1), cB + hstep + kstep, voffB);
    PG8_WAIT_V(6); PG8_BAR;
    PG8_STAMP();
    for (;;) {
        const bool has_next = S.next(ui + 1, nxt);
        const char* nA = has_next ? (const char*)g.A + (size_t)nxt.pm * tstep : cA; const char* nB = has_next ? (const char*)g.Bt + (size_t)nxt.pn * tstep : cB;
        for (int t = 0; t < nt; t += 2) {
            const bool last = (t == nt - 2);
            const char* a1 = cA + (size_t)(t + 1) * kstep;
            const char* a2 = last ? nA : cA + (size_t)(t + 2) * kstep; const char* b2 = last ? nB : cB + (size_t)(t + 2) * kstep;
            const char* a3 = a2 + kstep; const char* b3 = b2 + kstep;
            if (last && has_next) S.a_ready(nxt);
            PG8_LDB(B0, 0, 0); PG8_SCHED; PG8_LDA(At, 0, 0); PG8_STAGE(PG8_SA(1, 1), a1 + hstep, voffA);
            PG8_WAIT_L(8); PG8_BAR; PG8_WAIT_L(0); PG8_MMA(0, 0, At, B0); PG8_BAR; PG8_SCHED;
            PG8_LDB(B1, 0, 1); PG8_STAGE(PG8_SB(0, 0), b2, voffB);
            PG8_BAR; PG8_WAIT_L(0); PG8_MMA(0, 1, At, B1); PG8_BAR;
            PG8_LDA(At, 0, 1); PG8_STAGE(PG8_SA(0, 0), a2, voffA);
            PG8_BAR; PG8_WAIT_L(0); PG8_MMA(1, 0, At, B0); PG8_BAR; PG8_SCHED;
            PG8_STAGE(PG8_SB(0, 1), b2 + hstep, voffB);
            PG8_WAIT_V(6); PG8_BAR; PG8_MMA(1, 1, At, B1); PG8_BAR;
            PG8_LDB(B0, 1, 0); PG8_SCHED; PG8_LDA(At, 1, 0); PG8_STAGE(PG8_SA(0, 1), a2 + hstep, voffA);
            PG8_WAIT_L(8); PG8_BAR; PG8_WAIT_L(0); PG8_MMA(0, 0, At, B0); PG8_BAR; PG8_SCHED;
            PG8_LDB(B1, 1, 1); PG8_STAGE(PG8_SB(1, 0), b3, voffB);
            PG8_BAR; PG8_WAIT_L(0); PG8_MMA(0, 1, At, B1); PG8_BAR;
            PG8_LDA(At, 1, 1); PG8_STAGE(PG8_SA(1, 0), a3, voffA);
            PG8_BAR; PG8_WAIT_L(0); PG8_MMA(1, 0, At, B0); PG8_BAR; PG8_SCHED;
            PG8_STAGE(PG8_SB(1, 1), b3 + hstep, voffB);
            PG8_WAIT_V(6); PG8_BAR; PG8_MMA(1, 1, At, B1); PG8_BAR;
        }
        PG8_STAMP();
        if constexpr (!Epi::AFTER_DRAIN) { E(acc, cur, wr, wc, fr, fq); S.done(cur); }
        PG8_STAMP();
        if (!has_next) break;
#pragma unroll
        for (int a = 0; a < 2; ++a)
#pragma unroll
            for (int b = 0; b < 2; ++b)
#pragma unroll
                for (int m = 0; m < 4; ++m)
#pragma unroll
                    for (int n = 0; n < 2; ++n) acc[a][b][m][n] = (f32x4){0.f, 0.f, 0.f, 0.f};
        cur = nxt; cA = nA; cB = nB; ++ui;
    }
    PG8_WAIT_V(0);
    if (wr == 0) PG8_BAR;
    PG8_BAR;
    if constexpr (Epi::AFTER_DRAIN) { E.fused(acc, cur, wr, wc, fr, fq, lds, wid, lane); S.done(cur); }
    PG8_STAMP();
    if (STAMP && wid == 0) { stamps[lane] = lane < nts ? (((unsigned long long)(unsigned)ts_hi << 32) | (unsigned)ts_lo) : 0ull;
        if (lane == 62) stamps[62] = rt_entry; if (lane == 63) stamps[63] = (unsigned long long)wall_clock64(); }
#undef PG8_STAMP
#undef PG8_SA
#undef PG8_SB
#undef PG8_STAGE
#undef PG8_LDA
#undef PG8_LDB
#undef PG8_MMA
#undef PG8_WAIT_V
#undef PG8_WAIT_L
#undef PG8_BAR
#undef PG8_SCHED
}
}

template <class F> struct EpiAdapt {
    static constexpr bool PERM = true, AFTER_DRAIN = false;
    F f;
    __device__ __forceinline__ void operator()(const pg8::f32x4 (&acc)[2][2][4][2], const pg8::Unit& u, int wr, int wc, int fr, int fq) const {
        constexpr int B = F::BATCH;
        const int row0 = u.pm * 256 + wr * 64 + fr, col0 = u.pn * 256 + wc * 32 + 8 * fq;
        f32x4 b0[2], b1[2];
        if constexpr (F::COLBIAS) { f.bias8(col0, b0[0], b1[0]); f.bias8(col0 + 128, b0[1], b1[1]); }
#pragma unroll
        for (int q0 = 0; q0 < 16; q0 += B) {
            typename F::Pre pre[B];
#pragma unroll
            for (int i = 0; i < B; ++i) { const int q = q0 + i, bj = q & 1, m = (q >> 1) & 3, ai = q >> 3; pre[i] = f.pre(row0 + ai * 128 + m * 16, col0 + bj * 128); }
#pragma unroll
            for (int i = 0; i < B; ++i) { const int q = q0 + i, bj = q & 1, m = (q >> 1) & 3, ai = q >> 3;
                f32x4 v0 = acc[ai][bj][m][0], v1 = acc[ai][bj][m][1];
                if constexpr (F::COLBIAS) { v0 += b0[bj]; v1 += b1[bj]; }
                f.put(row0 + ai * 128 + m * 16, col0 + bj * 128, v0, v1, pre[i]); }
        }
    }
};
template <class F>
DEVI void gemm_pg8(const bf16_t* A, const bf16_t* Bt, int M, int N, int K, const F& f, char* smem, int bid, int nblk) {
    pg8::Gemm g{A, Bt, M, N, K};
    pg8::StaticOrder S; S.init(M, N, nblk, bid);
    EpiAdapt<F> E{f};
    __syncthreads();
    pg8::gemm_phase<EpiAdapt<F>, pg8::StaticOrder, false>((PG8_LAS unsigned char*)smem, g, S, E, nullptr);
    __syncthreads();
}

template <class F>
DEVI void gemm_small_rows(const bf16_t* __restrict__ A, const bf16_t* __restrict__ Bt, int N, const F& f, char* smem, int bid, int nblk) {
    const int tid = tid_opq(), lane = tid & 63, wid = tid >> 6, fr = lane & 15, fq = lane >> 4;
    float* part = (float*)smem;
    const int ntn = N / 64, ntiles = (NTS / 32) * ntn;
    for (int tile = bid; tile < ntiles; tile += nblk) {
        const int tm = tile / ntn, tn = tile % ntn;
        const int row0 = NTP + tm * 32, col0 = tn * 64;
        f32x4 acc[2][4];
#pragma unroll
        for (int m = 0; m < 2; ++m)
#pragma unroll
            for (int n = 0; n < 4; ++n) acc[m][n] = (f32x4){0.f, 0.f, 0.f, 0.f};
        const bf16_t* ap = A + (size_t)(row0 + fr) * 1024 + wid * 128 + fq * 8;
        const bf16_t* bp = Bt + (size_t)(col0 + fr) * 1024 + wid * 128 + fq * 8;
        bf16x8 af[4][2], bfr[4][4];
#pragma unroll
        for (int ks = 0; ks < 4; ++ks) {
#pragma unroll
            for (int m = 0; m < 2; ++m) af[ks][m] = *(const bf16x8*)(ap + (size_t)m * 16 * 1024 + ks * 32);
#pragma unroll
            for (int n = 0; n < 4; ++n) bfr[ks][n] = *(const bf16x8*)(bp + (size_t)n * 16 * 1024 + ks * 32);
        }
#pragma unroll
        for (int ks = 0; ks < 4; ++ks)
#pragma unroll
            for (int m = 0; m < 2; ++m)
#pragma unroll
                for (int n = 0; n < 4; ++n) acc[m][n] = __builtin_amdgcn_mfma_f32_16x16x32_bf16(bfr[ks][n], af[ks][m], acc[m][n], 0, 0, 0);
        __syncthreads();
#pragma unroll
        for (int m = 0; m < 2; ++m)
#pragma unroll
            for (int n = 0; n < 4; ++n) *(f32x4*)(part + ((size_t)wid * 32 + m * 16 + fr) * 64 + n * 16 + fq * 4) = acc[m][n];
        __syncthreads();
        if (tid < 256) {
            const int r = tid >> 3, c8 = (tid & 7) * 8;
            f32x4 v0 = {0.f, 0.f, 0.f, 0.f}, v1 = v0;
#pragma unroll
            for (int w = 0; w < 8; ++w) { v0 += *(const f32x4*)(part + ((size_t)w * 32 + r) * 64 + c8); v1 += *(const f32x4*)(part + ((size_t)w * 32 + r) * 64 + c8 + 4); }
            const typename F::Pre pre = f.pre(row0 + r, col0 + c8);
            f.put(row0 + r, col0 + c8, v0, v1, pre);
        }
    }
}
template <class F>
DEVI void gemm_tail(const bf16_t* A, const bf16_t* Bt, int N, const F& f, char* smem, int bid, int nblk) {
    gemm_small_rows(A, Bt, N, f, smem, bid, nblk);
    gemm_pg8(A, Bt, NTP, N, 1024, f, smem, bid, nblk);
}

#define XB_TMO      128
#define XB_XCNT(j)  (256  + 64 * (j))
#define XB_XSUB(j)  (1280 + 64 * (j))
#define XB_XGEN(j)  (2304 + 64 * (j))
#define XB_TOP      3328
#define XB_TOPGEN   3392
#define XCD_BAR_WORDS 3456
#define XB_SPIN_CAP (1u << 18)
#define LAS __attribute__((address_space(3)))

__device__ __forceinline__ unsigned xb_ld(unsigned* p)              { return __hip_atomic_load(p, __ATOMIC_RELAXED, __HIP_MEMORY_SCOPE_AGENT); }
__device__ __forceinline__ unsigned xb_add(unsigned* p, unsigned v) { return __hip_atomic_fetch_add(p, v, __ATOMIC_RELAXED, __HIP_MEMORY_SCOPE_AGENT); }
__device__ __forceinline__ unsigned xb_xcc_id() { return (unsigned)__builtin_amdgcn_s_getreg((3 << 11) | 20) & 0xFu; }
#define XB_SPIN(cond, bar) do { unsigned _sp = 0; while (cond) { __builtin_amdgcn_s_sleep(1); \
    if ((++_sp & 255u) == 0u) { if (xb_ld(&(bar)[XB_TMO])) break; if (_sp > XB_SPIN_CAP) { atomicAdd(&(bar)[XB_TMO], 1u); break; } } } } while (0)

struct XcdBarrier {
    unsigned* bar; unsigned x;
    volatile LAS unsigned* st;
};

__device__ __forceinline__ XcdBarrier xcd_barrier_post(unsigned* bar, volatile LAS unsigned* st) {
    XcdBarrier b; b.bar = bar; b.x = xb_xcc_id(); b.st = st;
    if (tid_opq() == 0) (void)xb_add(&bar[XB_XCNT(b.x)], 1u);
    return b;
}
__device__ __forceinline__ void xcd_barrier_complete(unsigned* bar, unsigned x, unsigned& nloc, unsigned& nx) {
    const unsigned G = gridDim.x * gridDim.y * gridDim.z;
    unsigned sum, cnt, mine, sp = 0u;
    for (;;) {
        sum = 0u; cnt = 0u; mine = 0u;
#pragma unroll
        for (unsigned j = 0; j < 16; ++j) { const unsigned c = xb_ld(&bar[XB_XCNT(j)]); sum += c; cnt += (c > 0u) ? 1u : 0u; mine = (j == x) ? c : mine; }
        if (sum == G) break;
        __builtin_amdgcn_s_sleep(1);
        if ((++sp & 255u) == 0u) { if (xb_ld(&bar[XB_TMO])) break; if (sp > XB_SPIN_CAP) { atomicAdd(&bar[XB_TMO], 1u); break; } }
    }
    nloc = mine > 0u ? mine : 1u; nx = cnt > 0u ? cnt : 1u;
}

__device__ __forceinline__ void xcd_barrier(const XcdBarrier& b) {
    asm volatile("s_waitcnt vmcnt(0)" ::: "memory");
    __syncthreads();
    if (tid_opq() == 0) {
        unsigned* bar = b.bar;
        __builtin_amdgcn_s_waitcnt(0);
        unsigned nloc = b.st[0], nx = b.st[1];
        if (nloc == 0u) { xcd_barrier_complete(bar, b.x, nloc, nx); b.st[0] = nloc; b.st[1] = nx; }
        const unsigned old = xb_add(&bar[XB_XSUB(b.x)], 1u);
        const unsigned gen = old / nloc;
        if (old + 1u == (gen + 1u) * nloc) {
            __builtin_amdgcn_fence(__ATOMIC_RELEASE, "agent");
            asm volatile("s_waitcnt vmcnt(0)" ::: "memory");
            const unsigned og = xb_add(&bar[XB_TOP], 1u);
            const unsigned tg = og / nx;
            if (og + 1u == (tg + 1u) * nx) xb_add(&bar[XB_TOPGEN], 1u);
            else XB_SPIN(xb_ld(&bar[XB_TOPGEN]) == tg, bar);
            __builtin_amdgcn_fence(__ATOMIC_ACQUIRE, "agent");
            xb_add(&bar[XB_XGEN(b.x)], 1u);
            asm volatile("s_waitcnt vmcnt(0)" ::: "memory");
        } else {
            XB_SPIN(xb_ld(&bar[XB_XGEN(b.x)]) == gen, bar);
            __builtin_amdgcn_fence(__ATOMIC_ACQUIRE, "agent");
            asm volatile("s_waitcnt vmcnt(0)" ::: "memory");
        }
    }
    __syncthreads();
}

constexpr int LDS_BYTES = 152 * 1024;

template <int S>
DEVI void run_stage(const P& p, char* smem, int bid, int nblk) {
    if (S == 0) stage_prologue(p, smem, bid, nblk);
    if (S == 1) { EpiInProj e{p}; gemm_pg8(p.XB, p.WINT, NT, NPAD_IN + 2048, 1024, e, smem, bid, nblk); }
    if (S == 2) {
        stage_mlstm_gates(p, smem, bid, nblk);
        if (bid & 1) { stage_mlstm_dc(p, smem, bid, nblk); stage_compress(p, smem, bid, nblk); stage_mlstm_sample(p, smem, bid, nblk); }
        else { stage_compress(p, smem, bid, nblk); stage_mlstm_dc(p, smem, bid, nblk); stage_mlstm_sample(p, smem, bid, nblk); }
    }
    if (S == 4) { stage_mlstm_scan(p, bid, nblk); stage_nsa_attn(p, smem, bid, nblk); }
    if (S == 5) { stage_mlstm_out(p, smem, bid, nblk); { EpiM1 e{p}; gemm_tail(p.YB, p.WBT, 1024, e, smem, bid, nblk); } }
    if (S == 6) { EpiM2 e{p}; gemm_tail(p.YA, p.WAT, 1024, e, smem, bid, nblk); }
    if (S == 8) { EpiR e{p}; gemm_tail(p.MERGED, p.WOT, 1024, e, smem, bid, nblk); }
    if (S == 9) stage_ln1(p, bid, nblk);
    if (S == 10) { EpiPQ e{p}; gemm_tail(p.HB, p.WQT, 2048, e, smem, bid, nblk); }
    if (S == 11) {
        if (bid & 1) {
            for (int ps = 0; ps < 4; ++ps) { stage_peer_route(p, smem, bid, nblk, ps, ps + 1); __threadfence_block(); __syncthreads(); stage_peer_apply(p, smem, bid, nblk, ps, ps + 1); __syncthreads(); }
        } else { stage_peer_route(p, smem, bid, nblk, 0, 64); __threadfence_block(); __syncthreads(); stage_peer_apply(p, smem, bid, nblk, 0, 64); }
    }
}
constexpr int NSTAGES = 13;

template <int S>
__global__ void __launch_bounds__(512, 2) k_stage(P p) {
    extern __shared__ __attribute__((aligned(16))) char smem[];
    run_stage<S>(p, smem, blockIdx.x, gridDim.x);
}


#if MK_ONE_LAUNCH
__global__ void __launch_bounds__(512, 2) k_mega(P p) {
    extern __shared__ __attribute__((aligned(16))) char smem_all[];
    if (tid_opq() == 0) *(u32x4*)smem_all = (u32x4){0u, 0u, 0u, 0u};
    __syncthreads();
    XcdBarrier bar = xcd_barrier_post(p.bar, (volatile LAS unsigned*)smem_all);
    char* smem = smem_all + 16;
    const int bid = blockIdx.x, nblk = gridDim.x;
    run_stage<0>(p, smem, bid, nblk); if ((REP_MASK >> 0) & 1) { xcd_barrier(bar); run_stage<0>(p, smem, bid, nblk); }  xcd_barrier(bar);
    run_stage<1>(p, smem, bid, nblk); if ((REP_MASK >> 1) & 1) { xcd_barrier(bar); run_stage<1>(p, smem, bid, nblk); }  xcd_barrier(bar);
    run_stage<2>(p, smem, bid, nblk); if ((REP_MASK >> 2) & 1) { xcd_barrier(bar); run_stage<2>(p, smem, bid, nblk); }  xcd_barrier(bar);
    run_stage<4>(p, smem, bid, nblk); if ((REP_MASK >> 4) & 1) { xcd_barrier(bar); run_stage<4>(p, smem, bid, nblk); }  xcd_barrier(bar);
    run_stage<5>(p, smem, bid, nblk); if ((REP_MASK >> 5) & 1) { xcd_barrier(bar); run_stage<5>(p, smem, bid, nblk); }  xcd_barrier(bar);
    run_stage<6>(p, smem, bid, nblk); if ((REP_MASK >> 6) & 1) { xcd_barrier(bar); run_stage<6>(p, smem, bid, nblk); }  xcd_barrier(bar);
    run_stage<8>(p, smem, bid, nblk); if ((REP_MASK >> 8) & 1) { xcd_barrier(bar); run_stage<8>(p, smem, bid, nblk); }  xcd_barrier(bar);
    run_stage<9>(p, smem, bid, nblk); if ((REP_MASK >> 9) & 1) { xcd_barrier(bar); run_stage<9>(p, smem, bid, nblk); }  xcd_barrier(bar);
    run_stage<10>(p, smem, bid, nblk); if ((REP_MASK >> 10) & 1) { xcd_barrier(bar); run_stage<10>(p, smem, bid, nblk); } xcd_barrier(bar);
    run_stage<11>(p, smem, bid, nblk); if ((REP_MASK >> 11) & 1) { xcd_barrier(bar); run_stage<11>(p, smem, bid, nblk); }
}
#endif

template <int S> static void launch_stage(const P& p, int grid, hipStream_t stream) {
    (void)hipFuncSetAttribute((const void*)k_stage<S>, hipFuncAttributeMaxDynamicSharedMemorySize, LDS_BYTES);
    k_stage<S><<<dim3(grid), dim3(512), LDS_BYTES, stream>>>(p);
}

extern "C" void kernel_launch(void* const* d_in, const int* in_sizes, int n_in, void* d_out, int out_size, void* d_ws, size_t ws_size, hipStream_t stream) {
    (void)in_sizes; (void)n_in; (void)out_size; (void)ws_size;
    P p{};
    p.xp = (const float*)d_in[0]; p.xs = (const float*)d_in[1]; p.cache_cmp = (const float*)d_in[2]; p.cache_slc = (const float*)d_in[3];
    p.cache_win = (const float*)d_in[4]; p.state_C = (const float*)d_in[5]; p.state_n = (const float*)d_in[6]; p.state_m = (const float*)d_in[7];
    p.page_table = (const int*)d_in[8];
    p.w_in = (const float*)d_in[9]; p.b_in = (const float*)d_in[10]; p.norm_a_g = (const float*)d_in[11]; p.nsa_pe = (const float*)d_in[12];
    p.nsa_w_cmp = (const float*)d_in[13]; p.w_br_a = (const float*)d_in[14]; p.w_br_b = (const float*)d_in[15]; p.w_merge = (const float*)d_in[16];
    p.w_out = (const float*)d_in[17]; p.ln1_g = (const float*)d_in[18]; p.ln1_b = (const float*)d_in[19];
    p.peer_wq = (const float*)d_in[20]; p.peer_keys = (const float*)d_in[21]; p.peer_u = (const float*)d_in[22]; p.peer_v = (const float*)d_in[23];
    p.ln2_g = (const float*)d_in[24]; p.ln2_b = (const float*)d_in[25];
    p.out = (float*)d_out;
    char* w = (char*)d_ws; size_t off = 0;
    auto take = [&](size_t bytes) { char* r = w + off; off += (bytes + 255) & ~(size_t)255; return r; };
    p.bar = (unsigned*)take(16384);
    p.PW = (float*)(p.bar + 3584);
    p.WCT = (bf16_t*)take((size_t)2 * 64 * 4096 * 2);
    p.XB = (bf16_t*)take((size_t)NT * 1024 * 2);
    p.WINT = (bf16_t*)take((size_t)(NPAD_IN + 2048) * 1024 * 2);
    p.WMT = (bf16_t*)take((size_t)2048 * 1024 * 2);
    p.WAT = (bf16_t*)take((size_t)1024 * 1024 * 2);
    p.WBT = (bf16_t*)take((size_t)1024 * 1024 * 2);
    p.WOT = (bf16_t*)take((size_t)1024 * 1024 * 2);
    p.WQT = (bf16_t*)take((size_t)2048 * 1024 * 2);
    p.KEYSB = (bf16_t*)take((size_t)16 * 128 * 128 * 2);
    p.U8 = (unsigned char*)take((size_t)16384 * 1024);
    p.V8 = (unsigned char*)take((size_t)16384 * 1024);
    p.US = (float*)take(16384 * 4);
    p.VS = (float*)take(16384 * 4);
    p.PROJ = (bf16_t*)take((size_t)NT * PS * 2);
    p.SM = (float*)take((size_t)NT * 64 * 4);
    p.BCUM = (float*)take((size_t)16 * 4096 * 4);
    p.MPREV = (float*)take(4096); p.ACOEF = (float*)take(4096); p.SCL = (float*)take(4096); p.MLOC = (float*)take(4096);
    p.DC = (float*)take((size_t)1024 * 272 * 128 * 4);
    p.CPT = (bf16_t*)take((size_t)1024 * 272 * 128 * 2);
    p.KC = (float*)take((size_t)4352 * 512 * 4);
    p.VC = p.KC + 256;
    p.OCMP = (float*)take((size_t)NT * 1024 * 4);
    p.SEL = (unsigned long long*)take((size_t)NT * 4 * 8);
    p.YA = (bf16_t*)take((size_t)NT * 1024 * 2);
    p.YB = (bf16_t*)take((size_t)NT * 1024 * 2);
    p.G = (bf16_t*)take((size_t)NT * 2048 * 2);
    p.TMPB = (bf16_t*)take((size_t)NT * 1024 * 2);
    p.MERGED = (bf16_t*)take((size_t)NT * 1024 * 2);
    p.R = (float*)take((size_t)NT * 1024 * 4);
    p.H = (float*)take((size_t)NT * 1024 * 4);
    p.HB = (bf16_t*)take((size_t)NT * 1024 * 2);
    p.PQ = (bf16_t*)take((size_t)NT * 2048 * 2);
    p.EIDX = (int*)take((size_t)NT * 128 * 4);
    p.EGATE = (float*)take((size_t)NT * 128 * 4);

    (void)hipMemsetAsync(p.bar, 0, 16384, stream);
#if MK_ONE_LAUNCH
    {
        constexpr size_t kDynLds = LDS_BYTES + 16;
        (void)hipFuncSetAttribute((const void*)k_mega, hipFuncAttributeMaxDynamicSharedMemorySize, (int)kDynLds);
        int dev = 0, cus = 0, per_cu = 0;
        (void)hipGetDevice(&dev);
        (void)hipDeviceGetAttribute(&cus, hipDeviceAttributeMultiprocessorCount, dev);
        (void)hipOccupancyMaxActiveBlocksPerMultiprocessor(&per_cu, (const void*)k_mega, 512, kDynLds);
        if (per_cu < 1 || cus < 1) return;
        const int grid = cus;
        k_mega<<<dim3(grid), dim3(512), kDynLds, stream>>>(p);
    }
#else
    const int grid = 512;
    launch_stage<0>(p, grid, stream);
    launch_stage<1>(p, grid, stream);
    launch_stage<2>(p, grid, stream);
    launch_stage<4>(p, grid, stream);
    launch_stage<5>(p, grid, stream);
    launch_stage<6>(p, grid, stream);
    launch_stage<8>(p, grid, stream);
    launch_stage<9>(p, grid, stream);
    launch_stage<10>(p, grid, stream);
    launch_stage<11>(p, grid, stream);
#endif
}
```

```cpp
#include <hip/hip_runtime.h>
#include <stdint.h>

#ifndef REP_MASK
#define REP_MASK 0
#endif
#ifndef MK_ONE_LAUNCH
#define MK_ONE_LAUNCH 1
#endif

typedef unsigned short bf16_t;
typedef short bf16x8 __attribute__((ext_vector_type(8)));
typedef float f32x4 __attribute__((ext_vector_type(4)));
typedef unsigned u32x4 __attribute__((ext_vector_type(4)));
typedef unsigned u32x2 __attribute__((ext_vector_type(2)));
typedef float f32x2 __attribute__((ext_vector_type(2)));
typedef __bf16 bf16x2_t __attribute__((ext_vector_type(2)));
#define DEVI __device__ __forceinline__
__device__ __forceinline__ int tid_opq() { int t = threadIdx.x; asm volatile("" : "+v"(t)); return t; }

constexpr int NTP = 16384, NTS = 512, NT = NTP + NTS, DM = 1024;
constexpr int PS = 5632;
constexpr int C_AQ = 0, C_AK = 512, C_AV = 1024, C_AO = 2048, C_BQ = 3072, C_CMP = 4096, C_SLC = 4608, C_WIN = 5120;
constexpr int NPAD_IN = 5888;
constexpr float DN_ALPHA = 1.189207115002721f;
constexpr float LN_EPS = 1e-5f;
constexpr size_t O_Y = 0;
constexpr size_t O_PCMP = O_Y + (size_t)NT * 1024;
constexpr size_t O_PSLC = O_PCMP + (size_t)NTP * 512;
constexpr size_t O_PWIN = O_PSLC + (size_t)NTP * 512;
constexpr size_t O_PC = O_PWIN + (size_t)4 * 512 * 512;
constexpr size_t O_PN = O_PC + (size_t)16 * 128 * 256;
constexpr size_t O_PM = O_PN + 16 * 128;
constexpr size_t O_SCMP = O_PM + 16;
constexpr size_t O_SSLC = O_SCMP + (size_t)NTS * 512;
constexpr size_t O_SWIN = O_SSLC + (size_t)NTS * 512;
constexpr size_t O_SC = O_SWIN + (size_t)128 * 512 * 512;
constexpr size_t O_SN = O_SC + (size_t)512 * 128 * 256;
constexpr size_t O_SM = O_SN + 512 * 128;

struct P {
    const float *xp, *xs, *cache_cmp, *cache_slc, *cache_win, *state_C, *state_n, *state_m;
    const int* page_table;
    const float *w_in, *b_in, *norm_a_g, *nsa_pe, *nsa_w_cmp, *w_br_a, *w_br_b, *w_merge, *w_out, *ln1_g, *ln1_b;
    const float *peer_wq, *peer_keys, *peer_u, *peer_v, *ln2_g, *ln2_b;
    float* out;
    bf16_t *XB, *WINT, *WMT, *WAT, *WBT, *WOT, *WQT, *KEYSB, *UB, *VB, *PROJ, *WCT;
    float* PW;
    float *SM, *BCUM, *MPREV, *ACOEF, *SCL, *MLOC, *DC, *KC, *VC, *OCMP;
    bf16_t* CPT;
    unsigned char *U8, *V8;
    float *US, *VS;
    unsigned long long* SEL;
    bf16_t *YA, *YB, *G, *MERGED, *HB, *PQ;
    float *R, *H, *EGATE;
    bf16_t* TMPB;
    int* EIDX;
    unsigned* bar;
};

DEVI bf16_t f2bf(float f) { return __builtin_bit_cast(unsigned short, (__bf16)f); }
DEVI float bf2f(bf16_t h) { return __uint_as_float(((unsigned)h) << 16); }
DEVI unsigned pack2(float a, float b) { return __builtin_bit_cast(unsigned, __builtin_convertvector((f32x2){a, b}, bf16x2_t)); }
DEVI u32x4 pack8f(const f32x4 a, const f32x4 b) { u32x4 r; r[0] = pack2(a[0], a[1]); r[1] = pack2(a[2], a[3]); r[2] = pack2(b[0], b[1]); r[3] = pack2(b[2], b[3]); return r; }
DEVI void ce_desc(unsigned& a, unsigned& b) { const unsigned hi = a > b ? a : b, lo = a > b ? b : a; a = hi; b = lo; }
template <int BASE> DEVI void sort16_desc(unsigned (&x)[64]) {
#pragma unroll
    for (int k = 2; k <= 16; k <<= 1)
#pragma unroll
        for (int j = k >> 1; j > 0; j >>= 1)
#pragma unroll
            for (int i = 0; i < 16; ++i) {
                const int l = i ^ j;
                if (l > i) { if ((i & k) == 0) ce_desc(x[BASE + i], x[BASE + l]); else ce_desc(x[BASE + l], x[BASE + i]); }
            }
}
DEVI void merge_top16(const unsigned* a, const unsigned* b, unsigned* t) {
    unsigned c[16];
#pragma unroll
    for (int i = 0; i < 16; ++i) c[i] = a[i] > b[15 - i] ? a[i] : b[15 - i];
#pragma unroll
    for (int j = 8; j > 0; j >>= 1)
#pragma unroll
        for (int i = 0; i < 16; ++i) { const int l = i ^ j; if (l > i) ce_desc(c[i], c[l]); }
#pragma unroll
    for (int i = 0; i < 16; ++i) t[i] = c[i];
}
DEVI float wave_max(float v) { for (int o = 32; o > 0; o >>= 1) v = fmaxf(v, __shfl_xor(v, o)); return v; }
DEVI float wave_sum(float v) { for (int o = 32; o > 0; o >>= 1) v += __shfl_xor(v, o); return v; }
DEVI float sigmoidf_(float x) { return __builtin_amdgcn_rcpf(1.f + __expf(-x)); }
DEVI float logsigmoidf_(float x) { return fminf(x, 0.f) - log1pf(__expf(-fabsf(x))); }
DEVI int win_map(int np) {
    if (np < 2048) return np;
    if (np < 5632) return np + 8;
    if (np < 5640) return np - 5632 + 2048;
    if (np < 5688) return np;
    return -1;
}
DEVI float alibi_slope(int h) { return exp2f(-0.5f * (float)(h + 1)); }

template <class MapFn>
DEVI void transpose_cvt(const float* __restrict__ W, bf16_t* __restrict__ WT, int K, int Nsrc, int Ndst, MapFn mapfn, float* tile  , int bid, int nblk) {
    const int tid = tid_opq();
    const int tn = Ndst / 64, tk = K / 64;
    for (int t = bid; t < tn * tk; t += nblk) {
        const int n0 = (t % tn) * 64, k0 = (t / tn) * 64;
        __syncthreads();
#pragma unroll
        for (int i = 0; i < 8; ++i) {
            const int kk = (tid >> 6) + i * 8, nn = tid & 63;
            const int n = mapfn(n0 + nn);
            tile[kk * 65 + nn] = n >= 0 ? W[(size_t)(k0 + kk) * Nsrc + n] : 0.f;
        }
        __syncthreads();
#pragma unroll
        for (int i = 0; i < 8; ++i) {
            const int nn = (tid >> 6) + i * 8, kk = tid & 63;
            WT[(size_t)(n0 + nn) * K + k0 + kk] = f2bf(tile[kk * 65 + nn]);
        }
    }
}
struct IdMap { DEVI int operator()(int n) const { return n; } };
struct WinMap { DEVI int operator()(int n) const { return win_map(n); } };

DEVI void cvt_rows(const float* __restrict__ src, bf16_t* __restrict__ dst, size_t n4, int bid, int nblk) {
    const size_t stride = (size_t)nblk * 512;
    for (size_t i0 = (size_t)bid * 512 + tid_opq(); i0 < n4; i0 += stride * 8) {
        f32x4 v[8];
#pragma unroll
        for (int u = 0; u < 8; ++u) { const size_t i = i0 + u * stride; v[u] = i < n4 ? __builtin_nontemporal_load((const f32x4*)src + i) : (f32x4){0.f, 0.f, 0.f, 0.f}; }
#pragma unroll
        for (int u = 0; u < 8; ++u) { const size_t i = i0 + u * stride; if (i < n4) { u32x2 o; o.x = pack2(v[u][0], v[u][1]); o.y = pack2(v[u][2], v[u][3]); ((u32x2*)dst)[i] = o; } }
    }
}

DEVI void stage_prologue(const P& p, char* smem, int bid, int nblk) {
    float* tile = (float*)smem;
    cvt_rows(p.xp, p.XB, (size_t)NTP * 256, bid, nblk);
    cvt_rows(p.xs, p.XB + (size_t)NTP * 1024, (size_t)NTS * 256, bid, nblk);
    {
        const int lane = tid_opq() & 63, wid = tid_opq() >> 6;
        for (int r0 = bid * 8 + wid; r0 < 2 * 16384; r0 += nblk * 8 * 2) {
            f32x4 x[2][4]; float am[2] = {0.f, 0.f};
#pragma unroll
            for (int j = 0; j < 2; ++j) {
                const int r = r0 + j * nblk * 8;
                if (r < 2 * 16384) {
                    const bool isv = r >= 16384; const int e = isv ? r - 16384 : r;
                    const float* src = (isv ? p.peer_v : p.peer_u) + (size_t)e * 1024 + lane * 16;
#pragma unroll
                    for (int i = 0; i < 4; ++i) x[j][i] = __builtin_nontemporal_load((const f32x4*)(src + i * 4));
                }
            }
#pragma unroll
            for (int j = 0; j < 2; ++j) {
                const int r = r0 + j * nblk * 8;
                if (r < 2 * 16384) {
                    const bool isv = r >= 16384; const int e = isv ? r - 16384 : r;
#pragma unroll
                    for (int i = 0; i < 4; ++i)
#pragma unroll
                        for (int k = 0; k < 4; ++k) am[j] = fmaxf(am[j], fabsf(x[j][i][k]));
                    const float amx = wave_max(am[j]);
                    const float inv = amx > 0.f ? 448.f / amx : 1.f;
                    u32x4 o;
#pragma unroll
                    for (int i = 0; i < 4; ++i) { int w = __builtin_amdgcn_cvt_pk_fp8_f32(x[j][i][0] * inv, x[j][i][1] * inv, 0, false); w = __builtin_amdgcn_cvt_pk_fp8_f32(x[j][i][2] * inv, x[j][i][3] * inv, w, true); o[i] = (unsigned)w; }
                    *(u32x4*)((isv ? p.V8 : p.U8) + (size_t)e * 1024 + lane * 16) = o;
                    if (lane == 0) (isv ? p.VS : p.US)[e] = amx > 0.f ? amx / 448.f : 1.f;
                }
            }
        }
    }
    cvt_rows(p.peer_keys, p.KEYSB, (size_t)16 * 128 * 128 / 4, bid, nblk);
    transpose_cvt(p.w_in, p.WINT, 1024, 5688, NPAD_IN, WinMap(), tile, bid, nblk);
    transpose_cvt(p.w_merge, p.WINT + (size_t)NPAD_IN * 1024, 1024, 2048, 2048, IdMap(), tile, bid, nblk);
    transpose_cvt(p.w_br_a, p.WAT, 1024, 1024, 1024, IdMap(), tile, bid, nblk);
    transpose_cvt(p.w_br_b, p.WBT, 1024, 1024, 1024, IdMap(), tile, bid, nblk);
    transpose_cvt(p.w_out, p.WOT, 1024, 1024, 1024, IdMap(), tile, bid, nblk);
    transpose_cvt(p.peer_wq, p.WQT, 1024, 2048, 2048, IdMap(), tile, bid, nblk);
    transpose_cvt(p.nsa_w_cmp, p.WCT, 4096, 64, 64, IdMap(), tile, bid, nblk);
    transpose_cvt(p.nsa_w_cmp + 4096 * 64, p.WCT + 64 * 4096, 4096, 64, 64, IdMap(), tile, bid, nblk);
    for (int blk = bid; blk < 32; blk += nblk) {
        const int tid = tid_opq(), kvv = tid >> 8, e = tid & 63, kq = (tid >> 6) & 3;
        float a = 0.f;
        for (int k = blk * 128 + kq * 32; k < blk * 128 + kq * 32 + 32; ++k) a += p.nsa_pe[kvv * 4096 + k] * p.nsa_w_cmp[((size_t)kvv * 4096 + k) * 64 + e];
        atomicAdd(p.PW + kvv * 64 + e, a);
    }
    {
        const size_t per_b = (size_t)508 * 512 / 4;
        const size_t stride = (size_t)nblk * 512, ntot = 128 * per_b;
        for (size_t i0 = (size_t)bid * 512 + tid_opq(); i0 < ntot; i0 += stride * 8) {
            f32x4 v[8];
#pragma unroll
            for (int u = 0; u < 8; ++u) { const size_t i = i0 + u * stride; if (i < ntot) { const size_t b = i / per_b, r = i % per_b; v[u] = __builtin_nontemporal_load((const f32x4*)(p.cache_win + b * 512 * 512 + 4 * 512) + r); } }
#pragma unroll
            for (int u = 0; u < 8; ++u) { const size_t i = i0 + u * stride; if (i < ntot) { const size_t b = i / per_b, r = i % per_b; __builtin_nontemporal_store(v[u], (f32x4*)(p.out + O_SWIN + b * 512 * 512) + r); } }
        }
    }
}

struct NoPre {};
DEVI f32x4 bf4_lo(const u32x4& g) { return (f32x4){__uint_as_float(g[0] << 16), __uint_as_float(g[0] & 0xFFFF0000u), __uint_as_float(g[1] << 16), __uint_as_float(g[1] & 0xFFFF0000u)}; }
DEVI f32x4 bf4_hi(const u32x4& g) { return (f32x4){__uint_as_float(g[2] << 16), __uint_as_float(g[2] & 0xFFFF0000u), __uint_as_float(g[3] << 16), __uint_as_float(g[3] & 0xFFFF0000u)}; }
struct EpiInProj {
    P p;
    typedef NoPre Pre;
    static constexpr int BATCH = 4;
    static constexpr bool COLBIAS = true;
    DEVI void bias8(int col, f32x4& b0, f32x4& b1) const {
        b0 = (f32x4){0.f, 0.f, 0.f, 0.f}; b1 = b0;
        if (col < 5688) { const int oc = win_map(col);
#pragma unroll
            for (int q = 0; q < 4; ++q) { b0[q] = p.b_in[oc + q]; b1[q] = p.b_in[oc + 4 + q]; } }
    }
    DEVI Pre pre(int, int) const { return NoPre(); }
    DEVI void put(int row, int col, f32x4 v0, f32x4 v1, const Pre&) const {
        if (col >= NPAD_IN) {
#pragma unroll
            for (int k = 0; k < 4; ++k) { v0[k] = sigmoidf_(v0[k]); v1[k] = sigmoidf_(v1[k]); }
            *(u32x4*)(p.G + (size_t)row * 2048 + (col - NPAD_IN)) = pack8f(v0, v1);
            return;
        }
        if (col >= 5688) return;
        if (col >= 5632) { *(f32x4*)(p.SM + (size_t)row * 64 + (col - 5632)) = v0; *(f32x4*)(p.SM + (size_t)row * 64 + (col - 5632) + 4) = v1; return; }
        if (col >= C_AK && col < C_AV) { v0 *= 0.08838834764831845f; v1 *= 0.08838834764831845f; }
        *(u32x4*)(p.PROJ + (size_t)row * PS + col) = pack8f(v0, v1);
        if (col >= C_CMP) {
            const int reg = (col - C_CMP) >> 9, c = (col - C_CMP) & 511;
            float* dst = nullptr;
            if (row < NTP) {
                if (reg == 0) dst = p.out + O_PCMP + (size_t)row * 512 + c;
                else if (reg == 1) dst = p.out + O_PSLC + (size_t)row * 512 + c;
                else { const int b = row >> 12, t = row & 4095; if (t >= 3584) dst = p.out + O_PWIN + ((size_t)b * 512 + (t - 3584)) * 512 + c; }
            } else {
                const int rs = row - NTP;
                if (reg == 0) dst = p.out + O_SCMP + (size_t)rs * 512 + c;
                else if (reg == 1) dst = p.out + O_SSLC + (size_t)rs * 512 + c;
                else { const int b = rs >> 2, tq = rs & 3; dst = p.out + O_SWIN + ((size_t)b * 512 + 508 + tq) * 512 + c; }
            }
            if (dst) { *(f32x4*)dst = v0; *(f32x4*)(dst + 4) = v1; }
        }
    }
};
struct EpiG {
    P p;
    typedef NoPre Pre;
    static constexpr int BATCH = 4;
    static constexpr bool COLBIAS = false;
    DEVI Pre pre(int, int) const { return NoPre(); }
    DEVI void put(int row, int col, f32x4 v0, f32x4 v1, const Pre&) const {
#pragma unroll
        for (int k = 0; k < 4; ++k) { v0[k] = sigmoidf_(v0[k]); v1[k] = sigmoidf_(v1[k]); }
        *(u32x4*)(p.G + (size_t)row * 2048 + col) = pack8f(v0, v1);
    }
};
struct EpiM1 {
    P p;
    typedef u32x4 Pre;
    static constexpr int BATCH = 8;
    static constexpr bool COLBIAS = false;
    DEVI Pre pre(int row, int col) const { return *(const u32x4*)(p.G + (size_t)row * 2048 + 1024 + col); }
    DEVI void put(int row, int col, f32x4 v0, f32x4 v1, const Pre& g) const {
        *(u32x4*)(p.TMPB + (size_t)row * 1024 + col) = pack8f(v0 * bf4_lo(g), v1 * bf4_hi(g));
    }
};
struct PreM2 { u32x4 g; u32x4 t; };
struct EpiM2 {
    P p;
    typedef PreM2 Pre;
    static constexpr int BATCH = 8;
    static constexpr bool COLBIAS = false;
    DEVI Pre pre(int row, int col) const { PreM2 r; r.g = *(const u32x4*)(p.G + (size_t)row * 2048 + col); r.t = *(const u32x4*)(p.TMPB + (size_t)row * 1024 + col); return r; }
    DEVI void put(int row, int col, f32x4 v0, f32x4 v1, const Pre& q) const {
        *(u32x4*)(p.MERGED + (size_t)row * 1024 + col) = pack8f(bf4_lo(q.t) + v0 * bf4_lo(q.g), bf4_hi(q.t) + v1 * bf4_hi(q.g));
    }
};
struct PreR { f32x4 a, b; };
struct EpiR {
    P p;
    typedef PreR Pre;
    static constexpr int BATCH = 8;
    static constexpr bool COLBIAS = false;
    DEVI Pre pre(int row, int col) const {
        const float* xr = row < NTP ? p.xp + (size_t)row * 1024 : p.xs + (size_t)(row - NTP) * 1024;
        PreR r; r.a = *(const f32x4*)(xr + col); r.b = *(const f32x4*)(xr + col + 4); return r;
    }
    DEVI void put(int row, int col, f32x4 v0, f32x4 v1, const Pre& x) const {
        *(f32x4*)(p.R + (size_t)row * 1024 + col) = x.a * DN_ALPHA + v0; *(f32x4*)(p.R + (size_t)row * 1024 + col + 4) = x.b * DN_ALPHA + v1;
    }
};
struct EpiPQ {
    P p;
    typedef NoPre Pre;
    static constexpr int BATCH = 4;
    static constexpr bool COLBIAS = false;
    DEVI Pre pre(int, int) const { return NoPre(); }
    DEVI void put(int row, int col, f32x4 v0, f32x4 v1, const Pre&) const { *(u32x4*)(p.PQ + (size_t)row * 2048 + col) = pack8f(v0, v1); }
};

DEVI void stage_mlstm_gates(const P& p, char* smem, int bid, int nblk) {
    const int lane = tid_opq() & 63, wid = tid_opq() >> 6;
    float* bend_s = (float*)smem; float* mloc_s = bend_s + 64;
    for (int bh = bid; bh < 16; bh += nblk) {
        const int b = bh >> 2, h = bh & 3;
        __syncthreads();
        for (int cc = 0; cc < 8; ++cc) {
            const int c = wid * 8 + cc;
            const size_t row = (size_t)b * 4096 + c * 64 + lane;
            const float ip = p.SM[row * 64 + h];
            const float lf = logsigmoidf_(p.SM[row * 64 + 4 + h]);
            float cs = lf;
#pragma unroll
            for (int o = 1; o < 64; o <<= 1) { const float t = __shfl_up(cs, o); if (lane >= o) cs += t; }
            p.BCUM[bh * 4096 + c * 64 + lane] = cs;
            const float bend = __shfl(cs, 63);
            const float mloc = wave_max(bend - cs + ip);
            if (lane == 0) { bend_s[c] = bend; mloc_s[c] = mloc; }
        }
        __syncthreads();
        if (tid_opq() == 0) {
            float m = 0.f;
            for (int c = 0; c < 64; ++c) {
                const float bend = bend_s[c], mloc = mloc_s[c];
                const float mnew = fmaxf(bend + m, mloc);
                p.MPREV[bh * 64 + c] = m;
                p.ACOEF[bh * 64 + c] = __expf(bend + m - mnew);
                p.SCL[bh * 64 + c] = __expf(mloc - mnew);
                p.MLOC[bh * 64 + c] = mloc;
                m = mnew;
            }
            p.out[O_PM + bh] = m;
        }
    }
}

constexpr int MD_KT = 0, MD_VT = 128 * 144, MD_WS = MD_VT + 272 * 144, MD_LDS = MD_WS + 256;
DEVI void stage_mlstm_dc(const P& p, char* smem, int bid, int nblk) {
    const int tid = tid_opq(), lane = tid & 63, wid = tid >> 6, fr = lane & 15, fq = lane >> 4;
    bf16_t* Kt = (bf16_t*)(smem + MD_KT);
    bf16_t* Vt = (bf16_t*)(smem + MD_VT);
    float* ws = (float*)(smem + MD_WS);
    for (int task = bid; task < 1024; task += nblk) {
        const int bh = task >> 6, c = task & 63, b = bh >> 2, h = bh & 3;
        const size_t row0 = (size_t)b * 4096 + c * 64;
        __syncthreads();
        if (tid < 64) {
            const float ip = p.SM[(row0 + tid) * 64 + h];
            float cs = logsigmoidf_(p.SM[(row0 + tid) * 64 + 4 + h]);
#pragma unroll
            for (int o = 1; o < 64; o <<= 1) { const float t = __shfl_up(cs, o); if (tid >= o) cs += t; }
            const float g = __shfl(cs, 63) - cs + ip;
            ws[tid] = __expf(g - wave_max(g));
        }
        __syncthreads();
        {
            const int sidx = tid & 63, ch = tid >> 6;
            const float w = ws[sidx];
#pragma unroll
            for (int half = 0; half < 2; ++half) {
                const u32x4 kk = *(const u32x4*)(p.PROJ + (row0 + sidx) * PS + C_AK + h * 128 + half * 64 + ch * 8);
#pragma unroll
                for (int e = 0; e < 4; ++e) {
                    Kt[(half * 64 + ch * 8 + e * 2) * 72 + sidx] = f2bf(w * __uint_as_float(kk[e] << 16));
                    Kt[(half * 64 + ch * 8 + e * 2 + 1) * 72 + sidx] = f2bf(w * __uint_as_float(kk[e] & 0xFFFF0000u));
                }
            }
#pragma unroll
            for (int q4 = 0; q4 < 4; ++q4) {
                const u32x4 vv = *(const u32x4*)(p.PROJ + (row0 + sidx) * PS + C_AV + h * 256 + q4 * 64 + ch * 8);
#pragma unroll
                for (int e = 0; e < 4; ++e) {
                    Vt[(q4 * 64 + ch * 8 + e * 2) * 72 + sidx] = (bf16_t)(vv[e] & 0xFFFFu);
                    Vt[(q4 * 64 + ch * 8 + e * 2 + 1) * 72 + sidx] = (bf16_t)(vv[e] >> 16);
                }
            }
            for (int i = tid; i < 16 * 64; i += 512) Vt[(256 + (i >> 6)) * 72 + (i & 63)] = (i >> 6) == 0 ? (bf16_t)0x3F80 : (bf16_t)0;
        }
        __syncthreads();
        const int nvt = wid == 0 ? 3 : 2;
        for (int vi = 0; vi < nvt; ++vi) {
            const int vt = vi < 2 ? wid * 2 + vi : 16;
            f32x4 acc[8];
#pragma unroll
            for (int dt = 0; dt < 8; ++dt) acc[dt] = (f32x4){0.f, 0.f, 0.f, 0.f};
#pragma unroll
            for (int ks = 0; ks < 2; ++ks) {
                const bf16x8 bf = *(const bf16x8*)(Vt + (vt * 16 + fr) * 72 + ks * 32 + fq * 8);
#pragma unroll
                for (int dt = 0; dt < 8; ++dt) {
                    const bf16x8 af = *(const bf16x8*)(Kt + (dt * 16 + fr) * 72 + ks * 32 + fq * 8);
                    acc[dt] = __builtin_amdgcn_mfma_f32_16x16x32_bf16(af, bf, acc[dt], 0, 0, 0);
                }
            }
            const int v = vt * 16 + fr;
            if (v <= 256) {
#pragma unroll
                for (int dt = 0; dt < 8; ++dt) *(f32x4*)(p.DC + ((size_t)task * 272 + v) * 128 + dt * 16 + fq * 4) = acc[dt];
            }
        }
    }
}

DEVI void stage_mlstm_scan(const P& p, int bid, int nblk) {
    const int nthr = 512;
    for (int e = bid * nthr + tid_opq(); e < 16 * 257 * 32; e += nblk * nthr) {
        const int bh = e / (257 * 32), r = e % (257 * 32), v = r >> 5, d = (r & 31) * 4;
        f32x4 C = {0.f, 0.f, 0.f, 0.f};
        const float* ac = p.ACOEF + bh * 64; const float* sc = p.SCL + bh * 64;
        const size_t base = ((size_t)(bh * 64) * 272 + v) * 128 + d, cstride = (size_t)272 * 128;
#pragma unroll 1
        for (int c0 = 0; c0 < 64; c0 += 8) {
            f32x4 dc[8];
#pragma unroll
            for (int i = 0; i < 8; ++i) dc[i] = __builtin_nontemporal_load((const f32x4*)(p.DC + base + (size_t)(c0 + i) * cstride));
#pragma unroll
            for (int i = 0; i < 8; ++i) {
                u32x2 o; o.x = pack2(C[0], C[1]); o.y = pack2(C[2], C[3]);
                *(u32x2*)(p.CPT + base + (size_t)(c0 + i) * cstride) = o;
                C = C * ac[c0 + i] + dc[i] * sc[c0 + i];
            }
        }
        if (v < 256) {
#pragma unroll
            for (int k = 0; k < 4; ++k) p.out[O_PC + ((size_t)bh * 128 + d + k) * 256 + v] = C[k];
        } else *(f32x4*)(p.out + O_PN + bh * 128 + d) = C;
    }
}

constexpr int MO_Q = 0, MO_K = 64 * 272, MO_VT = MO_K + 64 * 272, MO_P = MO_VT + 272 * 144, MO_SC = MO_P + 64 * 144, MO_HS = MO_SC + 2048, MO_LDS = MO_HS + 64 * 256 * 4;
static_assert(MO_LDS <= 152 * 1024, "lds");
DEVI void stage_mlstm_out(const P& p, char* smem, int bid, int nblk) {
    const int tid = tid_opq(), lane = tid & 63, wid = tid >> 6, fr = lane & 15, fq = lane >> 4;
    bf16_t* Qs = (bf16_t*)(smem + MO_Q);
    bf16_t* Ks = (bf16_t*)(smem + MO_K);
    bf16_t* Vt = (bf16_t*)(smem + MO_VT);
    bf16_t* Ps = (bf16_t*)(smem + MO_P);
    float* sc = (float*)(smem + MO_SC);
    float* rowt = sc; float* colt = sc + 64; float* wint = sc + 128; float* emt = sc + 192; float* den = sc + 256;
    float* hs = (float*)(smem + MO_HS);
    for (int task = bid; task < 1024; task += nblk) {
        const int bh = task >> 6, c = task & 63, b = bh >> 2, h = bh & 3;
        const size_t row0 = (size_t)b * 4096 + c * 64;
        __syncthreads();
        {
            for (int i = tid; i < 64 * 16; i += 512) {
                const int t = i >> 4, ch = i & 15;
                *(u32x4*)(Qs + t * 136 + ch * 8) = *(const u32x4*)(p.PROJ + (row0 + t) * PS + C_AQ + h * 128 + ch * 8);
                *(u32x4*)(Ks + t * 136 + ch * 8) = *(const u32x4*)(p.PROJ + (row0 + t) * PS + C_AK + h * 128 + ch * 8);
            }
            const int sidx = tid & 63, ch = tid >> 6;
#pragma unroll
            for (int q4 = 0; q4 < 4; ++q4) {
                const u32x4 vv = *(const u32x4*)(p.PROJ + (row0 + sidx) * PS + C_AV + h * 256 + q4 * 64 + ch * 8);
#pragma unroll
                for (int e = 0; e < 4; ++e) {
                    Vt[(q4 * 64 + ch * 8 + e * 2) * 72 + sidx] = (bf16_t)(vv[e] & 0xFFFFu);
                    Vt[(q4 * 64 + ch * 8 + e * 2 + 1) * 72 + sidx] = (bf16_t)(vv[e] >> 16);
                }
            }
            for (int i = tid; i < 16 * 64; i += 512) Vt[(256 + (i >> 6)) * 72 + (i & 63)] = (i >> 6) == 0 ? (bf16_t)0x3F80 : (bf16_t)0;
            if (wid == 0) {
                const float bc = p.BCUM[bh * 4096 + c * 64 + lane], ip = p.SM[(row0 + lane) * 64 + h];
                const float mprev = p.MPREV[task];
                float pm = ip - bc;
#pragma unroll
                for (int o = 1; o < 64; o <<= 1) { const float t = __shfl_up(pm, o); if (lane >= o) pm = fmaxf(pm, t); }
                const float mt = fmaxf(bc + mprev, bc + pm);
                rowt[lane] = bc - mt; colt[lane] = ip - bc; wint[lane] = __expf(bc + mprev - mt); emt[lane] = __expf(-mt);
            }
        }
        __syncthreads();
        {
            const int tt = wid >> 1;
#pragma unroll
            for (int si = 0; si < 2; ++si) {
                const int st = (wid & 1) * 2 + si;
                f32x4 acc = (f32x4){0.f, 0.f, 0.f, 0.f};
                if (st <= tt) {
#pragma unroll
                    for (int ks = 0; ks < 4; ++ks) {
                        const bf16x8 af = *(const bf16x8*)(Qs + (tt * 16 + fr) * 136 + ks * 32 + fq * 8);
                        const bf16x8 bf = *(const bf16x8*)(Ks + (st * 16 + fr) * 136 + ks * 32 + fq * 8);
                        acc = __builtin_amdgcn_mfma_f32_16x16x32_bf16(af, bf, acc, 0, 0, 0);
                    }
                }
                const int s = st * 16 + fr; const float ct = colt[s];
#pragma unroll
                for (int r = 0; r < 4; ++r) {
                    const int t = tt * 16 + fq * 4 + r;
                    const float pv = (s <= t) ? acc[r] * __expf(rowt[t] + ct) : 0.f;
                    Ps[t * 72 + s] = f2bf(pv);
                }
            }
        }
        __syncthreads();
        {
            const bf16_t* cpt = p.CPT + (size_t)task * 272 * 128;
            f32x4 acc[4][2];
#pragma unroll
            for (int tt = 0; tt < 4; ++tt)
#pragma unroll
                for (int vi = 0; vi < 2; ++vi) acc[tt][vi] = (f32x4){0.f, 0.f, 0.f, 0.f};
            f32x4 accd = (f32x4){0.f, 0.f, 0.f, 0.f};
            bf16x8 cb[4][2], cd[4];
#pragma unroll
            for (int ks = 0; ks < 4; ++ks) {
#pragma unroll
                for (int vi = 0; vi < 2; ++vi) cb[ks][vi] = *(const bf16x8*)(cpt + (size_t)((wid * 2 + vi) * 16 + fr) * 128 + ks * 32 + fq * 8);
                cd[ks] = *(const bf16x8*)(cpt + (size_t)(256 + fr) * 128 + ks * 32 + fq * 8);
            }
#pragma unroll
            for (int ks = 0; ks < 4; ++ks) {
                bf16x8 af[4];
#pragma unroll
                for (int tt = 0; tt < 4; ++tt) af[tt] = *(const bf16x8*)(Qs + (tt * 16 + fr) * 136 + ks * 32 + fq * 8);
#pragma unroll
                for (int vi = 0; vi < 2; ++vi) {
#pragma unroll
                    for (int tt = 0; tt < 4; ++tt) acc[tt][vi] = __builtin_amdgcn_mfma_f32_16x16x32_bf16(af[tt], cb[ks][vi], acc[tt][vi], 0, 0, 0);
                }
                if (wid < 4) {
                    const bf16x8 a2 = *(const bf16x8*)(Qs + (wid * 16 + fr) * 136 + ks * 32 + fq * 8);
                    accd = __builtin_amdgcn_mfma_f32_16x16x32_bf16(a2, cd[ks], accd, 0, 0, 0);
                }
            }
#pragma unroll
            for (int tt = 0; tt < 4; ++tt) {
                const f32x4 wv = *(const f32x4*)(wint + tt * 16 + fq * 4);
#pragma unroll
                for (int vi = 0; vi < 2; ++vi) acc[tt][vi] *= wv;
            }
            if (wid < 4) accd *= *(const f32x4*)(wint + wid * 16 + fq * 4);
#pragma unroll
            for (int ks = 0; ks < 2; ++ks) {
                bf16x8 af[4];
#pragma unroll
                for (int tt = 0; tt < 4; ++tt) af[tt] = *(const bf16x8*)(Ps + (tt * 16 + fr) * 72 + ks * 32 + fq * 8);
#pragma unroll
                for (int vi = 0; vi < 2; ++vi) {
                    const bf16x8 bf = *(const bf16x8*)(Vt + ((wid * 2 + vi) * 16 + fr) * 72 + ks * 32 + fq * 8);
#pragma unroll
                    for (int tt = 0; tt < 4; ++tt) acc[tt][vi] = __builtin_amdgcn_mfma_f32_16x16x32_bf16(af[tt], bf, acc[tt][vi], 0, 0, 0);
                }
                if (wid < 4) {
                    const bf16x8 bf = *(const bf16x8*)(Vt + (256 + fr) * 72 + ks * 32 + fq * 8);
                    const bf16x8 a2 = *(const bf16x8*)(Ps + (wid * 16 + fr) * 72 + ks * 32 + fq * 8);
                    accd = __builtin_amdgcn_mfma_f32_16x16x32_bf16(a2, bf, accd, 0, 0, 0);
                }
            }
            if (wid < 4 && fr == 0) *(f32x4*)(den + wid * 16 + fq * 4) = accd;
            __syncthreads();
#pragma unroll
            for (int tt = 0; tt < 4; ++tt) {
                const f32x4 dv = *(const f32x4*)(den + tt * 16 + fq * 4), ev = *(const f32x4*)(emt + tt * 16 + fq * 4);
#pragma unroll
                for (int vi = 0; vi < 2; ++vi)
#pragma unroll
                    for (int r = 0; r < 4; ++r) hs[(tt * 16 + fq * 4 + r) * 256 + (wid * 2 + vi) * 16 + fr] = acc[tt][vi][r] / fmaxf(fabsf(dv[r]), ev[r]);
            }
        }
        __syncthreads();
        u32x2 ovs[8];
#pragma unroll
        for (int rr = 0; rr < 8; ++rr) ovs[rr] = *(const u32x2*)(p.PROJ + (row0 + wid * 8 + rr) * PS + C_AO + h * 256 + lane * 4);
        const f32x4 gg = *(const f32x4*)(p.norm_a_g + h * 256 + lane * 4);
#pragma unroll
        for (int rr = 0; rr < 8; ++rr) {
            const int t = wid * 8 + rr;
            const f32x4 x = *(const f32x4*)(hs + t * 256 + lane * 4);
            const float mean = wave_sum(x[0] + x[1] + x[2] + x[3]) * (1.f / 256.f);
            float q = 0.f;
#pragma unroll
            for (int k = 0; k < 4; ++k) q += (x[k] - mean) * (x[k] - mean);
            const float rs = rsqrtf(wave_sum(q) * (1.f / 256.f) + LN_EPS);
            const u32x2 ov = ovs[rr];
            const float o4[4] = {__uint_as_float(ov.x << 16), __uint_as_float(ov.x & 0xFFFF0000u), __uint_as_float(ov.y << 16), __uint_as_float(ov.y & 0xFFFF0000u)};
            float y[4];
#pragma unroll
            for (int k = 0; k < 4; ++k) y[k] = (x[k] - mean) * rs * gg[k] * sigmoidf_(o4[k]);
            u32x2 o2; o2.x = pack2(y[0], y[1]); o2.y = pack2(y[2], y[3]);
            *(u32x2*)(p.YA + (row0 + t) * 1024 + h * 256 + lane * 4) = o2;
        }
    }
}

DEVI void stage_mlstm_sample(const P& p, char* smem, int bid, int nblk) {
    float* qs = (float*)smem;
    float* ks = qs + 512;
    float* vs = ks + 512;
    float* part = vs + 1024;
    float* hs = part + 2048;
    float* sc = hs + 1024;
    float* bc = sc; float* ip = sc + 4; float* mt = sc + 8; float* wint = sc + 12; float* emt = sc + 16; float* ww = sc + 20; float* den = sc + 24;
    float* Pm = sc + 32;
    float* misc = sc + 48;
    const int tid = tid_opq(), lane = tid & 63, wid = tid >> 6;
    for (int task = bid; task < 512; task += nblk) {
        const int b = task >> 2, h = task & 3;
        const size_t row0 = (size_t)NTP + b * 4;
        __syncthreads();
        { const int t = tid >> 7, d = tid & 127;
          qs[tid] = bf2f(p.PROJ[(row0 + t) * PS + C_AQ + h * 128 + d]);
          ks[tid] = bf2f(p.PROJ[(row0 + t) * PS + C_AK + h * 128 + d]); }
        for (int idx = tid; idx < 1024; idx += 512) { const int t = idx >> 8, v = idx & 255; vs[idx] = bf2f(p.PROJ[(row0 + t) * PS + C_AV + h * 256 + v]); }
        if (tid == 0) {
            const float m0 = p.state_m[task];
            float cs = 0.f;
            for (int t = 0; t < 4; ++t) { cs += logsigmoidf_(p.SM[(row0 + t) * 64 + 4 + h]); bc[t] = cs; ip[t] = p.SM[(row0 + t) * 64 + h]; }
            for (int t = 0; t < 4; ++t) {
                float mx = bc[t] + m0;
                for (int s = 0; s <= t; ++s) mx = fmaxf(mx, bc[t] - bc[s] + ip[s]);
                mt[t] = mx; wint[t] = __expf(bc[t] + m0 - mx); emt[t] = __expf(-mx);
            }
            const float bend = bc[3];
            float mnew = bend + m0;
            for (int s = 0; s < 4; ++s) mnew = fmaxf(mnew, bend - bc[s] + ip[s]);
            misc[0] = __expf(bend + m0 - mnew);
            for (int s = 0; s < 4; ++s) ww[s] = __expf(bend - bc[s] + ip[s] - mnew);
            p.out[O_SM + task] = mnew;
        }
        __syncthreads();
        if (tid < 16) {
            const int t = tid >> 2, s = tid & 3;
            float a = 0.f;
            if (s <= t) { for (int d = 0; d < 128; ++d) a += qs[t * 128 + d] * ks[s * 128 + d]; a *= __expf(bc[t] - bc[s] + ip[s] - mt[t]); }
            Pm[tid] = a;
        }
        __syncthreads();
        if (tid < 4) {
            const int t = tid; float qn = 0.f;
            for (int d = 0; d < 128; ++d) qn += qs[t * 128 + d] * p.state_n[(size_t)task * 128 + d];
            den[t] = wint[t] * qn + Pm[t * 4] + Pm[t * 4 + 1] + Pm[t * 4 + 2] + Pm[t * 4 + 3];
        }
        const float a = misc[0];
        if (tid >= 128 && tid < 256) {
            const int d = tid - 128;
            float n = a * p.state_n[(size_t)task * 128 + d];
            for (int s = 0; s < 4; ++s) n += ww[s] * ks[s * 128 + d];
            p.out[O_SN + (size_t)task * 128 + d] = n;
        }
        {
            const int v = tid & 255, dh = tid >> 8;
            float acc[4] = {0.f, 0.f, 0.f, 0.f};
            float wv[4];
#pragma unroll
            for (int s = 0; s < 4; ++s) wv[s] = ww[s] * vs[s * 256 + v];
            for (int d0 = dh * 64; d0 < dh * 64 + 64; d0 += 16) {
                float c0[16];
#pragma unroll
                for (int i = 0; i < 16; ++i) c0[i] = __builtin_nontemporal_load(p.state_C + ((size_t)task * 128 + d0 + i) * 256 + v);
#pragma unroll
                for (int i = 0; i < 16; ++i) {
                    const int d = d0 + i;
#pragma unroll
                    for (int t = 0; t < 4; ++t) acc[t] += qs[t * 128 + d] * c0[i];
                    float cn = a * c0[i];
#pragma unroll
                    for (int s = 0; s < 4; ++s) cn += ks[s * 128 + d] * wv[s];
                    __builtin_nontemporal_store(cn, p.out + O_SC + ((size_t)task * 128 + d) * 256 + v);
                }
            }
#pragma unroll
            for (int t = 0; t < 4; ++t) part[(dh * 4 + t) * 256 + v] = acc[t];
        }
        __syncthreads();
        if (tid < 256) {
            const int v = tid;
#pragma unroll
            for (int t = 0; t < 4; ++t) {
                float num = wint[t] * (part[t * 256 + v] + part[(4 + t) * 256 + v]);
#pragma unroll
                for (int s = 0; s < 4; ++s) num += Pm[t * 4 + s] * vs[s * 256 + v];
                hs[t * 256 + v] = num / fmaxf(fabsf(den[t]), emt[t]);
            }
        }
        __syncthreads();
        if (wid < 4) {
            const int t = wid;
            const f32x4 x = *(const f32x4*)(hs + t * 256 + lane * 4);
            const float mean = wave_sum(x[0] + x[1] + x[2] + x[3]) * (1.f / 256.f);
            float q = 0.f;
#pragma unroll
            for (int k = 0; k < 4; ++k) q += (x[k] - mean) * (x[k] - mean);
            const float rs = rsqrtf(wave_sum(q) * (1.f / 256.f) + LN_EPS);
            float y[4];
#pragma unroll
            for (int k = 0; k < 4; ++k) {
                const int vi = lane * 4 + k;
                const float o = bf2f(p.PROJ[(row0 + t) * PS + C_AO + h * 256 + vi]);
                y[k] = (x[k] - mean) * rs * p.norm_a_g[h * 256 + vi] * sigmoidf_(o);
            }
            u32x2 o2; o2.x = pack2(y[0], y[1]); o2.y = pack2(y[2], y[3]);
            *(u32x2*)(p.YA + (row0 + t) * 1024 + h * 256 + lane * 4) = o2;
        }
    }
}

constexpr int CP_ABUF = 33280, CP_WBUF = 18432, CP_A = 0, CP_W = 2 * CP_ABUF, CP_LDS = CP_W + 2 * CP_WBUF;
constexpr int CP_AROW = 1024 + 8;
DEVI void stage_compress(const P& p, char* smem, int bid, int nblk) {
    const int tid = tid_opq(), lane = tid & 63, wid = tid >> 6, fr = lane & 15, fq = lane >> 4;
    const int kv = wid & 1, rt = wid >> 1;
    const int n_it = (256 + nblk - 1) / nblk + (16 + nblk - 1) / nblk;
    for (int it = 0; it < n_it; ++it) {
        const int ns_it = (256 + nblk - 1) / nblk;
        const int task = it < ns_it ? bid + it * nblk : 256 + (nblk - 1 - bid) + (it - ns_it) * nblk;
        if (task >= 272 || (it < ns_it && task >= 256)) continue;
        const bool prompt = task >= 256;
        const int rowbytes = prompt ? 1024 : 2048, npieces = prompt ? 2 : 4;
        const char* src[4]; int dsto[4];
#pragma unroll
        for (int q = 0; q < 4; ++q) {
            const int off = q * 8192 + tid * 16, r = off / rowbytes, cb = off % rowbytes;
            if (prompt) { const int blk = (task - 256) * 16 + (r & 15); src[q] = (const char*)(p.PROJ + (size_t)blk * 64 * PS + C_CMP) + cb; dsto[q] = (r & 15) * CP_AROW * 2 + cb; }
            else { const int gb = task * 16 + r, b = gb >> 5, n = gb & 31; const int page = p.page_table[b * 16 + (n >> 1)];
                   src[q] = (const char*)(p.cache_cmp + ((size_t)page * 128 + (n & 1) * 64) * 512) + cb; dsto[q] = r * CP_AROW * 2 + (cb >> 1); }
        }
        const size_t sstride = prompt ? (size_t)PS * 2 : 2048;
        const char* wsrc[2]; int wdst[2];
#pragma unroll
        for (int q = 0; q < 2; ++q) { const int idx = q * 512 + tid, row = idx >> 3, ch = idx & 7; wsrc[q] = (const char*)(p.WCT + (size_t)row * 4096) + ch * 16; wdst[q] = row * 144 + ch * 16; }
        f32x4 acc[4];
#pragma unroll
        for (int nt = 0; nt < 4; ++nt) acc[nt] = (f32x4){0.f, 0.f, 0.f, 0.f};
        f32x4 ra0[4], ra1[4]; u32x4 rw0[2], rw1[2];
        auto issue = [&](int l, f32x4 (&ra)[4], u32x4 (&rw)[2]) {
#pragma unroll
            for (int q = 0; q < 4; ++q) if (q < npieces) ra[q] = *(const f32x4*)(src[q] + (size_t)l * sstride);
#pragma unroll
            for (int q = 0; q < 2; ++q) rw[q] = *(const u32x4*)(wsrc[q] + l * 128);
        };
        auto commit = [&](int buf, const f32x4 (&ra)[4], const u32x4 (&rw)[2]) {
            char* ab = smem + CP_A + buf * CP_ABUF; char* wbuf = smem + CP_W + buf * CP_WBUF;
#pragma unroll
            for (int q = 0; q < 4; ++q) if (q < npieces) {
                if (prompt) *(f32x4*)(ab + dsto[q]) = ra[q];
                else { u32x2 o; o.x = pack2(ra[q][0], ra[q][1]); o.y = pack2(ra[q][2], ra[q][3]); *(u32x2*)(ab + dsto[q]) = o; }
            }
#pragma unroll
            for (int q = 0; q < 2; ++q) *(u32x4*)(wbuf + wdst[q]) = rw[q];
        };
        auto consume = [&](int buf) {
            const char* ab = smem + CP_A + buf * CP_ABUF; const char* wbuf = smem + CP_W + buf * CP_WBUF;
            const bf16_t* arow = (const bf16_t*)ab + (rt * 4 + (fr >> 2)) * CP_AROW + kv * 256 + (fr & 3) * 64 + fq * 8;
#pragma unroll
            for (int hf = 0; hf < 2; ++hf) {
                const bf16x8 a = *(const bf16x8*)(arow + hf * 32);
#pragma unroll
                for (int nt = 0; nt < 4; ++nt) {
                    const bf16x8 bfrag = *(const bf16x8*)(wbuf + (kv * 64 + nt * 16 + fr) * 144 + hf * 64 + fq * 16);
                    acc[nt] = __builtin_amdgcn_mfma_f32_16x16x32_bf16(a, bfrag, acc[nt], 0, 0, 0);
                }
            }
        };
        __syncthreads();
        issue(0, ra0, rw0); issue(1, ra1, rw1); commit(0, ra0, rw0); issue(2, ra0, rw0);
        __syncthreads();
#pragma unroll 1
        for (int l = 0; l < 64; l += 2) {
            consume(0);
            commit(1, ra1, rw1);
            if (l + 3 < 64) issue(l + 3, ra1, rw1);
            __syncthreads();
            consume(1);
            if (l + 2 < 64) commit(0, ra0, rw0);
            if (l + 4 < 64) issue(l + 4, ra0, rw0);
            __syncthreads();
        }
        {
            const int ob = prompt ? (task - 256) * 16 + rt * 4 + fq : 256 + task * 16 + rt * 4 + fq;
#pragma unroll
            for (int nt = 0; nt < 4; ++nt) {
                const float bias = p.PW[kv * 64 + nt * 16 + fr];
#pragma unroll
                for (int r = 0; r < 4; ++r) p.KC[(size_t)ob * 512 + kv * 256 + r * 64 + nt * 16 + fr] = acc[nt][r] + bias;
            }
        }
    }
}

typedef float f32x16 __attribute__((ext_vector_type(16)));
typedef short s16x4 __attribute__((ext_vector_type(4)));
typedef __attribute__((address_space(3))) const char* lds_cptr;
#define MFMA32(a, b, c) __builtin_amdgcn_mfma_f32_32x32x16_bf16(a, b, c, 0, 0, 0)
DEVI int crow(int r, int hi) { return (r & 3) + 8 * (r >> 2) + 4 * hi; }
DEVI unsigned cvtpk(float lo, float hi) { return pack2(lo, hi); }
DEVI s16x4 vtr(lds_cptr p) { return __builtin_bit_cast(s16x4, __builtin_amdgcn_ds_read_tr16_b64_v4i16((__attribute__((address_space(3))) s16x4*)p)); }
DEVI float half_max(float m) { auto rr = __builtin_amdgcn_permlane32_swap(__float_as_uint(m), __float_as_uint(m), false, false); return fmaxf(__uint_as_float(rr[0]), __uint_as_float(rr[1])); }
DEVI float half_sum(float m) { auto rr = __builtin_amdgcn_permlane32_swap(__float_as_uint(m), __float_as_uint(m), false, false); return __uint_as_float(rr[0]) + __uint_as_float(rr[1]); }

struct BlkDesc { const char* k; int stride_bytes; int f32; int count; int pos0; };
DEVI void blk_load(const BlkDesc& d, int tid, u32x4& rk, u32x4& rv) {
    const int key = tid & 63, chunk = tid >> 6;
    rk = (u32x4){0u, 0u, 0u, 0u}; rv = rk;
    if (key < d.count) {
        const char* kr = d.k + (size_t)key * d.stride_bytes;
        if (d.f32) {
            const f32x4* s1 = (const f32x4*)(kr + chunk * 32); const f32x4* s2 = (const f32x4*)(kr + 1024 + chunk * 32);
            rk = pack8f(s1[0], s1[1]); rv = pack8f(s2[0], s2[1]);
        } else { rk = *(const u32x4*)(kr + chunk * 16); rv = *(const u32x4*)(kr + 512 + chunk * 16); }
    }
}
DEVI void blk_store(char* kimg, char* vimg, int tid, const u32x4& rk, const u32x4& rv) {
    const int key = tid & 63, chunk = tid >> 6;
    *(u32x4*)(kimg + chunk * 1024 + key * 16) = rk;
    *(u32x4*)(vimg + (chunk >> 2) * 4096 + key * 64 + (chunk & 3) * 16) = rv;
}

DEVI void attn_tile(const char* kimg, const char* vimg, const bf16x8 (&qr)[4], float& m2, float& lsum, f32x16& o0, f32x16& o1, f32x16& s0, f32x16& s1,
                    float sl, float bb, int lh, int ll, bool fast, float* wsf_hi  , float* wsf_r  , int lane) {
    const int r32 = lane & 31, hi = lane >> 5;
    const f32x16 z = {};
    s0 = z; s1 = z;
    {
        const char* kp = kimg + hi * 1024 + r32 * 16;
#pragma unroll
        for (int d0 = 0; d0 < 4; ++d0) {
            const bf16x8 k0 = *(const bf16x8*)(kp + d0 * 2048), k1 = *(const bf16x8*)(kp + d0 * 2048 + 512);
            s0 = MFMA32(k0, qr[d0], s0); s1 = MFMA32(k1, qr[d0], s1);
        }
    }
    float mx = -1e30f;
    if (fast) {
#pragma unroll
        for (int r = 0; r < 16; ++r) {
            const int c = (r & 3) + 8 * (r >> 2);
            s0[r] = fmaf(s0[r], 1.4426950408889634f, fmaf(sl, (float)c, bb)); s1[r] = fmaf(s1[r], 1.4426950408889634f, fmaf(sl, (float)(c + 32), bb));
            mx = fmaxf(mx, fmaxf(s0[r], s1[r]));
        }
    } else {
#pragma unroll
        for (int r = 0; r < 16; ++r) {
            const int c = (r & 3) + 8 * (r >> 2);
            const float t0 = fmaf(s0[r], 1.4426950408889634f, fmaf(sl, (float)c, bb)), t1 = fmaf(s1[r], 1.4426950408889634f, fmaf(sl, (float)(c + 32), bb));
            s0[r] = (c <= lh && c > ll) ? t0 : -INFINITY; s1[r] = (c + 32 <= lh && c + 32 > ll) ? t1 : -INFINITY;
            mx = fmaxf(mx, fmaxf(s0[r], s1[r]));
        }
    }
    mx = half_max(mx);
    const float mnew = fmaxf(m2, mx);
    const float f = __builtin_amdgcn_exp2f(m2 - mnew);
    m2 = mnew;
    float ps = 0.f;
#pragma unroll
    for (int r = 0; r < 16; ++r) { s0[r] = __builtin_amdgcn_exp2f(s0[r] - mnew); s1[r] = __builtin_amdgcn_exp2f(s1[r] - mnew); ps += s0[r] + s1[r]; }
    lsum = lsum * f + ps;
    if (__any(f != 1.f)) {
        if (hi == 0) *wsf_r = f;
        asm volatile("s_waitcnt lgkmcnt(0)" ::: "memory");
#pragma unroll
        for (int a = 0; a < 4; ++a) {
            const f32x4 fv = *(const f32x4*)(wsf_hi + 8 * a);
#pragma unroll
            for (int k = 0; k < 4; ++k) { o0[4 * a + k] *= fv[k]; o1[4 * a + k] *= fv[k]; }
        }
        asm volatile("s_waitcnt lgkmcnt(0)" ::: "memory");
    }
    u32x4 pw[4];
#pragma unroll
    for (int k = 0; k < 4; ++k) { pw[0][k] = cvtpk(s0[2 * k], s0[2 * k + 1]); pw[1][k] = cvtpk(s0[8 + 2 * k], s0[8 + 2 * k + 1]); pw[2][k] = cvtpk(s1[2 * k], s1[2 * k + 1]); pw[3][k] = cvtpk(s1[8 + 2 * k], s1[8 + 2 * k + 1]); }
    const lds_cptr vp = (lds_cptr)vimg + ((lane >> 4) & 1) * 32 + (lane & 3) * 8 + (4 * hi + ((lane & 15) >> 2)) * 64;
#pragma unroll
    for (int i = 0; i < 8; ++i) {
        const s16x4 lo = vtr(vp + ((i >> 2) * 4096 + (i & 3) * 1024)), hh = vtr(vp + ((i >> 2) * 4096 + (i & 3) * 1024 + 512));
        const bf16x8 vf = (bf16x8){lo[0], lo[1], lo[2], lo[3], hh[0], hh[1], hh[2], hh[3]};
        const bf16x8 pf = __builtin_bit_cast(bf16x8, pw[i & 3]);
        if (i < 4) o0 = MFMA32(pf, vf, o0); else o1 = MFMA32(pf, vf, o1);
    }
}

constexpr int NSA_KV0 = 0, NSA_KV1 = 16384, NSA_WSF = 32768, NSA_IMP = NSA_WSF + 2048, NSA_SEL = NSA_IMP + 16384, NSA_LIST = NSA_SEL + 512, NSA_OST = NSA_LIST + 256, NSA_YAC = NSA_OST + 32768, NSA_LDS = NSA_YAC + 65536;
static_assert(NSA_LDS <= 152 * 1024, "lds");

DEVI BlkDesc nsa_desc(const P& p, bool prompt, int b, int g, int branch, int j) {
    BlkDesc d;
    if (prompt) {
        if (branch == 0) { d.k = (const char*)(p.KC + ((size_t)(b * 64) * 512 + g * 64)); d.stride_bytes = 2048; d.f32 = 1; d.count = 64; d.pos0 = 0; }
        else { d.k = (const char*)(p.PROJ + ((size_t)b * 4096 + j * 64) * PS + (branch == 1 ? C_SLC : C_WIN) + g * 64); d.stride_bytes = PS * 2; d.f32 = 0; d.count = 64; d.pos0 = j * 64; }
    } else {
        if (branch == 0) { d.k = (const char*)(p.KC + ((size_t)(256 + b * 32) * 512 + g * 64)); d.stride_bytes = 2048; d.f32 = 1; d.count = 32; d.pos0 = 0; }
        else if (branch == 1 && j < 32) { const int page = p.page_table[b * 16 + (j >> 1)]; d.k = (const char*)(p.cache_slc + ((size_t)page * 128 + (j & 1) * 64) * 512 + g * 64); d.stride_bytes = 2048; d.f32 = 1; d.count = 64; d.pos0 = j * 64; }
        else if (branch == 2 && j < 8) { d.k = (const char*)(p.cache_win + ((size_t)b * 512 + j * 64) * 512 + g * 64); d.stride_bytes = 2048; d.f32 = 1; d.count = 64; d.pos0 = 1536 + j * 64; }
        else { d.k = (const char*)(p.PROJ + ((size_t)NTP + b * 4) * PS + (branch == 1 ? C_SLC : C_WIN) + g * 64); d.stride_bytes = PS * 2; d.f32 = 0; d.count = 4; d.pos0 = 2048; }
    }
    return d;
}

constexpr int NS_IMG = 0, NS_WSF = 131072, NS_IMP = NS_WSF + 2048, NS_SEL = NS_IMP + 2048, NS_LIST = NS_SEL + 64, NS_YC = NS_LIST + 64, NS_PM = NS_YC + 4096, NS_Q = NS_PM + 2048, NS_LDS = NS_Q + 4096;
static_assert(NS_LDS <= 152 * 1024, "lds");
DEVI void wave_stage_block(const BlkDesc& d, char* kimg, char* vimg, int lane) {
    asm volatile("" : "+v"(lane));
    const int rsub = lane >> 4, pc = lane & 15;
    if (d.f32) {
#pragma unroll
        for (int half = 0; half < 2; ++half) {
#pragma unroll
            for (int i0 = 0; i0 < 16; i0 += 6) {
                f32x4 x[6];
#pragma unroll
                for (int i = 0; i < 6; ++i) if (i0 + i < 16) { const int row = 4 * (i0 + i) + rsub; x[i] = row < d.count ? __builtin_nontemporal_load((const f32x4*)(d.k + (size_t)row * d.stride_bytes + half * 1024 + pc * 16)) : (f32x4){0.f, 0.f, 0.f, 0.f}; }
#pragma unroll
                for (int i = 0; i < 6; ++i) if (i0 + i < 16) {
                    const int row = 4 * (i0 + i) + rsub, c = pc >> 1;
                    u32x2 o; o.x = pack2(x[i][0], x[i][1]); o.y = pack2(x[i][2], x[i][3]);
                    if (half == 0) *(u32x2*)(kimg + c * 1024 + row * 16 + (pc & 1) * 8) = o;
                    else *(u32x2*)(vimg + (c >> 2) * 4096 + row * 64 + (c & 3) * 16 + (pc & 1) * 8) = o;
                }
            }
        }
    } else {
        const int row = lane >> 3, c = lane & 7;
#pragma unroll
        for (int i = 0; i < 8; ++i) {
            const int rr = 8 * i + row;
            u32x4 kk = {0u, 0u, 0u, 0u}, vv = {0u, 0u, 0u, 0u};
            if (rr < d.count) { kk = *(const u32x4*)(d.k + (size_t)rr * d.stride_bytes + c * 16); vv = *(const u32x4*)(d.k + (size_t)rr * d.stride_bytes + 512 + c * 16); }
            *(u32x4*)(kimg + c * 1024 + rr * 16) = kk;
            *(u32x4*)(vimg + (c >> 2) * 4096 + rr * 64 + (c & 3) * 16) = vv;
        }
    }
    asm volatile("s_waitcnt lgkmcnt(0)" ::: "memory");
}

DEVI void nsa_sample_unit(const P& p, char* smem, int us) {
    const int tid = tid_opq(), lane = tid & 63, wid = tid >> 6, r32 = lane & 31, hi = lane >> 5;
    const int b = us >> 2, g = us & 3;
    const size_t rowbase = (size_t)NTP + b * 4;
    char* kimg = smem + NS_IMG + wid * 16384; char* vimg = kimg + 8192;
    float* wsf = (float*)(smem + NS_WSF) + wid * 64;
    float* impb = (float*)(smem + NS_IMP);
    unsigned long long* selm = (unsigned long long*)(smem + NS_SEL);
    unsigned char* blist = (unsigned char*)(smem + NS_LIST);
    float* ycmp = (float*)(smem + NS_YC);
    const int tokl = r32 >> 2, head = r32 & 3;
    const bool tok_ok = r32 < 16;
    const int qpos = 2048 + tokl;
    const float slope2 = alibi_slope(g * 4 + head) * 1.4426950408889634f;
    char* qsh = smem + NS_Q;
    int hi4 = 4 * hi; asm volatile("" : "+v"(hi4));
    float* wsf_hi = wsf + hi4; float* wsf_r = wsf + r32;
    f32x16 s0, s1;
    __syncthreads();
    if (wid == 0) {
        bf16x8 qr[4];
        {
            const bf16_t* qp = p.PROJ + (rowbase + (tok_ok ? tokl : 0)) * PS + C_BQ + (g * 4 + head) * 64 + hi * 8;
#pragma unroll
            for (int d0 = 0; d0 < 4; ++d0) {
                u32x4 v = *(const u32x4*)(qp + d0 * 16);
#pragma unroll
                for (int k = 0; k < 4; ++k) { const float lo = __uint_as_float(v[k] << 16) * 0.125f, hh = __uint_as_float(v[k] & 0xFFFF0000u) * 0.125f; v[k] = tok_ok ? ((__float_as_uint(lo) >> 16) | (__float_as_uint(hh) & 0xFFFF0000u)) : 0u; }
                qr[d0] = __builtin_bit_cast(bf16x8, v);
                *(u32x4*)(qsh + d0 * 1024 + lane * 16) = v;
            }
        }
        f32x16 o0 = {}, o1 = {}; float m2 = -1e30f, lsum = 0.f;
        const BlkDesc d = nsa_desc(p, false, b, g, 0, 0);
        wave_stage_block(d, kimg, vimg, lane);
        const int lh = 31 - hi4;
        const float sl = 64.f * slope2;
        attn_tile(kimg, vimg, qr, m2, lsum, o0, o1, s0, s1, sl, tok_ok ? sl * (float)(hi4 - 32) : -INFINITY, lh, -1000, false, wsf_hi, wsf_r, lane);
        const float lt = half_sum(lsum);
        const float inv = lt > 0.f ? 1.f / lt : 0.f;
        unsigned x[64];
#pragma unroll
        for (int r = 0; r < 16; ++r) {
#pragma unroll
            for (int n = 0; n < 2; ++n) {
                float a = (n == 0 ? s0[r] : s1[r]) * inv;
                a += __shfl_xor(a, 1); a += __shfl_xor(a, 2);
                const int j = (r & 3) + 8 * (r >> 2) + 32 * n + hi4;
                if (j == 32 || j == 0) a = 5.0f;
                if (j > 32) a = -2.0f;
                const unsigned u = __float_as_uint(a);
                const unsigned o = (u & 0x80000000u) ? ~u : (u | 0x80000000u);
                x[n * 16 + r] = (o & ~63u) | (unsigned)(63 - j);
            }
        }
        float fac = 0.f;
        if (tok_ok && lt > 0.f) fac = sigmoidf_(p.SM[(rowbase + tokl) * 64 + 8 + g * 4 + head]) / lt;
        if (hi == 0) *wsf_r = fac;
        asm volatile("s_waitcnt lgkmcnt(0)" ::: "memory");
#pragma unroll
        for (int a = 0; a < 2; ++a) {
            const f32x4 fv = *(const f32x4*)(wsf_hi + 8 * a);
#pragma unroll
            for (int k = 0; k < 4; ++k) { float* yp = ycmp + (8 * a + k + hi4) * 64 + r32; yp[0] = o0[4 * a + k] * fv[k]; yp[32] = o1[4 * a + k] * fv[k]; }
        }
        asm volatile("s_waitcnt lgkmcnt(0)" ::: "memory");
        {
            sort16_desc<0>(x); sort16_desc<16>(x);
            unsigned th[16], oth[16], fin[16];
            merge_top16(&x[0], &x[16], th);
#pragma unroll
            for (int i = 0; i < 16; ++i) { auto rr = __builtin_amdgcn_permlane32_swap(th[i], th[i], false, false); oth[i] = hi ? rr[0] : rr[1]; }
            merge_top16(th, oth, fin);
            unsigned long long mask = 0ull;
#pragma unroll
            for (int i = 0; i < 16; ++i) mask |= 1ull << (63u - (fin[i] & 63u));
            if (head == 0 && hi == 0 && r32 < 16) selm[r32 >> 2] = mask;
        }
        asm volatile("s_waitcnt lgkmcnt(0)" ::: "memory");
        {
            const unsigned long long u = selm[0] | selm[1] | selm[2] | selm[3];
            const int n = __builtin_popcountll(u);
            if ((u >> lane) & 1ull) blist[1 + __builtin_popcountll(u & ((1ull << lane) - 1ull))] = (unsigned char)(0x40 | lane);
            if (lane <= 8) blist[1 + n + lane] = (unsigned char)(0x80 | lane);
            if (lane == 0) blist[0] = (unsigned char)(n + 9);
        }
    }
    __syncthreads();
    const int nb = blist[0];
    const unsigned long long mysel = tok_ok ? selm[tokl] : 0ull;
    int nslc = 0;
    for (int i = 0; i < nb; ++i) nslc += (blist[1 + i] >> 6) == 1 ? 1 : 0;
    float so[16], ms, lst;
    float wo[16], mw, lwt;
#pragma unroll 1
    for (int pass = 0; pass < 2; ++pass) {
        f32x16 o0 = {}, o1 = {}; float m2 = -1e30f, lsum = 0.f;
        const int i0 = pass == 0 ? 0 : nslc, i1 = pass == 0 ? nslc : nb;
#pragma unroll 1
        for (int i = i0 + wid; i < i1; i += 8) {
            const int e = blist[1 + i], br = e >> 6, j = e & 63;
            const BlkDesc d = nsa_desc(p, false, b, g, br, j);
            wave_stage_block(d, kimg, vimg, lane);
            asm volatile("" : "+v"(hi4));
            const bool lsel = tok_ok && (br == 2 || ((mysel >> j) & 1ull));
            const int rel = qpos - d.pos0;
            const int lh = (rel < d.count - 1 ? rel : d.count - 1) - hi4;
            const int ll = (br == 2 ? rel - 512 : -1000) - hi4;
            const bool fast = __all(!lsel || (lh >= 59 && ll < 0));
            const float bb = lsel ? slope2 * (float)(hi4 + d.pos0 - 2048) : -INFINITY;
            bf16x8 qr[4];
#pragma unroll
            for (int d0 = 0; d0 < 4; ++d0) qr[d0] = *(const bf16x8*)(qsh + d0 * 1024 + lane * 16);
            attn_tile(kimg, vimg, qr, m2, lsum, o0, o1, s0, s1, slope2, bb, lh, ll, fast, wsf_hi, wsf_r, lane);
        }
        const float lt = half_sum(lsum);
        if (pass == 0) { ms = m2; lst = lt;
#pragma unroll
            for (int r = 0; r < 8; ++r) { so[r] = o0[r]; so[8 + r] = o1[r]; } }
        else { mw = m2; lwt = lt;
#pragma unroll
            for (int r = 0; r < 8; ++r) { wo[r] = o0[r]; wo[8 + r] = o1[r]; } }
    }
    {
        float* po = (float*)kimg;
        float* pm = (float*)(smem + NS_PM) + wid * 64;
        if (lane < 16) { pm[lane * 2] = ms; pm[lane * 2 + 1] = lst; pm[32 + lane * 2] = mw; pm[32 + lane * 2 + 1] = lwt; }
#pragma unroll
        for (int a = 0; a < 2; ++a)
#pragma unroll
            for (int k = 0; k < 4; ++k) {
                float* yp = po + (8 * a + k + hi4) * 64 + r32;
                yp[0] = so[4 * a + k]; yp[32] = so[8 + 4 * a + k]; yp[1024] = wo[4 * a + k]; yp[1024 + 32] = wo[8 + 4 * a + k];
            }
    }
    __syncthreads();
    {
        const int row = tid >> 5, dcol = tid & 31, tk = row >> 2, hd = row & 3;
        float res[2][2];
#pragma unroll
        for (int br = 0; br < 2; ++br) {
            float M = -1e30f;
#pragma unroll
            for (int w = 0; w < 8; ++w) M = fmaxf(M, ((const float*)(smem + NS_PM))[w * 64 + br * 32 + row * 2]);
            float L = 0.f, a0 = 0.f, a1 = 0.f;
#pragma unroll
            for (int w = 0; w < 8; ++w) {
                const float* pmw = (const float*)(smem + NS_PM) + w * 64 + br * 32 + row * 2;
                const float f = __builtin_amdgcn_exp2f(pmw[0] - M);
                const float* pow_ = (const float*)(smem + NS_IMG + w * 16384) + br * 1024 + row * 64 + dcol;
                L += pmw[1] * f; a0 += pow_[0] * f; a1 += pow_[32] * f;
            }
            const float gate = sigmoidf_(p.SM[(rowbase + tk) * 64 + 8 + (br + 1) * 16 + g * 4 + hd]);
            const float sc = L > 0.f ? gate / L : 0.f;
            res[br][0] = a0 * sc; res[br][1] = a1 * sc;
        }
        const float y0 = ycmp[row * 64 + dcol] + res[0][0] + res[1][0], y1 = ycmp[row * 64 + dcol + 32] + res[0][1] + res[1][1];
        bf16_t* yb = p.YB + (rowbase + tk) * 1024 + (g * 4 + hd) * 64;
        yb[dcol] = f2bf(y0); yb[dcol + 32] = f2bf(y1);
    }
}

constexpr int NP_KVB = 18432, NP_KV0 = 0, NP_KV1 = NP_KVB, NP_WSF = 2 * NP_KVB, NP_IMP = NP_WSF + 2048, NP_SEL = NP_IMP + 16384, NP_LIST = NP_SEL + 512, NP_YAC = NP_LIST + 256, NP_LDS = NP_YAC + 65536;
static_assert(NP_LDS <= 152 * 1024, "lds");
DEVI void blk_store_ext(const BlkDesc& d, int pstep, int poff, int t0, char* kimg, char* vimg, int tid, const u32x4& rk, const u32x4& rv) {
    const int key = tid & 63, chunk = tid >> 6;
    *(u32x4*)(kimg + chunk * 1024 + key * 16) = rk;
    *(u32x4*)(vimg + (chunk >> 2) * 4096 + key * 64 + (chunk & 3) * 16) = rv;
    if (chunk == 0) {
        const int rel = d.pos0 + key * pstep + poff - t0;
        const int phi = (rel >> 6) << 6, plo = rel & 63;
        const unsigned bh = pack2((float)phi, (float)phi), bl = pack2((float)plo, (float)plo);
        *(u32x4*)(kimg + 8 * 1024 + key * 16) = (u32x4){bh, bl, 0x00003F80u, 0u};
    }
}
DEVI void attn_tile2(const char* kimg, const char* vimg, const bf16x8 (&qr)[4], const bf16x8 qext, float& m, float& lsum, f32x16& o0, f32x16& o1, f32x16& s0, f32x16& s1,
                     int lh, int ll, bool fast, float* wsf_hi, float* wsf_r, int lane) {
    const int r32 = lane & 31, hi = lane >> 5;
    const f32x16 z = {};
    s0 = z; s1 = z;
    {
        const char* kp = kimg + hi * 1024 + r32 * 16;
#pragma unroll
        for (int d0 = 0; d0 < 5; ++d0) {
            const bf16x8 k0 = *(const bf16x8*)(kp + d0 * 2048), k1 = *(const bf16x8*)(kp + d0 * 2048 + 512);
            const bf16x8 qf = d0 < 4 ? qr[d0 < 4 ? d0 : 0] : qext;
            s0 = MFMA32(k0, qf, s0); s1 = MFMA32(k1, qf, s1);
        }
    }
    if (!fast) {
#pragma unroll
        for (int r = 0; r < 16; ++r) {
            const int c = (r & 3) + 8 * (r >> 2);
            s0[r] = (c <= lh && c > ll) ? s0[r] : -INFINITY; s1[r] = (c + 32 <= lh && c + 32 > ll) ? s1[r] : -INFINITY;
        }
    }
    float mx = fmaxf(s0[0], s1[0]);
#pragma unroll
    for (int r = 1; r < 16; ++r) mx = fmaxf(mx, fmaxf(s0[r], s1[r]));
    mx = half_max(mx);
    const float mnew = fmaxf(m, mx);
    const float f = __builtin_amdgcn_exp2f((m - mnew) * 1.4426950408889634f);
    m = mnew;
    const float nm2 = -mnew * 1.4426950408889634f;
    float ps = 0.f;
#pragma unroll
    for (int r = 0; r < 16; ++r) { s0[r] = __builtin_amdgcn_exp2f(fmaf(s0[r], 1.4426950408889634f, nm2)); s1[r] = __builtin_amdgcn_exp2f(fmaf(s1[r], 1.4426950408889634f, nm2)); ps += s0[r] + s1[r]; }
    lsum = lsum * f + ps;
    if (__any(f != 1.f)) {
        if (hi == 0) *wsf_r = f;
        asm volatile("s_waitcnt lgkmcnt(0)" ::: "memory");
#pragma unroll
        for (int a = 0; a < 4; ++a) {
            const f32x4 fv = *(const f32x4*)(wsf_hi + 8 * a);
#pragma unroll
            for (int k = 0; k < 4; ++k) { o0[4 * a + k] *= fv[k]; o1[4 * a + k] *= fv[k]; }
        }
        asm volatile("s_waitcnt lgkmcnt(0)" ::: "memory");
    }
    u32x4 pw[4];
#pragma unroll
    for (int k = 0; k < 4; ++k) { pw[0][k] = cvtpk(s0[2 * k], s0[2 * k + 1]); pw[1][k] = cvtpk(s0[8 + 2 * k], s0[8 + 2 * k + 1]); pw[2][k] = cvtpk(s1[2 * k], s1[2 * k + 1]); pw[3][k] = cvtpk(s1[8 + 2 * k], s1[8 + 2 * k + 1]); }
    const lds_cptr vp = (lds_cptr)vimg + ((lane >> 4) & 1) * 32 + (lane & 3) * 8 + (4 * hi + ((lane & 15) >> 2)) * 64;
#pragma unroll
    for (int i = 0; i < 8; ++i) {
        const s16x4 lo = vtr(vp + ((i >> 2) * 4096 + (i & 3) * 1024)), hh = vtr(vp + ((i >> 2) * 4096 + (i & 3) * 1024 + 512));
        const bf16x8 vf = (bf16x8){lo[0], lo[1], lo[2], lo[3], hh[0], hh[1], hh[2], hh[3]};
        const bf16x8 pf = __builtin_bit_cast(bf16x8, pw[i & 3]);
        if (i < 4) o0 = MFMA32(pf, vf, o0); else o1 = MFMA32(pf, vf, o1);
    }
}

DEVI void attn_tile3(const char* kA, const char* vA, const char* kB, const char* vB, const bf16x8 (&qr)[4], const bf16x8 qeA, const bf16x8 qeB, float& m, float& lsum,
                     f32x16& o0, f32x16& o1, int lhA, int llA, bool fastA, int lhB, int llB, bool fastB, float* wsf_hi, float* wsf_r, int lane) {
    const int r32 = lane & 31, hi = lane >> 5;
    f32x16 a0 = {}, a1 = {}, b0 = {}, b1 = {};
    {
        const char* kpa = kA + hi * 1024 + r32 * 16; const char* kpb = kB + hi * 1024 + r32 * 16;
#pragma unroll
        for (int d0 = 0; d0 < 5; ++d0) {
            const bf16x8 ka0 = *(const bf16x8*)(kpa + d0 * 2048), ka1 = *(const bf16x8*)(kpa + d0 * 2048 + 512);
            const bf16x8 kb0 = *(const bf16x8*)(kpb + d0 * 2048), kb1 = *(const bf16x8*)(kpb + d0 * 2048 + 512);
            const bf16x8 qa = d0 < 4 ? qr[d0 < 4 ? d0 : 0] : qeA, qb = d0 < 4 ? qr[d0 < 4 ? d0 : 0] : qeB;
            a0 = MFMA32(ka0, qa, a0); a1 = MFMA32(ka1, qa, a1); b0 = MFMA32(kb0, qb, b0); b1 = MFMA32(kb1, qb, b1);
        }
    }
    if (!fastA) {
#pragma unroll
        for (int r = 0; r < 16; ++r) { const int c = (r & 3) + 8 * (r >> 2); a0[r] = (c <= lhA && c > llA) ? a0[r] : -INFINITY; a1[r] = (c + 32 <= lhA && c + 32 > llA) ? a1[r] : -INFINITY; }
    }
    if (!fastB) {
#pragma unroll
        for (int r = 0; r < 16; ++r) { const int c = (r & 3) + 8 * (r >> 2); b0[r] = (c <= lhB && c > llB) ? b0[r] : -INFINITY; b1[r] = (c + 32 <= lhB && c + 32 > llB) ? b1[r] : -INFINITY; }
    }
    float mx = fmaxf(fmaxf(a0[0], a1[0]), fmaxf(b0[0], b1[0]));
#pragma unroll
    for (int r = 1; r < 16; ++r) mx = fmaxf(mx, fmaxf(fmaxf(a0[r], a1[r]), fmaxf(b0[r], b1[r])));
    mx = half_max(mx);
    const float mnew = fmaxf(m, mx);
    const float f = __builtin_amdgcn_exp2f((m - mnew) * 1.4426950408889634f);
    m = mnew;
    const float nm2 = -mnew * 1.4426950408889634f;
    float ps = 0.f;
#pragma unroll
    for (int r = 0; r < 16; ++r) {
        a0[r] = __builtin_amdgcn_exp2f(fmaf(a0[r], 1.4426950408889634f, nm2)); a1[r] = __builtin_amdgcn_exp2f(fmaf(a1[r], 1.4426950408889634f, nm2));
        b0[r] = __builtin_amdgcn_exp2f(fmaf(b0[r], 1.4426950408889634f, nm2)); b1[r] = __builtin_amdgcn_exp2f(fmaf(b1[r], 1.4426950408889634f, nm2));
        ps += (a0[r] + a1[r]) + (b0[r] + b1[r]);
    }
    lsum = lsum * f + ps;
    if (__any(f != 1.f)) {
        if (hi == 0) *wsf_r = f;
        asm volatile("s_waitcnt lgkmcnt(0)" ::: "memory");
#pragma unroll
        for (int a = 0; a < 4; ++a) {
            const f32x4 fv = *(const f32x4*)(wsf_hi + 8 * a);
#pragma unroll
            for (int k = 0; k < 4; ++k) { o0[4 * a + k] *= fv[k]; o1[4 * a + k] *= fv[k]; }
        }
        asm volatile("s_waitcnt lgkmcnt(0)" ::: "memory");
    }
    const int voff = ((lane >> 4) & 1) * 32 + (lane & 3) * 8 + (4 * hi + ((lane & 15) >> 2)) * 64;
#pragma unroll
    for (int t = 0; t < 2; ++t) {
        const f32x16& p0 = t == 0 ? a0 : b0; const f32x16& p1 = t == 0 ? a1 : b1;
        u32x4 pw[4];
#pragma unroll
        for (int k = 0; k < 4; ++k) { pw[0][k] = cvtpk(p0[2 * k], p0[2 * k + 1]); pw[1][k] = cvtpk(p0[8 + 2 * k], p0[8 + 2 * k + 1]); pw[2][k] = cvtpk(p1[2 * k], p1[2 * k + 1]); pw[3][k] = cvtpk(p1[8 + 2 * k], p1[8 + 2 * k + 1]); }
        const lds_cptr vp = (lds_cptr)(t == 0 ? vA : vB) + voff;
#pragma unroll
        for (int i = 0; i < 8; ++i) {
            const s16x4 lo = vtr(vp + ((i >> 2) * 4096 + (i & 3) * 1024)), hh = vtr(vp + ((i >> 2) * 4096 + (i & 3) * 1024 + 512));
            const bf16x8 vf = (bf16x8){lo[0], lo[1], lo[2], lo[3], hh[0], hh[1], hh[2], hh[3]};
            const bf16x8 pf = __builtin_bit_cast(bf16x8, pw[i & 3]);
            if (i < 4) o0 = MFMA32(pf, vf, o0); else o1 = MFMA32(pf, vf, o1);
        }
    }
}

constexpr int NQ_KVB = 18432, NQ_WSF = 4 * NQ_KVB, NQ_SEL = NQ_WSF + 2048, NQ_LIST = NQ_SEL + 512, NQ_YAC = NQ_LIST + 256, NQ_LDS = NQ_YAC + 65536, NQ_IMP = 2 * NQ_KVB;
static_assert(NQ_LDS <= 152 * 1024, "lds");
DEVI void nsa_prompt_unit(const P& p, char* smem, int unit) {
    const int tid = tid_opq(), lane = tid & 63, wid = tid >> 6, r32 = lane & 31, hi = lane >> 5;
    float* wsf = (float*)(smem + NQ_WSF) + wid * 64;
    float* impb = (float*)(smem + NQ_IMP) + wid * 512;
    unsigned long long* selm = (unsigned long long*)(smem + NQ_SEL);
    unsigned char* blist = (unsigned char*)(smem + NQ_LIST);
    const int b = unit >> 8, g = ((unit >> 6) + b) & 3, qt = (b & 1) ? 63 - (unit & 63) : (unit & 63), t0 = qt * 64;
    const size_t rowbase = (size_t)b * 4096 + t0;
    const int tokl = wid * 8 + (r32 >> 2), head = r32 & 3;
    const int qpos = t0 + tokl;
    const float slope = alibi_slope(g * 4 + head);
    bf16x8 qr[4];
    {
        const bf16_t* qp = p.PROJ + (rowbase + tokl) * PS + C_BQ + (g * 4 + head) * 64 + hi * 8;
#pragma unroll
        for (int d0 = 0; d0 < 4; ++d0) {
            u32x4 v = *(const u32x4*)(qp + d0 * 16);
#pragma unroll
            for (int k = 0; k < 4; ++k) { const float lo = __uint_as_float(v[k] << 16) * 0.125f, hh = __uint_as_float(v[k] & 0xFFFF0000u) * 0.125f; v[k] = (__float_as_uint(lo) >> 16) | (__float_as_uint(hh) & 0xFFFF0000u); }
            qr[d0] = __builtin_bit_cast(bf16x8, v);
        }
    }
    unsigned qe_w;
    { const unsigned sh = (unsigned)f2bf(slope); const float rem = slope - __uint_as_float(sh << 16); qe_w = sh | ((unsigned)f2bf(rem) << 16); if (hi) qe_w = 0u; }
    int hi4 = 4 * hi; asm volatile("" : "+v"(hi4));
    float* yl = (float*)(smem + NQ_YAC) + wid * 2048 + hi4 * 64 + r32;
    float* wsf_hi = wsf + hi4; float* wsf_r = wsf + r32;
    f32x16 o0, o1; float m, lsum;
    auto finish = [&](int br) {
        const float lt = half_sum(lsum);
        float fac = 0.f;
        if (lt > 0.f) fac = sigmoidf_(p.SM[(rowbase + tokl) * 64 + 8 + br * 16 + g * 4 + head]) / lt;
        if (hi == 0) *wsf_r = fac;
        asm volatile("s_waitcnt lgkmcnt(0)" ::: "memory");
#pragma unroll
        for (int a = 0; a < 4; ++a) {
            const f32x4 fv = *(const f32x4*)(wsf_hi + 8 * a);
#pragma unroll
            for (int k = 0; k < 4; ++k) {
                float* yp = yl + (8 * a + k) * 64;
                if (br == 0) { yp[0] = o0[4 * a + k] * fv[k]; yp[32] = o1[4 * a + k] * fv[k]; }
                else { yp[0] += o0[4 * a + k] * fv[k]; yp[32] += o1[4 * a + k] * fv[k]; }
            }
        }
        asm volatile("s_waitcnt lgkmcnt(0)" ::: "memory");
    };
    __syncthreads();
    if (tid < 64) *(u32x4*)(smem + 9 * 1024 + tid * 16) = (u32x4){0u, 0u, 0u, 0u};
    {
        const BlkDesc d = nsa_desc(p, true, b, g, 0, 0);
        u32x4 rk, rv; blk_load(d, tid, rk, rv); blk_store_ext(d, 64, 63, t0, smem, smem + 10240, tid, rk, rv);
        __syncthreads();
        o0 = (f32x16){}; o1 = (f32x16){}; m = -1e30f; lsum = 0.f;
        f32x16 s0, s1;
        {
            const int nv = ((qpos + 1) >> 6) - 1;
            const int lh = (nv < 63 ? nv : 63) - hi4;
            const bf16x8 qext = __builtin_bit_cast(bf16x8, (u32x4){qe_w, qe_w, 0u, 0u});
            attn_tile2(smem, smem + 10240, qr, qext, m, lsum, o0, o1, s0, s1, lh, -1000, false, wsf_hi, wsf_r, lane);
        }
        const float lt = half_sum(lsum);
        const float inv = lt > 0.f ? 1.f / lt : 0.f;
        unsigned x[64];
#pragma unroll
        for (int r = 0; r < 16; ++r) {
#pragma unroll
            for (int n = 0; n < 2; ++n) {
                float a = (n == 0 ? s0[r] : s1[r]) * inv;
                a += __shfl_xor(a, 1); a += __shfl_xor(a, 2);
                const int j = (r & 3) + 8 * (r >> 2) + 32 * n + hi4;
                if (j == qt || j == 0) a = 5.0f;
                if (j > qt) a = -1.0f;
                const unsigned u = __float_as_uint(a);
                const unsigned o = (u & 0x80000000u) ? ~u : (u | 0x80000000u);
                x[n * 16 + r] = (o & ~63u) | (unsigned)(63 - j);
            }
        }
        finish(0);
        sort16_desc<0>(x); sort16_desc<16>(x);
        unsigned th[16], oth[16], fin[16];
        merge_top16(&x[0], &x[16], th);
#pragma unroll
        for (int i = 0; i < 16; ++i) { auto rr = __builtin_amdgcn_permlane32_swap(th[i], th[i], false, false); oth[i] = hi ? rr[0] : rr[1]; }
        merge_top16(th, oth, fin);
        unsigned long long mask = 0ull;
#pragma unroll
        for (int i = 0; i < 16; ++i) mask |= 1ull << (63u - (fin[i] & 63u));
        if (head == 0 && hi == 0) selm[wid * 8 + (r32 >> 2)] = mask;
    }
    __syncthreads();
    if (wid == 0) {
        unsigned long long u = selm[lane];
#pragma unroll
        for (int o = 32; o > 0; o >>= 1) u |= __shfl_xor(u, o);
        u &= (qt == 63) ? ~0ull : ((1ull << (qt + 1)) - 1ull);
        {
            const int n = __builtin_popcountll(u);
            if ((u >> lane) & 1ull) blist[2 + __builtin_popcountll(u & ((1ull << lane) - 1ull))] = (unsigned char)lane;
            const int w0 = qt - 8 > 0 ? qt - 8 : 0, nw = qt - w0 + 1;
            if (lane < nw) blist[2 + n + lane] = (unsigned char)(w0 + lane);
            if (lane == 0) { blist[0] = (unsigned char)n; blist[1] = (unsigned char)nw; }
        }
    }
    __syncthreads();
    if (tid >= 64 && tid < 256) *(u32x4*)(smem + (tid >> 6) * NQ_KVB + 9 * 1024 + (tid & 63) * 16) = (u32x4){0u, 0u, 0u, 0u};
    const int ns = blist[0], nw = blist[1];
    const int nss = (ns + 1) >> 1, nsteps = nss + ((nw + 1) >> 1);
    const unsigned long long mysel = selm[tokl];
    {
        auto step_blocks = [&](int s, int& br, int& jA, int& jB) {
            if (s < nss) { br = 1; jA = blist[2 + 2 * s]; jB = 2 * s + 1 < ns ? (int)blist[2 + 2 * s + 1] : -1; }
            else { const int w = s - nss; br = 2; jA = blist[2 + ns + 2 * w]; jB = 2 * w + 1 < nw ? (int)blist[2 + ns + 2 * w + 1] : -1; }
        };
        u32x4 rkA, rvA, rkB, rvB;
        auto load_step = [&](int s) {
            int br, jA, jB; step_blocks(s, br, jA, jB);
            const BlkDesc dA = nsa_desc(p, true, b, g, br, jA); blk_load(dA, tid, rkA, rvA);
            if (jB >= 0) { const BlkDesc dB = nsa_desc(p, true, b, g, br, jB); blk_load(dB, tid, rkB, rvB); }
        };
        auto store_step = [&](int s, char* buf) {
            int br, jA, jB; step_blocks(s, br, jA, jB);
            BlkDesc dA; dA.pos0 = jA * 64; blk_store_ext(dA, 1, 0, t0, buf, buf + 10240, tid, rkA, rvA);
            if (jB >= 0) { BlkDesc dB; dB.pos0 = jB * 64; blk_store_ext(dB, 1, 0, t0, buf + NQ_KVB, buf + NQ_KVB + 10240, tid, rkB, rvB); }
        };
        load_step(0); store_step(0, smem);
        __syncthreads();
        int prev_br = 1;
        o0 = (f32x16){}; o1 = (f32x16){}; m = -1e30f; lsum = 0.f;
        for (int s = 0; s < nsteps; ++s) {
            int br, jA, jB; step_blocks(s, br, jA, jB);
            char* cur = smem + (s & 1) * 2 * NQ_KVB;
            char* nxt = smem + ((s & 1) ^ 1) * 2 * NQ_KVB;
            if (s + 1 < nsteps) load_step(s + 1);
            if (br != prev_br) { finish(1); o0 = (f32x16){}; o1 = (f32x16){}; m = -1e30f; lsum = 0.f; prev_br = br; }
            {
                asm volatile("" : "+v"(hi4));
                const bool lselA = br == 2 || ((mysel >> jA) & 1ull);
                const int relA = qpos - jA * 64;
                const int lhA = (relA < 63 ? relA : 63) - hi4, llA = (br == 2 ? relA - 512 : -1000) - hi4;
                const bool fastA = __all(!lselA || (lhA >= 59 && llA < 0));
                const bool needA = __any(lselA && lhA + hi4 >= 0 && llA + hi4 < 63);
                const bf16x8 qeA = __builtin_bit_cast(bf16x8, (u32x4){qe_w, qe_w, (lselA || hi) ? 0u : 0x0000C6EAu, 0u});
                bool needB = false; bool lselB = false; int lhB = -1000, llB = -1000; bool fastB = false;
                if (jB >= 0) {
                    lselB = br == 2 || ((mysel >> jB) & 1ull);
                    const int relB = qpos - jB * 64;
                    lhB = (relB < 63 ? relB : 63) - hi4; llB = (br == 2 ? relB - 512 : -1000) - hi4;
                    fastB = __all(!lselB || (lhB >= 59 && llB < 0));
                    needB = __any(lselB && lhB + hi4 >= 0 && llB + hi4 < 63);
                }
                const bf16x8 qeB = __builtin_bit_cast(bf16x8, (u32x4){qe_w, qe_w, (lselB || hi) ? 0u : 0x0000C6EAu, 0u});
                f32x16 s0, s1;
                if (needA && needB) attn_tile3(cur, cur + 10240, cur + NQ_KVB, cur + NQ_KVB + 10240, qr, qeA, qeB, m, lsum, o0, o1, lhA, llA, fastA, lhB, llB, fastB, wsf_hi, wsf_r, lane);
                else if (needA) attn_tile2(cur, cur + 10240, qr, qeA, m, lsum, o0, o1, s0, s1, lhA, llA, fastA, wsf_hi, wsf_r, lane);
                else if (needB) attn_tile2(cur + NQ_KVB, cur + NQ_KVB + 10240, qr, qeB, m, lsum, o0, o1, s0, s1, lhB, llB, fastB, wsf_hi, wsf_r, lane);
            }
            if (s + 1 < nsteps) store_step(s + 1, nxt);
            __syncthreads();
        }
        finish(2);
    }
    {
        const float* yac = (const float*)(smem + NQ_YAC) + wid * 2048;
#pragma unroll
        for (int i = 0; i < 4; ++i) {
            const int orow = i * 8 + (lane >> 3), ch = lane & 7, tk = wid * 8 + (orow >> 2), hd = orow & 3;
            const f32x4 a = *(const f32x4*)(yac + orow * 64 + ch * 8), c = *(const f32x4*)(yac + orow * 64 + ch * 8 + 4);
            *(u32x4*)(p.YB + (rowbase + tk) * 1024 + (g * 4 + hd) * 64 + ch * 8) = pack8f(a, c);
        }
        asm volatile("s_waitcnt lgkmcnt(0)" ::: "memory");
    }
}

DEVI void stage_nsa_attn(const P& p, char* smem, int bid, int nblk) {
#ifndef NSA_REP
#define NSA_REP 0
#endif
    const int n_units = 1024 + 512 + (NSA_REP == 1 ? 1024 : 0) + (NSA_REP == 2 ? 512 : 0);
    for (int unit0 = bid; unit0 < n_units; unit0 += nblk) {
        const int unit = unit0 < 1536 ? unit0 : (NSA_REP == 1 ? unit0 - 1536 : unit0 - 512);
        if (unit < 1024) nsa_prompt_unit(p, smem, unit); else nsa_sample_unit(p, smem, unit - 1024);
    }
}

DEVI void stage_ln1(const P& p, int bid, int nblk) {
    const int lane = tid_opq() & 63, wid = tid_opq() >> 6;
    for (int row = bid * 8 + wid; row < NT; row += nblk * 8) {
        f32x4 x[4];
        float s = 0.f;
#pragma unroll
        for (int i = 0; i < 4; ++i) { x[i] = *(const f32x4*)(p.R + (size_t)row * 1024 + i * 256 + lane * 4); s += x[i][0] + x[i][1] + x[i][2] + x[i][3]; }
        const float mean = wave_sum(s) * (1.f / 1024.f);
        float q = 0.f;
#pragma unroll
        for (int i = 0; i < 4; ++i)
#pragma unroll
            for (int k = 0; k < 4; ++k) q += (x[i][k] - mean) * (x[i][k] - mean);
        const float rs = rsqrtf(wave_sum(q) * (1.f / 1024.f) + LN_EPS);
#pragma unroll
        for (int i = 0; i < 4; ++i) {
            const int c = i * 256 + lane * 4;
            const f32x4 gg = *(const f32x4*)(p.ln1_g + c), bb = *(const f32x4*)(p.ln1_b + c);
            f32x4 y;
#pragma unroll
            for (int k = 0; k < 4; ++k) y[k] = (x[i][k] - mean) * rs * gg[k] + bb[k];
            u32x2 o; o.x = pack2(y[0], y[1]); o.y = pack2(y[2], y[3]);
            *(u32x2*)(p.HB + (size_t)row * 1024 + c) = o;
        }
        if (lane == 0) { p.H[(size_t)row * 2] = mean; p.H[(size_t)row * 2 + 1] = rs; }
    }
}

__device__ const unsigned char PEER_CA[50] = {0,0,0,0,0,0,0,0,0,0,0,0,0,0,0,0, 1,1,1,1,1,1,1,1, 2,2,2,2,2, 3,3,3,3, 4,4,4, 5,5, 6,6, 7,7, 8,9,10,11,12,13,14,15};
__device__ const unsigned char PEER_CB[50] = {0,1,2,3,4,5,6,7,8,9,10,11,12,13,14,15, 0,1,2,3,4,5,6,7, 0,1,2,3,4, 0,1,2,3, 0,1,2, 0,1, 0,1, 0,1, 0,0,0,0,0,0,0,0};

DEVI float key_score(unsigned k) { const unsigned u = k & ~127u; return __uint_as_float((u & 0x80000000u) ? (u & 0x7FFFFFFFu) : ~u); }

DEVI void sort8_desc(unsigned (&x)[16]) {
#pragma unroll
    for (int k = 2; k <= 8; k <<= 1)
#pragma unroll
        for (int j = k >> 1; j > 0; j >>= 1)
#pragma unroll
            for (int i = 0; i < 8; ++i) {
                const int l = i ^ j;
                if (l > i) { if ((i & k) == 0) ce_desc(x[i], x[l]); else ce_desc(x[l], x[i]); }
            }
}
DEVI unsigned sum_key(unsigned ka, unsigned kb, unsigned tag) {
    const unsigned u = __float_as_uint(key_score(ka) + key_score(kb));
    const unsigned o = (u & 0x80000000u) ? ~u : (u | 0x80000000u);
    return (o & ~255u) | tag;
}
DEVI float key_score8(unsigned k) { const unsigned u = k & ~255u; return __uint_as_float((u & 0x80000000u) ? (u & 0x7FFFFFFFu) : ~u); }

DEVI void route_top16(const P& p, int row, int ph, int c, int r32, int hi, int hi4, unsigned (&fin)[16]) {
    f32x16 acc[4];
#pragma unroll
    for (int t = 0; t < 4; ++t) acc[t] = (f32x16){};
    const bf16_t* qp = p.PQ + (size_t)row * 2048 + ph * 256 + c * 128 + hi * 8;
    const bf16_t* kp = p.KEYSB + ((size_t)((ph * 2 + c) * 128 + r32)) * 128 + hi * 8;
#pragma unroll
    for (int s8 = 0; s8 < 8; ++s8) {
        const bf16x8 qf = *(const bf16x8*)(qp + s8 * 16);
#pragma unroll
        for (int t = 0; t < 4; ++t) {
            const bf16x8 kf = *(const bf16x8*)(kp + (size_t)t * 32 * 128 + s8 * 16);
            acc[t] = MFMA32(kf, qf, acc[t]);
        }
    }
    unsigned x[64];
#pragma unroll
    for (int t = 0; t < 4; ++t)
#pragma unroll
        for (int r = 0; r < 16; ++r) {
            const unsigned u = __float_as_uint(acc[t][r]);
            const unsigned o = (u & 0x80000000u) ? ~u : (u | 0x80000000u);
            x[t * 16 + r] = (o & ~127u) | (unsigned)(127 - ((r & 3) + 8 * (r >> 2) + 32 * t) - hi4);
        }
    sort16_desc<0>(x); sort16_desc<16>(x); sort16_desc<32>(x); sort16_desc<48>(x);
    unsigned t01[16], t23[16], tt[16], oth[16];
    merge_top16(&x[0], &x[16], t01); merge_top16(&x[32], &x[48], t23); merge_top16(t01, t23, tt);
#pragma unroll
    for (int i = 0; i < 16; ++i) { auto rr = __builtin_amdgcn_permlane32_swap(tt[i], tt[i], false, false); oth[i] = hi ? rr[0] : rr[1]; }
    merge_top16(tt, oth, fin);
}

DEVI void stage_peer_route(const P& p, char* smem, int bid, int nblk, int p0, int p1) {
    const int lane = tid_opq() & 63, wid = tid_opq() >> 6, r32 = lane & 31, hi = lane >> 5;
    unsigned char* tb = (unsigned char*)smem + wid * 1024 + r32 * 32;
    const int tpw = (NT + nblk - 1) / nblk, row_lo = bid * tpw, row_hi = (row_lo + tpw < NT) ? row_lo + tpw : NT;
    const int ph = wid;
    for (int pass = p0; pass < p1 && row_lo + pass * 32 < row_hi; ++pass) {
        const int row_raw = row_lo + pass * 32 + r32;
        const bool row_ok = row_raw < row_hi;
        const int row = row_ok ? row_raw : row_lo;
        int hi4 = 4 * hi; asm volatile("" : "+v"(hi4));
        unsigned fa[16], fb[16];
        route_top16(p, row, ph, 0, r32, hi, hi4, fa);
        asm volatile("" : "+v"(hi4));
        route_top16(p, row, ph, 1, r32, hi, hi4, fb);
        if (hi == 0) {
            u32x4 wa, wb;
#pragma unroll
            for (int i = 0; i < 4; ++i) {
                wa[i] = (127u - (fa[4 * i] & 127u)) | ((127u - (fa[4 * i + 1] & 127u)) << 8) | ((127u - (fa[4 * i + 2] & 127u)) << 16) | ((127u - (fa[4 * i + 3] & 127u)) << 24);
                wb[i] = (127u - (fb[4 * i] & 127u)) | ((127u - (fb[4 * i + 1] & 127u)) << 8) | ((127u - (fb[4 * i + 2] & 127u)) << 16) | ((127u - (fb[4 * i + 3] & 127u)) << 24);
            }
            *(u32x4*)tb = wa; *(u32x4*)(tb + 16) = wb;
        }
        unsigned g0[16], g1[16], g2[16], g3[16];
#pragma unroll
        for (int j = 0; j < 16; ++j) g0[j] = sum_key(fa[0], fb[j], (unsigned)j);
#pragma unroll
        for (int k = 0; k < 15; ++k) g1[k] = sum_key(fa[k + 1], fb[0], (unsigned)((k + 1) << 4));
        g1[15] = 0u;
#pragma unroll
        for (int j = 1; j < 8; ++j) g2[j - 1] = sum_key(fa[1], fb[j], (unsigned)(16 | j));
        g2[7] = 0u; g2[8] = 0u; g2[9] = 0u;
#pragma unroll
        for (int i = 2; i < 8; ++i) g2[17 - i] = sum_key(fa[i], fb[1], (unsigned)((i << 4) | 1));
#pragma unroll
        for (int j = 8; j > 0; j >>= 1)
#pragma unroll
            for (int i = 0; i < 16; ++i) { const int l = i ^ j; if (l > i) ce_desc(g2[i], g2[l]); }
        g3[0] = sum_key(fa[2], fb[2], 0x22u); g3[1] = sum_key(fa[2], fb[3], 0x23u); g3[2] = sum_key(fa[2], fb[4], 0x24u);
        g3[3] = sum_key(fa[3], fb[2], 0x32u); g3[4] = sum_key(fa[4], fb[2], 0x42u); g3[5] = sum_key(fa[3], fb[3], 0x33u);
#pragma unroll
        for (int i = 6; i < 16; ++i) g3[i] = 0u;
        sort8_desc(g3);
        unsigned t01[16], t23[16], top[16];
        merge_top16(g0, g1, t01); merge_top16(g2, g3, t23); merge_top16(t01, t23, top);
        float ev[16]; float sum = 0.f;
        const float vmax = key_score8(top[0]);
#pragma unroll
        for (int k = 0; k < 16; ++k) { ev[k] = __expf(key_score8(top[k]) - vmax); sum += ev[k]; }
        const float inv = 1.f / sum;
        asm volatile("s_waitcnt lgkmcnt(0)" ::: "memory");
        if (!row_ok) {   } else if (hi == 0) {
            int* dst = p.EIDX + (size_t)row * 128 + ph * 16;
#pragma unroll
            for (int q4 = 0; q4 < 4; ++q4) {
                u32x4 o;
#pragma unroll
                for (int k = 0; k < 4; ++k) { const unsigned tg = top[q4 * 4 + k] & 255u; o[k] = (unsigned)tb[tg >> 4] * 128u + (unsigned)tb[16 + (tg & 15u)]; }
                *(u32x4*)(dst + q4 * 4) = o;
            }
        } else {
            float* dst = p.EGATE + (size_t)row * 128 + ph * 16;
#pragma unroll
            for (int q4 = 0; q4 < 4; ++q4) *(f32x4*)(dst + q4 * 4) = (f32x4){ev[q4 * 4] * inv, ev[q4 * 4 + 1] * inv, ev[q4 * 4 + 2] * inv, ev[q4 * 4 + 3] * inv};
        }
        asm volatile("s_waitcnt lgkmcnt(0)" ::: "memory");
    }
}

constexpr int PA_WAVE_LDS = 1024 + 1024 + 512 + 512 + 512;
DEVI void stage_peer_apply(const P& p, char* smem, int bid, int nblk, int p0, int p1) {
    const int lane = tid_opq() & 63, wid = tid_opq() >> 6;
    char* wl = smem + wid * PA_WAVE_LDS;
    unsigned char* hhi = (unsigned char*)wl; unsigned char* hlo = hhi + 1024;
    int* idxs = (int*)(wl + 2048);
    float* gts = (float*)(wl + 2560);
    float* cs = (float*)(wl + 3072);
    const int fr = lane & 15, fq = lane >> 4;
    const int tpw = (NT + nblk - 1) / nblk, row_lo = bid * tpw, row_hi = (row_lo + tpw < NT) ? row_lo + tpw : NT;
    for (int row = row_lo + p0 * 32 + wid; row < row_hi && row < row_lo + p1 * 32; row += 8) {
        float hv[16];
        {
            const float* hr = p.R + (size_t)row * 1024 + lane * 16;
            const float mean1 = p.H[(size_t)row * 2], rs1 = p.H[(size_t)row * 2 + 1];
            u32x4 ohi, olo;
#pragma unroll
            for (int i = 0; i < 4; ++i) {
                f32x4 x = *(const f32x4*)(hr + i * 4);
                { const f32x4 g1 = *(const f32x4*)(p.ln1_g + lane * 16 + i * 4), b1 = *(const f32x4*)(p.ln1_b + lane * 16 + i * 4);
#pragma unroll
                  for (int k = 0; k < 4; ++k) x[k] = (x[k] - mean1) * rs1 * g1[k] + b1[k]; }
#pragma unroll
                for (int k = 0; k < 4; ++k) hv[i * 4 + k] = x[k];
                int w = __builtin_amdgcn_cvt_pk_fp8_f32(x[0], x[1], 0, false); w = __builtin_amdgcn_cvt_pk_fp8_f32(x[2], x[3], w, true);
                const f32x2 d01 = __builtin_amdgcn_cvt_pk_f32_fp8(w, false), d23 = __builtin_amdgcn_cvt_pk_f32_fp8(w, true);
                int w2 = __builtin_amdgcn_cvt_pk_fp8_f32(x[0] - d01[0], x[1] - d01[1], 0, false); w2 = __builtin_amdgcn_cvt_pk_fp8_f32(x[2] - d23[0], x[3] - d23[1], w2, true);
                ohi[i] = (unsigned)w; olo[i] = (unsigned)w2;
            }
            *(u32x4*)(hhi + lane * 16) = ohi; *(u32x4*)(hlo + lane * 16) = olo;
            idxs[lane] = p.EIDX[(size_t)row * 128 + lane]; idxs[lane + 64] = p.EIDX[(size_t)row * 128 + 64 + lane];
            gts[lane] = p.EGATE[(size_t)row * 128 + lane]; gts[lane + 64] = p.EGATE[(size_t)row * 128 + 64 + lane];
            asm volatile("s_waitcnt lgkmcnt(0)" ::: "memory");
        }
        {
            u32x4 a0[16], a1[16];
            auto issue_u = [&](int g, u32x4 (&a)[16]) {
                const unsigned char* ub = p.U8 + (size_t)idxs[g * 16 + fr] * 1024 + fq * 16;
#pragma unroll
                for (int s2 = 0; s2 < 16; ++s2) a[s2] = *(const u32x4*)(ub + s2 * 64);
            };
            auto consume_u = [&](int g, const u32x4 (&a)[16]) {
                f32x4 acc = (f32x4){0.f, 0.f, 0.f, 0.f};
#pragma unroll
                for (int s2 = 0; s2 < 16; ++s2) {
                    const u32x4 bh = *(const u32x4*)(hhi + s2 * 64 + fq * 16), bl = *(const u32x4*)(hlo + s2 * 64 + fq * 16);
                    const long x0 = (long)(((unsigned long long)a[s2][1] << 32) | a[s2][0]), x1 = (long)(((unsigned long long)a[s2][3] << 32) | a[s2][2]);
                    const long h0 = (long)(((unsigned long long)bh[1] << 32) | bh[0]), h1 = (long)(((unsigned long long)bh[3] << 32) | bh[2]);
                    const long l0 = (long)(((unsigned long long)bl[1] << 32) | bl[0]), l1 = (long)(((unsigned long long)bl[3] << 32) | bl[2]);
                    acc = __builtin_amdgcn_mfma_f32_16x16x32_fp8_fp8(x0, h0, acc, 0, 0, 0);
                    acc = __builtin_amdgcn_mfma_f32_16x16x32_fp8_fp8(x1, h1, acc, 0, 0, 0);
                    acc = __builtin_amdgcn_mfma_f32_16x16x32_fp8_fp8(x0, l0, acc, 0, 0, 0);
                    acc = __builtin_amdgcn_mfma_f32_16x16x32_fp8_fp8(x1, l1, acc, 0, 0, 0);
                }
                const f32x4 gg = *(const f32x4*)(gts + g * 16 + fq * 4);
                f32x4 cv;
#pragma unroll
                for (int r = 0; r < 4; ++r) {
                    const int e = idxs[g * 16 + fq * 4 + r];
                    const float d = acc[r] * p.US[e];
                    cv[r] = gg[r] * p.VS[e] * 0.5f * d * (1.f + erff(d * 0.7071067811865476f));
                }
                if (fr == 0) *(f32x4*)(cs + g * 16 + fq * 4) = cv;
            };
            issue_u(0, a0);
#pragma unroll 1
            for (int g = 0; g < 8; g += 2) {
                issue_u(g + 1, a1);
                consume_u(g, a0);
                if (g + 2 < 8) issue_u(g + 2, a0);
                consume_u(g + 1, a1);
            }
        }
        asm volatile("s_waitcnt lgkmcnt(0)" ::: "memory");
        float acc[16];
#pragma unroll
        for (int i = 0; i < 16; ++i) acc[i] = 0.f;
        {
            u32x4 v0[8], v1[8];
            auto issue_v = [&](int e0, u32x4 (&v)[8]) {
#pragma unroll
                for (int k = 0; k < 8; ++k) v[k] = *(const u32x4*)(p.V8 + (size_t)idxs[e0 + k] * 1024 + lane * 16);
            };
            auto consume_v = [&](int e0, const u32x4 (&v)[8]) {
#pragma unroll
                for (int k = 0; k < 8; ++k) {
                    const float c = cs[e0 + k];
#pragma unroll
                    for (int w = 0; w < 4; ++w) {
                        const f32x2 lo = __builtin_amdgcn_cvt_pk_f32_fp8((int)v[k][w], false), hh = __builtin_amdgcn_cvt_pk_f32_fp8((int)v[k][w], true);
                        acc[w * 4] += c * lo[0]; acc[w * 4 + 1] += c * lo[1]; acc[w * 4 + 2] += c * hh[0]; acc[w * 4 + 3] += c * hh[1];
                    }
                }
            };
            issue_v(0, v0);
#pragma unroll 1
            for (int e0 = 0; e0 < 128; e0 += 16) {
                issue_v(e0 + 8, v1);
                consume_v(e0, v0);
                if (e0 + 16 < 128) issue_v(e0 + 16, v0);
                consume_v(e0 + 8, v1);
            }
        }
        float s = 0.f;
#pragma unroll
        for (int i = 0; i < 16; ++i) { acc[i] += DN_ALPHA * hv[i]; s += acc[i]; }
        const float mean = wave_sum(s) * (1.f / 1024.f);
        float q = 0.f;
#pragma unroll
        for (int i = 0; i < 16; ++i) q += (acc[i] - mean) * (acc[i] - mean);
        const float rs = rsqrtf(wave_sum(q) * (1.f / 1024.f) + LN_EPS);
#pragma unroll
        for (int i = 0; i < 4; ++i) {
            const int c = lane * 16 + i * 4;
            const f32x4 g0 = *(const f32x4*)(p.ln2_g + c), b0 = *(const f32x4*)(p.ln2_b + c);
            f32x4 y0;
#pragma unroll
            for (int k = 0; k < 4; ++k) y0[k] = (acc[i * 4 + k] - mean) * rs * g0[k] + b0[k];
            *(f32x4*)(p.out + O_Y + (size_t)row * 1024 + c) = y0;
        }
    }
}

namespace pg8 {
#define PG8_LAS __attribute__((address_space(3)))
typedef unsigned short bf16_t;
typedef short bf16x8 __attribute__((ext_vector_type(8)));
typedef float f32x4 __attribute__((ext_vector_type(4)));
typedef unsigned u32x4 __attribute__((ext_vector_type(4)));
constexpr int BM = 256, BK = 64, HALF = 128, HTB = HALF * BK * 2  , STAGE_BYTES = 8 * HTB, NXCD = 8, WGM = 8;

__host__ __device__ __forceinline__ int lds_byte(int r, int c) { const int st = (r >> 4) * 2 + (c >> 5), rr = r & 15, cc = c & 31, ob = rr * 64 + cc * 2; return st * 1024 + (ob ^ (((ob >> 9) & 1) << 5)); }
__host__ __device__ __forceinline__ void stage_rc(int b, int& R, int& C) { const int st = b / 1024, sb = b % 1024, swz = sb ^ (((sb >> 9) & 1) << 5); R = (st >> 1) * 16 + swz / 64; C = (st & 1) * 32 + (swz % 64) / 2; }
__host__ __device__ __forceinline__ int perm32(int rho) { const int n = rho >> 4, i = rho & 15; return 8 * (i >> 2) + 4 * n + (i & 3); }

struct Unit { int pm, pn; };
struct Gemm { const bf16_t* A; const bf16_t* Bt; int M, N, K; };

struct StaticOrder {
    int nM, nN, nwg, G, c;
    __host__ __device__ void init(int M, int N, int G_, int c_) { nM = M / BM; nN = N / BM; nwg = nM * nN; G = G_; c = c_; }
    __host__ __device__ bool next(int i, Unit& u) const {
        const long L = (long)i * G + c; if (L >= nwg) return false;
        int wgid = (int)L; { const int q = nwg / NXCD, r = nwg % NXCD, xcd = wgid % NXCD, off = wgid / NXCD; wgid = (xcd < r ? xcd * (q + 1) : r * (q + 1) + (xcd - r) * q) + off; }
        const int nig = WGM * nN, gid = wgid / nig, fm = gid * WGM, gsz = (nM - fm) < WGM ? (nM - fm) : WGM;
        u.pm = fm + ((wgid % nig) % gsz); u.pn = (wgid % nig) / gsz; return true;
    }
    __device__ __forceinline__ void a_ready(const Unit&) const {}
    __device__ __forceinline__ void done(const Unit&) const {}
};
template <class Epi, class Sched, bool STAMP = false>
__device__ __forceinline__ void gemm_phase(PG8_LAS unsigned char* lds, const Gemm g, const Sched& S, const Epi& E, unsigned long long* stamps) {
    const int tid = tid_opq(), wid = __builtin_amdgcn_readfirstlane(tid >> 6), lane = tid & 63, wr = wid >> 2, wc = wid & 3, fr = lane & 15, fq = lane >> 4;
    const int K = g.K, nt = K / BK;
    int ts_lo = 0, ts_hi = 0, nts = 0; const unsigned long long rt_entry = STAMP ? (unsigned long long)wall_clock64() : 0ull;
#define PG8_STAMP() do { if (STAMP && wid == 0 && nts < 64) { const unsigned long long _c = (unsigned long long)clock64(); \
        ts_lo = (lane == nts) ? (int)(unsigned)_c : ts_lo; ts_hi = (lane == nts) ? (int)(unsigned)(_c >> 32) : ts_hi; ++nts; } } while (0)
    PG8_STAMP();
    unsigned voffA[2], voffB[2];
#pragma unroll
    for (int i = 0; i < 2; ++i) { int R, C; stage_rc(tid * 16 + i * 8192, R, C); const int Rb = Epi::PERM ? ((R & ~31) + perm32(R & 31)) : R;
        voffA[i] = (unsigned)(R * K + C) * 2u; voffB[i] = (unsigned)(Rb * K + C) * 2u; }
    const size_t kstep = (size_t)(BK * 2);
    const size_t hstep = (size_t)HALF * K * 2;
    const size_t tstep = 2 * hstep;
    const unsigned ldsw = (unsigned)wid * 1024u;
    const int aoff = lds_byte(wr * 64 + fr, fq * 8), boff = lds_byte(wc * 32 + fr, fq * 8);
#define PG8_SA(b, h) (((b) * 2 + (h)) * HTB)
#define PG8_SB(b, h) ((4 + (b) * 2 + (h)) * HTB)
#define PG8_STAGE(bufoff, gbase, voff) do { _Pragma("unroll") for (int _i = 0; _i < 2; ++_i) \
        __builtin_amdgcn_global_load_lds((const unsigned*)((const char*)(gbase) + (voff)[_i]), (PG8_LAS unsigned*)(lds + (bufoff) + ldsw + _i * 8192), 16, 0, 0); } while (0)
#define PG8_LDA(dst, b, h) do { _Pragma("unroll") for (int m = 0; m < 4; ++m) _Pragma("unroll") for (int k = 0; k < 2; ++k) dst[m][k] = *(const PG8_LAS bf16x8*)(lds + PG8_SA(b, h) + aoff + m * 2048 + k * 1024); } while (0)
#define PG8_LDB(dst, b, h) do { _Pragma("unroll") for (int n = 0; n < 2; ++n) _Pragma("unroll") for (int k = 0; k < 2; ++k) dst[n][k] = *(const PG8_LAS bf16x8*)(lds + PG8_SB(b, h) + boff + n * 2048 + k * 1024); } while (0)
#define PG8_MMA(ai, bj, At, Bt) do { __builtin_amdgcn_s_setprio(1); _Pragma("unroll") for (int m = 0; m < 4; ++m) _Pragma("unroll") for (int n = 0; n < 2; ++n) _Pragma("unroll") for (int k = 0; k < 2; ++k) \
        acc[ai][bj][m][n] = __builtin_amdgcn_mfma_f32_16x16x32_bf16(Bt[n][k], At[m][k], acc[ai][bj][m][n], 0, 0, 0); __builtin_amdgcn_s_setprio(0); } while (0)
#define PG8_WAIT_V(n) asm volatile("s_waitcnt vmcnt(" #n ")" ::: "memory")
#define PG8_WAIT_L(n) asm volatile("s_waitcnt lgkmcnt(" #n ")" ::: "memory")
#define PG8_BAR __builtin_amdgcn_s_barrier()
#define PG8_SCHED __builtin_amdgcn_sched_barrier(0)
    Unit cur, nxt; int ui = 0;
    if (!S.next(0, cur)) return;
    f32x4 acc[2][2][4][2];
#pragma unroll
    for (int a = 0; a < 2; ++a)
#pragma unroll
        for (int b = 0; b < 2; ++b)
#pragma unroll
            for (int m = 0; m < 4; ++m)
#pragma unroll
                for (int n = 0; n < 2; ++n) acc[a][b][m][n] = (f32x4){0.f, 0.f, 0.f, 0.f};
    bf16x8 At[4][2], B0[2][2], B1[2][2];
    const char* cA = (const char*)g.A + (size_t)cur.pm * tstep; const char* cB = (const char*)g.Bt + (size_t)cur.pn * tstep;
    S.a_ready(cur);
    PG8_STAGE(PG8_SB(0, 0), cB, voffB); PG8_STAGE(PG8_SA(0, 0), cA, voffA); PG8_STAGE(PG8_SB(0, 1), cB + hstep, voffB); PG8_STAGE(PG8_SA(0, 1), cA + hstep, voffA);
    if (wr == 1) PG8_BAR;
    PG8_WAIT_V(4); PG8_BAR;
    PG8_STAGE(PG8_SB(1, 0), cB + kstep, voffB); PG8_STAGE(PG8_SA(1, 0), cA + kstep, voffA); PG8_STAGE(PG8_SB(1, 1), cB + hstep + kstep, voffB);
    PG8_WAIT_V(6); PG8_BAR;
    PG8_STAMP();
    for (;;) {
        const bool has_next = S.next(ui + 1, nxt);
        const char* nA = has_next ? (const char*)g.A + (size_t)nxt.pm * tstep : cA; const char* nB = has_next ? (const char*)g.Bt + (size_t)nxt.pn * tstep : cB;
        for (int t = 0; t < nt; t += 2) {
            const bool last = (t == nt - 2);
            const char* a1 = cA + (size_t)(t + 1) * kstep;
            const char* a2 = last ? nA : cA + (size_t)(t + 2) * kstep; const char* b2 = last ? nB : cB + (size_t)(t + 2) * kstep;
            const char* a3 = a2 + kstep; const char* b3 = b2 + kstep;
            if (last && has_next) S.a_ready(nxt);
            PG8_LDB(B0, 0, 0); PG8_SCHED; PG8_LDA(At, 0, 0); PG8_STAGE(PG8_SA(1, 1), a1 + hstep, voffA);
            PG8_WAIT_L(8); PG8_BAR; PG8_WAIT_L(0); PG8_MMA(0, 0, At, B0); PG8_BAR; PG8_SCHED;
            PG8_LDB(B1, 0, 1); PG8_STAGE(PG8_SB(0, 0), b2, voffB);
            PG8_BAR; PG8_WAIT_L(0); PG8_MMA(0, 1, At, B1); PG8_BAR;
            PG8_LDA(At, 0, 1); PG8_STAGE(PG8_SA(0, 0), a2, voffA);
            PG8_BAR; PG8_WAIT_L(0); PG8_MMA(1, 0, At, B0); PG8_BAR; PG8_SCHED;
            PG8_STAGE(PG8_SB(0, 1), b2 + hstep, voffB);
            PG8_WAIT_V(6); PG8_BAR; PG8_MMA(1, 1, At, B1); PG8_BAR;
            PG8_LDB(B0, 1, 0); PG8_SCHED; PG8_LDA(At, 1, 0); PG8_STAGE(PG8_SA(0, 1), a2 + hstep, voffA);
            PG8_WAIT_L(8); PG8_BAR; PG8_WAIT_L(0); PG8_MMA(0, 0, At, B0); PG8_BAR; PG8_SCHED;
            PG8_LDB(B1, 1, 1); PG8_STAGE(PG8_SB(1, 0), b3, voffB);
            PG8_BAR; PG8_WAIT_L(0); PG8_MMA(0, 1, At, B1); PG8_BAR;
            PG8_LDA(At, 1, 1); PG8_STAGE(PG8_SA(1, 0), a3, voffA);
            PG8_BAR; PG8_WAIT_L(0); PG8_MMA(1, 0, At, B0); PG8_BAR; PG8_SCHED;
            PG8_STAGE(PG8_SB(1, 1), b3 + hstep, voffB);
            PG8_WAIT_V(6); PG8_BAR; PG8_MMA(1, 1, At, B1); PG8_BAR;
        }
        PG8_STAMP();
        if constexpr (!Epi::AFTER_DRAIN) { E(acc, cur, wr, wc, fr, fq); S.done(cur); }
        PG8_STAMP();
        if (!has_next) break;
#pragma unroll
        for (int a = 0; a < 2; ++a)
#pragma unroll
            for (int b = 0; b < 2; ++b)
#pragma unroll
                for (int m = 0; m < 4; ++m)
#pragma unroll
                    for (int n = 0; n < 2; ++n) acc[a][b][m][n] = (f32x4){0.f, 0.f, 0.f, 0.f};
        cur = nxt; cA = nA; cB = nB; ++ui;
    }
    PG8_WAIT_V(0);
    if (wr == 0) PG8_BAR;
    PG8_BAR;
    if constexpr (Epi::AFTER_DRAIN) { E.fused(acc, cur, wr, wc, fr, fq, lds, wid, lane); S.done(cur); }
    PG8_STAMP();
    if (STAMP && wid == 0) { stamps[lane] = lane < nts ? (((unsigned long long)(unsigned)ts_hi << 32) | (unsigned)ts_lo) : 0ull;
        if (lane == 62) stamps[62] = rt_entry; if (lane == 63) stamps[63] = (unsigned long long)wall_clock64(); }
#undef PG8_STAMP
#undef PG8_SA
#undef PG8_SB
#undef PG8_STAGE
#undef PG8_LDA
#undef PG8_LDB
#undef PG8_MMA
#undef PG8_WAIT_V
#undef PG8_WAIT_L
#undef PG8_BAR
#undef PG8_SCHED
}
}

template <class F> struct EpiAdapt {
    static constexpr bool PERM = true, AFTER_DRAIN = false;
    F f;
    __device__ __forceinline__ void operator()(const pg8::f32x4 (&acc)[2][2][4][2], const pg8::Unit& u, int wr, int wc, int fr, int fq) const {
        constexpr int B = F::BATCH;
        const int row0 = u.pm * 256 + wr * 64 + fr, col0 = u.pn * 256 + wc * 32 + 8 * fq;
        f32x4 b0[2], b1[2];
        if constexpr (F::COLBIAS) { f.bias8(col0, b0[0], b1[0]); f.bias8(col0 + 128, b0[1], b1[1]); }
#pragma unroll
        for (int q0 = 0; q0 < 16; q0 += B) {
            typename F::Pre pre[B];
#pragma unroll
            for (int i = 0; i < B; ++i) { const int q = q0 + i, bj = q & 1, m = (q >> 1) & 3, ai = q >> 3; pre[i] = f.pre(row0 + ai * 128 + m * 16, col0 + bj * 128); }
#pragma unroll
            for (int i = 0; i < B; ++i) { const int q = q0 + i, bj = q & 1, m = (q >> 1) & 3, ai = q >> 3;
                f32x4 v0 = acc[ai][bj][m][0], v1 = acc[ai][bj][m][1];
                if constexpr (F::COLBIAS) { v0 += b0[bj]; v1 += b1[bj]; }
                f.put(row0 + ai * 128 + m * 16, col0 + bj * 128, v0, v1, pre[i]); }
        }
    }
};
template <class F>
DEVI void gemm_pg8(const bf16_t* A, const bf16_t* Bt, int M, int N, int K, const F& f, char* smem, int bid, int nblk) {
    pg8::Gemm g{A, Bt, M, N, K};
    pg8::StaticOrder S; S.init(M, N, nblk, bid);
    EpiAdapt<F> E{f};
    __syncthreads();
    pg8::gemm_phase<EpiAdapt<F>, pg8::StaticOrder, false>((PG8_LAS unsigned char*)smem, g, S, E, nullptr);
    __syncthreads();
}

template <class F>
DEVI void gemm_small_rows(const bf16_t* __restrict__ A, const bf16_t* __restrict__ Bt, int N, const F& f, char* smem, int bid, int nblk) {
    const int tid = tid_opq(), lane = tid & 63, wid = tid >> 6, fr = lane & 15, fq = lane >> 4;
    float* part = (float*)smem;
    const int ntn = N / 64, ntiles = (NTS / 32) * ntn;
    for (int tile = bid; tile < ntiles; tile += nblk) {
        const int tm = tile / ntn, tn = tile % ntn;
        const int row0 = NTP + tm * 32, col0 = tn * 64;
        f32x4 acc[2][4];
#pragma unroll
        for (int m = 0; m < 2; ++m)
#pragma unroll
            for (int n = 0; n < 4; ++n) acc[m][n] = (f32x4){0.f, 0.f, 0.f, 0.f};
        const bf16_t* ap = A + (size_t)(row0 + fr) * 1024 + wid * 128 + fq * 8;
        const bf16_t* bp = Bt + (size_t)(col0 + fr) * 1024 + wid * 128 + fq * 8;
        bf16x8 af[4][2], bfr[4][4];
#pragma unroll
        for (int ks = 0; ks < 4; ++ks) {
#pragma unroll
            for (int m = 0; m < 2; ++m) af[ks][m] = *(const bf16x8*)(ap + (size_t)m * 16 * 1024 + ks * 32);
#pragma unroll
            for (int n = 0; n < 4; ++n) bfr[ks][n] = *(const bf16x8*)(bp + (size_t)n * 16 * 1024 + ks * 32);
        }
#pragma unroll
        for (int ks = 0; ks < 4; ++ks)
#pragma unroll
            for (int m = 0; m < 2; ++m)
#pragma unroll
                for (int n = 0; n < 4; ++n) acc[m][n] = __builtin_amdgcn_mfma_f32_16x16x32_bf16(bfr[ks][n], af[ks][m], acc[m][n], 0, 0, 0);
        __syncthreads();
#pragma unroll
        for (int m = 0; m < 2; ++m)
#pragma unroll
            for (int n = 0; n < 4; ++n) *(f32x4*)(part + ((size_t)wid * 32 + m * 16 + fr) * 64 + n * 16 + fq * 4) = acc[m][n];
        __syncthreads();
        if (tid < 256) {
            const int r = tid >> 3, c8 = (tid & 7) * 8;
            f32x4 v0 = {0.f, 0.f, 0.f, 0.f}, v1 = v0;
#pragma unroll
            for (int w = 0; w < 8; ++w) { v0 += *(const f32x4*)(part + ((size_t)w * 32 + r) * 64 + c8); v1 += *(const f32x4*)(part + ((size_t)w * 32 + r) * 64 + c8 + 4); }
            const typename F::Pre pre = f.pre(row0 + r, col0 + c8);
            f.put(row0 + r, col0 + c8, v0, v1, pre);
        }
    }
}
template <class F>
DEVI void gemm_tail(const bf16_t* A, const bf16_t* Bt, int N, const F& f, char* smem, int bid, int nblk) {
    gemm_small_rows(A, Bt, N, f, smem, bid, nblk);
    gemm_pg8(A, Bt, NTP, N, 1024, f, smem, bid, nblk);
}

#define XB_TMO      128
#define XB_XCNT(j)  (256  + 64 * (j))
#define XB_XSUB(j)  (1280 + 64 * (j))
#define XB_XGEN(j)  (2304 + 64 * (j))
#define XB_TOP      3328
#define XB_TOPGEN   3392
#define XCD_BAR_WORDS 3456
#define XB_SPIN_CAP (1u << 18)
#define LAS __attribute__((address_space(3)))

__device__ __forceinline__ unsigned xb_ld(unsigned* p)              { return __hip_atomic_load(p, __ATOMIC_RELAXED, __HIP_MEMORY_SCOPE_AGENT); }
__device__ __forceinline__ unsigned xb_add(unsigned* p, unsigned v) { return __hip_atomic_fetch_add(p, v, __ATOMIC_RELAXED, __HIP_MEMORY_SCOPE_AGENT); }
__device__ __forceinline__ unsigned xb_xcc_id() { return (unsigned)__builtin_amdgcn_s_getreg((3 << 11) | 20) & 0xFu; }
#define XB_SPIN(cond, bar) do { unsigned _sp = 0; while (cond) { __builtin_amdgcn_s_sleep(1); \
    if ((++_sp & 255u) == 0u) { if (xb_ld(&(bar)[XB_TMO])) break; if (_sp > XB_SPIN_CAP) { atomicAdd(&(bar)[XB_TMO], 1u); break; } } } } while (0)

struct XcdBarrier {
    unsigned* bar; unsigned x;
    volatile LAS unsigned* st;
};

__device__ __forceinline__ XcdBarrier xcd_barrier_post(unsigned* bar, volatile LAS unsigned* st) {
    XcdBarrier b; b.bar = bar; b.x = xb_xcc_id(); b.st = st;
    if (tid_opq() == 0) (void)xb_add(&bar[XB_XCNT(b.x)], 1u);
    return b;
}
__device__ __forceinline__ void xcd_barrier_complete(unsigned* bar, unsigned x, unsigned& nloc, unsigned& nx) {
    const unsigned G = gridDim.x * gridDim.y * gridDim.z;
    unsigned sum, cnt, mine, sp = 0u;
    for (;;) {
        sum = 0u; cnt = 0u; mine = 0u;
#pragma unroll
        for (unsigned j = 0; j < 16; ++j) { const unsigned c = xb_ld(&bar[XB_XCNT(j)]); sum += c; cnt += (c > 0u) ? 1u : 0u; mine = (j == x) ? c : mine; }
        if (sum == G) break;
        __builtin_amdgcn_s_sleep(1);
        if ((++sp & 255u) == 0u) { if (xb_ld(&bar[XB_TMO])) break; if (sp > XB_SPIN_CAP) { atomicAdd(&bar[XB_TMO], 1u); break; } }
    }
    nloc = mine > 0u ? mine : 1u; nx = cnt > 0u ? cnt : 1u;
}

__device__ __forceinline__ void xcd_barrier(const XcdBarrier& b) {
    asm volatile("s_waitcnt vmcnt(0)" ::: "memory");
    __syncthreads();
    if (tid_opq() == 0) {
        unsigned* bar = b.bar;
        __builtin_amdgcn_s_waitcnt(0);
        unsigned nloc = b.st[0], nx = b.st[1];
        if (nloc == 0u) { xcd_barrier_complete(bar, b.x, nloc, nx); b.st[0] = nloc; b.st[1] = nx; }
        const unsigned old = xb_add(&bar[XB_XSUB(b.x)], 1u);
        const unsigned gen = old / nloc;
        if (old + 1u == (gen + 1u) * nloc) {
            __builtin_amdgcn_fence(__ATOMIC_RELEASE, "agent");
            asm volatile("s_waitcnt vmcnt(0)" ::: "memory");
            const unsigned og = xb_add(&bar[XB_TOP], 1u);
            const unsigned tg = og / nx;
            if (og + 1u == (tg + 1u) * nx) xb_add(&bar[XB_TOPGEN], 1u);
            else XB_SPIN(xb_ld(&bar[XB_TOPGEN]) == tg, bar);
            __builtin_amdgcn_fence(__ATOMIC_ACQUIRE, "agent");
            xb_add(&bar[XB_XGEN(b.x)], 1u);
            asm volatile("s_waitcnt vmcnt(0)" ::: "memory");
        } else {
            XB_SPIN(xb_ld(&bar[XB_XGEN(b.x)]) == gen, bar);
            __builtin_amdgcn_fence(__ATOMIC_ACQUIRE, "agent");
            asm volatile("s_waitcnt vmcnt(0)" ::: "memory");
        }
    }
    __syncthreads();
}

constexpr int LDS_BYTES = 152 * 1024;

template <int S>
DEVI void run_stage(const P& p, char* smem, int bid, int nblk) {
    if (S == 0) stage_prologue(p, smem, bid, nblk);
    if (S == 1) { EpiInProj e{p}; gemm_pg8(p.XB, p.WINT, NT, NPAD_IN + 2048, 1024, e, smem, bid, nblk); }
    if (S == 2) {
        stage_mlstm_gates(p, smem, bid, nblk);
        if (bid & 1) { stage_mlstm_dc(p, smem, bid, nblk); stage_compress(p, smem, bid, nblk); stage_mlstm_sample(p, smem, bid, nblk); }
        else { stage_compress(p, smem, bid, nblk); stage_mlstm_dc(p, smem, bid, nblk); stage_mlstm_sample(p, smem, bid, nblk); }
    }
    if (S == 4) { stage_mlstm_scan(p, bid, nblk); stage_nsa_attn(p, smem, bid, nblk); }
    if (S == 5) { stage_mlstm_out(p, smem, bid, nblk); { EpiM1 e{p}; gemm_tail(p.YB, p.WBT, 1024, e, smem, bid, nblk); } }
    if (S == 6) { EpiM2 e{p}; gemm_tail(p.YA, p.WAT, 1024, e, smem, bid, nblk); }
    if (S == 8) { EpiR e{p}; gemm_tail(p.MERGED, p.WOT, 1024, e, smem, bid, nblk); }
    if (S == 9) stage_ln1(p, bid, nblk);
    if (S == 10) { EpiPQ e{p}; gemm_tail(p.HB, p.WQT, 2048, e, smem, bid, nblk); }
    if (S == 11) {
        if (bid & 1) {
            for (int ps = 0; ps < 4; ++ps) { stage_peer_route(p, smem, bid, nblk, ps, ps + 1); __threadfence_block(); __syncthreads(); stage_peer_apply(p, smem, bid, nblk, ps, ps + 1); __syncthreads(); }
        } else { stage_peer_route(p, smem, bid, nblk, 0, 64); __threadfence_block(); __syncthreads(); stage_peer_apply(p, smem, bid, nblk, 0, 64); }
    }
}
constexpr int NSTAGES = 13;

template <int S>
__global__ void __launch_bounds__(512, 2) k_stage(P p) {
    extern __shared__ __attribute__((aligned(16))) char smem[];
    run_stage<S>(p, smem, blockIdx.x, gridDim.x);
}


#if MK_ONE_LAUNCH
__global__ void __launch_bounds__(512, 2) k_mega(P p) {
    extern __shared__ __attribute__((aligned(16))) char smem_all[];
    if (tid_opq() == 0) *(u32x4*)smem_all = (u32x4){0u, 0u, 0u, 0u};
    __syncthreads();
    XcdBarrier bar = xcd_barrier_post(p.bar, (volatile LAS unsigned*)smem_all);
    char* smem = smem_all + 16;
    const int bid = blockIdx.x, nblk = gridDim.x;
    run_stage<0>(p, smem, bid, nblk); if ((REP_MASK >> 0) & 1) { xcd_barrier(bar); run_stage<0>(p, smem, bid, nblk); }  xcd_barrier(bar);
    run_stage<1>(p, smem, bid, nblk); if ((REP_MASK >> 1) & 1) { xcd_barrier(bar); run_stage<1>(p, smem, bid, nblk); }  xcd_barrier(bar);
    run_stage<2>(p, smem, bid, nblk); if ((REP_MASK >> 2) & 1) { xcd_barrier(bar); run_stage<2>(p, smem, bid, nblk); }  xcd_barrier(bar);
    run_stage<4>(p, smem, bid, nblk); if ((REP_MASK >> 4) & 1) { xcd_barrier(bar); run_stage<4>(p, smem, bid, nblk); }  xcd_barrier(bar);
    run_stage<5>(p, smem, bid, nblk); if ((REP_MASK >> 5) & 1) { xcd_barrier(bar); run_stage<5>(p, smem, bid, nblk); }  xcd_barrier(bar);
    run_stage<6>(p, smem, bid, nblk); if ((REP_MASK >> 6) & 1) { xcd_barrier(bar); run_stage<6>(p, smem, bid, nblk); }  xcd_barrier(bar);
    run_stage<8>(p, smem, bid, nblk); if ((REP_MASK >> 8) & 1) { xcd_barrier(bar); run_stage<8>(p, smem, bid, nblk); }  xcd_barrier(bar);
    run_stage<9>(p, smem, bid, nblk); if ((REP_MASK >> 9) & 1) { xcd_barrier(bar); run_stage<9>(p, smem, bid, nblk); }  xcd_barrier(bar);
    run_stage<10>(p, smem, bid, nblk); if ((REP_MASK >> 10) & 1) { xcd_barrier(bar); run_stage<10>(p, smem, bid, nblk); } xcd_barrier(bar);
    run_stage<11>(p, smem, bid, nblk); if ((REP_MASK >> 11) & 1) { xcd_barrier(bar); run_stage<11>(p, smem, bid, nblk); }
}
#endif

template <int S> static void launch_stage(const P& p, int grid, hipStream_t stream) {
    (void)hipFuncSetAttribute((const void*)k_stage<S>, hipFuncAttributeMaxDynamicSharedMemorySize, LDS_BYTES);
    k_stage<S><<<dim3(grid), dim3(512), LDS_BYTES, stream>>>(p);
}

extern "C" void kernel_launch(void* const* d_in, const int* in_sizes, int n_in, void* d_out, int out_size, void* d_ws, size_t ws_size, hipStream_t stream) {
    (void)in_sizes; (void)n_in; (void)out_size; (void)ws_size;
    P p{};
    p.xp = (const float*)d_in[0]; p.xs = (const float*)d_in[1]; p.cache_cmp = (const float*)d_in[2]; p.cache_slc = (const float*)d_in[3];
    p.cache_win = (const float*)d_in[4]; p.state_C = (const float*)d_in[5]; p.state_n = (const float*)d_in[6]; p.state_m = (const float*)d_in[7];
    p.page_table = (const int*)d_in[8];
    p.w_in = (const float*)d_in[9]; p.b_in = (const float*)d_in[10]; p.norm_a_g = (const float*)d_in[11]; p.nsa_pe = (const float*)d_in[12];
    p.nsa_w_cmp = (const float*)d_in[13]; p.w_br_a = (const float*)d_in[14]; p.w_br_b = (const float*)d_in[15]; p.w_merge = (const float*)d_in[16];
    p.w_out = (const float*)d_in[17]; p.ln1_g = (const float*)d_in[18]; p.ln1_b = (const float*)d_in[19];
    p.peer_wq = (const float*)d_in[20]; p.peer_keys = (const float*)d_in[21]; p.peer_u = (const float*)d_in[22]; p.peer_v = (const float*)d_in[23];
    p.ln2_g = (const float*)d_in[24]; p.ln2_b = (const float*)d_in[25];
    p.out = (float*)d_out;
    char* w = (char*)d_ws; size_t off = 0;
    auto take = [&](size_t bytes) { char* r = w + off; off += (bytes + 255) & ~(size_t)255; return r; };
    p.bar = (unsigned*)take(16384);
    p.PW = (float*)(p.bar + 3584);
    p.WCT = (bf16_t*)take((size_t)2 * 64 * 4096 * 2);
    p.XB = (bf16_t*)take((size_t)NT * 1024 * 2);
    p.WINT = (bf16_t*)take((size_t)(NPAD_IN + 2048) * 1024 * 2);
    p.WMT = (bf16_t*)take((size_t)2048 * 1024 * 2);
    p.WAT = (bf16_t*)take((size_t)1024 * 1024 * 2);
    p.WBT = (bf16_t*)take((size_t)1024 * 1024 * 2);
    p.WOT = (bf16_t*)take((size_t)1024 * 1024 * 2);
    p.WQT = (bf16_t*)take((size_t)2048 * 1024 * 2);
    p.KEYSB = (bf16_t*)take((size_t)16 * 128 * 128 * 2);
    p.U8 = (unsigned char*)take((size_t)16384 * 1024);
    p.V8 = (unsigned char*)take((size_t)16384 * 1024);
    p.US = (float*)take(16384 * 4);
    p.VS = (float*)take(16384 * 4);
    p.PROJ = (bf16_t*)take((size_t)NT * PS * 2);
    p.SM = (float*)take((size_t)NT * 64 * 4);
    p.BCUM = (float*)take((size_t)16 * 4096 * 4);
    p.MPREV = (float*)take(4096); p.ACOEF = (float*)take(4096); p.SCL = (float*)take(4096); p.MLOC = (float*)take(4096);
    p.DC = (float*)take((size_t)1024 * 272 * 128 * 4);
    p.CPT = (bf16_t*)take((size_t)1024 * 272 * 128 * 2);
    p.KC = (float*)take((size_t)4352 * 512 * 4);
    p.VC = p.KC + 256;
    p.OCMP = (float*)take((size_t)NT * 1024 * 4);
    p.SEL = (unsigned long long*)take((size_t)NT * 4 * 8);
    p.YA = (bf16_t*)take((size_t)NT * 1024 * 2);
    p.YB = (bf16_t*)take((size_t)NT * 1024 * 2);
    p.G = (bf16_t*)take((size_t)NT * 2048 * 2);
    p.TMPB = (bf16_t*)take((size_t)NT * 1024 * 2);
    p.MERGED = (bf16_t*)take((size_t)NT * 1024 * 2);
    p.R = (float*)take((size_t)NT * 1024 * 4);
    p.H = (float*)take((size_t)NT * 1024 * 4);
    p.HB = (bf16_t*)take((size_t)NT * 1024 * 2);
    p.PQ = (bf16_t*)take((size_t)NT * 2048 * 2);
    p.EIDX = (int*)take((size_t)NT * 128 * 4);
    p.EGATE = (float*)take((size_t)NT * 128 * 4);

    (void)hipMemsetAsync(p.bar, 0, 16384, stream);
#if MK_ONE_LAUNCH
    {
        constexpr size_t kDynLds = LDS_BYTES + 16;
        (void)hipFuncSetAttribute((const void*)k_mega, hipFuncAttributeMaxDynamicSharedMemorySize, (int)kDynLds);
        int dev = 0, cus = 0, per_cu = 0;
        (void)hipGetDevice(&dev);
        (void)hipDeviceGetAttribute(&cus, hipDeviceAttributeMultiprocessorCount, dev);
        (void)hipOccupancyMaxActiveBlocksPerMultiprocessor(&per_cu, (const void*)k_mega, 512, kDynLds);
        if (per_cu < 1 || cus < 1) return;
        const int grid = cus;
        k_mega<<<dim3(grid), dim3(512), kDynLds, stream>>>(p);
    }
#else
    const int grid = 512;
    launch_stage<0>(p, grid, stream);
    launch_stage<1>(p, grid, stream);
    launch_stage<2>(p, grid, stream);
    launch_stage<4>(p, grid, stream);
    launch_stage<5>(p, grid, stream);
    launch_stage<6>(p, grid, stream);
    launch_stage<8>(p, grid, stream);
    launch_stage<9>(p, grid, stream);
    launch_stage<10>(p, grid, stream);
    launch_stage<11>(p, grid, stream);
#endif
}
```

```cpp
#include <hip/hip_runtime.h>
#include <stdint.h>

#ifndef REP_MASK
#define REP_MASK 0
#endif
#ifndef MK_ONE_LAUNCH
#define MK_ONE_LAUNCH 1
#endif

typedef unsigned short bf16_t;
typedef short bf16x8 __attribute__((ext_vector_type(8)));
typedef float f32x4 __attribute__((ext_vector_type(4)));
typedef unsigned u32x4 __attribute__((ext_vector_type(4)));
typedef unsigned u32x2 __attribute__((ext_vector_type(2)));
typedef float f32x2 __attribute__((ext_vector_type(2)));
typedef __bf16 bf16x2_t __attribute__((ext_vector_type(2)));
#define DEVI __device__ __forceinline__
__device__ __forceinline__ int tid_opq() { int t = threadIdx.x; asm volatile("" : "+v"(t)); return t; }

constexpr int NTP = 16384, NTS = 512, NT = NTP + NTS, DM = 1024;
constexpr int PS = 5632;
constexpr int C_AQ = 0, C_AK = 512, C_AV = 1024, C_AO = 2048, C_BQ = 3072, C_CMP = 4096, C_SLC = 4608, C_WIN = 5120;
constexpr int NPAD_IN = 5888;
constexpr float DN_ALPHA = 1.189207115002721f;
constexpr float LN_EPS = 1e-5f;
constexpr size_t O_Y = 0;
constexpr size_t O_PCMP = O_Y + (size_t)NT * 1024;
constexpr size_t O_PSLC = O_PCMP + (size_t)NTP * 512;
constexpr size_t O_PWIN = O_PSLC + (size_t)NTP * 512;
constexpr size_t O_PC = O_PWIN + (size_t)4 * 512 * 512;
constexpr size_t O_PN = O_PC + (size_t)16 * 128 * 256;
constexpr size_t O_PM = O_PN + 16 * 128;
constexpr size_t O_SCMP = O_PM + 16;
constexpr size_t O_SSLC = O_SCMP + (size_t)NTS * 512;
constexpr size_t O_SWIN = O_SSLC + (size_t)NTS * 512;
constexpr size_t O_SC = O_SWIN + (size_t)128 * 512 * 512;
constexpr size_t O_SN = O_SC + (size_t)512 * 128 * 256;
constexpr size_t O_SM = O_SN + 512 * 128;

struct P {
    const float *xp, *xs, *cache_cmp, *cache_slc, *cache_win, *state_C, *state_n, *state_m;
    const int* page_table;
    const float *w_in, *b_in, *norm_a_g, *nsa_pe, *nsa_w_cmp, *w_br_a, *w_br_b, *w_merge, *w_out, *ln1_g, *ln1_b;
    const float *peer_wq, *peer_keys, *peer_u, *peer_v, *ln2_g, *ln2_b;
    float* out;
    bf16_t *XB, *WINT, *WMT, *WAT, *WBT, *WOT, *WQT, *KEYSB, *UB, *VB, *PROJ, *WCT;
    float* PW;
    float *SM, *BCUM, *MPREV, *ACOEF, *SCL, *MLOC, *DC, *KC, *VC, *OCMP;
    bf16_t* CPT;
    unsigned char *U8, *V8;
    float *US, *VS;
    unsigned long long* SEL;
    bf16_t *YA, *YB, *G, *MERGED, *HB, *PQ;
    float *R, *H, *EGATE;
    bf16_t* TMPB;
    int* EIDX;
    unsigned* bar;
};

DEVI bf16_t f2bf(float f) { return __builtin_bit_cast(unsigned short, (__bf16)f); }
DEVI float bf2f(bf16_t h) { return __uint_as_float(((unsigned)h) << 16); }
DEVI unsigned pack2(float a, float b) { return __builtin_bit_cast(unsigned, __builtin_convertvector((f32x2){a, b}, bf16x2_t)); }
DEVI u32x4 pack8f(const f32x4 a, const f32x4 b) { u32x4 r; r[0] = pack2(a[0], a[1]); r[1] = pack2(a[2], a[3]); r[2] = pack2(b[0], b[1]); r[3] = pack2(b[2], b[3]); return r; }
DEVI void ce_desc(unsigned& a, unsigned& b) { const unsigned hi = a > b ? a : b, lo = a > b ? b : a; a = hi; b = lo; }
template <int BASE> DEVI void sort16_desc(unsigned (&x)[64]) {
#pragma unroll
    for (int k = 2; k <= 16; k <<= 1)
#pragma unroll
        for (int j = k >> 1; j > 0; j >>= 1)
#pragma unroll
            for (int i = 0; i < 16; ++i) {
                const int l = i ^ j;
                if (l > i) { if ((i & k) == 0) ce_desc(x[BASE + i], x[BASE + l]); else ce_desc(x[BASE + l], x[BASE + i]); }
            }
}
DEVI void merge_top16(const unsigned* a, const unsigned* b, unsigned* t) {
    unsigned c[16];
#pragma unroll
    for (int i = 0; i < 16; ++i) c[i] = a[i] > b[15 - i] ? a[i] : b[15 - i];
#pragma unroll
    for (int j = 8; j > 0; j >>= 1)
#pragma unroll
        for (int i = 0; i < 16; ++i) { const int l = i ^ j; if (l > i) ce_desc(c[i], c[l]); }
#pragma unroll
    for (int i = 0; i < 16; ++i) t[i] = c[i];
}
DEVI float gelu_erf(float v) {
    const float av = fabsf(v), t = __builtin_amdgcn_rcpf(fmaf(av, 0.2316418882f, 1.0f));
    float q = fmaf(t, 0.5307027145f, -0.7265760135f); q = fmaf(q, t, 0.7107068705f); q = fmaf(q, t, -0.142248368f); q = fmaf(q, t, 0.127414796f); q = q * t;
    const float e = __builtin_amdgcn_exp2f(v * v * -0.72134752044f);
    const float mm = v * (q * e);
    return v < 0.f ? mm : v - mm;
}
DEVI float wave_max(float v) { for (int o = 32; o > 0; o >>= 1) v = fmaxf(v, __shfl_xor(v, o)); return v; }
DEVI float wave_sum(float v) { for (int o = 32; o > 0; o >>= 1) v += __shfl_xor(v, o); return v; }
DEVI float sigmoidf_(float x) { return __builtin_amdgcn_rcpf(1.f + __expf(-x)); }
DEVI float logsigmoidf_(float x) { return fminf(x, 0.f) - log1pf(__expf(-fabsf(x))); }
DEVI int win_map(int np) {
    if (np < 2048) return np;
    if (np < 5632) return np + 8;
    if (np < 5640) return np - 5632 + 2048;
    if (np < 5688) return np;
    return -1;
}
DEVI float alibi_slope(int h) { return exp2f(-0.5f * (float)(h + 1)); }

template <class MapFn>
DEVI void transpose_cvt(const float* __restrict__ W, bf16_t* __restrict__ WT, int K, int Nsrc, int Ndst, MapFn mapfn, float* tile  , int bid, int nblk) {
    const int tid = tid_opq();
    const int tn = Ndst / 64, tk = K / 64;
    for (int t = bid; t < tn * tk; t += nblk) {
        const int n0 = (t % tn) * 64, k0 = (t / tn) * 64;
        __syncthreads();
#pragma unroll
        for (int i = 0; i < 8; ++i) {
            const int kk = (tid >> 6) + i * 8, nn = tid & 63;
            const int n = mapfn(n0 + nn);
            tile[kk * 65 + nn] = n >= 0 ? W[(size_t)(k0 + kk) * Nsrc + n] : 0.f;
        }
        __syncthreads();
#pragma unroll
        for (int i = 0; i < 8; ++i) {
            const int nn = (tid >> 6) + i * 8, kk = tid & 63;
            WT[(size_t)(n0 + nn) * K + k0 + kk] = f2bf(tile[kk * 65 + nn]);
        }
    }
}
struct IdMap { DEVI int operator()(int n) const { return n; } };
struct WinMap { DEVI int operator()(int n) const { return win_map(n); } };

DEVI void cvt_rows(const float* __restrict__ src, bf16_t* __restrict__ dst, size_t n4, int bid, int nblk) {
    const size_t stride = (size_t)nblk * 512;
    for (size_t i0 = (size_t)bid * 512 + tid_opq(); i0 < n4; i0 += stride * 8) {
        f32x4 v[8];
#pragma unroll
        for (int u = 0; u < 8; ++u) { const size_t i = i0 + u * stride; v[u] = i < n4 ? __builtin_nontemporal_load((const f32x4*)src + i) : (f32x4){0.f, 0.f, 0.f, 0.f}; }
#pragma unroll
        for (int u = 0; u < 8; ++u) { const size_t i = i0 + u * stride; if (i < n4) { u32x2 o; o.x = pack2(v[u][0], v[u][1]); o.y = pack2(v[u][2], v[u][3]); ((u32x2*)dst)[i] = o; } }
    }
}

DEVI void stage_prologue(const P& p, char* smem, int bid, int nblk) {
    float* tile = (float*)smem;
    cvt_rows(p.xp, p.XB, (size_t)NTP * 256, bid, nblk);
    cvt_rows(p.xs, p.XB + (size_t)NTP * 1024, (size_t)NTS * 256, bid, nblk);
    {
        const int lane = tid_opq() & 63, wid = tid_opq() >> 6;
        for (int r0 = bid * 8 + wid; r0 < 2 * 16384; r0 += nblk * 8 * 2) {
            f32x4 x[2][4]; float am[2] = {0.f, 0.f};
#pragma unroll
            for (int j = 0; j < 2; ++j) {
                const int r = r0 + j * nblk * 8;
                if (r < 2 * 16384) {
                    const bool isv = r >= 16384; const int e = isv ? r - 16384 : r;
                    const float* src = (isv ? p.peer_v : p.peer_u) + (size_t)e * 1024 + lane * 16;
#pragma unroll
                    for (int i = 0; i < 4; ++i) x[j][i] = __builtin_nontemporal_load((const f32x4*)(src + i * 4));
                }
            }
#pragma unroll
            for (int j = 0; j < 2; ++j) {
                const int r = r0 + j * nblk * 8;
                if (r < 2 * 16384) {
                    const bool isv = r >= 16384; const int e = isv ? r - 16384 : r;
#pragma unroll
                    for (int i = 0; i < 4; ++i)
#pragma unroll
                        for (int k = 0; k < 4; ++k) am[j] = fmaxf(am[j], fabsf(x[j][i][k]));
                    const float amx = wave_max(am[j]);
                    const float inv = amx > 0.f ? 448.f / amx : 1.f;
                    u32x4 o;
#pragma unroll
                    for (int i = 0; i < 4; ++i) { int w = __builtin_amdgcn_cvt_pk_fp8_f32(x[j][i][0] * inv, x[j][i][1] * inv, 0, false); w = __builtin_amdgcn_cvt_pk_fp8_f32(x[j][i][2] * inv, x[j][i][3] * inv, w, true); o[i] = (unsigned)w; }
                    *(u32x4*)((isv ? p.V8 : p.U8) + (size_t)e * 1024 + lane * 16) = o;
                    if (lane == 0) (isv ? p.VS : p.US)[e] = amx > 0.f ? amx / 448.f : 1.f;
                }
            }
        }
    }
    cvt_rows(p.peer_keys, p.KEYSB, (size_t)16 * 128 * 128 / 4, bid, nblk);
    transpose_cvt(p.w_in, p.WINT, 1024, 5688, NPAD_IN, WinMap(), tile, bid, nblk);
    transpose_cvt(p.w_merge, p.WINT + (size_t)NPAD_IN * 1024, 1024, 2048, 2048, IdMap(), tile, bid, nblk);
    transpose_cvt(p.w_br_a, p.WAT, 1024, 1024, 1024, IdMap(), tile, bid, nblk);
    transpose_cvt(p.w_br_b, p.WBT, 1024, 1024, 1024, IdMap(), tile, bid, nblk);
    transpose_cvt(p.w_out, p.WOT, 1024, 1024, 1024, IdMap(), tile, bid, nblk);
    transpose_cvt(p.peer_wq, p.WQT, 1024, 2048, 2048, IdMap(), tile, bid, nblk);
    transpose_cvt(p.nsa_w_cmp, p.WCT, 4096, 64, 64, IdMap(), tile, bid, nblk);
    transpose_cvt(p.nsa_w_cmp + 4096 * 64, p.WCT + 64 * 4096, 4096, 64, 64, IdMap(), tile, bid, nblk);
    for (int blk = bid; blk < 32; blk += nblk) {
        const int tid = tid_opq(), kvv = tid >> 8, e = tid & 63, kq = (tid >> 6) & 3;
        float a = 0.f;
        for (int k = blk * 128 + kq * 32; k < blk * 128 + kq * 32 + 32; ++k) a += p.nsa_pe[kvv * 4096 + k] * p.nsa_w_cmp[((size_t)kvv * 4096 + k) * 64 + e];
        atomicAdd(p.PW + kvv * 64 + e, a);
    }
    {
        const size_t per_b = (size_t)508 * 512 / 4;
        const size_t stride = (size_t)nblk * 512, ntot = 128 * per_b;
        for (size_t i0 = (size_t)bid * 512 + tid_opq(); i0 < ntot; i0 += stride * 8) {
            f32x4 v[8];
#pragma unroll
            for (int u = 0; u < 8; ++u) { const size_t i = i0 + u * stride; if (i < ntot) { const size_t b = i / per_b, r = i % per_b; v[u] = __builtin_nontemporal_load((const f32x4*)(p.cache_win + b * 512 * 512 + 4 * 512) + r); } }
#pragma unroll
            for (int u = 0; u < 8; ++u) { const size_t i = i0 + u * stride; if (i < ntot) { const size_t b = i / per_b, r = i % per_b; __builtin_nontemporal_store(v[u], (f32x4*)(p.out + O_SWIN + b * 512 * 512) + r); } }
        }
    }
}

struct NoPre {};
DEVI f32x4 bf4_lo(const u32x4& g) { return (f32x4){__uint_as_float(g[0] << 16), __uint_as_float(g[0] & 0xFFFF0000u), __uint_as_float(g[1] << 16), __uint_as_float(g[1] & 0xFFFF0000u)}; }
DEVI f32x4 bf4_hi(const u32x4& g) { return (f32x4){__uint_as_float(g[2] << 16), __uint_as_float(g[2] & 0xFFFF0000u), __uint_as_float(g[3] << 16), __uint_as_float(g[3] & 0xFFFF0000u)}; }
struct EpiInProj {
    P p;
    typedef NoPre Pre;
    static constexpr int BATCH = 4;
    static constexpr bool COLBIAS = true;
    DEVI void bias8(int col, f32x4& b0, f32x4& b1) const {
        b0 = (f32x4){0.f, 0.f, 0.f, 0.f}; b1 = b0;
        if (col < 5688) { const int oc = win_map(col);
#pragma unroll
            for (int q = 0; q < 4; ++q) { b0[q] = p.b_in[oc + q]; b1[q] = p.b_in[oc + 4 + q]; } }
    }
    DEVI Pre pre(int, int) const { return NoPre(); }
    DEVI void put(int row, int col, f32x4 v0, f32x4 v1, const Pre&) const {
        if (col >= NPAD_IN) {
#pragma unroll
            for (int k = 0; k < 4; ++k) { v0[k] = sigmoidf_(v0[k]); v1[k] = sigmoidf_(v1[k]); }
            *(u32x4*)(p.G + (size_t)row * 2048 + (col - NPAD_IN)) = pack8f(v0, v1);
            return;
        }
        if (col >= 5688) return;
        if (col >= 5632) { *(f32x4*)(p.SM + (size_t)row * 64 + (col - 5632)) = v0; *(f32x4*)(p.SM + (size_t)row * 64 + (col - 5632) + 4) = v1; return; }
        if (col >= C_AK && col < C_AV) { v0 *= 0.08838834764831845f; v1 *= 0.08838834764831845f; }
        *(u32x4*)(p.PROJ + (size_t)row * PS + col) = pack8f(v0, v1);
        if (col >= C_CMP) {
            const int reg = (col - C_CMP) >> 9, c = (col - C_CMP) & 511;
            float* dst = nullptr;
            if (row < NTP) {
                if (reg == 0) dst = p.out + O_PCMP + (size_t)row * 512 + c;
                else if (reg == 1) dst = p.out + O_PSLC + (size_t)row * 512 + c;
                else { const int b = row >> 12, t = row & 4095; if (t >= 3584) dst = p.out + O_PWIN + ((size_t)b * 512 + (t - 3584)) * 512 + c; }
            } else {
                const int rs = row - NTP;
                if (reg == 0) dst = p.out + O_SCMP + (size_t)rs * 512 + c;
                else if (reg == 1) dst = p.out + O_SSLC + (size_t)rs * 512 + c;
                else { const int b = rs >> 2, tq = rs & 3; dst = p.out + O_SWIN + ((size_t)b * 512 + 508 + tq) * 512 + c; }
            }
            if (dst) { *(f32x4*)dst = v0; *(f32x4*)(dst + 4) = v1; }
        }
    }
};
struct EpiG {
    P p;
    typedef NoPre Pre;
    static constexpr int BATCH = 4;
    static constexpr bool COLBIAS = false;
    DEVI Pre pre(int, int) const { return NoPre(); }
    DEVI void put(int row, int col, f32x4 v0, f32x4 v1, const Pre&) const {
#pragma unroll
        for (int k = 0; k < 4; ++k) { v0[k] = sigmoidf_(v0[k]); v1[k] = sigmoidf_(v1[k]); }
        *(u32x4*)(p.G + (size_t)row * 2048 + col) = pack8f(v0, v1);
    }
};
struct EpiM1 {
    P p;
    typedef u32x4 Pre;
    static constexpr int BATCH = 8;
    static constexpr bool COLBIAS = false;
    DEVI Pre pre(int row, int col) const { return *(const u32x4*)(p.G + (size_t)row * 2048 + 1024 + col); }
    DEVI void put(int row, int col, f32x4 v0, f32x4 v1, const Pre& g) const {
        *(u32x4*)(p.TMPB + (size_t)row * 1024 + col) = pack8f(v0 * bf4_lo(g), v1 * bf4_hi(g));
    }
};
struct PreM2 { u32x4 g; u32x4 t; };
struct EpiM2 {
    P p;
    typedef PreM2 Pre;
    static constexpr int BATCH = 8;
    static constexpr bool COLBIAS = false;
    DEVI Pre pre(int row, int col) const { PreM2 r; r.g = *(const u32x4*)(p.G + (size_t)row * 2048 + col); r.t = *(const u32x4*)(p.TMPB + (size_t)row * 1024 + col); return r; }
    DEVI void put(int row, int col, f32x4 v0, f32x4 v1, const Pre& q) const {
        *(u32x4*)(p.MERGED + (size_t)row * 1024 + col) = pack8f(bf4_lo(q.t) + v0 * bf4_lo(q.g), bf4_hi(q.t) + v1 * bf4_hi(q.g));
    }
};
struct PreR { f32x4 a, b; };
struct EpiR {
    P p;
    typedef PreR Pre;
    static constexpr int BATCH = 8;
    static constexpr bool COLBIAS = false;
    DEVI Pre pre(int row, int col) const {
        const float* xr = row < NTP ? p.xp + (size_t)row * 1024 : p.xs + (size_t)(row - NTP) * 1024;
        PreR r; r.a = *(const f32x4*)(xr + col); r.b = *(const f32x4*)(xr + col + 4); return r;
    }
    DEVI void put(int row, int col, f32x4 v0, f32x4 v1, const Pre& x) const {
        *(f32x4*)(p.R + (size_t)row * 1024 + col) = x.a * DN_ALPHA + v0; *(f32x4*)(p.R + (size_t)row * 1024 + col + 4) = x.b * DN_ALPHA + v1;
    }
};
struct EpiPQ {
    P p;
    typedef NoPre Pre;
    static constexpr int BATCH = 4;
    static constexpr bool COLBIAS = false;
    DEVI Pre pre(int, int) const { return NoPre(); }
    DEVI void put(int row, int col, f32x4 v0, f32x4 v1, const Pre&) const { *(u32x4*)(p.PQ + (size_t)row * 2048 + col) = pack8f(v0, v1); }
};

DEVI void stage_mlstm_gates(const P& p, char* smem, int bid, int nblk) {
    const int lane = tid_opq() & 63, wid = tid_opq() >> 6;
    float* bend_s = (float*)smem; float* mloc_s = bend_s + 64;
    for (int bh = bid; bh < 16; bh += nblk) {
        const int b = bh >> 2, h = bh & 3;
        __syncthreads();
        for (int cc = 0; cc < 8; ++cc) {
            const int c = wid * 8 + cc;
            const size_t row = (size_t)b * 4096 + c * 64 + lane;
            const float ip = p.SM[row * 64 + h];
            const float lf = logsigmoidf_(p.SM[row * 64 + 4 + h]);
            float cs = lf;
#pragma unroll
            for (int o = 1; o < 64; o <<= 1) { const float t = __shfl_up(cs, o); if (lane >= o) cs += t; }
            p.BCUM[bh * 4096 + c * 64 + lane] = cs;
            const float bend = __shfl(cs, 63);
            const float mloc = wave_max(bend - cs + ip);
            if (lane == 0) { bend_s[c] = bend; mloc_s[c] = mloc; }
        }
        __syncthreads();
        if (tid_opq() == 0) {
            float m = 0.f;
            for (int c = 0; c < 64; ++c) {
                const float bend = bend_s[c], mloc = mloc_s[c];
                const float mnew = fmaxf(bend + m, mloc);
                p.MPREV[bh * 64 + c] = m;
                p.ACOEF[bh * 64 + c] = __expf(bend + m - mnew);
                p.SCL[bh * 64 + c] = __expf(mloc - mnew);
                p.MLOC[bh * 64 + c] = mloc;
                m = mnew;
            }
            p.out[O_PM + bh] = m;
        }
    }
}

constexpr int MD_KT = 0, MD_VT = 128 * 144, MD_WS = MD_VT + 272 * 144, MD_LDS = MD_WS + 256;
DEVI void stage_mlstm_dc(const P& p, char* smem, int bid, int nblk) {
    const int tid = tid_opq(), lane = tid & 63, wid = tid >> 6, fr = lane & 15, fq = lane >> 4;
    bf16_t* Kt = (bf16_t*)(smem + MD_KT);
    bf16_t* Vt = (bf16_t*)(smem + MD_VT);
    float* ws = (float*)(smem + MD_WS);
    for (int task = bid; task < 1024; task += nblk) {
        const int bh = task >> 6, c = task & 63, b = bh >> 2, h = bh & 3;
        const size_t row0 = (size_t)b * 4096 + c * 64;
        __syncthreads();
        if (tid < 64) {
            const float ip = p.SM[(row0 + tid) * 64 + h];
            float cs = logsigmoidf_(p.SM[(row0 + tid) * 64 + 4 + h]);
#pragma unroll
            for (int o = 1; o < 64; o <<= 1) { const float t = __shfl_up(cs, o); if (tid >= o) cs += t; }
            const float g = __shfl(cs, 63) - cs + ip;
            ws[tid] = __expf(g - wave_max(g));
        }
        __syncthreads();
        {
            const int sidx = tid & 63, ch = tid >> 6;
            const float w = ws[sidx];
#pragma unroll
            for (int half = 0; half < 2; ++half) {
                const u32x4 kk = *(const u32x4*)(p.PROJ + (row0 + sidx) * PS + C_AK + h * 128 + half * 64 + ch * 8);
#pragma unroll
                for (int e = 0; e < 4; ++e) {
                    Kt[(half * 64 + ch * 8 + e * 2) * 72 + sidx] = f2bf(w * __uint_as_float(kk[e] << 16));
                    Kt[(half * 64 + ch * 8 + e * 2 + 1) * 72 + sidx] = f2bf(w * __uint_as_float(kk[e] & 0xFFFF0000u));
                }
            }
#pragma unroll
            for (int q4 = 0; q4 < 4; ++q4) {
                const u32x4 vv = *(const u32x4*)(p.PROJ + (row0 + sidx) * PS + C_AV + h * 256 + q4 * 64 + ch * 8);
#pragma unroll
                for (int e = 0; e < 4; ++e) {
                    Vt[(q4 * 64 + ch * 8 + e * 2) * 72 + sidx] = (bf16_t)(vv[e] & 0xFFFFu);
                    Vt[(q4 * 64 + ch * 8 + e * 2 + 1) * 72 + sidx] = (bf16_t)(vv[e] >> 16);
                }
            }
            for (int i = tid; i < 16 * 64; i += 512) Vt[(256 + (i >> 6)) * 72 + (i & 63)] = (i >> 6) == 0 ? (bf16_t)0x3F80 : (bf16_t)0;
        }
        __syncthreads();
        const int nvt = wid == 0 ? 3 : 2;
        for (int vi = 0; vi < nvt; ++vi) {
            const int vt = vi < 2 ? wid * 2 + vi : 16;
            f32x4 acc[8];
#pragma unroll
            for (int dt = 0; dt < 8; ++dt) acc[dt] = (f32x4){0.f, 0.f, 0.f, 0.f};
#pragma unroll
            for (int ks = 0; ks < 2; ++ks) {
                const bf16x8 bf = *(const bf16x8*)(Vt + (vt * 16 + fr) * 72 + ks * 32 + fq * 8);
#pragma unroll
                for (int dt = 0; dt < 8; ++dt) {
                    const bf16x8 af = *(const bf16x8*)(Kt + (dt * 16 + fr) * 72 + ks * 32 + fq * 8);
                    acc[dt] = __builtin_amdgcn_mfma_f32_16x16x32_bf16(af, bf, acc[dt], 0, 0, 0);
                }
            }
            const int v = vt * 16 + fr;
            if (v <= 256) {
#pragma unroll
                for (int dt = 0; dt < 8; ++dt) *(f32x4*)(p.DC + ((size_t)task * 272 + v) * 128 + dt * 16 + fq * 4) = acc[dt];
            }
        }
    }
}

DEVI void stage_mlstm_scan(const P& p, int bid, int nblk) {
    const int nthr = 512;
    for (int e = bid * nthr + tid_opq(); e < 16 * 257 * 32; e += nblk * nthr) {
        const int bh = e / (257 * 32), r = e % (257 * 32), v = r >> 5, d = (r & 31) * 4;
        f32x4 C = {0.f, 0.f, 0.f, 0.f};
        const float* ac = p.ACOEF + bh * 64; const float* sc = p.SCL + bh * 64;
        const size_t base = ((size_t)(bh * 64) * 272 + v) * 128 + d, cstride = (size_t)272 * 128;
#pragma unroll 1
        for (int c0 = 0; c0 < 64; c0 += 8) {
            f32x4 dc[8];
#pragma unroll
            for (int i = 0; i < 8; ++i) dc[i] = __builtin_nontemporal_load((const f32x4*)(p.DC + base + (size_t)(c0 + i) * cstride));
#pragma unroll
            for (int i = 0; i < 8; ++i) {
                u32x2 o; o.x = pack2(C[0], C[1]); o.y = pack2(C[2], C[3]);
                *(u32x2*)(p.CPT + base + (size_t)(c0 + i) * cstride) = o;
                C = C * ac[c0 + i] + dc[i] * sc[c0 + i];
            }
        }
        if (v < 256) {
#pragma unroll
            for (int k = 0; k < 4; ++k) p.out[O_PC + ((size_t)bh * 128 + d + k) * 256 + v] = C[k];
        } else *(f32x4*)(p.out + O_PN + bh * 128 + d) = C;
    }
}

constexpr int MO_Q = 0, MO_K = 64 * 272, MO_VT = MO_K + 64 * 272, MO_P = MO_VT + 272 * 144, MO_SC = MO_P + 64 * 144, MO_HS = MO_SC + 2048, MO_LDS = MO_HS + 64 * 256 * 4;
static_assert(MO_LDS <= 152 * 1024, "lds");
DEVI void stage_mlstm_out(const P& p, char* smem, int bid, int nblk) {
    const int tid = tid_opq(), lane = tid & 63, wid = tid >> 6, fr = lane & 15, fq = lane >> 4;
    bf16_t* Qs = (bf16_t*)(smem + MO_Q);
    bf16_t* Ks = (bf16_t*)(smem + MO_K);
    bf16_t* Vt = (bf16_t*)(smem + MO_VT);
    bf16_t* Ps = (bf16_t*)(smem + MO_P);
    float* sc = (float*)(smem + MO_SC);
    float* rowt = sc; float* colt = sc + 64; float* wint = sc + 128; float* emt = sc + 192; float* den = sc + 256;
    float* hs = (float*)(smem + MO_HS);
    for (int task = bid; task < 1024; task += nblk) {
        const int bh = task >> 6, c = task & 63, b = bh >> 2, h = bh & 3;
        const size_t row0 = (size_t)b * 4096 + c * 64;
        __syncthreads();
        {
            for (int i = tid; i < 64 * 16; i += 512) {
                const int t = i >> 4, ch = i & 15;
                *(u32x4*)(Qs + t * 136 + ch * 8) = *(const u32x4*)(p.PROJ + (row0 + t) * PS + C_AQ + h * 128 + ch * 8);
                *(u32x4*)(Ks + t * 136 + ch * 8) = *(const u32x4*)(p.PROJ + (row0 + t) * PS + C_AK + h * 128 + ch * 8);
            }
            const int sidx = tid & 63, ch = tid >> 6;
#pragma unroll
            for (int q4 = 0; q4 < 4; ++q4) {
                const u32x4 vv = *(const u32x4*)(p.PROJ + (row0 + sidx) * PS + C_AV + h * 256 + q4 * 64 + ch * 8);
#pragma unroll
                for (int e = 0; e < 4; ++e) {
                    Vt[(q4 * 64 + ch * 8 + e * 2) * 72 + sidx] = (bf16_t)(vv[e] & 0xFFFFu);
                    Vt[(q4 * 64 + ch * 8 + e * 2 + 1) * 72 + sidx] = (bf16_t)(vv[e] >> 16);
                }
            }
            for (int i = tid; i < 16 * 64; i += 512) Vt[(256 + (i >> 6)) * 72 + (i & 63)] = (i >> 6) == 0 ? (bf16_t)0x3F80 : (bf16_t)0;
            if (wid == 0) {
                const float bc = p.BCUM[bh * 4096 + c * 64 + lane], ip = p.SM[(row0 + lane) * 64 + h];
                const float mprev = p.MPREV[task];
                float pm = ip - bc;
#pragma unroll
                for (int o = 1; o < 64; o <<= 1) { const float t = __shfl_up(pm, o); if (lane >= o) pm = fmaxf(pm, t); }
                const float mt = fmaxf(bc + mprev, bc + pm);
                rowt[lane] = bc - mt; colt[lane] = ip - bc; wint[lane] = __expf(bc + mprev - mt); emt[lane] = __expf(-mt);
            }
        }
        __syncthreads();
        {
            const int tt = wid >> 1;
#pragma unroll
            for (int si = 0; si < 2; ++si) {
                const int st = (wid & 1) * 2 + si;
                f32x4 acc = (f32x4){0.f, 0.f, 0.f, 0.f};
                if (st <= tt) {
#pragma unroll
                    for (int ks = 0; ks < 4; ++ks) {
                        const bf16x8 af = *(const bf16x8*)(Qs + (tt * 16 + fr) * 136 + ks * 32 + fq * 8);
                        const bf16x8 bf = *(const bf16x8*)(Ks + (st * 16 + fr) * 136 + ks * 32 + fq * 8);
                        acc = __builtin_amdgcn_mfma_f32_16x16x32_bf16(af, bf, acc, 0, 0, 0);
                    }
                }
                const int s = st * 16 + fr; const float ct = colt[s];
#pragma unroll
                for (int r = 0; r < 4; ++r) {
                    const int t = tt * 16 + fq * 4 + r;
                    const float pv = (s <= t) ? acc[r] * __expf(rowt[t] + ct) : 0.f;
                    Ps[t * 72 + s] = f2bf(pv);
                }
            }
        }
        __syncthreads();
        {
            const bf16_t* cpt = p.CPT + (size_t)task * 272 * 128;
            f32x4 acc[4][2];
#pragma unroll
            for (int tt = 0; tt < 4; ++tt)
#pragma unroll
                for (int vi = 0; vi < 2; ++vi) acc[tt][vi] = (f32x4){0.f, 0.f, 0.f, 0.f};
            f32x4 accd = (f32x4){0.f, 0.f, 0.f, 0.f};
            bf16x8 cb[4][2], cd[4];
#pragma unroll
            for (int ks = 0; ks < 4; ++ks) {
#pragma unroll
                for (int vi = 0; vi < 2; ++vi) cb[ks][vi] = *(const bf16x8*)(cpt + (size_t)((wid * 2 + vi) * 16 + fr) * 128 + ks * 32 + fq * 8);
                cd[ks] = *(const bf16x8*)(cpt + (size_t)(256 + fr) * 128 + ks * 32 + fq * 8);
            }
#pragma unroll
            for (int ks = 0; ks < 4; ++ks) {
                bf16x8 af[4];
#pragma unroll
                for (int tt = 0; tt < 4; ++tt) af[tt] = *(const bf16x8*)(Qs + (tt * 16 + fr) * 136 + ks * 32 + fq * 8);
#pragma unroll
                for (int vi = 0; vi < 2; ++vi) {
#pragma unroll
                    for (int tt = 0; tt < 4; ++tt) acc[tt][vi] = __builtin_amdgcn_mfma_f32_16x16x32_bf16(af[tt], cb[ks][vi], acc[tt][vi], 0, 0, 0);
                }
                if (wid < 4) {
                    const bf16x8 a2 = *(const bf16x8*)(Qs + (wid * 16 + fr) * 136 + ks * 32 + fq * 8);
                    accd = __builtin_amdgcn_mfma_f32_16x16x32_bf16(a2, cd[ks], accd, 0, 0, 0);
                }
            }
#pragma unroll
            for (int tt = 0; tt < 4; ++tt) {
                const f32x4 wv = *(const f32x4*)(wint + tt * 16 + fq * 4);
#pragma unroll
                for (int vi = 0; vi < 2; ++vi) acc[tt][vi] *= wv;
            }
            if (wid < 4) accd *= *(const f32x4*)(wint + wid * 16 + fq * 4);
#pragma unroll
            for (int ks = 0; ks < 2; ++ks) {
                bf16x8 af[4];
#pragma unroll
                for (int tt = 0; tt < 4; ++tt) af[tt] = *(const bf16x8*)(Ps + (tt * 16 + fr) * 72 + ks * 32 + fq * 8);
#pragma unroll
                for (int vi = 0; vi < 2; ++vi) {
                    const bf16x8 bf = *(const bf16x8*)(Vt + ((wid * 2 + vi) * 16 + fr) * 72 + ks * 32 + fq * 8);
#pragma unroll
                    for (int tt = 0; tt < 4; ++tt) acc[tt][vi] = __builtin_amdgcn_mfma_f32_16x16x32_bf16(af[tt], bf, acc[tt][vi], 0, 0, 0);
                }
                if (wid < 4) {
                    const bf16x8 bf = *(const bf16x8*)(Vt + (256 + fr) * 72 + ks * 32 + fq * 8);
                    const bf16x8 a2 = *(const bf16x8*)(Ps + (wid * 16 + fr) * 72 + ks * 32 + fq * 8);
                    accd = __builtin_amdgcn_mfma_f32_16x16x32_bf16(a2, bf, accd, 0, 0, 0);
                }
            }
            if (wid < 4 && fr == 0) *(f32x4*)(den + wid * 16 + fq * 4) = accd;
            __syncthreads();
#pragma unroll
            for (int tt = 0; tt < 4; ++tt) {
                const f32x4 dv = *(const f32x4*)(den + tt * 16 + fq * 4), ev = *(const f32x4*)(emt + tt * 16 + fq * 4);
#pragma unroll
                for (int vi = 0; vi < 2; ++vi)
#pragma unroll
                    for (int r = 0; r < 4; ++r) hs[(tt * 16 + fq * 4 + r) * 256 + (wid * 2 + vi) * 16 + fr] = acc[tt][vi][r] / fmaxf(fabsf(dv[r]), ev[r]);
            }
        }
        __syncthreads();
        u32x2 ovs[8];
#pragma unroll
        for (int rr = 0; rr < 8; ++rr) ovs[rr] = *(const u32x2*)(p.PROJ + (row0 + wid * 8 + rr) * PS + C_AO + h * 256 + lane * 4);
        const f32x4 gg = *(const f32x4*)(p.norm_a_g + h * 256 + lane * 4);
#pragma unroll
        for (int rr = 0; rr < 8; ++rr) {
            const int t = wid * 8 + rr;
            const f32x4 x = *(const f32x4*)(hs + t * 256 + lane * 4);
            const float mean = wave_sum(x[0] + x[1] + x[2] + x[3]) * (1.f / 256.f);
            float q = 0.f;
#pragma unroll
            for (int k = 0; k < 4; ++k) q += (x[k] - mean) * (x[k] - mean);
            const float rs = rsqrtf(wave_sum(q) * (1.f / 256.f) + LN_EPS);
            const u32x2 ov = ovs[rr];
            const float o4[4] = {__uint_as_float(ov.x << 16), __uint_as_float(ov.x & 0xFFFF0000u), __uint_as_float(ov.y << 16), __uint_as_float(ov.y & 0xFFFF0000u)};
            float y[4];
#pragma unroll
            for (int k = 0; k < 4; ++k) y[k] = (x[k] - mean) * rs * gg[k] * sigmoidf_(o4[k]);
            u32x2 o2; o2.x = pack2(y[0], y[1]); o2.y = pack2(y[2], y[3]);
            *(u32x2*)(p.YA + (row0 + t) * 1024 + h * 256 + lane * 4) = o2;
        }
    }
}

DEVI void stage_mlstm_sample(const P& p, char* smem, int bid, int nblk) {
    float* qs = (float*)smem;
    float* ks = qs + 512;
    float* vs = ks + 512;
    float* part = vs + 1024;
    float* hs = part + 2048;
    float* sc = hs + 1024;
    float* bc = sc; float* ip = sc + 4; float* mt = sc + 8; float* wint = sc + 12; float* emt = sc + 16; float* ww = sc + 20; float* den = sc + 24;
    float* Pm = sc + 32;
    float* misc = sc + 48;
    const int tid = tid_opq(), lane = tid & 63, wid = tid >> 6;
    for (int task = bid; task < 512; task += nblk) {
        const int b = task >> 2, h = task & 3;
        const size_t row0 = (size_t)NTP + b * 4;
        __syncthreads();
        { const int t = tid >> 7, d = tid & 127;
          qs[tid] = bf2f(p.PROJ[(row0 + t) * PS + C_AQ + h * 128 + d]);
          ks[tid] = bf2f(p.PROJ[(row0 + t) * PS + C_AK + h * 128 + d]); }
        for (int idx = tid; idx < 1024; idx += 512) { const int t = idx >> 8, v = idx & 255; vs[idx] = bf2f(p.PROJ[(row0 + t) * PS + C_AV + h * 256 + v]); }
        if (tid == 0) {
            const float m0 = p.state_m[task];
            float cs = 0.f;
            for (int t = 0; t < 4; ++t) { cs += logsigmoidf_(p.SM[(row0 + t) * 64 + 4 + h]); bc[t] = cs; ip[t] = p.SM[(row0 + t) * 64 + h]; }
            for (int t = 0; t < 4; ++t) {
                float mx = bc[t] + m0;
                for (int s = 0; s <= t; ++s) mx = fmaxf(mx, bc[t] - bc[s] + ip[s]);
                mt[t] = mx; wint[t] = __expf(bc[t] + m0 - mx); emt[t] = __expf(-mx);
            }
            const float bend = bc[3];
            float mnew = bend + m0;
            for (int s = 0; s < 4; ++s) mnew = fmaxf(mnew, bend - bc[s] + ip[s]);
            misc[0] = __expf(bend + m0 - mnew);
            for (int s = 0; s < 4; ++s) ww[s] = __expf(bend - bc[s] + ip[s] - mnew);
            p.out[O_SM + task] = mnew;
        }
        __syncthreads();
        if (tid < 16) {
            const int t = tid >> 2, s = tid & 3;
            float a = 0.f;
            if (s <= t) { for (int d = 0; d < 128; ++d) a += qs[t * 128 + d] * ks[s * 128 + d]; a *= __expf(bc[t] - bc[s] + ip[s] - mt[t]); }
            Pm[tid] = a;
        }
        __syncthreads();
        if (tid < 4) {
            const int t = tid; float qn = 0.f;
            for (int d = 0; d < 128; ++d) qn += qs[t * 128 + d] * p.state_n[(size_t)task * 128 + d];
            den[t] = wint[t] * qn + Pm[t * 4] + Pm[t * 4 + 1] + Pm[t * 4 + 2] + Pm[t * 4 + 3];
        }
        const float a = misc[0];
        if (tid >= 128 && tid < 256) {
            const int d = tid - 128;
            float n = a * p.state_n[(size_t)task * 128 + d];
            for (int s = 0; s < 4; ++s) n += ww[s] * ks[s * 128 + d];
            p.out[O_SN + (size_t)task * 128 + d] = n;
        }
        {
            const int v = tid & 255, dh = tid >> 8;
            float acc[4] = {0.f, 0.f, 0.f, 0.f};
            float wv[4];
#pragma unroll
            for (int s = 0; s < 4; ++s) wv[s] = ww[s] * vs[s * 256 + v];
            for (int d0 = dh * 64; d0 < dh * 64 + 64; d0 += 16) {
                float c0[16];
#pragma unroll
                for (int i = 0; i < 16; ++i) c0[i] = __builtin_nontemporal_load(p.state_C + ((size_t)task * 128 + d0 + i) * 256 + v);
#pragma unroll
                for (int i = 0; i < 16; ++i) {
                    const int d = d0 + i;
#pragma unroll
                    for (int t = 0; t < 4; ++t) acc[t] += qs[t * 128 + d] * c0[i];
                    float cn = a * c0[i];
#pragma unroll
                    for (int s = 0; s < 4; ++s) cn += ks[s * 128 + d] * wv[s];
                    __builtin_nontemporal_store(cn, p.out + O_SC + ((size_t)task * 128 + d) * 256 + v);
                }
            }
#pragma unroll
            for (int t = 0; t < 4; ++t) part[(dh * 4 + t) * 256 + v] = acc[t];
        }
        __syncthreads();
        if (tid < 256) {
            const int v = tid;
#pragma unroll
            for (int t = 0; t < 4; ++t) {
                float num = wint[t] * (part[t * 256 + v] + part[(4 + t) * 256 + v]);
#pragma unroll
                for (int s = 0; s < 4; ++s) num += Pm[t * 4 + s] * vs[s * 256 + v];
                hs[t * 256 + v] = num / fmaxf(fabsf(den[t]), emt[t]);
            }
        }
        __syncthreads();
        if (wid < 4) {
            const int t = wid;
            const f32x4 x = *(const f32x4*)(hs + t * 256 + lane * 4);
            const float mean = wave_sum(x[0] + x[1] + x[2] + x[3]) * (1.f / 256.f);
            float q = 0.f;
#pragma unroll
            for (int k = 0; k < 4; ++k) q += (x[k] - mean) * (x[k] - mean);
            const float rs = rsqrtf(wave_sum(q) * (1.f / 256.f) + LN_EPS);
            float y[4];
#pragma unroll
            for (int k = 0; k < 4; ++k) {
                const int vi = lane * 4 + k;
                const float o = bf2f(p.PROJ[(row0 + t) * PS + C_AO + h * 256 + vi]);
                y[k] = (x[k] - mean) * rs * p.norm_a_g[h * 256 + vi] * sigmoidf_(o);
            }
            u32x2 o2; o2.x = pack2(y[0], y[1]); o2.y = pack2(y[2], y[3]);
            *(u32x2*)(p.YA + (row0 + t) * 1024 + h * 256 + lane * 4) = o2;
        }
    }
}

constexpr int CP_ABUF = 33280, CP_WBUF = 18432, CP_A = 0, CP_W = 2 * CP_ABUF, CP_LDS = CP_W + 2 * CP_WBUF;
constexpr int CP_AROW = 1024 + 8;
DEVI void stage_compress(const P& p, char* smem, int bid, int nblk) {
    const int tid = tid_opq(), lane = tid & 63, wid = tid >> 6, fr = lane & 15, fq = lane >> 4;
    const int kv = wid & 1, rt = wid >> 1;
    const int n_it = (256 + nblk - 1) / nblk + (16 + nblk - 1) / nblk;
    for (int it = 0; it < n_it; ++it) {
        const int ns_it = (256 + nblk - 1) / nblk;
        const int task = it < ns_it ? bid + it * nblk : 256 + (nblk - 1 - bid) + (it - ns_it) * nblk;
        if (task >= 272 || (it < ns_it && task >= 256)) continue;
        const bool prompt = task >= 256;
        const int rowbytes = prompt ? 1024 : 2048, npieces = prompt ? 2 : 4;
        const char* src[4]; int dsto[4];
#pragma unroll
        for (int q = 0; q < 4; ++q) {
            const int off = q * 8192 + tid * 16, r = off / rowbytes, cb = off % rowbytes;
            if (prompt) { const int blk = (task - 256) * 16 + (r & 15); src[q] = (const char*)(p.PROJ + (size_t)blk * 64 * PS + C_CMP) + cb; dsto[q] = (r & 15) * CP_AROW * 2 + cb; }
            else { const int gb = task * 16 + r, b = gb >> 5, n = gb & 31; const int page = p.page_table[b * 16 + (n >> 1)];
                   src[q] = (const char*)(p.cache_cmp + ((size_t)page * 128 + (n & 1) * 64) * 512) + cb; dsto[q] = r * CP_AROW * 2 + (cb >> 1); }
        }
        const size_t sstride = prompt ? (size_t)PS * 2 : 2048;
        const char* wsrc[2]; int wdst[2];
#pragma unroll
        for (int q = 0; q < 2; ++q) { const int idx = q * 512 + tid, row = idx >> 3, ch = idx & 7; wsrc[q] = (const char*)(p.WCT + (size_t)row * 4096) + ch * 16; wdst[q] = row * 144 + ch * 16; }
        f32x4 acc[4];
#pragma unroll
        for (int nt = 0; nt < 4; ++nt) acc[nt] = (f32x4){0.f, 0.f, 0.f, 0.f};
        f32x4 ra0[4], ra1[4]; u32x4 rw0[2], rw1[2];
        auto issue = [&](int l, f32x4 (&ra)[4], u32x4 (&rw)[2]) {
#pragma unroll
            for (int q = 0; q < 4; ++q) if (q < npieces) ra[q] = *(const f32x4*)(src[q] + (size_t)l * sstride);
#pragma unroll
            for (int q = 0; q < 2; ++q) rw[q] = *(const u32x4*)(wsrc[q] + l * 128);
        };
        auto commit = [&](int buf, const f32x4 (&ra)[4], const u32x4 (&rw)[2]) {
            char* ab = smem + CP_A + buf * CP_ABUF; char* wbuf = smem + CP_W + buf * CP_WBUF;
#pragma unroll
            for (int q = 0; q < 4; ++q) if (q < npieces) {
                if (prompt) *(f32x4*)(ab + dsto[q]) = ra[q];
                else { u32x2 o; o.x = pack2(ra[q][0], ra[q][1]); o.y = pack2(ra[q][2], ra[q][3]); *(u32x2*)(ab + dsto[q]) = o; }
            }
#pragma unroll
            for (int q = 0; q < 2; ++q) *(u32x4*)(wbuf + wdst[q]) = rw[q];
        };
        auto consume = [&](int buf) {
            const char* ab = smem + CP_A + buf * CP_ABUF; const char* wbuf = smem + CP_W + buf * CP_WBUF;
            const bf16_t* arow = (const bf16_t*)ab + (rt * 4 + (fr >> 2)) * CP_AROW + kv * 256 + (fr & 3) * 64 + fq * 8;
#pragma unroll
            for (int hf = 0; hf < 2; ++hf) {
                const bf16x8 a = *(const bf16x8*)(arow + hf * 32);
#pragma unroll
                for (int nt = 0; nt < 4; ++nt) {
                    const bf16x8 bfrag = *(const bf16x8*)(wbuf + (kv * 64 + nt * 16 + fr) * 144 + hf * 64 + fq * 16);
                    acc[nt] = __builtin_amdgcn_mfma_f32_16x16x32_bf16(a, bfrag, acc[nt], 0, 0, 0);
                }
            }
        };
        __syncthreads();
        issue(0, ra0, rw0); issue(1, ra1, rw1); commit(0, ra0, rw0); issue(2, ra0, rw0);
        __syncthreads();
#pragma unroll 1
        for (int l = 0; l < 64; l += 2) {
            consume(0);
            commit(1, ra1, rw1);
            if (l + 3 < 64) issue(l + 3, ra1, rw1);
            __syncthreads();
            consume(1);
            if (l + 2 < 64) commit(0, ra0, rw0);
            if (l + 4 < 64) issue(l + 4, ra0, rw0);
            __syncthreads();
        }
        {
            const int ob = prompt ? (task - 256) * 16 + rt * 4 + fq : 256 + task * 16 + rt * 4 + fq;
#pragma unroll
            for (int nt = 0; nt < 4; ++nt) {
                const float bias = p.PW[kv * 64 + nt * 16 + fr];
#pragma unroll
                for (int r = 0; r < 4; ++r) p.KC[(size_t)ob * 512 + kv * 256 + r * 64 + nt * 16 + fr] = acc[nt][r] + bias;
            }
        }
    }
}

typedef float f32x16 __attribute__((ext_vector_type(16)));
typedef short s16x4 __attribute__((ext_vector_type(4)));
typedef __attribute__((address_space(3))) const char* lds_cptr;
#define MFMA32(a, b, c) __builtin_amdgcn_mfma_f32_32x32x16_bf16(a, b, c, 0, 0, 0)
DEVI int crow(int r, int hi) { return (r & 3) + 8 * (r >> 2) + 4 * hi; }
DEVI unsigned cvtpk(float lo, float hi) { return pack2(lo, hi); }
DEVI s16x4 vtr(lds_cptr p) { return __builtin_bit_cast(s16x4, __builtin_amdgcn_ds_read_tr16_b64_v4i16((__attribute__((address_space(3))) s16x4*)p)); }
DEVI float half_max(float m) { auto rr = __builtin_amdgcn_permlane32_swap(__float_as_uint(m), __float_as_uint(m), false, false); return fmaxf(__uint_as_float(rr[0]), __uint_as_float(rr[1])); }
DEVI float half_sum(float m) { auto rr = __builtin_amdgcn_permlane32_swap(__float_as_uint(m), __float_as_uint(m), false, false); return __uint_as_float(rr[0]) + __uint_as_float(rr[1]); }

struct BlkDesc { const char* k; int stride_bytes; int f32; int count; int pos0; };
DEVI void blk_load(const BlkDesc& d, int tid, u32x4& rk, u32x4& rv) {
    const int key = tid & 63, chunk = tid >> 6;
    rk = (u32x4){0u, 0u, 0u, 0u}; rv = rk;
    if (key < d.count) {
        const char* kr = d.k + (size_t)key * d.stride_bytes;
        if (d.f32) {
            const f32x4* s1 = (const f32x4*)(kr + chunk * 32); const f32x4* s2 = (const f32x4*)(kr + 1024 + chunk * 32);
            rk = pack8f(s1[0], s1[1]); rv = pack8f(s2[0], s2[1]);
        } else { rk = *(const u32x4*)(kr + chunk * 16); rv = *(const u32x4*)(kr + 512 + chunk * 16); }
    }
}
DEVI void blk_store(char* kimg, char* vimg, int tid, const u32x4& rk, const u32x4& rv) {
    const int key = tid & 63, chunk = tid >> 6;
    *(u32x4*)(kimg + chunk * 1024 + key * 16) = rk;
    *(u32x4*)(vimg + (chunk >> 2) * 4096 + key * 64 + (chunk & 3) * 16) = rv;
}

DEVI void attn_tile(const char* kimg, const char* vimg, const bf16x8 (&qr)[4], float& m2, float& lsum, f32x16& o0, f32x16& o1, f32x16& s0, f32x16& s1,
                    float sl, float bb, int lh, int ll, bool fast, float* wsf_hi  , float* wsf_r  , int lane) {
    const int r32 = lane & 31, hi = lane >> 5;
    const f32x16 z = {};
    s0 = z; s1 = z;
    {
        const char* kp = kimg + hi * 1024 + r32 * 16;
#pragma unroll
        for (int d0 = 0; d0 < 4; ++d0) {
            const bf16x8 k0 = *(const bf16x8*)(kp + d0 * 2048), k1 = *(const bf16x8*)(kp + d0 * 2048 + 512);
            s0 = MFMA32(k0, qr[d0], s0); s1 = MFMA32(k1, qr[d0], s1);
        }
    }
    float mx = -1e30f;
    if (fast) {
#pragma unroll
        for (int r = 0; r < 16; ++r) {
            const int c = (r & 3) + 8 * (r >> 2);
            s0[r] = fmaf(s0[r], 1.4426950408889634f, fmaf(sl, (float)c, bb)); s1[r] = fmaf(s1[r], 1.4426950408889634f, fmaf(sl, (float)(c + 32), bb));
            mx = fmaxf(mx, fmaxf(s0[r], s1[r]));
        }
    } else {
#pragma unroll
        for (int r = 0; r < 16; ++r) {
            const int c = (r & 3) + 8 * (r >> 2);
            const float t0 = fmaf(s0[r], 1.4426950408889634f, fmaf(sl, (float)c, bb)), t1 = fmaf(s1[r], 1.4426950408889634f, fmaf(sl, (float)(c + 32), bb));
            s0[r] = (c <= lh && c > ll) ? t0 : -INFINITY; s1[r] = (c + 32 <= lh && c + 32 > ll) ? t1 : -INFINITY;
            mx = fmaxf(mx, fmaxf(s0[r], s1[r]));
        }
    }
    mx = half_max(mx);
    const float mnew = fmaxf(m2, mx);
    const float f = __builtin_amdgcn_exp2f(m2 - mnew);
    m2 = mnew;
    float ps = 0.f;
#pragma unroll
    for (int r = 0; r < 16; ++r) { s0[r] = __builtin_amdgcn_exp2f(s0[r] - mnew); s1[r] = __builtin_amdgcn_exp2f(s1[r] - mnew); ps += s0[r] + s1[r]; }
    lsum = lsum * f + ps;
    if (__any(f != 1.f)) {
        if (hi == 0) *wsf_r = f;
        asm volatile("s_waitcnt lgkmcnt(0)" ::: "memory");
#pragma unroll
        for (int a = 0; a < 4; ++a) {
            const f32x4 fv = *(const f32x4*)(wsf_hi + 8 * a);
#pragma unroll
            for (int k = 0; k < 4; ++k) { o0[4 * a + k] *= fv[k]; o1[4 * a + k] *= fv[k]; }
        }
        asm volatile("s_waitcnt lgkmcnt(0)" ::: "memory");
    }
    u32x4 pw[4];
#pragma unroll
    for (int k = 0; k < 4; ++k) { pw[0][k] = cvtpk(s0[2 * k], s0[2 * k + 1]); pw[1][k] = cvtpk(s0[8 + 2 * k], s0[8 + 2 * k + 1]); pw[2][k] = cvtpk(s1[2 * k], s1[2 * k + 1]); pw[3][k] = cvtpk(s1[8 + 2 * k], s1[8 + 2 * k + 1]); }
    const lds_cptr vp = (lds_cptr)vimg + ((lane >> 4) & 1) * 32 + (lane & 3) * 8 + (4 * hi + ((lane & 15) >> 2)) * 64;
#pragma unroll
    for (int i = 0; i < 8; ++i) {
        const s16x4 lo = vtr(vp + ((i >> 2) * 4096 + (i & 3) * 1024)), hh = vtr(vp + ((i >> 2) * 4096 + (i & 3) * 1024 + 512));
        const bf16x8 vf = (bf16x8){lo[0], lo[1], lo[2], lo[3], hh[0], hh[1], hh[2], hh[3]};
        const bf16x8 pf = __builtin_bit_cast(bf16x8, pw[i & 3]);
        if (i < 4) o0 = MFMA32(pf, vf, o0); else o1 = MFMA32(pf, vf, o1);
    }
}

constexpr int NSA_KV0 = 0, NSA_KV1 = 16384, NSA_WSF = 32768, NSA_IMP = NSA_WSF + 2048, NSA_SEL = NSA_IMP + 16384, NSA_LIST = NSA_SEL + 512, NSA_OST = NSA_LIST + 256, NSA_YAC = NSA_OST + 32768, NSA_LDS = NSA_YAC + 65536;
static_assert(NSA_LDS <= 152 * 1024, "lds");

DEVI BlkDesc nsa_desc(const P& p, bool prompt, int b, int g, int branch, int j) {
    BlkDesc d;
    if (prompt) {
        if (branch == 0) { d.k = (const char*)(p.KC + ((size_t)(b * 64) * 512 + g * 64)); d.stride_bytes = 2048; d.f32 = 1; d.count = 64; d.pos0 = 0; }
        else { d.k = (const char*)(p.PROJ + ((size_t)b * 4096 + j * 64) * PS + (branch == 1 ? C_SLC : C_WIN) + g * 64); d.stride_bytes = PS * 2; d.f32 = 0; d.count = 64; d.pos0 = j * 64; }
    } else {
        if (branch == 0) { d.k = (const char*)(p.KC + ((size_t)(256 + b * 32) * 512 + g * 64)); d.stride_bytes = 2048; d.f32 = 1; d.count = 32; d.pos0 = 0; }
        else if (branch == 1 && j < 32) { const int page = p.page_table[b * 16 + (j >> 1)]; d.k = (const char*)(p.cache_slc + ((size_t)page * 128 + (j & 1) * 64) * 512 + g * 64); d.stride_bytes = 2048; d.f32 = 1; d.count = 64; d.pos0 = j * 64; }
        else if (branch == 2 && j < 8) { d.k = (const char*)(p.cache_win + ((size_t)b * 512 + j * 64) * 512 + g * 64); d.stride_bytes = 2048; d.f32 = 1; d.count = 64; d.pos0 = 1536 + j * 64; }
        else { d.k = (const char*)(p.PROJ + ((size_t)NTP + b * 4) * PS + (branch == 1 ? C_SLC : C_WIN) + g * 64); d.stride_bytes = PS * 2; d.f32 = 0; d.count = 4; d.pos0 = 2048; }
    }
    return d;
}

constexpr int NS_IMG = 0, NS_WSF = 131072, NS_IMP = NS_WSF + 2048, NS_SEL = NS_IMP + 2048, NS_LIST = NS_SEL + 64, NS_YC = NS_LIST + 64, NS_PM = NS_YC + 4096, NS_Q = NS_PM + 2048, NS_LDS = NS_Q + 4096;
static_assert(NS_LDS <= 152 * 1024, "lds");
DEVI void wave_stage_block(const BlkDesc& d, char* kimg, char* vimg, int lane) {
    asm volatile("" : "+v"(lane));
    const int rsub = lane >> 4, pc = lane & 15;
    if (d.f32) {
#pragma unroll
        for (int half = 0; half < 2; ++half) {
#pragma unroll
            for (int i0 = 0; i0 < 16; i0 += 6) {
                f32x4 x[6];
#pragma unroll
                for (int i = 0; i < 6; ++i) if (i0 + i < 16) { const int row = 4 * (i0 + i) + rsub; x[i] = row < d.count ? __builtin_nontemporal_load((const f32x4*)(d.k + (size_t)row * d.stride_bytes + half * 1024 + pc * 16)) : (f32x4){0.f, 0.f, 0.f, 0.f}; }
#pragma unroll
                for (int i = 0; i < 6; ++i) if (i0 + i < 16) {
                    const int row = 4 * (i0 + i) + rsub, c = pc >> 1;
                    u32x2 o; o.x = pack2(x[i][0], x[i][1]); o.y = pack2(x[i][2], x[i][3]);
                    if (half == 0) *(u32x2*)(kimg + c * 1024 + row * 16 + (pc & 1) * 8) = o;
                    else *(u32x2*)(vimg + (c >> 2) * 4096 + row * 64 + (c & 3) * 16 + (pc & 1) * 8) = o;
                }
            }
        }
    } else {
        const int row = lane >> 3, c = lane & 7;
#pragma unroll
        for (int i = 0; i < 8; ++i) {
            const int rr = 8 * i + row;
            u32x4 kk = {0u, 0u, 0u, 0u}, vv = {0u, 0u, 0u, 0u};
            if (rr < d.count) { kk = *(const u32x4*)(d.k + (size_t)rr * d.stride_bytes + c * 16); vv = *(const u32x4*)(d.k + (size_t)rr * d.stride_bytes + 512 + c * 16); }
            *(u32x4*)(kimg + c * 1024 + rr * 16) = kk;
            *(u32x4*)(vimg + (c >> 2) * 4096 + rr * 64 + (c & 3) * 16) = vv;
        }
    }
    asm volatile("s_waitcnt lgkmcnt(0)" ::: "memory");
}

DEVI void nsa_sample_unit(const P& p, char* smem, int us) {
    const int tid = tid_opq(), lane = tid & 63, wid = tid >> 6, r32 = lane & 31, hi = lane >> 5;
    const int b = us >> 2, g = us & 3;
    const size_t rowbase = (size_t)NTP + b * 4;
    char* kimg = smem + NS_IMG + wid * 16384; char* vimg = kimg + 8192;
    float* wsf = (float*)(smem + NS_WSF) + wid * 64;
    float* impb = (float*)(smem + NS_IMP);
    unsigned long long* selm = (unsigned long long*)(smem + NS_SEL);
    unsigned char* blist = (unsigned char*)(smem + NS_LIST);
    float* ycmp = (float*)(smem + NS_YC);
    const int tokl = r32 >> 2, head = r32 & 3;
    const bool tok_ok = r32 < 16;
    const int qpos = 2048 + tokl;
    const float slope2 = alibi_slope(g * 4 + head) * 1.4426950408889634f;
    char* qsh = smem + NS_Q;
    int hi4 = 4 * hi; asm volatile("" : "+v"(hi4));
    float* wsf_hi = wsf + hi4; float* wsf_r = wsf + r32;
    f32x16 s0, s1;
    __syncthreads();
    if (wid == 0) {
        bf16x8 qr[4];
        {
            const bf16_t* qp = p.PROJ + (rowbase + (tok_ok ? tokl : 0)) * PS + C_BQ + (g * 4 + head) * 64 + hi * 8;
#pragma unroll
            for (int d0 = 0; d0 < 4; ++d0) {
                u32x4 v = *(const u32x4*)(qp + d0 * 16);
#pragma unroll
                for (int k = 0; k < 4; ++k) { const float lo = __uint_as_float(v[k] << 16) * 0.125f, hh = __uint_as_float(v[k] & 0xFFFF0000u) * 0.125f; v[k] = tok_ok ? ((__float_as_uint(lo) >> 16) | (__float_as_uint(hh) & 0xFFFF0000u)) : 0u; }
                qr[d0] = __builtin_bit_cast(bf16x8, v);
                *(u32x4*)(qsh + d0 * 1024 + lane * 16) = v;
            }
        }
        f32x16 o0 = {}, o1 = {}; float m2 = -1e30f, lsum = 0.f;
        const BlkDesc d = nsa_desc(p, false, b, g, 0, 0);
        wave_stage_block(d, kimg, vimg, lane);
        const int lh = 31 - hi4;
        const float sl = 64.f * slope2;
        attn_tile(kimg, vimg, qr, m2, lsum, o0, o1, s0, s1, sl, tok_ok ? sl * (float)(hi4 - 32) : -INFINITY, lh, -1000, false, wsf_hi, wsf_r, lane);
        const float lt = half_sum(lsum);
        const float inv = lt > 0.f ? 1.f / lt : 0.f;
        unsigned x[64];
#pragma unroll
        for (int r = 0; r < 16; ++r) {
#pragma unroll
            for (int n = 0; n < 2; ++n) {
                float a = (n == 0 ? s0[r] : s1[r]) * inv;
                a += __shfl_xor(a, 1); a += __shfl_xor(a, 2);
                const int j = (r & 3) + 8 * (r >> 2) + 32 * n + hi4;
                if (j == 32 || j == 0) a = 5.0f;
                if (j > 32) a = -2.0f;
                const unsigned u = __float_as_uint(a);
                const unsigned o = (u & 0x80000000u) ? ~u : (u | 0x80000000u);
                x[n * 16 + r] = (o & ~63u) | (unsigned)(63 - j);
            }
        }
        float fac = 0.f;
        if (tok_ok && lt > 0.f) fac = sigmoidf_(p.SM[(rowbase + tokl) * 64 + 8 + g * 4 + head]) / lt;
        if (hi == 0) *wsf_r = fac;
        asm volatile("s_waitcnt lgkmcnt(0)" ::: "memory");
#pragma unroll
        for (int a = 0; a < 2; ++a) {
            const f32x4 fv = *(const f32x4*)(wsf_hi + 8 * a);
#pragma unroll
            for (int k = 0; k < 4; ++k) { float* yp = ycmp + (8 * a + k + hi4) * 64 + r32; yp[0] = o0[4 * a + k] * fv[k]; yp[32] = o1[4 * a + k] * fv[k]; }
        }
        asm volatile("s_waitcnt lgkmcnt(0)" ::: "memory");
        {
            sort16_desc<0>(x); sort16_desc<16>(x);
            unsigned th[16], oth[16], fin[16];
            merge_top16(&x[0], &x[16], th);
#pragma unroll
            for (int i = 0; i < 16; ++i) { auto rr = __builtin_amdgcn_permlane32_swap(th[i], th[i], false, false); oth[i] = hi ? rr[0] : rr[1]; }
            merge_top16(th, oth, fin);
            unsigned long long mask = 0ull;
#pragma unroll
            for (int i = 0; i < 16; ++i) mask |= 1ull << (63u - (fin[i] & 63u));
            if (head == 0 && hi == 0 && r32 < 16) selm[r32 >> 2] = mask;
        }
        asm volatile("s_waitcnt lgkmcnt(0)" ::: "memory");
        {
            const unsigned long long u = selm[0] | selm[1] | selm[2] | selm[3];
            const int n = __builtin_popcountll(u);
            if ((u >> lane) & 1ull) blist[1 + __builtin_popcountll(u & ((1ull << lane) - 1ull))] = (unsigned char)(0x40 | lane);
            if (lane <= 8) blist[1 + n + lane] = (unsigned char)(0x80 | lane);
            if (lane == 0) blist[0] = (unsigned char)(n + 9);
        }
    }
    __syncthreads();
    const int nb = blist[0];
    const unsigned long long mysel = tok_ok ? selm[tokl] : 0ull;
    int nslc = 0;
    for (int i = 0; i < nb; ++i) nslc += (blist[1 + i] >> 6) == 1 ? 1 : 0;
    float so[16], ms, lst;
    float wo[16], mw, lwt;
#pragma unroll 1
    for (int pass = 0; pass < 2; ++pass) {
        f32x16 o0 = {}, o1 = {}; float m2 = -1e30f, lsum = 0.f;
        const int i0 = pass == 0 ? 0 : nslc, i1 = pass == 0 ? nslc : nb;
#pragma unroll 1
        for (int i = i0 + wid; i < i1; i += 8) {
            const int e = blist[1 + i], br = e >> 6, j = e & 63;
            const BlkDesc d = nsa_desc(p, false, b, g, br, j);
            wave_stage_block(d, kimg, vimg, lane);
            asm volatile("" : "+v"(hi4));
            const bool lsel = tok_ok && (br == 2 || ((mysel >> j) & 1ull));
            const int rel = qpos - d.pos0;
            const int lh = (rel < d.count - 1 ? rel : d.count - 1) - hi4;
            const int ll = (br == 2 ? rel - 512 : -1000) - hi4;
            const bool fast = __all(!lsel || (lh >= 59 && ll < 0));
            const float bb = lsel ? slope2 * (float)(hi4 + d.pos0 - 2048) : -INFINITY;
            bf16x8 qr[4];
#pragma unroll
            for (int d0 = 0; d0 < 4; ++d0) qr[d0] = *(const bf16x8*)(qsh + d0 * 1024 + lane * 16);
            attn_tile(kimg, vimg, qr, m2, lsum, o0, o1, s0, s1, slope2, bb, lh, ll, fast, wsf_hi, wsf_r, lane);
        }
        const float lt = half_sum(lsum);
        if (pass == 0) { ms = m2; lst = lt;
#pragma unroll
            for (int r = 0; r < 8; ++r) { so[r] = o0[r]; so[8 + r] = o1[r]; } }
        else { mw = m2; lwt = lt;
#pragma unroll
            for (int r = 0; r < 8; ++r) { wo[r] = o0[r]; wo[8 + r] = o1[r]; } }
    }
    {
        float* po = (float*)kimg;
        float* pm = (float*)(smem + NS_PM) + wid * 64;
        if (lane < 16) { pm[lane * 2] = ms; pm[lane * 2 + 1] = lst; pm[32 + lane * 2] = mw; pm[32 + lane * 2 + 1] = lwt; }
#pragma unroll
        for (int a = 0; a < 2; ++a)
#pragma unroll
            for (int k = 0; k < 4; ++k) {
                float* yp = po + (8 * a + k + hi4) * 64 + r32;
                yp[0] = so[4 * a + k]; yp[32] = so[8 + 4 * a + k]; yp[1024] = wo[4 * a + k]; yp[1024 + 32] = wo[8 + 4 * a + k];
            }
    }
    __syncthreads();
    {
        const int row = tid >> 5, dcol = tid & 31, tk = row >> 2, hd = row & 3;
        float res[2][2];
#pragma unroll
        for (int br = 0; br < 2; ++br) {
            float M = -1e30f;
#pragma unroll
            for (int w = 0; w < 8; ++w) M = fmaxf(M, ((const float*)(smem + NS_PM))[w * 64 + br * 32 + row * 2]);
            float L = 0.f, a0 = 0.f, a1 = 0.f;
#pragma unroll
            for (int w = 0; w < 8; ++w) {
                const float* pmw = (const float*)(smem + NS_PM) + w * 64 + br * 32 + row * 2;
                const float f = __builtin_amdgcn_exp2f(pmw[0] - M);
                const float* pow_ = (const float*)(smem + NS_IMG + w * 16384) + br * 1024 + row * 64 + dcol;
                L += pmw[1] * f; a0 += pow_[0] * f; a1 += pow_[32] * f;
            }
            const float gate = sigmoidf_(p.SM[(rowbase + tk) * 64 + 8 + (br + 1) * 16 + g * 4 + hd]);
            const float sc = L > 0.f ? gate / L : 0.f;
            res[br][0] = a0 * sc; res[br][1] = a1 * sc;
        }
        const float y0 = ycmp[row * 64 + dcol] + res[0][0] + res[1][0], y1 = ycmp[row * 64 + dcol + 32] + res[0][1] + res[1][1];
        bf16_t* yb = p.YB + (rowbase + tk) * 1024 + (g * 4 + hd) * 64;
        yb[dcol] = f2bf(y0); yb[dcol + 32] = f2bf(y1);
    }
}

constexpr int NP_KVB = 18432, NP_KV0 = 0, NP_KV1 = NP_KVB, NP_WSF = 2 * NP_KVB, NP_IMP = NP_WSF + 2048, NP_SEL = NP_IMP + 16384, NP_LIST = NP_SEL + 512, NP_YAC = NP_LIST + 256, NP_LDS = NP_YAC + 65536;
static_assert(NP_LDS <= 152 * 1024, "lds");
DEVI void blk_store_ext(const BlkDesc& d, int pstep, int poff, int t0, char* kimg, char* vimg, int tid, const u32x4& rk, const u32x4& rv) {
    const int key = tid & 63, chunk = tid >> 6;
    *(u32x4*)(kimg + chunk * 1024 + key * 16) = rk;
    *(u32x4*)(vimg + (chunk >> 2) * 4096 + key * 64 + (chunk & 3) * 16) = rv;
    if (chunk == 0) {
        const int rel = d.pos0 + key * pstep + poff - t0;
        const int phi = (rel >> 6) << 6, plo = rel & 63;
        const unsigned bh = pack2((float)phi, (float)phi), bl = pack2((float)plo, (float)plo);
        *(u32x4*)(kimg + 8 * 1024 + key * 16) = (u32x4){bh, bl, 0x00003F80u, 0u};
    }
}
DEVI void attn_tile2(const char* kimg, const char* vimg, const bf16x8 (&qr)[4], const bf16x8 qext, float& m, float& lsum, f32x16& o0, f32x16& o1, f32x16& s0, f32x16& s1,
                     int lh, int ll, bool fast, float* wsf_hi, float* wsf_r, int lane) {
    const int r32 = lane & 31, hi = lane >> 5;
    const f32x16 z = {};
    s0 = z; s1 = z;
    {
        const char* kp = kimg + hi * 1024 + r32 * 16;
#pragma unroll
        for (int d0 = 0; d0 < 5; ++d0) {
            const bf16x8 k0 = *(const bf16x8*)(kp + d0 * 2048), k1 = *(const bf16x8*)(kp + d0 * 2048 + 512);
            const bf16x8 qf = d0 < 4 ? qr[d0 < 4 ? d0 : 0] : qext;
            s0 = MFMA32(k0, qf, s0); s1 = MFMA32(k1, qf, s1);
        }
    }
    if (!fast) {
#pragma unroll
        for (int r = 0; r < 16; ++r) {
            const int c = (r & 3) + 8 * (r >> 2);
            s0[r] = (c <= lh && c > ll) ? s0[r] : -INFINITY; s1[r] = (c + 32 <= lh && c + 32 > ll) ? s1[r] : -INFINITY;
        }
    }
    float mx = fmaxf(s0[0], s1[0]);
#pragma unroll
    for (int r = 1; r < 16; ++r) mx = fmaxf(mx, fmaxf(s0[r], s1[r]));
    mx = half_max(mx);
    const float mnew = fmaxf(m, mx);
    const float f = __builtin_amdgcn_exp2f((m - mnew) * 1.4426950408889634f);
    m = mnew;
    const float nm2 = -mnew * 1.4426950408889634f;
    float ps = 0.f;
#pragma unroll
    for (int r = 0; r < 16; ++r) { s0[r] = __builtin_amdgcn_exp2f(fmaf(s0[r], 1.4426950408889634f, nm2)); s1[r] = __builtin_amdgcn_exp2f(fmaf(s1[r], 1.4426950408889634f, nm2)); ps += s0[r] + s1[r]; }
    lsum = lsum * f + ps;
    if (__any(f != 1.f)) {
        if (hi == 0) *wsf_r = f;
        asm volatile("s_waitcnt lgkmcnt(0)" ::: "memory");
#pragma unroll
        for (int a = 0; a < 4; ++a) {
            const f32x4 fv = *(const f32x4*)(wsf_hi + 8 * a);
#pragma unroll
            for (int k = 0; k < 4; ++k) { o0[4 * a + k] *= fv[k]; o1[4 * a + k] *= fv[k]; }
        }
        asm volatile("s_waitcnt lgkmcnt(0)" ::: "memory");
    }
    u32x4 pw[4];
#pragma unroll
    for (int k = 0; k < 4; ++k) { pw[0][k] = cvtpk(s0[2 * k], s0[2 * k + 1]); pw[1][k] = cvtpk(s0[8 + 2 * k], s0[8 + 2 * k + 1]); pw[2][k] = cvtpk(s1[2 * k], s1[2 * k + 1]); pw[3][k] = cvtpk(s1[8 + 2 * k], s1[8 + 2 * k + 1]); }
    const lds_cptr vp = (lds_cptr)vimg + ((lane >> 4) & 1) * 32 + (lane & 3) * 8 + (4 * hi + ((lane & 15) >> 2)) * 64;
#pragma unroll
    for (int i = 0; i < 8; ++i) {
        const s16x4 lo = vtr(vp + ((i >> 2) * 4096 + (i & 3) * 1024)), hh = vtr(vp + ((i >> 2) * 4096 + (i & 3) * 1024 + 512));
        const bf16x8 vf = (bf16x8){lo[0], lo[1], lo[2], lo[3], hh[0], hh[1], hh[2], hh[3]};
        const bf16x8 pf = __builtin_bit_cast(bf16x8, pw[i & 3]);
        if (i < 4) o0 = MFMA32(pf, vf, o0); else o1 = MFMA32(pf, vf, o1);
    }
}

DEVI void attn_tile3(const char* kA, const char* vA, const char* kB, const char* vB, const bf16x8 (&qr)[4], const bf16x8 qeA, const bf16x8 qeB, float& m, float& lsum,
                     f32x16& o0, f32x16& o1, int lhA, int llA, bool fastA, int lhB, int llB, bool fastB, float* wsf_hi, float* wsf_r, int lane) {
    const int r32 = lane & 31, hi = lane >> 5;
    f32x16 a0 = {}, a1 = {}, b0 = {}, b1 = {};
    {
        const char* kpa = kA + hi * 1024 + r32 * 16; const char* kpb = kB + hi * 1024 + r32 * 16;
#pragma unroll
        for (int d0 = 0; d0 < 5; ++d0) {
            const bf16x8 ka0 = *(const bf16x8*)(kpa + d0 * 2048), ka1 = *(const bf16x8*)(kpa + d0 * 2048 + 512);
            const bf16x8 kb0 = *(const bf16x8*)(kpb + d0 * 2048), kb1 = *(const bf16x8*)(kpb + d0 * 2048 + 512);
            const bf16x8 qa = d0 < 4 ? qr[d0 < 4 ? d0 : 0] : qeA, qb = d0 < 4 ? qr[d0 < 4 ? d0 : 0] : qeB;
            a0 = MFMA32(ka0, qa, a0); a1 = MFMA32(ka1, qa, a1); b0 = MFMA32(kb0, qb, b0); b1 = MFMA32(kb1, qb, b1);
        }
    }
    if (!fastA) {
#pragma unroll
        for (int r = 0; r < 16; ++r) { const int c = (r & 3) + 8 * (r >> 2); a0[r] = (c <= lhA && c > llA) ? a0[r] : -INFINITY; a1[r] = (c + 32 <= lhA && c + 32 > llA) ? a1[r] : -INFINITY; }
    }
    if (!fastB) {
#pragma unroll
        for (int r = 0; r < 16; ++r) { const int c = (r & 3) + 8 * (r >> 2); b0[r] = (c <= lhB && c > llB) ? b0[r] : -INFINITY; b1[r] = (c + 32 <= lhB && c + 32 > llB) ? b1[r] : -INFINITY; }
    }
    float mx = fmaxf(fmaxf(a0[0], a1[0]), fmaxf(b0[0], b1[0]));
#pragma unroll
    for (int r = 1; r < 16; ++r) mx = fmaxf(mx, fmaxf(fmaxf(a0[r], a1[r]), fmaxf(b0[r], b1[r])));
    mx = half_max(mx);
    const float mnew = fmaxf(m, mx);
    const float f = __builtin_amdgcn_exp2f((m - mnew) * 1.4426950408889634f);
    m = mnew;
    const float nm2 = -mnew * 1.4426950408889634f;
    float ps = 0.f;
#pragma unroll
    for (int r = 0; r < 16; ++r) {
        a0[r] = __builtin_amdgcn_exp2f(fmaf(a0[r], 1.4426950408889634f, nm2)); a1[r] = __builtin_amdgcn_exp2f(fmaf(a1[r], 1.4426950408889634f, nm2));
        b0[r] = __builtin_amdgcn_exp2f(fmaf(b0[r], 1.4426950408889634f, nm2)); b1[r] = __builtin_amdgcn_exp2f(fmaf(b1[r], 1.4426950408889634f, nm2));
        ps += (a0[r] + a1[r]) + (b0[r] + b1[r]);
    }
    lsum = lsum * f + ps;
    if (__any(f != 1.f)) {
        if (hi == 0) *wsf_r = f;
        asm volatile("s_waitcnt lgkmcnt(0)" ::: "memory");
#pragma unroll
        for (int a = 0; a < 4; ++a) {
            const f32x4 fv = *(const f32x4*)(wsf_hi + 8 * a);
#pragma unroll
            for (int k = 0; k < 4; ++k) { o0[4 * a + k] *= fv[k]; o1[4 * a + k] *= fv[k]; }
        }
        asm volatile("s_waitcnt lgkmcnt(0)" ::: "memory");
    }
    const int voff = ((lane >> 4) & 1) * 32 + (lane & 3) * 8 + (4 * hi + ((lane & 15) >> 2)) * 64;
#pragma unroll
    for (int t = 0; t < 2; ++t) {
        const f32x16& p0 = t == 0 ? a0 : b0; const f32x16& p1 = t == 0 ? a1 : b1;
        u32x4 pw[4];
#pragma unroll
        for (int k = 0; k < 4; ++k) { pw[0][k] = cvtpk(p0[2 * k], p0[2 * k + 1]); pw[1][k] = cvtpk(p0[8 + 2 * k], p0[8 + 2 * k + 1]); pw[2][k] = cvtpk(p1[2 * k], p1[2 * k + 1]); pw[3][k] = cvtpk(p1[8 + 2 * k], p1[8 + 2 * k + 1]); }
        const lds_cptr vp = (lds_cptr)(t == 0 ? vA : vB) + voff;
#pragma unroll
        for (int i = 0; i < 8; ++i) {
            const s16x4 lo = vtr(vp + ((i >> 2) * 4096 + (i & 3) * 1024)), hh = vtr(vp + ((i >> 2) * 4096 + (i & 3) * 1024 + 512));
            const bf16x8 vf = (bf16x8){lo[0], lo[1], lo[2], lo[3], hh[0], hh[1], hh[2], hh[3]};
            const bf16x8 pf = __builtin_bit_cast(bf16x8, pw[i & 3]);
            if (i < 4) o0 = MFMA32(pf, vf, o0); else o1 = MFMA32(pf, vf, o1);
        }
    }
}

constexpr int NQ_KVB = 18432, NQ_WSF = 4 * NQ_KVB, NQ_SEL = NQ_WSF + 2048, NQ_LIST = NQ_SEL + 512, NQ_YAC = NQ_LIST + 256, NQ_LDS = NQ_YAC + 65536, NQ_IMP = 2 * NQ_KVB;
static_assert(NQ_LDS <= 152 * 1024, "lds");
DEVI void nsa_prompt_unit(const P& p, char* smem, int unit) {
    const int tid = tid_opq(), lane = tid & 63, wid = tid >> 6, r32 = lane & 31, hi = lane >> 5;
    float* wsf = (float*)(smem + NQ_WSF) + wid * 64;
    float* impb = (float*)(smem + NQ_IMP) + wid * 512;
    unsigned long long* selm = (unsigned long long*)(smem + NQ_SEL);
    unsigned char* blist = (unsigned char*)(smem + NQ_LIST);
    const int b = unit >> 8, g = ((unit >> 6) + b) & 3, qt = (b & 1) ? 63 - (unit & 63) : (unit & 63), t0 = qt * 64;
    const size_t rowbase = (size_t)b * 4096 + t0;
    const int tokl = wid * 8 + (r32 >> 2), head = r32 & 3;
    const int qpos = t0 + tokl;
    const float slope = alibi_slope(g * 4 + head);
    bf16x8 qr[4];
    {
        const bf16_t* qp = p.PROJ + (rowbase + tokl) * PS + C_BQ + (g * 4 + head) * 64 + hi * 8;
#pragma unroll
        for (int d0 = 0; d0 < 4; ++d0) {
            u32x4 v = *(const u32x4*)(qp + d0 * 16);
#pragma unroll
            for (int k = 0; k < 4; ++k) { const float lo = __uint_as_float(v[k] << 16) * 0.125f, hh = __uint_as_float(v[k] & 0xFFFF0000u) * 0.125f; v[k] = (__float_as_uint(lo) >> 16) | (__float_as_uint(hh) & 0xFFFF0000u); }
            qr[d0] = __builtin_bit_cast(bf16x8, v);
        }
    }
    unsigned qe_w;
    { const unsigned sh = (unsigned)f2bf(slope); const float rem = slope - __uint_as_float(sh << 16); qe_w = sh | ((unsigned)f2bf(rem) << 16); if (hi) qe_w = 0u; }
    int hi4 = 4 * hi; asm volatile("" : "+v"(hi4));
    float* yl = (float*)(smem + NQ_YAC) + wid * 2048 + hi4 * 64 + r32;
    float* wsf_hi = wsf + hi4; float* wsf_r = wsf + r32;
    f32x16 o0, o1; float m, lsum;
    auto finish = [&](int br) {
        const float lt = half_sum(lsum);
        float fac = 0.f;
        if (lt > 0.f) fac = sigmoidf_(p.SM[(rowbase + tokl) * 64 + 8 + br * 16 + g * 4 + head]) / lt;
        if (hi == 0) *wsf_r = fac;
        asm volatile("s_waitcnt lgkmcnt(0)" ::: "memory");
#pragma unroll
        for (int a = 0; a < 4; ++a) {
            const f32x4 fv = *(const f32x4*)(wsf_hi + 8 * a);
#pragma unroll
            for (int k = 0; k < 4; ++k) {
                float* yp = yl + (8 * a + k) * 64;
                if (br == 0) { yp[0] = o0[4 * a + k] * fv[k]; yp[32] = o1[4 * a + k] * fv[k]; }
                else { yp[0] += o0[4 * a + k] * fv[k]; yp[32] += o1[4 * a + k] * fv[k]; }
            }
        }
        asm volatile("s_waitcnt lgkmcnt(0)" ::: "memory");
    };
    __syncthreads();
    if (tid < 64) *(u32x4*)(smem + 9 * 1024 + tid * 16) = (u32x4){0u, 0u, 0u, 0u};
    {
        const BlkDesc d = nsa_desc(p, true, b, g, 0, 0);
        u32x4 rk, rv; blk_load(d, tid, rk, rv); blk_store_ext(d, 64, 63, t0, smem, smem + 10240, tid, rk, rv);
        __syncthreads();
        o0 = (f32x16){}; o1 = (f32x16){}; m = -1e30f; lsum = 0.f;
        f32x16 s0, s1;
        {
            const int nv = ((qpos + 1) >> 6) - 1;
            const int lh = (nv < 63 ? nv : 63) - hi4;
            const bf16x8 qext = __builtin_bit_cast(bf16x8, (u32x4){qe_w, qe_w, 0u, 0u});
            attn_tile2(smem, smem + 10240, qr, qext, m, lsum, o0, o1, s0, s1, lh, -1000, false, wsf_hi, wsf_r, lane);
        }
        const float lt = half_sum(lsum);
        const float inv = lt > 0.f ? 1.f / lt : 0.f;
        unsigned x[64];
#pragma unroll
        for (int r = 0; r < 16; ++r) {
#pragma unroll
            for (int n = 0; n < 2; ++n) {
                float a = (n == 0 ? s0[r] : s1[r]) * inv;
                a += __shfl_xor(a, 1); a += __shfl_xor(a, 2);
                const int j = (r & 3) + 8 * (r >> 2) + 32 * n + hi4;
                if (j == qt || j == 0) a = 5.0f;
                if (j > qt) a = -1.0f;
                const unsigned u = __float_as_uint(a);
                const unsigned o = (u & 0x80000000u) ? ~u : (u | 0x80000000u);
                x[n * 16 + r] = (o & ~63u) | (unsigned)(63 - j);
            }
        }
        finish(0);
        sort16_desc<0>(x); sort16_desc<16>(x);
        unsigned th[16], oth[16], fin[16];
        merge_top16(&x[0], &x[16], th);
#pragma unroll
        for (int i = 0; i < 16; ++i) { auto rr = __builtin_amdgcn_permlane32_swap(th[i], th[i], false, false); oth[i] = hi ? rr[0] : rr[1]; }
        merge_top16(th, oth, fin);
        unsigned long long mask = 0ull;
#pragma unroll
        for (int i = 0; i < 16; ++i) mask |= 1ull << (63u - (fin[i] & 63u));
        if (head == 0 && hi == 0) selm[wid * 8 + (r32 >> 2)] = mask;
    }
    __syncthreads();
    if (wid == 0) {
        unsigned long long u = selm[lane];
#pragma unroll
        for (int o = 32; o > 0; o >>= 1) u |= __shfl_xor(u, o);
        u &= (qt == 63) ? ~0ull : ((1ull << (qt + 1)) - 1ull);
        {
            const int n = __builtin_popcountll(u);
            if ((u >> lane) & 1ull) blist[2 + __builtin_popcountll(u & ((1ull << lane) - 1ull))] = (unsigned char)lane;
            const int w0 = qt - 8 > 0 ? qt - 8 : 0, nw = qt - w0 + 1;
            if (lane < nw) blist[2 + n + lane] = (unsigned char)(w0 + lane);
            if (lane == 0) { blist[0] = (unsigned char)n; blist[1] = (unsigned char)nw; }
        }
    }
    __syncthreads();
    if (tid >= 64 && tid < 256) *(u32x4*)(smem + (tid >> 6) * NQ_KVB + 9 * 1024 + (tid & 63) * 16) = (u32x4){0u, 0u, 0u, 0u};
    const int ns = blist[0], nw = blist[1];
    const int nss = (ns + 1) >> 1, nsteps = nss + ((nw + 1) >> 1);
    const unsigned long long mysel = selm[tokl];
    {
        auto step_blocks = [&](int s, int& br, int& jA, int& jB) {
            if (s < nss) { br = 1; jA = blist[2 + 2 * s]; jB = 2 * s + 1 < ns ? (int)blist[2 + 2 * s + 1] : -1; }
            else { const int w = s - nss; br = 2; jA = blist[2 + ns + 2 * w]; jB = 2 * w + 1 < nw ? (int)blist[2 + ns + 2 * w + 1] : -1; }
        };
        u32x4 rkA, rvA, rkB, rvB;
        auto load_step = [&](int s) {
            int br, jA, jB; step_blocks(s, br, jA, jB);
            const BlkDesc dA = nsa_desc(p, true, b, g, br, jA); blk_load(dA, tid, rkA, rvA);
            if (jB >= 0) { const BlkDesc dB = nsa_desc(p, true, b, g, br, jB); blk_load(dB, tid, rkB, rvB); }
        };
        auto store_step = [&](int s, char* buf) {
            int br, jA, jB; step_blocks(s, br, jA, jB);
            BlkDesc dA; dA.pos0 = jA * 64; blk_store_ext(dA, 1, 0, t0, buf, buf + 10240, tid, rkA, rvA);
            if (jB >= 0) { BlkDesc dB; dB.pos0 = jB * 64; blk_store_ext(dB, 1, 0, t0, buf + NQ_KVB, buf + NQ_KVB + 10240, tid, rkB, rvB); }
        };
        load_step(0); store_step(0, smem);
        __syncthreads();
        int prev_br = 1;
        o0 = (f32x16){}; o1 = (f32x16){}; m = -1e30f; lsum = 0.f;
        for (int s = 0; s < nsteps; ++s) {
            int br, jA, jB; step_blocks(s, br, jA, jB);
            char* cur = smem + (s & 1) * 2 * NQ_KVB;
            char* nxt = smem + ((s & 1) ^ 1) * 2 * NQ_KVB;
            if (s + 1 < nsteps) load_step(s + 1);
            if (br != prev_br) { finish(1); o0 = (f32x16){}; o1 = (f32x16){}; m = -1e30f; lsum = 0.f; prev_br = br; }
            {
                asm volatile("" : "+v"(hi4));
                const bool lselA = br == 2 || ((mysel >> jA) & 1ull);
                const int relA = qpos - jA * 64;
                const int lhA = (relA < 63 ? relA : 63) - hi4, llA = (br == 2 ? relA - 512 : -1000) - hi4;
                const bool fastA = __all(!lselA || (lhA >= 59 && llA < 0));
                const bool needA = __any(lselA && lhA + hi4 >= 0 && llA + hi4 < 63);
                const bf16x8 qeA = __builtin_bit_cast(bf16x8, (u32x4){qe_w, qe_w, (lselA || hi) ? 0u : 0x0000C6EAu, 0u});
                bool needB = false; bool lselB = false; int lhB = -1000, llB = -1000; bool fastB = false;
                if (jB >= 0) {
                    lselB = br == 2 || ((mysel >> jB) & 1ull);
                    const int relB = qpos - jB * 64;
                    lhB = (relB < 63 ? relB : 63) - hi4; llB = (br == 2 ? relB - 512 : -1000) - hi4;
                    fastB = __all(!lselB || (lhB >= 59 && llB < 0));
                    needB = __any(lselB && lhB + hi4 >= 0 && llB + hi4 < 63);
                }
                const bf16x8 qeB = __builtin_bit_cast(bf16x8, (u32x4){qe_w, qe_w, (lselB || hi) ? 0u : 0x0000C6EAu, 0u});
                f32x16 s0, s1;
                if (needA && needB) attn_tile3(cur, cur + 10240, cur + NQ_KVB, cur + NQ_KVB + 10240, qr, qeA, qeB, m, lsum, o0, o1, lhA, llA, fastA, lhB, llB, fastB, wsf_hi, wsf_r, lane);
                else if (needA) attn_tile2(cur, cur + 10240, qr, qeA, m, lsum, o0, o1, s0, s1, lhA, llA, fastA, wsf_hi, wsf_r, lane);
                else if (needB) attn_tile2(cur + NQ_KVB, cur + NQ_KVB + 10240, qr, qeB, m, lsum, o0, o1, s0, s1, lhB, llB, fastB, wsf_hi, wsf_r, lane);
            }
            if (s + 1 < nsteps) store_step(s + 1, nxt);
            __syncthreads();
        }
        finish(2);
    }
    {
        const float* yac = (const float*)(smem + NQ_YAC) + wid * 2048;
#pragma unroll
        for (int i = 0; i < 4; ++i) {
            const int orow = i * 8 + (lane >> 3), ch = lane & 7, tk = wid * 8 + (orow >> 2), hd = orow & 3;
            const f32x4 a = *(const f32x4*)(yac + orow * 64 + ch * 8), c = *(const f32x4*)(yac + orow * 64 + ch * 8 + 4);
            *(u32x4*)(p.YB + (rowbase + tk) * 1024 + (g * 4 + hd) * 64 + ch * 8) = pack8f(a, c);
        }
        asm volatile("s_waitcnt lgkmcnt(0)" ::: "memory");
    }
}

DEVI void stage_nsa_attn(const P& p, char* smem, int bid, int nblk) {
#ifndef NSA_REP
#define NSA_REP 0
#endif
    const int n_units = 1024 + 512 + (NSA_REP == 1 ? 1024 : 0) + (NSA_REP == 2 ? 512 : 0);
    for (int unit0 = bid; unit0 < n_units; unit0 += nblk) {
        const int unit = unit0 < 1536 ? unit0 : (NSA_REP == 1 ? unit0 - 1536 : unit0 - 512);
        if (unit < 1024) nsa_prompt_unit(p, smem, unit); else nsa_sample_unit(p, smem, unit - 1024);
    }
}

DEVI void stage_ln1(const P& p, int bid, int nblk) {
    const int lane = tid_opq() & 63, wid = tid_opq() >> 6;
    for (int row = bid * 8 + wid; row < NT; row += nblk * 8) {
        f32x4 x[4];
        float s = 0.f;
#pragma unroll
        for (int i = 0; i < 4; ++i) { x[i] = *(const f32x4*)(p.R + (size_t)row * 1024 + i * 256 + lane * 4); s += x[i][0] + x[i][1] + x[i][2] + x[i][3]; }
        const float mean = wave_sum(s) * (1.f / 1024.f);
        float q = 0.f;
#pragma unroll
        for (int i = 0; i < 4; ++i)
#pragma unroll
            for (int k = 0; k < 4; ++k) q += (x[i][k] - mean) * (x[i][k] - mean);
        const float rs = rsqrtf(wave_sum(q) * (1.f / 1024.f) + LN_EPS);
#pragma unroll
        for (int i = 0; i < 4; ++i) {
            const int c = i * 256 + lane * 4;
            const f32x4 gg = *(const f32x4*)(p.ln1_g + c), bb = *(const f32x4*)(p.ln1_b + c);
            f32x4 y;
#pragma unroll
            for (int k = 0; k < 4; ++k) y[k] = (x[i][k] - mean) * rs * gg[k] + bb[k];
            u32x2 o; o.x = pack2(y[0], y[1]); o.y = pack2(y[2], y[3]);
            *(u32x2*)(p.HB + (size_t)row * 1024 + c) = o;
        }
        if (lane == 0) { p.H[(size_t)row * 2] = mean; p.H[(size_t)row * 2 + 1] = rs; }
    }
}

__device__ const unsigned char PEER_CA[50] = {0,0,0,0,0,0,0,0,0,0,0,0,0,0,0,0, 1,1,1,1,1,1,1,1, 2,2,2,2,2, 3,3,3,3, 4,4,4, 5,5, 6,6, 7,7, 8,9,10,11,12,13,14,15};
__device__ const unsigned char PEER_CB[50] = {0,1,2,3,4,5,6,7,8,9,10,11,12,13,14,15, 0,1,2,3,4,5,6,7, 0,1,2,3,4, 0,1,2,3, 0,1,2, 0,1, 0,1, 0,1, 0,0,0,0,0,0,0,0};

DEVI float key_score(unsigned k) { const unsigned u = k & ~127u; return __uint_as_float((u & 0x80000000u) ? (u & 0x7FFFFFFFu) : ~u); }

DEVI void sort8_desc(unsigned (&x)[16]) {
#pragma unroll
    for (int k = 2; k <= 8; k <<= 1)
#pragma unroll
        for (int j = k >> 1; j > 0; j >>= 1)
#pragma unroll
            for (int i = 0; i < 8; ++i) {
                const int l = i ^ j;
                if (l > i) { if ((i & k) == 0) ce_desc(x[i], x[l]); else ce_desc(x[l], x[i]); }
            }
}
DEVI unsigned sum_key(unsigned ka, unsigned kb, unsigned tag) {
    const unsigned u = __float_as_uint(key_score(ka) + key_score(kb));
    const unsigned o = (u & 0x80000000u) ? ~u : (u | 0x80000000u);
    return (o & ~255u) | tag;
}
DEVI float key_score8(unsigned k) { const unsigned u = k & ~255u; return __uint_as_float((u & 0x80000000u) ? (u & 0x7FFFFFFFu) : ~u); }

DEVI void route_top16(const P& p, int row, int ph, int c, int r32, int hi, int hi4, unsigned (&fin)[16]) {
    f32x16 acc[4];
#pragma unroll
    for (int t = 0; t < 4; ++t) acc[t] = (f32x16){};
    const bf16_t* qp = p.PQ + (size_t)row * 2048 + ph * 256 + c * 128 + hi * 8;
    const bf16_t* kp = p.KEYSB + ((size_t)((ph * 2 + c) * 128 + r32)) * 128 + hi * 8;
#pragma unroll
    for (int s8 = 0; s8 < 8; ++s8) {
        const bf16x8 qf = *(const bf16x8*)(qp + s8 * 16);
#pragma unroll
        for (int t = 0; t < 4; ++t) {
            const bf16x8 kf = *(const bf16x8*)(kp + (size_t)t * 32 * 128 + s8 * 16);
            acc[t] = MFMA32(kf, qf, acc[t]);
        }
    }
    unsigned x[64];
#pragma unroll
    for (int t = 0; t < 4; ++t)
#pragma unroll
        for (int r = 0; r < 16; ++r) {
            const unsigned u = __float_as_uint(acc[t][r]);
            const unsigned o = (u & 0x80000000u) ? ~u : (u | 0x80000000u);
            x[t * 16 + r] = (o & ~127u) | (unsigned)(127 - ((r & 3) + 8 * (r >> 2) + 32 * t) - hi4);
        }
    sort16_desc<0>(x); sort16_desc<16>(x); sort16_desc<32>(x); sort16_desc<48>(x);
    unsigned t01[16], t23[16], tt[16], oth[16];
    merge_top16(&x[0], &x[16], t01); merge_top16(&x[32], &x[48], t23); merge_top16(t01, t23, tt);
#pragma unroll
    for (int i = 0; i < 16; ++i) { auto rr = __builtin_amdgcn_permlane32_swap(tt[i], tt[i], false, false); oth[i] = hi ? rr[0] : rr[1]; }
    merge_top16(tt, oth, fin);
}

DEVI void stage_peer_route(const P& p, char* smem, int bid, int nblk, int p0, int p1) {
    const int lane = tid_opq() & 63, wid = tid_opq() >> 6, r32 = lane & 31, hi = lane >> 5;
    unsigned char* tb = (unsigned char*)smem + wid * 1024 + r32 * 32;
    const int tpw = (NT + nblk - 1) / nblk, row_lo = bid * tpw, row_hi = (row_lo + tpw < NT) ? row_lo + tpw : NT;
    const int ph = wid;
    for (int pass = p0; pass < p1 && row_lo + pass * 32 < row_hi; ++pass) {
        const int row_raw = row_lo + pass * 32 + r32;
        const bool row_ok = row_raw < row_hi;
        const int row = row_ok ? row_raw : row_lo;
        int hi4 = 4 * hi; asm volatile("" : "+v"(hi4));
        unsigned fa[16], fb[16];
        route_top16(p, row, ph, 0, r32, hi, hi4, fa);
        asm volatile("" : "+v"(hi4));
        route_top16(p, row, ph, 1, r32, hi, hi4, fb);
        if (hi == 0) {
            u32x4 wa, wb;
#pragma unroll
            for (int i = 0; i < 4; ++i) {
                wa[i] = (127u - (fa[4 * i] & 127u)) | ((127u - (fa[4 * i + 1] & 127u)) << 8) | ((127u - (fa[4 * i + 2] & 127u)) << 16) | ((127u - (fa[4 * i + 3] & 127u)) << 24);
                wb[i] = (127u - (fb[4 * i] & 127u)) | ((127u - (fb[4 * i + 1] & 127u)) << 8) | ((127u - (fb[4 * i + 2] & 127u)) << 16) | ((127u - (fb[4 * i + 3] & 127u)) << 24);
            }
            *(u32x4*)tb = wa; *(u32x4*)(tb + 16) = wb;
        }
        unsigned g0[16], g1[16], g2[16], g3[16];
#pragma unroll
        for (int j = 0; j < 16; ++j) g0[j] = sum_key(fa[0], fb[j], (unsigned)j);
#pragma unroll
        for (int k = 0; k < 15; ++k) g1[k] = sum_key(fa[k + 1], fb[0], (unsigned)((k + 1) << 4));
        g1[15] = 0u;
#pragma unroll
        for (int j = 1; j < 8; ++j) g2[j - 1] = sum_key(fa[1], fb[j], (unsigned)(16 | j));
        g2[7] = 0u; g2[8] = 0u; g2[9] = 0u;
#pragma unroll
        for (int i = 2; i < 8; ++i) g2[17 - i] = sum_key(fa[i], fb[1], (unsigned)((i << 4) | 1));
#pragma unroll
        for (int j = 8; j > 0; j >>= 1)
#pragma unroll
            for (int i = 0; i < 16; ++i) { const int l = i ^ j; if (l > i) ce_desc(g2[i], g2[l]); }
        g3[0] = sum_key(fa[2], fb[2], 0x22u); g3[1] = sum_key(fa[2], fb[3], 0x23u); g3[2] = sum_key(fa[2], fb[4], 0x24u);
        g3[3] = sum_key(fa[3], fb[2], 0x32u); g3[4] = sum_key(fa[4], fb[2], 0x42u); g3[5] = sum_key(fa[3], fb[3], 0x33u);
#pragma unroll
        for (int i = 6; i < 16; ++i) g3[i] = 0u;
        sort8_desc(g3);
        unsigned t01[16], t23[16], top[16];
        merge_top16(g0, g1, t01); merge_top16(g2, g3, t23); merge_top16(t01, t23, top);
        float ev[16]; float sum = 0.f;
        const float vmax = key_score8(top[0]);
#pragma unroll
        for (int k = 0; k < 16; ++k) { ev[k] = __expf(key_score8(top[k]) - vmax); sum += ev[k]; }
        const float inv = 1.f / sum;
        asm volatile("s_waitcnt lgkmcnt(0)" ::: "memory");
        if (!row_ok) {   } else if (hi == 0) {
            int* dst = p.EIDX + (size_t)row * 128 + ph * 16;
#pragma unroll
            for (int q4 = 0; q4 < 4; ++q4) {
                u32x4 o;
#pragma unroll
                for (int k = 0; k < 4; ++k) { const unsigned tg = top[q4 * 4 + k] & 255u; o[k] = (unsigned)tb[tg >> 4] * 128u + (unsigned)tb[16 + (tg & 15u)]; }
                *(u32x4*)(dst + q4 * 4) = o;
            }
        } else {
            float* dst = p.EGATE + (size_t)row * 128 + ph * 16;
#pragma unroll
            for (int q4 = 0; q4 < 4; ++q4) *(f32x4*)(dst + q4 * 4) = (f32x4){ev[q4 * 4] * inv, ev[q4 * 4 + 1] * inv, ev[q4 * 4 + 2] * inv, ev[q4 * 4 + 3] * inv};
        }
        asm volatile("s_waitcnt lgkmcnt(0)" ::: "memory");
    }
}

constexpr int PA_WAVE_LDS = 1024 + 1024 + 512 + 512 + 512;
DEVI void stage_peer_apply(const P& p, char* smem, int bid, int nblk, int p0, int p1) {
    const int lane = tid_opq() & 63, wid = tid_opq() >> 6;
    char* wl = smem + wid * PA_WAVE_LDS;
    unsigned char* hhi = (unsigned char*)wl; unsigned char* hlo = hhi + 1024;
    int* idxs = (int*)(wl + 2048);
    float* gts = (float*)(wl + 2560);
    float* cs = (float*)(wl + 3072);
    const int fr = lane & 15, fq = lane >> 4;
    const int tpw = (NT + nblk - 1) / nblk, row_lo = bid * tpw, row_hi = (row_lo + tpw < NT) ? row_lo + tpw : NT;
    for (int row = row_lo + p0 * 32 + wid; row < row_hi && row < row_lo + p1 * 32; row += 8) {
        float hv[16];
        {
            const float* hr = p.R + (size_t)row * 1024 + lane * 16;
            const float mean1 = p.H[(size_t)row * 2], rs1 = p.H[(size_t)row * 2 + 1];
            u32x4 ohi, olo;
#pragma unroll
            for (int i = 0; i < 4; ++i) {
                f32x4 x = *(const f32x4*)(hr + i * 4);
                { const f32x4 g1 = *(const f32x4*)(p.ln1_g + lane * 16 + i * 4), b1 = *(const f32x4*)(p.ln1_b + lane * 16 + i * 4);
#pragma unroll
                  for (int k = 0; k < 4; ++k) x[k] = (x[k] - mean1) * rs1 * g1[k] + b1[k]; }
#pragma unroll
                for (int k = 0; k < 4; ++k) hv[i * 4 + k] = x[k];
                int w = __builtin_amdgcn_cvt_pk_fp8_f32(x[0], x[1], 0, false); w = __builtin_amdgcn_cvt_pk_fp8_f32(x[2], x[3], w, true);
                const f32x2 d01 = __builtin_amdgcn_cvt_pk_f32_fp8(w, false), d23 = __builtin_amdgcn_cvt_pk_f32_fp8(w, true);
                int w2 = __builtin_amdgcn_cvt_pk_fp8_f32(x[0] - d01[0], x[1] - d01[1], 0, false); w2 = __builtin_amdgcn_cvt_pk_fp8_f32(x[2] - d23[0], x[3] - d23[1], w2, true);
                ohi[i] = (unsigned)w; olo[i] = (unsigned)w2;
            }
            *(u32x4*)(hhi + lane * 16) = ohi; *(u32x4*)(hlo + lane * 16) = olo;
            idxs[lane] = p.EIDX[(size_t)row * 128 + lane]; idxs[lane + 64] = p.EIDX[(size_t)row * 128 + 64 + lane];
            gts[lane] = p.EGATE[(size_t)row * 128 + lane]; gts[lane + 64] = p.EGATE[(size_t)row * 128 + 64 + lane];
            asm volatile("s_waitcnt lgkmcnt(0)" ::: "memory");
        }
        {
            u32x4 a0[16], a1[16];
            auto issue_u = [&](int g, u32x4 (&a)[16]) {
                const unsigned char* ub = p.U8 + (size_t)idxs[g * 16 + fr] * 1024 + fq * 16;
#pragma unroll
                for (int s2 = 0; s2 < 16; ++s2) a[s2] = *(const u32x4*)(ub + s2 * 64);
            };
            auto consume_u = [&](int g, const u32x4 (&a)[16]) {
                f32x4 acc = (f32x4){0.f, 0.f, 0.f, 0.f};
#pragma unroll
                for (int s2 = 0; s2 < 16; ++s2) {
                    const u32x4 bh = *(const u32x4*)(hhi + s2 * 64 + fq * 16), bl = *(const u32x4*)(hlo + s2 * 64 + fq * 16);
                    const long x0 = (long)(((unsigned long long)a[s2][1] << 32) | a[s2][0]), x1 = (long)(((unsigned long long)a[s2][3] << 32) | a[s2][2]);
                    const long h0 = (long)(((unsigned long long)bh[1] << 32) | bh[0]), h1 = (long)(((unsigned long long)bh[3] << 32) | bh[2]);
                    const long l0 = (long)(((unsigned long long)bl[1] << 32) | bl[0]), l1 = (long)(((unsigned long long)bl[3] << 32) | bl[2]);
                    acc = __builtin_amdgcn_mfma_f32_16x16x32_fp8_fp8(x0, h0, acc, 0, 0, 0);
                    acc = __builtin_amdgcn_mfma_f32_16x16x32_fp8_fp8(x1, h1, acc, 0, 0, 0);
                    acc = __builtin_amdgcn_mfma_f32_16x16x32_fp8_fp8(x0, l0, acc, 0, 0, 0);
                    acc = __builtin_amdgcn_mfma_f32_16x16x32_fp8_fp8(x1, l1, acc, 0, 0, 0);
                }
                const f32x4 gg = *(const f32x4*)(gts + g * 16 + fq * 4);
                f32x4 cv;
#pragma unroll
                for (int r = 0; r < 4; ++r) {
                    const int e = idxs[g * 16 + fq * 4 + r];
                    const float d = acc[r] * p.US[e];
                    cv[r] = gg[r] * p.VS[e] * gelu_erf(d);
                }
                if (fr == 0) *(f32x4*)(cs + g * 16 + fq * 4) = cv;
            };
            issue_u(0, a0);
#pragma unroll 1
            for (int g = 0; g < 8; g += 2) {
                issue_u(g + 1, a1);
                consume_u(g, a0);
                if (g + 2 < 8) issue_u(g + 2, a0);
                consume_u(g + 1, a1);
            }
        }
        asm volatile("s_waitcnt lgkmcnt(0)" ::: "memory");
        float acc[16];
#pragma unroll
        for (int i = 0; i < 16; ++i) acc[i] = 0.f;
        {
            u32x4 v0[8], v1[8];
            auto issue_v = [&](int e0, u32x4 (&v)[8]) {
#pragma unroll
                for (int k = 0; k < 8; ++k) v[k] = *(const u32x4*)(p.V8 + (size_t)idxs[e0 + k] * 1024 + lane * 16);
            };
            auto consume_v = [&](int e0, const u32x4 (&v)[8]) {
#pragma unroll
                for (int k = 0; k < 8; ++k) {
                    const float c = cs[e0 + k];
#pragma unroll
                    for (int w = 0; w < 4; ++w) {
                        const f32x2 lo = __builtin_amdgcn_cvt_pk_f32_fp8((int)v[k][w], false), hh = __builtin_amdgcn_cvt_pk_f32_fp8((int)v[k][w], true);
                        acc[w * 4] += c * lo[0]; acc[w * 4 + 1] += c * lo[1]; acc[w * 4 + 2] += c * hh[0]; acc[w * 4 + 3] += c * hh[1];
                    }
                }
            };
            issue_v(0, v0);
#pragma unroll 1
            for (int e0 = 0; e0 < 128; e0 += 16) {
                issue_v(e0 + 8, v1);
                consume_v(e0, v0);
                if (e0 + 16 < 128) issue_v(e0 + 16, v0);
                consume_v(e0 + 8, v1);
            }
        }
        float s = 0.f;
#pragma unroll
        for (int i = 0; i < 16; ++i) { acc[i] += DN_ALPHA * hv[i]; s += acc[i]; }
        const float mean = wave_sum(s) * (1.f / 1024.f);
        float q = 0.f;
#pragma unroll
        for (int i = 0; i < 16; ++i) q += (acc[i] - mean) * (acc[i] - mean);
        const float rs = rsqrtf(wave_sum(q) * (1.f / 1024.f) + LN_EPS);
#pragma unroll
        for (int i = 0; i < 4; ++i) {
            const int c = lane * 16 + i * 4;
            const f32x4 g0 = *(const f32x4*)(p.ln2_g + c), b0 = *(const f32x4*)(p.ln2_b + c);
            f32x4 y0;
#pragma unroll
            for (int k = 0; k < 4; ++k) y0[k] = (acc[i * 4 + k] - mean) * rs * g0[k] + b0[k];
            *(f32x4*)(p.out + O_Y + (size_t)row * 1024 + c) = y0;
        }
    }
}

namespace pg8 {
#define PG8_LAS __attribute__((address_space(3)))
typedef unsigned short bf16_t;
typedef short bf16x8 __attribute__((ext_vector_type(8)));
typedef float f32x4 __attribute__((ext_vector_type(4)));
typedef unsigned u32x4 __attribute__((ext_vector_type(4)));
constexpr int BM = 256, BK = 64, HALF = 128, HTB = HALF * BK * 2  , STAGE_BYTES = 8 * HTB, NXCD = 8, WGM = 8;

__host__ __device__ __forceinline__ int lds_byte(int r, int c) { const int st = (r >> 4) * 2 + (c >> 5), rr = r & 15, cc = c & 31, ob = rr * 64 + cc * 2; return st * 1024 + (ob ^ (((ob >> 9) & 1) << 5)); }
__host__ __device__ __forceinline__ void stage_rc(int b, int& R, int& C) { const int st = b / 1024, sb = b % 1024, swz = sb ^ (((sb >> 9) & 1) << 5); R = (st >> 1) * 16 + swz / 64; C = (st & 1) * 32 + (swz % 64) / 2; }
__host__ __device__ __forceinline__ int perm32(int rho) { const int n = rho >> 4, i = rho & 15; return 8 * (i >> 2) + 4 * n + (i & 3); }

struct Unit { int pm, pn; };
struct Gemm { const bf16_t* A; const bf16_t* Bt; int M, N, K; };

struct StaticOrder {
    int nM, nN, nwg, G, c;
    __host__ __device__ void init(int M, int N, int G_, int c_) { nM = M / BM; nN = N / BM; nwg = nM * nN; G = G_; c = c_; }
    __host__ __device__ bool next(int i, Unit& u) const {
        const long L = (long)i * G + c; if (L >= nwg) return false;
        int wgid = (int)L; { const int q = nwg / NXCD, r = nwg % NXCD, xcd = wgid % NXCD, off = wgid / NXCD; wgid = (xcd < r ? xcd * (q + 1) : r * (q + 1) + (xcd - r) * q) + off; }
        const int nig = WGM * nN, gid = wgid / nig, fm = gid * WGM, gsz = (nM - fm) < WGM ? (nM - fm) : WGM;
        u.pm = fm + ((wgid % nig) % gsz); u.pn = (wgid % nig) / gsz; return true;
    }
    __device__ __forceinline__ void a_ready(const Unit&) const {}
    __device__ __forceinline__ void done(const Unit&) const {}
};
template <class Epi, class Sched, bool STAMP = false>
__device__ __forceinline__ void gemm_phase(PG8_LAS unsigned char* lds, const Gemm g, const Sched& S, const Epi& E, unsigned long long* stamps) {
    const int tid = tid_opq(), wid = __builtin_amdgcn_readfirstlane(tid >> 6), lane = tid & 63, wr = wid >> 2, wc = wid & 3, fr = lane & 15, fq = lane >> 4;
    const int K = g.K, nt = K / BK;
    int ts_lo = 0, ts_hi = 0, nts = 0; const unsigned long long rt_entry = STAMP ? (unsigned long long)wall_clock64() : 0ull;
#define PG8_STAMP() do { if (STAMP && wid == 0 && nts < 64) { const unsigned long long _c = (unsigned long long)clock64(); \
        ts_lo = (lane == nts) ? (int)(unsigned)_c : ts_lo; ts_hi = (lane == nts) ? (int)(unsigned)(_c >> 32) : ts_hi; ++nts; } } while (0)
    PG8_STAMP();
    unsigned voffA[2], voffB[2];
#pragma unroll
    for (int i = 0; i < 2; ++i) { int R, C; stage_rc(tid * 16 + i * 8192, R, C); const int Rb = Epi::PERM ? ((R & ~31) + perm32(R & 31)) : R;
        voffA[i] = (unsigned)(R * K + C) * 2u; voffB[i] = (unsigned)(Rb * K + C) * 2u; }
    const size_t kstep = (size_t)(BK * 2);
    const size_t hstep = (size_t)HALF * K * 2;
    const size_t tstep = 2 * hstep;
    const unsigned ldsw = (unsigned)wid * 1024u;
    const int aoff = lds_byte(wr * 64 + fr, fq * 8), boff = lds_byte(wc * 32 + fr, fq * 8);
#define PG8_SA(b, h) (((b) * 2 + (h)) * HTB)
#define PG8_SB(b, h) ((4 + (b) * 2 + (h)) * HTB)
#define PG8_STAGE(bufoff, gbase, voff) do { _Pragma("unroll") for (int _i = 0; _i < 2; ++_i) \
        __builtin_amdgcn_global_load_lds((const unsigned*)((const char*)(gbase) + (voff)[_i]), (PG8_LAS unsigned*)(lds + (bufoff) + ldsw + _i * 8192), 16, 0, 0); } while (0)
#define PG8_LDA(dst, b, h) do { _Pragma("unroll") for (int m = 0; m < 4; ++m) _Pragma("unroll") for (int k = 0; k < 2; ++k) dst[m][k] = *(const PG8_LAS bf16x8*)(lds + PG8_SA(b, h) + aoff + m * 2048 + k * 1024); } while (0)
#define PG8_LDB(dst, b, h) do { _Pragma("unroll") for (int n = 0; n < 2; ++n) _Pragma("unroll") for (int k = 0; k < 2; ++k) dst[n][k] = *(const PG8_LAS bf16x8*)(lds + PG8_SB(b, h) + boff + n * 2048 + k * 1024); } while (0)
#define PG8_MMA(ai, bj, At, Bt) do { __builtin_amdgcn_s_setprio(1); _Pragma("unroll") for (int m = 0; m < 4; ++m) _Pragma("unroll") for (int n = 0; n < 2; ++n) _Pragma("unroll") for (int k = 0; k < 2; ++k) \
        acc[ai][bj][m][n] = __builtin_amdgcn_mfma_f32_16x16x32_bf16(Bt[n][k], At[m][k], acc[ai][bj][m][n], 0, 0, 0); __builtin_amdgcn_s_setprio(0); } while (0)
#define PG8_WAIT_V(n) asm volatile("s_waitcnt vmcnt(" #n ")" ::: "memory")
#define PG8_WAIT_L(n) asm volatile("s_waitcnt lgkmcnt(" #n ")" ::: "memory")
#define PG8_BAR __builtin_amdgcn_s_barrier()
#define PG8_SCHED __builtin_amdgcn_sched_barrier(0)
    Unit cur, nxt; int ui = 0;
    if (!S.next(0, cur)) return;
    f32x4 acc[2][2][4][2];
#pragma unroll
    for (int a = 0; a < 2; ++a)
#pragma unroll
        for (int b = 0; b < 2; ++b)
#pragma unroll
            for (int m = 0; m < 4; ++m)
#pragma unroll
                for (int n = 0; n < 2; ++n) acc[a][b][m][n] = (f32x4){0.f, 0.f, 0.f, 0.f};
    bf16x8 At[4][2], B0[2][2], B1[2][2];
    const char* cA = (const char*)g.A + (size_t)cur.pm * tstep; const char* cB = (const char*)g.Bt + (size_t)cur.pn * tstep;
    S.a_ready(cur);
    PG8_STAGE(PG8_SB(0, 0), cB, voffB); PG8_STAGE(PG8_SA(0, 0), cA, voffA); PG8_STAGE(PG8_SB(0, 1), cB + hstep, voffB); PG8_STAGE(PG8_SA(0, 1), cA + hstep, voffA);
    if (wr == 1) PG8_BAR;
    PG8_WAIT_V(4); PG8_BAR;
    PG8_STAGE(PG8_SB(1, 0), cB + kstep, voffB); PG8_STAGE(PG8_SA(1, 0), cA + kstep, voffA); PG8_STAGE(PG8_SB(1, 1), cB + hstep + kstep, voffB);
    PG8_WAIT_V(6); PG8_BAR;
    PG8_STAMP();
    for (;;) {
        const bool has_next = S.next(ui + 1, nxt);
        const char* nA = has_next ? (const char*)g.A + (size_t)nxt.pm * tstep : cA; const char* nB = has_next ? (const char*)g.Bt + (size_t)nxt.pn * tstep : cB;
        for (int t = 0; t < nt; t += 2) {
            const bool last = (t == nt - 2);
            const char* a1 = cA + (size_t)(t + 1) * kstep;
            const char* a2 = last ? nA : cA + (size_t)(t + 2) * kstep; const char* b2 = last ? nB : cB + (size_t)(t + 2) * kstep;
            const char* a3 = a2 + kstep; const char* b3 = b2 + kstep;
            if (last && has_next) S.a_ready(nxt);
            PG8_LDB(B0, 0, 0); PG8_SCHED; PG8_LDA(At, 0, 0); PG8_STAGE(PG8_SA(1, 1), a1 + hstep, voffA);
            PG8_WAIT_L(8); PG8_BAR; PG8_WAIT_L(0); PG8_MMA(0, 0, At, B0); PG8_BAR; PG8_SCHED;
            PG8_LDB(B1, 0, 1); PG8_STAGE(PG8_SB(0, 0), b2, voffB);
            PG8_BAR; PG8_WAIT_L(0); PG8_MMA(0, 1, At, B1); PG8_BAR;
            PG8_LDA(At, 0, 1); PG8_STAGE(PG8_SA(0, 0), a2, voffA);
            PG8_BAR; PG8_WAIT_L(0); PG8_MMA(1, 0, At, B0); PG8_BAR; PG8_SCHED;
            PG8_STAGE(PG8_SB(0, 1), b2 + hstep, voffB);
            PG8_WAIT_V(6); PG8_BAR; PG8_MMA(1, 1, At, B1); PG8_BAR;
            PG8_LDB(B0, 1, 0); PG8_SCHED; PG8_LDA(At, 1, 0); PG8_STAGE(PG8_SA(0, 1), a2 + hstep, voffA);
            PG8_WAIT_L(8); PG8_BAR; PG8_WAIT_L(0); PG8_MMA(0, 0, At, B0); PG8_BAR; PG8_SCHED;
            PG8_LDB(B1, 1, 1); PG8_STAGE(PG8_SB(1, 0), b3, voffB);
            PG8_BAR; PG8_WAIT_L(0); PG8_MMA(0, 1, At, B1); PG8_BAR;
            PG8_LDA(At, 1, 1); PG8_STAGE(PG8_SA(1, 0), a3, voffA);
            PG8_BAR; PG8_WAIT_L(0); PG8_MMA(1, 0, At, B0); PG8_BAR; PG8_SCHED;
            PG8_STAGE(PG8_SB(1, 1), b3 + hstep, voffB);
            PG8_WAIT_V(6); PG8_BAR; PG8_MMA(1, 1, At, B1); PG8_BAR;
        }
        PG8_STAMP();
        if constexpr (!Epi::AFTER_DRAIN) { E(acc, cur, wr, wc, fr, fq); S.done(cur); }
        PG8_STAMP();
        if (!has_next) break;
#pragma unroll
        for (int a = 0; a < 2; ++a)
#pragma unroll
            for (int b = 0; b < 2; ++b)
#pragma unroll
                for (int m = 0; m < 4; ++m)
#pragma unroll
                    for (int n = 0; n < 2; ++n) acc[a][b][m][n] = (f32x4){0.f, 0.f, 0.f, 0.f};
        cur = nxt; cA = nA; cB = nB; ++ui;
    }
    PG8_WAIT_V(0);
    if (wr == 0) PG8_BAR;
    PG8_BAR;
    if constexpr (Epi::AFTER_DRAIN) { E.fused(acc, cur, wr, wc, fr, fq, lds, wid, lane); S.done(cur); }
    PG8_STAMP();
    if (STAMP && wid == 0) { stamps[lane] = lane < nts ? (((unsigned long long)(unsigned)ts_hi << 32) | (unsigned)ts_lo) : 0ull;
        if (lane == 62) stamps[62] = rt_entry; if (lane == 63) stamps[63] = (unsigned long long)wall_clock64(); }
#undef PG8_STAMP
#undef PG8_SA
#undef PG8_SB
#undef PG8_STAGE
#undef PG8_LDA
#undef PG8_LDB
#undef PG8_MMA
#undef PG8_WAIT_V
#undef PG8_WAIT_L
#undef PG8_BAR
#undef PG8_SCHED
}
}

template <class F> struct EpiAdapt {
    static constexpr bool PERM = true, AFTER_DRAIN = false;
    F f;
    __device__ __forceinline__ void operator()(const pg8::f32x4 (&acc)[2][2][4][2], const pg8::Unit& u, int wr, int wc, int fr, int fq) const {
        constexpr int B = F::BATCH;
        const int row0 = u.pm * 256 + wr * 64 + fr, col0 = u.pn * 256 + wc * 32 + 8 * fq;
        f32x4 b0[2], b1[2];
        if constexpr (F::COLBIAS) { f.bias8(col0, b0[0], b1[0]); f.bias8(col0 + 128, b0[1], b1[1]); }
#pragma unroll
        for (int q0 = 0; q0 < 16; q0 += B) {
            typename F::Pre pre[B];
#pragma unroll
            for (int i = 0; i < B; ++i) { const int q = q0 + i, bj = q & 1, m = (q >> 1) & 3, ai = q >> 3; pre[i] = f.pre(row0 + ai * 128 + m * 16, col0 + bj * 128); }
#pragma unroll
            for (int i = 0; i < B; ++i) { const int q = q0 + i, bj = q & 1, m = (q >> 1) & 3, ai = q >> 3;
                f32x4 v0 = acc[ai][bj][m][0], v1 = acc[ai][bj][m][1];
                if constexpr (F::COLBIAS) { v0 += b0[bj]; v1 += b1[bj]; }
                f.put(row0 + ai * 128 + m * 16, col0 + bj * 128, v0, v1, pre[i]); }
        }
    }
};
template <class F>
DEVI void gemm_pg8(const bf16_t* A, const bf16_t* Bt, int M, int N, int K, const F& f, char* smem, int bid, int nblk) {
    pg8::Gemm g{A, Bt, M, N, K};
    pg8::StaticOrder S; S.init(M, N, nblk, bid);
    EpiAdapt<F> E{f};
    __syncthreads();
    pg8::gemm_phase<EpiAdapt<F>, pg8::StaticOrder, false>((PG8_LAS unsigned char*)smem, g, S, E, nullptr);
    __syncthreads();
}

template <class F>
DEVI void gemm_small_rows(const bf16_t* __restrict__ A, const bf16_t* __restrict__ Bt, int N, const F& f, char* smem, int bid, int nblk) {
    const int tid = tid_opq(), lane = tid & 63, wid = tid >> 6, fr = lane & 15, fq = lane >> 4;
    float* part = (float*)smem;
    const int ntn = N / 64, ntiles = (NTS / 32) * ntn;
    for (int tile = bid; tile < ntiles; tile += nblk) {
        const int tm = tile / ntn, tn = tile % ntn;
        const int row0 = NTP + tm * 32, col0 = tn * 64;
        f32x4 acc[2][4];
#pragma unroll
        for (int m = 0; m < 2; ++m)
#pragma unroll
            for (int n = 0; n < 4; ++n) acc[m][n] = (f32x4){0.f, 0.f, 0.f, 0.f};
        const bf16_t* ap = A + (size_t)(row0 + fr) * 1024 + wid * 128 + fq * 8;
        const bf16_t* bp = Bt + (size_t)(col0 + fr) * 1024 + wid * 128 + fq * 8;
        bf16x8 af[4][2], bfr[4][4];
#pragma unroll
        for (int ks = 0; ks < 4; ++ks) {
#pragma unroll
            for (int m = 0; m < 2; ++m) af[ks][m] = *(const bf16x8*)(ap + (size_t)m * 16 * 1024 + ks * 32);
#pragma unroll
            for (int n = 0; n < 4; ++n) bfr[ks][n] = *(const bf16x8*)(bp + (size_t)n * 16 * 1024 + ks * 32);
        }
#pragma unroll
        for (int ks = 0; ks < 4; ++ks)
#pragma unroll
            for (int m = 0; m < 2; ++m)
#pragma unroll
                for (int n = 0; n < 4; ++n) acc[m][n] = __builtin_amdgcn_mfma_f32_16x16x32_bf16(bfr[ks][n], af[ks][m], acc[m][n], 0, 0, 0);
        __syncthreads();
#pragma unroll
        for (int m = 0; m < 2; ++m)
#pragma unroll
            for (int n = 0; n < 4; ++n) *(f32x4*)(part + ((size_t)wid * 32 + m * 16 + fr) * 64 + n * 16 + fq * 4) = acc[m][n];
        __syncthreads();
        if (tid < 256) {
            const int r = tid >> 3, c8 = (tid & 7) * 8;
            f32x4 v0 = {0.f, 0.f, 0.f, 0.f}, v1 = v0;
#pragma unroll
            for (int w = 0; w < 8; ++w) { v0 += *(const f32x4*)(part + ((size_t)w * 32 + r) * 64 + c8); v1 += *(const f32x4*)(part + ((size_t)w * 32 + r) * 64 + c8 + 4); }
            const typename F::Pre pre = f.pre(row0 + r, col0 + c8);
            f.put(row0 + r, col0 + c8, v0, v1, pre);
        }
    }
}
template <class F>
DEVI void gemm_tail(const bf16_t* A, const bf16_t* Bt, int N, const F& f, char* smem, int bid, int nblk) {
    gemm_small_rows(A, Bt, N, f, smem, bid, nblk);
    gemm_pg8(A, Bt, NTP, N, 1024, f, smem, bid, nblk);
}

#define XB_TMO      128
#define XB_XCNT(j)  (256  + 64 * (j))
#define XB_XSUB(j)  (1280 + 64 * (j))
#define XB_XGEN(j)  (2304 + 64 * (j))
#define XB_TOP      3328
#define XB_TOPGEN   3392
#define XCD_BAR_WORDS 3456
#define XB_SPIN_CAP (1u << 18)
#define LAS __attribute__((address_space(3)))

__device__ __forceinline__ unsigned xb_ld(unsigned* p)              { return __hip_atomic_load(p, __ATOMIC_RELAXED, __HIP_MEMORY_SCOPE_AGENT); }
__device__ __forceinline__ unsigned xb_add(unsigned* p, unsigned v) { return __hip_atomic_fetch_add(p, v, __ATOMIC_RELAXED, __HIP_MEMORY_SCOPE_AGENT); }
__device__ __forceinline__ unsigned xb_xcc_id() { return (unsigned)__builtin_amdgcn_s_getreg((3 << 11) | 20) & 0xFu; }
#define XB_SPIN(cond, bar) do { unsigned _sp = 0; while (cond) { __builtin_amdgcn_s_sleep(1); \
    if ((++_sp & 255u) == 0u) { if (xb_ld(&(bar)[XB_TMO])) break; if (_sp > XB_SPIN_CAP) { atomicAdd(&(bar)[XB_TMO], 1u); break; } } } } while (0)

struct XcdBarrier {
    unsigned* bar; unsigned x;
    volatile LAS unsigned* st;
};

__device__ __forceinline__ XcdBarrier xcd_barrier_post(unsigned* bar, volatile LAS unsigned* st) {
    XcdBarrier b; b.bar = bar; b.x = xb_xcc_id(); b.st = st;
    if (tid_opq() == 0) (void)xb_add(&bar[XB_XCNT(b.x)], 1u);
    return b;
}
__device__ __forceinline__ void xcd_barrier_complete(unsigned* bar, unsigned x, unsigned& nloc, unsigned& nx) {
    const unsigned G = gridDim.x * gridDim.y * gridDim.z;
    unsigned sum, cnt, mine, sp = 0u;
    for (;;) {
        sum = 0u; cnt = 0u; mine = 0u;
#pragma unroll
        for (unsigned j = 0; j < 16; ++j) { const unsigned c = xb_ld(&bar[XB_XCNT(j)]); sum += c; cnt += (c > 0u) ? 1u : 0u; mine = (j == x) ? c : mine; }
        if (sum == G) break;
        __builtin_amdgcn_s_sleep(1);
        if ((++sp & 255u) == 0u) { if (xb_ld(&bar[XB_TMO])) break; if (sp > XB_SPIN_CAP) { atomicAdd(&bar[XB_TMO], 1u); break; } }
    }
    nloc = mine > 0u ? mine : 1u; nx = cnt > 0u ? cnt : 1u;
}

__device__ __forceinline__ void xcd_barrier(const XcdBarrier& b) {
    asm volatile("s_waitcnt vmcnt(0)" ::: "memory");
    __syncthreads();
    if (tid_opq() == 0) {
        unsigned* bar = b.bar;
        __builtin_amdgcn_s_waitcnt(0);
        unsigned nloc = b.st[0], nx = b.st[1];
        if (nloc == 0u) { xcd_barrier_complete(bar, b.x, nloc, nx); b.st[0] = nloc; b.st[1] = nx; }
        const unsigned old = xb_add(&bar[XB_XSUB(b.x)], 1u);
        const unsigned gen = old / nloc;
        if (old + 1u == (gen + 1u) * nloc) {
            __builtin_amdgcn_fence(__ATOMIC_RELEASE, "agent");
            asm volatile("s_waitcnt vmcnt(0)" ::: "memory");
            const unsigned og = xb_add(&bar[XB_TOP], 1u);
            const unsigned tg = og / nx;
            if (og + 1u == (tg + 1u) * nx) xb_add(&bar[XB_TOPGEN], 1u);
            else XB_SPIN(xb_ld(&bar[XB_TOPGEN]) == tg, bar);
            __builtin_amdgcn_fence(__ATOMIC_ACQUIRE, "agent");
            xb_add(&bar[XB_XGEN(b.x)], 1u);
            asm volatile("s_waitcnt vmcnt(0)" ::: "memory");
        } else {
            XB_SPIN(xb_ld(&bar[XB_XGEN(b.x)]) == gen, bar);
            __builtin_amdgcn_fence(__ATOMIC_ACQUIRE, "agent");
            asm volatile("s_waitcnt vmcnt(0)" ::: "memory");
        }
    }
    __syncthreads();
}

constexpr int LDS_BYTES = 152 * 1024;

template <int S>
DEVI void run_stage(const P& p, char* smem, int bid, int nblk) {
    if (S == 0) stage_prologue(p, smem, bid, nblk);
    if (S == 1) { EpiInProj e{p}; gemm_pg8(p.XB, p.WINT, NT, NPAD_IN + 2048, 1024, e, smem, bid, nblk); }
    if (S == 2) {
        stage_mlstm_gates(p, smem, bid, nblk);
        if (bid & 1) { stage_mlstm_dc(p, smem, bid, nblk); stage_compress(p, smem, bid, nblk); stage_mlstm_sample(p, smem, bid, nblk); }
        else { stage_compress(p, smem, bid, nblk); stage_mlstm_dc(p, smem, bid, nblk); stage_mlstm_sample(p, smem, bid, nblk); }
    }
    if (S == 4) { stage_mlstm_scan(p, bid, nblk); stage_nsa_attn(p, smem, bid, nblk); }
    if (S == 5) { stage_mlstm_out(p, smem, bid, nblk); { EpiM1 e{p}; gemm_tail(p.YB, p.WBT, 1024, e, smem, bid, nblk); } }
    if (S == 6) { EpiM2 e{p}; gemm_tail(p.YA, p.WAT, 1024, e, smem, bid, nblk); }
    if (S == 8) { EpiR e{p}; gemm_tail(p.MERGED, p.WOT, 1024, e, smem, bid, nblk); }
    if (S == 9) stage_ln1(p, bid, nblk);
    if (S == 10) { EpiPQ e{p}; gemm_tail(p.HB, p.WQT, 2048, e, smem, bid, nblk); }
    if (S == 11) {
        if (bid & 1) {
            for (int ps = 0; ps < 4; ++ps) { stage_peer_route(p, smem, bid, nblk, ps, ps + 1); __threadfence_block(); __syncthreads(); stage_peer_apply(p, smem, bid, nblk, ps, ps + 1); __syncthreads(); }
        } else { stage_peer_route(p, smem, bid, nblk, 0, 64); __threadfence_block(); __syncthreads(); stage_peer_apply(p, smem, bid, nblk, 0, 64); }
    }
}
constexpr int NSTAGES = 13;

template <int S>
__global__ void __launch_bounds__(512, 2) k_stage(P p) {
    extern __shared__ __attribute__((aligned(16))) char smem[];
    run_stage<S>(p, smem, blockIdx.x, gridDim.x);
}


#if MK_ONE_LAUNCH
__global__ void __launch_bounds__(512, 2) k_mega(P p) {
    extern __shared__ __attribute__((aligned(16))) char smem_all[];
    if (tid_opq() == 0) *(u32x4*)smem_all = (u32x4){0u, 0u, 0u, 0u};
    __syncthreads();
    XcdBarrier bar = xcd_barrier_post(p.bar, (volatile LAS unsigned*)smem_all);
    char* smem = smem_all + 16;
    const int bid = blockIdx.x, nblk = gridDim.x;
    run_stage<0>(p, smem, bid, nblk); if ((REP_MASK >> 0) & 1) { xcd_barrier(bar); run_stage<0>(p, smem, bid, nblk); }  xcd_barrier(bar);
    run_stage<1>(p, smem, bid, nblk); if ((REP_MASK >> 1) & 1) { xcd_barrier(bar); run_stage<1>(p, smem, bid, nblk); }  xcd_barrier(bar);
    run_stage<2>(p, smem, bid, nblk); if ((REP_MASK >> 2) & 1) { xcd_barrier(bar); run_stage<2>(p, smem, bid, nblk); }  xcd_barrier(bar);
    run_stage<4>(p, smem, bid, nblk); if ((REP_MASK >> 4) & 1) { xcd_barrier(bar); run_stage<4>(p, smem, bid, nblk); }  xcd_barrier(bar);
    run_stage<5>(p, smem, bid, nblk); if ((REP_MASK >> 5) & 1) { xcd_barrier(bar); run_stage<5>(p, smem, bid, nblk); }  xcd_barrier(bar);
    run_stage<6>(p, smem, bid, nblk); if ((REP_MASK >> 6) & 1) { xcd_barrier(bar); run_stage<6>(p, smem, bid, nblk); }  xcd_barrier(bar);
    run_stage<8>(p, smem, bid, nblk); if ((REP_MASK >> 8) & 1) { xcd_barrier(bar); run_stage<8>(p, smem, bid, nblk); }  xcd_barrier(bar);
    run_stage<9>(p, smem, bid, nblk); if ((REP_MASK >> 9) & 1) { xcd_barrier(bar); run_stage<9>(p, smem, bid, nblk); }  xcd_barrier(bar);
    run_stage<10>(p, smem, bid, nblk); if ((REP_MASK >> 10) & 1) { xcd_barrier(bar); run_stage<10>(p, smem, bid, nblk); } xcd_barrier(bar);
    run_stage<11>(p, smem, bid, nblk); if ((REP_MASK >> 11) & 1) { xcd_barrier(bar); run_stage<11>(p, smem, bid, nblk); }
}
#endif

template <int S> static void launch_stage(const P& p, int grid, hipStream_t stream) {
    (void)hipFuncSetAttribute((const void*)k_stage<S>, hipFuncAttributeMaxDynamicSharedMemorySize, LDS_BYTES);
    k_stage<S><<<dim3(grid), dim3(512), LDS_BYTES, stream>>>(p);
}

extern "C" void kernel_launch(void* const* d_in, const int* in_sizes, int n_in, void* d_out, int out_size, void* d_ws, size_t ws_size, hipStream_t stream) {
    (void)in_sizes; (void)n_in; (void)out_size; (void)ws_size;
    P p{};
    p.xp = (const float*)d_in[0]; p.xs = (const float*)d_in[1]; p.cache_cmp = (const float*)d_in[2]; p.cache_slc = (const float*)d_in[3];
    p.cache_win = (const float*)d_in[4]; p.state_C = (const float*)d_in[5]; p.state_n = (const float*)d_in[6]; p.state_m = (const float*)d_in[7];
    p.page_table = (const int*)d_in[8];
    p.w_in = (const float*)d_in[9]; p.b_in = (const float*)d_in[10]; p.norm_a_g = (const float*)d_in[11]; p.nsa_pe = (const float*)d_in[12];
    p.nsa_w_cmp = (const float*)d_in[13]; p.w_br_a = (const float*)d_in[14]; p.w_br_b = (const float*)d_in[15]; p.w_merge = (const float*)d_in[16];
    p.w_out = (const float*)d_in[17]; p.ln1_g = (const float*)d_in[18]; p.ln1_b = (const float*)d_in[19];
    p.peer_wq = (const float*)d_in[20]; p.peer_keys = (const float*)d_in[21]; p.peer_u = (const float*)d_in[22]; p.peer_v = (const float*)d_in[23];
    p.ln2_g = (const float*)d_in[24]; p.ln2_b = (const float*)d_in[25];
    p.out = (float*)d_out;
    char* w = (char*)d_ws; size_t off = 0;
    auto take = [&](size_t bytes) { char* r = w + off; off += (bytes + 255) & ~(size_t)255; return r; };
    p.bar = (unsigned*)take(16384);
    p.PW = (float*)(p.bar + 3584);
    p.WCT = (bf16_t*)take((size_t)2 * 64 * 4096 * 2);
    p.XB = (bf16_t*)take((size_t)NT * 1024 * 2);
    p.WINT = (bf16_t*)take((size_t)(NPAD_IN + 2048) * 1024 * 2);
    p.WMT = (bf16_t*)take((size_t)2048 * 1024 * 2);
    p.WAT = (bf16_t*)take((size_t)1024 * 1024 * 2);
    p.WBT = (bf16_t*)take((size_t)1024 * 1024 * 2);
    p.WOT = (bf16_t*)take((size_t)1024 * 1024 * 2);
    p.WQT = (bf16_t*)take((size_t)2048 * 1024 * 2);
    p.KEYSB = (bf16_t*)take((size_t)16 * 128 * 128 * 2);
    p.U8 = (unsigned char*)take((size_t)16384 * 1024);
    p.V8 = (unsigned char*)take((size_t)16384 * 1024);
    p.US = (float*)take(16384 * 4);
    p.VS = (float*)take(16384 * 4);
    p.PROJ = (bf16_t*)take((size_t)NT * PS * 2);
    p.SM = (float*)take((size_t)NT * 64 * 4);
    p.BCUM = (float*)take((size_t)16 * 4096 * 4);
    p.MPREV = (float*)take(4096); p.ACOEF = (float*)take(4096); p.SCL = (float*)take(4096); p.MLOC = (float*)take(4096);
    p.DC = (float*)take((size_t)1024 * 272 * 128 * 4);
    p.CPT = (bf16_t*)take((size_t)1024 * 272 * 128 * 2);
    p.KC = (float*)take((size_t)4352 * 512 * 4);
    p.VC = p.KC + 256;
    p.OCMP = (float*)take((size_t)NT * 1024 * 4);
    p.SEL = (unsigned long long*)take((size_t)NT * 4 * 8);
    p.YA = (bf16_t*)take((size_t)NT * 1024 * 2);
    p.YB = (bf16_t*)take((size_t)NT * 1024 * 2);
    p.G = (bf16_t*)take((size_t)NT * 2048 * 2);
    p.TMPB = (bf16_t*)take((size_t)NT * 1024 * 2);
    p.MERGED = (bf16_t*)take((size_t)NT * 1024 * 2);
    p.R = (float*)take((size_t)NT * 1024 * 4);
    p.H = (float*)take((size_t)NT * 1024 * 4);
    p.HB = (bf16_t*)take((size_t)NT * 1024 * 2);
    p.PQ = (bf16_t*)take((size_t)NT * 2048 * 2);
    p.EIDX = (int*)take((size_t)NT * 128 * 4);
    p.EGATE = (float*)take((size_t)NT * 128 * 4);

    (void)hipMemsetAsync(p.bar, 0, 16384, stream);
#if MK_ONE_LAUNCH
    {
        constexpr size_t kDynLds = LDS_BYTES + 16;
        (void)hipFuncSetAttribute((const void*)k_mega, hipFuncAttributeMaxDynamicSharedMemorySize, (int)kDynLds);
        int dev = 0, cus = 0, per_cu = 0;
        (void)hipGetDevice(&dev);
        (void)hipDeviceGetAttribute(&cus, hipDeviceAttributeMultiprocessorCount, dev);
        (void)hipOccupancyMaxActiveBlocksPerMultiprocessor(&per_cu, (const void*)k_mega, 512, kDynLds);
        if (per_cu < 1 || cus < 1) return;
        const int grid = cus;
        k_mega<<<dim3(grid), dim3(512), kDynLds, stream>>>(p);
    }
#else
    const int grid = 512;
    launch_stage<0>(p, grid, stream);
    launch_stage<1>(p, grid, stream);
    launch_stage<2>(p, grid, stream);
    launch_stage<4>(p, grid, stream);
    launch_stage<5>(p, grid, stream);
    launch_stage<6>(p, grid, stream);
    launch_stage<8>(p, grid, stream);
    launch_stage<9>(p, grid, stream);
    launch_stage<10>(p, grid, stream);
    launch_stage<11>(p, grid, stream);
#endif
}
```

```cpp
#include <hip/hip_runtime.h>
#include <stdint.h>

#ifndef REP_MASK
#define REP_MASK 0
#endif
#ifndef MK_ONE_LAUNCH
#define MK_ONE_LAUNCH 1
#endif

typedef unsigned short bf16_t;
typedef short bf16x8 __attribute__((ext_vector_type(8)));
typedef float f32x4 __attribute__((ext_vector_type(4)));
typedef unsigned u32x4 __attribute__((ext_vector_type(4)));
typedef unsigned u32x2 __attribute__((ext_vector_type(2)));
typedef float f32x2 __attribute__((ext_vector_type(2)));
typedef __bf16 bf16x2_t __attribute__((ext_vector_type(2)));
#define DEVI __device__ __forceinline__
__device__ __forceinline__ int tid_opq() { int t = threadIdx.x; asm volatile("" : "+v"(t)); return t; }

constexpr int NTP = 16384, NTS = 512, NT = NTP + NTS, DM = 1024;
constexpr int PS = 5632;
constexpr int C_AQ = 0, C_AK = 512, C_AV = 1024, C_AO = 2048, C_BQ = 3072, C_CMP = 4096, C_SLC = 4608, C_WIN = 5120;
constexpr int NPAD_IN = 5888;
constexpr float DN_ALPHA = 1.189207115002721f;
constexpr float LN_EPS = 1e-5f;
constexpr size_t O_Y = 0;
constexpr size_t O_PCMP = O_Y + (size_t)NT * 1024;
constexpr size_t O_PSLC = O_PCMP + (size_t)NTP * 512;
constexpr size_t O_PWIN = O_PSLC + (size_t)NTP * 512;
constexpr size_t O_PC = O_PWIN + (size_t)4 * 512 * 512;
constexpr size_t O_PN = O_PC + (size_t)16 * 128 * 256;
constexpr size_t O_PM = O_PN + 16 * 128;
constexpr size_t O_SCMP = O_PM + 16;
constexpr size_t O_SSLC = O_SCMP + (size_t)NTS * 512;
constexpr size_t O_SWIN = O_SSLC + (size_t)NTS * 512;
constexpr size_t O_SC = O_SWIN + (size_t)128 * 512 * 512;
constexpr size_t O_SN = O_SC + (size_t)512 * 128 * 256;
constexpr size_t O_SM = O_SN + 512 * 128;

struct P {
    const float *xp, *xs, *cache_cmp, *cache_slc, *cache_win, *state_C, *state_n, *state_m;
    const int* page_table;
    const float *w_in, *b_in, *norm_a_g, *nsa_pe, *nsa_w_cmp, *w_br_a, *w_br_b, *w_merge, *w_out, *ln1_g, *ln1_b;
    const float *peer_wq, *peer_keys, *peer_u, *peer_v, *ln2_g, *ln2_b;
    float* out;
    bf16_t *XB, *WINT, *WMT, *WAT, *WBT, *WOT, *WQT, *KEYSB, *UB, *VB, *PROJ, *WCT;
    float* PW;
    float *SM, *BCUM, *MPREV, *ACOEF, *SCL, *MLOC, *DC, *KC, *VC, *OCMP;
    bf16_t* CPT;
    unsigned char *U8, *V8;
    float *US, *VS;
    unsigned long long* SEL;
    bf16_t *YA, *YB, *G, *MERGED, *HB, *PQ;
    float *R, *H, *EGATE;
    bf16_t* TMPB;
    int* EIDX;
    unsigned* bar;
};

DEVI bf16_t f2bf(float f) { return __builtin_bit_cast(unsigned short, (__bf16)f); }
DEVI float bf2f(bf16_t h) { return __uint_as_float(((unsigned)h) << 16); }
DEVI unsigned pack2(float a, float b) { return __builtin_bit_cast(unsigned, __builtin_convertvector((f32x2){a, b}, bf16x2_t)); }
DEVI u32x4 pack8f(const f32x4 a, const f32x4 b) { u32x4 r; r[0] = pack2(a[0], a[1]); r[1] = pack2(a[2], a[3]); r[2] = pack2(b[0], b[1]); r[3] = pack2(b[2], b[3]); return r; }
DEVI void ce_desc(unsigned& a, unsigned& b) { const unsigned hi = a > b ? a : b, lo = a > b ? b : a; a = hi; b = lo; }
template <int BASE> DEVI void sort16_desc(unsigned (&x)[64]) {
#pragma unroll
    for (int k = 2; k <= 16; k <<= 1)
#pragma unroll
        for (int j = k >> 1; j > 0; j >>= 1)
#pragma unroll
            for (int i = 0; i < 16; ++i) {
                const int l = i ^ j;
                if (l > i) { if ((i & k) == 0) ce_desc(x[BASE + i], x[BASE + l]); else ce_desc(x[BASE + l], x[BASE + i]); }
            }
}
DEVI void merge_top16(const unsigned* a, const unsigned* b, unsigned* t) {
    unsigned c[16];
#pragma unroll
    for (int i = 0; i < 16; ++i) c[i] = a[i] > b[15 - i] ? a[i] : b[15 - i];
#pragma unroll
    for (int j = 8; j > 0; j >>= 1)
#pragma unroll
        for (int i = 0; i < 16; ++i) { const int l = i ^ j; if (l > i) ce_desc(c[i], c[l]); }
#pragma unroll
    for (int i = 0; i < 16; ++i) t[i] = c[i];
}
DEVI float gelu_erf(float v) {
    const float av = fabsf(v), t = __builtin_amdgcn_rcpf(fmaf(av, 0.2316418882f, 1.0f));
    float q = fmaf(t, 0.5307027145f, -0.7265760135f); q = fmaf(q, t, 0.7107068705f); q = fmaf(q, t, -0.142248368f); q = fmaf(q, t, 0.127414796f); q = q * t;
    const float e = __builtin_amdgcn_exp2f(v * v * -0.72134752044f);
    const float mm = v * (q * e);
    return v < 0.f ? mm : v - mm;
}
DEVI float wave_max(float v) { for (int o = 32; o > 0; o >>= 1) v = fmaxf(v, __shfl_xor(v, o)); return v; }
DEVI float wave_sum(float v) { for (int o = 32; o > 0; o >>= 1) v += __shfl_xor(v, o); return v; }
DEVI float sigmoidf_(float x) { return __builtin_amdgcn_rcpf(1.f + __expf(-x)); }
DEVI float logsigmoidf_(float x) { return fminf(x, 0.f) - log1pf(__expf(-fabsf(x))); }
DEVI int win_map(int np) {
    if (np < 2048) return np;
    if (np < 5632) return np + 8;
    if (np < 5640) return np - 5632 + 2048;
    if (np < 5688) return np;
    return -1;
}
DEVI float alibi_slope(int h) { return exp2f(-0.5f * (float)(h + 1)); }

template <class MapFn>
DEVI void transpose_cvt(const float* __restrict__ W, bf16_t* __restrict__ WT, int K, int Nsrc, int Ndst, MapFn mapfn, float* tile  , int bid, int nblk) {
    const int tid = tid_opq();
    const int tn = Ndst / 64, tk = K / 64;
    for (int t = bid; t < tn * tk; t += nblk) {
        const int n0 = (t % tn) * 64, k0 = (t / tn) * 64;
        __syncthreads();
#pragma unroll
        for (int i = 0; i < 8; ++i) {
            const int kk = (tid >> 6) + i * 8, nn = tid & 63;
            const int n = mapfn(n0 + nn);
            tile[kk * 65 + nn] = n >= 0 ? W[(size_t)(k0 + kk) * Nsrc + n] : 0.f;
        }
        __syncthreads();
#pragma unroll
        for (int i = 0; i < 8; ++i) {
            const int nn = (tid >> 6) + i * 8, kk = tid & 63;
            WT[(size_t)(n0 + nn) * K + k0 + kk] = f2bf(tile[kk * 65 + nn]);
        }
    }
}
struct IdMap { DEVI int operator()(int n) const { return n; } };
struct WinMap { DEVI int operator()(int n) const { return win_map(n); } };

DEVI void cvt_rows(const float* __restrict__ src, bf16_t* __restrict__ dst, size_t n4, int bid, int nblk) {
    const size_t stride = (size_t)nblk * 512;
    for (size_t i0 = (size_t)bid * 512 + tid_opq(); i0 < n4; i0 += stride * 8) {
        f32x4 v[8];
#pragma unroll
        for (int u = 0; u < 8; ++u) { const size_t i = i0 + u * stride; v[u] = i < n4 ? __builtin_nontemporal_load((const f32x4*)src + i) : (f32x4){0.f, 0.f, 0.f, 0.f}; }
#pragma unroll
        for (int u = 0; u < 8; ++u) { const size_t i = i0 + u * stride; if (i < n4) { u32x2 o; o.x = pack2(v[u][0], v[u][1]); o.y = pack2(v[u][2], v[u][3]); ((u32x2*)dst)[i] = o; } }
    }
}

DEVI void stage_prologue(const P& p, char* smem, int bid, int nblk) {
    float* tile = (float*)smem;
    cvt_rows(p.xp, p.XB, (size_t)NTP * 256, bid, nblk);
    cvt_rows(p.xs, p.XB + (size_t)NTP * 1024, (size_t)NTS * 256, bid, nblk);
    {
        const int lane = tid_opq() & 63, wid = tid_opq() >> 6;
        for (int r0 = bid * 8 + wid; r0 < 2 * 16384; r0 += nblk * 8 * 2) {
            f32x4 x[2][4]; float am[2] = {0.f, 0.f};
#pragma unroll
            for (int j = 0; j < 2; ++j) {
                const int r = r0 + j * nblk * 8;
                if (r < 2 * 16384) {
                    const bool isv = r >= 16384; const int e = isv ? r - 16384 : r;
                    const float* src = (isv ? p.peer_v : p.peer_u) + (size_t)e * 1024 + lane * 16;
#pragma unroll
                    for (int i = 0; i < 4; ++i) x[j][i] = __builtin_nontemporal_load((const f32x4*)(src + i * 4));
                }
            }
#pragma unroll
            for (int j = 0; j < 2; ++j) {
                const int r = r0 + j * nblk * 8;
                if (r < 2 * 16384) {
                    const bool isv = r >= 16384; const int e = isv ? r - 16384 : r;
#pragma unroll
                    for (int i = 0; i < 4; ++i)
#pragma unroll
                        for (int k = 0; k < 4; ++k) am[j] = fmaxf(am[j], fabsf(x[j][i][k]));
                    const float amx = wave_max(am[j]);
                    const float inv = amx > 0.f ? 448.f / amx : 1.f;
                    u32x4 o;
#pragma unroll
                    for (int i = 0; i < 4; ++i) { int w = __builtin_amdgcn_cvt_pk_fp8_f32(x[j][i][0] * inv, x[j][i][1] * inv, 0, false); w = __builtin_amdgcn_cvt_pk_fp8_f32(x[j][i][2] * inv, x[j][i][3] * inv, w, true); o[i] = (unsigned)w; }
                    *(u32x4*)((isv ? p.V8 : p.U8) + (size_t)e * 1024 + lane * 16) = o;
                    if (lane == 0) (isv ? p.VS : p.US)[e] = amx > 0.f ? amx / 448.f : 1.f;
                }
            }
        }
    }
    cvt_rows(p.peer_keys, p.KEYSB, (size_t)16 * 128 * 128 / 4, bid, nblk);
    transpose_cvt(p.w_in, p.WINT, 1024, 5688, NPAD_IN, WinMap(), tile, bid, nblk);
    transpose_cvt(p.w_merge, p.WINT + (size_t)NPAD_IN * 1024, 1024, 2048, 2048, IdMap(), tile, bid, nblk);
    transpose_cvt(p.w_br_a, p.WAT, 1024, 1024, 1024, IdMap(), tile, bid, nblk);
    transpose_cvt(p.w_br_b, p.WBT, 1024, 1024, 1024, IdMap(), tile, bid, nblk);
    transpose_cvt(p.w_out, p.WOT, 1024, 1024, 1024, IdMap(), tile, bid, nblk);
    transpose_cvt(p.peer_wq, p.WQT, 1024, 2048, 2048, IdMap(), tile, bid, nblk);
    transpose_cvt(p.nsa_w_cmp, p.WCT, 4096, 64, 64, IdMap(), tile, bid, nblk);
    transpose_cvt(p.nsa_w_cmp + 4096 * 64, p.WCT + 64 * 4096, 4096, 64, 64, IdMap(), tile, bid, nblk);
    for (int blk = bid; blk < 32; blk += nblk) {
        const int tid = tid_opq(), kvv = tid >> 8, e = tid & 63, kq = (tid >> 6) & 3;
        float a = 0.f;
        for (int k = blk * 128 + kq * 32; k < blk * 128 + kq * 32 + 32; ++k) a += p.nsa_pe[kvv * 4096 + k] * p.nsa_w_cmp[((size_t)kvv * 4096 + k) * 64 + e];
        atomicAdd(p.PW + kvv * 64 + e, a);
    }
    {
        const size_t per_b = (size_t)508 * 512 / 4;
        const size_t stride = (size_t)nblk * 512, ntot = 128 * per_b;
        for (size_t i0 = (size_t)bid * 512 + tid_opq(); i0 < ntot; i0 += stride * 8) {
            f32x4 v[8];
#pragma unroll
            for (int u = 0; u < 8; ++u) { const size_t i = i0 + u * stride; if (i < ntot) { const size_t b = i / per_b, r = i % per_b; v[u] = __builtin_nontemporal_load((const f32x4*)(p.cache_win + b * 512 * 512 + 4 * 512) + r); } }
#pragma unroll
            for (int u = 0; u < 8; ++u) { const size_t i = i0 + u * stride; if (i < ntot) { const size_t b = i / per_b, r = i % per_b; __builtin_nontemporal_store(v[u], (f32x4*)(p.out + O_SWIN + b * 512 * 512) + r); } }
        }
    }
}

struct NoPre {};
DEVI f32x4 bf4_lo(const u32x4& g) { return (f32x4){__uint_as_float(g[0] << 16), __uint_as_float(g[0] & 0xFFFF0000u), __uint_as_float(g[1] << 16), __uint_as_float(g[1] & 0xFFFF0000u)}; }
DEVI f32x4 bf4_hi(const u32x4& g) { return (f32x4){__uint_as_float(g[2] << 16), __uint_as_float(g[2] & 0xFFFF0000u), __uint_as_float(g[3] << 16), __uint_as_float(g[3] & 0xFFFF0000u)}; }
struct EpiInProj {
    P p;
    typedef NoPre Pre;
    static constexpr int BATCH = 4;
    static constexpr bool COLBIAS = true;
    DEVI void bias8(int col, f32x4& b0, f32x4& b1) const {
        b0 = (f32x4){0.f, 0.f, 0.f, 0.f}; b1 = b0;
        if (col < 5688) { const int oc = win_map(col);
#pragma unroll
            for (int q = 0; q < 4; ++q) { b0[q] = p.b_in[oc + q]; b1[q] = p.b_in[oc + 4 + q]; } }
    }
    DEVI Pre pre(int, int) const { return NoPre(); }
    DEVI void put(int row, int col, f32x4 v0, f32x4 v1, const Pre&) const {
        if (col >= NPAD_IN) {
#pragma unroll
            for (int k = 0; k < 4; ++k) { v0[k] = sigmoidf_(v0[k]); v1[k] = sigmoidf_(v1[k]); }
            *(u32x4*)(p.G + (size_t)row * 2048 + (col - NPAD_IN)) = pack8f(v0, v1);
            return;
        }
        if (col >= 5688) return;
        if (col >= 5632) { *(f32x4*)(p.SM + (size_t)row * 64 + (col - 5632)) = v0; *(f32x4*)(p.SM + (size_t)row * 64 + (col - 5632) + 4) = v1; return; }
        if (col >= C_AK && col < C_AV) { v0 *= 0.08838834764831845f; v1 *= 0.08838834764831845f; }
        *(u32x4*)(p.PROJ + (size_t)row * PS + col) = pack8f(v0, v1);
        if (col >= C_CMP) {
            const int reg = (col - C_CMP) >> 9, c = (col - C_CMP) & 511;
            float* dst = nullptr;
            if (row < NTP) {
                if (reg == 0) dst = p.out + O_PCMP + (size_t)row * 512 + c;
                else if (reg == 1) dst = p.out + O_PSLC + (size_t)row * 512 + c;
                else { const int b = row >> 12, t = row & 4095; if (t >= 3584) dst = p.out + O_PWIN + ((size_t)b * 512 + (t - 3584)) * 512 + c; }
            } else {
                const int rs = row - NTP;
                if (reg == 0) dst = p.out + O_SCMP + (size_t)rs * 512 + c;
                else if (reg == 1) dst = p.out + O_SSLC + (size_t)rs * 512 + c;
                else { const int b = rs >> 2, tq = rs & 3; dst = p.out + O_SWIN + ((size_t)b * 512 + 508 + tq) * 512 + c; }
            }
            if (dst) { *(f32x4*)dst = v0; *(f32x4*)(dst + 4) = v1; }
        }
    }
};
struct EpiG {
    P p;
    typedef NoPre Pre;
    static constexpr int BATCH = 4;
    static constexpr bool COLBIAS = false;
    DEVI Pre pre(int, int) const { return NoPre(); }
    DEVI void put(int row, int col, f32x4 v0, f32x4 v1, const Pre&) const {
#pragma unroll
        for (int k = 0; k < 4; ++k) { v0[k] = sigmoidf_(v0[k]); v1[k] = sigmoidf_(v1[k]); }
        *(u32x4*)(p.G + (size_t)row * 2048 + col) = pack8f(v0, v1);
    }
};
struct EpiM1 {
    P p;
    typedef u32x4 Pre;
    static constexpr int BATCH = 8;
    static constexpr bool COLBIAS = false;
    DEVI Pre pre(int row, int col) const { return *(const u32x4*)(p.G + (size_t)row * 2048 + 1024 + col); }
    DEVI void put(int row, int col, f32x4 v0, f32x4 v1, const Pre& g) const {
        *(u32x4*)(p.TMPB + (size_t)row * 1024 + col) = pack8f(v0 * bf4_lo(g), v1 * bf4_hi(g));
    }
};
struct PreM2 { u32x4 g; u32x4 t; };
struct EpiM2 {
    P p;
    typedef PreM2 Pre;
    static constexpr int BATCH = 8;
    static constexpr bool COLBIAS = false;
    DEVI Pre pre(int row, int col) const { PreM2 r; r.g = *(const u32x4*)(p.G + (size_t)row * 2048 + col); r.t = *(const u32x4*)(p.TMPB + (size_t)row * 1024 + col); return r; }
    DEVI void put(int row, int col, f32x4 v0, f32x4 v1, const Pre& q) const {
        *(u32x4*)(p.MERGED + (size_t)row * 1024 + col) = pack8f(bf4_lo(q.t) + v0 * bf4_lo(q.g), bf4_hi(q.t) + v1 * bf4_hi(q.g));
    }
};
struct PreR { f32x4 a, b; };
struct EpiR {
    P p;
    typedef PreR Pre;
    static constexpr int BATCH = 8;
    static constexpr bool COLBIAS = false;
    DEVI Pre pre(int row, int col) const {
        const float* xr = row < NTP ? p.xp + (size_t)row * 1024 : p.xs + (size_t)(row - NTP) * 1024;
        PreR r; r.a = *(const f32x4*)(xr + col); r.b = *(const f32x4*)(xr + col + 4); return r;
    }
    DEVI void put(int row, int col, f32x4 v0, f32x4 v1, const Pre& x) const {
        *(f32x4*)(p.R + (size_t)row * 1024 + col) = x.a * DN_ALPHA + v0; *(f32x4*)(p.R + (size_t)row * 1024 + col + 4) = x.b * DN_ALPHA + v1;
    }
};
struct EpiPQ {
    P p;
    typedef NoPre Pre;
    static constexpr int BATCH = 4;
    static constexpr bool COLBIAS = false;
    DEVI Pre pre(int, int) const { return NoPre(); }
    DEVI void put(int row, int col, f32x4 v0, f32x4 v1, const Pre&) const { *(u32x4*)(p.PQ + (size_t)row * 2048 + col) = pack8f(v0, v1); }
};

DEVI void stage_mlstm_gates(const P& p, char* smem, int bid, int nblk) {
    const int lane = tid_opq() & 63, wid = tid_opq() >> 6;
    float* bend_s = (float*)smem; float* mloc_s = bend_s + 64;
    for (int bh = bid; bh < 16; bh += nblk) {
        const int b = bh >> 2, h = bh & 3;
        __syncthreads();
        for (int cc = 0; cc < 8; ++cc) {
            const int c = wid * 8 + cc;
            const size_t row = (size_t)b * 4096 + c * 64 + lane;
            const float ip = p.SM[row * 64 + h];
            const float lf = logsigmoidf_(p.SM[row * 64 + 4 + h]);
            float cs = lf;
#pragma unroll
            for (int o = 1; o < 64; o <<= 1) { const float t = __shfl_up(cs, o); if (lane >= o) cs += t; }
            p.BCUM[bh * 4096 + c * 64 + lane] = cs;
            const float bend = __shfl(cs, 63);
            const float mloc = wave_max(bend - cs + ip);
            if (lane == 0) { bend_s[c] = bend; mloc_s[c] = mloc; }
        }
        __syncthreads();
        if (tid_opq() == 0) {
            float m = 0.f;
            for (int c = 0; c < 64; ++c) {
                const float bend = bend_s[c], mloc = mloc_s[c];
                const float mnew = fmaxf(bend + m, mloc);
                p.MPREV[bh * 64 + c] = m;
                p.ACOEF[bh * 64 + c] = __expf(bend + m - mnew);
                p.SCL[bh * 64 + c] = __expf(mloc - mnew);
                p.MLOC[bh * 64 + c] = mloc;
                m = mnew;
            }
            p.out[O_PM + bh] = m;
        }
    }
}

constexpr int MD_KT = 0, MD_VT = 128 * 144, MD_WS = MD_VT + 272 * 144, MD_LDS = MD_WS + 256;
DEVI void stage_mlstm_dc(const P& p, char* smem, int bid, int nblk) {
    const int tid = tid_opq(), lane = tid & 63, wid = tid >> 6, fr = lane & 15, fq = lane >> 4;
    bf16_t* Kt = (bf16_t*)(smem + MD_KT);
    bf16_t* Vt = (bf16_t*)(smem + MD_VT);
    float* ws = (float*)(smem + MD_WS);
    for (int task = bid; task < 1024; task += nblk) {
        const int bh = task >> 6, c = task & 63, b = bh >> 2, h = bh & 3;
        const size_t row0 = (size_t)b * 4096 + c * 64;
        __syncthreads();
        if (tid < 64) {
            const float ip = p.SM[(row0 + tid) * 64 + h];
            float cs = logsigmoidf_(p.SM[(row0 + tid) * 64 + 4 + h]);
#pragma unroll
            for (int o = 1; o < 64; o <<= 1) { const float t = __shfl_up(cs, o); if (tid >= o) cs += t; }
            const float g = __shfl(cs, 63) - cs + ip;
            ws[tid] = __expf(g - wave_max(g));
        }
        __syncthreads();
        {
            const int sidx = tid & 63, ch = tid >> 6;
            const float w = ws[sidx];
#pragma unroll
            for (int half = 0; half < 2; ++half) {
                const u32x4 kk = *(const u32x4*)(p.PROJ + (row0 + sidx) * PS + C_AK + h * 128 + half * 64 + ch * 8);
#pragma unroll
                for (int e = 0; e < 4; ++e) {
                    Kt[(half * 64 + ch * 8 + e * 2) * 72 + sidx] = f2bf(w * __uint_as_float(kk[e] << 16));
                    Kt[(half * 64 + ch * 8 + e * 2 + 1) * 72 + sidx] = f2bf(w * __uint_as_float(kk[e] & 0xFFFF0000u));
                }
            }
#pragma unroll
            for (int q4 = 0; q4 < 4; ++q4) {
                const u32x4 vv = *(const u32x4*)(p.PROJ + (row0 + sidx) * PS + C_AV + h * 256 + q4 * 64 + ch * 8);
#pragma unroll
                for (int e = 0; e < 4; ++e) {
                    Vt[(q4 * 64 + ch * 8 + e * 2) * 72 + sidx] = (bf16_t)(vv[e] & 0xFFFFu);
                    Vt[(q4 * 64 + ch * 8 + e * 2 + 1) * 72 + sidx] = (bf16_t)(vv[e] >> 16);
                }
            }
            for (int i = tid; i < 16 * 64; i += 512) Vt[(256 + (i >> 6)) * 72 + (i & 63)] = (i >> 6) == 0 ? (bf16_t)0x3F80 : (bf16_t)0;
        }
        __syncthreads();
        const int nvt = wid == 0 ? 3 : 2;
        for (int vi = 0; vi < nvt; ++vi) {
            const int vt = vi < 2 ? wid * 2 + vi : 16;
            f32x4 acc[8];
#pragma unroll
            for (int dt = 0; dt < 8; ++dt) acc[dt] = (f32x4){0.f, 0.f, 0.f, 0.f};
#pragma unroll
            for (int ks = 0; ks < 2; ++ks) {
                const bf16x8 bf = *(const bf16x8*)(Vt + (vt * 16 + fr) * 72 + ks * 32 + fq * 8);
#pragma unroll
                for (int dt = 0; dt < 8; ++dt) {
                    const bf16x8 af = *(const bf16x8*)(Kt + (dt * 16 + fr) * 72 + ks * 32 + fq * 8);
                    acc[dt] = __builtin_amdgcn_mfma_f32_16x16x32_bf16(af, bf, acc[dt], 0, 0, 0);
                }
            }
            const int v = vt * 16 + fr;
            if (v <= 256) {
#pragma unroll
                for (int dt = 0; dt < 8; ++dt) *(f32x4*)(p.DC + ((size_t)task * 272 + v) * 128 + dt * 16 + fq * 4) = acc[dt];
            }
        }
    }
}

DEVI void stage_mlstm_scan(const P& p, int bid, int nblk) {
    const int nthr = 512;
    for (int e = bid * nthr + tid_opq(); e < 16 * 257 * 32; e += nblk * nthr) {
        const int bh = e / (257 * 32), r = e % (257 * 32), v = r >> 5, d = (r & 31) * 4;
        f32x4 C = {0.f, 0.f, 0.f, 0.f};
        const float* ac = p.ACOEF + bh * 64; const float* sc = p.SCL + bh * 64;
        const size_t base = ((size_t)(bh * 64) * 272 + v) * 128 + d, cstride = (size_t)272 * 128;
#pragma unroll 1
        for (int c0 = 0; c0 < 64; c0 += 8) {
            f32x4 dc[8];
#pragma unroll
            for (int i = 0; i < 8; ++i) dc[i] = __builtin_nontemporal_load((const f32x4*)(p.DC + base + (size_t)(c0 + i) * cstride));
#pragma unroll
            for (int i = 0; i < 8; ++i) {
                u32x2 o; o.x = pack2(C[0], C[1]); o.y = pack2(C[2], C[3]);
                *(u32x2*)(p.CPT + base + (size_t)(c0 + i) * cstride) = o;
                C = C * ac[c0 + i] + dc[i] * sc[c0 + i];
            }
        }
        if (v < 256) {
#pragma unroll
            for (int k = 0; k < 4; ++k) p.out[O_PC + ((size_t)bh * 128 + d + k) * 256 + v] = C[k];
        } else *(f32x4*)(p.out + O_PN + bh * 128 + d) = C;
    }
}

constexpr int MO_Q = 0, MO_K = 64 * 272, MO_VT = MO_K + 64 * 272, MO_P = MO_VT + 272 * 144, MO_SC = MO_P + 64 * 144, MO_HS = MO_SC + 2048, MO_LDS = MO_HS + 64 * 256 * 4;
static_assert(MO_LDS <= 152 * 1024, "lds");
DEVI void stage_mlstm_out(const P& p, char* smem, int bid, int nblk) {
    const int tid = tid_opq(), lane = tid & 63, wid = tid >> 6, fr = lane & 15, fq = lane >> 4;
    bf16_t* Qs = (bf16_t*)(smem + MO_Q);
    bf16_t* Ks = (bf16_t*)(smem + MO_K);
    bf16_t* Vt = (bf16_t*)(smem + MO_VT);
    bf16_t* Ps = (bf16_t*)(smem + MO_P);
    float* sc = (float*)(smem + MO_SC);
    float* rowt = sc; float* colt = sc + 64; float* wint = sc + 128; float* emt = sc + 192; float* den = sc + 256;
    float* hs = (float*)(smem + MO_HS);
    for (int task = bid; task < 1024; task += nblk) {
        const int bh = task >> 6, c = task & 63, b = bh >> 2, h = bh & 3;
        const size_t row0 = (size_t)b * 4096 + c * 64;
        __syncthreads();
        {
            for (int i = tid; i < 64 * 16; i += 512) {
                const int t = i >> 4, ch = i & 15;
                *(u32x4*)(Qs + t * 136 + ch * 8) = *(const u32x4*)(p.PROJ + (row0 + t) * PS + C_AQ + h * 128 + ch * 8);
                *(u32x4*)(Ks + t * 136 + ch * 8) = *(const u32x4*)(p.PROJ + (row0 + t) * PS + C_AK + h * 128 + ch * 8);
            }
            const int sidx = tid & 63, ch = tid >> 6;
#pragma unroll
            for (int q4 = 0; q4 < 4; ++q4) {
                const u32x4 vv = *(const u32x4*)(p.PROJ + (row0 + sidx) * PS + C_AV + h * 256 + q4 * 64 + ch * 8);
#pragma unroll
                for (int e = 0; e < 4; ++e) {
                    Vt[(q4 * 64 + ch * 8 + e * 2) * 72 + sidx] = (bf16_t)(vv[e] & 0xFFFFu);
                    Vt[(q4 * 64 + ch * 8 + e * 2 + 1) * 72 + sidx] = (bf16_t)(vv[e] >> 16);
                }
            }
            for (int i = tid; i < 16 * 64; i += 512) Vt[(256 + (i >> 6)) * 72 + (i & 63)] = (i >> 6) == 0 ? (bf16_t)0x3F80 : (bf16_t)0;
            if (wid == 0) {
                const float bc = p.BCUM[bh * 4096 + c * 64 + lane], ip = p.SM[(row0 + lane) * 64 + h];
                const float mprev = p.MPREV[task];
                float pm = ip - bc;
#pragma unroll
                for (int o = 1; o < 64; o <<= 1) { const float t = __shfl_up(pm, o); if (lane >= o) pm = fmaxf(pm, t); }
                const float mt = fmaxf(bc + mprev, bc + pm);
                rowt[lane] = bc - mt; colt[lane] = ip - bc; wint[lane] = __expf(bc + mprev - mt); emt[lane] = __expf(-mt);
            }
        }
        __syncthreads();
        {
            const int tt = wid >> 1;
#pragma unroll
            for (int si = 0; si < 2; ++si) {
                const int st = (wid & 1) * 2 + si;
                f32x4 acc = (f32x4){0.f, 0.f, 0.f, 0.f};
                if (st <= tt) {
#pragma unroll
                    for (int ks = 0; ks < 4; ++ks) {
                        const bf16x8 af = *(const bf16x8*)(Qs + (tt * 16 + fr) * 136 + ks * 32 + fq * 8);
                        const bf16x8 bf = *(const bf16x8*)(Ks + (st * 16 + fr) * 136 + ks * 32 + fq * 8);
                        acc = __builtin_amdgcn_mfma_f32_16x16x32_bf16(af, bf, acc, 0, 0, 0);
                    }
                }
                const int s = st * 16 + fr; const float ct = colt[s];
#pragma unroll
                for (int r = 0; r < 4; ++r) {
                    const int t = tt * 16 + fq * 4 + r;
                    const float pv = (s <= t) ? acc[r] * __expf(rowt[t] + ct) : 0.f;
                    Ps[t * 72 + s] = f2bf(pv);
                }
            }
        }
        __syncthreads();
        {
            const bf16_t* cpt = p.CPT + (size_t)task * 272 * 128;
            f32x4 acc[4][2];
#pragma unroll
            for (int tt = 0; tt < 4; ++tt)
#pragma unroll
                for (int vi = 0; vi < 2; ++vi) acc[tt][vi] = (f32x4){0.f, 0.f, 0.f, 0.f};
            f32x4 accd = (f32x4){0.f, 0.f, 0.f, 0.f};
            bf16x8 cb[4][2], cd[4];
#pragma unroll
            for (int ks = 0; ks < 4; ++ks) {
#pragma unroll
                for (int vi = 0; vi < 2; ++vi) cb[ks][vi] = *(const bf16x8*)(cpt + (size_t)((wid * 2 + vi) * 16 + fr) * 128 + ks * 32 + fq * 8);
                cd[ks] = *(const bf16x8*)(cpt + (size_t)(256 + fr) * 128 + ks * 32 + fq * 8);
            }
#pragma unroll
            for (int ks = 0; ks < 4; ++ks) {
                bf16x8 af[4];
#pragma unroll
                for (int tt = 0; tt < 4; ++tt) af[tt] = *(const bf16x8*)(Qs + (tt * 16 + fr) * 136 + ks * 32 + fq * 8);
#pragma unroll
                for (int vi = 0; vi < 2; ++vi) {
#pragma unroll
                    for (int tt = 0; tt < 4; ++tt) acc[tt][vi] = __builtin_amdgcn_mfma_f32_16x16x32_bf16(af[tt], cb[ks][vi], acc[tt][vi], 0, 0, 0);
                }
                if (wid < 4) {
                    const bf16x8 a2 = *(const bf16x8*)(Qs + (wid * 16 + fr) * 136 + ks * 32 + fq * 8);
                    accd = __builtin_amdgcn_mfma_f32_16x16x32_bf16(a2, cd[ks], accd, 0, 0, 0);
                }
            }
#pragma unroll
            for (int tt = 0; tt < 4; ++tt) {
                const f32x4 wv = *(const f32x4*)(wint + tt * 16 + fq * 4);
#pragma unroll
                for (int vi = 0; vi < 2; ++vi) acc[tt][vi] *= wv;
            }
            if (wid < 4) accd *= *(const f32x4*)(wint + wid * 16 + fq * 4);
#pragma unroll
            for (int ks = 0; ks < 2; ++ks) {
                bf16x8 af[4];
#pragma unroll
                for (int tt = 0; tt < 4; ++tt) af[tt] = *(const bf16x8*)(Ps + (tt * 16 + fr) * 72 + ks * 32 + fq * 8);
#pragma unroll
                for (int vi = 0; vi < 2; ++vi) {
                    const bf16x8 bf = *(const bf16x8*)(Vt + ((wid * 2 + vi) * 16 + fr) * 72 + ks * 32 + fq * 8);
#pragma unroll
                    for (int tt = 0; tt < 4; ++tt) acc[tt][vi] = __builtin_amdgcn_mfma_f32_16x16x32_bf16(af[tt], bf, acc[tt][vi], 0, 0, 0);
                }
                if (wid < 4) {
                    const bf16x8 bf = *(const bf16x8*)(Vt + (256 + fr) * 72 + ks * 32 + fq * 8);
                    const bf16x8 a2 = *(const bf16x8*)(Ps + (wid * 16 + fr) * 72 + ks * 32 + fq * 8);
                    accd = __builtin_amdgcn_mfma_f32_16x16x32_bf16(a2, bf, accd, 0, 0, 0);
                }
            }
            if (wid < 4 && fr == 0) *(f32x4*)(den + wid * 16 + fq * 4) = accd;
            __syncthreads();
#pragma unroll
            for (int tt = 0; tt < 4; ++tt) {
                const f32x4 dv = *(const f32x4*)(den + tt * 16 + fq * 4), ev = *(const f32x4*)(emt + tt * 16 + fq * 4);
#pragma unroll
                for (int vi = 0; vi < 2; ++vi)
#pragma unroll
                    for (int r = 0; r < 4; ++r) hs[(tt * 16 + fq * 4 + r) * 256 + (wid * 2 + vi) * 16 + fr] = acc[tt][vi][r] / fmaxf(fabsf(dv[r]), ev[r]);
            }
        }
        __syncthreads();
        u32x2 ovs[8];
#pragma unroll
        for (int rr = 0; rr < 8; ++rr) ovs[rr] = *(const u32x2*)(p.PROJ + (row0 + wid * 8 + rr) * PS + C_AO + h * 256 + lane * 4);
        const f32x4 gg = *(const f32x4*)(p.norm_a_g + h * 256 + lane * 4);
#pragma unroll
        for (int rr = 0; rr < 8; ++rr) {
            const int t = wid * 8 + rr;
            const f32x4 x = *(const f32x4*)(hs + t * 256 + lane * 4);
            const float mean = wave_sum(x[0] + x[1] + x[2] + x[3]) * (1.f / 256.f);
            float q = 0.f;
#pragma unroll
            for (int k = 0; k < 4; ++k) q += (x[k] - mean) * (x[k] - mean);
            const float rs = rsqrtf(wave_sum(q) * (1.f / 256.f) + LN_EPS);
            const u32x2 ov = ovs[rr];
            const float o4[4] = {__uint_as_float(ov.x << 16), __uint_as_float(ov.x & 0xFFFF0000u), __uint_as_float(ov.y << 16), __uint_as_float(ov.y & 0xFFFF0000u)};
            float y[4];
#pragma unroll
            for (int k = 0; k < 4; ++k) y[k] = (x[k] - mean) * rs * gg[k] * sigmoidf_(o4[k]);
            u32x2 o2; o2.x = pack2(y[0], y[1]); o2.y = pack2(y[2], y[3]);
            *(u32x2*)(p.YA + (row0 + t) * 1024 + h * 256 + lane * 4) = o2;
        }
    }
}

DEVI void stage_mlstm_sample(const P& p, char* smem, int bid, int nblk) {
    float* qs = (float*)smem;
    float* ks = qs + 512;
    float* vs = ks + 512;
    float* part = vs + 1024;
    float* hs = part + 2048;
    float* sc = hs + 1024;
    float* bc = sc; float* ip = sc + 4; float* mt = sc + 8; float* wint = sc + 12; float* emt = sc + 16; float* ww = sc + 20; float* den = sc + 24;
    float* Pm = sc + 32;
    float* misc = sc + 48;
    const int tid = tid_opq(), lane = tid & 63, wid = tid >> 6;
    for (int task = bid; task < 512; task += nblk) {
        const int b = task >> 2, h = task & 3;
        const size_t row0 = (size_t)NTP + b * 4;
        __syncthreads();
        { const int t = tid >> 7, d = tid & 127;
          qs[tid] = bf2f(p.PROJ[(row0 + t) * PS + C_AQ + h * 128 + d]);
          ks[tid] = bf2f(p.PROJ[(row0 + t) * PS + C_AK + h * 128 + d]); }
        for (int idx = tid; idx < 1024; idx += 512) { const int t = idx >> 8, v = idx & 255; vs[idx] = bf2f(p.PROJ[(row0 + t) * PS + C_AV + h * 256 + v]); }
        if (tid == 0) {
            const float m0 = p.state_m[task];
            float cs = 0.f;
            for (int t = 0; t < 4; ++t) { cs += logsigmoidf_(p.SM[(row0 + t) * 64 + 4 + h]); bc[t] = cs; ip[t] = p.SM[(row0 + t) * 64 + h]; }
            for (int t = 0; t < 4; ++t) {
                float mx = bc[t] + m0;
                for (int s = 0; s <= t; ++s) mx = fmaxf(mx, bc[t] - bc[s] + ip[s]);
                mt[t] = mx; wint[t] = __expf(bc[t] + m0 - mx); emt[t] = __expf(-mx);
            }
            const float bend = bc[3];
            float mnew = bend + m0;
            for (int s = 0; s < 4; ++s) mnew = fmaxf(mnew, bend - bc[s] + ip[s]);
            misc[0] = __expf(bend + m0 - mnew);
            for (int s = 0; s < 4; ++s) ww[s] = __expf(bend - bc[s] + ip[s] - mnew);
            p.out[O_SM + task] = mnew;
        }
        __syncthreads();
        if (tid < 16) {
            const int t = tid >> 2, s = tid & 3;
            float a = 0.f;
            if (s <= t) { for (int d = 0; d < 128; ++d) a += qs[t * 128 + d] * ks[s * 128 + d]; a *= __expf(bc[t] - bc[s] + ip[s] - mt[t]); }
            Pm[tid] = a;
        }
        __syncthreads();
        if (tid < 4) {
            const int t = tid; float qn = 0.f;
            for (int d = 0; d < 128; ++d) qn += qs[t * 128 + d] * p.state_n[(size_t)task * 128 + d];
            den[t] = wint[t] * qn + Pm[t * 4] + Pm[t * 4 + 1] + Pm[t * 4 + 2] + Pm[t * 4 + 3];
        }
        const float a = misc[0];
        if (tid >= 128 && tid < 256) {
            const int d = tid - 128;
            float n = a * p.state_n[(size_t)task * 128 + d];
            for (int s = 0; s < 4; ++s) n += ww[s] * ks[s * 128 + d];
            p.out[O_SN + (size_t)task * 128 + d] = n;
        }
        {
            const int v = tid & 255, dh = tid >> 8;
            float acc[4] = {0.f, 0.f, 0.f, 0.f};
            float wv[4];
#pragma unroll
            for (int s = 0; s < 4; ++s) wv[s] = ww[s] * vs[s * 256 + v];
            for (int d0 = dh * 64; d0 < dh * 64 + 64; d0 += 16) {
                float c0[16];
#pragma unroll
                for (int i = 0; i < 16; ++i) c0[i] = __builtin_nontemporal_load(p.state_C + ((size_t)task * 128 + d0 + i) * 256 + v);
#pragma unroll
                for (int i = 0; i < 16; ++i) {
                    const int d = d0 + i;
#pragma unroll
                    for (int t = 0; t < 4; ++t) acc[t] += qs[t * 128 + d] * c0[i];
                    float cn = a * c0[i];
#pragma unroll
                    for (int s = 0; s < 4; ++s) cn += ks[s * 128 + d] * wv[s];
                    __builtin_nontemporal_store(cn, p.out + O_SC + ((size_t)task * 128 + d) * 256 + v);
                }
            }
#pragma unroll
            for (int t = 0; t < 4; ++t) part[(dh * 4 + t) * 256 + v] = acc[t];
        }
        __syncthreads();
        if (tid < 256) {
            const int v = tid;
#pragma unroll
            for (int t = 0; t < 4; ++t) {
                float num = wint[t] * (part[t * 256 + v] + part[(4 + t) * 256 + v]);
#pragma unroll
                for (int s = 0; s < 4; ++s) num += Pm[t * 4 + s] * vs[s * 256 + v];
                hs[t * 256 + v] = num / fmaxf(fabsf(den[t]), emt[t]);
            }
        }
        __syncthreads();
        if (wid < 4) {
            const int t = wid;
            const f32x4 x = *(const f32x4*)(hs + t * 256 + lane * 4);
            const float mean = wave_sum(x[0] + x[1] + x[2] + x[3]) * (1.f / 256.f);
            float q = 0.f;
#pragma unroll
            for (int k = 0; k < 4; ++k) q += (x[k] - mean) * (x[k] - mean);
            const float rs = rsqrtf(wave_sum(q) * (1.f / 256.f) + LN_EPS);
            float y[4];
#pragma unroll
            for (int k = 0; k < 4; ++k) {
                const int vi = lane * 4 + k;
                const float o = bf2f(p.PROJ[(row0 + t) * PS + C_AO + h * 256 + vi]);
                y[k] = (x[k] - mean) * rs * p.norm_a_g[h * 256 + vi] * sigmoidf_(o);
            }
            u32x2 o2; o2.x = pack2(y[0], y[1]); o2.y = pack2(y[2], y[3]);
            *(u32x2*)(p.YA + (row0 + t) * 1024 + h * 256 + lane * 4) = o2;
        }
    }
}

constexpr int CP_ABUF = 33280, CP_WBUF = 18432, CP_A = 0, CP_W = 2 * CP_ABUF, CP_LDS = CP_W + 2 * CP_WBUF;
constexpr int CP_AROW = 1024 + 8;
DEVI void stage_compress(const P& p, char* smem, int bid, int nblk) {
    const int tid = tid_opq(), lane = tid & 63, wid = tid >> 6, fr = lane & 15, fq = lane >> 4;
    const int kv = wid & 1, rt = wid >> 1;
    const int n_it = (256 + nblk - 1) / nblk + (16 + nblk - 1) / nblk;
    for (int it = 0; it < n_it; ++it) {
        const int ns_it = (256 + nblk - 1) / nblk;
        const int task = it < ns_it ? bid + it * nblk : 256 + (nblk - 1 - bid) + (it - ns_it) * nblk;
        if (task >= 272 || (it < ns_it && task >= 256)) continue;
        const bool prompt = task >= 256;
        const int rowbytes = prompt ? 1024 : 2048, npieces = prompt ? 2 : 4;
        const char* src[4]; int dsto[4];
#pragma unroll
        for (int q = 0; q < 4; ++q) {
            const int off = q * 8192 + tid * 16, r = off / rowbytes, cb = off % rowbytes;
            if (prompt) { const int blk = (task - 256) * 16 + (r & 15); src[q] = (const char*)(p.PROJ + (size_t)blk * 64 * PS + C_CMP) + cb; dsto[q] = (r & 15) * CP_AROW * 2 + cb; }
            else { const int gb = task * 16 + r, b = gb >> 5, n = gb & 31; const int page = p.page_table[b * 16 + (n >> 1)];
                   src[q] = (const char*)(p.cache_cmp + ((size_t)page * 128 + (n & 1) * 64) * 512) + cb; dsto[q] = r * CP_AROW * 2 + (cb >> 1); }
        }
        const size_t sstride = prompt ? (size_t)PS * 2 : 2048;
        const char* wsrc[2]; int wdst[2];
#pragma unroll
        for (int q = 0; q < 2; ++q) { const int idx = q * 512 + tid, row = idx >> 3, ch = idx & 7; wsrc[q] = (const char*)(p.WCT + (size_t)row * 4096) + ch * 16; wdst[q] = row * 144 + ch * 16; }
        f32x4 acc[4];
#pragma unroll
        for (int nt = 0; nt < 4; ++nt) acc[nt] = (f32x4){0.f, 0.f, 0.f, 0.f};
        f32x4 ra0[4], ra1[4]; u32x4 rw0[2], rw1[2];
        auto issue = [&](int l, f32x4 (&ra)[4], u32x4 (&rw)[2]) {
#pragma unroll
            for (int q = 0; q < 4; ++q) if (q < npieces) ra[q] = prompt ? *(const f32x4*)(src[q] + (size_t)l * sstride) : __builtin_nontemporal_load((const f32x4*)(src[q] + (size_t)l * sstride));
#pragma unroll
            for (int q = 0; q < 2; ++q) rw[q] = *(const u32x4*)(wsrc[q] + l * 128);
        };
        auto commit = [&](int buf, const f32x4 (&ra)[4], const u32x4 (&rw)[2]) {
            char* ab = smem + CP_A + buf * CP_ABUF; char* wbuf = smem + CP_W + buf * CP_WBUF;
#pragma unroll
            for (int q = 0; q < 4; ++q) if (q < npieces) {
                if (prompt) *(f32x4*)(ab + dsto[q]) = ra[q];
                else { u32x2 o; o.x = pack2(ra[q][0], ra[q][1]); o.y = pack2(ra[q][2], ra[q][3]); *(u32x2*)(ab + dsto[q]) = o; }
            }
#pragma unroll
            for (int q = 0; q < 2; ++q) *(u32x4*)(wbuf + wdst[q]) = rw[q];
        };
        auto consume = [&](int buf) {
            const char* ab = smem + CP_A + buf * CP_ABUF; const char* wbuf = smem + CP_W + buf * CP_WBUF;
            const bf16_t* arow = (const bf16_t*)ab + (rt * 4 + (fr >> 2)) * CP_AROW + kv * 256 + (fr & 3) * 64 + fq * 8;
#pragma unroll
            for (int hf = 0; hf < 2; ++hf) {
                const bf16x8 a = *(const bf16x8*)(arow + hf * 32);
#pragma unroll
                for (int nt = 0; nt < 4; ++nt) {
                    const bf16x8 bfrag = *(const bf16x8*)(wbuf + (kv * 64 + nt * 16 + fr) * 144 + hf * 64 + fq * 16);
                    acc[nt] = __builtin_amdgcn_mfma_f32_16x16x32_bf16(a, bfrag, acc[nt], 0, 0, 0);
                }
            }
        };
        __syncthreads();
        issue(0, ra0, rw0); issue(1, ra1, rw1); commit(0, ra0, rw0); issue(2, ra0, rw0);
        __syncthreads();
#pragma unroll 1
        for (int l = 0; l < 64; l += 2) {
            consume(0);
            commit(1, ra1, rw1);
            if (l + 3 < 64) issue(l + 3, ra1, rw1);
            __syncthreads();
            consume(1);
            if (l + 2 < 64) commit(0, ra0, rw0);
            if (l + 4 < 64) issue(l + 4, ra0, rw0);
            __syncthreads();
        }
        {
            const int ob = prompt ? (task - 256) * 16 + rt * 4 + fq : 256 + task * 16 + rt * 4 + fq;
#pragma unroll
            for (int nt = 0; nt < 4; ++nt) {
                const float bias = p.PW[kv * 64 + nt * 16 + fr];
#pragma unroll
                for (int r = 0; r < 4; ++r) p.KC[(size_t)ob * 512 + kv * 256 + r * 64 + nt * 16 + fr] = acc[nt][r] + bias;
            }
        }
    }
}

typedef float f32x16 __attribute__((ext_vector_type(16)));
typedef short s16x4 __attribute__((ext_vector_type(4)));
typedef __attribute__((address_space(3))) const char* lds_cptr;
#define MFMA32(a, b, c) __builtin_amdgcn_mfma_f32_32x32x16_bf16(a, b, c, 0, 0, 0)
DEVI int crow(int r, int hi) { return (r & 3) + 8 * (r >> 2) + 4 * hi; }
DEVI unsigned cvtpk(float lo, float hi) { return pack2(lo, hi); }
DEVI s16x4 vtr(lds_cptr p) { return __builtin_bit_cast(s16x4, __builtin_amdgcn_ds_read_tr16_b64_v4i16((__attribute__((address_space(3))) s16x4*)p)); }
DEVI float half_max(float m) { auto rr = __builtin_amdgcn_permlane32_swap(__float_as_uint(m), __float_as_uint(m), false, false); return fmaxf(__uint_as_float(rr[0]), __uint_as_float(rr[1])); }
DEVI float half_sum(float m) { auto rr = __builtin_amdgcn_permlane32_swap(__float_as_uint(m), __float_as_uint(m), false, false); return __uint_as_float(rr[0]) + __uint_as_float(rr[1]); }

struct BlkDesc { const char* k; int stride_bytes; int f32; int count; int pos0; };
DEVI void blk_load(const BlkDesc& d, int tid, u32x4& rk, u32x4& rv) {
    const int key = tid & 63, chunk = tid >> 6;
    rk = (u32x4){0u, 0u, 0u, 0u}; rv = rk;
    if (key < d.count) {
        const char* kr = d.k + (size_t)key * d.stride_bytes;
        if (d.f32) {
            const f32x4* s1 = (const f32x4*)(kr + chunk * 32); const f32x4* s2 = (const f32x4*)(kr + 1024 + chunk * 32);
            rk = pack8f(s1[0], s1[1]); rv = pack8f(s2[0], s2[1]);
        } else { rk = *(const u32x4*)(kr + chunk * 16); rv = *(const u32x4*)(kr + 512 + chunk * 16); }
    }
}
DEVI void blk_store(char* kimg, char* vimg, int tid, const u32x4& rk, const u32x4& rv) {
    const int key = tid & 63, chunk = tid >> 6;
    *(u32x4*)(kimg + chunk * 1024 + key * 16) = rk;
    *(u32x4*)(vimg + (chunk >> 2) * 4096 + key * 64 + (chunk & 3) * 16) = rv;
}

DEVI void attn_tile(const char* kimg, const char* vimg, const bf16x8 (&qr)[4], float& m2, float& lsum, f32x16& o0, f32x16& o1, f32x16& s0, f32x16& s1,
                    float sl, float bb, int lh, int ll, bool fast, float* wsf_hi  , float* wsf_r  , int lane) {
    const int r32 = lane & 31, hi = lane >> 5;
    const f32x16 z = {};
    s0 = z; s1 = z;
    {
        const char* kp = kimg + hi * 1024 + r32 * 16;
#pragma unroll
        for (int d0 = 0; d0 < 4; ++d0) {
            const bf16x8 k0 = *(const bf16x8*)(kp + d0 * 2048), k1 = *(const bf16x8*)(kp + d0 * 2048 + 512);
            s0 = MFMA32(k0, qr[d0], s0); s1 = MFMA32(k1, qr[d0], s1);
        }
    }
    float mx = -1e30f;
    if (fast) {
#pragma unroll
        for (int r = 0; r < 16; ++r) {
            const int c = (r & 3) + 8 * (r >> 2);
            s0[r] = fmaf(s0[r], 1.4426950408889634f, fmaf(sl, (float)c, bb)); s1[r] = fmaf(s1[r], 1.4426950408889634f, fmaf(sl, (float)(c + 32), bb));
            mx = fmaxf(mx, fmaxf(s0[r], s1[r]));
        }
    } else {
#pragma unroll
        for (int r = 0; r < 16; ++r) {
            const int c = (r & 3) + 8 * (r >> 2);
            const float t0 = fmaf(s0[r], 1.4426950408889634f, fmaf(sl, (float)c, bb)), t1 = fmaf(s1[r], 1.4426950408889634f, fmaf(sl, (float)(c + 32), bb));
            s0[r] = (c <= lh && c > ll) ? t0 : -INFINITY; s1[r] = (c + 32 <= lh && c + 32 > ll) ? t1 : -INFINITY;
            mx = fmaxf(mx, fmaxf(s0[r], s1[r]));
        }
    }
    mx = half_max(mx);
    const float mnew = fmaxf(m2, mx);
    const float f = __builtin_amdgcn_exp2f(m2 - mnew);
    m2 = mnew;
    float ps = 0.f;
#pragma unroll
    for (int r = 0; r < 16; ++r) { s0[r] = __builtin_amdgcn_exp2f(s0[r] - mnew); s1[r] = __builtin_amdgcn_exp2f(s1[r] - mnew); ps += s0[r] + s1[r]; }
    lsum = lsum * f + ps;
    if (__any(f != 1.f)) {
        if (hi == 0) *wsf_r = f;
        asm volatile("s_waitcnt lgkmcnt(0)" ::: "memory");
#pragma unroll
        for (int a = 0; a < 4; ++a) {
            const f32x4 fv = *(const f32x4*)(wsf_hi + 8 * a);
#pragma unroll
            for (int k = 0; k < 4; ++k) { o0[4 * a + k] *= fv[k]; o1[4 * a + k] *= fv[k]; }
        }
        asm volatile("s_waitcnt lgkmcnt(0)" ::: "memory");
    }
    u32x4 pw[4];
#pragma unroll
    for (int k = 0; k < 4; ++k) { pw[0][k] = cvtpk(s0[2 * k], s0[2 * k + 1]); pw[1][k] = cvtpk(s0[8 + 2 * k], s0[8 + 2 * k + 1]); pw[2][k] = cvtpk(s1[2 * k], s1[2 * k + 1]); pw[3][k] = cvtpk(s1[8 + 2 * k], s1[8 + 2 * k + 1]); }
    const lds_cptr vp = (lds_cptr)vimg + ((lane >> 4) & 1) * 32 + (lane & 3) * 8 + (4 * hi + ((lane & 15) >> 2)) * 64;
#pragma unroll
    for (int i = 0; i < 8; ++i) {
        const s16x4 lo = vtr(vp + ((i >> 2) * 4096 + (i & 3) * 1024)), hh = vtr(vp + ((i >> 2) * 4096 + (i & 3) * 1024 + 512));
        const bf16x8 vf = (bf16x8){lo[0], lo[1], lo[2], lo[3], hh[0], hh[1], hh[2], hh[3]};
        const bf16x8 pf = __builtin_bit_cast(bf16x8, pw[i & 3]);
        if (i < 4) o0 = MFMA32(pf, vf, o0); else o1 = MFMA32(pf, vf, o1);
    }
}

constexpr int NSA_KV0 = 0, NSA_KV1 = 16384, NSA_WSF = 32768, NSA_IMP = NSA_WSF + 2048, NSA_SEL = NSA_IMP + 16384, NSA_LIST = NSA_SEL + 512, NSA_OST = NSA_LIST + 256, NSA_YAC = NSA_OST + 32768, NSA_LDS = NSA_YAC + 65536;
static_assert(NSA_LDS <= 152 * 1024, "lds");

DEVI BlkDesc nsa_desc(const P& p, bool prompt, int b, int g, int branch, int j) {
    BlkDesc d;
    if (prompt) {
        if (branch == 0) { d.k = (const char*)(p.KC + ((size_t)(b * 64) * 512 + g * 64)); d.stride_bytes = 2048; d.f32 = 1; d.count = 64; d.pos0 = 0; }
        else { d.k = (const char*)(p.PROJ + ((size_t)b * 4096 + j * 64) * PS + (branch == 1 ? C_SLC : C_WIN) + g * 64); d.stride_bytes = PS * 2; d.f32 = 0; d.count = 64; d.pos0 = j * 64; }
    } else {
        if (branch == 0) { d.k = (const char*)(p.KC + ((size_t)(256 + b * 32) * 512 + g * 64)); d.stride_bytes = 2048; d.f32 = 1; d.count = 32; d.pos0 = 0; }
        else if (branch == 1 && j < 32) { const int page = p.page_table[b * 16 + (j >> 1)]; d.k = (const char*)(p.cache_slc + ((size_t)page * 128 + (j & 1) * 64) * 512 + g * 64); d.stride_bytes = 2048; d.f32 = 1; d.count = 64; d.pos0 = j * 64; }
        else if (branch == 2 && j < 8) { d.k = (const char*)(p.cache_win + ((size_t)b * 512 + j * 64) * 512 + g * 64); d.stride_bytes = 2048; d.f32 = 1; d.count = 64; d.pos0 = 1536 + j * 64; }
        else { d.k = (const char*)(p.PROJ + ((size_t)NTP + b * 4) * PS + (branch == 1 ? C_SLC : C_WIN) + g * 64); d.stride_bytes = PS * 2; d.f32 = 0; d.count = 4; d.pos0 = 2048; }
    }
    return d;
}

constexpr int NS_IMG = 0, NS_WSF = 131072, NS_IMP = NS_WSF + 2048, NS_SEL = NS_IMP + 2048, NS_LIST = NS_SEL + 64, NS_YC = NS_LIST + 64, NS_PM = NS_YC + 4096, NS_Q = NS_PM + 2048, NS_LDS = NS_Q + 4096;
static_assert(NS_LDS <= 152 * 1024, "lds");
DEVI void wave_stage_block(const BlkDesc& d, char* kimg, char* vimg, int lane) {
    asm volatile("" : "+v"(lane));
    const int rsub = lane >> 4, pc = lane & 15;
    if (d.f32) {
#pragma unroll
        for (int half = 0; half < 2; ++half) {
#pragma unroll
            for (int i0 = 0; i0 < 16; i0 += 6) {
                f32x4 x[6];
#pragma unroll
                for (int i = 0; i < 6; ++i) if (i0 + i < 16) { const int row = 4 * (i0 + i) + rsub; x[i] = row < d.count ? __builtin_nontemporal_load((const f32x4*)(d.k + (size_t)row * d.stride_bytes + half * 1024 + pc * 16)) : (f32x4){0.f, 0.f, 0.f, 0.f}; }
#pragma unroll
                for (int i = 0; i < 6; ++i) if (i0 + i < 16) {
                    const int row = 4 * (i0 + i) + rsub, c = pc >> 1;
                    u32x2 o; o.x = pack2(x[i][0], x[i][1]); o.y = pack2(x[i][2], x[i][3]);
                    if (half == 0) *(u32x2*)(kimg + c * 1024 + row * 16 + (pc & 1) * 8) = o;
                    else *(u32x2*)(vimg + (c >> 2) * 4096 + row * 64 + (c & 3) * 16 + (pc & 1) * 8) = o;
                }
            }
        }
    } else {
        const int row = lane >> 3, c = lane & 7;
#pragma unroll
        for (int i = 0; i < 8; ++i) {
            const int rr = 8 * i + row;
            u32x4 kk = {0u, 0u, 0u, 0u}, vv = {0u, 0u, 0u, 0u};
            if (rr < d.count) { kk = *(const u32x4*)(d.k + (size_t)rr * d.stride_bytes + c * 16); vv = *(const u32x4*)(d.k + (size_t)rr * d.stride_bytes + 512 + c * 16); }
            *(u32x4*)(kimg + c * 1024 + rr * 16) = kk;
            *(u32x4*)(vimg + (c >> 2) * 4096 + rr * 64 + (c & 3) * 16) = vv;
        }
    }
    asm volatile("s_waitcnt lgkmcnt(0)" ::: "memory");
}

DEVI void nsa_sample_unit(const P& p, char* smem, int us) {
    const int tid = tid_opq(), lane = tid & 63, wid = tid >> 6, r32 = lane & 31, hi = lane >> 5;
    const int b = us >> 2, g = us & 3;
    const size_t rowbase = (size_t)NTP + b * 4;
    char* kimg = smem + NS_IMG + wid * 16384; char* vimg = kimg + 8192;
    float* wsf = (float*)(smem + NS_WSF) + wid * 64;
    float* impb = (float*)(smem + NS_IMP);
    unsigned long long* selm = (unsigned long long*)(smem + NS_SEL);
    unsigned char* blist = (unsigned char*)(smem + NS_LIST);
    float* ycmp = (float*)(smem + NS_YC);
    const int tokl = r32 >> 2, head = r32 & 3;
    const bool tok_ok = r32 < 16;
    const int qpos = 2048 + tokl;
    const float slope2 = alibi_slope(g * 4 + head) * 1.4426950408889634f;
    char* qsh = smem + NS_Q;
    int hi4 = 4 * hi; asm volatile("" : "+v"(hi4));
    float* wsf_hi = wsf + hi4; float* wsf_r = wsf + r32;
    f32x16 s0, s1;
    __syncthreads();
    if (wid == 0) {
        bf16x8 qr[4];
        {
            const bf16_t* qp = p.PROJ + (rowbase + (tok_ok ? tokl : 0)) * PS + C_BQ + (g * 4 + head) * 64 + hi * 8;
#pragma unroll
            for (int d0 = 0; d0 < 4; ++d0) {
                u32x4 v = *(const u32x4*)(qp + d0 * 16);
#pragma unroll
                for (int k = 0; k < 4; ++k) { const float lo = __uint_as_float(v[k] << 16) * 0.125f, hh = __uint_as_float(v[k] & 0xFFFF0000u) * 0.125f; v[k] = tok_ok ? ((__float_as_uint(lo) >> 16) | (__float_as_uint(hh) & 0xFFFF0000u)) : 0u; }
                qr[d0] = __builtin_bit_cast(bf16x8, v);
                *(u32x4*)(qsh + d0 * 1024 + lane * 16) = v;
            }
        }
        f32x16 o0 = {}, o1 = {}; float m2 = -1e30f, lsum = 0.f;
        const BlkDesc d = nsa_desc(p, false, b, g, 0, 0);
        wave_stage_block(d, kimg, vimg, lane);
        const int lh = 31 - hi4;
        const float sl = 64.f * slope2;
        attn_tile(kimg, vimg, qr, m2, lsum, o0, o1, s0, s1, sl, tok_ok ? sl * (float)(hi4 - 32) : -INFINITY, lh, -1000, false, wsf_hi, wsf_r, lane);
        const float lt = half_sum(lsum);
        const float inv = lt > 0.f ? 1.f / lt : 0.f;
        unsigned x[64];
#pragma unroll
        for (int r = 0; r < 16; ++r) {
#pragma unroll
            for (int n = 0; n < 2; ++n) {
                float a = (n == 0 ? s0[r] : s1[r]) * inv;
                a += __shfl_xor(a, 1); a += __shfl_xor(a, 2);
                const int j = (r & 3) + 8 * (r >> 2) + 32 * n + hi4;
                if (j == 32 || j == 0) a = 5.0f;
                if (j > 32) a = -2.0f;
                const unsigned u = __float_as_uint(a);
                const unsigned o = (u & 0x80000000u) ? ~u : (u | 0x80000000u);
                x[n * 16 + r] = (o & ~63u) | (unsigned)(63 - j);
            }
        }
        float fac = 0.f;
        if (tok_ok && lt > 0.f) fac = sigmoidf_(p.SM[(rowbase + tokl) * 64 + 8 + g * 4 + head]) / lt;
        if (hi == 0) *wsf_r = fac;
        asm volatile("s_waitcnt lgkmcnt(0)" ::: "memory");
#pragma unroll
        for (int a = 0; a < 2; ++a) {
            const f32x4 fv = *(const f32x4*)(wsf_hi + 8 * a);
#pragma unroll
            for (int k = 0; k < 4; ++k) { float* yp = ycmp + (8 * a + k + hi4) * 64 + r32; yp[0] = o0[4 * a + k] * fv[k]; yp[32] = o1[4 * a + k] * fv[k]; }
        }
        asm volatile("s_waitcnt lgkmcnt(0)" ::: "memory");
        {
            sort16_desc<0>(x); sort16_desc<16>(x);
            unsigned th[16], oth[16], fin[16];
            merge_top16(&x[0], &x[16], th);
#pragma unroll
            for (int i = 0; i < 16; ++i) { auto rr = __builtin_amdgcn_permlane32_swap(th[i], th[i], false, false); oth[i] = hi ? rr[0] : rr[1]; }
            merge_top16(th, oth, fin);
            unsigned long long mask = 0ull;
#pragma unroll
            for (int i = 0; i < 16; ++i) mask |= 1ull << (63u - (fin[i] & 63u));
            if (head == 0 && hi == 0 && r32 < 16) selm[r32 >> 2] = mask;
        }
        asm volatile("s_waitcnt lgkmcnt(0)" ::: "memory");
        {
            const unsigned long long u = selm[0] | selm[1] | selm[2] | selm[3];
            const int n = __builtin_popcountll(u);
            if ((u >> lane) & 1ull) blist[1 + __builtin_popcountll(u & ((1ull << lane) - 1ull))] = (unsigned char)(0x40 | lane);
            if (lane <= 8) blist[1 + n + lane] = (unsigned char)(0x80 | lane);
            if (lane == 0) blist[0] = (unsigned char)(n + 9);
        }
    }
    __syncthreads();
    const int nb = blist[0];
    const unsigned long long mysel = tok_ok ? selm[tokl] : 0ull;
    int nslc = 0;
    for (int i = 0; i < nb; ++i) nslc += (blist[1 + i] >> 6) == 1 ? 1 : 0;
    float so[16], ms, lst;
    float wo[16], mw, lwt;
#pragma unroll 1
    for (int pass = 0; pass < 2; ++pass) {
        f32x16 o0 = {}, o1 = {}; float m2 = -1e30f, lsum = 0.f;
        const int i0 = pass == 0 ? 0 : nslc, i1 = pass == 0 ? nslc : nb;
#pragma unroll 1
        for (int i = i0 + wid; i < i1; i += 8) {
            const int e = blist[1 + i], br = e >> 6, j = e & 63;
            const BlkDesc d = nsa_desc(p, false, b, g, br, j);
            wave_stage_block(d, kimg, vimg, lane);
            asm volatile("" : "+v"(hi4));
            const bool lsel = tok_ok && (br == 2 || ((mysel >> j) & 1ull));
            const int rel = qpos - d.pos0;
            const int lh = (rel < d.count - 1 ? rel : d.count - 1) - hi4;
            const int ll = (br == 2 ? rel - 512 : -1000) - hi4;
            const bool fast = __all(!lsel || (lh >= 59 && ll < 0));
            const float bb = lsel ? slope2 * (float)(hi4 + d.pos0 - 2048) : -INFINITY;
            bf16x8 qr[4];
#pragma unroll
            for (int d0 = 0; d0 < 4; ++d0) qr[d0] = *(const bf16x8*)(qsh + d0 * 1024 + lane * 16);
            attn_tile(kimg, vimg, qr, m2, lsum, o0, o1, s0, s1, slope2, bb, lh, ll, fast, wsf_hi, wsf_r, lane);
        }
        const float lt = half_sum(lsum);
        if (pass == 0) { ms = m2; lst = lt;
#pragma unroll
            for (int r = 0; r < 8; ++r) { so[r] = o0[r]; so[8 + r] = o1[r]; } }
        else { mw = m2; lwt = lt;
#pragma unroll
            for (int r = 0; r < 8; ++r) { wo[r] = o0[r]; wo[8 + r] = o1[r]; } }
    }
    {
        float* po = (float*)kimg;
        float* pm = (float*)(smem + NS_PM) + wid * 64;
        if (lane < 16) { pm[lane * 2] = ms; pm[lane * 2 + 1] = lst; pm[32 + lane * 2] = mw; pm[32 + lane * 2 + 1] = lwt; }
#pragma unroll
        for (int a = 0; a < 2; ++a)
#pragma unroll
            for (int k = 0; k < 4; ++k) {
                float* yp = po + (8 * a + k + hi4) * 64 + r32;
                yp[0] = so[4 * a + k]; yp[32] = so[8 + 4 * a + k]; yp[1024] = wo[4 * a + k]; yp[1024 + 32] = wo[8 + 4 * a + k];
            }
    }
    __syncthreads();
    {
        const int row = tid >> 5, dcol = tid & 31, tk = row >> 2, hd = row & 3;
        float res[2][2];
#pragma unroll
        for (int br = 0; br < 2; ++br) {
            float M = -1e30f;
#pragma unroll
            for (int w = 0; w < 8; ++w) M = fmaxf(M, ((const float*)(smem + NS_PM))[w * 64 + br * 32 + row * 2]);
            float L = 0.f, a0 = 0.f, a1 = 0.f;
#pragma unroll
            for (int w = 0; w < 8; ++w) {
                const float* pmw = (const float*)(smem + NS_PM) + w * 64 + br * 32 + row * 2;
                const float f = __builtin_amdgcn_exp2f(pmw[0] - M);
                const float* pow_ = (const float*)(smem + NS_IMG + w * 16384) + br * 1024 + row * 64 + dcol;
                L += pmw[1] * f; a0 += pow_[0] * f; a1 += pow_[32] * f;
            }
            const float gate = sigmoidf_(p.SM[(rowbase + tk) * 64 + 8 + (br + 1) * 16 + g * 4 + hd]);
            const float sc = L > 0.f ? gate / L : 0.f;
            res[br][0] = a0 * sc; res[br][1] = a1 * sc;
        }
        const float y0 = ycmp[row * 64 + dcol] + res[0][0] + res[1][0], y1 = ycmp[row * 64 + dcol + 32] + res[0][1] + res[1][1];
        bf16_t* yb = p.YB + (rowbase + tk) * 1024 + (g * 4 + hd) * 64;
        yb[dcol] = f2bf(y0); yb[dcol + 32] = f2bf(y1);
    }
}

constexpr int NP_KVB = 18432, NP_KV0 = 0, NP_KV1 = NP_KVB, NP_WSF = 2 * NP_KVB, NP_IMP = NP_WSF + 2048, NP_SEL = NP_IMP + 16384, NP_LIST = NP_SEL + 512, NP_YAC = NP_LIST + 256, NP_LDS = NP_YAC + 65536;
static_assert(NP_LDS <= 152 * 1024, "lds");
DEVI void blk_store_ext(const BlkDesc& d, int pstep, int poff, int t0, char* kimg, char* vimg, int tid, const u32x4& rk, const u32x4& rv) {
    const int key = tid & 63, chunk = tid >> 6;
    *(u32x4*)(kimg + chunk * 1024 + key * 16) = rk;
    *(u32x4*)(vimg + (chunk >> 2) * 4096 + key * 64 + (chunk & 3) * 16) = rv;
    if (chunk == 0) {
        const int rel = d.pos0 + key * pstep + poff - t0;
        const int phi = (rel >> 6) << 6, plo = rel & 63;
        const unsigned bh = pack2((float)phi, (float)phi), bl = pack2((float)plo, (float)plo);
        *(u32x4*)(kimg + 8 * 1024 + key * 16) = (u32x4){bh, bl, 0x00003F80u, 0u};
    }
}
DEVI void attn_tile2(const char* kimg, const char* vimg, const bf16x8 (&qr)[4], const bf16x8 qext, float& m, float& lsum, f32x16& o0, f32x16& o1, f32x16& s0, f32x16& s1,
                     int lh, int ll, bool fast, float* wsf_hi, float* wsf_r, int lane) {
    const int r32 = lane & 31, hi = lane >> 5;
    const f32x16 z = {};
    s0 = z; s1 = z;
    {
        const char* kp = kimg + hi * 1024 + r32 * 16;
#pragma unroll
        for (int d0 = 0; d0 < 5; ++d0) {
            const bf16x8 k0 = *(const bf16x8*)(kp + d0 * 2048), k1 = *(const bf16x8*)(kp + d0 * 2048 + 512);
            const bf16x8 qf = d0 < 4 ? qr[d0 < 4 ? d0 : 0] : qext;
            s0 = MFMA32(k0, qf, s0); s1 = MFMA32(k1, qf, s1);
        }
    }
    if (!fast) {
#pragma unroll
        for (int r = 0; r < 16; ++r) {
            const int c = (r & 3) + 8 * (r >> 2);
            s0[r] = (c <= lh && c > ll) ? s0[r] : -INFINITY; s1[r] = (c + 32 <= lh && c + 32 > ll) ? s1[r] : -INFINITY;
        }
    }
    float mx = fmaxf(s0[0], s1[0]);
#pragma unroll
    for (int r = 1; r < 16; ++r) mx = fmaxf(mx, fmaxf(s0[r], s1[r]));
    mx = half_max(mx);
    const float mnew = fmaxf(m, mx);
    const float f = __builtin_amdgcn_exp2f((m - mnew) * 1.4426950408889634f);
    m = mnew;
    const float nm2 = -mnew * 1.4426950408889634f;
    float ps = 0.f;
#pragma unroll
    for (int r = 0; r < 16; ++r) { s0[r] = __builtin_amdgcn_exp2f(fmaf(s0[r], 1.4426950408889634f, nm2)); s1[r] = __builtin_amdgcn_exp2f(fmaf(s1[r], 1.4426950408889634f, nm2)); ps += s0[r] + s1[r]; }
    lsum = lsum * f + ps;
    if (__any(f != 1.f)) {
        if (hi == 0) *wsf_r = f;
        asm volatile("s_waitcnt lgkmcnt(0)" ::: "memory");
#pragma unroll
        for (int a = 0; a < 4; ++a) {
            const f32x4 fv = *(const f32x4*)(wsf_hi + 8 * a);
#pragma unroll
            for (int k = 0; k < 4; ++k) { o0[4 * a + k] *= fv[k]; o1[4 * a + k] *= fv[k]; }
        }
        asm volatile("s_waitcnt lgkmcnt(0)" ::: "memory");
    }
    u32x4 pw[4];
#pragma unroll
    for (int k = 0; k < 4; ++k) { pw[0][k] = cvtpk(s0[2 * k], s0[2 * k + 1]); pw[1][k] = cvtpk(s0[8 + 2 * k], s0[8 + 2 * k + 1]); pw[2][k] = cvtpk(s1[2 * k], s1[2 * k + 1]); pw[3][k] = cvtpk(s1[8 + 2 * k], s1[8 + 2 * k + 1]); }
    const lds_cptr vp = (lds_cptr)vimg + ((lane >> 4) & 1) * 32 + (lane & 3) * 8 + (4 * hi + ((lane & 15) >> 2)) * 64;
#pragma unroll
    for (int i = 0; i < 8; ++i) {
        const s16x4 lo = vtr(vp + ((i >> 2) * 4096 + (i & 3) * 1024)), hh = vtr(vp + ((i >> 2) * 4096 + (i & 3) * 1024 + 512));
        const bf16x8 vf = (bf16x8){lo[0], lo[1], lo[2], lo[3], hh[0], hh[1], hh[2], hh[3]};
        const bf16x8 pf = __builtin_bit_cast(bf16x8, pw[i & 3]);
        if (i < 4) o0 = MFMA32(pf, vf, o0); else o1 = MFMA32(pf, vf, o1);
    }
}

DEVI void attn_tile3(const char* kA, const char* vA, const char* kB, const char* vB, const bf16x8 (&qr)[4], const bf16x8 qeA, const bf16x8 qeB, float& m, float& lsum,
                     f32x16& o0, f32x16& o1, int lhA, int llA, bool fastA, int lhB, int llB, bool fastB, float* wsf_hi, float* wsf_r, int lane) {
    const int r32 = lane & 31, hi = lane >> 5;
    f32x16 a0 = {}, a1 = {}, b0 = {}, b1 = {};
    {
        const char* kpa = kA + hi * 1024 + r32 * 16; const char* kpb = kB + hi * 1024 + r32 * 16;
#pragma unroll
        for (int d0 = 0; d0 < 5; ++d0) {
            const bf16x8 ka0 = *(const bf16x8*)(kpa + d0 * 2048), ka1 = *(const bf16x8*)(kpa + d0 * 2048 + 512);
            const bf16x8 kb0 = *(const bf16x8*)(kpb + d0 * 2048), kb1 = *(const bf16x8*)(kpb + d0 * 2048 + 512);
            const bf16x8 qa = d0 < 4 ? qr[d0 < 4 ? d0 : 0] : qeA, qb = d0 < 4 ? qr[d0 < 4 ? d0 : 0] : qeB;
            a0 = MFMA32(ka0, qa, a0); a1 = MFMA32(ka1, qa, a1); b0 = MFMA32(kb0, qb, b0); b1 = MFMA32(kb1, qb, b1);
        }
    }
    if (!fastA) {
#pragma unroll
        for (int r = 0; r < 16; ++r) { const int c = (r & 3) + 8 * (r >> 2); a0[r] = (c <= lhA && c > llA) ? a0[r] : -INFINITY; a1[r] = (c + 32 <= lhA && c + 32 > llA) ? a1[r] : -INFINITY; }
    }
    if (!fastB) {
#pragma unroll
        for (int r = 0; r < 16; ++r) { const int c = (r & 3) + 8 * (r >> 2); b0[r] = (c <= lhB && c > llB) ? b0[r] : -INFINITY; b1[r] = (c + 32 <= lhB && c + 32 > llB) ? b1[r] : -INFINITY; }
    }
    float mx = fmaxf(fmaxf(a0[0], a1[0]), fmaxf(b0[0], b1[0]));
#pragma unroll
    for (int r = 1; r < 16; ++r) mx = fmaxf(mx, fmaxf(fmaxf(a0[r], a1[r]), fmaxf(b0[r], b1[r])));
    mx = half_max(mx);
    const float mnew = fmaxf(m, mx);
    const float f = __builtin_amdgcn_exp2f((m - mnew) * 1.4426950408889634f);
    m = mnew;
    const float nm2 = -mnew * 1.4426950408889634f;
    float ps = 0.f;
#pragma unroll
    for (int r = 0; r < 16; ++r) {
        a0[r] = __builtin_amdgcn_exp2f(fmaf(a0[r], 1.4426950408889634f, nm2)); a1[r] = __builtin_amdgcn_exp2f(fmaf(a1[r], 1.4426950408889634f, nm2));
        b0[r] = __builtin_amdgcn_exp2f(fmaf(b0[r], 1.4426950408889634f, nm2)); b1[r] = __builtin_amdgcn_exp2f(fmaf(b1[r], 1.4426950408889634f, nm2));
        ps += (a0[r] + a1[r]) + (b0[r] + b1[r]);
    }
    lsum = lsum * f + ps;
    if (__any(f != 1.f)) {
        if (hi == 0) *wsf_r = f;
        asm volatile("s_waitcnt lgkmcnt(0)" ::: "memory");
#pragma unroll
        for (int a = 0; a < 4; ++a) {
            const f32x4 fv = *(const f32x4*)(wsf_hi + 8 * a);
#pragma unroll
            for (int k = 0; k < 4; ++k) { o0[4 * a + k] *= fv[k]; o1[4 * a + k] *= fv[k]; }
        }
        asm volatile("s_waitcnt lgkmcnt(0)" ::: "memory");
    }
    const int voff = ((lane >> 4) & 1) * 32 + (lane & 3) * 8 + (4 * hi + ((lane & 15) >> 2)) * 64;
#pragma unroll
    for (int t = 0; t < 2; ++t) {
        const f32x16& p0 = t == 0 ? a0 : b0; const f32x16& p1 = t == 0 ? a1 : b1;
        u32x4 pw[4];
#pragma unroll
        for (int k = 0; k < 4; ++k) { pw[0][k] = cvtpk(p0[2 * k], p0[2 * k + 1]); pw[1][k] = cvtpk(p0[8 + 2 * k], p0[8 + 2 * k + 1]); pw[2][k] = cvtpk(p1[2 * k], p1[2 * k + 1]); pw[3][k] = cvtpk(p1[8 + 2 * k], p1[8 + 2 * k + 1]); }
        const lds_cptr vp = (lds_cptr)(t == 0 ? vA : vB) + voff;
#pragma unroll
        for (int i = 0; i < 8; ++i) {
            const s16x4 lo = vtr(vp + ((i >> 2) * 4096 + (i & 3) * 1024)), hh = vtr(vp + ((i >> 2) * 4096 + (i & 3) * 1024 + 512));
            const bf16x8 vf = (bf16x8){lo[0], lo[1], lo[2], lo[3], hh[0], hh[1], hh[2], hh[3]};
            const bf16x8 pf = __builtin_bit_cast(bf16x8, pw[i & 3]);
            if (i < 4) o0 = MFMA32(pf, vf, o0); else o1 = MFMA32(pf, vf, o1);
        }
    }
}

constexpr int NQ_KVB = 18432, NQ_WSF = 4 * NQ_KVB, NQ_SEL = NQ_WSF + 2048, NQ_LIST = NQ_SEL + 512, NQ_YAC = NQ_LIST + 256, NQ_LDS = NQ_YAC + 65536, NQ_IMP = 2 * NQ_KVB;
static_assert(NQ_LDS <= 152 * 1024, "lds");
DEVI void nsa_prompt_unit(const P& p, char* smem, int b, int g, int qt) {
    const int tid = tid_opq(), lane = tid & 63, wid = tid >> 6, r32 = lane & 31, hi = lane >> 5;
    float* wsf = (float*)(smem + NQ_WSF) + wid * 64;
    float* impb = (float*)(smem + NQ_IMP) + wid * 512;
    unsigned long long* selm = (unsigned long long*)(smem + NQ_SEL);
    unsigned char* blist = (unsigned char*)(smem + NQ_LIST);
    const int t0 = qt * 64;
    const size_t rowbase = (size_t)b * 4096 + t0;
    const int tokl = wid * 8 + (r32 >> 2), head = r32 & 3;
    const int qpos = t0 + tokl;
    const float slope = alibi_slope(g * 4 + head);
    bf16x8 qr[4];
    {
        const bf16_t* qp = p.PROJ + (rowbase + tokl) * PS + C_BQ + (g * 4 + head) * 64 + hi * 8;
#pragma unroll
        for (int d0 = 0; d0 < 4; ++d0) {
            u32x4 v = *(const u32x4*)(qp + d0 * 16);
#pragma unroll
            for (int k = 0; k < 4; ++k) { const float lo = __uint_as_float(v[k] << 16) * 0.125f, hh = __uint_as_float(v[k] & 0xFFFF0000u) * 0.125f; v[k] = (__float_as_uint(lo) >> 16) | (__float_as_uint(hh) & 0xFFFF0000u); }
            qr[d0] = __builtin_bit_cast(bf16x8, v);
        }
    }
    unsigned qe_w;
    { const unsigned sh = (unsigned)f2bf(slope); const float rem = slope - __uint_as_float(sh << 16); qe_w = sh | ((unsigned)f2bf(rem) << 16); if (hi) qe_w = 0u; }
    int hi4 = 4 * hi; asm volatile("" : "+v"(hi4));
    float* yl = (float*)(smem + NQ_YAC) + wid * 2048 + hi4 * 64 + r32;
    float* wsf_hi = wsf + hi4; float* wsf_r = wsf + r32;
    f32x16 o0, o1; float m, lsum;
    auto finish = [&](int br) {
        const float lt = half_sum(lsum);
        float fac = 0.f;
        if (lt > 0.f) fac = sigmoidf_(p.SM[(rowbase + tokl) * 64 + 8 + br * 16 + g * 4 + head]) / lt;
        if (hi == 0) *wsf_r = fac;
        asm volatile("s_waitcnt lgkmcnt(0)" ::: "memory");
#pragma unroll
        for (int a = 0; a < 4; ++a) {
            const f32x4 fv = *(const f32x4*)(wsf_hi + 8 * a);
#pragma unroll
            for (int k = 0; k < 4; ++k) {
                float* yp = yl + (8 * a + k) * 64;
                if (br == 0) { yp[0] = o0[4 * a + k] * fv[k]; yp[32] = o1[4 * a + k] * fv[k]; }
                else { yp[0] += o0[4 * a + k] * fv[k]; yp[32] += o1[4 * a + k] * fv[k]; }
            }
        }
        asm volatile("s_waitcnt lgkmcnt(0)" ::: "memory");
    };
    __syncthreads();
    if (tid < 64) *(u32x4*)(smem + 9 * 1024 + tid * 16) = (u32x4){0u, 0u, 0u, 0u};
    {
        const BlkDesc d = nsa_desc(p, true, b, g, 0, 0);
        u32x4 rk, rv; blk_load(d, tid, rk, rv); blk_store_ext(d, 64, 63, t0, smem, smem + 10240, tid, rk, rv);
        __syncthreads();
        o0 = (f32x16){}; o1 = (f32x16){}; m = -1e30f; lsum = 0.f;
        f32x16 s0, s1;
        {
            const int nv = ((qpos + 1) >> 6) - 1;
            const int lh = (nv < 63 ? nv : 63) - hi4;
            const bf16x8 qext = __builtin_bit_cast(bf16x8, (u32x4){qe_w, qe_w, 0u, 0u});
            attn_tile2(smem, smem + 10240, qr, qext, m, lsum, o0, o1, s0, s1, lh, -1000, false, wsf_hi, wsf_r, lane);
        }
        const float lt = half_sum(lsum);
        const float inv = lt > 0.f ? 1.f / lt : 0.f;
        unsigned x[64];
#pragma unroll
        for (int r = 0; r < 16; ++r) {
#pragma unroll
            for (int n = 0; n < 2; ++n) {
                float a = (n == 0 ? s0[r] : s1[r]) * inv;
                a += __shfl_xor(a, 1); a += __shfl_xor(a, 2);
                const int j = (r & 3) + 8 * (r >> 2) + 32 * n + hi4;
                if (j == qt || j == 0) a = 5.0f;
                if (j > qt) a = -1.0f;
                const unsigned u = __float_as_uint(a);
                const unsigned o = (u & 0x80000000u) ? ~u : (u | 0x80000000u);
                x[n * 16 + r] = (o & ~63u) | (unsigned)(63 - j);
            }
        }
        finish(0);
        sort16_desc<0>(x); sort16_desc<16>(x);
        unsigned th[16], oth[16], fin[16];
        merge_top16(&x[0], &x[16], th);
#pragma unroll
        for (int i = 0; i < 16; ++i) { auto rr = __builtin_amdgcn_permlane32_swap(th[i], th[i], false, false); oth[i] = hi ? rr[0] : rr[1]; }
        merge_top16(th, oth, fin);
        unsigned long long mask = 0ull;
#pragma unroll
        for (int i = 0; i < 16; ++i) mask |= 1ull << (63u - (fin[i] & 63u));
        if (head == 0 && hi == 0) selm[wid * 8 + (r32 >> 2)] = mask;
    }
    __syncthreads();
    if (wid == 0) {
        unsigned long long u = selm[lane];
#pragma unroll
        for (int o = 32; o > 0; o >>= 1) u |= __shfl_xor(u, o);
        u &= (qt == 63) ? ~0ull : ((1ull << (qt + 1)) - 1ull);
        {
            const int n = __builtin_popcountll(u);
            if ((u >> lane) & 1ull) blist[2 + __builtin_popcountll(lane < 63 ? (u >> (lane + 1)) : 0ull)] = (unsigned char)lane;
            const int w0 = qt - 8 > 0 ? qt - 8 : 0, nw = qt - w0 + 1;
            if (lane < nw) blist[2 + n + lane] = (unsigned char)(qt - lane);
            if (lane == 0) { blist[0] = (unsigned char)n; blist[1] = (unsigned char)nw; }
        }
    }
    __syncthreads();
    if (tid >= 64 && tid < 256) *(u32x4*)(smem + (tid >> 6) * NQ_KVB + 9 * 1024 + (tid & 63) * 16) = (u32x4){0u, 0u, 0u, 0u};
    const int ns = blist[0], nw = blist[1];
    const int nss = (ns + 1) >> 1, nsteps = nss + ((nw + 1) >> 1);
    const unsigned long long mysel = selm[tokl];
    {
        auto step_blocks = [&](int s, int& br, int& jA, int& jB) {
            if (s < nss) { br = 1; jA = blist[2 + 2 * s]; jB = 2 * s + 1 < ns ? (int)blist[2 + 2 * s + 1] : -1; }
            else { const int w = s - nss; br = 2; jA = blist[2 + ns + 2 * w]; jB = 2 * w + 1 < nw ? (int)blist[2 + ns + 2 * w + 1] : -1; }
        };
        u32x4 rkA, rvA, rkB, rvB;
        auto load_step = [&](int s) {
            int br, jA, jB; step_blocks(s, br, jA, jB);
            const BlkDesc dA = nsa_desc(p, true, b, g, br, jA); blk_load(dA, tid, rkA, rvA);
            if (jB >= 0) { const BlkDesc dB = nsa_desc(p, true, b, g, br, jB); blk_load(dB, tid, rkB, rvB); }
        };
        auto store_step = [&](int s, char* buf) {
            int br, jA, jB; step_blocks(s, br, jA, jB);
            BlkDesc dA; dA.pos0 = jA * 64; blk_store_ext(dA, 1, 0, t0, buf, buf + 10240, tid, rkA, rvA);
            if (jB >= 0) { BlkDesc dB; dB.pos0 = jB * 64; blk_store_ext(dB, 1, 0, t0, buf + NQ_KVB, buf + NQ_KVB + 10240, tid, rkB, rvB); }
        };
        load_step(0); store_step(0, smem);
        __syncthreads();
        int prev_br = 1;
        o0 = (f32x16){}; o1 = (f32x16){}; m = -1e30f; lsum = 0.f;
        for (int s = 0; s < nsteps; ++s) {
            int br, jA, jB; step_blocks(s, br, jA, jB);
            char* cur = smem + (s & 1) * 2 * NQ_KVB;
            char* nxt = smem + ((s & 1) ^ 1) * 2 * NQ_KVB;
            if (s + 1 < nsteps) load_step(s + 1);
            if (br != prev_br) { finish(1); o0 = (f32x16){}; o1 = (f32x16){}; m = -1e30f; lsum = 0.f; prev_br = br; }
            {
                asm volatile("" : "+v"(hi4));
                const bool lselA = br == 2 || ((mysel >> jA) & 1ull);
                const int relA = qpos - jA * 64;
                const int lhA = (relA < 63 ? relA : 63) - hi4, llA = (br == 2 ? relA - 512 : -1000) - hi4;
                const bool fastA = __all(!lselA || (lhA >= 59 && llA < 0));
                const bool needA = __any(lselA && lhA + hi4 >= 0 && llA + hi4 < 63);
                const bf16x8 qeA = __builtin_bit_cast(bf16x8, (u32x4){qe_w, qe_w, (lselA || hi) ? 0u : 0x0000C6EAu, 0u});
                bool needB = false; bool lselB = false; int lhB = -1000, llB = -1000; bool fastB = false;
                if (jB >= 0) {
                    lselB = br == 2 || ((mysel >> jB) & 1ull);
                    const int relB = qpos - jB * 64;
                    lhB = (relB < 63 ? relB : 63) - hi4; llB = (br == 2 ? relB - 512 : -1000) - hi4;
                    fastB = __all(!lselB || (lhB >= 59 && llB < 0));
                    needB = __any(lselB && lhB + hi4 >= 0 && llB + hi4 < 63);
                }
                const bf16x8 qeB = __builtin_bit_cast(bf16x8, (u32x4){qe_w, qe_w, (lselB || hi) ? 0u : 0x0000C6EAu, 0u});
                f32x16 s0, s1;
                if (needA && needB) attn_tile3(cur, cur + 10240, cur + NQ_KVB, cur + NQ_KVB + 10240, qr, qeA, qeB, m, lsum, o0, o1, lhA, llA, fastA, lhB, llB, fastB, wsf_hi, wsf_r, lane);
                else if (needA) attn_tile2(cur, cur + 10240, qr, qeA, m, lsum, o0, o1, s0, s1, lhA, llA, fastA, wsf_hi, wsf_r, lane);
                else if (needB) attn_tile2(cur + NQ_KVB, cur + NQ_KVB + 10240, qr, qeB, m, lsum, o0, o1, s0, s1, lhB, llB, fastB, wsf_hi, wsf_r, lane);
            }
            if (s + 1 < nsteps) store_step(s + 1, nxt);
            __syncthreads();
        }
        finish(2);
    }
    {
        const float* yac = (const float*)(smem + NQ_YAC) + wid * 2048;
#pragma unroll
        for (int i = 0; i < 4; ++i) {
            const int orow = i * 8 + (lane >> 3), ch = lane & 7, tk = wid * 8 + (orow >> 2), hd = orow & 3;
            const f32x4 a = *(const f32x4*)(yac + orow * 64 + ch * 8), c = *(const f32x4*)(yac + orow * 64 + ch * 8 + 4);
            *(u32x4*)(p.YB + (rowbase + tk) * 1024 + (g * 4 + hd) * 64 + ch * 8) = pack8f(a, c);
        }
        asm volatile("s_waitcnt lgkmcnt(0)" ::: "memory");
    }
}

DEVI void stage_nsa_attn(const P& p, char* smem, int bid, int nblk) {
    (void)bid; (void)nblk;
    unsigned* head = p.bar + 3840;
    volatile unsigned* slot = (volatile unsigned*)(smem + 150 * 1024);
    for (;;) {
        __syncthreads();
        if (tid_opq() == 0) *slot = __hip_atomic_fetch_add(head, 1u, __ATOMIC_RELAXED, __HIP_MEMORY_SCOPE_AGENT);
        __syncthreads();
        const unsigned i = *slot;
        if (i >= 1536u) break;
        if (i < 1024u) nsa_prompt_unit(p, smem, (int)((i & 15u) >> 2), (int)(i & 3u), 63 - (int)(i >> 4));
        else nsa_sample_unit(p, smem, (int)i - 1024);
    }
}

DEVI void stage_ln1(const P& p, int bid, int nblk) {
    const int lane = tid_opq() & 63, wid = tid_opq() >> 6;
    for (int row = bid * 8 + wid; row < NT; row += nblk * 8) {
        f32x4 x[4];
        float s = 0.f;
#pragma unroll
        for (int i = 0; i < 4; ++i) { x[i] = *(const f32x4*)(p.R + (size_t)row * 1024 + i * 256 + lane * 4); s += x[i][0] + x[i][1] + x[i][2] + x[i][3]; }
        const float mean = wave_sum(s) * (1.f / 1024.f);
        float q = 0.f;
#pragma unroll
        for (int i = 0; i < 4; ++i)
#pragma unroll
            for (int k = 0; k < 4; ++k) q += (x[i][k] - mean) * (x[i][k] - mean);
        const float rs = rsqrtf(wave_sum(q) * (1.f / 1024.f) + LN_EPS);
#pragma unroll
        for (int i = 0; i < 4; ++i) {
            const int c = i * 256 + lane * 4;
            const f32x4 gg = *(const f32x4*)(p.ln1_g + c), bb = *(const f32x4*)(p.ln1_b + c);
            f32x4 y;
#pragma unroll
            for (int k = 0; k < 4; ++k) y[k] = (x[i][k] - mean) * rs * gg[k] + bb[k];
            u32x2 o; o.x = pack2(y[0], y[1]); o.y = pack2(y[2], y[3]);
            *(u32x2*)(p.HB + (size_t)row * 1024 + c) = o;
        }
        if (lane == 0) { p.H[(size_t)row * 2] = mean; p.H[(size_t)row * 2 + 1] = rs; }
    }
}

__device__ const unsigned char PEER_CA[50] = {0,0,0,0,0,0,0,0,0,0,0,0,0,0,0,0, 1,1,1,1,1,1,1,1, 2,2,2,2,2, 3,3,3,3, 4,4,4, 5,5, 6,6, 7,7, 8,9,10,11,12,13,14,15};
__device__ const unsigned char PEER_CB[50] = {0,1,2,3,4,5,6,7,8,9,10,11,12,13,14,15, 0,1,2,3,4,5,6,7, 0,1,2,3,4, 0,1,2,3, 0,1,2, 0,1, 0,1, 0,1, 0,0,0,0,0,0,0,0};

DEVI float key_score(unsigned k) { const unsigned u = k & ~127u; return __uint_as_float((u & 0x80000000u) ? (u & 0x7FFFFFFFu) : ~u); }

DEVI void sort8_desc(unsigned (&x)[16]) {
#pragma unroll
    for (int k = 2; k <= 8; k <<= 1)
#pragma unroll
        for (int j = k >> 1; j > 0; j >>= 1)
#pragma unroll
            for (int i = 0; i < 8; ++i) {
                const int l = i ^ j;
                if (l > i) { if ((i & k) == 0) ce_desc(x[i], x[l]); else ce_desc(x[l], x[i]); }
            }
}
DEVI unsigned sum_key(unsigned ka, unsigned kb, unsigned tag) {
    const unsigned u = __float_as_uint(key_score(ka) + key_score(kb));
    const unsigned o = (u & 0x80000000u) ? ~u : (u | 0x80000000u);
    return (o & ~255u) | tag;
}
DEVI float key_score8(unsigned k) { const unsigned u = k & ~255u; return __uint_as_float((u & 0x80000000u) ? (u & 0x7FFFFFFFu) : ~u); }

DEVI void route_top16(const P& p, int row, int ph, int c, int r32, int hi, int hi4, unsigned (&fin)[16]) {
    f32x16 acc[4];
#pragma unroll
    for (int t = 0; t < 4; ++t) acc[t] = (f32x16){};
    const bf16_t* qp = p.PQ + (size_t)row * 2048 + ph * 256 + c * 128 + hi * 8;
    const bf16_t* kp = p.KEYSB + ((size_t)((ph * 2 + c) * 128 + r32)) * 128 + hi * 8;
#pragma unroll
    for (int s8 = 0; s8 < 8; ++s8) {
        const bf16x8 qf = *(const bf16x8*)(qp + s8 * 16);
#pragma unroll
        for (int t = 0; t < 4; ++t) {
            const bf16x8 kf = *(const bf16x8*)(kp + (size_t)t * 32 * 128 + s8 * 16);
            acc[t] = MFMA32(kf, qf, acc[t]);
        }
    }
    unsigned x[64];
#pragma unroll
    for (int t = 0; t < 4; ++t)
#pragma unroll
        for (int r = 0; r < 16; ++r) {
            const unsigned u = __float_as_uint(acc[t][r]);
            const unsigned o = (u & 0x80000000u) ? ~u : (u | 0x80000000u);
            x[t * 16 + r] = (o & ~127u) | (unsigned)(127 - ((r & 3) + 8 * (r >> 2) + 32 * t) - hi4);
        }
    sort16_desc<0>(x); sort16_desc<16>(x); sort16_desc<32>(x); sort16_desc<48>(x);
    unsigned t01[16], t23[16], tt[16], oth[16];
    merge_top16(&x[0], &x[16], t01); merge_top16(&x[32], &x[48], t23); merge_top16(t01, t23, tt);
#pragma unroll
    for (int i = 0; i < 16; ++i) { auto rr = __builtin_amdgcn_permlane32_swap(tt[i], tt[i], false, false); oth[i] = hi ? rr[0] : rr[1]; }
    merge_top16(tt, oth, fin);
}

DEVI void stage_peer_route(const P& p, char* smem, int bid, int nblk, int p0, int p1) {
    const int lane = tid_opq() & 63, wid = tid_opq() >> 6, r32 = lane & 31, hi = lane >> 5;
    unsigned char* tb = (unsigned char*)smem + wid * 1024 + r32 * 32;
    const int tpw = (NT + nblk - 1) / nblk, row_lo = bid * tpw, row_hi = (row_lo + tpw < NT) ? row_lo + tpw : NT;
    const int ph = wid;
    for (int pass = p0; pass < p1 && row_lo + pass * 32 < row_hi; ++pass) {
        const int row_raw = row_lo + pass * 32 + r32;
        const bool row_ok = row_raw < row_hi;
        const int row = row_ok ? row_raw : row_lo;
        int hi4 = 4 * hi; asm volatile("" : "+v"(hi4));
        unsigned fa[16], fb[16];
        route_top16(p, row, ph, 0, r32, hi, hi4, fa);
        asm volatile("" : "+v"(hi4));
        route_top16(p, row, ph, 1, r32, hi, hi4, fb);
        if (hi == 0) {
            u32x4 wa, wb;
#pragma unroll
            for (int i = 0; i < 4; ++i) {
                wa[i] = (127u - (fa[4 * i] & 127u)) | ((127u - (fa[4 * i + 1] & 127u)) << 8) | ((127u - (fa[4 * i + 2] & 127u)) << 16) | ((127u - (fa[4 * i + 3] & 127u)) << 24);
                wb[i] = (127u - (fb[4 * i] & 127u)) | ((127u - (fb[4 * i + 1] & 127u)) << 8) | ((127u - (fb[4 * i + 2] & 127u)) << 16) | ((127u - (fb[4 * i + 3] & 127u)) << 24);
            }
            *(u32x4*)tb = wa; *(u32x4*)(tb + 16) = wb;
        }
        unsigned g0[16], g1[16], g2[16], g3[16];
#pragma unroll
        for (int j = 0; j < 16; ++j) g0[j] = sum_key(fa[0], fb[j], (unsigned)j);
#pragma unroll
        for (int k = 0; k < 15; ++k) g1[k] = sum_key(fa[k + 1], fb[0], (unsigned)((k + 1) << 4));
        g1[15] = 0u;
#pragma unroll
        for (int j = 1; j < 8; ++j) g2[j - 1] = sum_key(fa[1], fb[j], (unsigned)(16 | j));
        g2[7] = 0u; g2[8] = 0u; g2[9] = 0u;
#pragma unroll
        for (int i = 2; i < 8; ++i) g2[17 - i] = sum_key(fa[i], fb[1], (unsigned)((i << 4) | 1));
#pragma unroll
        for (int j = 8; j > 0; j >>= 1)
#pragma unroll
            for (int i = 0; i < 16; ++i) { const int l = i ^ j; if (l > i) ce_desc(g2[i], g2[l]); }
        g3[0] = sum_key(fa[2], fb[2], 0x22u); g3[1] = sum_key(fa[2], fb[3], 0x23u); g3[2] = sum_key(fa[2], fb[4], 0x24u);
        g3[3] = sum_key(fa[3], fb[2], 0x32u); g3[4] = sum_key(fa[4], fb[2], 0x42u); g3[5] = sum_key(fa[3], fb[3], 0x33u);
#pragma unroll
        for (int i = 6; i < 16; ++i) g3[i] = 0u;
        sort8_desc(g3);
        unsigned t01[16], t23[16], top[16];
        merge_top16(g0, g1, t01); merge_top16(g2, g3, t23); merge_top16(t01, t23, top);
        float ev[16]; float sum = 0.f;
        const float vmax = key_score8(top[0]);
#pragma unroll
        for (int k = 0; k < 16; ++k) { ev[k] = __expf(key_score8(top[k]) - vmax); sum += ev[k]; }
        const float inv = 1.f / sum;
        asm volatile("s_waitcnt lgkmcnt(0)" ::: "memory");
        if (!row_ok) {   } else if (hi == 0) {
            int* dst = p.EIDX + (size_t)row * 128 + ph * 16;
#pragma unroll
            for (int q4 = 0; q4 < 4; ++q4) {
                u32x4 o;
#pragma unroll
                for (int k = 0; k < 4; ++k) { const unsigned tg = top[q4 * 4 + k] & 255u; o[k] = (unsigned)tb[tg >> 4] * 128u + (unsigned)tb[16 + (tg & 15u)]; }
                *(u32x4*)(dst + q4 * 4) = o;
            }
        } else {
            float* dst = p.EGATE + (size_t)row * 128 + ph * 16;
#pragma unroll
            for (int q4 = 0; q4 < 4; ++q4) *(f32x4*)(dst + q4 * 4) = (f32x4){ev[q4 * 4] * inv, ev[q4 * 4 + 1] * inv, ev[q4 * 4 + 2] * inv, ev[q4 * 4 + 3] * inv};
        }
        asm volatile("s_waitcnt lgkmcnt(0)" ::: "memory");
    }
}

constexpr int PA_WAVE_LDS = 1024 + 1024 + 512 + 512 + 512;
DEVI void stage_peer_apply(const P& p, char* smem, int bid, int nblk, int p0, int p1) {
    const int lane = tid_opq() & 63, wid = tid_opq() >> 6;
    char* wl = smem + wid * PA_WAVE_LDS;
    unsigned char* hhi = (unsigned char*)wl; unsigned char* hlo = hhi + 1024;
    int* idxs = (int*)(wl + 2048);
    float* gts = (float*)(wl + 2560);
    float* cs = (float*)(wl + 3072);
    const int fr = lane & 15, fq = lane >> 4;
    const int tpw = (NT + nblk - 1) / nblk, row_lo = bid * tpw, row_hi = (row_lo + tpw < NT) ? row_lo + tpw : NT;
    for (int row = row_lo + p0 * 32 + wid; row < row_hi && row < row_lo + p1 * 32; row += 8) {
        float hv[16];
        {
            const float* hr = p.R + (size_t)row * 1024 + lane * 16;
            const float mean1 = p.H[(size_t)row * 2], rs1 = p.H[(size_t)row * 2 + 1];
            u32x4 ohi, olo;
#pragma unroll
            for (int i = 0; i < 4; ++i) {
                f32x4 x = *(const f32x4*)(hr + i * 4);
                { const f32x4 g1 = *(const f32x4*)(p.ln1_g + lane * 16 + i * 4), b1 = *(const f32x4*)(p.ln1_b + lane * 16 + i * 4);
#pragma unroll
                  for (int k = 0; k < 4; ++k) x[k] = (x[k] - mean1) * rs1 * g1[k] + b1[k]; }
#pragma unroll
                for (int k = 0; k < 4; ++k) hv[i * 4 + k] = x[k];
                int w = __builtin_amdgcn_cvt_pk_fp8_f32(x[0], x[1], 0, false); w = __builtin_amdgcn_cvt_pk_fp8_f32(x[2], x[3], w, true);
                const f32x2 d01 = __builtin_amdgcn_cvt_pk_f32_fp8(w, false), d23 = __builtin_amdgcn_cvt_pk_f32_fp8(w, true);
                int w2 = __builtin_amdgcn_cvt_pk_fp8_f32(x[0] - d01[0], x[1] - d01[1], 0, false); w2 = __builtin_amdgcn_cvt_pk_fp8_f32(x[2] - d23[0], x[3] - d23[1], w2, true);
                ohi[i] = (unsigned)w; olo[i] = (unsigned)w2;
            }
            *(u32x4*)(hhi + lane * 16) = ohi; *(u32x4*)(hlo + lane * 16) = olo;
            idxs[lane] = p.EIDX[(size_t)row * 128 + lane]; idxs[lane + 64] = p.EIDX[(size_t)row * 128 + 64 + lane];
            gts[lane] = p.EGATE[(size_t)row * 128 + lane]; gts[lane + 64] = p.EGATE[(size_t)row * 128 + 64 + lane];
            asm volatile("s_waitcnt lgkmcnt(0)" ::: "memory");
        }
        {
            u32x4 a0[16], a1[16];
            auto issue_u = [&](int g, u32x4 (&a)[16]) {
                const unsigned char* ub = p.U8 + (size_t)idxs[g * 16 + fr] * 1024 + fq * 16;
#pragma unroll
                for (int s2 = 0; s2 < 16; ++s2) a[s2] = *(const u32x4*)(ub + s2 * 64);
            };
            auto consume_u = [&](int g, const u32x4 (&a)[16]) {
                f32x4 acc = (f32x4){0.f, 0.f, 0.f, 0.f};
#pragma unroll
                for (int s2 = 0; s2 < 16; ++s2) {
                    const u32x4 bh = *(const u32x4*)(hhi + s2 * 64 + fq * 16), bl = *(const u32x4*)(hlo + s2 * 64 + fq * 16);
                    const long x0 = (long)(((unsigned long long)a[s2][1] << 32) | a[s2][0]), x1 = (long)(((unsigned long long)a[s2][3] << 32) | a[s2][2]);
                    const long h0 = (long)(((unsigned long long)bh[1] << 32) | bh[0]), h1 = (long)(((unsigned long long)bh[3] << 32) | bh[2]);
                    const long l0 = (long)(((unsigned long long)bl[1] << 32) | bl[0]), l1 = (long)(((unsigned long long)bl[3] << 32) | bl[2]);
                    acc = __builtin_amdgcn_mfma_f32_16x16x32_fp8_fp8(x0, h0, acc, 0, 0, 0);
                    acc = __builtin_amdgcn_mfma_f32_16x16x32_fp8_fp8(x1, h1, acc, 0, 0, 0);
                    acc = __builtin_amdgcn_mfma_f32_16x16x32_fp8_fp8(x0, l0, acc, 0, 0, 0);
                    acc = __builtin_amdgcn_mfma_f32_16x16x32_fp8_fp8(x1, l1, acc, 0, 0, 0);
                }
                const f32x4 gg = *(const f32x4*)(gts + g * 16 + fq * 4);
                f32x4 cv;
#pragma unroll
                for (int r = 0; r < 4; ++r) {
                    const int e = idxs[g * 16 + fq * 4 + r];
                    const float d = acc[r] * p.US[e];
                    cv[r] = gg[r] * p.VS[e] * gelu_erf(d);
                }
                if (fr == 0) *(f32x4*)(cs + g * 16 + fq * 4) = cv;
            };
            issue_u(0, a0);
#pragma unroll 1
            for (int g = 0; g < 8; g += 2) {
                issue_u(g + 1, a1);
                consume_u(g, a0);
                if (g + 2 < 8) issue_u(g + 2, a0);
                consume_u(g + 1, a1);
            }
        }
        asm volatile("s_waitcnt lgkmcnt(0)" ::: "memory");
        float acc[16];
#pragma unroll
        for (int i = 0; i < 16; ++i) acc[i] = 0.f;
        {
            u32x4 v0[8], v1[8];
            auto issue_v = [&](int e0, u32x4 (&v)[8]) {
#pragma unroll
                for (int k = 0; k < 8; ++k) v[k] = *(const u32x4*)(p.V8 + (size_t)idxs[e0 + k] * 1024 + lane * 16);
            };
            auto consume_v = [&](int e0, const u32x4 (&v)[8]) {
#pragma unroll
                for (int k = 0; k < 8; ++k) {
                    const float c = cs[e0 + k];
#pragma unroll
                    for (int w = 0; w < 4; ++w) {
                        const f32x2 lo = __builtin_amdgcn_cvt_pk_f32_fp8((int)v[k][w], false), hh = __builtin_amdgcn_cvt_pk_f32_fp8((int)v[k][w], true);
                        acc[w * 4] += c * lo[0]; acc[w * 4 + 1] += c * lo[1]; acc[w * 4 + 2] += c * hh[0]; acc[w * 4 + 3] += c * hh[1];
                    }
                }
            };
            issue_v(0, v0);
#pragma unroll 1
            for (int e0 = 0; e0 < 128; e0 += 16) {
                issue_v(e0 + 8, v1);
                consume_v(e0, v0);
                if (e0 + 16 < 128) issue_v(e0 + 16, v0);
                consume_v(e0 + 8, v1);
            }
        }
        float s = 0.f;
#pragma unroll
        for (int i = 0; i < 16; ++i) { acc[i] += DN_ALPHA * hv[i]; s += acc[i]; }
        const float mean = wave_sum(s) * (1.f / 1024.f);
        float q = 0.f;
#pragma unroll
        for (int i = 0; i < 16; ++i) q += (acc[i] - mean) * (acc[i] - mean);
        const float rs = rsqrtf(wave_sum(q) * (1.f / 1024.f) + LN_EPS);
#pragma unroll
        for (int i = 0; i < 4; ++i) {
            const int c = lane * 16 + i * 4;
            const f32x4 g0 = *(const f32x4*)(p.ln2_g + c), b0 = *(const f32x4*)(p.ln2_b + c);
            f32x4 y0;
#pragma unroll
            for (int k = 0; k < 4; ++k) y0[k] = (acc[i * 4 + k] - mean) * rs * g0[k] + b0[k];
            *(f32x4*)(p.out + O_Y + (size_t)row * 1024 + c) = y0;
        }
    }
}

namespace pg8 {
#define PG8_LAS __attribute__((address_space(3)))
typedef unsigned short bf16_t;
typedef short bf16x8 __attribute__((ext_vector_type(8)));
typedef float f32x4 __attribute__((ext_vector_type(4)));
typedef unsigned u32x4 __attribute__((ext_vector_type(4)));
constexpr int BM = 256, BK = 64, HALF = 128, HTB = HALF * BK * 2  , STAGE_BYTES = 8 * HTB, NXCD = 8, WGM = 8;

__host__ __device__ __forceinline__ int lds_byte(int r, int c) { const int st = (r >> 4) * 2 + (c >> 5), rr = r & 15, cc = c & 31, ob = rr * 64 + cc * 2; return st * 1024 + (ob ^ (((ob >> 9) & 1) << 5)); }
__host__ __device__ __forceinline__ void stage_rc(int b, int& R, int& C) { const int st = b / 1024, sb = b % 1024, swz = sb ^ (((sb >> 9) & 1) << 5); R = (st >> 1) * 16 + swz / 64; C = (st & 1) * 32 + (swz % 64) / 2; }
__host__ __device__ __forceinline__ int perm32(int rho) { const int n = rho >> 4, i = rho & 15; return 8 * (i >> 2) + 4 * n + (i & 3); }

struct Unit { int pm, pn; };
struct Gemm { const bf16_t* A; const bf16_t* Bt; int M, N, K; };

struct StaticOrder {
    int nM, nN, nwg, G, c;
    __host__ __device__ void init(int M, int N, int G_, int c_) { nM = M / BM; nN = N / BM; nwg = nM * nN; G = G_; c = c_; }
    __host__ __device__ bool next(int i, Unit& u) const {
        const long L = (long)i * G + c; if (L >= nwg) return false;
        int wgid = (int)L; { const int q = nwg / NXCD, r = nwg % NXCD, xcd = wgid % NXCD, off = wgid / NXCD; wgid = (xcd < r ? xcd * (q + 1) : r * (q + 1) + (xcd - r) * q) + off; }
        const int nig = WGM * nN, gid = wgid / nig, fm = gid * WGM, gsz = (nM - fm) < WGM ? (nM - fm) : WGM;
        u.pm = fm + ((wgid % nig) % gsz); u.pn = (wgid % nig) / gsz; return true;
    }
    __device__ __forceinline__ void a_ready(const Unit&) const {}
    __device__ __forceinline__ void done(const Unit&) const {}
};
template <class Epi, class Sched, bool STAMP = false>
__device__ __forceinline__ void gemm_phase(PG8_LAS unsigned char* lds, const Gemm g, const Sched& S, const Epi& E, unsigned long long* stamps) {
    const int tid = tid_opq(), wid = __builtin_amdgcn_readfirstlane(tid >> 6), lane = tid & 63, wr = wid >> 2, wc = wid & 3, fr = lane & 15, fq = lane >> 4;
    const int K = g.K, nt = K / BK;
    int ts_lo = 0, ts_hi = 0, nts = 0; const unsigned long long rt_entry = STAMP ? (unsigned long long)wall_clock64() : 0ull;
#define PG8_STAMP() do { if (STAMP && wid == 0 && nts < 64) { const unsigned long long _c = (unsigned long long)clock64(); \
        ts_lo = (lane == nts) ? (int)(unsigned)_c : ts_lo; ts_hi = (lane == nts) ? (int)(unsigned)(_c >> 32) : ts_hi; ++nts; } } while (0)
    PG8_STAMP();
    unsigned voffA[2], voffB[2];
#pragma unroll
    for (int i = 0; i < 2; ++i) { int R, C; stage_rc(tid * 16 + i * 8192, R, C); const int Rb = Epi::PERM ? ((R & ~31) + perm32(R & 31)) : R;
        voffA[i] = (unsigned)(R * K + C) * 2u; voffB[i] = (unsigned)(Rb * K + C) * 2u; }
    const size_t kstep = (size_t)(BK * 2);
    const size_t hstep = (size_t)HALF * K * 2;
    const size_t tstep = 2 * hstep;
    const unsigned ldsw = (unsigned)wid * 1024u;
    const int aoff = lds_byte(wr * 64 + fr, fq * 8), boff = lds_byte(wc * 32 + fr, fq * 8);
#define PG8_SA(b, h) (((b) * 2 + (h)) * HTB)
#define PG8_SB(b, h) ((4 + (b) * 2 + (h)) * HTB)
#define PG8_STAGE(bufoff, gbase, voff) do { _Pragma("unroll") for (int _i = 0; _i < 2; ++_i) \
        __builtin_amdgcn_global_load_lds((const unsigned*)((const char*)(gbase) + (voff)[_i]), (PG8_LAS unsigned*)(lds + (bufoff) + ldsw + _i * 8192), 16, 0, 0); } while (0)
#define PG8_LDA(dst, b, h) do { _Pragma("unroll") for (int m = 0; m < 4; ++m) _Pragma("unroll") for (int k = 0; k < 2; ++k) dst[m][k] = *(const PG8_LAS bf16x8*)(lds + PG8_SA(b, h) + aoff + m * 2048 + k * 1024); } while (0)
#define PG8_LDB(dst, b, h) do { _Pragma("unroll") for (int n = 0; n < 2; ++n) _Pragma("unroll") for (int k = 0; k < 2; ++k) dst[n][k] = *(const PG8_LAS bf16x8*)(lds + PG8_SB(b, h) + boff + n * 2048 + k * 1024); } while (0)
#define PG8_MMA(ai, bj, At, Bt) do { __builtin_amdgcn_s_setprio(1); _Pragma("unroll") for (int m = 0; m < 4; ++m) _Pragma("unroll") for (int n = 0; n < 2; ++n) _Pragma("unroll") for (int k = 0; k < 2; ++k) \
        acc[ai][bj][m][n] = __builtin_amdgcn_mfma_f32_16x16x32_bf16(Bt[n][k], At[m][k], acc[ai][bj][m][n], 0, 0, 0); __builtin_amdgcn_s_setprio(0); } while (0)
#define PG8_WAIT_V(n) asm volatile("s_waitcnt vmcnt(" #n ")" ::: "memory")
#define PG8_WAIT_L(n) asm volatile("s_waitcnt lgkmcnt(" #n ")" ::: "memory")
#define PG8_BAR __builtin_amdgcn_s_barrier()
#define PG8_SCHED __builtin_amdgcn_sched_barrier(0)
    Unit cur, nxt; int ui = 0;
    if (!S.next(0, cur)) return;
    f32x4 acc[2][2][4][2];
#pragma unroll
    for (int a = 0; a < 2; ++a)
#pragma unroll
        for (int b = 0; b < 2; ++b)
#pragma unroll
            for (int m = 0; m < 4; ++m)
#pragma unroll
                for (int n = 0; n < 2; ++n) acc[a][b][m][n] = (f32x4){0.f, 0.f, 0.f, 0.f};
    bf16x8 At[4][2], B0[2][2], B1[2][2];
    const char* cA = (const char*)g.A + (size_t)cur.pm * tstep; const char* cB = (const char*)g.Bt + (size_t)cur.pn * tstep;
    S.a_ready(cur);
    PG8_STAGE(PG8_SB(0, 0), cB, voffB); PG8_STAGE(PG8_SA(0, 0), cA, voffA); PG8_STAGE(PG8_SB(0, 1), cB + hstep, voffB); PG8_STAGE(PG8_SA(0, 1), cA + hstep, voffA);
    if (wr == 1) PG8_BAR;
    PG8_WAIT_V(4); PG8_BAR;
    PG8_STAGE(PG8_SB(1, 0), cB + kstep, voffB); PG8_STAGE(PG8_SA(1, 0), cA + kstep, voffA); PG8_STAGE(PG8_SB(1, 1), cB + hstep + kstep, voffB);
    PG8_WAIT_V(6); PG8_BAR;
    PG8_STAMP();
    for (;;) {
        const bool has_next = S.next(ui + 1, nxt);
        const char* nA = has_next ? (const char*)g.A + (size_t)nxt.pm * tstep : cA; const char* nB = has_next ? (const char*)g.Bt + (size_t)nxt.pn * tstep : cB;
        for (int t = 0; t < nt; t += 2) {
            const bool last = (t == nt - 2);
            const char* a1 = cA + (size_t)(t + 1) * kstep;
            const char* a2 = last ? nA : cA + (size_t)(t + 2) * kstep; const char* b2 = last ? nB : cB + (size_t)(t + 2) * kstep;
            const char* a3 = a2 + kstep; const char* b3 = b2 + kstep;
            if (last && has_next) S.a_ready(nxt);
            PG8_LDB(B0, 0, 0); PG8_SCHED; PG8_LDA(At, 0, 0); PG8_STAGE(PG8_SA(1, 1), a1 + hstep, voffA);
            PG8_WAIT_L(8); PG8_BAR; PG8_WAIT_L(0); PG8_MMA(0, 0, At, B0); PG8_BAR; PG8_SCHED;
            PG8_LDB(B1, 0, 1); PG8_STAGE(PG8_SB(0, 0), b2, voffB);
            PG8_BAR; PG8_WAIT_L(0); PG8_MMA(0, 1, At, B1); PG8_BAR;
            PG8_LDA(At, 0, 1); PG8_STAGE(PG8_SA(0, 0), a2, voffA);
            PG8_BAR; PG8_WAIT_L(0); PG8_MMA(1, 0, At, B0); PG8_BAR; PG8_SCHED;
            PG8_STAGE(PG8_SB(0, 1), b2 + hstep, voffB);
            PG8_WAIT_V(6); PG8_BAR; PG8_MMA(1, 1, At, B1); PG8_BAR;
            PG8_LDB(B0, 1, 0); PG8_SCHED; PG8_LDA(At, 1, 0); PG8_STAGE(PG8_SA(0, 1), a2 + hstep, voffA);
            PG8_WAIT_L(8); PG8_BAR; PG8_WAIT_L(0); PG8_MMA(0, 0, At, B0); PG8_BAR; PG8_SCHED;
            PG8_LDB(B1, 1, 1); PG8_STAGE(PG8_SB(1, 0), b3, voffB);
            PG8_BAR; PG8_WAIT_L(0); PG8_MMA(0, 1, At, B1); PG8_BAR;
            PG8_LDA(At, 1, 1); PG8_STAGE(PG8_SA(1, 0), a3, voffA);
            PG8_BAR; PG8_WAIT_L(0); PG8_MMA(1, 0, At, B0); PG8_BAR; PG8_SCHED;
            PG8_STAGE(PG8_SB(1, 1), b3 + hstep, voffB);
            PG8_WAIT_V(6); PG8_BAR; PG8_MMA(1, 1, At, B1); PG8_BAR;
        }
        PG8_STAMP();
        if constexpr (!Epi::AFTER_DRAIN) { E(acc, cur, wr, wc, fr, fq); S.done(cur); }
        PG8_STAMP();
        if (!has_next) break;
#pragma unroll
        for (int a = 0; a < 2; ++a)
#pragma unroll
            for (int b = 0; b < 2; ++b)
#pragma unroll
                for (int m = 0; m < 4; ++m)
#pragma unroll
                    for (int n = 0; n < 2; ++n) acc[a][b][m][n] = (f32x4){0.f, 0.f, 0.f, 0.f};
        cur = nxt; cA = nA; cB = nB; ++ui;
    }
    PG8_WAIT_V(0);
    if (wr == 0) PG8_BAR;
    PG8_BAR;
    if constexpr (Epi::AFTER_DRAIN) { E.fused(acc, cur, wr, wc, fr, fq, lds, wid, lane); S.done(cur); }
    PG8_STAMP();
    if (STAMP && wid == 0) { stamps[lane] = lane < nts ? (((unsigned long long)(unsigned)ts_hi << 32) | (unsigned)ts_lo) : 0ull;
        if (lane == 62) stamps[62] = rt_entry; if (lane == 63) stamps[63] = (unsigned long long)wall_clock64(); }
#undef PG8_STAMP
#undef PG8_SA
#undef PG8_SB
#undef PG8_STAGE
#undef PG8_LDA
#undef PG8_LDB
#undef PG8_MMA
#undef PG8_WAIT_V
#undef PG8_WAIT_L
#undef PG8_BAR
#undef PG8_SCHED
}
}

template <class F> struct EpiAdapt {
    static constexpr bool PERM = true, AFTER_DRAIN = false;
    F f;
    __device__ __forceinline__ void operator()(const pg8::f32x4 (&acc)[2][2][4][2], const pg8::Unit& u, int wr, int wc, int fr, int fq) const {
        constexpr int B = F::BATCH;
        const int row0 = u.pm * 256 + wr * 64 + fr, col0 = u.pn * 256 + wc * 32 + 8 * fq;
        f32x4 b0[2], b1[2];
        if constexpr (F::COLBIAS) { f.bias8(col0, b0[0], b1[0]); f.bias8(col0 + 128, b0[1], b1[1]); }
#pragma unroll
        for (int q0 = 0; q0 < 16; q0 += B) {
            typename F::Pre pre[B];
#pragma unroll
            for (int i = 0; i < B; ++i) { const int q = q0 + i, bj = q & 1, m = (q >> 1) & 3, ai = q >> 3; pre[i] = f.pre(row0 + ai * 128 + m * 16, col0 + bj * 128); }
#pragma unroll
            for (int i = 0; i < B; ++i) { const int q = q0 + i, bj = q & 1, m = (q >> 1) & 3, ai = q >> 3;
                f32x4 v0 = acc[ai][bj][m][0], v1 = acc[ai][bj][m][1];
                if constexpr (F::COLBIAS) { v0 += b0[bj]; v1 += b1[bj]; }
                f.put(row0 + ai * 128 + m * 16, col0 + bj * 128, v0, v1, pre[i]); }
        }
    }
};
template <class F>
DEVI void gemm_pg8(const bf16_t* A, const bf16_t* Bt, int M, int N, int K, const F& f, char* smem, int bid, int nblk) {
    pg8::Gemm g{A, Bt, M, N, K};
    pg8::StaticOrder S; S.init(M, N, nblk, bid);
    EpiAdapt<F> E{f};
    __syncthreads();
    pg8::gemm_phase<EpiAdapt<F>, pg8::StaticOrder, false>((PG8_LAS unsigned char*)smem, g, S, E, nullptr);
    __syncthreads();
}

template <class F>
DEVI void gemm_small_rows(const bf16_t* __restrict__ A, const bf16_t* __restrict__ Bt, int N, const F& f, char* smem, int bid, int nblk) {
    const int tid = tid_opq(), lane = tid & 63, wid = tid >> 6, fr = lane & 15, fq = lane >> 4;
    float* part = (float*)smem;
    const int ntn = N / 64, ntiles = (NTS / 32) * ntn;
    for (int tile = bid; tile < ntiles; tile += nblk) {
        const int tm = tile / ntn, tn = tile % ntn;
        const int row0 = NTP + tm * 32, col0 = tn * 64;
        f32x4 acc[2][4];
#pragma unroll
        for (int m = 0; m < 2; ++m)
#pragma unroll
            for (int n = 0; n < 4; ++n) acc[m][n] = (f32x4){0.f, 0.f, 0.f, 0.f};
        const bf16_t* ap = A + (size_t)(row0 + fr) * 1024 + wid * 128 + fq * 8;
        const bf16_t* bp = Bt + (size_t)(col0 + fr) * 1024 + wid * 128 + fq * 8;
        bf16x8 af[4][2], bfr[4][4];
#pragma unroll
        for (int ks = 0; ks < 4; ++ks) {
#pragma unroll
            for (int m = 0; m < 2; ++m) af[ks][m] = *(const bf16x8*)(ap + (size_t)m * 16 * 1024 + ks * 32);
#pragma unroll
            for (int n = 0; n < 4; ++n) bfr[ks][n] = *(const bf16x8*)(bp + (size_t)n * 16 * 1024 + ks * 32);
        }
#pragma unroll
        for (int ks = 0; ks < 4; ++ks)
#pragma unroll
            for (int m = 0; m < 2; ++m)
#pragma unroll
                for (int n = 0; n < 4; ++n) acc[m][n] = __builtin_amdgcn_mfma_f32_16x16x32_bf16(bfr[ks][n], af[ks][m], acc[m][n], 0, 0, 0);
        __syncthreads();
#pragma unroll
        for (int m = 0; m < 2; ++m)
#pragma unroll
            for (int n = 0; n < 4; ++n) *(f32x4*)(part + ((size_t)wid * 32 + m * 16 + fr) * 64 + n * 16 + fq * 4) = acc[m][n];
        __syncthreads();
        if (tid < 256) {
            const int r = tid >> 3, c8 = (tid & 7) * 8;
            f32x4 v0 = {0.f, 0.f, 0.f, 0.f}, v1 = v0;
#pragma unroll
            for (int w = 0; w < 8; ++w) { v0 += *(const f32x4*)(part + ((size_t)w * 32 + r) * 64 + c8); v1 += *(const f32x4*)(part + ((size_t)w * 32 + r) * 64 + c8 + 4); }
            const typename F::Pre pre = f.pre(row0 + r, col0 + c8);
            f.put(row0 + r, col0 + c8, v0, v1, pre);
        }
    }
}
template <class F>
DEVI void gemm_tail(const bf16_t* A, const bf16_t* Bt, int N, const F& f, char* smem, int bid, int nblk) {
    gemm_small_rows(A, Bt, N, f, smem, bid, nblk);
    gemm_pg8(A, Bt, NTP, N, 1024, f, smem, bid, nblk);
}

#define XB_TMO      128
#define XB_XCNT(j)  (256  + 64 * (j))
#define XB_XSUB(j)  (1280 + 64 * (j))
#define XB_XGEN(j)  (2304 + 64 * (j))
#define XB_TOP      3328
#define XB_TOPGEN   3392
#define XCD_BAR_WORDS 3456
#define XB_SPIN_CAP (1u << 18)
#define LAS __attribute__((address_space(3)))

__device__ __forceinline__ unsigned xb_ld(unsigned* p)              { return __hip_atomic_load(p, __ATOMIC_RELAXED, __HIP_MEMORY_SCOPE_AGENT); }
__device__ __forceinline__ unsigned xb_add(unsigned* p, unsigned v) { return __hip_atomic_fetch_add(p, v, __ATOMIC_RELAXED, __HIP_MEMORY_SCOPE_AGENT); }
__device__ __forceinline__ unsigned xb_xcc_id() { return (unsigned)__builtin_amdgcn_s_getreg((3 << 11) | 20) & 0xFu; }
#define XB_SPIN(cond, bar) do { unsigned _sp = 0; while (cond) { __builtin_amdgcn_s_sleep(1); \
    if ((++_sp & 255u) == 0u) { if (xb_ld(&(bar)[XB_TMO])) break; if (_sp > XB_SPIN_CAP) { atomicAdd(&(bar)[XB_TMO], 1u); break; } } } } while (0)

struct XcdBarrier {
    unsigned* bar; unsigned x;
    volatile LAS unsigned* st;
};

__device__ __forceinline__ XcdBarrier xcd_barrier_post(unsigned* bar, volatile LAS unsigned* st) {
    XcdBarrier b; b.bar = bar; b.x = xb_xcc_id(); b.st = st;
    if (tid_opq() == 0) (void)xb_add(&bar[XB_XCNT(b.x)], 1u);
    return b;
}
__device__ __forceinline__ void xcd_barrier_complete(unsigned* bar, unsigned x, unsigned& nloc, unsigned& nx) {
    const unsigned G = gridDim.x * gridDim.y * gridDim.z;
    unsigned sum, cnt, mine, sp = 0u;
    for (;;) {
        sum = 0u; cnt = 0u; mine = 0u;
#pragma unroll
        for (unsigned j = 0; j < 16; ++j) { const unsigned c = xb_ld(&bar[XB_XCNT(j)]); sum += c; cnt += (c > 0u) ? 1u : 0u; mine = (j == x) ? c : mine; }
        if (sum == G) break;
        __builtin_amdgcn_s_sleep(1);
        if ((++sp & 255u) == 0u) { if (xb_ld(&bar[XB_TMO])) break; if (sp > XB_SPIN_CAP) { atomicAdd(&bar[XB_TMO], 1u); break; } }
    }
    nloc = mine > 0u ? mine : 1u; nx = cnt > 0u ? cnt : 1u;
}

__device__ __forceinline__ void xcd_barrier(const XcdBarrier& b) {
    asm volatile("s_waitcnt vmcnt(0)" ::: "memory");
    __syncthreads();
    if (tid_opq() == 0) {
        unsigned* bar = b.bar;
        __builtin_amdgcn_s_waitcnt(0);
        unsigned nloc = b.st[0], nx = b.st[1];
        if (nloc == 0u) { xcd_barrier_complete(bar, b.x, nloc, nx); b.st[0] = nloc; b.st[1] = nx; }
        const unsigned old = xb_add(&bar[XB_XSUB(b.x)], 1u);
        const unsigned gen = old / nloc;
        if (old + 1u == (gen + 1u) * nloc) {
            __builtin_amdgcn_fence(__ATOMIC_RELEASE, "agent");
            asm volatile("s_waitcnt vmcnt(0)" ::: "memory");
            const unsigned og = xb_add(&bar[XB_TOP], 1u);
            const unsigned tg = og / nx;
            if (og + 1u == (tg + 1u) * nx) xb_add(&bar[XB_TOPGEN], 1u);
            else XB_SPIN(xb_ld(&bar[XB_TOPGEN]) == tg, bar);
            __builtin_amdgcn_fence(__ATOMIC_ACQUIRE, "agent");
            xb_add(&bar[XB_XGEN(b.x)], 1u);
            asm volatile("s_waitcnt vmcnt(0)" ::: "memory");
        } else {
            XB_SPIN(xb_ld(&bar[XB_XGEN(b.x)]) == gen, bar);
            __builtin_amdgcn_fence(__ATOMIC_ACQUIRE, "agent");
            asm volatile("s_waitcnt vmcnt(0)" ::: "memory");
        }
    }
    __syncthreads();
}

constexpr int LDS_BYTES = 152 * 1024;

template <int S>
DEVI void run_stage(const P& p, char* smem, int bid, int nblk) {
    if (S == 0) stage_prologue(p, smem, bid, nblk);
    if (S == 1) { EpiInProj e{p}; gemm_pg8(p.XB, p.WINT, NT, NPAD_IN + 2048, 1024, e, smem, bid, nblk); }
    if (S == 2) {
        stage_mlstm_gates(p, smem, bid, nblk);
        if (bid & 1) { stage_mlstm_dc(p, smem, bid, nblk); stage_compress(p, smem, bid, nblk); stage_mlstm_sample(p, smem, bid, nblk); }
        else { stage_compress(p, smem, bid, nblk); stage_mlstm_dc(p, smem, bid, nblk); stage_mlstm_sample(p, smem, bid, nblk); }
    }
    if (S == 4) { stage_mlstm_scan(p, bid, nblk); stage_nsa_attn(p, smem, bid, nblk); }
    if (S == 5) { stage_mlstm_out(p, smem, bid, nblk); { EpiM1 e{p}; gemm_tail(p.YB, p.WBT, 1024, e, smem, bid, nblk); } }
    if (S == 6) { EpiM2 e{p}; gemm_tail(p.YA, p.WAT, 1024, e, smem, bid, nblk); }
    if (S == 8) { EpiR e{p}; gemm_tail(p.MERGED, p.WOT, 1024, e, smem, bid, nblk); }
    if (S == 9) stage_ln1(p, bid, nblk);
    if (S == 10) { EpiPQ e{p}; gemm_tail(p.HB, p.WQT, 2048, e, smem, bid, nblk); }
    if (S == 11) {
        if (bid & 1) {
            for (int ps = 0; ps < 4; ++ps) { stage_peer_route(p, smem, bid, nblk, ps, ps + 1); __threadfence_block(); __syncthreads(); stage_peer_apply(p, smem, bid, nblk, ps, ps + 1); __syncthreads(); }
        } else { stage_peer_route(p, smem, bid, nblk, 0, 64); __threadfence_block(); __syncthreads(); stage_peer_apply(p, smem, bid, nblk, 0, 64); }
    }
}
constexpr int NSTAGES = 13;

template <int S>
__global__ void __launch_bounds__(512, 2) k_stage(P p) {
    extern __shared__ __attribute__((aligned(16))) char smem[];
    run_stage<S>(p, smem, blockIdx.x, gridDim.x);
}


#if MK_ONE_LAUNCH
__global__ void __launch_bounds__(512, 2) k_mega(P p) {
    extern __shared__ __attribute__((aligned(16))) char smem_all[];
    if (tid_opq() == 0) *(u32x4*)smem_all = (u32x4){0u, 0u, 0u, 0u};
    __syncthreads();
    XcdBarrier bar = xcd_barrier_post(p.bar, (volatile LAS unsigned*)smem_all);
    char* smem = smem_all + 16;
    const int bid = blockIdx.x, nblk = gridDim.x;
    run_stage<0>(p, smem, bid, nblk); if ((REP_MASK >> 0) & 1) { xcd_barrier(bar); run_stage<0>(p, smem, bid, nblk); }  xcd_barrier(bar);
    run_stage<1>(p, smem, bid, nblk); if ((REP_MASK >> 1) & 1) { xcd_barrier(bar); run_stage<1>(p, smem, bid, nblk); }  xcd_barrier(bar);
    run_stage<2>(p, smem, bid, nblk); if ((REP_MASK >> 2) & 1) { xcd_barrier(bar); run_stage<2>(p, smem, bid, nblk); }  xcd_barrier(bar);
    run_stage<4>(p, smem, bid, nblk); if ((REP_MASK >> 4) & 1) { xcd_barrier(bar); run_stage<4>(p, smem, bid, nblk); }  xcd_barrier(bar);
    run_stage<5>(p, smem, bid, nblk); if ((REP_MASK >> 5) & 1) { xcd_barrier(bar); run_stage<5>(p, smem, bid, nblk); }  xcd_barrier(bar);
    run_stage<6>(p, smem, bid, nblk); if ((REP_MASK >> 6) & 1) { xcd_barrier(bar); run_stage<6>(p, smem, bid, nblk); }  xcd_barrier(bar);
    run_stage<8>(p, smem, bid, nblk); if ((REP_MASK >> 8) & 1) { xcd_barrier(bar); run_stage<8>(p, smem, bid, nblk); }  xcd_barrier(bar);
    run_stage<9>(p, smem, bid, nblk); if ((REP_MASK >> 9) & 1) { xcd_barrier(bar); run_stage<9>(p, smem, bid, nblk); }  xcd_barrier(bar);
    run_stage<10>(p, smem, bid, nblk); if ((REP_MASK >> 10) & 1) { xcd_barrier(bar); run_stage<10>(p, smem, bid, nblk); } xcd_barrier(bar);
    run_stage<11>(p, smem, bid, nblk); if ((REP_MASK >> 11) & 1) { xcd_barrier(bar); run_stage<11>(p, smem, bid, nblk); }
}
#endif

template <int S> static void launch_stage(const P& p, int grid, hipStream_t stream) {
    (void)hipFuncSetAttribute((const void*)k_stage<S>, hipFuncAttributeMaxDynamicSharedMemorySize, LDS_BYTES);
    k_stage<S><<<dim3(grid), dim3(512), LDS_BYTES, stream>>>(p);
}

extern "C" void kernel_launch(void* const* d_in, const int* in_sizes, int n_in, void* d_out, int out_size, void* d_ws, size_t ws_size, hipStream_t stream) {
    (void)in_sizes; (void)n_in; (void)out_size; (void)ws_size;
    P p{};
    p.xp = (const float*)d_in[0]; p.xs = (const float*)d_in[1]; p.cache_cmp = (const float*)d_in[2]; p.cache_slc = (const float*)d_in[3];
    p.cache_win = (const float*)d_in[4]; p.state_C = (const float*)d_in[5]; p.state_n = (const float*)d_in[6]; p.state_m = (const float*)d_in[7];
    p.page_table = (const int*)d_in[8];
    p.w_in = (const float*)d_in[9]; p.b_in = (const float*)d_in[10]; p.norm_a_g = (const float*)d_in[11]; p.nsa_pe = (const float*)d_in[12];
    p.nsa_w_cmp = (const float*)d_in[13]; p.w_br_a = (const float*)d_in[14]; p.w_br_b = (const float*)d_in[15]; p.w_merge = (const float*)d_in[16];
    p.w_out = (const float*)d_in[17]; p.ln1_g = (const float*)d_in[18]; p.ln1_b = (const float*)d_in[19];
    p.peer_wq = (const float*)d_in[20]; p.peer_keys = (const float*)d_in[21]; p.peer_u = (const float*)d_in[22]; p.peer_v = (const float*)d_in[23];
    p.ln2_g = (const float*)d_in[24]; p.ln2_b = (const float*)d_in[25];
    p.out = (float*)d_out;
    char* w = (char*)d_ws; size_t off = 0;
    auto take = [&](size_t bytes) { char* r = w + off; off += (bytes + 255) & ~(size_t)255; return r; };
    p.bar = (unsigned*)take(16384);
    p.PW = (float*)(p.bar + 3584);
    p.WCT = (bf16_t*)take((size_t)2 * 64 * 4096 * 2);
    p.XB = (bf16_t*)take((size_t)NT * 1024 * 2);
    p.WINT = (bf16_t*)take((size_t)(NPAD_IN + 2048) * 1024 * 2);
    p.WMT = (bf16_t*)take((size_t)2048 * 1024 * 2);
    p.WAT = (bf16_t*)take((size_t)1024 * 1024 * 2);
    p.WBT = (bf16_t*)take((size_t)1024 * 1024 * 2);
    p.WOT = (bf16_t*)take((size_t)1024 * 1024 * 2);
    p.WQT = (bf16_t*)take((size_t)2048 * 1024 * 2);
    p.KEYSB = (bf16_t*)take((size_t)16 * 128 * 128 * 2);
    p.U8 = (unsigned char*)take((size_t)16384 * 1024);
    p.V8 = (unsigned char*)take((size_t)16384 * 1024);
    p.US = (float*)take(16384 * 4);
    p.VS = (float*)take(16384 * 4);
    p.PROJ = (bf16_t*)take((size_t)NT * PS * 2);
    p.SM = (float*)take((size_t)NT * 64 * 4);
    p.BCUM = (float*)take((size_t)16 * 4096 * 4);
    p.MPREV = (float*)take(4096); p.ACOEF = (float*)take(4096); p.SCL = (float*)take(4096); p.MLOC = (float*)take(4096);
    p.DC = (float*)take((size_t)1024 * 272 * 128 * 4);
    p.CPT = (bf16_t*)take((size_t)1024 * 272 * 128 * 2);
    p.KC = (float*)take((size_t)4352 * 512 * 4);
    p.VC = p.KC + 256;
    p.OCMP = (float*)take((size_t)NT * 1024 * 4);
    p.SEL = (unsigned long long*)take((size_t)NT * 4 * 8);
    p.YA = (bf16_t*)take((size_t)NT * 1024 * 2);
    p.YB = (bf16_t*)take((size_t)NT * 1024 * 2);
    p.G = (bf16_t*)take((size_t)NT * 2048 * 2);
    p.TMPB = (bf16_t*)take((size_t)NT * 1024 * 2);
    p.MERGED = (bf16_t*)take((size_t)NT * 1024 * 2);
    p.R = (float*)take((size_t)NT * 1024 * 4);
    p.H = (float*)take((size_t)NT * 1024 * 4);
    p.HB = (bf16_t*)take((size_t)NT * 1024 * 2);
    p.PQ = (bf16_t*)take((size_t)NT * 2048 * 2);
    p.EIDX = (int*)take((size_t)NT * 128 * 4);
    p.EGATE = (float*)take((size_t)NT * 128 * 4);

    (void)hipMemsetAsync(p.bar, 0, 16384, stream);
#if MK_ONE_LAUNCH
    {
        constexpr size_t kDynLds = LDS_BYTES + 16;
        (void)hipFuncSetAttribute((const void*)k_mega, hipFuncAttributeMaxDynamicSharedMemorySize, (int)kDynLds);
        int dev = 0, cus = 0, per_cu = 0;
        (void)hipGetDevice(&dev);
        (void)hipDeviceGetAttribute(&cus, hipDeviceAttributeMultiprocessorCount, dev);
        (void)hipOccupancyMaxActiveBlocksPerMultiprocessor(&per_cu, (const void*)k_mega, 512, kDynLds);
        if (per_cu < 1 || cus < 1) return;
        const int grid = cus;
        k_mega<<<dim3(grid), dim3(512), kDynLds, stream>>>(p);
    }
#else
    const int grid = 512;
    launch_stage<0>(p, grid, stream);
    launch_stage<1>(p, grid, stream);
    launch_stage<2>(p, grid, stream);
    launch_stage<4>(p, grid, stream);
    launch_stage<5>(p, grid, stream);
    launch_stage<6>(p, grid, stream);
    launch_stage<8>(p, grid, stream);
    launch_stage<9>(p, grid, stream);
    launch_stage<10>(p, grid, stream);
    launch_stage<11>(p, grid, stream);
#endif
}
```

```cpp
#include <hip/hip_runtime.h>
#include <stdint.h>

#ifndef REP_MASK
#define REP_MASK 0
#endif
#ifndef MK_ONE_LAUNCH
#define MK_ONE_LAUNCH 1
#endif

typedef unsigned short bf16_t;
typedef short bf16x8 __attribute__((ext_vector_type(8)));
typedef float f32x4 __attribute__((ext_vector_type(4)));
typedef unsigned u32x4 __attribute__((ext_vector_type(4)));
typedef unsigned u32x2 __attribute__((ext_vector_type(2)));
typedef float f32x2 __attribute__((ext_vector_type(2)));
typedef __bf16 bf16x2_t __attribute__((ext_vector_type(2)));
#define DEVI __device__ __forceinline__
__device__ __forceinline__ int tid_opq() { int t = threadIdx.x; asm volatile("" : "+v"(t)); return t; }

constexpr int NTP = 16384, NTS = 512, NT = NTP + NTS, DM = 1024;
constexpr int PS = 5632;
constexpr int C_AQ = 0, C_AK = 512, C_AV = 1024, C_AO = 2048, C_BQ = 3072, C_CMP = 4096, C_SLC = 4608, C_WIN = 5120;
constexpr int NPAD_IN = 5888;
constexpr float DN_ALPHA = 1.189207115002721f;
constexpr float LN_EPS = 1e-5f;
constexpr size_t O_Y = 0;
constexpr size_t O_PCMP = O_Y + (size_t)NT * 1024;
constexpr size_t O_PSLC = O_PCMP + (size_t)NTP * 512;
constexpr size_t O_PWIN = O_PSLC + (size_t)NTP * 512;
constexpr size_t O_PC = O_PWIN + (size_t)4 * 512 * 512;
constexpr size_t O_PN = O_PC + (size_t)16 * 128 * 256;
constexpr size_t O_PM = O_PN + 16 * 128;
constexpr size_t O_SCMP = O_PM + 16;
constexpr size_t O_SSLC = O_SCMP + (size_t)NTS * 512;
constexpr size_t O_SWIN = O_SSLC + (size_t)NTS * 512;
constexpr size_t O_SC = O_SWIN + (size_t)128 * 512 * 512;
constexpr size_t O_SN = O_SC + (size_t)512 * 128 * 256;
constexpr size_t O_SM = O_SN + 512 * 128;

struct P {
    const float *xp, *xs, *cache_cmp, *cache_slc, *cache_win, *state_C, *state_n, *state_m;
    const int* page_table;
    const float *w_in, *b_in, *norm_a_g, *nsa_pe, *nsa_w_cmp, *w_br_a, *w_br_b, *w_merge, *w_out, *ln1_g, *ln1_b;
    const float *peer_wq, *peer_keys, *peer_u, *peer_v, *ln2_g, *ln2_b;
    float* out;
    bf16_t *XB, *WINT, *WMT, *WAT, *WBT, *WOT, *WQT, *KEYSB, *UB, *VB, *PROJ, *WCT;
    float* PW;
    float *SM, *BCUM, *MPREV, *ACOEF, *SCL, *MLOC, *DC, *KC, *VC, *OCMP;
    bf16_t* CPT;
    unsigned char *U8, *V8;
    float *US, *VS;
    unsigned long long* SEL;
    bf16_t *YA, *YB, *G, *MERGED, *HB, *PQ;
    float *R, *H, *EGATE;
    bf16_t* TMPB;
    int* EIDX;
    unsigned* bar;
};

DEVI bf16_t f2bf(float f) { return __builtin_bit_cast(unsigned short, (__bf16)f); }
DEVI float bf2f(bf16_t h) { return __uint_as_float(((unsigned)h) << 16); }
DEVI unsigned pack2(float a, float b) { return __builtin_bit_cast(unsigned, __builtin_convertvector((f32x2){a, b}, bf16x2_t)); }
DEVI u32x4 pack8f(const f32x4 a, const f32x4 b) { u32x4 r; r[0] = pack2(a[0], a[1]); r[1] = pack2(a[2], a[3]); r[2] = pack2(b[0], b[1]); r[3] = pack2(b[2], b[3]); return r; }
DEVI void ce_desc(unsigned& a, unsigned& b) { const unsigned hi = a > b ? a : b, lo = a > b ? b : a; a = hi; b = lo; }
template <int BASE> DEVI void sort16_desc(unsigned (&x)[64]) {
#pragma unroll
    for (int k = 2; k <= 16; k <<= 1)
#pragma unroll
        for (int j = k >> 1; j > 0; j >>= 1)
#pragma unroll
            for (int i = 0; i < 16; ++i) {
                const int l = i ^ j;
                if (l > i) { if ((i & k) == 0) ce_desc(x[BASE + i], x[BASE + l]); else ce_desc(x[BASE + l], x[BASE + i]); }
            }
}
DEVI void merge_top16(const unsigned* a, const unsigned* b, unsigned* t) {
    unsigned c[16];
#pragma unroll
    for (int i = 0; i < 16; ++i) c[i] = a[i] > b[15 - i] ? a[i] : b[15 - i];
#pragma unroll
    for (int j = 8; j > 0; j >>= 1)
#pragma unroll
        for (int i = 0; i < 16; ++i) { const int l = i ^ j; if (l > i) ce_desc(c[i], c[l]); }
#pragma unroll
    for (int i = 0; i < 16; ++i) t[i] = c[i];
}
DEVI float gelu_erf(float v) {
    const float av = fabsf(v), t = __builtin_amdgcn_rcpf(fmaf(av, 0.2316418882f, 1.0f));
    float q = fmaf(t, 0.5307027145f, -0.7265760135f); q = fmaf(q, t, 0.7107068705f); q = fmaf(q, t, -0.142248368f); q = fmaf(q, t, 0.127414796f); q = q * t;
    const float e = __builtin_amdgcn_exp2f(v * v * -0.72134752044f);
    const float mm = v * (q * e);
    return v < 0.f ? mm : v - mm;
}
DEVI float wave_max(float v) { for (int o = 32; o > 0; o >>= 1) v = fmaxf(v, __shfl_xor(v, o)); return v; }
DEVI float wave_sum(float v) { for (int o = 32; o > 0; o >>= 1) v += __shfl_xor(v, o); return v; }
DEVI float sigmoidf_(float x) { return __builtin_amdgcn_rcpf(1.f + __expf(-x)); }
DEVI float logsigmoidf_(float x) { return fminf(x, 0.f) - log1pf(__expf(-fabsf(x))); }
DEVI int win_map(int np) {
    if (np < 2048) return np;
    if (np < 5632) return np + 8;
    if (np < 5640) return np - 5632 + 2048;
    if (np < 5688) return np;
    return -1;
}
DEVI float alibi_slope(int h) { return exp2f(-0.5f * (float)(h + 1)); }

template <class MapFn>
DEVI void transpose_cvt(const float* __restrict__ W, bf16_t* __restrict__ WT, int K, int Nsrc, int Ndst, MapFn mapfn, float* tile  , int bid, int nblk) {
    const int tid = tid_opq();
    const int tn = Ndst / 64, tk = K / 64;
    for (int t = bid; t < tn * tk; t += nblk) {
        const int n0 = (t % tn) * 64, k0 = (t / tn) * 64;
        __syncthreads();
#pragma unroll
        for (int i = 0; i < 8; ++i) {
            const int kk = (tid >> 6) + i * 8, nn = tid & 63;
            const int n = mapfn(n0 + nn);
            tile[kk * 65 + nn] = n >= 0 ? W[(size_t)(k0 + kk) * Nsrc + n] : 0.f;
        }
        __syncthreads();
#pragma unroll
        for (int i = 0; i < 8; ++i) {
            const int nn = (tid >> 6) + i * 8, kk = tid & 63;
            WT[(size_t)(n0 + nn) * K + k0 + kk] = f2bf(tile[kk * 65 + nn]);
        }
    }
}
struct IdMap { DEVI int operator()(int n) const { return n; } };
struct WinMap { DEVI int operator()(int n) const { return win_map(n); } };

DEVI void cvt_rows(const float* __restrict__ src, bf16_t* __restrict__ dst, size_t n4, int bid, int nblk) {
    const size_t stride = (size_t)nblk * 512;
    for (size_t i0 = (size_t)bid * 512 + tid_opq(); i0 < n4; i0 += stride * 8) {
        f32x4 v[8];
#pragma unroll
        for (int u = 0; u < 8; ++u) { const size_t i = i0 + u * stride; v[u] = i < n4 ? __builtin_nontemporal_load((const f32x4*)src + i) : (f32x4){0.f, 0.f, 0.f, 0.f}; }
#pragma unroll
        for (int u = 0; u < 8; ++u) { const size_t i = i0 + u * stride; if (i < n4) { u32x2 o; o.x = pack2(v[u][0], v[u][1]); o.y = pack2(v[u][2], v[u][3]); ((u32x2*)dst)[i] = o; } }
    }
}

DEVI void stage_prologue(const P& p, char* smem, int bid, int nblk) {
    float* tile = (float*)smem;
    cvt_rows(p.xp, p.XB, (size_t)NTP * 256, bid, nblk);
    cvt_rows(p.xs, p.XB + (size_t)NTP * 1024, (size_t)NTS * 256, bid, nblk);
    {
        const int lane = tid_opq() & 63, wid = tid_opq() >> 6;
        for (int r0 = bid * 8 + wid; r0 < 2 * 16384; r0 += nblk * 8 * 2) {
            f32x4 x[2][4]; float am[2] = {0.f, 0.f};
#pragma unroll
            for (int j = 0; j < 2; ++j) {
                const int r = r0 + j * nblk * 8;
                if (r < 2 * 16384) {
                    const bool isv = r >= 16384; const int e = isv ? r - 16384 : r;
                    const float* src = (isv ? p.peer_v : p.peer_u) + (size_t)e * 1024 + lane * 16;
#pragma unroll
                    for (int i = 0; i < 4; ++i) x[j][i] = __builtin_nontemporal_load((const f32x4*)(src + i * 4));
                }
            }
#pragma unroll
            for (int j = 0; j < 2; ++j) {
                const int r = r0 + j * nblk * 8;
                if (r < 2 * 16384) {
                    const bool isv = r >= 16384; const int e = isv ? r - 16384 : r;
#pragma unroll
                    for (int i = 0; i < 4; ++i)
#pragma unroll
                        for (int k = 0; k < 4; ++k) am[j] = fmaxf(am[j], fabsf(x[j][i][k]));
                    const float amx = wave_max(am[j]);
                    const float inv = amx > 0.f ? 448.f / amx : 1.f;
                    u32x4 o;
#pragma unroll
                    for (int i = 0; i < 4; ++i) { int w = __builtin_amdgcn_cvt_pk_fp8_f32(x[j][i][0] * inv, x[j][i][1] * inv, 0, false); w = __builtin_amdgcn_cvt_pk_fp8_f32(x[j][i][2] * inv, x[j][i][3] * inv, w, true); o[i] = (unsigned)w; }
                    *(u32x4*)((isv ? p.V8 : p.U8) + (size_t)e * 1024 + lane * 16) = o;
                    if (lane == 0) (isv ? p.VS : p.US)[e] = amx > 0.f ? amx / 448.f : 1.f;
                }
            }
        }
    }
    cvt_rows(p.peer_keys, p.KEYSB, (size_t)16 * 128 * 128 / 4, bid, nblk);
    transpose_cvt(p.w_in, p.WINT, 1024, 5688, NPAD_IN, WinMap(), tile, bid, nblk);
    transpose_cvt(p.w_merge, p.WINT + (size_t)NPAD_IN * 1024, 1024, 2048, 2048, IdMap(), tile, bid, nblk);
    transpose_cvt(p.w_br_a, p.WAT, 1024, 1024, 1024, IdMap(), tile, bid, nblk);
    transpose_cvt(p.w_br_b, p.WBT, 1024, 1024, 1024, IdMap(), tile, bid, nblk);
    transpose_cvt(p.w_out, p.WOT, 1024, 1024, 1024, IdMap(), tile, bid, nblk);
    transpose_cvt(p.peer_wq, p.WQT, 1024, 2048, 2048, IdMap(), tile, bid, nblk);
    transpose_cvt(p.nsa_w_cmp, p.WCT, 4096, 64, 64, IdMap(), tile, bid, nblk);
    transpose_cvt(p.nsa_w_cmp + 4096 * 64, p.WCT + 64 * 4096, 4096, 64, 64, IdMap(), tile, bid, nblk);
    for (int blk = bid; blk < 32; blk += nblk) {
        const int tid = tid_opq(), kvv = tid >> 8, e = tid & 63, kq = (tid >> 6) & 3;
        float a = 0.f;
        for (int k = blk * 128 + kq * 32; k < blk * 128 + kq * 32 + 32; ++k) a += p.nsa_pe[kvv * 4096 + k] * p.nsa_w_cmp[((size_t)kvv * 4096 + k) * 64 + e];
        atomicAdd(p.PW + kvv * 64 + e, a);
    }
    {
        const size_t per_b = (size_t)508 * 512 / 4;
        const size_t stride = (size_t)nblk * 512, ntot = 128 * per_b;
        for (size_t i0 = (size_t)bid * 512 + tid_opq(); i0 < ntot; i0 += stride * 8) {
            f32x4 v[8];
#pragma unroll
            for (int u = 0; u < 8; ++u) { const size_t i = i0 + u * stride; if (i < ntot) { const size_t b = i / per_b, r = i % per_b; v[u] = __builtin_nontemporal_load((const f32x4*)(p.cache_win + b * 512 * 512 + 4 * 512) + r); } }
#pragma unroll
            for (int u = 0; u < 8; ++u) { const size_t i = i0 + u * stride; if (i < ntot) { const size_t b = i / per_b, r = i % per_b; __builtin_nontemporal_store(v[u], (f32x4*)(p.out + O_SWIN + b * 512 * 512) + r); } }
        }
    }
}

struct NoPre {};
DEVI f32x4 bf4_lo(const u32x4& g) { return (f32x4){__uint_as_float(g[0] << 16), __uint_as_float(g[0] & 0xFFFF0000u), __uint_as_float(g[1] << 16), __uint_as_float(g[1] & 0xFFFF0000u)}; }
DEVI f32x4 bf4_hi(const u32x4& g) { return (f32x4){__uint_as_float(g[2] << 16), __uint_as_float(g[2] & 0xFFFF0000u), __uint_as_float(g[3] << 16), __uint_as_float(g[3] & 0xFFFF0000u)}; }
struct EpiInProj {
    P p;
    typedef NoPre Pre;
    static constexpr int BATCH = 4;
    static constexpr bool COLBIAS = true;
    DEVI void bias8(int col, f32x4& b0, f32x4& b1) const {
        b0 = (f32x4){0.f, 0.f, 0.f, 0.f}; b1 = b0;
        if (col < 5688) { const int oc = win_map(col);
#pragma unroll
            for (int q = 0; q < 4; ++q) { b0[q] = p.b_in[oc + q]; b1[q] = p.b_in[oc + 4 + q]; } }
    }
    DEVI Pre pre(int, int) const { return NoPre(); }
    DEVI void put(int row, int col, f32x4 v0, f32x4 v1, const Pre&) const {
        if (col >= NPAD_IN) {
#pragma unroll
            for (int k = 0; k < 4; ++k) { v0[k] = sigmoidf_(v0[k]); v1[k] = sigmoidf_(v1[k]); }
            *(u32x4*)(p.G + (size_t)row * 2048 + (col - NPAD_IN)) = pack8f(v0, v1);
            return;
        }
        if (col >= 5688) return;
        if (col >= 5632) { *(f32x4*)(p.SM + (size_t)row * 64 + (col - 5632)) = v0; *(f32x4*)(p.SM + (size_t)row * 64 + (col - 5632) + 4) = v1; return; }
        if (col >= C_AK && col < C_AV) { v0 *= 0.08838834764831845f; v1 *= 0.08838834764831845f; }
        *(u32x4*)(p.PROJ + (size_t)row * PS + col) = pack8f(v0, v1);
        if (col >= C_CMP) {
            const int reg = (col - C_CMP) >> 9, c = (col - C_CMP) & 511;
            float* dst = nullptr;
            if (row < NTP) {
                if (reg == 0) dst = p.out + O_PCMP + (size_t)row * 512 + c;
                else if (reg == 1) dst = p.out + O_PSLC + (size_t)row * 512 + c;
                else { const int b = row >> 12, t = row & 4095; if (t >= 3584) dst = p.out + O_PWIN + ((size_t)b * 512 + (t - 3584)) * 512 + c; }
            } else {
                const int rs = row - NTP;
                if (reg == 0) dst = p.out + O_SCMP + (size_t)rs * 512 + c;
                else if (reg == 1) dst = p.out + O_SSLC + (size_t)rs * 512 + c;
                else { const int b = rs >> 2, tq = rs & 3; dst = p.out + O_SWIN + ((size_t)b * 512 + 508 + tq) * 512 + c; }
            }
            if (dst) { *(f32x4*)dst = v0; *(f32x4*)(dst + 4) = v1; }
        }
    }
};
struct EpiG {
    P p;
    typedef NoPre Pre;
    static constexpr int BATCH = 4;
    static constexpr bool COLBIAS = false;
    DEVI Pre pre(int, int) const { return NoPre(); }
    DEVI void put(int row, int col, f32x4 v0, f32x4 v1, const Pre&) const {
#pragma unroll
        for (int k = 0; k < 4; ++k) { v0[k] = sigmoidf_(v0[k]); v1[k] = sigmoidf_(v1[k]); }
        *(u32x4*)(p.G + (size_t)row * 2048 + col) = pack8f(v0, v1);
    }
};
struct EpiM1 {
    P p;
    typedef u32x4 Pre;
    static constexpr int BATCH = 8;
    static constexpr bool COLBIAS = false;
    DEVI Pre pre(int row, int col) const { return *(const u32x4*)(p.G + (size_t)row * 2048 + 1024 + col); }
    DEVI void put(int row, int col, f32x4 v0, f32x4 v1, const Pre& g) const {
        *(u32x4*)(p.TMPB + (size_t)row * 1024 + col) = pack8f(v0 * bf4_lo(g), v1 * bf4_hi(g));
    }
};
struct PreM2 { u32x4 g; u32x4 t; };
struct EpiM2 {
    P p;
    typedef PreM2 Pre;
    static constexpr int BATCH = 8;
    static constexpr bool COLBIAS = false;
    DEVI Pre pre(int row, int col) const { PreM2 r; r.g = *(const u32x4*)(p.G + (size_t)row * 2048 + col); r.t = *(const u32x4*)(p.TMPB + (size_t)row * 1024 + col); return r; }
    DEVI void put(int row, int col, f32x4 v0, f32x4 v1, const Pre& q) const {
        *(u32x4*)(p.MERGED + (size_t)row * 1024 + col) = pack8f(bf4_lo(q.t) + v0 * bf4_lo(q.g), bf4_hi(q.t) + v1 * bf4_hi(q.g));
    }
};
struct PreR { f32x4 a, b; };
struct EpiR {
    P p;
    typedef PreR Pre;
    static constexpr int BATCH = 8;
    static constexpr bool COLBIAS = false;
    DEVI Pre pre(int row, int col) const {
        const float* xr = row < NTP ? p.xp + (size_t)row * 1024 : p.xs + (size_t)(row - NTP) * 1024;
        PreR r; r.a = *(const f32x4*)(xr + col); r.b = *(const f32x4*)(xr + col + 4); return r;
    }
    DEVI void put(int row, int col, f32x4 v0, f32x4 v1, const Pre& x) const {
        *(f32x4*)(p.R + (size_t)row * 1024 + col) = x.a * DN_ALPHA + v0; *(f32x4*)(p.R + (size_t)row * 1024 + col + 4) = x.b * DN_ALPHA + v1;
    }
};
struct EpiPQ {
    P p;
    typedef NoPre Pre;
    static constexpr int BATCH = 4;
    static constexpr bool COLBIAS = false;
    DEVI Pre pre(int, int) const { return NoPre(); }
    DEVI void put(int row, int col, f32x4 v0, f32x4 v1, const Pre&) const { *(u32x4*)(p.PQ + (size_t)row * 2048 + col) = pack8f(v0, v1); }
};

DEVI void stage_mlstm_gates(const P& p, char* smem, int bid, int nblk) {
    const int lane = tid_opq() & 63, wid = tid_opq() >> 6;
    float* bend_s = (float*)smem; float* mloc_s = bend_s + 64;
    for (int bh = bid; bh < 16; bh += nblk) {
        const int b = bh >> 2, h = bh & 3;
        __syncthreads();
        for (int cc = 0; cc < 8; ++cc) {
            const int c = wid * 8 + cc;
            const size_t row = (size_t)b * 4096 + c * 64 + lane;
            const float ip = p.SM[row * 64 + h];
            const float lf = logsigmoidf_(p.SM[row * 64 + 4 + h]);
            float cs = lf;
#pragma unroll
            for (int o = 1; o < 64; o <<= 1) { const float t = __shfl_up(cs, o); if (lane >= o) cs += t; }
            p.BCUM[bh * 4096 + c * 64 + lane] = cs;
            const float bend = __shfl(cs, 63);
            const float mloc = wave_max(bend - cs + ip);
            if (lane == 0) { bend_s[c] = bend; mloc_s[c] = mloc; }
        }
        __syncthreads();
        if (tid_opq() == 0) {
            float m = 0.f;
            for (int c = 0; c < 64; ++c) {
                const float bend = bend_s[c], mloc = mloc_s[c];
                const float mnew = fmaxf(bend + m, mloc);
                p.MPREV[bh * 64 + c] = m;
                p.ACOEF[bh * 64 + c] = __expf(bend + m - mnew);
                p.SCL[bh * 64 + c] = __expf(mloc - mnew);
                p.MLOC[bh * 64 + c] = mloc;
                m = mnew;
            }
            p.out[O_PM + bh] = m;
        }
    }
}

constexpr int MD_KT = 0, MD_VT = 128 * 144, MD_WS = MD_VT + 272 * 144, MD_LDS = MD_WS + 256;
DEVI void stage_mlstm_dc(const P& p, char* smem, int bid, int nblk) {
    const int tid = tid_opq(), lane = tid & 63, wid = tid >> 6, fr = lane & 15, fq = lane >> 4;
    bf16_t* Kt = (bf16_t*)(smem + MD_KT);
    bf16_t* Vt = (bf16_t*)(smem + MD_VT);
    float* ws = (float*)(smem + MD_WS);
    for (int task = bid; task < 1024; task += nblk) {
        const int bh = task >> 6, c = task & 63, b = bh >> 2, h = bh & 3;
        const size_t row0 = (size_t)b * 4096 + c * 64;
        __syncthreads();
        if (tid < 64) {
            const float ip = p.SM[(row0 + tid) * 64 + h];
            float cs = logsigmoidf_(p.SM[(row0 + tid) * 64 + 4 + h]);
#pragma unroll
            for (int o = 1; o < 64; o <<= 1) { const float t = __shfl_up(cs, o); if (tid >= o) cs += t; }
            const float g = __shfl(cs, 63) - cs + ip;
            ws[tid] = __expf(g - wave_max(g));
        }
        __syncthreads();
        {
            const int sidx = tid & 63, ch = tid >> 6;
            const float w = ws[sidx];
#pragma unroll
            for (int half = 0; half < 2; ++half) {
                const u32x4 kk = *(const u32x4*)(p.PROJ + (row0 + sidx) * PS + C_AK + h * 128 + half * 64 + ch * 8);
#pragma unroll
                for (int e = 0; e < 4; ++e) {
                    Kt[(half * 64 + ch * 8 + e * 2) * 72 + sidx] = f2bf(w * __uint_as_float(kk[e] << 16));
                    Kt[(half * 64 + ch * 8 + e * 2 + 1) * 72 + sidx] = f2bf(w * __uint_as_float(kk[e] & 0xFFFF0000u));
                }
            }
#pragma unroll
            for (int q4 = 0; q4 < 4; ++q4) {
                const u32x4 vv = *(const u32x4*)(p.PROJ + (row0 + sidx) * PS + C_AV + h * 256 + q4 * 64 + ch * 8);
#pragma unroll
                for (int e = 0; e < 4; ++e) {
                    Vt[(q4 * 64 + ch * 8 + e * 2) * 72 + sidx] = (bf16_t)(vv[e] & 0xFFFFu);
                    Vt[(q4 * 64 + ch * 8 + e * 2 + 1) * 72 + sidx] = (bf16_t)(vv[e] >> 16);
                }
            }
            for (int i = tid; i < 16 * 64; i += 512) Vt[(256 + (i >> 6)) * 72 + (i & 63)] = (i >> 6) == 0 ? (bf16_t)0x3F80 : (bf16_t)0;
        }
        __syncthreads();
        const int nvt = wid == 0 ? 3 : 2;
        for (int vi = 0; vi < nvt; ++vi) {
            const int vt = vi < 2 ? wid * 2 + vi : 16;
            f32x4 acc[8];
#pragma unroll
            for (int dt = 0; dt < 8; ++dt) acc[dt] = (f32x4){0.f, 0.f, 0.f, 0.f};
#pragma unroll
            for (int ks = 0; ks < 2; ++ks) {
                const bf16x8 bf = *(const bf16x8*)(Vt + (vt * 16 + fr) * 72 + ks * 32 + fq * 8);
#pragma unroll
                for (int dt = 0; dt < 8; ++dt) {
                    const bf16x8 af = *(const bf16x8*)(Kt + (dt * 16 + fr) * 72 + ks * 32 + fq * 8);
                    acc[dt] = __builtin_amdgcn_mfma_f32_16x16x32_bf16(af, bf, acc[dt], 0, 0, 0);
                }
            }
            const int v = vt * 16 + fr;
            if (v <= 256) {
#pragma unroll
                for (int dt = 0; dt < 8; ++dt) *(f32x4*)(p.DC + ((size_t)task * 272 + v) * 128 + dt * 16 + fq * 4) = acc[dt];
            }
        }
    }
}

DEVI void stage_mlstm_scan(const P& p, int bid, int nblk) {
    const int nthr = 512;
    for (int e = bid * nthr + tid_opq(); e < 16 * 257 * 32; e += nblk * nthr) {
        const int bh = e / (257 * 32), r = e % (257 * 32), v = r >> 5, d = (r & 31) * 4;
        f32x4 C = {0.f, 0.f, 0.f, 0.f};
        const float* ac = p.ACOEF + bh * 64; const float* sc = p.SCL + bh * 64;
        const size_t base = ((size_t)(bh * 64) * 272 + v) * 128 + d, cstride = (size_t)272 * 128;
#pragma unroll 1
        for (int c0 = 0; c0 < 64; c0 += 8) {
            f32x4 dc[8];
#pragma unroll
            for (int i = 0; i < 8; ++i) dc[i] = __builtin_nontemporal_load((const f32x4*)(p.DC + base + (size_t)(c0 + i) * cstride));
#pragma unroll
            for (int i = 0; i < 8; ++i) {
                u32x2 o; o.x = pack2(C[0], C[1]); o.y = pack2(C[2], C[3]);
                *(u32x2*)(p.CPT + base + (size_t)(c0 + i) * cstride) = o;
                C = C * ac[c0 + i] + dc[i] * sc[c0 + i];
            }
        }
        if (v < 256) {
#pragma unroll
            for (int k = 0; k < 4; ++k) p.out[O_PC + ((size_t)bh * 128 + d + k) * 256 + v] = C[k];
        } else *(f32x4*)(p.out + O_PN + bh * 128 + d) = C;
    }
}

constexpr int MO_Q = 0, MO_K = 64 * 272, MO_VT = MO_K + 64 * 272, MO_P = MO_VT + 272 * 144, MO_SC = MO_P + 64 * 144, MO_HS = MO_SC + 2048, MO_LDS = MO_HS + 64 * 256 * 4;
static_assert(MO_LDS <= 152 * 1024, "lds");
DEVI void stage_mlstm_out(const P& p, char* smem, int bid, int nblk) {
    const int tid = tid_opq(), lane = tid & 63, wid = tid >> 6, fr = lane & 15, fq = lane >> 4;
    bf16_t* Qs = (bf16_t*)(smem + MO_Q);
    bf16_t* Ks = (bf16_t*)(smem + MO_K);
    bf16_t* Vt = (bf16_t*)(smem + MO_VT);
    bf16_t* Ps = (bf16_t*)(smem + MO_P);
    float* sc = (float*)(smem + MO_SC);
    float* rowt = sc; float* colt = sc + 64; float* wint = sc + 128; float* emt = sc + 192; float* den = sc + 256;
    float* hs = (float*)(smem + MO_HS);
    for (int task = bid; task < 1024; task += nblk) {
        const int bh = task >> 6, c = task & 63, b = bh >> 2, h = bh & 3;
        const size_t row0 = (size_t)b * 4096 + c * 64;
        __syncthreads();
        {
            for (int i = tid; i < 64 * 16; i += 512) {
                const int t = i >> 4, ch = i & 15;
                *(u32x4*)(Qs + t * 136 + ch * 8) = *(const u32x4*)(p.PROJ + (row0 + t) * PS + C_AQ + h * 128 + ch * 8);
                *(u32x4*)(Ks + t * 136 + ch * 8) = *(const u32x4*)(p.PROJ + (row0 + t) * PS + C_AK + h * 128 + ch * 8);
            }
            const int sidx = tid & 63, ch = tid >> 6;
#pragma unroll
            for (int q4 = 0; q4 < 4; ++q4) {
                const u32x4 vv = *(const u32x4*)(p.PROJ + (row0 + sidx) * PS + C_AV + h * 256 + q4 * 64 + ch * 8);
#pragma unroll
                for (int e = 0; e < 4; ++e) {
                    Vt[(q4 * 64 + ch * 8 + e * 2) * 72 + sidx] = (bf16_t)(vv[e] & 0xFFFFu);
                    Vt[(q4 * 64 + ch * 8 + e * 2 + 1) * 72 + sidx] = (bf16_t)(vv[e] >> 16);
                }
            }
            for (int i = tid; i < 16 * 64; i += 512) Vt[(256 + (i >> 6)) * 72 + (i & 63)] = (i >> 6) == 0 ? (bf16_t)0x3F80 : (bf16_t)0;
            if (wid == 0) {
                const float bc = p.BCUM[bh * 4096 + c * 64 + lane], ip = p.SM[(row0 + lane) * 64 + h];
                const float mprev = p.MPREV[task];
                float pm = ip - bc;
#pragma unroll
                for (int o = 1; o < 64; o <<= 1) { const float t = __shfl_up(pm, o); if (lane >= o) pm = fmaxf(pm, t); }
                const float mt = fmaxf(bc + mprev, bc + pm);
                rowt[lane] = bc - mt; colt[lane] = ip - bc; wint[lane] = __expf(bc + mprev - mt); emt[lane] = __expf(-mt);
            }
        }
        __syncthreads();
        {
            const int tt = wid >> 1;
#pragma unroll
            for (int si = 0; si < 2; ++si) {
                const int st = (wid & 1) * 2 + si;
                f32x4 acc = (f32x4){0.f, 0.f, 0.f, 0.f};
                if (st <= tt) {
#pragma unroll
                    for (int ks = 0; ks < 4; ++ks) {
                        const bf16x8 af = *(const bf16x8*)(Qs + (tt * 16 + fr) * 136 + ks * 32 + fq * 8);
                        const bf16x8 bf = *(const bf16x8*)(Ks + (st * 16 + fr) * 136 + ks * 32 + fq * 8);
                        acc = __builtin_amdgcn_mfma_f32_16x16x32_bf16(af, bf, acc, 0, 0, 0);
                    }
                }
                const int s = st * 16 + fr; const float ct = colt[s];
#pragma unroll
                for (int r = 0; r < 4; ++r) {
                    const int t = tt * 16 + fq * 4 + r;
                    const float pv = (s <= t) ? acc[r] * __expf(rowt[t] + ct) : 0.f;
                    Ps[t * 72 + s] = f2bf(pv);
                }
            }
        }
        __syncthreads();
        {
            const bf16_t* cpt = p.CPT + (size_t)task * 272 * 128;
            f32x4 acc[4][2];
#pragma unroll
            for (int tt = 0; tt < 4; ++tt)
#pragma unroll
                for (int vi = 0; vi < 2; ++vi) acc[tt][vi] = (f32x4){0.f, 0.f, 0.f, 0.f};
            f32x4 accd = (f32x4){0.f, 0.f, 0.f, 0.f};
            bf16x8 cb[4][2], cd[4];
#pragma unroll
            for (int ks = 0; ks < 4; ++ks) {
#pragma unroll
                for (int vi = 0; vi < 2; ++vi) cb[ks][vi] = *(const bf16x8*)(cpt + (size_t)((wid * 2 + vi) * 16 + fr) * 128 + ks * 32 + fq * 8);
                cd[ks] = *(const bf16x8*)(cpt + (size_t)(256 + fr) * 128 + ks * 32 + fq * 8);
            }
#pragma unroll
            for (int ks = 0; ks < 4; ++ks) {
                bf16x8 af[4];
#pragma unroll
                for (int tt = 0; tt < 4; ++tt) af[tt] = *(const bf16x8*)(Qs + (tt * 16 + fr) * 136 + ks * 32 + fq * 8);
#pragma unroll
                for (int vi = 0; vi < 2; ++vi) {
#pragma unroll
                    for (int tt = 0; tt < 4; ++tt) acc[tt][vi] = __builtin_amdgcn_mfma_f32_16x16x32_bf16(af[tt], cb[ks][vi], acc[tt][vi], 0, 0, 0);
                }
                if (wid < 4) {
                    const bf16x8 a2 = *(const bf16x8*)(Qs + (wid * 16 + fr) * 136 + ks * 32 + fq * 8);
                    accd = __builtin_amdgcn_mfma_f32_16x16x32_bf16(a2, cd[ks], accd, 0, 0, 0);
                }
            }
#pragma unroll
            for (int tt = 0; tt < 4; ++tt) {
                const f32x4 wv = *(const f32x4*)(wint + tt * 16 + fq * 4);
#pragma unroll
                for (int vi = 0; vi < 2; ++vi) acc[tt][vi] *= wv;
            }
            if (wid < 4) accd *= *(const f32x4*)(wint + wid * 16 + fq * 4);
#pragma unroll
            for (int ks = 0; ks < 2; ++ks) {
                bf16x8 af[4];
#pragma unroll
                for (int tt = 0; tt < 4; ++tt) af[tt] = *(const bf16x8*)(Ps + (tt * 16 + fr) * 72 + ks * 32 + fq * 8);
#pragma unroll
                for (int vi = 0; vi < 2; ++vi) {
                    const bf16x8 bf = *(const bf16x8*)(Vt + ((wid * 2 + vi) * 16 + fr) * 72 + ks * 32 + fq * 8);
#pragma unroll
                    for (int tt = 0; tt < 4; ++tt) acc[tt][vi] = __builtin_amdgcn_mfma_f32_16x16x32_bf16(af[tt], bf, acc[tt][vi], 0, 0, 0);
                }
                if (wid < 4) {
                    const bf16x8 bf = *(const bf16x8*)(Vt + (256 + fr) * 72 + ks * 32 + fq * 8);
                    const bf16x8 a2 = *(const bf16x8*)(Ps + (wid * 16 + fr) * 72 + ks * 32 + fq * 8);
                    accd = __builtin_amdgcn_mfma_f32_16x16x32_bf16(a2, bf, accd, 0, 0, 0);
                }
            }
            if (wid < 4 && fr == 0) *(f32x4*)(den + wid * 16 + fq * 4) = accd;
            __syncthreads();
#pragma unroll
            for (int tt = 0; tt < 4; ++tt) {
                const f32x4 dv = *(const f32x4*)(den + tt * 16 + fq * 4), ev = *(const f32x4*)(emt + tt * 16 + fq * 4);
#pragma unroll
                for (int vi = 0; vi < 2; ++vi)
#pragma unroll
                    for (int r = 0; r < 4; ++r) hs[(tt * 16 + fq * 4 + r) * 256 + (wid * 2 + vi) * 16 + fr] = acc[tt][vi][r] / fmaxf(fabsf(dv[r]), ev[r]);
            }
        }
        __syncthreads();
        u32x2 ovs[8];
#pragma unroll
        for (int rr = 0; rr < 8; ++rr) ovs[rr] = *(const u32x2*)(p.PROJ + (row0 + wid * 8 + rr) * PS + C_AO + h * 256 + lane * 4);
        const f32x4 gg = *(const f32x4*)(p.norm_a_g + h * 256 + lane * 4);
#pragma unroll
        for (int rr = 0; rr < 8; ++rr) {
            const int t = wid * 8 + rr;
            const f32x4 x = *(const f32x4*)(hs + t * 256 + lane * 4);
            const float mean = wave_sum(x[0] + x[1] + x[2] + x[3]) * (1.f / 256.f);
            float q = 0.f;
#pragma unroll
            for (int k = 0; k < 4; ++k) q += (x[k] - mean) * (x[k] - mean);
            const float rs = rsqrtf(wave_sum(q) * (1.f / 256.f) + LN_EPS);
            const u32x2 ov = ovs[rr];
            const float o4[4] = {__uint_as_float(ov.x << 16), __uint_as_float(ov.x & 0xFFFF0000u), __uint_as_float(ov.y << 16), __uint_as_float(ov.y & 0xFFFF0000u)};
            float y[4];
#pragma unroll
            for (int k = 0; k < 4; ++k) y[k] = (x[k] - mean) * rs * gg[k] * sigmoidf_(o4[k]);
            u32x2 o2; o2.x = pack2(y[0], y[1]); o2.y = pack2(y[2], y[3]);
            *(u32x2*)(p.YA + (row0 + t) * 1024 + h * 256 + lane * 4) = o2;
        }
    }
}

DEVI void stage_mlstm_sample(const P& p, char* smem, int bid, int nblk) {
    float* qs = (float*)smem;
    float* ks = qs + 512;
    float* vs = ks + 512;
    float* part = vs + 1024;
    float* hs = part + 2048;
    float* sc = hs + 1024;
    float* bc = sc; float* ip = sc + 4; float* mt = sc + 8; float* wint = sc + 12; float* emt = sc + 16; float* ww = sc + 20; float* den = sc + 24;
    float* Pm = sc + 32;
    float* misc = sc + 48;
    const int tid = tid_opq(), lane = tid & 63, wid = tid >> 6;
    for (int task = bid; task < 512; task += nblk) {
        const int b = task >> 2, h = task & 3;
        const size_t row0 = (size_t)NTP + b * 4;
        __syncthreads();
        { const int t = tid >> 7, d = tid & 127;
          qs[tid] = bf2f(p.PROJ[(row0 + t) * PS + C_AQ + h * 128 + d]);
          ks[tid] = bf2f(p.PROJ[(row0 + t) * PS + C_AK + h * 128 + d]); }
        for (int idx = tid; idx < 1024; idx += 512) { const int t = idx >> 8, v = idx & 255; vs[idx] = bf2f(p.PROJ[(row0 + t) * PS + C_AV + h * 256 + v]); }
        if (tid == 0) {
            const float m0 = p.state_m[task];
            float cs = 0.f;
            for (int t = 0; t < 4; ++t) { cs += logsigmoidf_(p.SM[(row0 + t) * 64 + 4 + h]); bc[t] = cs; ip[t] = p.SM[(row0 + t) * 64 + h]; }
            for (int t = 0; t < 4; ++t) {
                float mx = bc[t] + m0;
                for (int s = 0; s <= t; ++s) mx = fmaxf(mx, bc[t] - bc[s] + ip[s]);
                mt[t] = mx; wint[t] = __expf(bc[t] + m0 - mx); emt[t] = __expf(-mx);
            }
            const float bend = bc[3];
            float mnew = bend + m0;
            for (int s = 0; s < 4; ++s) mnew = fmaxf(mnew, bend - bc[s] + ip[s]);
            misc[0] = __expf(bend + m0 - mnew);
            for (int s = 0; s < 4; ++s) ww[s] = __expf(bend - bc[s] + ip[s] - mnew);
            p.out[O_SM + task] = mnew;
        }
        __syncthreads();
        if (tid < 16) {
            const int t = tid >> 2, s = tid & 3;
            float a = 0.f;
            if (s <= t) { for (int d = 0; d < 128; ++d) a += qs[t * 128 + d] * ks[s * 128 + d]; a *= __expf(bc[t] - bc[s] + ip[s] - mt[t]); }
            Pm[tid] = a;
        }
        __syncthreads();
        if (tid < 4) {
            const int t = tid; float qn = 0.f;
            for (int d = 0; d < 128; ++d) qn += qs[t * 128 + d] * p.state_n[(size_t)task * 128 + d];
            den[t] = wint[t] * qn + Pm[t * 4] + Pm[t * 4 + 1] + Pm[t * 4 + 2] + Pm[t * 4 + 3];
        }
        const float a = misc[0];
        if (tid >= 128 && tid < 256) {
            const int d = tid - 128;
            float n = a * p.state_n[(size_t)task * 128 + d];
            for (int s = 0; s < 4; ++s) n += ww[s] * ks[s * 128 + d];
            p.out[O_SN + (size_t)task * 128 + d] = n;
        }
        {
            const int v = tid & 255, dh = tid >> 8;
            float acc[4] = {0.f, 0.f, 0.f, 0.f};
            float wv[4];
#pragma unroll
            for (int s = 0; s < 4; ++s) wv[s] = ww[s] * vs[s * 256 + v];
            for (int d0 = dh * 64; d0 < dh * 64 + 64; d0 += 16) {
                float c0[16];
#pragma unroll
                for (int i = 0; i < 16; ++i) c0[i] = __builtin_nontemporal_load(p.state_C + ((size_t)task * 128 + d0 + i) * 256 + v);
#pragma unroll
                for (int i = 0; i < 16; ++i) {
                    const int d = d0 + i;
#pragma unroll
                    for (int t = 0; t < 4; ++t) acc[t] += qs[t * 128 + d] * c0[i];
                    float cn = a * c0[i];
#pragma unroll
                    for (int s = 0; s < 4; ++s) cn += ks[s * 128 + d] * wv[s];
                    __builtin_nontemporal_store(cn, p.out + O_SC + ((size_t)task * 128 + d) * 256 + v);
                }
            }
#pragma unroll
            for (int t = 0; t < 4; ++t) part[(dh * 4 + t) * 256 + v] = acc[t];
        }
        __syncthreads();
        if (tid < 256) {
            const int v = tid;
#pragma unroll
            for (int t = 0; t < 4; ++t) {
                float num = wint[t] * (part[t * 256 + v] + part[(4 + t) * 256 + v]);
#pragma unroll
                for (int s = 0; s < 4; ++s) num += Pm[t * 4 + s] * vs[s * 256 + v];
                hs[t * 256 + v] = num / fmaxf(fabsf(den[t]), emt[t]);
            }
        }
        __syncthreads();
        if (wid < 4) {
            const int t = wid;
            const f32x4 x = *(const f32x4*)(hs + t * 256 + lane * 4);
            const float mean = wave_sum(x[0] + x[1] + x[2] + x[3]) * (1.f / 256.f);
            float q = 0.f;
#pragma unroll
            for (int k = 0; k < 4; ++k) q += (x[k] - mean) * (x[k] - mean);
            const float rs = rsqrtf(wave_sum(q) * (1.f / 256.f) + LN_EPS);
            float y[4];
#pragma unroll
            for (int k = 0; k < 4; ++k) {
                const int vi = lane * 4 + k;
                const float o = bf2f(p.PROJ[(row0 + t) * PS + C_AO + h * 256 + vi]);
                y[k] = (x[k] - mean) * rs * p.norm_a_g[h * 256 + vi] * sigmoidf_(o);
            }
            u32x2 o2; o2.x = pack2(y[0], y[1]); o2.y = pack2(y[2], y[3]);
            *(u32x2*)(p.YA + (row0 + t) * 1024 + h * 256 + lane * 4) = o2;
        }
    }
}

constexpr int CP_ABUF = 33280, CP_WBUF = 18432, CP_A = 0, CP_W = 2 * CP_ABUF, CP_LDS = CP_W + 2 * CP_WBUF;
constexpr int CP_AROW = 1024 + 8;
DEVI void stage_compress(const P& p, char* smem, int bid, int nblk, int only = -1) {
    const int tid = tid_opq(), lane = tid & 63, wid = tid >> 6, fr = lane & 15, fq = lane >> 4;
    const int kv = wid & 1, rt = wid >> 1;
    const int n_it = only >= 0 ? 1 : (256 + nblk - 1) / nblk + (16 + nblk - 1) / nblk;
    for (int it = 0; it < n_it; ++it) {
        const int ns_it = (256 + nblk - 1) / nblk;
        const int task = only >= 0 ? only : it < ns_it ? bid + it * nblk : 256 + (nblk - 1 - bid) + (it - ns_it) * nblk;
        if (only < 0 && (task >= 272 || (it < ns_it && task >= 256))) continue;
        const bool prompt = task >= 256;
        const int rowbytes = prompt ? 1024 : 2048, npieces = prompt ? 2 : 4;
        const char* src[4]; int dsto[4];
#pragma unroll
        for (int q = 0; q < 4; ++q) {
            const int off = q * 8192 + tid * 16, r = off / rowbytes, cb = off % rowbytes;
            if (prompt) { const int blk = (task - 256) * 16 + (r & 15); src[q] = (const char*)(p.PROJ + (size_t)blk * 64 * PS + C_CMP) + cb; dsto[q] = (r & 15) * CP_AROW * 2 + cb; }
            else { const int gb = task * 16 + r, b = gb >> 5, n = gb & 31; const int page = p.page_table[b * 16 + (n >> 1)];
                   src[q] = (const char*)(p.cache_cmp + ((size_t)page * 128 + (n & 1) * 64) * 512) + cb; dsto[q] = r * CP_AROW * 2 + (cb >> 1); }
        }
        const size_t sstride = prompt ? (size_t)PS * 2 : 2048;
        const char* wsrc[2]; int wdst[2];
#pragma unroll
        for (int q = 0; q < 2; ++q) { const int idx = q * 512 + tid, row = idx >> 3, ch = idx & 7; wsrc[q] = (const char*)(p.WCT + (size_t)row * 4096) + ch * 16; wdst[q] = row * 144 + ch * 16; }
        f32x4 acc[4];
#pragma unroll
        for (int nt = 0; nt < 4; ++nt) acc[nt] = (f32x4){0.f, 0.f, 0.f, 0.f};
        f32x4 ra0[4], ra1[4]; u32x4 rw0[2], rw1[2];
        auto issue = [&](int l, f32x4 (&ra)[4], u32x4 (&rw)[2]) {
#pragma unroll
            for (int q = 0; q < 4; ++q) if (q < npieces) ra[q] = prompt ? *(const f32x4*)(src[q] + (size_t)l * sstride) : __builtin_nontemporal_load((const f32x4*)(src[q] + (size_t)l * sstride));
#pragma unroll
            for (int q = 0; q < 2; ++q) rw[q] = *(const u32x4*)(wsrc[q] + l * 128);
        };
        auto commit = [&](int buf, const f32x4 (&ra)[4], const u32x4 (&rw)[2]) {
            char* ab = smem + CP_A + buf * CP_ABUF; char* wbuf = smem + CP_W + buf * CP_WBUF;
#pragma unroll
            for (int q = 0; q < 4; ++q) if (q < npieces) {
                if (prompt) *(f32x4*)(ab + dsto[q]) = ra[q];
                else { u32x2 o; o.x = pack2(ra[q][0], ra[q][1]); o.y = pack2(ra[q][2], ra[q][3]); *(u32x2*)(ab + dsto[q]) = o; }
            }
#pragma unroll
            for (int q = 0; q < 2; ++q) *(u32x4*)(wbuf + wdst[q]) = rw[q];
        };
        auto consume = [&](int buf) {
            const char* ab = smem + CP_A + buf * CP_ABUF; const char* wbuf = smem + CP_W + buf * CP_WBUF;
            const bf16_t* arow = (const bf16_t*)ab + (rt * 4 + (fr >> 2)) * CP_AROW + kv * 256 + (fr & 3) * 64 + fq * 8;
#pragma unroll
            for (int hf = 0; hf < 2; ++hf) {
                const bf16x8 a = *(const bf16x8*)(arow + hf * 32);
#pragma unroll
                for (int nt = 0; nt < 4; ++nt) {
                    const bf16x8 bfrag = *(const bf16x8*)(wbuf + (kv * 64 + nt * 16 + fr) * 144 + hf * 64 + fq * 16);
                    acc[nt] = __builtin_amdgcn_mfma_f32_16x16x32_bf16(a, bfrag, acc[nt], 0, 0, 0);
                }
            }
        };
        __syncthreads();
        issue(0, ra0, rw0); issue(1, ra1, rw1); commit(0, ra0, rw0); issue(2, ra0, rw0);
        __syncthreads();
#pragma unroll 1
        for (int l = 0; l < 64; l += 2) {
            consume(0);
            commit(1, ra1, rw1);
            if (l + 3 < 64) issue(l + 3, ra1, rw1);
            __syncthreads();
            consume(1);
            if (l + 2 < 64) commit(0, ra0, rw0);
            if (l + 4 < 64) issue(l + 4, ra0, rw0);
            __syncthreads();
        }
        {
            const int ob = prompt ? (task - 256) * 16 + rt * 4 + fq : 256 + task * 16 + rt * 4 + fq;
#pragma unroll
            for (int nt = 0; nt < 4; ++nt) {
                const float bias = p.PW[kv * 64 + nt * 16 + fr];
#pragma unroll
                for (int r = 0; r < 4; ++r) p.KC[(size_t)ob * 512 + kv * 256 + r * 64 + nt * 16 + fr] = acc[nt][r] + bias;
            }
        }
    }
}

typedef float f32x16 __attribute__((ext_vector_type(16)));
typedef short s16x4 __attribute__((ext_vector_type(4)));
typedef __attribute__((address_space(3))) const char* lds_cptr;
#define MFMA32(a, b, c) __builtin_amdgcn_mfma_f32_32x32x16_bf16(a, b, c, 0, 0, 0)
DEVI int crow(int r, int hi) { return (r & 3) + 8 * (r >> 2) + 4 * hi; }
DEVI unsigned cvtpk(float lo, float hi) { return pack2(lo, hi); }
DEVI s16x4 vtr(lds_cptr p) { return __builtin_bit_cast(s16x4, __builtin_amdgcn_ds_read_tr16_b64_v4i16((__attribute__((address_space(3))) s16x4*)p)); }
DEVI float half_max(float m) { auto rr = __builtin_amdgcn_permlane32_swap(__float_as_uint(m), __float_as_uint(m), false, false); return fmaxf(__uint_as_float(rr[0]), __uint_as_float(rr[1])); }
DEVI float half_sum(float m) { auto rr = __builtin_amdgcn_permlane32_swap(__float_as_uint(m), __float_as_uint(m), false, false); return __uint_as_float(rr[0]) + __uint_as_float(rr[1]); }

struct BlkDesc { const char* k; int stride_bytes; int f32; int count; int pos0; };
DEVI void blk_load(const BlkDesc& d, int tid, u32x4& rk, u32x4& rv) {
    const int key = tid & 63, chunk = tid >> 6;
    rk = (u32x4){0u, 0u, 0u, 0u}; rv = rk;
    if (key < d.count) {
        const char* kr = d.k + (size_t)key * d.stride_bytes;
        if (d.f32) {
            const f32x4* s1 = (const f32x4*)(kr + chunk * 32); const f32x4* s2 = (const f32x4*)(kr + 1024 + chunk * 32);
            rk = pack8f(s1[0], s1[1]); rv = pack8f(s2[0], s2[1]);
        } else { rk = *(const u32x4*)(kr + chunk * 16); rv = *(const u32x4*)(kr + 512 + chunk * 16); }
    }
}
DEVI void blk_store(char* kimg, char* vimg, int tid, const u32x4& rk, const u32x4& rv) {
    const int key = tid & 63, chunk = tid >> 6;
    *(u32x4*)(kimg + chunk * 1024 + key * 16) = rk;
    *(u32x4*)(vimg + (chunk >> 2) * 4096 + key * 64 + (chunk & 3) * 16) = rv;
}

DEVI void attn_tile(const char* kimg, const char* vimg, const bf16x8 (&qr)[4], float& m2, float& lsum, f32x16& o0, f32x16& o1, f32x16& s0, f32x16& s1,
                    float sl, float bb, int lh, int ll, bool fast, float* wsf_hi  , float* wsf_r  , int lane) {
    const int r32 = lane & 31, hi = lane >> 5;
    const f32x16 z = {};
    s0 = z; s1 = z;
    {
        const char* kp = kimg + hi * 1024 + r32 * 16;
#pragma unroll
        for (int d0 = 0; d0 < 4; ++d0) {
            const bf16x8 k0 = *(const bf16x8*)(kp + d0 * 2048), k1 = *(const bf16x8*)(kp + d0 * 2048 + 512);
            s0 = MFMA32(k0, qr[d0], s0); s1 = MFMA32(k1, qr[d0], s1);
        }
    }
    float mx = -1e30f;
    if (fast) {
#pragma unroll
        for (int r = 0; r < 16; ++r) {
            const int c = (r & 3) + 8 * (r >> 2);
            s0[r] = fmaf(s0[r], 1.4426950408889634f, fmaf(sl, (float)c, bb)); s1[r] = fmaf(s1[r], 1.4426950408889634f, fmaf(sl, (float)(c + 32), bb));
            mx = fmaxf(mx, fmaxf(s0[r], s1[r]));
        }
    } else {
#pragma unroll
        for (int r = 0; r < 16; ++r) {
            const int c = (r & 3) + 8 * (r >> 2);
            const float t0 = fmaf(s0[r], 1.4426950408889634f, fmaf(sl, (float)c, bb)), t1 = fmaf(s1[r], 1.4426950408889634f, fmaf(sl, (float)(c + 32), bb));
            s0[r] = (c <= lh && c > ll) ? t0 : -INFINITY; s1[r] = (c + 32 <= lh && c + 32 > ll) ? t1 : -INFINITY;
            mx = fmaxf(mx, fmaxf(s0[r], s1[r]));
        }
    }
    mx = half_max(mx);
    const float mnew = fmaxf(m2, mx);
    const float f = __builtin_amdgcn_exp2f(m2 - mnew);
    m2 = mnew;
    float ps = 0.f;
#pragma unroll
    for (int r = 0; r < 16; ++r) { s0[r] = __builtin_amdgcn_exp2f(s0[r] - mnew); s1[r] = __builtin_amdgcn_exp2f(s1[r] - mnew); ps += s0[r] + s1[r]; }
    lsum = lsum * f + ps;
    if (__any(f != 1.f)) {
        if (hi == 0) *wsf_r = f;
        asm volatile("s_waitcnt lgkmcnt(0)" ::: "memory");
#pragma unroll
        for (int a = 0; a < 4; ++a) {
            const f32x4 fv = *(const f32x4*)(wsf_hi + 8 * a);
#pragma unroll
            for (int k = 0; k < 4; ++k) { o0[4 * a + k] *= fv[k]; o1[4 * a + k] *= fv[k]; }
        }
        asm volatile("s_waitcnt lgkmcnt(0)" ::: "memory");
    }
    u32x4 pw[4];
#pragma unroll
    for (int k = 0; k < 4; ++k) { pw[0][k] = cvtpk(s0[2 * k], s0[2 * k + 1]); pw[1][k] = cvtpk(s0[8 + 2 * k], s0[8 + 2 * k + 1]); pw[2][k] = cvtpk(s1[2 * k], s1[2 * k + 1]); pw[3][k] = cvtpk(s1[8 + 2 * k], s1[8 + 2 * k + 1]); }
    const lds_cptr vp = (lds_cptr)vimg + ((lane >> 4) & 1) * 32 + (lane & 3) * 8 + (4 * hi + ((lane & 15) >> 2)) * 64;
#pragma unroll
    for (int i = 0; i < 8; ++i) {
        const s16x4 lo = vtr(vp + ((i >> 2) * 4096 + (i & 3) * 1024)), hh = vtr(vp + ((i >> 2) * 4096 + (i & 3) * 1024 + 512));
        const bf16x8 vf = (bf16x8){lo[0], lo[1], lo[2], lo[3], hh[0], hh[1], hh[2], hh[3]};
        const bf16x8 pf = __builtin_bit_cast(bf16x8, pw[i & 3]);
        if (i < 4) o0 = MFMA32(pf, vf, o0); else o1 = MFMA32(pf, vf, o1);
    }
}

constexpr int NSA_KV0 = 0, NSA_KV1 = 16384, NSA_WSF = 32768, NSA_IMP = NSA_WSF + 2048, NSA_SEL = NSA_IMP + 16384, NSA_LIST = NSA_SEL + 512, NSA_OST = NSA_LIST + 256, NSA_YAC = NSA_OST + 32768, NSA_LDS = NSA_YAC + 65536;
static_assert(NSA_LDS <= 152 * 1024, "lds");

DEVI BlkDesc nsa_desc(const P& p, bool prompt, int b, int g, int branch, int j) {
    BlkDesc d;
    if (prompt) {
        if (branch == 0) { d.k = (const char*)(p.KC + ((size_t)(b * 64) * 512 + g * 64)); d.stride_bytes = 2048; d.f32 = 1; d.count = 64; d.pos0 = 0; }
        else { d.k = (const char*)(p.PROJ + ((size_t)b * 4096 + j * 64) * PS + (branch == 1 ? C_SLC : C_WIN) + g * 64); d.stride_bytes = PS * 2; d.f32 = 0; d.count = 64; d.pos0 = j * 64; }
    } else {
        if (branch == 0) { d.k = (const char*)(p.KC + ((size_t)(256 + b * 32) * 512 + g * 64)); d.stride_bytes = 2048; d.f32 = 1; d.count = 32; d.pos0 = 0; }
        else if (branch == 1 && j < 32) { const int page = p.page_table[b * 16 + (j >> 1)]; d.k = (const char*)(p.cache_slc + ((size_t)page * 128 + (j & 1) * 64) * 512 + g * 64); d.stride_bytes = 2048; d.f32 = 1; d.count = 64; d.pos0 = j * 64; }
        else if (branch == 2 && j < 8) { d.k = (const char*)(p.cache_win + ((size_t)b * 512 + j * 64) * 512 + g * 64); d.stride_bytes = 2048; d.f32 = 1; d.count = 64; d.pos0 = 1536 + j * 64; }
        else { d.k = (const char*)(p.PROJ + ((size_t)NTP + b * 4) * PS + (branch == 1 ? C_SLC : C_WIN) + g * 64); d.stride_bytes = PS * 2; d.f32 = 0; d.count = 4; d.pos0 = 2048; }
    }
    return d;
}

constexpr int NS_IMG = 0, NS_WSF = 131072, NS_IMP = NS_WSF + 2048, NS_SEL = NS_IMP + 2048, NS_LIST = NS_SEL + 64, NS_YC = NS_LIST + 64, NS_PM = NS_YC + 4096, NS_Q = NS_PM + 2048, NS_LDS = NS_Q + 4096;
static_assert(NS_LDS <= 152 * 1024, "lds");
DEVI void wave_stage_block(const BlkDesc& d, char* kimg, char* vimg, int lane) {
    asm volatile("" : "+v"(lane));
    const int rsub = lane >> 4, pc = lane & 15;
    if (d.f32) {
#pragma unroll
        for (int half = 0; half < 2; ++half) {
#pragma unroll
            for (int i0 = 0; i0 < 16; i0 += 6) {
                f32x4 x[6];
#pragma unroll
                for (int i = 0; i < 6; ++i) if (i0 + i < 16) { const int row = 4 * (i0 + i) + rsub; x[i] = row < d.count ? __builtin_nontemporal_load((const f32x4*)(d.k + (size_t)row * d.stride_bytes + half * 1024 + pc * 16)) : (f32x4){0.f, 0.f, 0.f, 0.f}; }
#pragma unroll
                for (int i = 0; i < 6; ++i) if (i0 + i < 16) {
                    const int row = 4 * (i0 + i) + rsub, c = pc >> 1;
                    u32x2 o; o.x = pack2(x[i][0], x[i][1]); o.y = pack2(x[i][2], x[i][3]);
                    if (half == 0) *(u32x2*)(kimg + c * 1024 + row * 16 + (pc & 1) * 8) = o;
                    else *(u32x2*)(vimg + (c >> 2) * 4096 + row * 64 + (c & 3) * 16 + (pc & 1) * 8) = o;
                }
            }
        }
    } else {
        const int row = lane >> 3, c = lane & 7;
#pragma unroll
        for (int i = 0; i < 8; ++i) {
            const int rr = 8 * i + row;
            u32x4 kk = {0u, 0u, 0u, 0u}, vv = {0u, 0u, 0u, 0u};
            if (rr < d.count) { kk = *(const u32x4*)(d.k + (size_t)rr * d.stride_bytes + c * 16); vv = *(const u32x4*)(d.k + (size_t)rr * d.stride_bytes + 512 + c * 16); }
            *(u32x4*)(kimg + c * 1024 + rr * 16) = kk;
            *(u32x4*)(vimg + (c >> 2) * 4096 + rr * 64 + (c & 3) * 16) = vv;
        }
    }
    asm volatile("s_waitcnt lgkmcnt(0)" ::: "memory");
}

DEVI void nsa_sample_unit(const P& p, char* smem, int us) {
    const int tid = tid_opq(), lane = tid & 63, wid = tid >> 6, r32 = lane & 31, hi = lane >> 5;
    const int b = us >> 2, g = us & 3;
    const size_t rowbase = (size_t)NTP + b * 4;
    char* kimg = smem + NS_IMG + wid * 16384; char* vimg = kimg + 8192;
    float* wsf = (float*)(smem + NS_WSF) + wid * 64;
    float* impb = (float*)(smem + NS_IMP);
    unsigned long long* selm = (unsigned long long*)(smem + NS_SEL);
    unsigned char* blist = (unsigned char*)(smem + NS_LIST);
    float* ycmp = (float*)(smem + NS_YC);
    const int tokl = r32 >> 2, head = r32 & 3;
    const bool tok_ok = r32 < 16;
    const int qpos = 2048 + tokl;
    const float slope2 = alibi_slope(g * 4 + head) * 1.4426950408889634f;
    char* qsh = smem + NS_Q;
    int hi4 = 4 * hi; asm volatile("" : "+v"(hi4));
    float* wsf_hi = wsf + hi4; float* wsf_r = wsf + r32;
    f32x16 s0, s1;
    __syncthreads();
    if (wid == 0) {
        bf16x8 qr[4];
        {
            const bf16_t* qp = p.PROJ + (rowbase + (tok_ok ? tokl : 0)) * PS + C_BQ + (g * 4 + head) * 64 + hi * 8;
#pragma unroll
            for (int d0 = 0; d0 < 4; ++d0) {
                u32x4 v = *(const u32x4*)(qp + d0 * 16);
#pragma unroll
                for (int k = 0; k < 4; ++k) { const float lo = __uint_as_float(v[k] << 16) * 0.125f, hh = __uint_as_float(v[k] & 0xFFFF0000u) * 0.125f; v[k] = tok_ok ? ((__float_as_uint(lo) >> 16) | (__float_as_uint(hh) & 0xFFFF0000u)) : 0u; }
                qr[d0] = __builtin_bit_cast(bf16x8, v);
                *(u32x4*)(qsh + d0 * 1024 + lane * 16) = v;
            }
        }
        f32x16 o0 = {}, o1 = {}; float m2 = -1e30f, lsum = 0.f;
        const BlkDesc d = nsa_desc(p, false, b, g, 0, 0);
        wave_stage_block(d, kimg, vimg, lane);
        const int lh = 31 - hi4;
        const float sl = 64.f * slope2;
        attn_tile(kimg, vimg, qr, m2, lsum, o0, o1, s0, s1, sl, tok_ok ? sl * (float)(hi4 - 32) : -INFINITY, lh, -1000, false, wsf_hi, wsf_r, lane);
        const float lt = half_sum(lsum);
        const float inv = lt > 0.f ? 1.f / lt : 0.f;
        unsigned x[64];
#pragma unroll
        for (int r = 0; r < 16; ++r) {
#pragma unroll
            for (int n = 0; n < 2; ++n) {
                float a = (n == 0 ? s0[r] : s1[r]) * inv;
                a += __shfl_xor(a, 1); a += __shfl_xor(a, 2);
                const int j = (r & 3) + 8 * (r >> 2) + 32 * n + hi4;
                if (j == 32 || j == 0) a = 5.0f;
                if (j > 32) a = -2.0f;
                const unsigned u = __float_as_uint(a);
                const unsigned o = (u & 0x80000000u) ? ~u : (u | 0x80000000u);
                x[n * 16 + r] = (o & ~63u) | (unsigned)(63 - j);
            }
        }
        float fac = 0.f;
        if (tok_ok && lt > 0.f) fac = sigmoidf_(p.SM[(rowbase + tokl) * 64 + 8 + g * 4 + head]) / lt;
        if (hi == 0) *wsf_r = fac;
        asm volatile("s_waitcnt lgkmcnt(0)" ::: "memory");
#pragma unroll
        for (int a = 0; a < 2; ++a) {
            const f32x4 fv = *(const f32x4*)(wsf_hi + 8 * a);
#pragma unroll
            for (int k = 0; k < 4; ++k) { float* yp = ycmp + (8 * a + k + hi4) * 64 + r32; yp[0] = o0[4 * a + k] * fv[k]; yp[32] = o1[4 * a + k] * fv[k]; }
        }
        asm volatile("s_waitcnt lgkmcnt(0)" ::: "memory");
        {
            sort16_desc<0>(x); sort16_desc<16>(x);
            unsigned th[16], oth[16], fin[16];
            merge_top16(&x[0], &x[16], th);
#pragma unroll
            for (int i = 0; i < 16; ++i) { auto rr = __builtin_amdgcn_permlane32_swap(th[i], th[i], false, false); oth[i] = hi ? rr[0] : rr[1]; }
            merge_top16(th, oth, fin);
            unsigned long long mask = 0ull;
#pragma unroll
            for (int i = 0; i < 16; ++i) mask |= 1ull << (63u - (fin[i] & 63u));
            if (head == 0 && hi == 0 && r32 < 16) selm[r32 >> 2] = mask;
        }
        asm volatile("s_waitcnt lgkmcnt(0)" ::: "memory");
        {
            const unsigned long long u = selm[0] | selm[1] | selm[2] | selm[3];
            const int n = __builtin_popcountll(u);
            if ((u >> lane) & 1ull) blist[1 + __builtin_popcountll(u & ((1ull << lane) - 1ull))] = (unsigned char)(0x40 | lane);
            if (lane <= 8) blist[1 + n + lane] = (unsigned char)(0x80 | lane);
            if (lane == 0) blist[0] = (unsigned char)(n + 9);
        }
    }
    __syncthreads();
    const int nb = blist[0];
    const unsigned long long mysel = tok_ok ? selm[tokl] : 0ull;
    int nslc = 0;
    for (int i = 0; i < nb; ++i) nslc += (blist[1 + i] >> 6) == 1 ? 1 : 0;
    float so[16], ms, lst;
    float wo[16], mw, lwt;
#pragma unroll 1
    for (int pass = 0; pass < 2; ++pass) {
        f32x16 o0 = {}, o1 = {}; float m2 = -1e30f, lsum = 0.f;
        const int i0 = pass == 0 ? 0 : nslc, i1 = pass == 0 ? nslc : nb;
#pragma unroll 1
        for (int i = i0 + wid; i < i1; i += 8) {
            const int e = blist[1 + i], br = e >> 6, j = e & 63;
            const BlkDesc d = nsa_desc(p, false, b, g, br, j);
            wave_stage_block(d, kimg, vimg, lane);
            asm volatile("" : "+v"(hi4));
            const bool lsel = tok_ok && (br == 2 || ((mysel >> j) & 1ull));
            const int rel = qpos - d.pos0;
            const int lh = (rel < d.count - 1 ? rel : d.count - 1) - hi4;
            const int ll = (br == 2 ? rel - 512 : -1000) - hi4;
            const bool fast = __all(!lsel || (lh >= 59 && ll < 0));
            const float bb = lsel ? slope2 * (float)(hi4 + d.pos0 - 2048) : -INFINITY;
            bf16x8 qr[4];
#pragma unroll
            for (int d0 = 0; d0 < 4; ++d0) qr[d0] = *(const bf16x8*)(qsh + d0 * 1024 + lane * 16);
            attn_tile(kimg, vimg, qr, m2, lsum, o0, o1, s0, s1, slope2, bb, lh, ll, fast, wsf_hi, wsf_r, lane);
        }
        const float lt = half_sum(lsum);
        if (pass == 0) { ms = m2; lst = lt;
#pragma unroll
            for (int r = 0; r < 8; ++r) { so[r] = o0[r]; so[8 + r] = o1[r]; } }
        else { mw = m2; lwt = lt;
#pragma unroll
            for (int r = 0; r < 8; ++r) { wo[r] = o0[r]; wo[8 + r] = o1[r]; } }
    }
    {
        float* po = (float*)kimg;
        float* pm = (float*)(smem + NS_PM) + wid * 64;
        if (lane < 16) { pm[lane * 2] = ms; pm[lane * 2 + 1] = lst; pm[32 + lane * 2] = mw; pm[32 + lane * 2 + 1] = lwt; }
#pragma unroll
        for (int a = 0; a < 2; ++a)
#pragma unroll
            for (int k = 0; k < 4; ++k) {
                float* yp = po + (8 * a + k + hi4) * 64 + r32;
                yp[0] = so[4 * a + k]; yp[32] = so[8 + 4 * a + k]; yp[1024] = wo[4 * a + k]; yp[1024 + 32] = wo[8 + 4 * a + k];
            }
    }
    __syncthreads();
    {
        const int row = tid >> 5, dcol = tid & 31, tk = row >> 2, hd = row & 3;
        float res[2][2];
#pragma unroll
        for (int br = 0; br < 2; ++br) {
            float M = -1e30f;
#pragma unroll
            for (int w = 0; w < 8; ++w) M = fmaxf(M, ((const float*)(smem + NS_PM))[w * 64 + br * 32 + row * 2]);
            float L = 0.f, a0 = 0.f, a1 = 0.f;
#pragma unroll
            for (int w = 0; w < 8; ++w) {
                const float* pmw = (const float*)(smem + NS_PM) + w * 64 + br * 32 + row * 2;
                const float f = __builtin_amdgcn_exp2f(pmw[0] - M);
                const float* pow_ = (const float*)(smem + NS_IMG + w * 16384) + br * 1024 + row * 64 + dcol;
                L += pmw[1] * f; a0 += pow_[0] * f; a1 += pow_[32] * f;
            }
            const float gate = sigmoidf_(p.SM[(rowbase + tk) * 64 + 8 + (br + 1) * 16 + g * 4 + hd]);
            const float sc = L > 0.f ? gate / L : 0.f;
            res[br][0] = a0 * sc; res[br][1] = a1 * sc;
        }
        const float y0 = ycmp[row * 64 + dcol] + res[0][0] + res[1][0], y1 = ycmp[row * 64 + dcol + 32] + res[0][1] + res[1][1];
        bf16_t* yb = p.YB + (rowbase + tk) * 1024 + (g * 4 + hd) * 64;
        yb[dcol] = f2bf(y0); yb[dcol + 32] = f2bf(y1);
    }
}

constexpr int NP_KVB = 18432, NP_KV0 = 0, NP_KV1 = NP_KVB, NP_WSF = 2 * NP_KVB, NP_IMP = NP_WSF + 2048, NP_SEL = NP_IMP + 16384, NP_LIST = NP_SEL + 512, NP_YAC = NP_LIST + 256, NP_LDS = NP_YAC + 65536;
static_assert(NP_LDS <= 152 * 1024, "lds");
DEVI void blk_store_ext(const BlkDesc& d, int pstep, int poff, int t0, char* kimg, char* vimg, int tid, const u32x4& rk, const u32x4& rv) {
    const int key = tid & 63, chunk = tid >> 6;
    *(u32x4*)(kimg + chunk * 1024 + key * 16) = rk;
    *(u32x4*)(vimg + (chunk >> 2) * 4096 + key * 64 + (chunk & 3) * 16) = rv;
    if (chunk == 0) {
        const int rel = d.pos0 + key * pstep + poff - t0;
        const int phi = (rel >> 6) << 6, plo = rel & 63;
        const unsigned bh = pack2((float)phi, (float)phi), bl = pack2((float)plo, (float)plo);
        *(u32x4*)(kimg + 8 * 1024 + key * 16) = (u32x4){bh, bl, 0x00003F80u, 0u};
    }
}
DEVI void attn_tile2(const char* kimg, const char* vimg, const bf16x8 (&qr)[4], const bf16x8 qext, float& m, float& lsum, f32x16& o0, f32x16& o1, f32x16& s0, f32x16& s1,
                     int lh, int ll, bool fast, float* wsf_hi, float* wsf_r, int lane) {
    const int r32 = lane & 31, hi = lane >> 5;
    const f32x16 z = {};
    s0 = z; s1 = z;
    {
        const char* kp = kimg + hi * 1024 + r32 * 16;
#pragma unroll
        for (int d0 = 0; d0 < 5; ++d0) {
            const bf16x8 k0 = *(const bf16x8*)(kp + d0 * 2048), k1 = *(const bf16x8*)(kp + d0 * 2048 + 512);
            const bf16x8 qf = d0 < 4 ? qr[d0 < 4 ? d0 : 0] : qext;
            s0 = MFMA32(k0, qf, s0); s1 = MFMA32(k1, qf, s1);
        }
    }
    if (!fast) {
#pragma unroll
        for (int r = 0; r < 16; ++r) {
            const int c = (r & 3) + 8 * (r >> 2);
            s0[r] = (c <= lh && c > ll) ? s0[r] : -INFINITY; s1[r] = (c + 32 <= lh && c + 32 > ll) ? s1[r] : -INFINITY;
        }
    }
    float mx = fmaxf(s0[0], s1[0]);
#pragma unroll
    for (int r = 1; r < 16; ++r) mx = fmaxf(mx, fmaxf(s0[r], s1[r]));
    mx = half_max(mx);
    const float mnew = fmaxf(m, mx);
    const float f = __builtin_amdgcn_exp2f((m - mnew) * 1.4426950408889634f);
    m = mnew;
    const float nm2 = -mnew * 1.4426950408889634f;
    float ps = 0.f;
#pragma unroll
    for (int r = 0; r < 16; ++r) { s0[r] = __builtin_amdgcn_exp2f(fmaf(s0[r], 1.4426950408889634f, nm2)); s1[r] = __builtin_amdgcn_exp2f(fmaf(s1[r], 1.4426950408889634f, nm2)); ps += s0[r] + s1[r]; }
    lsum = lsum * f + ps;
    if (__any(f != 1.f)) {
        if (hi == 0) *wsf_r = f;
        asm volatile("s_waitcnt lgkmcnt(0)" ::: "memory");
#pragma unroll
        for (int a = 0; a < 4; ++a) {
            const f32x4 fv = *(const f32x4*)(wsf_hi + 8 * a);
#pragma unroll
            for (int k = 0; k < 4; ++k) { o0[4 * a + k] *= fv[k]; o1[4 * a + k] *= fv[k]; }
        }
        asm volatile("s_waitcnt lgkmcnt(0)" ::: "memory");
    }
    u32x4 pw[4];
#pragma unroll
    for (int k = 0; k < 4; ++k) { pw[0][k] = cvtpk(s0[2 * k], s0[2 * k + 1]); pw[1][k] = cvtpk(s0[8 + 2 * k], s0[8 + 2 * k + 1]); pw[2][k] = cvtpk(s1[2 * k], s1[2 * k + 1]); pw[3][k] = cvtpk(s1[8 + 2 * k], s1[8 + 2 * k + 1]); }
    const lds_cptr vp = (lds_cptr)vimg + ((lane >> 4) & 1) * 32 + (lane & 3) * 8 + (4 * hi + ((lane & 15) >> 2)) * 64;
#pragma unroll
    for (int i = 0; i < 8; ++i) {
        const s16x4 lo = vtr(vp + ((i >> 2) * 4096 + (i & 3) * 1024)), hh = vtr(vp + ((i >> 2) * 4096 + (i & 3) * 1024 + 512));
        const bf16x8 vf = (bf16x8){lo[0], lo[1], lo[2], lo[3], hh[0], hh[1], hh[2], hh[3]};
        const bf16x8 pf = __builtin_bit_cast(bf16x8, pw[i & 3]);
        if (i < 4) o0 = MFMA32(pf, vf, o0); else o1 = MFMA32(pf, vf, o1);
    }
}

DEVI void attn_tile3(const char* kA, const char* vA, const char* kB, const char* vB, const bf16x8 (&qr)[4], const bf16x8 qeA, const bf16x8 qeB, float& m, float& lsum,
                     f32x16& o0, f32x16& o1, int lhA, int llA, bool fastA, int lhB, int llB, bool fastB, float* wsf_hi, float* wsf_r, int lane) {
    const int r32 = lane & 31, hi = lane >> 5;
    f32x16 a0 = {}, a1 = {}, b0 = {}, b1 = {};
    {
        const char* kpa = kA + hi * 1024 + r32 * 16; const char* kpb = kB + hi * 1024 + r32 * 16;
#pragma unroll
        for (int d0 = 0; d0 < 5; ++d0) {
            const bf16x8 ka0 = *(const bf16x8*)(kpa + d0 * 2048), ka1 = *(const bf16x8*)(kpa + d0 * 2048 + 512);
            const bf16x8 kb0 = *(const bf16x8*)(kpb + d0 * 2048), kb1 = *(const bf16x8*)(kpb + d0 * 2048 + 512);
            const bf16x8 qa = d0 < 4 ? qr[d0 < 4 ? d0 : 0] : qeA, qb = d0 < 4 ? qr[d0 < 4 ? d0 : 0] : qeB;
            a0 = MFMA32(ka0, qa, a0); a1 = MFMA32(ka1, qa, a1); b0 = MFMA32(kb0, qb, b0); b1 = MFMA32(kb1, qb, b1);
        }
    }
    if (!fastA) {
#pragma unroll
        for (int r = 0; r < 16; ++r) { const int c = (r & 3) + 8 * (r >> 2); a0[r] = (c <= lhA && c > llA) ? a0[r] : -INFINITY; a1[r] = (c + 32 <= lhA && c + 32 > llA) ? a1[r] : -INFINITY; }
    }
    if (!fastB) {
#pragma unroll
        for (int r = 0; r < 16; ++r) { const int c = (r & 3) + 8 * (r >> 2); b0[r] = (c <= lhB && c > llB) ? b0[r] : -INFINITY; b1[r] = (c + 32 <= lhB && c + 32 > llB) ? b1[r] : -INFINITY; }
    }
    float mx = fmaxf(fmaxf(a0[0], a1[0]), fmaxf(b0[0], b1[0]));
#pragma unroll
    for (int r = 1; r < 16; ++r) mx = fmaxf(mx, fmaxf(fmaxf(a0[r], a1[r]), fmaxf(b0[r], b1[r])));
    mx = half_max(mx);
    const float mnew = fmaxf(m, mx);
    const float f = __builtin_amdgcn_exp2f((m - mnew) * 1.4426950408889634f);
    m = mnew;
    const float nm2 = -mnew * 1.4426950408889634f;
    float ps = 0.f;
#pragma unroll
    for (int r = 0; r < 16; ++r) {
        a0[r] = __builtin_amdgcn_exp2f(fmaf(a0[r], 1.4426950408889634f, nm2)); a1[r] = __builtin_amdgcn_exp2f(fmaf(a1[r], 1.4426950408889634f, nm2));
        b0[r] = __builtin_amdgcn_exp2f(fmaf(b0[r], 1.4426950408889634f, nm2)); b1[r] = __builtin_amdgcn_exp2f(fmaf(b1[r], 1.4426950408889634f, nm2));
        ps += (a0[r] + a1[r]) + (b0[r] + b1[r]);
    }
    lsum = lsum * f + ps;
    if (__any(f != 1.f)) {
        if (hi == 0) *wsf_r = f;
        asm volatile("s_waitcnt lgkmcnt(0)" ::: "memory");
#pragma unroll
        for (int a = 0; a < 4; ++a) {
            const f32x4 fv = *(const f32x4*)(wsf_hi + 8 * a);
#pragma unroll
            for (int k = 0; k < 4; ++k) { o0[4 * a + k] *= fv[k]; o1[4 * a + k] *= fv[k]; }
        }
        asm volatile("s_waitcnt lgkmcnt(0)" ::: "memory");
    }
    const int voff = ((lane >> 4) & 1) * 32 + (lane & 3) * 8 + (4 * hi + ((lane & 15) >> 2)) * 64;
#pragma unroll
    for (int t = 0; t < 2; ++t) {
        const f32x16& p0 = t == 0 ? a0 : b0; const f32x16& p1 = t == 0 ? a1 : b1;
        u32x4 pw[4];
#pragma unroll
        for (int k = 0; k < 4; ++k) { pw[0][k] = cvtpk(p0[2 * k], p0[2 * k + 1]); pw[1][k] = cvtpk(p0[8 + 2 * k], p0[8 + 2 * k + 1]); pw[2][k] = cvtpk(p1[2 * k], p1[2 * k + 1]); pw[3][k] = cvtpk(p1[8 + 2 * k], p1[8 + 2 * k + 1]); }
        const lds_cptr vp = (lds_cptr)(t == 0 ? vA : vB) + voff;
#pragma unroll
        for (int i = 0; i < 8; ++i) {
            const s16x4 lo = vtr(vp + ((i >> 2) * 4096 + (i & 3) * 1024)), hh = vtr(vp + ((i >> 2) * 4096 + (i & 3) * 1024 + 512));
            const bf16x8 vf = (bf16x8){lo[0], lo[1], lo[2], lo[3], hh[0], hh[1], hh[2], hh[3]};
            const bf16x8 pf = __builtin_bit_cast(bf16x8, pw[i & 3]);
            if (i < 4) o0 = MFMA32(pf, vf, o0); else o1 = MFMA32(pf, vf, o1);
        }
    }
}

constexpr int NQ_KVB = 18432, NQ_WSF = 4 * NQ_KVB, NQ_SEL = NQ_WSF + 2048, NQ_LIST = NQ_SEL + 512, NQ_YAC = NQ_LIST + 256, NQ_LDS = NQ_YAC + 65536, NQ_IMP = 2 * NQ_KVB;
static_assert(NQ_LDS <= 152 * 1024, "lds");
DEVI void nsa_prompt_unit(const P& p, char* smem, int b, int g, int qt) {
    const int tid = tid_opq(), lane = tid & 63, wid = tid >> 6, r32 = lane & 31, hi = lane >> 5;
    float* wsf = (float*)(smem + NQ_WSF) + wid * 64;
    float* impb = (float*)(smem + NQ_IMP) + wid * 512;
    unsigned long long* selm = (unsigned long long*)(smem + NQ_SEL);
    unsigned char* blist = (unsigned char*)(smem + NQ_LIST);
    const int t0 = qt * 64;
    const size_t rowbase = (size_t)b * 4096 + t0;
    const int tokl = wid * 8 + (r32 >> 2), head = r32 & 3;
    const int qpos = t0 + tokl;
    const float slope = alibi_slope(g * 4 + head);
    bf16x8 qr[4];
    {
        const bf16_t* qp = p.PROJ + (rowbase + tokl) * PS + C_BQ + (g * 4 + head) * 64 + hi * 8;
#pragma unroll
        for (int d0 = 0; d0 < 4; ++d0) {
            u32x4 v = *(const u32x4*)(qp + d0 * 16);
#pragma unroll
            for (int k = 0; k < 4; ++k) { const float lo = __uint_as_float(v[k] << 16) * 0.125f, hh = __uint_as_float(v[k] & 0xFFFF0000u) * 0.125f; v[k] = (__float_as_uint(lo) >> 16) | (__float_as_uint(hh) & 0xFFFF0000u); }
            qr[d0] = __builtin_bit_cast(bf16x8, v);
        }
    }
    unsigned qe_w;
    { const unsigned sh = (unsigned)f2bf(slope); const float rem = slope - __uint_as_float(sh << 16); qe_w = sh | ((unsigned)f2bf(rem) << 16); if (hi) qe_w = 0u; }
    int hi4 = 4 * hi; asm volatile("" : "+v"(hi4));
    float* yl = (float*)(smem + NQ_YAC) + wid * 2048 + hi4 * 64 + r32;
    float* wsf_hi = wsf + hi4; float* wsf_r = wsf + r32;
    f32x16 o0, o1; float m, lsum;
    auto finish = [&](int br) {
        const float lt = half_sum(lsum);
        float fac = 0.f;
        if (lt > 0.f) fac = sigmoidf_(p.SM[(rowbase + tokl) * 64 + 8 + br * 16 + g * 4 + head]) / lt;
        if (hi == 0) *wsf_r = fac;
        asm volatile("s_waitcnt lgkmcnt(0)" ::: "memory");
#pragma unroll
        for (int a = 0; a < 4; ++a) {
            const f32x4 fv = *(const f32x4*)(wsf_hi + 8 * a);
#pragma unroll
            for (int k = 0; k < 4; ++k) {
                float* yp = yl + (8 * a + k) * 64;
                if (br == 0) { yp[0] = o0[4 * a + k] * fv[k]; yp[32] = o1[4 * a + k] * fv[k]; }
                else { yp[0] += o0[4 * a + k] * fv[k]; yp[32] += o1[4 * a + k] * fv[k]; }
            }
        }
        asm volatile("s_waitcnt lgkmcnt(0)" ::: "memory");
    };
    __syncthreads();
    if (tid < 64) *(u32x4*)(smem + 9 * 1024 + tid * 16) = (u32x4){0u, 0u, 0u, 0u};
    {
        const BlkDesc d = nsa_desc(p, true, b, g, 0, 0);
        u32x4 rk, rv; blk_load(d, tid, rk, rv); blk_store_ext(d, 64, 63, t0, smem, smem + 10240, tid, rk, rv);
        __syncthreads();
        o0 = (f32x16){}; o1 = (f32x16){}; m = -1e30f; lsum = 0.f;
        f32x16 s0, s1;
        {
            const int nv = ((qpos + 1) >> 6) - 1;
            const int lh = (nv < 63 ? nv : 63) - hi4;
            const bf16x8 qext = __builtin_bit_cast(bf16x8, (u32x4){qe_w, qe_w, 0u, 0u});
            attn_tile2(smem, smem + 10240, qr, qext, m, lsum, o0, o1, s0, s1, lh, -1000, false, wsf_hi, wsf_r, lane);
        }
        const float lt = half_sum(lsum);
        const float inv = lt > 0.f ? 1.f / lt : 0.f;
        unsigned x[64];
#pragma unroll
        for (int r = 0; r < 16; ++r) {
#pragma unroll
            for (int n = 0; n < 2; ++n) {
                float a = (n == 0 ? s0[r] : s1[r]) * inv;
                a += __shfl_xor(a, 1); a += __shfl_xor(a, 2);
                const int j = (r & 3) + 8 * (r >> 2) + 32 * n + hi4;
                if (j == qt || j == 0) a = 5.0f;
                if (j > qt) a = -1.0f;
                const unsigned u = __float_as_uint(a);
                const unsigned o = (u & 0x80000000u) ? ~u : (u | 0x80000000u);
                x[n * 16 + r] = (o & ~63u) | (unsigned)(63 - j);
            }
        }
        finish(0);
        sort16_desc<0>(x); sort16_desc<16>(x);
        unsigned th[16], oth[16], fin[16];
        merge_top16(&x[0], &x[16], th);
#pragma unroll
        for (int i = 0; i < 16; ++i) { auto rr = __builtin_amdgcn_permlane32_swap(th[i], th[i], false, false); oth[i] = hi ? rr[0] : rr[1]; }
        merge_top16(th, oth, fin);
        unsigned long long mask = 0ull;
#pragma unroll
        for (int i = 0; i < 16; ++i) mask |= 1ull << (63u - (fin[i] & 63u));
        if (head == 0 && hi == 0) selm[wid * 8 + (r32 >> 2)] = mask;
    }
    __syncthreads();
    if (wid == 0) {
        unsigned long long u = selm[lane];
#pragma unroll
        for (int o = 32; o > 0; o >>= 1) u |= __shfl_xor(u, o);
        u &= (qt == 63) ? ~0ull : ((1ull << (qt + 1)) - 1ull);
        {
            const int n = __builtin_popcountll(u);
            if ((u >> lane) & 1ull) blist[2 + __builtin_popcountll(lane < 63 ? (u >> (lane + 1)) : 0ull)] = (unsigned char)lane;
            const int w0 = qt - 8 > 0 ? qt - 8 : 0, nw = qt - w0 + 1;
            if (lane < nw) blist[2 + n + lane] = (unsigned char)(qt - lane);
            if (lane == 0) { blist[0] = (unsigned char)n; blist[1] = (unsigned char)nw; }
        }
    }
    __syncthreads();
    if (tid >= 64 && tid < 256) *(u32x4*)(smem + (tid >> 6) * NQ_KVB + 9 * 1024 + (tid & 63) * 16) = (u32x4){0u, 0u, 0u, 0u};
    const int ns = blist[0], nw = blist[1];
    const int nss = (ns + 1) >> 1, nsteps = nss + ((nw + 1) >> 1);
    const unsigned long long mysel = selm[tokl];
    {
        auto step_blocks = [&](int s, int& br, int& jA, int& jB) {
            if (s < nss) { br = 1; jA = blist[2 + 2 * s]; jB = 2 * s + 1 < ns ? (int)blist[2 + 2 * s + 1] : -1; }
            else { const int w = s - nss; br = 2; jA = blist[2 + ns + 2 * w]; jB = 2 * w + 1 < nw ? (int)blist[2 + ns + 2 * w + 1] : -1; }
        };
        u32x4 rkA, rvA, rkB, rvB;
        auto load_step = [&](int s) {
            int br, jA, jB; step_blocks(s, br, jA, jB);
            const BlkDesc dA = nsa_desc(p, true, b, g, br, jA); blk_load(dA, tid, rkA, rvA);
            if (jB >= 0) { const BlkDesc dB = nsa_desc(p, true, b, g, br, jB); blk_load(dB, tid, rkB, rvB); }
        };
        auto store_step = [&](int s, char* buf) {
            int br, jA, jB; step_blocks(s, br, jA, jB);
            BlkDesc dA; dA.pos0 = jA * 64; blk_store_ext(dA, 1, 0, t0, buf, buf + 10240, tid, rkA, rvA);
            if (jB >= 0) { BlkDesc dB; dB.pos0 = jB * 64; blk_store_ext(dB, 1, 0, t0, buf + NQ_KVB, buf + NQ_KVB + 10240, tid, rkB, rvB); }
        };
        load_step(0); store_step(0, smem);
        __syncthreads();
        int prev_br = 1;
        o0 = (f32x16){}; o1 = (f32x16){}; m = -1e30f; lsum = 0.f;
        for (int s = 0; s < nsteps; ++s) {
            int br, jA, jB; step_blocks(s, br, jA, jB);
            char* cur = smem + (s & 1) * 2 * NQ_KVB;
            char* nxt = smem + ((s & 1) ^ 1) * 2 * NQ_KVB;
            if (s + 1 < nsteps) load_step(s + 1);
            if (br != prev_br) { finish(1); o0 = (f32x16){}; o1 = (f32x16){}; m = -1e30f; lsum = 0.f; prev_br = br; }
            {
                asm volatile("" : "+v"(hi4));
                const bool lselA = br == 2 || ((mysel >> jA) & 1ull);
                const int relA = qpos - jA * 64;
                const int lhA = (relA < 63 ? relA : 63) - hi4, llA = (br == 2 ? relA - 512 : -1000) - hi4;
                const bool fastA = __all(!lselA || (lhA >= 59 && llA < 0));
                const bool needA = __any(lselA && lhA + hi4 >= 0 && llA + hi4 < 63);
                const bf16x8 qeA = __builtin_bit_cast(bf16x8, (u32x4){qe_w, qe_w, (lselA || hi) ? 0u : 0x0000C6EAu, 0u});
                bool needB = false; bool lselB = false; int lhB = -1000, llB = -1000; bool fastB = false;
                if (jB >= 0) {
                    lselB = br == 2 || ((mysel >> jB) & 1ull);
                    const int relB = qpos - jB * 64;
                    lhB = (relB < 63 ? relB : 63) - hi4; llB = (br == 2 ? relB - 512 : -1000) - hi4;
                    fastB = __all(!lselB || (lhB >= 59 && llB < 0));
                    needB = __any(lselB && lhB + hi4 >= 0 && llB + hi4 < 63);
                }
                const bf16x8 qeB = __builtin_bit_cast(bf16x8, (u32x4){qe_w, qe_w, (lselB || hi) ? 0u : 0x0000C6EAu, 0u});
                f32x16 s0, s1;
                if (needA && needB) attn_tile3(cur, cur + 10240, cur + NQ_KVB, cur + NQ_KVB + 10240, qr, qeA, qeB, m, lsum, o0, o1, lhA, llA, fastA, lhB, llB, fastB, wsf_hi, wsf_r, lane);
                else if (needA) attn_tile2(cur, cur + 10240, qr, qeA, m, lsum, o0, o1, s0, s1, lhA, llA, fastA, wsf_hi, wsf_r, lane);
                else if (needB) attn_tile2(cur + NQ_KVB, cur + NQ_KVB + 10240, qr, qeB, m, lsum, o0, o1, s0, s1, lhB, llB, fastB, wsf_hi, wsf_r, lane);
            }
            if (s + 1 < nsteps) store_step(s + 1, nxt);
            __syncthreads();
        }
        finish(2);
    }
    {
        const float* yac = (const float*)(smem + NQ_YAC) + wid * 2048;
#pragma unroll
        for (int i = 0; i < 4; ++i) {
            const int orow = i * 8 + (lane >> 3), ch = lane & 7, tk = wid * 8 + (orow >> 2), hd = orow & 3;
            const f32x4 a = *(const f32x4*)(yac + orow * 64 + ch * 8), c = *(const f32x4*)(yac + orow * 64 + ch * 8 + 4);
            *(u32x4*)(p.YB + (rowbase + tk) * 1024 + (g * 4 + hd) * 64 + ch * 8) = pack8f(a, c);
        }
        asm volatile("s_waitcnt lgkmcnt(0)" ::: "memory");
    }
}

DEVI void stage_nsa_attn(const P& p, char* smem, int bid, int nblk) {
    (void)bid; (void)nblk;
    unsigned* head = p.bar + 3840;
    volatile unsigned* slot = (volatile unsigned*)(smem + 150 * 1024);
    for (;;) {
        __syncthreads();
        if (tid_opq() == 0) *slot = __hip_atomic_fetch_add(head, 1u, __ATOMIC_RELAXED, __HIP_MEMORY_SCOPE_AGENT);
        __syncthreads();
        const unsigned i = *slot;
        if (i >= 1536u) break;
        if (i < 1024u) nsa_prompt_unit(p, smem, (int)((i & 15u) >> 2), (int)(i & 3u), 63 - (int)(i >> 4));
        else nsa_sample_unit(p, smem, (int)i - 1024);
    }
}

DEVI void stage2_queue(const P& p, char* smem) {
    unsigned* head = p.bar + 3904;
    volatile unsigned* slot = (volatile unsigned*)(smem + 150 * 1024);
    constexpr int BIG = 1 << 20;
    for (;;) {
        __syncthreads();
        if (tid_opq() == 0) *slot = __hip_atomic_fetch_add(head, 1u, __ATOMIC_RELAXED, __HIP_MEMORY_SCOPE_AGENT);
        __syncthreads();
        const unsigned i = *slot;
        if (i >= 1824u) break;
        int kind, t;
        if (i < 16u) { kind = 0; t = (int)i; }
        else if (i < 528u) { const unsigned j = i - 16u; kind = (j & 1u) ? 1 : 2; t = (int)(j >> 1); }
        else if (i < 544u) { kind = 2; t = 256 + (int)(i - 528u); }
        else { const unsigned j = i - 544u, q = j / 5u, r = j - q * 5u; if (r < 3u) { kind = 1; t = 256 + (int)(q * 3u + r); } else { kind = 3; t = (int)(q * 2u + r - 3u); } }
        if (kind == 0) stage_mlstm_gates(p, smem, t, BIG);
        else if (kind == 1) stage_mlstm_dc(p, smem, t, BIG);
        else if (kind == 2) stage_compress(p, smem, 0, BIG, t);
        else stage_mlstm_sample(p, smem, t, BIG);
    }
}

DEVI void stage_ln1(const P& p, int bid, int nblk) {
    const int lane = tid_opq() & 63, wid = tid_opq() >> 6;
    for (int row = bid * 8 + wid; row < NT; row += nblk * 8) {
        f32x4 x[4];
        float s = 0.f;
#pragma unroll
        for (int i = 0; i < 4; ++i) { x[i] = *(const f32x4*)(p.R + (size_t)row * 1024 + i * 256 + lane * 4); s += x[i][0] + x[i][1] + x[i][2] + x[i][3]; }
        const float mean = wave_sum(s) * (1.f / 1024.f);
        float q = 0.f;
#pragma unroll
        for (int i = 0; i < 4; ++i)
#pragma unroll
            for (int k = 0; k < 4; ++k) q += (x[i][k] - mean) * (x[i][k] - mean);
        const float rs = rsqrtf(wave_sum(q) * (1.f / 1024.f) + LN_EPS);
#pragma unroll
        for (int i = 0; i < 4; ++i) {
            const int c = i * 256 + lane * 4;
            const f32x4 gg = *(const f32x4*)(p.ln1_g + c), bb = *(const f32x4*)(p.ln1_b + c);
            f32x4 y;
#pragma unroll
            for (int k = 0; k < 4; ++k) y[k] = (x[i][k] - mean) * rs * gg[k] + bb[k];
            u32x2 o; o.x = pack2(y[0], y[1]); o.y = pack2(y[2], y[3]);
            *(u32x2*)(p.HB + (size_t)row * 1024 + c) = o;
        }
        if (lane == 0) { p.H[(size_t)row * 2] = mean; p.H[(size_t)row * 2 + 1] = rs; }
    }
}

__device__ const unsigned char PEER_CA[50] = {0,0,0,0,0,0,0,0,0,0,0,0,0,0,0,0, 1,1,1,1,1,1,1,1, 2,2,2,2,2, 3,3,3,3, 4,4,4, 5,5, 6,6, 7,7, 8,9,10,11,12,13,14,15};
__device__ const unsigned char PEER_CB[50] = {0,1,2,3,4,5,6,7,8,9,10,11,12,13,14,15, 0,1,2,3,4,5,6,7, 0,1,2,3,4, 0,1,2,3, 0,1,2, 0,1, 0,1, 0,1, 0,0,0,0,0,0,0,0};

DEVI float key_score(unsigned k) { const unsigned u = k & ~127u; return __uint_as_float((u & 0x80000000u) ? (u & 0x7FFFFFFFu) : ~u); }

DEVI void sort8_desc(unsigned (&x)[16]) {
#pragma unroll
    for (int k = 2; k <= 8; k <<= 1)
#pragma unroll
        for (int j = k >> 1; j > 0; j >>= 1)
#pragma unroll
            for (int i = 0; i < 8; ++i) {
                const int l = i ^ j;
                if (l > i) { if ((i & k) == 0) ce_desc(x[i], x[l]); else ce_desc(x[l], x[i]); }
            }
}
DEVI unsigned sum_key(unsigned ka, unsigned kb, unsigned tag) {
    const unsigned u = __float_as_uint(key_score(ka) + key_score(kb));
    const unsigned o = (u & 0x80000000u) ? ~u : (u | 0x80000000u);
    return (o & ~255u) | tag;
}
DEVI float key_score8(unsigned k) { const unsigned u = k & ~255u; return __uint_as_float((u & 0x80000000u) ? (u & 0x7FFFFFFFu) : ~u); }

DEVI void route_top16(const P& p, int row, int ph, int c, int r32, int hi, int hi4, unsigned (&fin)[16]) {
    f32x16 acc[4];
#pragma unroll
    for (int t = 0; t < 4; ++t) acc[t] = (f32x16){};
    const bf16_t* qp = p.PQ + (size_t)row * 2048 + ph * 256 + c * 128 + hi * 8;
    const bf16_t* kp = p.KEYSB + ((size_t)((ph * 2 + c) * 128 + r32)) * 128 + hi * 8;
#pragma unroll
    for (int s8 = 0; s8 < 8; ++s8) {
        const bf16x8 qf = *(const bf16x8*)(qp + s8 * 16);
#pragma unroll
        for (int t = 0; t < 4; ++t) {
            const bf16x8 kf = *(const bf16x8*)(kp + (size_t)t * 32 * 128 + s8 * 16);
            acc[t] = MFMA32(kf, qf, acc[t]);
        }
    }
    unsigned x[64];
#pragma unroll
    for (int t = 0; t < 4; ++t)
#pragma unroll
        for (int r = 0; r < 16; ++r) {
            const unsigned u = __float_as_uint(acc[t][r]);
            const unsigned o = (u & 0x80000000u) ? ~u : (u | 0x80000000u);
            x[t * 16 + r] = (o & ~127u) | (unsigned)(127 - ((r & 3) + 8 * (r >> 2) + 32 * t) - hi4);
        }
    sort16_desc<0>(x); sort16_desc<16>(x); sort16_desc<32>(x); sort16_desc<48>(x);
    unsigned t01[16], t23[16], tt[16], oth[16];
    merge_top16(&x[0], &x[16], t01); merge_top16(&x[32], &x[48], t23); merge_top16(t01, t23, tt);
#pragma unroll
    for (int i = 0; i < 16; ++i) { auto rr = __builtin_amdgcn_permlane32_swap(tt[i], tt[i], false, false); oth[i] = hi ? rr[0] : rr[1]; }
    merge_top16(tt, oth, fin);
}

DEVI void stage_peer_route(const P& p, char* smem, int bid, int nblk, int p0, int p1) {
    const int lane = tid_opq() & 63, wid = tid_opq() >> 6, r32 = lane & 31, hi = lane >> 5;
    unsigned char* tb = (unsigned char*)smem + wid * 1024 + r32 * 32;
    const int tpw = (NT + nblk - 1) / nblk, row_lo = bid * tpw, row_hi = (row_lo + tpw < NT) ? row_lo + tpw : NT;
    const int ph = wid;
    for (int pass = p0; pass < p1 && row_lo + pass * 32 < row_hi; ++pass) {
        const int row_raw = row_lo + pass * 32 + r32;
        const bool row_ok = row_raw < row_hi;
        const int row = row_ok ? row_raw : row_lo;
        int hi4 = 4 * hi; asm volatile("" : "+v"(hi4));
        unsigned fa[16], fb[16];
        route_top16(p, row, ph, 0, r32, hi, hi4, fa);
        asm volatile("" : "+v"(hi4));
        route_top16(p, row, ph, 1, r32, hi, hi4, fb);
        if (hi == 0) {
            u32x4 wa, wb;
#pragma unroll
            for (int i = 0; i < 4; ++i) {
                wa[i] = (127u - (fa[4 * i] & 127u)) | ((127u - (fa[4 * i + 1] & 127u)) << 8) | ((127u - (fa[4 * i + 2] & 127u)) << 16) | ((127u - (fa[4 * i + 3] & 127u)) << 24);
                wb[i] = (127u - (fb[4 * i] & 127u)) | ((127u - (fb[4 * i + 1] & 127u)) << 8) | ((127u - (fb[4 * i + 2] & 127u)) << 16) | ((127u - (fb[4 * i + 3] & 127u)) << 24);
            }
            *(u32x4*)tb = wa; *(u32x4*)(tb + 16) = wb;
        }
        unsigned g0[16], g1[16], g2[16], g3[16];
#pragma unroll
        for (int j = 0; j < 16; ++j) g0[j] = sum_key(fa[0], fb[j], (unsigned)j);
#pragma unroll
        for (int k = 0; k < 15; ++k) g1[k] = sum_key(fa[k + 1], fb[0], (unsigned)((k + 1) << 4));
        g1[15] = 0u;
#pragma unroll
        for (int j = 1; j < 8; ++j) g2[j - 1] = sum_key(fa[1], fb[j], (unsigned)(16 | j));
        g2[7] = 0u; g2[8] = 0u; g2[9] = 0u;
#pragma unroll
        for (int i = 2; i < 8; ++i) g2[17 - i] = sum_key(fa[i], fb[1], (unsigned)((i << 4) | 1));
#pragma unroll
        for (int j = 8; j > 0; j >>= 1)
#pragma unroll
            for (int i = 0; i < 16; ++i) { const int l = i ^ j; if (l > i) ce_desc(g2[i], g2[l]); }
        g3[0] = sum_key(fa[2], fb[2], 0x22u); g3[1] = sum_key(fa[2], fb[3], 0x23u); g3[2] = sum_key(fa[2], fb[4], 0x24u);
        g3[3] = sum_key(fa[3], fb[2], 0x32u); g3[4] = sum_key(fa[4], fb[2], 0x42u); g3[5] = sum_key(fa[3], fb[3], 0x33u);
#pragma unroll
        for (int i = 6; i < 16; ++i) g3[i] = 0u;
        sort8_desc(g3);
        unsigned t01[16], t23[16], top[16];
        merge_top16(g0, g1, t01); merge_top16(g2, g3, t23); merge_top16(t01, t23, top);
        float ev[16]; float sum = 0.f;
        const float vmax = key_score8(top[0]);
#pragma unroll
        for (int k = 0; k < 16; ++k) { ev[k] = __expf(key_score8(top[k]) - vmax); sum += ev[k]; }
        const float inv = 1.f / sum;
        asm volatile("s_waitcnt lgkmcnt(0)" ::: "memory");
        if (!row_ok) {   } else if (hi == 0) {
            int* dst = p.EIDX + (size_t)row * 128 + ph * 16;
#pragma unroll
            for (int q4 = 0; q4 < 4; ++q4) {
                u32x4 o;
#pragma unroll
                for (int k = 0; k < 4; ++k) { const unsigned tg = top[q4 * 4 + k] & 255u; o[k] = (unsigned)tb[tg >> 4] * 128u + (unsigned)tb[16 + (tg & 15u)]; }
                *(u32x4*)(dst + q4 * 4) = o;
            }
        } else {
            float* dst = p.EGATE + (size_t)row * 128 + ph * 16;
#pragma unroll
            for (int q4 = 0; q4 < 4; ++q4) *(f32x4*)(dst + q4 * 4) = (f32x4){ev[q4 * 4] * inv, ev[q4 * 4 + 1] * inv, ev[q4 * 4 + 2] * inv, ev[q4 * 4 + 3] * inv};
        }
        asm volatile("s_waitcnt lgkmcnt(0)" ::: "memory");
    }
}

constexpr int PA_WAVE_LDS = 1024 + 1024 + 512 + 512 + 512;
DEVI void stage_peer_apply(const P& p, char* smem, int bid, int nblk, int p0, int p1) {
    const int lane = tid_opq() & 63, wid = tid_opq() >> 6;
    char* wl = smem + wid * PA_WAVE_LDS;
    unsigned char* hhi = (unsigned char*)wl; unsigned char* hlo = hhi + 1024;
    int* idxs = (int*)(wl + 2048);
    float* gts = (float*)(wl + 2560);
    float* cs = (float*)(wl + 3072);
    const int fr = lane & 15, fq = lane >> 4;
    const int tpw = (NT + nblk - 1) / nblk, row_lo = bid * tpw, row_hi = (row_lo + tpw < NT) ? row_lo + tpw : NT;
    for (int row = row_lo + p0 * 32 + wid; row < row_hi && row < row_lo + p1 * 32; row += 8) {
        float hv[16];
        {
            const float* hr = p.R + (size_t)row * 1024 + lane * 16;
            const float mean1 = p.H[(size_t)row * 2], rs1 = p.H[(size_t)row * 2 + 1];
            u32x4 ohi, olo;
#pragma unroll
            for (int i = 0; i < 4; ++i) {
                f32x4 x = *(const f32x4*)(hr + i * 4);
                { const f32x4 g1 = *(const f32x4*)(p.ln1_g + lane * 16 + i * 4), b1 = *(const f32x4*)(p.ln1_b + lane * 16 + i * 4);
#pragma unroll
                  for (int k = 0; k < 4; ++k) x[k] = (x[k] - mean1) * rs1 * g1[k] + b1[k]; }
#pragma unroll
                for (int k = 0; k < 4; ++k) hv[i * 4 + k] = x[k];
                int w = __builtin_amdgcn_cvt_pk_fp8_f32(x[0], x[1], 0, false); w = __builtin_amdgcn_cvt_pk_fp8_f32(x[2], x[3], w, true);
                const f32x2 d01 = __builtin_amdgcn_cvt_pk_f32_fp8(w, false), d23 = __builtin_amdgcn_cvt_pk_f32_fp8(w, true);
                int w2 = __builtin_amdgcn_cvt_pk_fp8_f32(x[0] - d01[0], x[1] - d01[1], 0, false); w2 = __builtin_amdgcn_cvt_pk_fp8_f32(x[2] - d23[0], x[3] - d23[1], w2, true);
                ohi[i] = (unsigned)w; olo[i] = (unsigned)w2;
            }
            *(u32x4*)(hhi + lane * 16) = ohi; *(u32x4*)(hlo + lane * 16) = olo;
            idxs[lane] = p.EIDX[(size_t)row * 128 + lane]; idxs[lane + 64] = p.EIDX[(size_t)row * 128 + 64 + lane];
            gts[lane] = p.EGATE[(size_t)row * 128 + lane]; gts[lane + 64] = p.EGATE[(size_t)row * 128 + 64 + lane];
            asm volatile("s_waitcnt lgkmcnt(0)" ::: "memory");
        }
        {
            u32x4 a0[16], a1[16];
            auto issue_u = [&](int g, u32x4 (&a)[16]) {
                const unsigned char* ub = p.U8 + (size_t)idxs[g * 16 + fr] * 1024 + fq * 16;
#pragma unroll
                for (int s2 = 0; s2 < 16; ++s2) a[s2] = *(const u32x4*)(ub + s2 * 64);
            };
            auto consume_u = [&](int g, const u32x4 (&a)[16]) {
                f32x4 acc = (f32x4){0.f, 0.f, 0.f, 0.f};
#pragma unroll
                for (int s2 = 0; s2 < 16; ++s2) {
                    const u32x4 bh = *(const u32x4*)(hhi + s2 * 64 + fq * 16), bl = *(const u32x4*)(hlo + s2 * 64 + fq * 16);
                    const long x0 = (long)(((unsigned long long)a[s2][1] << 32) | a[s2][0]), x1 = (long)(((unsigned long long)a[s2][3] << 32) | a[s2][2]);
                    const long h0 = (long)(((unsigned long long)bh[1] << 32) | bh[0]), h1 = (long)(((unsigned long long)bh[3] << 32) | bh[2]);
                    const long l0 = (long)(((unsigned long long)bl[1] << 32) | bl[0]), l1 = (long)(((unsigned long long)bl[3] << 32) | bl[2]);
                    acc = __builtin_amdgcn_mfma_f32_16x16x32_fp8_fp8(x0, h0, acc, 0, 0, 0);
                    acc = __builtin_amdgcn_mfma_f32_16x16x32_fp8_fp8(x1, h1, acc, 0, 0, 0);
                    acc = __builtin_amdgcn_mfma_f32_16x16x32_fp8_fp8(x0, l0, acc, 0, 0, 0);
                    acc = __builtin_amdgcn_mfma_f32_16x16x32_fp8_fp8(x1, l1, acc, 0, 0, 0);
                }
                const f32x4 gg = *(const f32x4*)(gts + g * 16 + fq * 4);
                f32x4 cv;
#pragma unroll
                for (int r = 0; r < 4; ++r) {
                    const int e = idxs[g * 16 + fq * 4 + r];
                    const float d = acc[r] * p.US[e];
                    cv[r] = gg[r] * p.VS[e] * gelu_erf(d);
                }
                if (fr == 0) *(f32x4*)(cs + g * 16 + fq * 4) = cv;
            };
            issue_u(0, a0);
#pragma unroll 1
            for (int g = 0; g < 8; g += 2) {
                issue_u(g + 1, a1);
                consume_u(g, a0);
                if (g + 2 < 8) issue_u(g + 2, a0);
                consume_u(g + 1, a1);
            }
        }
        asm volatile("s_waitcnt lgkmcnt(0)" ::: "memory");
        float acc[16];
#pragma unroll
        for (int i = 0; i < 16; ++i) acc[i] = 0.f;
        {
            u32x4 v0[8], v1[8];
            auto issue_v = [&](int e0, u32x4 (&v)[8]) {
#pragma unroll
                for (int k = 0; k < 8; ++k) v[k] = *(const u32x4*)(p.V8 + (size_t)idxs[e0 + k] * 1024 + lane * 16);
            };
            auto consume_v = [&](int e0, const u32x4 (&v)[8]) {
#pragma unroll
                for (int k = 0; k < 8; ++k) {
                    const float c = cs[e0 + k];
#pragma unroll
                    for (int w = 0; w < 4; ++w) {
                        const f32x2 lo = __builtin_amdgcn_cvt_pk_f32_fp8((int)v[k][w], false), hh = __builtin_amdgcn_cvt_pk_f32_fp8((int)v[k][w], true);
                        acc[w * 4] += c * lo[0]; acc[w * 4 + 1] += c * lo[1]; acc[w * 4 + 2] += c * hh[0]; acc[w * 4 + 3] += c * hh[1];
                    }
                }
            };
            issue_v(0, v0);
#pragma unroll 1
            for (int e0 = 0; e0 < 128; e0 += 16) {
                issue_v(e0 + 8, v1);
                consume_v(e0, v0);
                if (e0 + 16 < 128) issue_v(e0 + 16, v0);
                consume_v(e0 + 8, v1);
            }
        }
        float s = 0.f;
#pragma unroll
        for (int i = 0; i < 16; ++i) { acc[i] += DN_ALPHA * hv[i]; s += acc[i]; }
        const float mean = wave_sum(s) * (1.f / 1024.f);
        float q = 0.f;
#pragma unroll
        for (int i = 0; i < 16; ++i) q += (acc[i] - mean) * (acc[i] - mean);
        const float rs = rsqrtf(wave_sum(q) * (1.f / 1024.f) + LN_EPS);
#pragma unroll
        for (int i = 0; i < 4; ++i) {
            const int c = lane * 16 + i * 4;
            const f32x4 g0 = *(const f32x4*)(p.ln2_g + c), b0 = *(const f32x4*)(p.ln2_b + c);
            f32x4 y0;
#pragma unroll
            for (int k = 0; k < 4; ++k) y0[k] = (acc[i * 4 + k] - mean) * rs * g0[k] + b0[k];
            *(f32x4*)(p.out + O_Y + (size_t)row * 1024 + c) = y0;
        }
    }
}

namespace pg8 {
#define PG8_LAS __attribute__((address_space(3)))
typedef unsigned short bf16_t;
typedef short bf16x8 __attribute__((ext_vector_type(8)));
typedef float f32x4 __attribute__((ext_vector_type(4)));
typedef unsigned u32x4 __attribute__((ext_vector_type(4)));
constexpr int BM = 256, BK = 64, HALF = 128, HTB = HALF * BK * 2  , STAGE_BYTES = 8 * HTB, NXCD = 8, WGM = 8;

__host__ __device__ __forceinline__ int lds_byte(int r, int c) { const int st = (r >> 4) * 2 + (c >> 5), rr = r & 15, cc = c & 31, ob = rr * 64 + cc * 2; return st * 1024 + (ob ^ (((ob >> 9) & 1) << 5)); }
__host__ __device__ __forceinline__ void stage_rc(int b, int& R, int& C) { const int st = b / 1024, sb = b % 1024, swz = sb ^ (((sb >> 9) & 1) << 5); R = (st >> 1) * 16 + swz / 64; C = (st & 1) * 32 + (swz % 64) / 2; }
__host__ __device__ __forceinline__ int perm32(int rho) { const int n = rho >> 4, i = rho & 15; return 8 * (i >> 2) + 4 * n + (i & 3); }

struct Unit { int pm, pn; };
struct Gemm { const bf16_t* A; const bf16_t* Bt; int M, N, K; };

struct StaticOrder {
    int nM, nN, nwg, G, c;
    __host__ __device__ void init(int M, int N, int G_, int c_) { nM = M / BM; nN = N / BM; nwg = nM * nN; G = G_; c = c_; }
    __host__ __device__ bool next(int i, Unit& u) const {
        const long L = (long)i * G + c; if (L >= nwg) return false;
        int wgid = (int)L; { const int q = nwg / NXCD, r = nwg % NXCD, xcd = wgid % NXCD, off = wgid / NXCD; wgid = (xcd < r ? xcd * (q + 1) : r * (q + 1) + (xcd - r) * q) + off; }
        const int nig = WGM * nN, gid = wgid / nig, fm = gid * WGM, gsz = (nM - fm) < WGM ? (nM - fm) : WGM;
        u.pm = fm + ((wgid % nig) % gsz); u.pn = (wgid % nig) / gsz; return true;
    }
    __device__ __forceinline__ void a_ready(const Unit&) const {}
    __device__ __forceinline__ void done(const Unit&) const {}
};
template <class Epi, class Sched, bool STAMP = false>
__device__ __forceinline__ void gemm_phase(PG8_LAS unsigned char* lds, const Gemm g, const Sched& S, const Epi& E, unsigned long long* stamps) {
    const int tid = tid_opq(), wid = __builtin_amdgcn_readfirstlane(tid >> 6), lane = tid & 63, wr = wid >> 2, wc = wid & 3, fr = lane & 15, fq = lane >> 4;
    const int K = g.K, nt = K / BK;
    int ts_lo = 0, ts_hi = 0, nts = 0; const unsigned long long rt_entry = STAMP ? (unsigned long long)wall_clock64() : 0ull;
#define PG8_STAMP() do { if (STAMP && wid == 0 && nts < 64) { const unsigned long long _c = (unsigned long long)clock64(); \
        ts_lo = (lane == nts) ? (int)(unsigned)_c : ts_lo; ts_hi = (lane == nts) ? (int)(unsigned)(_c >> 32) : ts_hi; ++nts; } } while (0)
    PG8_STAMP();
    unsigned voffA[2], voffB[2];
#pragma unroll
    for (int i = 0; i < 2; ++i) { int R, C; stage_rc(tid * 16 + i * 8192, R, C); const int Rb = Epi::PERM ? ((R & ~31) + perm32(R & 31)) : R;
        voffA[i] = (unsigned)(R * K + C) * 2u; voffB[i] = (unsigned)(Rb * K + C) * 2u; }
    const size_t kstep = (size_t)(BK * 2);
    const size_t hstep = (size_t)HALF * K * 2;
    const size_t tstep = 2 * hstep;
    const unsigned ldsw = (unsigned)wid * 1024u;
    const int aoff = lds_byte(wr * 64 + fr, fq * 8), boff = lds_byte(wc * 32 + fr, fq * 8);
#define PG8_SA(b, h) (((b) * 2 + (h)) * HTB)
#define PG8_SB(b, h) ((4 + (b) * 2 + (h)) * HTB)
#define PG8_STAGE(bufoff, gbase, voff) do { _Pragma("unroll") for (int _i = 0; _i < 2; ++_i) \
        __builtin_amdgcn_global_load_lds((const unsigned*)((const char*)(gbase) + (voff)[_i]), (PG8_LAS unsigned*)(lds + (bufoff) + ldsw + _i * 8192), 16, 0, 0); } while (0)
#define PG8_LDA(dst, b, h) do { _Pragma("unroll") for (int m = 0; m < 4; ++m) _Pragma("unroll") for (int k = 0; k < 2; ++k) dst[m][k] = *(const PG8_LAS bf16x8*)(lds + PG8_SA(b, h) + aoff + m * 2048 + k * 1024); } while (0)
#define PG8_LDB(dst, b, h) do { _Pragma("unroll") for (int n = 0; n < 2; ++n) _Pragma("unroll") for (int k = 0; k < 2; ++k) dst[n][k] = *(const PG8_LAS bf16x8*)(lds + PG8_SB(b, h) + boff + n * 2048 + k * 1024); } while (0)
#define PG8_MMA(ai, bj, At, Bt) do { __builtin_amdgcn_s_setprio(1); _Pragma("unroll") for (int m = 0; m < 4; ++m) _Pragma("unroll") for (int n = 0; n < 2; ++n) _Pragma("unroll") for (int k = 0; k < 2; ++k) \
        acc[ai][bj][m][n] = __builtin_amdgcn_mfma_f32_16x16x32_bf16(Bt[n][k], At[m][k], acc[ai][bj][m][n], 0, 0, 0); __builtin_amdgcn_s_setprio(0); } while (0)
#define PG8_WAIT_V(n) asm volatile("s_waitcnt vmcnt(" #n ")" ::: "memory")
#define PG8_WAIT_L(n) asm volatile("s_waitcnt lgkmcnt(" #n ")" ::: "memory")
#define PG8_BAR __builtin_amdgcn_s_barrier()
#define PG8_SCHED __builtin_amdgcn_sched_barrier(0)
    Unit cur, nxt; int ui = 0;
    if (!S.next(0, cur)) return;
    f32x4 acc[2][2][4][2];
#pragma unroll
    for (int a = 0; a < 2; ++a)
#pragma unroll
        for (int b = 0; b < 2; ++b)
#pragma unroll
            for (int m = 0; m < 4; ++m)
#pragma unroll
                for (int n = 0; n < 2; ++n) acc[a][b][m][n] = (f32x4){0.f, 0.f, 0.f, 0.f};
    bf16x8 At[4][2], B0[2][2], B1[2][2];
    const char* cA = (const char*)g.A + (size_t)cur.pm * tstep; const char* cB = (const char*)g.Bt + (size_t)cur.pn * tstep;
    S.a_ready(cur);
    PG8_STAGE(PG8_SB(0, 0), cB, voffB); PG8_STAGE(PG8_SA(0, 0), cA, voffA); PG8_STAGE(PG8_SB(0, 1), cB + hstep, voffB); PG8_STAGE(PG8_SA(0, 1), cA + hstep, voffA);
    if (wr == 1) PG8_BAR;
    PG8_WAIT_V(4); PG8_BAR;
    PG8_STAGE(PG8_SB(1, 0), cB + kstep, voffB); PG8_STAGE(PG8_SA(1, 0), cA + kstep, voffA); PG8_STAGE(PG8_SB(1, 1), cB + hstep + kstep, voffB);
    PG8_WAIT_V(6); PG8_BAR;
    PG8_STAMP();
    for (;;) {
        const bool has_next = S.next(ui + 1, nxt);
        const char* nA = has_next ? (const char*)g.A + (size_t)nxt.pm * tstep : cA; const char* nB = has_next ? (const char*)g.Bt + (size_t)nxt.pn * tstep : cB;
        for (int t = 0; t < nt; t += 2) {
            const bool last = (t == nt - 2);
            const char* a1 = cA + (size_t)(t + 1) * kstep;
            const char* a2 = last ? nA : cA + (size_t)(t + 2) * kstep; const char* b2 = last ? nB : cB + (size_t)(t + 2) * kstep;
            const char* a3 = a2 + kstep; const char* b3 = b2 + kstep;
            if (last && has_next) S.a_ready(nxt);
            PG8_LDB(B0, 0, 0); PG8_SCHED; PG8_LDA(At, 0, 0); PG8_STAGE(PG8_SA(1, 1), a1 + hstep, voffA);
            PG8_WAIT_L(8); PG8_BAR; PG8_WAIT_L(0); PG8_MMA(0, 0, At, B0); PG8_BAR; PG8_SCHED;
            PG8_LDB(B1, 0, 1); PG8_STAGE(PG8_SB(0, 0), b2, voffB);
            PG8_BAR; PG8_WAIT_L(0); PG8_MMA(0, 1, At, B1); PG8_BAR;
            PG8_LDA(At, 0, 1); PG8_STAGE(PG8_SA(0, 0), a2, voffA);
            PG8_BAR; PG8_WAIT_L(0); PG8_MMA(1, 0, At, B0); PG8_BAR; PG8_SCHED;
            PG8_STAGE(PG8_SB(0, 1), b2 + hstep, voffB);
            PG8_WAIT_V(6); PG8_BAR; PG8_MMA(1, 1, At, B1); PG8_BAR;
            PG8_LDB(B0, 1, 0); PG8_SCHED; PG8_LDA(At, 1, 0); PG8_STAGE(PG8_SA(0, 1), a2 + hstep, voffA);
            PG8_WAIT_L(8); PG8_BAR; PG8_WAIT_L(0); PG8_MMA(0, 0, At, B0); PG8_BAR; PG8_SCHED;
            PG8_LDB(B1, 1, 1); PG8_STAGE(PG8_SB(1, 0), b3, voffB);
            PG8_BAR; PG8_WAIT_L(0); PG8_MMA(0, 1, At, B1); PG8_BAR;
            PG8_LDA(At, 1, 1); PG8_STAGE(PG8_SA(1, 0), a3, voffA);
            PG8_BAR; PG8_WAIT_L(0); PG8_MMA(1, 0, At, B0); PG8_BAR; PG8_SCHED;
            PG8_STAGE(PG8_SB(1, 1), b3 + hstep, voffB);
            PG8_WAIT_V(6); PG8_BAR; PG8_MMA(1, 1, At, B1); PG8_BAR;
        }
        PG8_STAMP();
        if constexpr (!Epi::AFTER_DRAIN) { E(acc, cur, wr, wc, fr, fq); S.done(cur); }
        PG8_STAMP();
        if (!has_next) break;
#pragma unroll
        for (int a = 0; a < 2; ++a)
#pragma unroll
            for (int b = 0; b < 2; ++b)
#pragma unroll
                for (int m = 0; m < 4; ++m)
#pragma unroll
                    for (int n = 0; n < 2; ++n) acc[a][b][m][n] = (f32x4){0.f, 0.f, 0.f, 0.f};
        cur = nxt; cA = nA; cB = nB; ++ui;
    }
    PG8_WAIT_V(0);
    if (wr == 0) PG8_BAR;
    PG8_BAR;
    if constexpr (Epi::AFTER_DRAIN) { E.fused(acc, cur, wr, wc, fr, fq, lds, wid, lane); S.done(cur); }
    PG8_STAMP();
    if (STAMP && wid == 0) { stamps[lane] = lane < nts ? (((unsigned long long)(unsigned)ts_hi << 32) | (unsigned)ts_lo) : 0ull;
        if (lane == 62) stamps[62] = rt_entry; if (lane == 63) stamps[63] = (unsigned long long)wall_clock64(); }
#undef PG8_STAMP
#undef PG8_SA
#undef PG8_SB
#undef PG8_STAGE
#undef PG8_LDA
#undef PG8_LDB
#undef PG8_MMA
#undef PG8_WAIT_V
#undef PG8_WAIT_L
#undef PG8_BAR
#undef PG8_SCHED
}
}

template <class F> struct EpiAdapt {
    static constexpr bool PERM = true, AFTER_DRAIN = false;
    F f;
    __device__ __forceinline__ void operator()(const pg8::f32x4 (&acc)[2][2][4][2], const pg8::Unit& u, int wr, int wc, int fr, int fq) const {
        constexpr int B = F::BATCH;
        const int row0 = u.pm * 256 + wr * 64 + fr, col0 = u.pn * 256 + wc * 32 + 8 * fq;
        f32x4 b0[2], b1[2];
        if constexpr (F::COLBIAS) { f.bias8(col0, b0[0], b1[0]); f.bias8(col0 + 128, b0[1], b1[1]); }
#pragma unroll
        for (int q0 = 0; q0 < 16; q0 += B) {
            typename F::Pre pre[B];
#pragma unroll
            for (int i = 0; i < B; ++i) { const int q = q0 + i, bj = q & 1, m = (q >> 1) & 3, ai = q >> 3; pre[i] = f.pre(row0 + ai * 128 + m * 16, col0 + bj * 128); }
#pragma unroll
            for (int i = 0; i < B; ++i) { const int q = q0 + i, bj = q & 1, m = (q >> 1) & 3, ai = q >> 3;
                f32x4 v0 = acc[ai][bj][m][0], v1 = acc[ai][bj][m][1];
                if constexpr (F::COLBIAS) { v0 += b0[bj]; v1 += b1[bj]; }
                f.put(row0 + ai * 128 + m * 16, col0 + bj * 128, v0, v1, pre[i]); }
        }
    }
};
template <class F>
DEVI void gemm_pg8(const bf16_t* A, const bf16_t* Bt, int M, int N, int K, const F& f, char* smem, int bid, int nblk) {
    pg8::Gemm g{A, Bt, M, N, K};
    pg8::StaticOrder S; S.init(M, N, nblk, bid);
    EpiAdapt<F> E{f};
    __syncthreads();
    pg8::gemm_phase<EpiAdapt<F>, pg8::StaticOrder, false>((PG8_LAS unsigned char*)smem, g, S, E, nullptr);
    __syncthreads();
}

template <class F>
DEVI void gemm_small_rows(const bf16_t* __restrict__ A, const bf16_t* __restrict__ Bt, int N, const F& f, char* smem, int bid, int nblk) {
    const int tid = tid_opq(), lane = tid & 63, wid = tid >> 6, fr = lane & 15, fq = lane >> 4;
    float* part = (float*)smem;
    const int ntn = N / 64, ntiles = (NTS / 32) * ntn;
    for (int tile = bid; tile < ntiles; tile += nblk) {
        const int tm = tile / ntn, tn = tile % ntn;
        const int row0 = NTP + tm * 32, col0 = tn * 64;
        f32x4 acc[2][4];
#pragma unroll
        for (int m = 0; m < 2; ++m)
#pragma unroll
            for (int n = 0; n < 4; ++n) acc[m][n] = (f32x4){0.f, 0.f, 0.f, 0.f};
        const bf16_t* ap = A + (size_t)(row0 + fr) * 1024 + wid * 128 + fq * 8;
        const bf16_t* bp = Bt + (size_t)(col0 + fr) * 1024 + wid * 128 + fq * 8;
        bf16x8 af[4][2], bfr[4][4];
#pragma unroll
        for (int ks = 0; ks < 4; ++ks) {
#pragma unroll
            for (int m = 0; m < 2; ++m) af[ks][m] = *(const bf16x8*)(ap + (size_t)m * 16 * 1024 + ks * 32);
#pragma unroll
            for (int n = 0; n < 4; ++n) bfr[ks][n] = *(const bf16x8*)(bp + (size_t)n * 16 * 1024 + ks * 32);
        }
#pragma unroll
        for (int ks = 0; ks < 4; ++ks)
#pragma unroll
            for (int m = 0; m < 2; ++m)
#pragma unroll
                for (int n = 0; n < 4; ++n) acc[m][n] = __builtin_amdgcn_mfma_f32_16x16x32_bf16(bfr[ks][n], af[ks][m], acc[m][n], 0, 0, 0);
        __syncthreads();
#pragma unroll
        for (int m = 0; m < 2; ++m)
#pragma unroll
            for (int n = 0; n < 4; ++n) *(f32x4*)(part + ((size_t)wid * 32 + m * 16 + fr) * 64 + n * 16 + fq * 4) = acc[m][n];
        __syncthreads();
        if (tid < 256) {
            const int r = tid >> 3, c8 = (tid & 7) * 8;
            f32x4 v0 = {0.f, 0.f, 0.f, 0.f}, v1 = v0;
#pragma unroll
            for (int w = 0; w < 8; ++w) { v0 += *(const f32x4*)(part + ((size_t)w * 32 + r) * 64 + c8); v1 += *(const f32x4*)(part + ((size_t)w * 32 + r) * 64 + c8 + 4); }
            const typename F::Pre pre = f.pre(row0 + r, col0 + c8);
            f.put(row0 + r, col0 + c8, v0, v1, pre);
        }
    }
}
template <class F>
DEVI void gemm_tail(const bf16_t* A, const bf16_t* Bt, int N, const F& f, char* smem, int bid, int nblk) {
    gemm_small_rows(A, Bt, N, f, smem, bid, nblk);
    gemm_pg8(A, Bt, NTP, N, 1024, f, smem, bid, nblk);
}

#define XB_TMO      128
#define XB_XCNT(j)  (256  + 64 * (j))
#define XB_XSUB(j)  (1280 + 64 * (j))
#define XB_XGEN(j)  (2304 + 64 * (j))
#define XB_TOP      3328
#define XB_TOPGEN   3392
#define XCD_BAR_WORDS 3456
#define XB_SPIN_CAP (1u << 18)
#define LAS __attribute__((address_space(3)))

__device__ __forceinline__ unsigned xb_ld(unsigned* p)              { return __hip_atomic_load(p, __ATOMIC_RELAXED, __HIP_MEMORY_SCOPE_AGENT); }
__device__ __forceinline__ unsigned xb_add(unsigned* p, unsigned v) { return __hip_atomic_fetch_add(p, v, __ATOMIC_RELAXED, __HIP_MEMORY_SCOPE_AGENT); }
__device__ __forceinline__ unsigned xb_xcc_id() { return (unsigned)__builtin_amdgcn_s_getreg((3 << 11) | 20) & 0xFu; }
#define XB_SPIN(cond, bar) do { unsigned _sp = 0; while (cond) { __builtin_amdgcn_s_sleep(1); \
    if ((++_sp & 255u) == 0u) { if (xb_ld(&(bar)[XB_TMO])) break; if (_sp > XB_SPIN_CAP) { atomicAdd(&(bar)[XB_TMO], 1u); break; } } } } while (0)

struct XcdBarrier {
    unsigned* bar; unsigned x;
    volatile LAS unsigned* st;
};

__device__ __forceinline__ XcdBarrier xcd_barrier_post(unsigned* bar, volatile LAS unsigned* st) {
    XcdBarrier b; b.bar = bar; b.x = xb_xcc_id(); b.st = st;
    if (tid_opq() == 0) (void)xb_add(&bar[XB_XCNT(b.x)], 1u);
    return b;
}
__device__ __forceinline__ void xcd_barrier_complete(unsigned* bar, unsigned x, unsigned& nloc, unsigned& nx) {
    const unsigned G = gridDim.x * gridDim.y * gridDim.z;
    unsigned sum, cnt, mine, sp = 0u;
    for (;;) {
        sum = 0u; cnt = 0u; mine = 0u;
#pragma unroll
        for (unsigned j = 0; j < 16; ++j) { const unsigned c = xb_ld(&bar[XB_XCNT(j)]); sum += c; cnt += (c > 0u) ? 1u : 0u; mine = (j == x) ? c : mine; }
        if (sum == G) break;
        __builtin_amdgcn_s_sleep(1);
        if ((++sp & 255u) == 0u) { if (xb_ld(&bar[XB_TMO])) break; if (sp > XB_SPIN_CAP) { atomicAdd(&bar[XB_TMO], 1u); break; } }
    }
    nloc = mine > 0u ? mine : 1u; nx = cnt > 0u ? cnt : 1u;
}

__device__ __forceinline__ void xcd_barrier(const XcdBarrier& b) {
    asm volatile("s_waitcnt vmcnt(0)" ::: "memory");
    __syncthreads();
    if (tid_opq() == 0) {
        unsigned* bar = b.bar;
        __builtin_amdgcn_s_waitcnt(0);
        unsigned nloc = b.st[0], nx = b.st[1];
        if (nloc == 0u) { xcd_barrier_complete(bar, b.x, nloc, nx); b.st[0] = nloc; b.st[1] = nx; }
        const unsigned old = xb_add(&bar[XB_XSUB(b.x)], 1u);
        const unsigned gen = old / nloc;
        if (old + 1u == (gen + 1u) * nloc) {
            __builtin_amdgcn_fence(__ATOMIC_RELEASE, "agent");
            asm volatile("s_waitcnt vmcnt(0)" ::: "memory");
            const unsigned og = xb_add(&bar[XB_TOP], 1u);
            const unsigned tg = og / nx;
            if (og + 1u == (tg + 1u) * nx) xb_add(&bar[XB_TOPGEN], 1u);
            else XB_SPIN(xb_ld(&bar[XB_TOPGEN]) == tg, bar);
            __builtin_amdgcn_fence(__ATOMIC_ACQUIRE, "agent");
            xb_add(&bar[XB_XGEN(b.x)], 1u);
            asm volatile("s_waitcnt vmcnt(0)" ::: "memory");
        } else {
            XB_SPIN(xb_ld(&bar[XB_XGEN(b.x)]) == gen, bar);
            __builtin_amdgcn_fence(__ATOMIC_ACQUIRE, "agent");
            asm volatile("s_waitcnt vmcnt(0)" ::: "memory");
        }
    }
    __syncthreads();
}

constexpr int LDS_BYTES = 152 * 1024;

template <int S>
DEVI void run_stage(const P& p, char* smem, int bid, int nblk) {
    if (S == 0) stage_prologue(p, smem, bid, nblk);
    if (S == 1) { EpiInProj e{p}; gemm_pg8(p.XB, p.WINT, NT, NPAD_IN + 2048, 1024, e, smem, bid, nblk); }
    if (S == 2) {
        stage2_queue(p, smem);
    }
    if (S == 4) { stage_mlstm_scan(p, bid, nblk); stage_nsa_attn(p, smem, bid, nblk); }
    if (S == 5) { stage_mlstm_out(p, smem, bid, nblk); { EpiM1 e{p}; gemm_tail(p.YB, p.WBT, 1024, e, smem, bid, nblk); } }
    if (S == 6) { EpiM2 e{p}; gemm_tail(p.YA, p.WAT, 1024, e, smem, bid, nblk); }
    if (S == 8) { EpiR e{p}; gemm_tail(p.MERGED, p.WOT, 1024, e, smem, bid, nblk); }
    if (S == 9) stage_ln1(p, bid, nblk);
    if (S == 10) { EpiPQ e{p}; gemm_tail(p.HB, p.WQT, 2048, e, smem, bid, nblk); }
    if (S == 11) {
        if (bid & 1) {
            for (int ps = 0; ps < 4; ++ps) { stage_peer_route(p, smem, bid, nblk, ps, ps + 1); __threadfence_block(); __syncthreads(); stage_peer_apply(p, smem, bid, nblk, ps, ps + 1); __syncthreads(); }
        } else { stage_peer_route(p, smem, bid, nblk, 0, 64); __threadfence_block(); __syncthreads(); stage_peer_apply(p, smem, bid, nblk, 0, 64); }
    }
}
constexpr int NSTAGES = 13;

template <int S>
__global__ void __launch_bounds__(512, 2) k_stage(P p) {
    extern __shared__ __attribute__((aligned(16))) char smem[];
    run_stage<S>(p, smem, blockIdx.x, gridDim.x);
}


#if MK_ONE_LAUNCH
__global__ void __launch_bounds__(512, 2) k_mega(P p) {
    extern __shared__ __attribute__((aligned(16))) char smem_all[];
    if (tid_opq() == 0) *(u32x4*)smem_all = (u32x4){0u, 0u, 0u, 0u};
    __syncthreads();
    XcdBarrier bar = xcd_barrier_post(p.bar, (volatile LAS unsigned*)smem_all);
    char* smem = smem_all + 16;
    const int bid = blockIdx.x, nblk = gridDim.x;
    run_stage<0>(p, smem, bid, nblk); if ((REP_MASK >> 0) & 1) { xcd_barrier(bar); run_stage<0>(p, smem, bid, nblk); }  xcd_barrier(bar);
    run_stage<1>(p, smem, bid, nblk); if ((REP_MASK >> 1) & 1) { xcd_barrier(bar); run_stage<1>(p, smem, bid, nblk); }  xcd_barrier(bar);
    run_stage<2>(p, smem, bid, nblk); if ((REP_MASK >> 2) & 1) { xcd_barrier(bar); run_stage<2>(p, smem, bid, nblk); }  xcd_barrier(bar);
    run_stage<4>(p, smem, bid, nblk); if ((REP_MASK >> 4) & 1) { xcd_barrier(bar); run_stage<4>(p, smem, bid, nblk); }  xcd_barrier(bar);
    run_stage<5>(p, smem, bid, nblk); if ((REP_MASK >> 5) & 1) { xcd_barrier(bar); run_stage<5>(p, smem, bid, nblk); }  xcd_barrier(bar);
    run_stage<6>(p, smem, bid, nblk); if ((REP_MASK >> 6) & 1) { xcd_barrier(bar); run_stage<6>(p, smem, bid, nblk); }  xcd_barrier(bar);
    run_stage<8>(p, smem, bid, nblk); if ((REP_MASK >> 8) & 1) { xcd_barrier(bar); run_stage<8>(p, smem, bid, nblk); }  xcd_barrier(bar);
    run_stage<9>(p, smem, bid, nblk); if ((REP_MASK >> 9) & 1) { xcd_barrier(bar); run_stage<9>(p, smem, bid, nblk); }  xcd_barrier(bar);
    run_stage<10>(p, smem, bid, nblk); if ((REP_MASK >> 10) & 1) { xcd_barrier(bar); run_stage<10>(p, smem, bid, nblk); } xcd_barrier(bar);
    run_stage<11>(p, smem, bid, nblk); if ((REP_MASK >> 11) & 1) { xcd_barrier(bar); run_stage<11>(p, smem, bid, nblk); }
}
#endif

template <int S> static void launch_stage(const P& p, int grid, hipStream_t stream) {
    (void)hipFuncSetAttribute((const void*)k_stage<S>, hipFuncAttributeMaxDynamicSharedMemorySize, LDS_BYTES);
    k_stage<S><<<dim3(grid), dim3(512), LDS_BYTES, stream>>>(p);
}

extern "C" void kernel_launch(void* const* d_in, const int* in_sizes, int n_in, void* d_out, int out_size, void* d_ws, size_t ws_size, hipStream_t stream) {
    (void)in_sizes; (void)n_in; (void)out_size; (void)ws_size;
    P p{};
    p.xp = (const float*)d_in[0]; p.xs = (const float*)d_in[1]; p.cache_cmp = (const float*)d_in[2]; p.cache_slc = (const float*)d_in[3];
    p.cache_win = (const float*)d_in[4]; p.state_C = (const float*)d_in[5]; p.state_n = (const float*)d_in[6]; p.state_m = (const float*)d_in[7];
    p.page_table = (const int*)d_in[8];
    p.w_in = (const float*)d_in[9]; p.b_in = (const float*)d_in[10]; p.norm_a_g = (const float*)d_in[11]; p.nsa_pe = (const float*)d_in[12];
    p.nsa_w_cmp = (const float*)d_in[13]; p.w_br_a = (const float*)d_in[14]; p.w_br_b = (const float*)d_in[15]; p.w_merge = (const float*)d_in[16];
    p.w_out = (const float*)d_in[17]; p.ln1_g = (const float*)d_in[18]; p.ln1_b = (const float*)d_in[19];
    p.peer_wq = (const float*)d_in[20]; p.peer_keys = (const float*)d_in[21]; p.peer_u = (const float*)d_in[22]; p.peer_v = (const float*)d_in[23];
    p.ln2_g = (const float*)d_in[24]; p.ln2_b = (const float*)d_in[25];
    p.out = (float*)d_out;
    char* w = (char*)d_ws; size_t off = 0;
    auto take = [&](size_t bytes) { char* r = w + off; off += (bytes + 255) & ~(size_t)255; return r; };
    p.bar = (unsigned*)take(16384);
    p.PW = (float*)(p.bar + 3584);
    p.WCT = (bf16_t*)take((size_t)2 * 64 * 4096 * 2);
    p.XB = (bf16_t*)take((size_t)NT * 1024 * 2);
    p.WINT = (bf16_t*)take((size_t)(NPAD_IN + 2048) * 1024 * 2);
    p.WMT = (bf16_t*)take((size_t)2048 * 1024 * 2);
    p.WAT = (bf16_t*)take((size_t)1024 * 1024 * 2);
    p.WBT = (bf16_t*)take((size_t)1024 * 1024 * 2);
    p.WOT = (bf16_t*)take((size_t)1024 * 1024 * 2);
    p.WQT = (bf16_t*)take((size_t)2048 * 1024 * 2);
    p.KEYSB = (bf16_t*)take((size_t)16 * 128 * 128 * 2);
    p.U8 = (unsigned char*)take((size_t)16384 * 1024);
    p.V8 = (unsigned char*)take((size_t)16384 * 1024);
    p.US = (float*)take(16384 * 4);
    p.VS = (float*)take(16384 * 4);
    p.PROJ = (bf16_t*)take((size_t)NT * PS * 2);
    p.SM = (float*)take((size_t)NT * 64 * 4);
    p.BCUM = (float*)take((size_t)16 * 4096 * 4);
    p.MPREV = (float*)take(4096); p.ACOEF = (float*)take(4096); p.SCL = (float*)take(4096); p.MLOC = (float*)take(4096);
    p.DC = (float*)take((size_t)1024 * 272 * 128 * 4);
    p.CPT = (bf16_t*)take((size_t)1024 * 272 * 128 * 2);
    p.KC = (float*)take((size_t)4352 * 512 * 4);
    p.VC = p.KC + 256;
    p.OCMP = (float*)take((size_t)NT * 1024 * 4);
    p.SEL = (unsigned long long*)take((size_t)NT * 4 * 8);
    p.YA = (bf16_t*)take((size_t)NT * 1024 * 2);
    p.YB = (bf16_t*)take((size_t)NT * 1024 * 2);
    p.G = (bf16_t*)take((size_t)NT * 2048 * 2);
    p.TMPB = (bf16_t*)take((size_t)NT * 1024 * 2);
    p.MERGED = (bf16_t*)take((size_t)NT * 1024 * 2);
    p.R = (float*)take((size_t)NT * 1024 * 4);
    p.H = (float*)take((size_t)NT * 1024 * 4);
    p.HB = (bf16_t*)take((size_t)NT * 1024 * 2);
    p.PQ = (bf16_t*)take((size_t)NT * 2048 * 2);
    p.EIDX = (int*)take((size_t)NT * 128 * 4);
    p.EGATE = (float*)take((size_t)NT * 128 * 4);

    (void)hipMemsetAsync(p.bar, 0, 16384, stream);
#if MK_ONE_LAUNCH
    {
        constexpr size_t kDynLds = LDS_BYTES + 16;
        (void)hipFuncSetAttribute((const void*)k_mega, hipFuncAttributeMaxDynamicSharedMemorySize, (int)kDynLds);
        int dev = 0, cus = 0, per_cu = 0;
        (void)hipGetDevice(&dev);
        (void)hipDeviceGetAttribute(&cus, hipDeviceAttributeMultiprocessorCount, dev);
        (void)hipOccupancyMaxActiveBlocksPerMultiprocessor(&per_cu, (const void*)k_mega, 512, kDynLds);
        if (per_cu < 1 || cus < 1) return;
        const int grid = cus;
        k_mega<<<dim3(grid), dim3(512), kDynLds, stream>>>(p);
    }
#else
    const int grid = 512;
    launch_stage<0>(p, grid, stream);
    launch_stage<1>(p, grid, stream);
    launch_stage<2>(p, grid, stream);
    launch_stage<4>(p, grid, stream);
    launch_stage<5>(p, grid, stream);
    launch_stage<6>(p, grid, stream);
    launch_stage<8>(p, grid, stream);
    launch_stage<9>(p, grid, stream);
    launch_stage<10>(p, grid, stream);
    launch_stage<11>(p, grid, stream);
#endif
}
```

```cpp
#include <hip/hip_runtime.h>
#include <stdint.h>

#ifndef REP_MASK
#define REP_MASK 0
#endif
#ifndef MK_ONE_LAUNCH
#define MK_ONE_LAUNCH 1
#endif

typedef unsigned short bf16_t;
typedef short bf16x8 __attribute__((ext_vector_type(8)));
typedef float f32x4 __attribute__((ext_vector_type(4)));
typedef unsigned u32x4 __attribute__((ext_vector_type(4)));
#define V_FP6 1
typedef int i32x8 __attribute__((ext_vector_type(8)));
typedef int i32x6 __attribute__((ext_vector_type(6)));
typedef float f32x32 __attribute__((ext_vector_type(32)));
struct __attribute__((packed, aligned(4))) U3 { unsigned a, b, c; };
typedef unsigned u32x2 __attribute__((ext_vector_type(2)));
typedef float f32x2 __attribute__((ext_vector_type(2)));
typedef __bf16 bf16x2_t __attribute__((ext_vector_type(2)));
#define DEVI __device__ __forceinline__
__device__ __forceinline__ int tid_opq() { int t = threadIdx.x; asm volatile("" : "+v"(t)); return t; }

constexpr int NTP = 16384, NTS = 512, NT = NTP + NTS, DM = 1024;
constexpr int PS = 5632;
constexpr int C_AQ = 0, C_AK = 512, C_AV = 1024, C_AO = 2048, C_BQ = 3072, C_CMP = 4096, C_SLC = 4608, C_WIN = 5120;
constexpr int NPAD_IN = 5888;
constexpr float DN_ALPHA = 1.189207115002721f;
constexpr float LN_EPS = 1e-5f;
constexpr size_t O_Y = 0;
constexpr size_t O_PCMP = O_Y + (size_t)NT * 1024;
constexpr size_t O_PSLC = O_PCMP + (size_t)NTP * 512;
constexpr size_t O_PWIN = O_PSLC + (size_t)NTP * 512;
constexpr size_t O_PC = O_PWIN + (size_t)4 * 512 * 512;
constexpr size_t O_PN = O_PC + (size_t)16 * 128 * 256;
constexpr size_t O_PM = O_PN + 16 * 128;
constexpr size_t O_SCMP = O_PM + 16;
constexpr size_t O_SSLC = O_SCMP + (size_t)NTS * 512;
constexpr size_t O_SWIN = O_SSLC + (size_t)NTS * 512;
constexpr size_t O_SC = O_SWIN + (size_t)128 * 512 * 512;
constexpr size_t O_SN = O_SC + (size_t)512 * 128 * 256;
constexpr size_t O_SM = O_SN + 512 * 128;

struct P {
    const float *xp, *xs, *cache_cmp, *cache_slc, *cache_win, *state_C, *state_n, *state_m;
    const int* page_table;
    const float *w_in, *b_in, *norm_a_g, *nsa_pe, *nsa_w_cmp, *w_br_a, *w_br_b, *w_merge, *w_out, *ln1_g, *ln1_b;
    const float *peer_wq, *peer_keys, *peer_u, *peer_v, *ln2_g, *ln2_b;
    float* out;
    bf16_t *XB, *WINT, *WMT, *WAT, *WBT, *WOT, *WQT, *KEYSB, *UB, *VB, *PROJ, *WCT;
    float* PW;
    float *SM, *BCUM, *MPREV, *ACOEF, *SCL, *MLOC, *DC, *KC, *VC, *OCMP;
    bf16_t* CPT;
    unsigned char *U8, *V8;
    float *US, *VS;
    unsigned long long* SEL;
    bf16_t *YA, *YB, *G, *MERGED, *HB, *PQ;
    float *R, *H, *EGATE;
    bf16_t* TMPB;
    int* EIDX;
    unsigned* bar;
};

DEVI bf16_t f2bf(float f) { return __builtin_bit_cast(unsigned short, (__bf16)f); }
DEVI float bf2f(bf16_t h) { return __uint_as_float(((unsigned)h) << 16); }
DEVI unsigned pack2(float a, float b) { return __builtin_bit_cast(unsigned, __builtin_convertvector((f32x2){a, b}, bf16x2_t)); }
DEVI u32x4 pack8f(const f32x4 a, const f32x4 b) { u32x4 r; r[0] = pack2(a[0], a[1]); r[1] = pack2(a[2], a[3]); r[2] = pack2(b[0], b[1]); r[3] = pack2(b[2], b[3]); return r; }
DEVI void ce_desc(unsigned& a, unsigned& b) { const unsigned hi = a > b ? a : b, lo = a > b ? b : a; a = hi; b = lo; }
template <int BASE> DEVI void sort16_desc(unsigned (&x)[64]) {
#pragma unroll
    for (int k = 2; k <= 16; k <<= 1)
#pragma unroll
        for (int j = k >> 1; j > 0; j >>= 1)
#pragma unroll
            for (int i = 0; i < 16; ++i) {
                const int l = i ^ j;
                if (l > i) { if ((i & k) == 0) ce_desc(x[BASE + i], x[BASE + l]); else ce_desc(x[BASE + l], x[BASE + i]); }
            }
}
DEVI void merge_top16(const unsigned* a, const unsigned* b, unsigned* t) {
    unsigned c[16];
#pragma unroll
    for (int i = 0; i < 16; ++i) c[i] = a[i] > b[15 - i] ? a[i] : b[15 - i];
#pragma unroll
    for (int j = 8; j > 0; j >>= 1)
#pragma unroll
        for (int i = 0; i < 16; ++i) { const int l = i ^ j; if (l > i) ce_desc(c[i], c[l]); }
#pragma unroll
    for (int i = 0; i < 16; ++i) t[i] = c[i];
}
DEVI float gelu_erf(float v) {
    const float av = fabsf(v), t = __builtin_amdgcn_rcpf(fmaf(av, 0.2316418882f, 1.0f));
    float q = fmaf(t, 0.5307027145f, -0.7265760135f); q = fmaf(q, t, 0.7107068705f); q = fmaf(q, t, -0.142248368f); q = fmaf(q, t, 0.127414796f); q = q * t;
    const float e = __builtin_amdgcn_exp2f(v * v * -0.72134752044f);
    const float mm = v * (q * e);
    return v < 0.f ? mm : v - mm;
}
DEVI float wave_max(float v) { for (int o = 32; o > 0; o >>= 1) v = fmaxf(v, __shfl_xor(v, o)); return v; }
DEVI float wave_sum(float v) { for (int o = 32; o > 0; o >>= 1) v += __shfl_xor(v, o); return v; }
DEVI float sigmoidf_(float x) { return __builtin_amdgcn_rcpf(1.f + __expf(-x)); }
DEVI float logsigmoidf_(float x) { return fminf(x, 0.f) - log1pf(__expf(-fabsf(x))); }
DEVI int win_map(int np) {
    if (np < 2048) return np;
    if (np < 5632) return np + 8;
    if (np < 5640) return np - 5632 + 2048;
    if (np < 5688) return np;
    return -1;
}
DEVI float alibi_slope(int h) { return exp2f(-0.5f * (float)(h + 1)); }

template <class MapFn>
DEVI void transpose_cvt(const float* __restrict__ W, bf16_t* __restrict__ WT, int K, int Nsrc, int Ndst, MapFn mapfn, float* tile  , int bid, int nblk) {
    const int tid = tid_opq();
    const int tn = Ndst / 64, tk = K / 64;
    for (int t = bid; t < tn * tk; t += nblk) {
        const int n0 = (t % tn) * 64, k0 = (t / tn) * 64;
        __syncthreads();
#pragma unroll
        for (int i = 0; i < 8; ++i) {
            const int kk = (tid >> 6) + i * 8, nn = tid & 63;
            const int n = mapfn(n0 + nn);
            tile[kk * 65 + nn] = n >= 0 ? W[(size_t)(k0 + kk) * Nsrc + n] : 0.f;
        }
        __syncthreads();
#pragma unroll
        for (int i = 0; i < 8; ++i) {
            const int nn = (tid >> 6) + i * 8, kk = tid & 63;
            WT[(size_t)(n0 + nn) * K + k0 + kk] = f2bf(tile[kk * 65 + nn]);
        }
    }
}
struct IdMap { DEVI int operator()(int n) const { return n; } };
struct WinMap { DEVI int operator()(int n) const { return win_map(n); } };

DEVI void cvt_rows(const float* __restrict__ src, bf16_t* __restrict__ dst, size_t n4, int bid, int nblk) {
    const size_t stride = (size_t)nblk * 512;
    for (size_t i0 = (size_t)bid * 512 + tid_opq(); i0 < n4; i0 += stride * 8) {
        f32x4 v[8];
#pragma unroll
        for (int u = 0; u < 8; ++u) { const size_t i = i0 + u * stride; v[u] = i < n4 ? __builtin_nontemporal_load((const f32x4*)src + i) : (f32x4){0.f, 0.f, 0.f, 0.f}; }
#pragma unroll
        for (int u = 0; u < 8; ++u) { const size_t i = i0 + u * stride; if (i < n4) { u32x2 o; o.x = pack2(v[u][0], v[u][1]); o.y = pack2(v[u][2], v[u][3]); ((u32x2*)dst)[i] = o; } }
    }
}

DEVI unsigned q_e2m3(float x) {
    const float a = fabsf(x);
    const float c = a < 2.f ? rintf(a * 8.f) : a < 4.f ? 16.f + rintf((a - 2.f) * 4.f) : fminf(31.f, 24.f + rintf((a - 4.f) * 2.f));
    return (unsigned)c | (x < 0.f ? 32u : 0u);
}

DEVI void stage_prologue(const P& p, char* smem, int bid, int nblk) {
    float* tile = (float*)smem;
    cvt_rows(p.xp, p.XB, (size_t)NTP * 256, bid, nblk);
    cvt_rows(p.xs, p.XB + (size_t)NTP * 1024, (size_t)NTS * 256, bid, nblk);
    {
        const int lane = tid_opq() & 63, wid = tid_opq() >> 6;
        for (int r0 = bid * 8 + wid; r0 < 2 * 16384; r0 += nblk * 8 * 2) {
            f32x4 x[2][4]; float am[2] = {0.f, 0.f};
#pragma unroll
            for (int j = 0; j < 2; ++j) {
                const int r = r0 + j * nblk * 8;
                if (r < 2 * 16384) {
                    const bool isv = r >= 16384; const int e = isv ? r - 16384 : r;
                    const float* src = (isv ? p.peer_v : p.peer_u) + (size_t)e * 1024 + lane * 16;
#pragma unroll
                    for (int i = 0; i < 4; ++i) x[j][i] = __builtin_nontemporal_load((const f32x4*)(src + i * 4));
                }
            }
#pragma unroll
            for (int j = 0; j < 2; ++j) {
                const int r = r0 + j * nblk * 8;
                if (r < 2 * 16384) {
                    const bool isv = r >= 16384; const int e = isv ? r - 16384 : r;
#pragma unroll
                    for (int i = 0; i < 4; ++i)
#pragma unroll
                        for (int k = 0; k < 4; ++k) am[j] = fmaxf(am[j], fabsf(x[j][i][k]));
                    const float amx = wave_max(am[j]);
#if !V_FP6
                    if (isv) {
                        const float inv8 = amx > 0.f ? 448.f / amx : 1.f;
                        u32x4 o;
#pragma unroll
                        for (int i = 0; i < 4; ++i) { int w = __builtin_amdgcn_cvt_pk_fp8_f32(x[j][i][0] * inv8, x[j][i][1] * inv8, 0, false); w = __builtin_amdgcn_cvt_pk_fp8_f32(x[j][i][2] * inv8, x[j][i][3] * inv8, w, true); o[i] = (unsigned)w; }
                        *(u32x4*)(p.V8 + (size_t)e * 1024 + lane * 16) = o;
                        if (lane == 0) p.VS[e] = amx > 0.f ? amx / 448.f : 1.f;
                        continue;
                    }
#endif
                    const float inv = amx > 0.f ? 7.5f / amx : 1.f;
                    unsigned long long lo = 0ull, hi = 0ull;
#pragma unroll
                    for (int i = 0; i < 16; ++i) {
                        const unsigned long long c = (unsigned long long)q_e2m3(x[j][i >> 2][i & 3] * inv);
                        if (i < 10) lo |= c << (6 * i);
                        else if (i == 10) { lo |= c << 60; hi |= c >> 4; }
                        else hi |= c << (6 * i - 64);
                    }
                    const unsigned w0 = (unsigned)lo, w1 = (unsigned)(lo >> 32), w2 = (unsigned)hi;
                    { unsigned* d = (unsigned*)((isv ? p.V8 : p.U8) + (size_t)e * 768 + lane * 12); d[0] = w0; d[1] = w1; d[2] = w2; }
                    if (lane == 0) (isv ? p.VS : p.US)[e] = amx > 0.f ? amx / 7.5f : 1.f;
                }
            }
        }
    }
    cvt_rows(p.peer_keys, p.KEYSB, (size_t)16 * 128 * 128 / 4, bid, nblk);
    transpose_cvt(p.w_in, p.WINT, 1024, 5688, NPAD_IN, WinMap(), tile, bid, nblk);
    transpose_cvt(p.w_merge, p.WINT + (size_t)NPAD_IN * 1024, 1024, 2048, 2048, IdMap(), tile, bid, nblk);
    transpose_cvt(p.w_br_a, p.WAT, 1024, 1024, 1024, IdMap(), tile, bid, nblk);
    transpose_cvt(p.w_br_b, p.WBT, 1024, 1024, 1024, IdMap(), tile, bid, nblk);
    transpose_cvt(p.w_out, p.WOT, 1024, 1024, 1024, IdMap(), tile, bid, nblk);
    transpose_cvt(p.peer_wq, p.WQT, 1024, 2048, 2048, IdMap(), tile, bid, nblk);
    transpose_cvt(p.nsa_w_cmp, p.WCT, 4096, 64, 64, IdMap(), tile, bid, nblk);
    transpose_cvt(p.nsa_w_cmp + 4096 * 64, p.WCT + 64 * 4096, 4096, 64, 64, IdMap(), tile, bid, nblk);
    for (int blk = bid; blk < 32; blk += nblk) {
        const int tid = tid_opq(), kvv = tid >> 8, e = tid & 63, kq = (tid >> 6) & 3;
        float a = 0.f;
        for (int k = blk * 128 + kq * 32; k < blk * 128 + kq * 32 + 32; ++k) a += p.nsa_pe[kvv * 4096 + k] * p.nsa_w_cmp[((size_t)kvv * 4096 + k) * 64 + e];
        atomicAdd(p.PW + kvv * 64 + e, a);
    }
    {
        const size_t per_b = (size_t)508 * 512 / 4;
        const size_t stride = (size_t)nblk * 512, ntot = 128 * per_b;
        for (size_t i0 = (size_t)bid * 512 + tid_opq(); i0 < ntot; i0 += stride * 8) {
            f32x4 v[8];
#pragma unroll
            for (int u = 0; u < 8; ++u) { const size_t i = i0 + u * stride; if (i < ntot) { const size_t b = i / per_b, r = i % per_b; v[u] = __builtin_nontemporal_load((const f32x4*)(p.cache_win + b * 512 * 512 + 4 * 512) + r); } }
#pragma unroll
            for (int u = 0; u < 8; ++u) { const size_t i = i0 + u * stride; if (i < ntot) { const size_t b = i / per_b, r = i % per_b; __builtin_nontemporal_store(v[u], (f32x4*)(p.out + O_SWIN + b * 512 * 512) + r); } }
        }
    }
}

struct NoPre {};
DEVI f32x4 bf4_lo(const u32x4& g) { return (f32x4){__uint_as_float(g[0] << 16), __uint_as_float(g[0] & 0xFFFF0000u), __uint_as_float(g[1] << 16), __uint_as_float(g[1] & 0xFFFF0000u)}; }
DEVI f32x4 bf4_hi(const u32x4& g) { return (f32x4){__uint_as_float(g[2] << 16), __uint_as_float(g[2] & 0xFFFF0000u), __uint_as_float(g[3] << 16), __uint_as_float(g[3] & 0xFFFF0000u)}; }
struct EpiInProj {
    P p;
    typedef NoPre Pre;
    static constexpr int BATCH = 4;
    static constexpr bool COLBIAS = true;
    DEVI void bias8(int col, f32x4& b0, f32x4& b1) const {
        b0 = (f32x4){0.f, 0.f, 0.f, 0.f}; b1 = b0;
        if (col < 5688) { const int oc = win_map(col);
#pragma unroll
            for (int q = 0; q < 4; ++q) { b0[q] = p.b_in[oc + q]; b1[q] = p.b_in[oc + 4 + q]; } }
    }
    DEVI Pre pre(int, int) const { return NoPre(); }
    DEVI void put(int row, int col, f32x4 v0, f32x4 v1, const Pre&) const {
        if (col >= NPAD_IN) {
#pragma unroll
            for (int k = 0; k < 4; ++k) { v0[k] = sigmoidf_(v0[k]); v1[k] = sigmoidf_(v1[k]); }
            *(u32x4*)(p.G + (size_t)row * 2048 + (col - NPAD_IN)) = pack8f(v0, v1);
            return;
        }
        if (col >= 5688) return;
        if (col >= 5632) { *(f32x4*)(p.SM + (size_t)row * 64 + (col - 5632)) = v0; *(f32x4*)(p.SM + (size_t)row * 64 + (col - 5632) + 4) = v1; return; }
        if (col >= C_AK && col < C_AV) { v0 *= 0.08838834764831845f; v1 *= 0.08838834764831845f; }
        *(u32x4*)(p.PROJ + (size_t)row * PS + col) = pack8f(v0, v1);
        if (col >= C_CMP) {
            const int reg = (col - C_CMP) >> 9, c = (col - C_CMP) & 511;
            float* dst = nullptr;
            if (row < NTP) {
                if (reg == 0) dst = p.out + O_PCMP + (size_t)row * 512 + c;
                else if (reg == 1) dst = p.out + O_PSLC + (size_t)row * 512 + c;
                else { const int b = row >> 12, t = row & 4095; if (t >= 3584) dst = p.out + O_PWIN + ((size_t)b * 512 + (t - 3584)) * 512 + c; }
            } else {
                const int rs = row - NTP;
                if (reg == 0) dst = p.out + O_SCMP + (size_t)rs * 512 + c;
                else if (reg == 1) dst = p.out + O_SSLC + (size_t)rs * 512 + c;
                else { const int b = rs >> 2, tq = rs & 3; dst = p.out + O_SWIN + ((size_t)b * 512 + 508 + tq) * 512 + c; }
            }
            if (dst) { *(f32x4*)dst = v0; *(f32x4*)(dst + 4) = v1; }
        }
    }
};
struct EpiG {
    P p;
    typedef NoPre Pre;
    static constexpr int BATCH = 4;
    static constexpr bool COLBIAS = false;
    DEVI Pre pre(int, int) const { return NoPre(); }
    DEVI void put(int row, int col, f32x4 v0, f32x4 v1, const Pre&) const {
#pragma unroll
        for (int k = 0; k < 4; ++k) { v0[k] = sigmoidf_(v0[k]); v1[k] = sigmoidf_(v1[k]); }
        *(u32x4*)(p.G + (size_t)row * 2048 + col) = pack8f(v0, v1);
    }
};
struct EpiM1 {
    P p;
    typedef u32x4 Pre;
    static constexpr int BATCH = 8;
    static constexpr bool COLBIAS = false;
    DEVI Pre pre(int row, int col) const { return *(const u32x4*)(p.G + (size_t)row * 2048 + 1024 + col); }
    DEVI void put(int row, int col, f32x4 v0, f32x4 v1, const Pre& g) const {
        *(u32x4*)(p.TMPB + (size_t)row * 1024 + col) = pack8f(v0 * bf4_lo(g), v1 * bf4_hi(g));
    }
};
struct PreM2 { u32x4 g; u32x4 t; };
struct EpiM2 {
    P p;
    typedef PreM2 Pre;
    static constexpr int BATCH = 8;
    static constexpr bool COLBIAS = false;
    DEVI Pre pre(int row, int col) const { PreM2 r; r.g = *(const u32x4*)(p.G + (size_t)row * 2048 + col); r.t = *(const u32x4*)(p.TMPB + (size_t)row * 1024 + col); return r; }
    DEVI void put(int row, int col, f32x4 v0, f32x4 v1, const Pre& q) const {
        *(u32x4*)(p.MERGED + (size_t)row * 1024 + col) = pack8f(bf4_lo(q.t) + v0 * bf4_lo(q.g), bf4_hi(q.t) + v1 * bf4_hi(q.g));
    }
};
struct PreR { f32x4 a, b; };
struct EpiR {
    P p;
    typedef PreR Pre;
    static constexpr int BATCH = 8;
    static constexpr bool COLBIAS = false;
    DEVI Pre pre(int row, int col) const {
        const float* xr = row < NTP ? p.xp + (size_t)row * 1024 : p.xs + (size_t)(row - NTP) * 1024;
        PreR r; r.a = *(const f32x4*)(xr + col); r.b = *(const f32x4*)(xr + col + 4); return r;
    }
    DEVI void put(int row, int col, f32x4 v0, f32x4 v1, const Pre& x) const {
        *(f32x4*)(p.R + (size_t)row * 1024 + col) = x.a * DN_ALPHA + v0; *(f32x4*)(p.R + (size_t)row * 1024 + col + 4) = x.b * DN_ALPHA + v1;
    }
};
struct EpiPQ {
    P p;
    typedef NoPre Pre;
    static constexpr int BATCH = 4;
    static constexpr bool COLBIAS = false;
    DEVI Pre pre(int, int) const { return NoPre(); }
    DEVI void put(int row, int col, f32x4 v0, f32x4 v1, const Pre&) const { *(u32x4*)(p.PQ + (size_t)row * 2048 + col) = pack8f(v0, v1); }
};

DEVI void stage_mlstm_gates(const P& p, char* smem, int bid, int nblk) {
    const int lane = tid_opq() & 63, wid = tid_opq() >> 6;
    float* bend_s = (float*)smem; float* mloc_s = bend_s + 64;
    for (int bh = bid; bh < 16; bh += nblk) {
        const int b = bh >> 2, h = bh & 3;
        __syncthreads();
        for (int cc = 0; cc < 8; ++cc) {
            const int c = wid * 8 + cc;
            const size_t row = (size_t)b * 4096 + c * 64 + lane;
            const float ip = p.SM[row * 64 + h];
            const float lf = logsigmoidf_(p.SM[row * 64 + 4 + h]);
            float cs = lf;
#pragma unroll
            for (int o = 1; o < 64; o <<= 1) { const float t = __shfl_up(cs, o); if (lane >= o) cs += t; }
            p.BCUM[bh * 4096 + c * 64 + lane] = cs;
            const float bend = __shfl(cs, 63);
            const float mloc = wave_max(bend - cs + ip);
            if (lane == 0) { bend_s[c] = bend; mloc_s[c] = mloc; }
        }
        __syncthreads();
        if (tid_opq() == 0) {
            float m = 0.f;
            for (int c = 0; c < 64; ++c) {
                const float bend = bend_s[c], mloc = mloc_s[c];
                const float mnew = fmaxf(bend + m, mloc);
                p.MPREV[bh * 64 + c] = m;
                p.ACOEF[bh * 64 + c] = __expf(bend + m - mnew);
                p.SCL[bh * 64 + c] = __expf(mloc - mnew);
                p.MLOC[bh * 64 + c] = mloc;
                m = mnew;
            }
            p.out[O_PM + bh] = m;
        }
    }
}

constexpr int MD_KT = 0, MD_VT = 128 * 144, MD_WS = MD_VT + 272 * 144, MD_LDS = MD_WS + 256;
DEVI void stage_mlstm_dc(const P& p, char* smem, int bid, int nblk) {
    const int tid = tid_opq(), lane = tid & 63, wid = tid >> 6, fr = lane & 15, fq = lane >> 4;
    bf16_t* Kt = (bf16_t*)(smem + MD_KT);
    bf16_t* Vt = (bf16_t*)(smem + MD_VT);
    float* ws = (float*)(smem + MD_WS);
    for (int task = bid; task < 1024; task += nblk) {
        const int bh = task >> 6, c = task & 63, b = bh >> 2, h = bh & 3;
        const size_t row0 = (size_t)b * 4096 + c * 64;
        __syncthreads();
        if (tid < 64) {
            const float ip = p.SM[(row0 + tid) * 64 + h];
            float cs = logsigmoidf_(p.SM[(row0 + tid) * 64 + 4 + h]);
#pragma unroll
            for (int o = 1; o < 64; o <<= 1) { const float t = __shfl_up(cs, o); if (tid >= o) cs += t; }
            const float g = __shfl(cs, 63) - cs + ip;
            ws[tid] = __expf(g - wave_max(g));
        }
        __syncthreads();
        {
            const int sidx = tid & 63, ch = tid >> 6;
            const float w = ws[sidx];
#pragma unroll
            for (int half = 0; half < 2; ++half) {
                const u32x4 kk = *(const u32x4*)(p.PROJ + (row0 + sidx) * PS + C_AK + h * 128 + half * 64 + ch * 8);
#pragma unroll
                for (int e = 0; e < 4; ++e) {
                    Kt[(half * 64 + ch * 8 + e * 2) * 72 + sidx] = f2bf(w * __uint_as_float(kk[e] << 16));
                    Kt[(half * 64 + ch * 8 + e * 2 + 1) * 72 + sidx] = f2bf(w * __uint_as_float(kk[e] & 0xFFFF0000u));
                }
            }
#pragma unroll
            for (int q4 = 0; q4 < 4; ++q4) {
                const u32x4 vv = *(const u32x4*)(p.PROJ + (row0 + sidx) * PS + C_AV + h * 256 + q4 * 64 + ch * 8);
#pragma unroll
                for (int e = 0; e < 4; ++e) {
                    Vt[(q4 * 64 + ch * 8 + e * 2) * 72 + sidx] = (bf16_t)(vv[e] & 0xFFFFu);
                    Vt[(q4 * 64 + ch * 8 + e * 2 + 1) * 72 + sidx] = (bf16_t)(vv[e] >> 16);
                }
            }
            for (int i = tid; i < 16 * 64; i += 512) Vt[(256 + (i >> 6)) * 72 + (i & 63)] = (i >> 6) == 0 ? (bf16_t)0x3F80 : (bf16_t)0;
        }
        __syncthreads();
        const int nvt = wid == 0 ? 3 : 2;
        for (int vi = 0; vi < nvt; ++vi) {
            const int vt = vi < 2 ? wid * 2 + vi : 16;
            f32x4 acc[8];
#pragma unroll
            for (int dt = 0; dt < 8; ++dt) acc[dt] = (f32x4){0.f, 0.f, 0.f, 0.f};
#pragma unroll
            for (int ks = 0; ks < 2; ++ks) {
                const bf16x8 bf = *(const bf16x8*)(Vt + (vt * 16 + fr) * 72 + ks * 32 + fq * 8);
#pragma unroll
                for (int dt = 0; dt < 8; ++dt) {
                    const bf16x8 af = *(const bf16x8*)(Kt + (dt * 16 + fr) * 72 + ks * 32 + fq * 8);
                    acc[dt] = __builtin_amdgcn_mfma_f32_16x16x32_bf16(af, bf, acc[dt], 0, 0, 0);
                }
            }
            const int v = vt * 16 + fr;
            if (v <= 256) {
#pragma unroll
                for (int dt = 0; dt < 8; ++dt) *(f32x4*)(p.DC + ((size_t)task * 272 + v) * 128 + dt * 16 + fq * 4) = acc[dt];
            }
        }
    }
}

DEVI void stage_mlstm_scan(const P& p, int bid, int nblk) {
    const int nthr = 512;
    for (int e = bid * nthr + tid_opq(); e < 16 * 257 * 32; e += nblk * nthr) {
        const int bh = e / (257 * 32), r = e % (257 * 32), v = r >> 5, d = (r & 31) * 4;
        f32x4 C = {0.f, 0.f, 0.f, 0.f};
        const float* ac = p.ACOEF + bh * 64; const float* sc = p.SCL + bh * 64;
        const size_t base = ((size_t)(bh * 64) * 272 + v) * 128 + d, cstride = (size_t)272 * 128;
#pragma unroll 1
        for (int c0 = 0; c0 < 64; c0 += 8) {
            f32x4 dc[8];
#pragma unroll
            for (int i = 0; i < 8; ++i) dc[i] = __builtin_nontemporal_load((const f32x4*)(p.DC + base + (size_t)(c0 + i) * cstride));
#pragma unroll
            for (int i = 0; i < 8; ++i) {
                u32x2 o; o.x = pack2(C[0], C[1]); o.y = pack2(C[2], C[3]);
                *(u32x2*)(p.CPT + base + (size_t)(c0 + i) * cstride) = o;
                C = C * ac[c0 + i] + dc[i] * sc[c0 + i];
            }
        }
        if (v < 256) {
#pragma unroll
            for (int k = 0; k < 4; ++k) p.out[O_PC + ((size_t)bh * 128 + d + k) * 256 + v] = C[k];
        } else *(f32x4*)(p.out + O_PN + bh * 128 + d) = C;
    }
}

constexpr int MO_Q = 0, MO_K = 64 * 272, MO_VT = MO_K + 64 * 272, MO_P = MO_VT + 272 * 144, MO_SC = MO_P + 64 * 144, MO_HS = MO_SC + 2048, MO_LDS = MO_HS + 64 * 256 * 4;
static_assert(MO_LDS <= 152 * 1024, "lds");
DEVI void stage_mlstm_out(const P& p, char* smem, int bid, int nblk) {
    const int tid = tid_opq(), lane = tid & 63, wid = tid >> 6, fr = lane & 15, fq = lane >> 4;
    bf16_t* Qs = (bf16_t*)(smem + MO_Q);
    bf16_t* Ks = (bf16_t*)(smem + MO_K);
    bf16_t* Vt = (bf16_t*)(smem + MO_VT);
    bf16_t* Ps = (bf16_t*)(smem + MO_P);
    float* sc = (float*)(smem + MO_SC);
    float* rowt = sc; float* colt = sc + 64; float* wint = sc + 128; float* emt = sc + 192; float* den = sc + 256;
    float* hs = (float*)(smem + MO_HS);
    for (int task = bid; task < 1024; task += nblk) {
        const int bh = task >> 6, c = task & 63, b = bh >> 2, h = bh & 3;
        const size_t row0 = (size_t)b * 4096 + c * 64;
        __syncthreads();
        {
            for (int i = tid; i < 64 * 16; i += 512) {
                const int t = i >> 4, ch = i & 15;
                *(u32x4*)(Qs + t * 136 + ch * 8) = *(const u32x4*)(p.PROJ + (row0 + t) * PS + C_AQ + h * 128 + ch * 8);
                *(u32x4*)(Ks + t * 136 + ch * 8) = *(const u32x4*)(p.PROJ + (row0 + t) * PS + C_AK + h * 128 + ch * 8);
            }
            const int sidx = tid & 63, ch = tid >> 6;
#pragma unroll
            for (int q4 = 0; q4 < 4; ++q4) {
                const u32x4 vv = *(const u32x4*)(p.PROJ + (row0 + sidx) * PS + C_AV + h * 256 + q4 * 64 + ch * 8);
#pragma unroll
                for (int e = 0; e < 4; ++e) {
                    Vt[(q4 * 64 + ch * 8 + e * 2) * 72 + sidx] = (bf16_t)(vv[e] & 0xFFFFu);
                    Vt[(q4 * 64 + ch * 8 + e * 2 + 1) * 72 + sidx] = (bf16_t)(vv[e] >> 16);
                }
            }
            for (int i = tid; i < 16 * 64; i += 512) Vt[(256 + (i >> 6)) * 72 + (i & 63)] = (i >> 6) == 0 ? (bf16_t)0x3F80 : (bf16_t)0;
            if (wid == 0) {
                const float bc = p.BCUM[bh * 4096 + c * 64 + lane], ip = p.SM[(row0 + lane) * 64 + h];
                const float mprev = p.MPREV[task];
                float pm = ip - bc;
#pragma unroll
                for (int o = 1; o < 64; o <<= 1) { const float t = __shfl_up(pm, o); if (lane >= o) pm = fmaxf(pm, t); }
                const float mt = fmaxf(bc + mprev, bc + pm);
                rowt[lane] = bc - mt; colt[lane] = ip - bc; wint[lane] = __expf(bc + mprev - mt); emt[lane] = __expf(-mt);
            }
        }
        __syncthreads();
        {
            const int tt = wid >> 1;
#pragma unroll
            for (int si = 0; si < 2; ++si) {
                const int st = (wid & 1) * 2 + si;
                f32x4 acc = (f32x4){0.f, 0.f, 0.f, 0.f};
                if (st <= tt) {
#pragma unroll
                    for (int ks = 0; ks < 4; ++ks) {
                        const bf16x8 af = *(const bf16x8*)(Qs + (tt * 16 + fr) * 136 + ks * 32 + fq * 8);
                        const bf16x8 bf = *(const bf16x8*)(Ks + (st * 16 + fr) * 136 + ks * 32 + fq * 8);
                        acc = __builtin_amdgcn_mfma_f32_16x16x32_bf16(af, bf, acc, 0, 0, 0);
                    }
                }
                const int s = st * 16 + fr; const float ct = colt[s];
#pragma unroll
                for (int r = 0; r < 4; ++r) {
                    const int t = tt * 16 + fq * 4 + r;
                    const float pv = (s <= t) ? acc[r] * __expf(rowt[t] + ct) : 0.f;
                    Ps[t * 72 + s] = f2bf(pv);
                }
            }
        }
        __syncthreads();
        {
            const bf16_t* cpt = p.CPT + (size_t)task * 272 * 128;
            f32x4 acc[4][2];
#pragma unroll
            for (int tt = 0; tt < 4; ++tt)
#pragma unroll
                for (int vi = 0; vi < 2; ++vi) acc[tt][vi] = (f32x4){0.f, 0.f, 0.f, 0.f};
            f32x4 accd = (f32x4){0.f, 0.f, 0.f, 0.f};
            bf16x8 cb[4][2], cd[4];
#pragma unroll
            for (int ks = 0; ks < 4; ++ks) {
#pragma unroll
                for (int vi = 0; vi < 2; ++vi) cb[ks][vi] = *(const bf16x8*)(cpt + (size_t)((wid * 2 + vi) * 16 + fr) * 128 + ks * 32 + fq * 8);
                cd[ks] = *(const bf16x8*)(cpt + (size_t)(256 + fr) * 128 + ks * 32 + fq * 8);
            }
#pragma unroll
            for (int ks = 0; ks < 4; ++ks) {
                bf16x8 af[4];
#pragma unroll
                for (int tt = 0; tt < 4; ++tt) af[tt] = *(const bf16x8*)(Qs + (tt * 16 + fr) * 136 + ks * 32 + fq * 8);
#pragma unroll
                for (int vi = 0; vi < 2; ++vi) {
#pragma unroll
                    for (int tt = 0; tt < 4; ++tt) acc[tt][vi] = __builtin_amdgcn_mfma_f32_16x16x32_bf16(af[tt], cb[ks][vi], acc[tt][vi], 0, 0, 0);
                }
                if (wid < 4) {
                    const bf16x8 a2 = *(const bf16x8*)(Qs + (wid * 16 + fr) * 136 + ks * 32 + fq * 8);
                    accd = __builtin_amdgcn_mfma_f32_16x16x32_bf16(a2, cd[ks], accd, 0, 0, 0);
                }
            }
#pragma unroll
            for (int tt = 0; tt < 4; ++tt) {
                const f32x4 wv = *(const f32x4*)(wint + tt * 16 + fq * 4);
#pragma unroll
                for (int vi = 0; vi < 2; ++vi) acc[tt][vi] *= wv;
            }
            if (wid < 4) accd *= *(const f32x4*)(wint + wid * 16 + fq * 4);
#pragma unroll
            for (int ks = 0; ks < 2; ++ks) {
                bf16x8 af[4];
#pragma unroll
                for (int tt = 0; tt < 4; ++tt) af[tt] = *(const bf16x8*)(Ps + (tt * 16 + fr) * 72 + ks * 32 + fq * 8);
#pragma unroll
                for (int vi = 0; vi < 2; ++vi) {
                    const bf16x8 bf = *(const bf16x8*)(Vt + ((wid * 2 + vi) * 16 + fr) * 72 + ks * 32 + fq * 8);
#pragma unroll
                    for (int tt = 0; tt < 4; ++tt) acc[tt][vi] = __builtin_amdgcn_mfma_f32_16x16x32_bf16(af[tt], bf, acc[tt][vi], 0, 0, 0);
                }
                if (wid < 4) {
                    const bf16x8 bf = *(const bf16x8*)(Vt + (256 + fr) * 72 + ks * 32 + fq * 8);
                    const bf16x8 a2 = *(const bf16x8*)(Ps + (wid * 16 + fr) * 72 + ks * 32 + fq * 8);
                    accd = __builtin_amdgcn_mfma_f32_16x16x32_bf16(a2, bf, accd, 0, 0, 0);
                }
            }
            if (wid < 4 && fr == 0) *(f32x4*)(den + wid * 16 + fq * 4) = accd;
            __syncthreads();
#pragma unroll
            for (int tt = 0; tt < 4; ++tt) {
                const f32x4 dv = *(const f32x4*)(den + tt * 16 + fq * 4), ev = *(const f32x4*)(emt + tt * 16 + fq * 4);
#pragma unroll
                for (int vi = 0; vi < 2; ++vi)
#pragma unroll
                    for (int r = 0; r < 4; ++r) hs[(tt * 16 + fq * 4 + r) * 256 + (wid * 2 + vi) * 16 + fr] = acc[tt][vi][r] / fmaxf(fabsf(dv[r]), ev[r]);
            }
        }
        __syncthreads();
        u32x2 ovs[8];
#pragma unroll
        for (int rr = 0; rr < 8; ++rr) ovs[rr] = *(const u32x2*)(p.PROJ + (row0 + wid * 8 + rr) * PS + C_AO + h * 256 + lane * 4);
        const f32x4 gg = *(const f32x4*)(p.norm_a_g + h * 256 + lane * 4);
#pragma unroll
        for (int rr = 0; rr < 8; ++rr) {
            const int t = wid * 8 + rr;
            const f32x4 x = *(const f32x4*)(hs + t * 256 + lane * 4);
            const float mean = wave_sum(x[0] + x[1] + x[2] + x[3]) * (1.f / 256.f);
            float q = 0.f;
#pragma unroll
            for (int k = 0; k < 4; ++k) q += (x[k] - mean) * (x[k] - mean);
            const float rs = rsqrtf(wave_sum(q) * (1.f / 256.f) + LN_EPS);
            const u32x2 ov = ovs[rr];
            const float o4[4] = {__uint_as_float(ov.x << 16), __uint_as_float(ov.x & 0xFFFF0000u), __uint_as_float(ov.y << 16), __uint_as_float(ov.y & 0xFFFF0000u)};
            float y[4];
#pragma unroll
            for (int k = 0; k < 4; ++k) y[k] = (x[k] - mean) * rs * gg[k] * sigmoidf_(o4[k]);
            u32x2 o2; o2.x = pack2(y[0], y[1]); o2.y = pack2(y[2], y[3]);
            *(u32x2*)(p.YA + (row0 + t) * 1024 + h * 256 + lane * 4) = o2;
        }
    }
}

DEVI void stage_mlstm_sample(const P& p, char* smem, int bid, int nblk) {
    float* qs = (float*)smem;
    float* ks = qs + 512;
    float* vs = ks + 512;
    float* part = vs + 1024;
    float* hs = part + 2048;
    float* sc = hs + 1024;
    float* bc = sc; float* ip = sc + 4; float* mt = sc + 8; float* wint = sc + 12; float* emt = sc + 16; float* ww = sc + 20; float* den = sc + 24;
    float* Pm = sc + 32;
    float* misc = sc + 48;
    const int tid = tid_opq(), lane = tid & 63, wid = tid >> 6;
    for (int task = bid; task < 512; task += nblk) {
        const int b = task >> 2, h = task & 3;
        const size_t row0 = (size_t)NTP + b * 4;
        __syncthreads();
        { const int t = tid >> 7, d = tid & 127;
          qs[tid] = bf2f(p.PROJ[(row0 + t) * PS + C_AQ + h * 128 + d]);
          ks[tid] = bf2f(p.PROJ[(row0 + t) * PS + C_AK + h * 128 + d]); }
        for (int idx = tid; idx < 1024; idx += 512) { const int t = idx >> 8, v = idx & 255; vs[idx] = bf2f(p.PROJ[(row0 + t) * PS + C_AV + h * 256 + v]); }
        if (tid == 0) {
            const float m0 = p.state_m[task];
            float cs = 0.f;
            for (int t = 0; t < 4; ++t) { cs += logsigmoidf_(p.SM[(row0 + t) * 64 + 4 + h]); bc[t] = cs; ip[t] = p.SM[(row0 + t) * 64 + h]; }
            for (int t = 0; t < 4; ++t) {
                float mx = bc[t] + m0;
                for (int s = 0; s <= t; ++s) mx = fmaxf(mx, bc[t] - bc[s] + ip[s]);
                mt[t] = mx; wint[t] = __expf(bc[t] + m0 - mx); emt[t] = __expf(-mx);
            }
            const float bend = bc[3];
            float mnew = bend + m0;
            for (int s = 0; s < 4; ++s) mnew = fmaxf(mnew, bend - bc[s] + ip[s]);
            misc[0] = __expf(bend + m0 - mnew);
            for (int s = 0; s < 4; ++s) ww[s] = __expf(bend - bc[s] + ip[s] - mnew);
            p.out[O_SM + task] = mnew;
        }
        __syncthreads();
        if (tid < 16) {
            const int t = tid >> 2, s = tid & 3;
            float a = 0.f;
            if (s <= t) { for (int d = 0; d < 128; ++d) a += qs[t * 128 + d] * ks[s * 128 + d]; a *= __expf(bc[t] - bc[s] + ip[s] - mt[t]); }
            Pm[tid] = a;
        }
        __syncthreads();
        if (tid < 4) {
            const int t = tid; float qn = 0.f;
            for (int d = 0; d < 128; ++d) qn += qs[t * 128 + d] * p.state_n[(size_t)task * 128 + d];
            den[t] = wint[t] * qn + Pm[t * 4] + Pm[t * 4 + 1] + Pm[t * 4 + 2] + Pm[t * 4 + 3];
        }
        const float a = misc[0];
        if (tid >= 128 && tid < 256) {
            const int d = tid - 128;
            float n = a * p.state_n[(size_t)task * 128 + d];
            for (int s = 0; s < 4; ++s) n += ww[s] * ks[s * 128 + d];
            p.out[O_SN + (size_t)task * 128 + d] = n;
        }
        {
            const int v = tid & 255, dh = tid >> 8;
            float acc[4] = {0.f, 0.f, 0.f, 0.f};
            float wv[4];
#pragma unroll
            for (int s = 0; s < 4; ++s) wv[s] = ww[s] * vs[s * 256 + v];
            for (int d0 = dh * 64; d0 < dh * 64 + 64; d0 += 16) {
                float c0[16];
#pragma unroll
                for (int i = 0; i < 16; ++i) c0[i] = __builtin_nontemporal_load(p.state_C + ((size_t)task * 128 + d0 + i) * 256 + v);
#pragma unroll
                for (int i = 0; i < 16; ++i) {
                    const int d = d0 + i;
#pragma unroll
                    for (int t = 0; t < 4; ++t) acc[t] += qs[t * 128 + d] * c0[i];
                    float cn = a * c0[i];
#pragma unroll
                    for (int s = 0; s < 4; ++s) cn += ks[s * 128 + d] * wv[s];
                    __builtin_nontemporal_store(cn, p.out + O_SC + ((size_t)task * 128 + d) * 256 + v);
                }
            }
#pragma unroll
            for (int t = 0; t < 4; ++t) part[(dh * 4 + t) * 256 + v] = acc[t];
        }
        __syncthreads();
        if (tid < 256) {
            const int v = tid;
#pragma unroll
            for (int t = 0; t < 4; ++t) {
                float num = wint[t] * (part[t * 256 + v] + part[(4 + t) * 256 + v]);
#pragma unroll
                for (int s = 0; s < 4; ++s) num += Pm[t * 4 + s] * vs[s * 256 + v];
                hs[t * 256 + v] = num / fmaxf(fabsf(den[t]), emt[t]);
            }
        }
        __syncthreads();
        if (wid < 4) {
            const int t = wid;
            const f32x4 x = *(const f32x4*)(hs + t * 256 + lane * 4);
            const float mean = wave_sum(x[0] + x[1] + x[2] + x[3]) * (1.f / 256.f);
            float q = 0.f;
#pragma unroll
            for (int k = 0; k < 4; ++k) q += (x[k] - mean) * (x[k] - mean);
            const float rs = rsqrtf(wave_sum(q) * (1.f / 256.f) + LN_EPS);
            float y[4];
#pragma unroll
            for (int k = 0; k < 4; ++k) {
                const int vi = lane * 4 + k;
                const float o = bf2f(p.PROJ[(row0 + t) * PS + C_AO + h * 256 + vi]);
                y[k] = (x[k] - mean) * rs * p.norm_a_g[h * 256 + vi] * sigmoidf_(o);
            }
            u32x2 o2; o2.x = pack2(y[0], y[1]); o2.y = pack2(y[2], y[3]);
            *(u32x2*)(p.YA + (row0 + t) * 1024 + h * 256 + lane * 4) = o2;
        }
    }
}

constexpr int CP_ABUF = 33280, CP_WBUF = 18432, CP_A = 0, CP_W = 2 * CP_ABUF, CP_LDS = CP_W + 2 * CP_WBUF;
constexpr int CP_AROW = 1024 + 8;
DEVI void stage_compress(const P& p, char* smem, int bid, int nblk, int only = -1) {
    const int tid = tid_opq(), lane = tid & 63, wid = tid >> 6, fr = lane & 15, fq = lane >> 4;
    const int kv = wid & 1, rt = wid >> 1;
    const int n_it = only >= 0 ? 1 : (256 + nblk - 1) / nblk + (16 + nblk - 1) / nblk;
    for (int it = 0; it < n_it; ++it) {
        const int ns_it = (256 + nblk - 1) / nblk;
        const int task = only >= 0 ? only : it < ns_it ? bid + it * nblk : 256 + (nblk - 1 - bid) + (it - ns_it) * nblk;
        if (only < 0 && (task >= 272 || (it < ns_it && task >= 256))) continue;
        const bool prompt = task >= 256;
        const int rowbytes = prompt ? 1024 : 2048, npieces = prompt ? 2 : 4;
        const char* src[4]; int dsto[4];
#pragma unroll
        for (int q = 0; q < 4; ++q) {
            const int off = q * 8192 + tid * 16, r = off / rowbytes, cb = off % rowbytes;
            if (prompt) { const int blk = (task - 256) * 16 + (r & 15); src[q] = (const char*)(p.PROJ + (size_t)blk * 64 * PS + C_CMP) + cb; dsto[q] = (r & 15) * CP_AROW * 2 + cb; }
            else { const int gb = task * 16 + r, b = gb >> 5, n = gb & 31; const int page = p.page_table[b * 16 + (n >> 1)];
                   src[q] = (const char*)(p.cache_cmp + ((size_t)page * 128 + (n & 1) * 64) * 512) + cb; dsto[q] = r * CP_AROW * 2 + (cb >> 1); }
        }
        const size_t sstride = prompt ? (size_t)PS * 2 : 2048;
        const char* wsrc[2]; int wdst[2];
#pragma unroll
        for (int q = 0; q < 2; ++q) { const int idx = q * 512 + tid, row = idx >> 3, ch = idx & 7; wsrc[q] = (const char*)(p.WCT + (size_t)row * 4096) + ch * 16; wdst[q] = row * 144 + ch * 16; }
        f32x4 acc[4];
#pragma unroll
        for (int nt = 0; nt < 4; ++nt) acc[nt] = (f32x4){0.f, 0.f, 0.f, 0.f};
        f32x4 ra0[4], ra1[4]; u32x4 rw0[2], rw1[2];
        auto issue = [&](int l, f32x4 (&ra)[4], u32x4 (&rw)[2]) {
#pragma unroll
            for (int q = 0; q < 4; ++q) if (q < npieces) ra[q] = prompt ? *(const f32x4*)(src[q] + (size_t)l * sstride) : __builtin_nontemporal_load((const f32x4*)(src[q] + (size_t)l * sstride));
#pragma unroll
            for (int q = 0; q < 2; ++q) rw[q] = *(const u32x4*)(wsrc[q] + l * 128);
        };
        auto commit = [&](int buf, const f32x4 (&ra)[4], const u32x4 (&rw)[2]) {
            char* ab = smem + CP_A + buf * CP_ABUF; char* wbuf = smem + CP_W + buf * CP_WBUF;
#pragma unroll
            for (int q = 0; q < 4; ++q) if (q < npieces) {
                if (prompt) *(f32x4*)(ab + dsto[q]) = ra[q];
                else { u32x2 o; o.x = pack2(ra[q][0], ra[q][1]); o.y = pack2(ra[q][2], ra[q][3]); *(u32x2*)(ab + dsto[q]) = o; }
            }
#pragma unroll
            for (int q = 0; q < 2; ++q) *(u32x4*)(wbuf + wdst[q]) = rw[q];
        };
        auto consume = [&](int buf) {
            const char* ab = smem + CP_A + buf * CP_ABUF; const char* wbuf = smem + CP_W + buf * CP_WBUF;
            const bf16_t* arow = (const bf16_t*)ab + (rt * 4 + (fr >> 2)) * CP_AROW + kv * 256 + (fr & 3) * 64 + fq * 8;
#pragma unroll
            for (int hf = 0; hf < 2; ++hf) {
                const bf16x8 a = *(const bf16x8*)(arow + hf * 32);
#pragma unroll
                for (int nt = 0; nt < 4; ++nt) {
                    const bf16x8 bfrag = *(const bf16x8*)(wbuf + (kv * 64 + nt * 16 + fr) * 144 + hf * 64 + fq * 16);
                    acc[nt] = __builtin_amdgcn_mfma_f32_16x16x32_bf16(a, bfrag, acc[nt], 0, 0, 0);
                }
            }
        };
        __syncthreads();
        issue(0, ra0, rw0); issue(1, ra1, rw1); commit(0, ra0, rw0); issue(2, ra0, rw0);
        __syncthreads();
#pragma unroll 1
        for (int l = 0; l < 64; l += 2) {
            consume(0);
            commit(1, ra1, rw1);
            if (l + 3 < 64) issue(l + 3, ra1, rw1);
            __syncthreads();
            consume(1);
            if (l + 2 < 64) commit(0, ra0, rw0);
            if (l + 4 < 64) issue(l + 4, ra0, rw0);
            __syncthreads();
        }
        {
            const int ob = prompt ? (task - 256) * 16 + rt * 4 + fq : 256 + task * 16 + rt * 4 + fq;
#pragma unroll
            for (int nt = 0; nt < 4; ++nt) {
                const float bias = p.PW[kv * 64 + nt * 16 + fr];
#pragma unroll
                for (int r = 0; r < 4; ++r) p.KC[(size_t)ob * 512 + kv * 256 + r * 64 + nt * 16 + fr] = acc[nt][r] + bias;
            }
        }
    }
}

typedef float f32x16 __attribute__((ext_vector_type(16)));
typedef short s16x4 __attribute__((ext_vector_type(4)));
typedef __attribute__((address_space(3))) const char* lds_cptr;
#define MFMA32(a, b, c) __builtin_amdgcn_mfma_f32_32x32x16_bf16(a, b, c, 0, 0, 0)
DEVI int crow(int r, int hi) { return (r & 3) + 8 * (r >> 2) + 4 * hi; }
DEVI unsigned cvtpk(float lo, float hi) { return pack2(lo, hi); }
DEVI s16x4 vtr(lds_cptr p) { return __builtin_bit_cast(s16x4, __builtin_amdgcn_ds_read_tr16_b64_v4i16((__attribute__((address_space(3))) s16x4*)p)); }
DEVI float half_max(float m) { auto rr = __builtin_amdgcn_permlane32_swap(__float_as_uint(m), __float_as_uint(m), false, false); return fmaxf(__uint_as_float(rr[0]), __uint_as_float(rr[1])); }
DEVI float half_sum(float m) { auto rr = __builtin_amdgcn_permlane32_swap(__float_as_uint(m), __float_as_uint(m), false, false); return __uint_as_float(rr[0]) + __uint_as_float(rr[1]); }

struct BlkDesc { const char* k; int stride_bytes; int f32; int count; int pos0; };
DEVI void blk_load(const BlkDesc& d, int tid, u32x4& rk, u32x4& rv) {
    const int key = tid & 63, chunk = tid >> 6;
    rk = (u32x4){0u, 0u, 0u, 0u}; rv = rk;
    if (key < d.count) {
        const char* kr = d.k + (size_t)key * d.stride_bytes;
        if (d.f32) {
            const f32x4* s1 = (const f32x4*)(kr + chunk * 32); const f32x4* s2 = (const f32x4*)(kr + 1024 + chunk * 32);
            rk = pack8f(s1[0], s1[1]); rv = pack8f(s2[0], s2[1]);
        } else { rk = *(const u32x4*)(kr + chunk * 16); rv = *(const u32x4*)(kr + 512 + chunk * 16); }
    }
}
DEVI void blk_store(char* kimg, char* vimg, int tid, const u32x4& rk, const u32x4& rv) {
    const int key = tid & 63, chunk = tid >> 6;
    *(u32x4*)(kimg + chunk * 1024 + key * 16) = rk;
    *(u32x4*)(vimg + (chunk >> 2) * 4096 + key * 64 + (chunk & 3) * 16) = rv;
}

DEVI void attn_tile(const char* kimg, const char* vimg, const bf16x8 (&qr)[4], float& m2, float& lsum, f32x16& o0, f32x16& o1, f32x16& s0, f32x16& s1,
                    float sl, float bb, int lh, int ll, bool fast, float* wsf_hi  , float* wsf_r  , int lane) {
    const int r32 = lane & 31, hi = lane >> 5;
    const f32x16 z = {};
    s0 = z; s1 = z;
    {
        const char* kp = kimg + hi * 1024 + r32 * 16;
#pragma unroll
        for (int d0 = 0; d0 < 4; ++d0) {
            const bf16x8 k0 = *(const bf16x8*)(kp + d0 * 2048), k1 = *(const bf16x8*)(kp + d0 * 2048 + 512);
            s0 = MFMA32(k0, qr[d0], s0); s1 = MFMA32(k1, qr[d0], s1);
        }
    }
    float mx = -1e30f;
    if (fast) {
#pragma unroll
        for (int r = 0; r < 16; ++r) {
            const int c = (r & 3) + 8 * (r >> 2);
            s0[r] = fmaf(s0[r], 1.4426950408889634f, fmaf(sl, (float)c, bb)); s1[r] = fmaf(s1[r], 1.4426950408889634f, fmaf(sl, (float)(c + 32), bb));
            mx = fmaxf(mx, fmaxf(s0[r], s1[r]));
        }
    } else {
#pragma unroll
        for (int r = 0; r < 16; ++r) {
            const int c = (r & 3) + 8 * (r >> 2);
            const float t0 = fmaf(s0[r], 1.4426950408889634f, fmaf(sl, (float)c, bb)), t1 = fmaf(s1[r], 1.4426950408889634f, fmaf(sl, (float)(c + 32), bb));
            s0[r] = (c <= lh && c > ll) ? t0 : -INFINITY; s1[r] = (c + 32 <= lh && c + 32 > ll) ? t1 : -INFINITY;
            mx = fmaxf(mx, fmaxf(s0[r], s1[r]));
        }
    }
    mx = half_max(mx);
    const float mnew = fmaxf(m2, mx);
    const float f = __builtin_amdgcn_exp2f(m2 - mnew);
    m2 = mnew;
    float ps = 0.f;
#pragma unroll
    for (int r = 0; r < 16; ++r) { s0[r] = __builtin_amdgcn_exp2f(s0[r] - mnew); s1[r] = __builtin_amdgcn_exp2f(s1[r] - mnew); ps += s0[r] + s1[r]; }
    lsum = lsum * f + ps;
    if (__any(f != 1.f)) {
        if (hi == 0) *wsf_r = f;
        asm volatile("s_waitcnt lgkmcnt(0)" ::: "memory");
#pragma unroll
        for (int a = 0; a < 4; ++a) {
            const f32x4 fv = *(const f32x4*)(wsf_hi + 8 * a);
#pragma unroll
            for (int k = 0; k < 4; ++k) { o0[4 * a + k] *= fv[k]; o1[4 * a + k] *= fv[k]; }
        }
        asm volatile("s_waitcnt lgkmcnt(0)" ::: "memory");
    }
    u32x4 pw[4];
#pragma unroll
    for (int k = 0; k < 4; ++k) { pw[0][k] = cvtpk(s0[2 * k], s0[2 * k + 1]); pw[1][k] = cvtpk(s0[8 + 2 * k], s0[8 + 2 * k + 1]); pw[2][k] = cvtpk(s1[2 * k], s1[2 * k + 1]); pw[3][k] = cvtpk(s1[8 + 2 * k], s1[8 + 2 * k + 1]); }
    const lds_cptr vp = (lds_cptr)vimg + ((lane >> 4) & 1) * 32 + (lane & 3) * 8 + (4 * hi + ((lane & 15) >> 2)) * 64;
#pragma unroll
    for (int i = 0; i < 8; ++i) {
        const s16x4 lo = vtr(vp + ((i >> 2) * 4096 + (i & 3) * 1024)), hh = vtr(vp + ((i >> 2) * 4096 + (i & 3) * 1024 + 512));
        const bf16x8 vf = (bf16x8){lo[0], lo[1], lo[2], lo[3], hh[0], hh[1], hh[2], hh[3]};
        const bf16x8 pf = __builtin_bit_cast(bf16x8, pw[i & 3]);
        if (i < 4) o0 = MFMA32(pf, vf, o0); else o1 = MFMA32(pf, vf, o1);
    }
}

constexpr int NSA_KV0 = 0, NSA_KV1 = 16384, NSA_WSF = 32768, NSA_IMP = NSA_WSF + 2048, NSA_SEL = NSA_IMP + 16384, NSA_LIST = NSA_SEL + 512, NSA_OST = NSA_LIST + 256, NSA_YAC = NSA_OST + 32768, NSA_LDS = NSA_YAC + 65536;
static_assert(NSA_LDS <= 152 * 1024, "lds");

DEVI BlkDesc nsa_desc(const P& p, bool prompt, int b, int g, int branch, int j) {
    BlkDesc d;
    if (prompt) {
        if (branch == 0) { d.k = (const char*)(p.KC + ((size_t)(b * 64) * 512 + g * 64)); d.stride_bytes = 2048; d.f32 = 1; d.count = 64; d.pos0 = 0; }
        else { d.k = (const char*)(p.PROJ + ((size_t)b * 4096 + j * 64) * PS + (branch == 1 ? C_SLC : C_WIN) + g * 64); d.stride_bytes = PS * 2; d.f32 = 0; d.count = 64; d.pos0 = j * 64; }
    } else {
        if (branch == 0) { d.k = (const char*)(p.KC + ((size_t)(256 + b * 32) * 512 + g * 64)); d.stride_bytes = 2048; d.f32 = 1; d.count = 32; d.pos0 = 0; }
        else if (branch == 1 && j < 32) { const int page = p.page_table[b * 16 + (j >> 1)]; d.k = (const char*)(p.cache_slc + ((size_t)page * 128 + (j & 1) * 64) * 512 + g * 64); d.stride_bytes = 2048; d.f32 = 1; d.count = 64; d.pos0 = j * 64; }
        else if (branch == 2 && j < 8) { d.k = (const char*)(p.cache_win + ((size_t)b * 512 + j * 64) * 512 + g * 64); d.stride_bytes = 2048; d.f32 = 1; d.count = 64; d.pos0 = 1536 + j * 64; }
        else { d.k = (const char*)(p.PROJ + ((size_t)NTP + b * 4) * PS + (branch == 1 ? C_SLC : C_WIN) + g * 64); d.stride_bytes = PS * 2; d.f32 = 0; d.count = 4; d.pos0 = 2048; }
    }
    return d;
}

constexpr int NS_IMG = 0, NS_WSF = 131072, NS_IMP = NS_WSF + 2048, NS_SEL = NS_IMP + 2048, NS_LIST = NS_SEL + 64, NS_YC = NS_LIST + 64, NS_PM = NS_YC + 4096, NS_Q = NS_PM + 2048, NS_LDS = NS_Q + 4096;
static_assert(NS_LDS <= 152 * 1024, "lds");
DEVI void wave_stage_block(const BlkDesc& d, char* kimg, char* vimg, int lane) {
    asm volatile("" : "+v"(lane));
    const int rsub = lane >> 4, pc = lane & 15;
    if (d.f32) {
#pragma unroll
        for (int half = 0; half < 2; ++half) {
#pragma unroll
            for (int i0 = 0; i0 < 16; i0 += 6) {
                f32x4 x[6];
#pragma unroll
                for (int i = 0; i < 6; ++i) if (i0 + i < 16) { const int row = 4 * (i0 + i) + rsub; x[i] = row < d.count ? __builtin_nontemporal_load((const f32x4*)(d.k + (size_t)row * d.stride_bytes + half * 1024 + pc * 16)) : (f32x4){0.f, 0.f, 0.f, 0.f}; }
#pragma unroll
                for (int i = 0; i < 6; ++i) if (i0 + i < 16) {
                    const int row = 4 * (i0 + i) + rsub, c = pc >> 1;
                    u32x2 o; o.x = pack2(x[i][0], x[i][1]); o.y = pack2(x[i][2], x[i][3]);
                    if (half == 0) *(u32x2*)(kimg + c * 1024 + row * 16 + (pc & 1) * 8) = o;
                    else *(u32x2*)(vimg + (c >> 2) * 4096 + row * 64 + (c & 3) * 16 + (pc & 1) * 8) = o;
                }
            }
        }
    } else {
        const int row = lane >> 3, c = lane & 7;
#pragma unroll
        for (int i = 0; i < 8; ++i) {
            const int rr = 8 * i + row;
            u32x4 kk = {0u, 0u, 0u, 0u}, vv = {0u, 0u, 0u, 0u};
            if (rr < d.count) { kk = *(const u32x4*)(d.k + (size_t)rr * d.stride_bytes + c * 16); vv = *(const u32x4*)(d.k + (size_t)rr * d.stride_bytes + 512 + c * 16); }
            *(u32x4*)(kimg + c * 1024 + rr * 16) = kk;
            *(u32x4*)(vimg + (c >> 2) * 4096 + rr * 64 + (c & 3) * 16) = vv;
        }
    }
    asm volatile("s_waitcnt lgkmcnt(0)" ::: "memory");
}

DEVI void nsa_sample_unit(const P& p, char* smem, int us) {
    const int tid = tid_opq(), lane = tid & 63, wid = tid >> 6, r32 = lane & 31, hi = lane >> 5;
    const int b = us >> 2, g = us & 3;
    const size_t rowbase = (size_t)NTP + b * 4;
    char* kimg = smem + NS_IMG + wid * 16384; char* vimg = kimg + 8192;
    float* wsf = (float*)(smem + NS_WSF) + wid * 64;
    float* impb = (float*)(smem + NS_IMP);
    unsigned long long* selm = (unsigned long long*)(smem + NS_SEL);
    unsigned char* blist = (unsigned char*)(smem + NS_LIST);
    float* ycmp = (float*)(smem + NS_YC);
    const int tokl = r32 >> 2, head = r32 & 3;
    const bool tok_ok = r32 < 16;
    const int qpos = 2048 + tokl;
    const float slope2 = alibi_slope(g * 4 + head) * 1.4426950408889634f;
    char* qsh = smem + NS_Q;
    int hi4 = 4 * hi; asm volatile("" : "+v"(hi4));
    float* wsf_hi = wsf + hi4; float* wsf_r = wsf + r32;
    f32x16 s0, s1;
    __syncthreads();
    if (wid == 0) {
        bf16x8 qr[4];
        {
            const bf16_t* qp = p.PROJ + (rowbase + (tok_ok ? tokl : 0)) * PS + C_BQ + (g * 4 + head) * 64 + hi * 8;
#pragma unroll
            for (int d0 = 0; d0 < 4; ++d0) {
                u32x4 v = *(const u32x4*)(qp + d0 * 16);
#pragma unroll
                for (int k = 0; k < 4; ++k) { const float lo = __uint_as_float(v[k] << 16) * 0.125f, hh = __uint_as_float(v[k] & 0xFFFF0000u) * 0.125f; v[k] = tok_ok ? ((__float_as_uint(lo) >> 16) | (__float_as_uint(hh) & 0xFFFF0000u)) : 0u; }
                qr[d0] = __builtin_bit_cast(bf16x8, v);
                *(u32x4*)(qsh + d0 * 1024 + lane * 16) = v;
            }
        }
        f32x16 o0 = {}, o1 = {}; float m2 = -1e30f, lsum = 0.f;
        const BlkDesc d = nsa_desc(p, false, b, g, 0, 0);
        wave_stage_block(d, kimg, vimg, lane);
        const int lh = 31 - hi4;
        const float sl = 64.f * slope2;
        attn_tile(kimg, vimg, qr, m2, lsum, o0, o1, s0, s1, sl, tok_ok ? sl * (float)(hi4 - 32) : -INFINITY, lh, -1000, false, wsf_hi, wsf_r, lane);
        const float lt = half_sum(lsum);
        const float inv = lt > 0.f ? 1.f / lt : 0.f;
        unsigned x[64];
#pragma unroll
        for (int r = 0; r < 16; ++r) {
#pragma unroll
            for (int n = 0; n < 2; ++n) {
                float a = (n == 0 ? s0[r] : s1[r]) * inv;
                a += __shfl_xor(a, 1); a += __shfl_xor(a, 2);
                const int j = (r & 3) + 8 * (r >> 2) + 32 * n + hi4;
                if (j == 32 || j == 0) a = 5.0f;
                if (j > 32) a = -2.0f;
                const unsigned u = __float_as_uint(a);
                const unsigned o = (u & 0x80000000u) ? ~u : (u | 0x80000000u);
                x[n * 16 + r] = (o & ~63u) | (unsigned)(63 - j);
            }
        }
        float fac = 0.f;
        if (tok_ok && lt > 0.f) fac = sigmoidf_(p.SM[(rowbase + tokl) * 64 + 8 + g * 4 + head]) / lt;
        if (hi == 0) *wsf_r = fac;
        asm volatile("s_waitcnt lgkmcnt(0)" ::: "memory");
#pragma unroll
        for (int a = 0; a < 2; ++a) {
            const f32x4 fv = *(const f32x4*)(wsf_hi + 8 * a);
#pragma unroll
            for (int k = 0; k < 4; ++k) { float* yp = ycmp + (8 * a + k + hi4) * 64 + r32; yp[0] = o0[4 * a + k] * fv[k]; yp[32] = o1[4 * a + k] * fv[k]; }
        }
        asm volatile("s_waitcnt lgkmcnt(0)" ::: "memory");
        {
            sort16_desc<0>(x); sort16_desc<16>(x);
            unsigned th[16], oth[16], fin[16];
            merge_top16(&x[0], &x[16], th);
#pragma unroll
            for (int i = 0; i < 16; ++i) { auto rr = __builtin_amdgcn_permlane32_swap(th[i], th[i], false, false); oth[i] = hi ? rr[0] : rr[1]; }
            merge_top16(th, oth, fin);
            unsigned long long mask = 0ull;
#pragma unroll
            for (int i = 0; i < 16; ++i) mask |= 1ull << (63u - (fin[i] & 63u));
            if (head == 0 && hi == 0 && r32 < 16) selm[r32 >> 2] = mask;
        }
        asm volatile("s_waitcnt lgkmcnt(0)" ::: "memory");
        {
            const unsigned long long u = selm[0] | selm[1] | selm[2] | selm[3];
            const int n = __builtin_popcountll(u);
            if ((u >> lane) & 1ull) blist[1 + __builtin_popcountll(u & ((1ull << lane) - 1ull))] = (unsigned char)(0x40 | lane);
            if (lane <= 8) blist[1 + n + lane] = (unsigned char)(0x80 | lane);
            if (lane == 0) blist[0] = (unsigned char)(n + 9);
        }
    }
    __syncthreads();
    const int nb = blist[0];
    const unsigned long long mysel = tok_ok ? selm[tokl] : 0ull;
    int nslc = 0;
    for (int i = 0; i < nb; ++i) nslc += (blist[1 + i] >> 6) == 1 ? 1 : 0;
    float so[16], ms, lst;
    float wo[16], mw, lwt;
#pragma unroll 1
    for (int pass = 0; pass < 2; ++pass) {
        f32x16 o0 = {}, o1 = {}; float m2 = -1e30f, lsum = 0.f;
        const int i0 = pass == 0 ? 0 : nslc, i1 = pass == 0 ? nslc : nb;
#pragma unroll 1
        for (int i = i0 + wid; i < i1; i += 8) {
            const int e = blist[1 + i], br = e >> 6, j = e & 63;
            const BlkDesc d = nsa_desc(p, false, b, g, br, j);
            wave_stage_block(d, kimg, vimg, lane);
            asm volatile("" : "+v"(hi4));
            const bool lsel = tok_ok && (br == 2 || ((mysel >> j) & 1ull));
            const int rel = qpos - d.pos0;
            const int lh = (rel < d.count - 1 ? rel : d.count - 1) - hi4;
            const int ll = (br == 2 ? rel - 512 : -1000) - hi4;
            const bool fast = __all(!lsel || (lh >= 59 && ll < 0));
            const float bb = lsel ? slope2 * (float)(hi4 + d.pos0 - 2048) : -INFINITY;
            bf16x8 qr[4];
#pragma unroll
            for (int d0 = 0; d0 < 4; ++d0) qr[d0] = *(const bf16x8*)(qsh + d0 * 1024 + lane * 16);
            attn_tile(kimg, vimg, qr, m2, lsum, o0, o1, s0, s1, slope2, bb, lh, ll, fast, wsf_hi, wsf_r, lane);
        }
        const float lt = half_sum(lsum);
        if (pass == 0) { ms = m2; lst = lt;
#pragma unroll
            for (int r = 0; r < 8; ++r) { so[r] = o0[r]; so[8 + r] = o1[r]; } }
        else { mw = m2; lwt = lt;
#pragma unroll
            for (int r = 0; r < 8; ++r) { wo[r] = o0[r]; wo[8 + r] = o1[r]; } }
    }
    {
        float* po = (float*)kimg;
        float* pm = (float*)(smem + NS_PM) + wid * 64;
        if (lane < 16) { pm[lane * 2] = ms; pm[lane * 2 + 1] = lst; pm[32 + lane * 2] = mw; pm[32 + lane * 2 + 1] = lwt; }
#pragma unroll
        for (int a = 0; a < 2; ++a)
#pragma unroll
            for (int k = 0; k < 4; ++k) {
                float* yp = po + (8 * a + k + hi4) * 64 + r32;
                yp[0] = so[4 * a + k]; yp[32] = so[8 + 4 * a + k]; yp[1024] = wo[4 * a + k]; yp[1024 + 32] = wo[8 + 4 * a + k];
            }
    }
    __syncthreads();
    {
        const int row = tid >> 5, dcol = tid & 31, tk = row >> 2, hd = row & 3;
        float res[2][2];
#pragma unroll
        for (int br = 0; br < 2; ++br) {
            float M = -1e30f;
#pragma unroll
            for (int w = 0; w < 8; ++w) M = fmaxf(M, ((const float*)(smem + NS_PM))[w * 64 + br * 32 + row * 2]);
            float L = 0.f, a0 = 0.f, a1 = 0.f;
#pragma unroll
            for (int w = 0; w < 8; ++w) {
                const float* pmw = (const float*)(smem + NS_PM) + w * 64 + br * 32 + row * 2;
                const float f = __builtin_amdgcn_exp2f(pmw[0] - M);
                const float* pow_ = (const float*)(smem + NS_IMG + w * 16384) + br * 1024 + row * 64 + dcol;
                L += pmw[1] * f; a0 += pow_[0] * f; a1 += pow_[32] * f;
            }
            const float gate = sigmoidf_(p.SM[(rowbase + tk) * 64 + 8 + (br + 1) * 16 + g * 4 + hd]);
            const float sc = L > 0.f ? gate / L : 0.f;
            res[br][0] = a0 * sc; res[br][1] = a1 * sc;
        }
        const float y0 = ycmp[row * 64 + dcol] + res[0][0] + res[1][0], y1 = ycmp[row * 64 + dcol + 32] + res[0][1] + res[1][1];
        bf16_t* yb = p.YB + (rowbase + tk) * 1024 + (g * 4 + hd) * 64;
        yb[dcol] = f2bf(y0); yb[dcol + 32] = f2bf(y1);
    }
}

constexpr int NP_KVB = 18432, NP_KV0 = 0, NP_KV1 = NP_KVB, NP_WSF = 2 * NP_KVB, NP_IMP = NP_WSF + 2048, NP_SEL = NP_IMP + 16384, NP_LIST = NP_SEL + 512, NP_YAC = NP_LIST + 256, NP_LDS = NP_YAC + 65536;
static_assert(NP_LDS <= 152 * 1024, "lds");
DEVI void blk_store_ext(const BlkDesc& d, int pstep, int poff, int t0, char* kimg, char* vimg, int tid, const u32x4& rk, const u32x4& rv) {
    const int key = tid & 63, chunk = tid >> 6;
    *(u32x4*)(kimg + chunk * 1024 + key * 16) = rk;
    *(u32x4*)(vimg + (chunk >> 2) * 4096 + key * 64 + (chunk & 3) * 16) = rv;
    if (chunk == 0) {
        const int rel = d.pos0 + key * pstep + poff - t0;
        const int phi = (rel >> 6) << 6, plo = rel & 63;
        const unsigned bh = pack2((float)phi, (float)phi), bl = pack2((float)plo, (float)plo);
        *(u32x4*)(kimg + 8 * 1024 + key * 16) = (u32x4){bh, bl, 0x00003F80u, 0u};
    }
}
DEVI void attn_tile2(const char* kimg, const char* vimg, const bf16x8 (&qr)[4], const bf16x8 qext, float& m, float& lsum, f32x16& o0, f32x16& o1, f32x16& s0, f32x16& s1,
                     int lh, int ll, bool fast, float* wsf_hi, float* wsf_r, int lane) {
    const int r32 = lane & 31, hi = lane >> 5;
    const f32x16 z = {};
    s0 = z; s1 = z;
    {
        const char* kp = kimg + hi * 1024 + r32 * 16;
#pragma unroll
        for (int d0 = 0; d0 < 5; ++d0) {
            const bf16x8 k0 = *(const bf16x8*)(kp + d0 * 2048), k1 = *(const bf16x8*)(kp + d0 * 2048 + 512);
            const bf16x8 qf = d0 < 4 ? qr[d0 < 4 ? d0 : 0] : qext;
            s0 = MFMA32(k0, qf, s0); s1 = MFMA32(k1, qf, s1);
        }
    }
    if (!fast) {
#pragma unroll
        for (int r = 0; r < 16; ++r) {
            const int c = (r & 3) + 8 * (r >> 2);
            s0[r] = (c <= lh && c > ll) ? s0[r] : -INFINITY; s1[r] = (c + 32 <= lh && c + 32 > ll) ? s1[r] : -INFINITY;
        }
    }
    float mx = fmaxf(s0[0], s1[0]);
#pragma unroll
    for (int r = 1; r < 16; ++r) mx = fmaxf(mx, fmaxf(s0[r], s1[r]));
    mx = half_max(mx);
    const float mnew = fmaxf(m, mx);
    const float f = __builtin_amdgcn_exp2f((m - mnew) * 1.4426950408889634f);
    m = mnew;
    const float nm2 = -mnew * 1.4426950408889634f;
    float ps = 0.f;
#pragma unroll
    for (int r = 0; r < 16; ++r) { s0[r] = __builtin_amdgcn_exp2f(fmaf(s0[r], 1.4426950408889634f, nm2)); s1[r] = __builtin_amdgcn_exp2f(fmaf(s1[r], 1.4426950408889634f, nm2)); ps += s0[r] + s1[r]; }
    lsum = lsum * f + ps;
    if (__any(f != 1.f)) {
        if (hi == 0) *wsf_r = f;
        asm volatile("s_waitcnt lgkmcnt(0)" ::: "memory");
#pragma unroll
        for (int a = 0; a < 4; ++a) {
            const f32x4 fv = *(const f32x4*)(wsf_hi + 8 * a);
#pragma unroll
            for (int k = 0; k < 4; ++k) { o0[4 * a + k] *= fv[k]; o1[4 * a + k] *= fv[k]; }
        }
        asm volatile("s_waitcnt lgkmcnt(0)" ::: "memory");
    }
    u32x4 pw[4];
#pragma unroll
    for (int k = 0; k < 4; ++k) { pw[0][k] = cvtpk(s0[2 * k], s0[2 * k + 1]); pw[1][k] = cvtpk(s0[8 + 2 * k], s0[8 + 2 * k + 1]); pw[2][k] = cvtpk(s1[2 * k], s1[2 * k + 1]); pw[3][k] = cvtpk(s1[8 + 2 * k], s1[8 + 2 * k + 1]); }
    const lds_cptr vp = (lds_cptr)vimg + ((lane >> 4) & 1) * 32 + (lane & 3) * 8 + (4 * hi + ((lane & 15) >> 2)) * 64;
#pragma unroll
    for (int i = 0; i < 8; ++i) {
        const s16x4 lo = vtr(vp + ((i >> 2) * 4096 + (i & 3) * 1024)), hh = vtr(vp + ((i >> 2) * 4096 + (i & 3) * 1024 + 512));
        const bf16x8 vf = (bf16x8){lo[0], lo[1], lo[2], lo[3], hh[0], hh[1], hh[2], hh[3]};
        const bf16x8 pf = __builtin_bit_cast(bf16x8, pw[i & 3]);
        if (i < 4) o0 = MFMA32(pf, vf, o0); else o1 = MFMA32(pf, vf, o1);
    }
}

DEVI void attn_tile3(const char* kA, const char* vA, const char* kB, const char* vB, const bf16x8 (&qr)[4], const bf16x8 qeA, const bf16x8 qeB, float& m, float& lsum,
                     f32x16& o0, f32x16& o1, int lhA, int llA, bool fastA, int lhB, int llB, bool fastB, float* wsf_hi, float* wsf_r, int lane) {
    const int r32 = lane & 31, hi = lane >> 5;
    f32x16 a0 = {}, a1 = {}, b0 = {}, b1 = {};
    {
        const char* kpa = kA + hi * 1024 + r32 * 16; const char* kpb = kB + hi * 1024 + r32 * 16;
#pragma unroll
        for (int d0 = 0; d0 < 5; ++d0) {
            const bf16x8 ka0 = *(const bf16x8*)(kpa + d0 * 2048), ka1 = *(const bf16x8*)(kpa + d0 * 2048 + 512);
            const bf16x8 kb0 = *(const bf16x8*)(kpb + d0 * 2048), kb1 = *(const bf16x8*)(kpb + d0 * 2048 + 512);
            const bf16x8 qa = d0 < 4 ? qr[d0 < 4 ? d0 : 0] : qeA, qb = d0 < 4 ? qr[d0 < 4 ? d0 : 0] : qeB;
            a0 = MFMA32(ka0, qa, a0); a1 = MFMA32(ka1, qa, a1); b0 = MFMA32(kb0, qb, b0); b1 = MFMA32(kb1, qb, b1);
        }
    }
    if (!fastA) {
#pragma unroll
        for (int r = 0; r < 16; ++r) { const int c = (r & 3) + 8 * (r >> 2); a0[r] = (c <= lhA && c > llA) ? a0[r] : -INFINITY; a1[r] = (c + 32 <= lhA && c + 32 > llA) ? a1[r] : -INFINITY; }
    }
    if (!fastB) {
#pragma unroll
        for (int r = 0; r < 16; ++r) { const int c = (r & 3) + 8 * (r >> 2); b0[r] = (c <= lhB && c > llB) ? b0[r] : -INFINITY; b1[r] = (c + 32 <= lhB && c + 32 > llB) ? b1[r] : -INFINITY; }
    }
    float mx = fmaxf(fmaxf(a0[0], a1[0]), fmaxf(b0[0], b1[0]));
#pragma unroll
    for (int r = 1; r < 16; ++r) mx = fmaxf(mx, fmaxf(fmaxf(a0[r], a1[r]), fmaxf(b0[r], b1[r])));
    mx = half_max(mx);
    const float mnew = fmaxf(m, mx);
    const float f = __builtin_amdgcn_exp2f((m - mnew) * 1.4426950408889634f);
    m = mnew;
    const float nm2 = -mnew * 1.4426950408889634f;
    float ps = 0.f;
#pragma unroll
    for (int r = 0; r < 16; ++r) {
        a0[r] = __builtin_amdgcn_exp2f(fmaf(a0[r], 1.4426950408889634f, nm2)); a1[r] = __builtin_amdgcn_exp2f(fmaf(a1[r], 1.4426950408889634f, nm2));
        b0[r] = __builtin_amdgcn_exp2f(fmaf(b0[r], 1.4426950408889634f, nm2)); b1[r] = __builtin_amdgcn_exp2f(fmaf(b1[r], 1.4426950408889634f, nm2));
        ps += (a0[r] + a1[r]) + (b0[r] + b1[r]);
    }
    lsum = lsum * f + ps;
    if (__any(f != 1.f)) {
        if (hi == 0) *wsf_r = f;
        asm volatile("s_waitcnt lgkmcnt(0)" ::: "memory");
#pragma unroll
        for (int a = 0; a < 4; ++a) {
            const f32x4 fv = *(const f32x4*)(wsf_hi + 8 * a);
#pragma unroll
            for (int k = 0; k < 4; ++k) { o0[4 * a + k] *= fv[k]; o1[4 * a + k] *= fv[k]; }
        }
        asm volatile("s_waitcnt lgkmcnt(0)" ::: "memory");
    }
    const int voff = ((lane >> 4) & 1) * 32 + (lane & 3) * 8 + (4 * hi + ((lane & 15) >> 2)) * 64;
#pragma unroll
    for (int t = 0; t < 2; ++t) {
        const f32x16& p0 = t == 0 ? a0 : b0; const f32x16& p1 = t == 0 ? a1 : b1;
        u32x4 pw[4];
#pragma unroll
        for (int k = 0; k < 4; ++k) { pw[0][k] = cvtpk(p0[2 * k], p0[2 * k + 1]); pw[1][k] = cvtpk(p0[8 + 2 * k], p0[8 + 2 * k + 1]); pw[2][k] = cvtpk(p1[2 * k], p1[2 * k + 1]); pw[3][k] = cvtpk(p1[8 + 2 * k], p1[8 + 2 * k + 1]); }
        const lds_cptr vp = (lds_cptr)(t == 0 ? vA : vB) + voff;
#pragma unroll
        for (int i = 0; i < 8; ++i) {
            const s16x4 lo = vtr(vp + ((i >> 2) * 4096 + (i & 3) * 1024)), hh = vtr(vp + ((i >> 2) * 4096 + (i & 3) * 1024 + 512));
            const bf16x8 vf = (bf16x8){lo[0], lo[1], lo[2], lo[3], hh[0], hh[1], hh[2], hh[3]};
            const bf16x8 pf = __builtin_bit_cast(bf16x8, pw[i & 3]);
            if (i < 4) o0 = MFMA32(pf, vf, o0); else o1 = MFMA32(pf, vf, o1);
        }
    }
}

constexpr int NQ_KVB = 18432, NQ_WSF = 4 * NQ_KVB, NQ_SEL = NQ_WSF + 2048, NQ_LIST = NQ_SEL + 512, NQ_YAC = NQ_LIST + 256, NQ_LDS = NQ_YAC + 65536, NQ_IMP = 2 * NQ_KVB;
static_assert(NQ_LDS <= 152 * 1024, "lds");
DEVI void nsa_prompt_unit(const P& p, char* smem, int b, int g, int qt) {
    const int tid = tid_opq(), lane = tid & 63, wid = tid >> 6, r32 = lane & 31, hi = lane >> 5;
    float* wsf = (float*)(smem + NQ_WSF) + wid * 64;
    float* impb = (float*)(smem + NQ_IMP) + wid * 512;
    unsigned long long* selm = (unsigned long long*)(smem + NQ_SEL);
    unsigned char* blist = (unsigned char*)(smem + NQ_LIST);
    const int t0 = qt * 64;
    const size_t rowbase = (size_t)b * 4096 + t0;
    const int tokl = wid * 8 + (r32 >> 2), head = r32 & 3;
    const int qpos = t0 + tokl;
    const float slope = alibi_slope(g * 4 + head);
    bf16x8 qr[4];
    {
        const bf16_t* qp = p.PROJ + (rowbase + tokl) * PS + C_BQ + (g * 4 + head) * 64 + hi * 8;
#pragma unroll
        for (int d0 = 0; d0 < 4; ++d0) {
            u32x4 v = *(const u32x4*)(qp + d0 * 16);
#pragma unroll
            for (int k = 0; k < 4; ++k) { const float lo = __uint_as_float(v[k] << 16) * 0.125f, hh = __uint_as_float(v[k] & 0xFFFF0000u) * 0.125f; v[k] = (__float_as_uint(lo) >> 16) | (__float_as_uint(hh) & 0xFFFF0000u); }
            qr[d0] = __builtin_bit_cast(bf16x8, v);
        }
    }
    unsigned qe_w;
    { const unsigned sh = (unsigned)f2bf(slope); const float rem = slope - __uint_as_float(sh << 16); qe_w = sh | ((unsigned)f2bf(rem) << 16); if (hi) qe_w = 0u; }
    int hi4 = 4 * hi; asm volatile("" : "+v"(hi4));
    float* yl = (float*)(smem + NQ_YAC) + wid * 2048 + hi4 * 64 + r32;
    float* wsf_hi = wsf + hi4; float* wsf_r = wsf + r32;
    f32x16 o0, o1; float m, lsum;
    auto finish = [&](int br) {
        const float lt = half_sum(lsum);
        float fac = 0.f;
        if (lt > 0.f) fac = sigmoidf_(p.SM[(rowbase + tokl) * 64 + 8 + br * 16 + g * 4 + head]) / lt;
        if (hi == 0) *wsf_r = fac;
        asm volatile("s_waitcnt lgkmcnt(0)" ::: "memory");
#pragma unroll
        for (int a = 0; a < 4; ++a) {
            const f32x4 fv = *(const f32x4*)(wsf_hi + 8 * a);
#pragma unroll
            for (int k = 0; k < 4; ++k) {
                float* yp = yl + (8 * a + k) * 64;
                if (br == 0) { yp[0] = o0[4 * a + k] * fv[k]; yp[32] = o1[4 * a + k] * fv[k]; }
                else { yp[0] += o0[4 * a + k] * fv[k]; yp[32] += o1[4 * a + k] * fv[k]; }
            }
        }
        asm volatile("s_waitcnt lgkmcnt(0)" ::: "memory");
    };
    __syncthreads();
    if (tid < 64) *(u32x4*)(smem + 9 * 1024 + tid * 16) = (u32x4){0u, 0u, 0u, 0u};
    {
        const BlkDesc d = nsa_desc(p, true, b, g, 0, 0);
        u32x4 rk, rv; blk_load(d, tid, rk, rv); blk_store_ext(d, 64, 63, t0, smem, smem + 10240, tid, rk, rv);
        __syncthreads();
        o0 = (f32x16){}; o1 = (f32x16){}; m = -1e30f; lsum = 0.f;
        f32x16 s0, s1;
        {
            const int nv = ((qpos + 1) >> 6) - 1;
            const int lh = (nv < 63 ? nv : 63) - hi4;
            const bf16x8 qext = __builtin_bit_cast(bf16x8, (u32x4){qe_w, qe_w, 0u, 0u});
            attn_tile2(smem, smem + 10240, qr, qext, m, lsum, o0, o1, s0, s1, lh, -1000, false, wsf_hi, wsf_r, lane);
        }
        const float lt = half_sum(lsum);
        const float inv = lt > 0.f ? 1.f / lt : 0.f;
        unsigned x[64];
#pragma unroll
        for (int r = 0; r < 16; ++r) {
#pragma unroll
            for (int n = 0; n < 2; ++n) {
                float a = (n == 0 ? s0[r] : s1[r]) * inv;
                a += __shfl_xor(a, 1); a += __shfl_xor(a, 2);
                const int j = (r & 3) + 8 * (r >> 2) + 32 * n + hi4;
                if (j == qt || j == 0) a = 5.0f;
                if (j > qt) a = -1.0f;
                const unsigned u = __float_as_uint(a);
                const unsigned o = (u & 0x80000000u) ? ~u : (u | 0x80000000u);
                x[n * 16 + r] = (o & ~63u) | (unsigned)(63 - j);
            }
        }
        finish(0);
        sort16_desc<0>(x); sort16_desc<16>(x);
        unsigned th[16], oth[16], fin[16];
        merge_top16(&x[0], &x[16], th);
#pragma unroll
        for (int i = 0; i < 16; ++i) { auto rr = __builtin_amdgcn_permlane32_swap(th[i], th[i], false, false); oth[i] = hi ? rr[0] : rr[1]; }
        merge_top16(th, oth, fin);
        unsigned long long mask = 0ull;
#pragma unroll
        for (int i = 0; i < 16; ++i) mask |= 1ull << (63u - (fin[i] & 63u));
        if (head == 0 && hi == 0) selm[wid * 8 + (r32 >> 2)] = mask;
    }
    __syncthreads();
    if (wid == 0) {
        unsigned long long u = selm[lane];
#pragma unroll
        for (int o = 32; o > 0; o >>= 1) u |= __shfl_xor(u, o);
        u &= (qt == 63) ? ~0ull : ((1ull << (qt + 1)) - 1ull);
        {
            const int n = __builtin_popcountll(u);
            if ((u >> lane) & 1ull) blist[2 + __builtin_popcountll(lane < 63 ? (u >> (lane + 1)) : 0ull)] = (unsigned char)lane;
            const int w0 = qt - 8 > 0 ? qt - 8 : 0, nw = qt - w0 + 1;
            if (lane < nw) blist[2 + n + lane] = (unsigned char)(qt - lane);
            if (lane == 0) { blist[0] = (unsigned char)n; blist[1] = (unsigned char)nw; }
        }
    }
    __syncthreads();
    if (tid >= 64 && tid < 256) *(u32x4*)(smem + (tid >> 6) * NQ_KVB + 9 * 1024 + (tid & 63) * 16) = (u32x4){0u, 0u, 0u, 0u};
    const int ns = blist[0], nw = blist[1];
    const int nss = (ns + 1) >> 1, nsteps = nss + ((nw + 1) >> 1);
    const unsigned long long mysel = selm[tokl];
    {
        auto step_blocks = [&](int s, int& br, int& jA, int& jB) {
            if (s < nss) { br = 1; jA = blist[2 + 2 * s]; jB = 2 * s + 1 < ns ? (int)blist[2 + 2 * s + 1] : -1; }
            else { const int w = s - nss; br = 2; jA = blist[2 + ns + 2 * w]; jB = 2 * w + 1 < nw ? (int)blist[2 + ns + 2 * w + 1] : -1; }
        };
        u32x4 rkA, rvA, rkB, rvB;
        auto load_step = [&](int s) {
            int br, jA, jB; step_blocks(s, br, jA, jB);
            const BlkDesc dA = nsa_desc(p, true, b, g, br, jA); blk_load(dA, tid, rkA, rvA);
            if (jB >= 0) { const BlkDesc dB = nsa_desc(p, true, b, g, br, jB); blk_load(dB, tid, rkB, rvB); }
        };
        auto store_step = [&](int s, char* buf) {
            int br, jA, jB; step_blocks(s, br, jA, jB);
            BlkDesc dA; dA.pos0 = jA * 64; blk_store_ext(dA, 1, 0, t0, buf, buf + 10240, tid, rkA, rvA);
            if (jB >= 0) { BlkDesc dB; dB.pos0 = jB * 64; blk_store_ext(dB, 1, 0, t0, buf + NQ_KVB, buf + NQ_KVB + 10240, tid, rkB, rvB); }
        };
        load_step(0); store_step(0, smem);
        __syncthreads();
        int prev_br = 1;
        o0 = (f32x16){}; o1 = (f32x16){}; m = -1e30f; lsum = 0.f;
        for (int s = 0; s < nsteps; ++s) {
            int br, jA, jB; step_blocks(s, br, jA, jB);
            char* cur = smem + (s & 1) * 2 * NQ_KVB;
            char* nxt = smem + ((s & 1) ^ 1) * 2 * NQ_KVB;
            if (s + 1 < nsteps) load_step(s + 1);
            if (br != prev_br) { finish(1); o0 = (f32x16){}; o1 = (f32x16){}; m = -1e30f; lsum = 0.f; prev_br = br; }
            {
                asm volatile("" : "+v"(hi4));
                const bool lselA = br == 2 || ((mysel >> jA) & 1ull);
                const int relA = qpos - jA * 64;
                const int lhA = (relA < 63 ? relA : 63) - hi4, llA = (br == 2 ? relA - 512 : -1000) - hi4;
                const bool fastA = __all(!lselA || (lhA >= 59 && llA < 0));
                const bool needA = __any(lselA && lhA + hi4 >= 0 && llA + hi4 < 63);
                const bf16x8 qeA = __builtin_bit_cast(bf16x8, (u32x4){qe_w, qe_w, (lselA || hi) ? 0u : 0x0000C6EAu, 0u});
                bool needB = false; bool lselB = false; int lhB = -1000, llB = -1000; bool fastB = false;
                if (jB >= 0) {
                    lselB = br == 2 || ((mysel >> jB) & 1ull);
                    const int relB = qpos - jB * 64;
                    lhB = (relB < 63 ? relB : 63) - hi4; llB = (br == 2 ? relB - 512 : -1000) - hi4;
                    fastB = __all(!lselB || (lhB >= 59 && llB < 0));
                    needB = __any(lselB && lhB + hi4 >= 0 && llB + hi4 < 63);
                }
                const bf16x8 qeB = __builtin_bit_cast(bf16x8, (u32x4){qe_w, qe_w, (lselB || hi) ? 0u : 0x0000C6EAu, 0u});
                f32x16 s0, s1;
                if (needA && needB) attn_tile3(cur, cur + 10240, cur + NQ_KVB, cur + NQ_KVB + 10240, qr, qeA, qeB, m, lsum, o0, o1, lhA, llA, fastA, lhB, llB, fastB, wsf_hi, wsf_r, lane);
                else if (needA) attn_tile2(cur, cur + 10240, qr, qeA, m, lsum, o0, o1, s0, s1, lhA, llA, fastA, wsf_hi, wsf_r, lane);
                else if (needB) attn_tile2(cur + NQ_KVB, cur + NQ_KVB + 10240, qr, qeB, m, lsum, o0, o1, s0, s1, lhB, llB, fastB, wsf_hi, wsf_r, lane);
            }
            if (s + 1 < nsteps) store_step(s + 1, nxt);
            __syncthreads();
        }
        finish(2);
    }
    {
        const float* yac = (const float*)(smem + NQ_YAC) + wid * 2048;
#pragma unroll
        for (int i = 0; i < 4; ++i) {
            const int orow = i * 8 + (lane >> 3), ch = lane & 7, tk = wid * 8 + (orow >> 2), hd = orow & 3;
            const f32x4 a = *(const f32x4*)(yac + orow * 64 + ch * 8), c = *(const f32x4*)(yac + orow * 64 + ch * 8 + 4);
            *(u32x4*)(p.YB + (rowbase + tk) * 1024 + (g * 4 + hd) * 64 + ch * 8) = pack8f(a, c);
        }
        asm volatile("s_waitcnt lgkmcnt(0)" ::: "memory");
    }
}

DEVI void stage_nsa_attn(const P& p, char* smem, int bid, int nblk) {
    (void)bid; (void)nblk;
    unsigned* head = p.bar + 3840;
    volatile unsigned* slot = (volatile unsigned*)(smem + 150 * 1024);
    for (;;) {
        __syncthreads();
        if (tid_opq() == 0) *slot = __hip_atomic_fetch_add(head, 1u, __ATOMIC_RELAXED, __HIP_MEMORY_SCOPE_AGENT);
        __syncthreads();
        const unsigned i = *slot;
        if (i >= 1536u) break;
        if (i < 1024u) nsa_prompt_unit(p, smem, (int)((i & 15u) >> 2), (int)(i & 3u), 63 - (int)(i >> 4));
        else nsa_sample_unit(p, smem, (int)i - 1024);
    }
}

DEVI void stage2_queue(const P& p, char* smem) {
    unsigned* head = p.bar + 3904;
    volatile unsigned* slot = (volatile unsigned*)(smem + 150 * 1024);
    constexpr int BIG = 1 << 20;
    for (;;) {
        __syncthreads();
        if (tid_opq() == 0) *slot = __hip_atomic_fetch_add(head, 1u, __ATOMIC_RELAXED, __HIP_MEMORY_SCOPE_AGENT);
        __syncthreads();
        const unsigned i = *slot;
        if (i >= 1824u) break;
        int kind, t;
        if (i < 16u) { kind = 0; t = (int)i; }
        else if (i < 528u) { const unsigned j = i - 16u; kind = (j & 1u) ? 1 : 2; t = (int)(j >> 1); }
        else if (i < 544u) { kind = 2; t = 256 + (int)(i - 528u); }
        else { const unsigned j = i - 544u, q = j / 5u, r = j - q * 5u; if (r < 3u) { kind = 1; t = 256 + (int)(q * 3u + r); } else { kind = 3; t = (int)(q * 2u + r - 3u); } }
        if (kind == 0) stage_mlstm_gates(p, smem, t, BIG);
        else if (kind == 1) stage_mlstm_dc(p, smem, t, BIG);
        else if (kind == 2) stage_compress(p, smem, 0, BIG, t);
        else stage_mlstm_sample(p, smem, t, BIG);
    }
}

DEVI void stage_ln1(const P& p, int bid, int nblk) {
    const int lane = tid_opq() & 63, wid = tid_opq() >> 6;
    for (int row = bid * 8 + wid; row < NT; row += nblk * 8) {
        f32x4 x[4];
        float s = 0.f;
#pragma unroll
        for (int i = 0; i < 4; ++i) { x[i] = *(const f32x4*)(p.R + (size_t)row * 1024 + i * 256 + lane * 4); s += x[i][0] + x[i][1] + x[i][2] + x[i][3]; }
        const float mean = wave_sum(s) * (1.f / 1024.f);
        float q = 0.f;
#pragma unroll
        for (int i = 0; i < 4; ++i)
#pragma unroll
            for (int k = 0; k < 4; ++k) q += (x[i][k] - mean) * (x[i][k] - mean);
        const float rs = rsqrtf(wave_sum(q) * (1.f / 1024.f) + LN_EPS);
#pragma unroll
        for (int i = 0; i < 4; ++i) {
            const int c = i * 256 + lane * 4;
            const f32x4 gg = *(const f32x4*)(p.ln1_g + c), bb = *(const f32x4*)(p.ln1_b + c);
            f32x4 y;
#pragma unroll
            for (int k = 0; k < 4; ++k) y[k] = (x[i][k] - mean) * rs * gg[k] + bb[k];
            u32x2 o; o.x = pack2(y[0], y[1]); o.y = pack2(y[2], y[3]);
            *(u32x2*)(p.HB + (size_t)row * 1024 + c) = o;
        }
        if (lane == 0) { p.H[(size_t)row * 2] = mean; p.H[(size_t)row * 2 + 1] = rs; }
    }
}

__device__ const unsigned char PEER_CA[50] = {0,0,0,0,0,0,0,0,0,0,0,0,0,0,0,0, 1,1,1,1,1,1,1,1, 2,2,2,2,2, 3,3,3,3, 4,4,4, 5,5, 6,6, 7,7, 8,9,10,11,12,13,14,15};
__device__ const unsigned char PEER_CB[50] = {0,1,2,3,4,5,6,7,8,9,10,11,12,13,14,15, 0,1,2,3,4,5,6,7, 0,1,2,3,4, 0,1,2,3, 0,1,2, 0,1, 0,1, 0,1, 0,0,0,0,0,0,0,0};

DEVI float key_score(unsigned k) { const unsigned u = k & ~127u; return __uint_as_float((u & 0x80000000u) ? (u & 0x7FFFFFFFu) : ~u); }

DEVI void sort8_desc(unsigned (&x)[16]) {
#pragma unroll
    for (int k = 2; k <= 8; k <<= 1)
#pragma unroll
        for (int j = k >> 1; j > 0; j >>= 1)
#pragma unroll
            for (int i = 0; i < 8; ++i) {
                const int l = i ^ j;
                if (l > i) { if ((i & k) == 0) ce_desc(x[i], x[l]); else ce_desc(x[l], x[i]); }
            }
}
DEVI unsigned sum_key(unsigned ka, unsigned kb, unsigned tag) {
    const unsigned u = __float_as_uint(key_score(ka) + key_score(kb));
    const unsigned o = (u & 0x80000000u) ? ~u : (u | 0x80000000u);
    return (o & ~255u) | tag;
}
DEVI float key_score8(unsigned k) { const unsigned u = k & ~255u; return __uint_as_float((u & 0x80000000u) ? (u & 0x7FFFFFFFu) : ~u); }

DEVI void route_top16(const P& p, int row, int ph, int c, int r32, int hi, int hi4, unsigned (&fin)[16]) {
    f32x16 acc[4];
#pragma unroll
    for (int t = 0; t < 4; ++t) acc[t] = (f32x16){};
    const bf16_t* qp = p.PQ + (size_t)row * 2048 + ph * 256 + c * 128 + hi * 8;
    const bf16_t* kp = p.KEYSB + ((size_t)((ph * 2 + c) * 128 + r32)) * 128 + hi * 8;
#pragma unroll
    for (int s8 = 0; s8 < 8; ++s8) {
        const bf16x8 qf = *(const bf16x8*)(qp + s8 * 16);
#pragma unroll
        for (int t = 0; t < 4; ++t) {
            const bf16x8 kf = *(const bf16x8*)(kp + (size_t)t * 32 * 128 + s8 * 16);
            acc[t] = MFMA32(kf, qf, acc[t]);
        }
    }
    unsigned x[64];
#pragma unroll
    for (int t = 0; t < 4; ++t)
#pragma unroll
        for (int r = 0; r < 16; ++r) {
            const unsigned u = __float_as_uint(acc[t][r]);
            const unsigned o = (u & 0x80000000u) ? ~u : (u | 0x80000000u);
            x[t * 16 + r] = (o & ~127u) | (unsigned)(127 - ((r & 3) + 8 * (r >> 2) + 32 * t) - hi4);
        }
    sort16_desc<0>(x); sort16_desc<16>(x); sort16_desc<32>(x); sort16_desc<48>(x);
    unsigned t01[16], t23[16], tt[16], oth[16];
    merge_top16(&x[0], &x[16], t01); merge_top16(&x[32], &x[48], t23); merge_top16(t01, t23, tt);
#pragma unroll
    for (int i = 0; i < 16; ++i) { auto rr = __builtin_amdgcn_permlane32_swap(tt[i], tt[i], false, false); oth[i] = hi ? rr[0] : rr[1]; }
    merge_top16(tt, oth, fin);
}

DEVI void stage_peer_route(const P& p, char* smem, int bid, int nblk, int p0, int p1) {
    const int lane = tid_opq() & 63, wid = tid_opq() >> 6, r32 = lane & 31, hi = lane >> 5;
    unsigned char* tb = (unsigned char*)smem + wid * 1024 + r32 * 32;
    const int tpw = (NT + nblk - 1) / nblk, row_lo = bid * tpw, row_hi = (row_lo + tpw < NT) ? row_lo + tpw : NT;
    const int ph = wid;
    for (int pass = p0; pass < p1 && row_lo + pass * 32 < row_hi; ++pass) {
        const int row_raw = row_lo + pass * 32 + r32;
        const bool row_ok = row_raw < row_hi;
        const int row = row_ok ? row_raw : row_lo;
        int hi4 = 4 * hi; asm volatile("" : "+v"(hi4));
        unsigned fa[16], fb[16];
        route_top16(p, row, ph, 0, r32, hi, hi4, fa);
        asm volatile("" : "+v"(hi4));
        route_top16(p, row, ph, 1, r32, hi, hi4, fb);
        if (hi == 0) {
            u32x4 wa, wb;
#pragma unroll
            for (int i = 0; i < 4; ++i) {
                wa[i] = (127u - (fa[4 * i] & 127u)) | ((127u - (fa[4 * i + 1] & 127u)) << 8) | ((127u - (fa[4 * i + 2] & 127u)) << 16) | ((127u - (fa[4 * i + 3] & 127u)) << 24);
                wb[i] = (127u - (fb[4 * i] & 127u)) | ((127u - (fb[4 * i + 1] & 127u)) << 8) | ((127u - (fb[4 * i + 2] & 127u)) << 16) | ((127u - (fb[4 * i + 3] & 127u)) << 24);
            }
            *(u32x4*)tb = wa; *(u32x4*)(tb + 16) = wb;
        }
        unsigned g0[16], g1[16], g2[16], g3[16];
#pragma unroll
        for (int j = 0; j < 16; ++j) g0[j] = sum_key(fa[0], fb[j], (unsigned)j);
#pragma unroll
        for (int k = 0; k < 15; ++k) g1[k] = sum_key(fa[k + 1], fb[0], (unsigned)((k + 1) << 4));
        g1[15] = 0u;
#pragma unroll
        for (int j = 1; j < 8; ++j) g2[j - 1] = sum_key(fa[1], fb[j], (unsigned)(16 | j));
        g2[7] = 0u; g2[8] = 0u; g2[9] = 0u;
#pragma unroll
        for (int i = 2; i < 8; ++i) g2[17 - i] = sum_key(fa[i], fb[1], (unsigned)((i << 4) | 1));
#pragma unroll
        for (int j = 8; j > 0; j >>= 1)
#pragma unroll
            for (int i = 0; i < 16; ++i) { const int l = i ^ j; if (l > i) ce_desc(g2[i], g2[l]); }
        g3[0] = sum_key(fa[2], fb[2], 0x22u); g3[1] = sum_key(fa[2], fb[3], 0x23u); g3[2] = sum_key(fa[2], fb[4], 0x24u);
        g3[3] = sum_key(fa[3], fb[2], 0x32u); g3[4] = sum_key(fa[4], fb[2], 0x42u); g3[5] = sum_key(fa[3], fb[3], 0x33u);
#pragma unroll
        for (int i = 6; i < 16; ++i) g3[i] = 0u;
        sort8_desc(g3);
        unsigned t01[16], t23[16], top[16];
        merge_top16(g0, g1, t01); merge_top16(g2, g3, t23); merge_top16(t01, t23, top);
        float ev[16]; float sum = 0.f;
        const float vmax = key_score8(top[0]);
#pragma unroll
        for (int k = 0; k < 16; ++k) { ev[k] = __expf(key_score8(top[k]) - vmax); sum += ev[k]; }
        const float inv = 1.f / sum;
        asm volatile("s_waitcnt lgkmcnt(0)" ::: "memory");
        if (!row_ok) {   } else if (hi == 0) {
            int* dst = p.EIDX + (size_t)row * 128 + ph * 16;
#pragma unroll
            for (int q4 = 0; q4 < 4; ++q4) {
                u32x4 o;
#pragma unroll
                for (int k = 0; k < 4; ++k) { const unsigned tg = top[q4 * 4 + k] & 255u; o[k] = (unsigned)tb[tg >> 4] * 128u + (unsigned)tb[16 + (tg & 15u)]; }
                *(u32x4*)(dst + q4 * 4) = o;
            }
        } else {
            float* dst = p.EGATE + (size_t)row * 128 + ph * 16;
#pragma unroll
            for (int q4 = 0; q4 < 4; ++q4) *(f32x4*)(dst + q4 * 4) = (f32x4){ev[q4 * 4] * inv, ev[q4 * 4 + 1] * inv, ev[q4 * 4 + 2] * inv, ev[q4 * 4 + 3] * inv};
        }
        asm volatile("s_waitcnt lgkmcnt(0)" ::: "memory");
    }
}

constexpr int PA_WAVE_LDS = 1024 + 1024 + 512 + 512 + 512 + 4096;
DEVI void stage_peer_apply(const P& p, char* smem, int bid, int nblk, int p0, int p1) {
    const int lane = tid_opq() & 63, wid = tid_opq() >> 6;
    char* wl = smem + wid * PA_WAVE_LDS;
    unsigned char* hhi = (unsigned char*)wl; unsigned char* hlo = hhi + 1024;
    int* idxs = (int*)(wl + 2048);
    float* gts = (float*)(wl + 2560);
    float* cs = (float*)(wl + 3072);
    const int fr = lane & 15, fq = lane >> 4;
    const int tpw = (NT + nblk - 1) / nblk, row_lo = bid * tpw, row_hi = (row_lo + tpw < NT) ? row_lo + tpw : NT;
    for (int row = row_lo + p0 * 32 + wid; row < row_hi && row < row_lo + p1 * 32; row += 8) {
        float* hvs = (float*)(wl + 3584);
        {
            const float* hr = p.R + (size_t)row * 1024 + lane * 16;
            const float mean1 = p.H[(size_t)row * 2], rs1 = p.H[(size_t)row * 2 + 1];
            u32x4 ohi, olo;
#pragma unroll
            for (int i = 0; i < 4; ++i) {
                f32x4 x = *(const f32x4*)(hr + i * 4);
                { const f32x4 g1 = *(const f32x4*)(p.ln1_g + lane * 16 + i * 4), b1 = *(const f32x4*)(p.ln1_b + lane * 16 + i * 4);
#pragma unroll
                  for (int k = 0; k < 4; ++k) x[k] = (x[k] - mean1) * rs1 * g1[k] + b1[k]; }
                *(f32x4*)(hvs + lane * 16 + i * 4) = x;
                int w = __builtin_amdgcn_cvt_pk_fp8_f32(x[0], x[1], 0, false); w = __builtin_amdgcn_cvt_pk_fp8_f32(x[2], x[3], w, true);
                const f32x2 d01 = __builtin_amdgcn_cvt_pk_f32_fp8(w, false), d23 = __builtin_amdgcn_cvt_pk_f32_fp8(w, true);
                int w2 = __builtin_amdgcn_cvt_pk_fp8_f32(x[0] - d01[0], x[1] - d01[1], 0, false); w2 = __builtin_amdgcn_cvt_pk_fp8_f32(x[2] - d23[0], x[3] - d23[1], w2, true);
                ohi[i] = (unsigned)w; olo[i] = (unsigned)w2;
            }
            *(u32x4*)(hhi + lane * 16) = ohi; *(u32x4*)(hlo + lane * 16) = olo;
            idxs[lane] = p.EIDX[(size_t)row * 128 + lane]; idxs[lane + 64] = p.EIDX[(size_t)row * 128 + 64 + lane];
            gts[lane] = p.EGATE[(size_t)row * 128 + lane]; gts[lane + 64] = p.EGATE[(size_t)row * 128 + 64 + lane];
            asm volatile("s_waitcnt lgkmcnt(0)" ::: "memory");
        }
        {
            float hreg[16];
#pragma unroll
            for (int i = 0; i < 4; ++i) { const f32x4 t = *(const f32x4*)(hvs + lane * 16 + i * 4); hreg[i * 4] = t[0]; hreg[i * 4 + 1] = t[1]; hreg[i * 4 + 2] = t[2]; hreg[i * 4 + 3] = t[3]; }
            U3 u0[8], u1[8];
            auto issue_u = [&](int e0, U3 (&u)[8]) {
#pragma unroll
                for (int k = 0; k < 8; ++k) u[k] = *(const U3*)(p.U8 + (size_t)idxs[e0 + k] * 768 + lane * 12);
            };
            auto dots_u = [&](const U3 (&u)[8], float (&sp)[8]) {
#pragma unroll
                for (int k = 0; k < 8; k += 2) {
                    const i32x6 src = {(int)u[k].a, (int)u[k].b, (int)u[k].c, (int)u[k + 1].a, (int)u[k + 1].b, (int)u[k + 1].c};
                    const f32x32 f = __builtin_amdgcn_cvt_scalef32_pk32_f32_fp6(src, 1.0f);
                    float s0 = 0.f, s1 = 0.f;
#pragma unroll
                    for (int i = 0; i < 16; ++i) { s0 += f[i] * hreg[i]; s1 += f[16 + i] * hreg[i]; }
                    sp[k] = s0; sp[k + 1] = s1;
                }
            };
            auto finish_u = [&](int e0, const float (&sa)[8], const float (&sb)[8]) {
                float t[8], w[4];
#pragma unroll
                for (int i = 0; i < 8; ++i) {
                    const float x = i < 4 ? sa[2 * i] : sb[2 * i - 8], y = i < 4 ? sa[2 * i + 1] : sb[2 * i - 7];
                    const auto r = __builtin_amdgcn_permlane32_swap(__float_as_uint(x), __float_as_uint(y), false, false);
                    t[i] = __uint_as_float(r[0]) + __uint_as_float(r[1]);
                }
#pragma unroll
                for (int i = 0; i < 4; ++i) {
                    const auto r = __builtin_amdgcn_permlane16_swap(__float_as_uint(t[2 * i]), __float_as_uint(t[2 * i + 1]), false, false);
                    float v = __uint_as_float(r[0]) + __uint_as_float(r[1]);
                    v += __uint_as_float(__builtin_amdgcn_update_dpp(0u, __float_as_uint(v), 0x128, 0xf, 0xf, false));
                    v += __uint_as_float(__builtin_amdgcn_update_dpp(0u, __float_as_uint(v), 0x124, 0xf, 0xf, false));
                    v += __uint_as_float(__builtin_amdgcn_update_dpp(0u, __float_as_uint(v), 0x4e, 0xf, 0xf, false));
                    v += __uint_as_float(__builtin_amdgcn_update_dpp(0u, __float_as_uint(v), 0xb1, 0xf, 0xf, false));
                    w[i] = v;
                }
                const int c = lane & 3, r = lane >> 4;
                const float tot = c == 0 ? w[0] : c == 1 ? w[1] : c == 2 ? w[2] : w[3];
                const int k = 4 * c + ((r & 1) << 1) + (r >> 1);
                if ((lane & 15) < 4) {
                    const int e = idxs[e0 + k];
                    cs[e0 + k] = gts[e0 + k] * p.VS[e] * gelu_erf(tot * p.US[e]);
                }
            };
            issue_u(0, u0);
#pragma unroll 1
            for (int e0 = 0; e0 < 128; e0 += 16) {
                float sa[8], sb[8];
                issue_u(e0 + 8, u1);
                dots_u(u0, sa);
                if (e0 + 16 < 128) issue_u(e0 + 16, u0);
                dots_u(u1, sb);
                finish_u(e0, sa, sb);
            }
        }
        asm volatile("s_waitcnt lgkmcnt(0)" ::: "memory");
        float acc[16];
#pragma unroll
        for (int i = 0; i < 16; ++i) acc[i] = 0.f;
        {
#if V_FP6
            U3 v0[8], v1[8];
            auto issue_v = [&](int e0, U3 (&v)[8]) {
#pragma unroll
                for (int k = 0; k < 8; ++k) v[k] = *(const U3*)(p.V8 + (size_t)idxs[e0 + k] * 768 + lane * 12);
            };
            auto consume_v = [&](int e0, const U3 (&v)[8]) {
#pragma unroll
                for (int k = 0; k < 8; k += 2) {
                    const float c0 = cs[e0 + k], c1 = cs[e0 + k + 1];
                    const i32x6 src = {(int)v[k].a, (int)v[k].b, (int)v[k].c, (int)v[k + 1].a, (int)v[k + 1].b, (int)v[k + 1].c};
                    const f32x32 f = __builtin_amdgcn_cvt_scalef32_pk32_f32_fp6(src, 1.0f);
#pragma unroll
                    for (int i = 0; i < 16; ++i) acc[i] += c0 * f[i] + c1 * f[16 + i];
                }
            };
#else
            u32x4 v0[8], v1[8];
            auto issue_v = [&](int e0, u32x4 (&v)[8]) {
#pragma unroll
                for (int k = 0; k < 8; ++k) v[k] = *(const u32x4*)(p.V8 + (size_t)idxs[e0 + k] * 1024 + lane * 16);
            };
            auto consume_v = [&](int e0, const u32x4 (&v)[8]) {
#pragma unroll
                for (int k = 0; k < 8; ++k) {
                    const float c = cs[e0 + k];
#pragma unroll
                    for (int w = 0; w < 4; ++w) {
                        const f32x2 lo = __builtin_amdgcn_cvt_pk_f32_fp8((int)v[k][w], false), hh = __builtin_amdgcn_cvt_pk_f32_fp8((int)v[k][w], true);
                        acc[w * 4] += c * lo[0]; acc[w * 4 + 1] += c * lo[1]; acc[w * 4 + 2] += c * hh[0]; acc[w * 4 + 3] += c * hh[1];
                    }
                }
            };
#endif
            issue_v(0, v0);
#pragma unroll 1
            for (int e0 = 0; e0 < 128; e0 += 16) {
                issue_v(e0 + 8, v1);
                consume_v(e0, v0);
                if (e0 + 16 < 128) issue_v(e0 + 16, v0);
                consume_v(e0 + 8, v1);
            }
        }
        float s = 0.f;
#pragma unroll
        for (int i = 0; i < 16; ++i) { acc[i] += DN_ALPHA * hvs[lane * 16 + i]; s += acc[i]; }
        const float mean = wave_sum(s) * (1.f / 1024.f);
        float q = 0.f;
#pragma unroll
        for (int i = 0; i < 16; ++i) q += (acc[i] - mean) * (acc[i] - mean);
        const float rs = rsqrtf(wave_sum(q) * (1.f / 1024.f) + LN_EPS);
#pragma unroll
        for (int i = 0; i < 4; ++i) {
            const int c = lane * 16 + i * 4;
            const f32x4 g0 = *(const f32x4*)(p.ln2_g + c), b0 = *(const f32x4*)(p.ln2_b + c);
            f32x4 y0;
#pragma unroll
            for (int k = 0; k < 4; ++k) y0[k] = (acc[i * 4 + k] - mean) * rs * g0[k] + b0[k];
            *(f32x4*)(p.out + O_Y + (size_t)row * 1024 + c) = y0;
        }
    }
}

namespace pg8 {
#define PG8_LAS __attribute__((address_space(3)))
typedef unsigned short bf16_t;
typedef short bf16x8 __attribute__((ext_vector_type(8)));
typedef float f32x4 __attribute__((ext_vector_type(4)));
typedef unsigned u32x4 __attribute__((ext_vector_type(4)));
constexpr int BM = 256, BK = 64, HALF = 128, HTB = HALF * BK * 2  , STAGE_BYTES = 8 * HTB, NXCD = 8, WGM = 8;

__host__ __device__ __forceinline__ int lds_byte(int r, int c) { const int st = (r >> 4) * 2 + (c >> 5), rr = r & 15, cc = c & 31, ob = rr * 64 + cc * 2; return st * 1024 + (ob ^ (((ob >> 9) & 1) << 5)); }
__host__ __device__ __forceinline__ void stage_rc(int b, int& R, int& C) { const int st = b / 1024, sb = b % 1024, swz = sb ^ (((sb >> 9) & 1) << 5); R = (st >> 1) * 16 + swz / 64; C = (st & 1) * 32 + (swz % 64) / 2; }
__host__ __device__ __forceinline__ int perm32(int rho) { const int n = rho >> 4, i = rho & 15; return 8 * (i >> 2) + 4 * n + (i & 3); }

struct Unit { int pm, pn; };
struct Gemm { const bf16_t* A; const bf16_t* Bt; int M, N, K; };

struct StaticOrder {
    int nM, nN, nwg, G, c;
    __host__ __device__ void init(int M, int N, int G_, int c_) { nM = M / BM; nN = N / BM; nwg = nM * nN; G = G_; c = c_; }
    __host__ __device__ bool next(int i, Unit& u) const {
        const long L = (long)i * G + c; if (L >= nwg) return false;
        int wgid = (int)L; { const int q = nwg / NXCD, r = nwg % NXCD, xcd = wgid % NXCD, off = wgid / NXCD; wgid = (xcd < r ? xcd * (q + 1) : r * (q + 1) + (xcd - r) * q) + off; }
        const int nig = WGM * nN, gid = wgid / nig, fm = gid * WGM, gsz = (nM - fm) < WGM ? (nM - fm) : WGM;
        u.pm = fm + ((wgid % nig) % gsz); u.pn = (wgid % nig) / gsz; return true;
    }
    __device__ __forceinline__ void a_ready(const Unit&) const {}
    __device__ __forceinline__ void done(const Unit&) const {}
};
template <class Epi, class Sched, bool STAMP = false>
__device__ __forceinline__ void gemm_phase(PG8_LAS unsigned char* lds, const Gemm g, const Sched& S, const Epi& E, unsigned long long* stamps) {
    const int tid = tid_opq(), wid = __builtin_amdgcn_readfirstlane(tid >> 6), lane = tid & 63, wr = wid >> 2, wc = wid & 3, fr = lane & 15, fq = lane >> 4;
    const int K = g.K, nt = K / BK;
    int ts_lo = 0, ts_hi = 0, nts = 0; const unsigned long long rt_entry = STAMP ? (unsigned long long)wall_clock64() : 0ull;
#define PG8_STAMP() do { if (STAMP && wid == 0 && nts < 64) { const unsigned long long _c = (unsigned long long)clock64(); \
        ts_lo = (lane == nts) ? (int)(unsigned)_c : ts_lo; ts_hi = (lane == nts) ? (int)(unsigned)(_c >> 32) : ts_hi; ++nts; } } while (0)
    PG8_STAMP();
    unsigned voffA[2], voffB[2];
#pragma unroll
    for (int i = 0; i < 2; ++i) { int R, C; stage_rc(tid * 16 + i * 8192, R, C); const int Rb = Epi::PERM ? ((R & ~31) + perm32(R & 31)) : R;
        voffA[i] = (unsigned)(R * K + C) * 2u; voffB[i] = (unsigned)(Rb * K + C) * 2u; }
    const size_t kstep = (size_t)(BK * 2);
    const size_t hstep = (size_t)HALF * K * 2;
    const size_t tstep = 2 * hstep;
    const unsigned ldsw = (unsigned)wid * 1024u;
    const int aoff = lds_byte(wr * 64 + fr, fq * 8), boff = lds_byte(wc * 32 + fr, fq * 8);
#define PG8_SA(b, h) (((b) * 2 + (h)) * HTB)
#define PG8_SB(b, h) ((4 + (b) * 2 + (h)) * HTB)
#define PG8_STAGE(bufoff, gbase, voff) do { _Pragma("unroll") for (int _i = 0; _i < 2; ++_i) \
        __builtin_amdgcn_global_load_lds((const unsigned*)((const char*)(gbase) + (voff)[_i]), (PG8_LAS unsigned*)(lds + (bufoff) + ldsw + _i * 8192), 16, 0, 0); } while (0)
#define PG8_LDA(dst, b, h) do { _Pragma("unroll") for (int m = 0; m < 4; ++m) _Pragma("unroll") for (int k = 0; k < 2; ++k) dst[m][k] = *(const PG8_LAS bf16x8*)(lds + PG8_SA(b, h) + aoff + m * 2048 + k * 1024); } while (0)
#define PG8_LDB(dst, b, h) do { _Pragma("unroll") for (int n = 0; n < 2; ++n) _Pragma("unroll") for (int k = 0; k < 2; ++k) dst[n][k] = *(const PG8_LAS bf16x8*)(lds + PG8_SB(b, h) + boff + n * 2048 + k * 1024); } while (0)
#define PG8_MMA(ai, bj, At, Bt) do { __builtin_amdgcn_s_setprio(1); _Pragma("unroll") for (int m = 0; m < 4; ++m) _Pragma("unroll") for (int n = 0; n < 2; ++n) _Pragma("unroll") for (int k = 0; k < 2; ++k) \
        acc[ai][bj][m][n] = __builtin_amdgcn_mfma_f32_16x16x32_bf16(Bt[n][k], At[m][k], acc[ai][bj][m][n], 0, 0, 0); __builtin_amdgcn_s_setprio(0); } while (0)
#define PG8_WAIT_V(n) asm volatile("s_waitcnt vmcnt(" #n ")" ::: "memory")
#define PG8_WAIT_L(n) asm volatile("s_waitcnt lgkmcnt(" #n ")" ::: "memory")
#define PG8_BAR __builtin_amdgcn_s_barrier()
#define PG8_SCHED __builtin_amdgcn_sched_barrier(0)
    Unit cur, nxt; int ui = 0;
    if (!S.next(0, cur)) return;
    f32x4 acc[2][2][4][2];
#pragma unroll
    for (int a = 0; a < 2; ++a)
#pragma unroll
        for (int b = 0; b < 2; ++b)
#pragma unroll
            for (int m = 0; m < 4; ++m)
#pragma unroll
                for (int n = 0; n < 2; ++n) acc[a][b][m][n] = (f32x4){0.f, 0.f, 0.f, 0.f};
    bf16x8 At[4][2], B0[2][2], B1[2][2];
    const char* cA = (const char*)g.A + (size_t)cur.pm * tstep; const char* cB = (const char*)g.Bt + (size_t)cur.pn * tstep;
    S.a_ready(cur);
    PG8_STAGE(PG8_SB(0, 0), cB, voffB); PG8_STAGE(PG8_SA(0, 0), cA, voffA); PG8_STAGE(PG8_SB(0, 1), cB + hstep, voffB); PG8_STAGE(PG8_SA(0, 1), cA + hstep, voffA);
    if (wr == 1) PG8_BAR;
    PG8_WAIT_V(4); PG8_BAR;
    PG8_STAGE(PG8_SB(1, 0), cB + kstep, voffB); PG8_STAGE(PG8_SA(1, 0), cA + kstep, voffA); PG8_STAGE(PG8_SB(1, 1), cB + hstep + kstep, voffB);
    PG8_WAIT_V(6); PG8_BAR;
    PG8_STAMP();
    for (;;) {
        const bool has_next = S.next(ui + 1, nxt);
        const char* nA = has_next ? (const char*)g.A + (size_t)nxt.pm * tstep : cA; const char* nB = has_next ? (const char*)g.Bt + (size_t)nxt.pn * tstep : cB;
        for (int t = 0; t < nt; t += 2) {
            const bool last = (t == nt - 2);
            const char* a1 = cA + (size_t)(t + 1) * kstep;
            const char* a2 = last ? nA : cA + (size_t)(t + 2) * kstep; const char* b2 = last ? nB : cB + (size_t)(t + 2) * kstep;
            const char* a3 = a2 + kstep; const char* b3 = b2 + kstep;
            if (last && has_next) S.a_ready(nxt);
            PG8_LDB(B0, 0, 0); PG8_SCHED; PG8_LDA(At, 0, 0); PG8_STAGE(PG8_SA(1, 1), a1 + hstep, voffA);
            PG8_WAIT_L(8); PG8_BAR; PG8_WAIT_L(0); PG8_MMA(0, 0, At, B0); PG8_BAR; PG8_SCHED;
            PG8_LDB(B1, 0, 1); PG8_STAGE(PG8_SB(0, 0), b2, voffB);
            PG8_BAR; PG8_WAIT_L(0); PG8_MMA(0, 1, At, B1); PG8_BAR;
            PG8_LDA(At, 0, 1); PG8_STAGE(PG8_SA(0, 0), a2, voffA);
            PG8_BAR; PG8_WAIT_L(0); PG8_MMA(1, 0, At, B0); PG8_BAR; PG8_SCHED;
            PG8_STAGE(PG8_SB(0, 1), b2 + hstep, voffB);
            PG8_WAIT_V(6); PG8_BAR; PG8_MMA(1, 1, At, B1); PG8_BAR;
            PG8_LDB(B0, 1, 0); PG8_SCHED; PG8_LDA(At, 1, 0); PG8_STAGE(PG8_SA(0, 1), a2 + hstep, voffA);
            PG8_WAIT_L(8); PG8_BAR; PG8_WAIT_L(0); PG8_MMA(0, 0, At, B0); PG8_BAR; PG8_SCHED;
            PG8_LDB(B1, 1, 1); PG8_STAGE(PG8_SB(1, 0), b3, voffB);
            PG8_BAR; PG8_WAIT_L(0); PG8_MMA(0, 1, At, B1); PG8_BAR;
            PG8_LDA(At, 1, 1); PG8_STAGE(PG8_SA(1, 0), a3, voffA);
            PG8_BAR; PG8_WAIT_L(0); PG8_MMA(1, 0, At, B0); PG8_BAR; PG8_SCHED;
            PG8_STAGE(PG8_SB(1, 1), b3 + hstep, voffB);
            PG8_WAIT_V(6); PG8_BAR; PG8_MMA(1, 1, At, B1); PG8_BAR;
        }
        PG8_STAMP();
        if constexpr (!Epi::AFTER_DRAIN) { E(acc, cur, wr, wc, fr, fq); S.done(cur); }
        PG8_STAMP();
        if (!has_next) break;
#pragma unroll
        for (int a = 0; a < 2; ++a)
#pragma unroll
            for (int b = 0; b < 2; ++b)
#pragma unroll
                for (int m = 0; m < 4; ++m)
#pragma unroll
                    for (int n = 0; n < 2; ++n) acc[a][b][m][n] = (f32x4){0.f, 0.f, 0.f, 0.f};
        cur = nxt; cA = nA; cB = nB; ++ui;
    }
    PG8_WAIT_V(0);
    if (wr == 0) PG8_BAR;
    PG8_BAR;
    if constexpr (Epi::AFTER_DRAIN) { E.fused(acc, cur, wr, wc, fr, fq, lds, wid, lane); S.done(cur); }
    PG8_STAMP();
    if (STAMP && wid == 0) { stamps[lane] = lane < nts ? (((unsigned long long)(unsigned)ts_hi << 32) | (unsigned)ts_lo) : 0ull;
        if (lane == 62) stamps[62] = rt_entry; if (lane == 63) stamps[63] = (unsigned long long)wall_clock64(); }
#undef PG8_STAMP
#undef PG8_SA
#undef PG8_SB
#undef PG8_STAGE
#undef PG8_LDA
#undef PG8_LDB
#undef PG8_MMA
#undef PG8_WAIT_V
#undef PG8_WAIT_L
#undef PG8_BAR
#undef PG8_SCHED
}
}

template <class F> struct EpiAdapt {
    static constexpr bool PERM = true, AFTER_DRAIN = false;
    F f;
    __device__ __forceinline__ void operator()(const pg8::f32x4 (&acc)[2][2][4][2], const pg8::Unit& u, int wr, int wc, int fr, int fq) const {
        constexpr int B = F::BATCH;
        const int row0 = u.pm * 256 + wr * 64 + fr, col0 = u.pn * 256 + wc * 32 + 8 * fq;
        f32x4 b0[2], b1[2];
        if constexpr (F::COLBIAS) { f.bias8(col0, b0[0], b1[0]); f.bias8(col0 + 128, b0[1], b1[1]); }
#pragma unroll
        for (int q0 = 0; q0 < 16; q0 += B) {
            typename F::Pre pre[B];
#pragma unroll
            for (int i = 0; i < B; ++i) { const int q = q0 + i, bj = q & 1, m = (q >> 1) & 3, ai = q >> 3; pre[i] = f.pre(row0 + ai * 128 + m * 16, col0 + bj * 128); }
#pragma unroll
            for (int i = 0; i < B; ++i) { const int q = q0 + i, bj = q & 1, m = (q >> 1) & 3, ai = q >> 3;
                f32x4 v0 = acc[ai][bj][m][0], v1 = acc[ai][bj][m][1];
                if constexpr (F::COLBIAS) { v0 += b0[bj]; v1 += b1[bj]; }
                f.put(row0 + ai * 128 + m * 16, col0 + bj * 128, v0, v1, pre[i]); }
        }
    }
};
template <class F>
DEVI void gemm_pg8(const bf16_t* A, const bf16_t* Bt, int M, int N, int K, const F& f, char* smem, int bid, int nblk) {
    pg8::Gemm g{A, Bt, M, N, K};
    pg8::StaticOrder S; S.init(M, N, nblk, bid);
    EpiAdapt<F> E{f};
    __syncthreads();
    pg8::gemm_phase<EpiAdapt<F>, pg8::StaticOrder, false>((PG8_LAS unsigned char*)smem, g, S, E, nullptr);
    __syncthreads();
}

template <class F>
DEVI void gemm_small_rows(const bf16_t* __restrict__ A, const bf16_t* __restrict__ Bt, int N, const F& f, char* smem, int bid, int nblk) {
    const int tid = tid_opq(), lane = tid & 63, wid = tid >> 6, fr = lane & 15, fq = lane >> 4;
    float* part = (float*)smem;
    const int ntn = N / 64, ntiles = (NTS / 32) * ntn;
    for (int tile = bid; tile < ntiles; tile += nblk) {
        const int tm = tile / ntn, tn = tile % ntn;
        const int row0 = NTP + tm * 32, col0 = tn * 64;
        f32x4 acc[2][4];
#pragma unroll
        for (int m = 0; m < 2; ++m)
#pragma unroll
            for (int n = 0; n < 4; ++n) acc[m][n] = (f32x4){0.f, 0.f, 0.f, 0.f};
        const bf16_t* ap = A + (size_t)(row0 + fr) * 1024 + wid * 128 + fq * 8;
        const bf16_t* bp = Bt + (size_t)(col0 + fr) * 1024 + wid * 128 + fq * 8;
        bf16x8 af[4][2], bfr[4][4];
#pragma unroll
        for (int ks = 0; ks < 4; ++ks) {
#pragma unroll
            for (int m = 0; m < 2; ++m) af[ks][m] = *(const bf16x8*)(ap + (size_t)m * 16 * 1024 + ks * 32);
#pragma unroll
            for (int n = 0; n < 4; ++n) bfr[ks][n] = *(const bf16x8*)(bp + (size_t)n * 16 * 1024 + ks * 32);
        }
#pragma unroll
        for (int ks = 0; ks < 4; ++ks)
#pragma unroll
            for (int m = 0; m < 2; ++m)
#pragma unroll
                for (int n = 0; n < 4; ++n) acc[m][n] = __builtin_amdgcn_mfma_f32_16x16x32_bf16(bfr[ks][n], af[ks][m], acc[m][n], 0, 0, 0);
        __syncthreads();
#pragma unroll
        for (int m = 0; m < 2; ++m)
#pragma unroll
            for (int n = 0; n < 4; ++n) *(f32x4*)(part + ((size_t)wid * 32 + m * 16 + fr) * 64 + n * 16 + fq * 4) = acc[m][n];
        __syncthreads();
        if (tid < 256) {
            const int r = tid >> 3, c8 = (tid & 7) * 8;
            f32x4 v0 = {0.f, 0.f, 0.f, 0.f}, v1 = v0;
#pragma unroll
            for (int w = 0; w < 8; ++w) { v0 += *(const f32x4*)(part + ((size_t)w * 32 + r) * 64 + c8); v1 += *(const f32x4*)(part + ((size_t)w * 32 + r) * 64 + c8 + 4); }
            const typename F::Pre pre = f.pre(row0 + r, col0 + c8);
            f.put(row0 + r, col0 + c8, v0, v1, pre);
        }
    }
}
template <class F>
DEVI void gemm_tail(const bf16_t* A, const bf16_t* Bt, int N, const F& f, char* smem, int bid, int nblk) {
    gemm_small_rows(A, Bt, N, f, smem, bid, nblk);
    gemm_pg8(A, Bt, NTP, N, 1024, f, smem, bid, nblk);
}

#define XB_TMO      128
#define XB_XCNT(j)  (256  + 64 * (j))
#define XB_XSUB(j)  (1280 + 64 * (j))
#define XB_XGEN(j)  (2304 + 64 * (j))
#define XB_TOP      3328
#define XB_TOPGEN   3392
#define XCD_BAR_WORDS 3456
#define XB_SPIN_CAP (1u << 18)
#define LAS __attribute__((address_space(3)))

__device__ __forceinline__ unsigned xb_ld(unsigned* p)              { return __hip_atomic_load(p, __ATOMIC_RELAXED, __HIP_MEMORY_SCOPE_AGENT); }
__device__ __forceinline__ unsigned xb_add(unsigned* p, unsigned v) { return __hip_atomic_fetch_add(p, v, __ATOMIC_RELAXED, __HIP_MEMORY_SCOPE_AGENT); }
__device__ __forceinline__ unsigned xb_xcc_id() { return (unsigned)__builtin_amdgcn_s_getreg((3 << 11) | 20) & 0xFu; }
#define XB_SPIN(cond, bar) do { unsigned _sp = 0; while (cond) { __builtin_amdgcn_s_sleep(1); \
    if ((++_sp & 255u) == 0u) { if (xb_ld(&(bar)[XB_TMO])) break; if (_sp > XB_SPIN_CAP) { atomicAdd(&(bar)[XB_TMO], 1u); break; } } } } while (0)

struct XcdBarrier {
    unsigned* bar; unsigned x;
    volatile LAS unsigned* st;
};

__device__ __forceinline__ XcdBarrier xcd_barrier_post(unsigned* bar, volatile LAS unsigned* st) {
    XcdBarrier b; b.bar = bar; b.x = xb_xcc_id(); b.st = st;
    if (tid_opq() == 0) (void)xb_add(&bar[XB_XCNT(b.x)], 1u);
    return b;
}
__device__ __forceinline__ void xcd_barrier_complete(unsigned* bar, unsigned x, unsigned& nloc, unsigned& nx) {
    const unsigned G = gridDim.x * gridDim.y * gridDim.z;
    unsigned sum, cnt, mine, sp = 0u;
    for (;;) {
        sum = 0u; cnt = 0u; mine = 0u;
#pragma unroll
        for (unsigned j = 0; j < 16; ++j) { const unsigned c = xb_ld(&bar[XB_XCNT(j)]); sum += c; cnt += (c > 0u) ? 1u : 0u; mine = (j == x) ? c : mine; }
        if (sum == G) break;
        __builtin_amdgcn_s_sleep(1);
        if ((++sp & 255u) == 0u) { if (xb_ld(&bar[XB_TMO])) break; if (sp > XB_SPIN_CAP) { atomicAdd(&bar[XB_TMO], 1u); break; } }
    }
    nloc = mine > 0u ? mine : 1u; nx = cnt > 0u ? cnt : 1u;
}

__device__ __forceinline__ void xcd_barrier(const XcdBarrier& b) {
    asm volatile("s_waitcnt vmcnt(0)" ::: "memory");
    __syncthreads();
    if (tid_opq() == 0) {
        unsigned* bar = b.bar;
        __builtin_amdgcn_s_waitcnt(0);
        unsigned nloc = b.st[0], nx = b.st[1];
        if (nloc == 0u) { xcd_barrier_complete(bar, b.x, nloc, nx); b.st[0] = nloc; b.st[1] = nx; }
        const unsigned old = xb_add(&bar[XB_XSUB(b.x)], 1u);
        const unsigned gen = old / nloc;
        if (old + 1u == (gen + 1u) * nloc) {
            __builtin_amdgcn_fence(__ATOMIC_RELEASE, "agent");
            asm volatile("s_waitcnt vmcnt(0)" ::: "memory");
            const unsigned og = xb_add(&bar[XB_TOP], 1u);
            const unsigned tg = og / nx;
            if (og + 1u == (tg + 1u) * nx) xb_add(&bar[XB_TOPGEN], 1u);
            else XB_SPIN(xb_ld(&bar[XB_TOPGEN]) == tg, bar);
            __builtin_amdgcn_fence(__ATOMIC_ACQUIRE, "agent");
            xb_add(&bar[XB_XGEN(b.x)], 1u);
            asm volatile("s_waitcnt vmcnt(0)" ::: "memory");
        } else {
            XB_SPIN(xb_ld(&bar[XB_XGEN(b.x)]) == gen, bar);
            __builtin_amdgcn_fence(__ATOMIC_ACQUIRE, "agent");
            asm volatile("s_waitcnt vmcnt(0)" ::: "memory");
        }
    }
    __syncthreads();
}

constexpr int LDS_BYTES = 152 * 1024;

template <int S>
DEVI void run_stage(const P& p, char* smem, int bid, int nblk) {
    if (S == 0) stage_prologue(p, smem, bid, nblk);
    if (S == 1) { EpiInProj e{p}; gemm_pg8(p.XB, p.WINT, NT, NPAD_IN + 2048, 1024, e, smem, bid, nblk); }
    if (S == 2) {
        stage2_queue(p, smem);
    }
    if (S == 4) { stage_mlstm_scan(p, bid, nblk); stage_nsa_attn(p, smem, bid, nblk); }
    if (S == 5) { stage_mlstm_out(p, smem, bid, nblk); { EpiM1 e{p}; gemm_tail(p.YB, p.WBT, 1024, e, smem, bid, nblk); } }
    if (S == 6) { EpiM2 e{p}; gemm_tail(p.YA, p.WAT, 1024, e, smem, bid, nblk); }
    if (S == 8) { EpiR e{p}; gemm_tail(p.MERGED, p.WOT, 1024, e, smem, bid, nblk); }
    if (S == 9) stage_ln1(p, bid, nblk);
    if (S == 10) { EpiPQ e{p}; gemm_tail(p.HB, p.WQT, 2048, e, smem, bid, nblk); }
    if (S == 11) {
        if (bid & 1) {
            for (int ps = 0; ps < 4; ++ps) { stage_peer_route(p, smem, bid, nblk, ps, ps + 1); __threadfence_block(); __syncthreads(); stage_peer_apply(p, smem, bid, nblk, ps, ps + 1); __syncthreads(); }
        } else { stage_peer_route(p, smem, bid, nblk, 0, 64); __threadfence_block(); __syncthreads(); stage_peer_apply(p, smem, bid, nblk, 0, 64); }
    }
}
constexpr int NSTAGES = 13;

template <int S>
__global__ void __launch_bounds__(512, 2) k_stage(P p) {
    extern __shared__ __attribute__((aligned(16))) char smem[];
    run_stage<S>(p, smem, blockIdx.x, gridDim.x);
}


#if MK_ONE_LAUNCH
__global__ void __launch_bounds__(512, 2) k_mega(P p) {
    extern __shared__ __attribute__((aligned(16))) char smem_all[];
    if (tid_opq() == 0) *(u32x4*)smem_all = (u32x4){0u, 0u, 0u, 0u};
    __syncthreads();
    XcdBarrier bar = xcd_barrier_post(p.bar, (volatile LAS unsigned*)smem_all);
    char* smem = smem_all + 16;
    const int bid = blockIdx.x, nblk = gridDim.x;
    run_stage<0>(p, smem, bid, nblk); if ((REP_MASK >> 0) & 1) { xcd_barrier(bar); run_stage<0>(p, smem, bid, nblk); }  xcd_barrier(bar);
    run_stage<1>(p, smem, bid, nblk); if ((REP_MASK >> 1) & 1) { xcd_barrier(bar); run_stage<1>(p, smem, bid, nblk); }  xcd_barrier(bar);
    run_stage<2>(p, smem, bid, nblk); if ((REP_MASK >> 2) & 1) { xcd_barrier(bar); run_stage<2>(p, smem, bid, nblk); }  xcd_barrier(bar);
    run_stage<4>(p, smem, bid, nblk); if ((REP_MASK >> 4) & 1) { xcd_barrier(bar); run_stage<4>(p, smem, bid, nblk); }  xcd_barrier(bar);
    run_stage<5>(p, smem, bid, nblk); if ((REP_MASK >> 5) & 1) { xcd_barrier(bar); run_stage<5>(p, smem, bid, nblk); }  xcd_barrier(bar);
    run_stage<6>(p, smem, bid, nblk); if ((REP_MASK >> 6) & 1) { xcd_barrier(bar); run_stage<6>(p, smem, bid, nblk); }  xcd_barrier(bar);
    run_stage<8>(p, smem, bid, nblk); if ((REP_MASK >> 8) & 1) { xcd_barrier(bar); run_stage<8>(p, smem, bid, nblk); }  xcd_barrier(bar);
    run_stage<9>(p, smem, bid, nblk); if ((REP_MASK >> 9) & 1) { xcd_barrier(bar); run_stage<9>(p, smem, bid, nblk); }  xcd_barrier(bar);
    run_stage<10>(p, smem, bid, nblk); if ((REP_MASK >> 10) & 1) { xcd_barrier(bar); run_stage<10>(p, smem, bid, nblk); } xcd_barrier(bar);
    run_stage<11>(p, smem, bid, nblk); if ((REP_MASK >> 11) & 1) { xcd_barrier(bar); run_stage<11>(p, smem, bid, nblk); }
}
#endif

template <int S> static void launch_stage(const P& p, int grid, hipStream_t stream) {
    (void)hipFuncSetAttribute((const void*)k_stage<S>, hipFuncAttributeMaxDynamicSharedMemorySize, LDS_BYTES);
    k_stage<S><<<dim3(grid), dim3(512), LDS_BYTES, stream>>>(p);
}

extern "C" void kernel_launch(void* const* d_in, const int* in_sizes, int n_in, void* d_out, int out_size, void* d_ws, size_t ws_size, hipStream_t stream) {
    (void)in_sizes; (void)n_in; (void)out_size; (void)ws_size;
    P p{};
    p.xp = (const float*)d_in[0]; p.xs = (const float*)d_in[1]; p.cache_cmp = (const float*)d_in[2]; p.cache_slc = (const float*)d_in[3];
    p.cache_win = (const float*)d_in[4]; p.state_C = (const float*)d_in[5]; p.state_n = (const float*)d_in[6]; p.state_m = (const float*)d_in[7];
    p.page_table = (const int*)d_in[8];
    p.w_in = (const float*)d_in[9]; p.b_in = (const float*)d_in[10]; p.norm_a_g = (const float*)d_in[11]; p.nsa_pe = (const float*)d_in[12];
    p.nsa_w_cmp = (const float*)d_in[13]; p.w_br_a = (const float*)d_in[14]; p.w_br_b = (const float*)d_in[15]; p.w_merge = (const float*)d_in[16];
    p.w_out = (const float*)d_in[17]; p.ln1_g = (const float*)d_in[18]; p.ln1_b = (const float*)d_in[19];
    p.peer_wq = (const float*)d_in[20]; p.peer_keys = (const float*)d_in[21]; p.peer_u = (const float*)d_in[22]; p.peer_v = (const float*)d_in[23];
    p.ln2_g = (const float*)d_in[24]; p.ln2_b = (const float*)d_in[25];
    p.out = (float*)d_out;
    char* w = (char*)d_ws; size_t off = 0;
    auto take = [&](size_t bytes) { char* r = w + off; off += (bytes + 255) & ~(size_t)255; return r; };
    p.bar = (unsigned*)take(16384);
    p.PW = (float*)(p.bar + 3584);
    p.WCT = (bf16_t*)take((size_t)2 * 64 * 4096 * 2);
    p.XB = (bf16_t*)take((size_t)NT * 1024 * 2);
    p.WINT = (bf16_t*)take((size_t)(NPAD_IN + 2048) * 1024 * 2);
    p.WMT = (bf16_t*)take((size_t)2048 * 1024 * 2);
    p.WAT = (bf16_t*)take((size_t)1024 * 1024 * 2);
    p.WBT = (bf16_t*)take((size_t)1024 * 1024 * 2);
    p.WOT = (bf16_t*)take((size_t)1024 * 1024 * 2);
    p.WQT = (bf16_t*)take((size_t)2048 * 1024 * 2);
    p.KEYSB = (bf16_t*)take((size_t)16 * 128 * 128 * 2);
    p.U8 = (unsigned char*)take((size_t)16384 * 768 + 256);
    p.V8 = (unsigned char*)take((size_t)16384 * 1024 + 256);
    p.US = (float*)take(16384 * 4);
    p.VS = (float*)take(16384 * 4);
    p.PROJ = (bf16_t*)take((size_t)NT * PS * 2);
    p.SM = (float*)take((size_t)NT * 64 * 4);
    p.BCUM = (float*)take((size_t)16 * 4096 * 4);
    p.MPREV = (float*)take(4096); p.ACOEF = (float*)take(4096); p.SCL = (float*)take(4096); p.MLOC = (float*)take(4096);
    p.DC = (float*)take((size_t)1024 * 272 * 128 * 4);
    p.CPT = (bf16_t*)take((size_t)1024 * 272 * 128 * 2);
    p.KC = (float*)take((size_t)4352 * 512 * 4);
    p.VC = p.KC + 256;
    p.OCMP = (float*)take((size_t)NT * 1024 * 4);
    p.SEL = (unsigned long long*)take((size_t)NT * 4 * 8);
    p.YA = (bf16_t*)take((size_t)NT * 1024 * 2);
    p.YB = (bf16_t*)take((size_t)NT * 1024 * 2);
    p.G = (bf16_t*)take((size_t)NT * 2048 * 2);
    p.TMPB = (bf16_t*)take((size_t)NT * 1024 * 2);
    p.MERGED = (bf16_t*)take((size_t)NT * 1024 * 2);
    p.R = (float*)take((size_t)NT * 1024 * 4);
    p.H = (float*)take((size_t)NT * 1024 * 4);
    p.HB = (bf16_t*)take((size_t)NT * 1024 * 2);
    p.PQ = (bf16_t*)take((size_t)NT * 2048 * 2);
    p.EIDX = (int*)take((size_t)NT * 128 * 4);
    p.EGATE = (float*)take((size_t)NT * 128 * 4);

    (void)hipMemsetAsync(p.bar, 0, 16384, stream);
#if MK_ONE_LAUNCH
    {
        constexpr size_t kDynLds = LDS_BYTES + 16;
        (void)hipFuncSetAttribute((const void*)k_mega, hipFuncAttributeMaxDynamicSharedMemorySize, (int)kDynLds);
        int dev = 0, cus = 0, per_cu = 0;
        (void)hipGetDevice(&dev);
        (void)hipDeviceGetAttribute(&cus, hipDeviceAttributeMultiprocessorCount, dev);
        (void)hipOccupancyMaxActiveBlocksPerMultiprocessor(&per_cu, (const void*)k_mega, 512, kDynLds);
        if (per_cu < 1 || cus < 1) return;
        const int grid = cus;
        k_mega<<<dim3(grid), dim3(512), kDynLds, stream>>>(p);
    }
#else
    const int grid = 512;
    launch_stage<0>(p, grid, stream);
    launch_stage<1>(p, grid, stream);
    launch_stage<2>(p, grid, stream);
    launch_stage<4>(p, grid, stream);
    launch_stage<5>(p, grid, stream);
    launch_stage<6>(p, grid, stream);
    launch_stage<8>(p, grid, stream);
    launch_stage<9>(p, grid, stream);
    launch_stage<10>(p, grid, stream);
    launch_stage<11>(p, grid, stream);
#endif
}
```

```cpp
#include <hip/hip_runtime.h>
#include <stdint.h>

#ifndef REP_MASK
#define REP_MASK 0
#endif
#ifndef MK_ONE_LAUNCH
#define MK_ONE_LAUNCH 1
#endif

typedef unsigned short bf16_t;
typedef short bf16x8 __attribute__((ext_vector_type(8)));
typedef float f32x4 __attribute__((ext_vector_type(4)));
typedef unsigned u32x4 __attribute__((ext_vector_type(4)));
#define V_FP6 1
typedef int i32x8 __attribute__((ext_vector_type(8)));
typedef int i32x6 __attribute__((ext_vector_type(6)));
typedef float f32x32 __attribute__((ext_vector_type(32)));
struct __attribute__((packed, aligned(4))) U3 { unsigned a, b, c; };
typedef unsigned u32x2 __attribute__((ext_vector_type(2)));
typedef float f32x2 __attribute__((ext_vector_type(2)));
typedef __bf16 bf16x2_t __attribute__((ext_vector_type(2)));
#define DEVI __device__ __forceinline__
__device__ __forceinline__ int tid_opq() { int t = threadIdx.x; asm volatile("" : "+v"(t)); return t; }

constexpr int NTP = 16384, NTS = 512, NT = NTP + NTS, DM = 1024;
constexpr int PS = 5632;
constexpr int C_AQ = 0, C_AK = 512, C_AV = 1024, C_AO = 2048, C_BQ = 3072, C_CMP = 4096, C_SLC = 4608, C_WIN = 5120;
constexpr int NPAD_IN = 5888;
constexpr float DN_ALPHA = 1.189207115002721f;
constexpr float LN_EPS = 1e-5f;
constexpr size_t O_Y = 0;
constexpr size_t O_PCMP = O_Y + (size_t)NT * 1024;
constexpr size_t O_PSLC = O_PCMP + (size_t)NTP * 512;
constexpr size_t O_PWIN = O_PSLC + (size_t)NTP * 512;
constexpr size_t O_PC = O_PWIN + (size_t)4 * 512 * 512;
constexpr size_t O_PN = O_PC + (size_t)16 * 128 * 256;
constexpr size_t O_PM = O_PN + 16 * 128;
constexpr size_t O_SCMP = O_PM + 16;
constexpr size_t O_SSLC = O_SCMP + (size_t)NTS * 512;
constexpr size_t O_SWIN = O_SSLC + (size_t)NTS * 512;
constexpr size_t O_SC = O_SWIN + (size_t)128 * 512 * 512;
constexpr size_t O_SN = O_SC + (size_t)512 * 128 * 256;
constexpr size_t O_SM = O_SN + 512 * 128;

struct P {
    const float *xp, *xs, *cache_cmp, *cache_slc, *cache_win, *state_C, *state_n, *state_m;
    const int* page_table;
    const float *w_in, *b_in, *norm_a_g, *nsa_pe, *nsa_w_cmp, *w_br_a, *w_br_b, *w_merge, *w_out, *ln1_g, *ln1_b;
    const float *peer_wq, *peer_keys, *peer_u, *peer_v, *ln2_g, *ln2_b;
    float* out;
    bf16_t *XB, *WINT, *WMT, *WAT, *WBT, *WOT, *WQT, *KEYSB, *UB, *VB, *PROJ, *WCT;
    float* PW;
    float *SM, *BCUM, *MPREV, *ACOEF, *SCL, *MLOC, *DC, *KC, *VC, *OCMP;
    bf16_t* CPT;
    unsigned char *U8, *V8;
    float *US, *VS;
    unsigned long long* SEL;
    bf16_t *YA, *YB, *G, *MERGED, *HB, *PQ;
    float *R, *H, *EGATE;
    bf16_t* TMPB;
    int* EIDX;
    unsigned* bar;
};

DEVI bf16_t f2bf(float f) { return __builtin_bit_cast(unsigned short, (__bf16)f); }
DEVI float bf2f(bf16_t h) { return __uint_as_float(((unsigned)h) << 16); }
DEVI unsigned pack2(float a, float b) { return __builtin_bit_cast(unsigned, __builtin_convertvector((f32x2){a, b}, bf16x2_t)); }
DEVI u32x4 pack8f(const f32x4 a, const f32x4 b) { u32x4 r; r[0] = pack2(a[0], a[1]); r[1] = pack2(a[2], a[3]); r[2] = pack2(b[0], b[1]); r[3] = pack2(b[2], b[3]); return r; }
DEVI void ce_desc(unsigned& a, unsigned& b) { const unsigned hi = a > b ? a : b, lo = a > b ? b : a; a = hi; b = lo; }
template <int BASE> DEVI void sort16_desc(unsigned (&x)[64]) {
#pragma unroll
    for (int k = 2; k <= 16; k <<= 1)
#pragma unroll
        for (int j = k >> 1; j > 0; j >>= 1)
#pragma unroll
            for (int i = 0; i < 16; ++i) {
                const int l = i ^ j;
                if (l > i) { if ((i & k) == 0) ce_desc(x[BASE + i], x[BASE + l]); else ce_desc(x[BASE + l], x[BASE + i]); }
            }
}
DEVI void merge_top16(const unsigned* a, const unsigned* b, unsigned* t) {
    unsigned c[16];
#pragma unroll
    for (int i = 0; i < 16; ++i) c[i] = a[i] > b[15 - i] ? a[i] : b[15 - i];
#pragma unroll
    for (int j = 8; j > 0; j >>= 1)
#pragma unroll
        for (int i = 0; i < 16; ++i) { const int l = i ^ j; if (l > i) ce_desc(c[i], c[l]); }
#pragma unroll
    for (int i = 0; i < 16; ++i) t[i] = c[i];
}
DEVI float gelu_erf(float v) {
    const float av = fabsf(v), t = __builtin_amdgcn_rcpf(fmaf(av, 0.2316418882f, 1.0f));
    float q = fmaf(t, 0.5307027145f, -0.7265760135f); q = fmaf(q, t, 0.7107068705f); q = fmaf(q, t, -0.142248368f); q = fmaf(q, t, 0.127414796f); q = q * t;
    const float e = __builtin_amdgcn_exp2f(v * v * -0.72134752044f);
    const float mm = v * (q * e);
    return v < 0.f ? mm : v - mm;
}
DEVI float wave_max(float v) { for (int o = 32; o > 0; o >>= 1) v = fmaxf(v, __shfl_xor(v, o)); return v; }
DEVI float wave_sum(float v) { for (int o = 32; o > 0; o >>= 1) v += __shfl_xor(v, o); return v; }
DEVI float sigmoidf_(float x) { return __builtin_amdgcn_rcpf(1.f + __expf(-x)); }
DEVI float logsigmoidf_(float x) { return fminf(x, 0.f) - log1pf(__expf(-fabsf(x))); }
DEVI int win_map(int np) {
    if (np < 2048) return np;
    if (np < 5632) return np + 8;
    if (np < 5640) return np - 5632 + 2048;
    if (np < 5688) return np;
    return -1;
}
DEVI float alibi_slope(int h) { return exp2f(-0.5f * (float)(h + 1)); }

template <class MapFn>
DEVI void transpose_cvt(const float* __restrict__ W, bf16_t* __restrict__ WT, int K, int Nsrc, int Ndst, MapFn mapfn, float* tile  , int bid, int nblk) {
    const int tid = tid_opq();
    const int tn = Ndst / 64, tk = K / 64;
    for (int t = bid; t < tn * tk; t += nblk) {
        const int n0 = (t % tn) * 64, k0 = (t / tn) * 64;
        __syncthreads();
#pragma unroll
        for (int i = 0; i < 8; ++i) {
            const int kk = (tid >> 6) + i * 8, nn = tid & 63;
            const int n = mapfn(n0 + nn);
            tile[kk * 65 + nn] = n >= 0 ? W[(size_t)(k0 + kk) * Nsrc + n] : 0.f;
        }
        __syncthreads();
#pragma unroll
        for (int i = 0; i < 8; ++i) {
            const int nn = (tid >> 6) + i * 8, kk = tid & 63;
            WT[(size_t)(n0 + nn) * K + k0 + kk] = f2bf(tile[kk * 65 + nn]);
        }
    }
}
struct IdMap { DEVI int operator()(int n) const { return n; } };
struct WinMap { DEVI int operator()(int n) const { return win_map(n); } };

DEVI void cvt_rows(const float* __restrict__ src, bf16_t* __restrict__ dst, size_t n4, int bid, int nblk) {
    const size_t stride = (size_t)nblk * 512;
    for (size_t i0 = (size_t)bid * 512 + tid_opq(); i0 < n4; i0 += stride * 8) {
        f32x4 v[8];
#pragma unroll
        for (int u = 0; u < 8; ++u) { const size_t i = i0 + u * stride; v[u] = i < n4 ? __builtin_nontemporal_load((const f32x4*)src + i) : (f32x4){0.f, 0.f, 0.f, 0.f}; }
#pragma unroll
        for (int u = 0; u < 8; ++u) { const size_t i = i0 + u * stride; if (i < n4) { u32x2 o; o.x = pack2(v[u][0], v[u][1]); o.y = pack2(v[u][2], v[u][3]); ((u32x2*)dst)[i] = o; } }
    }
}

DEVI unsigned q_e2m3(float x) {
    const float a = fabsf(x);
    const float c = a < 2.f ? rintf(a * 8.f) : a < 4.f ? 16.f + rintf((a - 2.f) * 4.f) : fminf(31.f, 24.f + rintf((a - 4.f) * 2.f));
    return (unsigned)c | (x < 0.f ? 32u : 0u);
}

DEVI void stage_prologue(const P& p, char* smem, int bid, int nblk) {
    float* tile = (float*)smem;
    cvt_rows(p.xp, p.XB, (size_t)NTP * 256, bid, nblk);
    cvt_rows(p.xs, p.XB + (size_t)NTP * 1024, (size_t)NTS * 256, bid, nblk);
    {
        const int lane = tid_opq() & 63, wid = tid_opq() >> 6;
        for (int r0 = bid * 8 + wid; r0 < 2 * 16384; r0 += nblk * 8 * 2) {
            f32x4 x[2][4]; float am[2] = {0.f, 0.f};
#pragma unroll
            for (int j = 0; j < 2; ++j) {
                const int r = r0 + j * nblk * 8;
                if (r < 2 * 16384) {
                    const bool isv = r >= 16384; const int e = isv ? r - 16384 : r;
                    const float* src = (isv ? p.peer_v : p.peer_u) + (size_t)e * 1024 + lane * 16;
#pragma unroll
                    for (int i = 0; i < 4; ++i) x[j][i] = __builtin_nontemporal_load((const f32x4*)(src + i * 4));
                }
            }
#pragma unroll
            for (int j = 0; j < 2; ++j) {
                const int r = r0 + j * nblk * 8;
                if (r < 2 * 16384) {
                    const bool isv = r >= 16384; const int e = isv ? r - 16384 : r;
#pragma unroll
                    for (int i = 0; i < 4; ++i)
#pragma unroll
                        for (int k = 0; k < 4; ++k) am[j] = fmaxf(am[j], fabsf(x[j][i][k]));
                    const float amx = wave_max(am[j]);
#if !V_FP6
                    if (isv) {
                        const float inv8 = amx > 0.f ? 448.f / amx : 1.f;
                        u32x4 o;
#pragma unroll
                        for (int i = 0; i < 4; ++i) { int w = __builtin_amdgcn_cvt_pk_fp8_f32(x[j][i][0] * inv8, x[j][i][1] * inv8, 0, false); w = __builtin_amdgcn_cvt_pk_fp8_f32(x[j][i][2] * inv8, x[j][i][3] * inv8, w, true); o[i] = (unsigned)w; }
                        *(u32x4*)(p.V8 + (size_t)e * 1024 + lane * 16) = o;
                        if (lane == 0) p.VS[e] = amx > 0.f ? amx / 448.f : 1.f;
                        continue;
                    }
#endif
                    const float inv = amx > 0.f ? 7.5f / amx : 1.f;
                    unsigned long long lo = 0ull, hi = 0ull;
#pragma unroll
                    for (int i = 0; i < 16; ++i) {
                        const unsigned long long c = (unsigned long long)q_e2m3(x[j][i >> 2][i & 3] * inv);
                        if (i < 10) lo |= c << (6 * i);
                        else if (i == 10) { lo |= c << 60; hi |= c >> 4; }
                        else hi |= c << (6 * i - 64);
                    }
                    const unsigned w0 = (unsigned)lo, w1 = (unsigned)(lo >> 32), w2 = (unsigned)hi;
                    { unsigned* d = (unsigned*)((isv ? p.V8 : p.U8) + (size_t)e * 768 + lane * 12); d[0] = w0; d[1] = w1; d[2] = w2; }
                    if (lane == 0) (isv ? p.VS : p.US)[e] = amx > 0.f ? amx / 7.5f : 1.f;
                }
            }
        }
    }
    cvt_rows(p.peer_keys, p.KEYSB, (size_t)16 * 128 * 128 / 4, bid, nblk);
    transpose_cvt(p.w_in, p.WINT, 1024, 5688, NPAD_IN, WinMap(), tile, bid, nblk);
    transpose_cvt(p.w_merge, p.WINT + (size_t)NPAD_IN * 1024, 1024, 2048, 2048, IdMap(), tile, bid, nblk);
    transpose_cvt(p.w_br_a, p.WAT, 1024, 1024, 1024, IdMap(), tile, bid, nblk);
    transpose_cvt(p.w_br_b, p.WBT, 1024, 1024, 1024, IdMap(), tile, bid, nblk);
    transpose_cvt(p.w_out, p.WOT, 1024, 1024, 1024, IdMap(), tile, bid, nblk);
    transpose_cvt(p.peer_wq, p.WQT, 1024, 2048, 2048, IdMap(), tile, bid, nblk);
    transpose_cvt(p.nsa_w_cmp, p.WCT, 4096, 64, 64, IdMap(), tile, bid, nblk);
    transpose_cvt(p.nsa_w_cmp + 4096 * 64, p.WCT + 64 * 4096, 4096, 64, 64, IdMap(), tile, bid, nblk);
    for (int blk = bid; blk < 32; blk += nblk) {
        const int tid = tid_opq(), kvv = tid >> 8, e = tid & 63, kq = (tid >> 6) & 3;
        float a = 0.f;
        for (int k = blk * 128 + kq * 32; k < blk * 128 + kq * 32 + 32; ++k) a += p.nsa_pe[kvv * 4096 + k] * p.nsa_w_cmp[((size_t)kvv * 4096 + k) * 64 + e];
        atomicAdd(p.PW + kvv * 64 + e, a);
    }
    {
        const size_t per_b = (size_t)508 * 512 / 4;
        const size_t stride = (size_t)nblk * 512, ntot = 128 * per_b;
        for (size_t i0 = (size_t)bid * 512 + tid_opq(); i0 < ntot; i0 += stride * 8) {
            f32x4 v[8];
#pragma unroll
            for (int u = 0; u < 8; ++u) { const size_t i = i0 + u * stride; if (i < ntot) { const size_t b = i / per_b, r = i % per_b; v[u] = __builtin_nontemporal_load((const f32x4*)(p.cache_win + b * 512 * 512 + 4 * 512) + r); } }
#pragma unroll
            for (int u = 0; u < 8; ++u) { const size_t i = i0 + u * stride; if (i < ntot) { const size_t b = i / per_b, r = i % per_b; __builtin_nontemporal_store(v[u], (f32x4*)(p.out + O_SWIN + b * 512 * 512) + r); } }
        }
    }
}

struct NoPre {};
DEVI f32x4 bf4_lo(const u32x4& g) { return (f32x4){__uint_as_float(g[0] << 16), __uint_as_float(g[0] & 0xFFFF0000u), __uint_as_float(g[1] << 16), __uint_as_float(g[1] & 0xFFFF0000u)}; }
DEVI f32x4 bf4_hi(const u32x4& g) { return (f32x4){__uint_as_float(g[2] << 16), __uint_as_float(g[2] & 0xFFFF0000u), __uint_as_float(g[3] << 16), __uint_as_float(g[3] & 0xFFFF0000u)}; }
struct EpiInProj {
    P p;
    typedef NoPre Pre;
    static constexpr int BATCH = 4;
    static constexpr bool COLBIAS = true;
    DEVI void bias8(int col, f32x4& b0, f32x4& b1) const {
        b0 = (f32x4){0.f, 0.f, 0.f, 0.f}; b1 = b0;
        if (col < 5688) { const int oc = win_map(col);
#pragma unroll
            for (int q = 0; q < 4; ++q) { b0[q] = p.b_in[oc + q]; b1[q] = p.b_in[oc + 4 + q]; } }
    }
    DEVI Pre pre(int, int) const { return NoPre(); }
    DEVI void put(int row, int col, f32x4 v0, f32x4 v1, const Pre&) const {
        if (col >= NPAD_IN) {
#pragma unroll
            for (int k = 0; k < 4; ++k) { v0[k] = sigmoidf_(v0[k]); v1[k] = sigmoidf_(v1[k]); }
            *(u32x4*)(p.G + (size_t)row * 2048 + (col - NPAD_IN)) = pack8f(v0, v1);
            return;
        }
        if (col >= 5688) return;
        if (col >= 5632) { *(f32x4*)(p.SM + (size_t)row * 64 + (col - 5632)) = v0; *(f32x4*)(p.SM + (size_t)row * 64 + (col - 5632) + 4) = v1; return; }
        if (col >= C_AK && col < C_AV) { v0 *= 0.08838834764831845f; v1 *= 0.08838834764831845f; }
        *(u32x4*)(p.PROJ + (size_t)row * PS + col) = pack8f(v0, v1);
        if (col >= C_CMP) {
            const int reg = (col - C_CMP) >> 9, c = (col - C_CMP) & 511;
            float* dst = nullptr;
            if (row < NTP) {
                if (reg == 0) dst = p.out + O_PCMP + (size_t)row * 512 + c;
                else if (reg == 1) dst = p.out + O_PSLC + (size_t)row * 512 + c;
                else { const int b = row >> 12, t = row & 4095; if (t >= 3584) dst = p.out + O_PWIN + ((size_t)b * 512 + (t - 3584)) * 512 + c; }
            } else {
                const int rs = row - NTP;
                if (reg == 0) dst = p.out + O_SCMP + (size_t)rs * 512 + c;
                else if (reg == 1) dst = p.out + O_SSLC + (size_t)rs * 512 + c;
                else { const int b = rs >> 2, tq = rs & 3; dst = p.out + O_SWIN + ((size_t)b * 512 + 508 + tq) * 512 + c; }
            }
            if (dst) { *(f32x4*)dst = v0; *(f32x4*)(dst + 4) = v1; }
        }
    }
};
struct EpiG {
    P p;
    typedef NoPre Pre;
    static constexpr int BATCH = 4;
    static constexpr bool COLBIAS = false;
    DEVI Pre pre(int, int) const { return NoPre(); }
    DEVI void put(int row, int col, f32x4 v0, f32x4 v1, const Pre&) const {
#pragma unroll
        for (int k = 0; k < 4; ++k) { v0[k] = sigmoidf_(v0[k]); v1[k] = sigmoidf_(v1[k]); }
        *(u32x4*)(p.G + (size_t)row * 2048 + col) = pack8f(v0, v1);
    }
};
struct EpiM1 {
    P p;
    typedef u32x4 Pre;
    static constexpr int BATCH = 8;
    static constexpr bool COLBIAS = false;
    DEVI Pre pre(int row, int col) const { return *(const u32x4*)(p.G + (size_t)row * 2048 + 1024 + col); }
    DEVI void put(int row, int col, f32x4 v0, f32x4 v1, const Pre& g) const {
        *(u32x4*)(p.TMPB + (size_t)row * 1024 + col) = pack8f(v0 * bf4_lo(g), v1 * bf4_hi(g));
    }
};
struct PreM2 { u32x4 g; u32x4 t; };
struct EpiM2 {
    P p;
    typedef PreM2 Pre;
    static constexpr int BATCH = 8;
    static constexpr bool COLBIAS = false;
    DEVI Pre pre(int row, int col) const { PreM2 r; r.g = *(const u32x4*)(p.G + (size_t)row * 2048 + col); r.t = *(const u32x4*)(p.TMPB + (size_t)row * 1024 + col); return r; }
    DEVI void put(int row, int col, f32x4 v0, f32x4 v1, const Pre& q) const {
        *(u32x4*)(p.MERGED + (size_t)row * 1024 + col) = pack8f(bf4_lo(q.t) + v0 * bf4_lo(q.g), bf4_hi(q.t) + v1 * bf4_hi(q.g));
    }
};
struct PreR { f32x4 a, b; };
struct EpiR {
    P p;
    typedef PreR Pre;
    static constexpr int BATCH = 8;
    static constexpr bool COLBIAS = false;
    DEVI Pre pre(int row, int col) const {
        const float* xr = row < NTP ? p.xp + (size_t)row * 1024 : p.xs + (size_t)(row - NTP) * 1024;
        PreR r; r.a = *(const f32x4*)(xr + col); r.b = *(const f32x4*)(xr + col + 4); return r;
    }
    DEVI void put(int row, int col, f32x4 v0, f32x4 v1, const Pre& x) const {
        *(f32x4*)(p.R + (size_t)row * 1024 + col) = x.a * DN_ALPHA + v0; *(f32x4*)(p.R + (size_t)row * 1024 + col + 4) = x.b * DN_ALPHA + v1;
    }
};
struct EpiPQ {
    P p;
    typedef NoPre Pre;
    static constexpr int BATCH = 4;
    static constexpr bool COLBIAS = false;
    DEVI Pre pre(int, int) const { return NoPre(); }
    DEVI void put(int row, int col, f32x4 v0, f32x4 v1, const Pre&) const { *(u32x4*)(p.PQ + (size_t)row * 2048 + col) = pack8f(v0, v1); }
};

DEVI void stage_mlstm_gates(const P& p, char* smem, int bid, int nblk) {
    const int lane = tid_opq() & 63, wid = tid_opq() >> 6;
    float* bend_s = (float*)smem; float* mloc_s = bend_s + 64;
    for (int bh = bid; bh < 16; bh += nblk) {
        const int b = bh >> 2, h = bh & 3;
        __syncthreads();
        for (int cc = 0; cc < 8; ++cc) {
            const int c = wid * 8 + cc;
            const size_t row = (size_t)b * 4096 + c * 64 + lane;
            const float ip = p.SM[row * 64 + h];
            const float lf = logsigmoidf_(p.SM[row * 64 + 4 + h]);
            float cs = lf;
#pragma unroll
            for (int o = 1; o < 64; o <<= 1) { const float t = __shfl_up(cs, o); if (lane >= o) cs += t; }
            p.BCUM[bh * 4096 + c * 64 + lane] = cs;
            const float bend = __shfl(cs, 63);
            const float mloc = wave_max(bend - cs + ip);
            if (lane == 0) { bend_s[c] = bend; mloc_s[c] = mloc; }
        }
        __syncthreads();
        if (tid_opq() == 0) {
            float m = 0.f;
            for (int c = 0; c < 64; ++c) {
                const float bend = bend_s[c], mloc = mloc_s[c];
                const float mnew = fmaxf(bend + m, mloc);
                p.MPREV[bh * 64 + c] = m;
                p.ACOEF[bh * 64 + c] = __expf(bend + m - mnew);
                p.SCL[bh * 64 + c] = __expf(mloc - mnew);
                p.MLOC[bh * 64 + c] = mloc;
                m = mnew;
            }
            p.out[O_PM + bh] = m;
        }
    }
}

constexpr int MD_KT = 0, MD_VT = 128 * 144, MD_WS = MD_VT + 272 * 144, MD_LDS = MD_WS + 256;
DEVI void stage_mlstm_dc(const P& p, char* smem, int bid, int nblk) {
    const int tid = tid_opq(), lane = tid & 63, wid = tid >> 6, fr = lane & 15, fq = lane >> 4;
    bf16_t* Kt = (bf16_t*)(smem + MD_KT);
    bf16_t* Vt = (bf16_t*)(smem + MD_VT);
    float* ws = (float*)(smem + MD_WS);
    for (int task = bid; task < 1024; task += nblk) {
        const int bh = task >> 6, c = task & 63, b = bh >> 2, h = bh & 3;
        const size_t row0 = (size_t)b * 4096 + c * 64;
        __syncthreads();
        if (tid < 64) {
            const float ip = p.SM[(row0 + tid) * 64 + h];
            float cs = logsigmoidf_(p.SM[(row0 + tid) * 64 + 4 + h]);
#pragma unroll
            for (int o = 1; o < 64; o <<= 1) { const float t = __shfl_up(cs, o); if (tid >= o) cs += t; }
            const float g = __shfl(cs, 63) - cs + ip;
            ws[tid] = __expf(g - wave_max(g));
        }
        __syncthreads();
        {
            const int sidx = tid & 63, ch = tid >> 6;
            const float w = ws[sidx];
#pragma unroll
            for (int half = 0; half < 2; ++half) {
                const u32x4 kk = *(const u32x4*)(p.PROJ + (row0 + sidx) * PS + C_AK + h * 128 + half * 64 + ch * 8);
#pragma unroll
                for (int e = 0; e < 4; ++e) {
                    Kt[(half * 64 + ch * 8 + e * 2) * 72 + sidx] = f2bf(w * __uint_as_float(kk[e] << 16));
                    Kt[(half * 64 + ch * 8 + e * 2 + 1) * 72 + sidx] = f2bf(w * __uint_as_float(kk[e] & 0xFFFF0000u));
                }
            }
#pragma unroll
            for (int q4 = 0; q4 < 4; ++q4) {
                const u32x4 vv = *(const u32x4*)(p.PROJ + (row0 + sidx) * PS + C_AV + h * 256 + q4 * 64 + ch * 8);
#pragma unroll
                for (int e = 0; e < 4; ++e) {
                    Vt[(q4 * 64 + ch * 8 + e * 2) * 72 + sidx] = (bf16_t)(vv[e] & 0xFFFFu);
                    Vt[(q4 * 64 + ch * 8 + e * 2 + 1) * 72 + sidx] = (bf16_t)(vv[e] >> 16);
                }
            }
            for (int i = tid; i < 16 * 64; i += 512) Vt[(256 + (i >> 6)) * 72 + (i & 63)] = (i >> 6) == 0 ? (bf16_t)0x3F80 : (bf16_t)0;
        }
        __syncthreads();
        const int nvt = wid == 0 ? 3 : 2;
        for (int vi = 0; vi < nvt; ++vi) {
            const int vt = vi < 2 ? wid * 2 + vi : 16;
            f32x4 acc[8];
#pragma unroll
            for (int dt = 0; dt < 8; ++dt) acc[dt] = (f32x4){0.f, 0.f, 0.f, 0.f};
#pragma unroll
            for (int ks = 0; ks < 2; ++ks) {
                const bf16x8 bf = *(const bf16x8*)(Vt + (vt * 16 + fr) * 72 + ks * 32 + fq * 8);
#pragma unroll
                for (int dt = 0; dt < 8; ++dt) {
                    const bf16x8 af = *(const bf16x8*)(Kt + (dt * 16 + fr) * 72 + ks * 32 + fq * 8);
                    acc[dt] = __builtin_amdgcn_mfma_f32_16x16x32_bf16(af, bf, acc[dt], 0, 0, 0);
                }
            }
            const int v = vt * 16 + fr;
            if (v <= 256) {
#pragma unroll
                for (int dt = 0; dt < 8; ++dt) *(f32x4*)(p.DC + ((size_t)task * 272 + v) * 128 + dt * 16 + fq * 4) = acc[dt];
            }
        }
    }
}

DEVI void stage_mlstm_scan(const P& p, int bid, int nblk) {
    const int nthr = 512;
    for (int e = bid * nthr + tid_opq(); e < 16 * 257 * 32; e += nblk * nthr) {
        const int bh = e / (257 * 32), r = e % (257 * 32), v = r >> 5, d = (r & 31) * 4;
        f32x4 C = {0.f, 0.f, 0.f, 0.f};
        const float* ac = p.ACOEF + bh * 64; const float* sc = p.SCL + bh * 64;
        const size_t base = ((size_t)(bh * 64) * 272 + v) * 128 + d, cstride = (size_t)272 * 128;
#pragma unroll 1
        for (int c0 = 0; c0 < 64; c0 += 8) {
            f32x4 dc[8];
#pragma unroll
            for (int i = 0; i < 8; ++i) dc[i] = __builtin_nontemporal_load((const f32x4*)(p.DC + base + (size_t)(c0 + i) * cstride));
#pragma unroll
            for (int i = 0; i < 8; ++i) {
                u32x2 o; o.x = pack2(C[0], C[1]); o.y = pack2(C[2], C[3]);
                *(u32x2*)(p.CPT + base + (size_t)(c0 + i) * cstride) = o;
                C = C * ac[c0 + i] + dc[i] * sc[c0 + i];
            }
        }
        if (v < 256) {
#pragma unroll
            for (int k = 0; k < 4; ++k) p.out[O_PC + ((size_t)bh * 128 + d + k) * 256 + v] = C[k];
        } else *(f32x4*)(p.out + O_PN + bh * 128 + d) = C;
    }
}

constexpr int MO_Q = 0, MO_K = 64 * 272, MO_VT = MO_K + 64 * 272, MO_P = MO_VT + 272 * 144, MO_SC = MO_P + 64 * 144, MO_HS = MO_SC + 2048, MO_LDS = MO_HS + 64 * 256 * 4;
static_assert(MO_LDS <= 152 * 1024, "lds");
DEVI void stage_mlstm_out(const P& p, char* smem, int bid, int nblk) {
    const int tid = tid_opq(), lane = tid & 63, wid = tid >> 6, fr = lane & 15, fq = lane >> 4;
    bf16_t* Qs = (bf16_t*)(smem + MO_Q);
    bf16_t* Ks = (bf16_t*)(smem + MO_K);
    bf16_t* Vt = (bf16_t*)(smem + MO_VT);
    bf16_t* Ps = (bf16_t*)(smem + MO_P);
    float* sc = (float*)(smem + MO_SC);
    float* rowt = sc; float* colt = sc + 64; float* wint = sc + 128; float* emt = sc + 192; float* den = sc + 256;
    float* hs = (float*)(smem + MO_HS);
    for (int task = bid; task < 1024; task += nblk) {
        const int bh = task >> 6, c = task & 63, b = bh >> 2, h = bh & 3;
        const size_t row0 = (size_t)b * 4096 + c * 64;
        __syncthreads();
        {
            for (int i = tid; i < 64 * 16; i += 512) {
                const int t = i >> 4, ch = i & 15;
                *(u32x4*)(Qs + t * 136 + ch * 8) = *(const u32x4*)(p.PROJ + (row0 + t) * PS + C_AQ + h * 128 + ch * 8);
                *(u32x4*)(Ks + t * 136 + ch * 8) = *(const u32x4*)(p.PROJ + (row0 + t) * PS + C_AK + h * 128 + ch * 8);
            }
            const int sidx = tid & 63, ch = tid >> 6;
#pragma unroll
            for (int q4 = 0; q4 < 4; ++q4) {
                const u32x4 vv = *(const u32x4*)(p.PROJ + (row0 + sidx) * PS + C_AV + h * 256 + q4 * 64 + ch * 8);
#pragma unroll
                for (int e = 0; e < 4; ++e) {
                    Vt[(q4 * 64 + ch * 8 + e * 2) * 72 + sidx] = (bf16_t)(vv[e] & 0xFFFFu);
                    Vt[(q4 * 64 + ch * 8 + e * 2 + 1) * 72 + sidx] = (bf16_t)(vv[e] >> 16);
                }
            }
            for (int i = tid; i < 16 * 64; i += 512) Vt[(256 + (i >> 6)) * 72 + (i & 63)] = (i >> 6) == 0 ? (bf16_t)0x3F80 : (bf16_t)0;
            if (wid == 0) {
                const float bc = p.BCUM[bh * 4096 + c * 64 + lane], ip = p.SM[(row0 + lane) * 64 + h];
                const float mprev = p.MPREV[task];
                float pm = ip - bc;
#pragma unroll
                for (int o = 1; o < 64; o <<= 1) { const float t = __shfl_up(pm, o); if (lane >= o) pm = fmaxf(pm, t); }
                const float mt = fmaxf(bc + mprev, bc + pm);
                rowt[lane] = bc - mt; colt[lane] = ip - bc; wint[lane] = __expf(bc + mprev - mt); emt[lane] = __expf(-mt);
            }
        }
        __syncthreads();
        {
            const int tt = wid >> 1;
#pragma unroll
            for (int si = 0; si < 2; ++si) {
                const int st = (wid & 1) * 2 + si;
                f32x4 acc = (f32x4){0.f, 0.f, 0.f, 0.f};
                if (st <= tt) {
#pragma unroll
                    for (int ks = 0; ks < 4; ++ks) {
                        const bf16x8 af = *(const bf16x8*)(Qs + (tt * 16 + fr) * 136 + ks * 32 + fq * 8);
                        const bf16x8 bf = *(const bf16x8*)(Ks + (st * 16 + fr) * 136 + ks * 32 + fq * 8);
                        acc = __builtin_amdgcn_mfma_f32_16x16x32_bf16(af, bf, acc, 0, 0, 0);
                    }
                }
                const int s = st * 16 + fr; const float ct = colt[s];
#pragma unroll
                for (int r = 0; r < 4; ++r) {
                    const int t = tt * 16 + fq * 4 + r;
                    const float pv = (s <= t) ? acc[r] * __expf(rowt[t] + ct) : 0.f;
                    Ps[t * 72 + s] = f2bf(pv);
                }
            }
        }
        __syncthreads();
        {
            const bf16_t* cpt = p.CPT + (size_t)task * 272 * 128;
            f32x4 acc[4][2];
#pragma unroll
            for (int tt = 0; tt < 4; ++tt)
#pragma unroll
                for (int vi = 0; vi < 2; ++vi) acc[tt][vi] = (f32x4){0.f, 0.f, 0.f, 0.f};
            f32x4 accd = (f32x4){0.f, 0.f, 0.f, 0.f};
            bf16x8 cb[4][2], cd[4];
#pragma unroll
            for (int ks = 0; ks < 4; ++ks) {
#pragma unroll
                for (int vi = 0; vi < 2; ++vi) cb[ks][vi] = *(const bf16x8*)(cpt + (size_t)((wid * 2 + vi) * 16 + fr) * 128 + ks * 32 + fq * 8);
                cd[ks] = *(const bf16x8*)(cpt + (size_t)(256 + fr) * 128 + ks * 32 + fq * 8);
            }
#pragma unroll
            for (int ks = 0; ks < 4; ++ks) {
                bf16x8 af[4];
#pragma unroll
                for (int tt = 0; tt < 4; ++tt) af[tt] = *(const bf16x8*)(Qs + (tt * 16 + fr) * 136 + ks * 32 + fq * 8);
#pragma unroll
                for (int vi = 0; vi < 2; ++vi) {
#pragma unroll
                    for (int tt = 0; tt < 4; ++tt) acc[tt][vi] = __builtin_amdgcn_mfma_f32_16x16x32_bf16(af[tt], cb[ks][vi], acc[tt][vi], 0, 0, 0);
                }
                if (wid < 4) {
                    const bf16x8 a2 = *(const bf16x8*)(Qs + (wid * 16 + fr) * 136 + ks * 32 + fq * 8);
                    accd = __builtin_amdgcn_mfma_f32_16x16x32_bf16(a2, cd[ks], accd, 0, 0, 0);
                }
            }
#pragma unroll
            for (int tt = 0; tt < 4; ++tt) {
                const f32x4 wv = *(const f32x4*)(wint + tt * 16 + fq * 4);
#pragma unroll
                for (int vi = 0; vi < 2; ++vi) acc[tt][vi] *= wv;
            }
            if (wid < 4) accd *= *(const f32x4*)(wint + wid * 16 + fq * 4);
#pragma unroll
            for (int ks = 0; ks < 2; ++ks) {
                bf16x8 af[4];
#pragma unroll
                for (int tt = 0; tt < 4; ++tt) af[tt] = *(const bf16x8*)(Ps + (tt * 16 + fr) * 72 + ks * 32 + fq * 8);
#pragma unroll
                for (int vi = 0; vi < 2; ++vi) {
                    const bf16x8 bf = *(const bf16x8*)(Vt + ((wid * 2 + vi) * 16 + fr) * 72 + ks * 32 + fq * 8);
#pragma unroll
                    for (int tt = 0; tt < 4; ++tt) acc[tt][vi] = __builtin_amdgcn_mfma_f32_16x16x32_bf16(af[tt], bf, acc[tt][vi], 0, 0, 0);
                }
                if (wid < 4) {
                    const bf16x8 bf = *(const bf16x8*)(Vt + (256 + fr) * 72 + ks * 32 + fq * 8);
                    const bf16x8 a2 = *(const bf16x8*)(Ps + (wid * 16 + fr) * 72 + ks * 32 + fq * 8);
                    accd = __builtin_amdgcn_mfma_f32_16x16x32_bf16(a2, bf, accd, 0, 0, 0);
                }
            }
            if (wid < 4 && fr == 0) *(f32x4*)(den + wid * 16 + fq * 4) = accd;
            __syncthreads();
#pragma unroll
            for (int tt = 0; tt < 4; ++tt) {
                const f32x4 dv = *(const f32x4*)(den + tt * 16 + fq * 4), ev = *(const f32x4*)(emt + tt * 16 + fq * 4);
#pragma unroll
                for (int vi = 0; vi < 2; ++vi)
#pragma unroll
                    for (int r = 0; r < 4; ++r) hs[(tt * 16 + fq * 4 + r) * 256 + (wid * 2 + vi) * 16 + fr] = acc[tt][vi][r] / fmaxf(fabsf(dv[r]), ev[r]);
            }
        }
        __syncthreads();
        u32x2 ovs[8];
#pragma unroll
        for (int rr = 0; rr < 8; ++rr) ovs[rr] = *(const u32x2*)(p.PROJ + (row0 + wid * 8 + rr) * PS + C_AO + h * 256 + lane * 4);
        const f32x4 gg = *(const f32x4*)(p.norm_a_g + h * 256 + lane * 4);
#pragma unroll
        for (int rr = 0; rr < 8; ++rr) {
            const int t = wid * 8 + rr;
            const f32x4 x = *(const f32x4*)(hs + t * 256 + lane * 4);
            const float mean = wave_sum(x[0] + x[1] + x[2] + x[3]) * (1.f / 256.f);
            float q = 0.f;
#pragma unroll
            for (int k = 0; k < 4; ++k) q += (x[k] - mean) * (x[k] - mean);
            const float rs = rsqrtf(wave_sum(q) * (1.f / 256.f) + LN_EPS);
            const u32x2 ov = ovs[rr];
            const float o4[4] = {__uint_as_float(ov.x << 16), __uint_as_float(ov.x & 0xFFFF0000u), __uint_as_float(ov.y << 16), __uint_as_float(ov.y & 0xFFFF0000u)};
            float y[4];
#pragma unroll
            for (int k = 0; k < 4; ++k) y[k] = (x[k] - mean) * rs * gg[k] * sigmoidf_(o4[k]);
            u32x2 o2; o2.x = pack2(y[0], y[1]); o2.y = pack2(y[2], y[3]);
            *(u32x2*)(p.YA + (row0 + t) * 1024 + h * 256 + lane * 4) = o2;
        }
    }
}

DEVI void stage_mlstm_sample(const P& p, char* smem, int bid, int nblk) {
    float* qs = (float*)smem;
    float* ks = qs + 512;
    float* vs = ks + 512;
    float* part = vs + 1024;
    float* hs = part + 2048;
    float* sc = hs + 1024;
    float* bc = sc; float* ip = sc + 4; float* mt = sc + 8; float* wint = sc + 12; float* emt = sc + 16; float* ww = sc + 20; float* den = sc + 24;
    float* Pm = sc + 32;
    float* misc = sc + 48;
    const int tid = tid_opq(), lane = tid & 63, wid = tid >> 6;
    for (int task = bid; task < 512; task += nblk) {
        const int b = task >> 2, h = task & 3;
        const size_t row0 = (size_t)NTP + b * 4;
        __syncthreads();
        { const int t = tid >> 7, d = tid & 127;
          qs[tid] = bf2f(p.PROJ[(row0 + t) * PS + C_AQ + h * 128 + d]);
          ks[tid] = bf2f(p.PROJ[(row0 + t) * PS + C_AK + h * 128 + d]); }
        for (int idx = tid; idx < 1024; idx += 512) { const int t = idx >> 8, v = idx & 255; vs[idx] = bf2f(p.PROJ[(row0 + t) * PS + C_AV + h * 256 + v]); }
        if (tid == 0) {
            const float m0 = p.state_m[task];
            float cs = 0.f;
            for (int t = 0; t < 4; ++t) { cs += logsigmoidf_(p.SM[(row0 + t) * 64 + 4 + h]); bc[t] = cs; ip[t] = p.SM[(row0 + t) * 64 + h]; }
            for (int t = 0; t < 4; ++t) {
                float mx = bc[t] + m0;
                for (int s = 0; s <= t; ++s) mx = fmaxf(mx, bc[t] - bc[s] + ip[s]);
                mt[t] = mx; wint[t] = __expf(bc[t] + m0 - mx); emt[t] = __expf(-mx);
            }
            const float bend = bc[3];
            float mnew = bend + m0;
            for (int s = 0; s < 4; ++s) mnew = fmaxf(mnew, bend - bc[s] + ip[s]);
            misc[0] = __expf(bend + m0 - mnew);
            for (int s = 0; s < 4; ++s) ww[s] = __expf(bend - bc[s] + ip[s] - mnew);
            p.out[O_SM + task] = mnew;
        }
        __syncthreads();
        if (tid < 16) {
            const int t = tid >> 2, s = tid & 3;
            float a = 0.f;
            if (s <= t) { for (int d = 0; d < 128; ++d) a += qs[t * 128 + d] * ks[s * 128 + d]; a *= __expf(bc[t] - bc[s] + ip[s] - mt[t]); }
            Pm[tid] = a;
        }
        __syncthreads();
        if (tid < 4) {
            const int t = tid; float qn = 0.f;
            for (int d = 0; d < 128; ++d) qn += qs[t * 128 + d] * p.state_n[(size_t)task * 128 + d];
            den[t] = wint[t] * qn + Pm[t * 4] + Pm[t * 4 + 1] + Pm[t * 4 + 2] + Pm[t * 4 + 3];
        }
        const float a = misc[0];
        if (tid >= 128 && tid < 256) {
            const int d = tid - 128;
            float n = a * p.state_n[(size_t)task * 128 + d];
            for (int s = 0; s < 4; ++s) n += ww[s] * ks[s * 128 + d];
            p.out[O_SN + (size_t)task * 128 + d] = n;
        }
        {
            const int v = tid & 255, dh = tid >> 8;
            float acc[4] = {0.f, 0.f, 0.f, 0.f};
            float wv[4];
#pragma unroll
            for (int s = 0; s < 4; ++s) wv[s] = ww[s] * vs[s * 256 + v];
            for (int d0 = dh * 64; d0 < dh * 64 + 64; d0 += 16) {
                float c0[16];
#pragma unroll
                for (int i = 0; i < 16; ++i) c0[i] = __builtin_nontemporal_load(p.state_C + ((size_t)task * 128 + d0 + i) * 256 + v);
#pragma unroll
                for (int i = 0; i < 16; ++i) {
                    const int d = d0 + i;
#pragma unroll
                    for (int t = 0; t < 4; ++t) acc[t] += qs[t * 128 + d] * c0[i];
                    float cn = a * c0[i];
#pragma unroll
                    for (int s = 0; s < 4; ++s) cn += ks[s * 128 + d] * wv[s];
                    __builtin_nontemporal_store(cn, p.out + O_SC + ((size_t)task * 128 + d) * 256 + v);
                }
            }
#pragma unroll
            for (int t = 0; t < 4; ++t) part[(dh * 4 + t) * 256 + v] = acc[t];
        }
        __syncthreads();
        if (tid < 256) {
            const int v = tid;
#pragma unroll
            for (int t = 0; t < 4; ++t) {
                float num = wint[t] * (part[t * 256 + v] + part[(4 + t) * 256 + v]);
#pragma unroll
                for (int s = 0; s < 4; ++s) num += Pm[t * 4 + s] * vs[s * 256 + v];
                hs[t * 256 + v] = num / fmaxf(fabsf(den[t]), emt[t]);
            }
        }
        __syncthreads();
        if (wid < 4) {
            const int t = wid;
            const f32x4 x = *(const f32x4*)(hs + t * 256 + lane * 4);
            const float mean = wave_sum(x[0] + x[1] + x[2] + x[3]) * (1.f / 256.f);
            float q = 0.f;
#pragma unroll
            for (int k = 0; k < 4; ++k) q += (x[k] - mean) * (x[k] - mean);
            const float rs = rsqrtf(wave_sum(q) * (1.f / 256.f) + LN_EPS);
            float y[4];
#pragma unroll
            for (int k = 0; k < 4; ++k) {
                const int vi = lane * 4 + k;
                const float o = bf2f(p.PROJ[(row0 + t) * PS + C_AO + h * 256 + vi]);
                y[k] = (x[k] - mean) * rs * p.norm_a_g[h * 256 + vi] * sigmoidf_(o);
            }
            u32x2 o2; o2.x = pack2(y[0], y[1]); o2.y = pack2(y[2], y[3]);
            *(u32x2*)(p.YA + (row0 + t) * 1024 + h * 256 + lane * 4) = o2;
        }
    }
}

constexpr int CP_ABUF = 33280, CP_WBUF = 18432, CP_A = 0, CP_W = 2 * CP_ABUF, CP_LDS = CP_W + 2 * CP_WBUF;
constexpr int CP_AROW = 1024 + 8;
DEVI void stage_compress(const P& p, char* smem, int bid, int nblk, int only = -1) {
    const int tid = tid_opq(), lane = tid & 63, wid = tid >> 6, fr = lane & 15, fq = lane >> 4;
    const int kv = wid & 1, rt = wid >> 1;
    const int n_it = only >= 0 ? 1 : (256 + nblk - 1) / nblk + (16 + nblk - 1) / nblk;
    for (int it = 0; it < n_it; ++it) {
        const int ns_it = (256 + nblk - 1) / nblk;
        const int task = only >= 0 ? only : it < ns_it ? bid + it * nblk : 256 + (nblk - 1 - bid) + (it - ns_it) * nblk;
        if (only < 0 && (task >= 272 || (it < ns_it && task >= 256))) continue;
        const bool prompt = task >= 256;
        const int rowbytes = prompt ? 1024 : 2048, npieces = prompt ? 2 : 4;
        const char* src[4]; int dsto[4];
#pragma unroll
        for (int q = 0; q < 4; ++q) {
            const int off = q * 8192 + tid * 16, r = off / rowbytes, cb = off % rowbytes;
            if (prompt) { const int blk = (task - 256) * 16 + (r & 15); src[q] = (const char*)(p.PROJ + (size_t)blk * 64 * PS + C_CMP) + cb; dsto[q] = (r & 15) * CP_AROW * 2 + cb; }
            else { const int gb = task * 16 + r, b = gb >> 5, n = gb & 31; const int page = p.page_table[b * 16 + (n >> 1)];
                   src[q] = (const char*)(p.cache_cmp + ((size_t)page * 128 + (n & 1) * 64) * 512) + cb; dsto[q] = r * CP_AROW * 2 + (cb >> 1); }
        }
        const size_t sstride = prompt ? (size_t)PS * 2 : 2048;
        const char* wsrc[2]; int wdst[2];
#pragma unroll
        for (int q = 0; q < 2; ++q) { const int idx = q * 512 + tid, row = idx >> 3, ch = idx & 7; wsrc[q] = (const char*)(p.WCT + (size_t)row * 4096) + ch * 16; wdst[q] = row * 144 + ch * 16; }
        f32x4 acc[4];
#pragma unroll
        for (int nt = 0; nt < 4; ++nt) acc[nt] = (f32x4){0.f, 0.f, 0.f, 0.f};
        f32x4 ra0[4], ra1[4]; u32x4 rw0[2], rw1[2];
        auto issue = [&](int l, f32x4 (&ra)[4], u32x4 (&rw)[2]) {
#pragma unroll
            for (int q = 0; q < 4; ++q) if (q < npieces) ra[q] = prompt ? *(const f32x4*)(src[q] + (size_t)l * sstride) : __builtin_nontemporal_load((const f32x4*)(src[q] + (size_t)l * sstride));
#pragma unroll
            for (int q = 0; q < 2; ++q) rw[q] = *(const u32x4*)(wsrc[q] + l * 128);
        };
        auto commit = [&](int buf, const f32x4 (&ra)[4], const u32x4 (&rw)[2]) {
            char* ab = smem + CP_A + buf * CP_ABUF; char* wbuf = smem + CP_W + buf * CP_WBUF;
#pragma unroll
            for (int q = 0; q < 4; ++q) if (q < npieces) {
                if (prompt) *(f32x4*)(ab + dsto[q]) = ra[q];
                else { u32x2 o; o.x = pack2(ra[q][0], ra[q][1]); o.y = pack2(ra[q][2], ra[q][3]); *(u32x2*)(ab + dsto[q]) = o; }
            }
#pragma unroll
            for (int q = 0; q < 2; ++q) *(u32x4*)(wbuf + wdst[q]) = rw[q];
        };
        auto consume = [&](int buf) {
            const char* ab = smem + CP_A + buf * CP_ABUF; const char* wbuf = smem + CP_W + buf * CP_WBUF;
            const bf16_t* arow = (const bf16_t*)ab + (rt * 4 + (fr >> 2)) * CP_AROW + kv * 256 + (fr & 3) * 64 + fq * 8;
#pragma unroll
            for (int hf = 0; hf < 2; ++hf) {
                const bf16x8 a = *(const bf16x8*)(arow + hf * 32);
#pragma unroll
                for (int nt = 0; nt < 4; ++nt) {
                    const bf16x8 bfrag = *(const bf16x8*)(wbuf + (kv * 64 + nt * 16 + fr) * 144 + hf * 64 + fq * 16);
                    acc[nt] = __builtin_amdgcn_mfma_f32_16x16x32_bf16(a, bfrag, acc[nt], 0, 0, 0);
                }
            }
        };
        __syncthreads();
        issue(0, ra0, rw0); issue(1, ra1, rw1); commit(0, ra0, rw0); issue(2, ra0, rw0);
        __syncthreads();
#pragma unroll 1
        for (int l = 0; l < 64; l += 2) {
            consume(0);
            commit(1, ra1, rw1);
            if (l + 3 < 64) issue(l + 3, ra1, rw1);
            __syncthreads();
            consume(1);
            if (l + 2 < 64) commit(0, ra0, rw0);
            if (l + 4 < 64) issue(l + 4, ra0, rw0);
            __syncthreads();
        }
        {
            const int ob = prompt ? (task - 256) * 16 + rt * 4 + fq : 256 + task * 16 + rt * 4 + fq;
#pragma unroll
            for (int nt = 0; nt < 4; ++nt) {
                const float bias = p.PW[kv * 64 + nt * 16 + fr];
#pragma unroll
                for (int r = 0; r < 4; ++r) p.KC[(size_t)ob * 512 + kv * 256 + r * 64 + nt * 16 + fr] = acc[nt][r] + bias;
            }
        }
    }
}

typedef float f32x16 __attribute__((ext_vector_type(16)));
typedef short s16x4 __attribute__((ext_vector_type(4)));
typedef __attribute__((address_space(3))) const char* lds_cptr;
#define MFMA32(a, b, c) __builtin_amdgcn_mfma_f32_32x32x16_bf16(a, b, c, 0, 0, 0)
DEVI int crow(int r, int hi) { return (r & 3) + 8 * (r >> 2) + 4 * hi; }
DEVI unsigned cvtpk(float lo, float hi) { return pack2(lo, hi); }
DEVI s16x4 vtr(lds_cptr p) { return __builtin_bit_cast(s16x4, __builtin_amdgcn_ds_read_tr16_b64_v4i16((__attribute__((address_space(3))) s16x4*)p)); }
DEVI float half_max(float m) { auto rr = __builtin_amdgcn_permlane32_swap(__float_as_uint(m), __float_as_uint(m), false, false); return fmaxf(__uint_as_float(rr[0]), __uint_as_float(rr[1])); }
DEVI float half_sum(float m) { auto rr = __builtin_amdgcn_permlane32_swap(__float_as_uint(m), __float_as_uint(m), false, false); return __uint_as_float(rr[0]) + __uint_as_float(rr[1]); }

struct BlkDesc { const char* k; int stride_bytes; int f32; int count; int pos0; };
DEVI void blk_load(const BlkDesc& d, int tid, u32x4& rk, u32x4& rv) {
    const int key = tid & 63, chunk = tid >> 6;
    rk = (u32x4){0u, 0u, 0u, 0u}; rv = rk;
    if (key < d.count) {
        const char* kr = d.k + (size_t)key * d.stride_bytes;
        if (d.f32) {
            const f32x4* s1 = (const f32x4*)(kr + chunk * 32); const f32x4* s2 = (const f32x4*)(kr + 1024 + chunk * 32);
            rk = pack8f(s1[0], s1[1]); rv = pack8f(s2[0], s2[1]);
        } else { rk = *(const u32x4*)(kr + chunk * 16); rv = *(const u32x4*)(kr + 512 + chunk * 16); }
    }
}
DEVI void blk_store(char* kimg, char* vimg, int tid, const u32x4& rk, const u32x4& rv) {
    const int key = tid & 63, chunk = tid >> 6;
    *(u32x4*)(kimg + chunk * 1024 + key * 16) = rk;
    *(u32x4*)(vimg + (chunk >> 2) * 4096 + key * 64 + (chunk & 3) * 16) = rv;
}

DEVI void attn_tile(const char* kimg, const char* vimg, const bf16x8 (&qr)[4], float& m2, float& lsum, f32x16& o0, f32x16& o1, f32x16& s0, f32x16& s1,
                    float sl, float bb, int lh, int ll, bool fast, float* wsf_hi  , float* wsf_r  , int lane) {
    const int r32 = lane & 31, hi = lane >> 5;
    const f32x16 z = {};
    s0 = z; s1 = z;
    {
        const char* kp = kimg + hi * 1024 + r32 * 16;
#pragma unroll
        for (int d0 = 0; d0 < 4; ++d0) {
            const bf16x8 k0 = *(const bf16x8*)(kp + d0 * 2048), k1 = *(const bf16x8*)(kp + d0 * 2048 + 512);
            s0 = MFMA32(k0, qr[d0], s0); s1 = MFMA32(k1, qr[d0], s1);
        }
    }
    float mx = -1e30f;
    if (fast) {
#pragma unroll
        for (int r = 0; r < 16; ++r) {
            const int c = (r & 3) + 8 * (r >> 2);
            s0[r] = fmaf(s0[r], 1.4426950408889634f, fmaf(sl, (float)c, bb)); s1[r] = fmaf(s1[r], 1.4426950408889634f, fmaf(sl, (float)(c + 32), bb));
            mx = fmaxf(mx, fmaxf(s0[r], s1[r]));
        }
    } else {
#pragma unroll
        for (int r = 0; r < 16; ++r) {
            const int c = (r & 3) + 8 * (r >> 2);
            const float t0 = fmaf(s0[r], 1.4426950408889634f, fmaf(sl, (float)c, bb)), t1 = fmaf(s1[r], 1.4426950408889634f, fmaf(sl, (float)(c + 32), bb));
            s0[r] = (c <= lh && c > ll) ? t0 : -INFINITY; s1[r] = (c + 32 <= lh && c + 32 > ll) ? t1 : -INFINITY;
            mx = fmaxf(mx, fmaxf(s0[r], s1[r]));
        }
    }
    mx = half_max(mx);
    const float mnew = fmaxf(m2, mx);
    const float f = __builtin_amdgcn_exp2f(m2 - mnew);
    m2 = mnew;
    float ps = 0.f;
#pragma unroll
    for (int r = 0; r < 16; ++r) { s0[r] = __builtin_amdgcn_exp2f(s0[r] - mnew); s1[r] = __builtin_amdgcn_exp2f(s1[r] - mnew); ps += s0[r] + s1[r]; }
    lsum = lsum * f + ps;
    if (__any(f != 1.f)) {
        if (hi == 0) *wsf_r = f;
        asm volatile("s_waitcnt lgkmcnt(0)" ::: "memory");
#pragma unroll
        for (int a = 0; a < 4; ++a) {
            const f32x4 fv = *(const f32x4*)(wsf_hi + 8 * a);
#pragma unroll
            for (int k = 0; k < 4; ++k) { o0[4 * a + k] *= fv[k]; o1[4 * a + k] *= fv[k]; }
        }
        asm volatile("s_waitcnt lgkmcnt(0)" ::: "memory");
    }
    u32x4 pw[4];
#pragma unroll
    for (int k = 0; k < 4; ++k) { pw[0][k] = cvtpk(s0[2 * k], s0[2 * k + 1]); pw[1][k] = cvtpk(s0[8 + 2 * k], s0[8 + 2 * k + 1]); pw[2][k] = cvtpk(s1[2 * k], s1[2 * k + 1]); pw[3][k] = cvtpk(s1[8 + 2 * k], s1[8 + 2 * k + 1]); }
    const lds_cptr vp = (lds_cptr)vimg + ((lane >> 4) & 1) * 32 + (lane & 3) * 8 + (4 * hi + ((lane & 15) >> 2)) * 64;
#pragma unroll
    for (int i = 0; i < 8; ++i) {
        const s16x4 lo = vtr(vp + ((i >> 2) * 4096 + (i & 3) * 1024)), hh = vtr(vp + ((i >> 2) * 4096 + (i & 3) * 1024 + 512));
        const bf16x8 vf = (bf16x8){lo[0], lo[1], lo[2], lo[3], hh[0], hh[1], hh[2], hh[3]};
        const bf16x8 pf = __builtin_bit_cast(bf16x8, pw[i & 3]);
        if (i < 4) o0 = MFMA32(pf, vf, o0); else o1 = MFMA32(pf, vf, o1);
    }
}

constexpr int NSA_KV0 = 0, NSA_KV1 = 16384, NSA_WSF = 32768, NSA_IMP = NSA_WSF + 2048, NSA_SEL = NSA_IMP + 16384, NSA_LIST = NSA_SEL + 512, NSA_OST = NSA_LIST + 256, NSA_YAC = NSA_OST + 32768, NSA_LDS = NSA_YAC + 65536;
static_assert(NSA_LDS <= 152 * 1024, "lds");

DEVI BlkDesc nsa_desc(const P& p, bool prompt, int b, int g, int branch, int j) {
    BlkDesc d;
    if (prompt) {
        if (branch == 0) { d.k = (const char*)(p.KC + ((size_t)(b * 64) * 512 + g * 64)); d.stride_bytes = 2048; d.f32 = 1; d.count = 64; d.pos0 = 0; }
        else { d.k = (const char*)(p.PROJ + ((size_t)b * 4096 + j * 64) * PS + (branch == 1 ? C_SLC : C_WIN) + g * 64); d.stride_bytes = PS * 2; d.f32 = 0; d.count = 64; d.pos0 = j * 64; }
    } else {
        if (branch == 0) { d.k = (const char*)(p.KC + ((size_t)(256 + b * 32) * 512 + g * 64)); d.stride_bytes = 2048; d.f32 = 1; d.count = 32; d.pos0 = 0; }
        else if (branch == 1 && j < 32) { const int page = p.page_table[b * 16 + (j >> 1)]; d.k = (const char*)(p.cache_slc + ((size_t)page * 128 + (j & 1) * 64) * 512 + g * 64); d.stride_bytes = 2048; d.f32 = 1; d.count = 64; d.pos0 = j * 64; }
        else if (branch == 2 && j < 8) { d.k = (const char*)(p.cache_win + ((size_t)b * 512 + j * 64) * 512 + g * 64); d.stride_bytes = 2048; d.f32 = 1; d.count = 64; d.pos0 = 1536 + j * 64; }
        else { d.k = (const char*)(p.PROJ + ((size_t)NTP + b * 4) * PS + (branch == 1 ? C_SLC : C_WIN) + g * 64); d.stride_bytes = PS * 2; d.f32 = 0; d.count = 4; d.pos0 = 2048; }
    }
    return d;
}

constexpr int NS_IMG = 0, NS_WSF = 131072, NS_IMP = NS_WSF + 2048, NS_SEL = NS_IMP + 2048, NS_LIST = NS_SEL + 64, NS_YC = NS_LIST + 64, NS_PM = NS_YC + 4096, NS_Q = NS_PM + 2048, NS_LDS = NS_Q + 4096;
static_assert(NS_LDS <= 152 * 1024, "lds");
DEVI void wave_stage_block(const BlkDesc& d, char* kimg, char* vimg, int lane) {
    asm volatile("" : "+v"(lane));
    const int rsub = lane >> 4, pc = lane & 15;
    if (d.f32) {
#pragma unroll
        for (int half = 0; half < 2; ++half) {
#pragma unroll
            for (int i0 = 0; i0 < 16; i0 += 6) {
                f32x4 x[6];
#pragma unroll
                for (int i = 0; i < 6; ++i) if (i0 + i < 16) { const int row = 4 * (i0 + i) + rsub; x[i] = row < d.count ? __builtin_nontemporal_load((const f32x4*)(d.k + (size_t)row * d.stride_bytes + half * 1024 + pc * 16)) : (f32x4){0.f, 0.f, 0.f, 0.f}; }
#pragma unroll
                for (int i = 0; i < 6; ++i) if (i0 + i < 16) {
                    const int row = 4 * (i0 + i) + rsub, c = pc >> 1;
                    u32x2 o; o.x = pack2(x[i][0], x[i][1]); o.y = pack2(x[i][2], x[i][3]);
                    if (half == 0) *(u32x2*)(kimg + c * 1024 + row * 16 + (pc & 1) * 8) = o;
                    else *(u32x2*)(vimg + (c >> 2) * 4096 + row * 64 + (c & 3) * 16 + (pc & 1) * 8) = o;
                }
            }
        }
    } else {
        const int row = lane >> 3, c = lane & 7;
#pragma unroll
        for (int i = 0; i < 8; ++i) {
            const int rr = 8 * i + row;
            u32x4 kk = {0u, 0u, 0u, 0u}, vv = {0u, 0u, 0u, 0u};
            if (rr < d.count) { kk = *(const u32x4*)(d.k + (size_t)rr * d.stride_bytes + c * 16); vv = *(const u32x4*)(d.k + (size_t)rr * d.stride_bytes + 512 + c * 16); }
            *(u32x4*)(kimg + c * 1024 + rr * 16) = kk;
            *(u32x4*)(vimg + (c >> 2) * 4096 + rr * 64 + (c & 3) * 16) = vv;
        }
    }
    asm volatile("s_waitcnt lgkmcnt(0)" ::: "memory");
}

DEVI void nsa_sample_unit(const P& p, char* smem, int us) {
    const int tid = tid_opq(), lane = tid & 63, wid = tid >> 6, r32 = lane & 31, hi = lane >> 5;
    const int b = us >> 2, g = us & 3;
    const size_t rowbase = (size_t)NTP + b * 4;
    char* kimg = smem + NS_IMG + wid * 16384; char* vimg = kimg + 8192;
    float* wsf = (float*)(smem + NS_WSF) + wid * 64;
    float* impb = (float*)(smem + NS_IMP);
    unsigned long long* selm = (unsigned long long*)(smem + NS_SEL);
    unsigned char* blist = (unsigned char*)(smem + NS_LIST);
    float* ycmp = (float*)(smem + NS_YC);
    const int tokl = r32 >> 2, head = r32 & 3;
    const bool tok_ok = r32 < 16;
    const int qpos = 2048 + tokl;
    const float slope2 = alibi_slope(g * 4 + head) * 1.4426950408889634f;
    char* qsh = smem + NS_Q;
    int hi4 = 4 * hi; asm volatile("" : "+v"(hi4));
    float* wsf_hi = wsf + hi4; float* wsf_r = wsf + r32;
    f32x16 s0, s1;
    __syncthreads();
    if (wid == 0) {
        bf16x8 qr[4];
        {
            const bf16_t* qp = p.PROJ + (rowbase + (tok_ok ? tokl : 0)) * PS + C_BQ + (g * 4 + head) * 64 + hi * 8;
#pragma unroll
            for (int d0 = 0; d0 < 4; ++d0) {
                u32x4 v = *(const u32x4*)(qp + d0 * 16);
#pragma unroll
                for (int k = 0; k < 4; ++k) { const float lo = __uint_as_float(v[k] << 16) * 0.125f, hh = __uint_as_float(v[k] & 0xFFFF0000u) * 0.125f; v[k] = tok_ok ? ((__float_as_uint(lo) >> 16) | (__float_as_uint(hh) & 0xFFFF0000u)) : 0u; }
                qr[d0] = __builtin_bit_cast(bf16x8, v);
                *(u32x4*)(qsh + d0 * 1024 + lane * 16) = v;
            }
        }
        f32x16 o0 = {}, o1 = {}; float m2 = -1e30f, lsum = 0.f;
        const BlkDesc d = nsa_desc(p, false, b, g, 0, 0);
        wave_stage_block(d, kimg, vimg, lane);
        const int lh = 31 - hi4;
        const float sl = 64.f * slope2;
        attn_tile(kimg, vimg, qr, m2, lsum, o0, o1, s0, s1, sl, tok_ok ? sl * (float)(hi4 - 32) : -INFINITY, lh, -1000, false, wsf_hi, wsf_r, lane);
        const float lt = half_sum(lsum);
        const float inv = lt > 0.f ? 1.f / lt : 0.f;
        unsigned x[64];
#pragma unroll
        for (int r = 0; r < 16; ++r) {
#pragma unroll
            for (int n = 0; n < 2; ++n) {
                float a = (n == 0 ? s0[r] : s1[r]) * inv;
                a += __shfl_xor(a, 1); a += __shfl_xor(a, 2);
                const int j = (r & 3) + 8 * (r >> 2) + 32 * n + hi4;
                if (j == 32 || j == 0) a = 5.0f;
                if (j > 32) a = -2.0f;
                const unsigned u = __float_as_uint(a);
                const unsigned o = (u & 0x80000000u) ? ~u : (u | 0x80000000u);
                x[n * 16 + r] = (o & ~63u) | (unsigned)(63 - j);
            }
        }
        float fac = 0.f;
        if (tok_ok && lt > 0.f) fac = sigmoidf_(p.SM[(rowbase + tokl) * 64 + 8 + g * 4 + head]) / lt;
        if (hi == 0) *wsf_r = fac;
        asm volatile("s_waitcnt lgkmcnt(0)" ::: "memory");
#pragma unroll
        for (int a = 0; a < 2; ++a) {
            const f32x4 fv = *(const f32x4*)(wsf_hi + 8 * a);
#pragma unroll
            for (int k = 0; k < 4; ++k) { float* yp = ycmp + (8 * a + k + hi4) * 64 + r32; yp[0] = o0[4 * a + k] * fv[k]; yp[32] = o1[4 * a + k] * fv[k]; }
        }
        asm volatile("s_waitcnt lgkmcnt(0)" ::: "memory");
        {
            sort16_desc<0>(x); sort16_desc<16>(x);
            unsigned th[16], oth[16], fin[16];
            merge_top16(&x[0], &x[16], th);
#pragma unroll
            for (int i = 0; i < 16; ++i) { auto rr = __builtin_amdgcn_permlane32_swap(th[i], th[i], false, false); oth[i] = hi ? rr[0] : rr[1]; }
            merge_top16(th, oth, fin);
            unsigned long long mask = 0ull;
#pragma unroll
            for (int i = 0; i < 16; ++i) mask |= 1ull << (63u - (fin[i] & 63u));
            if (head == 0 && hi == 0 && r32 < 16) selm[r32 >> 2] = mask;
        }
        asm volatile("s_waitcnt lgkmcnt(0)" ::: "memory");
        {
            const unsigned long long u = selm[0] | selm[1] | selm[2] | selm[3];
            const int n = __builtin_popcountll(u);
            if ((u >> lane) & 1ull) blist[1 + __builtin_popcountll(u & ((1ull << lane) - 1ull))] = (unsigned char)(0x40 | lane);
            if (lane <= 8) blist[1 + n + lane] = (unsigned char)(0x80 | lane);
            if (lane == 0) blist[0] = (unsigned char)(n + 9);
        }
    }
    __syncthreads();
    const int nb = blist[0];
    const unsigned long long mysel = tok_ok ? selm[tokl] : 0ull;
    int nslc = 0;
    for (int i = 0; i < nb; ++i) nslc += (blist[1 + i] >> 6) == 1 ? 1 : 0;
    float so[16], ms, lst;
    float wo[16], mw, lwt;
#pragma unroll 1
    for (int pass = 0; pass < 2; ++pass) {
        f32x16 o0 = {}, o1 = {}; float m2 = -1e30f, lsum = 0.f;
        const int i0 = pass == 0 ? 0 : nslc, i1 = pass == 0 ? nslc : nb;
#pragma unroll 1
        for (int i = i0 + wid; i < i1; i += 8) {
            const int e = blist[1 + i], br = e >> 6, j = e & 63;
            const BlkDesc d = nsa_desc(p, false, b, g, br, j);
            wave_stage_block(d, kimg, vimg, lane);
            asm volatile("" : "+v"(hi4));
            const bool lsel = tok_ok && (br == 2 || ((mysel >> j) & 1ull));
            const int rel = qpos - d.pos0;
            const int lh = (rel < d.count - 1 ? rel : d.count - 1) - hi4;
            const int ll = (br == 2 ? rel - 512 : -1000) - hi4;
            const bool fast = __all(!lsel || (lh >= 59 && ll < 0));
            const float bb = lsel ? slope2 * (float)(hi4 + d.pos0 - 2048) : -INFINITY;
            bf16x8 qr[4];
#pragma unroll
            for (int d0 = 0; d0 < 4; ++d0) qr[d0] = *(const bf16x8*)(qsh + d0 * 1024 + lane * 16);
            attn_tile(kimg, vimg, qr, m2, lsum, o0, o1, s0, s1, slope2, bb, lh, ll, fast, wsf_hi, wsf_r, lane);
        }
        const float lt = half_sum(lsum);
        if (pass == 0) { ms = m2; lst = lt;
#pragma unroll
            for (int r = 0; r < 8; ++r) { so[r] = o0[r]; so[8 + r] = o1[r]; } }
        else { mw = m2; lwt = lt;
#pragma unroll
            for (int r = 0; r < 8; ++r) { wo[r] = o0[r]; wo[8 + r] = o1[r]; } }
    }
    {
        float* po = (float*)kimg;
        float* pm = (float*)(smem + NS_PM) + wid * 64;
        if (lane < 16) { pm[lane * 2] = ms; pm[lane * 2 + 1] = lst; pm[32 + lane * 2] = mw; pm[32 + lane * 2 + 1] = lwt; }
#pragma unroll
        for (int a = 0; a < 2; ++a)
#pragma unroll
            for (int k = 0; k < 4; ++k) {
                float* yp = po + (8 * a + k + hi4) * 64 + r32;
                yp[0] = so[4 * a + k]; yp[32] = so[8 + 4 * a + k]; yp[1024] = wo[4 * a + k]; yp[1024 + 32] = wo[8 + 4 * a + k];
            }
    }
    __syncthreads();
    {
        const int row = tid >> 5, dcol = tid & 31, tk = row >> 2, hd = row & 3;
        float res[2][2];
#pragma unroll
        for (int br = 0; br < 2; ++br) {
            float M = -1e30f;
#pragma unroll
            for (int w = 0; w < 8; ++w) M = fmaxf(M, ((const float*)(smem + NS_PM))[w * 64 + br * 32 + row * 2]);
            float L = 0.f, a0 = 0.f, a1 = 0.f;
#pragma unroll
            for (int w = 0; w < 8; ++w) {
                const float* pmw = (const float*)(smem + NS_PM) + w * 64 + br * 32 + row * 2;
                const float f = __builtin_amdgcn_exp2f(pmw[0] - M);
                const float* pow_ = (const float*)(smem + NS_IMG + w * 16384) + br * 1024 + row * 64 + dcol;
                L += pmw[1] * f; a0 += pow_[0] * f; a1 += pow_[32] * f;
            }
            const float gate = sigmoidf_(p.SM[(rowbase + tk) * 64 + 8 + (br + 1) * 16 + g * 4 + hd]);
            const float sc = L > 0.f ? gate / L : 0.f;
            res[br][0] = a0 * sc; res[br][1] = a1 * sc;
        }
        const float y0 = ycmp[row * 64 + dcol] + res[0][0] + res[1][0], y1 = ycmp[row * 64 + dcol + 32] + res[0][1] + res[1][1];
        bf16_t* yb = p.YB + (rowbase + tk) * 1024 + (g * 4 + hd) * 64;
        yb[dcol] = f2bf(y0); yb[dcol + 32] = f2bf(y1);
    }
}

constexpr int NP_KVB = 18432, NP_KV0 = 0, NP_KV1 = NP_KVB, NP_WSF = 2 * NP_KVB, NP_IMP = NP_WSF + 2048, NP_SEL = NP_IMP + 16384, NP_LIST = NP_SEL + 512, NP_YAC = NP_LIST + 256, NP_LDS = NP_YAC + 65536;
static_assert(NP_LDS <= 152 * 1024, "lds");
DEVI void blk_store_ext(const BlkDesc& d, int pstep, int poff, int t0, char* kimg, char* vimg, int tid, const u32x4& rk, const u32x4& rv) {
    const int key = tid & 63, chunk = tid >> 6;
    *(u32x4*)(kimg + chunk * 1024 + key * 16) = rk;
    *(u32x4*)(vimg + (chunk >> 2) * 4096 + key * 64 + (chunk & 3) * 16) = rv;
    if (chunk == 0) {
        const int rel = d.pos0 + key * pstep + poff - t0;
        const int phi = (rel >> 6) << 6, plo = rel & 63;
        const unsigned bh = pack2((float)phi, (float)phi), bl = pack2((float)plo, (float)plo);
        *(u32x4*)(kimg + 8 * 1024 + key * 16) = (u32x4){bh, bl, 0x00003F80u, 0u};
    }
}
DEVI void attn_tile2(const char* kimg, const char* vimg, const bf16x8 (&qr)[4], const bf16x8 qext, float& m, float& lsum, f32x16& o0, f32x16& o1, f32x16& s0, f32x16& s1,
                     int lh, int ll, bool fast, float* wsf_hi, float* wsf_r, int lane) {
    const int r32 = lane & 31, hi = lane >> 5;
    const f32x16 z = {};
    s0 = z; s1 = z;
    {
        const char* kp = kimg + hi * 1024 + r32 * 16;
#pragma unroll
        for (int d0 = 0; d0 < 5; ++d0) {
            const bf16x8 k0 = *(const bf16x8*)(kp + d0 * 2048), k1 = *(const bf16x8*)(kp + d0 * 2048 + 512);
            const bf16x8 qf = d0 < 4 ? qr[d0 < 4 ? d0 : 0] : qext;
            s0 = MFMA32(k0, qf, s0); s1 = MFMA32(k1, qf, s1);
        }
    }
    if (!fast) {
#pragma unroll
        for (int r = 0; r < 16; ++r) {
            const int c = (r & 3) + 8 * (r >> 2);
            s0[r] = (c <= lh && c > ll) ? s0[r] : -INFINITY; s1[r] = (c + 32 <= lh && c + 32 > ll) ? s1[r] : -INFINITY;
        }
    }
    float mx = fmaxf(s0[0], s1[0]);
#pragma unroll
    for (int r = 1; r < 16; ++r) mx = fmaxf(mx, fmaxf(s0[r], s1[r]));
    mx = half_max(mx);
    const float mnew = fmaxf(m, mx);
    const float f = __builtin_amdgcn_exp2f((m - mnew) * 1.4426950408889634f);
    m = mnew;
    const float nm2 = -mnew * 1.4426950408889634f;
    float ps = 0.f;
#pragma unroll
    for (int r = 0; r < 16; ++r) { s0[r] = __builtin_amdgcn_exp2f(fmaf(s0[r], 1.4426950408889634f, nm2)); s1[r] = __builtin_amdgcn_exp2f(fmaf(s1[r], 1.4426950408889634f, nm2)); ps += s0[r] + s1[r]; }
    lsum = lsum * f + ps;
    if (__any(f != 1.f)) {
        if (hi == 0) *wsf_r = f;
        asm volatile("s_waitcnt lgkmcnt(0)" ::: "memory");
#pragma unroll
        for (int a = 0; a < 4; ++a) {
            const f32x4 fv = *(const f32x4*)(wsf_hi + 8 * a);
#pragma unroll
            for (int k = 0; k < 4; ++k) { o0[4 * a + k] *= fv[k]; o1[4 * a + k] *= fv[k]; }
        }
        asm volatile("s_waitcnt lgkmcnt(0)" ::: "memory");
    }
    u32x4 pw[4];
#pragma unroll
    for (int k = 0; k < 4; ++k) { pw[0][k] = cvtpk(s0[2 * k], s0[2 * k + 1]); pw[1][k] = cvtpk(s0[8 + 2 * k], s0[8 + 2 * k + 1]); pw[2][k] = cvtpk(s1[2 * k], s1[2 * k + 1]); pw[3][k] = cvtpk(s1[8 + 2 * k], s1[8 + 2 * k + 1]); }
    const lds_cptr vp = (lds_cptr)vimg + ((lane >> 4) & 1) * 32 + (lane & 3) * 8 + (4 * hi + ((lane & 15) >> 2)) * 64;
#pragma unroll
    for (int i = 0; i < 8; ++i) {
        const s16x4 lo = vtr(vp + ((i >> 2) * 4096 + (i & 3) * 1024)), hh = vtr(vp + ((i >> 2) * 4096 + (i & 3) * 1024 + 512));
        const bf16x8 vf = (bf16x8){lo[0], lo[1], lo[2], lo[3], hh[0], hh[1], hh[2], hh[3]};
        const bf16x8 pf = __builtin_bit_cast(bf16x8, pw[i & 3]);
        if (i < 4) o0 = MFMA32(pf, vf, o0); else o1 = MFMA32(pf, vf, o1);
    }
}

DEVI void attn_tile3(const char* kA, const char* vA, const char* kB, const char* vB, const bf16x8 (&qr)[4], const bf16x8 qeA, const bf16x8 qeB, float& m, float& lsum,
                     f32x16& o0, f32x16& o1, int lhA, int llA, bool fastA, int lhB, int llB, bool fastB, float* wsf_hi, float* wsf_r, int lane) {
    const int r32 = lane & 31, hi = lane >> 5;
    f32x16 a0 = {}, a1 = {}, b0 = {}, b1 = {};
    {
        const char* kpa = kA + hi * 1024 + r32 * 16; const char* kpb = kB + hi * 1024 + r32 * 16;
#pragma unroll
        for (int d0 = 0; d0 < 5; ++d0) {
            const bf16x8 ka0 = *(const bf16x8*)(kpa + d0 * 2048), ka1 = *(const bf16x8*)(kpa + d0 * 2048 + 512);
            const bf16x8 kb0 = *(const bf16x8*)(kpb + d0 * 2048), kb1 = *(const bf16x8*)(kpb + d0 * 2048 + 512);
            const bf16x8 qa = d0 < 4 ? qr[d0 < 4 ? d0 : 0] : qeA, qb = d0 < 4 ? qr[d0 < 4 ? d0 : 0] : qeB;
            a0 = MFMA32(ka0, qa, a0); a1 = MFMA32(ka1, qa, a1); b0 = MFMA32(kb0, qb, b0); b1 = MFMA32(kb1, qb, b1);
        }
    }
    if (!fastA) {
#pragma unroll
        for (int r = 0; r < 16; ++r) { const int c = (r & 3) + 8 * (r >> 2); a0[r] = (c <= lhA && c > llA) ? a0[r] : -INFINITY; a1[r] = (c + 32 <= lhA && c + 32 > llA) ? a1[r] : -INFINITY; }
    }
    if (!fastB) {
#pragma unroll
        for (int r = 0; r < 16; ++r) { const int c = (r & 3) + 8 * (r >> 2); b0[r] = (c <= lhB && c > llB) ? b0[r] : -INFINITY; b1[r] = (c + 32 <= lhB && c + 32 > llB) ? b1[r] : -INFINITY; }
    }
    float mx = fmaxf(fmaxf(a0[0], a1[0]), fmaxf(b0[0], b1[0]));
#pragma unroll
    for (int r = 1; r < 16; ++r) mx = fmaxf(mx, fmaxf(fmaxf(a0[r], a1[r]), fmaxf(b0[r], b1[r])));
    mx = half_max(mx);
    const float mnew = fmaxf(m, mx);
    const float f = __builtin_amdgcn_exp2f((m - mnew) * 1.4426950408889634f);
    m = mnew;
    const float nm2 = -mnew * 1.4426950408889634f;
    float ps = 0.f;
#pragma unroll
    for (int r = 0; r < 16; ++r) {
        a0[r] = __builtin_amdgcn_exp2f(fmaf(a0[r], 1.4426950408889634f, nm2)); a1[r] = __builtin_amdgcn_exp2f(fmaf(a1[r], 1.4426950408889634f, nm2));
        b0[r] = __builtin_amdgcn_exp2f(fmaf(b0[r], 1.4426950408889634f, nm2)); b1[r] = __builtin_amdgcn_exp2f(fmaf(b1[r], 1.4426950408889634f, nm2));
        ps += (a0[r] + a1[r]) + (b0[r] + b1[r]);
    }
    lsum = lsum * f + ps;
    if (__any(f != 1.f)) {
        if (hi == 0) *wsf_r = f;
        asm volatile("s_waitcnt lgkmcnt(0)" ::: "memory");
#pragma unroll
        for (int a = 0; a < 4; ++a) {
            const f32x4 fv = *(const f32x4*)(wsf_hi + 8 * a);
#pragma unroll
            for (int k = 0; k < 4; ++k) { o0[4 * a + k] *= fv[k]; o1[4 * a + k] *= fv[k]; }
        }
        asm volatile("s_waitcnt lgkmcnt(0)" ::: "memory");
    }
    const int voff = ((lane >> 4) & 1) * 32 + (lane & 3) * 8 + (4 * hi + ((lane & 15) >> 2)) * 64;
#pragma unroll
    for (int t = 0; t < 2; ++t) {
        const f32x16& p0 = t == 0 ? a0 : b0; const f32x16& p1 = t == 0 ? a1 : b1;
        u32x4 pw[4];
#pragma unroll
        for (int k = 0; k < 4; ++k) { pw[0][k] = cvtpk(p0[2 * k], p0[2 * k + 1]); pw[1][k] = cvtpk(p0[8 + 2 * k], p0[8 + 2 * k + 1]); pw[2][k] = cvtpk(p1[2 * k], p1[2 * k + 1]); pw[3][k] = cvtpk(p1[8 + 2 * k], p1[8 + 2 * k + 1]); }
        const lds_cptr vp = (lds_cptr)(t == 0 ? vA : vB) + voff;
#pragma unroll
        for (int i = 0; i < 8; ++i) {
            const s16x4 lo = vtr(vp + ((i >> 2) * 4096 + (i & 3) * 1024)), hh = vtr(vp + ((i >> 2) * 4096 + (i & 3) * 1024 + 512));
            const bf16x8 vf = (bf16x8){lo[0], lo[1], lo[2], lo[3], hh[0], hh[1], hh[2], hh[3]};
            const bf16x8 pf = __builtin_bit_cast(bf16x8, pw[i & 3]);
            if (i < 4) o0 = MFMA32(pf, vf, o0); else o1 = MFMA32(pf, vf, o1);
        }
    }
}

constexpr int NQ_KVB = 18432, NQ_WSF = 4 * NQ_KVB, NQ_SEL = NQ_WSF + 2048, NQ_LIST = NQ_SEL + 512, NQ_YAC = NQ_LIST + 256, NQ_LDS = NQ_YAC + 65536, NQ_IMP = 2 * NQ_KVB;
static_assert(NQ_LDS <= 152 * 1024, "lds");
DEVI void nsa_prompt_unit(const P& p, char* smem, int b, int g, int qt) {
    const int tid = tid_opq(), lane = tid & 63, wid = tid >> 6, r32 = lane & 31, hi = lane >> 5;
    float* wsf = (float*)(smem + NQ_WSF) + wid * 64;
    float* impb = (float*)(smem + NQ_IMP) + wid * 512;
    unsigned long long* selm = (unsigned long long*)(smem + NQ_SEL);
    unsigned char* blist = (unsigned char*)(smem + NQ_LIST);
    const int t0 = qt * 64;
    const size_t rowbase = (size_t)b * 4096 + t0;
    const int tokl = wid * 8 + (r32 >> 2), head = r32 & 3;
    const int qpos = t0 + tokl;
    const float slope = alibi_slope(g * 4 + head);
    bf16x8 qr[4];
    {
        const bf16_t* qp = p.PROJ + (rowbase + tokl) * PS + C_BQ + (g * 4 + head) * 64 + hi * 8;
#pragma unroll
        for (int d0 = 0; d0 < 4; ++d0) {
            u32x4 v = *(const u32x4*)(qp + d0 * 16);
#pragma unroll
            for (int k = 0; k < 4; ++k) { const float lo = __uint_as_float(v[k] << 16) * 0.125f, hh = __uint_as_float(v[k] & 0xFFFF0000u) * 0.125f; v[k] = (__float_as_uint(lo) >> 16) | (__float_as_uint(hh) & 0xFFFF0000u); }
            qr[d0] = __builtin_bit_cast(bf16x8, v);
        }
    }
    unsigned qe_w;
    { const unsigned sh = (unsigned)f2bf(slope); const float rem = slope - __uint_as_float(sh << 16); qe_w = sh | ((unsigned)f2bf(rem) << 16); if (hi) qe_w = 0u; }
    int hi4 = 4 * hi; asm volatile("" : "+v"(hi4));
    float* yl = (float*)(smem + NQ_YAC) + wid * 2048 + hi4 * 64 + r32;
    float* wsf_hi = wsf + hi4; float* wsf_r = wsf + r32;
    f32x16 o0, o1; float m, lsum;
    auto finish = [&](int br) {
        const float lt = half_sum(lsum);
        float fac = 0.f;
        if (lt > 0.f) fac = sigmoidf_(p.SM[(rowbase + tokl) * 64 + 8 + br * 16 + g * 4 + head]) / lt;
        if (hi == 0) *wsf_r = fac;
        asm volatile("s_waitcnt lgkmcnt(0)" ::: "memory");
#pragma unroll
        for (int a = 0; a < 4; ++a) {
            const f32x4 fv = *(const f32x4*)(wsf_hi + 8 * a);
#pragma unroll
            for (int k = 0; k < 4; ++k) {
                float* yp = yl + (8 * a + k) * 64;
                if (br == 0) { yp[0] = o0[4 * a + k] * fv[k]; yp[32] = o1[4 * a + k] * fv[k]; }
                else { yp[0] += o0[4 * a + k] * fv[k]; yp[32] += o1[4 * a + k] * fv[k]; }
            }
        }
        asm volatile("s_waitcnt lgkmcnt(0)" ::: "memory");
    };
    __syncthreads();
    if (tid < 64) *(u32x4*)(smem + 9 * 1024 + tid * 16) = (u32x4){0u, 0u, 0u, 0u};
    {
        const BlkDesc d = nsa_desc(p, true, b, g, 0, 0);
        u32x4 rk, rv; blk_load(d, tid, rk, rv); blk_store_ext(d, 64, 63, t0, smem, smem + 10240, tid, rk, rv);
        __syncthreads();
        o0 = (f32x16){}; o1 = (f32x16){}; m = -1e30f; lsum = 0.f;
        f32x16 s0, s1;
        {
            const int nv = ((qpos + 1) >> 6) - 1;
            const int lh = (nv < 63 ? nv : 63) - hi4;
            const bf16x8 qext = __builtin_bit_cast(bf16x8, (u32x4){qe_w, qe_w, 0u, 0u});
            attn_tile2(smem, smem + 10240, qr, qext, m, lsum, o0, o1, s0, s1, lh, -1000, false, wsf_hi, wsf_r, lane);
        }
        const float lt = half_sum(lsum);
        const float inv = lt > 0.f ? 1.f / lt : 0.f;
        unsigned x[64];
#pragma unroll
        for (int r = 0; r < 16; ++r) {
#pragma unroll
            for (int n = 0; n < 2; ++n) {
                float a = (n == 0 ? s0[r] : s1[r]) * inv;
                a += __shfl_xor(a, 1); a += __shfl_xor(a, 2);
                const int j = (r & 3) + 8 * (r >> 2) + 32 * n + hi4;
                if (j == qt || j == 0) a = 5.0f;
                if (j > qt) a = -1.0f;
                const unsigned u = __float_as_uint(a);
                const unsigned o = (u & 0x80000000u) ? ~u : (u | 0x80000000u);
                x[n * 16 + r] = (o & ~63u) | (unsigned)(63 - j);
            }
        }
        finish(0);
        sort16_desc<0>(x); sort16_desc<16>(x);
        unsigned th[16], oth[16], fin[16];
        merge_top16(&x[0], &x[16], th);
#pragma unroll
        for (int i = 0; i < 16; ++i) { auto rr = __builtin_amdgcn_permlane32_swap(th[i], th[i], false, false); oth[i] = hi ? rr[0] : rr[1]; }
        merge_top16(th, oth, fin);
        unsigned long long mask = 0ull;
#pragma unroll
        for (int i = 0; i < 16; ++i) mask |= 1ull << (63u - (fin[i] & 63u));
        if (head == 0 && hi == 0) selm[wid * 8 + (r32 >> 2)] = mask;
    }
    __syncthreads();
    if (wid == 0) {
        unsigned long long u = selm[lane];
#pragma unroll
        for (int o = 32; o > 0; o >>= 1) u |= __shfl_xor(u, o);
        u &= (qt == 63) ? ~0ull : ((1ull << (qt + 1)) - 1ull);
        {
            const int n = __builtin_popcountll(u);
            if ((u >> lane) & 1ull) blist[2 + __builtin_popcountll(lane < 63 ? (u >> (lane + 1)) : 0ull)] = (unsigned char)lane;
            const int w0 = qt - 8 > 0 ? qt - 8 : 0, nw = qt - w0 + 1;
            if (lane < nw) blist[2 + n + lane] = (unsigned char)(qt - lane);
            if (lane == 0) { blist[0] = (unsigned char)n; blist[1] = (unsigned char)nw; }
        }
    }
    __syncthreads();
    if (tid >= 64 && tid < 256) *(u32x4*)(smem + (tid >> 6) * NQ_KVB + 9 * 1024 + (tid & 63) * 16) = (u32x4){0u, 0u, 0u, 0u};
    const int ns = blist[0], nw = blist[1];
    const int nss = (ns + 1) >> 1, nsteps = nss + ((nw + 1) >> 1);
    const unsigned long long mysel = selm[tokl];
    {
        auto step_blocks = [&](int s, int& br, int& jA, int& jB) {
            if (s < nss) { br = 1; jA = blist[2 + 2 * s]; jB = 2 * s + 1 < ns ? (int)blist[2 + 2 * s + 1] : -1; }
            else { const int w = s - nss; br = 2; jA = blist[2 + ns + 2 * w]; jB = 2 * w + 1 < nw ? (int)blist[2 + ns + 2 * w + 1] : -1; }
        };
        u32x4 rkA, rvA, rkB, rvB;
        auto load_step = [&](int s) {
            int br, jA, jB; step_blocks(s, br, jA, jB);
            const BlkDesc dA = nsa_desc(p, true, b, g, br, jA); blk_load(dA, tid, rkA, rvA);
            if (jB >= 0) { const BlkDesc dB = nsa_desc(p, true, b, g, br, jB); blk_load(dB, tid, rkB, rvB); }
        };
        auto store_step = [&](int s, char* buf) {
            int br, jA, jB; step_blocks(s, br, jA, jB);
            BlkDesc dA; dA.pos0 = jA * 64; blk_store_ext(dA, 1, 0, t0, buf, buf + 10240, tid, rkA, rvA);
            if (jB >= 0) { BlkDesc dB; dB.pos0 = jB * 64; blk_store_ext(dB, 1, 0, t0, buf + NQ_KVB, buf + NQ_KVB + 10240, tid, rkB, rvB); }
        };
        load_step(0); store_step(0, smem);
        __syncthreads();
        int prev_br = 1;
        o0 = (f32x16){}; o1 = (f32x16){}; m = -1e30f; lsum = 0.f;
        for (int s = 0; s < nsteps; ++s) {
            int br, jA, jB; step_blocks(s, br, jA, jB);
            char* cur = smem + (s & 1) * 2 * NQ_KVB;
            char* nxt = smem + ((s & 1) ^ 1) * 2 * NQ_KVB;
            if (s + 1 < nsteps) load_step(s + 1);
            if (br != prev_br) { finish(1); o0 = (f32x16){}; o1 = (f32x16){}; m = -1e30f; lsum = 0.f; prev_br = br; }
            {
                asm volatile("" : "+v"(hi4));
                const bool lselA = br == 2 || ((mysel >> jA) & 1ull);
                const int relA = qpos - jA * 64;
                const int lhA = (relA < 63 ? relA : 63) - hi4, llA = (br == 2 ? relA - 512 : -1000) - hi4;
                const bool fastA = __all(!lselA || (lhA >= 59 && llA < 0));
                const bool needA = __any(lselA && lhA + hi4 >= 0 && llA + hi4 < 63);
                const bf16x8 qeA = __builtin_bit_cast(bf16x8, (u32x4){qe_w, qe_w, (lselA || hi) ? 0u : 0x0000C6EAu, 0u});
                bool needB = false; bool lselB = false; int lhB = -1000, llB = -1000; bool fastB = false;
                if (jB >= 0) {
                    lselB = br == 2 || ((mysel >> jB) & 1ull);
                    const int relB = qpos - jB * 64;
                    lhB = (relB < 63 ? relB : 63) - hi4; llB = (br == 2 ? relB - 512 : -1000) - hi4;
                    fastB = __all(!lselB || (lhB >= 59 && llB < 0));
                    needB = __any(lselB && lhB + hi4 >= 0 && llB + hi4 < 63);
                }
                const bf16x8 qeB = __builtin_bit_cast(bf16x8, (u32x4){qe_w, qe_w, (lselB || hi) ? 0u : 0x0000C6EAu, 0u});
                f32x16 s0, s1;
                if (needA && needB) attn_tile3(cur, cur + 10240, cur + NQ_KVB, cur + NQ_KVB + 10240, qr, qeA, qeB, m, lsum, o0, o1, lhA, llA, fastA, lhB, llB, fastB, wsf_hi, wsf_r, lane);
                else if (needA) attn_tile2(cur, cur + 10240, qr, qeA, m, lsum, o0, o1, s0, s1, lhA, llA, fastA, wsf_hi, wsf_r, lane);
                else if (needB) attn_tile2(cur + NQ_KVB, cur + NQ_KVB + 10240, qr, qeB, m, lsum, o0, o1, s0, s1, lhB, llB, fastB, wsf_hi, wsf_r, lane);
            }
            if (s + 1 < nsteps) store_step(s + 1, nxt);
            __syncthreads();
        }
        finish(2);
    }
    {
        const float* yac = (const float*)(smem + NQ_YAC) + wid * 2048;
#pragma unroll
        for (int i = 0; i < 4; ++i) {
            const int orow = i * 8 + (lane >> 3), ch = lane & 7, tk = wid * 8 + (orow >> 2), hd = orow & 3;
            const f32x4 a = *(const f32x4*)(yac + orow * 64 + ch * 8), c = *(const f32x4*)(yac + orow * 64 + ch * 8 + 4);
            *(u32x4*)(p.YB + (rowbase + tk) * 1024 + (g * 4 + hd) * 64 + ch * 8) = pack8f(a, c);
        }
        asm volatile("s_waitcnt lgkmcnt(0)" ::: "memory");
    }
}

DEVI void stage_nsa_attn(const P& p, char* smem, int bid, int nblk) {
    (void)bid; (void)nblk;
    unsigned* head = p.bar + 3840;
    volatile unsigned* slot = (volatile unsigned*)(smem + 150 * 1024);
    for (;;) {
        __syncthreads();
        if (tid_opq() == 0) *slot = __hip_atomic_fetch_add(head, 1u, __ATOMIC_RELAXED, __HIP_MEMORY_SCOPE_AGENT);
        __syncthreads();
        const unsigned i = *slot;
        if (i >= 1536u) break;
        if (i < 1024u) nsa_prompt_unit(p, smem, (int)((i & 15u) >> 2), (int)(i & 3u), 63 - (int)(i >> 4));
        else nsa_sample_unit(p, smem, (int)i - 1024);
    }
}

DEVI void stage2_queue(const P& p, char* smem) {
    unsigned* head = p.bar + 3904;
    volatile unsigned* slot = (volatile unsigned*)(smem + 150 * 1024);
    constexpr int BIG = 1 << 20;
    for (;;) {
        __syncthreads();
        if (tid_opq() == 0) *slot = __hip_atomic_fetch_add(head, 1u, __ATOMIC_RELAXED, __HIP_MEMORY_SCOPE_AGENT);
        __syncthreads();
        const unsigned i = *slot;
        if (i >= 1824u) break;
        int kind, t;
        if (i < 16u) { kind = 0; t = (int)i; }
        else if (i < 528u) { const unsigned j = i - 16u; kind = (j & 1u) ? 1 : 2; t = (int)(j >> 1); }
        else if (i < 544u) { kind = 2; t = 256 + (int)(i - 528u); }
        else { const unsigned j = i - 544u, q = j / 5u, r = j - q * 5u; if (r < 3u) { kind = 1; t = 256 + (int)(q * 3u + r); } else { kind = 3; t = (int)(q * 2u + r - 3u); } }
        if (kind == 0) stage_mlstm_gates(p, smem, t, BIG);
        else if (kind == 1) stage_mlstm_dc(p, smem, t, BIG);
        else if (kind == 2) stage_compress(p, smem, 0, BIG, t);
        else stage_mlstm_sample(p, smem, t, BIG);
    }
}

DEVI void stage_ln1(const P& p, int bid, int nblk) {
    const int lane = tid_opq() & 63, wid = tid_opq() >> 6;
    for (int row = bid * 8 + wid; row < NT; row += nblk * 8) {
        f32x4 x[4];
        float s = 0.f;
#pragma unroll
        for (int i = 0; i < 4; ++i) { x[i] = *(const f32x4*)(p.R + (size_t)row * 1024 + i * 256 + lane * 4); s += x[i][0] + x[i][1] + x[i][2] + x[i][3]; }
        const float mean = wave_sum(s) * (1.f / 1024.f);
        float q = 0.f;
#pragma unroll
        for (int i = 0; i < 4; ++i)
#pragma unroll
            for (int k = 0; k < 4; ++k) q += (x[i][k] - mean) * (x[i][k] - mean);
        const float rs = rsqrtf(wave_sum(q) * (1.f / 1024.f) + LN_EPS);
#pragma unroll
        for (int i = 0; i < 4; ++i) {
            const int c = i * 256 + lane * 4;
            const f32x4 gg = *(const f32x4*)(p.ln1_g + c), bb = *(const f32x4*)(p.ln1_b + c);
            f32x4 y;
#pragma unroll
            for (int k = 0; k < 4; ++k) y[k] = (x[i][k] - mean) * rs * gg[k] + bb[k];
            u32x2 o; o.x = pack2(y[0], y[1]); o.y = pack2(y[2], y[3]);
            *(u32x2*)(p.HB + (size_t)row * 1024 + c) = o;
        }
        if (lane == 0) { p.H[(size_t)row * 2] = mean; p.H[(size_t)row * 2 + 1] = rs; }
    }
}

__device__ const unsigned char PEER_CA[50] = {0,0,0,0,0,0,0,0,0,0,0,0,0,0,0,0, 1,1,1,1,1,1,1,1, 2,2,2,2,2, 3,3,3,3, 4,4,4, 5,5, 6,6, 7,7, 8,9,10,11,12,13,14,15};
__device__ const unsigned char PEER_CB[50] = {0,1,2,3,4,5,6,7,8,9,10,11,12,13,14,15, 0,1,2,3,4,5,6,7, 0,1,2,3,4, 0,1,2,3, 0,1,2, 0,1, 0,1, 0,1, 0,0,0,0,0,0,0,0};

DEVI float key_score(unsigned k) { const unsigned u = k & ~127u; return __uint_as_float((u & 0x80000000u) ? (u & 0x7FFFFFFFu) : ~u); }

DEVI void sort8_desc(unsigned (&x)[16]) {
#pragma unroll
    for (int k = 2; k <= 8; k <<= 1)
#pragma unroll
        for (int j = k >> 1; j > 0; j >>= 1)
#pragma unroll
            for (int i = 0; i < 8; ++i) {
                const int l = i ^ j;
                if (l > i) { if ((i & k) == 0) ce_desc(x[i], x[l]); else ce_desc(x[l], x[i]); }
            }
}
DEVI unsigned sum_key(unsigned ka, unsigned kb, unsigned tag) {
    const unsigned u = __float_as_uint(key_score(ka) + key_score(kb));
    const unsigned o = (u & 0x80000000u) ? ~u : (u | 0x80000000u);
    return (o & ~255u) | tag;
}
DEVI float key_score8(unsigned k) { const unsigned u = k & ~255u; return __uint_as_float((u & 0x80000000u) ? (u & 0x7FFFFFFFu) : ~u); }

DEVI void route_top16(const P& p, int row, int ph, int c, int r32, int hi, int hi4, unsigned (&fin)[16]) {
    f32x16 acc[4];
#pragma unroll
    for (int t = 0; t < 4; ++t) acc[t] = (f32x16){};
    const bf16_t* qp = p.PQ + (size_t)row * 2048 + ph * 256 + c * 128 + hi * 8;
    const bf16_t* kp = p.KEYSB + ((size_t)((ph * 2 + c) * 128 + r32)) * 128 + hi * 8;
#pragma unroll
    for (int s8 = 0; s8 < 8; ++s8) {
        const bf16x8 qf = *(const bf16x8*)(qp + s8 * 16);
#pragma unroll
        for (int t = 0; t < 4; ++t) {
            const bf16x8 kf = *(const bf16x8*)(kp + (size_t)t * 32 * 128 + s8 * 16);
            acc[t] = MFMA32(kf, qf, acc[t]);
        }
    }
    unsigned x[64];
#pragma unroll
    for (int t = 0; t < 4; ++t)
#pragma unroll
        for (int r = 0; r < 16; ++r) {
            const unsigned u = __float_as_uint(acc[t][r]);
            const unsigned o = (u & 0x80000000u) ? ~u : (u | 0x80000000u);
            x[t * 16 + r] = (o & ~127u) | (unsigned)(127 - ((r & 3) + 8 * (r >> 2) + 32 * t) - hi4);
        }
    sort16_desc<0>(x); sort16_desc<16>(x); sort16_desc<32>(x); sort16_desc<48>(x);
    unsigned t01[16], t23[16], tt[16], oth[16];
    merge_top16(&x[0], &x[16], t01); merge_top16(&x[32], &x[48], t23); merge_top16(t01, t23, tt);
#pragma unroll
    for (int i = 0; i < 16; ++i) { auto rr = __builtin_amdgcn_permlane32_swap(tt[i], tt[i], false, false); oth[i] = hi ? rr[0] : rr[1]; }
    merge_top16(tt, oth, fin);
}

DEVI void stage_peer_route(const P& p, char* smem, int bid, int nblk, int p0, int p1) {
    const int lane = tid_opq() & 63, wid = tid_opq() >> 6, r32 = lane & 31, hi = lane >> 5;
    unsigned char* tb = (unsigned char*)smem + wid * 1024 + r32 * 32;
    const int tpw = (NT + nblk - 1) / nblk, row_lo = bid * tpw, row_hi = (row_lo + tpw < NT) ? row_lo + tpw : NT;
    const int ph = wid;
    for (int pass = p0; pass < p1 && row_lo + pass * 32 < row_hi; ++pass) {
        const int row_raw = row_lo + pass * 32 + r32;
        const bool row_ok = row_raw < row_hi;
        const int row = row_ok ? row_raw : row_lo;
        int hi4 = 4 * hi; asm volatile("" : "+v"(hi4));
        unsigned fa[16], fb[16];
        route_top16(p, row, ph, 0, r32, hi, hi4, fa);
        asm volatile("" : "+v"(hi4));
        route_top16(p, row, ph, 1, r32, hi, hi4, fb);
        if (hi == 0) {
            u32x4 wa, wb;
#pragma unroll
            for (int i = 0; i < 4; ++i) {
                wa[i] = (127u - (fa[4 * i] & 127u)) | ((127u - (fa[4 * i + 1] & 127u)) << 8) | ((127u - (fa[4 * i + 2] & 127u)) << 16) | ((127u - (fa[4 * i + 3] & 127u)) << 24);
                wb[i] = (127u - (fb[4 * i] & 127u)) | ((127u - (fb[4 * i + 1] & 127u)) << 8) | ((127u - (fb[4 * i + 2] & 127u)) << 16) | ((127u - (fb[4 * i + 3] & 127u)) << 24);
            }
            *(u32x4*)tb = wa; *(u32x4*)(tb + 16) = wb;
        }
        unsigned g0[16], g1[16], g2[16], g3[16];
#pragma unroll
        for (int j = 0; j < 16; ++j) g0[j] = sum_key(fa[0], fb[j], (unsigned)j);
#pragma unroll
        for (int k = 0; k < 15; ++k) g1[k] = sum_key(fa[k + 1], fb[0], (unsigned)((k + 1) << 4));
        g1[15] = 0u;
#pragma unroll
        for (int j = 1; j < 8; ++j) g2[j - 1] = sum_key(fa[1], fb[j], (unsigned)(16 | j));
        g2[7] = 0u; g2[8] = 0u; g2[9] = 0u;
#pragma unroll
        for (int i = 2; i < 8; ++i) g2[17 - i] = sum_key(fa[i], fb[1], (unsigned)((i << 4) | 1));
#pragma unroll
        for (int j = 8; j > 0; j >>= 1)
#pragma unroll
            for (int i = 0; i < 16; ++i) { const int l = i ^ j; if (l > i) ce_desc(g2[i], g2[l]); }
        g3[0] = sum_key(fa[2], fb[2], 0x22u); g3[1] = sum_key(fa[2], fb[3], 0x23u); g3[2] = sum_key(fa[2], fb[4], 0x24u);
        g3[3] = sum_key(fa[3], fb[2], 0x32u); g3[4] = sum_key(fa[4], fb[2], 0x42u); g3[5] = sum_key(fa[3], fb[3], 0x33u);
#pragma unroll
        for (int i = 6; i < 16; ++i) g3[i] = 0u;
        sort8_desc(g3);
        unsigned t01[16], t23[16], top[16];
        merge_top16(g0, g1, t01); merge_top16(g2, g3, t23); merge_top16(t01, t23, top);
        float ev[16]; float sum = 0.f;
        const float vmax = key_score8(top[0]);
#pragma unroll
        for (int k = 0; k < 16; ++k) { ev[k] = __expf(key_score8(top[k]) - vmax); sum += ev[k]; }
        const float inv = 1.f / sum;
        asm volatile("s_waitcnt lgkmcnt(0)" ::: "memory");
        if (!row_ok) {   } else if (hi == 0) {
            int* dst = p.EIDX + (size_t)row * 128 + ph * 16;
#pragma unroll
            for (int q4 = 0; q4 < 4; ++q4) {
                u32x4 o;
#pragma unroll
                for (int k = 0; k < 4; ++k) { const unsigned tg = top[q4 * 4 + k] & 255u; o[k] = (unsigned)tb[tg >> 4] * 128u + (unsigned)tb[16 + (tg & 15u)]; }
                *(u32x4*)(dst + q4 * 4) = o;
            }
        } else {
            float* dst = p.EGATE + (size_t)row * 128 + ph * 16;
#pragma unroll
            for (int q4 = 0; q4 < 4; ++q4) *(f32x4*)(dst + q4 * 4) = (f32x4){ev[q4 * 4] * inv, ev[q4 * 4 + 1] * inv, ev[q4 * 4 + 2] * inv, ev[q4 * 4 + 3] * inv};
        }
        asm volatile("s_waitcnt lgkmcnt(0)" ::: "memory");
    }
}

constexpr int PA_WAVE_LDS = 1024 + 1024 + 512 + 512 + 512 + 4096;
DEVI void stage_peer_apply(const P& p, char* smem, int bid, int nblk, int p0, int p1) {
    const int lane = tid_opq() & 63, wid = tid_opq() >> 6;
    char* wl = smem + wid * PA_WAVE_LDS;
    int* idxs = (int*)(wl + 2048);
    float* gts = (float*)(wl + 2560);
    float* cs = (float*)(wl + 3072);
    const int fr = lane & 15, fq = lane >> 4;
    const int tpw = (NT + nblk - 1) / nblk, row_lo = bid * tpw, row_hi = (row_lo + tpw < NT) ? row_lo + tpw : NT;
    for (int row = row_lo + p0 * 32 + wid; row < row_hi && row < row_lo + p1 * 32; row += 8) {
        float* hvs = (float*)(wl + 3584);
        {
            const float* hr = p.R + (size_t)row * 1024 + lane * 16;
            const float mean1 = p.H[(size_t)row * 2], rs1 = p.H[(size_t)row * 2 + 1];
#pragma unroll
            for (int i = 0; i < 4; ++i) {
                f32x4 x = *(const f32x4*)(hr + i * 4);
                const f32x4 g1 = *(const f32x4*)(p.ln1_g + lane * 16 + i * 4), b1 = *(const f32x4*)(p.ln1_b + lane * 16 + i * 4);
#pragma unroll
                for (int k = 0; k < 4; ++k) x[k] = (x[k] - mean1) * rs1 * g1[k] + b1[k];
                *(f32x4*)(hvs + lane * 16 + i * 4) = x;
            }
            idxs[lane] = p.EIDX[(size_t)row * 128 + lane]; idxs[lane + 64] = p.EIDX[(size_t)row * 128 + 64 + lane];
            gts[lane] = p.EGATE[(size_t)row * 128 + lane]; gts[lane + 64] = p.EGATE[(size_t)row * 128 + 64 + lane];
            asm volatile("s_waitcnt lgkmcnt(0)" ::: "memory");
        }
        {
            f32x2 hreg[8];
#pragma unroll
            for (int i = 0; i < 4; ++i) { const f32x4 t = *(const f32x4*)(hvs + lane * 16 + i * 4); hreg[i * 2] = (f32x2){t[0], t[1]}; hreg[i * 2 + 1] = (f32x2){t[2], t[3]}; }
            U3 u0[8], u1[8];
            auto issue_u = [&](int e0, U3 (&u)[8]) {
#pragma unroll
                for (int k = 0; k < 8; ++k) u[k] = *(const U3*)(p.U8 + (size_t)idxs[e0 + k] * 768 + lane * 12);
            };
            auto dots_u = [&](const U3 (&u)[8], float (&sp)[8]) {
#pragma unroll
                for (int k = 0; k < 8; k += 2) {
                    const i32x6 src = {(int)u[k].a, (int)u[k].b, (int)u[k].c, (int)u[k + 1].a, (int)u[k + 1].b, (int)u[k + 1].c};
                    const f32x32 f = __builtin_amdgcn_cvt_scalef32_pk32_f32_fp6(src, 1.0f);
                    f32x2 s0 = (f32x2){0.f, 0.f}, s1 = (f32x2){0.f, 0.f};
#pragma unroll
                    for (int i = 0; i < 8; ++i) {
                        s0 = __builtin_elementwise_fma((f32x2){f[2 * i], f[2 * i + 1]}, hreg[i], s0);
                        s1 = __builtin_elementwise_fma((f32x2){f[16 + 2 * i], f[17 + 2 * i]}, hreg[i], s1);
                    }
                    sp[k] = s0[0] + s0[1]; sp[k + 1] = s1[0] + s1[1];
                }
            };
            auto finish_u = [&](int e0, const float (&sa)[8], const float (&sb)[8]) {
                float t[8], w[4];
#pragma unroll
                for (int i = 0; i < 8; ++i) {
                    const float x = i < 4 ? sa[2 * i] : sb[2 * i - 8], y = i < 4 ? sa[2 * i + 1] : sb[2 * i - 7];
                    const auto r = __builtin_amdgcn_permlane32_swap(__float_as_uint(x), __float_as_uint(y), false, false);
                    t[i] = __uint_as_float(r[0]) + __uint_as_float(r[1]);
                }
#pragma unroll
                for (int i = 0; i < 4; ++i) {
                    const auto r = __builtin_amdgcn_permlane16_swap(__float_as_uint(t[2 * i]), __float_as_uint(t[2 * i + 1]), false, false);
                    float v = __uint_as_float(r[0]) + __uint_as_float(r[1]);
                    v += __uint_as_float(__builtin_amdgcn_update_dpp(0u, __float_as_uint(v), 0x128, 0xf, 0xf, false));
                    v += __uint_as_float(__builtin_amdgcn_update_dpp(0u, __float_as_uint(v), 0x124, 0xf, 0xf, false));
                    v += __uint_as_float(__builtin_amdgcn_update_dpp(0u, __float_as_uint(v), 0x4e, 0xf, 0xf, false));
                    v += __uint_as_float(__builtin_amdgcn_update_dpp(0u, __float_as_uint(v), 0xb1, 0xf, 0xf, false));
                    w[i] = v;
                }
                const int c = lane & 3, r = lane >> 4;
                const float tot = c == 0 ? w[0] : c == 1 ? w[1] : c == 2 ? w[2] : w[3];
                const int k = 4 * c + ((r & 1) << 1) + (r >> 1);
                if ((lane & 15) < 4) {
                    const int e = idxs[e0 + k];
                    cs[e0 + k] = gts[e0 + k] * p.VS[e] * gelu_erf(tot * p.US[e]);
                }
            };
            issue_u(0, u0);
#pragma unroll 1
            for (int e0 = 0; e0 < 128; e0 += 16) {
                float sa[8], sb[8];
                issue_u(e0 + 8, u1);
                dots_u(u0, sa);
                if (e0 + 16 < 128) issue_u(e0 + 16, u0);
                dots_u(u1, sb);
                finish_u(e0, sa, sb);
            }
        }
        asm volatile("s_waitcnt lgkmcnt(0)" ::: "memory");
        float acc[16];
#pragma unroll
        for (int i = 0; i < 16; ++i) acc[i] = 0.f;
        {
#if V_FP6
            U3 v0[8], v1[8];
            auto issue_v = [&](int e0, U3 (&v)[8]) {
#pragma unroll
                for (int k = 0; k < 8; ++k) v[k] = *(const U3*)(p.V8 + (size_t)idxs[e0 + k] * 768 + lane * 12);
            };
            auto consume_v = [&](int e0, const U3 (&v)[8]) {
#pragma unroll
                for (int k = 0; k < 8; k += 2) {
                    const float c0 = cs[e0 + k], c1 = cs[e0 + k + 1];
                    const i32x6 src = {(int)v[k].a, (int)v[k].b, (int)v[k].c, (int)v[k + 1].a, (int)v[k + 1].b, (int)v[k + 1].c};
                    const f32x32 f = __builtin_amdgcn_cvt_scalef32_pk32_f32_fp6(src, 1.0f);
#pragma unroll
                    for (int i = 0; i < 16; ++i) { acc[i] = __builtin_fmaf(c0, f[i], acc[i]); acc[i] = __builtin_fmaf(c1, f[16 + i], acc[i]); }
                }
            };
#else
            u32x4 v0[8], v1[8];
            auto issue_v = [&](int e0, u32x4 (&v)[8]) {
#pragma unroll
                for (int k = 0; k < 8; ++k) v[k] = *(const u32x4*)(p.V8 + (size_t)idxs[e0 + k] * 1024 + lane * 16);
            };
            auto consume_v = [&](int e0, const u32x4 (&v)[8]) {
#pragma unroll
                for (int k = 0; k < 8; ++k) {
                    const float c = cs[e0 + k];
#pragma unroll
                    for (int w = 0; w < 4; ++w) {
                        const f32x2 lo = __builtin_amdgcn_cvt_pk_f32_fp8((int)v[k][w], false), hh = __builtin_amdgcn_cvt_pk_f32_fp8((int)v[k][w], true);
                        acc[w * 4] += c * lo[0]; acc[w * 4 + 1] += c * lo[1]; acc[w * 4 + 2] += c * hh[0]; acc[w * 4 + 3] += c * hh[1];
                    }
                }
            };
#endif
            issue_v(0, v0);
#pragma unroll 1
            for (int e0 = 0; e0 < 128; e0 += 16) {
                issue_v(e0 + 8, v1);
                consume_v(e0, v0);
                if (e0 + 16 < 128) issue_v(e0 + 16, v0);
                consume_v(e0 + 8, v1);
            }
        }
        float s = 0.f;
#pragma unroll
        for (int i = 0; i < 16; ++i) { acc[i] += DN_ALPHA * hvs[lane * 16 + i]; s += acc[i]; }
        const float mean = wave_sum(s) * (1.f / 1024.f);
        float q = 0.f;
#pragma unroll
        for (int i = 0; i < 16; ++i) q += (acc[i] - mean) * (acc[i] - mean);
        const float rs = rsqrtf(wave_sum(q) * (1.f / 1024.f) + LN_EPS);
#pragma unroll
        for (int i = 0; i < 4; ++i) {
            const int c = lane * 16 + i * 4;
            const f32x4 g0 = *(const f32x4*)(p.ln2_g + c), b0 = *(const f32x4*)(p.ln2_b + c);
            f32x4 y0;
#pragma unroll
            for (int k = 0; k < 4; ++k) y0[k] = (acc[i * 4 + k] - mean) * rs * g0[k] + b0[k];
            *(f32x4*)(p.out + O_Y + (size_t)row * 1024 + c) = y0;
        }
    }
}

namespace pg8 {
#define PG8_LAS __attribute__((address_space(3)))
typedef unsigned short bf16_t;
typedef short bf16x8 __attribute__((ext_vector_type(8)));
typedef float f32x4 __attribute__((ext_vector_type(4)));
typedef unsigned u32x4 __attribute__((ext_vector_type(4)));
constexpr int BM = 256, BK = 64, HALF = 128, HTB = HALF * BK * 2  , STAGE_BYTES = 8 * HTB, NXCD = 8, WGM = 8;

__host__ __device__ __forceinline__ int lds_byte(int r, int c) { const int st = (r >> 4) * 2 + (c >> 5), rr = r & 15, cc = c & 31, ob = rr * 64 + cc * 2; return st * 1024 + (ob ^ (((ob >> 9) & 1) << 5)); }
__host__ __device__ __forceinline__ void stage_rc(int b, int& R, int& C) { const int st = b / 1024, sb = b % 1024, swz = sb ^ (((sb >> 9) & 1) << 5); R = (st >> 1) * 16 + swz / 64; C = (st & 1) * 32 + (swz % 64) / 2; }
__host__ __device__ __forceinline__ int perm32(int rho) { const int n = rho >> 4, i = rho & 15; return 8 * (i >> 2) + 4 * n + (i & 3); }

struct Unit { int pm, pn; };
struct Gemm { const bf16_t* A; const bf16_t* Bt; int M, N, K; };

struct StaticOrder {
    int nM, nN, nwg, G, c;
    __host__ __device__ void init(int M, int N, int G_, int c_) { nM = M / BM; nN = N / BM; nwg = nM * nN; G = G_; c = c_; }
    __host__ __device__ bool next(int i, Unit& u) const {
        const long L = (long)i * G + c; if (L >= nwg) return false;
        int wgid = (int)L; { const int q = nwg / NXCD, r = nwg % NXCD, xcd = wgid % NXCD, off = wgid / NXCD; wgid = (xcd < r ? xcd * (q + 1) : r * (q + 1) + (xcd - r) * q) + off; }
        const int nig = WGM * nN, gid = wgid / nig, fm = gid * WGM, gsz = (nM - fm) < WGM ? (nM - fm) : WGM;
        u.pm = fm + ((wgid % nig) % gsz); u.pn = (wgid % nig) / gsz; return true;
    }
    __device__ __forceinline__ void a_ready(const Unit&) const {}
    __device__ __forceinline__ void done(const Unit&) const {}
};
template <class Epi, class Sched, bool STAMP = false>
__device__ __forceinline__ void gemm_phase(PG8_LAS unsigned char* lds, const Gemm g, const Sched& S, const Epi& E, unsigned long long* stamps) {
    const int tid = tid_opq(), wid = __builtin_amdgcn_readfirstlane(tid >> 6), lane = tid & 63, wr = wid >> 2, wc = wid & 3, fr = lane & 15, fq = lane >> 4;
    const int K = g.K, nt = K / BK;
    int ts_lo = 0, ts_hi = 0, nts = 0; const unsigned long long rt_entry = STAMP ? (unsigned long long)wall_clock64() : 0ull;
#define PG8_STAMP() do { if (STAMP && wid == 0 && nts < 64) { const unsigned long long _c = (unsigned long long)clock64(); \
        ts_lo = (lane == nts) ? (int)(unsigned)_c : ts_lo; ts_hi = (lane == nts) ? (int)(unsigned)(_c >> 32) : ts_hi; ++nts; } } while (0)
    PG8_STAMP();
    unsigned voffA[2], voffB[2];
#pragma unroll
    for (int i = 0; i < 2; ++i) { int R, C; stage_rc(tid * 16 + i * 8192, R, C); const int Rb = Epi::PERM ? ((R & ~31) + perm32(R & 31)) : R;
        voffA[i] = (unsigned)(R * K + C) * 2u; voffB[i] = (unsigned)(Rb * K + C) * 2u; }
    const size_t kstep = (size_t)(BK * 2);
    const size_t hstep = (size_t)HALF * K * 2;
    const size_t tstep = 2 * hstep;
    const unsigned ldsw = (unsigned)wid * 1024u;
    const int aoff = lds_byte(wr * 64 + fr, fq * 8), boff = lds_byte(wc * 32 + fr, fq * 8);
#define PG8_SA(b, h) (((b) * 2 + (h)) * HTB)
#define PG8_SB(b, h) ((4 + (b) * 2 + (h)) * HTB)
#define PG8_STAGE(bufoff, gbase, voff) do { _Pragma("unroll") for (int _i = 0; _i < 2; ++_i) \
        __builtin_amdgcn_global_load_lds((const unsigned*)((const char*)(gbase) + (voff)[_i]), (PG8_LAS unsigned*)(lds + (bufoff) + ldsw + _i * 8192), 16, 0, 0); } while (0)
#define PG8_LDA(dst, b, h) do { _Pragma("unroll") for (int m = 0; m < 4; ++m) _Pragma("unroll") for (int k = 0; k < 2; ++k) dst[m][k] = *(const PG8_LAS bf16x8*)(lds + PG8_SA(b, h) + aoff + m * 2048 + k * 1024); } while (0)
#define PG8_LDB(dst, b, h) do { _Pragma("unroll") for (int n = 0; n < 2; ++n) _Pragma("unroll") for (int k = 0; k < 2; ++k) dst[n][k] = *(const PG8_LAS bf16x8*)(lds + PG8_SB(b, h) + boff + n * 2048 + k * 1024); } while (0)
#define PG8_MMA(ai, bj, At, Bt) do { __builtin_amdgcn_s_setprio(1); _Pragma("unroll") for (int m = 0; m < 4; ++m) _Pragma("unroll") for (int n = 0; n < 2; ++n) _Pragma("unroll") for (int k = 0; k < 2; ++k) \
        acc[ai][bj][m][n] = __builtin_amdgcn_mfma_f32_16x16x32_bf16(Bt[n][k], At[m][k], acc[ai][bj][m][n], 0, 0, 0); __builtin_amdgcn_s_setprio(0); } while (0)
#define PG8_WAIT_V(n) asm volatile("s_waitcnt vmcnt(" #n ")" ::: "memory")
#define PG8_WAIT_L(n) asm volatile("s_waitcnt lgkmcnt(" #n ")" ::: "memory")
#define PG8_BAR __builtin_amdgcn_s_barrier()
#define PG8_SCHED __builtin_amdgcn_sched_barrier(0)
    Unit cur, nxt; int ui = 0;
    if (!S.next(0, cur)) return;
    f32x4 acc[2][2][4][2];
#pragma unroll
    for (int a = 0; a < 2; ++a)
#pragma unroll
        for (int b = 0; b < 2; ++b)
#pragma unroll
            for (int m = 0; m < 4; ++m)
#pragma unroll
                for (int n = 0; n < 2; ++n) acc[a][b][m][n] = (f32x4){0.f, 0.f, 0.f, 0.f};
    bf16x8 At[4][2], B0[2][2], B1[2][2];
    const char* cA = (const char*)g.A + (size_t)cur.pm * tstep; const char* cB = (const char*)g.Bt + (size_t)cur.pn * tstep;
    S.a_ready(cur);
    PG8_STAGE(PG8_SB(0, 0), cB, voffB); PG8_STAGE(PG8_SA(0, 0), cA, voffA); PG8_STAGE(PG8_SB(0, 1), cB + hstep, voffB); PG8_STAGE(PG8_SA(0, 1), cA + hstep, voffA);
    if (wr == 1) PG8_BAR;
    PG8_WAIT_V(4); PG8_BAR;
    PG8_STAGE(PG8_SB(1, 0), cB + kstep, voffB); PG8_STAGE(PG8_SA(1, 0), cA + kstep, voffA); PG8_STAGE(PG8_SB(1, 1), cB + hstep + kstep, voffB);
    PG8_WAIT_V(6); PG8_BAR;
    PG8_STAMP();
    for (;;) {
        const bool has_next = S.next(ui + 1, nxt);
        const char* nA = has_next ? (const char*)g.A + (size_t)nxt.pm * tstep : cA; const char* nB = has_next ? (const char*)g.Bt + (size_t)nxt.pn * tstep : cB;
        for (int t = 0; t < nt; t += 2) {
            const bool last = (t == nt - 2);
            const char* a1 = cA + (size_t)(t + 1) * kstep;
            const char* a2 = last ? nA : cA + (size_t)(t + 2) * kstep; const char* b2 = last ? nB : cB + (size_t)(t + 2) * kstep;
            const char* a3 = a2 + kstep; const char* b3 = b2 + kstep;
            if (last && has_next) S.a_ready(nxt);
            PG8_LDB(B0, 0, 0); PG8_SCHED; PG8_LDA(At, 0, 0); PG8_STAGE(PG8_SA(1, 1), a1 + hstep, voffA);
            PG8_WAIT_L(8); PG8_BAR; PG8_WAIT_L(0); PG8_MMA(0, 0, At, B0); PG8_BAR; PG8_SCHED;
            PG8_LDB(B1, 0, 1); PG8_STAGE(PG8_SB(0, 0), b2, voffB);
            PG8_BAR; PG8_WAIT_L(0); PG8_MMA(0, 1, At, B1); PG8_BAR;
            PG8_LDA(At, 0, 1); PG8_STAGE(PG8_SA(0, 0), a2, voffA);
            PG8_BAR; PG8_WAIT_L(0); PG8_MMA(1, 0, At, B0); PG8_BAR; PG8_SCHED;
            PG8_STAGE(PG8_SB(0, 1), b2 + hstep, voffB);
            PG8_WAIT_V(6); PG8_BAR; PG8_MMA(1, 1, At, B1); PG8_BAR;
            PG8_LDB(B0, 1, 0); PG8_SCHED; PG8_LDA(At, 1, 0); PG8_STAGE(PG8_SA(0, 1), a2 + hstep, voffA);
            PG8_WAIT_L(8); PG8_BAR; PG8_WAIT_L(0); PG8_MMA(0, 0, At, B0); PG8_BAR; PG8_SCHED;
            PG8_LDB(B1, 1, 1); PG8_STAGE(PG8_SB(1, 0), b3, voffB);
            PG8_BAR; PG8_WAIT_L(0); PG8_MMA(0, 1, At, B1); PG8_BAR;
            PG8_LDA(At, 1, 1); PG8_STAGE(PG8_SA(1, 0), a3, voffA);
            PG8_BAR; PG8_WAIT_L(0); PG8_MMA(1, 0, At, B0); PG8_BAR; PG8_SCHED;
            PG8_STAGE(PG8_SB(1, 1), b3 + hstep, voffB);
            PG8_WAIT_V(6); PG8_BAR; PG8_MMA(1, 1, At, B1); PG8_BAR;
        }
        PG8_STAMP();
        if constexpr (!Epi::AFTER_DRAIN) { E(acc, cur, wr, wc, fr, fq); S.done(cur); }
        PG8_STAMP();
        if (!has_next) break;
#pragma unroll
        for (int a = 0; a < 2; ++a)
#pragma unroll
            for (int b = 0; b < 2; ++b)
#pragma unroll
                for (int m = 0; m < 4; ++m)
#pragma unroll
                    for (int n = 0; n < 2; ++n) acc[a][b][m][n] = (f32x4){0.f, 0.f, 0.f, 0.f};
        cur = nxt; cA = nA; cB = nB; ++ui;
    }
    PG8_WAIT_V(0);
    if (wr == 0) PG8_BAR;
    PG8_BAR;
    if constexpr (Epi::AFTER_DRAIN) { E.fused(acc, cur, wr, wc, fr, fq, lds, wid, lane); S.done(cur); }
    PG8_STAMP();
    if (STAMP && wid == 0) { stamps[lane] = lane < nts ? (((unsigned long long)(unsigned)ts_hi << 32) | (unsigned)ts_lo) : 0ull;
        if (lane == 62) stamps[62] = rt_entry; if (lane == 63) stamps[63] = (unsigned long long)wall_clock64(); }
#undef PG8_STAMP
#undef PG8_SA
#undef PG8_SB
#undef PG8_STAGE
#undef PG8_LDA
#undef PG8_LDB
#undef PG8_MMA
#undef PG8_WAIT_V
#undef PG8_WAIT_L
#undef PG8_BAR
#undef PG8_SCHED
}
}

template <class F> struct EpiAdapt {
    static constexpr bool PERM = true, AFTER_DRAIN = false;
    F f;
    __device__ __forceinline__ void operator()(const pg8::f32x4 (&acc)[2][2][4][2], const pg8::Unit& u, int wr, int wc, int fr, int fq) const {
        constexpr int B = F::BATCH;
        const int row0 = u.pm * 256 + wr * 64 + fr, col0 = u.pn * 256 + wc * 32 + 8 * fq;
        f32x4 b0[2], b1[2];
        if constexpr (F::COLBIAS) { f.bias8(col0, b0[0], b1[0]); f.bias8(col0 + 128, b0[1], b1[1]); }
#pragma unroll
        for (int q0 = 0; q0 < 16; q0 += B) {
            typename F::Pre pre[B];
#pragma unroll
            for (int i = 0; i < B; ++i) { const int q = q0 + i, bj = q & 1, m = (q >> 1) & 3, ai = q >> 3; pre[i] = f.pre(row0 + ai * 128 + m * 16, col0 + bj * 128); }
#pragma unroll
            for (int i = 0; i < B; ++i) { const int q = q0 + i, bj = q & 1, m = (q >> 1) & 3, ai = q >> 3;
                f32x4 v0 = acc[ai][bj][m][0], v1 = acc[ai][bj][m][1];
                if constexpr (F::COLBIAS) { v0 += b0[bj]; v1 += b1[bj]; }
                f.put(row0 + ai * 128 + m * 16, col0 + bj * 128, v0, v1, pre[i]); }
        }
    }
};
template <class F>
DEVI void gemm_pg8(const bf16_t* A, const bf16_t* Bt, int M, int N, int K, const F& f, char* smem, int bid, int nblk) {
    pg8::Gemm g{A, Bt, M, N, K};
    pg8::StaticOrder S; S.init(M, N, nblk, bid);
    EpiAdapt<F> E{f};
    __syncthreads();
    pg8::gemm_phase<EpiAdapt<F>, pg8::StaticOrder, false>((PG8_LAS unsigned char*)smem, g, S, E, nullptr);
    __syncthreads();
}

template <class F>
DEVI void gemm_small_rows(const bf16_t* __restrict__ A, const bf16_t* __restrict__ Bt, int N, const F& f, char* smem, int bid, int nblk) {
    const int tid = tid_opq(), lane = tid & 63, wid = tid >> 6, fr = lane & 15, fq = lane >> 4;
    float* part = (float*)smem;
    const int ntn = N / 64, ntiles = (NTS / 32) * ntn;
    for (int tile = bid; tile < ntiles; tile += nblk) {
        const int tm = tile / ntn, tn = tile % ntn;
        const int row0 = NTP + tm * 32, col0 = tn * 64;
        f32x4 acc[2][4];
#pragma unroll
        for (int m = 0; m < 2; ++m)
#pragma unroll
            for (int n = 0; n < 4; ++n) acc[m][n] = (f32x4){0.f, 0.f, 0.f, 0.f};
        const bf16_t* ap = A + (size_t)(row0 + fr) * 1024 + wid * 128 + fq * 8;
        const bf16_t* bp = Bt + (size_t)(col0 + fr) * 1024 + wid * 128 + fq * 8;
        bf16x8 af[4][2], bfr[4][4];
#pragma unroll
        for (int ks = 0; ks < 4; ++ks) {
#pragma unroll
            for (int m = 0; m < 2; ++m) af[ks][m] = *(const bf16x8*)(ap + (size_t)m * 16 * 1024 + ks * 32);
#pragma unroll
            for (int n = 0; n < 4; ++n) bfr[ks][n] = *(const bf16x8*)(bp + (size_t)n * 16 * 1024 + ks * 32);
        }
#pragma unroll
        for (int ks = 0; ks < 4; ++ks)
#pragma unroll
            for (int m = 0; m < 2; ++m)
#pragma unroll
                for (int n = 0; n < 4; ++n) acc[m][n] = __builtin_amdgcn_mfma_f32_16x16x32_bf16(bfr[ks][n], af[ks][m], acc[m][n], 0, 0, 0);
        __syncthreads();
#pragma unroll
        for (int m = 0; m < 2; ++m)
#pragma unroll
            for (int n = 0; n < 4; ++n) *(f32x4*)(part + ((size_t)wid * 32 + m * 16 + fr) * 64 + n * 16 + fq * 4) = acc[m][n];
        __syncthreads();
        if (tid < 256) {
            const int r = tid >> 3, c8 = (tid & 7) * 8;
            f32x4 v0 = {0.f, 0.f, 0.f, 0.f}, v1 = v0;
#pragma unroll
            for (int w = 0; w < 8; ++w) { v0 += *(const f32x4*)(part + ((size_t)w * 32 + r) * 64 + c8); v1 += *(const f32x4*)(part + ((size_t)w * 32 + r) * 64 + c8 + 4); }
            const typename F::Pre pre = f.pre(row0 + r, col0 + c8);
            f.put(row0 + r, col0 + c8, v0, v1, pre);
        }
    }
}
template <class F>
DEVI void gemm_tail(const bf16_t* A, const bf16_t* Bt, int N, const F& f, char* smem, int bid, int nblk) {
    gemm_small_rows(A, Bt, N, f, smem, bid, nblk);
    gemm_pg8(A, Bt, NTP, N, 1024, f, smem, bid, nblk);
}

#define XB_TMO      128
#define XB_XCNT(j)  (256  + 64 * (j))
#define XB_XSUB(j)  (1280 + 64 * (j))
#define XB_XGEN(j)  (2304 + 64 * (j))
#define XB_TOP      3328
#define XB_TOPGEN   3392
#define XCD_BAR_WORDS 3456
#define XB_SPIN_CAP (1u << 18)
#define LAS __attribute__((address_space(3)))

__device__ __forceinline__ unsigned xb_ld(unsigned* p)              { return __hip_atomic_load(p, __ATOMIC_RELAXED, __HIP_MEMORY_SCOPE_AGENT); }
__device__ __forceinline__ unsigned xb_add(unsigned* p, unsigned v) { return __hip_atomic_fetch_add(p, v, __ATOMIC_RELAXED, __HIP_MEMORY_SCOPE_AGENT); }
__device__ __forceinline__ unsigned xb_xcc_id() { return (unsigned)__builtin_amdgcn_s_getreg((3 << 11) | 20) & 0xFu; }
#define XB_SPIN(cond, bar) do { unsigned _sp = 0; while (cond) { __builtin_amdgcn_s_sleep(1); \
    if ((++_sp & 255u) == 0u) { if (xb_ld(&(bar)[XB_TMO])) break; if (_sp > XB_SPIN_CAP) { atomicAdd(&(bar)[XB_TMO], 1u); break; } } } } while (0)

struct XcdBarrier {
    unsigned* bar; unsigned x;
    volatile LAS unsigned* st;
};

__device__ __forceinline__ XcdBarrier xcd_barrier_post(unsigned* bar, volatile LAS unsigned* st) {
    XcdBarrier b; b.bar = bar; b.x = xb_xcc_id(); b.st = st;
    if (tid_opq() == 0) (void)xb_add(&bar[XB_XCNT(b.x)], 1u);
    return b;
}
__device__ __forceinline__ void xcd_barrier_complete(unsigned* bar, unsigned x, unsigned& nloc, unsigned& nx) {
    const unsigned G = gridDim.x * gridDim.y * gridDim.z;
    unsigned sum, cnt, mine, sp = 0u;
    for (;;) {
        sum = 0u; cnt = 0u; mine = 0u;
#pragma unroll
        for (unsigned j = 0; j < 16; ++j) { const unsigned c = xb_ld(&bar[XB_XCNT(j)]); sum += c; cnt += (c > 0u) ? 1u : 0u; mine = (j == x) ? c : mine; }
        if (sum == G) break;
        __builtin_amdgcn_s_sleep(1);
        if ((++sp & 255u) == 0u) { if (xb_ld(&bar[XB_TMO])) break; if (sp > XB_SPIN_CAP) { atomicAdd(&bar[XB_TMO], 1u); break; } }
    }
    nloc = mine > 0u ? mine : 1u; nx = cnt > 0u ? cnt : 1u;
}

__device__ __forceinline__ void xcd_barrier(const XcdBarrier& b) {
    asm volatile("s_waitcnt vmcnt(0)" ::: "memory");
    __syncthreads();
    if (tid_opq() == 0) {
        unsigned* bar = b.bar;
        __builtin_amdgcn_s_waitcnt(0);
        unsigned nloc = b.st[0], nx = b.st[1];
        if (nloc == 0u) { xcd_barrier_complete(bar, b.x, nloc, nx); b.st[0] = nloc; b.st[1] = nx; }
        const unsigned old = xb_add(&bar[XB_XSUB(b.x)], 1u);
        const unsigned gen = old / nloc;
        if (old + 1u == (gen + 1u) * nloc) {
            __builtin_amdgcn_fence(__ATOMIC_RELEASE, "agent");
            asm volatile("s_waitcnt vmcnt(0)" ::: "memory");
            const unsigned og = xb_add(&bar[XB_TOP], 1u);
            const unsigned tg = og / nx;
            if (og + 1u == (tg + 1u) * nx) xb_add(&bar[XB_TOPGEN], 1u);
            else XB_SPIN(xb_ld(&bar[XB_TOPGEN]) == tg, bar);
            __builtin_amdgcn_fence(__ATOMIC_ACQUIRE, "agent");
            xb_add(&bar[XB_XGEN(b.x)], 1u);
            asm volatile("s_waitcnt vmcnt(0)" ::: "memory");
        } else {
            XB_SPIN(xb_ld(&bar[XB_XGEN(b.x)]) == gen, bar);
            __builtin_amdgcn_fence(__ATOMIC_ACQUIRE, "agent");
            asm volatile("s_waitcnt vmcnt(0)" ::: "memory");
        }
    }
    __syncthreads();
}

constexpr int LDS_BYTES = 152 * 1024;

template <int S>
DEVI void run_stage(const P& p, char* smem, int bid, int nblk) {
    if (S == 0) stage_prologue(p, smem, bid, nblk);
    if (S == 1) { EpiInProj e{p}; gemm_pg8(p.XB, p.WINT, NT, NPAD_IN + 2048, 1024, e, smem, bid, nblk); }
    if (S == 2) {
        stage2_queue(p, smem);
    }
    if (S == 4) { stage_mlstm_scan(p, bid, nblk); stage_nsa_attn(p, smem, bid, nblk); }
    if (S == 5) { stage_mlstm_out(p, smem, bid, nblk); { EpiM1 e{p}; gemm_tail(p.YB, p.WBT, 1024, e, smem, bid, nblk); } }
    if (S == 6) { EpiM2 e{p}; gemm_tail(p.YA, p.WAT, 1024, e, smem, bid, nblk); }
    if (S == 8) { EpiR e{p}; gemm_tail(p.MERGED, p.WOT, 1024, e, smem, bid, nblk); }
    if (S == 9) stage_ln1(p, bid, nblk);
    if (S == 10) { EpiPQ e{p}; gemm_tail(p.HB, p.WQT, 2048, e, smem, bid, nblk); }
    if (S == 11) {
        if (bid & 1) {
            for (int ps = 0; ps < 4; ++ps) { stage_peer_route(p, smem, bid, nblk, ps, ps + 1); __threadfence_block(); __syncthreads(); stage_peer_apply(p, smem, bid, nblk, ps, ps + 1); __syncthreads(); }
        } else { stage_peer_route(p, smem, bid, nblk, 0, 64); __threadfence_block(); __syncthreads(); stage_peer_apply(p, smem, bid, nblk, 0, 64); }
    }
}
constexpr int NSTAGES = 13;

template <int S>
__global__ void __launch_bounds__(512, 2) k_stage(P p) {
    extern __shared__ __attribute__((aligned(16))) char smem[];
    run_stage<S>(p, smem, blockIdx.x, gridDim.x);
}


#if MK_ONE_LAUNCH
__global__ void __launch_bounds__(512, 2) k_mega(P p) {
    extern __shared__ __attribute__((aligned(16))) char smem_all[];
    if (tid_opq() == 0) *(u32x4*)smem_all = (u32x4){0u, 0u, 0u, 0u};
    __syncthreads();
    XcdBarrier bar = xcd_barrier_post(p.bar, (volatile LAS unsigned*)smem_all);
    char* smem = smem_all + 16;
    const int bid = blockIdx.x, nblk = gridDim.x;
    run_stage<0>(p, smem, bid, nblk); if ((REP_MASK >> 0) & 1) { xcd_barrier(bar); run_stage<0>(p, smem, bid, nblk); }  xcd_barrier(bar);
    run_stage<1>(p, smem, bid, nblk); if ((REP_MASK >> 1) & 1) { xcd_barrier(bar); run_stage<1>(p, smem, bid, nblk); }  xcd_barrier(bar);
    run_stage<2>(p, smem, bid, nblk); if ((REP_MASK >> 2) & 1) { xcd_barrier(bar); run_stage<2>(p, smem, bid, nblk); }  xcd_barrier(bar);
    run_stage<4>(p, smem, bid, nblk); if ((REP_MASK >> 4) & 1) { xcd_barrier(bar); run_stage<4>(p, smem, bid, nblk); }  xcd_barrier(bar);
    run_stage<5>(p, smem, bid, nblk); if ((REP_MASK >> 5) & 1) { xcd_barrier(bar); run_stage<5>(p, smem, bid, nblk); }  xcd_barrier(bar);
    run_stage<6>(p, smem, bid, nblk); if ((REP_MASK >> 6) & 1) { xcd_barrier(bar); run_stage<6>(p, smem, bid, nblk); }  xcd_barrier(bar);
    run_stage<8>(p, smem, bid, nblk); if ((REP_MASK >> 8) & 1) { xcd_barrier(bar); run_stage<8>(p, smem, bid, nblk); }  xcd_barrier(bar);
    run_stage<9>(p, smem, bid, nblk); if ((REP_MASK >> 9) & 1) { xcd_barrier(bar); run_stage<9>(p, smem, bid, nblk); }  xcd_barrier(bar);
    run_stage<10>(p, smem, bid, nblk); if ((REP_MASK >> 10) & 1) { xcd_barrier(bar); run_stage<10>(p, smem, bid, nblk); } xcd_barrier(bar);
    run_stage<11>(p, smem, bid, nblk); if ((REP_MASK >> 11) & 1) { xcd_barrier(bar); run_stage<11>(p, smem, bid, nblk); }
}
#endif

template <int S> static void launch_stage(const P& p, int grid, hipStream_t stream) {
    (void)hipFuncSetAttribute((const void*)k_stage<S>, hipFuncAttributeMaxDynamicSharedMemorySize, LDS_BYTES);
    k_stage<S><<<dim3(grid), dim3(512), LDS_BYTES, stream>>>(p);
}

extern "C" void kernel_launch(void* const* d_in, const int* in_sizes, int n_in, void* d_out, int out_size, void* d_ws, size_t ws_size, hipStream_t stream) {
    (void)in_sizes; (void)n_in; (void)out_size; (void)ws_size;
    P p{};
    p.xp = (const float*)d_in[0]; p.xs = (const float*)d_in[1]; p.cache_cmp = (const float*)d_in[2]; p.cache_slc = (const float*)d_in[3];
    p.cache_win = (const float*)d_in[4]; p.state_C = (const float*)d_in[5]; p.state_n = (const float*)d_in[6]; p.state_m = (const float*)d_in[7];
    p.page_table = (const int*)d_in[8];
    p.w_in = (const float*)d_in[9]; p.b_in = (const float*)d_in[10]; p.norm_a_g = (const float*)d_in[11]; p.nsa_pe = (const float*)d_in[12];
    p.nsa_w_cmp = (const float*)d_in[13]; p.w_br_a = (const float*)d_in[14]; p.w_br_b = (const float*)d_in[15]; p.w_merge = (const float*)d_in[16];
    p.w_out = (const float*)d_in[17]; p.ln1_g = (const float*)d_in[18]; p.ln1_b = (const float*)d_in[19];
    p.peer_wq = (const float*)d_in[20]; p.peer_keys = (const float*)d_in[21]; p.peer_u = (const float*)d_in[22]; p.peer_v = (const float*)d_in[23];
    p.ln2_g = (const float*)d_in[24]; p.ln2_b = (const float*)d_in[25];
    p.out = (float*)d_out;
    char* w = (char*)d_ws; size_t off = 0;
    auto take = [&](size_t bytes) { char* r = w + off; off += (bytes + 255) & ~(size_t)255; return r; };
    p.bar = (unsigned*)take(16384);
    p.PW = (float*)(p.bar + 3584);
    p.WCT = (bf16_t*)take((size_t)2 * 64 * 4096 * 2);
    p.XB = (bf16_t*)take((size_t)NT * 1024 * 2);
    p.WINT = (bf16_t*)take((size_t)(NPAD_IN + 2048) * 1024 * 2);
    p.WMT = (bf16_t*)take((size_t)2048 * 1024 * 2);
    p.WAT = (bf16_t*)take((size_t)1024 * 1024 * 2);
    p.WBT = (bf16_t*)take((size_t)1024 * 1024 * 2);
    p.WOT = (bf16_t*)take((size_t)1024 * 1024 * 2);
    p.WQT = (bf16_t*)take((size_t)2048 * 1024 * 2);
    p.KEYSB = (bf16_t*)take((size_t)16 * 128 * 128 * 2);
    p.U8 = (unsigned char*)take((size_t)16384 * 768 + 256);
    p.V8 = (unsigned char*)take((size_t)16384 * 1024 + 256);
    p.US = (float*)take(16384 * 4);
    p.VS = (float*)take(16384 * 4);
    p.PROJ = (bf16_t*)take((size_t)NT * PS * 2);
    p.SM = (float*)take((size_t)NT * 64 * 4);
    p.BCUM = (float*)take((size_t)16 * 4096 * 4);
    p.MPREV = (float*)take(4096); p.ACOEF = (float*)take(4096); p.SCL = (float*)take(4096); p.MLOC = (float*)take(4096);
    p.DC = (float*)take((size_t)1024 * 272 * 128 * 4);
    p.CPT = (bf16_t*)take((size_t)1024 * 272 * 128 * 2);
    p.KC = (float*)take((size_t)4352 * 512 * 4);
    p.VC = p.KC + 256;
    p.OCMP = (float*)take((size_t)NT * 1024 * 4);
    p.SEL = (unsigned long long*)take((size_t)NT * 4 * 8);
    p.YA = (bf16_t*)take((size_t)NT * 1024 * 2);
    p.YB = (bf16_t*)take((size_t)NT * 1024 * 2);
    p.G = (bf16_t*)take((size_t)NT * 2048 * 2);
    p.TMPB = (bf16_t*)take((size_t)NT * 1024 * 2);
    p.MERGED = (bf16_t*)take((size_t)NT * 1024 * 2);
    p.R = (float*)take((size_t)NT * 1024 * 4);
    p.H = (float*)take((size_t)NT * 1024 * 4);
    p.HB = (bf16_t*)take((size_t)NT * 1024 * 2);
    p.PQ = (bf16_t*)take((size_t)NT * 2048 * 2);
    p.EIDX = (int*)take((size_t)NT * 128 * 4);
    p.EGATE = (float*)take((size_t)NT * 128 * 4);

    (void)hipMemsetAsync(p.bar, 0, 16384, stream);
#if MK_ONE_LAUNCH
    {
        constexpr size_t kDynLds = LDS_BYTES + 16;
        (void)hipFuncSetAttribute((const void*)k_mega, hipFuncAttributeMaxDynamicSharedMemorySize, (int)kDynLds);
        int dev = 0, cus = 0, per_cu = 0;
        (void)hipGetDevice(&dev);
        (void)hipDeviceGetAttribute(&cus, hipDeviceAttributeMultiprocessorCount, dev);
        (void)hipOccupancyMaxActiveBlocksPerMultiprocessor(&per_cu, (const void*)k_mega, 512, kDynLds);
        if (per_cu < 1 || cus < 1) return;
        const int grid = cus;
        k_mega<<<dim3(grid), dim3(512), kDynLds, stream>>>(p);
    }
#else
    const int grid = 512;
    launch_stage<0>(p, grid, stream);
    launch_stage<1>(p, grid, stream);
    launch_stage<2>(p, grid, stream);
    launch_stage<4>(p, grid, stream);
    launch_stage<5>(p, grid, stream);
    launch_stage<6>(p, grid, stream);
    launch_stage<8>(p, grid, stream);
    launch_stage<9>(p, grid, stream);
    launch_stage<10>(p, grid, stream);
    launch_stage<11>(p, grid, stream);
#endif
}
```

```cpp
#include <hip/hip_runtime.h>
#include <stdint.h>

#ifndef REP_MASK
#define REP_MASK 0
#endif
#ifndef MK_ONE_LAUNCH
#define MK_ONE_LAUNCH 1
#endif

typedef unsigned short bf16_t;
typedef short bf16x8 __attribute__((ext_vector_type(8)));
typedef float f32x4 __attribute__((ext_vector_type(4)));
typedef unsigned u32x4 __attribute__((ext_vector_type(4)));
#define U_BITS 4
#define V_BITS 4
typedef int i32x8 __attribute__((ext_vector_type(8)));
typedef int i32x6 __attribute__((ext_vector_type(6)));
typedef float f32x32 __attribute__((ext_vector_type(32)));
struct __attribute__((packed, aligned(4))) U3 { unsigned a, b, c; };
typedef unsigned u32x2 __attribute__((ext_vector_type(2)));
typedef float f32x2 __attribute__((ext_vector_type(2)));
typedef __bf16 bf16x2_t __attribute__((ext_vector_type(2)));
#define DEVI __device__ __forceinline__
__device__ __forceinline__ int tid_opq() { int t = threadIdx.x; asm volatile("" : "+v"(t)); return t; }

constexpr int NTP = 16384, NTS = 512, NT = NTP + NTS, DM = 1024;
constexpr int PS = 5632;
constexpr int C_AQ = 0, C_AK = 512, C_AV = 1024, C_AO = 2048, C_BQ = 3072, C_CMP = 4096, C_SLC = 4608, C_WIN = 5120;
constexpr int NPAD_IN = 5888;
constexpr float DN_ALPHA = 1.189207115002721f;
constexpr float LN_EPS = 1e-5f;
constexpr size_t O_Y = 0;
constexpr size_t O_PCMP = O_Y + (size_t)NT * 1024;
constexpr size_t O_PSLC = O_PCMP + (size_t)NTP * 512;
constexpr size_t O_PWIN = O_PSLC + (size_t)NTP * 512;
constexpr size_t O_PC = O_PWIN + (size_t)4 * 512 * 512;
constexpr size_t O_PN = O_PC + (size_t)16 * 128 * 256;
constexpr size_t O_PM = O_PN + 16 * 128;
constexpr size_t O_SCMP = O_PM + 16;
constexpr size_t O_SSLC = O_SCMP + (size_t)NTS * 512;
constexpr size_t O_SWIN = O_SSLC + (size_t)NTS * 512;
constexpr size_t O_SC = O_SWIN + (size_t)128 * 512 * 512;
constexpr size_t O_SN = O_SC + (size_t)512 * 128 * 256;
constexpr size_t O_SM = O_SN + 512 * 128;

struct P {
    const float *xp, *xs, *cache_cmp, *cache_slc, *cache_win, *state_C, *state_n, *state_m;
    const int* page_table;
    const float *w_in, *b_in, *norm_a_g, *nsa_pe, *nsa_w_cmp, *w_br_a, *w_br_b, *w_merge, *w_out, *ln1_g, *ln1_b;
    const float *peer_wq, *peer_keys, *peer_u, *peer_v, *ln2_g, *ln2_b;
    float* out;
    bf16_t *XB, *WINT, *WMT, *WAT, *WBT, *WOT, *WQT, *KEYSB, *UB, *VB, *PROJ, *WCT;
    float* PW;
    float *SM, *BCUM, *MPREV, *ACOEF, *SCL, *MLOC, *DC, *KC, *VC, *OCMP;
    bf16_t* CPT;
    unsigned char *U8, *V8;
    float *US, *VS;
    unsigned long long* SEL;
    bf16_t *YA, *YB, *G, *MERGED, *HB, *PQ;
    float *R, *H, *EGATE;
    bf16_t* TMPB;
    int* EIDX;
    unsigned* bar;
};

DEVI bf16_t f2bf(float f) { return __builtin_bit_cast(unsigned short, (__bf16)f); }
DEVI float bf2f(bf16_t h) { return __uint_as_float(((unsigned)h) << 16); }
DEVI unsigned pack2(float a, float b) { return __builtin_bit_cast(unsigned, __builtin_convertvector((f32x2){a, b}, bf16x2_t)); }
DEVI u32x4 pack8f(const f32x4 a, const f32x4 b) { u32x4 r; r[0] = pack2(a[0], a[1]); r[1] = pack2(a[2], a[3]); r[2] = pack2(b[0], b[1]); r[3] = pack2(b[2], b[3]); return r; }
DEVI void ce_desc(unsigned& a, unsigned& b) { const unsigned hi = a > b ? a : b, lo = a > b ? b : a; a = hi; b = lo; }
template <int BASE> DEVI void sort16_desc(unsigned (&x)[64]) {
#pragma unroll
    for (int k = 2; k <= 16; k <<= 1)
#pragma unroll
        for (int j = k >> 1; j > 0; j >>= 1)
#pragma unroll
            for (int i = 0; i < 16; ++i) {
                const int l = i ^ j;
                if (l > i) { if ((i & k) == 0) ce_desc(x[BASE + i], x[BASE + l]); else ce_desc(x[BASE + l], x[BASE + i]); }
            }
}
DEVI void merge_top16(const unsigned* a, const unsigned* b, unsigned* t) {
    unsigned c[16];
#pragma unroll
    for (int i = 0; i < 16; ++i) c[i] = a[i] > b[15 - i] ? a[i] : b[15 - i];
#pragma unroll
    for (int j = 8; j > 0; j >>= 1)
#pragma unroll
        for (int i = 0; i < 16; ++i) { const int l = i ^ j; if (l > i) ce_desc(c[i], c[l]); }
#pragma unroll
    for (int i = 0; i < 16; ++i) t[i] = c[i];
}
DEVI float gelu_erf(float v) {
    const float av = fabsf(v), t = __builtin_amdgcn_rcpf(fmaf(av, 0.2316418882f, 1.0f));
    float q = fmaf(t, 0.5307027145f, -0.7265760135f); q = fmaf(q, t, 0.7107068705f); q = fmaf(q, t, -0.142248368f); q = fmaf(q, t, 0.127414796f); q = q * t;
    const float e = __builtin_amdgcn_exp2f(v * v * -0.72134752044f);
    const float mm = v * (q * e);
    return v < 0.f ? mm : v - mm;
}
DEVI float wave_max(float v) { for (int o = 32; o > 0; o >>= 1) v = fmaxf(v, __shfl_xor(v, o)); return v; }
DEVI float wave_sum(float v) { for (int o = 32; o > 0; o >>= 1) v += __shfl_xor(v, o); return v; }
DEVI float sigmoidf_(float x) { return __builtin_amdgcn_rcpf(1.f + __expf(-x)); }
DEVI float logsigmoidf_(float x) { return fminf(x, 0.f) - log1pf(__expf(-fabsf(x))); }
DEVI int win_map(int np) {
    if (np < 2048) return np;
    if (np < 5632) return np + 8;
    if (np < 5640) return np - 5632 + 2048;
    if (np < 5688) return np;
    return -1;
}
DEVI float alibi_slope(int h) { return exp2f(-0.5f * (float)(h + 1)); }

template <class MapFn>
DEVI void transpose_cvt(const float* __restrict__ W, bf16_t* __restrict__ WT, int K, int Nsrc, int Ndst, MapFn mapfn, float* tile  , int bid, int nblk) {
    const int tid = tid_opq();
    const int tn = Ndst / 64, tk = K / 64;
    for (int t = bid; t < tn * tk; t += nblk) {
        const int n0 = (t % tn) * 64, k0 = (t / tn) * 64;
        __syncthreads();
#pragma unroll
        for (int i = 0; i < 8; ++i) {
            const int kk = (tid >> 6) + i * 8, nn = tid & 63;
            const int n = mapfn(n0 + nn);
            tile[kk * 65 + nn] = n >= 0 ? W[(size_t)(k0 + kk) * Nsrc + n] : 0.f;
        }
        __syncthreads();
#pragma unroll
        for (int i = 0; i < 8; ++i) {
            const int nn = (tid >> 6) + i * 8, kk = tid & 63;
            WT[(size_t)(n0 + nn) * K + k0 + kk] = f2bf(tile[kk * 65 + nn]);
        }
    }
}
struct IdMap { DEVI int operator()(int n) const { return n; } };
struct WinMap { DEVI int operator()(int n) const { return win_map(n); } };

DEVI void cvt_rows(const float* __restrict__ src, bf16_t* __restrict__ dst, size_t n4, int bid, int nblk) {
    const size_t stride = (size_t)nblk * 512;
    for (size_t i0 = (size_t)bid * 512 + tid_opq(); i0 < n4; i0 += stride * 8) {
        f32x4 v[8];
#pragma unroll
        for (int u = 0; u < 8; ++u) { const size_t i = i0 + u * stride; v[u] = i < n4 ? __builtin_nontemporal_load((const f32x4*)src + i) : (f32x4){0.f, 0.f, 0.f, 0.f}; }
#pragma unroll
        for (int u = 0; u < 8; ++u) { const size_t i = i0 + u * stride; if (i < n4) { u32x2 o; o.x = pack2(v[u][0], v[u][1]); o.y = pack2(v[u][2], v[u][3]); ((u32x2*)dst)[i] = o; } }
    }
}

DEVI unsigned q_e2m3(float x) {
    const float a = fabsf(x);
    const float c = a < 2.f ? rintf(a * 8.f) : a < 4.f ? 16.f + rintf((a - 2.f) * 4.f) : fminf(31.f, 24.f + rintf((a - 4.f) * 2.f));
    return (unsigned)c | (x < 0.f ? 32u : 0u);
}

DEVI unsigned q_e2m1(float x) {
    const float a = fabsf(x);
    const float c = a < 2.f ? rintf(a * 2.f) : a < 4.f ? 4.f + rintf(a - 2.f) : fminf(7.f, 6.f + rintf((a - 4.f) * 0.5f));
    return (unsigned)c | (x < 0.f ? 8u : 0u);
}

DEVI void stage_prologue(const P& p, char* smem, int bid, int nblk) {
    float* tile = (float*)smem;
    cvt_rows(p.xp, p.XB, (size_t)NTP * 256, bid, nblk);
    cvt_rows(p.xs, p.XB + (size_t)NTP * 1024, (size_t)NTS * 256, bid, nblk);
    {
        const int lane = tid_opq() & 63, wid = tid_opq() >> 6;
        for (int r0 = bid * 8 + wid; r0 < 2 * 16384; r0 += nblk * 8 * 2) {
            f32x4 x[2][4]; float am[2] = {0.f, 0.f};
#pragma unroll
            for (int j = 0; j < 2; ++j) {
                const int r = r0 + j * nblk * 8;
                if (r < 2 * 16384) {
                    const bool isv = r >= 16384; const int e = isv ? r - 16384 : r;
                    const float* src = (isv ? p.peer_v : p.peer_u) + (size_t)e * 1024 + lane * 16;
#pragma unroll
                    for (int i = 0; i < 4; ++i) x[j][i] = __builtin_nontemporal_load((const f32x4*)(src + i * 4));
                }
            }
#pragma unroll
            for (int j = 0; j < 2; ++j) {
                const int r = r0 + j * nblk * 8;
                if (r < 2 * 16384) {
                    const bool isv = r >= 16384; const int e = isv ? r - 16384 : r;
#pragma unroll
                    for (int i = 0; i < 4; ++i)
#pragma unroll
                        for (int k = 0; k < 4; ++k) am[j] = fmaxf(am[j], fabsf(x[j][i][k]));
                    const float amx = wave_max(am[j]);
                    if ((isv ? V_BITS : U_BITS) == 6) {
                        const float inv = amx > 0.f ? 7.5f / amx : 1.f;
                        unsigned long long lo = 0ull, hi = 0ull;
#pragma unroll
                        for (int i = 0; i < 16; ++i) {
                            const unsigned long long c = (unsigned long long)q_e2m3(x[j][i >> 2][i & 3] * inv);
                            if (i < 10) lo |= c << (6 * i);
                            else if (i == 10) { lo |= c << 60; hi |= c >> 4; }
                            else hi |= c << (6 * i - 64);
                        }
                        unsigned* d = (unsigned*)((isv ? p.V8 : p.U8) + (size_t)e * 768 + lane * 12);
                        d[0] = (unsigned)lo; d[1] = (unsigned)(lo >> 32); d[2] = (unsigned)hi;
                        if (lane == 0) (isv ? p.VS : p.US)[e] = amx > 0.f ? amx / 7.5f : 1.f;
                    } else {
                        const float inv = amx > 0.f ? 6.f / amx : 1.f;
                        unsigned w0 = 0u, w1 = 0u;
#pragma unroll
                        for (int i = 0; i < 8; ++i) { w0 |= q_e2m1(x[j][i >> 2][i & 3] * inv) << (4 * i); w1 |= q_e2m1(x[j][2 + (i >> 2)][i & 3] * inv) << (4 * i); }
                        *(u32x2*)((isv ? p.V8 : p.U8) + (size_t)e * 512 + lane * 8) = (u32x2){w0, w1};
                        if (lane == 0) (isv ? p.VS : p.US)[e] = amx > 0.f ? amx / 6.f : 1.f;
                    }
                }
            }
        }
    }
    cvt_rows(p.peer_keys, p.KEYSB, (size_t)16 * 128 * 128 / 4, bid, nblk);
    transpose_cvt(p.w_in, p.WINT, 1024, 5688, NPAD_IN, WinMap(), tile, bid, nblk);
    transpose_cvt(p.w_merge, p.WINT + (size_t)NPAD_IN * 1024, 1024, 2048, 2048, IdMap(), tile, bid, nblk);
    transpose_cvt(p.w_br_a, p.WAT, 1024, 1024, 1024, IdMap(), tile, bid, nblk);
    transpose_cvt(p.w_br_b, p.WBT, 1024, 1024, 1024, IdMap(), tile, bid, nblk);
    transpose_cvt(p.w_out, p.WOT, 1024, 1024, 1024, IdMap(), tile, bid, nblk);
    transpose_cvt(p.peer_wq, p.WQT, 1024, 2048, 2048, IdMap(), tile, bid, nblk);
    transpose_cvt(p.nsa_w_cmp, p.WCT, 4096, 64, 64, IdMap(), tile, bid, nblk);
    transpose_cvt(p.nsa_w_cmp + 4096 * 64, p.WCT + 64 * 4096, 4096, 64, 64, IdMap(), tile, bid, nblk);
    for (int blk = bid; blk < 32; blk += nblk) {
        const int tid = tid_opq(), kvv = tid >> 8, e = tid & 63, kq = (tid >> 6) & 3;
        float a = 0.f;
        for (int k = blk * 128 + kq * 32; k < blk * 128 + kq * 32 + 32; ++k) a += p.nsa_pe[kvv * 4096 + k] * p.nsa_w_cmp[((size_t)kvv * 4096 + k) * 64 + e];
        atomicAdd(p.PW + kvv * 64 + e, a);
    }
    {
        const size_t per_b = (size_t)508 * 512 / 4;
        const size_t stride = (size_t)nblk * 512, ntot = 128 * per_b;
        for (size_t i0 = (size_t)bid * 512 + tid_opq(); i0 < ntot; i0 += stride * 8) {
            f32x4 v[8];
#pragma unroll
            for (int u = 0; u < 8; ++u) { const size_t i = i0 + u * stride; if (i < ntot) { const size_t b = i / per_b, r = i % per_b; v[u] = __builtin_nontemporal_load((const f32x4*)(p.cache_win + b * 512 * 512 + 4 * 512) + r); } }
#pragma unroll
            for (int u = 0; u < 8; ++u) { const size_t i = i0 + u * stride; if (i < ntot) { const size_t b = i / per_b, r = i % per_b; __builtin_nontemporal_store(v[u], (f32x4*)(p.out + O_SWIN + b * 512 * 512) + r); } }
        }
    }
}

struct NoPre {};
DEVI f32x4 bf4_lo(const u32x4& g) { return (f32x4){__uint_as_float(g[0] << 16), __uint_as_float(g[0] & 0xFFFF0000u), __uint_as_float(g[1] << 16), __uint_as_float(g[1] & 0xFFFF0000u)}; }
DEVI f32x4 bf4_hi(const u32x4& g) { return (f32x4){__uint_as_float(g[2] << 16), __uint_as_float(g[2] & 0xFFFF0000u), __uint_as_float(g[3] << 16), __uint_as_float(g[3] & 0xFFFF0000u)}; }
struct EpiInProj {
    P p;
    typedef NoPre Pre;
    static constexpr int BATCH = 4;
    static constexpr bool COLBIAS = true;
    DEVI void bias8(int col, f32x4& b0, f32x4& b1) const {
        b0 = (f32x4){0.f, 0.f, 0.f, 0.f}; b1 = b0;
        if (col < 5688) { const int oc = win_map(col);
#pragma unroll
            for (int q = 0; q < 4; ++q) { b0[q] = p.b_in[oc + q]; b1[q] = p.b_in[oc + 4 + q]; } }
    }
    DEVI Pre pre(int, int) const { return NoPre(); }
    DEVI void put(int row, int col, f32x4 v0, f32x4 v1, const Pre&) const {
        if (col >= NPAD_IN) {
#pragma unroll
            for (int k = 0; k < 4; ++k) { v0[k] = sigmoidf_(v0[k]); v1[k] = sigmoidf_(v1[k]); }
            *(u32x4*)(p.G + (size_t)row * 2048 + (col - NPAD_IN)) = pack8f(v0, v1);
            return;
        }
        if (col >= 5688) return;
        if (col >= 5632) { *(f32x4*)(p.SM + (size_t)row * 64 + (col - 5632)) = v0; *(f32x4*)(p.SM + (size_t)row * 64 + (col - 5632) + 4) = v1; return; }
        if (col >= C_AK && col < C_AV) { v0 *= 0.08838834764831845f; v1 *= 0.08838834764831845f; }
        *(u32x4*)(p.PROJ + (size_t)row * PS + col) = pack8f(v0, v1);
        if (col >= C_CMP) {
            const int reg = (col - C_CMP) >> 9, c = (col - C_CMP) & 511;
            float* dst = nullptr;
            if (row < NTP) {
                if (reg == 0) dst = p.out + O_PCMP + (size_t)row * 512 + c;
                else if (reg == 1) dst = p.out + O_PSLC + (size_t)row * 512 + c;
                else { const int b = row >> 12, t = row & 4095; if (t >= 3584) dst = p.out + O_PWIN + ((size_t)b * 512 + (t - 3584)) * 512 + c; }
            } else {
                const int rs = row - NTP;
                if (reg == 0) dst = p.out + O_SCMP + (size_t)rs * 512 + c;
                else if (reg == 1) dst = p.out + O_SSLC + (size_t)rs * 512 + c;
                else { const int b = rs >> 2, tq = rs & 3; dst = p.out + O_SWIN + ((size_t)b * 512 + 508 + tq) * 512 + c; }
            }
            if (dst) { *(f32x4*)dst = v0; *(f32x4*)(dst + 4) = v1; }
        }
    }
};
struct EpiG {
    P p;
    typedef NoPre Pre;
    static constexpr int BATCH = 4;
    static constexpr bool COLBIAS = false;
    DEVI Pre pre(int, int) const { return NoPre(); }
    DEVI void put(int row, int col, f32x4 v0, f32x4 v1, const Pre&) const {
#pragma unroll
        for (int k = 0; k < 4; ++k) { v0[k] = sigmoidf_(v0[k]); v1[k] = sigmoidf_(v1[k]); }
        *(u32x4*)(p.G + (size_t)row * 2048 + col) = pack8f(v0, v1);
    }
};
struct EpiM1 {
    P p;
    typedef u32x4 Pre;
    static constexpr int BATCH = 8;
    static constexpr bool COLBIAS = false;
    DEVI Pre pre(int row, int col) const { return *(const u32x4*)(p.G + (size_t)row * 2048 + 1024 + col); }
    DEVI void put(int row, int col, f32x4 v0, f32x4 v1, const Pre& g) const {
        *(u32x4*)(p.TMPB + (size_t)row * 1024 + col) = pack8f(v0 * bf4_lo(g), v1 * bf4_hi(g));
    }
};
struct PreM2 { u32x4 g; u32x4 t; };
struct EpiM2 {
    P p;
    typedef PreM2 Pre;
    static constexpr int BATCH = 8;
    static constexpr bool COLBIAS = false;
    DEVI Pre pre(int row, int col) const { PreM2 r; r.g = *(const u32x4*)(p.G + (size_t)row * 2048 + col); r.t = *(const u32x4*)(p.TMPB + (size_t)row * 1024 + col); return r; }
    DEVI void put(int row, int col, f32x4 v0, f32x4 v1, const Pre& q) const {
        *(u32x4*)(p.MERGED + (size_t)row * 1024 + col) = pack8f(bf4_lo(q.t) + v0 * bf4_lo(q.g), bf4_hi(q.t) + v1 * bf4_hi(q.g));
    }
};
struct PreR { f32x4 a, b; };
struct EpiR {
    P p;
    typedef PreR Pre;
    static constexpr int BATCH = 8;
    static constexpr bool COLBIAS = false;
    DEVI Pre pre(int row, int col) const {
        const float* xr = row < NTP ? p.xp + (size_t)row * 1024 : p.xs + (size_t)(row - NTP) * 1024;
        PreR r; r.a = *(const f32x4*)(xr + col); r.b = *(const f32x4*)(xr + col + 4); return r;
    }
    DEVI void put(int row, int col, f32x4 v0, f32x4 v1, const Pre& x) const {
        *(f32x4*)(p.R + (size_t)row * 1024 + col) = x.a * DN_ALPHA + v0; *(f32x4*)(p.R + (size_t)row * 1024 + col + 4) = x.b * DN_ALPHA + v1;
    }
};
struct EpiPQ {
    P p;
    typedef NoPre Pre;
    static constexpr int BATCH = 4;
    static constexpr bool COLBIAS = false;
    DEVI Pre pre(int, int) const { return NoPre(); }
    DEVI void put(int row, int col, f32x4 v0, f32x4 v1, const Pre&) const { *(u32x4*)(p.PQ + (size_t)row * 2048 + col) = pack8f(v0, v1); }
};

DEVI void stage_mlstm_gates(const P& p, char* smem, int bid, int nblk) {
    const int lane = tid_opq() & 63, wid = tid_opq() >> 6;
    float* bend_s = (float*)smem; float* mloc_s = bend_s + 64;
    for (int bh = bid; bh < 16; bh += nblk) {
        const int b = bh >> 2, h = bh & 3;
        __syncthreads();
        for (int cc = 0; cc < 8; ++cc) {
            const int c = wid * 8 + cc;
            const size_t row = (size_t)b * 4096 + c * 64 + lane;
            const float ip = p.SM[row * 64 + h];
            const float lf = logsigmoidf_(p.SM[row * 64 + 4 + h]);
            float cs = lf;
#pragma unroll
            for (int o = 1; o < 64; o <<= 1) { const float t = __shfl_up(cs, o); if (lane >= o) cs += t; }
            p.BCUM[bh * 4096 + c * 64 + lane] = cs;
            const float bend = __shfl(cs, 63);
            const float mloc = wave_max(bend - cs + ip);
            if (lane == 0) { bend_s[c] = bend; mloc_s[c] = mloc; }
        }
        __syncthreads();
        if (tid_opq() == 0) {
            float m = 0.f;
            for (int c = 0; c < 64; ++c) {
                const float bend = bend_s[c], mloc = mloc_s[c];
                const float mnew = fmaxf(bend + m, mloc);
                p.MPREV[bh * 64 + c] = m;
                p.ACOEF[bh * 64 + c] = __expf(bend + m - mnew);
                p.SCL[bh * 64 + c] = __expf(mloc - mnew);
                p.MLOC[bh * 64 + c] = mloc;
                m = mnew;
            }
            p.out[O_PM + bh] = m;
        }
    }
}

constexpr int MD_KT = 0, MD_VT = 128 * 144, MD_WS = MD_VT + 272 * 144, MD_LDS = MD_WS + 256;
DEVI void stage_mlstm_dc(const P& p, char* smem, int bid, int nblk) {
    const int tid = tid_opq(), lane = tid & 63, wid = tid >> 6, fr = lane & 15, fq = lane >> 4;
    bf16_t* Kt = (bf16_t*)(smem + MD_KT);
    bf16_t* Vt = (bf16_t*)(smem + MD_VT);
    float* ws = (float*)(smem + MD_WS);
    for (int task = bid; task < 1024; task += nblk) {
        const int bh = task >> 6, c = task & 63, b = bh >> 2, h = bh & 3;
        const size_t row0 = (size_t)b * 4096 + c * 64;
        __syncthreads();
        if (tid < 64) {
            const float ip = p.SM[(row0 + tid) * 64 + h];
            float cs = logsigmoidf_(p.SM[(row0 + tid) * 64 + 4 + h]);
#pragma unroll
            for (int o = 1; o < 64; o <<= 1) { const float t = __shfl_up(cs, o); if (tid >= o) cs += t; }
            const float g = __shfl(cs, 63) - cs + ip;
            ws[tid] = __expf(g - wave_max(g));
        }
        __syncthreads();
        {
            const int sidx = tid & 63, ch = tid >> 6;
            const float w = ws[sidx];
#pragma unroll
            for (int half = 0; half < 2; ++half) {
                const u32x4 kk = *(const u32x4*)(p.PROJ + (row0 + sidx) * PS + C_AK + h * 128 + half * 64 + ch * 8);
#pragma unroll
                for (int e = 0; e < 4; ++e) {
                    Kt[(half * 64 + ch * 8 + e * 2) * 72 + sidx] = f2bf(w * __uint_as_float(kk[e] << 16));
                    Kt[(half * 64 + ch * 8 + e * 2 + 1) * 72 + sidx] = f2bf(w * __uint_as_float(kk[e] & 0xFFFF0000u));
                }
            }
#pragma unroll
            for (int q4 = 0; q4 < 4; ++q4) {
                const u32x4 vv = *(const u32x4*)(p.PROJ + (row0 + sidx) * PS + C_AV + h * 256 + q4 * 64 + ch * 8);
#pragma unroll
                for (int e = 0; e < 4; ++e) {
                    Vt[(q4 * 64 + ch * 8 + e * 2) * 72 + sidx] = (bf16_t)(vv[e] & 0xFFFFu);
                    Vt[(q4 * 64 + ch * 8 + e * 2 + 1) * 72 + sidx] = (bf16_t)(vv[e] >> 16);
                }
            }
            for (int i = tid; i < 16 * 64; i += 512) Vt[(256 + (i >> 6)) * 72 + (i & 63)] = (i >> 6) == 0 ? (bf16_t)0x3F80 : (bf16_t)0;
        }
        __syncthreads();
        const int nvt = wid == 0 ? 3 : 2;
        for (int vi = 0; vi < nvt; ++vi) {
            const int vt = vi < 2 ? wid * 2 + vi : 16;
            f32x4 acc[8];
#pragma unroll
            for (int dt = 0; dt < 8; ++dt) acc[dt] = (f32x4){0.f, 0.f, 0.f, 0.f};
#pragma unroll
            for (int ks = 0; ks < 2; ++ks) {
                const bf16x8 bf = *(const bf16x8*)(Vt + (vt * 16 + fr) * 72 + ks * 32 + fq * 8);
#pragma unroll
                for (int dt = 0; dt < 8; ++dt) {
                    const bf16x8 af = *(const bf16x8*)(Kt + (dt * 16 + fr) * 72 + ks * 32 + fq * 8);
                    acc[dt] = __builtin_amdgcn_mfma_f32_16x16x32_bf16(af, bf, acc[dt], 0, 0, 0);
                }
            }
            const int v = vt * 16 + fr;
            if (v <= 256) {
#pragma unroll
                for (int dt = 0; dt < 8; ++dt) *(f32x4*)(p.DC + ((size_t)task * 272 + v) * 128 + dt * 16 + fq * 4) = acc[dt];
            }
        }
    }
}

DEVI void stage_mlstm_scan(const P& p, int bid, int nblk) {
    const int nthr = 512;
    for (int e = bid * nthr + tid_opq(); e < 16 * 257 * 32; e += nblk * nthr) {
        const int bh = e / (257 * 32), r = e % (257 * 32), v = r >> 5, d = (r & 31) * 4;
        f32x4 C = {0.f, 0.f, 0.f, 0.f};
        const float* ac = p.ACOEF + bh * 64; const float* sc = p.SCL + bh * 64;
        const size_t base = ((size_t)(bh * 64) * 272 + v) * 128 + d, cstride = (size_t)272 * 128;
#pragma unroll 1
        for (int c0 = 0; c0 < 64; c0 += 8) {
            f32x4 dc[8];
#pragma unroll
            for (int i = 0; i < 8; ++i) dc[i] = __builtin_nontemporal_load((const f32x4*)(p.DC + base + (size_t)(c0 + i) * cstride));
#pragma unroll
            for (int i = 0; i < 8; ++i) {
                u32x2 o; o.x = pack2(C[0], C[1]); o.y = pack2(C[2], C[3]);
                *(u32x2*)(p.CPT + base + (size_t)(c0 + i) * cstride) = o;
                C = C * ac[c0 + i] + dc[i] * sc[c0 + i];
            }
        }
        if (v < 256) {
#pragma unroll
            for (int k = 0; k < 4; ++k) p.out[O_PC + ((size_t)bh * 128 + d + k) * 256 + v] = C[k];
        } else *(f32x4*)(p.out + O_PN + bh * 128 + d) = C;
    }
}

constexpr int MO_Q = 0, MO_K = 64 * 272, MO_VT = MO_K + 64 * 272, MO_P = MO_VT + 272 * 144, MO_SC = MO_P + 64 * 144, MO_HS = MO_SC + 2048, MO_LDS = MO_HS + 64 * 256 * 4;
static_assert(MO_LDS <= 152 * 1024, "lds");
DEVI void stage_mlstm_out(const P& p, char* smem, int bid, int nblk) {
    const int tid = tid_opq(), lane = tid & 63, wid = tid >> 6, fr = lane & 15, fq = lane >> 4;
    bf16_t* Qs = (bf16_t*)(smem + MO_Q);
    bf16_t* Ks = (bf16_t*)(smem + MO_K);
    bf16_t* Vt = (bf16_t*)(smem + MO_VT);
    bf16_t* Ps = (bf16_t*)(smem + MO_P);
    float* sc = (float*)(smem + MO_SC);
    float* rowt = sc; float* colt = sc + 64; float* wint = sc + 128; float* emt = sc + 192; float* den = sc + 256;
    float* hs = (float*)(smem + MO_HS);
    for (int task = bid; task < 1024; task += nblk) {
        const int bh = task >> 6, c = task & 63, b = bh >> 2, h = bh & 3;
        const size_t row0 = (size_t)b * 4096 + c * 64;
        __syncthreads();
        {
            for (int i = tid; i < 64 * 16; i += 512) {
                const int t = i >> 4, ch = i & 15;
                *(u32x4*)(Qs + t * 136 + ch * 8) = *(const u32x4*)(p.PROJ + (row0 + t) * PS + C_AQ + h * 128 + ch * 8);
                *(u32x4*)(Ks + t * 136 + ch * 8) = *(const u32x4*)(p.PROJ + (row0 + t) * PS + C_AK + h * 128 + ch * 8);
            }
            const int sidx = tid & 63, ch = tid >> 6;
#pragma unroll
            for (int q4 = 0; q4 < 4; ++q4) {
                const u32x4 vv = *(const u32x4*)(p.PROJ + (row0 + sidx) * PS + C_AV + h * 256 + q4 * 64 + ch * 8);
#pragma unroll
                for (int e = 0; e < 4; ++e) {
                    Vt[(q4 * 64 + ch * 8 + e * 2) * 72 + sidx] = (bf16_t)(vv[e] & 0xFFFFu);
                    Vt[(q4 * 64 + ch * 8 + e * 2 + 1) * 72 + sidx] = (bf16_t)(vv[e] >> 16);
                }
            }
            for (int i = tid; i < 16 * 64; i += 512) Vt[(256 + (i >> 6)) * 72 + (i & 63)] = (i >> 6) == 0 ? (bf16_t)0x3F80 : (bf16_t)0;
            if (wid == 0) {
                const float bc = p.BCUM[bh * 4096 + c * 64 + lane], ip = p.SM[(row0 + lane) * 64 + h];
                const float mprev = p.MPREV[task];
                float pm = ip - bc;
#pragma unroll
                for (int o = 1; o < 64; o <<= 1) { const float t = __shfl_up(pm, o); if (lane >= o) pm = fmaxf(pm, t); }
                const float mt = fmaxf(bc + mprev, bc + pm);
                rowt[lane] = bc - mt; colt[lane] = ip - bc; wint[lane] = __expf(bc + mprev - mt); emt[lane] = __expf(-mt);
            }
        }
        __syncthreads();
        {
            const int tt = wid >> 1;
#pragma unroll
            for (int si = 0; si < 2; ++si) {
                const int st = (wid & 1) * 2 + si;
                f32x4 acc = (f32x4){0.f, 0.f, 0.f, 0.f};
                if (st <= tt) {
#pragma unroll
                    for (int ks = 0; ks < 4; ++ks) {
                        const bf16x8 af = *(const bf16x8*)(Qs + (tt * 16 + fr) * 136 + ks * 32 + fq * 8);
                        const bf16x8 bf = *(const bf16x8*)(Ks + (st * 16 + fr) * 136 + ks * 32 + fq * 8);
                        acc = __builtin_amdgcn_mfma_f32_16x16x32_bf16(af, bf, acc, 0, 0, 0);
                    }
                }
                const int s = st * 16 + fr; const float ct = colt[s];
#pragma unroll
                for (int r = 0; r < 4; ++r) {
                    const int t = tt * 16 + fq * 4 + r;
                    const float pv = (s <= t) ? acc[r] * __expf(rowt[t] + ct) : 0.f;
                    Ps[t * 72 + s] = f2bf(pv);
                }
            }
        }
        __syncthreads();
        {
            const bf16_t* cpt = p.CPT + (size_t)task * 272 * 128;
            f32x4 acc[4][2];
#pragma unroll
            for (int tt = 0; tt < 4; ++tt)
#pragma unroll
                for (int vi = 0; vi < 2; ++vi) acc[tt][vi] = (f32x4){0.f, 0.f, 0.f, 0.f};
            f32x4 accd = (f32x4){0.f, 0.f, 0.f, 0.f};
            bf16x8 cb[4][2], cd[4];
#pragma unroll
            for (int ks = 0; ks < 4; ++ks) {
#pragma unroll
                for (int vi = 0; vi < 2; ++vi) cb[ks][vi] = *(const bf16x8*)(cpt + (size_t)((wid * 2 + vi) * 16 + fr) * 128 + ks * 32 + fq * 8);
                cd[ks] = *(const bf16x8*)(cpt + (size_t)(256 + fr) * 128 + ks * 32 + fq * 8);
            }
#pragma unroll
            for (int ks = 0; ks < 4; ++ks) {
                bf16x8 af[4];
#pragma unroll
                for (int tt = 0; tt < 4; ++tt) af[tt] = *(const bf16x8*)(Qs + (tt * 16 + fr) * 136 + ks * 32 + fq * 8);
#pragma unroll
                for (int vi = 0; vi < 2; ++vi) {
#pragma unroll
                    for (int tt = 0; tt < 4; ++tt) acc[tt][vi] = __builtin_amdgcn_mfma_f32_16x16x32_bf16(af[tt], cb[ks][vi], acc[tt][vi], 0, 0, 0);
                }
                if (wid < 4) {
                    const bf16x8 a2 = *(const bf16x8*)(Qs + (wid * 16 + fr) * 136 + ks * 32 + fq * 8);
                    accd = __builtin_amdgcn_mfma_f32_16x16x32_bf16(a2, cd[ks], accd, 0, 0, 0);
                }
            }
#pragma unroll
            for (int tt = 0; tt < 4; ++tt) {
                const f32x4 wv = *(const f32x4*)(wint + tt * 16 + fq * 4);
#pragma unroll
                for (int vi = 0; vi < 2; ++vi) acc[tt][vi] *= wv;
            }
            if (wid < 4) accd *= *(const f32x4*)(wint + wid * 16 + fq * 4);
#pragma unroll
            for (int ks = 0; ks < 2; ++ks) {
                bf16x8 af[4];
#pragma unroll
                for (int tt = 0; tt < 4; ++tt) af[tt] = *(const bf16x8*)(Ps + (tt * 16 + fr) * 72 + ks * 32 + fq * 8);
#pragma unroll
                for (int vi = 0; vi < 2; ++vi) {
                    const bf16x8 bf = *(const bf16x8*)(Vt + ((wid * 2 + vi) * 16 + fr) * 72 + ks * 32 + fq * 8);
#pragma unroll
                    for (int tt = 0; tt < 4; ++tt) acc[tt][vi] = __builtin_amdgcn_mfma_f32_16x16x32_bf16(af[tt], bf, acc[tt][vi], 0, 0, 0);
                }
                if (wid < 4) {
                    const bf16x8 bf = *(const bf16x8*)(Vt + (256 + fr) * 72 + ks * 32 + fq * 8);
                    const bf16x8 a2 = *(const bf16x8*)(Ps + (wid * 16 + fr) * 72 + ks * 32 + fq * 8);
                    accd = __builtin_amdgcn_mfma_f32_16x16x32_bf16(a2, bf, accd, 0, 0, 0);
                }
            }
            if (wid < 4 && fr == 0) *(f32x4*)(den + wid * 16 + fq * 4) = accd;
            __syncthreads();
#pragma unroll
            for (int tt = 0; tt < 4; ++tt) {
                const f32x4 dv = *(const f32x4*)(den + tt * 16 + fq * 4), ev = *(const f32x4*)(emt + tt * 16 + fq * 4);
#pragma unroll
                for (int vi = 0; vi < 2; ++vi)
#pragma unroll
                    for (int r = 0; r < 4; ++r) hs[(tt * 16 + fq * 4 + r) * 256 + (wid * 2 + vi) * 16 + fr] = acc[tt][vi][r] / fmaxf(fabsf(dv[r]), ev[r]);
            }
        }
        __syncthreads();
        u32x2 ovs[8];
#pragma unroll
        for (int rr = 0; rr < 8; ++rr) ovs[rr] = *(const u32x2*)(p.PROJ + (row0 + wid * 8 + rr) * PS + C_AO + h * 256 + lane * 4);
        const f32x4 gg = *(const f32x4*)(p.norm_a_g + h * 256 + lane * 4);
#pragma unroll
        for (int rr = 0; rr < 8; ++rr) {
            const int t = wid * 8 + rr;
            const f32x4 x = *(const f32x4*)(hs + t * 256 + lane * 4);
            const float mean = wave_sum(x[0] + x[1] + x[2] + x[3]) * (1.f / 256.f);
            float q = 0.f;
#pragma unroll
            for (int k = 0; k < 4; ++k) q += (x[k] - mean) * (x[k] - mean);
            const float rs = rsqrtf(wave_sum(q) * (1.f / 256.f) + LN_EPS);
            const u32x2 ov = ovs[rr];
            const float o4[4] = {__uint_as_float(ov.x << 16), __uint_as_float(ov.x & 0xFFFF0000u), __uint_as_float(ov.y << 16), __uint_as_float(ov.y & 0xFFFF0000u)};
            float y[4];
#pragma unroll
            for (int k = 0; k < 4; ++k) y[k] = (x[k] - mean) * rs * gg[k] * sigmoidf_(o4[k]);
            u32x2 o2; o2.x = pack2(y[0], y[1]); o2.y = pack2(y[2], y[3]);
            *(u32x2*)(p.YA + (row0 + t) * 1024 + h * 256 + lane * 4) = o2;
        }
    }
}

DEVI void stage_mlstm_sample(const P& p, char* smem, int bid, int nblk) {
    float* qs = (float*)smem;
    float* ks = qs + 512;
    float* vs = ks + 512;
    float* part = vs + 1024;
    float* hs = part + 2048;
    float* sc = hs + 1024;
    float* bc = sc; float* ip = sc + 4; float* mt = sc + 8; float* wint = sc + 12; float* emt = sc + 16; float* ww = sc + 20; float* den = sc + 24;
    float* Pm = sc + 32;
    float* misc = sc + 48;
    const int tid = tid_opq(), lane = tid & 63, wid = tid >> 6;
    for (int task = bid; task < 512; task += nblk) {
        const int b = task >> 2, h = task & 3;
        const size_t row0 = (size_t)NTP + b * 4;
        __syncthreads();
        { const int t = tid >> 7, d = tid & 127;
          qs[tid] = bf2f(p.PROJ[(row0 + t) * PS + C_AQ + h * 128 + d]);
          ks[tid] = bf2f(p.PROJ[(row0 + t) * PS + C_AK + h * 128 + d]); }
        for (int idx = tid; idx < 1024; idx += 512) { const int t = idx >> 8, v = idx & 255; vs[idx] = bf2f(p.PROJ[(row0 + t) * PS + C_AV + h * 256 + v]); }
        if (tid == 0) {
            const float m0 = p.state_m[task];
            float cs = 0.f;
            for (int t = 0; t < 4; ++t) { cs += logsigmoidf_(p.SM[(row0 + t) * 64 + 4 + h]); bc[t] = cs; ip[t] = p.SM[(row0 + t) * 64 + h]; }
            for (int t = 0; t < 4; ++t) {
                float mx = bc[t] + m0;
                for (int s = 0; s <= t; ++s) mx = fmaxf(mx, bc[t] - bc[s] + ip[s]);
                mt[t] = mx; wint[t] = __expf(bc[t] + m0 - mx); emt[t] = __expf(-mx);
            }
            const float bend = bc[3];
            float mnew = bend + m0;
            for (int s = 0; s < 4; ++s) mnew = fmaxf(mnew, bend - bc[s] + ip[s]);
            misc[0] = __expf(bend + m0 - mnew);
            for (int s = 0; s < 4; ++s) ww[s] = __expf(bend - bc[s] + ip[s] - mnew);
            p.out[O_SM + task] = mnew;
        }
        __syncthreads();
        if (tid < 16) {
            const int t = tid >> 2, s = tid & 3;
            float a = 0.f;
            if (s <= t) { for (int d = 0; d < 128; ++d) a += qs[t * 128 + d] * ks[s * 128 + d]; a *= __expf(bc[t] - bc[s] + ip[s] - mt[t]); }
            Pm[tid] = a;
        }
        __syncthreads();
        if (tid < 4) {
            const int t = tid; float qn = 0.f;
            for (int d = 0; d < 128; ++d) qn += qs[t * 128 + d] * p.state_n[(size_t)task * 128 + d];
            den[t] = wint[t] * qn + Pm[t * 4] + Pm[t * 4 + 1] + Pm[t * 4 + 2] + Pm[t * 4 + 3];
        }
        const float a = misc[0];
        if (tid >= 128 && tid < 256) {
            const int d = tid - 128;
            float n = a * p.state_n[(size_t)task * 128 + d];
            for (int s = 0; s < 4; ++s) n += ww[s] * ks[s * 128 + d];
            p.out[O_SN + (size_t)task * 128 + d] = n;
        }
        {
            const int v = tid & 255, dh = tid >> 8;
            float acc[4] = {0.f, 0.f, 0.f, 0.f};
            float wv[4];
#pragma unroll
            for (int s = 0; s < 4; ++s) wv[s] = ww[s] * vs[s * 256 + v];
            for (int d0 = dh * 64; d0 < dh * 64 + 64; d0 += 16) {
                float c0[16];
#pragma unroll
                for (int i = 0; i < 16; ++i) c0[i] = __builtin_nontemporal_load(p.state_C + ((size_t)task * 128 + d0 + i) * 256 + v);
#pragma unroll
                for (int i = 0; i < 16; ++i) {
                    const int d = d0 + i;
#pragma unroll
                    for (int t = 0; t < 4; ++t) acc[t] += qs[t * 128 + d] * c0[i];
                    float cn = a * c0[i];
#pragma unroll
                    for (int s = 0; s < 4; ++s) cn += ks[s * 128 + d] * wv[s];
                    __builtin_nontemporal_store(cn, p.out + O_SC + ((size_t)task * 128 + d) * 256 + v);
                }
            }
#pragma unroll
            for (int t = 0; t < 4; ++t) part[(dh * 4 + t) * 256 + v] = acc[t];
        }
        __syncthreads();
        if (tid < 256) {
            const int v = tid;
#pragma unroll
            for (int t = 0; t < 4; ++t) {
                float num = wint[t] * (part[t * 256 + v] + part[(4 + t) * 256 + v]);
#pragma unroll
                for (int s = 0; s < 4; ++s) num += Pm[t * 4 + s] * vs[s * 256 + v];
                hs[t * 256 + v] = num / fmaxf(fabsf(den[t]), emt[t]);
            }
        }
        __syncthreads();
        if (wid < 4) {
            const int t = wid;
            const f32x4 x = *(const f32x4*)(hs + t * 256 + lane * 4);
            const float mean = wave_sum(x[0] + x[1] + x[2] + x[3]) * (1.f / 256.f);
            float q = 0.f;
#pragma unroll
            for (int k = 0; k < 4; ++k) q += (x[k] - mean) * (x[k] - mean);
            const float rs = rsqrtf(wave_sum(q) * (1.f / 256.f) + LN_EPS);
            float y[4];
#pragma unroll
            for (int k = 0; k < 4; ++k) {
                const int vi = lane * 4 + k;
                const float o = bf2f(p.PROJ[(row0 + t) * PS + C_AO + h * 256 + vi]);
                y[k] = (x[k] - mean) * rs * p.norm_a_g[h * 256 + vi] * sigmoidf_(o);
            }
            u32x2 o2; o2.x = pack2(y[0], y[1]); o2.y = pack2(y[2], y[3]);
            *(u32x2*)(p.YA + (row0 + t) * 1024 + h * 256 + lane * 4) = o2;
        }
    }
}

constexpr int CP_ABUF = 33280, CP_WBUF = 18432, CP_A = 0, CP_W = 2 * CP_ABUF, CP_LDS = CP_W + 2 * CP_WBUF;
constexpr int CP_AROW = 1024 + 8;
DEVI void stage_compress(const P& p, char* smem, int bid, int nblk, int only = -1) {
    const int tid = tid_opq(), lane = tid & 63, wid = tid >> 6, fr = lane & 15, fq = lane >> 4;
    const int kv = wid & 1, rt = wid >> 1;
    const int n_it = only >= 0 ? 1 : (256 + nblk - 1) / nblk + (16 + nblk - 1) / nblk;
    for (int it = 0; it < n_it; ++it) {
        const int ns_it = (256 + nblk - 1) / nblk;
        const int task = only >= 0 ? only : it < ns_it ? bid + it * nblk : 256 + (nblk - 1 - bid) + (it - ns_it) * nblk;
        if (only < 0 && (task >= 272 || (it < ns_it && task >= 256))) continue;
        const bool prompt = task >= 256;
        const int rowbytes = prompt ? 1024 : 2048, npieces = prompt ? 2 : 4;
        const char* src[4]; int dsto[4];
#pragma unroll
        for (int q = 0; q < 4; ++q) {
            const int off = q * 8192 + tid * 16, r = off / rowbytes, cb = off % rowbytes;
            if (prompt) { const int blk = (task - 256) * 16 + (r & 15); src[q] = (const char*)(p.PROJ + (size_t)blk * 64 * PS + C_CMP) + cb; dsto[q] = (r & 15) * CP_AROW * 2 + cb; }
            else { const int gb = task * 16 + r, b = gb >> 5, n = gb & 31; const int page = p.page_table[b * 16 + (n >> 1)];
                   src[q] = (const char*)(p.cache_cmp + ((size_t)page * 128 + (n & 1) * 64) * 512) + cb; dsto[q] = r * CP_AROW * 2 + (cb >> 1); }
        }
        const size_t sstride = prompt ? (size_t)PS * 2 : 2048;
        const char* wsrc[2]; int wdst[2];
#pragma unroll
        for (int q = 0; q < 2; ++q) { const int idx = q * 512 + tid, row = idx >> 3, ch = idx & 7; wsrc[q] = (const char*)(p.WCT + (size_t)row * 4096) + ch * 16; wdst[q] = row * 144 + ch * 16; }
        f32x4 acc[4];
#pragma unroll
        for (int nt = 0; nt < 4; ++nt) acc[nt] = (f32x4){0.f, 0.f, 0.f, 0.f};
        f32x4 ra0[4], ra1[4]; u32x4 rw0[2], rw1[2];
        auto issue = [&](int l, f32x4 (&ra)[4], u32x4 (&rw)[2]) {
#pragma unroll
            for (int q = 0; q < 4; ++q) if (q < npieces) ra[q] = prompt ? *(const f32x4*)(src[q] + (size_t)l * sstride) : __builtin_nontemporal_load((const f32x4*)(src[q] + (size_t)l * sstride));
#pragma unroll
            for (int q = 0; q < 2; ++q) rw[q] = *(const u32x4*)(wsrc[q] + l * 128);
        };
        auto commit = [&](int buf, const f32x4 (&ra)[4], const u32x4 (&rw)[2]) {
            char* ab = smem + CP_A + buf * CP_ABUF; char* wbuf = smem + CP_W + buf * CP_WBUF;
#pragma unroll
            for (int q = 0; q < 4; ++q) if (q < npieces) {
                if (prompt) *(f32x4*)(ab + dsto[q]) = ra[q];
                else { u32x2 o; o.x = pack2(ra[q][0], ra[q][1]); o.y = pack2(ra[q][2], ra[q][3]); *(u32x2*)(ab + dsto[q]) = o; }
            }
#pragma unroll
            for (int q = 0; q < 2; ++q) *(u32x4*)(wbuf + wdst[q]) = rw[q];
        };
        auto consume = [&](int buf) {
            const char* ab = smem + CP_A + buf * CP_ABUF; const char* wbuf = smem + CP_W + buf * CP_WBUF;
            const bf16_t* arow = (const bf16_t*)ab + (rt * 4 + (fr >> 2)) * CP_AROW + kv * 256 + (fr & 3) * 64 + fq * 8;
#pragma unroll
            for (int hf = 0; hf < 2; ++hf) {
                const bf16x8 a = *(const bf16x8*)(arow + hf * 32);
#pragma unroll
                for (int nt = 0; nt < 4; ++nt) {
                    const bf16x8 bfrag = *(const bf16x8*)(wbuf + (kv * 64 + nt * 16 + fr) * 144 + hf * 64 + fq * 16);
                    acc[nt] = __builtin_amdgcn_mfma_f32_16x16x32_bf16(a, bfrag, acc[nt], 0, 0, 0);
                }
            }
        };
        __syncthreads();
        issue(0, ra0, rw0); issue(1, ra1, rw1); commit(0, ra0, rw0); issue(2, ra0, rw0);
        __syncthreads();
#pragma unroll 1
        for (int l = 0; l < 64; l += 2) {
            consume(0);
            commit(1, ra1, rw1);
            if (l + 3 < 64) issue(l + 3, ra1, rw1);
            __syncthreads();
            consume(1);
            if (l + 2 < 64) commit(0, ra0, rw0);
            if (l + 4 < 64) issue(l + 4, ra0, rw0);
            __syncthreads();
        }
        {
            const int ob = prompt ? (task - 256) * 16 + rt * 4 + fq : 256 + task * 16 + rt * 4 + fq;
#pragma unroll
            for (int nt = 0; nt < 4; ++nt) {
                const float bias = p.PW[kv * 64 + nt * 16 + fr];
#pragma unroll
                for (int r = 0; r < 4; ++r) p.KC[(size_t)ob * 512 + kv * 256 + r * 64 + nt * 16 + fr] = acc[nt][r] + bias;
            }
        }
    }
}

typedef float f32x16 __attribute__((ext_vector_type(16)));
typedef short s16x4 __attribute__((ext_vector_type(4)));
typedef __attribute__((address_space(3))) const char* lds_cptr;
#define MFMA32(a, b, c) __builtin_amdgcn_mfma_f32_32x32x16_bf16(a, b, c, 0, 0, 0)
DEVI int crow(int r, int hi) { return (r & 3) + 8 * (r >> 2) + 4 * hi; }
DEVI unsigned cvtpk(float lo, float hi) { return pack2(lo, hi); }
DEVI s16x4 vtr(lds_cptr p) { return __builtin_bit_cast(s16x4, __builtin_amdgcn_ds_read_tr16_b64_v4i16((__attribute__((address_space(3))) s16x4*)p)); }
DEVI float half_max(float m) { auto rr = __builtin_amdgcn_permlane32_swap(__float_as_uint(m), __float_as_uint(m), false, false); return fmaxf(__uint_as_float(rr[0]), __uint_as_float(rr[1])); }
DEVI float half_sum(float m) { auto rr = __builtin_amdgcn_permlane32_swap(__float_as_uint(m), __float_as_uint(m), false, false); return __uint_as_float(rr[0]) + __uint_as_float(rr[1]); }

struct BlkDesc { const char* k; int stride_bytes; int f32; int count; int pos0; };
DEVI void blk_load(const BlkDesc& d, int tid, u32x4& rk, u32x4& rv) {
    const int key = tid & 63, chunk = tid >> 6;
    rk = (u32x4){0u, 0u, 0u, 0u}; rv = rk;
    if (key < d.count) {
        const char* kr = d.k + (size_t)key * d.stride_bytes;
        if (d.f32) {
            const f32x4* s1 = (const f32x4*)(kr + chunk * 32); const f32x4* s2 = (const f32x4*)(kr + 1024 + chunk * 32);
            rk = pack8f(s1[0], s1[1]); rv = pack8f(s2[0], s2[1]);
        } else { rk = *(const u32x4*)(kr + chunk * 16); rv = *(const u32x4*)(kr + 512 + chunk * 16); }
    }
}
DEVI void blk_store(char* kimg, char* vimg, int tid, const u32x4& rk, const u32x4& rv) {
    const int key = tid & 63, chunk = tid >> 6;
    *(u32x4*)(kimg + chunk * 1024 + key * 16) = rk;
    *(u32x4*)(vimg + (chunk >> 2) * 4096 + key * 64 + (chunk & 3) * 16) = rv;
}

DEVI void attn_tile(const char* kimg, const char* vimg, const bf16x8 (&qr)[4], float& m2, float& lsum, f32x16& o0, f32x16& o1, f32x16& s0, f32x16& s1,
                    float sl, float bb, int lh, int ll, bool fast, float* wsf_hi  , float* wsf_r  , int lane) {
    const int r32 = lane & 31, hi = lane >> 5;
    const f32x16 z = {};
    s0 = z; s1 = z;
    {
        const char* kp = kimg + hi * 1024 + r32 * 16;
#pragma unroll
        for (int d0 = 0; d0 < 4; ++d0) {
            const bf16x8 k0 = *(const bf16x8*)(kp + d0 * 2048), k1 = *(const bf16x8*)(kp + d0 * 2048 + 512);
            s0 = MFMA32(k0, qr[d0], s0); s1 = MFMA32(k1, qr[d0], s1);
        }
    }
    float mx = -1e30f;
    if (fast) {
#pragma unroll
        for (int r = 0; r < 16; ++r) {
            const int c = (r & 3) + 8 * (r >> 2);
            s0[r] = fmaf(s0[r], 1.4426950408889634f, fmaf(sl, (float)c, bb)); s1[r] = fmaf(s1[r], 1.4426950408889634f, fmaf(sl, (float)(c + 32), bb));
            mx = fmaxf(mx, fmaxf(s0[r], s1[r]));
        }
    } else {
#pragma unroll
        for (int r = 0; r < 16; ++r) {
            const int c = (r & 3) + 8 * (r >> 2);
            const float t0 = fmaf(s0[r], 1.4426950408889634f, fmaf(sl, (float)c, bb)), t1 = fmaf(s1[r], 1.4426950408889634f, fmaf(sl, (float)(c + 32), bb));
            s0[r] = (c <= lh && c > ll) ? t0 : -INFINITY; s1[r] = (c + 32 <= lh && c + 32 > ll) ? t1 : -INFINITY;
            mx = fmaxf(mx, fmaxf(s0[r], s1[r]));
        }
    }
    mx = half_max(mx);
    const float mnew = fmaxf(m2, mx);
    const float f = __builtin_amdgcn_exp2f(m2 - mnew);
    m2 = mnew;
    float ps = 0.f;
#pragma unroll
    for (int r = 0; r < 16; ++r) { s0[r] = __builtin_amdgcn_exp2f(s0[r] - mnew); s1[r] = __builtin_amdgcn_exp2f(s1[r] - mnew); ps += s0[r] + s1[r]; }
    lsum = lsum * f + ps;
    if (__any(f != 1.f)) {
        if (hi == 0) *wsf_r = f;
        asm volatile("s_waitcnt lgkmcnt(0)" ::: "memory");
#pragma unroll
        for (int a = 0; a < 4; ++a) {
            const f32x4 fv = *(const f32x4*)(wsf_hi + 8 * a);
#pragma unroll
            for (int k = 0; k < 4; ++k) { o0[4 * a + k] *= fv[k]; o1[4 * a + k] *= fv[k]; }
        }
        asm volatile("s_waitcnt lgkmcnt(0)" ::: "memory");
    }
    u32x4 pw[4];
#pragma unroll
    for (int k = 0; k < 4; ++k) { pw[0][k] = cvtpk(s0[2 * k], s0[2 * k + 1]); pw[1][k] = cvtpk(s0[8 + 2 * k], s0[8 + 2 * k + 1]); pw[2][k] = cvtpk(s1[2 * k], s1[2 * k + 1]); pw[3][k] = cvtpk(s1[8 + 2 * k], s1[8 + 2 * k + 1]); }
    const lds_cptr vp = (lds_cptr)vimg + ((lane >> 4) & 1) * 32 + (lane & 3) * 8 + (4 * hi + ((lane & 15) >> 2)) * 64;
#pragma unroll
    for (int i = 0; i < 8; ++i) {
        const s16x4 lo = vtr(vp + ((i >> 2) * 4096 + (i & 3) * 1024)), hh = vtr(vp + ((i >> 2) * 4096 + (i & 3) * 1024 + 512));
        const bf16x8 vf = (bf16x8){lo[0], lo[1], lo[2], lo[3], hh[0], hh[1], hh[2], hh[3]};
        const bf16x8 pf = __builtin_bit_cast(bf16x8, pw[i & 3]);
        if (i < 4) o0 = MFMA32(pf, vf, o0); else o1 = MFMA32(pf, vf, o1);
    }
}

constexpr int NSA_KV0 = 0, NSA_KV1 = 16384, NSA_WSF = 32768, NSA_IMP = NSA_WSF + 2048, NSA_SEL = NSA_IMP + 16384, NSA_LIST = NSA_SEL + 512, NSA_OST = NSA_LIST + 256, NSA_YAC = NSA_OST + 32768, NSA_LDS = NSA_YAC + 65536;
static_assert(NSA_LDS <= 152 * 1024, "lds");

DEVI BlkDesc nsa_desc(const P& p, bool prompt, int b, int g, int branch, int j) {
    BlkDesc d;
    if (prompt) {
        if (branch == 0) { d.k = (const char*)(p.KC + ((size_t)(b * 64) * 512 + g * 64)); d.stride_bytes = 2048; d.f32 = 1; d.count = 64; d.pos0 = 0; }
        else { d.k = (const char*)(p.PROJ + ((size_t)b * 4096 + j * 64) * PS + (branch == 1 ? C_SLC : C_WIN) + g * 64); d.stride_bytes = PS * 2; d.f32 = 0; d.count = 64; d.pos0 = j * 64; }
    } else {
        if (branch == 0) { d.k = (const char*)(p.KC + ((size_t)(256 + b * 32) * 512 + g * 64)); d.stride_bytes = 2048; d.f32 = 1; d.count = 32; d.pos0 = 0; }
        else if (branch == 1 && j < 32) { const int page = p.page_table[b * 16 + (j >> 1)]; d.k = (const char*)(p.cache_slc + ((size_t)page * 128 + (j & 1) * 64) * 512 + g * 64); d.stride_bytes = 2048; d.f32 = 1; d.count = 64; d.pos0 = j * 64; }
        else if (branch == 2 && j < 8) { d.k = (const char*)(p.cache_win + ((size_t)b * 512 + j * 64) * 512 + g * 64); d.stride_bytes = 2048; d.f32 = 1; d.count = 64; d.pos0 = 1536 + j * 64; }
        else { d.k = (const char*)(p.PROJ + ((size_t)NTP + b * 4) * PS + (branch == 1 ? C_SLC : C_WIN) + g * 64); d.stride_bytes = PS * 2; d.f32 = 0; d.count = 4; d.pos0 = 2048; }
    }
    return d;
}

constexpr int NS_IMG = 0, NS_WSF = 131072, NS_IMP = NS_WSF + 2048, NS_SEL = NS_IMP + 2048, NS_LIST = NS_SEL + 64, NS_YC = NS_LIST + 64, NS_PM = NS_YC + 4096, NS_Q = NS_PM + 2048, NS_LDS = NS_Q + 4096;
static_assert(NS_LDS <= 152 * 1024, "lds");
DEVI void wave_stage_block(const BlkDesc& d, char* kimg, char* vimg, int lane) {
    asm volatile("" : "+v"(lane));
    const int rsub = lane >> 4, pc = lane & 15;
    if (d.f32) {
#pragma unroll
        for (int half = 0; half < 2; ++half) {
#pragma unroll
            for (int i0 = 0; i0 < 16; i0 += 6) {
                f32x4 x[6];
#pragma unroll
                for (int i = 0; i < 6; ++i) if (i0 + i < 16) { const int row = 4 * (i0 + i) + rsub; x[i] = row < d.count ? __builtin_nontemporal_load((const f32x4*)(d.k + (size_t)row * d.stride_bytes + half * 1024 + pc * 16)) : (f32x4){0.f, 0.f, 0.f, 0.f}; }
#pragma unroll
                for (int i = 0; i < 6; ++i) if (i0 + i < 16) {
                    const int row = 4 * (i0 + i) + rsub, c = pc >> 1;
                    u32x2 o; o.x = pack2(x[i][0], x[i][1]); o.y = pack2(x[i][2], x[i][3]);
                    if (half == 0) *(u32x2*)(kimg + c * 1024 + row * 16 + (pc & 1) * 8) = o;
                    else *(u32x2*)(vimg + (c >> 2) * 4096 + row * 64 + (c & 3) * 16 + (pc & 1) * 8) = o;
                }
            }
        }
    } else {
        const int row = lane >> 3, c = lane & 7;
#pragma unroll
        for (int i = 0; i < 8; ++i) {
            const int rr = 8 * i + row;
            u32x4 kk = {0u, 0u, 0u, 0u}, vv = {0u, 0u, 0u, 0u};
            if (rr < d.count) { kk = *(const u32x4*)(d.k + (size_t)rr * d.stride_bytes + c * 16); vv = *(const u32x4*)(d.k + (size_t)rr * d.stride_bytes + 512 + c * 16); }
            *(u32x4*)(kimg + c * 1024 + rr * 16) = kk;
            *(u32x4*)(vimg + (c >> 2) * 4096 + rr * 64 + (c & 3) * 16) = vv;
        }
    }
    asm volatile("s_waitcnt lgkmcnt(0)" ::: "memory");
}

DEVI void nsa_sample_unit(const P& p, char* smem, int us) {
    const int tid = tid_opq(), lane = tid & 63, wid = tid >> 6, r32 = lane & 31, hi = lane >> 5;
    const int b = us >> 2, g = us & 3;
    const size_t rowbase = (size_t)NTP + b * 4;
    char* kimg = smem + NS_IMG + wid * 16384; char* vimg = kimg + 8192;
    float* wsf = (float*)(smem + NS_WSF) + wid * 64;
    float* impb = (float*)(smem + NS_IMP);
    unsigned long long* selm = (unsigned long long*)(smem + NS_SEL);
    unsigned char* blist = (unsigned char*)(smem + NS_LIST);
    float* ycmp = (float*)(smem + NS_YC);
    const int tokl = r32 >> 2, head = r32 & 3;
    const bool tok_ok = r32 < 16;
    const int qpos = 2048 + tokl;
    const float slope2 = alibi_slope(g * 4 + head) * 1.4426950408889634f;
    char* qsh = smem + NS_Q;
    int hi4 = 4 * hi; asm volatile("" : "+v"(hi4));
    float* wsf_hi = wsf + hi4; float* wsf_r = wsf + r32;
    f32x16 s0, s1;
    __syncthreads();
    if (wid == 0) {
        bf16x8 qr[4];
        {
            const bf16_t* qp = p.PROJ + (rowbase + (tok_ok ? tokl : 0)) * PS + C_BQ + (g * 4 + head) * 64 + hi * 8;
#pragma unroll
            for (int d0 = 0; d0 < 4; ++d0) {
                u32x4 v = *(const u32x4*)(qp + d0 * 16);
#pragma unroll
                for (int k = 0; k < 4; ++k) { const float lo = __uint_as_float(v[k] << 16) * 0.125f, hh = __uint_as_float(v[k] & 0xFFFF0000u) * 0.125f; v[k] = tok_ok ? ((__float_as_uint(lo) >> 16) | (__float_as_uint(hh) & 0xFFFF0000u)) : 0u; }
                qr[d0] = __builtin_bit_cast(bf16x8, v);
                *(u32x4*)(qsh + d0 * 1024 + lane * 16) = v;
            }
        }
        f32x16 o0 = {}, o1 = {}; float m2 = -1e30f, lsum = 0.f;
        const BlkDesc d = nsa_desc(p, false, b, g, 0, 0);
        wave_stage_block(d, kimg, vimg, lane);
        const int lh = 31 - hi4;
        const float sl = 64.f * slope2;
        attn_tile(kimg, vimg, qr, m2, lsum, o0, o1, s0, s1, sl, tok_ok ? sl * (float)(hi4 - 32) : -INFINITY, lh, -1000, false, wsf_hi, wsf_r, lane);
        const float lt = half_sum(lsum);
        const float inv = lt > 0.f ? 1.f / lt : 0.f;
        unsigned x[64];
#pragma unroll
        for (int r = 0; r < 16; ++r) {
#pragma unroll
            for (int n = 0; n < 2; ++n) {
                float a = (n == 0 ? s0[r] : s1[r]) * inv;
                a += __shfl_xor(a, 1); a += __shfl_xor(a, 2);
                const int j = (r & 3) + 8 * (r >> 2) + 32 * n + hi4;
                if (j == 32 || j == 0) a = 5.0f;
                if (j > 32) a = -2.0f;
                const unsigned u = __float_as_uint(a);
                const unsigned o = (u & 0x80000000u) ? ~u : (u | 0x80000000u);
                x[n * 16 + r] = (o & ~63u) | (unsigned)(63 - j);
            }
        }
        float fac = 0.f;
        if (tok_ok && lt > 0.f) fac = sigmoidf_(p.SM[(rowbase + tokl) * 64 + 8 + g * 4 + head]) / lt;
        if (hi == 0) *wsf_r = fac;
        asm volatile("s_waitcnt lgkmcnt(0)" ::: "memory");
#pragma unroll
        for (int a = 0; a < 2; ++a) {
            const f32x4 fv = *(const f32x4*)(wsf_hi + 8 * a);
#pragma unroll
            for (int k = 0; k < 4; ++k) { float* yp = ycmp + (8 * a + k + hi4) * 64 + r32; yp[0] = o0[4 * a + k] * fv[k]; yp[32] = o1[4 * a + k] * fv[k]; }
        }
        asm volatile("s_waitcnt lgkmcnt(0)" ::: "memory");
        {
            sort16_desc<0>(x); sort16_desc<16>(x);
            unsigned th[16], oth[16], fin[16];
            merge_top16(&x[0], &x[16], th);
#pragma unroll
            for (int i = 0; i < 16; ++i) { auto rr = __builtin_amdgcn_permlane32_swap(th[i], th[i], false, false); oth[i] = hi ? rr[0] : rr[1]; }
            merge_top16(th, oth, fin);
            unsigned long long mask = 0ull;
#pragma unroll
            for (int i = 0; i < 16; ++i) mask |= 1ull << (63u - (fin[i] & 63u));
            if (head == 0 && hi == 0 && r32 < 16) selm[r32 >> 2] = mask;
        }
        asm volatile("s_waitcnt lgkmcnt(0)" ::: "memory");
        {
            const unsigned long long u = selm[0] | selm[1] | selm[2] | selm[3];
            const int n = __builtin_popcountll(u);
            if ((u >> lane) & 1ull) blist[1 + __builtin_popcountll(u & ((1ull << lane) - 1ull))] = (unsigned char)(0x40 | lane);
            if (lane <= 8) blist[1 + n + lane] = (unsigned char)(0x80 | lane);
            if (lane == 0) blist[0] = (unsigned char)(n + 9);
        }
    }
    __syncthreads();
    const int nb = blist[0];
    const unsigned long long mysel = tok_ok ? selm[tokl] : 0ull;
    int nslc = 0;
    for (int i = 0; i < nb; ++i) nslc += (blist[1 + i] >> 6) == 1 ? 1 : 0;
    float so[16], ms, lst;
    float wo[16], mw, lwt;
#pragma unroll 1
    for (int pass = 0; pass < 2; ++pass) {
        f32x16 o0 = {}, o1 = {}; float m2 = -1e30f, lsum = 0.f;
        const int i0 = pass == 0 ? 0 : nslc, i1 = pass == 0 ? nslc : nb;
#pragma unroll 1
        for (int i = i0 + wid; i < i1; i += 8) {
            const int e = blist[1 + i], br = e >> 6, j = e & 63;
            const BlkDesc d = nsa_desc(p, false, b, g, br, j);
            wave_stage_block(d, kimg, vimg, lane);
            asm volatile("" : "+v"(hi4));
            const bool lsel = tok_ok && (br == 2 || ((mysel >> j) & 1ull));
            const int rel = qpos - d.pos0;
            const int lh = (rel < d.count - 1 ? rel : d.count - 1) - hi4;
            const int ll = (br == 2 ? rel - 512 : -1000) - hi4;
            const bool fast = __all(!lsel || (lh >= 59 && ll < 0));
            const float bb = lsel ? slope2 * (float)(hi4 + d.pos0 - 2048) : -INFINITY;
            bf16x8 qr[4];
#pragma unroll
            for (int d0 = 0; d0 < 4; ++d0) qr[d0] = *(const bf16x8*)(qsh + d0 * 1024 + lane * 16);
            attn_tile(kimg, vimg, qr, m2, lsum, o0, o1, s0, s1, slope2, bb, lh, ll, fast, wsf_hi, wsf_r, lane);
        }
        const float lt = half_sum(lsum);
        if (pass == 0) { ms = m2; lst = lt;
#pragma unroll
            for (int r = 0; r < 8; ++r) { so[r] = o0[r]; so[8 + r] = o1[r]; } }
        else { mw = m2; lwt = lt;
#pragma unroll
            for (int r = 0; r < 8; ++r) { wo[r] = o0[r]; wo[8 + r] = o1[r]; } }
    }
    {
        float* po = (float*)kimg;
        float* pm = (float*)(smem + NS_PM) + wid * 64;
        if (lane < 16) { pm[lane * 2] = ms; pm[lane * 2 + 1] = lst; pm[32 + lane * 2] = mw; pm[32 + lane * 2 + 1] = lwt; }
#pragma unroll
        for (int a = 0; a < 2; ++a)
#pragma unroll
            for (int k = 0; k < 4; ++k) {
                float* yp = po + (8 * a + k + hi4) * 64 + r32;
                yp[0] = so[4 * a + k]; yp[32] = so[8 + 4 * a + k]; yp[1024] = wo[4 * a + k]; yp[1024 + 32] = wo[8 + 4 * a + k];
            }
    }
    __syncthreads();
    {
        const int row = tid >> 5, dcol = tid & 31, tk = row >> 2, hd = row & 3;
        float res[2][2];
#pragma unroll
        for (int br = 0; br < 2; ++br) {
            float M = -1e30f;
#pragma unroll
            for (int w = 0; w < 8; ++w) M = fmaxf(M, ((const float*)(smem + NS_PM))[w * 64 + br * 32 + row * 2]);
            float L = 0.f, a0 = 0.f, a1 = 0.f;
#pragma unroll
            for (int w = 0; w < 8; ++w) {
                const float* pmw = (const float*)(smem + NS_PM) + w * 64 + br * 32 + row * 2;
                const float f = __builtin_amdgcn_exp2f(pmw[0] - M);
                const float* pow_ = (const float*)(smem + NS_IMG + w * 16384) + br * 1024 + row * 64 + dcol;
                L += pmw[1] * f; a0 += pow_[0] * f; a1 += pow_[32] * f;
            }
            const float gate = sigmoidf_(p.SM[(rowbase + tk) * 64 + 8 + (br + 1) * 16 + g * 4 + hd]);
            const float sc = L > 0.f ? gate / L : 0.f;
            res[br][0] = a0 * sc; res[br][1] = a1 * sc;
        }
        const float y0 = ycmp[row * 64 + dcol] + res[0][0] + res[1][0], y1 = ycmp[row * 64 + dcol + 32] + res[0][1] + res[1][1];
        bf16_t* yb = p.YB + (rowbase + tk) * 1024 + (g * 4 + hd) * 64;
        yb[dcol] = f2bf(y0); yb[dcol + 32] = f2bf(y1);
    }
}

constexpr int NP_KVB = 18432, NP_KV0 = 0, NP_KV1 = NP_KVB, NP_WSF = 2 * NP_KVB, NP_IMP = NP_WSF + 2048, NP_SEL = NP_IMP + 16384, NP_LIST = NP_SEL + 512, NP_YAC = NP_LIST + 256, NP_LDS = NP_YAC + 65536;
static_assert(NP_LDS <= 152 * 1024, "lds");
DEVI void blk_store_ext(const BlkDesc& d, int pstep, int poff, int t0, char* kimg, char* vimg, int tid, const u32x4& rk, const u32x4& rv) {
    const int key = tid & 63, chunk = tid >> 6;
    *(u32x4*)(kimg + chunk * 1024 + key * 16) = rk;
    *(u32x4*)(vimg + (chunk >> 2) * 4096 + key * 64 + (chunk & 3) * 16) = rv;
    if (chunk == 0) {
        const int rel = d.pos0 + key * pstep + poff - t0;
        const int phi = (rel >> 6) << 6, plo = rel & 63;
        const unsigned bh = pack2((float)phi, (float)phi), bl = pack2((float)plo, (float)plo);
        *(u32x4*)(kimg + 8 * 1024 + key * 16) = (u32x4){bh, bl, 0x00003F80u, 0u};
    }
}
DEVI void attn_tile2(const char* kimg, const char* vimg, const bf16x8 (&qr)[4], const bf16x8 qext, float& m, float& lsum, f32x16& o0, f32x16& o1, f32x16& s0, f32x16& s1,
                     int lh, int ll, bool fast, float* wsf_hi, float* wsf_r, int lane) {
    const int r32 = lane & 31, hi = lane >> 5;
    const f32x16 z = {};
    s0 = z; s1 = z;
    {
        const char* kp = kimg + hi * 1024 + r32 * 16;
#pragma unroll
        for (int d0 = 0; d0 < 5; ++d0) {
            const bf16x8 k0 = *(const bf16x8*)(kp + d0 * 2048), k1 = *(const bf16x8*)(kp + d0 * 2048 + 512);
            const bf16x8 qf = d0 < 4 ? qr[d0 < 4 ? d0 : 0] : qext;
            s0 = MFMA32(k0, qf, s0); s1 = MFMA32(k1, qf, s1);
        }
    }
    if (!fast) {
#pragma unroll
        for (int r = 0; r < 16; ++r) {
            const int c = (r & 3) + 8 * (r >> 2);
            s0[r] = (c <= lh && c > ll) ? s0[r] : -INFINITY; s1[r] = (c + 32 <= lh && c + 32 > ll) ? s1[r] : -INFINITY;
        }
    }
    float mx = fmaxf(s0[0], s1[0]);
#pragma unroll
    for (int r = 1; r < 16; ++r) mx = fmaxf(mx, fmaxf(s0[r], s1[r]));
    mx = half_max(mx);
    const float mnew = fmaxf(m, mx);
    const float f = __builtin_amdgcn_exp2f((m - mnew) * 1.4426950408889634f);
    m = mnew;
    const float nm2 = -mnew * 1.4426950408889634f;
    float ps = 0.f;
#pragma unroll
    for (int r = 0; r < 16; ++r) { s0[r] = __builtin_amdgcn_exp2f(fmaf(s0[r], 1.4426950408889634f, nm2)); s1[r] = __builtin_amdgcn_exp2f(fmaf(s1[r], 1.4426950408889634f, nm2)); ps += s0[r] + s1[r]; }
    lsum = lsum * f + ps;
    if (__any(f != 1.f)) {
        if (hi == 0) *wsf_r = f;
        asm volatile("s_waitcnt lgkmcnt(0)" ::: "memory");
#pragma unroll
        for (int a = 0; a < 4; ++a) {
            const f32x4 fv = *(const f32x4*)(wsf_hi + 8 * a);
#pragma unroll
            for (int k = 0; k < 4; ++k) { o0[4 * a + k] *= fv[k]; o1[4 * a + k] *= fv[k]; }
        }
        asm volatile("s_waitcnt lgkmcnt(0)" ::: "memory");
    }
    u32x4 pw[4];
#pragma unroll
    for (int k = 0; k < 4; ++k) { pw[0][k] = cvtpk(s0[2 * k], s0[2 * k + 1]); pw[1][k] = cvtpk(s0[8 + 2 * k], s0[8 + 2 * k + 1]); pw[2][k] = cvtpk(s1[2 * k], s1[2 * k + 1]); pw[3][k] = cvtpk(s1[8 + 2 * k], s1[8 + 2 * k + 1]); }
    const lds_cptr vp = (lds_cptr)vimg + ((lane >> 4) & 1) * 32 + (lane & 3) * 8 + (4 * hi + ((lane & 15) >> 2)) * 64;
#pragma unroll
    for (int i = 0; i < 8; ++i) {
        const s16x4 lo = vtr(vp + ((i >> 2) * 4096 + (i & 3) * 1024)), hh = vtr(vp + ((i >> 2) * 4096 + (i & 3) * 1024 + 512));
        const bf16x8 vf = (bf16x8){lo[0], lo[1], lo[2], lo[3], hh[0], hh[1], hh[2], hh[3]};
        const bf16x8 pf = __builtin_bit_cast(bf16x8, pw[i & 3]);
        if (i < 4) o0 = MFMA32(pf, vf, o0); else o1 = MFMA32(pf, vf, o1);
    }
}

DEVI void attn_tile3(const char* kA, const char* vA, const char* kB, const char* vB, const bf16x8 (&qr)[4], const bf16x8 qeA, const bf16x8 qeB, float& m, float& lsum,
                     f32x16& o0, f32x16& o1, int lhA, int llA, bool fastA, int lhB, int llB, bool fastB, float* wsf_hi, float* wsf_r, int lane) {
    const int r32 = lane & 31, hi = lane >> 5;
    f32x16 a0 = {}, a1 = {}, b0 = {}, b1 = {};
    {
        const char* kpa = kA + hi * 1024 + r32 * 16; const char* kpb = kB + hi * 1024 + r32 * 16;
#pragma unroll
        for (int d0 = 0; d0 < 5; ++d0) {
            const bf16x8 ka0 = *(const bf16x8*)(kpa + d0 * 2048), ka1 = *(const bf16x8*)(kpa + d0 * 2048 + 512);
            const bf16x8 kb0 = *(const bf16x8*)(kpb + d0 * 2048), kb1 = *(const bf16x8*)(kpb + d0 * 2048 + 512);
            const bf16x8 qa = d0 < 4 ? qr[d0 < 4 ? d0 : 0] : qeA, qb = d0 < 4 ? qr[d0 < 4 ? d0 : 0] : qeB;
            a0 = MFMA32(ka0, qa, a0); a1 = MFMA32(ka1, qa, a1); b0 = MFMA32(kb0, qb, b0); b1 = MFMA32(kb1, qb, b1);
        }
    }
    if (!fastA) {
#pragma unroll
        for (int r = 0; r < 16; ++r) { const int c = (r & 3) + 8 * (r >> 2); a0[r] = (c <= lhA && c > llA) ? a0[r] : -INFINITY; a1[r] = (c + 32 <= lhA && c + 32 > llA) ? a1[r] : -INFINITY; }
    }
    if (!fastB) {
#pragma unroll
        for (int r = 0; r < 16; ++r) { const int c = (r & 3) + 8 * (r >> 2); b0[r] = (c <= lhB && c > llB) ? b0[r] : -INFINITY; b1[r] = (c + 32 <= lhB && c + 32 > llB) ? b1[r] : -INFINITY; }
    }
    float mx = fmaxf(fmaxf(a0[0], a1[0]), fmaxf(b0[0], b1[0]));
#pragma unroll
    for (int r = 1; r < 16; ++r) mx = fmaxf(mx, fmaxf(fmaxf(a0[r], a1[r]), fmaxf(b0[r], b1[r])));
    mx = half_max(mx);
    const float mnew = fmaxf(m, mx);
    const float f = __builtin_amdgcn_exp2f((m - mnew) * 1.4426950408889634f);
    m = mnew;
    const float nm2 = -mnew * 1.4426950408889634f;
    float ps = 0.f;
#pragma unroll
    for (int r = 0; r < 16; ++r) {
        a0[r] = __builtin_amdgcn_exp2f(fmaf(a0[r], 1.4426950408889634f, nm2)); a1[r] = __builtin_amdgcn_exp2f(fmaf(a1[r], 1.4426950408889634f, nm2));
        b0[r] = __builtin_amdgcn_exp2f(fmaf(b0[r], 1.4426950408889634f, nm2)); b1[r] = __builtin_amdgcn_exp2f(fmaf(b1[r], 1.4426950408889634f, nm2));
        ps += (a0[r] + a1[r]) + (b0[r] + b1[r]);
    }
    lsum = lsum * f + ps;
    if (__any(f != 1.f)) {
        if (hi == 0) *wsf_r = f;
        asm volatile("s_waitcnt lgkmcnt(0)" ::: "memory");
#pragma unroll
        for (int a = 0; a < 4; ++a) {
            const f32x4 fv = *(const f32x4*)(wsf_hi + 8 * a);
#pragma unroll
            for (int k = 0; k < 4; ++k) { o0[4 * a + k] *= fv[k]; o1[4 * a + k] *= fv[k]; }
        }
        asm volatile("s_waitcnt lgkmcnt(0)" ::: "memory");
    }
    const int voff = ((lane >> 4) & 1) * 32 + (lane & 3) * 8 + (4 * hi + ((lane & 15) >> 2)) * 64;
#pragma unroll
    for (int t = 0; t < 2; ++t) {
        const f32x16& p0 = t == 0 ? a0 : b0; const f32x16& p1 = t == 0 ? a1 : b1;
        u32x4 pw[4];
#pragma unroll
        for (int k = 0; k < 4; ++k) { pw[0][k] = cvtpk(p0[2 * k], p0[2 * k + 1]); pw[1][k] = cvtpk(p0[8 + 2 * k], p0[8 + 2 * k + 1]); pw[2][k] = cvtpk(p1[2 * k], p1[2 * k + 1]); pw[3][k] = cvtpk(p1[8 + 2 * k], p1[8 + 2 * k + 1]); }
        const lds_cptr vp = (lds_cptr)(t == 0 ? vA : vB) + voff;
#pragma unroll
        for (int i = 0; i < 8; ++i) {
            const s16x4 lo = vtr(vp + ((i >> 2) * 4096 + (i & 3) * 1024)), hh = vtr(vp + ((i >> 2) * 4096 + (i & 3) * 1024 + 512));
            const bf16x8 vf = (bf16x8){lo[0], lo[1], lo[2], lo[3], hh[0], hh[1], hh[2], hh[3]};
            const bf16x8 pf = __builtin_bit_cast(bf16x8, pw[i & 3]);
            if (i < 4) o0 = MFMA32(pf, vf, o0); else o1 = MFMA32(pf, vf, o1);
        }
    }
}

constexpr int NQ_KVB = 18432, NQ_WSF = 4 * NQ_KVB, NQ_SEL = NQ_WSF + 2048, NQ_LIST = NQ_SEL + 512, NQ_YAC = NQ_LIST + 256, NQ_LDS = NQ_YAC + 65536, NQ_IMP = 2 * NQ_KVB;
static_assert(NQ_LDS <= 152 * 1024, "lds");
DEVI void nsa_prompt_unit(const P& p, char* smem, int b, int g, int qt) {
    const int tid = tid_opq(), lane = tid & 63, wid = tid >> 6, r32 = lane & 31, hi = lane >> 5;
    float* wsf = (float*)(smem + NQ_WSF) + wid * 64;
    float* impb = (float*)(smem + NQ_IMP) + wid * 512;
    unsigned long long* selm = (unsigned long long*)(smem + NQ_SEL);
    unsigned char* blist = (unsigned char*)(smem + NQ_LIST);
    const int t0 = qt * 64;
    const size_t rowbase = (size_t)b * 4096 + t0;
    const int tokl = wid * 8 + (r32 >> 2), head = r32 & 3;
    const int qpos = t0 + tokl;
    const float slope = alibi_slope(g * 4 + head);
    bf16x8 qr[4];
    {
        const bf16_t* qp = p.PROJ + (rowbase + tokl) * PS + C_BQ + (g * 4 + head) * 64 + hi * 8;
#pragma unroll
        for (int d0 = 0; d0 < 4; ++d0) {
            u32x4 v = *(const u32x4*)(qp + d0 * 16);
#pragma unroll
            for (int k = 0; k < 4; ++k) { const float lo = __uint_as_float(v[k] << 16) * 0.125f, hh = __uint_as_float(v[k] & 0xFFFF0000u) * 0.125f; v[k] = (__float_as_uint(lo) >> 16) | (__float_as_uint(hh) & 0xFFFF0000u); }
            qr[d0] = __builtin_bit_cast(bf16x8, v);
        }
    }
    unsigned qe_w;
    { const unsigned sh = (unsigned)f2bf(slope); const float rem = slope - __uint_as_float(sh << 16); qe_w = sh | ((unsigned)f2bf(rem) << 16); if (hi) qe_w = 0u; }
    int hi4 = 4 * hi; asm volatile("" : "+v"(hi4));
    float* yl = (float*)(smem + NQ_YAC) + wid * 2048 + hi4 * 64 + r32;
    float* wsf_hi = wsf + hi4; float* wsf_r = wsf + r32;
    f32x16 o0, o1; float m, lsum;
    auto finish = [&](int br) {
        const float lt = half_sum(lsum);
        float fac = 0.f;
        if (lt > 0.f) fac = sigmoidf_(p.SM[(rowbase + tokl) * 64 + 8 + br * 16 + g * 4 + head]) / lt;
        if (hi == 0) *wsf_r = fac;
        asm volatile("s_waitcnt lgkmcnt(0)" ::: "memory");
#pragma unroll
        for (int a = 0; a < 4; ++a) {
            const f32x4 fv = *(const f32x4*)(wsf_hi + 8 * a);
#pragma unroll
            for (int k = 0; k < 4; ++k) {
                float* yp = yl + (8 * a + k) * 64;
                if (br == 0) { yp[0] = o0[4 * a + k] * fv[k]; yp[32] = o1[4 * a + k] * fv[k]; }
                else { yp[0] += o0[4 * a + k] * fv[k]; yp[32] += o1[4 * a + k] * fv[k]; }
            }
        }
        asm volatile("s_waitcnt lgkmcnt(0)" ::: "memory");
    };
    __syncthreads();
    if (tid < 64) *(u32x4*)(smem + 9 * 1024 + tid * 16) = (u32x4){0u, 0u, 0u, 0u};
    {
        const BlkDesc d = nsa_desc(p, true, b, g, 0, 0);
        u32x4 rk, rv; blk_load(d, tid, rk, rv); blk_store_ext(d, 64, 63, t0, smem, smem + 10240, tid, rk, rv);
        __syncthreads();
        o0 = (f32x16){}; o1 = (f32x16){}; m = -1e30f; lsum = 0.f;
        f32x16 s0, s1;
        {
            const int nv = ((qpos + 1) >> 6) - 1;
            const int lh = (nv < 63 ? nv : 63) - hi4;
            const bf16x8 qext = __builtin_bit_cast(bf16x8, (u32x4){qe_w, qe_w, 0u, 0u});
            attn_tile2(smem, smem + 10240, qr, qext, m, lsum, o0, o1, s0, s1, lh, -1000, false, wsf_hi, wsf_r, lane);
        }
        const float lt = half_sum(lsum);
        const float inv = lt > 0.f ? 1.f / lt : 0.f;
        unsigned x[64];
#pragma unroll
        for (int r = 0; r < 16; ++r) {
#pragma unroll
            for (int n = 0; n < 2; ++n) {
                float a = (n == 0 ? s0[r] : s1[r]) * inv;
                a += __shfl_xor(a, 1); a += __shfl_xor(a, 2);
                const int j = (r & 3) + 8 * (r >> 2) + 32 * n + hi4;
                if (j == qt || j == 0) a = 5.0f;
                if (j > qt) a = -1.0f;
                const unsigned u = __float_as_uint(a);
                const unsigned o = (u & 0x80000000u) ? ~u : (u | 0x80000000u);
                x[n * 16 + r] = (o & ~63u) | (unsigned)(63 - j);
            }
        }
        finish(0);
        sort16_desc<0>(x); sort16_desc<16>(x);
        unsigned th[16], oth[16], fin[16];
        merge_top16(&x[0], &x[16], th);
#pragma unroll
        for (int i = 0; i < 16; ++i) { auto rr = __builtin_amdgcn_permlane32_swap(th[i], th[i], false, false); oth[i] = hi ? rr[0] : rr[1]; }
        merge_top16(th, oth, fin);
        unsigned long long mask = 0ull;
#pragma unroll
        for (int i = 0; i < 16; ++i) mask |= 1ull << (63u - (fin[i] & 63u));
        if (head == 0 && hi == 0) selm[wid * 8 + (r32 >> 2)] = mask;
    }
    __syncthreads();
    if (wid == 0) {
        unsigned long long u = selm[lane];
#pragma unroll
        for (int o = 32; o > 0; o >>= 1) u |= __shfl_xor(u, o);
        u &= (qt == 63) ? ~0ull : ((1ull << (qt + 1)) - 1ull);
        {
            const int n = __builtin_popcountll(u);
            if ((u >> lane) & 1ull) blist[2 + __builtin_popcountll(lane < 63 ? (u >> (lane + 1)) : 0ull)] = (unsigned char)lane;
            const int w0 = qt - 8 > 0 ? qt - 8 : 0, nw = qt - w0 + 1;
            if (lane < nw) blist[2 + n + lane] = (unsigned char)(qt - lane);
            if (lane == 0) { blist[0] = (unsigned char)n; blist[1] = (unsigned char)nw; }
        }
    }
    __syncthreads();
    if (tid >= 64 && tid < 256) *(u32x4*)(smem + (tid >> 6) * NQ_KVB + 9 * 1024 + (tid & 63) * 16) = (u32x4){0u, 0u, 0u, 0u};
    const int ns = blist[0], nw = blist[1];
    const int nss = (ns + 1) >> 1, nsteps = nss + ((nw + 1) >> 1);
    const unsigned long long mysel = selm[tokl];
    {
        auto step_blocks = [&](int s, int& br, int& jA, int& jB) {
            if (s < nss) { br = 1; jA = blist[2 + 2 * s]; jB = 2 * s + 1 < ns ? (int)blist[2 + 2 * s + 1] : -1; }
            else { const int w = s - nss; br = 2; jA = blist[2 + ns + 2 * w]; jB = 2 * w + 1 < nw ? (int)blist[2 + ns + 2 * w + 1] : -1; }
        };
        u32x4 rkA, rvA, rkB, rvB;
        auto load_step = [&](int s) {
            int br, jA, jB; step_blocks(s, br, jA, jB);
            const BlkDesc dA = nsa_desc(p, true, b, g, br, jA); blk_load(dA, tid, rkA, rvA);
            if (jB >= 0) { const BlkDesc dB = nsa_desc(p, true, b, g, br, jB); blk_load(dB, tid, rkB, rvB); }
        };
        auto store_step = [&](int s, char* buf) {
            int br, jA, jB; step_blocks(s, br, jA, jB);
            BlkDesc dA; dA.pos0 = jA * 64; blk_store_ext(dA, 1, 0, t0, buf, buf + 10240, tid, rkA, rvA);
            if (jB >= 0) { BlkDesc dB; dB.pos0 = jB * 64; blk_store_ext(dB, 1, 0, t0, buf + NQ_KVB, buf + NQ_KVB + 10240, tid, rkB, rvB); }
        };
        load_step(0); store_step(0, smem);
        __syncthreads();
        int prev_br = 1;
        o0 = (f32x16){}; o1 = (f32x16){}; m = -1e30f; lsum = 0.f;
        for (int s = 0; s < nsteps; ++s) {
            int br, jA, jB; step_blocks(s, br, jA, jB);
            char* cur = smem + (s & 1) * 2 * NQ_KVB;
            char* nxt = smem + ((s & 1) ^ 1) * 2 * NQ_KVB;
            if (s + 1 < nsteps) load_step(s + 1);
            if (br != prev_br) { finish(1); o0 = (f32x16){}; o1 = (f32x16){}; m = -1e30f; lsum = 0.f; prev_br = br; }
            {
                asm volatile("" : "+v"(hi4));
                const bool lselA = br == 2 || ((mysel >> jA) & 1ull);
                const int relA = qpos - jA * 64;
                const int lhA = (relA < 63 ? relA : 63) - hi4, llA = (br == 2 ? relA - 512 : -1000) - hi4;
                const bool fastA = __all(!lselA || (lhA >= 59 && llA < 0));
                const bool needA = __any(lselA && lhA + hi4 >= 0 && llA + hi4 < 63);
                const bf16x8 qeA = __builtin_bit_cast(bf16x8, (u32x4){qe_w, qe_w, (lselA || hi) ? 0u : 0x0000C6EAu, 0u});
                bool needB = false; bool lselB = false; int lhB = -1000, llB = -1000; bool fastB = false;
                if (jB >= 0) {
                    lselB = br == 2 || ((mysel >> jB) & 1ull);
                    const int relB = qpos - jB * 64;
                    lhB = (relB < 63 ? relB : 63) - hi4; llB = (br == 2 ? relB - 512 : -1000) - hi4;
                    fastB = __all(!lselB || (lhB >= 59 && llB < 0));
                    needB = __any(lselB && lhB + hi4 >= 0 && llB + hi4 < 63);
                }
                const bf16x8 qeB = __builtin_bit_cast(bf16x8, (u32x4){qe_w, qe_w, (lselB || hi) ? 0u : 0x0000C6EAu, 0u});
                f32x16 s0, s1;
                if (needA && needB) attn_tile3(cur, cur + 10240, cur + NQ_KVB, cur + NQ_KVB + 10240, qr, qeA, qeB, m, lsum, o0, o1, lhA, llA, fastA, lhB, llB, fastB, wsf_hi, wsf_r, lane);
                else if (needA) attn_tile2(cur, cur + 10240, qr, qeA, m, lsum, o0, o1, s0, s1, lhA, llA, fastA, wsf_hi, wsf_r, lane);
                else if (needB) attn_tile2(cur + NQ_KVB, cur + NQ_KVB + 10240, qr, qeB, m, lsum, o0, o1, s0, s1, lhB, llB, fastB, wsf_hi, wsf_r, lane);
            }
            if (s + 1 < nsteps) store_step(s + 1, nxt);
            __syncthreads();
        }
        finish(2);
    }
    {
        const float* yac = (const float*)(smem + NQ_YAC) + wid * 2048;
#pragma unroll
        for (int i = 0; i < 4; ++i) {
            const int orow = i * 8 + (lane >> 3), ch = lane & 7, tk = wid * 8 + (orow >> 2), hd = orow & 3;
            const f32x4 a = *(const f32x4*)(yac + orow * 64 + ch * 8), c = *(const f32x4*)(yac + orow * 64 + ch * 8 + 4);
            *(u32x4*)(p.YB + (rowbase + tk) * 1024 + (g * 4 + hd) * 64 + ch * 8) = pack8f(a, c);
        }
        asm volatile("s_waitcnt lgkmcnt(0)" ::: "memory");
    }
}

DEVI void stage_nsa_attn(const P& p, char* smem, int bid, int nblk) {
    (void)bid; (void)nblk;
    unsigned* head = p.bar + 3840;
    volatile unsigned* slot = (volatile unsigned*)(smem + 150 * 1024);
    for (;;) {
        __syncthreads();
        if (tid_opq() == 0) *slot = __hip_atomic_fetch_add(head, 1u, __ATOMIC_RELAXED, __HIP_MEMORY_SCOPE_AGENT);
        __syncthreads();
        const unsigned i = *slot;
        if (i >= 1536u) break;
        if (i < 1024u) nsa_prompt_unit(p, smem, (int)((i & 15u) >> 2), (int)(i & 3u), 63 - (int)(i >> 4));
        else nsa_sample_unit(p, smem, (int)i - 1024);
    }
}

DEVI void stage2_queue(const P& p, char* smem) {
    unsigned* head = p.bar + 3904;
    volatile unsigned* slot = (volatile unsigned*)(smem + 150 * 1024);
    constexpr int BIG = 1 << 20;
    for (;;) {
        __syncthreads();
        if (tid_opq() == 0) *slot = __hip_atomic_fetch_add(head, 1u, __ATOMIC_RELAXED, __HIP_MEMORY_SCOPE_AGENT);
        __syncthreads();
        const unsigned i = *slot;
        if (i >= 1824u) break;
        int kind, t;
        if (i < 16u) { kind = 0; t = (int)i; }
        else if (i < 528u) { const unsigned j = i - 16u; kind = (j & 1u) ? 1 : 2; t = (int)(j >> 1); }
        else if (i < 544u) { kind = 2; t = 256 + (int)(i - 528u); }
        else { const unsigned j = i - 544u, q = j / 5u, r = j - q * 5u; if (r < 3u) { kind = 1; t = 256 + (int)(q * 3u + r); } else { kind = 3; t = (int)(q * 2u + r - 3u); } }
        if (kind == 0) stage_mlstm_gates(p, smem, t, BIG);
        else if (kind == 1) stage_mlstm_dc(p, smem, t, BIG);
        else if (kind == 2) stage_compress(p, smem, 0, BIG, t);
        else stage_mlstm_sample(p, smem, t, BIG);
    }
}

DEVI void stage_ln1(const P& p, int bid, int nblk) {
    const int lane = tid_opq() & 63, wid = tid_opq() >> 6;
    for (int row = bid * 8 + wid; row < NT; row += nblk * 8) {
        f32x4 x[4];
        float s = 0.f;
#pragma unroll
        for (int i = 0; i < 4; ++i) { x[i] = *(const f32x4*)(p.R + (size_t)row * 1024 + i * 256 + lane * 4); s += x[i][0] + x[i][1] + x[i][2] + x[i][3]; }
        const float mean = wave_sum(s) * (1.f / 1024.f);
        float q = 0.f;
#pragma unroll
        for (int i = 0; i < 4; ++i)
#pragma unroll
            for (int k = 0; k < 4; ++k) q += (x[i][k] - mean) * (x[i][k] - mean);
        const float rs = rsqrtf(wave_sum(q) * (1.f / 1024.f) + LN_EPS);
#pragma unroll
        for (int i = 0; i < 4; ++i) {
            const int c = i * 256 + lane * 4;
            const f32x4 gg = *(const f32x4*)(p.ln1_g + c), bb = *(const f32x4*)(p.ln1_b + c);
            f32x4 y;
#pragma unroll
            for (int k = 0; k < 4; ++k) y[k] = (x[i][k] - mean) * rs * gg[k] + bb[k];
            u32x2 o; o.x = pack2(y[0], y[1]); o.y = pack2(y[2], y[3]);
            *(u32x2*)(p.HB + (size_t)row * 1024 + c) = o;
        }
        if (lane == 0) { p.H[(size_t)row * 2] = mean; p.H[(size_t)row * 2 + 1] = rs; }
    }
}

__device__ const unsigned char PEER_CA[50] = {0,0,0,0,0,0,0,0,0,0,0,0,0,0,0,0, 1,1,1,1,1,1,1,1, 2,2,2,2,2, 3,3,3,3, 4,4,4, 5,5, 6,6, 7,7, 8,9,10,11,12,13,14,15};
__device__ const unsigned char PEER_CB[50] = {0,1,2,3,4,5,6,7,8,9,10,11,12,13,14,15, 0,1,2,3,4,5,6,7, 0,1,2,3,4, 0,1,2,3, 0,1,2, 0,1, 0,1, 0,1, 0,0,0,0,0,0,0,0};

DEVI float key_score(unsigned k) { const unsigned u = k & ~127u; return __uint_as_float((u & 0x80000000u) ? (u & 0x7FFFFFFFu) : ~u); }

DEVI void sort8_desc(unsigned (&x)[16]) {
#pragma unroll
    for (int k = 2; k <= 8; k <<= 1)
#pragma unroll
        for (int j = k >> 1; j > 0; j >>= 1)
#pragma unroll
            for (int i = 0; i < 8; ++i) {
                const int l = i ^ j;
                if (l > i) { if ((i & k) == 0) ce_desc(x[i], x[l]); else ce_desc(x[l], x[i]); }
            }
}
DEVI unsigned sum_key(unsigned ka, unsigned kb, unsigned tag) {
    const unsigned u = __float_as_uint(key_score(ka) + key_score(kb));
    const unsigned o = (u & 0x80000000u) ? ~u : (u | 0x80000000u);
    return (o & ~255u) | tag;
}
DEVI float key_score8(unsigned k) { const unsigned u = k & ~255u; return __uint_as_float((u & 0x80000000u) ? (u & 0x7FFFFFFFu) : ~u); }

DEVI void route_top16(const P& p, int row, int ph, int c, int r32, int hi, int hi4, unsigned (&fin)[16]) {
    f32x16 acc[4];
#pragma unroll
    for (int t = 0; t < 4; ++t) acc[t] = (f32x16){};
    const bf16_t* qp = p.PQ + (size_t)row * 2048 + ph * 256 + c * 128 + hi * 8;
    const bf16_t* kp = p.KEYSB + ((size_t)((ph * 2 + c) * 128 + r32)) * 128 + hi * 8;
#pragma unroll
    for (int s8 = 0; s8 < 8; ++s8) {
        const bf16x8 qf = *(const bf16x8*)(qp + s8 * 16);
#pragma unroll
        for (int t = 0; t < 4; ++t) {
            const bf16x8 kf = *(const bf16x8*)(kp + (size_t)t * 32 * 128 + s8 * 16);
            acc[t] = MFMA32(kf, qf, acc[t]);
        }
    }
    unsigned x[64];
#pragma unroll
    for (int t = 0; t < 4; ++t)
#pragma unroll
        for (int r = 0; r < 16; ++r) {
            const unsigned u = __float_as_uint(acc[t][r]);
            const unsigned o = (u & 0x80000000u) ? ~u : (u | 0x80000000u);
            x[t * 16 + r] = (o & ~127u) | (unsigned)(127 - ((r & 3) + 8 * (r >> 2) + 32 * t) - hi4);
        }
    sort16_desc<0>(x); sort16_desc<16>(x); sort16_desc<32>(x); sort16_desc<48>(x);
    unsigned t01[16], t23[16], tt[16], oth[16];
    merge_top16(&x[0], &x[16], t01); merge_top16(&x[32], &x[48], t23); merge_top16(t01, t23, tt);
#pragma unroll
    for (int i = 0; i < 16; ++i) { auto rr = __builtin_amdgcn_permlane32_swap(tt[i], tt[i], false, false); oth[i] = hi ? rr[0] : rr[1]; }
    merge_top16(tt, oth, fin);
}

DEVI void stage_peer_route(const P& p, char* smem, int bid, int nblk, int p0, int p1) {
    const int lane = tid_opq() & 63, wid = tid_opq() >> 6, r32 = lane & 31, hi = lane >> 5;
    unsigned char* tb = (unsigned char*)smem + wid * 1024 + r32 * 32;
    const int tpw = (NT + nblk - 1) / nblk, row_lo = bid * tpw, row_hi = (row_lo + tpw < NT) ? row_lo + tpw : NT;
    const int ph = wid;
    for (int pass = p0; pass < p1 && row_lo + pass * 32 < row_hi; ++pass) {
        const int row_raw = row_lo + pass * 32 + r32;
        const bool row_ok = row_raw < row_hi;
        const int row = row_ok ? row_raw : row_lo;
        int hi4 = 4 * hi; asm volatile("" : "+v"(hi4));
        unsigned fa[16], fb[16];
        route_top16(p, row, ph, 0, r32, hi, hi4, fa);
        asm volatile("" : "+v"(hi4));
        route_top16(p, row, ph, 1, r32, hi, hi4, fb);
        if (hi == 0) {
            u32x4 wa, wb;
#pragma unroll
            for (int i = 0; i < 4; ++i) {
                wa[i] = (127u - (fa[4 * i] & 127u)) | ((127u - (fa[4 * i + 1] & 127u)) << 8) | ((127u - (fa[4 * i + 2] & 127u)) << 16) | ((127u - (fa[4 * i + 3] & 127u)) << 24);
                wb[i] = (127u - (fb[4 * i] & 127u)) | ((127u - (fb[4 * i + 1] & 127u)) << 8) | ((127u - (fb[4 * i + 2] & 127u)) << 16) | ((127u - (fb[4 * i + 3] & 127u)) << 24);
            }
            *(u32x4*)tb = wa; *(u32x4*)(tb + 16) = wb;
        }
        unsigned g0[16], g1[16], g2[16], g3[16];
#pragma unroll
        for (int j = 0; j < 16; ++j) g0[j] = sum_key(fa[0], fb[j], (unsigned)j);
#pragma unroll
        for (int k = 0; k < 15; ++k) g1[k] = sum_key(fa[k + 1], fb[0], (unsigned)((k + 1) << 4));
        g1[15] = 0u;
#pragma unroll
        for (int j = 1; j < 8; ++j) g2[j - 1] = sum_key(fa[1], fb[j], (unsigned)(16 | j));
        g2[7] = 0u; g2[8] = 0u; g2[9] = 0u;
#pragma unroll
        for (int i = 2; i < 8; ++i) g2[17 - i] = sum_key(fa[i], fb[1], (unsigned)((i << 4) | 1));
#pragma unroll
        for (int j = 8; j > 0; j >>= 1)
#pragma unroll
            for (int i = 0; i < 16; ++i) { const int l = i ^ j; if (l > i) ce_desc(g2[i], g2[l]); }
        g3[0] = sum_key(fa[2], fb[2], 0x22u); g3[1] = sum_key(fa[2], fb[3], 0x23u); g3[2] = sum_key(fa[2], fb[4], 0x24u);
        g3[3] = sum_key(fa[3], fb[2], 0x32u); g3[4] = sum_key(fa[4], fb[2], 0x42u); g3[5] = sum_key(fa[3], fb[3], 0x33u);
#pragma unroll
        for (int i = 6; i < 16; ++i) g3[i] = 0u;
        sort8_desc(g3);
        unsigned t01[16], t23[16], top[16];
        merge_top16(g0, g1, t01); merge_top16(g2, g3, t23); merge_top16(t01, t23, top);
        float ev[16]; float sum = 0.f;
        const float vmax = key_score8(top[0]);
#pragma unroll
        for (int k = 0; k < 16; ++k) { ev[k] = __expf(key_score8(top[k]) - vmax); sum += ev[k]; }
        const float inv = 1.f / sum;
        asm volatile("s_waitcnt lgkmcnt(0)" ::: "memory");
        if (!row_ok) {   } else if (hi == 0) {
            int* dst = p.EIDX + (size_t)row * 128 + ph * 16;
#pragma unroll
            for (int q4 = 0; q4 < 4; ++q4) {
                u32x4 o;
#pragma unroll
                for (int k = 0; k < 4; ++k) { const unsigned tg = top[q4 * 4 + k] & 255u; o[k] = (unsigned)tb[tg >> 4] * 128u + (unsigned)tb[16 + (tg & 15u)]; }
                *(u32x4*)(dst + q4 * 4) = o;
            }
        } else {
            float* dst = p.EGATE + (size_t)row * 128 + ph * 16;
#pragma unroll
            for (int q4 = 0; q4 < 4; ++q4) *(f32x4*)(dst + q4 * 4) = (f32x4){ev[q4 * 4] * inv, ev[q4 * 4 + 1] * inv, ev[q4 * 4 + 2] * inv, ev[q4 * 4 + 3] * inv};
        }
        asm volatile("s_waitcnt lgkmcnt(0)" ::: "memory");
    }
}

constexpr int PA_WAVE_LDS = 1024 + 1024 + 512 + 512 + 512 + 4096;
DEVI void stage_peer_apply(const P& p, char* smem, int bid, int nblk, int p0, int p1) {
    const int lane = tid_opq() & 63, wid = tid_opq() >> 6;
    char* wl = smem + wid * PA_WAVE_LDS;
    int* idxs = (int*)(wl + 2048);
    float* gts = (float*)(wl + 2560);
    float* cs = (float*)(wl + 3072);
    const int fr = lane & 15, fq = lane >> 4;
    const int tpw = (NT + nblk - 1) / nblk, row_lo = bid * tpw, row_hi = (row_lo + tpw < NT) ? row_lo + tpw : NT;
    for (int row = row_lo + p0 * 32 + wid; row < row_hi && row < row_lo + p1 * 32; row += 8) {
        float* hvs = (float*)(wl + 3584);
        {
            const float* hr = p.R + (size_t)row * 1024 + lane * 16;
            const float mean1 = p.H[(size_t)row * 2], rs1 = p.H[(size_t)row * 2 + 1];
#pragma unroll
            for (int i = 0; i < 4; ++i) {
                f32x4 x = *(const f32x4*)(hr + i * 4);
                const f32x4 g1 = *(const f32x4*)(p.ln1_g + lane * 16 + i * 4), b1 = *(const f32x4*)(p.ln1_b + lane * 16 + i * 4);
#pragma unroll
                for (int k = 0; k < 4; ++k) x[k] = (x[k] - mean1) * rs1 * g1[k] + b1[k];
                *(f32x4*)(hvs + lane * 16 + i * 4) = x;
            }
            idxs[lane] = p.EIDX[(size_t)row * 128 + lane]; idxs[lane + 64] = p.EIDX[(size_t)row * 128 + 64 + lane];
            gts[lane] = p.EGATE[(size_t)row * 128 + lane]; gts[lane + 64] = p.EGATE[(size_t)row * 128 + 64 + lane];
            asm volatile("s_waitcnt lgkmcnt(0)" ::: "memory");
        }
        {
            f32x2 hreg[8];
#pragma unroll
            for (int i = 0; i < 4; ++i) { const f32x4 t = *(const f32x4*)(hvs + lane * 16 + i * 4); hreg[i * 2] = (f32x2){t[0], t[1]}; hreg[i * 2 + 1] = (f32x2){t[2], t[3]}; }
#if U_BITS == 4
            constexpr int UB = 8;
            u32x2 u0[8], u1[8];
            auto issue_u = [&](int e0, u32x2 (&u)[8]) {
#pragma unroll
                for (int k = 0; k < 8; ++k) u[k] = *(const u32x2*)(p.U8 + (size_t)idxs[e0 + k] * 512 + lane * 8);
            };
            auto dots_u = [&](const u32x2 (&u)[8], float (&sp)[8]) {
#pragma unroll
                for (int k = 0; k < 8; ++k) {
                    f32x2 s0 = (f32x2){0.f, 0.f};
                    s0 = __builtin_elementwise_fma(__builtin_amdgcn_cvt_scalef32_pk_f32_fp4(u[k][0], 1.0f, 0), hreg[0], s0);
                    s0 = __builtin_elementwise_fma(__builtin_amdgcn_cvt_scalef32_pk_f32_fp4(u[k][0], 1.0f, 1), hreg[1], s0);
                    s0 = __builtin_elementwise_fma(__builtin_amdgcn_cvt_scalef32_pk_f32_fp4(u[k][0], 1.0f, 2), hreg[2], s0);
                    s0 = __builtin_elementwise_fma(__builtin_amdgcn_cvt_scalef32_pk_f32_fp4(u[k][0], 1.0f, 3), hreg[3], s0);
                    s0 = __builtin_elementwise_fma(__builtin_amdgcn_cvt_scalef32_pk_f32_fp4(u[k][1], 1.0f, 0), hreg[4], s0);
                    s0 = __builtin_elementwise_fma(__builtin_amdgcn_cvt_scalef32_pk_f32_fp4(u[k][1], 1.0f, 1), hreg[5], s0);
                    s0 = __builtin_elementwise_fma(__builtin_amdgcn_cvt_scalef32_pk_f32_fp4(u[k][1], 1.0f, 2), hreg[6], s0);
                    s0 = __builtin_elementwise_fma(__builtin_amdgcn_cvt_scalef32_pk_f32_fp4(u[k][1], 1.0f, 3), hreg[7], s0);
                    sp[k] = s0[0] + s0[1];
                }
            };
#else
            U3 u0[8], u1[8];
            auto issue_u = [&](int e0, U3 (&u)[8]) {
#pragma unroll
                for (int k = 0; k < 8; ++k) u[k] = *(const U3*)(p.U8 + (size_t)idxs[e0 + k] * 768 + lane * 12);
            };
            constexpr int UB = 8;
            auto dots_u = [&](const U3 (&u)[8], float (&sp)[8]) {
#pragma unroll
                for (int k = 0; k < 8; k += 2) {
                    const i32x6 src = {(int)u[k].a, (int)u[k].b, (int)u[k].c, (int)u[k + 1].a, (int)u[k + 1].b, (int)u[k + 1].c};
                    const f32x32 f = __builtin_amdgcn_cvt_scalef32_pk32_f32_fp6(src, 1.0f);
                    f32x2 s0 = (f32x2){0.f, 0.f}, s1 = (f32x2){0.f, 0.f};
#pragma unroll
                    for (int i = 0; i < 8; ++i) {
                        s0 = __builtin_elementwise_fma((f32x2){f[2 * i], f[2 * i + 1]}, hreg[i], s0);
                        s1 = __builtin_elementwise_fma((f32x2){f[16 + 2 * i], f[17 + 2 * i]}, hreg[i], s1);
                    }
                    sp[k] = s0[0] + s0[1]; sp[k + 1] = s1[0] + s1[1];
                }
            };
#endif
            auto finish_u = [&](int e0, const float (&sv)[16]) {
                float t[8], w[4];
#pragma unroll
                for (int i = 0; i < 8; ++i) {
                    const float x = sv[2 * i], y = sv[2 * i + 1];
                    const auto r = __builtin_amdgcn_permlane32_swap(__float_as_uint(x), __float_as_uint(y), false, false);
                    t[i] = __uint_as_float(r[0]) + __uint_as_float(r[1]);
                }
#pragma unroll
                for (int i = 0; i < 4; ++i) {
                    const auto r = __builtin_amdgcn_permlane16_swap(__float_as_uint(t[2 * i]), __float_as_uint(t[2 * i + 1]), false, false);
                    float v = __uint_as_float(r[0]) + __uint_as_float(r[1]);
                    v += __uint_as_float(__builtin_amdgcn_update_dpp(0u, __float_as_uint(v), 0x128, 0xf, 0xf, false));
                    v += __uint_as_float(__builtin_amdgcn_update_dpp(0u, __float_as_uint(v), 0x124, 0xf, 0xf, false));
                    v += __uint_as_float(__builtin_amdgcn_update_dpp(0u, __float_as_uint(v), 0x4e, 0xf, 0xf, false));
                    v += __uint_as_float(__builtin_amdgcn_update_dpp(0u, __float_as_uint(v), 0xb1, 0xf, 0xf, false));
                    w[i] = v;
                }
                const int c = lane & 3, r = lane >> 4;
                const float tot = c == 0 ? w[0] : c == 1 ? w[1] : c == 2 ? w[2] : w[3];
                const int k = 4 * c + ((r & 1) << 1) + (r >> 1);
                if ((lane & 15) < 4) {
                    const int e = idxs[e0 + k];
                    cs[e0 + k] = gts[e0 + k] * p.VS[e] * gelu_erf(tot * p.US[e]);
                }
            };
            issue_u(0, u0);
#pragma unroll 1
            for (int e0 = 0; e0 < 128; e0 += 16) {
                float sa[8], sb[8], sv[16];
                issue_u(e0 + 8, u1);
                dots_u(u0, sa);
                if (e0 + 16 < 128) issue_u(e0 + 16, u0);
                dots_u(u1, sb);
#pragma unroll
                for (int i = 0; i < 8; ++i) { sv[i] = sa[i]; sv[8 + i] = sb[i]; }
                finish_u(e0, sv);
            }
            (void)UB;
        }
        asm volatile("s_waitcnt lgkmcnt(0)" ::: "memory");
        float acc[16];
#pragma unroll
        for (int i = 0; i < 16; ++i) acc[i] = 0.f;
        {
#if V_BITS == 4
            u32x2 v0[8], v1[8];
            auto issue_v = [&](int e0, u32x2 (&v)[8]) {
#pragma unroll
                for (int k = 0; k < 8; ++k) v[k] = *(const u32x2*)(p.V8 + (size_t)idxs[e0 + k] * 512 + lane * 8);
            };
            auto consume_v = [&](int e0, const u32x2 (&v)[8]) {
#pragma unroll
                for (int k = 0; k < 8; ++k) {
                    const float c = cs[e0 + k];
                    const f32x2 cc = (f32x2){c, c};
#pragma unroll
                    for (int w = 0; w < 2; ++w) {
                        const f32x2 f0 = __builtin_amdgcn_cvt_scalef32_pk_f32_fp4(v[k][w], 1.0f, 0), f1 = __builtin_amdgcn_cvt_scalef32_pk_f32_fp4(v[k][w], 1.0f, 1);
                        const f32x2 f2 = __builtin_amdgcn_cvt_scalef32_pk_f32_fp4(v[k][w], 1.0f, 2), f3 = __builtin_amdgcn_cvt_scalef32_pk_f32_fp4(v[k][w], 1.0f, 3);
                        f32x2 a0 = (f32x2){acc[w * 8], acc[w * 8 + 1]}, a1 = (f32x2){acc[w * 8 + 2], acc[w * 8 + 3]}, a2 = (f32x2){acc[w * 8 + 4], acc[w * 8 + 5]}, a3 = (f32x2){acc[w * 8 + 6], acc[w * 8 + 7]};
                        a0 = __builtin_elementwise_fma(cc, f0, a0); a1 = __builtin_elementwise_fma(cc, f1, a1); a2 = __builtin_elementwise_fma(cc, f2, a2); a3 = __builtin_elementwise_fma(cc, f3, a3);
                        acc[w * 8] = a0[0]; acc[w * 8 + 1] = a0[1]; acc[w * 8 + 2] = a1[0]; acc[w * 8 + 3] = a1[1]; acc[w * 8 + 4] = a2[0]; acc[w * 8 + 5] = a2[1]; acc[w * 8 + 6] = a3[0]; acc[w * 8 + 7] = a3[1];
                    }
                }
            };
#else
            U3 v0[8], v1[8];
            auto issue_v = [&](int e0, U3 (&v)[8]) {
#pragma unroll
                for (int k = 0; k < 8; ++k) v[k] = *(const U3*)(p.V8 + (size_t)idxs[e0 + k] * 768 + lane * 12);
            };
            auto consume_v = [&](int e0, const U3 (&v)[8]) {
#pragma unroll
                for (int k = 0; k < 8; k += 2) {
                    const float c0 = cs[e0 + k], c1 = cs[e0 + k + 1];
                    const i32x6 src = {(int)v[k].a, (int)v[k].b, (int)v[k].c, (int)v[k + 1].a, (int)v[k + 1].b, (int)v[k + 1].c};
                    const f32x32 f = __builtin_amdgcn_cvt_scalef32_pk32_f32_fp6(src, 1.0f);
#pragma unroll
                    for (int i = 0; i < 16; ++i) { acc[i] = __builtin_fmaf(c0, f[i], acc[i]); acc[i] = __builtin_fmaf(c1, f[16 + i], acc[i]); }
                }
            };
#endif
            constexpr int VB = 8;
            issue_v(0, v0);
#pragma unroll 1
            for (int e0 = 0; e0 < 128; e0 += 2 * VB) {
                issue_v(e0 + VB, v1);
                consume_v(e0, v0);
                if (e0 + 2 * VB < 128) issue_v(e0 + 2 * VB, v0);
                consume_v(e0 + VB, v1);
            }
        }
        float s = 0.f;
#pragma unroll
        for (int i = 0; i < 16; ++i) { acc[i] += DN_ALPHA * hvs[lane * 16 + i]; s += acc[i]; }
        const float mean = wave_sum(s) * (1.f / 1024.f);
        float q = 0.f;
#pragma unroll
        for (int i = 0; i < 16; ++i) q += (acc[i] - mean) * (acc[i] - mean);
        const float rs = rsqrtf(wave_sum(q) * (1.f / 1024.f) + LN_EPS);
#pragma unroll
        for (int i = 0; i < 4; ++i) {
            const int c = lane * 16 + i * 4;
            const f32x4 g0 = *(const f32x4*)(p.ln2_g + c), b0 = *(const f32x4*)(p.ln2_b + c);
            f32x4 y0;
#pragma unroll
            for (int k = 0; k < 4; ++k) y0[k] = (acc[i * 4 + k] - mean) * rs * g0[k] + b0[k];
            *(f32x4*)(p.out + O_Y + (size_t)row * 1024 + c) = y0;
        }
    }
}

namespace pg8 {
#define PG8_LAS __attribute__((address_space(3)))
typedef unsigned short bf16_t;
typedef short bf16x8 __attribute__((ext_vector_type(8)));
typedef float f32x4 __attribute__((ext_vector_type(4)));
typedef unsigned u32x4 __attribute__((ext_vector_type(4)));
constexpr int BM = 256, BK = 64, HALF = 128, HTB = HALF * BK * 2  , STAGE_BYTES = 8 * HTB, NXCD = 8, WGM = 8;

__host__ __device__ __forceinline__ int lds_byte(int r, int c) { const int st = (r >> 4) * 2 + (c >> 5), rr = r & 15, cc = c & 31, ob = rr * 64 + cc * 2; return st * 1024 + (ob ^ (((ob >> 9) & 1) << 5)); }
__host__ __device__ __forceinline__ void stage_rc(int b, int& R, int& C) { const int st = b / 1024, sb = b % 1024, swz = sb ^ (((sb >> 9) & 1) << 5); R = (st >> 1) * 16 + swz / 64; C = (st & 1) * 32 + (swz % 64) / 2; }
__host__ __device__ __forceinline__ int perm32(int rho) { const int n = rho >> 4, i = rho & 15; return 8 * (i >> 2) + 4 * n + (i & 3); }

struct Unit { int pm, pn; };
struct Gemm { const bf16_t* A; const bf16_t* Bt; int M, N, K; };

struct StaticOrder {
    int nM, nN, nwg, G, c;
    __host__ __device__ void init(int M, int N, int G_, int c_) { nM = M / BM; nN = N / BM; nwg = nM * nN; G = G_; c = c_; }
    __host__ __device__ bool next(int i, Unit& u) const {
        const long L = (long)i * G + c; if (L >= nwg) return false;
        int wgid = (int)L; { const int q = nwg / NXCD, r = nwg % NXCD, xcd = wgid % NXCD, off = wgid / NXCD; wgid = (xcd < r ? xcd * (q + 1) : r * (q + 1) + (xcd - r) * q) + off; }
        const int nig = WGM * nN, gid = wgid / nig, fm = gid * WGM, gsz = (nM - fm) < WGM ? (nM - fm) : WGM;
        u.pm = fm + ((wgid % nig) % gsz); u.pn = (wgid % nig) / gsz; return true;
    }
    __device__ __forceinline__ void a_ready(const Unit&) const {}
    __device__ __forceinline__ void done(const Unit&) const {}
};
template <class Epi, class Sched, bool STAMP = false>
__device__ __forceinline__ void gemm_phase(PG8_LAS unsigned char* lds, const Gemm g, const Sched& S, const Epi& E, unsigned long long* stamps) {
    const int tid = tid_opq(), wid = __builtin_amdgcn_readfirstlane(tid >> 6), lane = tid & 63, wr = wid >> 2, wc = wid & 3, fr = lane & 15, fq = lane >> 4;
    const int K = g.K, nt = K / BK;
    int ts_lo = 0, ts_hi = 0, nts = 0; const unsigned long long rt_entry = STAMP ? (unsigned long long)wall_clock64() : 0ull;
#define PG8_STAMP() do { if (STAMP && wid == 0 && nts < 64) { const unsigned long long _c = (unsigned long long)clock64(); \
        ts_lo = (lane == nts) ? (int)(unsigned)_c : ts_lo; ts_hi = (lane == nts) ? (int)(unsigned)(_c >> 32) : ts_hi; ++nts; } } while (0)
    PG8_STAMP();
    unsigned voffA[2], voffB[2];
#pragma unroll
    for (int i = 0; i < 2; ++i) { int R, C; stage_rc(tid * 16 + i * 8192, R, C); const int Rb = Epi::PERM ? ((R & ~31) + perm32(R & 31)) : R;
        voffA[i] = (unsigned)(R * K + C) * 2u; voffB[i] = (unsigned)(Rb * K + C) * 2u; }
    const size_t kstep = (size_t)(BK * 2);
    const size_t hstep = (size_t)HALF * K * 2;
    const size_t tstep = 2 * hstep;
    const unsigned ldsw = (unsigned)wid * 1024u;
    const int aoff = lds_byte(wr * 64 + fr, fq * 8), boff = lds_byte(wc * 32 + fr, fq * 8);
#define PG8_SA(b, h) (((b) * 2 + (h)) * HTB)
#define PG8_SB(b, h) ((4 + (b) * 2 + (h)) * HTB)
#define PG8_STAGE(bufoff, gbase, voff) do { _Pragma("unroll") for (int _i = 0; _i < 2; ++_i) \
        __builtin_amdgcn_global_load_lds((const unsigned*)((const char*)(gbase) + (voff)[_i]), (PG8_LAS unsigned*)(lds + (bufoff) + ldsw + _i * 8192), 16, 0, 0); } while (0)
#define PG8_LDA(dst, b, h) do { _Pragma("unroll") for (int m = 0; m < 4; ++m) _Pragma("unroll") for (int k = 0; k < 2; ++k) dst[m][k] = *(const PG8_LAS bf16x8*)(lds + PG8_SA(b, h) + aoff + m * 2048 + k * 1024); } while (0)
#define PG8_LDB(dst, b, h) do { _Pragma("unroll") for (int n = 0; n < 2; ++n) _Pragma("unroll") for (int k = 0; k < 2; ++k) dst[n][k] = *(const PG8_LAS bf16x8*)(lds + PG8_SB(b, h) + boff + n * 2048 + k * 1024); } while (0)
#define PG8_MMA(ai, bj, At, Bt) do { __builtin_amdgcn_s_setprio(1); _Pragma("unroll") for (int m = 0; m < 4; ++m) _Pragma("unroll") for (int n = 0; n < 2; ++n) _Pragma("unroll") for (int k = 0; k < 2; ++k) \
        acc[ai][bj][m][n] = __builtin_amdgcn_mfma_f32_16x16x32_bf16(Bt[n][k], At[m][k], acc[ai][bj][m][n], 0, 0, 0); __builtin_amdgcn_s_setprio(0); } while (0)
#define PG8_WAIT_V(n) asm volatile("s_waitcnt vmcnt(" #n ")" ::: "memory")
#define PG8_WAIT_L(n) asm volatile("s_waitcnt lgkmcnt(" #n ")" ::: "memory")
#define PG8_BAR __builtin_amdgcn_s_barrier()
#define PG8_SCHED __builtin_amdgcn_sched_barrier(0)
    Unit cur, nxt; int ui = 0;
    if (!S.next(0, cur)) return;
    f32x4 acc[2][2][4][2];
#pragma unroll
    for (int a = 0; a < 2; ++a)
#pragma unroll
        for (int b = 0; b < 2; ++b)
#pragma unroll
            for (int m = 0; m < 4; ++m)
#pragma unroll
                for (int n = 0; n < 2; ++n) acc[a][b][m][n] = (f32x4){0.f, 0.f, 0.f, 0.f};
    bf16x8 At[4][2], B0[2][2], B1[2][2];
    const char* cA = (const char*)g.A + (size_t)cur.pm * tstep; const char* cB = (const char*)g.Bt + (size_t)cur.pn * tstep;
    S.a_ready(cur);
    PG8_STAGE(PG8_SB(0, 0), cB, voffB); PG8_STAGE(PG8_SA(0, 0), cA, voffA); PG8_STAGE(PG8_SB(0, 1), cB + hstep, voffB); PG8_STAGE(PG8_SA(0, 1), cA + hstep, voffA);
    if (wr == 1) PG8_BAR;
    PG8_WAIT_V(4); PG8_BAR;
    PG8_STAGE(PG8_SB(1, 0), cB + kstep, voffB); PG8_STAGE(PG8_SA(1, 0), cA + kstep, voffA); PG8_STAGE(PG8_SB(1, 1), cB + hstep + kstep, voffB);
    PG8_WAIT_V(6); PG8_BAR;
    PG8_STAMP();
    for (;;) {
        const bool has_next = S.next(ui + 1, nxt);
        const char* nA = has_next ? (const char*)g.A + (size_t)nxt.pm * tstep : cA; const char* nB = has_next ? (const char*)g.Bt + (size_t)nxt.pn * tstep : cB;
        for (int t = 0; t < nt; t += 2) {
            const bool last = (t == nt - 2);
            const char* a1 = cA + (size_t)(t + 1) * kstep;
            const char* a2 = last ? nA : cA + (size_t)(t + 2) * kstep; const char* b2 = last ? nB : cB + (size_t)(t + 2) * kstep;
            const char* a3 = a2 + kstep; const char* b3 = b2 + kstep;
            if (last && has_next) S.a_ready(nxt);
            PG8_LDB(B0, 0, 0); PG8_SCHED; PG8_LDA(At, 0, 0); PG8_STAGE(PG8_SA(1, 1), a1 + hstep, voffA);
            PG8_WAIT_L(8); PG8_BAR; PG8_WAIT_L(0); PG8_MMA(0, 0, At, B0); PG8_BAR; PG8_SCHED;
            PG8_LDB(B1, 0, 1); PG8_STAGE(PG8_SB(0, 0), b2, voffB);
            PG8_BAR; PG8_WAIT_L(0); PG8_MMA(0, 1, At, B1); PG8_BAR;
            PG8_LDA(At, 0, 1); PG8_STAGE(PG8_SA(0, 0), a2, voffA);
            PG8_BAR; PG8_WAIT_L(0); PG8_MMA(1, 0, At, B0); PG8_BAR; PG8_SCHED;
            PG8_STAGE(PG8_SB(0, 1), b2 + hstep, voffB);
            PG8_WAIT_V(6); PG8_BAR; PG8_MMA(1, 1, At, B1); PG8_BAR;
            PG8_LDB(B0, 1, 0); PG8_SCHED; PG8_LDA(At, 1, 0); PG8_STAGE(PG8_SA(0, 1), a2 + hstep, voffA);
            PG8_WAIT_L(8); PG8_BAR; PG8_WAIT_L(0); PG8_MMA(0, 0, At, B0); PG8_BAR; PG8_SCHED;
            PG8_LDB(B1, 1, 1); PG8_STAGE(PG8_SB(1, 0), b3, voffB);
            PG8_BAR; PG8_WAIT_L(0); PG8_MMA(0, 1, At, B1); PG8_BAR;
            PG8_LDA(At, 1, 1); PG8_STAGE(PG8_SA(1, 0), a3, voffA);
            PG8_BAR; PG8_WAIT_L(0); PG8_MMA(1, 0, At, B0); PG8_BAR; PG8_SCHED;
            PG8_STAGE(PG8_SB(1, 1), b3 + hstep, voffB);
            PG8_WAIT_V(6); PG8_BAR; PG8_MMA(1, 1, At, B1); PG8_BAR;
        }
        PG8_STAMP();
        if constexpr (!Epi::AFTER_DRAIN) { E(acc, cur, wr, wc, fr, fq); S.done(cur); }
        PG8_STAMP();
        if (!has_next) break;
#pragma unroll
        for (int a = 0; a < 2; ++a)
#pragma unroll
            for (int b = 0; b < 2; ++b)
#pragma unroll
                for (int m = 0; m < 4; ++m)
#pragma unroll
                    for (int n = 0; n < 2; ++n) acc[a][b][m][n] = (f32x4){0.f, 0.f, 0.f, 0.f};
        cur = nxt; cA = nA; cB = nB; ++ui;
    }
    PG8_WAIT_V(0);
    if (wr == 0) PG8_BAR;
    PG8_BAR;
    if constexpr (Epi::AFTER_DRAIN) { E.fused(acc, cur, wr, wc, fr, fq, lds, wid, lane); S.done(cur); }
    PG8_STAMP();
    if (STAMP && wid == 0) { stamps[lane] = lane < nts ? (((unsigned long long)(unsigned)ts_hi << 32) | (unsigned)ts_lo) : 0ull;
        if (lane == 62) stamps[62] = rt_entry; if (lane == 63) stamps[63] = (unsigned long long)wall_clock64(); }
#undef PG8_STAMP
#undef PG8_SA
#undef PG8_SB
#undef PG8_STAGE
#undef PG8_LDA
#undef PG8_LDB
#undef PG8_MMA
#undef PG8_WAIT_V
#undef PG8_WAIT_L
#undef PG8_BAR
#undef PG8_SCHED
}
}

template <class F> struct EpiAdapt {
    static constexpr bool PERM = true, AFTER_DRAIN = false;
    F f;
    __device__ __forceinline__ void operator()(const pg8::f32x4 (&acc)[2][2][4][2], const pg8::Unit& u, int wr, int wc, int fr, int fq) const {
        constexpr int B = F::BATCH;
        const int row0 = u.pm * 256 + wr * 64 + fr, col0 = u.pn * 256 + wc * 32 + 8 * fq;
        f32x4 b0[2], b1[2];
        if constexpr (F::COLBIAS) { f.bias8(col0, b0[0], b1[0]); f.bias8(col0 + 128, b0[1], b1[1]); }
#pragma unroll
        for (int q0 = 0; q0 < 16; q0 += B) {
            typename F::Pre pre[B];
#pragma unroll
            for (int i = 0; i < B; ++i) { const int q = q0 + i, bj = q & 1, m = (q >> 1) & 3, ai = q >> 3; pre[i] = f.pre(row0 + ai * 128 + m * 16, col0 + bj * 128); }
#pragma unroll
            for (int i = 0; i < B; ++i) { const int q = q0 + i, bj = q & 1, m = (q >> 1) & 3, ai = q >> 3;
                f32x4 v0 = acc[ai][bj][m][0], v1 = acc[ai][bj][m][1];
                if constexpr (F::COLBIAS) { v0 += b0[bj]; v1 += b1[bj]; }
                f.put(row0 + ai * 128 + m * 16, col0 + bj * 128, v0, v1, pre[i]); }
        }
    }
};
template <class F>
DEVI void gemm_pg8(const bf16_t* A, const bf16_t* Bt, int M, int N, int K, const F& f, char* smem, int bid, int nblk) {
    pg8::Gemm g{A, Bt, M, N, K};
    pg8::StaticOrder S; S.init(M, N, nblk, bid);
    EpiAdapt<F> E{f};
    __syncthreads();
    pg8::gemm_phase<EpiAdapt<F>, pg8::StaticOrder, false>((PG8_LAS unsigned char*)smem, g, S, E, nullptr);
    __syncthreads();
}

template <class F>
DEVI void gemm_small_rows(const bf16_t* __restrict__ A, const bf16_t* __restrict__ Bt, int N, const F& f, char* smem, int bid, int nblk) {
    const int tid = tid_opq(), lane = tid & 63, wid = tid >> 6, fr = lane & 15, fq = lane >> 4;
    float* part = (float*)smem;
    const int ntn = N / 64, ntiles = (NTS / 32) * ntn;
    for (int tile = bid; tile < ntiles; tile += nblk) {
        const int tm = tile / ntn, tn = tile % ntn;
        const int row0 = NTP + tm * 32, col0 = tn * 64;
        f32x4 acc[2][4];
#pragma unroll
        for (int m = 0; m < 2; ++m)
#pragma unroll
            for (int n = 0; n < 4; ++n) acc[m][n] = (f32x4){0.f, 0.f, 0.f, 0.f};
        const bf16_t* ap = A + (size_t)(row0 + fr) * 1024 + wid * 128 + fq * 8;
        const bf16_t* bp = Bt + (size_t)(col0 + fr) * 1024 + wid * 128 + fq * 8;
        bf16x8 af[4][2], bfr[4][4];
#pragma unroll
        for (int ks = 0; ks < 4; ++ks) {
#pragma unroll
            for (int m = 0; m < 2; ++m) af[ks][m] = *(const bf16x8*)(ap + (size_t)m * 16 * 1024 + ks * 32);
#pragma unroll
            for (int n = 0; n < 4; ++n) bfr[ks][n] = *(const bf16x8*)(bp + (size_t)n * 16 * 1024 + ks * 32);
        }
#pragma unroll
        for (int ks = 0; ks < 4; ++ks)
#pragma unroll
            for (int m = 0; m < 2; ++m)
#pragma unroll
                for (int n = 0; n < 4; ++n) acc[m][n] = __builtin_amdgcn_mfma_f32_16x16x32_bf16(bfr[ks][n], af[ks][m], acc[m][n], 0, 0, 0);
        __syncthreads();
#pragma unroll
        for (int m = 0; m < 2; ++m)
#pragma unroll
            for (int n = 0; n < 4; ++n) *(f32x4*)(part + ((size_t)wid * 32 + m * 16 + fr) * 64 + n * 16 + fq * 4) = acc[m][n];
        __syncthreads();
        if (tid < 256) {
            const int r = tid >> 3, c8 = (tid & 7) * 8;
            f32x4 v0 = {0.f, 0.f, 0.f, 0.f}, v1 = v0;
#pragma unroll
            for (int w = 0; w < 8; ++w) { v0 += *(const f32x4*)(part + ((size_t)w * 32 + r) * 64 + c8); v1 += *(const f32x4*)(part + ((size_t)w * 32 + r) * 64 + c8 + 4); }
            const typename F::Pre pre = f.pre(row0 + r, col0 + c8);
            f.put(row0 + r, col0 + c8, v0, v1, pre);
        }
    }
}
template <class F>
DEVI void gemm_tail(const bf16_t* A, const bf16_t* Bt, int N, const F& f, char* smem, int bid, int nblk) {
    gemm_small_rows(A, Bt, N, f, smem, bid, nblk);
    gemm_pg8(A, Bt, NTP, N, 1024, f, smem, bid, nblk);
}

#define XB_TMO      128
#define XB_XCNT(j)  (256  + 64 * (j))
#define XB_XSUB(j)  (1280 + 64 * (j))
#define XB_XGEN(j)  (2304 + 64 * (j))
#define XB_TOP      3328
#define XB_TOPGEN   3392
#define XCD_BAR_WORDS 3456
#define XB_SPIN_CAP (1u << 18)
#define LAS __attribute__((address_space(3)))

__device__ __forceinline__ unsigned xb_ld(unsigned* p)              { return __hip_atomic_load(p, __ATOMIC_RELAXED, __HIP_MEMORY_SCOPE_AGENT); }
__device__ __forceinline__ unsigned xb_add(unsigned* p, unsigned v) { return __hip_atomic_fetch_add(p, v, __ATOMIC_RELAXED, __HIP_MEMORY_SCOPE_AGENT); }
__device__ __forceinline__ unsigned xb_xcc_id() { return (unsigned)__builtin_amdgcn_s_getreg((3 << 11) | 20) & 0xFu; }
#define XB_SPIN(cond, bar) do { unsigned _sp = 0; while (cond) { __builtin_amdgcn_s_sleep(1); \
    if ((++_sp & 255u) == 0u) { if (xb_ld(&(bar)[XB_TMO])) break; if (_sp > XB_SPIN_CAP) { atomicAdd(&(bar)[XB_TMO], 1u); break; } } } } while (0)

struct XcdBarrier {
    unsigned* bar; unsigned x;
    volatile LAS unsigned* st;
};

__device__ __forceinline__ XcdBarrier xcd_barrier_post(unsigned* bar, volatile LAS unsigned* st) {
    XcdBarrier b; b.bar = bar; b.x = xb_xcc_id(); b.st = st;
    if (tid_opq() == 0) (void)xb_add(&bar[XB_XCNT(b.x)], 1u);
    return b;
}
__device__ __forceinline__ void xcd_barrier_complete(unsigned* bar, unsigned x, unsigned& nloc, unsigned& nx) {
    const unsigned G = gridDim.x * gridDim.y * gridDim.z;
    unsigned sum, cnt, mine, sp = 0u;
    for (;;) {
        sum = 0u; cnt = 0u; mine = 0u;
#pragma unroll
        for (unsigned j = 0; j < 16; ++j) { const unsigned c = xb_ld(&bar[XB_XCNT(j)]); sum += c; cnt += (c > 0u) ? 1u : 0u; mine = (j == x) ? c : mine; }
        if (sum == G) break;
        __builtin_amdgcn_s_sleep(1);
        if ((++sp & 255u) == 0u) { if (xb_ld(&bar[XB_TMO])) break; if (sp > XB_SPIN_CAP) { atomicAdd(&bar[XB_TMO], 1u); break; } }
    }
    nloc = mine > 0u ? mine : 1u; nx = cnt > 0u ? cnt : 1u;
}

__device__ __forceinline__ void xcd_barrier(const XcdBarrier& b) {
    asm volatile("s_waitcnt vmcnt(0)" ::: "memory");
    __syncthreads();
    if (tid_opq() == 0) {
        unsigned* bar = b.bar;
        __builtin_amdgcn_s_waitcnt(0);
        unsigned nloc = b.st[0], nx = b.st[1];
        if (nloc == 0u) { xcd_barrier_complete(bar, b.x, nloc, nx); b.st[0] = nloc; b.st[1] = nx; }
        const unsigned old = xb_add(&bar[XB_XSUB(b.x)], 1u);
        const unsigned gen = old / nloc;
        if (old + 1u == (gen + 1u) * nloc) {
            __builtin_amdgcn_fence(__ATOMIC_RELEASE, "agent");
            asm volatile("s_waitcnt vmcnt(0)" ::: "memory");
            const unsigned og = xb_add(&bar[XB_TOP], 1u);
            const unsigned tg = og / nx;
            if (og + 1u == (tg + 1u) * nx) xb_add(&bar[XB_TOPGEN], 1u);
            else XB_SPIN(xb_ld(&bar[XB_TOPGEN]) == tg, bar);
            __builtin_amdgcn_fence(__ATOMIC_ACQUIRE, "agent");
            xb_add(&bar[XB_XGEN(b.x)], 1u);
            asm volatile("s_waitcnt vmcnt(0)" ::: "memory");
        } else {
            XB_SPIN(xb_ld(&bar[XB_XGEN(b.x)]) == gen, bar);
            __builtin_amdgcn_fence(__ATOMIC_ACQUIRE, "agent");
            asm volatile("s_waitcnt vmcnt(0)" ::: "memory");
        }
    }
    __syncthreads();
}

constexpr int LDS_BYTES = 152 * 1024;

template <int S>
DEVI void run_stage(const P& p, char* smem, int bid, int nblk) {
    if (S == 0) stage_prologue(p, smem, bid, nblk);
    if (S == 1) { EpiInProj e{p}; gemm_pg8(p.XB, p.WINT, NT, NPAD_IN + 2048, 1024, e, smem, bid, nblk); }
    if (S == 2) {
        stage2_queue(p, smem);
    }
    if (S == 4) { stage_mlstm_scan(p, bid, nblk); stage_nsa_attn(p, smem, bid, nblk); }
    if (S == 5) { stage_mlstm_out(p, smem, bid, nblk); { EpiM1 e{p}; gemm_tail(p.YB, p.WBT, 1024, e, smem, bid, nblk); } }
    if (S == 6) { EpiM2 e{p}; gemm_tail(p.YA, p.WAT, 1024, e, smem, bid, nblk); }
    if (S == 8) { EpiR e{p}; gemm_tail(p.MERGED, p.WOT, 1024, e, smem, bid, nblk); }
    if (S == 9) stage_ln1(p, bid, nblk);
    if (S == 10) { EpiPQ e{p}; gemm_tail(p.HB, p.WQT, 2048, e, smem, bid, nblk); }
    if (S == 11) {
        if (bid & 1) {
            for (int ps = 0; ps < 4; ++ps) { stage_peer_route(p, smem, bid, nblk, ps, ps + 1); __threadfence_block(); __syncthreads(); stage_peer_apply(p, smem, bid, nblk, ps, ps + 1); __syncthreads(); }
        } else { stage_peer_route(p, smem, bid, nblk, 0, 64); __threadfence_block(); __syncthreads(); stage_peer_apply(p, smem, bid, nblk, 0, 64); }
    }
}
constexpr int NSTAGES = 13;

template <int S>
__global__ void __launch_bounds__(512, 2) k_stage(P p) {
    extern __shared__ __attribute__((aligned(16))) char smem[];
    run_stage<S>(p, smem, blockIdx.x, gridDim.x);
}


#if MK_ONE_LAUNCH
__global__ void __launch_bounds__(512, 2) k_mega(P p) {
    extern __shared__ __attribute__((aligned(16))) char smem_all[];
    if (tid_opq() == 0) *(u32x4*)smem_all = (u32x4){0u, 0u, 0u, 0u};
    __syncthreads();
    XcdBarrier bar = xcd_barrier_post(p.bar, (volatile LAS unsigned*)smem_all);
    char* smem = smem_all + 16;
    const int bid = blockIdx.x, nblk = gridDim.x;
    run_stage<0>(p, smem, bid, nblk); if ((REP_MASK >> 0) & 1) { xcd_barrier(bar); run_stage<0>(p, smem, bid, nblk); }  xcd_barrier(bar);
    run_stage<1>(p, smem, bid, nblk); if ((REP_MASK >> 1) & 1) { xcd_barrier(bar); run_stage<1>(p, smem, bid, nblk); }  xcd_barrier(bar);
    run_stage<2>(p, smem, bid, nblk); if ((REP_MASK >> 2) & 1) { xcd_barrier(bar); run_stage<2>(p, smem, bid, nblk); }  xcd_barrier(bar);
    run_stage<4>(p, smem, bid, nblk); if ((REP_MASK >> 4) & 1) { xcd_barrier(bar); run_stage<4>(p, smem, bid, nblk); }  xcd_barrier(bar);
    run_stage<5>(p, smem, bid, nblk); if ((REP_MASK >> 5) & 1) { xcd_barrier(bar); run_stage<5>(p, smem, bid, nblk); }  xcd_barrier(bar);
    run_stage<6>(p, smem, bid, nblk); if ((REP_MASK >> 6) & 1) { xcd_barrier(bar); run_stage<6>(p, smem, bid, nblk); }  xcd_barrier(bar);
    run_stage<8>(p, smem, bid, nblk); if ((REP_MASK >> 8) & 1) { xcd_barrier(bar); run_stage<8>(p, smem, bid, nblk); }  xcd_barrier(bar);
    run_stage<9>(p, smem, bid, nblk); if ((REP_MASK >> 9) & 1) { xcd_barrier(bar); run_stage<9>(p, smem, bid, nblk); }  xcd_barrier(bar);
    run_stage<10>(p, smem, bid, nblk); if ((REP_MASK >> 10) & 1) { xcd_barrier(bar); run_stage<10>(p, smem, bid, nblk); } xcd_barrier(bar);
    run_stage<11>(p, smem, bid, nblk); if ((REP_MASK >> 11) & 1) { xcd_barrier(bar); run_stage<11>(p, smem, bid, nblk); }
}
#endif

template <int S> static void launch_stage(const P& p, int grid, hipStream_t stream) {
    (void)hipFuncSetAttribute((const void*)k_stage<S>, hipFuncAttributeMaxDynamicSharedMemorySize, LDS_BYTES);
    k_stage<S><<<dim3(grid), dim3(512), LDS_BYTES, stream>>>(p);
}

extern "C" void kernel_launch(void* const* d_in, const int* in_sizes, int n_in, void* d_out, int out_size, void* d_ws, size_t ws_size, hipStream_t stream) {
    (void)in_sizes; (void)n_in; (void)out_size; (void)ws_size;
    P p{};
    p.xp = (const float*)d_in[0]; p.xs = (const float*)d_in[1]; p.cache_cmp = (const float*)d_in[2]; p.cache_slc = (const float*)d_in[3];
    p.cache_win = (const float*)d_in[4]; p.state_C = (const float*)d_in[5]; p.state_n = (const float*)d_in[6]; p.state_m = (const float*)d_in[7];
    p.page_table = (const int*)d_in[8];
    p.w_in = (const float*)d_in[9]; p.b_in = (const float*)d_in[10]; p.norm_a_g = (const float*)d_in[11]; p.nsa_pe = (const float*)d_in[12];
    p.nsa_w_cmp = (const float*)d_in[13]; p.w_br_a = (const float*)d_in[14]; p.w_br_b = (const float*)d_in[15]; p.w_merge = (const float*)d_in[16];
    p.w_out = (const float*)d_in[17]; p.ln1_g = (const float*)d_in[18]; p.ln1_b = (const float*)d_in[19];
    p.peer_wq = (const float*)d_in[20]; p.peer_keys = (const float*)d_in[21]; p.peer_u = (const float*)d_in[22]; p.peer_v = (const float*)d_in[23];
    p.ln2_g = (const float*)d_in[24]; p.ln2_b = (const float*)d_in[25];
    p.out = (float*)d_out;
    char* w = (char*)d_ws; size_t off = 0;
    auto take = [&](size_t bytes) { char* r = w + off; off += (bytes + 255) & ~(size_t)255; return r; };
    p.bar = (unsigned*)take(16384);
    p.PW = (float*)(p.bar + 3584);
    p.WCT = (bf16_t*)take((size_t)2 * 64 * 4096 * 2);
    p.XB = (bf16_t*)take((size_t)NT * 1024 * 2);
    p.WINT = (bf16_t*)take((size_t)(NPAD_IN + 2048) * 1024 * 2);
    p.WMT = (bf16_t*)take((size_t)2048 * 1024 * 2);
    p.WAT = (bf16_t*)take((size_t)1024 * 1024 * 2);
    p.WBT = (bf16_t*)take((size_t)1024 * 1024 * 2);
    p.WOT = (bf16_t*)take((size_t)1024 * 1024 * 2);
    p.WQT = (bf16_t*)take((size_t)2048 * 1024 * 2);
    p.KEYSB = (bf16_t*)take((size_t)16 * 128 * 128 * 2);
    p.U8 = (unsigned char*)take((size_t)16384 * 768 + 256);
    p.V8 = (unsigned char*)take((size_t)16384 * 768 + 256);
    p.US = (float*)take(16384 * 4);
    p.VS = (float*)take(16384 * 4);
    p.PROJ = (bf16_t*)take((size_t)NT * PS * 2);
    p.SM = (float*)take((size_t)NT * 64 * 4);
    p.BCUM = (float*)take((size_t)16 * 4096 * 4);
    p.MPREV = (float*)take(4096); p.ACOEF = (float*)take(4096); p.SCL = (float*)take(4096); p.MLOC = (float*)take(4096);
    p.DC = (float*)take((size_t)1024 * 272 * 128 * 4);
    p.CPT = (bf16_t*)take((size_t)1024 * 272 * 128 * 2);
    p.KC = (float*)take((size_t)4352 * 512 * 4);
    p.VC = p.KC + 256;
    p.OCMP = (float*)take((size_t)NT * 1024 * 4);
    p.SEL = (unsigned long long*)take((size_t)NT * 4 * 8);
    p.YA = (bf16_t*)take((size_t)NT * 1024 * 2);
    p.YB = (bf16_t*)take((size_t)NT * 1024 * 2);
    p.G = (bf16_t*)take((size_t)NT * 2048 * 2);
    p.TMPB = (bf16_t*)take((size_t)NT * 1024 * 2);
    p.MERGED = (bf16_t*)take((size_t)NT * 1024 * 2);
    p.R = (float*)take((size_t)NT * 1024 * 4);
    p.H = (float*)take((size_t)NT * 1024 * 4);
    p.HB = (bf16_t*)take((size_t)NT * 1024 * 2);
    p.PQ = (bf16_t*)take((size_t)NT * 2048 * 2);
    p.EIDX = (int*)take((size_t)NT * 128 * 4);
    p.EGATE = (float*)take((size_t)NT * 128 * 4);

    (void)hipMemsetAsync(p.bar, 0, 16384, stream);
#if MK_ONE_LAUNCH
    {
        constexpr size_t kDynLds = LDS_BYTES + 16;
        (void)hipFuncSetAttribute((const void*)k_mega, hipFuncAttributeMaxDynamicSharedMemorySize, (int)kDynLds);
        int dev = 0, cus = 0, per_cu = 0;
        (void)hipGetDevice(&dev);
        (void)hipDeviceGetAttribute(&cus, hipDeviceAttributeMultiprocessorCount, dev);
        (void)hipOccupancyMaxActiveBlocksPerMultiprocessor(&per_cu, (const void*)k_mega, 512, kDynLds);
        if (per_cu < 1 || cus < 1) return;
        const int grid = cus;
        k_mega<<<dim3(grid), dim3(512), kDynLds, stream>>>(p);
    }
#else
    const int grid = 512;
    launch_stage<0>(p, grid, stream);
    launch_stage<1>(p, grid, stream);
    launch_stage<2>(p, grid, stream);
    launch_stage<4>(p, grid, stream);
    launch_stage<5>(p, grid, stream);
    launch_stage<6>(p, grid, stream);
    launch_stage<8>(p, grid, stream);
    launch_stage<9>(p, grid, stream);
    launch_stage<10>(p, grid, stream);
    launch_stage<11>(p, grid, stream);
#endif
}
```

```cpp
#include <hip/hip_runtime.h>
#include <stdint.h>

#ifndef REP_MASK
#define REP_MASK 0
#endif
#ifndef MK_ONE_LAUNCH
#define MK_ONE_LAUNCH 1
#endif

typedef unsigned short bf16_t;
typedef short bf16x8 __attribute__((ext_vector_type(8)));
typedef float f32x4 __attribute__((ext_vector_type(4)));
typedef unsigned u32x4 __attribute__((ext_vector_type(4)));
#define U_BITS 4
#define V_BITS 4
typedef int i32x8 __attribute__((ext_vector_type(8)));
typedef int i32x6 __attribute__((ext_vector_type(6)));
typedef float f32x32 __attribute__((ext_vector_type(32)));
struct __attribute__((packed, aligned(4))) U3 { unsigned a, b, c; };
typedef unsigned u32x2 __attribute__((ext_vector_type(2)));
typedef float f32x2 __attribute__((ext_vector_type(2)));
typedef __bf16 bf16x2_t __attribute__((ext_vector_type(2)));
#define DEVI __device__ __forceinline__
__device__ __forceinline__ int tid_opq() { int t = threadIdx.x; asm volatile("" : "+v"(t)); return t; }

constexpr int NTP = 16384, NTS = 512, NT = NTP + NTS, DM = 1024;
constexpr int PS = 5632;
constexpr int C_AQ = 0, C_AK = 512, C_AV = 1024, C_AO = 2048, C_BQ = 3072, C_CMP = 4096, C_SLC = 4608, C_WIN = 5120;
constexpr int NPAD_IN = 5888;
constexpr float DN_ALPHA = 1.189207115002721f;
constexpr float LN_EPS = 1e-5f;
constexpr size_t O_Y = 0;
constexpr size_t O_PCMP = O_Y + (size_t)NT * 1024;
constexpr size_t O_PSLC = O_PCMP + (size_t)NTP * 512;
constexpr size_t O_PWIN = O_PSLC + (size_t)NTP * 512;
constexpr size_t O_PC = O_PWIN + (size_t)4 * 512 * 512;
constexpr size_t O_PN = O_PC + (size_t)16 * 128 * 256;
constexpr size_t O_PM = O_PN + 16 * 128;
constexpr size_t O_SCMP = O_PM + 16;
constexpr size_t O_SSLC = O_SCMP + (size_t)NTS * 512;
constexpr size_t O_SWIN = O_SSLC + (size_t)NTS * 512;
constexpr size_t O_SC = O_SWIN + (size_t)128 * 512 * 512;
constexpr size_t O_SN = O_SC + (size_t)512 * 128 * 256;
constexpr size_t O_SM = O_SN + 512 * 128;

struct P {
    const float *xp, *xs, *cache_cmp, *cache_slc, *cache_win, *state_C, *state_n, *state_m;
    const int* page_table;
    const float *w_in, *b_in, *norm_a_g, *nsa_pe, *nsa_w_cmp, *w_br_a, *w_br_b, *w_merge, *w_out, *ln1_g, *ln1_b;
    const float *peer_wq, *peer_keys, *peer_u, *peer_v, *ln2_g, *ln2_b;
    float* out;
    bf16_t *XB, *WINT, *WMT, *WAT, *WBT, *WOT, *WQT, *KEYSB, *UB, *VB, *PROJ, *WCT;
    float* PW;
    float *SM, *BCUM, *MPREV, *ACOEF, *SCL, *MLOC, *DC, *KC, *VC, *OCMP;
    bf16_t* CPT;
    unsigned char *U8, *V8;
    float *US, *VS;
    unsigned long long* SEL;
    bf16_t *YA, *YB, *G, *MERGED, *HB, *PQ;
    float *R, *H, *EGATE;
    bf16_t* TMPB;
    int* EIDX;
    unsigned* bar;
};

DEVI bf16_t f2bf(float f) { return __builtin_bit_cast(unsigned short, (__bf16)f); }
DEVI float bf2f(bf16_t h) { return __uint_as_float(((unsigned)h) << 16); }
DEVI unsigned pack2(float a, float b) { return __builtin_bit_cast(unsigned, __builtin_convertvector((f32x2){a, b}, bf16x2_t)); }
DEVI u32x4 pack8f(const f32x4 a, const f32x4 b) { u32x4 r; r[0] = pack2(a[0], a[1]); r[1] = pack2(a[2], a[3]); r[2] = pack2(b[0], b[1]); r[3] = pack2(b[2], b[3]); return r; }
DEVI void ce_desc(unsigned& a, unsigned& b) { const unsigned hi = a > b ? a : b, lo = a > b ? b : a; a = hi; b = lo; }
template <int BASE> DEVI void sort16_desc(unsigned (&x)[64]) {
#pragma unroll
    for (int k = 2; k <= 16; k <<= 1)
#pragma unroll
        for (int j = k >> 1; j > 0; j >>= 1)
#pragma unroll
            for (int i = 0; i < 16; ++i) {
                const int l = i ^ j;
                if (l > i) { if ((i & k) == 0) ce_desc(x[BASE + i], x[BASE + l]); else ce_desc(x[BASE + l], x[BASE + i]); }
            }
}
DEVI void merge_top16(const unsigned* a, const unsigned* b, unsigned* t) {
    unsigned c[16];
#pragma unroll
    for (int i = 0; i < 16; ++i) c[i] = a[i] > b[15 - i] ? a[i] : b[15 - i];
#pragma unroll
    for (int j = 8; j > 0; j >>= 1)
#pragma unroll
        for (int i = 0; i < 16; ++i) { const int l = i ^ j; if (l > i) ce_desc(c[i], c[l]); }
#pragma unroll
    for (int i = 0; i < 16; ++i) t[i] = c[i];
}
DEVI float gelu_erf(float v) {
    const float av = fabsf(v), t = __builtin_amdgcn_rcpf(fmaf(av, 0.2316418882f, 1.0f));
    float q = fmaf(t, 0.5307027145f, -0.7265760135f); q = fmaf(q, t, 0.7107068705f); q = fmaf(q, t, -0.142248368f); q = fmaf(q, t, 0.127414796f); q = q * t;
    const float e = __builtin_amdgcn_exp2f(v * v * -0.72134752044f);
    const float mm = v * (q * e);
    return v < 0.f ? mm : v - mm;
}
DEVI float wave_max(float v) { for (int o = 32; o > 0; o >>= 1) v = fmaxf(v, __shfl_xor(v, o)); return v; }
DEVI float wave_sum(float v) { for (int o = 32; o > 0; o >>= 1) v += __shfl_xor(v, o); return v; }
DEVI float sigmoidf_(float x) { return __builtin_amdgcn_rcpf(1.f + __expf(-x)); }
DEVI float logsigmoidf_(float x) { return fminf(x, 0.f) - log1pf(__expf(-fabsf(x))); }
DEVI int win_map(int np) {
    if (np < 2048) return np;
    if (np < 5632) return np + 8;
    if (np < 5640) return np - 5632 + 2048;
    if (np < 5688) return np;
    return -1;
}
DEVI float alibi_slope(int h) { return exp2f(-0.5f * (float)(h + 1)); }

template <class MapFn>
DEVI void transpose_cvt(const float* __restrict__ W, bf16_t* __restrict__ WT, int K, int Nsrc, int Ndst, MapFn mapfn, float* tile  , int bid, int nblk) {
    const int tid = tid_opq();
    const int tn = Ndst / 64, tk = K / 64;
    for (int t = bid; t < tn * tk; t += nblk) {
        const int n0 = (t % tn) * 64, k0 = (t / tn) * 64;
        __syncthreads();
#pragma unroll
        for (int i = 0; i < 8; ++i) {
            const int kk = (tid >> 6) + i * 8, nn = tid & 63;
            const int n = mapfn(n0 + nn);
            tile[kk * 65 + nn] = n >= 0 ? W[(size_t)(k0 + kk) * Nsrc + n] : 0.f;
        }
        __syncthreads();
#pragma unroll
        for (int i = 0; i < 8; ++i) {
            const int nn = (tid >> 6) + i * 8, kk = tid & 63;
            WT[(size_t)(n0 + nn) * K + k0 + kk] = f2bf(tile[kk * 65 + nn]);
        }
    }
}
struct IdMap { DEVI int operator()(int n) const { return n; } };
struct WinMap { DEVI int operator()(int n) const { return win_map(n); } };

DEVI void cvt_rows(const float* __restrict__ src, bf16_t* __restrict__ dst, size_t n4, int bid, int nblk) {
    const size_t stride = (size_t)nblk * 512;
    for (size_t i0 = (size_t)bid * 512 + tid_opq(); i0 < n4; i0 += stride * 8) {
        f32x4 v[8];
#pragma unroll
        for (int u = 0; u < 8; ++u) { const size_t i = i0 + u * stride; v[u] = i < n4 ? __builtin_nontemporal_load((const f32x4*)src + i) : (f32x4){0.f, 0.f, 0.f, 0.f}; }
#pragma unroll
        for (int u = 0; u < 8; ++u) { const size_t i = i0 + u * stride; if (i < n4) { u32x2 o; o.x = pack2(v[u][0], v[u][1]); o.y = pack2(v[u][2], v[u][3]); ((u32x2*)dst)[i] = o; } }
    }
}

DEVI unsigned q_e2m3(float x) {
    const float a = fabsf(x);
    const float c = a < 2.f ? rintf(a * 8.f) : a < 4.f ? 16.f + rintf((a - 2.f) * 4.f) : fminf(31.f, 24.f + rintf((a - 4.f) * 2.f));
    return (unsigned)c | (x < 0.f ? 32u : 0u);
}

DEVI unsigned q_e2m1(float x) {
    const float a = fabsf(x);
    const float c = a < 2.f ? rintf(a * 2.f) : a < 4.f ? 4.f + rintf(a - 2.f) : fminf(7.f, 6.f + rintf((a - 4.f) * 0.5f));
    return (unsigned)c | (x < 0.f ? 8u : 0u);
}

DEVI void stage_prologue(const P& p, char* smem, int bid, int nblk) {
    float* tile = (float*)smem;
    cvt_rows(p.xp, p.XB, (size_t)NTP * 256, bid, nblk);
    cvt_rows(p.xs, p.XB + (size_t)NTP * 1024, (size_t)NTS * 256, bid, nblk);
    {
        const int lane = tid_opq() & 63, wid = tid_opq() >> 6;
        for (int r0 = bid * 8 + wid; r0 < 2 * 16384; r0 += nblk * 8 * 2) {
            f32x4 x[2][4]; float am[2] = {0.f, 0.f};
#pragma unroll
            for (int j = 0; j < 2; ++j) {
                const int r = r0 + j * nblk * 8;
                if (r < 2 * 16384) {
                    const bool isv = r >= 16384; const int e = isv ? r - 16384 : r;
                    const float* src = (isv ? p.peer_v : p.peer_u) + (size_t)e * 1024 + lane * 16;
#pragma unroll
                    for (int i = 0; i < 4; ++i) x[j][i] = __builtin_nontemporal_load((const f32x4*)(src + i * 4));
                }
            }
#pragma unroll
            for (int j = 0; j < 2; ++j) {
                const int r = r0 + j * nblk * 8;
                if (r < 2 * 16384) {
                    const bool isv = r >= 16384; const int e = isv ? r - 16384 : r;
#pragma unroll
                    for (int i = 0; i < 4; ++i)
#pragma unroll
                        for (int k = 0; k < 4; ++k) am[j] = fmaxf(am[j], fabsf(x[j][i][k]));
                    const float amx = wave_max(am[j]);
                    if ((isv ? V_BITS : U_BITS) == 6) {
                        const float inv = amx > 0.f ? 7.5f / amx : 1.f;
                        unsigned long long lo = 0ull, hi = 0ull;
#pragma unroll
                        for (int i = 0; i < 16; ++i) {
                            const unsigned long long c = (unsigned long long)q_e2m3(x[j][i >> 2][i & 3] * inv);
                            if (i < 10) lo |= c << (6 * i);
                            else if (i == 10) { lo |= c << 60; hi |= c >> 4; }
                            else hi |= c << (6 * i - 64);
                        }
                        unsigned* d = (unsigned*)((isv ? p.V8 : p.U8) + (size_t)e * 768 + lane * 12);
                        d[0] = (unsigned)lo; d[1] = (unsigned)(lo >> 32); d[2] = (unsigned)hi;
                        if (lane == 0) (isv ? p.VS : p.US)[e] = amx > 0.f ? amx / 7.5f : 1.f;
                    } else {
                        const float inv = amx > 0.f ? 6.f / amx : 1.f;
                        unsigned w0 = 0u, w1 = 0u;
#pragma unroll
                        for (int i = 0; i < 8; ++i) { w0 |= q_e2m1(x[j][i >> 2][i & 3] * inv) << (4 * i); w1 |= q_e2m1(x[j][2 + (i >> 2)][i & 3] * inv) << (4 * i); }
                        *(u32x2*)((isv ? p.V8 : p.U8) + (size_t)e * 512 + lane * 8) = (u32x2){w0, w1};
                        if (lane == 0) (isv ? p.VS : p.US)[e] = amx > 0.f ? amx / 6.f : 1.f;
                    }
                }
            }
        }
    }
    cvt_rows(p.peer_keys, p.KEYSB, (size_t)16 * 128 * 128 / 4, bid, nblk);
    transpose_cvt(p.w_in, p.WINT, 1024, 5688, NPAD_IN, WinMap(), tile, bid, nblk);
    transpose_cvt(p.w_merge, p.WINT + (size_t)NPAD_IN * 1024, 1024, 2048, 2048, IdMap(), tile, bid, nblk);
    transpose_cvt(p.w_br_a, p.WAT, 1024, 1024, 1024, IdMap(), tile, bid, nblk);
    transpose_cvt(p.w_br_b, p.WBT, 1024, 1024, 1024, IdMap(), tile, bid, nblk);
    transpose_cvt(p.w_out, p.WOT, 1024, 1024, 1024, IdMap(), tile, bid, nblk);
    transpose_cvt(p.peer_wq, p.WQT, 1024, 2048, 2048, IdMap(), tile, bid, nblk);
    transpose_cvt(p.nsa_w_cmp, p.WCT, 4096, 64, 64, IdMap(), tile, bid, nblk);
    transpose_cvt(p.nsa_w_cmp + 4096 * 64, p.WCT + 64 * 4096, 4096, 64, 64, IdMap(), tile, bid, nblk);
    for (int blk = bid; blk < 32; blk += nblk) {
        const int tid = tid_opq(), kvv = tid >> 8, e = tid & 63, kq = (tid >> 6) & 3;
        float a = 0.f;
        for (int k = blk * 128 + kq * 32; k < blk * 128 + kq * 32 + 32; ++k) a += p.nsa_pe[kvv * 4096 + k] * p.nsa_w_cmp[((size_t)kvv * 4096 + k) * 64 + e];
        atomicAdd(p.PW + kvv * 64 + e, a);
    }
}

struct NoPre {};
DEVI f32x4 bf4_lo(const u32x4& g) { return (f32x4){__uint_as_float(g[0] << 16), __uint_as_float(g[0] & 0xFFFF0000u), __uint_as_float(g[1] << 16), __uint_as_float(g[1] & 0xFFFF0000u)}; }
DEVI f32x4 bf4_hi(const u32x4& g) { return (f32x4){__uint_as_float(g[2] << 16), __uint_as_float(g[2] & 0xFFFF0000u), __uint_as_float(g[3] << 16), __uint_as_float(g[3] & 0xFFFF0000u)}; }
struct EpiInProj {
    P p;
    typedef NoPre Pre;
    static constexpr int BATCH = 4;
    static constexpr bool COLBIAS = true;
    DEVI void bias8(int col, f32x4& b0, f32x4& b1) const {
        b0 = (f32x4){0.f, 0.f, 0.f, 0.f}; b1 = b0;
        if (col < 5688) { const int oc = win_map(col);
#pragma unroll
            for (int q = 0; q < 4; ++q) { b0[q] = p.b_in[oc + q]; b1[q] = p.b_in[oc + 4 + q]; } }
    }
    DEVI Pre pre(int, int) const { return NoPre(); }
    DEVI void put(int row, int col, f32x4 v0, f32x4 v1, const Pre&) const {
        if (col >= NPAD_IN) {
#pragma unroll
            for (int k = 0; k < 4; ++k) { v0[k] = sigmoidf_(v0[k]); v1[k] = sigmoidf_(v1[k]); }
            *(u32x4*)(p.G + (size_t)row * 2048 + (col - NPAD_IN)) = pack8f(v0, v1);
            return;
        }
        if (col >= 5688) return;
        if (col >= 5632) { *(f32x4*)(p.SM + (size_t)row * 64 + (col - 5632)) = v0; *(f32x4*)(p.SM + (size_t)row * 64 + (col - 5632) + 4) = v1; return; }
        if (col >= C_AK && col < C_AV) { v0 *= 0.08838834764831845f; v1 *= 0.08838834764831845f; }
        *(u32x4*)(p.PROJ + (size_t)row * PS + col) = pack8f(v0, v1);
        if (col >= C_CMP) {
            const int reg = (col - C_CMP) >> 9, c = (col - C_CMP) & 511;
            float* dst = nullptr;
            if (row < NTP) {
                if (reg == 0) dst = p.out + O_PCMP + (size_t)row * 512 + c;
                else if (reg == 1) dst = p.out + O_PSLC + (size_t)row * 512 + c;
                else { const int b = row >> 12, t = row & 4095; if (t >= 3584) dst = p.out + O_PWIN + ((size_t)b * 512 + (t - 3584)) * 512 + c; }
            } else {
                const int rs = row - NTP;
                if (reg == 0) dst = p.out + O_SCMP + (size_t)rs * 512 + c;
                else if (reg == 1) dst = p.out + O_SSLC + (size_t)rs * 512 + c;
                else { const int b = rs >> 2, tq = rs & 3; dst = p.out + O_SWIN + ((size_t)b * 512 + 508 + tq) * 512 + c; }
            }
            if (dst) { *(f32x4*)dst = v0; *(f32x4*)(dst + 4) = v1; }
        }
    }
};
struct EpiG {
    P p;
    typedef NoPre Pre;
    static constexpr int BATCH = 4;
    static constexpr bool COLBIAS = false;
    DEVI Pre pre(int, int) const { return NoPre(); }
    DEVI void put(int row, int col, f32x4 v0, f32x4 v1, const Pre&) const {
#pragma unroll
        for (int k = 0; k < 4; ++k) { v0[k] = sigmoidf_(v0[k]); v1[k] = sigmoidf_(v1[k]); }
        *(u32x4*)(p.G + (size_t)row * 2048 + col) = pack8f(v0, v1);
    }
};
struct EpiM1 {
    P p;
    typedef u32x4 Pre;
    static constexpr int BATCH = 8;
    static constexpr bool COLBIAS = false;
    DEVI Pre pre(int row, int col) const { return *(const u32x4*)(p.G + (size_t)row * 2048 + 1024 + col); }
    DEVI void put(int row, int col, f32x4 v0, f32x4 v1, const Pre& g) const {
        *(u32x4*)(p.TMPB + (size_t)row * 1024 + col) = pack8f(v0 * bf4_lo(g), v1 * bf4_hi(g));
    }
};
struct PreM2 { u32x4 g; u32x4 t; };
struct EpiM2 {
    P p;
    typedef PreM2 Pre;
    static constexpr int BATCH = 8;
    static constexpr bool COLBIAS = false;
    DEVI Pre pre(int row, int col) const { PreM2 r; r.g = *(const u32x4*)(p.G + (size_t)row * 2048 + col); r.t = *(const u32x4*)(p.TMPB + (size_t)row * 1024 + col); return r; }
    DEVI void put(int row, int col, f32x4 v0, f32x4 v1, const Pre& q) const {
        *(u32x4*)(p.MERGED + (size_t)row * 1024 + col) = pack8f(bf4_lo(q.t) + v0 * bf4_lo(q.g), bf4_hi(q.t) + v1 * bf4_hi(q.g));
    }
};
struct PreR { f32x4 a, b; };
struct EpiR {
    P p;
    typedef PreR Pre;
    static constexpr int BATCH = 8;
    static constexpr bool COLBIAS = false;
    DEVI Pre pre(int row, int col) const {
        const float* xr = row < NTP ? p.xp + (size_t)row * 1024 : p.xs + (size_t)(row - NTP) * 1024;
        PreR r; r.a = *(const f32x4*)(xr + col); r.b = *(const f32x4*)(xr + col + 4); return r;
    }
    DEVI void put(int row, int col, f32x4 v0, f32x4 v1, const Pre& x) const {
        *(f32x4*)(p.R + (size_t)row * 1024 + col) = x.a * DN_ALPHA + v0; *(f32x4*)(p.R + (size_t)row * 1024 + col + 4) = x.b * DN_ALPHA + v1;
    }
};
struct EpiPQ {
    P p;
    typedef NoPre Pre;
    static constexpr int BATCH = 4;
    static constexpr bool COLBIAS = false;
    DEVI Pre pre(int, int) const { return NoPre(); }
    DEVI void put(int row, int col, f32x4 v0, f32x4 v1, const Pre&) const { *(u32x4*)(p.PQ + (size_t)row * 2048 + col) = pack8f(v0, v1); }
};

DEVI void stage_mlstm_gates(const P& p, char* smem, int bid, int nblk) {
    const int lane = tid_opq() & 63, wid = tid_opq() >> 6;
    float* bend_s = (float*)smem; float* mloc_s = bend_s + 64;
    for (int bh = bid; bh < 16; bh += nblk) {
        const int b = bh >> 2, h = bh & 3;
        __syncthreads();
        for (int cc = 0; cc < 8; ++cc) {
            const int c = wid * 8 + cc;
            const size_t row = (size_t)b * 4096 + c * 64 + lane;
            const float ip = p.SM[row * 64 + h];
            const float lf = logsigmoidf_(p.SM[row * 64 + 4 + h]);
            float cs = lf;
#pragma unroll
            for (int o = 1; o < 64; o <<= 1) { const float t = __shfl_up(cs, o); if (lane >= o) cs += t; }
            p.BCUM[bh * 4096 + c * 64 + lane] = cs;
            const float bend = __shfl(cs, 63);
            const float mloc = wave_max(bend - cs + ip);
            if (lane == 0) { bend_s[c] = bend; mloc_s[c] = mloc; }
        }
        __syncthreads();
        if (tid_opq() == 0) {
            float m = 0.f;
            for (int c = 0; c < 64; ++c) {
                const float bend = bend_s[c], mloc = mloc_s[c];
                const float mnew = fmaxf(bend + m, mloc);
                p.MPREV[bh * 64 + c] = m;
                p.ACOEF[bh * 64 + c] = __expf(bend + m - mnew);
                p.SCL[bh * 64 + c] = __expf(mloc - mnew);
                p.MLOC[bh * 64 + c] = mloc;
                m = mnew;
            }
            p.out[O_PM + bh] = m;
        }
    }
}

constexpr int MD_KT = 0, MD_VT = 128 * 144, MD_WS = MD_VT + 272 * 144, MD_LDS = MD_WS + 256;
DEVI void stage_mlstm_dc(const P& p, char* smem, int bid, int nblk) {
    const int tid = tid_opq(), lane = tid & 63, wid = tid >> 6, fr = lane & 15, fq = lane >> 4;
    bf16_t* Kt = (bf16_t*)(smem + MD_KT);
    bf16_t* Vt = (bf16_t*)(smem + MD_VT);
    float* ws = (float*)(smem + MD_WS);
    for (int task = bid; task < 1024; task += nblk) {
        const int bh = task >> 6, c = task & 63, b = bh >> 2, h = bh & 3;
        const size_t row0 = (size_t)b * 4096 + c * 64;
        __syncthreads();
        if (tid < 64) {
            const float ip = p.SM[(row0 + tid) * 64 + h];
            float cs = logsigmoidf_(p.SM[(row0 + tid) * 64 + 4 + h]);
#pragma unroll
            for (int o = 1; o < 64; o <<= 1) { const float t = __shfl_up(cs, o); if (tid >= o) cs += t; }
            const float g = __shfl(cs, 63) - cs + ip;
            ws[tid] = __expf(g - wave_max(g));
        }
        __syncthreads();
        {
            const int sidx = tid & 63, ch = tid >> 6;
            const float w = ws[sidx];
#pragma unroll
            for (int half = 0; half < 2; ++half) {
                const u32x4 kk = *(const u32x4*)(p.PROJ + (row0 + sidx) * PS + C_AK + h * 128 + half * 64 + ch * 8);
#pragma unroll
                for (int e = 0; e < 4; ++e) {
                    Kt[(half * 64 + ch * 8 + e * 2) * 72 + sidx] = f2bf(w * __uint_as_float(kk[e] << 16));
                    Kt[(half * 64 + ch * 8 + e * 2 + 1) * 72 + sidx] = f2bf(w * __uint_as_float(kk[e] & 0xFFFF0000u));
                }
            }
#pragma unroll
            for (int q4 = 0; q4 < 4; ++q4) {
                const u32x4 vv = *(const u32x4*)(p.PROJ + (row0 + sidx) * PS + C_AV + h * 256 + q4 * 64 + ch * 8);
#pragma unroll
                for (int e = 0; e < 4; ++e) {
                    Vt[(q4 * 64 + ch * 8 + e * 2) * 72 + sidx] = (bf16_t)(vv[e] & 0xFFFFu);
                    Vt[(q4 * 64 + ch * 8 + e * 2 + 1) * 72 + sidx] = (bf16_t)(vv[e] >> 16);
                }
            }
            for (int i = tid; i < 16 * 64; i += 512) Vt[(256 + (i >> 6)) * 72 + (i & 63)] = (i >> 6) == 0 ? (bf16_t)0x3F80 : (bf16_t)0;
        }
        __syncthreads();
        const int nvt = wid == 0 ? 3 : 2;
        for (int vi = 0; vi < nvt; ++vi) {
            const int vt = vi < 2 ? wid * 2 + vi : 16;
            f32x4 acc[8];
#pragma unroll
            for (int dt = 0; dt < 8; ++dt) acc[dt] = (f32x4){0.f, 0.f, 0.f, 0.f};
#pragma unroll
            for (int ks = 0; ks < 2; ++ks) {
                const bf16x8 bf = *(const bf16x8*)(Vt + (vt * 16 + fr) * 72 + ks * 32 + fq * 8);
#pragma unroll
                for (int dt = 0; dt < 8; ++dt) {
                    const bf16x8 af = *(const bf16x8*)(Kt + (dt * 16 + fr) * 72 + ks * 32 + fq * 8);
                    acc[dt] = __builtin_amdgcn_mfma_f32_16x16x32_bf16(af, bf, acc[dt], 0, 0, 0);
                }
            }
            const int v = vt * 16 + fr;
            if (v <= 256) {
#pragma unroll
                for (int dt = 0; dt < 8; ++dt) *(f32x4*)(p.DC + ((size_t)task * 272 + v) * 128 + dt * 16 + fq * 4) = acc[dt];
            }
        }
    }
}

DEVI void stage_mlstm_scan(const P& p, int bid, int nblk) {
    const int nthr = 512;
    for (int e = bid * nthr + tid_opq(); e < 16 * 257 * 32; e += nblk * nthr) {
        const int bh = e / (257 * 32), r = e % (257 * 32), v = r >> 5, d = (r & 31) * 4;
        f32x4 C = {0.f, 0.f, 0.f, 0.f};
        const float* ac = p.ACOEF + bh * 64; const float* sc = p.SCL + bh * 64;
        const size_t base = ((size_t)(bh * 64) * 272 + v) * 128 + d, cstride = (size_t)272 * 128;
#pragma unroll 1
        for (int c0 = 0; c0 < 64; c0 += 8) {
            f32x4 dc[8];
#pragma unroll
            for (int i = 0; i < 8; ++i) dc[i] = __builtin_nontemporal_load((const f32x4*)(p.DC + base + (size_t)(c0 + i) * cstride));
#pragma unroll
            for (int i = 0; i < 8; ++i) {
                u32x2 o; o.x = pack2(C[0], C[1]); o.y = pack2(C[2], C[3]);
                *(u32x2*)(p.CPT + base + (size_t)(c0 + i) * cstride) = o;
                C = C * ac[c0 + i] + dc[i] * sc[c0 + i];
            }
        }
        if (v < 256) {
#pragma unroll
            for (int k = 0; k < 4; ++k) p.out[O_PC + ((size_t)bh * 128 + d + k) * 256 + v] = C[k];
        } else *(f32x4*)(p.out + O_PN + bh * 128 + d) = C;
    }
}

constexpr int MO_Q = 0, MO_K = 64 * 272, MO_VT = MO_K + 64 * 272, MO_P = MO_VT + 272 * 144, MO_SC = MO_P + 64 * 144, MO_HS = MO_SC + 2048, MO_LDS = MO_HS + 64 * 256 * 4;
static_assert(MO_LDS <= 152 * 1024, "lds");
DEVI void stage_mlstm_out(const P& p, char* smem, int bid, int nblk) {
    const int tid = tid_opq(), lane = tid & 63, wid = tid >> 6, fr = lane & 15, fq = lane >> 4;
    bf16_t* Qs = (bf16_t*)(smem + MO_Q);
    bf16_t* Ks = (bf16_t*)(smem + MO_K);
    bf16_t* Vt = (bf16_t*)(smem + MO_VT);
    bf16_t* Ps = (bf16_t*)(smem + MO_P);
    float* sc = (float*)(smem + MO_SC);
    float* rowt = sc; float* colt = sc + 64; float* wint = sc + 128; float* emt = sc + 192; float* den = sc + 256;
    float* hs = (float*)(smem + MO_HS);
    for (int task = bid; task < 1024; task += nblk) {
        const int bh = task >> 6, c = task & 63, b = bh >> 2, h = bh & 3;
        const size_t row0 = (size_t)b * 4096 + c * 64;
        __syncthreads();
        {
            for (int i = tid; i < 64 * 16; i += 512) {
                const int t = i >> 4, ch = i & 15;
                *(u32x4*)(Qs + t * 136 + ch * 8) = *(const u32x4*)(p.PROJ + (row0 + t) * PS + C_AQ + h * 128 + ch * 8);
                *(u32x4*)(Ks + t * 136 + ch * 8) = *(const u32x4*)(p.PROJ + (row0 + t) * PS + C_AK + h * 128 + ch * 8);
            }
            const int sidx = tid & 63, ch = tid >> 6;
#pragma unroll
            for (int q4 = 0; q4 < 4; ++q4) {
                const u32x4 vv = *(const u32x4*)(p.PROJ + (row0 + sidx) * PS + C_AV + h * 256 + q4 * 64 + ch * 8);
#pragma unroll
                for (int e = 0; e < 4; ++e) {
                    Vt[(q4 * 64 + ch * 8 + e * 2) * 72 + sidx] = (bf16_t)(vv[e] & 0xFFFFu);
                    Vt[(q4 * 64 + ch * 8 + e * 2 + 1) * 72 + sidx] = (bf16_t)(vv[e] >> 16);
                }
            }
            for (int i = tid; i < 16 * 64; i += 512) Vt[(256 + (i >> 6)) * 72 + (i & 63)] = (i >> 6) == 0 ? (bf16_t)0x3F80 : (bf16_t)0;
            if (wid == 0) {
                const float bc = p.BCUM[bh * 4096 + c * 64 + lane], ip = p.SM[(row0 + lane) * 64 + h];
                const float mprev = p.MPREV[task];
                float pm = ip - bc;
#pragma unroll
                for (int o = 1; o < 64; o <<= 1) { const float t = __shfl_up(pm, o); if (lane >= o) pm = fmaxf(pm, t); }
                const float mt = fmaxf(bc + mprev, bc + pm);
                rowt[lane] = bc - mt; colt[lane] = ip - bc; wint[lane] = __expf(bc + mprev - mt); emt[lane] = __expf(-mt);
            }
        }
        __syncthreads();
        {
            const int tt = wid >> 1;
#pragma unroll
            for (int si = 0; si < 2; ++si) {
                const int st = (wid & 1) * 2 + si;
                f32x4 acc = (f32x4){0.f, 0.f, 0.f, 0.f};
                if (st <= tt) {
#pragma unroll
                    for (int ks = 0; ks < 4; ++ks) {
                        const bf16x8 af = *(const bf16x8*)(Qs + (tt * 16 + fr) * 136 + ks * 32 + fq * 8);
                        const bf16x8 bf = *(const bf16x8*)(Ks + (st * 16 + fr) * 136 + ks * 32 + fq * 8);
                        acc = __builtin_amdgcn_mfma_f32_16x16x32_bf16(af, bf, acc, 0, 0, 0);
                    }
                }
                const int s = st * 16 + fr; const float ct = colt[s];
#pragma unroll
                for (int r = 0; r < 4; ++r) {
                    const int t = tt * 16 + fq * 4 + r;
                    const float pv = (s <= t) ? acc[r] * __expf(rowt[t] + ct) : 0.f;
                    Ps[t * 72 + s] = f2bf(pv);
                }
            }
        }
        __syncthreads();
        {
            const bf16_t* cpt = p.CPT + (size_t)task * 272 * 128;
            f32x4 acc[4][2];
#pragma unroll
            for (int tt = 0; tt < 4; ++tt)
#pragma unroll
                for (int vi = 0; vi < 2; ++vi) acc[tt][vi] = (f32x4){0.f, 0.f, 0.f, 0.f};
            f32x4 accd = (f32x4){0.f, 0.f, 0.f, 0.f};
            bf16x8 cb[4][2], cd[4];
#pragma unroll
            for (int ks = 0; ks < 4; ++ks) {
#pragma unroll
                for (int vi = 0; vi < 2; ++vi) cb[ks][vi] = *(const bf16x8*)(cpt + (size_t)((wid * 2 + vi) * 16 + fr) * 128 + ks * 32 + fq * 8);
                cd[ks] = *(const bf16x8*)(cpt + (size_t)(256 + fr) * 128 + ks * 32 + fq * 8);
            }
#pragma unroll
            for (int ks = 0; ks < 4; ++ks) {
                bf16x8 af[4];
#pragma unroll
                for (int tt = 0; tt < 4; ++tt) af[tt] = *(const bf16x8*)(Qs + (tt * 16 + fr) * 136 + ks * 32 + fq * 8);
#pragma unroll
                for (int vi = 0; vi < 2; ++vi) {
#pragma unroll
                    for (int tt = 0; tt < 4; ++tt) acc[tt][vi] = __builtin_amdgcn_mfma_f32_16x16x32_bf16(af[tt], cb[ks][vi], acc[tt][vi], 0, 0, 0);
                }
                if (wid < 4) {
                    const bf16x8 a2 = *(const bf16x8*)(Qs + (wid * 16 + fr) * 136 + ks * 32 + fq * 8);
                    accd = __builtin_amdgcn_mfma_f32_16x16x32_bf16(a2, cd[ks], accd, 0, 0, 0);
                }
            }
#pragma unroll
            for (int tt = 0; tt < 4; ++tt) {
                const f32x4 wv = *(const f32x4*)(wint + tt * 16 + fq * 4);
#pragma unroll
                for (int vi = 0; vi < 2; ++vi) acc[tt][vi] *= wv;
            }
            if (wid < 4) accd *= *(const f32x4*)(wint + wid * 16 + fq * 4);
#pragma unroll
            for (int ks = 0; ks < 2; ++ks) {
                bf16x8 af[4];
#pragma unroll
                for (int tt = 0; tt < 4; ++tt) af[tt] = *(const bf16x8*)(Ps + (tt * 16 + fr) * 72 + ks * 32 + fq * 8);
#pragma unroll
                for (int vi = 0; vi < 2; ++vi) {
                    const bf16x8 bf = *(const bf16x8*)(Vt + ((wid * 2 + vi) * 16 + fr) * 72 + ks * 32 + fq * 8);
#pragma unroll
                    for (int tt = 0; tt < 4; ++tt) acc[tt][vi] = __builtin_amdgcn_mfma_f32_16x16x32_bf16(af[tt], bf, acc[tt][vi], 0, 0, 0);
                }
                if (wid < 4) {
                    const bf16x8 bf = *(const bf16x8*)(Vt + (256 + fr) * 72 + ks * 32 + fq * 8);
                    const bf16x8 a2 = *(const bf16x8*)(Ps + (wid * 16 + fr) * 72 + ks * 32 + fq * 8);
                    accd = __builtin_amdgcn_mfma_f32_16x16x32_bf16(a2, bf, accd, 0, 0, 0);
                }
            }
            if (wid < 4 && fr == 0) *(f32x4*)(den + wid * 16 + fq * 4) = accd;
            __syncthreads();
#pragma unroll
            for (int tt = 0; tt < 4; ++tt) {
                const f32x4 dv = *(const f32x4*)(den + tt * 16 + fq * 4), ev = *(const f32x4*)(emt + tt * 16 + fq * 4);
#pragma unroll
                for (int vi = 0; vi < 2; ++vi)
#pragma unroll
                    for (int r = 0; r < 4; ++r) hs[(tt * 16 + fq * 4 + r) * 256 + (wid * 2 + vi) * 16 + fr] = acc[tt][vi][r] / fmaxf(fabsf(dv[r]), ev[r]);
            }
        }
        __syncthreads();
        u32x2 ovs[8];
#pragma unroll
        for (int rr = 0; rr < 8; ++rr) ovs[rr] = *(const u32x2*)(p.PROJ + (row0 + wid * 8 + rr) * PS + C_AO + h * 256 + lane * 4);
        const f32x4 gg = *(const f32x4*)(p.norm_a_g + h * 256 + lane * 4);
#pragma unroll
        for (int rr = 0; rr < 8; ++rr) {
            const int t = wid * 8 + rr;
            const f32x4 x = *(const f32x4*)(hs + t * 256 + lane * 4);
            const float mean = wave_sum(x[0] + x[1] + x[2] + x[3]) * (1.f / 256.f);
            float q = 0.f;
#pragma unroll
            for (int k = 0; k < 4; ++k) q += (x[k] - mean) * (x[k] - mean);
            const float rs = rsqrtf(wave_sum(q) * (1.f / 256.f) + LN_EPS);
            const u32x2 ov = ovs[rr];
            const float o4[4] = {__uint_as_float(ov.x << 16), __uint_as_float(ov.x & 0xFFFF0000u), __uint_as_float(ov.y << 16), __uint_as_float(ov.y & 0xFFFF0000u)};
            float y[4];
#pragma unroll
            for (int k = 0; k < 4; ++k) y[k] = (x[k] - mean) * rs * gg[k] * sigmoidf_(o4[k]);
            u32x2 o2; o2.x = pack2(y[0], y[1]); o2.y = pack2(y[2], y[3]);
            *(u32x2*)(p.YA + (row0 + t) * 1024 + h * 256 + lane * 4) = o2;
        }
    }
}

DEVI void stage_mlstm_sample(const P& p, char* smem, int bid, int nblk) {
    float* qs = (float*)smem;
    float* ks = qs + 512;
    float* vs = ks + 512;
    float* part = vs + 1024;
    float* hs = part + 2048;
    float* sc = hs + 1024;
    float* bc = sc; float* ip = sc + 4; float* mt = sc + 8; float* wint = sc + 12; float* emt = sc + 16; float* ww = sc + 20; float* den = sc + 24;
    float* Pm = sc + 32;
    float* misc = sc + 48;
    const int tid = tid_opq(), lane = tid & 63, wid = tid >> 6;
    for (int task = bid; task < 512; task += nblk) {
        const int b = task >> 2, h = task & 3;
        const size_t row0 = (size_t)NTP + b * 4;
        __syncthreads();
        { const int t = tid >> 7, d = tid & 127;
          qs[tid] = bf2f(p.PROJ[(row0 + t) * PS + C_AQ + h * 128 + d]);
          ks[tid] = bf2f(p.PROJ[(row0 + t) * PS + C_AK + h * 128 + d]); }
        for (int idx = tid; idx < 1024; idx += 512) { const int t = idx >> 8, v = idx & 255; vs[idx] = bf2f(p.PROJ[(row0 + t) * PS + C_AV + h * 256 + v]); }
        if (tid == 0) {
            const float m0 = p.state_m[task];
            float cs = 0.f;
            for (int t = 0; t < 4; ++t) { cs += logsigmoidf_(p.SM[(row0 + t) * 64 + 4 + h]); bc[t] = cs; ip[t] = p.SM[(row0 + t) * 64 + h]; }
            for (int t = 0; t < 4; ++t) {
                float mx = bc[t] + m0;
                for (int s = 0; s <= t; ++s) mx = fmaxf(mx, bc[t] - bc[s] + ip[s]);
                mt[t] = mx; wint[t] = __expf(bc[t] + m0 - mx); emt[t] = __expf(-mx);
            }
            const float bend = bc[3];
            float mnew = bend + m0;
            for (int s = 0; s < 4; ++s) mnew = fmaxf(mnew, bend - bc[s] + ip[s]);
            misc[0] = __expf(bend + m0 - mnew);
            for (int s = 0; s < 4; ++s) ww[s] = __expf(bend - bc[s] + ip[s] - mnew);
            p.out[O_SM + task] = mnew;
        }
        __syncthreads();
        if (tid < 16) {
            const int t = tid >> 2, s = tid & 3;
            float a = 0.f;
            if (s <= t) { for (int d = 0; d < 128; ++d) a += qs[t * 128 + d] * ks[s * 128 + d]; a *= __expf(bc[t] - bc[s] + ip[s] - mt[t]); }
            Pm[tid] = a;
        }
        __syncthreads();
        if (tid < 4) {
            const int t = tid; float qn = 0.f;
            for (int d = 0; d < 128; ++d) qn += qs[t * 128 + d] * p.state_n[(size_t)task * 128 + d];
            den[t] = wint[t] * qn + Pm[t * 4] + Pm[t * 4 + 1] + Pm[t * 4 + 2] + Pm[t * 4 + 3];
        }
        const float a = misc[0];
        if (tid >= 128 && tid < 256) {
            const int d = tid - 128;
            float n = a * p.state_n[(size_t)task * 128 + d];
            for (int s = 0; s < 4; ++s) n += ww[s] * ks[s * 128 + d];
            p.out[O_SN + (size_t)task * 128 + d] = n;
        }
        {
            const int v = tid & 255, dh = tid >> 8;
            float acc[4] = {0.f, 0.f, 0.f, 0.f};
            float wv[4];
#pragma unroll
            for (int s = 0; s < 4; ++s) wv[s] = ww[s] * vs[s * 256 + v];
            for (int d0 = dh * 64; d0 < dh * 64 + 64; d0 += 16) {
                float c0[16];
#pragma unroll
                for (int i = 0; i < 16; ++i) c0[i] = __builtin_nontemporal_load(p.state_C + ((size_t)task * 128 + d0 + i) * 256 + v);
#pragma unroll
                for (int i = 0; i < 16; ++i) {
                    const int d = d0 + i;
#pragma unroll
                    for (int t = 0; t < 4; ++t) acc[t] += qs[t * 128 + d] * c0[i];
                    float cn = a * c0[i];
#pragma unroll
                    for (int s = 0; s < 4; ++s) cn += ks[s * 128 + d] * wv[s];
                    __builtin_nontemporal_store(cn, p.out + O_SC + ((size_t)task * 128 + d) * 256 + v);
                }
            }
#pragma unroll
            for (int t = 0; t < 4; ++t) part[(dh * 4 + t) * 256 + v] = acc[t];
        }
        __syncthreads();
        if (tid < 256) {
            const int v = tid;
#pragma unroll
            for (int t = 0; t < 4; ++t) {
                float num = wint[t] * (part[t * 256 + v] + part[(4 + t) * 256 + v]);
#pragma unroll
                for (int s = 0; s < 4; ++s) num += Pm[t * 4 + s] * vs[s * 256 + v];
                hs[t * 256 + v] = num / fmaxf(fabsf(den[t]), emt[t]);
            }
        }
        __syncthreads();
        if (wid < 4) {
            const int t = wid;
            const f32x4 x = *(const f32x4*)(hs + t * 256 + lane * 4);
            const float mean = wave_sum(x[0] + x[1] + x[2] + x[3]) * (1.f / 256.f);
            float q = 0.f;
#pragma unroll
            for (int k = 0; k < 4; ++k) q += (x[k] - mean) * (x[k] - mean);
            const float rs = rsqrtf(wave_sum(q) * (1.f / 256.f) + LN_EPS);
            float y[4];
#pragma unroll
            for (int k = 0; k < 4; ++k) {
                const int vi = lane * 4 + k;
                const float o = bf2f(p.PROJ[(row0 + t) * PS + C_AO + h * 256 + vi]);
                y[k] = (x[k] - mean) * rs * p.norm_a_g[h * 256 + vi] * sigmoidf_(o);
            }
            u32x2 o2; o2.x = pack2(y[0], y[1]); o2.y = pack2(y[2], y[3]);
            *(u32x2*)(p.YA + (row0 + t) * 1024 + h * 256 + lane * 4) = o2;
        }
    }
}

constexpr int CP_ABUF = 33280, CP_WBUF = 18432, CP_A = 0, CP_W = 2 * CP_ABUF, CP_LDS = CP_W + 2 * CP_WBUF;
constexpr int CP_AROW = 1024 + 8;
DEVI void stage_compress(const P& p, char* smem, int bid, int nblk, int only = -1) {
    const int tid = tid_opq(), lane = tid & 63, wid = tid >> 6, fr = lane & 15, fq = lane >> 4;
    const int kv = wid & 1, rt = wid >> 1;
    const int n_it = only >= 0 ? 1 : (256 + nblk - 1) / nblk + (16 + nblk - 1) / nblk;
    for (int it = 0; it < n_it; ++it) {
        const int ns_it = (256 + nblk - 1) / nblk;
        const int task = only >= 0 ? only : it < ns_it ? bid + it * nblk : 256 + (nblk - 1 - bid) + (it - ns_it) * nblk;
        if (only < 0 && (task >= 272 || (it < ns_it && task >= 256))) continue;
        const bool prompt = task >= 256;
        const int rowbytes = prompt ? 1024 : 2048, npieces = prompt ? 2 : 4;
        const char* src[4]; int dsto[4];
#pragma unroll
        for (int q = 0; q < 4; ++q) {
            const int off = q * 8192 + tid * 16, r = off / rowbytes, cb = off % rowbytes;
            if (prompt) { const int blk = (task - 256) * 16 + (r & 15); src[q] = (const char*)(p.PROJ + (size_t)blk * 64 * PS + C_CMP) + cb; dsto[q] = (r & 15) * CP_AROW * 2 + cb; }
            else { const int gb = task * 16 + r, b = gb >> 5, n = gb & 31; const int page = p.page_table[b * 16 + (n >> 1)];
                   src[q] = (const char*)(p.cache_cmp + ((size_t)page * 128 + (n & 1) * 64) * 512) + cb; dsto[q] = r * CP_AROW * 2 + (cb >> 1); }
        }
        const size_t sstride = prompt ? (size_t)PS * 2 : 2048;
        const char* wsrc[2]; int wdst[2];
#pragma unroll
        for (int q = 0; q < 2; ++q) { const int idx = q * 512 + tid, row = idx >> 3, ch = idx & 7; wsrc[q] = (const char*)(p.WCT + (size_t)row * 4096) + ch * 16; wdst[q] = row * 144 + ch * 16; }
        f32x4 acc[4];
#pragma unroll
        for (int nt = 0; nt < 4; ++nt) acc[nt] = (f32x4){0.f, 0.f, 0.f, 0.f};
        f32x4 ra0[4], ra1[4]; u32x4 rw0[2], rw1[2];
        auto issue = [&](int l, f32x4 (&ra)[4], u32x4 (&rw)[2]) {
#pragma unroll
            for (int q = 0; q < 4; ++q) if (q < npieces) ra[q] = prompt ? *(const f32x4*)(src[q] + (size_t)l * sstride) : __builtin_nontemporal_load((const f32x4*)(src[q] + (size_t)l * sstride));
#pragma unroll
            for (int q = 0; q < 2; ++q) rw[q] = *(const u32x4*)(wsrc[q] + l * 128);
        };
        auto commit = [&](int buf, const f32x4 (&ra)[4], const u32x4 (&rw)[2]) {
            char* ab = smem + CP_A + buf * CP_ABUF; char* wbuf = smem + CP_W + buf * CP_WBUF;
#pragma unroll
            for (int q = 0; q < 4; ++q) if (q < npieces) {
                if (prompt) *(f32x4*)(ab + dsto[q]) = ra[q];
                else { u32x2 o; o.x = pack2(ra[q][0], ra[q][1]); o.y = pack2(ra[q][2], ra[q][3]); *(u32x2*)(ab + dsto[q]) = o; }
            }
#pragma unroll
            for (int q = 0; q < 2; ++q) *(u32x4*)(wbuf + wdst[q]) = rw[q];
        };
        auto consume = [&](int buf) {
            const char* ab = smem + CP_A + buf * CP_ABUF; const char* wbuf = smem + CP_W + buf * CP_WBUF;
            const bf16_t* arow = (const bf16_t*)ab + (rt * 4 + (fr >> 2)) * CP_AROW + kv * 256 + (fr & 3) * 64 + fq * 8;
#pragma unroll
            for (int hf = 0; hf < 2; ++hf) {
                const bf16x8 a = *(const bf16x8*)(arow + hf * 32);
#pragma unroll
                for (int nt = 0; nt < 4; ++nt) {
                    const bf16x8 bfrag = *(const bf16x8*)(wbuf + (kv * 64 + nt * 16 + fr) * 144 + hf * 64 + fq * 16);
                    acc[nt] = __builtin_amdgcn_mfma_f32_16x16x32_bf16(a, bfrag, acc[nt], 0, 0, 0);
                }
            }
        };
        __syncthreads();
        issue(0, ra0, rw0); issue(1, ra1, rw1); commit(0, ra0, rw0); issue(2, ra0, rw0);
        __syncthreads();
#pragma unroll 1
        for (int l = 0; l < 64; l += 2) {
            consume(0);
            commit(1, ra1, rw1);
            if (l + 3 < 64) issue(l + 3, ra1, rw1);
            __syncthreads();
            consume(1);
            if (l + 2 < 64) commit(0, ra0, rw0);
            if (l + 4 < 64) issue(l + 4, ra0, rw0);
            __syncthreads();
        }
        {
            const int ob = prompt ? (task - 256) * 16 + rt * 4 + fq : 256 + task * 16 + rt * 4 + fq;
#pragma unroll
            for (int nt = 0; nt < 4; ++nt) {
                const float bias = p.PW[kv * 64 + nt * 16 + fr];
#pragma unroll
                for (int r = 0; r < 4; ++r) p.KC[(size_t)ob * 512 + kv * 256 + r * 64 + nt * 16 + fr] = acc[nt][r] + bias;
            }
        }
    }
}

typedef float f32x16 __attribute__((ext_vector_type(16)));
typedef short s16x4 __attribute__((ext_vector_type(4)));
typedef __attribute__((address_space(3))) const char* lds_cptr;
#define MFMA32(a, b, c) __builtin_amdgcn_mfma_f32_32x32x16_bf16(a, b, c, 0, 0, 0)
DEVI int crow(int r, int hi) { return (r & 3) + 8 * (r >> 2) + 4 * hi; }
DEVI unsigned cvtpk(float lo, float hi) { return pack2(lo, hi); }
DEVI s16x4 vtr(lds_cptr p) { return __builtin_bit_cast(s16x4, __builtin_amdgcn_ds_read_tr16_b64_v4i16((__attribute__((address_space(3))) s16x4*)p)); }
DEVI float half_max(float m) { auto rr = __builtin_amdgcn_permlane32_swap(__float_as_uint(m), __float_as_uint(m), false, false); return fmaxf(__uint_as_float(rr[0]), __uint_as_float(rr[1])); }
DEVI float half_sum(float m) { auto rr = __builtin_amdgcn_permlane32_swap(__float_as_uint(m), __float_as_uint(m), false, false); return __uint_as_float(rr[0]) + __uint_as_float(rr[1]); }

struct BlkDesc { const char* k; int stride_bytes; int f32; int count; int pos0; };
DEVI void blk_load(const BlkDesc& d, int tid, u32x4& rk, u32x4& rv) {
    const int key = tid & 63, chunk = tid >> 6;
    rk = (u32x4){0u, 0u, 0u, 0u}; rv = rk;
    if (key < d.count) {
        const char* kr = d.k + (size_t)key * d.stride_bytes;
        if (d.f32) {
            const f32x4* s1 = (const f32x4*)(kr + chunk * 32); const f32x4* s2 = (const f32x4*)(kr + 1024 + chunk * 32);
            rk = pack8f(s1[0], s1[1]); rv = pack8f(s2[0], s2[1]);
        } else { rk = *(const u32x4*)(kr + chunk * 16); rv = *(const u32x4*)(kr + 512 + chunk * 16); }
    }
}
DEVI void blk_store(char* kimg, char* vimg, int tid, const u32x4& rk, const u32x4& rv) {
    const int key = tid & 63, chunk = tid >> 6;
    *(u32x4*)(kimg + chunk * 1024 + key * 16) = rk;
    *(u32x4*)(vimg + (chunk >> 2) * 4096 + key * 64 + (chunk & 3) * 16) = rv;
}

DEVI void attn_tile(const char* kimg, const char* vimg, const bf16x8 (&qr)[4], float& m2, float& lsum, f32x16& o0, f32x16& o1, f32x16& s0, f32x16& s1,
                    float sl, float bb, int lh, int ll, bool fast, float* wsf_hi  , float* wsf_r  , int lane) {
    const int r32 = lane & 31, hi = lane >> 5;
    const f32x16 z = {};
    s0 = z; s1 = z;
    {
        const char* kp = kimg + hi * 1024 + r32 * 16;
#pragma unroll
        for (int d0 = 0; d0 < 4; ++d0) {
            const bf16x8 k0 = *(const bf16x8*)(kp + d0 * 2048), k1 = *(const bf16x8*)(kp + d0 * 2048 + 512);
            s0 = MFMA32(k0, qr[d0], s0); s1 = MFMA32(k1, qr[d0], s1);
        }
    }
    float mx = -1e30f;
    if (fast) {
#pragma unroll
        for (int r = 0; r < 16; ++r) {
            const int c = (r & 3) + 8 * (r >> 2);
            s0[r] = fmaf(s0[r], 1.4426950408889634f, fmaf(sl, (float)c, bb)); s1[r] = fmaf(s1[r], 1.4426950408889634f, fmaf(sl, (float)(c + 32), bb));
            mx = fmaxf(mx, fmaxf(s0[r], s1[r]));
        }
    } else {
#pragma unroll
        for (int r = 0; r < 16; ++r) {
            const int c = (r & 3) + 8 * (r >> 2);
            const float t0 = fmaf(s0[r], 1.4426950408889634f, fmaf(sl, (float)c, bb)), t1 = fmaf(s1[r], 1.4426950408889634f, fmaf(sl, (float)(c + 32), bb));
            s0[r] = (c <= lh && c > ll) ? t0 : -INFINITY; s1[r] = (c + 32 <= lh && c + 32 > ll) ? t1 : -INFINITY;
            mx = fmaxf(mx, fmaxf(s0[r], s1[r]));
        }
    }
    mx = half_max(mx);
    const float mnew = fmaxf(m2, mx);
    const float f = __builtin_amdgcn_exp2f(m2 - mnew);
    m2 = mnew;
    float ps = 0.f;
#pragma unroll
    for (int r = 0; r < 16; ++r) { s0[r] = __builtin_amdgcn_exp2f(s0[r] - mnew); s1[r] = __builtin_amdgcn_exp2f(s1[r] - mnew); ps += s0[r] + s1[r]; }
    lsum = lsum * f + ps;
    if (__any(f != 1.f)) {
        if (hi == 0) *wsf_r = f;
        asm volatile("s_waitcnt lgkmcnt(0)" ::: "memory");
#pragma unroll
        for (int a = 0; a < 4; ++a) {
            const f32x4 fv = *(const f32x4*)(wsf_hi + 8 * a);
#pragma unroll
            for (int k = 0; k < 4; ++k) { o0[4 * a + k] *= fv[k]; o1[4 * a + k] *= fv[k]; }
        }
        asm volatile("s_waitcnt lgkmcnt(0)" ::: "memory");
    }
    u32x4 pw[4];
#pragma unroll
    for (int k = 0; k < 4; ++k) { pw[0][k] = cvtpk(s0[2 * k], s0[2 * k + 1]); pw[1][k] = cvtpk(s0[8 + 2 * k], s0[8 + 2 * k + 1]); pw[2][k] = cvtpk(s1[2 * k], s1[2 * k + 1]); pw[3][k] = cvtpk(s1[8 + 2 * k], s1[8 + 2 * k + 1]); }
    const lds_cptr vp = (lds_cptr)vimg + ((lane >> 4) & 1) * 32 + (lane & 3) * 8 + (4 * hi + ((lane & 15) >> 2)) * 64;
#pragma unroll
    for (int i = 0; i < 8; ++i) {
        const s16x4 lo = vtr(vp + ((i >> 2) * 4096 + (i & 3) * 1024)), hh = vtr(vp + ((i >> 2) * 4096 + (i & 3) * 1024 + 512));
        const bf16x8 vf = (bf16x8){lo[0], lo[1], lo[2], lo[3], hh[0], hh[1], hh[2], hh[3]};
        const bf16x8 pf = __builtin_bit_cast(bf16x8, pw[i & 3]);
        if (i < 4) o0 = MFMA32(pf, vf, o0); else o1 = MFMA32(pf, vf, o1);
    }
}

constexpr int NSA_KV0 = 0, NSA_KV1 = 16384, NSA_WSF = 32768, NSA_IMP = NSA_WSF + 2048, NSA_SEL = NSA_IMP + 16384, NSA_LIST = NSA_SEL + 512, NSA_OST = NSA_LIST + 256, NSA_YAC = NSA_OST + 32768, NSA_LDS = NSA_YAC + 65536;
static_assert(NSA_LDS <= 152 * 1024, "lds");

DEVI BlkDesc nsa_desc(const P& p, bool prompt, int b, int g, int branch, int j) {
    BlkDesc d;
    if (prompt) {
        if (branch == 0) { d.k = (const char*)(p.KC + ((size_t)(b * 64) * 512 + g * 64)); d.stride_bytes = 2048; d.f32 = 1; d.count = 64; d.pos0 = 0; }
        else { d.k = (const char*)(p.PROJ + ((size_t)b * 4096 + j * 64) * PS + (branch == 1 ? C_SLC : C_WIN) + g * 64); d.stride_bytes = PS * 2; d.f32 = 0; d.count = 64; d.pos0 = j * 64; }
    } else {
        if (branch == 0) { d.k = (const char*)(p.KC + ((size_t)(256 + b * 32) * 512 + g * 64)); d.stride_bytes = 2048; d.f32 = 1; d.count = 32; d.pos0 = 0; }
        else if (branch == 1 && j < 32) { const int page = p.page_table[b * 16 + (j >> 1)]; d.k = (const char*)(p.cache_slc + ((size_t)page * 128 + (j & 1) * 64) * 512 + g * 64); d.stride_bytes = 2048; d.f32 = 1; d.count = 64; d.pos0 = j * 64; }
        else if (branch == 2 && j < 8) { d.k = (const char*)(p.cache_win + ((size_t)b * 512 + j * 64) * 512 + g * 64); d.stride_bytes = 2048; d.f32 = 1; d.count = 64; d.pos0 = 1536 + j * 64; }
        else { d.k = (const char*)(p.PROJ + ((size_t)NTP + b * 4) * PS + (branch == 1 ? C_SLC : C_WIN) + g * 64); d.stride_bytes = PS * 2; d.f32 = 0; d.count = 4; d.pos0 = 2048; }
    }
    return d;
}

constexpr int NS_IMG = 0, NS_WSF = 131072, NS_IMP = NS_WSF + 2048, NS_SEL = NS_IMP + 2048, NS_LIST = NS_SEL + 64, NS_YC = NS_LIST + 64, NS_PM = NS_YC + 4096, NS_Q = NS_PM + 2048, NS_LDS = NS_Q + 4096;
static_assert(NS_LDS <= 152 * 1024, "lds");
DEVI void wave_stage_block(const BlkDesc& d, char* kimg, char* vimg, int lane, float* sw = nullptr, int sw_row_min = 0) {
    asm volatile("" : "+v"(lane));
    const int rsub = lane >> 4, pc = lane & 15;
    if (d.f32) {
        auto ld = [&](int k, f32x4 (&x)[6]) {
            const int half = k / 3, i0 = (k % 3) * 6;
#pragma unroll
            for (int i = 0; i < 6; ++i) if (i0 + i < 16) { const int row = 4 * (i0 + i) + rsub; x[i] = row < d.count ? __builtin_nontemporal_load((const f32x4*)(d.k + (size_t)row * d.stride_bytes + half * 1024 + pc * 16)) : (f32x4){0.f, 0.f, 0.f, 0.f}; }
        };
        auto use = [&](int k, const f32x4 (&x)[6]) {
            const int half = k / 3, i0 = (k % 3) * 6;
#pragma unroll
            for (int i = 0; i < 6; ++i) if (i0 + i < 16) {
                const int row = 4 * (i0 + i) + rsub, c = pc >> 1;
                if (sw != nullptr && row >= sw_row_min && row < d.count) __builtin_nontemporal_store(x[i], (f32x4*)(sw + (size_t)row * 512 + half * 256) + pc);
                u32x2 o; o.x = pack2(x[i][0], x[i][1]); o.y = pack2(x[i][2], x[i][3]);
                if (half == 0) *(u32x2*)(kimg + c * 1024 + row * 16 + (pc & 1) * 8) = o;
                else *(u32x2*)(vimg + (c >> 2) * 4096 + row * 64 + (c & 3) * 16 + (pc & 1) * 8) = o;
            }
        };
        f32x4 xa[6], xb[6];
        ld(0, xa);
        ld(1, xb); __builtin_amdgcn_sched_barrier(0); use(0, xa);
        ld(2, xa); __builtin_amdgcn_sched_barrier(0); use(1, xb);
        ld(3, xb); __builtin_amdgcn_sched_barrier(0); use(2, xa);
        ld(4, xa); __builtin_amdgcn_sched_barrier(0); use(3, xb);
        ld(5, xb); __builtin_amdgcn_sched_barrier(0); use(4, xa);
        use(5, xb);
    } else {
        const int row = lane >> 3, c = lane & 7;
#pragma unroll
        for (int i = 0; i < 8; ++i) {
            const int rr = 8 * i + row;
            u32x4 kk = {0u, 0u, 0u, 0u}, vv = {0u, 0u, 0u, 0u};
            if (rr < d.count) { kk = *(const u32x4*)(d.k + (size_t)rr * d.stride_bytes + c * 16); vv = *(const u32x4*)(d.k + (size_t)rr * d.stride_bytes + 512 + c * 16); }
            *(u32x4*)(kimg + c * 1024 + rr * 16) = kk;
            *(u32x4*)(vimg + (c >> 2) * 4096 + rr * 64 + (c & 3) * 16) = vv;
        }
    }
    asm volatile("s_waitcnt lgkmcnt(0)" ::: "memory");
}

DEVI void nsa_sample_unit(const P& p, char* smem, int us) {
    const int tid = tid_opq(), lane = tid & 63, wid = tid >> 6, r32 = lane & 31, hi = lane >> 5;
    const int b = us >> 2, g = us & 3;
    const size_t rowbase = (size_t)NTP + b * 4;
    char* kimg = smem + NS_IMG + wid * 16384; char* vimg = kimg + 8192;
    float* wsf = (float*)(smem + NS_WSF) + wid * 64;
    float* impb = (float*)(smem + NS_IMP);
    unsigned long long* selm = (unsigned long long*)(smem + NS_SEL);
    unsigned char* blist = (unsigned char*)(smem + NS_LIST);
    float* ycmp = (float*)(smem + NS_YC);
    const int tokl = r32 >> 2, head = r32 & 3;
    const bool tok_ok = r32 < 16;
    const int qpos = 2048 + tokl;
    const float slope2 = alibi_slope(g * 4 + head) * 1.4426950408889634f;
    char* qsh = smem + NS_Q;
    int hi4 = 4 * hi; asm volatile("" : "+v"(hi4));
    float* wsf_hi = wsf + hi4; float* wsf_r = wsf + r32;
    f32x16 s0, s1;
    __syncthreads();
    if (wid == 0) {
        bf16x8 qr[4];
        {
            const bf16_t* qp = p.PROJ + (rowbase + (tok_ok ? tokl : 0)) * PS + C_BQ + (g * 4 + head) * 64 + hi * 8;
#pragma unroll
            for (int d0 = 0; d0 < 4; ++d0) {
                u32x4 v = *(const u32x4*)(qp + d0 * 16);
#pragma unroll
                for (int k = 0; k < 4; ++k) { const float lo = __uint_as_float(v[k] << 16) * 0.125f, hh = __uint_as_float(v[k] & 0xFFFF0000u) * 0.125f; v[k] = tok_ok ? ((__float_as_uint(lo) >> 16) | (__float_as_uint(hh) & 0xFFFF0000u)) : 0u; }
                qr[d0] = __builtin_bit_cast(bf16x8, v);
                *(u32x4*)(qsh + d0 * 1024 + lane * 16) = v;
            }
        }
        f32x16 o0 = {}, o1 = {}; float m2 = -1e30f, lsum = 0.f;
        const BlkDesc d = nsa_desc(p, false, b, g, 0, 0);
        wave_stage_block(d, kimg, vimg, lane);
        const int lh = 31 - hi4;
        const float sl = 64.f * slope2;
        attn_tile(kimg, vimg, qr, m2, lsum, o0, o1, s0, s1, sl, tok_ok ? sl * (float)(hi4 - 32) : -INFINITY, lh, -1000, false, wsf_hi, wsf_r, lane);
        const float lt = half_sum(lsum);
        const float inv = lt > 0.f ? 1.f / lt : 0.f;
        unsigned x[64];
#pragma unroll
        for (int r = 0; r < 16; ++r) {
#pragma unroll
            for (int n = 0; n < 2; ++n) {
                float a = (n == 0 ? s0[r] : s1[r]) * inv;
                a += __shfl_xor(a, 1); a += __shfl_xor(a, 2);
                const int j = (r & 3) + 8 * (r >> 2) + 32 * n + hi4;
                if (j == 32 || j == 0) a = 5.0f;
                if (j > 32) a = -2.0f;
                const unsigned u = __float_as_uint(a);
                const unsigned o = (u & 0x80000000u) ? ~u : (u | 0x80000000u);
                x[n * 16 + r] = (o & ~63u) | (unsigned)(63 - j);
            }
        }
        float fac = 0.f;
        if (tok_ok && lt > 0.f) fac = sigmoidf_(p.SM[(rowbase + tokl) * 64 + 8 + g * 4 + head]) / lt;
        if (hi == 0) *wsf_r = fac;
        asm volatile("s_waitcnt lgkmcnt(0)" ::: "memory");
#pragma unroll
        for (int a = 0; a < 2; ++a) {
            const f32x4 fv = *(const f32x4*)(wsf_hi + 8 * a);
#pragma unroll
            for (int k = 0; k < 4; ++k) { float* yp = ycmp + (8 * a + k + hi4) * 64 + r32; yp[0] = o0[4 * a + k] * fv[k]; yp[32] = o1[4 * a + k] * fv[k]; }
        }
        asm volatile("s_waitcnt lgkmcnt(0)" ::: "memory");
        {
            sort16_desc<0>(x); sort16_desc<16>(x);
            unsigned th[16], oth[16], fin[16];
            merge_top16(&x[0], &x[16], th);
#pragma unroll
            for (int i = 0; i < 16; ++i) { auto rr = __builtin_amdgcn_permlane32_swap(th[i], th[i], false, false); oth[i] = hi ? rr[0] : rr[1]; }
            merge_top16(th, oth, fin);
            unsigned long long mask = 0ull;
#pragma unroll
            for (int i = 0; i < 16; ++i) mask |= 1ull << (63u - (fin[i] & 63u));
            if (head == 0 && hi == 0 && r32 < 16) selm[r32 >> 2] = mask;
        }
        asm volatile("s_waitcnt lgkmcnt(0)" ::: "memory");
        {
            const unsigned long long u = selm[0] | selm[1] | selm[2] | selm[3];
            const int n = __builtin_popcountll(u);
            if ((u >> lane) & 1ull) blist[1 + __builtin_popcountll(u & ((1ull << lane) - 1ull))] = (unsigned char)(0x40 | lane);
            if (lane <= 8) blist[1 + n + lane] = (unsigned char)(0x80 | lane);
            if (lane == 0) blist[0] = (unsigned char)(n + 9);
        }
    }
    __syncthreads();
    const int nb = blist[0];
    const unsigned long long mysel = tok_ok ? selm[tokl] : 0ull;
    int nslc = 0;
    for (int i = 0; i < nb; ++i) nslc += (blist[1 + i] >> 6) == 1 ? 1 : 0;
    float so[16], ms, lst;
    float wo[16], mw, lwt;
#pragma unroll 1
    for (int pass = 0; pass < 2; ++pass) {
        f32x16 o0 = {}, o1 = {}; float m2 = -1e30f, lsum = 0.f;
        const int i0 = pass == 0 ? 0 : nslc, i1 = pass == 0 ? nslc : nb;
#pragma unroll 1
        for (int i = i0 + wid; i < i1; i += 8) {
            const int e = blist[1 + i], br = e >> 6, j = e & 63;
            const BlkDesc d = nsa_desc(p, false, b, g, br, j);
            float* sw = (br == 2 && j < 8) ? p.out + O_SWIN + ((size_t)b * 512 + j * 64) * 512 - 4 * 512 + g * 64 : nullptr;
            wave_stage_block(d, kimg, vimg, lane, sw, j == 0 ? 4 : 0);
            asm volatile("" : "+v"(hi4));
            const bool lsel = tok_ok && (br == 2 || ((mysel >> j) & 1ull));
            const int rel = qpos - d.pos0;
            const int lh = (rel < d.count - 1 ? rel : d.count - 1) - hi4;
            const int ll = (br == 2 ? rel - 512 : -1000) - hi4;
            const bool fast = __all(!lsel || (lh >= 59 && ll < 0));
            const float bb = lsel ? slope2 * (float)(hi4 + d.pos0 - 2048) : -INFINITY;
            bf16x8 qr[4];
#pragma unroll
            for (int d0 = 0; d0 < 4; ++d0) qr[d0] = *(const bf16x8*)(qsh + d0 * 1024 + lane * 16);
            attn_tile(kimg, vimg, qr, m2, lsum, o0, o1, s0, s1, slope2, bb, lh, ll, fast, wsf_hi, wsf_r, lane);
        }
        const float lt = half_sum(lsum);
        if (pass == 0) { ms = m2; lst = lt;
#pragma unroll
            for (int r = 0; r < 8; ++r) { so[r] = o0[r]; so[8 + r] = o1[r]; } }
        else { mw = m2; lwt = lt;
#pragma unroll
            for (int r = 0; r < 8; ++r) { wo[r] = o0[r]; wo[8 + r] = o1[r]; } }
    }
    {
        float* po = (float*)kimg;
        float* pm = (float*)(smem + NS_PM) + wid * 64;
        if (lane < 16) { pm[lane * 2] = ms; pm[lane * 2 + 1] = lst; pm[32 + lane * 2] = mw; pm[32 + lane * 2 + 1] = lwt; }
#pragma unroll
        for (int a = 0; a < 2; ++a)
#pragma unroll
            for (int k = 0; k < 4; ++k) {
                float* yp = po + (8 * a + k + hi4) * 64 + r32;
                yp[0] = so[4 * a + k]; yp[32] = so[8 + 4 * a + k]; yp[1024] = wo[4 * a + k]; yp[1024 + 32] = wo[8 + 4 * a + k];
            }
    }
    __syncthreads();
    {
        const int row = tid >> 5, dcol = tid & 31, tk = row >> 2, hd = row & 3;
        float res[2][2];
#pragma unroll
        for (int br = 0; br < 2; ++br) {
            float M = -1e30f;
#pragma unroll
            for (int w = 0; w < 8; ++w) M = fmaxf(M, ((const float*)(smem + NS_PM))[w * 64 + br * 32 + row * 2]);
            float L = 0.f, a0 = 0.f, a1 = 0.f;
#pragma unroll
            for (int w = 0; w < 8; ++w) {
                const float* pmw = (const float*)(smem + NS_PM) + w * 64 + br * 32 + row * 2;
                const float f = __builtin_amdgcn_exp2f(pmw[0] - M);
                const float* pow_ = (const float*)(smem + NS_IMG + w * 16384) + br * 1024 + row * 64 + dcol;
                L += pmw[1] * f; a0 += pow_[0] * f; a1 += pow_[32] * f;
            }
            const float gate = sigmoidf_(p.SM[(rowbase + tk) * 64 + 8 + (br + 1) * 16 + g * 4 + hd]);
            const float sc = L > 0.f ? gate / L : 0.f;
            res[br][0] = a0 * sc; res[br][1] = a1 * sc;
        }
        const float y0 = ycmp[row * 64 + dcol] + res[0][0] + res[1][0], y1 = ycmp[row * 64 + dcol + 32] + res[0][1] + res[1][1];
        bf16_t* yb = p.YB + (rowbase + tk) * 1024 + (g * 4 + hd) * 64;
        yb[dcol] = f2bf(y0); yb[dcol + 32] = f2bf(y1);
    }
}

constexpr int NP_KVB = 18432, NP_KV0 = 0, NP_KV1 = NP_KVB, NP_WSF = 2 * NP_KVB, NP_IMP = NP_WSF + 2048, NP_SEL = NP_IMP + 16384, NP_LIST = NP_SEL + 512, NP_YAC = NP_LIST + 256, NP_LDS = NP_YAC + 65536;
static_assert(NP_LDS <= 152 * 1024, "lds");
DEVI void blk_store_ext(const BlkDesc& d, int pstep, int poff, int t0, char* kimg, char* vimg, int tid, const u32x4& rk, const u32x4& rv) {
    const int key = tid & 63, chunk = tid >> 6;
    *(u32x4*)(kimg + chunk * 1024 + key * 16) = rk;
    *(u32x4*)(vimg + (chunk >> 2) * 4096 + key * 64 + (chunk & 3) * 16) = rv;
    if (chunk == 0) {
        const int rel = d.pos0 + key * pstep + poff - t0;
        const int phi = (rel >> 6) << 6, plo = rel & 63;
        const unsigned bh = pack2((float)phi, (float)phi), bl = pack2((float)plo, (float)plo);
        *(u32x4*)(kimg + 8 * 1024 + key * 16) = (u32x4){bh, bl, 0x00003F80u, 0u};
    }
}
DEVI void attn_tile2(const char* kimg, const char* vimg, const bf16x8 (&qr)[4], const bf16x8 qext, float& m, float& lsum, f32x16& o0, f32x16& o1, f32x16& s0, f32x16& s1,
                     int lh, int ll, bool fast, float* wsf_hi, float* wsf_r, int lane) {
    const int r32 = lane & 31, hi = lane >> 5;
    const f32x16 z = {};
    s0 = z; s1 = z;
    {
        const char* kp = kimg + hi * 1024 + r32 * 16;
#pragma unroll
        for (int d0 = 0; d0 < 5; ++d0) {
            const bf16x8 k0 = *(const bf16x8*)(kp + d0 * 2048), k1 = *(const bf16x8*)(kp + d0 * 2048 + 512);
            const bf16x8 qf = d0 < 4 ? qr[d0 < 4 ? d0 : 0] : qext;
            s0 = MFMA32(k0, qf, s0); s1 = MFMA32(k1, qf, s1);
        }
    }
    if (!fast) {
#pragma unroll
        for (int r = 0; r < 16; ++r) {
            const int c = (r & 3) + 8 * (r >> 2);
            s0[r] = (c <= lh && c > ll) ? s0[r] : -INFINITY; s1[r] = (c + 32 <= lh && c + 32 > ll) ? s1[r] : -INFINITY;
        }
    }
    float mx = fmaxf(s0[0], s1[0]);
#pragma unroll
    for (int r = 1; r < 16; ++r) mx = fmaxf(mx, fmaxf(s0[r], s1[r]));
    mx = half_max(mx);
    const float mnew = fmaxf(m, mx);
    const float f = __builtin_amdgcn_exp2f((m - mnew) * 1.4426950408889634f);
    m = mnew;
    const float nm2 = -mnew * 1.4426950408889634f;
    float ps = 0.f;
#pragma unroll
    for (int r = 0; r < 16; ++r) { s0[r] = __builtin_amdgcn_exp2f(fmaf(s0[r], 1.4426950408889634f, nm2)); s1[r] = __builtin_amdgcn_exp2f(fmaf(s1[r], 1.4426950408889634f, nm2)); ps += s0[r] + s1[r]; }
    lsum = lsum * f + ps;
    if (__any(f != 1.f)) {
        if (hi == 0) *wsf_r = f;
        asm volatile("s_waitcnt lgkmcnt(0)" ::: "memory");
#pragma unroll
        for (int a = 0; a < 4; ++a) {
            const f32x4 fv = *(const f32x4*)(wsf_hi + 8 * a);
#pragma unroll
            for (int k = 0; k < 4; ++k) { o0[4 * a + k] *= fv[k]; o1[4 * a + k] *= fv[k]; }
        }
        asm volatile("s_waitcnt lgkmcnt(0)" ::: "memory");
    }
    u32x4 pw[4];
#pragma unroll
    for (int k = 0; k < 4; ++k) { pw[0][k] = cvtpk(s0[2 * k], s0[2 * k + 1]); pw[1][k] = cvtpk(s0[8 + 2 * k], s0[8 + 2 * k + 1]); pw[2][k] = cvtpk(s1[2 * k], s1[2 * k + 1]); pw[3][k] = cvtpk(s1[8 + 2 * k], s1[8 + 2 * k + 1]); }
    const lds_cptr vp = (lds_cptr)vimg + ((lane >> 4) & 1) * 32 + (lane & 3) * 8 + (4 * hi + ((lane & 15) >> 2)) * 64;
#pragma unroll
    for (int i = 0; i < 8; ++i) {
        const s16x4 lo = vtr(vp + ((i >> 2) * 4096 + (i & 3) * 1024)), hh = vtr(vp + ((i >> 2) * 4096 + (i & 3) * 1024 + 512));
        const bf16x8 vf = (bf16x8){lo[0], lo[1], lo[2], lo[3], hh[0], hh[1], hh[2], hh[3]};
        const bf16x8 pf = __builtin_bit_cast(bf16x8, pw[i & 3]);
        if (i < 4) o0 = MFMA32(pf, vf, o0); else o1 = MFMA32(pf, vf, o1);
    }
}

DEVI void attn_tile3(const char* kA, const char* vA, const char* kB, const char* vB, const bf16x8 (&qr)[4], const bf16x8 qeA, const bf16x8 qeB, float& m, float& lsum,
                     f32x16& o0, f32x16& o1, int lhA, int llA, bool fastA, int lhB, int llB, bool fastB, float* wsf_hi, float* wsf_r, int lane) {
    const int r32 = lane & 31, hi = lane >> 5;
    f32x16 a0 = {}, a1 = {}, b0 = {}, b1 = {};
    {
        const char* kpa = kA + hi * 1024 + r32 * 16; const char* kpb = kB + hi * 1024 + r32 * 16;
#pragma unroll
        for (int d0 = 0; d0 < 5; ++d0) {
            const bf16x8 ka0 = *(const bf16x8*)(kpa + d0 * 2048), ka1 = *(const bf16x8*)(kpa + d0 * 2048 + 512);
            const bf16x8 kb0 = *(const bf16x8*)(kpb + d0 * 2048), kb1 = *(const bf16x8*)(kpb + d0 * 2048 + 512);
            const bf16x8 qa = d0 < 4 ? qr[d0 < 4 ? d0 : 0] : qeA, qb = d0 < 4 ? qr[d0 < 4 ? d0 : 0] : qeB;
            a0 = MFMA32(ka0, qa, a0); a1 = MFMA32(ka1, qa, a1); b0 = MFMA32(kb0, qb, b0); b1 = MFMA32(kb1, qb, b1);
        }
    }
    if (!fastA) {
#pragma unroll
        for (int r = 0; r < 16; ++r) { const int c = (r & 3) + 8 * (r >> 2); a0[r] = (c <= lhA && c > llA) ? a0[r] : -INFINITY; a1[r] = (c + 32 <= lhA && c + 32 > llA) ? a1[r] : -INFINITY; }
    }
    if (!fastB) {
#pragma unroll
        for (int r = 0; r < 16; ++r) { const int c = (r & 3) + 8 * (r >> 2); b0[r] = (c <= lhB && c > llB) ? b0[r] : -INFINITY; b1[r] = (c + 32 <= lhB && c + 32 > llB) ? b1[r] : -INFINITY; }
    }
    float mx = fmaxf(fmaxf(a0[0], a1[0]), fmaxf(b0[0], b1[0]));
#pragma unroll
    for (int r = 1; r < 16; ++r) mx = fmaxf(mx, fmaxf(fmaxf(a0[r], a1[r]), fmaxf(b0[r], b1[r])));
    mx = half_max(mx);
    const float mnew = fmaxf(m, mx);
    const float f = __builtin_amdgcn_exp2f((m - mnew) * 1.4426950408889634f);
    m = mnew;
    const float nm2 = -mnew * 1.4426950408889634f;
    float ps = 0.f;
#pragma unroll
    for (int r = 0; r < 16; ++r) {
        a0[r] = __builtin_amdgcn_exp2f(fmaf(a0[r], 1.4426950408889634f, nm2)); a1[r] = __builtin_amdgcn_exp2f(fmaf(a1[r], 1.4426950408889634f, nm2));
        b0[r] = __builtin_amdgcn_exp2f(fmaf(b0[r], 1.4426950408889634f, nm2)); b1[r] = __builtin_amdgcn_exp2f(fmaf(b1[r], 1.4426950408889634f, nm2));
        ps += (a0[r] + a1[r]) + (b0[r] + b1[r]);
    }
    lsum = lsum * f + ps;
    if (__any(f != 1.f)) {
        if (hi == 0) *wsf_r = f;
        asm volatile("s_waitcnt lgkmcnt(0)" ::: "memory");
#pragma unroll
        for (int a = 0; a < 4; ++a) {
            const f32x4 fv = *(const f32x4*)(wsf_hi + 8 * a);
#pragma unroll
            for (int k = 0; k < 4; ++k) { o0[4 * a + k] *= fv[k]; o1[4 * a + k] *= fv[k]; }
        }
        asm volatile("s_waitcnt lgkmcnt(0)" ::: "memory");
    }
    const int voff = ((lane >> 4) & 1) * 32 + (lane & 3) * 8 + (4 * hi + ((lane & 15) >> 2)) * 64;
#pragma unroll
    for (int t = 0; t < 2; ++t) {
        const f32x16& p0 = t == 0 ? a0 : b0; const f32x16& p1 = t == 0 ? a1 : b1;
        u32x4 pw[4];
#pragma unroll
        for (int k = 0; k < 4; ++k) { pw[0][k] = cvtpk(p0[2 * k], p0[2 * k + 1]); pw[1][k] = cvtpk(p0[8 + 2 * k], p0[8 + 2 * k + 1]); pw[2][k] = cvtpk(p1[2 * k], p1[2 * k + 1]); pw[3][k] = cvtpk(p1[8 + 2 * k], p1[8 + 2 * k + 1]); }
        const lds_cptr vp = (lds_cptr)(t == 0 ? vA : vB) + voff;
#pragma unroll
        for (int i = 0; i < 8; ++i) {
            const s16x4 lo = vtr(vp + ((i >> 2) * 4096 + (i & 3) * 1024)), hh = vtr(vp + ((i >> 2) * 4096 + (i & 3) * 1024 + 512));
            const bf16x8 vf = (bf16x8){lo[0], lo[1], lo[2], lo[3], hh[0], hh[1], hh[2], hh[3]};
            const bf16x8 pf = __builtin_bit_cast(bf16x8, pw[i & 3]);
            if (i < 4) o0 = MFMA32(pf, vf, o0); else o1 = MFMA32(pf, vf, o1);
        }
    }
}

constexpr int NQ_KVB = 18432, NQ_WSF = 4 * NQ_KVB, NQ_SEL = NQ_WSF + 2048, NQ_LIST = NQ_SEL + 512, NQ_YAC = NQ_LIST + 256, NQ_LDS = NQ_YAC + 65536, NQ_IMP = 2 * NQ_KVB;
static_assert(NQ_LDS <= 152 * 1024, "lds");
DEVI void nsa_prompt_unit(const P& p, char* smem, int b, int g, int qt) {
    const int tid = tid_opq(), lane = tid & 63, wid = tid >> 6, r32 = lane & 31, hi = lane >> 5;
    float* wsf = (float*)(smem + NQ_WSF) + wid * 64;
    float* impb = (float*)(smem + NQ_IMP) + wid * 512;
    unsigned long long* selm = (unsigned long long*)(smem + NQ_SEL);
    unsigned char* blist = (unsigned char*)(smem + NQ_LIST);
    const int t0 = qt * 64;
    const size_t rowbase = (size_t)b * 4096 + t0;
    const int tokl = wid * 8 + (r32 >> 2), head = r32 & 3;
    const int qpos = t0 + tokl;
    const float slope = alibi_slope(g * 4 + head);
    bf16x8 qr[4];
    {
        const bf16_t* qp = p.PROJ + (rowbase + tokl) * PS + C_BQ + (g * 4 + head) * 64 + hi * 8;
#pragma unroll
        for (int d0 = 0; d0 < 4; ++d0) {
            u32x4 v = *(const u32x4*)(qp + d0 * 16);
#pragma unroll
            for (int k = 0; k < 4; ++k) { const float lo = __uint_as_float(v[k] << 16) * 0.125f, hh = __uint_as_float(v[k] & 0xFFFF0000u) * 0.125f; v[k] = (__float_as_uint(lo) >> 16) | (__float_as_uint(hh) & 0xFFFF0000u); }
            qr[d0] = __builtin_bit_cast(bf16x8, v);
        }
    }
    unsigned qe_w;
    { const unsigned sh = (unsigned)f2bf(slope); const float rem = slope - __uint_as_float(sh << 16); qe_w = sh | ((unsigned)f2bf(rem) << 16); if (hi) qe_w = 0u; }
    int hi4 = 4 * hi; asm volatile("" : "+v"(hi4));
    float* yl = (float*)(smem + NQ_YAC) + wid * 2048 + hi4 * 64 + r32;
    float* wsf_hi = wsf + hi4; float* wsf_r = wsf + r32;
    f32x16 o0, o1; float m, lsum;
    auto finish = [&](int br) {
        const float lt = half_sum(lsum);
        float fac = 0.f;
        if (lt > 0.f) fac = sigmoidf_(p.SM[(rowbase + tokl) * 64 + 8 + br * 16 + g * 4 + head]) / lt;
        if (hi == 0) *wsf_r = fac;
        asm volatile("s_waitcnt lgkmcnt(0)" ::: "memory");
#pragma unroll
        for (int a = 0; a < 4; ++a) {
            const f32x4 fv = *(const f32x4*)(wsf_hi + 8 * a);
#pragma unroll
            for (int k = 0; k < 4; ++k) {
                float* yp = yl + (8 * a + k) * 64;
                if (br == 0) { yp[0] = o0[4 * a + k] * fv[k]; yp[32] = o1[4 * a + k] * fv[k]; }
                else { yp[0] += o0[4 * a + k] * fv[k]; yp[32] += o1[4 * a + k] * fv[k]; }
            }
        }
        asm volatile("s_waitcnt lgkmcnt(0)" ::: "memory");
    };
    __syncthreads();
    if (tid < 64) *(u32x4*)(smem + 9 * 1024 + tid * 16) = (u32x4){0u, 0u, 0u, 0u};
    {
        const BlkDesc d = nsa_desc(p, true, b, g, 0, 0);
        u32x4 rk, rv; blk_load(d, tid, rk, rv); blk_store_ext(d, 64, 63, t0, smem, smem + 10240, tid, rk, rv);
        __syncthreads();
        o0 = (f32x16){}; o1 = (f32x16){}; m = -1e30f; lsum = 0.f;
        f32x16 s0, s1;
        {
            const int nv = ((qpos + 1) >> 6) - 1;
            const int lh = (nv < 63 ? nv : 63) - hi4;
            const bf16x8 qext = __builtin_bit_cast(bf16x8, (u32x4){qe_w, qe_w, 0u, 0u});
            attn_tile2(smem, smem + 10240, qr, qext, m, lsum, o0, o1, s0, s1, lh, -1000, false, wsf_hi, wsf_r, lane);
        }
        const float lt = half_sum(lsum);
        const float inv = lt > 0.f ? 1.f / lt : 0.f;
        unsigned x[64];
#pragma unroll
        for (int r = 0; r < 16; ++r) {
#pragma unroll
            for (int n = 0; n < 2; ++n) {
                float a = (n == 0 ? s0[r] : s1[r]) * inv;
                a += __shfl_xor(a, 1); a += __shfl_xor(a, 2);
                const int j = (r & 3) + 8 * (r >> 2) + 32 * n + hi4;
                if (j == qt || j == 0) a = 5.0f;
                if (j > qt) a = -1.0f;
                const unsigned u = __float_as_uint(a);
                const unsigned o = (u & 0x80000000u) ? ~u : (u | 0x80000000u);
                x[n * 16 + r] = (o & ~63u) | (unsigned)(63 - j);
            }
        }
        finish(0);
        sort16_desc<0>(x); sort16_desc<16>(x);
        unsigned th[16], oth[16], fin[16];
        merge_top16(&x[0], &x[16], th);
#pragma unroll
        for (int i = 0; i < 16; ++i) { auto rr = __builtin_amdgcn_permlane32_swap(th[i], th[i], false, false); oth[i] = hi ? rr[0] : rr[1]; }
        merge_top16(th, oth, fin);
        unsigned long long mask = 0ull;
#pragma unroll
        for (int i = 0; i < 16; ++i) mask |= 1ull << (63u - (fin[i] & 63u));
        if (head == 0 && hi == 0) selm[wid * 8 + (r32 >> 2)] = mask;
    }
    __syncthreads();
    if (wid == 0) {
        unsigned long long u = selm[lane];
#pragma unroll
        for (int o = 32; o > 0; o >>= 1) u |= __shfl_xor(u, o);
        u &= (qt == 63) ? ~0ull : ((1ull << (qt + 1)) - 1ull);
        {
            const int n = __builtin_popcountll(u);
            if ((u >> lane) & 1ull) blist[2 + __builtin_popcountll(lane < 63 ? (u >> (lane + 1)) : 0ull)] = (unsigned char)lane;
            const int w0 = qt - 8 > 0 ? qt - 8 : 0, nw = qt - w0 + 1;
            if (lane < nw) blist[2 + n + lane] = (unsigned char)(qt - lane);
            if (lane == 0) { blist[0] = (unsigned char)n; blist[1] = (unsigned char)nw; }
        }
    }
    __syncthreads();
    if (tid >= 64 && tid < 256) *(u32x4*)(smem + (tid >> 6) * NQ_KVB + 9 * 1024 + (tid & 63) * 16) = (u32x4){0u, 0u, 0u, 0u};
    const int ns = blist[0], nw = blist[1];
    const int nss = (ns + 1) >> 1, nsteps = nss + ((nw + 1) >> 1);
    const unsigned long long mysel = selm[tokl];
    {
        auto step_blocks = [&](int s, int& br, int& jA, int& jB) {
            if (s < nss) { br = 1; jA = blist[2 + 2 * s]; jB = 2 * s + 1 < ns ? (int)blist[2 + 2 * s + 1] : -1; }
            else { const int w = s - nss; br = 2; jA = blist[2 + ns + 2 * w]; jB = 2 * w + 1 < nw ? (int)blist[2 + ns + 2 * w + 1] : -1; }
        };
        u32x4 rkA, rvA, rkB, rvB;
        auto load_step = [&](int s) {
            int br, jA, jB; step_blocks(s, br, jA, jB);
            const BlkDesc dA = nsa_desc(p, true, b, g, br, jA); blk_load(dA, tid, rkA, rvA);
            if (jB >= 0) { const BlkDesc dB = nsa_desc(p, true, b, g, br, jB); blk_load(dB, tid, rkB, rvB); }
        };
        auto store_step = [&](int s, char* buf) {
            int br, jA, jB; step_blocks(s, br, jA, jB);
            BlkDesc dA; dA.pos0 = jA * 64; blk_store_ext(dA, 1, 0, t0, buf, buf + 10240, tid, rkA, rvA);
            if (jB >= 0) { BlkDesc dB; dB.pos0 = jB * 64; blk_store_ext(dB, 1, 0, t0, buf + NQ_KVB, buf + NQ_KVB + 10240, tid, rkB, rvB); }
        };
        load_step(0); store_step(0, smem);
        __syncthreads();
        int prev_br = 1;
        o0 = (f32x16){}; o1 = (f32x16){}; m = -1e30f; lsum = 0.f;
        for (int s = 0; s < nsteps; ++s) {
            int br, jA, jB; step_blocks(s, br, jA, jB);
            char* cur = smem + (s & 1) * 2 * NQ_KVB;
            char* nxt = smem + ((s & 1) ^ 1) * 2 * NQ_KVB;
            if (s + 1 < nsteps) load_step(s + 1);
            if (br != prev_br) { finish(1); o0 = (f32x16){}; o1 = (f32x16){}; m = -1e30f; lsum = 0.f; prev_br = br; }
            {
                asm volatile("" : "+v"(hi4));
                const bool lselA = br == 2 || ((mysel >> jA) & 1ull);
                const int relA = qpos - jA * 64;
                const int lhA = (relA < 63 ? relA : 63) - hi4, llA = (br == 2 ? relA - 512 : -1000) - hi4;
                const bool fastA = __all(!lselA || (lhA >= 59 && llA < 0));
                const bool needA = __any(lselA && lhA + hi4 >= 0 && llA + hi4 < 63);
                const bf16x8 qeA = __builtin_bit_cast(bf16x8, (u32x4){qe_w, qe_w, (lselA || hi) ? 0u : 0x0000C6EAu, 0u});
                bool needB = false; bool lselB = false; int lhB = -1000, llB = -1000; bool fastB = false;
                if (jB >= 0) {
                    lselB = br == 2 || ((mysel >> jB) & 1ull);
                    const int relB = qpos - jB * 64;
                    lhB = (relB < 63 ? relB : 63) - hi4; llB = (br == 2 ? relB - 512 : -1000) - hi4;
                    fastB = __all(!lselB || (lhB >= 59 && llB < 0));
                    needB = __any(lselB && lhB + hi4 >= 0 && llB + hi4 < 63);
                }
                const bf16x8 qeB = __builtin_bit_cast(bf16x8, (u32x4){qe_w, qe_w, (lselB || hi) ? 0u : 0x0000C6EAu, 0u});
                f32x16 s0, s1;
                if (needA && needB) attn_tile3(cur, cur + 10240, cur + NQ_KVB, cur + NQ_KVB + 10240, qr, qeA, qeB, m, lsum, o0, o1, lhA, llA, fastA, lhB, llB, fastB, wsf_hi, wsf_r, lane);
                else if (needA) attn_tile2(cur, cur + 10240, qr, qeA, m, lsum, o0, o1, s0, s1, lhA, llA, fastA, wsf_hi, wsf_r, lane);
                else if (needB) attn_tile2(cur + NQ_KVB, cur + NQ_KVB + 10240, qr, qeB, m, lsum, o0, o1, s0, s1, lhB, llB, fastB, wsf_hi, wsf_r, lane);
            }
            if (s + 1 < nsteps) store_step(s + 1, nxt);
            __syncthreads();
        }
        finish(2);
    }
    {
        const float* yac = (const float*)(smem + NQ_YAC) + wid * 2048;
#pragma unroll
        for (int i = 0; i < 4; ++i) {
            const int orow = i * 8 + (lane >> 3), ch = lane & 7, tk = wid * 8 + (orow >> 2), hd = orow & 3;
            const f32x4 a = *(const f32x4*)(yac + orow * 64 + ch * 8), c = *(const f32x4*)(yac + orow * 64 + ch * 8 + 4);
            *(u32x4*)(p.YB + (rowbase + tk) * 1024 + (g * 4 + hd) * 64 + ch * 8) = pack8f(a, c);
        }
        asm volatile("s_waitcnt lgkmcnt(0)" ::: "memory");
    }
}

DEVI void stage_nsa_attn(const P& p, char* smem, int bid, int nblk) {
    (void)bid; (void)nblk;
    unsigned* head = p.bar + 3840;
    volatile unsigned* slot = (volatile unsigned*)(smem + 150 * 1024);
    for (;;) {
        __syncthreads();
        if (tid_opq() == 0) *slot = __hip_atomic_fetch_add(head, 1u, __ATOMIC_RELAXED, __HIP_MEMORY_SCOPE_AGENT);
        __syncthreads();
        const unsigned i0 = *slot;
        if (i0 >= 1536u) break;
        if (i0 < 1024u && !(i0 & 1u)) { nsa_sample_unit(p, smem, (int)(i0 >> 1)); continue; }
        const unsigned i = i0 < 1024u ? (i0 >> 1) : i0 - 512u;
        nsa_prompt_unit(p, smem, (int)((i & 15u) >> 2), (int)(i & 3u), 63 - (int)(i >> 4));
    }
}

DEVI void stage2_queue(const P& p, char* smem) {
    unsigned* head = p.bar + 3904;
    volatile unsigned* slot = (volatile unsigned*)(smem + 150 * 1024);
    constexpr int BIG = 1 << 20;
    for (;;) {
        __syncthreads();
        if (tid_opq() == 0) *slot = __hip_atomic_fetch_add(head, 1u, __ATOMIC_RELAXED, __HIP_MEMORY_SCOPE_AGENT);
        __syncthreads();
        const unsigned i = *slot;
        if (i >= 1824u) break;
        int kind, t;
        if (i < 16u) { kind = 0; t = (int)i; }
        else if (i < 528u) { const unsigned j = i - 16u; kind = (j & 1u) ? 1 : 2; t = (int)(j >> 1); }
        else if (i < 544u) { kind = 2; t = 256 + (int)(i - 528u); }
        else { const unsigned j = i - 544u, q = j / 5u, r = j - q * 5u; if (r < 3u) { kind = 1; t = 256 + (int)(q * 3u + r); } else { kind = 3; t = (int)(q * 2u + r - 3u); } }
        if (kind == 0) stage_mlstm_gates(p, smem, t, BIG);
        else if (kind == 1) stage_mlstm_dc(p, smem, t, BIG);
        else if (kind == 2) stage_compress(p, smem, 0, BIG, t);
        else stage_mlstm_sample(p, smem, t, BIG);
    }
}

DEVI void stage_ln1(const P& p, int bid, int nblk) {
    const int lane = tid_opq() & 63, wid = tid_opq() >> 6;
    for (int row = bid * 8 + wid; row < NT; row += nblk * 8) {
        f32x4 x[4];
        float s = 0.f;
#pragma unroll
        for (int i = 0; i < 4; ++i) { x[i] = *(const f32x4*)(p.R + (size_t)row * 1024 + i * 256 + lane * 4); s += x[i][0] + x[i][1] + x[i][2] + x[i][3]; }
        const float mean = wave_sum(s) * (1.f / 1024.f);
        float q = 0.f;
#pragma unroll
        for (int i = 0; i < 4; ++i)
#pragma unroll
            for (int k = 0; k < 4; ++k) q += (x[i][k] - mean) * (x[i][k] - mean);
        const float rs = rsqrtf(wave_sum(q) * (1.f / 1024.f) + LN_EPS);
#pragma unroll
        for (int i = 0; i < 4; ++i) {
            const int c = i * 256 + lane * 4;
            const f32x4 gg = *(const f32x4*)(p.ln1_g + c), bb = *(const f32x4*)(p.ln1_b + c);
            f32x4 y;
#pragma unroll
            for (int k = 0; k < 4; ++k) y[k] = (x[i][k] - mean) * rs * gg[k] + bb[k];
            u32x2 o; o.x = pack2(y[0], y[1]); o.y = pack2(y[2], y[3]);
            *(u32x2*)(p.HB + (size_t)row * 1024 + c) = o;
        }
        if (lane == 0) { p.H[(size_t)row * 2] = mean; p.H[(size_t)row * 2 + 1] = rs; }
    }
}

__device__ const unsigned char PEER_CA[50] = {0,0,0,0,0,0,0,0,0,0,0,0,0,0,0,0, 1,1,1,1,1,1,1,1, 2,2,2,2,2, 3,3,3,3, 4,4,4, 5,5, 6,6, 7,7, 8,9,10,11,12,13,14,15};
__device__ const unsigned char PEER_CB[50] = {0,1,2,3,4,5,6,7,8,9,10,11,12,13,14,15, 0,1,2,3,4,5,6,7, 0,1,2,3,4, 0,1,2,3, 0,1,2, 0,1, 0,1, 0,1, 0,0,0,0,0,0,0,0};

DEVI float key_score(unsigned k) { const unsigned u = k & ~127u; return __uint_as_float((u & 0x80000000u) ? (u & 0x7FFFFFFFu) : ~u); }

DEVI void sort8_desc(unsigned (&x)[16]) {
#pragma unroll
    for (int k = 2; k <= 8; k <<= 1)
#pragma unroll
        for (int j = k >> 1; j > 0; j >>= 1)
#pragma unroll
            for (int i = 0; i < 8; ++i) {
                const int l = i ^ j;
                if (l > i) { if ((i & k) == 0) ce_desc(x[i], x[l]); else ce_desc(x[l], x[i]); }
            }
}
DEVI unsigned sum_key(unsigned ka, unsigned kb, unsigned tag) {
    const unsigned u = __float_as_uint(key_score(ka) + key_score(kb));
    const unsigned o = (u & 0x80000000u) ? ~u : (u | 0x80000000u);
    return (o & ~255u) | tag;
}
DEVI float key_score8(unsigned k) { const unsigned u = k & ~255u; return __uint_as_float((u & 0x80000000u) ? (u & 0x7FFFFFFFu) : ~u); }

DEVI void route_top16(const P& p, int row, int ph, int c, int r32, int hi, int hi4, unsigned (&fin)[16]) {
    f32x16 acc[4];
#pragma unroll
    for (int t = 0; t < 4; ++t) acc[t] = (f32x16){};
    const bf16_t* qp = p.PQ + (size_t)row * 2048 + ph * 256 + c * 128 + hi * 8;
    const bf16_t* kp = p.KEYSB + ((size_t)((ph * 2 + c) * 128 + r32)) * 128 + hi * 8;
#pragma unroll
    for (int s8 = 0; s8 < 8; ++s8) {
        const bf16x8 qf = *(const bf16x8*)(qp + s8 * 16);
#pragma unroll
        for (int t = 0; t < 4; ++t) {
            const bf16x8 kf = *(const bf16x8*)(kp + (size_t)t * 32 * 128 + s8 * 16);
            acc[t] = MFMA32(kf, qf, acc[t]);
        }
    }
    unsigned x[64];
#pragma unroll
    for (int t = 0; t < 4; ++t)
#pragma unroll
        for (int r = 0; r < 16; ++r) {
            const unsigned u = __float_as_uint(acc[t][r]);
            const unsigned o = (u & 0x80000000u) ? ~u : (u | 0x80000000u);
            x[t * 16 + r] = (o & ~127u) | (unsigned)(127 - ((r & 3) + 8 * (r >> 2) + 32 * t) - hi4);
        }
    sort16_desc<0>(x); sort16_desc<16>(x); sort16_desc<32>(x); sort16_desc<48>(x);
    unsigned t01[16], t23[16], tt[16], oth[16];
    merge_top16(&x[0], &x[16], t01); merge_top16(&x[32], &x[48], t23); merge_top16(t01, t23, tt);
#pragma unroll
    for (int i = 0; i < 16; ++i) { auto rr = __builtin_amdgcn_permlane32_swap(tt[i], tt[i], false, false); oth[i] = hi ? rr[0] : rr[1]; }
    merge_top16(tt, oth, fin);
}

DEVI void stage_peer_route(const P& p, char* smem, int bid, int nblk, int p0, int p1) {
    const int lane = tid_opq() & 63, wid = tid_opq() >> 6, r32 = lane & 31, hi = lane >> 5;
    unsigned char* tb = (unsigned char*)smem + wid * 1024 + r32 * 32;
    const int tpw = (NT + nblk - 1) / nblk, row_lo = bid * tpw, row_hi = (row_lo + tpw < NT) ? row_lo + tpw : NT;
    const int ph = wid;
    for (int pass = p0; pass < p1 && row_lo + pass * 32 < row_hi; ++pass) {
        const int row_raw = row_lo + pass * 32 + r32;
        const bool row_ok = row_raw < row_hi;
        const int row = row_ok ? row_raw : row_lo;
        int hi4 = 4 * hi; asm volatile("" : "+v"(hi4));
        unsigned fa[16], fb[16];
        route_top16(p, row, ph, 0, r32, hi, hi4, fa);
        asm volatile("" : "+v"(hi4));
        route_top16(p, row, ph, 1, r32, hi, hi4, fb);
        if (hi == 0) {
            u32x4 wa, wb;
#pragma unroll
            for (int i = 0; i < 4; ++i) {
                wa[i] = (127u - (fa[4 * i] & 127u)) | ((127u - (fa[4 * i + 1] & 127u)) << 8) | ((127u - (fa[4 * i + 2] & 127u)) << 16) | ((127u - (fa[4 * i + 3] & 127u)) << 24);
                wb[i] = (127u - (fb[4 * i] & 127u)) | ((127u - (fb[4 * i + 1] & 127u)) << 8) | ((127u - (fb[4 * i + 2] & 127u)) << 16) | ((127u - (fb[4 * i + 3] & 127u)) << 24);
            }
            *(u32x4*)tb = wa; *(u32x4*)(tb + 16) = wb;
        }
        unsigned g0[16], g1[16], g2[16], g3[16];
#pragma unroll
        for (int j = 0; j < 16; ++j) g0[j] = sum_key(fa[0], fb[j], (unsigned)j);
#pragma unroll
        for (int k = 0; k < 15; ++k) g1[k] = sum_key(fa[k + 1], fb[0], (unsigned)((k + 1) << 4));
        g1[15] = 0u;
#pragma unroll
        for (int j = 1; j < 8; ++j) g2[j - 1] = sum_key(fa[1], fb[j], (unsigned)(16 | j));
        g2[7] = 0u; g2[8] = 0u; g2[9] = 0u;
#pragma unroll
        for (int i = 2; i < 8; ++i) g2[17 - i] = sum_key(fa[i], fb[1], (unsigned)((i << 4) | 1));
#pragma unroll
        for (int j = 8; j > 0; j >>= 1)
#pragma unroll
            for (int i = 0; i < 16; ++i) { const int l = i ^ j; if (l > i) ce_desc(g2[i], g2[l]); }
        g3[0] = sum_key(fa[2], fb[2], 0x22u); g3[1] = sum_key(fa[2], fb[3], 0x23u); g3[2] = sum_key(fa[2], fb[4], 0x24u);
        g3[3] = sum_key(fa[3], fb[2], 0x32u); g3[4] = sum_key(fa[4], fb[2], 0x42u); g3[5] = sum_key(fa[3], fb[3], 0x33u);
#pragma unroll
        for (int i = 6; i < 16; ++i) g3[i] = 0u;
        sort8_desc(g3);
        unsigned t01[16], t23[16], top[16];
        merge_top16(g0, g1, t01); merge_top16(g2, g3, t23); merge_top16(t01, t23, top);
        float ev[16]; float sum = 0.f;
        const float vmax = key_score8(top[0]);
#pragma unroll
        for (int k = 0; k < 16; ++k) { ev[k] = __expf(key_score8(top[k]) - vmax); sum += ev[k]; }
        const float inv = 1.f / sum;
        asm volatile("s_waitcnt lgkmcnt(0)" ::: "memory");
        if (!row_ok) {   } else if (hi == 0) {
            int* dst = p.EIDX + (size_t)row * 128 + ph * 16;
#pragma unroll
            for (int q4 = 0; q4 < 4; ++q4) {
                u32x4 o;
#pragma unroll
                for (int k = 0; k < 4; ++k) { const unsigned tg = top[q4 * 4 + k] & 255u; o[k] = (unsigned)tb[tg >> 4] * 128u + (unsigned)tb[16 + (tg & 15u)]; }
                *(u32x4*)(dst + q4 * 4) = o;
            }
        } else {
            float* dst = p.EGATE + (size_t)row * 128 + ph * 16;
#pragma unroll
            for (int q4 = 0; q4 < 4; ++q4) *(f32x4*)(dst + q4 * 4) = (f32x4){ev[q4 * 4] * inv, ev[q4 * 4 + 1] * inv, ev[q4 * 4 + 2] * inv, ev[q4 * 4 + 3] * inv};
        }
        asm volatile("s_waitcnt lgkmcnt(0)" ::: "memory");
    }
}

constexpr int PA_WAVE_LDS = 1024 + 1024 + 512 + 512 + 512 + 4096;
DEVI void stage_peer_apply(const P& p, char* smem, int bid, int nblk, int p0, int p1) {
    const int lane = tid_opq() & 63, wid = tid_opq() >> 6;
    char* wl = smem + wid * PA_WAVE_LDS;
    int* idxs = (int*)(wl + 2048);
    float* gts = (float*)(wl + 2560);
    float* cs = (float*)(wl + 3072);
    const int fr = lane & 15, fq = lane >> 4;
    const int tpw = (NT + nblk - 1) / nblk, row_lo = bid * tpw, row_hi = (row_lo + tpw < NT) ? row_lo + tpw : NT;
    for (int row = row_lo + p0 * 32 + wid; row < row_hi && row < row_lo + p1 * 32; row += 8) {
        float* hvs = (float*)(wl + 3584);
        {
            const float* hr = p.R + (size_t)row * 1024 + lane * 16;
            const float mean1 = p.H[(size_t)row * 2], rs1 = p.H[(size_t)row * 2 + 1];
#pragma unroll
            for (int i = 0; i < 4; ++i) {
                f32x4 x = *(const f32x4*)(hr + i * 4);
                const f32x4 g1 = *(const f32x4*)(p.ln1_g + lane * 16 + i * 4), b1 = *(const f32x4*)(p.ln1_b + lane * 16 + i * 4);
#pragma unroll
                for (int k = 0; k < 4; ++k) x[k] = (x[k] - mean1) * rs1 * g1[k] + b1[k];
                *(f32x4*)(hvs + lane * 16 + i * 4) = x;
            }
            idxs[lane] = p.EIDX[(size_t)row * 128 + lane]; idxs[lane + 64] = p.EIDX[(size_t)row * 128 + 64 + lane];
            gts[lane] = p.EGATE[(size_t)row * 128 + lane]; gts[lane + 64] = p.EGATE[(size_t)row * 128 + 64 + lane];
            asm volatile("s_waitcnt lgkmcnt(0)" ::: "memory");
        }
        {
            f32x2 hreg[8];
#pragma unroll
            for (int i = 0; i < 4; ++i) { const f32x4 t = *(const f32x4*)(hvs + lane * 16 + i * 4); hreg[i * 2] = (f32x2){t[0], t[1]}; hreg[i * 2 + 1] = (f32x2){t[2], t[3]}; }
#if U_BITS == 4
            constexpr int UB = 8;
            u32x2 u0[8], u1[8];
            auto issue_u = [&](int e0, u32x2 (&u)[8]) {
#pragma unroll
                for (int k = 0; k < 8; ++k) u[k] = *(const u32x2*)(p.U8 + (size_t)idxs[e0 + k] * 512 + lane * 8);
            };
            auto dots_u = [&](const u32x2 (&u)[8], float (&sp)[8]) {
#pragma unroll
                for (int k = 0; k < 8; ++k) {
                    f32x2 s0 = (f32x2){0.f, 0.f};
                    s0 = __builtin_elementwise_fma(__builtin_amdgcn_cvt_scalef32_pk_f32_fp4(u[k][0], 1.0f, 0), hreg[0], s0);
                    s0 = __builtin_elementwise_fma(__builtin_amdgcn_cvt_scalef32_pk_f32_fp4(u[k][0], 1.0f, 1), hreg[1], s0);
                    s0 = __builtin_elementwise_fma(__builtin_amdgcn_cvt_scalef32_pk_f32_fp4(u[k][0], 1.0f, 2), hreg[2], s0);
                    s0 = __builtin_elementwise_fma(__builtin_amdgcn_cvt_scalef32_pk_f32_fp4(u[k][0], 1.0f, 3), hreg[3], s0);
                    s0 = __builtin_elementwise_fma(__builtin_amdgcn_cvt_scalef32_pk_f32_fp4(u[k][1], 1.0f, 0), hreg[4], s0);
                    s0 = __builtin_elementwise_fma(__builtin_amdgcn_cvt_scalef32_pk_f32_fp4(u[k][1], 1.0f, 1), hreg[5], s0);
                    s0 = __builtin_elementwise_fma(__builtin_amdgcn_cvt_scalef32_pk_f32_fp4(u[k][1], 1.0f, 2), hreg[6], s0);
                    s0 = __builtin_elementwise_fma(__builtin_amdgcn_cvt_scalef32_pk_f32_fp4(u[k][1], 1.0f, 3), hreg[7], s0);
                    sp[k] = s0[0] + s0[1];
                }
            };
#else
            U3 u0[8], u1[8];
            auto issue_u = [&](int e0, U3 (&u)[8]) {
#pragma unroll
                for (int k = 0; k < 8; ++k) u[k] = *(const U3*)(p.U8 + (size_t)idxs[e0 + k] * 768 + lane * 12);
            };
            constexpr int UB = 8;
            auto dots_u = [&](const U3 (&u)[8], float (&sp)[8]) {
#pragma unroll
                for (int k = 0; k < 8; k += 2) {
                    const i32x6 src = {(int)u[k].a, (int)u[k].b, (int)u[k].c, (int)u[k + 1].a, (int)u[k + 1].b, (int)u[k + 1].c};
                    const f32x32 f = __builtin_amdgcn_cvt_scalef32_pk32_f32_fp6(src, 1.0f);
                    f32x2 s0 = (f32x2){0.f, 0.f}, s1 = (f32x2){0.f, 0.f};
#pragma unroll
                    for (int i = 0; i < 8; ++i) {
                        s0 = __builtin_elementwise_fma((f32x2){f[2 * i], f[2 * i + 1]}, hreg[i], s0);
                        s1 = __builtin_elementwise_fma((f32x2){f[16 + 2 * i], f[17 + 2 * i]}, hreg[i], s1);
                    }
                    sp[k] = s0[0] + s0[1]; sp[k + 1] = s1[0] + s1[1];
                }
            };
#endif
            auto finish_u = [&](int e0, const float (&sv)[16]) {
                float t[8], w[4];
#pragma unroll
                for (int i = 0; i < 8; ++i) {
                    const float x = sv[2 * i], y = sv[2 * i + 1];
                    const auto r = __builtin_amdgcn_permlane32_swap(__float_as_uint(x), __float_as_uint(y), false, false);
                    t[i] = __uint_as_float(r[0]) + __uint_as_float(r[1]);
                }
#pragma unroll
                for (int i = 0; i < 4; ++i) {
                    const auto r = __builtin_amdgcn_permlane16_swap(__float_as_uint(t[2 * i]), __float_as_uint(t[2 * i + 1]), false, false);
                    float v = __uint_as_float(r[0]) + __uint_as_float(r[1]);
                    v += __uint_as_float(__builtin_amdgcn_update_dpp(0u, __float_as_uint(v), 0x128, 0xf, 0xf, false));
                    v += __uint_as_float(__builtin_amdgcn_update_dpp(0u, __float_as_uint(v), 0x124, 0xf, 0xf, false));
                    v += __uint_as_float(__builtin_amdgcn_update_dpp(0u, __float_as_uint(v), 0x4e, 0xf, 0xf, false));
                    v += __uint_as_float(__builtin_amdgcn_update_dpp(0u, __float_as_uint(v), 0xb1, 0xf, 0xf, false));
                    w[i] = v;
                }
                const int c = lane & 3, r = lane >> 4;
                const float tot = c == 0 ? w[0] : c == 1 ? w[1] : c == 2 ? w[2] : w[3];
                const int k = 4 * c + ((r & 1) << 1) + (r >> 1);
                if ((lane & 15) < 4) {
                    const int e = idxs[e0 + k];
                    cs[e0 + k] = gts[e0 + k] * p.VS[e] * gelu_erf(tot * p.US[e]);
                }
            };
            issue_u(0, u0);
#pragma unroll 1
            for (int e0 = 0; e0 < 128; e0 += 16) {
                float sa[8], sb[8], sv[16];
                issue_u(e0 + 8, u1);
                dots_u(u0, sa);
                if (e0 + 16 < 128) issue_u(e0 + 16, u0);
                dots_u(u1, sb);
#pragma unroll
                for (int i = 0; i < 8; ++i) { sv[i] = sa[i]; sv[8 + i] = sb[i]; }
                finish_u(e0, sv);
            }
            (void)UB;
        }
        asm volatile("s_waitcnt lgkmcnt(0)" ::: "memory");
        float acc[16];
#pragma unroll
        for (int i = 0; i < 16; ++i) acc[i] = 0.f;
        {
#if V_BITS == 4
            u32x2 v0[8], v1[8];
            auto issue_v = [&](int e0, u32x2 (&v)[8]) {
#pragma unroll
                for (int k = 0; k < 8; ++k) v[k] = *(const u32x2*)(p.V8 + (size_t)idxs[e0 + k] * 512 + lane * 8);
            };
            auto consume_v = [&](int e0, const u32x2 (&v)[8]) {
#pragma unroll
                for (int k = 0; k < 8; ++k) {
                    const float c = cs[e0 + k];
                    const f32x2 cc = (f32x2){c, c};
#pragma unroll
                    for (int w = 0; w < 2; ++w) {
                        const f32x2 f0 = __builtin_amdgcn_cvt_scalef32_pk_f32_fp4(v[k][w], 1.0f, 0), f1 = __builtin_amdgcn_cvt_scalef32_pk_f32_fp4(v[k][w], 1.0f, 1);
                        const f32x2 f2 = __builtin_amdgcn_cvt_scalef32_pk_f32_fp4(v[k][w], 1.0f, 2), f3 = __builtin_amdgcn_cvt_scalef32_pk_f32_fp4(v[k][w], 1.0f, 3);
                        f32x2 a0 = (f32x2){acc[w * 8], acc[w * 8 + 1]}, a1 = (f32x2){acc[w * 8 + 2], acc[w * 8 + 3]}, a2 = (f32x2){acc[w * 8 + 4], acc[w * 8 + 5]}, a3 = (f32x2){acc[w * 8 + 6], acc[w * 8 + 7]};
                        a0 = __builtin_elementwise_fma(cc, f0, a0); a1 = __builtin_elementwise_fma(cc, f1, a1); a2 = __builtin_elementwise_fma(cc, f2, a2); a3 = __builtin_elementwise_fma(cc, f3, a3);
                        acc[w * 8] = a0[0]; acc[w * 8 + 1] = a0[1]; acc[w * 8 + 2] = a1[0]; acc[w * 8 + 3] = a1[1]; acc[w * 8 + 4] = a2[0]; acc[w * 8 + 5] = a2[1]; acc[w * 8 + 6] = a3[0]; acc[w * 8 + 7] = a3[1];
                    }
                }
            };
#else
            U3 v0[8], v1[8];
            auto issue_v = [&](int e0, U3 (&v)[8]) {
#pragma unroll
                for (int k = 0; k < 8; ++k) v[k] = *(const U3*)(p.V8 + (size_t)idxs[e0 + k] * 768 + lane * 12);
            };
            auto consume_v = [&](int e0, const U3 (&v)[8]) {
#pragma unroll
                for (int k = 0; k < 8; k += 2) {
                    const float c0 = cs[e0 + k], c1 = cs[e0 + k + 1];
                    const i32x6 src = {(int)v[k].a, (int)v[k].b, (int)v[k].c, (int)v[k + 1].a, (int)v[k + 1].b, (int)v[k + 1].c};
                    const f32x32 f = __builtin_amdgcn_cvt_scalef32_pk32_f32_fp6(src, 1.0f);
#pragma unroll
                    for (int i = 0; i < 16; ++i) { acc[i] = __builtin_fmaf(c0, f[i], acc[i]); acc[i] = __builtin_fmaf(c1, f[16 + i], acc[i]); }
                }
            };
#endif
            constexpr int VB = 8;
            issue_v(0, v0);
#pragma unroll 1
            for (int e0 = 0; e0 < 128; e0 += 2 * VB) {
                issue_v(e0 + VB, v1);
                consume_v(e0, v0);
                if (e0 + 2 * VB < 128) issue_v(e0 + 2 * VB, v0);
                consume_v(e0 + VB, v1);
            }
        }
        float s = 0.f;
#pragma unroll
        for (int i = 0; i < 16; ++i) { acc[i] += DN_ALPHA * hvs[lane * 16 + i]; s += acc[i]; }
        const float mean = wave_sum(s) * (1.f / 1024.f);
        float q = 0.f;
#pragma unroll
        for (int i = 0; i < 16; ++i) q += (acc[i] - mean) * (acc[i] - mean);
        const float rs = rsqrtf(wave_sum(q) * (1.f / 1024.f) + LN_EPS);
#pragma unroll
        for (int i = 0; i < 4; ++i) {
            const int c = lane * 16 + i * 4;
            const f32x4 g0 = *(const f32x4*)(p.ln2_g + c), b0 = *(const f32x4*)(p.ln2_b + c);
            f32x4 y0;
#pragma unroll
            for (int k = 0; k < 4; ++k) y0[k] = (acc[i * 4 + k] - mean) * rs * g0[k] + b0[k];
            *(f32x4*)(p.out + O_Y + (size_t)row * 1024 + c) = y0;
        }
    }
}

namespace pg8 {
#define PG8_LAS __attribute__((address_space(3)))
typedef unsigned short bf16_t;
typedef short bf16x8 __attribute__((ext_vector_type(8)));
typedef float f32x4 __attribute__((ext_vector_type(4)));
typedef unsigned u32x4 __attribute__((ext_vector_type(4)));
constexpr int BM = 256, BK = 64, HALF = 128, HTB = HALF * BK * 2  , STAGE_BYTES = 8 * HTB, NXCD = 8, WGM = 8;

__host__ __device__ __forceinline__ int lds_byte(int r, int c) { const int st = (r >> 4) * 2 + (c >> 5), rr = r & 15, cc = c & 31, ob = rr * 64 + cc * 2; return st * 1024 + (ob ^ (((ob >> 9) & 1) << 5)); }
__host__ __device__ __forceinline__ void stage_rc(int b, int& R, int& C) { const int st = b / 1024, sb = b % 1024, swz = sb ^ (((sb >> 9) & 1) << 5); R = (st >> 1) * 16 + swz / 64; C = (st & 1) * 32 + (swz % 64) / 2; }
__host__ __device__ __forceinline__ int perm32(int rho) { const int n = rho >> 4, i = rho & 15; return 8 * (i >> 2) + 4 * n + (i & 3); }

struct Unit { int pm, pn; };
struct Gemm { const bf16_t* A; const bf16_t* Bt; int M, N, K; };

struct StaticOrder {
    int nM, nN, nwg, G, c;
    __host__ __device__ void init(int M, int N, int G_, int c_) { nM = M / BM; nN = N / BM; nwg = nM * nN; G = G_; c = c_; }
    __host__ __device__ bool next(int i, Unit& u) const {
        const long L = (long)i * G + c; if (L >= nwg) return false;
        int wgid = (int)L; { const int q = nwg / NXCD, r = nwg % NXCD, xcd = wgid % NXCD, off = wgid / NXCD; wgid = (xcd < r ? xcd * (q + 1) : r * (q + 1) + (xcd - r) * q) + off; }
        const int nig = WGM * nN, gid = wgid / nig, fm = gid * WGM, gsz = (nM - fm) < WGM ? (nM - fm) : WGM;
        u.pm = fm + ((wgid % nig) % gsz); u.pn = (wgid % nig) / gsz; return true;
    }
    __device__ __forceinline__ void a_ready(const Unit&) const {}
    __device__ __forceinline__ void done(const Unit&) const {}
};
template <class Epi, class Sched, bool STAMP = false>
__device__ __forceinline__ void gemm_phase(PG8_LAS unsigned char* lds, const Gemm g, const Sched& S, const Epi& E, unsigned long long* stamps) {
    const int tid = tid_opq(), wid = __builtin_amdgcn_readfirstlane(tid >> 6), lane = tid & 63, wr = wid >> 2, wc = wid & 3, fr = lane & 15, fq = lane >> 4;
    const int K = g.K, nt = K / BK;
    int ts_lo = 0, ts_hi = 0, nts = 0; const unsigned long long rt_entry = STAMP ? (unsigned long long)wall_clock64() : 0ull;
#define PG8_STAMP() do { if (STAMP && wid == 0 && nts < 64) { const unsigned long long _c = (unsigned long long)clock64(); \
        ts_lo = (lane == nts) ? (int)(unsigned)_c : ts_lo; ts_hi = (lane == nts) ? (int)(unsigned)(_c >> 32) : ts_hi; ++nts; } } while (0)
    PG8_STAMP();
    unsigned voffA[2], voffB[2];
#pragma unroll
    for (int i = 0; i < 2; ++i) { int R, C; stage_rc(tid * 16 + i * 8192, R, C); const int Rb = Epi::PERM ? ((R & ~31) + perm32(R & 31)) : R;
        voffA[i] = (unsigned)(R * K + C) * 2u; voffB[i] = (unsigned)(Rb * K + C) * 2u; }
    const size_t kstep = (size_t)(BK * 2);
    const size_t hstep = (size_t)HALF * K * 2;
    const size_t tstep = 2 * hstep;
    const unsigned ldsw = (unsigned)wid * 1024u;
    const int aoff = lds_byte(wr * 64 + fr, fq * 8), boff = lds_byte(wc * 32 + fr, fq * 8);
#define PG8_SA(b, h) (((b) * 2 + (h)) * HTB)
#define PG8_SB(b, h) ((4 + (b) * 2 + (h)) * HTB)
#define PG8_STAGE(bufoff, gbase, voff) do { _Pragma("unroll") for (int _i = 0; _i < 2; ++_i) \
        __builtin_amdgcn_global_load_lds((const unsigned*)((const char*)(gbase) + (voff)[_i]), (PG8_LAS unsigned*)(lds + (bufoff) + ldsw + _i * 8192), 16, 0, 0); } while (0)
#define PG8_LDA(dst, b, h) do { _Pragma("unroll") for (int m = 0; m < 4; ++m) _Pragma("unroll") for (int k = 0; k < 2; ++k) dst[m][k] = *(const PG8_LAS bf16x8*)(lds + PG8_SA(b, h) + aoff + m * 2048 + k * 1024); } while (0)
#define PG8_LDB(dst, b, h) do { _Pragma("unroll") for (int n = 0; n < 2; ++n) _Pragma("unroll") for (int k = 0; k < 2; ++k) dst[n][k] = *(const PG8_LAS bf16x8*)(lds + PG8_SB(b, h) + boff + n * 2048 + k * 1024); } while (0)
#define PG8_MMA(ai, bj, At, Bt) do { __builtin_amdgcn_s_setprio(1); _Pragma("unroll") for (int m = 0; m < 4; ++m) _Pragma("unroll") for (int n = 0; n < 2; ++n) _Pragma("unroll") for (int k = 0; k < 2; ++k) \
        acc[ai][bj][m][n] = __builtin_amdgcn_mfma_f32_16x16x32_bf16(Bt[n][k], At[m][k], acc[ai][bj][m][n], 0, 0, 0); __builtin_amdgcn_s_setprio(0); } while (0)
#define PG8_WAIT_V(n) asm volatile("s_waitcnt vmcnt(" #n ")" ::: "memory")
#define PG8_WAIT_L(n) asm volatile("s_waitcnt lgkmcnt(" #n ")" ::: "memory")
#define PG8_BAR __builtin_amdgcn_s_barrier()
#define PG8_SCHED __builtin_amdgcn_sched_barrier(0)
    Unit cur, nxt; int ui = 0;
    if (!S.next(0, cur)) return;
    f32x4 acc[2][2][4][2];
#pragma unroll
    for (int a = 0; a < 2; ++a)
#pragma unroll
        for (int b = 0; b < 2; ++b)
#pragma unroll
            for (int m = 0; m < 4; ++m)
#pragma unroll
                for (int n = 0; n < 2; ++n) acc[a][b][m][n] = (f32x4){0.f, 0.f, 0.f, 0.f};
    bf16x8 At[4][2], B0[2][2], B1[2][2];
    const char* cA = (const char*)g.A + (size_t)cur.pm * tstep; const char* cB = (const char*)g.Bt + (size_t)cur.pn * tstep;
    S.a_ready(cur);
    PG8_STAGE(PG8_SB(0, 0), cB, voffB); PG8_STAGE(PG8_SA(0, 0), cA, voffA); PG8_STAGE(PG8_SB(0, 1), cB + hstep, voffB); PG8_STAGE(PG8_SA(0, 1), cA + hstep, voffA);
    if (wr == 1) PG8_BAR;
    PG8_WAIT_V(4); PG8_BAR;
    PG8_STAGE(PG8_SB(1, 0), cB + kstep, voffB); PG8_STAGE(PG8_SA(1, 0), cA + kstep, voffA); PG8_STAGE(PG8_SB(1, 1), cB + hstep + kstep, voffB);
    PG8_WAIT_V(6); PG8_BAR;
    PG8_STAMP();
    for (;;) {
        const bool has_next = S.next(ui + 1, nxt);
        const char* nA = has_next ? (const char*)g.A + (size_t)nxt.pm * tstep : cA; const char* nB = has_next ? (const char*)g.Bt + (size_t)nxt.pn * tstep : cB;
        for (int t = 0; t < nt; t += 2) {
            const bool last = (t == nt - 2);
            const char* a1 = cA + (size_t)(t + 1) * kstep;
            const char* a2 = last ? nA : cA + (size_t)(t + 2) * kstep; const char* b2 = last ? nB : cB + (size_t)(t + 2) * kstep;
            const char* a3 = a2 + kstep; const char* b3 = b2 + kstep;
            if (last && has_next) S.a_ready(nxt);
            PG8_LDB(B0, 0, 0); PG8_SCHED; PG8_LDA(At, 0, 0); PG8_STAGE(PG8_SA(1, 1), a1 + hstep, voffA);
            PG8_WAIT_L(8); PG8_BAR; PG8_WAIT_L(0); PG8_MMA(0, 0, At, B0); PG8_BAR; PG8_SCHED;
            PG8_LDB(B1, 0, 1); PG8_STAGE(PG8_SB(0, 0), b2, voffB);
            PG8_BAR; PG8_WAIT_L(0); PG8_MMA(0, 1, At, B1); PG8_BAR;
            PG8_LDA(At, 0, 1); PG8_STAGE(PG8_SA(0, 0), a2, voffA);
            PG8_BAR; PG8_WAIT_L(0); PG8_MMA(1, 0, At, B0); PG8_BAR; PG8_SCHED;
            PG8_STAGE(PG8_SB(0, 1), b2 + hstep, voffB);
            PG8_WAIT_V(6); PG8_BAR; PG8_MMA(1, 1, At, B1); PG8_BAR;
            PG8_LDB(B0, 1, 0); PG8_SCHED; PG8_LDA(At, 1, 0); PG8_STAGE(PG8_SA(0, 1), a2 + hstep, voffA);
            PG8_WAIT_L(8); PG8_BAR; PG8_WAIT_L(0); PG8_MMA(0, 0, At, B0); PG8_BAR; PG8_SCHED;
            PG8_LDB(B1, 1, 1); PG8_STAGE(PG8_SB(1, 0), b3, voffB);
            PG8_BAR; PG8_WAIT_L(0); PG8_MMA(0, 1, At, B1); PG8_BAR;
            PG8_LDA(At, 1, 1); PG8_STAGE(PG8_SA(1, 0), a3, voffA);
            PG8_BAR; PG8_WAIT_L(0); PG8_MMA(1, 0, At, B0); PG8_BAR; PG8_SCHED;
            PG8_STAGE(PG8_SB(1, 1), b3 + hstep, voffB);
            PG8_WAIT_V(6); PG8_BAR; PG8_MMA(1, 1, At, B1); PG8_BAR;
        }
        PG8_STAMP();
        if constexpr (!Epi::AFTER_DRAIN) { E(acc, cur, wr, wc, fr, fq); S.done(cur); }
        PG8_STAMP();
        if (!has_next) break;
#pragma unroll
        for (int a = 0; a < 2; ++a)
#pragma unroll
            for (int b = 0; b < 2; ++b)
#pragma unroll
                for (int m = 0; m < 4; ++m)
#pragma unroll
                    for (int n = 0; n < 2; ++n) acc[a][b][m][n] = (f32x4){0.f, 0.f, 0.f, 0.f};
        cur = nxt; cA = nA; cB = nB; ++ui;
    }
    PG8_WAIT_V(0);
    if (wr == 0) PG8_BAR;
    PG8_BAR;
    if constexpr (Epi::AFTER_DRAIN) { E.fused(acc, cur, wr, wc, fr, fq, lds, wid, lane); S.done(cur); }
    PG8_STAMP();
    if (STAMP && wid == 0) { stamps[lane] = lane < nts ? (((unsigned long long)(unsigned)ts_hi << 32) | (unsigned)ts_lo) : 0ull;
        if (lane == 62) stamps[62] = rt_entry; if (lane == 63) stamps[63] = (unsigned long long)wall_clock64(); }
#undef PG8_STAMP
#undef PG8_SA
#undef PG8_SB
#undef PG8_STAGE
#undef PG8_LDA
#undef PG8_LDB
#undef PG8_MMA
#undef PG8_WAIT_V
#undef PG8_WAIT_L
#undef PG8_BAR
#undef PG8_SCHED
}
}

template <class F> struct EpiAdapt {
    static constexpr bool PERM = true, AFTER_DRAIN = false;
    F f;
    __device__ __forceinline__ void operator()(const pg8::f32x4 (&acc)[2][2][4][2], const pg8::Unit& u, int wr, int wc, int fr, int fq) const {
        constexpr int B = F::BATCH;
        const int row0 = u.pm * 256 + wr * 64 + fr, col0 = u.pn * 256 + wc * 32 + 8 * fq;
        f32x4 b0[2], b1[2];
        if constexpr (F::COLBIAS) { f.bias8(col0, b0[0], b1[0]); f.bias8(col0 + 128, b0[1], b1[1]); }
#pragma unroll
        for (int q0 = 0; q0 < 16; q0 += B) {
            typename F::Pre pre[B];
#pragma unroll
            for (int i = 0; i < B; ++i) { const int q = q0 + i, bj = q & 1, m = (q >> 1) & 3, ai = q >> 3; pre[i] = f.pre(row0 + ai * 128 + m * 16, col0 + bj * 128); }
#pragma unroll
            for (int i = 0; i < B; ++i) { const int q = q0 + i, bj = q & 1, m = (q >> 1) & 3, ai = q >> 3;
                f32x4 v0 = acc[ai][bj][m][0], v1 = acc[ai][bj][m][1];
                if constexpr (F::COLBIAS) { v0 += b0[bj]; v1 += b1[bj]; }
                f.put(row0 + ai * 128 + m * 16, col0 + bj * 128, v0, v1, pre[i]); }
        }
    }
};
template <class F>
DEVI void gemm_pg8(const bf16_t* A, const bf16_t* Bt, int M, int N, int K, const F& f, char* smem, int bid, int nblk) {
    pg8::Gemm g{A, Bt, M, N, K};
    pg8::StaticOrder S; S.init(M, N, nblk, bid);
    EpiAdapt<F> E{f};
    __syncthreads();
    pg8::gemm_phase<EpiAdapt<F>, pg8::StaticOrder, false>((PG8_LAS unsigned char*)smem, g, S, E, nullptr);
    __syncthreads();
}

template <class F>
DEVI void gemm_small_rows(const bf16_t* __restrict__ A, const bf16_t* __restrict__ Bt, int N, const F& f, char* smem, int bid, int nblk) {
    const int tid = tid_opq(), lane = tid & 63, wid = tid >> 6, fr = lane & 15, fq = lane >> 4;
    float* part = (float*)smem;
    const int ntn = N / 64, ntiles = (NTS / 32) * ntn;
    for (int tile = bid; tile < ntiles; tile += nblk) {
        const int tm = tile / ntn, tn = tile % ntn;
        const int row0 = NTP + tm * 32, col0 = tn * 64;
        f32x4 acc[2][4];
#pragma unroll
        for (int m = 0; m < 2; ++m)
#pragma unroll
            for (int n = 0; n < 4; ++n) acc[m][n] = (f32x4){0.f, 0.f, 0.f, 0.f};
        const bf16_t* ap = A + (size_t)(row0 + fr) * 1024 + wid * 128 + fq * 8;
        const bf16_t* bp = Bt + (size_t)(col0 + fr) * 1024 + wid * 128 + fq * 8;
        bf16x8 af[4][2], bfr[4][4];
#pragma unroll
        for (int ks = 0; ks < 4; ++ks) {
#pragma unroll
            for (int m = 0; m < 2; ++m) af[ks][m] = *(const bf16x8*)(ap + (size_t)m * 16 * 1024 + ks * 32);
#pragma unroll
            for (int n = 0; n < 4; ++n) bfr[ks][n] = *(const bf16x8*)(bp + (size_t)n * 16 * 1024 + ks * 32);
        }
#pragma unroll
        for (int ks = 0; ks < 4; ++ks)
#pragma unroll
            for (int m = 0; m < 2; ++m)
#pragma unroll
                for (int n = 0; n < 4; ++n) acc[m][n] = __builtin_amdgcn_mfma_f32_16x16x32_bf16(bfr[ks][n], af[ks][m], acc[m][n], 0, 0, 0);
        __syncthreads();
#pragma unroll
        for (int m = 0; m < 2; ++m)
#pragma unroll
            for (int n = 0; n < 4; ++n) *(f32x4*)(part + ((size_t)wid * 32 + m * 16 + fr) * 64 + n * 16 + fq * 4) = acc[m][n];
        __syncthreads();
        if (tid < 256) {
            const int r = tid >> 3, c8 = (tid & 7) * 8;
            f32x4 v0 = {0.f, 0.f, 0.f, 0.f}, v1 = v0;
#pragma unroll
            for (int w = 0; w < 8; ++w) { v0 += *(const f32x4*)(part + ((size_t)w * 32 + r) * 64 + c8); v1 += *(const f32x4*)(part + ((size_t)w * 32 + r) * 64 + c8 + 4); }
            const typename F::Pre pre = f.pre(row0 + r, col0 + c8);
            f.put(row0 + r, col0 + c8, v0, v1, pre);
        }
    }
}
template <class F>
DEVI void gemm_tail(const bf16_t* A, const bf16_t* Bt, int N, const F& f, char* smem, int bid, int nblk) {
    gemm_small_rows(A, Bt, N, f, smem, bid, nblk);
    gemm_pg8(A, Bt, NTP, N, 1024, f, smem, bid, nblk);
}

#define XB_TMO      128
#define XB_XCNT(j)  (256  + 64 * (j))
#define XB_XSUB(j)  (1280 + 64 * (j))
#define XB_XGEN(j)  (2304 + 64 * (j))
#define XB_TOP      3328
#define XB_TOPGEN   3392
#define XCD_BAR_WORDS 3456
#define XB_SPIN_CAP (1u << 18)
#define LAS __attribute__((address_space(3)))

__device__ __forceinline__ unsigned xb_ld(unsigned* p)              { return __hip_atomic_load(p, __ATOMIC_RELAXED, __HIP_MEMORY_SCOPE_AGENT); }
__device__ __forceinline__ unsigned xb_add(unsigned* p, unsigned v) { return __hip_atomic_fetch_add(p, v, __ATOMIC_RELAXED, __HIP_MEMORY_SCOPE_AGENT); }
__device__ __forceinline__ unsigned xb_xcc_id() { return (unsigned)__builtin_amdgcn_s_getreg((3 << 11) | 20) & 0xFu; }
#define XB_SPIN(cond, bar) do { unsigned _sp = 0; while (cond) { __builtin_amdgcn_s_sleep(1); \
    if ((++_sp & 255u) == 0u) { if (xb_ld(&(bar)[XB_TMO])) break; if (_sp > XB_SPIN_CAP) { atomicAdd(&(bar)[XB_TMO], 1u); break; } } } } while (0)

struct XcdBarrier {
    unsigned* bar; unsigned x;
    volatile LAS unsigned* st;
};

__device__ __forceinline__ XcdBarrier xcd_barrier_post(unsigned* bar, volatile LAS unsigned* st) {
    XcdBarrier b; b.bar = bar; b.x = xb_xcc_id(); b.st = st;
    if (tid_opq() == 0) (void)xb_add(&bar[XB_XCNT(b.x)], 1u);
    return b;
}
__device__ __forceinline__ void xcd_barrier_complete(unsigned* bar, unsigned x, unsigned& nloc, unsigned& nx) {
    const unsigned G = gridDim.x * gridDim.y * gridDim.z;
    unsigned sum, cnt, mine, sp = 0u;
    for (;;) {
        sum = 0u; cnt = 0u; mine = 0u;
#pragma unroll
        for (unsigned j = 0; j < 16; ++j) { const unsigned c = xb_ld(&bar[XB_XCNT(j)]); sum += c; cnt += (c > 0u) ? 1u : 0u; mine = (j == x) ? c : mine; }
        if (sum == G) break;
        __builtin_amdgcn_s_sleep(1);
        if ((++sp & 255u) == 0u) { if (xb_ld(&bar[XB_TMO])) break; if (sp > XB_SPIN_CAP) { atomicAdd(&bar[XB_TMO], 1u); break; } }
    }
    nloc = mine > 0u ? mine : 1u; nx = cnt > 0u ? cnt : 1u;
}

__device__ __forceinline__ void xcd_barrier(const XcdBarrier& b) {
    asm volatile("s_waitcnt vmcnt(0)" ::: "memory");
    __syncthreads();
    if (tid_opq() == 0) {
        unsigned* bar = b.bar;
        __builtin_amdgcn_s_waitcnt(0);
        unsigned nloc = b.st[0], nx = b.st[1];
        if (nloc == 0u) { xcd_barrier_complete(bar, b.x, nloc, nx); b.st[0] = nloc; b.st[1] = nx; }
        const unsigned old = xb_add(&bar[XB_XSUB(b.x)], 1u);
        const unsigned gen = old / nloc;
        if (old + 1u == (gen + 1u) * nloc) {
            __builtin_amdgcn_fence(__ATOMIC_RELEASE, "agent");
            asm volatile("s_waitcnt vmcnt(0)" ::: "memory");
            const unsigned og = xb_add(&bar[XB_TOP], 1u);
            const unsigned tg = og / nx;
            if (og + 1u == (tg + 1u) * nx) xb_add(&bar[XB_TOPGEN], 1u);
            else XB_SPIN(xb_ld(&bar[XB_TOPGEN]) == tg, bar);
            __builtin_amdgcn_fence(__ATOMIC_ACQUIRE, "agent");
            xb_add(&bar[XB_XGEN(b.x)], 1u);
            asm volatile("s_waitcnt vmcnt(0)" ::: "memory");
        } else {
            XB_SPIN(xb_ld(&bar[XB_XGEN(b.x)]) == gen, bar);
            __builtin_amdgcn_fence(__ATOMIC_ACQUIRE, "agent");
            asm volatile("s_waitcnt vmcnt(0)" ::: "memory");
        }
    }
    __syncthreads();
}

constexpr int LDS_BYTES = 152 * 1024;

template <int S>
DEVI void run_stage(const P& p, char* smem, int bid, int nblk) {
    if (S == 0) stage_prologue(p, smem, bid, nblk);
    if (S == 1) { EpiInProj e{p}; gemm_pg8(p.XB, p.WINT, NT, NPAD_IN + 2048, 1024, e, smem, bid, nblk); }
    if (S == 2) {
        stage2_queue(p, smem);
    }
    if (S == 4) { stage_mlstm_scan(p, bid, nblk); stage_nsa_attn(p, smem, bid, nblk); }
    if (S == 5) { stage_mlstm_out(p, smem, bid, nblk); { EpiM1 e{p}; gemm_tail(p.YB, p.WBT, 1024, e, smem, bid, nblk); } }
    if (S == 6) { EpiM2 e{p}; gemm_tail(p.YA, p.WAT, 1024, e, smem, bid, nblk); }
    if (S == 8) { EpiR e{p}; gemm_tail(p.MERGED, p.WOT, 1024, e, smem, bid, nblk); }
    if (S == 9) stage_ln1(p, bid, nblk);
    if (S == 10) { EpiPQ e{p}; gemm_tail(p.HB, p.WQT, 2048, e, smem, bid, nblk); }
    if (S == 11) {
        if (bid & 1) {
            for (int ps = 0; ps < 4; ++ps) { stage_peer_route(p, smem, bid, nblk, ps, ps + 1); __threadfence_block(); __syncthreads(); stage_peer_apply(p, smem, bid, nblk, ps, ps + 1); __syncthreads(); }
        } else { stage_peer_route(p, smem, bid, nblk, 0, 64); __threadfence_block(); __syncthreads(); stage_peer_apply(p, smem, bid, nblk, 0, 64); }
    }
}
constexpr int NSTAGES = 13;

template <int S>
__global__ void __launch_bounds__(512, 2) k_stage(P p) {
    extern __shared__ __attribute__((aligned(16))) char smem[];
    run_stage<S>(p, smem, blockIdx.x, gridDim.x);
}


#if MK_ONE_LAUNCH
__global__ void __launch_bounds__(512, 2) k_mega(P p) {
    extern __shared__ __attribute__((aligned(16))) char smem_all[];
    if (tid_opq() == 0) *(u32x4*)smem_all = (u32x4){0u, 0u, 0u, 0u};
    __syncthreads();
    XcdBarrier bar = xcd_barrier_post(p.bar, (volatile LAS unsigned*)smem_all);
    char* smem = smem_all + 16;
    const int bid = blockIdx.x, nblk = gridDim.x;
    run_stage<0>(p, smem, bid, nblk); if ((REP_MASK >> 0) & 1) { xcd_barrier(bar); run_stage<0>(p, smem, bid, nblk); }  xcd_barrier(bar);
    run_stage<1>(p, smem, bid, nblk); if ((REP_MASK >> 1) & 1) { xcd_barrier(bar); run_stage<1>(p, smem, bid, nblk); }  xcd_barrier(bar);
    run_stage<2>(p, smem, bid, nblk); if ((REP_MASK >> 2) & 1) { xcd_barrier(bar); run_stage<2>(p, smem, bid, nblk); }  xcd_barrier(bar);
    run_stage<4>(p, smem, bid, nblk); if ((REP_MASK >> 4) & 1) { xcd_barrier(bar); run_stage<4>(p, smem, bid, nblk); }  xcd_barrier(bar);
    run_stage<5>(p, smem, bid, nblk); if ((REP_MASK >> 5) & 1) { xcd_barrier(bar); run_stage<5>(p, smem, bid, nblk); }  xcd_barrier(bar);
    run_stage<6>(p, smem, bid, nblk); if ((REP_MASK >> 6) & 1) { xcd_barrier(bar); run_stage<6>(p, smem, bid, nblk); }  xcd_barrier(bar);
    run_stage<8>(p, smem, bid, nblk); if ((REP_MASK >> 8) & 1) { xcd_barrier(bar); run_stage<8>(p, smem, bid, nblk); }  xcd_barrier(bar);
    run_stage<9>(p, smem, bid, nblk); if ((REP_MASK >> 9) & 1) { xcd_barrier(bar); run_stage<9>(p, smem, bid, nblk); }  xcd_barrier(bar);
    run_stage<10>(p, smem, bid, nblk); if ((REP_MASK >> 10) & 1) { xcd_barrier(bar); run_stage<10>(p, smem, bid, nblk); } xcd_barrier(bar);
    run_stage<11>(p, smem, bid, nblk); if ((REP_MASK >> 11) & 1) { xcd_barrier(bar); run_stage<11>(p, smem, bid, nblk); }
}
#endif

template <int S> static void launch_stage(const P& p, int grid, hipStream_t stream) {
    (void)hipFuncSetAttribute((const void*)k_stage<S>, hipFuncAttributeMaxDynamicSharedMemorySize, LDS_BYTES);
    k_stage<S><<<dim3(grid), dim3(512), LDS_BYTES, stream>>>(p);
}

extern "C" void kernel_launch(void* const* d_in, const int* in_sizes, int n_in, void* d_out, int out_size, void* d_ws, size_t ws_size, hipStream_t stream) {
    (void)in_sizes; (void)n_in; (void)out_size; (void)ws_size;
    P p{};
    p.xp = (const float*)d_in[0]; p.xs = (const float*)d_in[1]; p.cache_cmp = (const float*)d_in[2]; p.cache_slc = (const float*)d_in[3];
    p.cache_win = (const float*)d_in[4]; p.state_C = (const float*)d_in[5]; p.state_n = (const float*)d_in[6]; p.state_m = (const float*)d_in[7];
    p.page_table = (const int*)d_in[8];
    p.w_in = (const float*)d_in[9]; p.b_in = (const float*)d_in[10]; p.norm_a_g = (const float*)d_in[11]; p.nsa_pe = (const float*)d_in[12];
    p.nsa_w_cmp = (const float*)d_in[13]; p.w_br_a = (const float*)d_in[14]; p.w_br_b = (const float*)d_in[15]; p.w_merge = (const float*)d_in[16];
    p.w_out = (const float*)d_in[17]; p.ln1_g = (const float*)d_in[18]; p.ln1_b = (const float*)d_in[19];
    p.peer_wq = (const float*)d_in[20]; p.peer_keys = (const float*)d_in[21]; p.peer_u = (const float*)d_in[22]; p.peer_v = (const float*)d_in[23];
    p.ln2_g = (const float*)d_in[24]; p.ln2_b = (const float*)d_in[25];
    p.out = (float*)d_out;
    char* w = (char*)d_ws; size_t off = 0;
    auto take = [&](size_t bytes) { char* r = w + off; off += (bytes + 255) & ~(size_t)255; return r; };
    p.bar = (unsigned*)take(16384);
    p.PW = (float*)(p.bar + 3584);
    p.WCT = (bf16_t*)take((size_t)2 * 64 * 4096 * 2);
    p.XB = (bf16_t*)take((size_t)NT * 1024 * 2);
    p.WINT = (bf16_t*)take((size_t)(NPAD_IN + 2048) * 1024 * 2);
    p.WMT = (bf16_t*)take((size_t)2048 * 1024 * 2);
    p.WAT = (bf16_t*)take((size_t)1024 * 1024 * 2);
    p.WBT = (bf16_t*)take((size_t)1024 * 1024 * 2);
    p.WOT = (bf16_t*)take((size_t)1024 * 1024 * 2);
    p.WQT = (bf16_t*)take((size_t)2048 * 1024 * 2);
    p.KEYSB = (bf16_t*)take((size_t)16 * 128 * 128 * 2);
    p.U8 = (unsigned char*)take((size_t)16384 * 768 + 256);
    p.V8 = (unsigned char*)take((size_t)16384 * 768 + 256);
    p.US = (float*)take(16384 * 4);
    p.VS = (float*)take(16384 * 4);
    p.PROJ = (bf16_t*)take((size_t)NT * PS * 2);
    p.SM = (float*)take((size_t)NT * 64 * 4);
    p.BCUM = (float*)take((size_t)16 * 4096 * 4);
    p.MPREV = (float*)take(4096); p.ACOEF = (float*)take(4096); p.SCL = (float*)take(4096); p.MLOC = (float*)take(4096);
    p.DC = (float*)take((size_t)1024 * 272 * 128 * 4);
    p.CPT = (bf16_t*)take((size_t)1024 * 272 * 128 * 2);
    p.KC = (float*)take((size_t)4352 * 512 * 4);
    p.VC = p.KC + 256;
    p.OCMP = (float*)take((size_t)NT * 1024 * 4);
    p.SEL = (unsigned long long*)take((size_t)NT * 4 * 8);
    p.YA = (bf16_t*)take((size_t)NT * 1024 * 2);
    p.YB = (bf16_t*)take((size_t)NT * 1024 * 2);
    p.G = (bf16_t*)take((size_t)NT * 2048 * 2);
    p.TMPB = (bf16_t*)take((size_t)NT * 1024 * 2);
    p.MERGED = (bf16_t*)take((size_t)NT * 1024 * 2);
    p.R = (float*)take((size_t)NT * 1024 * 4);
    p.H = (float*)take((size_t)NT * 1024 * 4);
    p.HB = (bf16_t*)take((size_t)NT * 1024 * 2);
    p.PQ = (bf16_t*)take((size_t)NT * 2048 * 2);
    p.EIDX = (int*)take((size_t)NT * 128 * 4);
    p.EGATE = (float*)take((size_t)NT * 128 * 4);

    (void)hipMemsetAsync(p.bar, 0, 16384, stream);
#if MK_ONE_LAUNCH
    {
        constexpr size_t kDynLds = LDS_BYTES + 16;
        (void)hipFuncSetAttribute((const void*)k_mega, hipFuncAttributeMaxDynamicSharedMemorySize, (int)kDynLds);
        int dev = 0, cus = 0, per_cu = 0;
        (void)hipGetDevice(&dev);
        (void)hipDeviceGetAttribute(&cus, hipDeviceAttributeMultiprocessorCount, dev);
        (void)hipOccupancyMaxActiveBlocksPerMultiprocessor(&per_cu, (const void*)k_mega, 512, kDynLds);
        if (per_cu < 1 || cus < 1) return;
        const int grid = cus;
        k_mega<<<dim3(grid), dim3(512), kDynLds, stream>>>(p);
    }
#else
    const int grid = 512;
    launch_stage<0>(p, grid, stream);
    launch_stage<1>(p, grid, stream);
    launch_stage<2>(p, grid, stream);
    launch_stage<4>(p, grid, stream);
    launch_stage<5>(p, grid, stream);
    launch_stage<6>(p, grid, stream);
    launch_stage<8>(p, grid, stream);
    launch_stage<9>(p, grid, stream);
    launch_stage<10>(p, grid, stream);
    launch_stage<11>(p, grid, stream);
#endif
}
```
